# Optimizing an MI355X kernel written in HIP

```python
import math
import jax, jax.numpy as jnp
from jax import lax
import numpy as np

D_MODEL = 2048
BATCH = 2
SEQ = 16384
DEPTH = 2

CHUNK = 64
Q_BLOCK = 128
NORM_EPS = 1e-6

A_HEADS = 8
A_HEAD_DIM = 128
IDX_HEADS = 16
IDX_DIM = 64
TOPK_MAX = 256
POOL_WINDOWS = (2, 4, 8, 16)
POOL_GROUP = 256
POOL_WIDTH = POOL_GROUP * len(POOL_WINDOWS)
C_HEADS = 8
Q_LORA = 512
KV_LORA = 256
QK_NOPE = 128
QK_ROPE = 64
V_HEAD = 128
ROPE_THETA = 10000.0
LRU_WIDTH = 1024
LRU_BLOCKS = 8
LRU_CONV = 4
LRU_C = 8.0
D_FF = 4096
FFN_CONV = 3

A_WIDTH = A_HEADS * A_HEAD_DIM
AB_IN = 3 * A_WIDTH + IDX_HEADS * IDX_DIM + IDX_DIM + IDX_HEADS + POOL_WIDTH
AB_OUT = A_WIDTH + POOL_WIDTH
CD_IN = Q_LORA + KV_LORA + QK_ROPE + 2 * LRU_WIDTH
CD_OUT = C_HEADS * V_HEAD + LRU_WIDTH
N_EVEN = (DEPTH + 1) // 2
N_ODD = DEPTH // 2

kernel_name = 'hybrid_dsa_pool_mla_rglru_convffn'


def rms_norm(x, g):
    xf = x.astype(jnp.float32)
    y = xf * lax.rsqrt(jnp.mean(xf * xf, axis=-1, keepdims=True) + NORM_EPS)
    return (y * g.astype(jnp.float32)).astype(x.dtype)


def causal_dwconv(x, w, b):
    K = w.shape[0]
    T = x.shape[1]
    xp = jnp.pad(x, ((0, 0), (K - 1, 0), (0, 0)))
    y = xp[:, 0:T] * w[0]
    for k in range(1, K):
        y = y + xp[:, k:k + T] * w[k]
    return y + b


def chunk_limit(q_pos):
    return (q_pos // CHUNK + 1) * CHUNK


def rope(x, pos):
    half = x.shape[-1] // 2
    freq = ROPE_THETA ** (-jnp.arange(half, dtype=jnp.float32) / half)
    ang = pos.astype(jnp.float32)[:, :, None, None] * freq
    cos, sin = jnp.cos(ang), jnp.sin(ang)
    xf = x.astype(jnp.float32)
    x1, x2 = xf[..., :half], xf[..., half:]
    return jnp.concatenate([x1 * cos - x2 * sin, x2 * cos + x1 * sin], axis=-1).astype(x.dtype)


def dsa_attention(q, k, v, q_idx, k_idx, w_idx):
    Bsz, T = q.shape[:2]
    k_top = min(TOPK_MAX, T // 4)
    n_blocks = T // Q_BLOCK
    key_pos = jnp.arange(T)
    idx_scale = (IDX_DIM ** -0.5) * (IDX_HEADS ** -0.5)
    att_scale = A_HEAD_DIM ** -0.5

    def block(i):
        start = i * Q_BLOCK
        qb = lax.dynamic_slice_in_dim(q, start, Q_BLOCK, 1)
        qib = lax.dynamic_slice_in_dim(q_idx, start, Q_BLOCK, 1)
        wb = lax.dynamic_slice_in_dim(w_idx, start, Q_BLOCK, 1)
        limit = chunk_limit(start + jnp.arange(Q_BLOCK))
        admissible = key_pos[None, :] < limit[:, None]
        logits = jnp.einsum('bqhd,bsd->bqhs', qib, k_idx, preferred_element_type=jnp.float32)
        score = jnp.einsum('bqhs,bqh->bqs', jax.nn.relu(logits), wb.astype(jnp.float32)) * idx_scale
        score = jnp.where(admissible[None], score, -jnp.inf)
        _, sel = lax.top_k(score, k_top)
        sel_ok = sel < limit[None, :, None]
        k_sel = jax.vmap(lambda kb, ib: kb[ib])(k, sel)
        v_sel = jax.vmap(lambda vb, ib: vb[ib])(v, sel)
        s = jnp.einsum('bqhd,bqkhd->bhqk', qb, k_sel, preferred_element_type=jnp.float32) * att_scale
        s = jnp.where(sel_ok[:, None], s, -jnp.inf)
        p = jax.nn.softmax(s, axis=-1)
        return jnp.einsum('bhqk,bqkhd->bqhd', p.astype(v.dtype), v_sel)

    out = lax.map(block, jnp.arange(n_blocks))
    return jnp.moveaxis(out, 0, 1).reshape(Bsz, T, A_WIDTH)


def multiscale_pool(u, w, b, scale):
    Bsz, T, _ = u.shape
    G = len(POOL_WINDOWS)
    uf = u.reshape(Bsz, T, G, POOL_GROUP).astype(jnp.float32)
    csum = jnp.cumsum(uf, axis=1)
    t = jnp.arange(T)
    outs = []
    for g, win in enumerate(POOL_WINDOWS):
        c = csum[:, :, g]
        c_prev = jnp.pad(c, ((0, 0), (win, 0), (0, 0)))[:, :T]
        count = jnp.minimum(t + 1, win).astype(jnp.float32)[None, :, None]
        outs.append((c - c_prev) / count - uf[:, :, g])
    pooled = jnp.stack(outs, axis=2).astype(u.dtype)
    mixed = jnp.einsum('btgc,gcd->btgd', pooled, w) + b
    return mixed.reshape(Bsz, T, POOL_WIDTH) * scale


def mla_attention(c_q, c_kv, k_rope_in, positions, q_norm_g, w_q_up, kv_norm_g, w_kv_up):
    Bsz, T = c_q.shape[:2]
    q = (rms_norm(c_q, q_norm_g) @ w_q_up).reshape(Bsz, T, C_HEADS, QK_NOPE + QK_ROPE)
    kv = (rms_norm(c_kv, kv_norm_g) @ w_kv_up).reshape(Bsz, T, C_HEADS, QK_NOPE + V_HEAD)
    q_nope = q[..., :QK_NOPE]
    q_rope = rope(q[..., QK_NOPE:], positions)
    k_nope = kv[..., :QK_NOPE]
    v = kv[..., QK_NOPE:]
    k_rope = rope(k_rope_in[:, :, None, :], positions)[:, :, 0]
    scale = (QK_NOPE + QK_ROPE) ** -0.5
    key_pos = jnp.arange(T)
    n_blocks = T // Q_BLOCK

    def block(i):
        start = i * Q_BLOCK
        qn = lax.dynamic_slice_in_dim(q_nope, start, Q_BLOCK, 1)
        qr = lax.dynamic_slice_in_dim(q_rope, start, Q_BLOCK, 1)
        limit = chunk_limit(start + jnp.arange(Q_BLOCK))
        admissible = key_pos[None, :] < limit[:, None]
        s = (jnp.einsum('bqhd,bshd->bhqs', qn, k_nope, preferred_element_type=jnp.float32)
             + jnp.einsum('bqhr,bsr->bhqs', qr, k_rope, preferred_element_type=jnp.float32)) * scale
        s = jnp.where(admissible[None, None], s, -jnp.inf)
        p = jax.nn.softmax(s, axis=-1)
        return jnp.einsum('bhqs,bshd->bqhd', p.astype(v.dtype), v)

    out = lax.map(block, jnp.arange(n_blocks))
    return jnp.moveaxis(out, 0, 1).reshape(Bsz, T, C_HEADS * V_HEAD)


def rg_lru_branch(x_in, y_in, conv_w, conv_b, wa, ba, wx, bx, lam):
    Bsz, T, _ = x_in.shape
    xc = causal_dwconv(x_in, conv_w, conv_b)
    xb = xc.reshape(Bsz, T, LRU_BLOCKS, LRU_WIDTH // LRU_BLOCKS)
    gate_r = jax.nn.sigmoid(jnp.einsum('btnc,ncd->btnd', xb, wa).reshape(Bsz, T, LRU_WIDTH) + ba)
    gate_i = jax.nn.sigmoid(jnp.einsum('btnc,ncd->btnd', xb, wx).reshape(Bsz, T, LRU_WIDTH) + bx)
    log_a = (-LRU_C * gate_r.astype(jnp.float32)) * jax.nn.softplus(-lam.astype(jnp.float32))
    a = jnp.exp(log_a)
    mult = jnp.sqrt(-jnp.expm1(2.0 * log_a))
    bterm = mult * (gate_i * xc).astype(jnp.float32)

    def combine(lhs, rhs):
        a_l, b_l = lhs
        a_r, b_r = rhs
        return a_l * a_r, a_r * b_l + b_r

    _, h = lax.associative_scan(combine, (a, bterm), axis=1)
    return h.astype(x_in.dtype) * jax.nn.gelu(y_in, approximate=True)


def mixer_ab(h, w_in, pool_w, pool_b, pool_scale, w_out):
    Bsz, T, _ = h.shape
    z = h @ w_in
    sizes = [A_WIDTH, A_WIDTH, A_WIDTH, IDX_HEADS * IDX_DIM, IDX_DIM, IDX_HEADS]
    cuts = [int(c) for c in np.cumsum(sizes)]
    q, k, v, qi, ki, wi, u = jnp.split(z, cuts, axis=-1)
    heads = (Bsz, T, A_HEADS, A_HEAD_DIM)
    a_out = dsa_attention(q.reshape(heads), k.reshape(heads), v.reshape(heads),
                          qi.reshape(Bsz, T, IDX_HEADS, IDX_DIM), ki, wi)
    b_out = multiscale_pool(u, pool_w, pool_b, pool_scale)
    return jnp.concatenate([a_out, b_out], axis=-1) @ w_out


def mixer_cd(h, positions, w_in, q_norm_g, w_q_up, kv_norm_g, w_kv_up,
             conv_w, conv_b, wa, ba, wx, bx, lam, w_out):
    z = h @ w_in
    sizes = [Q_LORA, KV_LORA, QK_ROPE, LRU_WIDTH]
    cuts = [int(c) for c in np.cumsum(sizes)]
    c_q, c_kv, k_rope, x_lru, y_gate = jnp.split(z, cuts, axis=-1)
    c_out = mla_attention(c_q, c_kv, k_rope, positions, q_norm_g, w_q_up, kv_norm_g, w_kv_up)
    d_out = rg_lru_branch(x_lru, y_gate, conv_w, conv_b, wa, ba, wx, bx, lam)
    return jnp.concatenate([c_out, d_out], axis=-1) @ w_out


def channel_mixer(h, up, conv_w, conv_b, down):
    hid = causal_dwconv(h @ up, conv_w, conv_b)
    gate, val = jnp.split(hid, 2, axis=-1)
    return (jax.nn.gelu(gate, approximate=True) * val) @ down


def setup_inputs(seed: int = 0) -> dict:
    key = jax.random.key(seed)
    keys = iter(jax.random.split(key, 40))

    def dense(shape, fan_in):
        return jax.random.normal(next(keys), shape, jnp.float32) * (fan_in ** -0.5)

    def gain(shape):
        return 1.0 + 0.05 * jax.random.normal(next(keys), shape, jnp.float32)

    def small(shape, s=0.02):
        return s * jax.random.normal(next(keys), shape, jnp.float32)

    x = jax.random.normal(next(keys), (BATCH, SEQ, D_MODEL), jnp.float32)
    offset = jax.random.randint(next(keys), (BATCH, 1), 0, 64) * CHUNK
    positions = (offset + jnp.arange(SEQ)[None, :]).astype(jnp.int32)
    u = jax.random.uniform(next(keys), (N_ODD, LRU_WIDTH), jnp.float32, 0.9, 0.999)
    s = u ** (1.0 / LRU_C)
    lru_lambda = jnp.log(s) - jnp.log1p(-s)
    bw = LRU_WIDTH // LRU_BLOCKS
    return {
        'x': x,
        'positions': positions,
        'mix_pre_g': gain((DEPTH, D_MODEL)),
        'mix_post_g': gain((DEPTH, D_MODEL)),
        'ffn_pre_g': gain((DEPTH, D_MODEL)),
        'ffn_post_g': gain((DEPTH, D_MODEL)),
        'ffn_up': dense((DEPTH, D_MODEL, 2 * D_FF), D_MODEL),
        'ffn_conv_w': dense((DEPTH, FFN_CONV, 2 * D_FF), FFN_CONV),
        'ffn_conv_b': small((DEPTH, 2 * D_FF)),
        'ffn_down': dense((DEPTH, D_FF, D_MODEL), D_FF),
        'ab_w_in': dense((N_EVEN, D_MODEL, AB_IN), D_MODEL),
        'pool_w': dense((N_EVEN, len(POOL_WINDOWS), POOL_GROUP, POOL_GROUP), POOL_GROUP),
        'pool_b': small((N_EVEN, len(POOL_WINDOWS), POOL_GROUP)),
        'pool_scale': 1.0 + 0.1 * jax.random.normal(next(keys), (N_EVEN, POOL_WIDTH), jnp.float32),
        'ab_w_out': dense((N_EVEN, AB_OUT, D_MODEL), AB_OUT),
        'cd_w_in': dense((N_ODD, D_MODEL, CD_IN), D_MODEL),
        'q_norm_g': gain((N_ODD, Q_LORA)),
        'w_q_up': dense((N_ODD, Q_LORA, C_HEADS * (QK_NOPE + QK_ROPE)), Q_LORA),
        'kv_norm_g': gain((N_ODD, KV_LORA)),
        'w_kv_up': dense((N_ODD, KV_LORA, C_HEADS * (QK_NOPE + V_HEAD)), KV_LORA),
        'lru_conv_w': dense((N_ODD, LRU_CONV, LRU_WIDTH), LRU_CONV),
        'lru_conv_b': small((N_ODD, LRU_WIDTH)),
        'lru_wa': dense((N_ODD, LRU_BLOCKS, bw, bw), bw),
        'lru_ba': small((N_ODD, LRU_WIDTH), 0.1),
        'lru_wx': dense((N_ODD, LRU_BLOCKS, bw, bw), bw),
        'lru_bx': small((N_ODD, LRU_WIDTH), 0.1),
        'lru_lambda': lru_lambda,
        'cd_w_out': dense((N_ODD, CD_OUT, D_MODEL), CD_OUT),
    }


def reference(x, positions, mix_pre_g, mix_post_g, ffn_pre_g, ffn_post_g,
              ffn_up, ffn_conv_w, ffn_conv_b, ffn_down,
              ab_w_in, pool_w, pool_b, pool_scale, ab_w_out,
              cd_w_in, q_norm_g, w_q_up, kv_norm_g, w_kv_up,
              lru_conv_w, lru_conv_b, lru_wa, lru_ba, lru_wx, lru_bx, lru_lambda, cd_w_out):
    for layer in range(DEPTH):
        j = layer // 2
        h = rms_norm(x, mix_pre_g[layer])
        if layer % 2 == 0:
            m = mixer_ab(h, ab_w_in[j], pool_w[j], pool_b[j], pool_scale[j], ab_w_out[j])
        else:
            m = mixer_cd(h, positions, cd_w_in[j], q_norm_g[j], w_q_up[j], kv_norm_g[j], w_kv_up[j],
                         lru_conv_w[j], lru_conv_b[j], lru_wa[j], lru_ba[j], lru_wx[j], lru_bx[j],
                         lru_lambda[j], cd_w_out[j])
        x = x + rms_norm(m, mix_post_g[layer])
        h = rms_norm(x, ffn_pre_g[layer])
        f = channel_mixer(h, ffn_up[layer], ffn_conv_w[layer], ffn_conv_b[layer], ffn_down[layer])
        x = x + rms_norm(f, ffn_post_g[layer])
    return x
```

```cpp
#include <hip/hip_runtime.h>
#include <stdint.h>
#include <stdio.h>

#define LAS __attribute__((address_space(3)))
typedef unsigned short bf16_t;
typedef float f32x4 __attribute__((ext_vector_type(4)));
typedef unsigned u32x4 __attribute__((ext_vector_type(4)));
typedef unsigned u32x2 __attribute__((ext_vector_type(2)));

static constexpr int NTOK = 32768, SEQ = 16384, NBATCH = 2, DM = 2048, DFF = 4096;
static constexpr float NORM_EPS = 1e-6f;

__device__ __forceinline__ bf16_t f2bf(float f) { unsigned u = __float_as_uint(f); u += 0x7FFFu + ((u >> 16) & 1u); return (bf16_t)(u >> 16); }
__device__ __forceinline__ float bf2f(bf16_t b) { return __uint_as_float(((unsigned)b) << 16); }
__device__ __forceinline__ unsigned pack2bf(float lo, float hi) { return (unsigned)f2bf(lo) | ((unsigned)f2bf(hi) << 16); }
__device__ __forceinline__ float gelu_tanh(float x) { const float u = 0.7978845608028654f * (x + 0.044715f * x * x * x); return 0.5f * x * (1.0f + tanhf(u)); }
__device__ __forceinline__ float wave_sum(float v) {
#pragma unroll
    for (int o = 32; o >= 1; o >>= 1) v += __shfl_xor(v, o);
    return v;
}

#include <hip/hip_runtime.h>
namespace pg8 {
#define PG8_LAS __attribute__((address_space(3)))
typedef unsigned short bf16_t;
typedef short bf16x8 __attribute__((ext_vector_type(8)));
typedef float f32x4 __attribute__((ext_vector_type(4)));
typedef unsigned u32x4 __attribute__((ext_vector_type(4)));
constexpr int BM = 256, BK = 64, HALF = 128, HTB = HALF * BK * 2  , STAGE_BYTES = 8 * HTB, NXCD = 8, WGM = 8;

__host__ __device__ __forceinline__ int lds_byte(int r, int c) { const int st = (r >> 4) * 2 + (c >> 5), rr = r & 15, cc = c & 31, ob = rr * 64 + cc * 2; return st * 1024 + (ob ^ (((ob >> 9) & 1) << 5)); }
__host__ __device__ __forceinline__ void stage_rc(int b, int& R, int& C) { const int st = b / 1024, sb = b % 1024, swz = sb ^ (((sb >> 9) & 1) << 5); R = (st >> 1) * 16 + swz / 64; C = (st & 1) * 32 + (swz % 64) / 2; }
__host__ __device__ __forceinline__ int perm32(int rho) { const int n = rho >> 4, i = rho & 15; return 8 * (i >> 2) + 4 * n + (i & 3); }

struct Unit { int pm, pn; };
struct Gemm { const bf16_t* A; const bf16_t* Bt; int M, N, K, lda, ldb, pad_; };

struct StaticOrder {
    int nM, nN, nwg, G, c;
    __host__ __device__ void init(int M, int N, int G_, int c_) { nM = M / BM; nN = N / BM; nwg = nM * nN; G = G_; c = c_; }
    __host__ __device__ bool next(int i, Unit& u) const {
        const long L = (long)i * G + c; if (L >= nwg) return false;
        int wgid = (int)L; { const int q = nwg / NXCD, r = nwg % NXCD, xcd = wgid % NXCD, off = wgid / NXCD; wgid = (xcd < r ? xcd * (q + 1) : r * (q + 1) + (xcd - r) * q) + off; }
        const int nig = WGM * nN, gid = wgid / nig, fm = gid * WGM, gsz = (nM - fm) < WGM ? (nM - fm) : WGM;
        u.pm = fm + ((wgid % nig) % gsz); u.pn = (wgid % nig) / gsz; return true;
    }
    __device__ __forceinline__ void a_ready(const Unit&) const {}
    __device__ __forceinline__ void done(const Unit&) const {}
};

template <class Epi, class Sched, bool STAMP = false>
__device__ __forceinline__ void gemm_phase(PG8_LAS unsigned char* lds, const Gemm g, const Sched& S, const Epi& E, unsigned long long* stamps) {
    const int tid = threadIdx.x, wid = __builtin_amdgcn_readfirstlane(tid >> 6), lane = tid & 63, wr = wid >> 2, wc = wid & 3, fr = lane & 15, fq = lane >> 4;
    const int K = g.K, nt = K / BK;
    int ts_lo = 0, ts_hi = 0, nts = 0; const unsigned long long rt_entry = STAMP ? (unsigned long long)wall_clock64() : 0ull;
#define PG8_STAMP() do { if (STAMP && wid == 0 && nts < 64) { const unsigned long long _c = (unsigned long long)clock64(); \
        ts_lo = (lane == nts) ? (int)(unsigned)_c : ts_lo; ts_hi = (lane == nts) ? (int)(unsigned)(_c >> 32) : ts_hi; ++nts; } } while (0)
    PG8_STAMP();
    unsigned voffA[2], voffB[2];
#pragma unroll
    for (int i = 0; i < 2; ++i) { int R, C; stage_rc(tid * 16 + i * 8192, R, C); const int Rb = Epi::PERM ? ((R & ~31) + perm32(R & 31)) : R;
        voffA[i] = (unsigned)(R * g.lda + C) * 2u; voffB[i] = (unsigned)(Rb * g.ldb + C) * 2u; }
    const size_t kstep = (size_t)(BK * 2);
    const size_t hstepA = (size_t)HALF * g.lda * 2, hstepB = (size_t)HALF * g.ldb * 2;
    const size_t tstepA = 2 * hstepA, tstepB = 2 * hstepB;
    const unsigned ldsw = (unsigned)wid * 1024u;
    const int aoff = lds_byte(wr * 64 + fr, fq * 8), boff = lds_byte(wc * 32 + fr, fq * 8);
#define PG8_SA(b, h) (((b) * 2 + (h)) * HTB)
#define PG8_SB(b, h) ((4 + (b) * 2 + (h)) * HTB)
#define PG8_STAGE(bufoff, gbase, voff) do { _Pragma("unroll") for (int _i = 0; _i < 2; ++_i) \
        __builtin_amdgcn_global_load_lds((const unsigned*)((const char*)(gbase) + (voff)[_i]), (PG8_LAS unsigned*)(lds + (bufoff) + ldsw + _i * 8192), 16, 0, 0); } while (0)
#define PG8_LDA(dst, b, h) do { _Pragma("unroll") for (int m = 0; m < 4; ++m) _Pragma("unroll") for (int k = 0; k < 2; ++k) dst[m][k] = *(const PG8_LAS bf16x8*)(lds + PG8_SA(b, h) + aoff + m * 2048 + k * 1024); } while (0)
#define PG8_LDB(dst, b, h) do { _Pragma("unroll") for (int n = 0; n < 2; ++n) _Pragma("unroll") for (int k = 0; k < 2; ++k) dst[n][k] = *(const PG8_LAS bf16x8*)(lds + PG8_SB(b, h) + boff + n * 2048 + k * 1024); } while (0)
#define PG8_MMA(ai, bj, At, Bt) do { __builtin_amdgcn_s_setprio(1); _Pragma("unroll") for (int m = 0; m < 4; ++m) _Pragma("unroll") for (int n = 0; n < 2; ++n) _Pragma("unroll") for (int k = 0; k < 2; ++k) \
        acc[ai][bj][m][n] = __builtin_amdgcn_mfma_f32_16x16x32_bf16(Bt[n][k], At[m][k], acc[ai][bj][m][n], 0, 0, 0); __builtin_amdgcn_s_setprio(0); } while (0)
#define PG8_WAIT_V(n) asm volatile("s_waitcnt vmcnt(" #n ")" ::: "memory")
#define PG8_WAIT_L(n) asm volatile("s_waitcnt lgkmcnt(" #n ")" ::: "memory")
#define PG8_BAR __builtin_amdgcn_s_barrier()
#define PG8_SCHED __builtin_amdgcn_sched_barrier(0)
    Unit cur, nxt; int ui = 0;
    if (!S.next(0, cur)) return;
    f32x4 acc[2][2][4][2];
#pragma unroll
    for (int a = 0; a < 2; ++a)
#pragma unroll
        for (int b = 0; b < 2; ++b)
#pragma unroll
            for (int m = 0; m < 4; ++m)
#pragma unroll
                for (int n = 0; n < 2; ++n) acc[a][b][m][n] = (f32x4){0.f, 0.f, 0.f, 0.f};
    bf16x8 At[4][2], B0[2][2], B1[2][2];
    const char* cA = (const char*)g.A + (size_t)cur.pm * tstepA; const char* cB = (const char*)g.Bt + (size_t)cur.pn * tstepB;
    S.a_ready(cur);
    PG8_STAGE(PG8_SB(0, 0), cB, voffB); PG8_STAGE(PG8_SA(0, 0), cA, voffA); PG8_STAGE(PG8_SB(0, 1), cB + hstepB, voffB); PG8_STAGE(PG8_SA(0, 1), cA + hstepA, voffA);
    if (wr == 1) PG8_BAR;
    PG8_WAIT_V(4); PG8_BAR;
    PG8_STAGE(PG8_SB(1, 0), cB + kstep, voffB); PG8_STAGE(PG8_SA(1, 0), cA + kstep, voffA); PG8_STAGE(PG8_SB(1, 1), cB + hstepB + kstep, voffB);
    PG8_WAIT_V(6); PG8_BAR;
    PG8_STAMP();
    for (;;) {
        const bool has_next = S.next(ui + 1, nxt);
        const char* nA = has_next ? (const char*)g.A + (size_t)nxt.pm * tstepA : cA; const char* nB = has_next ? (const char*)g.Bt + (size_t)nxt.pn * tstepB : cB;
        for (int t = 0; t < nt; t += 2) {
            const bool last = (t == nt - 2);
            const char* a1 = cA + (size_t)(t + 1) * kstep;
            const char* a2 = last ? nA : cA + (size_t)(t + 2) * kstep; const char* b2 = last ? nB : cB + (size_t)(t + 2) * kstep;
            const char* a3 = a2 + kstep; const char* b3 = b2 + kstep;
            if (last && has_next) S.a_ready(nxt);
            PG8_LDB(B0, 0, 0); PG8_SCHED; PG8_LDA(At, 0, 0); PG8_STAGE(PG8_SA(1, 1), a1 + hstepA, voffA);
            PG8_WAIT_L(8); PG8_BAR; PG8_WAIT_L(0); PG8_MMA(0, 0, At, B0); PG8_BAR; PG8_SCHED;
            PG8_LDB(B1, 0, 1); PG8_STAGE(PG8_SB(0, 0), b2, voffB);
            PG8_BAR; PG8_WAIT_L(0); PG8_MMA(0, 1, At, B1); PG8_BAR;
            PG8_LDA(At, 0, 1); PG8_STAGE(PG8_SA(0, 0), a2, voffA);
            PG8_BAR; PG8_WAIT_L(0); PG8_MMA(1, 0, At, B0); PG8_BAR; PG8_SCHED;
            PG8_STAGE(PG8_SB(0, 1), b2 + hstepB, voffB);
            PG8_WAIT_V(6); PG8_BAR; PG8_MMA(1, 1, At, B1); PG8_BAR;
            PG8_LDB(B0, 1, 0); PG8_SCHED; PG8_LDA(At, 1, 0); PG8_STAGE(PG8_SA(0, 1), a2 + hstepA, voffA);
            PG8_WAIT_L(8); PG8_BAR; PG8_WAIT_L(0); PG8_MMA(0, 0, At, B0); PG8_BAR; PG8_SCHED;
            PG8_LDB(B1, 1, 1); PG8_STAGE(PG8_SB(1, 0), b3, voffB);
            PG8_BAR; PG8_WAIT_L(0); PG8_MMA(0, 1, At, B1); PG8_BAR;
            PG8_LDA(At, 1, 1); PG8_STAGE(PG8_SA(1, 0), a3, voffA);
            PG8_BAR; PG8_WAIT_L(0); PG8_MMA(1, 0, At, B0); PG8_BAR; PG8_SCHED;
            PG8_STAGE(PG8_SB(1, 1), b3 + hstepB, voffB);
            PG8_WAIT_V(6); PG8_BAR; PG8_MMA(1, 1, At, B1); PG8_BAR;
        }
        PG8_STAMP();
        if constexpr (!Epi::AFTER_DRAIN) { E(acc, cur, wr, wc, fr, fq); S.done(cur); }
        PG8_STAMP();
        if (!has_next) break;
#pragma unroll
        for (int a = 0; a < 2; ++a)
#pragma unroll
            for (int b = 0; b < 2; ++b)
#pragma unroll
                for (int m = 0; m < 4; ++m)
#pragma unroll
                    for (int n = 0; n < 2; ++n) acc[a][b][m][n] = (f32x4){0.f, 0.f, 0.f, 0.f};
        cur = nxt; cA = nA; cB = nB; ++ui;
    }
    PG8_WAIT_V(0);
    if (wr == 0) PG8_BAR;
    PG8_BAR;
    if constexpr (Epi::AFTER_DRAIN) { E.fused(acc, cur, wr, wc, fr, fq, lds, wid, lane); S.done(cur); }
    PG8_STAMP();
    if (STAMP && wid == 0) { stamps[lane] = lane < nts ? (((unsigned long long)(unsigned)ts_hi << 32) | (unsigned)ts_lo) : 0ull;
        if (lane == 62) stamps[62] = rt_entry; if (lane == 63) stamps[63] = (unsigned long long)wall_clock64(); }
#undef PG8_STAMP
#undef PG8_SA
#undef PG8_SB
#undef PG8_STAGE
#undef PG8_LDA
#undef PG8_LDB
#undef PG8_MMA
#undef PG8_WAIT_V
#undef PG8_WAIT_L
#undef PG8_BAR
#undef PG8_SCHED
}
}

#include <cstdio>
#include <ctime>
#include <cstdlib>
#include <cstring>
#include <cmath>
#include <vector>

template <class F> struct EpiG {
    static constexpr bool PERM = false, AFTER_DRAIN = false;
    F f;
    __device__ __forceinline__ void operator()(const f32x4 (&acc)[2][2][4][2], const pg8::Unit& u, int wr, int wc, int fr, int fq) const {
        const int row0 = u.pm * 256 + wr * 64 + fr, col0 = u.pn * 256 + wc * 32 + 4 * fq;
#pragma unroll
        for (int ai = 0; ai < 2; ++ai)
#pragma unroll
            for (int m = 0; m < 4; ++m)
#pragma unroll
                for (int bj = 0; bj < 2; ++bj)
#pragma unroll
                    for (int n = 0; n < 2; ++n) f(row0 + ai * 128 + m * 16, col0 + bj * 128 + n * 16, acc[ai][bj][m][n]);
    }
};
__device__ __forceinline__ void st_bf16x4(bf16_t* p, f32x4 v) { u32x2 w; w.x = pack2bf(v[0], v[1]); w.y = pack2bf(v[2], v[3]); *(u32x2*)p = w; }
__device__ __forceinline__ void st_f32x4(float* p, f32x4 v) { *(f32x4*)p = v; }

struct FStoreBf16 { bf16_t* O; int ldc; int pad_; __device__ __forceinline__ void operator()(int r, int c, f32x4 v) const { st_bf16x4(O + (size_t)r * ldc + c, v); } };
struct FAbIn { bf16_t *Q, *K, *V; float *QI, *U, *KI, *WI;
    __device__ __forceinline__ void operator()(int r, int c, f32x4 v) const {
        if (c < 1024) st_bf16x4(Q + (size_t)r * 1024 + c, v);
        else if (c < 2048) st_bf16x4(K + (size_t)r * 1024 + (c - 1024), v);
        else if (c < 3072) st_bf16x4(V + (size_t)r * 1024 + (c - 2048), v);
        else if (c < 4096) st_f32x4(QI + (size_t)r * 1024 + (c - 3072), v);
        else if (c < 5120) st_f32x4(U + (size_t)r * 1024 + (c - 4096), v);
        else if (c < 5184) st_f32x4(KI + (size_t)r * 64 + (c - 5120), v);
        else if (c < 5200) st_f32x4(WI + (size_t)r * 16 + (c - 5184), v);
    } };
struct FCdIn { float *CQ, *CKV, *KR; bf16_t *XL, *YG;
    __device__ __forceinline__ void operator()(int r, int c, f32x4 v) const {
        if (c < 512) st_f32x4(CQ + (size_t)r * 512 + c, v);
        else if (c < 768) st_f32x4(CKV + (size_t)r * 256 + (c - 512), v);
        else if (c < 832) st_f32x4(KR + (size_t)r * 64 + (c - 768), v);
        else if (c < 1024) {}
        else if (c < 2048) st_bf16x4(XL + (size_t)r * 1024 + (c - 1024), v);
        else st_bf16x4(YG + (size_t)r * 1024 + (c - 2048), v);
    } };
struct FKvUp { bf16_t *K1, *V1;
    __device__ __forceinline__ void operator()(int r, int c, f32x4 v) const {
        const int h = c >> 8, d = c & 255;
        if (d < 128) st_bf16x4(K1 + (size_t)r * 1536 + h * 192 + d, v);
        else st_bf16x4(V1 + (size_t)r * 1024 + h * 128 + (d - 128), v);
    } };

template <class Epi> __global__ __launch_bounds__(512, 2) void k_gemm(pg8::Gemm g, Epi E) {
    extern __shared__ __attribute__((aligned(16))) unsigned char shm[];
    pg8::StaticOrder S; S.init(g.M, g.N, (int)gridDim.x, (int)blockIdx.x);
    pg8::gemm_phase<Epi, pg8::StaticOrder, false>((LAS unsigned char*)shm, g, S, E, nullptr);
}

__global__ void k_convT(const float* __restrict__ W, int ldw, int src_col0, int ncols, int K, bf16_t* __restrict__ Bt) {
    __shared__ float tile[32][33];
    const int n0 = blockIdx.x * 32, k0 = blockIdx.y * 32, tx = threadIdx.x, ty = threadIdx.y;
#pragma unroll
    for (int i = 0; i < 4; ++i) { const int k = k0 + ty + 8 * i, n = n0 + tx; tile[ty + 8 * i][tx] = (n < ncols) ? W[(size_t)k * ldw + src_col0 + n] : 0.f; }
    __syncthreads();
#pragma unroll
    for (int i = 0; i < 4; ++i) { const int n = n0 + ty + 8 * i, k = k0 + tx; if (n < ncols) Bt[(size_t)n * K + k] = f2bf(tile[tx][ty + 8 * i]); }
}

template <int NC> __global__ __launch_bounds__(256) void k_rmsnorm(const float* __restrict__ x, const float* __restrict__ g, bf16_t* __restrict__ out) {
    const int lane = threadIdx.x & 63, row = blockIdx.x * 4 + (threadIdx.x >> 6);
    constexpr int NV = NC / 256;
    const f32x4* xr = (const f32x4*)(x + (size_t)row * NC);
    f32x4 v[NV]; float ss = 0.f;
#pragma unroll
    for (int i = 0; i < NV; ++i) { v[i] = xr[lane + 64 * i]; ss += v[i][0] * v[i][0] + v[i][1] * v[i][1] + v[i][2] * v[i][2] + v[i][3] * v[i][3]; }
    ss = wave_sum(ss);
    const float r = rsqrtf(ss * (1.0f / NC) + NORM_EPS);
#pragma unroll
    for (int i = 0; i < NV; ++i) { const f32x4 gg = ((const f32x4*)g)[lane + 64 * i]; st_bf16x4(out + (size_t)row * NC + 4 * (lane + 64 * i), v[i] * r * gg); }
}
__global__ __launch_bounds__(256) void k_resnorm(const float* xin, const bf16_t* __restrict__ m, const float* __restrict__ gpost, const float* __restrict__ gpre,
                                                 float* xout, bf16_t* __restrict__ h) {
    const int lane = threadIdx.x & 63, row = blockIdx.x * 4 + (threadIdx.x >> 6);
    const f32x4* xr = (const f32x4*)(xin + (size_t)row * DM);
    const u32x2* mr = (const u32x2*)(m + (size_t)row * DM);
    f32x4 mv[8], xv[8]; float ss = 0.f;
#pragma unroll
    for (int i = 0; i < 8; ++i) { const u32x2 w = mr[lane + 64 * i]; mv[i][0] = __uint_as_float(w.x << 16); mv[i][1] = __uint_as_float(w.x & 0xFFFF0000u); mv[i][2] = __uint_as_float(w.y << 16); mv[i][3] = __uint_as_float(w.y & 0xFFFF0000u);
        xv[i] = xr[lane + 64 * i]; ss += mv[i][0] * mv[i][0] + mv[i][1] * mv[i][1] + mv[i][2] * mv[i][2] + mv[i][3] * mv[i][3]; }
    ss = wave_sum(ss);
    const float r1 = rsqrtf(ss * (1.0f / DM) + NORM_EPS);
    float s2 = 0.f;
#pragma unroll
    for (int i = 0; i < 8; ++i) { const f32x4 gg = ((const f32x4*)gpost)[lane + 64 * i]; xv[i] = xv[i] + mv[i] * r1 * gg; ((f32x4*)(xout + (size_t)row * DM))[lane + 64 * i] = xv[i];
        s2 += xv[i][0] * xv[i][0] + xv[i][1] * xv[i][1] + xv[i][2] * xv[i][2] + xv[i][3] * xv[i][3]; }
    if (gpre) {
        s2 = wave_sum(s2);
        const float r2 = rsqrtf(s2 * (1.0f / DM) + NORM_EPS);
#pragma unroll
        for (int i = 0; i < 8; ++i) { const f32x4 gg = ((const f32x4*)gpre)[lane + 64 * i]; st_bf16x4(h + (size_t)row * DM + 4 * (lane + 64 * i), xv[i] * r2 * gg); }
    }
}

__device__ __forceinline__ unsigned ord_key(float f) { const unsigned b = __float_as_uint(f); return (b & 0x80000000u) ? ~b : (b | 0x80000000u); }
__global__ __launch_bounds__(256) void k_indexer_naive(const float* __restrict__ QI, const float* __restrict__ KI, const float* __restrict__ WI, unsigned* __restrict__ mask) {
    extern __shared__ __attribute__((aligned(16))) unsigned char smem_raw[];
    float* scores = (float*)smem_raw;
    float* qs = scores + 16384;
    float* ws = qs + 1024;
    unsigned* hist = (unsigned*)(ws + 16);
    unsigned* misc = hist + 256;
    unsigned* bitmap = misc + 16;
    const int q = blockIdx.x, tid = threadIdx.x, b = q / SEQ, t = q % SEQ, L = (t / 64 + 1) * 64;
    ((f32x4*)qs)[tid] = ((const f32x4*)(QI + (size_t)q * 1024))[tid];
    if (tid < 16) ws[tid] = WI[(size_t)q * 16 + tid] * (0.125f * 0.25f);
    bitmap[tid] = 0u; bitmap[tid + 256] = 0u;
    __syncthreads();
    for (int s = tid; s < L; s += 256) {
        const f32x4* kr = (const f32x4*)(KI + (size_t)(b * SEQ + s) * 64);
        f32x4 kv[16];
#pragma unroll
        for (int j = 0; j < 16; ++j) kv[j] = kr[j];
        float sc = 0.f;
        for (int h = 0; h < 16; ++h) {
            float d = 0.f;
#pragma unroll
            for (int j = 0; j < 16; ++j) { const f32x4 qq = ((const f32x4*)qs)[h * 16 + j]; d += qq[0] * kv[j][0] + qq[1] * kv[j][1] + qq[2] * kv[j][2] + qq[3] * kv[j][3]; }
            sc += fmaxf(d, 0.f) * ws[h];
        }
        scores[s] = sc;
    }
    __syncthreads();
    if (L <= 256) {
        for (int s = tid; s < L; s += 256) atomicOr(&bitmap[s >> 5], 1u << (s & 31));
    } else {
        unsigned prefix = 0u, pmask = 0u, krem = 256u;
        for (int shift = 24; shift >= 0; shift -= 8) {
            hist[tid] = 0u;
            __syncthreads();
            for (int s = tid; s < L; s += 256) { const unsigned k = ord_key(scores[s]); if ((k & pmask) == prefix) atomicAdd(&hist[(k >> shift) & 255u], 1u); }
            __syncthreads();
            if (tid == 0) { unsigned cum = 0u; int d = 255; for (; d > 0; --d) { if (cum + hist[d] >= krem) break; cum += hist[d]; } misc[0] = (unsigned)d; misc[1] = krem - cum; }
            __syncthreads();
            prefix |= misc[0] << shift; pmask |= 255u << shift; krem = misc[1];
            __syncthreads();
        }
        if (tid == 0) misc[2] = 0u;
        __syncthreads();
        for (int s = tid; s < L; s += 256) { const unsigned k = ord_key(scores[s]); if (k > prefix) atomicOr(&bitmap[s >> 5], 1u << (s & 31)); else if (k == prefix) atomicAdd(&misc[2], 1u); }
        __syncthreads();
        const unsigned neq = misc[2];
        if (neq == krem) { for (int s = tid; s < L; s += 256) { if (ord_key(scores[s]) == prefix) atomicOr(&bitmap[s >> 5], 1u << (s & 31)); } }
        else if (tid == 0) { unsigned left = krem; for (int s = 0; s < L && left; ++s) if (ord_key(scores[s]) == prefix) { bitmap[s >> 5] |= 1u << (s & 31); --left; } }
    }
    __syncthreads();
    mask[(size_t)q * 512 + tid] = bitmap[tid]; mask[(size_t)q * 512 + 256 + tid] = bitmap[tid + 256];
}

template <int DQK, int DV, bool SPARSE>
__global__ __launch_bounds__(256) void k_attn_naive(const bf16_t* __restrict__ Q, int ldq, const bf16_t* __restrict__ K, int ldk, const bf16_t* __restrict__ V, int ldv,
                                                    const unsigned* __restrict__ mask, bf16_t* __restrict__ O, int ldo, float scale) {
    constexpr int QP = DQK / 4, VP = DV / 4;
    const int tid = threadIdx.x, part = tid & 3, row = blockIdx.x * 64 + (tid >> 2), h = blockIdx.y, b = row / SEQ, t = row % SEQ, L = (t / 64 + 1) * 64;
    float q[QP], o[VP];
    { const bf16_t* qp = Q + (size_t)row * ldq + h * DQK + part * QP;
#pragma unroll
      for (int i = 0; i < QP; ++i) q[i] = bf2f(qp[i]) * scale; }
#pragma unroll
    for (int i = 0; i < VP; ++i) o[i] = 0.f;
    float m = -INFINITY, l = 0.f;
    const bf16_t* Kb = K + (size_t)b * SEQ * ldk + h * DQK + part * QP;
    const bf16_t* Vb = V + (size_t)b * SEQ * ldv + h * DV + part * VP;
    auto body = [&](int j) {
        const bf16_t* kp = Kb + (size_t)j * ldk;
        float d = 0.f;
#pragma unroll
        for (int i = 0; i < QP; i += 8) { const u32x4 w = *(const u32x4*)(kp + i);
            d += q[i + 0] * __uint_as_float(w.x << 16) + q[i + 1] * __uint_as_float(w.x & 0xFFFF0000u) + q[i + 2] * __uint_as_float(w.y << 16) + q[i + 3] * __uint_as_float(w.y & 0xFFFF0000u)
               + q[i + 4] * __uint_as_float(w.z << 16) + q[i + 5] * __uint_as_float(w.z & 0xFFFF0000u) + q[i + 6] * __uint_as_float(w.w << 16) + q[i + 7] * __uint_as_float(w.w & 0xFFFF0000u); }
        d += __shfl_xor(d, 1); d += __shfl_xor(d, 2);
        const float mn = fmaxf(m, d), corr = __expf(m - mn), p = __expf(d - mn);
        l = l * corr + p; m = mn;
        const bf16_t* vp = Vb + (size_t)j * ldv;
#pragma unroll
        for (int i = 0; i < VP; i += 8) { const u32x4 w = *(const u32x4*)(vp + i);
            o[i + 0] = o[i + 0] * corr + p * __uint_as_float(w.x << 16); o[i + 1] = o[i + 1] * corr + p * __uint_as_float(w.x & 0xFFFF0000u);
            o[i + 2] = o[i + 2] * corr + p * __uint_as_float(w.y << 16); o[i + 3] = o[i + 3] * corr + p * __uint_as_float(w.y & 0xFFFF0000u);
            o[i + 4] = o[i + 4] * corr + p * __uint_as_float(w.z << 16); o[i + 5] = o[i + 5] * corr + p * __uint_as_float(w.z & 0xFFFF0000u);
            o[i + 6] = o[i + 6] * corr + p * __uint_as_float(w.w << 16); o[i + 7] = o[i + 7] * corr + p * __uint_as_float(w.w & 0xFFFF0000u); }
    };
    if (SPARSE) {
        const unsigned* mr = mask + (size_t)row * 512;
        for (int w = 0; w < L / 32; ++w) { unsigned bits = mr[w]; while (bits) { const int j = w * 32 + __builtin_ctz(bits); bits &= bits - 1u; body(j); } }
    } else {
        for (int j = 0; j < L; ++j) body(j);
    }
    const float inv = 1.0f / l;
    bf16_t* op = O + (size_t)row * ldo + h * DV + part * VP;
#pragma unroll
    for (int i = 0; i < VP; i += 4) st_bf16x4(op + i, (f32x4){o[i] * inv, o[i + 1] * inv, o[i + 2] * inv, o[i + 3] * inv});
}

__global__ __launch_bounds__(256) void k_pool(const float* __restrict__ U, const float* __restrict__ pw, const float* __restrict__ pb, const float* __restrict__ ps, bf16_t* __restrict__ CC) {
    __shared__ float A[16][256];
    const int r0 = blockIdx.x * 16, g = blockIdx.y, tid = threadIdx.x, win = 2 << g;
    for (int r = 0; r < 16; ++r) {
        const int row = r0 + r, t = row % SEQ, cnt = (t + 1 < win) ? (t + 1) : win;
        float s = 0.f;
        for (int i = 0; i < cnt; ++i) s += U[(size_t)(row - i) * 1024 + g * 256 + tid];
        A[r][tid] = s / (float)cnt - U[(size_t)row * 1024 + g * 256 + tid];
    }
    __syncthreads();
    float acc[16];
#pragma unroll
    for (int r = 0; r < 16; ++r) acc[r] = 0.f;
    const float* w = pw + (size_t)g * 256 * 256 + tid;
    for (int c = 0; c < 256; ++c) { const float wv = w[(size_t)c * 256];
#pragma unroll
        for (int r = 0; r < 16; ++r) acc[r] += A[r][c] * wv; }
    const float bb = pb[g * 256 + tid], sc = ps[g * 256 + tid];
#pragma unroll
    for (int r = 0; r < 16; ++r) CC[(size_t)(r0 + r) * 2048 + 1024 + g * 256 + tid] = f2bf((acc[r] + bb) * sc);
}

__global__ void k_lru_conv(const bf16_t* __restrict__ XL, const float* __restrict__ cw, const float* __restrict__ cb, float* __restrict__ XC) {
    const size_t i = (size_t)blockIdx.x * blockDim.x + threadIdx.x;
    const int c = (int)(i & 1023); const int row = (int)(i >> 10), t = row % SEQ;
    float y = cb[c];
#pragma unroll
    for (int k = 0; k < 4; ++k) { const int tt = t - 3 + k; if (tt >= 0) y += cw[k * 1024 + c] * bf2f(XL[(size_t)(row - 3 + k) * 1024 + c]); }
    XC[i] = y;
}
__global__ __launch_bounds__(128) void k_lru_gates(const float* __restrict__ XC, const float* __restrict__ wa, const float* __restrict__ ba, const float* __restrict__ wx, const float* __restrict__ bx,
                                                   const float* __restrict__ lam, float* __restrict__ Aout, float* __restrict__ Bout) {
    __shared__ float A[16][128];
    const int r0 = blockIdx.x * 16, n = blockIdx.y, tid = threadIdx.x, ch = n * 128 + tid;
    for (int r = 0; r < 16; ++r) A[r][tid] = XC[(size_t)(r0 + r) * 1024 + ch];
    __syncthreads();
    float ga[16], gx[16];
#pragma unroll
    for (int r = 0; r < 16; ++r) { ga[r] = 0.f; gx[r] = 0.f; }
    const float* pa = wa + (size_t)n * 128 * 128 + tid; const float* px = wx + (size_t)n * 128 * 128 + tid;
    for (int c = 0; c < 128; ++c) { const float va = pa[(size_t)c * 128], vx = px[(size_t)c * 128];
#pragma unroll
        for (int r = 0; r < 16; ++r) { ga[r] += A[r][c] * va; gx[r] += A[r][c] * vx; } }
    const float bav = ba[ch], bxv = bx[ch], lm = lam[ch];
    const float sp = (lm > 20.f) ? expf(-lm) : log1pf(expf(-lm));
#pragma unroll
    for (int r = 0; r < 16; ++r) {
        const float rg = 1.0f / (1.0f + expf(-(ga[r] + bav))), ig = 1.0f / (1.0f + expf(-(gx[r] + bxv)));
        const float log_a = -8.0f * rg * sp, a = expf(log_a), mult = sqrtf(-expm1f(2.0f * log_a));
        Aout[(size_t)(r0 + r) * 1024 + ch] = a; Bout[(size_t)(r0 + r) * 1024 + ch] = mult * (ig * A[r][tid]);
    }
}
__global__ void k_lru_scan1(const float* __restrict__ Aa, const float* __restrict__ Bb, float* __restrict__ CA, float* __restrict__ CH) {
    const int i = blockIdx.x * blockDim.x + threadIdx.x;
    const int ch = i & 1023, chunk = (i >> 10) & 255, b = i >> 18;
    const size_t base = ((size_t)b * SEQ + (size_t)chunk * 64) * 1024 + ch;
    float h = 0.f, P = 1.f;
    for (int s = 0; s < 64; ++s) { const float a = Aa[base + (size_t)s * 1024]; h = a * h + Bb[base + (size_t)s * 1024]; P *= a; }
    CA[i] = P; CH[i] = h;
}
__global__ void k_lru_scan2(const float* __restrict__ CA, const float* __restrict__ CH, float* __restrict__ CIN) {
    const int i = blockIdx.x * blockDim.x + threadIdx.x;
    const int ch = i & 1023, b = i >> 10;
    float h = 0.f;
    for (int c = 0; c < 256; ++c) { const int j = (b * 256 + c) * 1024 + ch; CIN[j] = h; h = CA[j] * h + CH[j]; }
}
__global__ void k_lru_scan3(const float* __restrict__ Aa, const float* __restrict__ Bb, const float* __restrict__ CIN, const bf16_t* __restrict__ YG, bf16_t* __restrict__ CC) {
    const int i = blockIdx.x * blockDim.x + threadIdx.x;
    const int ch = i & 1023, chunk = (i >> 10) & 255, b = i >> 18;
    const size_t row0 = (size_t)b * SEQ + (size_t)chunk * 64;
    float h = CIN[i];
    for (int s = 0; s < 64; ++s) { const size_t r = row0 + s; h = Aa[r * 1024 + ch] * h + Bb[r * 1024 + ch];
        CC[r * 2048 + 1024 + ch] = f2bf(h * gelu_tanh(bf2f(YG[r * 1024 + ch]))); }
}

__device__ __forceinline__ void rope_cs(int pos, int i, float& c, float& s) { const float freq = powf(10000.0f, -(float)i / 32.0f); const float ang = (float)pos * freq; sincosf(ang, &s, &c); }
__global__ void k_rope_q(bf16_t* __restrict__ Q1, const int* __restrict__ pos) {
    const int idx = blockIdx.x * blockDim.x + threadIdx.x;
    const int i = idx & 31, h = (idx >> 5) & 7, row = idx >> 8;
    float c, s; rope_cs(pos[row], i, c, s);
    bf16_t* p = Q1 + (size_t)row * 1536 + h * 192 + 128;
    const float x1 = bf2f(p[i]), x2 = bf2f(p[32 + i]);
    p[i] = f2bf(x1 * c - x2 * s); p[32 + i] = f2bf(x2 * c + x1 * s);
}
__global__ void k_rope_k(const float* __restrict__ KR, const int* __restrict__ pos, bf16_t* __restrict__ K1) {
    const int idx = blockIdx.x * blockDim.x + threadIdx.x;
    const int i = idx & 31, row = idx >> 5;
    float c, s; rope_cs(pos[row], i, c, s);
    const float x1 = KR[(size_t)row * 64 + i], x2 = KR[(size_t)row * 64 + 32 + i];
    const bf16_t o1 = f2bf(x1 * c - x2 * s), o2 = f2bf(x2 * c + x1 * s);
#pragma unroll
    for (int h = 0; h < 8; ++h) { bf16_t* p = K1 + (size_t)row * 1536 + h * 192 + 128; p[i] = o1; p[32 + i] = o2; }
}

__global__ void k_ffn_gate(const bf16_t* __restrict__ HID, const float* __restrict__ cw, const float* __restrict__ cb, bf16_t* __restrict__ ACT) {
    const size_t i = (size_t)blockIdx.x * blockDim.x + threadIdx.x;
    const int c8 = (int)(i & 511) * 8, t = (int)(i >> 9);
    float g[8], v[8];
#pragma unroll
    for (int j = 0; j < 8; ++j) { g[j] = cb[c8 + j]; v[j] = cb[4096 + c8 + j]; }
#pragma unroll
    for (int k = 0; k < 3; ++k) { const int tt = t - 2 + k; if (tt < 0) continue;
        const u32x4 wg = *(const u32x4*)(HID + (size_t)tt * 8192 + c8), wv = *(const u32x4*)(HID + (size_t)tt * 8192 + 4096 + c8);
        const unsigned ug[4] = {wg.x, wg.y, wg.z, wg.w}, uv[4] = {wv.x, wv.y, wv.z, wv.w};
#pragma unroll
        for (int j = 0; j < 4; ++j) {
            g[2 * j] += cw[k * 8192 + c8 + 2 * j] * __uint_as_float(ug[j] << 16); g[2 * j + 1] += cw[k * 8192 + c8 + 2 * j + 1] * __uint_as_float(ug[j] & 0xFFFF0000u);
            v[2 * j] += cw[k * 8192 + 4096 + c8 + 2 * j] * __uint_as_float(uv[j] << 16); v[2 * j + 1] += cw[k * 8192 + 4096 + c8 + 2 * j + 1] * __uint_as_float(uv[j] & 0xFFFF0000u); } }
    u32x4 o;
    o.x = pack2bf(gelu_tanh(g[0]) * v[0], gelu_tanh(g[1]) * v[1]); o.y = pack2bf(gelu_tanh(g[2]) * v[2], gelu_tanh(g[3]) * v[3]);
    o.z = pack2bf(gelu_tanh(g[4]) * v[4], gelu_tanh(g[5]) * v[5]); o.w = pack2bf(gelu_tanh(g[6]) * v[6], gelu_tanh(g[7]) * v[7]);
    *(u32x4*)(ACT + (size_t)t * 4096 + c8) = o;
}

static constexpr size_t MiB = 1048576;
static constexpr size_t W_UP0 = 0 * MiB, W_UP1 = 32 * MiB, W_DN0 = 64 * MiB, W_DN1 = 80 * MiB, W_ABIN = 96 * MiB, W_ABOUT = 117 * MiB, W_CDIN = 125 * MiB, W_CDOUT = 137 * MiB,
                        W_QUP = 145 * MiB, W_KVUP = 146 * MiB + 512 * 1024;
static constexpr size_t R_H = 148 * MiB;
static constexpr size_t R_Q0 = 276 * MiB, R_K0 = 340 * MiB, R_V0 = 404 * MiB, R_QI = 468 * MiB, R_M0 = 468 * MiB, R_U = 596 * MiB, R_KI = 724 * MiB, R_WI = 732 * MiB, R_MASK = 734 * MiB, R_CC0 = 830 * MiB;
static constexpr size_t R_HID = 276 * MiB, R_ACT = 532 * MiB, R_F = 660 * MiB;
static constexpr size_t R_CQ = 276 * MiB, R_CKV = 340 * MiB, R_KR = 372 * MiB, R_XL = 380 * MiB, R_YG = 444 * MiB, R_CQN = 508 * MiB, R_CKVN = 540 * MiB, R_Q1 = 556 * MiB, R_K1 = 652 * MiB, R_V1 = 748 * MiB,
                        R_LA = 556 * MiB, R_LB = 684 * MiB, R_XC = 812 * MiB, R_CA = 940 * MiB, R_CH = 942 * MiB, R_CIN = 944 * MiB, R_CC1 = 148 * MiB, R_M1 = 276 * MiB;
static constexpr size_t WS_NEED = 1022 * MiB;
static constexpr int GEMM_LDS = 131072;

template <class F> static void launch_gemm(hipStream_t st, const bf16_t* A, int lda, const bf16_t* Bt, int ldb, int M, int N, int K, const F& f) {
    typedef EpiG<F> E;
    static bool attr = false;
    if (!attr) { (void)hipFuncSetAttribute((const void*)k_gemm<E>, hipFuncAttributeMaxDynamicSharedMemorySize, GEMM_LDS); attr = true; }
    pg8::Gemm g{}; g.A = A; g.Bt = Bt; g.M = M; g.N = N; g.K = K; g.lda = lda; g.ldb = ldb;
    E e{}; e.f = f;
    hipLaunchKernelGGL(k_gemm<E>, dim3(256), dim3(512), GEMM_LDS, st, g, e);
}
static void convT(hipStream_t st, const float* W, int ldw, int src_col0, int ncols, int K, bf16_t* Bt) {
    hipLaunchKernelGGL(k_convT, dim3((ncols + 31) / 32, K / 32), dim3(32, 8), 0, st, W, ldw, src_col0, ncols, K, Bt);
}

extern "C" void kernel_launch(void* const* d_in, const int* in_sizes, int n_in, void* d_out, int out_size, void* d_ws, size_t ws_size, hipStream_t stream) {
    if (n_in != 28 || out_size != NTOK * DM || ws_size < WS_NEED) { fprintf(stderr, "kernel_launch: unexpected shapes (n_in %d out %d ws %zu)\n", n_in, out_size, ws_size); return; }
    const float* x = (const float*)d_in[0]; const int* positions = (const int*)d_in[1];
    const float *mix_pre_g = (const float*)d_in[2], *mix_post_g = (const float*)d_in[3], *ffn_pre_g = (const float*)d_in[4], *ffn_post_g = (const float*)d_in[5];
    const float *ffn_up = (const float*)d_in[6], *ffn_conv_w = (const float*)d_in[7], *ffn_conv_b = (const float*)d_in[8], *ffn_down = (const float*)d_in[9];
    const float *ab_w_in = (const float*)d_in[10], *pool_w = (const float*)d_in[11], *pool_b = (const float*)d_in[12], *pool_scale = (const float*)d_in[13], *ab_w_out = (const float*)d_in[14];
    const float *cd_w_in = (const float*)d_in[15], *q_norm_g = (const float*)d_in[16], *w_q_up = (const float*)d_in[17], *kv_norm_g = (const float*)d_in[18], *w_kv_up = (const float*)d_in[19];
    const float *lru_conv_w = (const float*)d_in[20], *lru_conv_b = (const float*)d_in[21], *lru_wa = (const float*)d_in[22], *lru_ba = (const float*)d_in[23], *lru_wx = (const float*)d_in[24],
                *lru_bx = (const float*)d_in[25], *lru_lambda = (const float*)d_in[26], *cd_w_out = (const float*)d_in[27];
    unsigned char* ws = (unsigned char*)d_ws; float* xo = (float*)d_out;
#define WSP(T, off) ((T*)(ws + (off)))
    for (int l = 0; l < 2; ++l) {
        convT(stream, ffn_up + (size_t)l * 2048 * 8192, 8192, 0, 8192, 2048, WSP(bf16_t, l ? W_UP1 : W_UP0));
        convT(stream, ffn_down + (size_t)l * 4096 * 2048, 2048, 0, 2048, 4096, WSP(bf16_t, l ? W_DN1 : W_DN0));
    }
    (void)hipMemsetAsync(ws + W_ABIN + (size_t)5200 * 2048 * 2, 0, (size_t)176 * 2048 * 2, stream);
    convT(stream, ab_w_in, 5200, 0, 4096, 2048, WSP(bf16_t, W_ABIN));
    convT(stream, ab_w_in, 5200, 4176, 1024, 2048, WSP(bf16_t, W_ABIN) + (size_t)4096 * 2048);
    convT(stream, ab_w_in, 5200, 4096, 64, 2048, WSP(bf16_t, W_ABIN) + (size_t)5120 * 2048);
    convT(stream, ab_w_in, 5200, 4160, 16, 2048, WSP(bf16_t, W_ABIN) + (size_t)5184 * 2048);
    convT(stream, ab_w_out, 2048, 0, 2048, 2048, WSP(bf16_t, W_ABOUT));
    (void)hipMemsetAsync(ws + W_CDIN + (size_t)832 * 2048 * 2, 0, (size_t)192 * 2048 * 2, stream);
    convT(stream, cd_w_in, 2880, 0, 832, 2048, WSP(bf16_t, W_CDIN));
    convT(stream, cd_w_in, 2880, 832, 2048, 2048, WSP(bf16_t, W_CDIN) + (size_t)1024 * 2048);
    convT(stream, cd_w_out, 2048, 0, 2048, 2048, WSP(bf16_t, W_CDOUT));
    convT(stream, w_q_up, 1536, 0, 1536, 512, WSP(bf16_t, W_QUP));
    convT(stream, w_kv_up, 2048, 0, 2048, 256, WSP(bf16_t, W_KVUP));

    bf16_t* H = WSP(bf16_t, R_H);
    hipLaunchKernelGGL(k_rmsnorm<2048>, dim3(NTOK / 4), dim3(256), 0, stream, x, mix_pre_g, H);
    { FAbIn f{}; f.Q = WSP(bf16_t, R_Q0); f.K = WSP(bf16_t, R_K0); f.V = WSP(bf16_t, R_V0); f.QI = WSP(float, R_QI); f.U = WSP(float, R_U); f.KI = WSP(float, R_KI); f.WI = WSP(float, R_WI);
      launch_gemm(stream, H, 2048, WSP(bf16_t, W_ABIN), 2048, NTOK, 5376, 2048, f); }
    { static bool attr = false; const int lds = (16384 + 1024 + 16 + 256 + 16 + 512) * 4;
      if (!attr) { (void)hipFuncSetAttribute((const void*)k_indexer_naive, hipFuncAttributeMaxDynamicSharedMemorySize, lds); attr = true; }
      hipLaunchKernelGGL(k_indexer_naive, dim3(NTOK), dim3(256), lds, stream, WSP(float, R_QI), WSP(float, R_KI), WSP(float, R_WI), WSP(unsigned, R_MASK)); }
    hipLaunchKernelGGL((k_attn_naive<128, 128, true>), dim3(NTOK / 64, 8), dim3(256), 0, stream, WSP(bf16_t, R_Q0), 1024, WSP(bf16_t, R_K0), 1024, WSP(bf16_t, R_V0), 1024, WSP(unsigned, R_MASK),
                       WSP(bf16_t, R_CC0), 2048, 0.08838834764831845f);
    hipLaunchKernelGGL(k_pool, dim3(NTOK / 16, 4), dim3(256), 0, stream, WSP(float, R_U), pool_w, pool_b, pool_scale, WSP(bf16_t, R_CC0));
    { FStoreBf16 f{}; f.O = WSP(bf16_t, R_M0); f.ldc = 2048; launch_gemm(stream, WSP(bf16_t, R_CC0), 2048, WSP(bf16_t, W_ABOUT), 2048, NTOK, 2048, 2048, f); }
    hipLaunchKernelGGL(k_resnorm, dim3(NTOK / 4), dim3(256), 0, stream, x, WSP(bf16_t, R_M0), mix_post_g, ffn_pre_g, xo, H);
    for (int layer = 0; layer < 2; ++layer) {
        if (layer == 1) {
            { FCdIn f{}; f.CQ = WSP(float, R_CQ); f.CKV = WSP(float, R_CKV); f.KR = WSP(float, R_KR); f.XL = WSP(bf16_t, R_XL); f.YG = WSP(bf16_t, R_YG);
              launch_gemm(stream, H, 2048, WSP(bf16_t, W_CDIN), 2048, NTOK, 3072, 2048, f); }
            hipLaunchKernelGGL(k_lru_conv, dim3(NTOK * 1024 / 256), dim3(256), 0, stream, WSP(bf16_t, R_XL), lru_conv_w, lru_conv_b, WSP(float, R_XC));
            hipLaunchKernelGGL(k_lru_gates, dim3(NTOK / 16, 8), dim3(128), 0, stream, WSP(float, R_XC), lru_wa, lru_ba, lru_wx, lru_bx, lru_lambda, WSP(float, R_LA), WSP(float, R_LB));
            hipLaunchKernelGGL(k_lru_scan1, dim3(2 * 256 * 1024 / 256), dim3(256), 0, stream, WSP(float, R_LA), WSP(float, R_LB), WSP(float, R_CA), WSP(float, R_CH));
            hipLaunchKernelGGL(k_lru_scan2, dim3(2048 / 256), dim3(256), 0, stream, WSP(float, R_CA), WSP(float, R_CH), WSP(float, R_CIN));
            hipLaunchKernelGGL(k_lru_scan3, dim3(2 * 256 * 1024 / 256), dim3(256), 0, stream, WSP(float, R_LA), WSP(float, R_LB), WSP(float, R_CIN), WSP(bf16_t, R_YG), WSP(bf16_t, R_CC1));
            hipLaunchKernelGGL(k_rmsnorm<512>, dim3(NTOK / 4), dim3(256), 0, stream, WSP(float, R_CQ), q_norm_g, WSP(bf16_t, R_CQN));
            hipLaunchKernelGGL(k_rmsnorm<256>, dim3(NTOK / 4), dim3(256), 0, stream, WSP(float, R_CKV), kv_norm_g, WSP(bf16_t, R_CKVN));
            { FStoreBf16 f{}; f.O = WSP(bf16_t, R_Q1); f.ldc = 1536; launch_gemm(stream, WSP(bf16_t, R_CQN), 512, WSP(bf16_t, W_QUP), 512, NTOK, 1536, 512, f); }
            { FKvUp f{}; f.K1 = WSP(bf16_t, R_K1); f.V1 = WSP(bf16_t, R_V1); launch_gemm(stream, WSP(bf16_t, R_CKVN), 256, WSP(bf16_t, W_KVUP), 256, NTOK, 2048, 256, f); }
            hipLaunchKernelGGL(k_rope_q, dim3(NTOK * 8 * 32 / 256), dim3(256), 0, stream, WSP(bf16_t, R_Q1), positions);
            hipLaunchKernelGGL(k_rope_k, dim3(NTOK * 32 / 256), dim3(256), 0, stream, WSP(float, R_KR), positions, WSP(bf16_t, R_K1));
            hipLaunchKernelGGL((k_attn_naive<192, 128, false>), dim3(NTOK / 64, 8), dim3(256), 0, stream, WSP(bf16_t, R_Q1), 1536, WSP(bf16_t, R_K1), 1536, WSP(bf16_t, R_V1), 1024, (const unsigned*)nullptr,
                               WSP(bf16_t, R_CC1), 2048, 0.07216878364870322f);
            { FStoreBf16 f{}; f.O = WSP(bf16_t, R_M1); f.ldc = 2048; launch_gemm(stream, WSP(bf16_t, R_CC1), 2048, WSP(bf16_t, W_CDOUT), 2048, NTOK, 2048, 2048, f); }
            hipLaunchKernelGGL(k_resnorm, dim3(NTOK / 4), dim3(256), 0, stream, xo, WSP(bf16_t, R_M1), mix_post_g + 2048, ffn_pre_g + 2048, xo, H);
        }
        for (int half = 0; half < 2; ++half) {
            { FStoreBf16 f{}; f.O = WSP(bf16_t, R_HID); f.ldc = 8192; launch_gemm(stream, H + (size_t)half * SEQ * 2048, 2048, WSP(bf16_t, layer ? W_UP1 : W_UP0), 2048, SEQ, 8192, 2048, f); }
            hipLaunchKernelGGL(k_ffn_gate, dim3(SEQ * 512 / 256), dim3(256), 0, stream, WSP(bf16_t, R_HID), ffn_conv_w + (size_t)layer * 3 * 8192, ffn_conv_b + (size_t)layer * 8192, WSP(bf16_t, R_ACT));
            { FStoreBf16 f{}; f.O = WSP(bf16_t, R_F) + (size_t)half * SEQ * 2048; f.ldc = 2048; launch_gemm(stream, WSP(bf16_t, R_ACT), 4096, WSP(bf16_t, layer ? W_DN1 : W_DN0), 4096, SEQ, 2048, 4096, f); }
        }
        hipLaunchKernelGGL(k_resnorm, dim3(NTOK / 4), dim3(256), 0, stream, xo, WSP(bf16_t, R_F), ffn_post_g + (size_t)layer * 2048, layer == 0 ? mix_pre_g + 2048 : (const float*)nullptr, xo, H);
    }
#undef WSP
}
```

```cpp
#include <hip/hip_runtime.h>
#include <stdint.h>
#include <stdio.h>

#define LAS __attribute__((address_space(3)))
typedef unsigned short bf16_t;
typedef float f32x4 __attribute__((ext_vector_type(4)));
typedef unsigned u32x4 __attribute__((ext_vector_type(4)));
typedef unsigned u32x2 __attribute__((ext_vector_type(2)));

static constexpr int NTOK = 32768, SEQ = 16384, NBATCH = 2, DM = 2048, DFF = 4096;
static constexpr float NORM_EPS = 1e-6f;

__device__ __forceinline__ bf16_t f2bf(float f) { unsigned u = __float_as_uint(f); u += 0x7FFFu + ((u >> 16) & 1u); return (bf16_t)(u >> 16); }
__device__ __forceinline__ float bf2f(bf16_t b) { return __uint_as_float(((unsigned)b) << 16); }
__device__ __forceinline__ unsigned pack2bf(float lo, float hi) { return (unsigned)f2bf(lo) | ((unsigned)f2bf(hi) << 16); }
__device__ __forceinline__ float gelu_tanh(float x) { const float u = 0.7978845608028654f * (x + 0.044715f * x * x * x); return 0.5f * x * (1.0f + tanhf(u)); }
__device__ __forceinline__ float wave_sum(float v) {
#pragma unroll
    for (int o = 32; o >= 1; o >>= 1) v += __shfl_xor(v, o);
    return v;
}

#include <hip/hip_runtime.h>
namespace pg8 {
#define PG8_LAS __attribute__((address_space(3)))
typedef unsigned short bf16_t;
typedef short bf16x8 __attribute__((ext_vector_type(8)));
typedef float f32x4 __attribute__((ext_vector_type(4)));
typedef unsigned u32x4 __attribute__((ext_vector_type(4)));
constexpr int BM = 256, BK = 64, HALF = 128, HTB = HALF * BK * 2  , STAGE_BYTES = 8 * HTB, NXCD = 8, WGM = 8;

__host__ __device__ __forceinline__ int lds_byte(int r, int c) { const int st = (r >> 4) * 2 + (c >> 5), rr = r & 15, cc = c & 31, ob = rr * 64 + cc * 2; return st * 1024 + (ob ^ (((ob >> 9) & 1) << 5)); }
__host__ __device__ __forceinline__ void stage_rc(int b, int& R, int& C) { const int st = b / 1024, sb = b % 1024, swz = sb ^ (((sb >> 9) & 1) << 5); R = (st >> 1) * 16 + swz / 64; C = (st & 1) * 32 + (swz % 64) / 2; }
__host__ __device__ __forceinline__ int perm32(int rho) { const int n = rho >> 4, i = rho & 15; return 8 * (i >> 2) + 4 * n + (i & 3); }

struct Unit { int pm, pn; };
struct Gemm { const bf16_t* A; const bf16_t* Bt; int M, N, K, lda, ldb, pad_; };

struct StaticOrder {
    int nM, nN, nwg, G, c;
    __host__ __device__ void init(int M, int N, int G_, int c_) { nM = M / BM; nN = N / BM; nwg = nM * nN; G = G_; c = c_; }
    __host__ __device__ bool next(int i, Unit& u) const {
        const long L = (long)i * G + c; if (L >= nwg) return false;
        int wgid = (int)L; { const int q = nwg / NXCD, r = nwg % NXCD, xcd = wgid % NXCD, off = wgid / NXCD; wgid = (xcd < r ? xcd * (q + 1) : r * (q + 1) + (xcd - r) * q) + off; }
        const int nig = WGM * nN, gid = wgid / nig, fm = gid * WGM, gsz = (nM - fm) < WGM ? (nM - fm) : WGM;
        u.pm = fm + ((wgid % nig) % gsz); u.pn = (wgid % nig) / gsz; return true;
    }
    __device__ __forceinline__ void a_ready(const Unit&) const {}
    __device__ __forceinline__ void done(const Unit&) const {}
};

template <class Epi, class Sched, bool STAMP = false>
__device__ __forceinline__ void gemm_phase(PG8_LAS unsigned char* lds, const Gemm g, const Sched& S, const Epi& E, unsigned long long* stamps) {
    const int tid = threadIdx.x, wid = __builtin_amdgcn_readfirstlane(tid >> 6), lane = tid & 63, wr = wid >> 2, wc = wid & 3, fr = lane & 15, fq = lane >> 4;
    const int K = g.K, nt = K / BK;
    int ts_lo = 0, ts_hi = 0, nts = 0; const unsigned long long rt_entry = STAMP ? (unsigned long long)wall_clock64() : 0ull;
#define PG8_STAMP() do { if (STAMP && wid == 0 && nts < 64) { const unsigned long long _c = (unsigned long long)clock64(); \
        ts_lo = (lane == nts) ? (int)(unsigned)_c : ts_lo; ts_hi = (lane == nts) ? (int)(unsigned)(_c >> 32) : ts_hi; ++nts; } } while (0)
    PG8_STAMP();
    unsigned voffA[2], voffB[2];
#pragma unroll
    for (int i = 0; i < 2; ++i) { int R, C; stage_rc(tid * 16 + i * 8192, R, C); const int Rb = Epi::PERM ? ((R & ~31) + perm32(R & 31)) : R;
        voffA[i] = (unsigned)(R * g.lda + C) * 2u; voffB[i] = (unsigned)(Rb * g.ldb + C) * 2u; }
    const size_t kstep = (size_t)(BK * 2);
    const size_t hstepA = (size_t)HALF * g.lda * 2, hstepB = (size_t)HALF * g.ldb * 2;
    const size_t tstepA = 2 * hstepA, tstepB = 2 * hstepB;
    const unsigned ldsw = (unsigned)wid * 1024u;
    const int aoff = lds_byte(wr * 64 + fr, fq * 8), boff = lds_byte(wc * 32 + fr, fq * 8);
#define PG8_SA(b, h) (((b) * 2 + (h)) * HTB)
#define PG8_SB(b, h) ((4 + (b) * 2 + (h)) * HTB)
#define PG8_STAGE(bufoff, gbase, voff) do { _Pragma("unroll") for (int _i = 0; _i < 2; ++_i) \
        __builtin_amdgcn_global_load_lds((const unsigned*)((const char*)(gbase) + (voff)[_i]), (PG8_LAS unsigned*)(lds + (bufoff) + ldsw + _i * 8192), 16, 0, 0); } while (0)
#define PG8_LDA(dst, b, h) do { _Pragma("unroll") for (int m = 0; m < 4; ++m) _Pragma("unroll") for (int k = 0; k < 2; ++k) dst[m][k] = *(const PG8_LAS bf16x8*)(lds + PG8_SA(b, h) + aoff + m * 2048 + k * 1024); } while (0)
#define PG8_LDB(dst, b, h) do { _Pragma("unroll") for (int n = 0; n < 2; ++n) _Pragma("unroll") for (int k = 0; k < 2; ++k) dst[n][k] = *(const PG8_LAS bf16x8*)(lds + PG8_SB(b, h) + boff + n * 2048 + k * 1024); } while (0)
#define PG8_MMA(ai, bj, At, Bt) do { __builtin_amdgcn_s_setprio(1); _Pragma("unroll") for (int m = 0; m < 4; ++m) _Pragma("unroll") for (int n = 0; n < 2; ++n) _Pragma("unroll") for (int k = 0; k < 2; ++k) \
        acc[ai][bj][m][n] = __builtin_amdgcn_mfma_f32_16x16x32_bf16(Bt[n][k], At[m][k], acc[ai][bj][m][n], 0, 0, 0); __builtin_amdgcn_s_setprio(0); } while (0)
#define PG8_WAIT_V(n) asm volatile("s_waitcnt vmcnt(" #n ")" ::: "memory")
#define PG8_WAIT_L(n) asm volatile("s_waitcnt lgkmcnt(" #n ")" ::: "memory")
#define PG8_BAR __builtin_amdgcn_s_barrier()
#define PG8_SCHED __builtin_amdgcn_sched_barrier(0)
    Unit cur, nxt; int ui = 0;
    if (!S.next(0, cur)) return;
    f32x4 acc[2][2][4][2];
#pragma unroll
    for (int a = 0; a < 2; ++a)
#pragma unroll
        for (int b = 0; b < 2; ++b)
#pragma unroll
            for (int m = 0; m < 4; ++m)
#pragma unroll
                for (int n = 0; n < 2; ++n) acc[a][b][m][n] = (f32x4){0.f, 0.f, 0.f, 0.f};
    bf16x8 At[4][2], B0[2][2], B1[2][2];
    const char* cA = (const char*)g.A + (size_t)cur.pm * tstepA; const char* cB = (const char*)g.Bt + (size_t)cur.pn * tstepB;
    S.a_ready(cur);
    PG8_STAGE(PG8_SB(0, 0), cB, voffB); PG8_STAGE(PG8_SA(0, 0), cA, voffA); PG8_STAGE(PG8_SB(0, 1), cB + hstepB, voffB); PG8_STAGE(PG8_SA(0, 1), cA + hstepA, voffA);
    if (wr == 1) PG8_BAR;
    PG8_WAIT_V(4); PG8_BAR;
    PG8_STAGE(PG8_SB(1, 0), cB + kstep, voffB); PG8_STAGE(PG8_SA(1, 0), cA + kstep, voffA); PG8_STAGE(PG8_SB(1, 1), cB + hstepB + kstep, voffB);
    PG8_WAIT_V(6); PG8_BAR;
    PG8_STAMP();
    for (;;) {
        const bool has_next = S.next(ui + 1, nxt);
        const char* nA = has_next ? (const char*)g.A + (size_t)nxt.pm * tstepA : cA; const char* nB = has_next ? (const char*)g.Bt + (size_t)nxt.pn * tstepB : cB;
        for (int t = 0; t < nt; t += 2) {
            const bool last = (t == nt - 2);
            const char* a1 = cA + (size_t)(t + 1) * kstep;
            const char* a2 = last ? nA : cA + (size_t)(t + 2) * kstep; const char* b2 = last ? nB : cB + (size_t)(t + 2) * kstep;
            const char* a3 = a2 + kstep; const char* b3 = b2 + kstep;
            if (last && has_next) S.a_ready(nxt);
            PG8_LDB(B0, 0, 0); PG8_SCHED; PG8_LDA(At, 0, 0); PG8_STAGE(PG8_SA(1, 1), a1 + hstepA, voffA);
            PG8_WAIT_L(8); PG8_BAR; PG8_WAIT_L(0); PG8_MMA(0, 0, At, B0); PG8_BAR; PG8_SCHED;
            PG8_LDB(B1, 0, 1); PG8_STAGE(PG8_SB(0, 0), b2, voffB);
            PG8_BAR; PG8_WAIT_L(0); PG8_MMA(0, 1, At, B1); PG8_BAR;
            PG8_LDA(At, 0, 1); PG8_STAGE(PG8_SA(0, 0), a2, voffA);
            PG8_BAR; PG8_WAIT_L(0); PG8_MMA(1, 0, At, B0); PG8_BAR; PG8_SCHED;
            PG8_STAGE(PG8_SB(0, 1), b2 + hstepB, voffB);
            PG8_WAIT_V(6); PG8_BAR; PG8_MMA(1, 1, At, B1); PG8_BAR;
            PG8_LDB(B0, 1, 0); PG8_SCHED; PG8_LDA(At, 1, 0); PG8_STAGE(PG8_SA(0, 1), a2 + hstepA, voffA);
            PG8_WAIT_L(8); PG8_BAR; PG8_WAIT_L(0); PG8_MMA(0, 0, At, B0); PG8_BAR; PG8_SCHED;
            PG8_LDB(B1, 1, 1); PG8_STAGE(PG8_SB(1, 0), b3, voffB);
            PG8_BAR; PG8_WAIT_L(0); PG8_MMA(0, 1, At, B1); PG8_BAR;
            PG8_LDA(At, 1, 1); PG8_STAGE(PG8_SA(1, 0), a3, voffA);
            PG8_BAR; PG8_WAIT_L(0); PG8_MMA(1, 0, At, B0); PG8_BAR; PG8_SCHED;
            PG8_STAGE(PG8_SB(1, 1), b3 + hstepB, voffB);
            PG8_WAIT_V(6); PG8_BAR; PG8_MMA(1, 1, At, B1); PG8_BAR;
        }
        PG8_STAMP();
        if constexpr (!Epi::AFTER_DRAIN) { E(acc, cur, wr, wc, fr, fq); S.done(cur); }
        PG8_STAMP();
        if (!has_next) break;
#pragma unroll
        for (int a = 0; a < 2; ++a)
#pragma unroll
            for (int b = 0; b < 2; ++b)
#pragma unroll
                for (int m = 0; m < 4; ++m)
#pragma unroll
                    for (int n = 0; n < 2; ++n) acc[a][b][m][n] = (f32x4){0.f, 0.f, 0.f, 0.f};
        cur = nxt; cA = nA; cB = nB; ++ui;
    }
    PG8_WAIT_V(0);
    if (wr == 0) PG8_BAR;
    PG8_BAR;
    if constexpr (Epi::AFTER_DRAIN) { E.fused(acc, cur, wr, wc, fr, fq, lds, wid, lane); S.done(cur); }
    PG8_STAMP();
    if (STAMP && wid == 0) { stamps[lane] = lane < nts ? (((unsigned long long)(unsigned)ts_hi << 32) | (unsigned)ts_lo) : 0ull;
        if (lane == 62) stamps[62] = rt_entry; if (lane == 63) stamps[63] = (unsigned long long)wall_clock64(); }
#undef PG8_STAMP
#undef PG8_SA
#undef PG8_SB
#undef PG8_STAGE
#undef PG8_LDA
#undef PG8_LDB
#undef PG8_MMA
#undef PG8_WAIT_V
#undef PG8_WAIT_L
#undef PG8_BAR
#undef PG8_SCHED
}
}

#include <cstdio>
#include <ctime>
#include <cstdlib>
#include <cstring>
#include <cmath>
#include <vector>

template <class F> struct EpiG {
    static constexpr bool PERM = false, AFTER_DRAIN = false;
    F f;
    __device__ __forceinline__ void operator()(const f32x4 (&acc)[2][2][4][2], const pg8::Unit& u, int wr, int wc, int fr, int fq) const {
        const int row0 = u.pm * 256 + wr * 64 + fr, col0 = u.pn * 256 + wc * 32 + 4 * fq;
#pragma unroll
        for (int ai = 0; ai < 2; ++ai)
#pragma unroll
            for (int m = 0; m < 4; ++m)
#pragma unroll
                for (int bj = 0; bj < 2; ++bj)
#pragma unroll
                    for (int n = 0; n < 2; ++n) f(row0 + ai * 128 + m * 16, col0 + bj * 128 + n * 16, acc[ai][bj][m][n]);
    }
};
__device__ __forceinline__ void st_bf16x4(bf16_t* p, f32x4 v) { u32x2 w; w.x = pack2bf(v[0], v[1]); w.y = pack2bf(v[2], v[3]); *(u32x2*)p = w; }
__device__ __forceinline__ void st_f32x4(float* p, f32x4 v) { *(f32x4*)p = v; }

struct FStoreBf16 { bf16_t* O; int ldc; int pad_; __device__ __forceinline__ void operator()(int r, int c, f32x4 v) const { st_bf16x4(O + (size_t)r * ldc + c, v); } };
struct FAbIn { bf16_t *Q, *K, *V; float *QI, *U, *WI; unsigned short* KI16;
    __device__ __forceinline__ void operator()(int r, int c, f32x4 v) const {
        if (c < 1024) st_bf16x4(Q + (size_t)r * 1024 + c, v);
        else if (c < 2048) st_bf16x4(K + (size_t)r * 1024 + (c - 1024), v);
        else if (c < 3072) st_bf16x4(V + (size_t)r * 1024 + (c - 2048), v);
        else if (c < 4096) st_f32x4(QI + (size_t)r * 1024 + (c - 3072), v);
        else if (c < 5120) st_f32x4(U + (size_t)r * 1024 + (c - 4096), v);
        else if (c < 5184) { typedef _Float16 h2 __attribute__((ext_vector_type(2))); union { h2 h; unsigned u; } a, b; a.h = (h2){(_Float16)v[0], (_Float16)v[1]}; b.h = (h2){(_Float16)v[2], (_Float16)v[3]};
            u32x2 w; w.x = a.u; w.y = b.u; *(u32x2*)(KI16 + (size_t)r * 64 + (c - 5120)) = w; }
        else if (c < 5200) st_f32x4(WI + (size_t)r * 16 + (c - 5184), v);
    } };
struct FCdIn { float *CQ, *CKV, *KR; bf16_t *XL, *YG;
    __device__ __forceinline__ void operator()(int r, int c, f32x4 v) const {
        if (c < 512) st_f32x4(CQ + (size_t)r * 512 + c, v);
        else if (c < 768) st_f32x4(CKV + (size_t)r * 256 + (c - 512), v);
        else if (c < 832) st_f32x4(KR + (size_t)r * 64 + (c - 768), v);
        else if (c < 1024) {}
        else if (c < 2048) st_bf16x4(XL + (size_t)r * 1024 + (c - 1024), v);
        else st_bf16x4(YG + (size_t)r * 1024 + (c - 2048), v);
    } };
struct FKvUp { bf16_t *K1, *V1;
    __device__ __forceinline__ void operator()(int r, int c, f32x4 v) const {
        const int h = c >> 8, d = c & 255;
        if (d < 128) st_bf16x4(K1 + (size_t)r * 1536 + h * 192 + d, v);
        else st_bf16x4(V1 + (size_t)r * 1024 + h * 128 + (d - 128), v);
    } };

template <class Epi> __global__ __launch_bounds__(512, 2) void k_gemm(pg8::Gemm g, Epi E) {
    extern __shared__ __attribute__((aligned(16))) unsigned char shm[];
    pg8::StaticOrder S; S.init(g.M, g.N, (int)gridDim.x, (int)blockIdx.x);
    pg8::gemm_phase<Epi, pg8::StaticOrder, false>((LAS unsigned char*)shm, g, S, E, nullptr);
}

__global__ void k_convT(const float* __restrict__ W, int ldw, int src_col0, int ncols, int K, bf16_t* __restrict__ Bt) {
    __shared__ float tile[32][33];
    const int n0 = blockIdx.x * 32, k0 = blockIdx.y * 32, tx = threadIdx.x, ty = threadIdx.y;
#pragma unroll
    for (int i = 0; i < 4; ++i) { const int k = k0 + ty + 8 * i, n = n0 + tx; tile[ty + 8 * i][tx] = (n < ncols) ? W[(size_t)k * ldw + src_col0 + n] : 0.f; }
    __syncthreads();
#pragma unroll
    for (int i = 0; i < 4; ++i) { const int n = n0 + ty + 8 * i, k = k0 + tx; if (n < ncols) Bt[(size_t)n * K + k] = f2bf(tile[tx][ty + 8 * i]); }
}

template <int NC> __global__ __launch_bounds__(256) void k_rmsnorm(const float* __restrict__ x, const float* __restrict__ g, bf16_t* __restrict__ out) {
    const int lane = threadIdx.x & 63, row = blockIdx.x * 4 + (threadIdx.x >> 6);
    constexpr int NV = NC / 256;
    const f32x4* xr = (const f32x4*)(x + (size_t)row * NC);
    f32x4 v[NV]; float ss = 0.f;
#pragma unroll
    for (int i = 0; i < NV; ++i) { v[i] = xr[lane + 64 * i]; ss += v[i][0] * v[i][0] + v[i][1] * v[i][1] + v[i][2] * v[i][2] + v[i][3] * v[i][3]; }
    ss = wave_sum(ss);
    const float r = rsqrtf(ss * (1.0f / NC) + NORM_EPS);
#pragma unroll
    for (int i = 0; i < NV; ++i) { const f32x4 gg = ((const f32x4*)g)[lane + 64 * i]; st_bf16x4(out + (size_t)row * NC + 4 * (lane + 64 * i), v[i] * r * gg); }
}
__global__ __launch_bounds__(256) void k_resnorm(const float* xin, const bf16_t* __restrict__ m, const float* __restrict__ gpost, const float* __restrict__ gpre,
                                                 float* xout, bf16_t* __restrict__ h) {
    const int lane = threadIdx.x & 63, row = blockIdx.x * 4 + (threadIdx.x >> 6);
    const f32x4* xr = (const f32x4*)(xin + (size_t)row * DM);
    const u32x2* mr = (const u32x2*)(m + (size_t)row * DM);
    f32x4 mv[8], xv[8]; float ss = 0.f;
#pragma unroll
    for (int i = 0; i < 8; ++i) { const u32x2 w = mr[lane + 64 * i]; mv[i][0] = __uint_as_float(w.x << 16); mv[i][1] = __uint_as_float(w.x & 0xFFFF0000u); mv[i][2] = __uint_as_float(w.y << 16); mv[i][3] = __uint_as_float(w.y & 0xFFFF0000u);
        xv[i] = xr[lane + 64 * i]; ss += mv[i][0] * mv[i][0] + mv[i][1] * mv[i][1] + mv[i][2] * mv[i][2] + mv[i][3] * mv[i][3]; }
    ss = wave_sum(ss);
    const float r1 = rsqrtf(ss * (1.0f / DM) + NORM_EPS);
    float s2 = 0.f;
#pragma unroll
    for (int i = 0; i < 8; ++i) { const f32x4 gg = ((const f32x4*)gpost)[lane + 64 * i]; xv[i] = xv[i] + mv[i] * r1 * gg; ((f32x4*)(xout + (size_t)row * DM))[lane + 64 * i] = xv[i];
        s2 += xv[i][0] * xv[i][0] + xv[i][1] * xv[i][1] + xv[i][2] * xv[i][2] + xv[i][3] * xv[i][3]; }
    if (gpre) {
        s2 = wave_sum(s2);
        const float r2 = rsqrtf(s2 * (1.0f / DM) + NORM_EPS);
#pragma unroll
        for (int i = 0; i < 8; ++i) { const f32x4 gg = ((const f32x4*)gpre)[lane + 64 * i]; st_bf16x4(h + (size_t)row * DM + 4 * (lane + 64 * i), xv[i] * r2 * gg); }
    }
}

__device__ __forceinline__ unsigned ord_key(float f) { const unsigned b = __float_as_uint(f); return (b & 0x80000000u) ? ~b : (b | 0x80000000u); }

__global__ __launch_bounds__(256) void k_pool(const float* __restrict__ U, const float* __restrict__ pw, const float* __restrict__ pb, const float* __restrict__ ps, bf16_t* __restrict__ CC) {
    __shared__ float A[16][256];
    const int r0 = blockIdx.x * 16, g = blockIdx.y, tid = threadIdx.x, win = 2 << g;
    for (int r = 0; r < 16; ++r) {
        const int row = r0 + r, t = row % SEQ, cnt = (t + 1 < win) ? (t + 1) : win;
        float s = 0.f;
        for (int i = 0; i < cnt; ++i) s += U[(size_t)(row - i) * 1024 + g * 256 + tid];
        A[r][tid] = s / (float)cnt - U[(size_t)row * 1024 + g * 256 + tid];
    }
    __syncthreads();
    float acc[16];
#pragma unroll
    for (int r = 0; r < 16; ++r) acc[r] = 0.f;
    const float* w = pw + (size_t)g * 256 * 256 + tid;
    for (int c = 0; c < 256; ++c) { const float wv = w[(size_t)c * 256];
#pragma unroll
        for (int r = 0; r < 16; ++r) acc[r] += A[r][c] * wv; }
    const float bb = pb[g * 256 + tid], sc = ps[g * 256 + tid];
#pragma unroll
    for (int r = 0; r < 16; ++r) CC[(size_t)(r0 + r) * 2048 + 1024 + g * 256 + tid] = f2bf((acc[r] + bb) * sc);
}

__global__ void k_lru_conv(const bf16_t* __restrict__ XL, const float* __restrict__ cw, const float* __restrict__ cb, float* __restrict__ XC) {
    const size_t i = (size_t)blockIdx.x * blockDim.x + threadIdx.x;
    const int c = (int)(i & 1023); const int row = (int)(i >> 10), t = row % SEQ;
    float y = cb[c];
#pragma unroll
    for (int k = 0; k < 4; ++k) { const int tt = t - 3 + k; if (tt >= 0) y += cw[k * 1024 + c] * bf2f(XL[(size_t)(row - 3 + k) * 1024 + c]); }
    XC[i] = y;
}
__global__ __launch_bounds__(128) void k_lru_gates(const float* __restrict__ XC, const float* __restrict__ wa, const float* __restrict__ ba, const float* __restrict__ wx, const float* __restrict__ bx,
                                                   const float* __restrict__ lam, float* __restrict__ Aout, float* __restrict__ Bout) {
    __shared__ float A[16][128];
    const int r0 = blockIdx.x * 16, n = blockIdx.y, tid = threadIdx.x, ch = n * 128 + tid;
    for (int r = 0; r < 16; ++r) A[r][tid] = XC[(size_t)(r0 + r) * 1024 + ch];
    __syncthreads();
    float ga[16], gx[16];
#pragma unroll
    for (int r = 0; r < 16; ++r) { ga[r] = 0.f; gx[r] = 0.f; }
    const float* pa = wa + (size_t)n * 128 * 128 + tid; const float* px = wx + (size_t)n * 128 * 128 + tid;
    for (int c = 0; c < 128; ++c) { const float va = pa[(size_t)c * 128], vx = px[(size_t)c * 128];
#pragma unroll
        for (int r = 0; r < 16; ++r) { ga[r] += A[r][c] * va; gx[r] += A[r][c] * vx; } }
    const float bav = ba[ch], bxv = bx[ch], lm = lam[ch];
    const float sp = (lm > 20.f) ? expf(-lm) : log1pf(expf(-lm));
#pragma unroll
    for (int r = 0; r < 16; ++r) {
        const float rg = 1.0f / (1.0f + expf(-(ga[r] + bav))), ig = 1.0f / (1.0f + expf(-(gx[r] + bxv)));
        const float log_a = -8.0f * rg * sp, a = expf(log_a), mult = sqrtf(-expm1f(2.0f * log_a));
        Aout[(size_t)(r0 + r) * 1024 + ch] = a; Bout[(size_t)(r0 + r) * 1024 + ch] = mult * (ig * A[r][tid]);
    }
}
__global__ void k_lru_scan1(const float* __restrict__ Aa, const float* __restrict__ Bb, float* __restrict__ CA, float* __restrict__ CH) {
    const int i = blockIdx.x * blockDim.x + threadIdx.x;
    const int ch = i & 1023, chunk = (i >> 10) & 255, b = i >> 18;
    const size_t base = ((size_t)b * SEQ + (size_t)chunk * 64) * 1024 + ch;
    float h = 0.f, P = 1.f;
    for (int s = 0; s < 64; ++s) { const float a = Aa[base + (size_t)s * 1024]; h = a * h + Bb[base + (size_t)s * 1024]; P *= a; }
    CA[i] = P; CH[i] = h;
}
__global__ void k_lru_scan2(const float* __restrict__ CA, const float* __restrict__ CH, float* __restrict__ CIN) {
    const int i = blockIdx.x * blockDim.x + threadIdx.x;
    const int ch = i & 1023, b = i >> 10;
    float h = 0.f;
    for (int c = 0; c < 256; ++c) { const int j = (b * 256 + c) * 1024 + ch; CIN[j] = h; h = CA[j] * h + CH[j]; }
}
__global__ void k_lru_scan3(const float* __restrict__ Aa, const float* __restrict__ Bb, const float* __restrict__ CIN, const bf16_t* __restrict__ YG, bf16_t* __restrict__ CC) {
    const int i = blockIdx.x * blockDim.x + threadIdx.x;
    const int ch = i & 1023, chunk = (i >> 10) & 255, b = i >> 18;
    const size_t row0 = (size_t)b * SEQ + (size_t)chunk * 64;
    float h = CIN[i];
    for (int s = 0; s < 64; ++s) { const size_t r = row0 + s; h = Aa[r * 1024 + ch] * h + Bb[r * 1024 + ch];
        CC[r * 2048 + 1024 + ch] = f2bf(h * gelu_tanh(bf2f(YG[r * 1024 + ch]))); }
}

__device__ __forceinline__ void rope_cs(int pos, int i, float& c, float& s) { const float freq = powf(10000.0f, -(float)i / 32.0f); const float ang = (float)pos * freq; sincosf(ang, &s, &c); }
__global__ void k_rope_q(bf16_t* __restrict__ Q1, const int* __restrict__ pos) {
    const int idx = blockIdx.x * blockDim.x + threadIdx.x;
    const int i = idx & 31, h = (idx >> 5) & 7, row = idx >> 8;
    float c, s; rope_cs(pos[row], i, c, s);
    bf16_t* p = Q1 + (size_t)row * 1536 + h * 192 + 128;
    const float x1 = bf2f(p[i]), x2 = bf2f(p[32 + i]);
    p[i] = f2bf(x1 * c - x2 * s); p[32 + i] = f2bf(x2 * c + x1 * s);
}
__global__ void k_rope_k(const float* __restrict__ KR, const int* __restrict__ pos, bf16_t* __restrict__ K1) {
    const int idx = blockIdx.x * blockDim.x + threadIdx.x;
    const int i = idx & 31, row = idx >> 5;
    float c, s; rope_cs(pos[row], i, c, s);
    const float x1 = KR[(size_t)row * 64 + i], x2 = KR[(size_t)row * 64 + 32 + i];
    const bf16_t o1 = f2bf(x1 * c - x2 * s), o2 = f2bf(x2 * c + x1 * s);
#pragma unroll
    for (int h = 0; h < 8; ++h) { bf16_t* p = K1 + (size_t)row * 1536 + h * 192 + 128; p[i] = o1; p[32 + i] = o2; }
}

__global__ void k_ffn_gate(const bf16_t* __restrict__ HID, const float* __restrict__ cw, const float* __restrict__ cb, bf16_t* __restrict__ ACT) {
    const size_t i = (size_t)blockIdx.x * blockDim.x + threadIdx.x;
    const int c8 = (int)(i & 511) * 8, t = (int)(i >> 9);
    float g[8], v[8];
#pragma unroll
    for (int j = 0; j < 8; ++j) { g[j] = cb[c8 + j]; v[j] = cb[4096 + c8 + j]; }
#pragma unroll
    for (int k = 0; k < 3; ++k) { const int tt = t - 2 + k; if (tt < 0) continue;
        const u32x4 wg = *(const u32x4*)(HID + (size_t)tt * 8192 + c8), wv = *(const u32x4*)(HID + (size_t)tt * 8192 + 4096 + c8);
        const unsigned ug[4] = {wg.x, wg.y, wg.z, wg.w}, uv[4] = {wv.x, wv.y, wv.z, wv.w};
#pragma unroll
        for (int j = 0; j < 4; ++j) {
            g[2 * j] += cw[k * 8192 + c8 + 2 * j] * __uint_as_float(ug[j] << 16); g[2 * j + 1] += cw[k * 8192 + c8 + 2 * j + 1] * __uint_as_float(ug[j] & 0xFFFF0000u);
            v[2 * j] += cw[k * 8192 + 4096 + c8 + 2 * j] * __uint_as_float(uv[j] << 16); v[2 * j + 1] += cw[k * 8192 + 4096 + c8 + 2 * j + 1] * __uint_as_float(uv[j] & 0xFFFF0000u); } }
    u32x4 o;
    o.x = pack2bf(gelu_tanh(g[0]) * v[0], gelu_tanh(g[1]) * v[1]); o.y = pack2bf(gelu_tanh(g[2]) * v[2], gelu_tanh(g[3]) * v[3]);
    o.z = pack2bf(gelu_tanh(g[4]) * v[4], gelu_tanh(g[5]) * v[5]); o.w = pack2bf(gelu_tanh(g[6]) * v[6], gelu_tanh(g[7]) * v[7]);
    *(u32x4*)(ACT + (size_t)t * 4096 + c8) = o;
}


typedef short bf16x8 __attribute__((ext_vector_type(8)));
typedef float f32x16 __attribute__((ext_vector_type(16)));
__device__ __forceinline__ unsigned cvtpk(float lo, float hi) { unsigned r; asm volatile("v_cvt_pk_bf16_f32 %0, %1, %2" : "=v"(r) : "v"(lo), "v"(hi)); return r; }

__device__ __forceinline__ void transpose_v_tile(LAS unsigned short* tile  , const bf16_t* __restrict__ V, bf16_t* __restrict__ VT, int tileid, int tid) {
    const int tt = tileid >> 4, ct = tileid & 15;
    const int row0 = tt * 64, c0 = ct * 64;
#pragma unroll
    for (int i = 0; i < 2; ++i) { const int r = (tid >> 3) + 32 * i, c = (tid & 7) * 8;
        const u32x4 w = *(const u32x4*)(V + (size_t)(row0 + r) * 1024 + c0 + c);
        LAS unsigned* dst = (LAS unsigned*)(tile + r * 66 + c);
        dst[0] = w.x; dst[1] = w.y; dst[2] = w.z; dst[3] = w.w; }
    __syncthreads();
    { const int d = tid >> 2, part = tid & 3;
      const int b = row0 / SEQ, t0 = row0 % SEQ, col = c0 + d, h = col >> 7, dd = col & 127;
      unsigned short v[16];
#pragma unroll
      for (int p = 0; p < 16; ++p) { const int a = p >> 2, i = p & 3, ka = (a == 1) ? 2 : ((a == 2) ? 1 : a); v[p] = tile[(part * 16 + ka * 4 + i) * 66 + d]; }
      u32x4 w0, w1;
      w0.x = v[0] | ((unsigned)v[1] << 16); w0.y = v[2] | ((unsigned)v[3] << 16); w0.z = v[4] | ((unsigned)v[5] << 16); w0.w = v[6] | ((unsigned)v[7] << 16);
      w1.x = v[8] | ((unsigned)v[9] << 16); w1.y = v[10] | ((unsigned)v[11] << 16); w1.z = v[12] | ((unsigned)v[13] << 16); w1.w = v[14] | ((unsigned)v[15] << 16);
      bf16_t* dst = VT + ((size_t)(b * 8 + h) * 128 + dd) * SEQ + t0 + part * 16;
      *(u32x4*)dst = w0; *(u32x4*)(dst + 8) = w1; }
    __syncthreads();
}
__global__ __launch_bounds__(256) void k_transpose_v(const bf16_t* __restrict__ V, bf16_t* __restrict__ VT) {
    __shared__ unsigned short tile[64 * 66];
    for (int t = blockIdx.x; t < 8192; t += gridDim.x) transpose_v_tile((LAS unsigned short*)tile, V, VT, t, threadIdx.x);
}

struct AttnArgs { const bf16_t* Q; const bf16_t* K; const bf16_t* VT; const unsigned long long* MT; bf16_t* O; int ldq, ldk, ldo; float sc_log2e; };

template <int DQK, bool MASKED>
__device__ __forceinline__ void attn_item(LAS unsigned char* lds, const AttnArgs& a, int b, int h, int qb) {
    constexpr int NKS = DQK / 16, PK = DQK * 2, PV = 128, KB_BYTES = 64 * PK, VB_BYTES = 128 * PV, STAGE = KB_BYTES + VB_BYTES, NPK = DQK / 8, NKP = (64 * NPK) / 512;
    const int tid = threadIdx.x, lane = tid & 63, w = __builtin_amdgcn_readfirstlane(tid >> 6), n = lane & 31, hf = lane >> 5;
    const int nt = 4 * qb + 4, cw = 4 * qb + (w >> 1);
    const int trow = qb * 256 + w * 32 + n;
    const size_t grow = (size_t)b * SEQ + trow;
    bf16x8 qf[NKS];
    { const bf16_t* qp = a.Q + grow * a.ldq + h * DQK + hf * 8;
#pragma unroll
      for (int ks = 0; ks < NKS; ++ks) qf[ks] = *(const bf16x8*)(qp + ks * 16); }
    f32x16 o[4];
#pragma unroll
    for (int dt = 0; dt < 4; ++dt)
#pragma unroll
        for (int r = 0; r < 16; ++r) o[dt][r] = 0.f;
    float m_run = -INFINITY, l_run = 0.f;
    const float c = a.sc_log2e;
    const bf16_t* Kg = a.K + (size_t)b * SEQ * a.ldk + h * DQK;
    const bf16_t* Vg = a.VT + (size_t)(b * 8 + h) * 128 * SEQ;
    const unsigned long long* Mg = MASKED ? a.MT + (size_t)b * 256 * SEQ + trow : nullptr;
    auto dma = [&](int kt, int buf) {
        LAS unsigned char* kb = lds + buf * STAGE; LAS unsigned char* vb = kb + KB_BYTES;
#pragma unroll
        for (int i = 0; i < NKP; ++i) { const int s = (w + 8 * i) * 64 + lane, r = s / NPK, cp = s % NPK, cc = cp ^ (NPK == 16 ? (r & 15) : ((r >> 1) & 7));
            __builtin_amdgcn_global_load_lds((const unsigned*)(Kg + (size_t)(kt * 64 + r) * a.ldk + cc * 8), (LAS unsigned*)(kb + (w + 8 * i) * 1024), 16, 0, 0); }
#pragma unroll
        for (int i = 0; i < 2; ++i) { const int s = (w + 8 * i) * 64 + lane, d = s >> 3, cp = s & 7, cc = cp ^ ((d >> 1) & 7);
            __builtin_amdgcn_global_load_lds((const unsigned*)(Vg + (size_t)d * SEQ + kt * 64 + cc * 8), (LAS unsigned*)(vb + (w + 8 * i) * 1024), 16, 0, 0); }
    };
    dma(0, 0);
    asm volatile("s_waitcnt vmcnt(0)" ::: "memory");
    __syncthreads();
    for (int kt = 0; kt < nt; ++kt) {
        const bool more = (kt + 1 < nt);
        if (more) dma(kt + 1, (kt + 1) & 1);
        if (kt <= cw) {
            unsigned mlo = 0xFFFFFFFFu, mhi = 0xFFFFFFFFu;
            if (MASKED) { const unsigned long long mw = Mg[(size_t)kt * SEQ]; mlo = (unsigned)mw >> (hf * 4); mhi = (unsigned)(mw >> 32) >> (hf * 4); }
            LAS unsigned char* kb = lds + (kt & 1) * STAGE; LAS unsigned char* vb = kb + KB_BYTES;
            f32x16 s0, s1;
#pragma unroll
            for (int r = 0; r < 16; ++r) { s0[r] = 0.f; s1[r] = 0.f; }
            const int kswz = (NPK == 16) ? (n & 15) : ((n >> 1) & 7);
            const LAS unsigned char* ka = kb + n * PK;
#pragma unroll
            for (int ks = 0; ks < NKS; ++ks) {
                const int po = ((2 * ks + hf) ^ kswz) * 16;
                const bf16x8 a0 = *(const LAS bf16x8*)(ka + po), a1 = *(const LAS bf16x8*)(ka + 32 * PK + po);
                s0 = __builtin_amdgcn_mfma_f32_32x32x16_bf16(a0, qf[ks], s0, 0, 0, 0);
                s1 = __builtin_amdgcn_mfma_f32_32x32x16_bf16(a1, qf[ks], s1, 0, 0, 0);
            }
            if (MASKED) {
#pragma unroll
                for (int r = 0; r < 16; ++r) { const unsigned bit = 1u << ((r >> 2) * 8 + (r & 3));
                    s0[r] = (mlo & bit) ? s0[r] : -INFINITY; s1[r] = (mhi & bit) ? s1[r] : -INFINITY; }
            }
            float mx = fmaxf(s0[0], s1[0]);
#pragma unroll
            for (int r = 1; r < 16; ++r) mx = fmaxf(mx, fmaxf(s0[r], s1[r]));
            mx = fmaxf(mx, __shfl_xor(mx, 32));
            const float m_new = fmaxf(m_run, mx);
            const float m_use = (MASKED && m_new == -INFINITY) ? 0.f : m_new;
            if (__any(m_new > m_run)) {
                const float al = __builtin_amdgcn_exp2f((m_run - m_use) * c);
                l_run *= al;
#pragma unroll
                for (int dt = 0; dt < 4; ++dt)
#pragma unroll
                    for (int r = 0; r < 16; ++r) o[dt][r] *= al;
            }
            m_run = m_new;
            const float mc = m_use * c;
            float ps = 0.f;
#pragma unroll
            for (int r = 0; r < 16; ++r) { s0[r] = __builtin_amdgcn_exp2f(fmaf(s0[r], c, -mc)); s1[r] = __builtin_amdgcn_exp2f(fmaf(s1[r], c, -mc)); ps += s0[r] + s1[r]; }
            l_run += ps;
            bf16x8 pf[4];
            { u32x4 t;
              t.x = cvtpk(s0[0], s0[1]); t.y = cvtpk(s0[2], s0[3]); t.z = cvtpk(s0[4], s0[5]); t.w = cvtpk(s0[6], s0[7]); pf[0] = *(bf16x8*)&t;
              t.x = cvtpk(s0[8], s0[9]); t.y = cvtpk(s0[10], s0[11]); t.z = cvtpk(s0[12], s0[13]); t.w = cvtpk(s0[14], s0[15]); pf[1] = *(bf16x8*)&t;
              t.x = cvtpk(s1[0], s1[1]); t.y = cvtpk(s1[2], s1[3]); t.z = cvtpk(s1[4], s1[5]); t.w = cvtpk(s1[6], s1[7]); pf[2] = *(bf16x8*)&t;
              t.x = cvtpk(s1[8], s1[9]); t.y = cvtpk(s1[10], s1[11]); t.z = cvtpk(s1[12], s1[13]); t.w = cvtpk(s1[14], s1[15]); pf[3] = *(bf16x8*)&t; }
            const int vswz = (n >> 1) & 7;
            const LAS unsigned char* va = vb + n * PV;
#pragma unroll
            for (int g = 0; g < 4; ++g) { const int po = ((2 * g + hf) ^ vswz) * 16;
#pragma unroll
                for (int dt = 0; dt < 4; ++dt) { const bf16x8 vf = *(const LAS bf16x8*)(va + dt * 32 * PV + po); o[dt] = __builtin_amdgcn_mfma_f32_32x32x16_bf16(vf, pf[g], o[dt], 0, 0, 0); } }
        }
        asm volatile("s_waitcnt vmcnt(0)" ::: "memory");
        __syncthreads();
    }
    const float lt = l_run + __shfl_xor(l_run, 32);
    const float inv = 1.0f / lt;
    bf16_t* op = a.O + grow * a.ldo + h * 128 + hf * 4;
#pragma unroll
    for (int dt = 0; dt < 4; ++dt)
#pragma unroll
        for (int r4 = 0; r4 < 4; ++r4) { u32x2 wv; wv.x = cvtpk(o[dt][4 * r4] * inv, o[dt][4 * r4 + 1] * inv); wv.y = cvtpk(o[dt][4 * r4 + 2] * inv, o[dt][4 * r4 + 3] * inv);
            *(u32x2*)(op + dt * 32 + r4 * 8) = wv; }
}
template <int DQK, bool MASKED>
__device__ __forceinline__ void attn_phase(LAS unsigned char* lds, const AttnArgs& a, int bid, int nblk) {
    for (int p = bid; p < 512; p += nblk) {
        const int bh = (p & 7) + 8 * (p >> 8), j = (p >> 3) & 31;
        attn_item<DQK, MASKED>(lds, a, bh >> 3, bh & 7, 63 - j);
        attn_item<DQK, MASKED>(lds, a, bh >> 3, bh & 7, j);
    }
}
template <int DQK, bool MASKED> __global__ __launch_bounds__(512, 2) void k_attn(AttnArgs a) {
    extern __shared__ __attribute__((aligned(16))) unsigned char shm[];
    attn_phase<DQK, MASKED>((LAS unsigned char*)shm, a, (int)blockIdx.x, (int)gridDim.x);
}

typedef _Float16 f16x8 __attribute__((ext_vector_type(8)));
struct IdxArgs { const float* QI; const unsigned short* KI16; const float* WI; unsigned long long* MT; };
static constexpr int IDX_CS = 0, IDX_CI = 65536, IDX_KT = 98304, IDX_BM = 131072, IDX_CNT = 147456, IDX_TAU = 147584, IDX_LDS = 147712, IDX_CAP = 512;

__device__ __forceinline__ float ord_inv(unsigned T) { return __uint_as_float((T & 0x80000000u) ? (T & 0x7FFFFFFFu) : ~T); }
__device__ __forceinline__ unsigned lane_prefix(unsigned long long m) { return __builtin_amdgcn_mbcnt_hi((unsigned)(m >> 32), __builtin_amdgcn_mbcnt_lo((unsigned)m, 0u)); }

__device__ __forceinline__ void idx_compact(LAS unsigned char* lds, int qq, int lane) {
    LAS float* cs = (LAS float*)(lds + IDX_CS) + qq * IDX_CAP; LAS unsigned short* ci = (LAS unsigned short*)(lds + IDX_CI) + qq * IDX_CAP;
    LAS unsigned* cnt = (LAS unsigned*)(lds + IDX_CNT); LAS float* tau = (LAS float*)(lds + IDX_TAU);
    const int n = (int)cnt[qq];
    float sv[8]; unsigned short iv[8]; unsigned uk[8];
#pragma unroll
    for (int j = 0; j < 8; ++j) { const int idx = lane + 64 * j; const bool valid = idx < n; sv[j] = cs[idx]; iv[j] = ci[idx]; uk[j] = valid ? ord_key(sv[j]) : 0u; }
    unsigned T = 0u;
    for (int bit = 31; bit >= 0; --bit) {
        const unsigned Tc = T | (1u << bit); int c = 0;
#pragma unroll
        for (int j = 0; j < 8; ++j) c += __builtin_popcountll(__ballot(uk[j] >= Tc));
        if (c >= 256) T = Tc;
    }
    int ngt = 0;
#pragma unroll
    for (int j = 0; j < 8; ++j) ngt += __builtin_popcountll(__ballot(uk[j] > T));
    const int need = 256 - ngt;
    int base = 0, tiebase = 0;
#pragma unroll
    for (int j = 0; j < 8; ++j) {
        const bool gt = uk[j] > T, eq = uk[j] == T;
        const unsigned long long em = __ballot(eq);
        const bool keep = gt || (eq && (tiebase + (int)lane_prefix(em)) < need);
        tiebase += __builtin_popcountll(em);
        const unsigned long long km = __ballot(keep);
        const int pos = base + (int)lane_prefix(km);
        if (keep) { cs[pos] = sv[j]; ci[pos] = iv[j]; }
        base += __builtin_popcountll(km);
    }
    if (lane == 0) { cnt[qq] = 256u; tau[qq] = ord_inv(T); }
}

__device__ __forceinline__ void idx_item(LAS unsigned char* lds, const IdxArgs& a, int b, int hc) {
    const int tid = threadIdx.x, lane = tid & 63, w = __builtin_amdgcn_readfirstlane(tid >> 6), n = lane & 31, hf = lane >> 5;
    const int t0 = hc * 32, L = (t0 / 64 + 1) * 64, nsub = L / 32, ntile = (L + 127) / 128;
    const size_t q0 = (size_t)b * SEQ + t0 + 4 * w;
    LAS float* cs = (LAS float*)(lds + IDX_CS); LAS unsigned short* ci = (LAS unsigned short*)(lds + IDX_CI);
    LAS unsigned* cnt = (LAS unsigned*)(lds + IDX_CNT); LAS float* tau = (LAS float*)(lds + IDX_TAU);
    f16x8 qf[2][4];
#pragma unroll
    for (int rt = 0; rt < 2; ++rt) { const float* qp = a.QI + (q0 + 2 * rt + (n >> 4)) * 1024 + (n & 15) * 64 + hf * 8;
#pragma unroll
        for (int ks = 0; ks < 4; ++ks) { const f32x4 x0 = *(const f32x4*)(qp + ks * 16), x1 = *(const f32x4*)(qp + ks * 16 + 4);
            f16x8 v; v[0] = (_Float16)x0[0]; v[1] = (_Float16)x0[1]; v[2] = (_Float16)x0[2]; v[3] = (_Float16)x0[3]; v[4] = (_Float16)x1[0]; v[5] = (_Float16)x1[1]; v[6] = (_Float16)x1[2]; v[7] = (_Float16)x1[3];
            qf[rt][ks] = v; } }
    float wv[2][16];
#pragma unroll
    for (int rt = 0; rt < 2; ++rt)
#pragma unroll
        for (int r = 0; r < 16; ++r) wv[rt][r] = a.WI[(q0 + 2 * rt + (r >> 3)) * 16 + (((r & 3) + 8 * (r >> 2) + 4 * hf) & 15)] * (0.125f * 0.25f);
    if (tid < 32) { cnt[tid] = 0u; tau[tid] = -INFINITY; }
    float tau_reg[2] = {-INFINITY, -INFINITY};
    const unsigned short* Kg = a.KI16 + (size_t)b * SEQ * 64;
    auto dma = [&](int kt, int buf) {
        LAS unsigned char* kb = lds + IDX_KT + buf * 16384;
#pragma unroll
        for (int i = 0; i < 2; ++i) { const int s = (w + 8 * i) * 64 + lane, r = s >> 3, cp = s & 7, cc = cp ^ ((r >> 1) & 7);
            __builtin_amdgcn_global_load_lds((const unsigned*)(Kg + (size_t)(kt * 128 + r) * 64 + cc * 8), (LAS unsigned*)(kb + (w + 8 * i) * 1024), 16, 0, 0); }
    };
    dma(0, 0);
    asm volatile("s_waitcnt vmcnt(0)" ::: "memory");
    __syncthreads();
    const int kswz = (n >> 1) & 7;
    for (int kt = 0; kt < ntile; ++kt) {
        if (kt + 1 < ntile) dma(kt + 1, (kt + 1) & 1);
        { const unsigned c_all = cnt[lane & 31];
          if (__ballot(c_all > (unsigned)(IDX_CAP - 128))) {
#pragma unroll 1
              for (int i = 0; i < 4; ++i) { const int qq = 4 * w + i; if (cnt[qq] > 288u) idx_compact(lds, qq, lane); }
              tau_reg[0] = tau[4 * w + hf]; tau_reg[1] = tau[4 * w + 2 + hf];
          } }
        const LAS unsigned char* kb = lds + IDX_KT + (kt & 1) * 16384;
#pragma unroll 1
        for (int sub = 0; sub < 4; ++sub) {
            if (kt * 4 + sub >= nsub) break;
            const LAS unsigned char* kr = kb + (sub * 32 + n) * 128;
            f16x8 kf[4];
#pragma unroll
            for (int ks = 0; ks < 4; ++ks) kf[ks] = *(const LAS f16x8*)(kr + ((2 * ks + hf) ^ kswz) * 16);
            const int key = kt * 128 + sub * 32 + n;
#pragma unroll
            for (int rt = 0; rt < 2; ++rt) {
                f32x16 acc;
#pragma unroll
                for (int r = 0; r < 16; ++r) acc[r] = 0.f;
#pragma unroll
                for (int ks = 0; ks < 4; ++ks) acc = __builtin_amdgcn_mfma_f32_32x32x16_f16(qf[rt][ks], kf[ks], acc, 0, 0, 0);
                float pa = 0.f, pb = 0.f;
#pragma unroll
                for (int r = 0; r < 8; ++r) { pa = fmaf(fmaxf(acc[r], 0.f), wv[rt][r], pa); pb = fmaf(fmaxf(acc[r + 8], 0.f), wv[rt][r + 8], pb); }
                const float send = hf ? pa : pb, mine = hf ? pb : pa;
                const float sc = mine + __shfl_xor(send, 32);
                if (sc > tau_reg[rt]) { const int qq = 4 * w + 2 * rt + hf; const unsigned pos = __hip_atomic_fetch_add(cnt + qq, 1u, __ATOMIC_RELAXED, __HIP_MEMORY_SCOPE_WORKGROUP);
                    if (pos < (unsigned)IDX_CAP) { cs[qq * IDX_CAP + pos] = sc; ci[qq * IDX_CAP + pos] = (unsigned short)key; } }
            }
        }
        asm volatile("s_waitcnt vmcnt(0)" ::: "memory");
        __syncthreads();
    }
    LAS unsigned* bm = (LAS unsigned*)(lds + IDX_BM) + w * 512;
#pragma unroll 1
    for (int i = 0; i < 4; ++i) {
        const int qq = 4 * w + i;
        if (cnt[qq] > 256u) idx_compact(lds, qq, lane);
        const int nsel = (int)cnt[qq];
#pragma unroll
        for (int j = 0; j < 8; ++j) bm[lane + 64 * j] = 0u;
#pragma unroll
        for (int j = 0; j < 4; ++j) { const int idx = lane + 64 * j; if (idx < nsel) { const unsigned k = ci[qq * IDX_CAP + idx]; (void)__hip_atomic_fetch_or(bm + (k >> 5), 1u << (k & 31), __ATOMIC_RELAXED, __HIP_MEMORY_SCOPE_WORKGROUP); } }
        const int tq = t0 + qq;
#pragma unroll 1
        for (int kt = lane; kt < L / 64; kt += 64) { const unsigned long long v = (unsigned long long)bm[2 * kt] | ((unsigned long long)bm[2 * kt + 1] << 32); a.MT[((size_t)b * 256 + kt) * SEQ + tq] = v; }
    }
    __syncthreads();
}
__device__ __forceinline__ void idx_phase(LAS unsigned char* lds, const IdxArgs& a, int bid, int nblk) {
    for (int k = bid; k < 256; k += nblk) {
        idx_item(lds, a, 0, 511 - k); idx_item(lds, a, 1, 511 - k); idx_item(lds, a, 0, k); idx_item(lds, a, 1, k);
    }
}
__global__ __launch_bounds__(512, 2) void k_indexer(IdxArgs a) {
    extern __shared__ __attribute__((aligned(16))) unsigned char shm[];
    idx_phase((LAS unsigned char*)shm, a, (int)blockIdx.x, (int)gridDim.x);
}
static constexpr size_t MiB = 1048576;
static constexpr size_t W_UP0 = 0 * MiB, W_UP1 = 32 * MiB, W_DN0 = 64 * MiB, W_DN1 = 80 * MiB, W_ABIN = 96 * MiB, W_ABOUT = 117 * MiB, W_CDIN = 125 * MiB, W_CDOUT = 137 * MiB,
                        W_QUP = 145 * MiB, W_KVUP = 146 * MiB + 512 * 1024;
static constexpr size_t R_H = 148 * MiB;
static constexpr size_t R_Q0 = 276 * MiB, R_K0 = 340 * MiB, R_V0 = 404 * MiB, R_QI = 468 * MiB, R_M0 = 468 * MiB, R_U = 596 * MiB, R_KI = 724 * MiB, R_WI = 732 * MiB, R_MASK = 734 * MiB, R_CC0 = 830 * MiB, R_VT0 = 958 * MiB;
static constexpr size_t R_HID = 276 * MiB, R_ACT = 532 * MiB, R_F = 660 * MiB;
static constexpr size_t R_CQ = 276 * MiB, R_CKV = 340 * MiB, R_KR = 372 * MiB, R_XL = 380 * MiB, R_YG = 444 * MiB, R_CQN = 508 * MiB, R_CKVN = 540 * MiB, R_Q1 = 556 * MiB, R_K1 = 652 * MiB, R_V1 = 748 * MiB, R_VT1 = 812 * MiB,
                        R_LA = 556 * MiB, R_LB = 684 * MiB, R_XC = 812 * MiB, R_CA = 940 * MiB, R_CH = 942 * MiB, R_CIN = 944 * MiB, R_CC1 = 148 * MiB, R_M1 = 276 * MiB;
static constexpr size_t WS_NEED = 1022 * MiB;
static constexpr int GEMM_LDS = 131072;

template <class F> static void launch_gemm(hipStream_t st, const bf16_t* A, int lda, const bf16_t* Bt, int ldb, int M, int N, int K, const F& f) {
    typedef EpiG<F> E;
    static bool attr = false;
    if (!attr) { (void)hipFuncSetAttribute((const void*)k_gemm<E>, hipFuncAttributeMaxDynamicSharedMemorySize, GEMM_LDS); attr = true; }
    pg8::Gemm g{}; g.A = A; g.Bt = Bt; g.M = M; g.N = N; g.K = K; g.lda = lda; g.ldb = ldb;
    E e{}; e.f = f;
    hipLaunchKernelGGL(k_gemm<E>, dim3(256), dim3(512), GEMM_LDS, st, g, e);
}
template <int DQK, bool MASKED> static void launch_attn(hipStream_t st, const AttnArgs& a) {
    constexpr int lds = 2 * (64 * DQK * 2 + 128 * 128);
    static bool attr = false;
    if (!attr) { (void)hipFuncSetAttribute((const void*)k_attn<DQK, MASKED>, hipFuncAttributeMaxDynamicSharedMemorySize, lds); attr = true; }
    hipLaunchKernelGGL((k_attn<DQK, MASKED>), dim3(256), dim3(512), lds, st, a);
}
static void convT(hipStream_t st, const float* W, int ldw, int src_col0, int ncols, int K, bf16_t* Bt) {
    hipLaunchKernelGGL(k_convT, dim3((ncols + 31) / 32, K / 32), dim3(32, 8), 0, st, W, ldw, src_col0, ncols, K, Bt);
}

extern "C" void kernel_launch(void* const* d_in, const int* in_sizes, int n_in, void* d_out, int out_size, void* d_ws, size_t ws_size, hipStream_t stream) {
    if (n_in != 28 || out_size != NTOK * DM || ws_size < WS_NEED) { fprintf(stderr, "kernel_launch: unexpected shapes (n_in %d out %d ws %zu)\n", n_in, out_size, ws_size); return; }
    const float* x = (const float*)d_in[0]; const int* positions = (const int*)d_in[1];
    const float *mix_pre_g = (const float*)d_in[2], *mix_post_g = (const float*)d_in[3], *ffn_pre_g = (const float*)d_in[4], *ffn_post_g = (const float*)d_in[5];
    const float *ffn_up = (const float*)d_in[6], *ffn_conv_w = (const float*)d_in[7], *ffn_conv_b = (const float*)d_in[8], *ffn_down = (const float*)d_in[9];
    const float *ab_w_in = (const float*)d_in[10], *pool_w = (const float*)d_in[11], *pool_b = (const float*)d_in[12], *pool_scale = (const float*)d_in[13], *ab_w_out = (const float*)d_in[14];
    const float *cd_w_in = (const float*)d_in[15], *q_norm_g = (const float*)d_in[16], *w_q_up = (const float*)d_in[17], *kv_norm_g = (const float*)d_in[18], *w_kv_up = (const float*)d_in[19];
    const float *lru_conv_w = (const float*)d_in[20], *lru_conv_b = (const float*)d_in[21], *lru_wa = (const float*)d_in[22], *lru_ba = (const float*)d_in[23], *lru_wx = (const float*)d_in[24],
                *lru_bx = (const float*)d_in[25], *lru_lambda = (const float*)d_in[26], *cd_w_out = (const float*)d_in[27];
    unsigned char* ws = (unsigned char*)d_ws; float* xo = (float*)d_out;
#define WSP(T, off) ((T*)(ws + (off)))
    for (int l = 0; l < 2; ++l) {
        convT(stream, ffn_up + (size_t)l * 2048 * 8192, 8192, 0, 8192, 2048, WSP(bf16_t, l ? W_UP1 : W_UP0));
        convT(stream, ffn_down + (size_t)l * 4096 * 2048, 2048, 0, 2048, 4096, WSP(bf16_t, l ? W_DN1 : W_DN0));
    }
    (void)hipMemsetAsync(ws + W_ABIN + (size_t)5200 * 2048 * 2, 0, (size_t)176 * 2048 * 2, stream);
    convT(stream, ab_w_in, 5200, 0, 4096, 2048, WSP(bf16_t, W_ABIN));
    convT(stream, ab_w_in, 5200, 4176, 1024, 2048, WSP(bf16_t, W_ABIN) + (size_t)4096 * 2048);
    convT(stream, ab_w_in, 5200, 4096, 64, 2048, WSP(bf16_t, W_ABIN) + (size_t)5120 * 2048);
    convT(stream, ab_w_in, 5200, 4160, 16, 2048, WSP(bf16_t, W_ABIN) + (size_t)5184 * 2048);
    convT(stream, ab_w_out, 2048, 0, 2048, 2048, WSP(bf16_t, W_ABOUT));
    (void)hipMemsetAsync(ws + W_CDIN + (size_t)832 * 2048 * 2, 0, (size_t)192 * 2048 * 2, stream);
    convT(stream, cd_w_in, 2880, 0, 832, 2048, WSP(bf16_t, W_CDIN));
    convT(stream, cd_w_in, 2880, 832, 2048, 2048, WSP(bf16_t, W_CDIN) + (size_t)1024 * 2048);
    convT(stream, cd_w_out, 2048, 0, 2048, 2048, WSP(bf16_t, W_CDOUT));
    convT(stream, w_q_up, 1536, 0, 1536, 512, WSP(bf16_t, W_QUP));
    convT(stream, w_kv_up, 2048, 0, 2048, 256, WSP(bf16_t, W_KVUP));

    bf16_t* H = WSP(bf16_t, R_H);
    hipLaunchKernelGGL(k_rmsnorm<2048>, dim3(NTOK / 4), dim3(256), 0, stream, x, mix_pre_g, H);
    { FAbIn f{}; f.Q = WSP(bf16_t, R_Q0); f.K = WSP(bf16_t, R_K0); f.V = WSP(bf16_t, R_V0); f.QI = WSP(float, R_QI); f.U = WSP(float, R_U); f.KI16 = WSP(unsigned short, R_KI); f.WI = WSP(float, R_WI);
      launch_gemm(stream, H, 2048, WSP(bf16_t, W_ABIN), 2048, NTOK, 5376, 2048, f); }
    { static bool attr = false;
      if (!attr) { (void)hipFuncSetAttribute((const void*)k_indexer, hipFuncAttributeMaxDynamicSharedMemorySize, IDX_LDS); attr = true; }
      IdxArgs a{}; a.QI = WSP(float, R_QI); a.KI16 = WSP(unsigned short, R_KI); a.WI = WSP(float, R_WI); a.MT = WSP(unsigned long long, R_MASK);
      hipLaunchKernelGGL(k_indexer, dim3(256), dim3(512), IDX_LDS, stream, a); }
    hipLaunchKernelGGL(k_transpose_v, dim3(2048), dim3(256), 0, stream, WSP(bf16_t, R_V0), WSP(bf16_t, R_VT0));
    { AttnArgs a{}; a.Q = WSP(bf16_t, R_Q0); a.K = WSP(bf16_t, R_K0); a.VT = WSP(bf16_t, R_VT0); a.MT = WSP(unsigned long long, R_MASK); a.O = WSP(bf16_t, R_CC0); a.ldq = 1024; a.ldk = 1024; a.ldo = 2048;
      a.sc_log2e = 0.08838834764831845f * 1.4426950408889634f; launch_attn<128, true>(stream, a); }
    hipLaunchKernelGGL(k_pool, dim3(NTOK / 16, 4), dim3(256), 0, stream, WSP(float, R_U), pool_w, pool_b, pool_scale, WSP(bf16_t, R_CC0));
    { FStoreBf16 f{}; f.O = WSP(bf16_t, R_M0); f.ldc = 2048; launch_gemm(stream, WSP(bf16_t, R_CC0), 2048, WSP(bf16_t, W_ABOUT), 2048, NTOK, 2048, 2048, f); }
    hipLaunchKernelGGL(k_resnorm, dim3(NTOK / 4), dim3(256), 0, stream, x, WSP(bf16_t, R_M0), mix_post_g, ffn_pre_g, xo, H);
    for (int layer = 0; layer < 2; ++layer) {
        if (layer == 1) {
            { FCdIn f{}; f.CQ = WSP(float, R_CQ); f.CKV = WSP(float, R_CKV); f.KR = WSP(float, R_KR); f.XL = WSP(bf16_t, R_XL); f.YG = WSP(bf16_t, R_YG);
              launch_gemm(stream, H, 2048, WSP(bf16_t, W_CDIN), 2048, NTOK, 3072, 2048, f); }
            hipLaunchKernelGGL(k_lru_conv, dim3(NTOK * 1024 / 256), dim3(256), 0, stream, WSP(bf16_t, R_XL), lru_conv_w, lru_conv_b, WSP(float, R_XC));
            hipLaunchKernelGGL(k_lru_gates, dim3(NTOK / 16, 8), dim3(128), 0, stream, WSP(float, R_XC), lru_wa, lru_ba, lru_wx, lru_bx, lru_lambda, WSP(float, R_LA), WSP(float, R_LB));
            hipLaunchKernelGGL(k_lru_scan1, dim3(2 * 256 * 1024 / 256), dim3(256), 0, stream, WSP(float, R_LA), WSP(float, R_LB), WSP(float, R_CA), WSP(float, R_CH));
            hipLaunchKernelGGL(k_lru_scan2, dim3(2048 / 256), dim3(256), 0, stream, WSP(float, R_CA), WSP(float, R_CH), WSP(float, R_CIN));
            hipLaunchKernelGGL(k_lru_scan3, dim3(2 * 256 * 1024 / 256), dim3(256), 0, stream, WSP(float, R_LA), WSP(float, R_LB), WSP(float, R_CIN), WSP(bf16_t, R_YG), WSP(bf16_t, R_CC1));
            hipLaunchKernelGGL(k_rmsnorm<512>, dim3(NTOK / 4), dim3(256), 0, stream, WSP(float, R_CQ), q_norm_g, WSP(bf16_t, R_CQN));
            hipLaunchKernelGGL(k_rmsnorm<256>, dim3(NTOK / 4), dim3(256), 0, stream, WSP(float, R_CKV), kv_norm_g, WSP(bf16_t, R_CKVN));
            { FStoreBf16 f{}; f.O = WSP(bf16_t, R_Q1); f.ldc = 1536; launch_gemm(stream, WSP(bf16_t, R_CQN), 512, WSP(bf16_t, W_QUP), 512, NTOK, 1536, 512, f); }
            { FKvUp f{}; f.K1 = WSP(bf16_t, R_K1); f.V1 = WSP(bf16_t, R_V1); launch_gemm(stream, WSP(bf16_t, R_CKVN), 256, WSP(bf16_t, W_KVUP), 256, NTOK, 2048, 256, f); }
            hipLaunchKernelGGL(k_rope_q, dim3(NTOK * 8 * 32 / 256), dim3(256), 0, stream, WSP(bf16_t, R_Q1), positions);
            hipLaunchKernelGGL(k_rope_k, dim3(NTOK * 32 / 256), dim3(256), 0, stream, WSP(float, R_KR), positions, WSP(bf16_t, R_K1));
            hipLaunchKernelGGL(k_transpose_v, dim3(2048), dim3(256), 0, stream, WSP(bf16_t, R_V1), WSP(bf16_t, R_VT1));
            { AttnArgs a{}; a.Q = WSP(bf16_t, R_Q1); a.K = WSP(bf16_t, R_K1); a.VT = WSP(bf16_t, R_VT1); a.MT = nullptr; a.O = WSP(bf16_t, R_CC1); a.ldq = 1536; a.ldk = 1536; a.ldo = 2048;
              a.sc_log2e = 0.07216878364870322f * 1.4426950408889634f; launch_attn<192, false>(stream, a); }
            { FStoreBf16 f{}; f.O = WSP(bf16_t, R_M1); f.ldc = 2048; launch_gemm(stream, WSP(bf16_t, R_CC1), 2048, WSP(bf16_t, W_CDOUT), 2048, NTOK, 2048, 2048, f); }
            hipLaunchKernelGGL(k_resnorm, dim3(NTOK / 4), dim3(256), 0, stream, xo, WSP(bf16_t, R_M1), mix_post_g + 2048, ffn_pre_g + 2048, xo, H);
        }
        for (int half = 0; half < 2; ++half) {
            { FStoreBf16 f{}; f.O = WSP(bf16_t, R_HID); f.ldc = 8192; launch_gemm(stream, H + (size_t)half * SEQ * 2048, 2048, WSP(bf16_t, layer ? W_UP1 : W_UP0), 2048, SEQ, 8192, 2048, f); }
            hipLaunchKernelGGL(k_ffn_gate, dim3(SEQ * 512 / 256), dim3(256), 0, stream, WSP(bf16_t, R_HID), ffn_conv_w + (size_t)layer * 3 * 8192, ffn_conv_b + (size_t)layer * 8192, WSP(bf16_t, R_ACT));
            { FStoreBf16 f{}; f.O = WSP(bf16_t, R_F) + (size_t)half * SEQ * 2048; f.ldc = 2048; launch_gemm(stream, WSP(bf16_t, R_ACT), 4096, WSP(bf16_t, layer ? W_DN1 : W_DN0), 4096, SEQ, 2048, 4096, f); }
        }
        hipLaunchKernelGGL(k_resnorm, dim3(NTOK / 4), dim3(256), 0, stream, xo, WSP(bf16_t, R_F), ffn_post_g + (size_t)layer * 2048, layer == 0 ? mix_pre_g + 2048 : (const float*)nullptr, xo, H);
    }
#undef WSP
}
```

```cpp
#include <hip/hip_runtime.h>
#include <stdint.h>
#include <stdio.h>

#define LAS __attribute__((address_space(3)))
typedef unsigned short bf16_t;
typedef float f32x4 __attribute__((ext_vector_type(4)));
typedef unsigned u32x4 __attribute__((ext_vector_type(4)));
typedef unsigned u32x2 __attribute__((ext_vector_type(2)));

static constexpr int NTOK = 32768, SEQ = 16384, NBATCH = 2, DM = 2048, DFF = 4096;
static constexpr float NORM_EPS = 1e-6f;

__device__ __forceinline__ bf16_t f2bf(float f) { unsigned u = __float_as_uint(f); u += 0x7FFFu + ((u >> 16) & 1u); return (bf16_t)(u >> 16); }
__device__ __forceinline__ float bf2f(bf16_t b) { return __uint_as_float(((unsigned)b) << 16); }
__device__ __forceinline__ unsigned pack2bf(float lo, float hi) { return (unsigned)f2bf(lo) | ((unsigned)f2bf(hi) << 16); }
__device__ __forceinline__ float gelu_tanh(float x) { const float u = 0.7978845608028654f * (x + 0.044715f * x * x * x); return 0.5f * x * (1.0f + tanhf(u)); }
__device__ __forceinline__ float wave_sum(float v) {
#pragma unroll
    for (int o = 32; o >= 1; o >>= 1) v += __shfl_xor(v, o);
    return v;
}

__device__ __forceinline__ int opaque_tid() { int t = (int)threadIdx.x; asm volatile("" : "+v"(t)); return t; }

__device__ __forceinline__ int opaque_s(int v) { asm volatile("" : "+s"(v)); return v; }

#include <hip/hip_runtime.h>
namespace pg8 {
#define PG8_LAS __attribute__((address_space(3)))
typedef unsigned short bf16_t;
typedef short bf16x8 __attribute__((ext_vector_type(8)));
typedef float f32x4 __attribute__((ext_vector_type(4)));
typedef unsigned u32x4 __attribute__((ext_vector_type(4)));
constexpr int BM = 256, BK = 64, HALF = 128, HTB = HALF * BK * 2  , STAGE_BYTES = 8 * HTB, NXCD = 8, WGM = 8;

__host__ __device__ __forceinline__ int lds_byte(int r, int c) { const int st = (r >> 4) * 2 + (c >> 5), rr = r & 15, cc = c & 31, ob = rr * 64 + cc * 2; return st * 1024 + (ob ^ (((ob >> 9) & 1) << 5)); }
__host__ __device__ __forceinline__ void stage_rc(int b, int& R, int& C) { const int st = b / 1024, sb = b % 1024, swz = sb ^ (((sb >> 9) & 1) << 5); R = (st >> 1) * 16 + swz / 64; C = (st & 1) * 32 + (swz % 64) / 2; }
__host__ __device__ __forceinline__ int perm32(int rho) { const int n = rho >> 4, i = rho & 15; return 8 * (i >> 2) + 4 * n + (i & 3); }

struct Unit { int pm, pn; };
struct Gemm { const bf16_t* A; const bf16_t* Bt; int M, N, K, lda, ldb, pad_; };

struct StaticOrder {
    int nM, nN, nwg, G, c;
    __host__ __device__ void init(int M, int N, int G_, int c_) { nM = M / BM; nN = N / BM; nwg = nM * nN; G = G_; c = c_; }
    __host__ __device__ bool next(int i, Unit& u) const {
        const long L = (long)i * G + c; if (L >= nwg) return false;
        int wgid = (int)L; { const int q = nwg / NXCD, r = nwg % NXCD, xcd = wgid % NXCD, off = wgid / NXCD; wgid = (xcd < r ? xcd * (q + 1) : r * (q + 1) + (xcd - r) * q) + off; }
        const int nig = WGM * nN, gid = wgid / nig, fm = gid * WGM, gsz = (nM - fm) < WGM ? (nM - fm) : WGM;
        u.pm = fm + ((wgid % nig) % gsz); u.pn = (wgid % nig) / gsz; return true;
    }
    __device__ __forceinline__ void a_ready(const Unit&) const {}
    __device__ __forceinline__ void done(const Unit&) const {}
};

template <class Epi, class Sched, bool STAMP = false>
__device__ __forceinline__ void gemm_phase(PG8_LAS unsigned char* lds, const Gemm g, const Sched& S, const Epi& E, unsigned long long* stamps) {
    const int tid = opaque_tid(), wid = __builtin_amdgcn_readfirstlane(tid >> 6), lane = tid & 63, wr = wid >> 2, wc = wid & 3, fr = lane & 15, fq = lane >> 4;
    const int K = g.K, nt = K / BK;
    int ts_lo = 0, ts_hi = 0, nts = 0; const unsigned long long rt_entry = STAMP ? (unsigned long long)wall_clock64() : 0ull;
#define PG8_STAMP() do { if (STAMP && wid == 0 && nts < 64) { const unsigned long long _c = (unsigned long long)clock64(); \
        ts_lo = (lane == nts) ? (int)(unsigned)_c : ts_lo; ts_hi = (lane == nts) ? (int)(unsigned)(_c >> 32) : ts_hi; ++nts; } } while (0)
    PG8_STAMP();
    unsigned voffA[2], voffB[2];
#pragma unroll
    for (int i = 0; i < 2; ++i) { int R, C; stage_rc(tid * 16 + i * 8192, R, C); const int Rb = Epi::PERM ? ((R & ~31) + perm32(R & 31)) : R;
        voffA[i] = (unsigned)(R * g.lda + C) * 2u; voffB[i] = (unsigned)(Rb * g.ldb + C) * 2u; }
    const size_t kstep = (size_t)(BK * 2);
    const size_t hstepA = (size_t)HALF * g.lda * 2, hstepB = (size_t)HALF * g.ldb * 2;
    const size_t tstepA = 2 * hstepA, tstepB = 2 * hstepB;
    const unsigned ldsw = (unsigned)wid * 1024u;
    const int aoff = lds_byte(wr * 64 + fr, fq * 8), boff = lds_byte(wc * 32 + fr, fq * 8);
#define PG8_SA(b, h) (((b) * 2 + (h)) * HTB)
#define PG8_SB(b, h) ((4 + (b) * 2 + (h)) * HTB)
#define PG8_STAGE(bufoff, gbase, voff) do { _Pragma("unroll") for (int _i = 0; _i < 2; ++_i) \
        __builtin_amdgcn_global_load_lds((const unsigned*)((const char*)(gbase) + (voff)[_i]), (PG8_LAS unsigned*)(lds + (bufoff) + ldsw + _i * 8192), 16, 0, 0); } while (0)
#define PG8_LDA(dst, b, h) do { _Pragma("unroll") for (int m = 0; m < 4; ++m) _Pragma("unroll") for (int k = 0; k < 2; ++k) dst[m][k] = *(const PG8_LAS bf16x8*)(lds + PG8_SA(b, h) + aoff + m * 2048 + k * 1024); } while (0)
#define PG8_LDB(dst, b, h) do { _Pragma("unroll") for (int n = 0; n < 2; ++n) _Pragma("unroll") for (int k = 0; k < 2; ++k) dst[n][k] = *(const PG8_LAS bf16x8*)(lds + PG8_SB(b, h) + boff + n * 2048 + k * 1024); } while (0)
#define PG8_MMA(ai, bj, At, Bt) do { __builtin_amdgcn_s_setprio(1); _Pragma("unroll") for (int m = 0; m < 4; ++m) _Pragma("unroll") for (int n = 0; n < 2; ++n) _Pragma("unroll") for (int k = 0; k < 2; ++k) \
        acc[ai][bj][m][n] = __builtin_amdgcn_mfma_f32_16x16x32_bf16(Bt[n][k], At[m][k], acc[ai][bj][m][n], 0, 0, 0); __builtin_amdgcn_s_setprio(0); } while (0)
#define PG8_WAIT_V(n) asm volatile("s_waitcnt vmcnt(" #n ")" ::: "memory")
#define PG8_WAIT_L(n) asm volatile("s_waitcnt lgkmcnt(" #n ")" ::: "memory")
#define PG8_BAR __builtin_amdgcn_s_barrier()
#define PG8_SCHED __builtin_amdgcn_sched_barrier(0)
    Unit cur, nxt; int ui = 0;
    if (!S.next(0, cur)) return;
    f32x4 acc[2][2][4][2];
#pragma unroll
    for (int a = 0; a < 2; ++a)
#pragma unroll
        for (int b = 0; b < 2; ++b)
#pragma unroll
            for (int m = 0; m < 4; ++m)
#pragma unroll
                for (int n = 0; n < 2; ++n) acc[a][b][m][n] = (f32x4){0.f, 0.f, 0.f, 0.f};
    bf16x8 At[4][2], B0[2][2], B1[2][2];
    const char* cA = (const char*)g.A + (size_t)cur.pm * tstepA; const char* cB = (const char*)g.Bt + (size_t)cur.pn * tstepB;
    S.a_ready(cur);
    PG8_STAGE(PG8_SB(0, 0), cB, voffB); PG8_STAGE(PG8_SA(0, 0), cA, voffA); PG8_STAGE(PG8_SB(0, 1), cB + hstepB, voffB); PG8_STAGE(PG8_SA(0, 1), cA + hstepA, voffA);
    if (wr == 1) PG8_BAR;
    PG8_WAIT_V(4); PG8_BAR;
    PG8_STAGE(PG8_SB(1, 0), cB + kstep, voffB); PG8_STAGE(PG8_SA(1, 0), cA + kstep, voffA); PG8_STAGE(PG8_SB(1, 1), cB + hstepB + kstep, voffB);
    PG8_WAIT_V(6); PG8_BAR;
    PG8_STAMP();
    for (;;) {
        const bool has_next = S.next(ui + 1, nxt);
        const char* nA = has_next ? (const char*)g.A + (size_t)nxt.pm * tstepA : cA; const char* nB = has_next ? (const char*)g.Bt + (size_t)nxt.pn * tstepB : cB;
        for (int t = 0; t < nt; t += 2) {
            const bool last = (t == nt - 2);
            const char* a1 = cA + (size_t)(t + 1) * kstep;
            const char* a2 = last ? nA : cA + (size_t)(t + 2) * kstep; const char* b2 = last ? nB : cB + (size_t)(t + 2) * kstep;
            const char* a3 = a2 + kstep; const char* b3 = b2 + kstep;
            if (last && has_next) S.a_ready(nxt);
            PG8_LDB(B0, 0, 0); PG8_SCHED; PG8_LDA(At, 0, 0); PG8_STAGE(PG8_SA(1, 1), a1 + hstepA, voffA);
            PG8_WAIT_L(8); PG8_BAR; PG8_WAIT_L(0); PG8_MMA(0, 0, At, B0); PG8_BAR; PG8_SCHED;
            PG8_LDB(B1, 0, 1); PG8_STAGE(PG8_SB(0, 0), b2, voffB);
            PG8_BAR; PG8_WAIT_L(0); PG8_MMA(0, 1, At, B1); PG8_BAR;
            PG8_LDA(At, 0, 1); PG8_STAGE(PG8_SA(0, 0), a2, voffA);
            PG8_BAR; PG8_WAIT_L(0); PG8_MMA(1, 0, At, B0); PG8_BAR; PG8_SCHED;
            PG8_STAGE(PG8_SB(0, 1), b2 + hstepB, voffB);
            PG8_WAIT_V(6); PG8_BAR; PG8_MMA(1, 1, At, B1); PG8_BAR;
            PG8_LDB(B0, 1, 0); PG8_SCHED; PG8_LDA(At, 1, 0); PG8_STAGE(PG8_SA(0, 1), a2 + hstepA, voffA);
            PG8_WAIT_L(8); PG8_BAR; PG8_WAIT_L(0); PG8_MMA(0, 0, At, B0); PG8_BAR; PG8_SCHED;
            PG8_LDB(B1, 1, 1); PG8_STAGE(PG8_SB(1, 0), b3, voffB);
            PG8_BAR; PG8_WAIT_L(0); PG8_MMA(0, 1, At, B1); PG8_BAR;
            PG8_LDA(At, 1, 1); PG8_STAGE(PG8_SA(1, 0), a3, voffA);
            PG8_BAR; PG8_WAIT_L(0); PG8_MMA(1, 0, At, B0); PG8_BAR; PG8_SCHED;
            PG8_STAGE(PG8_SB(1, 1), b3 + hstepB, voffB);
            PG8_WAIT_V(6); PG8_BAR; PG8_MMA(1, 1, At, B1); PG8_BAR;
        }
        PG8_STAMP();
        if constexpr (!Epi::AFTER_DRAIN) { E(acc, cur, wr, wc, fr, fq); S.done(cur); }
        PG8_STAMP();
        if (!has_next) break;
#pragma unroll
        for (int a = 0; a < 2; ++a)
#pragma unroll
            for (int b = 0; b < 2; ++b)
#pragma unroll
                for (int m = 0; m < 4; ++m)
#pragma unroll
                    for (int n = 0; n < 2; ++n) acc[a][b][m][n] = (f32x4){0.f, 0.f, 0.f, 0.f};
        cur = nxt; cA = nA; cB = nB; ++ui;
    }
    PG8_WAIT_V(0);
    if (wr == 0) PG8_BAR;
    PG8_BAR;
    if constexpr (Epi::AFTER_DRAIN) { E.fused(acc, cur, wr, wc, fr, fq, lds, wid, lane); S.done(cur); }
    PG8_STAMP();
    if (STAMP && wid == 0) { stamps[lane] = lane < nts ? (((unsigned long long)(unsigned)ts_hi << 32) | (unsigned)ts_lo) : 0ull;
        if (lane == 62) stamps[62] = rt_entry; if (lane == 63) stamps[63] = (unsigned long long)wall_clock64(); }
#undef PG8_STAMP
#undef PG8_SA
#undef PG8_SB
#undef PG8_STAGE
#undef PG8_LDA
#undef PG8_LDB
#undef PG8_MMA
#undef PG8_WAIT_V
#undef PG8_WAIT_L
#undef PG8_BAR
#undef PG8_SCHED
}
}

#include <cstdio>
#include <ctime>
#include <cstdlib>
#include <cstring>
#include <cmath>
#include <vector>

template <class F> struct EpiG {
    static constexpr bool PERM = false, AFTER_DRAIN = false;
    F f;
    __device__ __forceinline__ void operator()(const f32x4 (&acc)[2][2][4][2], const pg8::Unit& u, int wr, int wc, int fr, int fq) const {
        const int row0 = u.pm * 256 + wr * 64 + fr, col0 = u.pn * 256 + wc * 32 + 4 * fq;
#pragma unroll
        for (int ai = 0; ai < 2; ++ai)
#pragma unroll
            for (int m = 0; m < 4; ++m)
#pragma unroll
                for (int bj = 0; bj < 2; ++bj)
#pragma unroll
                    for (int n = 0; n < 2; ++n) f(row0 + ai * 128 + m * 16, col0 + bj * 128 + n * 16, acc[ai][bj][m][n]);
    }
};
__device__ __forceinline__ void st_bf16x4(bf16_t* p, f32x4 v) { u32x2 w; w.x = pack2bf(v[0], v[1]); w.y = pack2bf(v[2], v[3]); *(u32x2*)p = w; }
__device__ __forceinline__ void st_f32x4(float* p, f32x4 v) { *(f32x4*)p = v; }

struct FStoreBf16 { bf16_t* O; int ldc; int pad_; __device__ __forceinline__ void operator()(int r, int c, f32x4 v) const { st_bf16x4(O + (size_t)r * ldc + c, v); } };
struct FAbIn { bf16_t *Q, *K, *V; float *QI, *U, *WI; unsigned short* KI16;
    __device__ __forceinline__ void operator()(int r, int c, f32x4 v) const {
        if (c < 1024) st_bf16x4(Q + (size_t)r * 1024 + c, v);
        else if (c < 2048) st_bf16x4(K + (size_t)r * 1024 + (c - 1024), v);
        else if (c < 3072) st_bf16x4(V + (size_t)r * 1024 + (c - 2048), v);
        else if (c < 4096) st_f32x4(QI + (size_t)r * 1024 + (c - 3072), v);
        else if (c < 5120) st_f32x4(U + (size_t)r * 1024 + (c - 4096), v);
        else if (c < 5184) { typedef _Float16 h2 __attribute__((ext_vector_type(2))); union { h2 h; unsigned u; } a, b; a.h = (h2){(_Float16)v[0], (_Float16)v[1]}; b.h = (h2){(_Float16)v[2], (_Float16)v[3]};
            u32x2 w; w.x = a.u; w.y = b.u; *(u32x2*)(KI16 + (size_t)r * 64 + (c - 5120)) = w; }
        else if (c < 5200) st_f32x4(WI + (size_t)r * 16 + (c - 5184), v);
    } };
struct FCdIn { float *CQ, *CKV, *KR; bf16_t *XL, *YG;
    __device__ __forceinline__ void operator()(int r, int c, f32x4 v) const {
        if (c < 512) st_f32x4(CQ + (size_t)r * 512 + c, v);
        else if (c < 768) st_f32x4(CKV + (size_t)r * 256 + (c - 512), v);
        else if (c < 832) st_f32x4(KR + (size_t)r * 64 + (c - 768), v);
        else if (c < 1024) {}
        else if (c < 2048) st_bf16x4(XL + (size_t)r * 1024 + (c - 1024), v);
        else st_bf16x4(YG + (size_t)r * 1024 + (c - 2048), v);
    } };
struct FKvUp { bf16_t *K1, *V1;
    __device__ __forceinline__ void operator()(int r, int c, f32x4 v) const {
        const int h = c >> 8, d = c & 255;
        if (d < 128) st_bf16x4(K1 + (size_t)r * 1536 + h * 192 + d, v);
        else st_bf16x4(V1 + (size_t)r * 1024 + h * 128 + (d - 128), v);
    } };

__device__ __forceinline__ unsigned ord_key(float f) { const unsigned b = __float_as_uint(f); return (b & 0x80000000u) ? ~b : (b | 0x80000000u); }
__device__ __forceinline__ void rope_cs(int pos, int i, float& c, float& s) { const float freq = powf(10000.0f, -(float)i / 32.0f); const float ang = (float)pos * freq; sincosf(ang, &s, &c); }

typedef short bf16x8 __attribute__((ext_vector_type(8)));
typedef float f32x16 __attribute__((ext_vector_type(16)));
__device__ __forceinline__ unsigned cvtpk(float lo, float hi) { unsigned r; asm volatile("v_cvt_pk_bf16_f32 %0, %1, %2" : "=v"(r) : "v"(lo), "v"(hi)); return r; }

__device__ __forceinline__ void transpose_v_tile(LAS unsigned short* tile  , const bf16_t* __restrict__ V, bf16_t* __restrict__ VT, int tileid, int tid) {
    const int tt = tileid >> 4, ct = tileid & 15;
    const int row0 = tt * 64, c0 = ct * 64;
#pragma unroll
    for (int i = 0; i < 2; ++i) { const int r = (tid >> 3) + 32 * i, c = (tid & 7) * 8;
        const u32x4 w = *(const u32x4*)(V + (size_t)(row0 + r) * 1024 + c0 + c);
        LAS unsigned* dst = (LAS unsigned*)(tile + r * 66 + c);
        dst[0] = w.x; dst[1] = w.y; dst[2] = w.z; dst[3] = w.w; }
    __syncthreads();
    { const int d = tid >> 2, part = tid & 3;
      const int b = row0 / SEQ, t0 = row0 % SEQ, col = c0 + d, h = col >> 7, dd = col & 127;
      unsigned short v[16];
#pragma unroll
      for (int p = 0; p < 16; ++p) { const int a = p >> 2, i = p & 3, ka = (a == 1) ? 2 : ((a == 2) ? 1 : a); v[p] = tile[(part * 16 + ka * 4 + i) * 66 + d]; }
      u32x4 w0, w1;
      w0.x = v[0] | ((unsigned)v[1] << 16); w0.y = v[2] | ((unsigned)v[3] << 16); w0.z = v[4] | ((unsigned)v[5] << 16); w0.w = v[6] | ((unsigned)v[7] << 16);
      w1.x = v[8] | ((unsigned)v[9] << 16); w1.y = v[10] | ((unsigned)v[11] << 16); w1.z = v[12] | ((unsigned)v[13] << 16); w1.w = v[14] | ((unsigned)v[15] << 16);
      bf16_t* dst = VT + ((size_t)(b * 8 + h) * 128 + dd) * SEQ + t0 + part * 16;
      *(u32x4*)dst = w0; *(u32x4*)(dst + 8) = w1; }
    __syncthreads();
}
struct AttnArgs { const bf16_t* Q; const bf16_t* K; const bf16_t* VT; const unsigned long long* MT; bf16_t* O; int ldq, ldk, ldo; float sc_log2e; };

template <int DQK, bool MASKED>
__device__ __forceinline__ void attn_item(LAS unsigned char* lds, const AttnArgs& a, int b, int h, int qb) {
    constexpr int NKS = DQK / 16, PK = DQK * 2, PV = 128, KB_BYTES = 64 * PK, VB_BYTES = 128 * PV, STAGE = KB_BYTES + VB_BYTES, NPK = DQK / 8, NKP = (64 * NPK) / 512;
    const int tid = opaque_tid(), lane = tid & 63, w = __builtin_amdgcn_readfirstlane(tid >> 6), n = lane & 31, hf = lane >> 5;
    const int nt = 4 * qb + 4, cw = 4 * qb + (w >> 1);
    const int trow = qb * 256 + w * 32 + n;
    const size_t grow = (size_t)b * SEQ + trow;
    bf16x8 qf[NKS];
    { const bf16_t* qp = a.Q + grow * a.ldq + h * DQK + hf * 8;
#pragma unroll
      for (int ks = 0; ks < NKS; ++ks) qf[ks] = *(const bf16x8*)(qp + ks * 16); }
    f32x16 o[4];
#pragma unroll
    for (int dt = 0; dt < 4; ++dt)
#pragma unroll
        for (int r = 0; r < 16; ++r) o[dt][r] = 0.f;
    float m_run = -INFINITY, l_run = 0.f;
    const float c = a.sc_log2e;
    const bf16_t* Kg = a.K + (size_t)b * SEQ * a.ldk + h * DQK;
    const bf16_t* Vg = a.VT + (size_t)(b * 8 + h) * 128 * SEQ;
    const unsigned long long* Mg = MASKED ? a.MT + (size_t)b * 256 * SEQ + trow : nullptr;
    auto dma = [&](int kt, int buf) {
        LAS unsigned char* kb = lds + buf * STAGE; LAS unsigned char* vb = kb + KB_BYTES;
#pragma unroll
        for (int i = 0; i < NKP; ++i) { const int s = (w + 8 * i) * 64 + lane, r = s / NPK, cp = s % NPK, cc = cp ^ (NPK == 16 ? (r & 15) : ((r >> 1) & 7));
            __builtin_amdgcn_global_load_lds((const unsigned*)(Kg + (size_t)(kt * 64 + r) * a.ldk + cc * 8), (LAS unsigned*)(kb + (w + 8 * i) * 1024), 16, 0, 0); }
#pragma unroll
        for (int i = 0; i < 2; ++i) { const int s = (w + 8 * i) * 64 + lane, d = s >> 3, cp = s & 7, cc = cp ^ ((d >> 1) & 7);
            __builtin_amdgcn_global_load_lds((const unsigned*)(Vg + (size_t)d * SEQ + kt * 64 + cc * 8), (LAS unsigned*)(vb + (w + 8 * i) * 1024), 16, 0, 0); }
    };
    dma(0, 0);
    asm volatile("s_waitcnt vmcnt(0)" ::: "memory");
    __syncthreads();
    for (int kt = 0; kt < nt; ++kt) {
        const bool more = (kt + 1 < nt);
        if (more) dma(kt + 1, (kt + 1) & 1);
        if (kt <= cw) {
            unsigned mlo = 0xFFFFFFFFu, mhi = 0xFFFFFFFFu;
            if (MASKED) { const unsigned long long mw = Mg[(size_t)kt * SEQ]; mlo = (unsigned)mw >> (hf * 4); mhi = (unsigned)(mw >> 32) >> (hf * 4); }
            LAS unsigned char* kb = lds + (kt & 1) * STAGE; LAS unsigned char* vb = kb + KB_BYTES;
            f32x16 s0, s1;
#pragma unroll
            for (int r = 0; r < 16; ++r) { s0[r] = 0.f; s1[r] = 0.f; }
            const int kswz = (NPK == 16) ? (n & 15) : ((n >> 1) & 7);
            const LAS unsigned char* ka = kb + n * PK;
#pragma unroll
            for (int ks = 0; ks < NKS; ++ks) {
                const int po = ((2 * ks + hf) ^ kswz) * 16;
                const bf16x8 a0 = *(const LAS bf16x8*)(ka + po), a1 = *(const LAS bf16x8*)(ka + 32 * PK + po);
                s0 = __builtin_amdgcn_mfma_f32_32x32x16_bf16(a0, qf[ks], s0, 0, 0, 0);
                s1 = __builtin_amdgcn_mfma_f32_32x32x16_bf16(a1, qf[ks], s1, 0, 0, 0);
            }
            if (MASKED) {
#pragma unroll
                for (int r = 0; r < 16; ++r) { const unsigned bit = 1u << ((r >> 2) * 8 + (r & 3));
                    s0[r] = (mlo & bit) ? s0[r] : -INFINITY; s1[r] = (mhi & bit) ? s1[r] : -INFINITY; }
            }
            float mx = fmaxf(s0[0], s1[0]);
#pragma unroll
            for (int r = 1; r < 16; ++r) mx = fmaxf(mx, fmaxf(s0[r], s1[r]));
            mx = fmaxf(mx, __shfl_xor(mx, 32));
            const float m_new = fmaxf(m_run, mx);
            const float m_use = (MASKED && m_new == -INFINITY) ? 0.f : m_new;
            if (__any(m_new > m_run)) {
                const float al = __builtin_amdgcn_exp2f((m_run - m_use) * c);
                l_run *= al;
#pragma unroll
                for (int dt = 0; dt < 4; ++dt)
#pragma unroll
                    for (int r = 0; r < 16; ++r) o[dt][r] *= al;
            }
            m_run = m_new;
            const float mc = m_use * c;
            float ps = 0.f;
#pragma unroll
            for (int r = 0; r < 16; ++r) { s0[r] = __builtin_amdgcn_exp2f(fmaf(s0[r], c, -mc)); s1[r] = __builtin_amdgcn_exp2f(fmaf(s1[r], c, -mc)); ps += s0[r] + s1[r]; }
            l_run += ps;
            bf16x8 pf[4];
            { u32x4 t;
              t.x = cvtpk(s0[0], s0[1]); t.y = cvtpk(s0[2], s0[3]); t.z = cvtpk(s0[4], s0[5]); t.w = cvtpk(s0[6], s0[7]); pf[0] = *(bf16x8*)&t;
              t.x = cvtpk(s0[8], s0[9]); t.y = cvtpk(s0[10], s0[11]); t.z = cvtpk(s0[12], s0[13]); t.w = cvtpk(s0[14], s0[15]); pf[1] = *(bf16x8*)&t;
              t.x = cvtpk(s1[0], s1[1]); t.y = cvtpk(s1[2], s1[3]); t.z = cvtpk(s1[4], s1[5]); t.w = cvtpk(s1[6], s1[7]); pf[2] = *(bf16x8*)&t;
              t.x = cvtpk(s1[8], s1[9]); t.y = cvtpk(s1[10], s1[11]); t.z = cvtpk(s1[12], s1[13]); t.w = cvtpk(s1[14], s1[15]); pf[3] = *(bf16x8*)&t; }
            const int vswz = (n >> 1) & 7;
            const LAS unsigned char* va = vb + n * PV;
#pragma unroll
            for (int g = 0; g < 4; ++g) { const int po = ((2 * g + hf) ^ vswz) * 16;
#pragma unroll
                for (int dt = 0; dt < 4; ++dt) { const bf16x8 vf = *(const LAS bf16x8*)(va + dt * 32 * PV + po); o[dt] = __builtin_amdgcn_mfma_f32_32x32x16_bf16(vf, pf[g], o[dt], 0, 0, 0); } }
        }
        asm volatile("s_waitcnt vmcnt(0)" ::: "memory");
        __syncthreads();
    }
    const float lt = l_run + __shfl_xor(l_run, 32);
    const float inv = 1.0f / lt;
    bf16_t* op = a.O + grow * a.ldo + h * 128 + hf * 4;
#pragma unroll
    for (int dt = 0; dt < 4; ++dt)
#pragma unroll
        for (int r4 = 0; r4 < 4; ++r4) { u32x2 wv; wv.x = cvtpk(o[dt][4 * r4] * inv, o[dt][4 * r4 + 1] * inv); wv.y = cvtpk(o[dt][4 * r4 + 2] * inv, o[dt][4 * r4 + 3] * inv);
            *(u32x2*)(op + dt * 32 + r4 * 8) = wv; }
}
template <int DQK, bool MASKED>
__device__ __forceinline__ void attn_phase(LAS unsigned char* lds, const AttnArgs& a, int bid, int nblk) {
    for (int p = bid; p < 512; p += nblk) {
        const int bh = (p & 7) + 8 * (p >> 8), j = (p >> 3) & 31;
        attn_item<DQK, MASKED>(lds, a, bh >> 3, bh & 7, 63 - j);
        attn_item<DQK, MASKED>(lds, a, bh >> 3, bh & 7, j);
    }
}

typedef _Float16 f16x8 __attribute__((ext_vector_type(8)));
struct IdxArgs { const float* QI; const unsigned short* KI16; const float* WI; unsigned long long* MT; };
static constexpr int IDX_CS = 0, IDX_CI = 65536, IDX_KT = 98304, IDX_BM = 131072, IDX_CNT = 147456, IDX_TAU = 147584, IDX_LDS = 147712, IDX_CAP = 512;

__device__ __forceinline__ float ord_inv(unsigned T) { return __uint_as_float((T & 0x80000000u) ? (T & 0x7FFFFFFFu) : ~T); }
__device__ __forceinline__ unsigned lane_prefix(unsigned long long m) { return __builtin_amdgcn_mbcnt_hi((unsigned)(m >> 32), __builtin_amdgcn_mbcnt_lo((unsigned)m, 0u)); }

__device__ __forceinline__ void idx_compact(LAS unsigned char* lds, int qq, int lane) {
    LAS float* cs = (LAS float*)(lds + IDX_CS) + qq * IDX_CAP; LAS unsigned short* ci = (LAS unsigned short*)(lds + IDX_CI) + qq * IDX_CAP;
    LAS unsigned* cnt = (LAS unsigned*)(lds + IDX_CNT); LAS float* tau = (LAS float*)(lds + IDX_TAU);
    const int n = (int)cnt[qq];
    float sv[8]; unsigned short iv[8]; unsigned uk[8];
#pragma unroll
    for (int j = 0; j < 8; ++j) { const int idx = lane + 64 * j; const bool valid = idx < n; sv[j] = cs[idx]; iv[j] = ci[idx]; uk[j] = valid ? ord_key(sv[j]) : 0u; }
    unsigned T = 0u;
    for (int bit = 31; bit >= 0; --bit) {
        const unsigned Tc = T | (1u << bit); int c = 0;
#pragma unroll
        for (int j = 0; j < 8; ++j) c += __builtin_popcountll(__ballot(uk[j] >= Tc));
        if (c >= 256) T = Tc;
    }
    int ngt = 0;
#pragma unroll
    for (int j = 0; j < 8; ++j) ngt += __builtin_popcountll(__ballot(uk[j] > T));
    const int need = 256 - ngt;
    int base = 0, tiebase = 0;
#pragma unroll
    for (int j = 0; j < 8; ++j) {
        const bool gt = uk[j] > T, eq = uk[j] == T;
        const unsigned long long em = __ballot(eq);
        const bool keep = gt || (eq && (tiebase + (int)lane_prefix(em)) < need);
        tiebase += __builtin_popcountll(em);
        const unsigned long long km = __ballot(keep);
        const int pos = base + (int)lane_prefix(km);
        if (keep) { cs[pos] = sv[j]; ci[pos] = iv[j]; }
        base += __builtin_popcountll(km);
    }
    if (lane == 0) { cnt[qq] = 256u; tau[qq] = ord_inv(T); }
}

__device__ __forceinline__ void idx_item(LAS unsigned char* lds, const IdxArgs& a, int b, int hc) {
    const int tid = opaque_tid(), lane = tid & 63, w = __builtin_amdgcn_readfirstlane(tid >> 6), n = lane & 31, hf = lane >> 5;
    const int t0 = hc * 32, L = (t0 / 64 + 1) * 64, nsub = L / 32, ntile = (L + 127) / 128;
    const size_t q0 = (size_t)b * SEQ + t0 + 4 * w;
    LAS float* cs = (LAS float*)(lds + IDX_CS); LAS unsigned short* ci = (LAS unsigned short*)(lds + IDX_CI);
    LAS unsigned* cnt = (LAS unsigned*)(lds + IDX_CNT); LAS float* tau = (LAS float*)(lds + IDX_TAU);
    f16x8 qf[2][4];
#pragma unroll
    for (int rt = 0; rt < 2; ++rt) { const float* qp = a.QI + (q0 + 2 * rt + (n >> 4)) * 1024 + (n & 15) * 64 + hf * 8;
#pragma unroll
        for (int ks = 0; ks < 4; ++ks) { const f32x4 x0 = *(const f32x4*)(qp + ks * 16), x1 = *(const f32x4*)(qp + ks * 16 + 4);
            f16x8 v; v[0] = (_Float16)x0[0]; v[1] = (_Float16)x0[1]; v[2] = (_Float16)x0[2]; v[3] = (_Float16)x0[3]; v[4] = (_Float16)x1[0]; v[5] = (_Float16)x1[1]; v[6] = (_Float16)x1[2]; v[7] = (_Float16)x1[3];
            qf[rt][ks] = v; } }
    float wv[2][16];
#pragma unroll
    for (int rt = 0; rt < 2; ++rt)
#pragma unroll
        for (int r = 0; r < 16; ++r) wv[rt][r] = a.WI[(q0 + 2 * rt + (r >> 3)) * 16 + (((r & 3) + 8 * (r >> 2) + 4 * hf) & 15)] * (0.125f * 0.25f);
    if (tid < 32) { cnt[tid] = 0u; tau[tid] = -INFINITY; }
    float tau_reg[2] = {-INFINITY, -INFINITY};
    const unsigned short* Kg = a.KI16 + (size_t)b * SEQ * 64;
    auto dma = [&](int kt, int buf) {
        LAS unsigned char* kb = lds + IDX_KT + buf * 16384;
#pragma unroll
        for (int i = 0; i < 2; ++i) { const int s = (w + 8 * i) * 64 + lane, r = s >> 3, cp = s & 7, cc = cp ^ ((r >> 1) & 7);
            __builtin_amdgcn_global_load_lds((const unsigned*)(Kg + (size_t)(kt * 128 + r) * 64 + cc * 8), (LAS unsigned*)(kb + (w + 8 * i) * 1024), 16, 0, 0); }
    };
    dma(0, 0);
    asm volatile("s_waitcnt vmcnt(0)" ::: "memory");
    __syncthreads();
    const int kswz = (n >> 1) & 7;
    for (int kt = 0; kt < ntile; ++kt) {
        if (kt + 1 < ntile) dma(kt + 1, (kt + 1) & 1);
        { const unsigned c_all = cnt[lane & 31];
          if (__ballot(c_all > (unsigned)(IDX_CAP - 128))) {
#pragma unroll 1
              for (int i = 0; i < 4; ++i) { const int qq = 4 * w + i; if (cnt[qq] > 288u) idx_compact(lds, qq, lane); }
              tau_reg[0] = tau[4 * w + hf]; tau_reg[1] = tau[4 * w + 2 + hf];
          } }
        const LAS unsigned char* kb = lds + IDX_KT + (kt & 1) * 16384;
#pragma unroll 1
        for (int sub = 0; sub < 4; ++sub) {
            if (kt * 4 + sub >= nsub) break;
            const LAS unsigned char* kr = kb + (sub * 32 + n) * 128;
            f16x8 kf[4];
#pragma unroll
            for (int ks = 0; ks < 4; ++ks) kf[ks] = *(const LAS f16x8*)(kr + ((2 * ks + hf) ^ kswz) * 16);
            const int key = kt * 128 + sub * 32 + n;
#pragma unroll
            for (int rt = 0; rt < 2; ++rt) {
                f32x16 acc;
#pragma unroll
                for (int r = 0; r < 16; ++r) acc[r] = 0.f;
#pragma unroll
                for (int ks = 0; ks < 4; ++ks) acc = __builtin_amdgcn_mfma_f32_32x32x16_f16(qf[rt][ks], kf[ks], acc, 0, 0, 0);
                float pa = 0.f, pb = 0.f;
#pragma unroll
                for (int r = 0; r < 8; ++r) { pa = fmaf(fmaxf(acc[r], 0.f), wv[rt][r], pa); pb = fmaf(fmaxf(acc[r + 8], 0.f), wv[rt][r + 8], pb); }
                const float send = hf ? pa : pb, mine = hf ? pb : pa;
                const float sc = mine + __shfl_xor(send, 32);
                if (sc > tau_reg[rt]) { const int qq = 4 * w + 2 * rt + hf; const unsigned pos = __hip_atomic_fetch_add(cnt + qq, 1u, __ATOMIC_RELAXED, __HIP_MEMORY_SCOPE_WORKGROUP);
                    if (pos < (unsigned)IDX_CAP) { cs[qq * IDX_CAP + pos] = sc; ci[qq * IDX_CAP + pos] = (unsigned short)key; } }
            }
        }
        asm volatile("s_waitcnt vmcnt(0)" ::: "memory");
        __syncthreads();
    }
    LAS unsigned* bm = (LAS unsigned*)(lds + IDX_BM) + w * 512;
#pragma unroll 1
    for (int i = 0; i < 4; ++i) {
        const int qq = 4 * w + i;
        if (cnt[qq] > 256u) idx_compact(lds, qq, lane);
        const int nsel = (int)cnt[qq];
#pragma unroll
        for (int j = 0; j < 8; ++j) bm[lane + 64 * j] = 0u;
#pragma unroll
        for (int j = 0; j < 4; ++j) { const int idx = lane + 64 * j; if (idx < nsel) { const unsigned k = ci[qq * IDX_CAP + idx]; (void)__hip_atomic_fetch_or(bm + (k >> 5), 1u << (k & 31), __ATOMIC_RELAXED, __HIP_MEMORY_SCOPE_WORKGROUP); } }
        const int tq = t0 + qq;
#pragma unroll 1
        for (int kt = lane; kt < L / 64; kt += 64) { const unsigned long long v = (unsigned long long)bm[2 * kt] | ((unsigned long long)bm[2 * kt + 1] << 32); a.MT[((size_t)b * 256 + kt) * SEQ + tq] = v; }
    }
    __syncthreads();
}
__device__ __forceinline__ void idx_phase(LAS unsigned char* lds, const IdxArgs& a, int bid, int nblk) {
    for (int k = bid; k < 256; k += nblk) {
#pragma unroll 1
        for (int i = 0; i < 4; ++i) idx_item(lds, a, i & 1, (i < 2) ? 511 - k : k);
    }
}
#define XB_TMO      128
#define XB_XCNT(j)  (256  + 64 * (j))
#define XB_XSUB(j)  (1280 + 64 * (j))
#define XB_XGEN(j)  (2304 + 64 * (j))
#define XB_TOP      3328
#define XB_TOPGEN   3392
#define XCD_BAR_WORDS 3456
#define XB_SPIN_CAP (1u << 23)


__device__ __forceinline__ unsigned xb_ld(unsigned* p)              { return __hip_atomic_load(p, __ATOMIC_RELAXED, __HIP_MEMORY_SCOPE_AGENT); }
__device__ __forceinline__ unsigned xb_add(unsigned* p, unsigned v) { return __hip_atomic_fetch_add(p, v, __ATOMIC_RELAXED, __HIP_MEMORY_SCOPE_AGENT); }
__device__ __forceinline__ unsigned xb_xcc_id() { return (unsigned)__builtin_amdgcn_s_getreg((3 << 11) | 20) & 0xFu; }
#define XB_SPIN(cond, bar) do { unsigned _sp = 0; while (cond) { __builtin_amdgcn_s_sleep(1); \
    if ((++_sp & 255u) == 0u) { if (xb_ld(&(bar)[XB_TMO])) break; if (_sp > XB_SPIN_CAP) { atomicAdd(&(bar)[XB_TMO], 1u); break; } } } } while (0)

struct XcdBarrier {
    unsigned* bar; unsigned x;
    volatile LAS unsigned* st;
};

__device__ __forceinline__ XcdBarrier xcd_barrier_post(unsigned* bar, volatile LAS unsigned* st) {
    XcdBarrier b; b.bar = bar; b.x = xb_xcc_id(); b.st = st;
    if (threadIdx.x == 0) (void)xb_add(&bar[XB_XCNT(b.x)], 1u);
    return b;
}
__device__ __forceinline__ void xcd_barrier_complete(unsigned* bar, unsigned x, unsigned& nloc, unsigned& nx) {
    const unsigned G = gridDim.x * gridDim.y * gridDim.z;
    unsigned sum, cnt, mine, sp = 0u;
    for (;;) {
        sum = 0u; cnt = 0u; mine = 0u;
#pragma unroll
        for (unsigned j = 0; j < 16; ++j) { const unsigned c = xb_ld(&bar[XB_XCNT(j)]); sum += c; cnt += (c > 0u) ? 1u : 0u; mine = (j == x) ? c : mine; }
        if (sum == G) break;
        __builtin_amdgcn_s_sleep(1);
        if ((++sp & 255u) == 0u) { if (xb_ld(&bar[XB_TMO])) break; if (sp > XB_SPIN_CAP) { atomicAdd(&bar[XB_TMO], 1u); break; } }
    }
    nloc = mine > 0u ? mine : 1u; nx = cnt > 0u ? cnt : 1u;
}

__device__ __forceinline__ void xcd_barrier(const XcdBarrier& b) {
    asm volatile("s_waitcnt vmcnt(0)" ::: "memory");
    __syncthreads();
    if (threadIdx.x == 0) {
        unsigned* bar = b.bar;
        __builtin_amdgcn_s_waitcnt(0);
        unsigned nloc = b.st[0], nx = b.st[1];
        if (nloc == 0u) { xcd_barrier_complete(bar, b.x, nloc, nx); b.st[0] = nloc; b.st[1] = nx; }
        const unsigned old = xb_add(&bar[XB_XSUB(b.x)], 1u);
        const unsigned gen = old / nloc;
        if (old + 1u == (gen + 1u) * nloc) {
            __builtin_amdgcn_fence(__ATOMIC_RELEASE, "agent");
            asm volatile("s_waitcnt vmcnt(0)" ::: "memory");
            const unsigned og = xb_add(&bar[XB_TOP], 1u);
            const unsigned tg = og / nx;
            if (og + 1u == (tg + 1u) * nx) xb_add(&bar[XB_TOPGEN], 1u);
            else XB_SPIN(xb_ld(&bar[XB_TOPGEN]) == tg, bar);
            __builtin_amdgcn_fence(__ATOMIC_ACQUIRE, "agent");
            xb_add(&bar[XB_XGEN(b.x)], 1u);
            asm volatile("s_waitcnt vmcnt(0)" ::: "memory");
        } else {
            XB_SPIN(xb_ld(&bar[XB_XGEN(b.x)]) == gen, bar);
            __builtin_amdgcn_fence(__ATOMIC_ACQUIRE, "agent");
            asm volatile("s_waitcnt vmcnt(0)" ::: "memory");
        }
    }
    __syncthreads();
}

#ifndef SKIPMASK
#define SKIPMASK 0
#endif

__device__ __forceinline__ int perm16(int t) { const int a = (t >> 2) & 3; return (t & ~12) | ((a == 1 ? 2 : (a == 2 ? 1 : a)) << 2); }
__device__ __forceinline__ void st_vt(bf16_t* VT, int row, int h, int d, f32x4 v) {
    const int b = row / SEQ, t = row % SEQ; bf16_t* p = VT + ((size_t)(b * 8 + h) * 128 + d) * SEQ + (t & ~15) + perm16(t & 15);
    p[0] = f2bf(v[0]); p[SEQ] = f2bf(v[1]); p[2 * (size_t)SEQ] = f2bf(v[2]); p[3 * (size_t)SEQ] = f2bf(v[3]);
}
struct FAbIn2 { bf16_t *Q, *K, *VT; float *QI, *U, *WI; unsigned short* KI16;
    __device__ __forceinline__ void operator()(int r, int c, f32x4 v) const {
        if (c < 1024) st_bf16x4(Q + (size_t)r * 1024 + c, v);
        else if (c < 2048) st_bf16x4(K + (size_t)r * 1024 + (c - 1024), v);
        else if (c < 3072) st_vt(VT, r, (c - 2048) >> 7, (c - 2048) & 127, v);
        else if (c < 4096) st_f32x4(QI + (size_t)r * 1024 + (c - 3072), v);
        else if (c < 5120) st_f32x4(U + (size_t)r * 1024 + (c - 4096), v);
        else if (c < 5184) { typedef _Float16 h2 __attribute__((ext_vector_type(2))); union { h2 h; unsigned u; } a, b; a.h = (h2){(_Float16)v[0], (_Float16)v[1]}; b.h = (h2){(_Float16)v[2], (_Float16)v[3]};
            u32x2 w; w.x = a.u; w.y = b.u; *(u32x2*)(KI16 + (size_t)r * 64 + (c - 5120)) = w; }
        else if (c < 5200) st_f32x4(WI + (size_t)r * 16 + (c - 5184), v);
    } };
struct FKvUp2 { bf16_t *K1, *VT;
    __device__ __forceinline__ void operator()(int r, int c, f32x4 v) const {
        const int h = c >> 8, d = c & 255;
        if (d < 128) st_bf16x4(K1 + (size_t)r * 1536 + h * 192 + d, v);
        else st_vt(VT, r, h, d - 128, v);
    } };

template <class F> __device__ __forceinline__ void ph_gemm(LAS unsigned char* lds, const bf16_t* A, int lda, const bf16_t* Bt, int ldb, int M, int N, int K, const F& f, int bid, int nblk) {
    pg8::Gemm g; g.A = A; g.Bt = Bt; g.M = M; g.N = N; g.K = K; g.lda = lda; g.ldb = ldb; g.pad_ = 0;
    EpiG<F> e; e.f = f;
    pg8::StaticOrder S; S.init(M, N, nblk, bid);
    pg8::gemm_phase<EpiG<F>, pg8::StaticOrder, false>(lds, g, S, e, nullptr);
    __syncthreads();
}
__device__ __forceinline__ void ph_convT(LAS unsigned char* lds, const float* __restrict__ W, int ldw, int src_col0, int ncols, int K, bf16_t* __restrict__ Bt, int bid, int nblk) {
    const int tid = opaque_tid(), sub = tid >> 8, t8 = tid & 255, tx = t8 & 31, ty = t8 >> 5;
    LAS float* tile = (LAS float*)lds + sub * (32 * 33);
    const int ntx = (ncols + 31) / 32, ntiles = ntx * (K / 32);
    for (int base = bid * 2; base < ntiles; base += nblk * 2) {
        const int tl = base + sub; const bool act = tl < ntiles;
        const int n0 = (tl % ntx) * 32, k0 = (tl / ntx) * 32;
        if (act) {
#pragma unroll
            for (int i = 0; i < 4; ++i) { const int k = k0 + ty + 8 * i, n = n0 + tx; tile[(ty + 8 * i) * 33 + tx] = (n < ncols) ? W[(size_t)k * ldw + src_col0 + n] : 0.f; } }
        __syncthreads();
        if (act) {
#pragma unroll
            for (int i = 0; i < 4; ++i) { const int n = n0 + ty + 8 * i, k = k0 + tx; if (n < ncols) Bt[(size_t)n * K + k] = f2bf(tile[tx * 33 + ty + 8 * i]); } }
        __syncthreads();
    }
}
template <int NC> __device__ __forceinline__ void ph_rmsnorm(const float* __restrict__ x, const float* __restrict__ g, bf16_t* __restrict__ out, int bid, int nblk) {
    const int lane = opaque_tid() & 63, w = opaque_tid() >> 6;
    constexpr int NV = NC / 256;
    for (int row = bid * 8 + w; row < NTOK; row += nblk * 8) {
        const f32x4* xr = (const f32x4*)(x + (size_t)row * NC);
        f32x4 v[NV]; float ss = 0.f;
#pragma unroll
        for (int i = 0; i < NV; ++i) { v[i] = xr[lane + 64 * i]; ss += v[i][0] * v[i][0] + v[i][1] * v[i][1] + v[i][2] * v[i][2] + v[i][3] * v[i][3]; }
        ss = wave_sum(ss);
        const float r = rsqrtf(ss * (1.0f / NC) + NORM_EPS);
#pragma unroll
        for (int i = 0; i < NV; ++i) { const f32x4 gg = ((const f32x4*)g)[lane + 64 * i]; st_bf16x4(out + (size_t)row * NC + 4 * (lane + 64 * i), v[i] * r * gg); }
    }
}
__device__ __forceinline__ void ph_resnorm(const float* xin, const bf16_t* __restrict__ m, const float* __restrict__ gpost, const float* __restrict__ gpre, float* xout, bf16_t* __restrict__ h, int bid, int nblk) {
    const int lane = opaque_tid() & 63, w = opaque_tid() >> 6;
    for (int row = bid * 8 + w; row < NTOK; row += nblk * 8) {
        const f32x4* xr = (const f32x4*)(xin + (size_t)row * DM);
        const u32x2* mr = (const u32x2*)(m + (size_t)row * DM);
        f32x4 mv[8], xv[8]; float ss = 0.f;
#pragma unroll
        for (int i = 0; i < 8; ++i) { const u32x2 wd = mr[lane + 64 * i]; mv[i][0] = __uint_as_float(wd.x << 16); mv[i][1] = __uint_as_float(wd.x & 0xFFFF0000u); mv[i][2] = __uint_as_float(wd.y << 16); mv[i][3] = __uint_as_float(wd.y & 0xFFFF0000u);
            xv[i] = xr[lane + 64 * i]; ss += mv[i][0] * mv[i][0] + mv[i][1] * mv[i][1] + mv[i][2] * mv[i][2] + mv[i][3] * mv[i][3]; }
        ss = wave_sum(ss);
        const float r1 = rsqrtf(ss * (1.0f / DM) + NORM_EPS);
        float s2 = 0.f;
#pragma unroll
        for (int i = 0; i < 8; ++i) { const f32x4 gg = ((const f32x4*)gpost)[lane + 64 * i]; xv[i] = xv[i] + mv[i] * r1 * gg; ((f32x4*)(xout + (size_t)row * DM))[lane + 64 * i] = xv[i];
            s2 += xv[i][0] * xv[i][0] + xv[i][1] * xv[i][1] + xv[i][2] * xv[i][2] + xv[i][3] * xv[i][3]; }
        if (gpre) {
            s2 = wave_sum(s2);
            const float r2 = rsqrtf(s2 * (1.0f / DM) + NORM_EPS);
#pragma unroll
            for (int i = 0; i < 8; ++i) { const f32x4 gg = ((const f32x4*)gpre)[lane + 64 * i]; st_bf16x4(h + (size_t)row * DM + 4 * (lane + 64 * i), xv[i] * r2 * gg); }
        }
    }
}
__device__ __forceinline__ void ph_pool(LAS unsigned char* lds, const float* __restrict__ U, const float* __restrict__ pw, const float* __restrict__ pb, const float* __restrict__ ps, bf16_t* __restrict__ CC, int bid, int nblk) {
    const int tid = opaque_tid(), sub = tid >> 8, t8 = tid & 255;
    LAS float* A = (LAS float*)lds + sub * (16 * 256);
    for (int it = bid; it < (NTOK / 16) * 2; it += nblk) {
        const int r0 = (it >> 1) * 16, g = (it & 1) * 2 + sub, win = 2 << g;
        for (int r = 0; r < 16; ++r) {
            const int row = r0 + r, t = row % SEQ, cnt = (t + 1 < win) ? (t + 1) : win;
            float s = 0.f;
            for (int i = 0; i < cnt; ++i) s += U[(size_t)(row - i) * 1024 + g * 256 + t8];
            A[r * 256 + t8] = s / (float)cnt - U[(size_t)row * 1024 + g * 256 + t8];
        }
        __syncthreads();
        float acc[16];
#pragma unroll
        for (int r = 0; r < 16; ++r) acc[r] = 0.f;
        const float* wp = pw + (size_t)g * 256 * 256 + t8;
        for (int c = 0; c < 256; ++c) { const float wv = wp[(size_t)c * 256];
#pragma unroll
            for (int r = 0; r < 16; ++r) acc[r] += A[r * 256 + c] * wv; }
        const float bb = pb[g * 256 + t8], sc = ps[g * 256 + t8];
#pragma unroll
        for (int r = 0; r < 16; ++r) CC[(size_t)(r0 + r) * 2048 + 1024 + g * 256 + t8] = f2bf((acc[r] + bb) * sc);
        __syncthreads();
    }
}
__device__ __forceinline__ void ph_lru_gates(LAS unsigned char* lds, const bf16_t* __restrict__ XL, const float* __restrict__ cw, const float* __restrict__ cb, const float* __restrict__ wa, const float* __restrict__ ba,
                                             const float* __restrict__ wx, const float* __restrict__ bx, const float* __restrict__ lam, float* __restrict__ Aout, float* __restrict__ Bout, int bid, int nblk) {
    const int tid = opaque_tid(), sub = tid >> 7, t7 = tid & 127;
    LAS float* A = (LAS float*)lds + sub * (16 * 128);
    for (int it = bid; it < (NTOK / 16) * 2; it += nblk) {
        const int r0 = (it >> 1) * 16, nb = (it & 1) * 4 + sub, ch = nb * 128 + t7;
        const float c0 = cw[ch], c1 = cw[1024 + ch], c2 = cw[2048 + ch], c3 = cw[3072 + ch], cbv = cb[ch];
        for (int r = 0; r < 16; ++r) {
            const int row = r0 + r, t = row % SEQ;
            float y = cbv + c3 * bf2f(XL[(size_t)row * 1024 + ch]);
            if (t >= 1) y += c2 * bf2f(XL[(size_t)(row - 1) * 1024 + ch]);
            if (t >= 2) y += c1 * bf2f(XL[(size_t)(row - 2) * 1024 + ch]);
            if (t >= 3) y += c0 * bf2f(XL[(size_t)(row - 3) * 1024 + ch]);
            A[r * 128 + t7] = y;
        }
        __syncthreads();
        float ga[16], gx[16];
#pragma unroll
        for (int r = 0; r < 16; ++r) { ga[r] = 0.f; gx[r] = 0.f; }
        const float* pa = wa + (size_t)nb * 128 * 128 + t7; const float* px = wx + (size_t)nb * 128 * 128 + t7;
        for (int c = 0; c < 128; ++c) { const float va = pa[(size_t)c * 128], vx = px[(size_t)c * 128];
#pragma unroll
            for (int r = 0; r < 16; ++r) { ga[r] += A[r * 128 + c] * va; gx[r] += A[r * 128 + c] * vx; } }
        const float bav = ba[ch], bxv = bx[ch], lm = lam[ch];
        const float sp = (lm > 20.f) ? expf(-lm) : log1pf(expf(-lm));
#pragma unroll
        for (int r = 0; r < 16; ++r) {
            const float rg = 1.0f / (1.0f + expf(-(ga[r] + bav))), ig = 1.0f / (1.0f + expf(-(gx[r] + bxv)));
            const float log_a = -8.0f * rg * sp, a = expf(log_a), mult = sqrtf(-expm1f(2.0f * log_a));
            Aout[(size_t)(r0 + r) * 1024 + ch] = a; Bout[(size_t)(r0 + r) * 1024 + ch] = mult * (ig * A[r * 128 + t7]);
        }
        __syncthreads();
    }
}
__device__ __forceinline__ void ph_scan1(const float* __restrict__ Aa, const float* __restrict__ Bb, float* __restrict__ CA, float* __restrict__ CH, int bid, int nblk) {
    for (int i = bid * 512 + opaque_tid(); i < 2 * 256 * 1024; i += nblk * 512) {
        const int ch = i & 1023, chunk = (i >> 10) & 255, b = i >> 18;
        const size_t base = ((size_t)b * SEQ + (size_t)chunk * 64) * 1024 + ch;
        float h = 0.f, P = 1.f;
        for (int s = 0; s < 64; ++s) { const float a = Aa[base + (size_t)s * 1024]; h = a * h + Bb[base + (size_t)s * 1024]; P *= a; }
        CA[i] = P; CH[i] = h;
    }
}
__device__ __forceinline__ void ph_scan2(const float* __restrict__ CA, const float* __restrict__ CH, float* __restrict__ CIN, int bid, int nblk) {
    for (int i = bid * 512 + opaque_tid(); i < 2048; i += nblk * 512) {
        const int ch = i & 1023, b = i >> 10;
        float h = 0.f;
        for (int c = 0; c < 256; ++c) { const int j = (b * 256 + c) * 1024 + ch; CIN[j] = h; h = CA[j] * h + CH[j]; }
    }
}
__device__ __forceinline__ void ph_scan3(const float* __restrict__ Aa, const float* __restrict__ Bb, const float* __restrict__ CIN, const bf16_t* __restrict__ YG, bf16_t* __restrict__ CC, int bid, int nblk) {
    for (int i = bid * 512 + opaque_tid(); i < 2 * 256 * 1024; i += nblk * 512) {
        const int ch = i & 1023, chunk = (i >> 10) & 255, b = i >> 18;
        const size_t row0 = (size_t)b * SEQ + (size_t)chunk * 64;
        float h = CIN[i];
        for (int s = 0; s < 64; ++s) { const size_t r = row0 + s; h = Aa[r * 1024 + ch] * h + Bb[r * 1024 + ch];
            CC[r * 2048 + 1024 + ch] = f2bf(h * gelu_tanh(bf2f(YG[r * 1024 + ch]))); }
    }
}
__device__ __forceinline__ void ph_rope_q(bf16_t* __restrict__ Q1, const int* __restrict__ pos, int bid, int nblk) {
    for (int idx = bid * 512 + opaque_tid(); idx < NTOK * 8 * 32; idx += nblk * 512) {
        const int i = idx & 31, h = (idx >> 5) & 7, row = idx >> 8;
        float c, s; rope_cs(pos[row], i, c, s);
        bf16_t* p = Q1 + (size_t)row * 1536 + h * 192 + 128;
        const float x1 = bf2f(p[i]), x2 = bf2f(p[32 + i]);
        p[i] = f2bf(x1 * c - x2 * s); p[32 + i] = f2bf(x2 * c + x1 * s);
    }
}
__device__ __forceinline__ void ph_rope_k(const float* __restrict__ KR, const int* __restrict__ pos, bf16_t* __restrict__ K1, int bid, int nblk) {
    for (int idx = bid * 512 + opaque_tid(); idx < NTOK * 32; idx += nblk * 512) {
        const int i = idx & 31, row = idx >> 5;
        float c, s; rope_cs(pos[row], i, c, s);
        const float x1 = KR[(size_t)row * 64 + i], x2 = KR[(size_t)row * 64 + 32 + i];
        const bf16_t o1 = f2bf(x1 * c - x2 * s), o2 = f2bf(x2 * c + x1 * s);
#pragma unroll
        for (int h = 0; h < 8; ++h) { bf16_t* p = K1 + (size_t)row * 1536 + h * 192 + 128; p[i] = o1; p[32 + i] = o2; }
    }
}
__device__ __forceinline__ void ph_ffn_gate(const bf16_t* __restrict__ HID, const float* __restrict__ cw, const float* __restrict__ cb, bf16_t* __restrict__ ACT, int bid, int nblk) {
    for (int i = bid * 512 + opaque_tid(); i < SEQ * 512; i += nblk * 512) {
        const int c8 = (i & 511) * 8, t = i >> 9;
        float g[8], v[8];
#pragma unroll
        for (int j = 0; j < 8; ++j) { g[j] = cb[c8 + j]; v[j] = cb[4096 + c8 + j]; }
#pragma unroll
        for (int k = 0; k < 3; ++k) { const int tt = t - 2 + k; if (tt < 0) continue;
            const u32x4 wg = *(const u32x4*)(HID + (size_t)tt * 8192 + c8), wv = *(const u32x4*)(HID + (size_t)tt * 8192 + 4096 + c8);
            const unsigned ug[4] = {wg.x, wg.y, wg.z, wg.w}, uv[4] = {wv.x, wv.y, wv.z, wv.w};
#pragma unroll
            for (int j = 0; j < 4; ++j) {
                g[2 * j] += cw[k * 8192 + c8 + 2 * j] * __uint_as_float(ug[j] << 16); g[2 * j + 1] += cw[k * 8192 + c8 + 2 * j + 1] * __uint_as_float(ug[j] & 0xFFFF0000u);
                v[2 * j] += cw[k * 8192 + 4096 + c8 + 2 * j] * __uint_as_float(uv[j] << 16); v[2 * j + 1] += cw[k * 8192 + 4096 + c8 + 2 * j + 1] * __uint_as_float(uv[j] & 0xFFFF0000u); } }
        u32x4 o;
        o.x = pack2bf(gelu_tanh(g[0]) * v[0], gelu_tanh(g[1]) * v[1]); o.y = pack2bf(gelu_tanh(g[2]) * v[2], gelu_tanh(g[3]) * v[3]);
        o.z = pack2bf(gelu_tanh(g[4]) * v[4], gelu_tanh(g[5]) * v[5]); o.w = pack2bf(gelu_tanh(g[6]) * v[6], gelu_tanh(g[7]) * v[7]);
        *(u32x4*)(ACT + (size_t)t * 4096 + c8) = o;
    }
}

static constexpr size_t MiB = 1048576;
static constexpr size_t W_UP0 = 0 * MiB, W_UP1 = 32 * MiB, W_DN0 = 64 * MiB, W_DN1 = 80 * MiB, W_ABIN = 96 * MiB, W_ABOUT = 117 * MiB, W_CDIN = 125 * MiB, W_CDOUT = 137 * MiB,
                        W_QUP = 145 * MiB, W_KVUP = 146 * MiB + 512 * 1024;
static constexpr size_t R_H = 148 * MiB;
static constexpr size_t R_Q0 = 276 * MiB, R_K0 = 340 * MiB, R_VT0 = 404 * MiB, R_QI = 468 * MiB, R_M0 = 468 * MiB, R_U = 596 * MiB, R_KI = 724 * MiB, R_WI = 732 * MiB, R_MASK = 734 * MiB, R_CC0 = 830 * MiB;
static constexpr size_t R_HID = 276 * MiB, R_ACT = 532 * MiB, R_F = 660 * MiB;
static constexpr size_t R_VT1 = 276 * MiB, R_CQ = 276 * MiB, R_CKV = 340 * MiB, R_KR = 372 * MiB, R_XL = 380 * MiB, R_YG = 444 * MiB, R_CQN = 508 * MiB, R_CKVN = 540 * MiB, R_LA = 556 * MiB, R_LB = 684 * MiB,
                        R_Q1 = 812 * MiB, R_K1 = 908 * MiB, R_CA = 1004 * MiB, R_CH = 1006 * MiB, R_CIN = 1008 * MiB, R_CC1 = 148 * MiB, R_M1 = 276 * MiB;
static constexpr size_t WS_BAR = 1022 * MiB, WS_NEED = 1022 * MiB + 65536;
static constexpr int MK_LDS = 155648;

struct MK { const float* in[28]; float* out; unsigned char* ws; int ph_lo, ph_hi; };

__global__ __launch_bounds__(512, 2) void k_mega(MK p) {
    extern __shared__ __attribute__((aligned(16))) unsigned char shm[];
    LAS unsigned char* lds = (LAS unsigned char*)shm;
    const int bid0 = (int)blockIdx.x, nblk0 = (int)gridDim.x;
    volatile LAS unsigned* xbw = (volatile LAS unsigned*)(lds + MK_LDS - 16);
    if (threadIdx.x == 0) { xbw[0] = 0u; xbw[1] = 0u; xbw[2] = 0u; xbw[3] = 0u; }
    __syncthreads();
    XcdBarrier bar = xcd_barrier_post((unsigned*)(p.ws + WS_BAR), xbw);
    unsigned char* ws = p.ws; float* xo = p.out;
    const float* x = p.in[0]; const int* positions = (const int*)p.in[1];
    const float *mix_pre_g = p.in[2], *mix_post_g = p.in[3], *ffn_pre_g = p.in[4], *ffn_post_g = p.in[5];
    const float *ffn_up = p.in[6], *ffn_conv_w = p.in[7], *ffn_conv_b = p.in[8], *ffn_down = p.in[9];
    const float *ab_w_in = p.in[10], *pool_w = p.in[11], *pool_b = p.in[12], *pool_scale = p.in[13], *ab_w_out = p.in[14];
    const float *cd_w_in = p.in[15], *q_norm_g = p.in[16], *w_q_up = p.in[17], *kv_norm_g = p.in[18], *w_kv_up = p.in[19];
    const float *lru_conv_w = p.in[20], *lru_conv_b = p.in[21], *lru_wa = p.in[22], *lru_ba = p.in[23], *lru_wx = p.in[24], *lru_bx = p.in[25], *lru_lambda = p.in[26], *cd_w_out = p.in[27];
#define WSP(T, off) ((T*)(ws + (off)))
#define PHASE_BEGIN if (pc >= p.ph_lo && pc < p.ph_hi) { const int bid = opaque_s(bid0), nblk = opaque_s(nblk0);
#define PHASE_END } if (pc >= p.ph_lo && pc + 1 < p.ph_hi) xcd_barrier(bar); ++pc;
    int pc = 0;
    bf16_t* H = WSP(bf16_t, R_H);
    PHASE_BEGIN
#if !((SKIPMASK >> 0) & 1)
        ph_convT(lds, ffn_up, 8192, 0, 8192, 2048, WSP(bf16_t, W_UP0), bid, nblk);
        ph_convT(lds, ffn_up + (size_t)2048 * 8192, 8192, 0, 8192, 2048, WSP(bf16_t, W_UP1), bid, nblk);
        ph_convT(lds, ffn_down, 2048, 0, 2048, 4096, WSP(bf16_t, W_DN0), bid, nblk);
        ph_convT(lds, ffn_down + (size_t)4096 * 2048, 2048, 0, 2048, 4096, WSP(bf16_t, W_DN1), bid, nblk);
        ph_convT(lds, ab_w_in, 5200, 0, 4096, 2048, WSP(bf16_t, W_ABIN), bid, nblk);
        ph_convT(lds, ab_w_in, 5200, 4176, 1024, 2048, WSP(bf16_t, W_ABIN) + (size_t)4096 * 2048, bid, nblk);
        ph_convT(lds, ab_w_in, 5200, 4096, 64, 2048, WSP(bf16_t, W_ABIN) + (size_t)5120 * 2048, bid, nblk);
        ph_convT(lds, ab_w_in, 5200, 4160, 16, 2048, WSP(bf16_t, W_ABIN) + (size_t)5184 * 2048, bid, nblk);
        ph_convT(lds, ab_w_out, 2048, 0, 2048, 2048, WSP(bf16_t, W_ABOUT), bid, nblk);
        ph_convT(lds, cd_w_in, 2880, 0, 832, 2048, WSP(bf16_t, W_CDIN), bid, nblk);
        ph_convT(lds, cd_w_in, 2880, 832, 2048, 2048, WSP(bf16_t, W_CDIN) + (size_t)1024 * 2048, bid, nblk);
        ph_convT(lds, cd_w_out, 2048, 0, 2048, 2048, WSP(bf16_t, W_CDOUT), bid, nblk);
        ph_convT(lds, w_q_up, 1536, 0, 1536, 512, WSP(bf16_t, W_QUP), bid, nblk);
        ph_convT(lds, w_kv_up, 2048, 0, 2048, 256, WSP(bf16_t, W_KVUP), bid, nblk);
        ph_rmsnorm<2048>(x, mix_pre_g, H, bid, nblk);
#endif
    PHASE_END
    { const bf16_t* CC; bf16_t* Mx;
            CC = WSP(bf16_t, R_CC0); Mx = WSP(bf16_t, R_M0);
            PHASE_BEGIN
#if !((SKIPMASK >> 1) & 1)
                FAbIn2 f; f.Q = WSP(bf16_t, R_Q0); f.K = WSP(bf16_t, R_K0); f.VT = WSP(bf16_t, R_VT0); f.QI = WSP(float, R_QI); f.U = WSP(float, R_U); f.WI = WSP(float, R_WI); f.KI16 = WSP(unsigned short, R_KI);
                ph_gemm(lds, H, 2048, WSP(bf16_t, W_ABIN), 2048, NTOK, 5376, 2048, f, bid, nblk);
#endif
            PHASE_END
            PHASE_BEGIN
#if !((SKIPMASK >> 2) & 1)
                ph_pool(lds, WSP(float, R_U), pool_w, pool_b, pool_scale, WSP(bf16_t, R_CC0), bid, nblk);
                IdxArgs a; a.QI = WSP(float, R_QI); a.KI16 = WSP(unsigned short, R_KI); a.WI = WSP(float, R_WI); a.MT = WSP(unsigned long long, R_MASK);
                idx_phase(lds, a, bid, nblk);
#endif
            PHASE_END
            PHASE_BEGIN
#if !((SKIPMASK >> 3) & 1)
                AttnArgs a; a.Q = WSP(bf16_t, R_Q0); a.K = WSP(bf16_t, R_K0); a.VT = WSP(bf16_t, R_VT0); a.MT = WSP(unsigned long long, R_MASK); a.O = WSP(bf16_t, R_CC0); a.ldq = 1024; a.ldk = 1024; a.ldo = 2048;
                a.sc_log2e = 0.08838834764831845f * 1.4426950408889634f;
                attn_phase<128, true>(lds, a, bid, nblk);
#endif
            PHASE_END
        PHASE_BEGIN
#if !((SKIPMASK >> 4) & 1)
            FStoreBf16 f; f.O = Mx; f.ldc = 2048; f.pad_ = 0;
            ph_gemm(lds, CC, 2048, WSP(bf16_t, W_ABOUT), 2048, NTOK, 2048, 2048, f, bid, nblk);
#endif
        PHASE_END
        PHASE_BEGIN
#if !((SKIPMASK >> 5) & 1)
            ph_resnorm(x, Mx, mix_post_g + 0, ffn_pre_g + 0, xo, H, bid, nblk);
#endif
        PHASE_END
        for (int half = 0; half < 2; ++half) {
            PHASE_BEGIN
#if !((SKIPMASK >> 6) & 1)
                FStoreBf16 f; f.O = WSP(bf16_t, R_HID); f.ldc = 8192; f.pad_ = 0;
                ph_gemm(lds, H + (size_t)half * SEQ * 2048, 2048, WSP(bf16_t, W_UP0), 2048, SEQ, 8192, 2048, f, bid, nblk);
#endif
            PHASE_END
            PHASE_BEGIN
#if !((SKIPMASK >> 7) & 1)
                ph_ffn_gate(WSP(bf16_t, R_HID), ffn_conv_w + 0, ffn_conv_b + 0, WSP(bf16_t, R_ACT), bid, nblk);
#endif
            PHASE_END
            PHASE_BEGIN
#if !((SKIPMASK >> 8) & 1)
                FStoreBf16 f; f.O = WSP(bf16_t, R_F) + (size_t)half * SEQ * 2048; f.ldc = 2048; f.pad_ = 0;
                ph_gemm(lds, WSP(bf16_t, R_ACT), 4096, WSP(bf16_t, W_DN0), 4096, SEQ, 2048, 4096, f, bid, nblk);
#endif
            PHASE_END
        }
        PHASE_BEGIN
#if !((SKIPMASK >> 9) & 1)
            ph_resnorm(xo, WSP(bf16_t, R_F), ffn_post_g + 0, mix_pre_g + 2048, xo, H, bid, nblk);
#endif
        PHASE_END
    }
    { const bf16_t* CC; bf16_t* Mx;
            CC = WSP(bf16_t, R_CC1); Mx = WSP(bf16_t, R_M1);
            PHASE_BEGIN
#if !((SKIPMASK >> 10) & 1)
                FCdIn f; f.CQ = WSP(float, R_CQ); f.CKV = WSP(float, R_CKV); f.KR = WSP(float, R_KR); f.XL = WSP(bf16_t, R_XL); f.YG = WSP(bf16_t, R_YG);
                ph_gemm(lds, H, 2048, WSP(bf16_t, W_CDIN), 2048, NTOK, 3072, 2048, f, bid, nblk);
#endif
            PHASE_END
            PHASE_BEGIN
#if !((SKIPMASK >> 11) & 1)
                ph_lru_gates(lds, WSP(bf16_t, R_XL), lru_conv_w, lru_conv_b, lru_wa, lru_ba, lru_wx, lru_bx, lru_lambda, WSP(float, R_LA), WSP(float, R_LB), bid, nblk);
                ph_rmsnorm<512>(WSP(float, R_CQ), q_norm_g, WSP(bf16_t, R_CQN), bid, nblk);
                ph_rmsnorm<256>(WSP(float, R_CKV), kv_norm_g, WSP(bf16_t, R_CKVN), bid, nblk);
#endif
            PHASE_END
            PHASE_BEGIN
#if !((SKIPMASK >> 12) & 1)
                ph_scan1(WSP(float, R_LA), WSP(float, R_LB), WSP(float, R_CA), WSP(float, R_CH), bid, nblk);
                { FStoreBf16 f; f.O = WSP(bf16_t, R_Q1); f.ldc = 1536; f.pad_ = 0; ph_gemm(lds, WSP(bf16_t, R_CQN), 512, WSP(bf16_t, W_QUP), 512, NTOK, 1536, 512, f, bid, nblk); }
                { FKvUp2 f; f.K1 = WSP(bf16_t, R_K1); f.VT = WSP(bf16_t, R_VT1); ph_gemm(lds, WSP(bf16_t, R_CKVN), 256, WSP(bf16_t, W_KVUP), 256, NTOK, 2048, 256, f, bid, nblk); }
#endif
            PHASE_END
            PHASE_BEGIN
#if !((SKIPMASK >> 13) & 1)
                ph_scan2(WSP(float, R_CA), WSP(float, R_CH), WSP(float, R_CIN), bid, nblk);
                ph_rope_q(WSP(bf16_t, R_Q1), positions, bid, nblk);
                ph_rope_k(WSP(float, R_KR), positions, WSP(bf16_t, R_K1), bid, nblk);
#endif
            PHASE_END
            PHASE_BEGIN
#if !((SKIPMASK >> 14) & 1)
                ph_scan3(WSP(float, R_LA), WSP(float, R_LB), WSP(float, R_CIN), WSP(bf16_t, R_YG), WSP(bf16_t, R_CC1), bid, nblk);
                AttnArgs a; a.Q = WSP(bf16_t, R_Q1); a.K = WSP(bf16_t, R_K1); a.VT = WSP(bf16_t, R_VT1); a.MT = nullptr; a.O = WSP(bf16_t, R_CC1); a.ldq = 1536; a.ldk = 1536; a.ldo = 2048;
                a.sc_log2e = 0.07216878364870322f * 1.4426950408889634f;
                attn_phase<192, false>(lds, a, bid, nblk);
#endif
            PHASE_END
        PHASE_BEGIN
#if !((SKIPMASK >> 15) & 1)
            FStoreBf16 f; f.O = Mx; f.ldc = 2048; f.pad_ = 0;
            ph_gemm(lds, CC, 2048, WSP(bf16_t, W_CDOUT), 2048, NTOK, 2048, 2048, f, bid, nblk);
#endif
        PHASE_END
        PHASE_BEGIN
#if !((SKIPMASK >> 16) & 1)
            ph_resnorm((const float*)xo, Mx, mix_post_g + 2048, ffn_pre_g + 2048, xo, H, bid, nblk);
#endif
        PHASE_END
        for (int half = 0; half < 2; ++half) {
            PHASE_BEGIN
#if !((SKIPMASK >> 17) & 1)
                FStoreBf16 f; f.O = WSP(bf16_t, R_HID); f.ldc = 8192; f.pad_ = 0;
                ph_gemm(lds, H + (size_t)half * SEQ * 2048, 2048, WSP(bf16_t, W_UP1), 2048, SEQ, 8192, 2048, f, bid, nblk);
#endif
            PHASE_END
            PHASE_BEGIN
#if !((SKIPMASK >> 18) & 1)
                ph_ffn_gate(WSP(bf16_t, R_HID), ffn_conv_w + 24576, ffn_conv_b + 8192, WSP(bf16_t, R_ACT), bid, nblk);
#endif
            PHASE_END
            PHASE_BEGIN
#if !((SKIPMASK >> 19) & 1)
                FStoreBf16 f; f.O = WSP(bf16_t, R_F) + (size_t)half * SEQ * 2048; f.ldc = 2048; f.pad_ = 0;
                ph_gemm(lds, WSP(bf16_t, R_ACT), 4096, WSP(bf16_t, W_DN1), 4096, SEQ, 2048, 4096, f, bid, nblk);
#endif
            PHASE_END
        }
        PHASE_BEGIN
#if !((SKIPMASK >> 20) & 1)
            ph_resnorm(xo, WSP(bf16_t, R_F), ffn_post_g + 2048, (const float*)nullptr, xo, H, bid, nblk);
#endif
        PHASE_END
    }
#undef WSP
#undef PHASE_BEGIN
#undef PHASE_END
}

#ifndef MK_N_LAUNCHES
#define MK_N_LAUNCHES 1
#endif
static constexpr int MK_NPHASES = 1 + 3 + 6 + 2 * 9;

extern "C" void kernel_launch(void* const* d_in, const int* in_sizes, int n_in, void* d_out, int out_size, void* d_ws, size_t ws_size, hipStream_t stream) {
    static int grid = 0;
    if (grid == 0) {
        if (n_in != 28 || out_size != NTOK * DM || ws_size < WS_NEED) { fprintf(stderr, "kernel_launch: unexpected shapes (n_in %d out %d ws %zu)\n", n_in, out_size, ws_size); grid = -1; return; }
        int dev = 0, cus = 0, per_cu = 0;
        if (hipGetDevice(&dev) != hipSuccess || hipDeviceGetAttribute(&cus, hipDeviceAttributeMultiprocessorCount, dev) != hipSuccess) { grid = -1; return; }
        if (hipFuncSetAttribute((const void*)k_mega, hipFuncAttributeMaxDynamicSharedMemorySize, MK_LDS) != hipSuccess) { fprintf(stderr, "kernel_launch: hipFuncSetAttribute failed\n"); grid = -1; return; }
        if (hipOccupancyMaxActiveBlocksPerMultiprocessor(&per_cu, (const void*)k_mega, 512, MK_LDS) != hipSuccess || per_cu < 1) { fprintf(stderr, "kernel_launch: occupancy query says %d\n", per_cu); }
        (void)hipGetLastError();
        grid = cus;
        if (grid != 256) { fprintf(stderr, "kernel_launch: built for 256 CUs, found %d\n", grid); grid = -1; return; }
    }
    if (grid < 0) return;
    unsigned char* ws = (unsigned char*)d_ws;
    (void)hipMemsetAsync(ws + WS_BAR, 0, XCD_BAR_WORDS * sizeof(unsigned), stream);
    (void)hipMemsetAsync(ws + W_ABIN + (size_t)5200 * 2048 * 2, 0, (size_t)176 * 2048 * 2, stream);
    (void)hipMemsetAsync(ws + W_CDIN + (size_t)832 * 2048 * 2, 0, (size_t)192 * 2048 * 2, stream);
    MK p{};
    for (int i = 0; i < 28; ++i) p.in[i] = (const float*)d_in[i];
    p.out = (float*)d_out; p.ws = ws;
#if MK_N_LAUNCHES == 1
    p.ph_lo = 0; p.ph_hi = 1 << 20;
    hipLaunchKernelGGL(k_mega, dim3(grid), dim3(512), MK_LDS, stream, p);
#else
    for (int ph = 0; ph < MK_NPHASES; ++ph) { p.ph_lo = ph; p.ph_hi = ph + 1; hipLaunchKernelGGL(k_mega, dim3(grid), dim3(512), MK_LDS, stream, p); }
#endif
}
```

```cpp
#include <hip/hip_runtime.h>
#include <stdint.h>
#include <stdio.h>

#define LAS __attribute__((address_space(3)))
typedef unsigned short bf16_t;
typedef float f32x4 __attribute__((ext_vector_type(4)));
typedef unsigned u32x4 __attribute__((ext_vector_type(4)));
typedef unsigned u32x2 __attribute__((ext_vector_type(2)));

static constexpr int NTOK = 32768, SEQ = 16384, NBATCH = 2, DM = 2048, DFF = 4096;
static constexpr float NORM_EPS = 1e-6f;

__device__ __forceinline__ bf16_t f2bf(float f) { unsigned u = __float_as_uint(f); u += 0x7FFFu + ((u >> 16) & 1u); return (bf16_t)(u >> 16); }
__device__ __forceinline__ float bf2f(bf16_t b) { return __uint_as_float(((unsigned)b) << 16); }
__device__ __forceinline__ unsigned pack2bf(float lo, float hi) { return (unsigned)f2bf(lo) | ((unsigned)f2bf(hi) << 16); }
__device__ __forceinline__ float gelu_tanh(float x) { const float u = 0.7978845608028654f * (x + 0.044715f * x * x * x); return 0.5f * x * (1.0f + tanhf(u)); }
__device__ __forceinline__ float wave_sum(float v) {
#pragma unroll
    for (int o = 32; o >= 1; o >>= 1) v += __shfl_xor(v, o);
    return v;
}

__device__ __forceinline__ int opaque_tid() { int t = (int)threadIdx.x; asm volatile("" : "+v"(t)); return t; }

__device__ __forceinline__ int opaque_s(int v) { asm volatile("" : "+s"(v)); return v; }

#include <hip/hip_runtime.h>
namespace pg8 {
#define PG8_LAS __attribute__((address_space(3)))
typedef unsigned short bf16_t;
typedef short bf16x8 __attribute__((ext_vector_type(8)));
typedef float f32x4 __attribute__((ext_vector_type(4)));
typedef unsigned u32x4 __attribute__((ext_vector_type(4)));
constexpr int BM = 256, BK = 64, HALF = 128, HTB = HALF * BK * 2  , STAGE_BYTES = 8 * HTB, NXCD = 8, WGM = 8;

__host__ __device__ __forceinline__ int lds_byte(int r, int c) { const int st = (r >> 4) * 2 + (c >> 5), rr = r & 15, cc = c & 31, ob = rr * 64 + cc * 2; return st * 1024 + (ob ^ (((ob >> 9) & 1) << 5)); }
__host__ __device__ __forceinline__ void stage_rc(int b, int& R, int& C) { const int st = b / 1024, sb = b % 1024, swz = sb ^ (((sb >> 9) & 1) << 5); R = (st >> 1) * 16 + swz / 64; C = (st & 1) * 32 + (swz % 64) / 2; }
__host__ __device__ __forceinline__ int perm32(int rho) { const int n = rho >> 4, i = rho & 15; return 8 * (i >> 2) + 4 * n + (i & 3); }

struct Unit { int pm, pn; };
struct Gemm { const bf16_t* A; const bf16_t* Bt; int M, N, K, lda, ldb, a_shift, a_bytes, pad_; };

struct StaticOrder {
    int nM, nN, nwg, G, c;
    __host__ __device__ void init(int M, int N, int G_, int c_) { nM = M / BM; nN = N / BM; nwg = nM * nN; G = G_; c = c_; }
    __host__ __device__ bool next(int i, Unit& u) const {
        const long L = (long)i * G + c; if (L >= nwg) return false;
        int wgid = (int)L; { const int q = nwg / NXCD, r = nwg % NXCD, xcd = wgid % NXCD, off = wgid / NXCD; wgid = (xcd < r ? xcd * (q + 1) : r * (q + 1) + (xcd - r) * q) + off; }
        const int nig = WGM * nN, gid = wgid / nig, fm = gid * WGM, gsz = (nM - fm) < WGM ? (nM - fm) : WGM;
        u.pm = fm + ((wgid % nig) % gsz); u.pn = (wgid % nig) / gsz; return true;
    }
    __device__ __forceinline__ void a_ready(const Unit&) const {}
    __device__ __forceinline__ void done(const Unit&) const {}
};

template <class Epi, class Sched, bool STAMP = false>
__device__ __forceinline__ void gemm_phase(PG8_LAS unsigned char* lds, const Gemm g, const Sched& S, const Epi& E, unsigned long long* stamps) {
    const int tid = opaque_tid(), wid = __builtin_amdgcn_readfirstlane(tid >> 6), lane = tid & 63, wr = wid >> 2, wc = wid & 3, fr = lane & 15, fq = lane >> 4;
    const int K = g.K, nt = K / BK;
    int ts_lo = 0, ts_hi = 0, nts = 0; const unsigned long long rt_entry = STAMP ? (unsigned long long)wall_clock64() : 0ull;
#define PG8_STAMP() do { if (STAMP && wid == 0 && nts < 64) { const unsigned long long _c = (unsigned long long)clock64(); \
        ts_lo = (lane == nts) ? (int)(unsigned)_c : ts_lo; ts_hi = (lane == nts) ? (int)(unsigned)(_c >> 32) : ts_hi; ++nts; } } while (0)
    PG8_STAMP();
    unsigned voffA[2], voffB[2];
#pragma unroll
    for (int i = 0; i < 2; ++i) { int R, C; stage_rc(tid * 16 + i * 8192, R, C); const int Rb = Epi::PERM ? ((R & ~31) + perm32(R & 31)) : R;
        voffA[i] = (unsigned)(R * g.lda + C) * 2u; voffB[i] = (unsigned)(Rb * g.ldb + C) * 2u; }
    const size_t kstep = (size_t)(BK * 2);
    const size_t hstepA = (size_t)HALF * g.lda * 2, hstepB = (size_t)HALF * g.ldb * 2;
    const size_t tstepA = 2 * hstepA, tstepB = 2 * hstepB;
    const unsigned ldsw = (unsigned)wid * 1024u;
    const int aoff = lds_byte(wr * 64 + fr, fq * 8), boff = lds_byte(wc * 32 + fr, fq * 8);
#define PG8_SA(b, h) (((b) * 2 + (h)) * HTB)
#define PG8_SB(b, h) ((4 + (b) * 2 + (h)) * HTB)
#define PG8_STAGE(bufoff, gbase, voff) do { _Pragma("unroll") for (int _i = 0; _i < 2; ++_i) \
        __builtin_amdgcn_global_load_lds((const unsigned*)((const char*)(gbase) + (voff)[_i]), (PG8_LAS unsigned*)(lds + (bufoff) + ldsw + _i * 8192), 16, 0, 0); } while (0)
#define PG8_LDA(dst, b, h) do { _Pragma("unroll") for (int m = 0; m < 4; ++m) _Pragma("unroll") for (int k = 0; k < 2; ++k) dst[m][k] = *(const PG8_LAS bf16x8*)(lds + PG8_SA(b, h) + aoff + m * 2048 + k * 1024); } while (0)
#define PG8_LDB(dst, b, h) do { _Pragma("unroll") for (int n = 0; n < 2; ++n) _Pragma("unroll") for (int k = 0; k < 2; ++k) dst[n][k] = *(const PG8_LAS bf16x8*)(lds + PG8_SB(b, h) + boff + n * 2048 + k * 1024); } while (0)
#define PG8_MMA(ai, bj, At, Bt) do { __builtin_amdgcn_s_setprio(1); _Pragma("unroll") for (int m = 0; m < 4; ++m) _Pragma("unroll") for (int n = 0; n < 2; ++n) _Pragma("unroll") for (int k = 0; k < 2; ++k) \
        acc[ai][bj][m][n] = __builtin_amdgcn_mfma_f32_16x16x32_bf16(Bt[n][k], At[m][k], acc[ai][bj][m][n], 0, 0, 0); __builtin_amdgcn_s_setprio(0); } while (0)
#define PG8_WAIT_V(n) asm volatile("s_waitcnt vmcnt(" #n ")" ::: "memory")
#define PG8_WAIT_L(n) asm volatile("s_waitcnt lgkmcnt(" #n ")" ::: "memory")
#define PG8_BAR __builtin_amdgcn_s_barrier()
#define PG8_SCHED __builtin_amdgcn_sched_barrier(0)
    Unit cur, nxt; int ui = 0;
    if (!S.next(0, cur)) return;
    f32x4 acc[2][2][4][2];
#pragma unroll
    for (int a = 0; a < 2; ++a)
#pragma unroll
        for (int b = 0; b < 2; ++b)
#pragma unroll
            for (int m = 0; m < 4; ++m)
#pragma unroll
                for (int n = 0; n < 2; ++n) acc[a][b][m][n] = (f32x4){0.f, 0.f, 0.f, 0.f};
    bf16x8 At[4][2], B0[2][2], B1[2][2];
    const char* cA = (const char*)g.A + (size_t)cur.pm * tstepA + (size_t)(cur.pn >> g.a_shift) * g.a_bytes; const char* cB = (const char*)g.Bt + (size_t)cur.pn * tstepB;
    S.a_ready(cur);
    PG8_STAGE(PG8_SB(0, 0), cB, voffB); PG8_STAGE(PG8_SA(0, 0), cA, voffA); PG8_STAGE(PG8_SB(0, 1), cB + hstepB, voffB); PG8_STAGE(PG8_SA(0, 1), cA + hstepA, voffA);
    if (wr == 1) PG8_BAR;
    PG8_WAIT_V(4); PG8_BAR;
    PG8_STAGE(PG8_SB(1, 0), cB + kstep, voffB); PG8_STAGE(PG8_SA(1, 0), cA + kstep, voffA); PG8_STAGE(PG8_SB(1, 1), cB + hstepB + kstep, voffB);
    PG8_WAIT_V(6); PG8_BAR;
    PG8_STAMP();
    for (;;) {
        const bool has_next = S.next(ui + 1, nxt);
        const char* nA = has_next ? (const char*)g.A + (size_t)nxt.pm * tstepA + (size_t)(nxt.pn >> g.a_shift) * g.a_bytes : cA; const char* nB = has_next ? (const char*)g.Bt + (size_t)nxt.pn * tstepB : cB;
        for (int t = 0; t < nt; t += 2) {
            const bool last = (t == nt - 2);
            const char* a1 = cA + (size_t)(t + 1) * kstep;
            const char* a2 = last ? nA : cA + (size_t)(t + 2) * kstep; const char* b2 = last ? nB : cB + (size_t)(t + 2) * kstep;
            const char* a3 = a2 + kstep; const char* b3 = b2 + kstep;
            if (last && has_next) S.a_ready(nxt);
            PG8_LDB(B0, 0, 0); PG8_SCHED; PG8_LDA(At, 0, 0); PG8_STAGE(PG8_SA(1, 1), a1 + hstepA, voffA);
            PG8_WAIT_L(8); PG8_BAR; PG8_WAIT_L(0); PG8_MMA(0, 0, At, B0); PG8_BAR; PG8_SCHED;
            PG8_LDB(B1, 0, 1); PG8_STAGE(PG8_SB(0, 0), b2, voffB);
            PG8_BAR; PG8_WAIT_L(0); PG8_MMA(0, 1, At, B1); PG8_BAR;
            PG8_LDA(At, 0, 1); PG8_STAGE(PG8_SA(0, 0), a2, voffA);
            PG8_BAR; PG8_WAIT_L(0); PG8_MMA(1, 0, At, B0); PG8_BAR; PG8_SCHED;
            PG8_STAGE(PG8_SB(0, 1), b2 + hstepB, voffB);
            PG8_WAIT_V(6); PG8_BAR; PG8_MMA(1, 1, At, B1); PG8_BAR;
            PG8_LDB(B0, 1, 0); PG8_SCHED; PG8_LDA(At, 1, 0); PG8_STAGE(PG8_SA(0, 1), a2 + hstepA, voffA);
            PG8_WAIT_L(8); PG8_BAR; PG8_WAIT_L(0); PG8_MMA(0, 0, At, B0); PG8_BAR; PG8_SCHED;
            PG8_LDB(B1, 1, 1); PG8_STAGE(PG8_SB(1, 0), b3, voffB);
            PG8_BAR; PG8_WAIT_L(0); PG8_MMA(0, 1, At, B1); PG8_BAR;
            PG8_LDA(At, 1, 1); PG8_STAGE(PG8_SA(1, 0), a3, voffA);
            PG8_BAR; PG8_WAIT_L(0); PG8_MMA(1, 0, At, B0); PG8_BAR; PG8_SCHED;
            PG8_STAGE(PG8_SB(1, 1), b3 + hstepB, voffB);
            PG8_WAIT_V(6); PG8_BAR; PG8_MMA(1, 1, At, B1); PG8_BAR;
        }
        PG8_STAMP();
        if constexpr (!Epi::AFTER_DRAIN) { E(acc, cur, wr, wc, fr, fq); S.done(cur); }
        PG8_STAMP();
        if (!has_next) break;
#pragma unroll
        for (int a = 0; a < 2; ++a)
#pragma unroll
            for (int b = 0; b < 2; ++b)
#pragma unroll
                for (int m = 0; m < 4; ++m)
#pragma unroll
                    for (int n = 0; n < 2; ++n) acc[a][b][m][n] = (f32x4){0.f, 0.f, 0.f, 0.f};
        cur = nxt; cA = nA; cB = nB; ++ui;
    }
    PG8_WAIT_V(0);
    if (wr == 0) PG8_BAR;
    PG8_BAR;
    if constexpr (Epi::AFTER_DRAIN) { E.fused(acc, cur, wr, wc, fr, fq, lds, wid, lane); S.done(cur); }
    PG8_STAMP();
    if (STAMP && wid == 0) { stamps[lane] = lane < nts ? (((unsigned long long)(unsigned)ts_hi << 32) | (unsigned)ts_lo) : 0ull;
        if (lane == 62) stamps[62] = rt_entry; if (lane == 63) stamps[63] = (unsigned long long)wall_clock64(); }
#undef PG8_STAMP
#undef PG8_SA
#undef PG8_SB
#undef PG8_STAGE
#undef PG8_LDA
#undef PG8_LDB
#undef PG8_MMA
#undef PG8_WAIT_V
#undef PG8_WAIT_L
#undef PG8_BAR
#undef PG8_SCHED
}
}

#include <cstdio>
#include <ctime>
#include <cstdlib>
#include <cstring>
#include <cmath>
#include <vector>

template <class F> struct EpiG {
    static constexpr bool PERM = false, AFTER_DRAIN = false;
    F f;
    __device__ __forceinline__ void operator()(const f32x4 (&acc)[2][2][4][2], const pg8::Unit& u, int wr, int wc, int fr, int fq) const {
        const int row0 = u.pm * 256 + wr * 64 + fr, col0 = u.pn * 256 + wc * 32 + 4 * fq;
#pragma unroll
        for (int ai = 0; ai < 2; ++ai)
#pragma unroll
            for (int m = 0; m < 4; ++m)
#pragma unroll
                for (int bj = 0; bj < 2; ++bj)
#pragma unroll
                    for (int n = 0; n < 2; ++n) f(row0 + ai * 128 + m * 16, col0 + bj * 128 + n * 16, acc[ai][bj][m][n]);
    }
};
__device__ __forceinline__ void st_bf16x4(bf16_t* p, f32x4 v) { u32x2 w; w.x = pack2bf(v[0], v[1]); w.y = pack2bf(v[2], v[3]); *(u32x2*)p = w; }
__device__ __forceinline__ void st_f32x4(float* p, f32x4 v) { *(f32x4*)p = v; }

struct FStoreBf16 { bf16_t* O; int ldc; int pad_; __device__ __forceinline__ void operator()(int r, int c, f32x4 v) const { st_bf16x4(O + (size_t)r * ldc + c, v); } };
struct FAbIn { bf16_t *Q, *K, *V; float *QI, *U, *WI; unsigned short* KI16;
    __device__ __forceinline__ void operator()(int r, int c, f32x4 v) const {
        if (c < 1024) st_bf16x4(Q + (size_t)r * 1024 + c, v);
        else if (c < 2048) st_bf16x4(K + (size_t)r * 1024 + (c - 1024), v);
        else if (c < 3072) st_bf16x4(V + (size_t)r * 1024 + (c - 2048), v);
        else if (c < 4096) st_f32x4(QI + (size_t)r * 1024 + (c - 3072), v);
        else if (c < 5120) st_f32x4(U + (size_t)r * 1024 + (c - 4096), v);
        else if (c < 5184) { typedef _Float16 h2 __attribute__((ext_vector_type(2))); union { h2 h; unsigned u; } a, b; a.h = (h2){(_Float16)v[0], (_Float16)v[1]}; b.h = (h2){(_Float16)v[2], (_Float16)v[3]};
            u32x2 w; w.x = a.u; w.y = b.u; *(u32x2*)(KI16 + (size_t)r * 64 + (c - 5120)) = w; }
        else if (c < 5200) st_f32x4(WI + (size_t)r * 16 + (c - 5184), v);
    } };
struct FCdIn { float *CQ, *CKV, *KR; bf16_t *XL, *YG;
    __device__ __forceinline__ void operator()(int r, int c, f32x4 v) const {
        if (c < 512) st_f32x4(CQ + (size_t)r * 512 + c, v);
        else if (c < 768) st_f32x4(CKV + (size_t)r * 256 + (c - 512), v);
        else if (c < 832) st_f32x4(KR + (size_t)r * 64 + (c - 768), v);
        else if (c < 1024) {}
        else if (c < 2048) st_bf16x4(XL + (size_t)r * 1024 + (c - 1024), v);
        else st_bf16x4(YG + (size_t)r * 1024 + (c - 2048), v);
    } };
struct FKvUp { bf16_t *K1, *V1;
    __device__ __forceinline__ void operator()(int r, int c, f32x4 v) const {
        const int h = c >> 8, d = c & 255;
        if (d < 128) st_bf16x4(K1 + (size_t)r * 1536 + h * 192 + d, v);
        else st_bf16x4(V1 + (size_t)r * 1024 + h * 128 + (d - 128), v);
    } };

__device__ __forceinline__ unsigned ord_key(float f) { const unsigned b = __float_as_uint(f); return (b & 0x80000000u) ? ~b : (b | 0x80000000u); }
__device__ __forceinline__ void rope_cs(int pos, int i, float& c, float& s) { const float freq = powf(10000.0f, -(float)i / 32.0f); const float ang = (float)pos * freq; sincosf(ang, &s, &c); }

typedef short bf16x8 __attribute__((ext_vector_type(8)));
typedef float f32x16 __attribute__((ext_vector_type(16)));
__device__ __forceinline__ unsigned cvtpk(float lo, float hi) { unsigned r; asm volatile("v_cvt_pk_bf16_f32 %0, %1, %2" : "=v"(r) : "v"(lo), "v"(hi)); return r; }

__device__ __forceinline__ void transpose_v_tile(LAS unsigned short* tile  , const bf16_t* __restrict__ V, bf16_t* __restrict__ VT, int tileid, int tid) {
    const int tt = tileid >> 4, ct = tileid & 15;
    const int row0 = tt * 64, c0 = ct * 64;
#pragma unroll
    for (int i = 0; i < 2; ++i) { const int r = (tid >> 3) + 32 * i, c = (tid & 7) * 8;
        const u32x4 w = *(const u32x4*)(V + (size_t)(row0 + r) * 1024 + c0 + c);
        LAS unsigned* dst = (LAS unsigned*)(tile + r * 66 + c);
        dst[0] = w.x; dst[1] = w.y; dst[2] = w.z; dst[3] = w.w; }
    __syncthreads();
    { const int d = tid >> 2, part = tid & 3;
      const int b = row0 / SEQ, t0 = row0 % SEQ, col = c0 + d, h = col >> 7, dd = col & 127;
      unsigned short v[16];
#pragma unroll
      for (int p = 0; p < 16; ++p) { const int a = p >> 2, i = p & 3, ka = (a == 1) ? 2 : ((a == 2) ? 1 : a); v[p] = tile[(part * 16 + ka * 4 + i) * 66 + d]; }
      u32x4 w0, w1;
      w0.x = v[0] | ((unsigned)v[1] << 16); w0.y = v[2] | ((unsigned)v[3] << 16); w0.z = v[4] | ((unsigned)v[5] << 16); w0.w = v[6] | ((unsigned)v[7] << 16);
      w1.x = v[8] | ((unsigned)v[9] << 16); w1.y = v[10] | ((unsigned)v[11] << 16); w1.z = v[12] | ((unsigned)v[13] << 16); w1.w = v[14] | ((unsigned)v[15] << 16);
      bf16_t* dst = VT + ((size_t)(b * 8 + h) * 128 + dd) * SEQ + t0 + part * 16;
      *(u32x4*)dst = w0; *(u32x4*)(dst + 8) = w1; }
    __syncthreads();
}
struct AttnArgs { const bf16_t* Q; const bf16_t* K; const bf16_t* VT; const unsigned long long* MT; bf16_t* O; int ldq, ldk, ldo; float sc_log2e; };

template <int DQK, bool MASKED>
__device__ __forceinline__ void attn_item(LAS unsigned char* lds, const AttnArgs& a, int b, int h, int qb) {
    constexpr int NKS = DQK / 16, PK = DQK * 2, PV = 128, KB_BYTES = 64 * PK, VB_BYTES = 128 * PV, STAGE = KB_BYTES + VB_BYTES, NPK = DQK / 8, NKP = (64 * NPK) / 512;
    const int tid = opaque_tid(), lane = tid & 63, w = __builtin_amdgcn_readfirstlane(tid >> 6), n = lane & 31, hf = lane >> 5;
    const int nt = 4 * qb + 4, cw = 4 * qb + (w >> 1);
    const int trow = qb * 256 + w * 32 + n;
    const size_t grow = (size_t)b * SEQ + trow;
    bf16x8 qf[NKS];
    { const bf16_t* qp = a.Q + grow * a.ldq + h * DQK + hf * 8;
#pragma unroll
      for (int ks = 0; ks < NKS; ++ks) qf[ks] = *(const bf16x8*)(qp + ks * 16); }
    f32x16 o[4];
#pragma unroll
    for (int dt = 0; dt < 4; ++dt)
#pragma unroll
        for (int r = 0; r < 16; ++r) o[dt][r] = 0.f;
    float m_run = -INFINITY, l_run = 0.f;
    const float c = a.sc_log2e;
    const bf16_t* Kg = a.K + (size_t)b * SEQ * a.ldk + h * DQK;
    const bf16_t* Vg = a.VT + (size_t)(b * 8 + h) * 128 * SEQ;
    const unsigned long long* Mg = MASKED ? a.MT + (size_t)b * 256 * SEQ + trow : nullptr;
    auto dma = [&](int kt, int buf) {
        LAS unsigned char* kb = lds + buf * STAGE; LAS unsigned char* vb = kb + KB_BYTES;
#pragma unroll
        for (int i = 0; i < NKP; ++i) { const int s = (w + 8 * i) * 64 + lane, r = s / NPK, cp = s % NPK, cc = cp ^ (NPK == 16 ? (r & 15) : ((r >> 1) & 7));
            __builtin_amdgcn_global_load_lds((const unsigned*)(Kg + (size_t)(kt * 64 + r) * a.ldk + cc * 8), (LAS unsigned*)(kb + (w + 8 * i) * 1024), 16, 0, 0); }
#pragma unroll
        for (int i = 0; i < 2; ++i) { const int s = (w + 8 * i) * 64 + lane, d = s >> 3, cp = s & 7, cc = cp ^ ((d >> 1) & 7);
            __builtin_amdgcn_global_load_lds((const unsigned*)(Vg + (size_t)d * SEQ + kt * 64 + cc * 8), (LAS unsigned*)(vb + (w + 8 * i) * 1024), 16, 0, 0); }
    };
    dma(0, 0);
    asm volatile("s_waitcnt vmcnt(0)" ::: "memory");
    __syncthreads();
    for (int kt = 0; kt < nt; ++kt) {
        const bool more = (kt + 1 < nt);
        if (more) dma(kt + 1, (kt + 1) & 1);
        if (kt <= cw) {
            unsigned mlo = 0xFFFFFFFFu, mhi = 0xFFFFFFFFu;
            if (MASKED) { const unsigned long long mw = Mg[(size_t)kt * SEQ]; mlo = (unsigned)mw >> (hf * 4); mhi = (unsigned)(mw >> 32) >> (hf * 4); }
            LAS unsigned char* kb = lds + (kt & 1) * STAGE; LAS unsigned char* vb = kb + KB_BYTES;
            f32x16 s0, s1;
#pragma unroll
            for (int r = 0; r < 16; ++r) { s0[r] = 0.f; s1[r] = 0.f; }
            const int kswz = (NPK == 16) ? (n & 15) : ((n >> 1) & 7);
            const LAS unsigned char* ka = kb + n * PK;
#pragma unroll
            for (int ks = 0; ks < NKS; ++ks) {
                const int po = ((2 * ks + hf) ^ kswz) * 16;
                const bf16x8 a0 = *(const LAS bf16x8*)(ka + po), a1 = *(const LAS bf16x8*)(ka + 32 * PK + po);
                s0 = __builtin_amdgcn_mfma_f32_32x32x16_bf16(a0, qf[ks], s0, 0, 0, 0);
                s1 = __builtin_amdgcn_mfma_f32_32x32x16_bf16(a1, qf[ks], s1, 0, 0, 0);
            }
            if (MASKED) {
#pragma unroll
                for (int r = 0; r < 16; ++r) { const unsigned bit = 1u << ((r >> 2) * 8 + (r & 3));
                    s0[r] = (mlo & bit) ? s0[r] : -INFINITY; s1[r] = (mhi & bit) ? s1[r] : -INFINITY; }
            }
            float mx = fmaxf(s0[0], s1[0]);
#pragma unroll
            for (int r = 1; r < 16; ++r) mx = fmaxf(mx, fmaxf(s0[r], s1[r]));
            mx = fmaxf(mx, __shfl_xor(mx, 32));
            const float m_new = fmaxf(m_run, mx);
            const float m_use = (MASKED && m_new == -INFINITY) ? 0.f : m_new;
            if (__any(m_new > m_run)) {
                const float al = __builtin_amdgcn_exp2f((m_run - m_use) * c);
                l_run *= al;
#pragma unroll
                for (int dt = 0; dt < 4; ++dt)
#pragma unroll
                    for (int r = 0; r < 16; ++r) o[dt][r] *= al;
            }
            m_run = m_new;
            const float mc = m_use * c;
            float ps = 0.f;
#pragma unroll
            for (int r = 0; r < 16; ++r) { s0[r] = __builtin_amdgcn_exp2f(fmaf(s0[r], c, -mc)); s1[r] = __builtin_amdgcn_exp2f(fmaf(s1[r], c, -mc)); ps += s0[r] + s1[r]; }
            l_run += ps;
            bf16x8 pf[4];
            { u32x4 t;
              t.x = cvtpk(s0[0], s0[1]); t.y = cvtpk(s0[2], s0[3]); t.z = cvtpk(s0[4], s0[5]); t.w = cvtpk(s0[6], s0[7]); pf[0] = *(bf16x8*)&t;
              t.x = cvtpk(s0[8], s0[9]); t.y = cvtpk(s0[10], s0[11]); t.z = cvtpk(s0[12], s0[13]); t.w = cvtpk(s0[14], s0[15]); pf[1] = *(bf16x8*)&t;
              t.x = cvtpk(s1[0], s1[1]); t.y = cvtpk(s1[2], s1[3]); t.z = cvtpk(s1[4], s1[5]); t.w = cvtpk(s1[6], s1[7]); pf[2] = *(bf16x8*)&t;
              t.x = cvtpk(s1[8], s1[9]); t.y = cvtpk(s1[10], s1[11]); t.z = cvtpk(s1[12], s1[13]); t.w = cvtpk(s1[14], s1[15]); pf[3] = *(bf16x8*)&t; }
            const int vswz = (n >> 1) & 7;
            const LAS unsigned char* va = vb + n * PV;
#pragma unroll
            for (int g = 0; g < 4; ++g) { const int po = ((2 * g + hf) ^ vswz) * 16;
#pragma unroll
                for (int dt = 0; dt < 4; ++dt) { const bf16x8 vf = *(const LAS bf16x8*)(va + dt * 32 * PV + po); o[dt] = __builtin_amdgcn_mfma_f32_32x32x16_bf16(vf, pf[g], o[dt], 0, 0, 0); } }
        }
        asm volatile("s_waitcnt vmcnt(0)" ::: "memory");
        __syncthreads();
    }
    const float lt = l_run + __shfl_xor(l_run, 32);
    const float inv = 1.0f / lt;
    bf16_t* op = a.O + grow * a.ldo + h * 128 + hf * 4;
#pragma unroll
    for (int dt = 0; dt < 4; ++dt)
#pragma unroll
        for (int r4 = 0; r4 < 4; ++r4) { u32x2 wv; wv.x = cvtpk(o[dt][4 * r4] * inv, o[dt][4 * r4 + 1] * inv); wv.y = cvtpk(o[dt][4 * r4 + 2] * inv, o[dt][4 * r4 + 3] * inv);
            *(u32x2*)(op + dt * 32 + r4 * 8) = wv; }
}
template <int DQK, bool MASKED>
__device__ __forceinline__ void attn_phase(LAS unsigned char* lds, const AttnArgs& a, int bid, int nblk) {
    for (int p = bid; p < 512; p += nblk) {
        const int bh = (p & 7) + 8 * (p >> 8), j = (p >> 3) & 31;
        attn_item<DQK, MASKED>(lds, a, bh >> 3, bh & 7, 63 - j);
        attn_item<DQK, MASKED>(lds, a, bh >> 3, bh & 7, j);
    }
}

typedef _Float16 f16x8 __attribute__((ext_vector_type(8)));
struct IdxArgs { const float* QI; const unsigned short* KI16; const float* WI; unsigned long long* MT; };
static constexpr int IDX_CAP = 640, IDX_CS = 0, IDX_CI = 32 * IDX_CAP * 4, IDX_KT = IDX_CI + 32 * IDX_CAP * 2, IDX_CNT = IDX_KT + 32768, IDX_TAU = IDX_CNT + 128, IDX_LDS = IDX_TAU + 128;
static_assert(IDX_KT % 1024 == 0, "K tile buffers must be 1 KiB aligned");

__device__ __forceinline__ float ord_inv(unsigned T) { return __uint_as_float((T & 0x80000000u) ? (T & 0x7FFFFFFFu) : ~T); }
__device__ __forceinline__ unsigned lane_prefix(unsigned long long m) { return __builtin_amdgcn_mbcnt_hi((unsigned)(m >> 32), __builtin_amdgcn_mbcnt_lo((unsigned)m, 0u)); }
__device__ __forceinline__ float relu_asm(float x) { float y; asm("v_max_f32 %0, 0, %1" : "=v"(y) : "v"(x)); return y; }
__device__ __forceinline__ void glds16(const void* gsrc, unsigned lds_dst) {
    unsigned keep;
    asm volatile("s_mov_b32 %0, m0\n\ts_mov_b32 m0, %2\n\ts_nop 0\n\tglobal_load_lds_dwordx4 %1, off\n\ts_mov_b32 m0, %0" : "=&s"(keep) : "v"(gsrc), "s"(lds_dst) : "memory");
}

template <bool EXACT> __device__ __forceinline__ void idx_compact(LAS unsigned char* lds, int qq, int lane) {
    LAS float* cs = (LAS float*)(lds + IDX_CS) + qq * IDX_CAP; LAS unsigned short* ci = (LAS unsigned short*)(lds + IDX_CI) + qq * IDX_CAP;
    LAS unsigned* cnt = (LAS unsigned*)(lds + IDX_CNT); LAS float* tau = (LAS float*)(lds + IDX_TAU);
    const int n = (int)cnt[qq];
    float sv[10]; unsigned short iv[10]; unsigned uk[10]; unsigned kmax = 0u;
#pragma unroll
    for (int j = 0; j < 10; ++j) { const int idx = lane + 64 * j; const bool valid = idx < n; sv[j] = cs[idx]; iv[j] = ci[idx]; uk[j] = valid ? ord_key(sv[j]) : 0u; kmax = uk[j] > kmax ? uk[j] : kmax; }
#pragma unroll
    for (int o = 32; o >= 1; o >>= 1) { const unsigned t = (unsigned)__shfl_xor((int)kmax, o); kmax = t > kmax ? t : kmax; }
    unsigned lo = ord_key(tau[qq]), hi = kmax + 1u;
    while (hi - lo > 1u) {
        const unsigned mid = lo + ((hi - lo) >> 1); int c = 0;
#pragma unroll
        for (int j = 0; j < 10; ++j) c += __builtin_popcountll(__ballot(uk[j] >= mid));
        if (c >= 256) { lo = mid; if (!EXACT && c <= 336) break; } else hi = mid;
    }
    const unsigned T = lo;
    int need = 0;
    if (EXACT) { int ngt = 0;
#pragma unroll
        for (int j = 0; j < 10; ++j) ngt += __builtin_popcountll(__ballot(uk[j] > T));
        need = 256 - ngt; }
    int base = 0, tiebase = 0;
#pragma unroll
    for (int j = 0; j < 10; ++j) {
        bool keep;
        if (EXACT) { const bool gt = uk[j] > T, eq = uk[j] == T; const unsigned long long em = __ballot(eq); keep = gt || (eq && (tiebase + (int)lane_prefix(em)) < need); tiebase += __builtin_popcountll(em); }
        else keep = uk[j] >= T;
        const unsigned long long km = __ballot(keep);
        const int pos = base + (int)lane_prefix(km);
        if (keep) { cs[pos] = sv[j]; ci[pos] = iv[j]; }
        base += __builtin_popcountll(km);
    }
    if (lane == 0) { cnt[qq] = (unsigned)base; tau[qq] = ord_inv(T); }
}

__device__ __forceinline__ void idx_item(LAS unsigned char* lds, const IdxArgs& a, int b, int hc) {
    const int tid = opaque_tid(), lane = tid & 63, w = __builtin_amdgcn_readfirstlane(tid >> 6), n = lane & 31, hf = lane >> 5;
    const int t0 = hc * 32, L = (t0 / 64 + 1) * 64, nsub = L / 32, ntile = (L + 127) / 128;
    const size_t q0 = (size_t)b * SEQ + t0 + 4 * w;
    LAS float* cs = (LAS float*)(lds + IDX_CS); LAS unsigned short* ci = (LAS unsigned short*)(lds + IDX_CI);
    LAS unsigned* cnt = (LAS unsigned*)(lds + IDX_CNT); LAS float* tau = (LAS float*)(lds + IDX_TAU);
    f16x8 qf[2][4];
#pragma unroll
    for (int rt = 0; rt < 2; ++rt) { const float* qp = a.QI + (q0 + 2 * rt + (n >> 4)) * 1024 + (n & 15) * 64 + hf * 8;
#pragma unroll
        for (int ks = 0; ks < 4; ++ks) { const f32x4 x0 = *(const f32x4*)(qp + ks * 16), x1 = *(const f32x4*)(qp + ks * 16 + 4);
            f16x8 v; v[0] = (_Float16)x0[0]; v[1] = (_Float16)x0[1]; v[2] = (_Float16)x0[2]; v[3] = (_Float16)x0[3]; v[4] = (_Float16)x1[0]; v[5] = (_Float16)x1[1]; v[6] = (_Float16)x1[2]; v[7] = (_Float16)x1[3];
            qf[rt][ks] = v; } }
    float wv[2][16];
#pragma unroll
    for (int rt = 0; rt < 2; ++rt)
#pragma unroll
        for (int r = 0; r < 16; ++r) wv[rt][r] = a.WI[(q0 + 2 * rt + (r >> 3)) * 16 + (((r & 3) + 8 * (r >> 2) + 4 * hf) & 15)] * (0.125f * 0.25f);
    if (tid < 32) { cnt[tid] = 0u; tau[tid] = -INFINITY; }
    float tau0 = INFINITY, tau1 = INFINITY;
    const unsigned short* Kg = a.KI16 + (size_t)b * SEQ * 64;
    const unsigned ldsbase = (unsigned)(size_t)lds;
    auto dma = [&](int kt, int buf) {
#pragma unroll
        for (int i = 0; i < 2; ++i) { const int s = (w + 8 * i) * 64 + lane, r = s >> 3, cp = s & 7, cc = cp ^ ((r >> 1) & 7);
            glds16(Kg + (size_t)(kt * 128 + r) * 64 + cc * 8, ldsbase + IDX_KT + buf * 16384 + (w + 8 * i) * 1024); }
    };
    dma(0, 0);
    asm volatile("s_waitcnt vmcnt(0)" ::: "memory");
    __syncthreads();
    const int kswz = (n >> 1) & 7;
    f32x16 accA[2], accB[2];
#pragma unroll
    for (int rt = 0; rt < 2; ++rt)
#pragma unroll
        for (int r = 0; r < 16; ++r) { accA[rt][r] = 0.f; accB[rt][r] = 0.f; }
    int keyA = 0, keyB = 0;
    auto epilogue = [&](const f32x16 (&acc)[2], int key) {
        float sc[2];
#pragma unroll
        for (int rt = 0; rt < 2; ++rt) { float pa = 0.f, pb = 0.f;
#pragma unroll
            for (int r = 0; r < 8; ++r) { pa = fmaf(relu_asm(acc[rt][r]), wv[rt][r], pa); pb = fmaf(relu_asm(acc[rt][r + 8]), wv[rt][r + 8], pb); }
            const auto rr = __builtin_amdgcn_permlane32_swap(__float_as_uint(pa), __float_as_uint(pb), false, false);
            sc[rt] = __uint_as_float(rr[0]) + __uint_as_float(rr[1]); }
        const bool c0 = sc[0] > tau0, c1 = sc[1] > tau1;
        if (__ballot(c0 || c1)) {
            if (c0) { const int qq = 4 * w + hf; const unsigned pos = __hip_atomic_fetch_add(cnt + qq, 1u, __ATOMIC_RELAXED, __HIP_MEMORY_SCOPE_WORKGROUP);
                if (pos < (unsigned)IDX_CAP) { cs[qq * IDX_CAP + pos] = sc[0]; ci[qq * IDX_CAP + pos] = (unsigned short)key; } }
            if (c1) { const int qq = 4 * w + 2 + hf; const unsigned pos = __hip_atomic_fetch_add(cnt + qq, 1u, __ATOMIC_RELAXED, __HIP_MEMORY_SCOPE_WORKGROUP);
                if (pos < (unsigned)IDX_CAP) { cs[qq * IDX_CAP + pos] = sc[1]; ci[qq * IDX_CAP + pos] = (unsigned short)key; } }
        }
    };
    auto mma = [&](f32x16 (&acc)[2], const LAS unsigned char* kr) {
        f16x8 kf[4];
#pragma unroll
        for (int ks = 0; ks < 4; ++ks) kf[ks] = *(const LAS f16x8*)(kr + ((2 * ks + hf) ^ kswz) * 16);
#pragma unroll
        for (int rt = 0; rt < 2; ++rt) {
            f32x16 c;
#pragma unroll
            for (int r = 0; r < 16; ++r) c[r] = 0.f;
#pragma unroll
            for (int ks = 0; ks < 4; ++ks) c = __builtin_amdgcn_mfma_f32_32x32x16_f16(qf[rt][ks], kf[ks], c, 0, 0, 0);
            acc[rt] = c; }
    };
    for (int kt = 0; kt < ntile; ++kt) {
        if (kt + 1 < ntile) dma(kt + 1, (kt + 1) & 1);
        { const unsigned c_all = cnt[lane & 31];
          if (__ballot(c_all > (unsigned)(IDX_CAP - 160))) {
#pragma unroll 1
              for (int i = 0; i < 4; ++i) { const int qq = 4 * w + i; if (cnt[qq] > 400u) idx_compact<false>(lds, qq, lane); }
              if (kt > 0) { tau0 = tau[4 * w + hf]; tau1 = tau[4 * w + 2 + hf]; }
          } }
        const LAS unsigned char* kb = lds + IDX_KT + (kt & 1) * 16384 + n * 128;
        const int sbase = kt * 4;
        if (sbase + 0 < nsub) { mma(accA, kb); epilogue(accB, keyB); keyA = kt * 128 + n; if (kt == 0) { tau0 = -INFINITY; tau1 = -INFINITY; } }
        if (sbase + 1 < nsub) { mma(accB, kb + 32 * 128); epilogue(accA, keyA); keyB = kt * 128 + 32 + n; }
        if (sbase + 2 < nsub) { mma(accA, kb + 64 * 128); epilogue(accB, keyB); keyA = kt * 128 + 64 + n; }
        if (sbase + 3 < nsub) { mma(accB, kb + 96 * 128); epilogue(accA, keyA); keyB = kt * 128 + 96 + n; }
        asm volatile("s_waitcnt vmcnt(0)" ::: "memory");
        __syncthreads();
    }
    epilogue(accB, keyB);
    __syncthreads();
    LAS unsigned* bm = (LAS unsigned*)(lds + IDX_KT) + w * 512;
#pragma unroll 1
    for (int i = 0; i < 4; ++i) {
        const int qq = 4 * w + i;
        if (cnt[qq] > 256u) idx_compact<true>(lds, qq, lane);
        const int nsel = (int)cnt[qq];
#pragma unroll
        for (int j = 0; j < 8; ++j) bm[lane + 64 * j] = 0u;
#pragma unroll
        for (int j = 0; j < 4; ++j) { const int idx = lane + 64 * j; if (idx < nsel) { const unsigned k = ci[qq * IDX_CAP + idx]; (void)__hip_atomic_fetch_or(bm + (k >> 5), 1u << (k & 31), __ATOMIC_RELAXED, __HIP_MEMORY_SCOPE_WORKGROUP); } }
        const int tq = t0 + qq;
#pragma unroll 1
        for (int kt = lane; kt < L / 64; kt += 64) { const unsigned long long v = (unsigned long long)bm[2 * kt] | ((unsigned long long)bm[2 * kt + 1] << 32); a.MT[((size_t)b * 256 + kt) * SEQ + tq] = v; }
    }
    __syncthreads();
}
__device__ __forceinline__ void idx_phase(LAS unsigned char* lds, const IdxArgs& a, int bid, int nblk) {
    for (int k = bid; k < 256; k += nblk) {
#pragma unroll 1
        for (int i = 0; i < 4; ++i) idx_item(lds, a, i & 1, (i < 2) ? 511 - k : k);
    }
}
#define XB_TMO      128
#define XB_XCNT(j)  (256  + 64 * (j))
#define XB_XSUB(j)  (1280 + 64 * (j))
#define XB_XGEN(j)  (2304 + 64 * (j))
#define XB_TOP      3328
#define XB_TOPGEN   3392
#define XCD_BAR_WORDS 3456
#define XB_SPIN_CAP (1u << 23)


__device__ __forceinline__ unsigned xb_ld(unsigned* p)              { return __hip_atomic_load(p, __ATOMIC_RELAXED, __HIP_MEMORY_SCOPE_AGENT); }
__device__ __forceinline__ unsigned xb_add(unsigned* p, unsigned v) { return __hip_atomic_fetch_add(p, v, __ATOMIC_RELAXED, __HIP_MEMORY_SCOPE_AGENT); }
__device__ __forceinline__ unsigned xb_xcc_id() { return (unsigned)__builtin_amdgcn_s_getreg((3 << 11) | 20) & 0xFu; }
#define XB_SPIN(cond, bar) do { unsigned _sp = 0; while (cond) { __builtin_amdgcn_s_sleep(1); \
    if ((++_sp & 255u) == 0u) { if (xb_ld(&(bar)[XB_TMO])) break; if (_sp > XB_SPIN_CAP) { atomicAdd(&(bar)[XB_TMO], 1u); break; } } } } while (0)

struct XcdBarrier {
    unsigned* bar; unsigned x;
    volatile LAS unsigned* st;
};

__device__ __forceinline__ XcdBarrier xcd_barrier_post(unsigned* bar, volatile LAS unsigned* st) {
    XcdBarrier b; b.bar = bar; b.x = xb_xcc_id(); b.st = st;
    if (threadIdx.x == 0) (void)xb_add(&bar[XB_XCNT(b.x)], 1u);
    return b;
}
__device__ __forceinline__ void xcd_barrier_complete(unsigned* bar, unsigned x, unsigned& nloc, unsigned& nx) {
    const unsigned G = gridDim.x * gridDim.y * gridDim.z;
    unsigned sum, cnt, mine, sp = 0u;
    for (;;) {
        sum = 0u; cnt = 0u; mine = 0u;
#pragma unroll
        for (unsigned j = 0; j < 16; ++j) { const unsigned c = xb_ld(&bar[XB_XCNT(j)]); sum += c; cnt += (c > 0u) ? 1u : 0u; mine = (j == x) ? c : mine; }
        if (sum == G) break;
        __builtin_amdgcn_s_sleep(1);
        if ((++sp & 255u) == 0u) { if (xb_ld(&bar[XB_TMO])) break; if (sp > XB_SPIN_CAP) { atomicAdd(&bar[XB_TMO], 1u); break; } }
    }
    nloc = mine > 0u ? mine : 1u; nx = cnt > 0u ? cnt : 1u;
}

__device__ __forceinline__ void xcd_barrier(const XcdBarrier& b) {
    asm volatile("s_waitcnt vmcnt(0)" ::: "memory");
    __syncthreads();
    if (threadIdx.x == 0) {
        unsigned* bar = b.bar;
        __builtin_amdgcn_s_waitcnt(0);
        unsigned nloc = b.st[0], nx = b.st[1];
        if (nloc == 0u) { xcd_barrier_complete(bar, b.x, nloc, nx); b.st[0] = nloc; b.st[1] = nx; }
        const unsigned old = xb_add(&bar[XB_XSUB(b.x)], 1u);
        const unsigned gen = old / nloc;
        if (old + 1u == (gen + 1u) * nloc) {
            __builtin_amdgcn_fence(__ATOMIC_RELEASE, "agent");
            asm volatile("s_waitcnt vmcnt(0)" ::: "memory");
            const unsigned og = xb_add(&bar[XB_TOP], 1u);
            const unsigned tg = og / nx;
            if (og + 1u == (tg + 1u) * nx) xb_add(&bar[XB_TOPGEN], 1u);
            else XB_SPIN(xb_ld(&bar[XB_TOPGEN]) == tg, bar);
            __builtin_amdgcn_fence(__ATOMIC_ACQUIRE, "agent");
            xb_add(&bar[XB_XGEN(b.x)], 1u);
            asm volatile("s_waitcnt vmcnt(0)" ::: "memory");
        } else {
            XB_SPIN(xb_ld(&bar[XB_XGEN(b.x)]) == gen, bar);
            __builtin_amdgcn_fence(__ATOMIC_ACQUIRE, "agent");
            asm volatile("s_waitcnt vmcnt(0)" ::: "memory");
        }
    }
    __syncthreads();
}

#ifndef SKIPMASK
#define SKIPMASK 0
#endif

__device__ __forceinline__ int perm16(int t) { const int a = (t >> 2) & 3; return (t & ~12) | ((a == 1 ? 2 : (a == 2 ? 1 : a)) << 2); }
__device__ __forceinline__ void st_vt(bf16_t* VT, int row, int h, int d, f32x4 v) {
    const int b = row / SEQ, t = row % SEQ; bf16_t* p = VT + ((size_t)(b * 8 + h) * 128 + d) * SEQ + (t & ~15) + perm16(t & 15);
    p[0] = f2bf(v[0]); p[SEQ] = f2bf(v[1]); p[2 * (size_t)SEQ] = f2bf(v[2]); p[3 * (size_t)SEQ] = f2bf(v[3]);
}
struct FAbIn2 { bf16_t *Q, *K, *VT; float *QI, *U, *WI; unsigned short* KI16;
    __device__ __forceinline__ void operator()(int r, int c, f32x4 v) const {
        if (c < 1024) st_bf16x4(Q + (size_t)r * 1024 + c, v);
        else if (c < 2048) st_bf16x4(K + (size_t)r * 1024 + (c - 1024), v);
        else if (c < 3072) st_vt(VT, r, (c - 2048) >> 7, (c - 2048) & 127, v);
        else if (c < 4096) st_f32x4(QI + (size_t)r * 1024 + (c - 3072), v);
        else if (c < 5120) st_f32x4(U + (size_t)r * 1024 + (c - 4096), v);
        else if (c < 5184) { typedef _Float16 h2 __attribute__((ext_vector_type(2))); union { h2 h; unsigned u; } a, b; a.h = (h2){(_Float16)v[0], (_Float16)v[1]}; b.h = (h2){(_Float16)v[2], (_Float16)v[3]};
            u32x2 w; w.x = a.u; w.y = b.u; *(u32x2*)(KI16 + (size_t)r * 64 + (c - 5120)) = w; }
        else if (c < 5200) st_f32x4(WI + (size_t)r * 16 + (c - 5184), v);
    } };
struct FKvUp2 { bf16_t *K1, *VT;
    __device__ __forceinline__ void operator()(int r, int c, f32x4 v) const {
        const int h = c >> 8, d = c & 255;
        if (d < 128) st_bf16x4(K1 + (size_t)r * 1536 + h * 192 + d, v);
        else st_vt(VT, r, h, d - 128, v);
    } };

template <class E> __device__ __forceinline__ void ph_gemm_e(LAS unsigned char* lds, const bf16_t* A, int lda, const bf16_t* Bt, int ldb, int M, int N, int K, const E& e, int bid, int nblk, int a_shift = 0, int a_bytes = 0) {
    pg8::Gemm g; g.A = A; g.Bt = Bt; g.M = M; g.N = N; g.K = K; g.lda = lda; g.ldb = ldb; g.a_shift = a_shift; g.a_bytes = a_bytes; g.pad_ = 0;
    pg8::StaticOrder S; S.init(M, N, nblk, bid);
    pg8::gemm_phase<E, pg8::StaticOrder, false>(lds, g, S, e, nullptr);
    __syncthreads();
}
template <class F> __device__ __forceinline__ void ph_gemm(LAS unsigned char* lds, const bf16_t* A, int lda, const bf16_t* Bt, int ldb, int M, int N, int K, const F& f, int bid, int nblk, int a_shift = 0, int a_bytes = 0) {
    EpiG<F> e; e.f = f;
    ph_gemm_e(lds, A, lda, Bt, ldb, M, N, K, e, bid, nblk, a_shift, a_bytes);
}
struct FPool { bf16_t* CC; const float* pb; const float* ps;
    __device__ __forceinline__ void operator()(int r, int c, f32x4 v) const { const f32x4 b = *(const f32x4*)(pb + c), s = *(const f32x4*)(ps + c); st_bf16x4(CC + (size_t)r * 2048 + 1024 + c, (v + b) * s); } };
struct EpiLru {
    static constexpr bool PERM = false, AFTER_DRAIN = false;
    const bf16_t* XCB; const float *ba, *bx, *lam; float *LA, *LB;
    __device__ __forceinline__ void operator()(const f32x4 (&acc)[2][2][4][2], const pg8::Unit& u, int wr, int wc, int fr, int fq) const {
        const int row0 = u.pm * 256 + wr * 64 + fr;
#pragma unroll
        for (int n = 0; n < 2; ++n) {
            const int ch = u.pn * 128 + wc * 32 + 16 * n + 4 * fq;
            const f32x4 bav = *(const f32x4*)(ba + ch), bxv = *(const f32x4*)(bx + ch), lm = *(const f32x4*)(lam + ch);
            f32x4 sp;
#pragma unroll
            for (int j = 0; j < 4; ++j) sp[j] = log1pf(__expf(-lm[j]));
#pragma unroll
            for (int ai = 0; ai < 2; ++ai)
#pragma unroll
                for (int m = 0; m < 4; ++m) {
                    const int row = row0 + ai * 128 + m * 16;
                    const u32x2 xw = *(const u32x2*)(XCB + (size_t)row * 1024 + ch);
                    const f32x4 xc = {__uint_as_float(xw.x << 16), __uint_as_float(xw.x & 0xFFFF0000u), __uint_as_float(xw.y << 16), __uint_as_float(xw.y & 0xFFFF0000u)};
                    const f32x4 ga = acc[ai][0][m][n] + bav, gx = acc[ai][1][m][n] + bxv;
                    f32x4 av, bv;
#pragma unroll
                    for (int j = 0; j < 4; ++j) {
                        const float rg = 1.0f / (1.0f + __expf(-ga[j])), ig = 1.0f / (1.0f + __expf(-gx[j]));
                        const float log_a = -8.0f * rg * sp[j], a = __expf(log_a), mult = sqrtf(-expm1f(2.0f * log_a));
                        av[j] = a; bv[j] = mult * (ig * xc[j]);
                    }
                    *(f32x4*)(LA + (size_t)row * 1024 + ch) = av; *(f32x4*)(LB + (size_t)row * 1024 + ch) = bv;
                }
        }
    }
};
__device__ __forceinline__ void ph_pooled(const float* __restrict__ U, bf16_t* __restrict__ P, int bid, int nblk) {
    for (int i = bid * 512 + opaque_tid(); i < NTOK * 256; i += nblk * 512) {
        const int c4 = i & 255, row = i >> 8, t = row % SEQ, g = c4 >> 6, win = 2 << g, cnt = (t + 1 < win) ? (t + 1) : win;
        const f32x4* up = (const f32x4*)U + (size_t)row * 256 + c4;
        const f32x4 u0 = up[0]; f32x4 s = u0;
        for (int k = 1; k < cnt; ++k) s += up[-(ptrdiff_t)k * 256];
        st_bf16x4(P + (size_t)row * 1024 + c4 * 4, s * (1.0f / (float)cnt) - u0);
    }
}
__device__ __forceinline__ void ph_xc(const bf16_t* __restrict__ XL, const float* __restrict__ cw, const float* __restrict__ cb, bf16_t* __restrict__ XCB, int bid, int nblk) {
    for (int i = bid * 512 + opaque_tid(); i < 128 * (NTOK / 32); i += nblk * 512) {
        const int c8 = (i & 127) * 8, row0 = (i >> 7) * 32, t0 = row0 % SEQ;
        float w0[8], w1[8], w2[8], w3[8], bb[8];
#pragma unroll
        for (int j = 0; j < 8; ++j) { w0[j] = cw[c8 + j]; w1[j] = cw[1024 + c8 + j]; w2[j] = cw[2048 + c8 + j]; w3[j] = cw[3072 + c8 + j]; bb[j] = cb[c8 + j]; }
        u32x4 p3 = {0u, 0u, 0u, 0u}, p2 = p3, p1 = p3;
        if (t0 >= 3) { p3 = *(const u32x4*)(XL + (size_t)(row0 - 3) * 1024 + c8); p2 = *(const u32x4*)(XL + (size_t)(row0 - 2) * 1024 + c8); p1 = *(const u32x4*)(XL + (size_t)(row0 - 1) * 1024 + c8); }
        for (int r = 0; r < 32; ++r) {
            const u32x4 cur = *(const u32x4*)(XL + (size_t)(row0 + r) * 1024 + c8);
            const unsigned a3[4] = {p3.x, p3.y, p3.z, p3.w}, a2[4] = {p2.x, p2.y, p2.z, p2.w}, a1[4] = {p1.x, p1.y, p1.z, p1.w}, a0[4] = {cur.x, cur.y, cur.z, cur.w};
            float y[8];
#pragma unroll
            for (int j = 0; j < 4; ++j) {
                y[2 * j] = bb[2 * j] + w0[2 * j] * __uint_as_float(a3[j] << 16) + w1[2 * j] * __uint_as_float(a2[j] << 16) + w2[2 * j] * __uint_as_float(a1[j] << 16) + w3[2 * j] * __uint_as_float(a0[j] << 16);
                y[2 * j + 1] = bb[2 * j + 1] + w0[2 * j + 1] * __uint_as_float(a3[j] & 0xFFFF0000u) + w1[2 * j + 1] * __uint_as_float(a2[j] & 0xFFFF0000u) + w2[2 * j + 1] * __uint_as_float(a1[j] & 0xFFFF0000u) + w3[2 * j + 1] * __uint_as_float(a0[j] & 0xFFFF0000u); }
            u32x4 o; o.x = pack2bf(y[0], y[1]); o.y = pack2bf(y[2], y[3]); o.z = pack2bf(y[4], y[5]); o.w = pack2bf(y[6], y[7]);
            *(u32x4*)(XCB + (size_t)(row0 + r) * 1024 + c8) = o;
            p3 = p2; p2 = p1; p1 = cur;
        }
    }
}
__device__ __forceinline__ void ph_convT(LAS unsigned char* lds, const float* __restrict__ W, int ldw, int src_col0, int ncols, int K, bf16_t* __restrict__ Bt, int ldd, int bid, int nblk) {
    const int tid = opaque_tid(), sub = tid >> 8, t8 = tid & 255, tx = t8 & 31, ty = t8 >> 5;
    LAS float* tile = (LAS float*)lds + sub * (32 * 33);
    const int ntx = (ncols + 31) / 32, ntiles = ntx * (K / 32);
    for (int base = bid * 2; base < ntiles; base += nblk * 2) {
        const int tl = base + sub; const bool act = tl < ntiles;
        const int n0 = (tl % ntx) * 32, k0 = (tl / ntx) * 32;
        if (act) {
#pragma unroll
            for (int i = 0; i < 4; ++i) { const int k = k0 + ty + 8 * i, n = n0 + tx; tile[(ty + 8 * i) * 33 + tx] = (n < ncols) ? W[(size_t)k * ldw + src_col0 + n] : 0.f; } }
        __syncthreads();
        if (act) {
#pragma unroll
            for (int i = 0; i < 4; ++i) { const int n = n0 + ty + 8 * i, k = k0 + tx; if (n < ncols) Bt[(size_t)n * ldd + k] = f2bf(tile[tx * 33 + ty + 8 * i]); } }
        __syncthreads();
    }
}
template <int NC> __device__ __forceinline__ void ph_rmsnorm(const float* __restrict__ x, const float* __restrict__ g, bf16_t* __restrict__ out, int bid, int nblk) {
    const int lane = opaque_tid() & 63, w = opaque_tid() >> 6;
    constexpr int NV = NC / 256;
    for (int row = bid * 8 + w; row < NTOK; row += nblk * 8) {
        const f32x4* xr = (const f32x4*)(x + (size_t)row * NC);
        f32x4 v[NV]; float ss = 0.f;
#pragma unroll
        for (int i = 0; i < NV; ++i) { v[i] = xr[lane + 64 * i]; ss += v[i][0] * v[i][0] + v[i][1] * v[i][1] + v[i][2] * v[i][2] + v[i][3] * v[i][3]; }
        ss = wave_sum(ss);
        const float r = rsqrtf(ss * (1.0f / NC) + NORM_EPS);
#pragma unroll
        for (int i = 0; i < NV; ++i) { const f32x4 gg = ((const f32x4*)g)[lane + 64 * i]; st_bf16x4(out + (size_t)row * NC + 4 * (lane + 64 * i), v[i] * r * gg); }
    }
}
__device__ __forceinline__ void ph_resnorm(const float* xin, const bf16_t* __restrict__ m, const float* __restrict__ gpost, const float* __restrict__ gpre, float* xout, bf16_t* __restrict__ h, int bid, int nblk) {
    const int lane = opaque_tid() & 63, w = opaque_tid() >> 6;
    for (int row = bid * 8 + w; row < NTOK; row += nblk * 8) {
        const f32x4* xr = (const f32x4*)(xin + (size_t)row * DM);
        const u32x2* mr = (const u32x2*)(m + (size_t)row * DM);
        f32x4 mv[8], xv[8]; float ss = 0.f;
#pragma unroll
        for (int i = 0; i < 8; ++i) { const u32x2 wd = mr[lane + 64 * i]; mv[i][0] = __uint_as_float(wd.x << 16); mv[i][1] = __uint_as_float(wd.x & 0xFFFF0000u); mv[i][2] = __uint_as_float(wd.y << 16); mv[i][3] = __uint_as_float(wd.y & 0xFFFF0000u);
            xv[i] = xr[lane + 64 * i]; ss += mv[i][0] * mv[i][0] + mv[i][1] * mv[i][1] + mv[i][2] * mv[i][2] + mv[i][3] * mv[i][3]; }
        ss = wave_sum(ss);
        const float r1 = rsqrtf(ss * (1.0f / DM) + NORM_EPS);
        float s2 = 0.f;
#pragma unroll
        for (int i = 0; i < 8; ++i) { const f32x4 gg = ((const f32x4*)gpost)[lane + 64 * i]; xv[i] = xv[i] + mv[i] * r1 * gg; ((f32x4*)(xout + (size_t)row * DM))[lane + 64 * i] = xv[i];
            s2 += xv[i][0] * xv[i][0] + xv[i][1] * xv[i][1] + xv[i][2] * xv[i][2] + xv[i][3] * xv[i][3]; }
        if (gpre) {
            s2 = wave_sum(s2);
            const float r2 = rsqrtf(s2 * (1.0f / DM) + NORM_EPS);
#pragma unroll
            for (int i = 0; i < 8; ++i) { const f32x4 gg = ((const f32x4*)gpre)[lane + 64 * i]; st_bf16x4(h + (size_t)row * DM + 4 * (lane + 64 * i), xv[i] * r2 * gg); }
        }
    }
}
__device__ __forceinline__ void ph_scan1(const float* __restrict__ Aa, const float* __restrict__ Bb, float* __restrict__ CA, float* __restrict__ CH, int bid, int nblk) {
    for (int i = bid * 512 + opaque_tid(); i < 2 * 256 * 1024; i += nblk * 512) {
        const int ch = i & 1023, chunk = (i >> 10) & 255, b = i >> 18;
        const size_t base = ((size_t)b * SEQ + (size_t)chunk * 64) * 1024 + ch;
        float h = 0.f, P = 1.f;
        for (int s = 0; s < 64; ++s) { const float a = Aa[base + (size_t)s * 1024]; h = a * h + Bb[base + (size_t)s * 1024]; P *= a; }
        CA[i] = P; CH[i] = h;
    }
}
__device__ __forceinline__ void ph_scan2(const float* __restrict__ CA, const float* __restrict__ CH, float* __restrict__ CIN, int bid, int nblk) {
    for (int i = bid * 512 + opaque_tid(); i < 2048; i += nblk * 512) {
        const int ch = i & 1023, b = i >> 10;
        float h = 0.f;
        for (int c = 0; c < 256; ++c) { const int j = (b * 256 + c) * 1024 + ch; CIN[j] = h; h = CA[j] * h + CH[j]; }
    }
}
__device__ __forceinline__ void ph_scan3(const float* __restrict__ Aa, const float* __restrict__ Bb, const float* __restrict__ CIN, const bf16_t* __restrict__ YG, bf16_t* __restrict__ CC, int bid, int nblk) {
    for (int i = bid * 512 + opaque_tid(); i < 2 * 256 * 1024; i += nblk * 512) {
        const int ch = i & 1023, chunk = (i >> 10) & 255, b = i >> 18;
        const size_t row0 = (size_t)b * SEQ + (size_t)chunk * 64;
        float h = CIN[i];
        for (int s = 0; s < 64; ++s) { const size_t r = row0 + s; h = Aa[r * 1024 + ch] * h + Bb[r * 1024 + ch];
            CC[r * 2048 + 1024 + ch] = f2bf(h * gelu_tanh(bf2f(YG[r * 1024 + ch]))); }
    }
}
__device__ __forceinline__ void ph_rope_q(bf16_t* __restrict__ Q1, const int* __restrict__ pos, int bid, int nblk) {
    for (int idx = bid * 512 + opaque_tid(); idx < NTOK * 8 * 32; idx += nblk * 512) {
        const int i = idx & 31, h = (idx >> 5) & 7, row = idx >> 8;
        float c, s; rope_cs(pos[row], i, c, s);
        bf16_t* p = Q1 + (size_t)row * 1536 + h * 192 + 128;
        const float x1 = bf2f(p[i]), x2 = bf2f(p[32 + i]);
        p[i] = f2bf(x1 * c - x2 * s); p[32 + i] = f2bf(x2 * c + x1 * s);
    }
}
__device__ __forceinline__ void ph_rope_k(const float* __restrict__ KR, const int* __restrict__ pos, bf16_t* __restrict__ K1, int bid, int nblk) {
    for (int idx = bid * 512 + opaque_tid(); idx < NTOK * 32; idx += nblk * 512) {
        const int i = idx & 31, row = idx >> 5;
        float c, s; rope_cs(pos[row], i, c, s);
        const float x1 = KR[(size_t)row * 64 + i], x2 = KR[(size_t)row * 64 + 32 + i];
        const bf16_t o1 = f2bf(x1 * c - x2 * s), o2 = f2bf(x2 * c + x1 * s);
#pragma unroll
        for (int h = 0; h < 8; ++h) { bf16_t* p = K1 + (size_t)row * 1536 + h * 192 + 128; p[i] = o1; p[32 + i] = o2; }
    }
}
__device__ __forceinline__ void ph_ffn_gate(const bf16_t* __restrict__ HID, const float* __restrict__ cw, const float* __restrict__ cb, bf16_t* __restrict__ ACT, int bid, int nblk) {
    for (int i = bid * 512 + opaque_tid(); i < 512 * (SEQ / 64); i += nblk * 512) {
        const int c8 = (i & 511) * 8, t0 = (i >> 9) * 64;
        float wg[3][8], wv[3][8], bg[8], bv[8];
#pragma unroll
        for (int j = 0; j < 8; ++j) { bg[j] = cb[c8 + j]; bv[j] = cb[4096 + c8 + j];
#pragma unroll
            for (int k = 0; k < 3; ++k) { wg[k][j] = cw[k * 8192 + c8 + j]; wv[k][j] = cw[k * 8192 + 4096 + c8 + j]; } }
        u32x4 g2 = {0u, 0u, 0u, 0u}, g1 = g2, v2 = g2, v1 = g2;
        if (t0 >= 2) { g2 = *(const u32x4*)(HID + (size_t)(t0 - 2) * 8192 + c8); g1 = *(const u32x4*)(HID + (size_t)(t0 - 1) * 8192 + c8);
                       v2 = *(const u32x4*)(HID + (size_t)(t0 - 2) * 8192 + 4096 + c8); v1 = *(const u32x4*)(HID + (size_t)(t0 - 1) * 8192 + 4096 + c8); }
        for (int r = 0; r < 64; ++r) {
            const u32x4 g0 = *(const u32x4*)(HID + (size_t)(t0 + r) * 8192 + c8), v0 = *(const u32x4*)(HID + (size_t)(t0 + r) * 8192 + 4096 + c8);
            const unsigned G2[4] = {g2.x, g2.y, g2.z, g2.w}, G1[4] = {g1.x, g1.y, g1.z, g1.w}, G0[4] = {g0.x, g0.y, g0.z, g0.w};
            const unsigned V2[4] = {v2.x, v2.y, v2.z, v2.w}, V1[4] = {v1.x, v1.y, v1.z, v1.w}, V0[4] = {v0.x, v0.y, v0.z, v0.w};
            float o[8];
#pragma unroll
            for (int j = 0; j < 4; ++j) {
                const float ge = bg[2 * j] + wg[0][2 * j] * __uint_as_float(G2[j] << 16) + wg[1][2 * j] * __uint_as_float(G1[j] << 16) + wg[2][2 * j] * __uint_as_float(G0[j] << 16);
                const float go = bg[2 * j + 1] + wg[0][2 * j + 1] * __uint_as_float(G2[j] & 0xFFFF0000u) + wg[1][2 * j + 1] * __uint_as_float(G1[j] & 0xFFFF0000u) + wg[2][2 * j + 1] * __uint_as_float(G0[j] & 0xFFFF0000u);
                const float ve = bv[2 * j] + wv[0][2 * j] * __uint_as_float(V2[j] << 16) + wv[1][2 * j] * __uint_as_float(V1[j] << 16) + wv[2][2 * j] * __uint_as_float(V0[j] << 16);
                const float vo = bv[2 * j + 1] + wv[0][2 * j + 1] * __uint_as_float(V2[j] & 0xFFFF0000u) + wv[1][2 * j + 1] * __uint_as_float(V1[j] & 0xFFFF0000u) + wv[2][2 * j + 1] * __uint_as_float(V0[j] & 0xFFFF0000u);
                o[2 * j] = gelu_tanh(ge) * ve; o[2 * j + 1] = gelu_tanh(go) * vo; }
            u32x4 ov; ov.x = pack2bf(o[0], o[1]); ov.y = pack2bf(o[2], o[3]); ov.z = pack2bf(o[4], o[5]); ov.w = pack2bf(o[6], o[7]);
            *(u32x4*)(ACT + (size_t)(t0 + r) * 4096 + c8) = ov;
            g2 = g1; g1 = g0; v2 = v1; v1 = v0;
        }
    }
}

__device__ __forceinline__ void ph_conv_lru(const float* __restrict__ wa, const float* __restrict__ wx, bf16_t* __restrict__ Bt, int bid, int nblk) {
    for (int e = bid * 512 + opaque_tid(); e < 8 * 2 * 128 * 128; e += nblk * 512) {
        const int d = e & 127, c = (e >> 7) & 127, gate = (e >> 14) & 1, nb = e >> 15;
        const float v = (gate ? wx : wa)[((size_t)nb * 128 + c) * 128 + d];
        bf16_t* row = Bt + (size_t)(nb * 256 + gate * 128 + d) * 256;
        row[(nb & 1) * 128 + c] = f2bf(v); row[(1 - (nb & 1)) * 128 + c] = 0;
    }
}

static constexpr size_t MiB = 1048576;
static constexpr size_t W_UP0 = 0 * MiB, W_UP1 = 32 * MiB, W_DN0 = 64 * MiB, W_DN1 = 80 * MiB, W_ABIN = 96 * MiB, W_ABOUT = 117 * MiB, W_CDIN = 125 * MiB, W_CDOUT = 137 * MiB,
                        W_QUP = 145 * MiB, W_KVUP = 146 * MiB + 512 * 1024, W_POOL = 147 * MiB + 512 * 1024;
static constexpr size_t R_H = 148 * MiB;
static constexpr size_t R_Q0 = 276 * MiB, R_K0 = 340 * MiB, R_VT0 = 404 * MiB, R_QI = 468 * MiB, R_M0 = 468 * MiB, R_U = 596 * MiB, R_KI = 724 * MiB, R_WI = 732 * MiB, R_MASK = 734 * MiB, R_CC0 = 830 * MiB, R_POOLED = 958 * MiB;
static constexpr size_t R_HID = 276 * MiB, R_ACT = 532 * MiB, R_F = 660 * MiB;
static constexpr size_t R_VT1 = 276 * MiB, R_CQ = 276 * MiB, R_CKV = 340 * MiB, R_KR = 372 * MiB, R_XL = 380 * MiB, R_YG = 444 * MiB, R_CQN = 508 * MiB, R_CKVN = 540 * MiB, R_LA = 556 * MiB, R_LB = 684 * MiB,
                        R_Q1 = 812 * MiB, R_K1 = 908 * MiB, R_CA = 1004 * MiB, R_CH = 1006 * MiB, R_CIN = 1008 * MiB, R_CC1 = 148 * MiB, R_M1 = 276 * MiB, R_XCB = 148 * MiB, W_LRU = 1010 * MiB;
static constexpr size_t WS_BAR = 1022 * MiB, WS_NEED = 1022 * MiB + 65536;
static constexpr int MK_LDS = 162816;

struct MK { const float* in[28]; float* out; unsigned char* ws; int ph_lo, ph_hi; };

__global__ __launch_bounds__(512, 2) void k_mega(MK p) {
    extern __shared__ __attribute__((aligned(16))) unsigned char shm[];
    LAS unsigned char* lds = (LAS unsigned char*)shm;
    const int bid0 = (int)blockIdx.x, nblk0 = (int)gridDim.x;
    volatile LAS unsigned* xbw = (volatile LAS unsigned*)(lds + MK_LDS - 16);
    if (threadIdx.x == 0) { xbw[0] = 0u; xbw[1] = 0u; xbw[2] = 0u; xbw[3] = 0u; }
    __syncthreads();
    XcdBarrier bar = xcd_barrier_post((unsigned*)(p.ws + WS_BAR), xbw);
    unsigned char* ws = p.ws; float* xo = p.out;
    const float* x = p.in[0]; const int* positions = (const int*)p.in[1];
    const float *mix_pre_g = p.in[2], *mix_post_g = p.in[3], *ffn_pre_g = p.in[4], *ffn_post_g = p.in[5];
    const float *ffn_up = p.in[6], *ffn_conv_w = p.in[7], *ffn_conv_b = p.in[8], *ffn_down = p.in[9];
    const float *ab_w_in = p.in[10], *pool_w = p.in[11], *pool_b = p.in[12], *pool_scale = p.in[13], *ab_w_out = p.in[14];
    const float *cd_w_in = p.in[15], *q_norm_g = p.in[16], *w_q_up = p.in[17], *kv_norm_g = p.in[18], *w_kv_up = p.in[19];
    const float *lru_conv_w = p.in[20], *lru_conv_b = p.in[21], *lru_wa = p.in[22], *lru_ba = p.in[23], *lru_wx = p.in[24], *lru_bx = p.in[25], *lru_lambda = p.in[26], *cd_w_out = p.in[27];
#define WSP(T, off) ((T*)(ws + (off)))
#define PHASE_BEGIN if (pc >= p.ph_lo && pc < p.ph_hi) { const int bid = opaque_s(bid0), nblk = opaque_s(nblk0);
#define PHASE_END } if (pc >= p.ph_lo && pc + 1 < p.ph_hi) xcd_barrier(bar); ++pc;
    int pc = 0;
    bf16_t* H = WSP(bf16_t, R_H);
    PHASE_BEGIN
#if !((SKIPMASK >> 0) & 1)
        ph_convT(lds, ffn_up, 8192, 0, 8192, 2048, WSP(bf16_t, W_UP0), 2048, bid, nblk);
        ph_convT(lds, ffn_up + (size_t)2048 * 8192, 8192, 0, 8192, 2048, WSP(bf16_t, W_UP1), 2048, bid, nblk);
        ph_convT(lds, ffn_down, 2048, 0, 2048, 4096, WSP(bf16_t, W_DN0), 4096, bid, nblk);
        ph_convT(lds, ffn_down + (size_t)4096 * 2048, 2048, 0, 2048, 4096, WSP(bf16_t, W_DN1), 4096, bid, nblk);
        ph_convT(lds, ab_w_in, 5200, 0, 4096, 2048, WSP(bf16_t, W_ABIN), 2048, bid, nblk);
        ph_convT(lds, ab_w_in, 5200, 4176, 1024, 2048, WSP(bf16_t, W_ABIN) + (size_t)4096 * 2048, 2048, bid, nblk);
        ph_convT(lds, ab_w_in, 5200, 4096, 64, 2048, WSP(bf16_t, W_ABIN) + (size_t)5120 * 2048, 2048, bid, nblk);
        ph_convT(lds, ab_w_in, 5200, 4160, 16, 2048, WSP(bf16_t, W_ABIN) + (size_t)5184 * 2048, 2048, bid, nblk);
        ph_convT(lds, ab_w_out, 2048, 0, 2048, 2048, WSP(bf16_t, W_ABOUT), 2048, bid, nblk);
        ph_convT(lds, cd_w_in, 2880, 0, 832, 2048, WSP(bf16_t, W_CDIN), 2048, bid, nblk);
        ph_convT(lds, cd_w_in, 2880, 832, 2048, 2048, WSP(bf16_t, W_CDIN) + (size_t)1024 * 2048, 2048, bid, nblk);
        ph_convT(lds, cd_w_out, 2048, 0, 2048, 2048, WSP(bf16_t, W_CDOUT), 2048, bid, nblk);
        ph_convT(lds, w_q_up, 1536, 0, 1536, 512, WSP(bf16_t, W_QUP), 512, bid, nblk);
        ph_convT(lds, w_kv_up, 2048, 0, 2048, 256, WSP(bf16_t, W_KVUP), 256, bid, nblk);
        for (int g = 0; g < 4; ++g) ph_convT(lds, pool_w + (size_t)g * 65536, 256, 0, 256, 256, WSP(bf16_t, W_POOL) + (size_t)g * 65536, 256, bid, nblk);
        ph_rmsnorm<2048>(x, mix_pre_g, H, bid, nblk);
#endif
    PHASE_END
    { const bf16_t* CC; bf16_t* Mx;
            CC = WSP(bf16_t, R_CC0); Mx = WSP(bf16_t, R_M0);
            PHASE_BEGIN
#if !((SKIPMASK >> 1) & 1)
                FAbIn2 f; f.Q = WSP(bf16_t, R_Q0); f.K = WSP(bf16_t, R_K0); f.VT = WSP(bf16_t, R_VT0); f.QI = WSP(float, R_QI); f.U = WSP(float, R_U); f.WI = WSP(float, R_WI); f.KI16 = WSP(unsigned short, R_KI);
                ph_gemm(lds, H, 2048, WSP(bf16_t, W_ABIN), 2048, NTOK, 5376, 2048, f, bid, nblk);
#endif
            PHASE_END
            PHASE_BEGIN
#if !((SKIPMASK >> 2) & 1)
                ph_pooled(WSP(float, R_U), WSP(bf16_t, R_POOLED), bid, nblk);
                IdxArgs a; a.QI = WSP(float, R_QI); a.KI16 = WSP(unsigned short, R_KI); a.WI = WSP(float, R_WI); a.MT = WSP(unsigned long long, R_MASK);
                idx_phase(lds, a, bid, nblk);
#endif
            PHASE_END
            PHASE_BEGIN
#if !((SKIPMASK >> 3) & 1)
                { FPool f; f.CC = WSP(bf16_t, R_CC0); f.pb = pool_b; f.ps = pool_scale; ph_gemm(lds, WSP(bf16_t, R_POOLED), 1024, WSP(bf16_t, W_POOL), 256, NTOK, 1024, 256, f, bid, nblk, 0, 512); }
                AttnArgs a; a.Q = WSP(bf16_t, R_Q0); a.K = WSP(bf16_t, R_K0); a.VT = WSP(bf16_t, R_VT0); a.MT = WSP(unsigned long long, R_MASK); a.O = WSP(bf16_t, R_CC0); a.ldq = 1024; a.ldk = 1024; a.ldo = 2048;
                a.sc_log2e = 0.08838834764831845f * 1.4426950408889634f;
                attn_phase<128, true>(lds, a, bid, nblk);
#endif
            PHASE_END
        PHASE_BEGIN
#if !((SKIPMASK >> 4) & 1)
            FStoreBf16 f; f.O = Mx; f.ldc = 2048; f.pad_ = 0;
            ph_gemm(lds, CC, 2048, WSP(bf16_t, W_ABOUT), 2048, NTOK, 2048, 2048, f, bid, nblk);
#endif
        PHASE_END
        PHASE_BEGIN
#if !((SKIPMASK >> 5) & 1)
            ph_resnorm(x, Mx, mix_post_g + 0, ffn_pre_g + 0, xo, H, bid, nblk);
#endif
        PHASE_END
        for (int half = 0; half < 2; ++half) {
            PHASE_BEGIN
#if !((SKIPMASK >> 6) & 1)
                FStoreBf16 f; f.O = WSP(bf16_t, R_HID); f.ldc = 8192; f.pad_ = 0;
                ph_gemm(lds, H + (size_t)half * SEQ * 2048, 2048, WSP(bf16_t, W_UP0), 2048, SEQ, 8192, 2048, f, bid, nblk);
#endif
            PHASE_END
            PHASE_BEGIN
#if !((SKIPMASK >> 7) & 1)
                ph_ffn_gate(WSP(bf16_t, R_HID), ffn_conv_w + 0, ffn_conv_b + 0, WSP(bf16_t, R_ACT), bid, nblk);
#endif
            PHASE_END
            PHASE_BEGIN
#if !((SKIPMASK >> 8) & 1)
                FStoreBf16 f; f.O = WSP(bf16_t, R_F) + (size_t)half * SEQ * 2048; f.ldc = 2048; f.pad_ = 0;
                ph_gemm(lds, WSP(bf16_t, R_ACT), 4096, WSP(bf16_t, W_DN0), 4096, SEQ, 2048, 4096, f, bid, nblk);
#endif
            PHASE_END
        }
        PHASE_BEGIN
#if !((SKIPMASK >> 9) & 1)
            ph_resnorm(xo, WSP(bf16_t, R_F), ffn_post_g + 0, mix_pre_g + 2048, xo, H, bid, nblk);
#endif
        PHASE_END
    }
    { const bf16_t* CC; bf16_t* Mx;
            CC = WSP(bf16_t, R_CC1); Mx = WSP(bf16_t, R_M1);
            PHASE_BEGIN
#if !((SKIPMASK >> 10) & 1)
                FCdIn f; f.CQ = WSP(float, R_CQ); f.CKV = WSP(float, R_CKV); f.KR = WSP(float, R_KR); f.XL = WSP(bf16_t, R_XL); f.YG = WSP(bf16_t, R_YG);
                ph_gemm(lds, H, 2048, WSP(bf16_t, W_CDIN), 2048, NTOK, 3072, 2048, f, bid, nblk);
#endif
            PHASE_END
            PHASE_BEGIN
#if !((SKIPMASK >> 11) & 1)
                ph_xc(WSP(bf16_t, R_XL), lru_conv_w, lru_conv_b, WSP(bf16_t, R_XCB), bid, nblk);
                ph_conv_lru(lru_wa, lru_wx, WSP(bf16_t, W_LRU), bid, nblk);
                ph_rmsnorm<512>(WSP(float, R_CQ), q_norm_g, WSP(bf16_t, R_CQN), bid, nblk);
                ph_rmsnorm<256>(WSP(float, R_CKV), kv_norm_g, WSP(bf16_t, R_CKVN), bid, nblk);
            PHASE_END
            PHASE_BEGIN
                { EpiLru ep; ep.XCB = WSP(bf16_t, R_XCB); ep.ba = lru_ba; ep.bx = lru_bx; ep.lam = lru_lambda; ep.LA = WSP(float, R_LA); ep.LB = WSP(float, R_LB);
                  ph_gemm_e(lds, WSP(bf16_t, R_XCB), 1024, WSP(bf16_t, W_LRU), 256, NTOK, 2048, 256, ep, bid, nblk, 1, 512); }
                { FStoreBf16 f; f.O = WSP(bf16_t, R_Q1); f.ldc = 1536; f.pad_ = 0; ph_gemm(lds, WSP(bf16_t, R_CQN), 512, WSP(bf16_t, W_QUP), 512, NTOK, 1536, 512, f, bid, nblk); }
                { FKvUp2 f; f.K1 = WSP(bf16_t, R_K1); f.VT = WSP(bf16_t, R_VT1); ph_gemm(lds, WSP(bf16_t, R_CKVN), 256, WSP(bf16_t, W_KVUP), 256, NTOK, 2048, 256, f, bid, nblk); }
            PHASE_END
            PHASE_BEGIN
                ph_scan1(WSP(float, R_LA), WSP(float, R_LB), WSP(float, R_CA), WSP(float, R_CH), bid, nblk);
                ph_rope_q(WSP(bf16_t, R_Q1), positions, bid, nblk);
                ph_rope_k(WSP(float, R_KR), positions, WSP(bf16_t, R_K1), bid, nblk);
            PHASE_END
            PHASE_BEGIN
                ph_scan2(WSP(float, R_CA), WSP(float, R_CH), WSP(float, R_CIN), bid, nblk);
            PHASE_END
            PHASE_BEGIN
                ph_scan3(WSP(float, R_LA), WSP(float, R_LB), WSP(float, R_CIN), WSP(bf16_t, R_YG), WSP(bf16_t, R_CC1), bid, nblk);
                AttnArgs a; a.Q = WSP(bf16_t, R_Q1); a.K = WSP(bf16_t, R_K1); a.VT = WSP(bf16_t, R_VT1); a.MT = nullptr; a.O = WSP(bf16_t, R_CC1); a.ldq = 1536; a.ldk = 1536; a.ldo = 2048;
                a.sc_log2e = 0.07216878364870322f * 1.4426950408889634f;
                attn_phase<192, false>(lds, a, bid, nblk);
#endif
            PHASE_END
        PHASE_BEGIN
#if !((SKIPMASK >> 15) & 1)
            FStoreBf16 f; f.O = Mx; f.ldc = 2048; f.pad_ = 0;
            ph_gemm(lds, CC, 2048, WSP(bf16_t, W_CDOUT), 2048, NTOK, 2048, 2048, f, bid, nblk);
#endif
        PHASE_END
        PHASE_BEGIN
#if !((SKIPMASK >> 16) & 1)
            ph_resnorm((const float*)xo, Mx, mix_post_g + 2048, ffn_pre_g + 2048, xo, H, bid, nblk);
#endif
        PHASE_END
        for (int half = 0; half < 2; ++half) {
            PHASE_BEGIN
#if !((SKIPMASK >> 17) & 1)
                FStoreBf16 f; f.O = WSP(bf16_t, R_HID); f.ldc = 8192; f.pad_ = 0;
                ph_gemm(lds, H + (size_t)half * SEQ * 2048, 2048, WSP(bf16_t, W_UP1), 2048, SEQ, 8192, 2048, f, bid, nblk);
#endif
            PHASE_END
            PHASE_BEGIN
#if !((SKIPMASK >> 18) & 1)
                ph_ffn_gate(WSP(bf16_t, R_HID), ffn_conv_w + 24576, ffn_conv_b + 8192, WSP(bf16_t, R_ACT), bid, nblk);
#endif
            PHASE_END
            PHASE_BEGIN
#if !((SKIPMASK >> 19) & 1)
                FStoreBf16 f; f.O = WSP(bf16_t, R_F) + (size_t)half * SEQ * 2048; f.ldc = 2048; f.pad_ = 0;
                ph_gemm(lds, WSP(bf16_t, R_ACT), 4096, WSP(bf16_t, W_DN1), 4096, SEQ, 2048, 4096, f, bid, nblk);
#endif
            PHASE_END
        }
        PHASE_BEGIN
#if !((SKIPMASK >> 20) & 1)
            ph_resnorm(xo, WSP(bf16_t, R_F), ffn_post_g + 2048, (const float*)nullptr, xo, H, bid, nblk);
#endif
        PHASE_END
    }
#undef WSP
#undef PHASE_BEGIN
#undef PHASE_END
}

#ifndef MK_N_LAUNCHES
#define MK_N_LAUNCHES 1
#endif
static constexpr int MK_NPHASES = 1 + 3 + 7 + 2 * 9;

extern "C" void kernel_launch(void* const* d_in, const int* in_sizes, int n_in, void* d_out, int out_size, void* d_ws, size_t ws_size, hipStream_t stream) {
    static int grid = 0;
    if (grid == 0) {
        if (n_in != 28 || out_size != NTOK * DM || ws_size < WS_NEED) { fprintf(stderr, "kernel_launch: unexpected shapes (n_in %d out %d ws %zu)\n", n_in, out_size, ws_size); grid = -1; return; }
        int dev = 0, cus = 0, per_cu = 0;
        if (hipGetDevice(&dev) != hipSuccess || hipDeviceGetAttribute(&cus, hipDeviceAttributeMultiprocessorCount, dev) != hipSuccess) { grid = -1; return; }
        if (hipFuncSetAttribute((const void*)k_mega, hipFuncAttributeMaxDynamicSharedMemorySize, MK_LDS) != hipSuccess) { fprintf(stderr, "kernel_launch: hipFuncSetAttribute failed\n"); grid = -1; return; }
        if (hipOccupancyMaxActiveBlocksPerMultiprocessor(&per_cu, (const void*)k_mega, 512, MK_LDS) != hipSuccess || per_cu < 1) { fprintf(stderr, "kernel_launch: occupancy query says %d\n", per_cu); }
        (void)hipGetLastError();
        grid = cus;
        if (grid != 256) { fprintf(stderr, "kernel_launch: built for 256 CUs, found %d\n", grid); grid = -1; return; }
    }
    if (grid < 0) return;
    unsigned char* ws = (unsigned char*)d_ws;
    (void)hipMemsetAsync(ws + WS_BAR, 0, XCD_BAR_WORDS * sizeof(unsigned), stream);
    (void)hipMemsetAsync(ws + W_ABIN + (size_t)5200 * 2048 * 2, 0, (size_t)176 * 2048 * 2, stream);
    (void)hipMemsetAsync(ws + W_CDIN + (size_t)832 * 2048 * 2, 0, (size_t)192 * 2048 * 2, stream);
    MK p{};
    for (int i = 0; i < 28; ++i) p.in[i] = (const float*)d_in[i];
    p.out = (float*)d_out; p.ws = ws;
#if MK_N_LAUNCHES == 1
    p.ph_lo = 0; p.ph_hi = 1 << 20;
    hipLaunchKernelGGL(k_mega, dim3(grid), dim3(512), MK_LDS, stream, p);
#else
    for (int ph = 0; ph < MK_NPHASES; ++ph) { p.ph_lo = ph; p.ph_hi = ph + 1; hipLaunchKernelGGL(k_mega, dim3(grid), dim3(512), MK_LDS, stream, p); }
#endif
}
```

```cpp
#include <hip/hip_runtime.h>
#include <stdint.h>
#include <stdio.h>

#define LAS __attribute__((address_space(3)))
typedef unsigned short bf16_t;
typedef float f32x4 __attribute__((ext_vector_type(4)));
typedef unsigned u32x4 __attribute__((ext_vector_type(4)));
typedef unsigned u32x2 __attribute__((ext_vector_type(2)));

static constexpr int NTOK = 32768, SEQ = 16384, NBATCH = 2, DM = 2048, DFF = 4096;
static constexpr float NORM_EPS = 1e-6f;

__device__ __forceinline__ bf16_t f2bf(float f) { unsigned u = __float_as_uint(f); u += 0x7FFFu + ((u >> 16) & 1u); return (bf16_t)(u >> 16); }
__device__ __forceinline__ float bf2f(bf16_t b) { return __uint_as_float(((unsigned)b) << 16); }
__device__ __forceinline__ unsigned pack2bf(float lo, float hi) { return (unsigned)f2bf(lo) | ((unsigned)f2bf(hi) << 16); }
__device__ __forceinline__ float gelu_tanh(float x) { const float u = 0.7978845608028654f * (x + 0.044715f * x * x * x); return 0.5f * x * (1.0f + tanhf(u)); }
__device__ __forceinline__ float wave_sum(float v) {
#pragma unroll
    for (int o = 32; o >= 1; o >>= 1) v += __shfl_xor(v, o);
    return v;
}

#ifndef TID_PLAIN
#define TID_PLAIN 0
#endif
static constexpr int TID_TAB_LDS = 162816 - 16 - 256;
#if TID_PLAIN
__device__ __forceinline__ int opaque_tid() { int t = (int)threadIdx.x; asm volatile("" : "+v"(t)); return t; }
#else
__device__ __forceinline__ int opaque_tid() {
    const unsigned slot = (unsigned)__builtin_amdgcn_s_getreg(((6 - 1) << 11) | 4) & 63u;
    const int w = __builtin_amdgcn_readfirstlane(*(const volatile LAS int*)(size_t)(TID_TAB_LDS + 4 * slot));
    int lane; asm volatile("v_mbcnt_lo_u32_b32 %0, -1, 0\n\tv_mbcnt_hi_u32_b32 %0, -1, %0" : "=v"(lane));
    return w * 64 + lane;
}
#endif

__device__ __forceinline__ int opaque_s(int v) { asm volatile("" : "+s"(v)); return v; }

template <class T> __device__ __forceinline__ const T* opaque_p(const T* p) { asm volatile("" : "+s"(p)); return p; }

#ifndef PG8_EPI_RECOMP
#define PG8_EPI_RECOMP 1
#endif
#ifndef PG8_ASM_DMA
#define PG8_ASM_DMA 1
#endif
#include <hip/hip_runtime.h>
namespace pg8 {
#define PG8_LAS __attribute__((address_space(3)))
typedef unsigned short bf16_t;
typedef short bf16x8 __attribute__((ext_vector_type(8)));
typedef float f32x4 __attribute__((ext_vector_type(4)));
typedef unsigned u32x4 __attribute__((ext_vector_type(4)));
typedef int i32x8 __attribute__((ext_vector_type(8)));
typedef int i32x4 __attribute__((ext_vector_type(4)));
constexpr int BM = 256, BK = 64, HALF = 128, HTB = HALF * BK * 2  , STAGE_BYTES = 8 * HTB, NXCD = 8, WGM = 8;

__host__ __device__ __forceinline__ int lds_byte(int r, int c) { const int st = (r >> 4) * 2 + (c >> 5), rr = r & 15, cc = c & 31, ob = rr * 64 + cc * 2; return st * 1024 + (ob ^ (((ob >> 9) & 1) << 5)); }
__host__ __device__ __forceinline__ void stage_rc(int b, int& R, int& C) { const int st = b / 1024, sb = b % 1024, swz = sb ^ (((sb >> 9) & 1) << 5); R = (st >> 1) * 16 + swz / 64; C = (st & 1) * 32 + (swz % 64) / 2; }
__host__ __device__ __forceinline__ int perm32(int rho) { const int n = rho >> 4, i = rho & 15; return 8 * (i >> 2) + 4 * n + (i & 3); }

struct Unit { int pm, pn; };
struct Gemm { const bf16_t* A; const bf16_t* Bt; int M, N, K, lda, ldb, a_shift, a_bytes, pad_; };

struct StaticOrder {
    int nM, nN, nwg, G, c;
    __host__ __device__ void init(int M, int N, int G_, int c_) { nM = M / BM; nN = N / BM; nwg = nM * nN; G = G_; c = c_; }
    __host__ __device__ bool next(int i, Unit& u) const {
        const long L = (long)i * G + c; if (L >= nwg) return false;
        int wgid = (int)L; { const int q = nwg / NXCD, r = nwg % NXCD, xcd = wgid % NXCD, off = wgid / NXCD; wgid = (xcd < r ? xcd * (q + 1) : r * (q + 1) + (xcd - r) * q) + off; }
        const int nig = WGM * nN, gid = wgid / nig, fm = gid * WGM, gsz = (nM - fm) < WGM ? (nM - fm) : WGM;
        u.pm = fm + ((wgid % nig) % gsz); u.pn = (wgid % nig) / gsz; return true;
    }
    __device__ __forceinline__ void a_ready(const Unit&) const {}
    __device__ __forceinline__ void done(const Unit&) const {}
};

template <class Epi, class Sched, bool STAMP = false>
__device__ __forceinline__ void gemm_phase(PG8_LAS unsigned char* lds, const Gemm g, const Sched& S, const Epi& E, unsigned long long* stamps) {
    const int tid = opaque_tid(), wid = __builtin_amdgcn_readfirstlane(tid >> 6), lane = tid & 63, wr = wid >> 2, wc = wid & 3, fr = lane & 15, fq = lane >> 4;
    const int K = g.K, nt = K / BK;
    int ts_lo = 0, ts_hi = 0, nts = 0; const unsigned long long rt_entry = STAMP ? (unsigned long long)wall_clock64() : 0ull;
#define PG8_STAMP() do { if (STAMP && wid == 0 && nts < 64) { const unsigned long long _c = (unsigned long long)clock64(); \
        ts_lo = (lane == nts) ? (int)(unsigned)_c : ts_lo; ts_hi = (lane == nts) ? (int)(unsigned)(_c >> 32) : ts_hi; ++nts; } } while (0)
    PG8_STAMP();
    unsigned voffA[2], voffB[2];
#pragma unroll
    for (int i = 0; i < 2; ++i) { int R, C; stage_rc(tid * 16 + i * 8192, R, C); const int Rb = Epi::PERM ? ((R & ~31) + perm32(R & 31)) : R;
        voffA[i] = (unsigned)(R * g.lda + C) * 2u; voffB[i] = (unsigned)(Rb * g.ldb + C) * 2u; }
    const size_t kstep = (size_t)(BK * 2);
    const size_t hstepA = (size_t)HALF * g.lda * 2, hstepB = (size_t)HALF * g.ldb * 2;
    const size_t tstepA = 2 * hstepA, tstepB = 2 * hstepB;
    const unsigned ldsbase_ = (unsigned)(size_t)lds;
    const int sc_w_ = 0x79797979, sc_a_ = 0x7F7F7F7F;
    (void)sc_w_; (void)sc_a_;
    const unsigned ldsw = (unsigned)wid * 1024u;
    const int aoff = lds_byte(wr * 64 + fr, fq * 8), boff = lds_byte(wc * 32 + fr, fq * 8);
#define PG8_SA(b, h) (((b) * 2 + (h)) * HTB)
#define PG8_SB(b, h) ((4 + (b) * 2 + (h)) * HTB)
#if PG8_ASM_DMA
#define PG8_STAGE(bufoff, gbase, voff) do { _Pragma("unroll") for (int _i = 0; _i < 2; ++_i) { unsigned keep_; \
        asm volatile("s_mov_b32 %0, m0\n\ts_mov_b32 m0, %3\n\ts_nop 0\n\tglobal_load_lds_dwordx4 %1, %2\n\ts_mov_b32 m0, %0" \
                     : "=&s"(keep_) : "v"((voff)[_i]), "s"((const char*)(gbase)), "s"(ldsbase_ + (unsigned)(bufoff) + ldsw + (unsigned)(_i * 8192)) : "memory"); } } while (0)
#else
#define PG8_STAGE(bufoff, gbase, voff) do { _Pragma("unroll") for (int _i = 0; _i < 2; ++_i) \
        __builtin_amdgcn_global_load_lds((const unsigned*)((const char*)(gbase) + (voff)[_i]), (PG8_LAS unsigned*)(lds + (bufoff) + ldsw + _i * 8192), 16, 0, 0); } while (0)
#endif
#define PG8_LDA(dst, b, h) do { _Pragma("unroll") for (int m = 0; m < 4; ++m) { dst[m].lo = *(const PG8_LAS i32x4*)(lds + PG8_SA(b, h) + aoff + m * 2048); dst[m].hi = *(const PG8_LAS i32x4*)(lds + PG8_SA(b, h) + aoff + m * 2048 + 1024); } } while (0)
#define PG8_LDB(dst, b, h) do { _Pragma("unroll") for (int n = 0; n < 2; ++n) { dst[n].lo = *(const PG8_LAS i32x4*)(lds + PG8_SB(b, h) + boff + n * 2048); dst[n].hi = *(const PG8_LAS i32x4*)(lds + PG8_SB(b, h) + boff + n * 2048 + 1024); } } while (0)
#define PG8_MMA(ai, bj, At, Bt) do { __builtin_amdgcn_s_setprio(1); \
        if constexpr (Epi::FP8) { _Pragma("unroll") for (int m = 0; m < 4; ++m) _Pragma("unroll") for (int n = 0; n < 2; ++n) \
            asm volatile("v_mfma_scale_f32_16x16x128_f8f6f4 %0, %1, %2, %0, %3, %4 op_sel_hi:[0,0,0]" : "+v"(acc[ai][bj][m][n]) : "v"(Bt[n]), "v"(At[m]), "v"(sc_w_), "v"(sc_a_)); } \
        else { _Pragma("unroll") for (int m = 0; m < 4; ++m) _Pragma("unroll") for (int n = 0; n < 2; ++n) { \
            const i32x4 bl_ = Bt[n].lo, bh_ = Bt[n].hi, al_ = At[m].lo, ah_ = At[m].hi;     \
            acc[ai][bj][m][n] = __builtin_amdgcn_mfma_f32_16x16x32_bf16(__builtin_bit_cast(bf16x8, bl_), __builtin_bit_cast(bf16x8, al_), acc[ai][bj][m][n], 0, 0, 0); \
            acc[ai][bj][m][n] = __builtin_amdgcn_mfma_f32_16x16x32_bf16(__builtin_bit_cast(bf16x8, bh_), __builtin_bit_cast(bf16x8, ah_), acc[ai][bj][m][n], 0, 0, 0); } } \
        __builtin_amdgcn_s_setprio(0); } while (0)
#define PG8_WAIT_V(n) asm volatile("s_waitcnt vmcnt(" #n ")" ::: "memory")
#define PG8_WAIT_L(n) asm volatile("s_waitcnt lgkmcnt(" #n ")" ::: "memory")
#define PG8_BAR __builtin_amdgcn_s_barrier()
#define PG8_SCHED __builtin_amdgcn_sched_barrier(0)
    Unit cur, nxt; int ui = 0;
    if (!S.next(0, cur)) return;
    f32x4 acc[2][2][4][2];
#pragma unroll
    for (int a = 0; a < 2; ++a)
#pragma unroll
        for (int b = 0; b < 2; ++b)
#pragma unroll
            for (int m = 0; m < 4; ++m)
#pragma unroll
                for (int n = 0; n < 2; ++n) acc[a][b][m][n] = (f32x4){0.f, 0.f, 0.f, 0.f};
    i32x8 At[4], B0[2], B1[2];
    const char* cA = (const char*)g.A + (size_t)cur.pm * tstepA + (size_t)(cur.pn >> g.a_shift) * g.a_bytes; const char* cB = (const char*)g.Bt + (size_t)cur.pn * tstepB;
    S.a_ready(cur);
    PG8_STAGE(PG8_SB(0, 0), cB, voffB); PG8_STAGE(PG8_SA(0, 0), cA, voffA); PG8_STAGE(PG8_SB(0, 1), cB + hstepB, voffB); PG8_STAGE(PG8_SA(0, 1), cA + hstepA, voffA);
    if (wr == 1) PG8_BAR;
    PG8_WAIT_V(4); PG8_BAR;
    PG8_STAGE(PG8_SB(1, 0), cB + kstep, voffB); PG8_STAGE(PG8_SA(1, 0), cA + kstep, voffA); PG8_STAGE(PG8_SB(1, 1), cB + hstepB + kstep, voffB);
    PG8_WAIT_V(6); PG8_BAR;
    PG8_STAMP();
    for (;;) {
        const bool has_next = S.next(ui + 1, nxt);
        const char* nA = has_next ? (const char*)g.A + (size_t)nxt.pm * tstepA + (size_t)(nxt.pn >> g.a_shift) * g.a_bytes : cA; const char* nB = has_next ? (const char*)g.Bt + (size_t)nxt.pn * tstepB : cB;
        for (int t = 0; t < nt; t += 2) {
            const bool last = (t == nt - 2);
            const char* a1 = cA + (size_t)(t + 1) * kstep;
            const char* a2 = last ? nA : cA + (size_t)(t + 2) * kstep; const char* b2 = last ? nB : cB + (size_t)(t + 2) * kstep;
            const char* a3 = a2 + kstep; const char* b3 = b2 + kstep;
            if (last && has_next) S.a_ready(nxt);
            PG8_LDB(B0, 0, 0); PG8_SCHED; PG8_LDA(At, 0, 0); PG8_STAGE(PG8_SA(1, 1), a1 + hstepA, voffA);
            PG8_WAIT_L(8); PG8_BAR; PG8_WAIT_L(0); PG8_MMA(0, 0, At, B0); PG8_BAR; PG8_SCHED;
            PG8_LDB(B1, 0, 1); PG8_STAGE(PG8_SB(0, 0), b2, voffB);
            PG8_BAR; PG8_WAIT_L(0); PG8_MMA(0, 1, At, B1); PG8_BAR;
            PG8_LDA(At, 0, 1); PG8_STAGE(PG8_SA(0, 0), a2, voffA);
            PG8_BAR; PG8_WAIT_L(0); PG8_MMA(1, 0, At, B0); PG8_BAR; PG8_SCHED;
            PG8_STAGE(PG8_SB(0, 1), b2 + hstepB, voffB);
            PG8_WAIT_V(6); PG8_BAR; PG8_MMA(1, 1, At, B1); PG8_BAR;
            PG8_LDB(B0, 1, 0); PG8_SCHED; PG8_LDA(At, 1, 0); PG8_STAGE(PG8_SA(0, 1), a2 + hstepA, voffA);
            PG8_WAIT_L(8); PG8_BAR; PG8_WAIT_L(0); PG8_MMA(0, 0, At, B0); PG8_BAR; PG8_SCHED;
            PG8_LDB(B1, 1, 1); PG8_STAGE(PG8_SB(1, 0), b3, voffB);
            PG8_BAR; PG8_WAIT_L(0); PG8_MMA(0, 1, At, B1); PG8_BAR;
            PG8_LDA(At, 1, 1); PG8_STAGE(PG8_SA(1, 0), a3, voffA);
            PG8_BAR; PG8_WAIT_L(0); PG8_MMA(1, 0, At, B0); PG8_BAR; PG8_SCHED;
            PG8_STAGE(PG8_SB(1, 1), b3 + hstepB, voffB);
            PG8_WAIT_V(6); PG8_BAR; PG8_MMA(1, 1, At, B1); PG8_BAR;
        }
        PG8_STAMP();
        if constexpr (Epi::FP8) { asm volatile("s_nop 15\n\ts_nop 15" ::: "memory"); }
        if constexpr (!Epi::AFTER_DRAIN) {
#if PG8_EPI_RECOMP
            const int t2_ = opaque_tid(), l2_ = t2_ & 63, w2_ = __builtin_amdgcn_readfirstlane(t2_ >> 6);
            E(acc, cur, w2_ >> 2, w2_ & 3, l2_ & 15, l2_ >> 4); S.done(cur);
#else
            E(acc, cur, wr, wc, fr, fq); S.done(cur);
#endif
        }
        PG8_STAMP();
        if (!has_next) break;
#pragma unroll
        for (int a = 0; a < 2; ++a)
#pragma unroll
            for (int b = 0; b < 2; ++b)
#pragma unroll
                for (int m = 0; m < 4; ++m)
#pragma unroll
                    for (int n = 0; n < 2; ++n) acc[a][b][m][n] = (f32x4){0.f, 0.f, 0.f, 0.f};
        cur = nxt; cA = nA; cB = nB; ++ui;
    }
    PG8_WAIT_V(0);
    if (wr == 0) PG8_BAR;
    PG8_BAR;
    if constexpr (Epi::AFTER_DRAIN) { E.fused(acc, cur, wr, wc, fr, fq, lds, wid, lane); S.done(cur); }
    PG8_STAMP();
    if (STAMP && wid == 0) { stamps[lane] = lane < nts ? (((unsigned long long)(unsigned)ts_hi << 32) | (unsigned)ts_lo) : 0ull;
        if (lane == 62) stamps[62] = rt_entry; if (lane == 63) stamps[63] = (unsigned long long)wall_clock64(); }
#undef PG8_STAMP
#undef PG8_SA
#undef PG8_SB
#undef PG8_STAGE
#undef PG8_LDA
#undef PG8_LDB
#undef PG8_MMA
#undef PG8_WAIT_V
#undef PG8_WAIT_L
#undef PG8_BAR
#undef PG8_SCHED
}
}

#include <cstdio>
#include <ctime>
#include <cstdlib>
#include <cstring>
#include <cmath>
#include <vector>

template <class F, bool F8 = false> struct EpiG {
    static constexpr bool PERM = false, AFTER_DRAIN = false, FP8 = F8;
    F f;
    __device__ __forceinline__ void operator()(const f32x4 (&acc)[2][2][4][2], const pg8::Unit& u, int wr, int wc, int fr, int fq) const {
        const int row0 = u.pm * 256 + wr * 64 + fr, col0 = u.pn * 256 + wc * 32 + 4 * fq;
#pragma unroll
        for (int ai = 0; ai < 2; ++ai)
#pragma unroll
            for (int m = 0; m < 4; ++m)
#pragma unroll
                for (int bj = 0; bj < 2; ++bj)
#pragma unroll
                    for (int n = 0; n < 2; ++n) f(row0 + ai * 128 + m * 16, col0 + bj * 128 + n * 16, acc[ai][bj][m][n]);
    }
};
__device__ __forceinline__ void st_bf16x4(bf16_t* p, f32x4 v) { u32x2 w; w.x = pack2bf(v[0], v[1]); w.y = pack2bf(v[2], v[3]); *(u32x2*)p = w; }
__device__ __forceinline__ void st_f32x4(float* p, f32x4 v) { *(f32x4*)p = v; }

struct FStoreBf16 { bf16_t* O; int ldc; int pad_; __device__ __forceinline__ void operator()(int r, int c, f32x4 v) const { st_bf16x4(O + (size_t)r * ldc + c, v); } };
struct FAbIn { bf16_t *Q, *K, *V; float *QI, *U, *WI; unsigned short* KI16;
    __device__ __forceinline__ void operator()(int r, int c, f32x4 v) const {
        if (c < 1024) st_bf16x4(Q + (size_t)r * 1024 + c, v);
        else if (c < 2048) st_bf16x4(K + (size_t)r * 1024 + (c - 1024), v);
        else if (c < 3072) st_bf16x4(V + (size_t)r * 1024 + (c - 2048), v);
        else if (c < 4096) st_f32x4(QI + (size_t)r * 1024 + (c - 3072), v);
        else if (c < 5120) st_f32x4(U + (size_t)r * 1024 + (c - 4096), v);
        else if (c < 5184) { typedef _Float16 h2 __attribute__((ext_vector_type(2))); union { h2 h; unsigned u; } a, b; a.h = (h2){(_Float16)v[0], (_Float16)v[1]}; b.h = (h2){(_Float16)v[2], (_Float16)v[3]};
            u32x2 w; w.x = a.u; w.y = b.u; *(u32x2*)(KI16 + (size_t)r * 64 + (c - 5120)) = w; }
        else if (c < 5200) st_f32x4(WI + (size_t)r * 16 + (c - 5184), v);
    } };
struct FCdIn { float *CQ, *CKV, *KR; bf16_t *XL, *YG;
    __device__ __forceinline__ void operator()(int r, int c, f32x4 v) const {
        if (c < 512) st_f32x4(CQ + (size_t)r * 512 + c, v);
        else if (c < 768) st_f32x4(CKV + (size_t)r * 256 + (c - 512), v);
        else if (c < 832) st_f32x4(KR + (size_t)r * 64 + (c - 768), v);
        else if (c < 1024) {}
        else if (c < 2048) st_bf16x4(XL + (size_t)r * 1024 + (c - 1024), v);
        else st_bf16x4(YG + (size_t)r * 1024 + (c - 2048), v);
    } };
struct FKvUp { bf16_t *K1, *V1;
    __device__ __forceinline__ void operator()(int r, int c, f32x4 v) const {
        const int h = c >> 8, d = c & 255;
        if (d < 128) st_bf16x4(K1 + (size_t)r * 1536 + h * 192 + d, v);
        else st_bf16x4(V1 + (size_t)r * 1024 + h * 128 + (d - 128), v);
    } };

__device__ __forceinline__ unsigned ord_key(float f) { const unsigned b = __float_as_uint(f); return (b & 0x80000000u) ? ~b : (b | 0x80000000u); }
__device__ __forceinline__ void rope_cs(int pos, int i, float& c, float& s) { const float freq = powf(10000.0f, -(float)i / 32.0f); const float ang = (float)pos * freq; sincosf(ang, &s, &c); }

typedef short bf16x8 __attribute__((ext_vector_type(8)));
typedef float f32x16 __attribute__((ext_vector_type(16)));
__device__ __forceinline__ unsigned cvtpk(float lo, float hi) { unsigned r; asm("v_cvt_pk_bf16_f32 %0, %1, %2" : "=v"(r) : "v"(lo), "v"(hi)); return r; }
__device__ __forceinline__ float max3_asm(float a, float b, float c) { float r; asm("v_max3_f32 %0, %1, %2, %3" : "=v"(r) : "v"(a), "v"(b), "v"(c)); return r; }

struct AttnArgs { const bf16_t* Q; const bf16_t* K; const bf16_t* VT; const unsigned long long* MT; bf16_t* O; int ldq, ldk, ldo; float sc_log2e; };

template <int DQK, bool MASKED>
__device__ __forceinline__ void attn_item(LAS unsigned char* lds, const AttnArgs& a, int b, int h, int qb) {
    constexpr int NKS = DQK / 16, PK = DQK * 2, PV = 128, KB_BYTES = 64 * PK, VB_BYTES = 128 * PV, NPK = DQK / 8, NKP = (64 * NPK) / 512, V_OFF = 3 * KB_BYTES;
    const int tid = opaque_tid(), lane = tid & 63, w = __builtin_amdgcn_readfirstlane(tid >> 6), n = lane & 31, hf = lane >> 5;
    const int nt = 4 * qb + 4, cw = 4 * qb + (w >> 1);
    const int trow = qb * 256 + w * 32 + n;
    const size_t grow = (size_t)b * SEQ + trow;
    bf16x8 qf[NKS];
    { const bf16_t* qp = a.Q + grow * a.ldq + h * DQK + hf * 8;
#pragma unroll
      for (int ks = 0; ks < NKS; ++ks) qf[ks] = *(const bf16x8*)(qp + ks * 16); }
    f32x16 o[4];
#pragma unroll
    for (int dt = 0; dt < 4; ++dt)
#pragma unroll
        for (int r = 0; r < 16; ++r) o[dt][r] = 0.f;
    float m_run = -INFINITY, l_run = 0.f;
    const float c = a.sc_log2e;
    const bf16_t* Kg = a.K + (size_t)b * SEQ * a.ldk + h * DQK;
    const bf16_t* Vg = a.VT + (size_t)(b * 8 + h) * 128 * SEQ;
    const unsigned long long* Mg = MASKED ? a.MT + (size_t)b * 256 * SEQ + trow : nullptr;
    auto dma_k = [&](int kt) {
        LAS unsigned char* kb = lds + (kt % 3) * KB_BYTES;
#pragma unroll
        for (int i = 0; i < NKP; ++i) { const int s = (w + 8 * i) * 64 + lane, r = s / NPK, cp = s % NPK, cc = cp ^ (NPK == 16 ? (r & 15) : ((r >> 1) & 7));
            __builtin_amdgcn_global_load_lds((const unsigned*)(Kg + (size_t)(kt * 64 + r) * a.ldk + cc * 8), (LAS unsigned*)(kb + (w + 8 * i) * 1024), 16, 0, 0); }
    };
    auto dma_v = [&](int kt) {
        LAS unsigned char* vb = lds + V_OFF + (kt & 1) * VB_BYTES;
#pragma unroll
        for (int i = 0; i < 2; ++i) { const int s = (w + 8 * i) * 64 + lane, d = s >> 3, cp = s & 7, cc = cp ^ ((d >> 1) & 7);
            __builtin_amdgcn_global_load_lds((const unsigned*)(Vg + (size_t)d * SEQ + kt * 64 + cc * 8), (LAS unsigned*)(vb + (w + 8 * i) * 1024), 16, 0, 0); }
    };
    const int kswz = (NPK == 16) ? (n & 15) : ((n >> 1) & 7), vswz = (n >> 1) & 7;
    auto qk = [&](int kt, f32x16& s0, f32x16& s1) {
        const LAS unsigned char* ka = lds + (kt % 3) * KB_BYTES + n * PK;
#pragma unroll
        for (int r = 0; r < 16; ++r) { s0[r] = 0.f; s1[r] = 0.f; }
#pragma unroll
        for (int ks = 0; ks < NKS; ++ks) {
            const int po = ((2 * ks + hf) ^ kswz) * 16;
            const bf16x8 a0 = *(const LAS bf16x8*)(ka + po), a1 = *(const LAS bf16x8*)(ka + 32 * PK + po);
            s0 = __builtin_amdgcn_mfma_f32_32x32x16_bf16(a0, qf[ks], s0, 0, 0, 0);
            s1 = __builtin_amdgcn_mfma_f32_32x32x16_bf16(a1, qf[ks], s1, 0, 0, 0);
        }
    };
    auto rowmax = [&](int kt, f32x16& s0, f32x16& s1) -> float {
        if (MASKED) {
            const unsigned long long mw = Mg[(size_t)kt * SEQ]; const unsigned mlo = (unsigned)mw >> (hf * 4), mhi = (unsigned)(mw >> 32) >> (hf * 4);
#pragma unroll
            for (int r = 0; r < 16; ++r) { const unsigned bit = 1u << ((r >> 2) * 8 + (r & 3));
                s0[r] = (mlo & bit) ? s0[r] : -INFINITY; s1[r] = (mhi & bit) ? s1[r] : -INFINITY; }
        }
        float mx = max3_asm(s0[0], s1[0], s0[1]);
        mx = max3_asm(mx, s1[1], s0[2]);
#pragma unroll
        for (int r = 2; r < 15; ++r) mx = max3_asm(mx, s1[r], s0[r + 1]);
        mx = max3_asm(mx, s1[15], mx);
        const auto rr = __builtin_amdgcn_permlane32_swap(__float_as_uint(mx), __float_as_uint(mx), false, false);
        return fmaxf(__uint_as_float(rr[0]), __uint_as_float(rr[1]));
    };
    dma_k(0); dma_v(0); if (nt > 1) dma_k(1);
    asm volatile("s_waitcnt vmcnt(0)" ::: "memory");
    __syncthreads();
    f32x16 sc0, sc1, sn0, sn1;
    qk(0, sc0, sc1);
    float mx_cur = rowmax(0, sc0, sc1), mx_next = -INFINITY;
#pragma unroll
    for (int r = 0; r < 16; ++r) { sn0[r] = 0.f; sn1[r] = 0.f; }
    for (int kt = 0; kt < nt; ++kt) {
        if (kt + 2 < nt) dma_k(kt + 2);
        if (kt + 1 < nt) dma_v(kt + 1);
        const bool act = kt <= cw, actn = kt + 1 <= cw;
        float m_use = 0.f;
        if (act) {
            const float m_new = fmaxf(m_run, mx_cur);
            m_use = (MASKED && m_new == -INFINITY) ? 0.f : m_new;
            if (__any(m_new > m_run)) {
                const float al = __builtin_amdgcn_exp2f((m_run - m_use) * c);
                l_run *= al;
#pragma unroll
                for (int dt = 0; dt < 4; ++dt)
#pragma unroll
                    for (int r = 0; r < 16; ++r) o[dt][r] *= al;
            }
            m_run = m_new;
        }
        if (actn) qk(kt + 1, sn0, sn1);
        bf16x8 pf[4];
        if (act) {
            const float mc = m_use * c;
            float ps = 0.f;
#pragma unroll
            for (int r = 0; r < 16; ++r) { sc0[r] = __builtin_amdgcn_exp2f(fmaf(sc0[r], c, -mc)); sc1[r] = __builtin_amdgcn_exp2f(fmaf(sc1[r], c, -mc)); ps += sc0[r] + sc1[r]; }
            l_run += ps;
            u32x4 t;
            t.x = cvtpk(sc0[0], sc0[1]); t.y = cvtpk(sc0[2], sc0[3]); t.z = cvtpk(sc0[4], sc0[5]); t.w = cvtpk(sc0[6], sc0[7]); pf[0] = *(bf16x8*)&t;
            t.x = cvtpk(sc0[8], sc0[9]); t.y = cvtpk(sc0[10], sc0[11]); t.z = cvtpk(sc0[12], sc0[13]); t.w = cvtpk(sc0[14], sc0[15]); pf[1] = *(bf16x8*)&t;
            t.x = cvtpk(sc1[0], sc1[1]); t.y = cvtpk(sc1[2], sc1[3]); t.z = cvtpk(sc1[4], sc1[5]); t.w = cvtpk(sc1[6], sc1[7]); pf[2] = *(bf16x8*)&t;
            t.x = cvtpk(sc1[8], sc1[9]); t.y = cvtpk(sc1[10], sc1[11]); t.z = cvtpk(sc1[12], sc1[13]); t.w = cvtpk(sc1[14], sc1[15]); pf[3] = *(bf16x8*)&t;
            const LAS unsigned char* va = lds + V_OFF + (kt & 1) * VB_BYTES + n * PV;
#pragma unroll
            for (int g = 0; g < 4; ++g) { const int po = ((2 * g + hf) ^ vswz) * 16;
#pragma unroll
                for (int dt = 0; dt < 4; ++dt) { const bf16x8 vf = *(const LAS bf16x8*)(va + dt * 32 * PV + po); o[dt] = __builtin_amdgcn_mfma_f32_32x32x16_bf16(vf, pf[g], o[dt], 0, 0, 0); } }
        }
        if (actn) mx_next = rowmax(kt + 1, sn0, sn1);
        sc0 = sn0; sc1 = sn1; mx_cur = mx_next;
        asm volatile("s_waitcnt vmcnt(0)" ::: "memory");
        __syncthreads();
    }
    const float lt = l_run + __shfl_xor(l_run, 32);
    const float inv = 1.0f / lt;
    bf16_t* op = a.O + grow * a.ldo + h * 128 + hf * 4;
#pragma unroll
    for (int dt = 0; dt < 4; ++dt)
#pragma unroll
        for (int r4 = 0; r4 < 4; ++r4) { u32x2 wv; wv.x = cvtpk(o[dt][4 * r4] * inv, o[dt][4 * r4 + 1] * inv); wv.y = cvtpk(o[dt][4 * r4 + 2] * inv, o[dt][4 * r4 + 3] * inv);
            *(u32x2*)(op + dt * 32 + r4 * 8) = wv; }
}
struct TTrue { static constexpr bool value = true; }; struct TFalse { static constexpr bool value = false; };
template <int DQK, bool MASKED>
__device__ __forceinline__ void attn_item3(LAS unsigned char* lds, const AttnArgs& a, int b, int h, int qb) {
    constexpr int NKS = DQK / 16, PK = DQK * 2, PV = 128, KB_BYTES = 64 * PK, VB_BYTES = 128 * PV, NPK = DQK / 8, NKP = (64 * NPK) / 512, V_OFF = 3 * KB_BYTES;
    const int tid = opaque_tid(), lane = tid & 63, w = __builtin_amdgcn_readfirstlane(tid >> 6), n = lane & 31, hf = lane >> 5;
    const int nt = 4 * qb + 4, cw = 4 * qb + (w >> 1);
    const int trow = qb * 256 + w * 32 + n;
    const size_t grow = (size_t)b * SEQ + trow;
    bf16x8 qf[NKS];
    { const bf16_t* qp = a.Q + grow * a.ldq + h * DQK + hf * 8;
#pragma unroll
      for (int ks = 0; ks < NKS; ++ks) qf[ks] = *(const bf16x8*)(qp + ks * 16); }
    f32x16 o[4];
#pragma unroll
    for (int dt = 0; dt < 4; ++dt)
#pragma unroll
        for (int r = 0; r < 16; ++r) o[dt][r] = 0.f;
    float m_run = -INFINITY, l_run = 0.f;
    const float c = a.sc_log2e;
    const bf16_t* Kg = a.K + (size_t)b * SEQ * a.ldk + h * DQK;
    const bf16_t* Vg = a.VT + (size_t)(b * 8 + h) * 128 * SEQ;
    const unsigned long long* Mg = MASKED ? a.MT + (size_t)b * 256 * SEQ + trow : nullptr;
    auto dma_k = [&](int kt) {
        LAS unsigned char* kb = lds + (kt % 3) * KB_BYTES;
#pragma unroll
        for (int i = 0; i < NKP; ++i) { const int s = (w + 8 * i) * 64 + lane, r = s / NPK, cp = s % NPK, cc = cp ^ (NPK == 16 ? (r & 15) : ((r >> 1) & 7));
            __builtin_amdgcn_global_load_lds((const unsigned*)(Kg + (size_t)(kt * 64 + r) * a.ldk + cc * 8), (LAS unsigned*)(kb + (w + 8 * i) * 1024), 16, 0, 0); }
    };
    auto dma_v = [&](int kt) {
        LAS unsigned char* vb = lds + V_OFF + (kt & 1) * VB_BYTES;
#pragma unroll
        for (int i = 0; i < 2; ++i) { const int s = (w + 8 * i) * 64 + lane, d = s >> 3, cp = s & 7, cc = cp ^ ((d >> 1) & 7);
            __builtin_amdgcn_global_load_lds((const unsigned*)(Vg + (size_t)d * SEQ + kt * 64 + cc * 8), (LAS unsigned*)(vb + (w + 8 * i) * 1024), 16, 0, 0); }
    };
    const int kswz = (NPK == 16) ? (n & 15) : ((n >> 1) & 7), vswz = (n >> 1) & 7;
    auto qk = [&](int kt, f32x16& s0, f32x16& s1) {
        const LAS unsigned char* ka = lds + (kt % 3) * KB_BYTES + n * PK;
#pragma unroll
        for (int r = 0; r < 16; ++r) { s0[r] = 0.f; s1[r] = 0.f; }
#pragma unroll
        for (int ks = 0; ks < NKS; ++ks) {
            const int po = ((2 * ks + hf) ^ kswz) * 16;
            const bf16x8 a0 = *(const LAS bf16x8*)(ka + po), a1 = *(const LAS bf16x8*)(ka + 32 * PK + po);
            s0 = __builtin_amdgcn_mfma_f32_32x32x16_bf16(a0, qf[ks], s0, 0, 0, 0);
            s1 = __builtin_amdgcn_mfma_f32_32x32x16_bf16(a1, qf[ks], s1, 0, 0, 0);
        }
    };
    auto rowmax = [&](unsigned long long mw, bool, f32x16& s0, f32x16& s1) -> float {
        if (MASKED) {
            const unsigned mlo = (unsigned)mw >> (hf * 4), mhi = (unsigned)(mw >> 32) >> (hf * 4);
#pragma unroll
            for (int r = 0; r < 16; ++r) { const unsigned bit = 1u << ((r >> 2) * 8 + (r & 3));
                s0[r] = (mlo & bit) ? s0[r] : -INFINITY; s1[r] = (mhi & bit) ? s1[r] : -INFINITY; }
        }
        float mx = max3_asm(s0[0], s1[0], s0[1]);
        mx = max3_asm(mx, s1[1], s0[2]);
#pragma unroll
        for (int r = 2; r < 15; ++r) mx = max3_asm(mx, s1[r], s0[r + 1]);
        mx = max3_asm(mx, s1[15], mx);
        const auto rr = __builtin_amdgcn_permlane32_swap(__float_as_uint(mx), __float_as_uint(mx), false, false);
        return fmaxf(__uint_as_float(rr[0]), __uint_as_float(rr[1]));
    };
    dma_k(0); dma_v(0); if (nt > 1) dma_k(1);
    unsigned long long mw_pre = MASKED ? Mg[(size_t)(nt > 1 ? 1 : 0) * SEQ] : 0ull;
    asm volatile("s_waitcnt vmcnt(0)" ::: "memory");
    __syncthreads();
    f32x16 sa0, sa1, sb0, sb1;
    qk(0, sa0, sa1);
    float mx_cur = rowmax(MASKED ? Mg[0] : 0ull, false, sa0, sa1);
    auto step = [&](int kt, f32x16& c0, f32x16& c1, f32x16& n0, f32x16& n1, auto full_tag) {
        constexpr bool FULL = decltype(full_tag)::value;
        if (kt + 2 < nt) dma_k(kt + 2);
        if (kt + 1 < nt) dma_v(kt + 1);
        const unsigned long long mw_now = mw_pre;
        if (MASKED) mw_pre = Mg[(size_t)(kt + 2 < nt ? kt + 2 : kt) * SEQ];
        const bool act = FULL || kt <= cw, actn = FULL || kt + 1 <= cw;
        const float m_new = fmaxf(m_run, mx_cur);
        const float m_use = (MASKED && m_new == -INFINITY) ? 0.f : m_new;
        if (act && __any(m_new > m_run)) {
            const float al = __builtin_amdgcn_exp2f((m_run - m_use) * c);
            l_run *= al;
#pragma unroll
            for (int dt = 0; dt < 4; ++dt)
#pragma unroll
                for (int r = 0; r < 16; ++r) o[dt][r] *= al;
        }
        if (act) m_run = m_new;
        if (FULL) {
            qk(kt + 1, n0, n1);
            const float mc = m_use * c;
            float ps = 0.f;
#pragma unroll
            for (int r = 0; r < 16; ++r) { c0[r] = __builtin_amdgcn_exp2f(fmaf(c0[r], c, -mc)); c1[r] = __builtin_amdgcn_exp2f(fmaf(c1[r], c, -mc)); ps += c0[r] + c1[r]; }
            l_run += ps;
            bf16x8 pf[4]; u32x4 t;
            t.x = cvtpk(c0[0], c0[1]); t.y = cvtpk(c0[2], c0[3]); t.z = cvtpk(c0[4], c0[5]); t.w = cvtpk(c0[6], c0[7]); pf[0] = *(bf16x8*)&t;
            t.x = cvtpk(c0[8], c0[9]); t.y = cvtpk(c0[10], c0[11]); t.z = cvtpk(c0[12], c0[13]); t.w = cvtpk(c0[14], c0[15]); pf[1] = *(bf16x8*)&t;
            t.x = cvtpk(c1[0], c1[1]); t.y = cvtpk(c1[2], c1[3]); t.z = cvtpk(c1[4], c1[5]); t.w = cvtpk(c1[6], c1[7]); pf[2] = *(bf16x8*)&t;
            t.x = cvtpk(c1[8], c1[9]); t.y = cvtpk(c1[10], c1[11]); t.z = cvtpk(c1[12], c1[13]); t.w = cvtpk(c1[14], c1[15]); pf[3] = *(bf16x8*)&t;
            const LAS unsigned char* va = lds + V_OFF + (kt & 1) * VB_BYTES + n * PV;
#pragma unroll
            for (int g = 0; g < 4; ++g) { const int po = ((2 * g + hf) ^ vswz) * 16;
#pragma unroll
                for (int dt = 0; dt < 4; ++dt) { const bf16x8 vf = *(const LAS bf16x8*)(va + dt * 32 * PV + po); o[dt] = __builtin_amdgcn_mfma_f32_32x32x16_bf16(vf, pf[g], o[dt], 0, 0, 0); } }
            mx_cur = rowmax(mw_now, false, n0, n1);
        } else {
            if (actn) qk(kt + 1, n0, n1);
            if (act) {
                const float mc = m_use * c;
                float ps = 0.f;
#pragma unroll
                for (int r = 0; r < 16; ++r) { c0[r] = __builtin_amdgcn_exp2f(fmaf(c0[r], c, -mc)); c1[r] = __builtin_amdgcn_exp2f(fmaf(c1[r], c, -mc)); ps += c0[r] + c1[r]; }
                l_run += ps;
                bf16x8 pf[4]; u32x4 t;
                t.x = cvtpk(c0[0], c0[1]); t.y = cvtpk(c0[2], c0[3]); t.z = cvtpk(c0[4], c0[5]); t.w = cvtpk(c0[6], c0[7]); pf[0] = *(bf16x8*)&t;
                t.x = cvtpk(c0[8], c0[9]); t.y = cvtpk(c0[10], c0[11]); t.z = cvtpk(c0[12], c0[13]); t.w = cvtpk(c0[14], c0[15]); pf[1] = *(bf16x8*)&t;
                t.x = cvtpk(c1[0], c1[1]); t.y = cvtpk(c1[2], c1[3]); t.z = cvtpk(c1[4], c1[5]); t.w = cvtpk(c1[6], c1[7]); pf[2] = *(bf16x8*)&t;
                t.x = cvtpk(c1[8], c1[9]); t.y = cvtpk(c1[10], c1[11]); t.z = cvtpk(c1[12], c1[13]); t.w = cvtpk(c1[14], c1[15]); pf[3] = *(bf16x8*)&t;
                const LAS unsigned char* va = lds + V_OFF + (kt & 1) * VB_BYTES + n * PV;
#pragma unroll
                for (int g = 0; g < 4; ++g) { const int po = ((2 * g + hf) ^ vswz) * 16;
#pragma unroll
                    for (int dt = 0; dt < 4; ++dt) { const bf16x8 vf = *(const LAS bf16x8*)(va + dt * 32 * PV + po); o[dt] = __builtin_amdgcn_mfma_f32_32x32x16_bf16(vf, pf[g], o[dt], 0, 0, 0); } }
            }
            if (actn) mx_cur = rowmax(mw_now, false, n0, n1);
        }
        asm volatile("s_waitcnt vmcnt(0)" ::: "memory");
        __syncthreads();
    };
    int kt = 0;
    for (; kt < 4 * qb; kt += 2) { step(kt, sa0, sa1, sb0, sb1, TTrue{}); step(kt + 1, sb0, sb1, sa0, sa1, TTrue{}); }
    for (; kt < nt; kt += 2) { step(kt, sa0, sa1, sb0, sb1, TFalse{}); step(kt + 1, sb0, sb1, sa0, sa1, TFalse{}); }
    const float lt = l_run + __shfl_xor(l_run, 32);
    const float inv = 1.0f / lt;
    bf16_t* op = a.O + grow * a.ldo + h * 128 + hf * 4;
#pragma unroll
    for (int dt = 0; dt < 4; ++dt)
#pragma unroll
        for (int r4 = 0; r4 < 4; ++r4) { u32x2 wv; wv.x = cvtpk(o[dt][4 * r4] * inv, o[dt][4 * r4 + 1] * inv); wv.y = cvtpk(o[dt][4 * r4 + 2] * inv, o[dt][4 * r4 + 3] * inv);
            *(u32x2*)(op + dt * 32 + r4 * 8) = wv; }
}
template <int DQK, bool MASKED>
__device__ __forceinline__ void attn_phase(LAS unsigned char* lds, const AttnArgs& a, int bid, int nblk) {
    for (int p = bid; p < 512; p += nblk) {
        const int bh = (p & 7) + 8 * (p >> 8), j = (p >> 3) & 31;
#pragma unroll 1
        for (int i = 0; i < 2; ++i) { if (DQK == 128) attn_item3<DQK, MASKED>(lds, a, bh >> 3, bh & 7, i ? j : 63 - j); else attn_item<DQK, MASKED>(lds, a, bh >> 3, bh & 7, i ? j : 63 - j); }
    }
}

typedef _Float16 f16x8 __attribute__((ext_vector_type(8)));
struct IdxArgs { const float* QI; const unsigned short* KI16; const float* WI; unsigned long long* MT; };
static constexpr int IDX_CAP = 640, IDX_CS = 0, IDX_CI = 32 * IDX_CAP * 4, IDX_KT = IDX_CI + 32 * IDX_CAP * 2, IDX_CNT = IDX_KT + 32768, IDX_TAU = IDX_CNT + 128, IDX_LDS = IDX_TAU + 128;
static_assert(IDX_KT % 1024 == 0, "K tile buffers must be 1 KiB aligned");

__device__ __forceinline__ float ord_inv(unsigned T) { return __uint_as_float((T & 0x80000000u) ? (T & 0x7FFFFFFFu) : ~T); }
__device__ __forceinline__ unsigned lane_prefix(unsigned long long m) { return __builtin_amdgcn_mbcnt_hi((unsigned)(m >> 32), __builtin_amdgcn_mbcnt_lo((unsigned)m, 0u)); }
__device__ __forceinline__ float relu_asm(float x) { float y; asm("v_max_f32 %0, 0, %1" : "=v"(y) : "v"(x)); return y; }
__device__ __forceinline__ void glds16(const void* gsrc, unsigned lds_dst) {
    unsigned keep;
    asm volatile("s_mov_b32 %0, m0\n\ts_mov_b32 m0, %2\n\ts_nop 0\n\tglobal_load_lds_dwordx4 %1, off\n\ts_mov_b32 m0, %0" : "=&s"(keep) : "v"(gsrc), "s"(lds_dst) : "memory");
}

template <bool EXACT> __device__ __forceinline__ int idx_compact(LAS unsigned char* lds, int qq, int lane, int n, float& tau) {
    LAS float* cs = (LAS float*)(lds + IDX_CS) + qq * IDX_CAP; LAS unsigned short* ci = (LAS unsigned short*)(lds + IDX_CI) + qq * IDX_CAP;
    float sv[10]; unsigned short iv[10]; unsigned uk[10];
#pragma unroll
    for (int j = 0; j < 10; ++j) { const int idx = lane + 64 * j; const bool valid = idx < n; sv[j] = cs[idx]; iv[j] = ci[idx]; uk[j] = valid ? ord_key(sv[j]) : 0u; }
    auto count_ge = [&](unsigned t) { int c = 0;
#pragma unroll
        for (int j = 0; j < 10; ++j) c += __builtin_popcountll(__ballot(uk[j] >= t));
        return c; };
    unsigned lo = ord_key(tau), hi = 0xFF800001u;
    if (lo > 0x80800000u) { const unsigned h2 = lo + 0x00800000u;
        if (h2 < hi) { if (count_ge(h2) >= 256) lo = h2; else hi = h2; } }
    while (hi - lo > 1u) {
        const unsigned mid = lo + ((hi - lo) >> 1); const int c = count_ge(mid);
        if (c >= 256) { lo = mid; if (!EXACT && c <= 336) break; } else hi = mid;
    }
    const unsigned T = lo;
    int need = 0;
    if (EXACT) { int ngt = 0;
#pragma unroll
        for (int j = 0; j < 10; ++j) ngt += __builtin_popcountll(__ballot(uk[j] > T));
        need = 256 - ngt; }
    int base = 0, tiebase = 0;
#pragma unroll
    for (int j = 0; j < 10; ++j) {
        bool keep;
        if (EXACT) { const bool gt = uk[j] > T, eq = uk[j] == T; const unsigned long long em = __ballot(eq); keep = gt || (eq && (tiebase + (int)lane_prefix(em)) < need); tiebase += __builtin_popcountll(em); }
        else keep = uk[j] >= T;
        const unsigned long long km = __ballot(keep);
        const int pos = base + (int)lane_prefix(km);
        if (keep) { cs[pos] = sv[j]; ci[pos] = iv[j]; }
        base += __builtin_popcountll(km);
    }
    tau = ord_inv(T);
    return base;
}

__device__ __forceinline__ void idx_item(LAS unsigned char* lds, const IdxArgs& a, int b, int hc) {
    const int tid = opaque_tid(), lane = tid & 63, w = __builtin_amdgcn_readfirstlane(tid >> 6), n = lane & 31, hf = lane >> 5;
    const int t0 = hc * 32, L = (t0 / 64 + 1) * 64, nsub = L / 32, ntile = (L + 127) / 128;
    const size_t q0 = (size_t)b * SEQ + t0 + 4 * w;
    LAS float* cs = (LAS float*)(lds + IDX_CS); LAS unsigned short* ci = (LAS unsigned short*)(lds + IDX_CI);
    LAS unsigned* cnt = (LAS unsigned*)(lds + IDX_CNT);
    f16x8 qf[2][4];
#pragma unroll
    for (int rt = 0; rt < 2; ++rt) { const float* qp = a.QI + (q0 + 2 * rt + (n >> 4)) * 1024 + (n & 15) * 64 + hf * 8;
#pragma unroll
        for (int ks = 0; ks < 4; ++ks) { const f32x4 x0 = *(const f32x4*)(qp + ks * 16), x1 = *(const f32x4*)(qp + ks * 16 + 4);
            f16x8 v; v[0] = (_Float16)x0[0]; v[1] = (_Float16)x0[1]; v[2] = (_Float16)x0[2]; v[3] = (_Float16)x0[3]; v[4] = (_Float16)x1[0]; v[5] = (_Float16)x1[1]; v[6] = (_Float16)x1[2]; v[7] = (_Float16)x1[3];
            qf[rt][ks] = v; } }
    float wv[2][16];
#pragma unroll
    for (int rt = 0; rt < 2; ++rt)
#pragma unroll
        for (int r = 0; r < 16; ++r) wv[rt][r] = a.WI[(q0 + 2 * rt + (r >> 3)) * 16 + (((r & 3) + 8 * (r >> 2) + 4 * hf) & 15)] * (0.125f * 0.25f);
    if (tid < 32) cnt[tid] = 0u;
    int cq0 = 0, cq1 = 0, cq2 = 0, cq3 = 0;
    float tq0 = -INFINITY, tq1 = -INFINITY, tq2 = -INFINITY, tq3 = -INFINITY;
    float tau0 = INFINITY, tau1 = INFINITY;
    const unsigned short* Kg = a.KI16 + (size_t)b * SEQ * 64;
    const unsigned ldsbase = (unsigned)(size_t)lds;
    auto dma = [&](int kt, int buf) {
#pragma unroll
        for (int i = 0; i < 2; ++i) { const int s = (w + 8 * i) * 64 + lane, r = s >> 3, cp = s & 7, cc = cp ^ ((r >> 1) & 7);
            glds16(Kg + (size_t)(kt * 128 + r) * 64 + cc * 8, ldsbase + IDX_KT + buf * 16384 + (w + 8 * i) * 1024); }
    };
    dma(0, 0);
    asm volatile("s_waitcnt vmcnt(0)" ::: "memory");
    __syncthreads();
    const int kswz = (n >> 1) & 7;
    f32x16 accA[2], accB[2];
#pragma unroll
    for (int rt = 0; rt < 2; ++rt)
#pragma unroll
        for (int r = 0; r < 16; ++r) { accA[rt][r] = 0.f; accB[rt][r] = 0.f; }
    int keyA = 0, keyB = 0;
    auto epilogue = [&](const f32x16 (&acc)[2], int key) {
        float sc[2];
#pragma unroll
        for (int rt = 0; rt < 2; ++rt) { float pa = 0.f, pb = 0.f;
#pragma unroll
            for (int r = 0; r < 8; ++r) { pa = fmaf(relu_asm(acc[rt][r]), wv[rt][r], pa); pb = fmaf(relu_asm(acc[rt][r + 8]), wv[rt][r + 8], pb); }
            const auto rr = __builtin_amdgcn_permlane32_swap(__float_as_uint(pa), __float_as_uint(pb), false, false);
            sc[rt] = __uint_as_float(rr[0]) + __uint_as_float(rr[1]); }
        const bool c0 = sc[0] > tau0, c1 = sc[1] > tau1;
        const unsigned long long m0 = __ballot(c0), m1 = __ballot(c1);
        if (m0 | m1) {
            const unsigned l0 = (unsigned)m0, h0 = (unsigned)(m0 >> 32), l1 = (unsigned)m1, h1 = (unsigned)(m1 >> 32);
            const int p0 = hf ? cq1 + (int)__builtin_amdgcn_mbcnt_hi(h0, 0u) : cq0 + (int)__builtin_amdgcn_mbcnt_lo(l0, 0u);
            const int p1 = hf ? cq3 + (int)__builtin_amdgcn_mbcnt_hi(h1, 0u) : cq2 + (int)__builtin_amdgcn_mbcnt_lo(l1, 0u);
            if (c0 && p0 < IDX_CAP) { const int qq = 4 * w + hf; cs[qq * IDX_CAP + p0] = sc[0]; ci[qq * IDX_CAP + p0] = (unsigned short)key; }
            if (c1 && p1 < IDX_CAP) { const int qq = 4 * w + 2 + hf; cs[qq * IDX_CAP + p1] = sc[1]; ci[qq * IDX_CAP + p1] = (unsigned short)key; }
            cq0 += __builtin_popcount(l0); cq1 += __builtin_popcount(h0); cq2 += __builtin_popcount(l1); cq3 += __builtin_popcount(h1);
        }
    };
    auto mma = [&](f32x16 (&acc)[2], const LAS unsigned char* kr) {
        f16x8 kf[4];
#pragma unroll
        for (int ks = 0; ks < 4; ++ks) kf[ks] = *(const LAS f16x8*)(kr + ((2 * ks + hf) ^ kswz) * 16);
#pragma unroll
        for (int rt = 0; rt < 2; ++rt) {
            f32x16 c;
#pragma unroll
            for (int r = 0; r < 16; ++r) c[r] = 0.f;
#pragma unroll
            for (int ks = 0; ks < 4; ++ks) c = __builtin_amdgcn_mfma_f32_32x32x16_f16(qf[rt][ks], kf[ks], c, 0, 0, 0);
            acc[rt] = c; }
    };
#ifdef IDX_PROBE2
  for (int rep_ = 0; rep_ < 2; ++rep_) {
    if (rep_ == 1) { epilogue(accB, keyB); tau0 = INFINITY; tau1 = INFINITY; __syncthreads(); dma(0, 0); asm volatile("s_waitcnt vmcnt(0)" ::: "memory"); __syncthreads(); }
#endif
    for (int kt = 0; kt < ntile; ++kt) {
        if (kt + 1 < ntile) dma(kt + 1, (kt + 1) & 1);
#ifdef IDX_PROBE2
        if (rep_ == 0)
#endif
        { const unsigned c_all = cnt[lane & 31];
          if (__ballot(c_all > (unsigned)(IDX_CAP - 160))) {
              if (cq0 > 400) cq0 = idx_compact<false>(lds, 4 * w + 0, lane, cq0, tq0);
              if (cq1 > 400) cq1 = idx_compact<false>(lds, 4 * w + 1, lane, cq1, tq1);
              if (cq2 > 400) cq2 = idx_compact<false>(lds, 4 * w + 2, lane, cq2, tq2);
              if (cq3 > 400) cq3 = idx_compact<false>(lds, 4 * w + 3, lane, cq3, tq3);
              if (kt > 0) { tau0 = hf ? tq1 : tq0; tau1 = hf ? tq3 : tq2; }
          } }
        const LAS unsigned char* kb = lds + IDX_KT + (kt & 1) * 16384 + n * 128;
        const int sbase = kt * 4;
#ifdef IDX_PROBE2
        if (sbase + 0 < nsub) { mma(accA, kb); epilogue(accB, keyB); keyA = kt * 128 + n; if (kt == 0 && rep_ == 0) { tau0 = -INFINITY; tau1 = -INFINITY; } }
#else
        if (sbase + 0 < nsub) { mma(accA, kb); epilogue(accB, keyB); keyA = kt * 128 + n; if (kt == 0) { tau0 = -INFINITY; tau1 = -INFINITY; } }
#endif
        if (sbase + 1 < nsub) { mma(accB, kb + 32 * 128); epilogue(accA, keyA); keyB = kt * 128 + 32 + n; }
        if (sbase + 2 < nsub) { mma(accA, kb + 64 * 128); epilogue(accB, keyB); keyA = kt * 128 + 64 + n; }
        if (sbase + 3 < nsub) { mma(accB, kb + 96 * 128); epilogue(accA, keyA); keyB = kt * 128 + 96 + n; }
        if (lane < 4) cnt[4 * w + lane] = (unsigned)(lane == 0 ? cq0 : (lane == 1 ? cq1 : (lane == 2 ? cq2 : cq3)));
        asm volatile("s_waitcnt vmcnt(0)" ::: "memory");
        __syncthreads();
    }
#ifdef IDX_PROBE2
  }
#endif
    epilogue(accB, keyB);
    __syncthreads();
    LAS unsigned* bm = (LAS unsigned*)(lds + IDX_KT) + w * 512;
    if (cq0 > 256) cq0 = idx_compact<true>(lds, 4 * w + 0, lane, cq0, tq0);
    if (cq1 > 256) cq1 = idx_compact<true>(lds, 4 * w + 1, lane, cq1, tq1);
    if (cq2 > 256) cq2 = idx_compact<true>(lds, 4 * w + 2, lane, cq2, tq2);
    if (cq3 > 256) cq3 = idx_compact<true>(lds, 4 * w + 3, lane, cq3, tq3);
#pragma unroll 1
    for (int i = 0; i < 4; ++i) {
        const int qq = 4 * w + i;
        const int nsel = (i == 0) ? cq0 : ((i == 1) ? cq1 : ((i == 2) ? cq2 : cq3));
#pragma unroll
        for (int j = 0; j < 8; ++j) bm[lane + 64 * j] = 0u;
#pragma unroll
        for (int j = 0; j < 4; ++j) { const int idx = lane + 64 * j; if (idx < nsel) { const unsigned k = ci[qq * IDX_CAP + idx]; (void)__hip_atomic_fetch_or(bm + (k >> 5), 1u << (k & 31), __ATOMIC_RELAXED, __HIP_MEMORY_SCOPE_WORKGROUP); } }
        const int tq = t0 + qq;
#pragma unroll 1
        for (int kt = lane; kt < L / 64; kt += 64) { const unsigned long long v = (unsigned long long)bm[2 * kt] | ((unsigned long long)bm[2 * kt + 1] << 32); a.MT[((size_t)b * 256 + kt) * SEQ + tq] = v; }
    }
    __syncthreads();
}
__device__ __forceinline__ void idx_phase(LAS unsigned char* lds, const IdxArgs& a, int bid, int nblk) {
    for (int k = bid; k < 256; k += nblk) {
#pragma unroll 1
        for (int i = 0; i < 4; ++i) idx_item(lds, a, i & 1, (i < 2) ? 511 - k : k);
    }
}
#define XB_TMO      128
#define XB_XCNT(j)  (256  + 64 * (j))
#define XB_XSUB(j)  (1280 + 64 * (j))
#define XB_XGEN(j)  (2304 + 64 * (j))
#define XB_TOP      3328
#define XB_TOPGEN   3392
#define XCD_BAR_WORDS 3456
#define XB_SPIN_CAP (1u << 23)


__device__ __forceinline__ unsigned xb_ld(unsigned* p)              { return __hip_atomic_load(p, __ATOMIC_RELAXED, __HIP_MEMORY_SCOPE_AGENT); }
__device__ __forceinline__ unsigned xb_add(unsigned* p, unsigned v) { return __hip_atomic_fetch_add(p, v, __ATOMIC_RELAXED, __HIP_MEMORY_SCOPE_AGENT); }
__device__ __forceinline__ unsigned xb_xcc_id() { return (unsigned)__builtin_amdgcn_s_getreg((3 << 11) | 20) & 0xFu; }
#define XB_SPIN(cond, bar) do { unsigned _sp = 0; while (cond) { __builtin_amdgcn_s_sleep(1); \
    if ((++_sp & 255u) == 0u) { if (xb_ld(&(bar)[XB_TMO])) break; if (_sp > XB_SPIN_CAP) { atomicAdd(&(bar)[XB_TMO], 1u); break; } } } } while (0)

struct XcdBarrier {
    unsigned* bar; unsigned x;
    volatile LAS unsigned* st;
};

__device__ __forceinline__ XcdBarrier xcd_barrier_post(unsigned* bar, volatile LAS unsigned* st) {
    XcdBarrier b; b.bar = bar; b.x = xb_xcc_id(); b.st = st;
    if (threadIdx.x == 0) (void)xb_add(&bar[XB_XCNT(b.x)], 1u);
    return b;
}
__device__ __forceinline__ void xcd_barrier_complete(unsigned* bar, unsigned x, unsigned& nloc, unsigned& nx) {
    const unsigned G = gridDim.x * gridDim.y * gridDim.z;
    unsigned sum, cnt, mine, sp = 0u;
    for (;;) {
        sum = 0u; cnt = 0u; mine = 0u;
#pragma unroll
        for (unsigned j = 0; j < 16; ++j) { const unsigned c = xb_ld(&bar[XB_XCNT(j)]); sum += c; cnt += (c > 0u) ? 1u : 0u; mine = (j == x) ? c : mine; }
        if (sum == G) break;
        __builtin_amdgcn_s_sleep(1);
        if ((++sp & 255u) == 0u) { if (xb_ld(&bar[XB_TMO])) break; if (sp > XB_SPIN_CAP) { atomicAdd(&bar[XB_TMO], 1u); break; } }
    }
    nloc = mine > 0u ? mine : 1u; nx = cnt > 0u ? cnt : 1u;
}

__device__ __forceinline__ void xcd_barrier(const XcdBarrier& b) {
    asm volatile("s_waitcnt vmcnt(0)" ::: "memory");
    __syncthreads();
    if (threadIdx.x == 0) {
        unsigned* bar = b.bar;
        __builtin_amdgcn_s_waitcnt(0);
        unsigned nloc = b.st[0], nx = b.st[1];
        if (nloc == 0u) { xcd_barrier_complete(bar, b.x, nloc, nx); b.st[0] = nloc; b.st[1] = nx; }
        const unsigned old = xb_add(&bar[XB_XSUB(b.x)], 1u);
        const unsigned gen = old / nloc;
        if (old + 1u == (gen + 1u) * nloc) {
            __builtin_amdgcn_fence(__ATOMIC_RELEASE, "agent");
            asm volatile("s_waitcnt vmcnt(0)" ::: "memory");
            const unsigned og = xb_add(&bar[XB_TOP], 1u);
            const unsigned tg = og / nx;
            if (og + 1u == (tg + 1u) * nx) xb_add(&bar[XB_TOPGEN], 1u);
            else XB_SPIN(xb_ld(&bar[XB_TOPGEN]) == tg, bar);
            __builtin_amdgcn_fence(__ATOMIC_ACQUIRE, "agent");
            xb_add(&bar[XB_XGEN(b.x)], 1u);
            asm volatile("s_waitcnt vmcnt(0)" ::: "memory");
        } else {
            XB_SPIN(xb_ld(&bar[XB_XGEN(b.x)]) == gen, bar);
            __builtin_amdgcn_fence(__ATOMIC_ACQUIRE, "agent");
            asm volatile("s_waitcnt vmcnt(0)" ::: "memory");
        }
    }
    __syncthreads();
}

#ifndef FP8_UP0
#define FP8_UP0 0
#endif
#ifndef FP8_UP1
#define FP8_UP1 1
#endif
#ifndef SKIPMASK
#define SKIPMASK 0
#endif

__device__ __forceinline__ int perm16(int t) { const int a = (t >> 2) & 3; return (t & ~12) | ((a == 1 ? 2 : (a == 2 ? 1 : a)) << 2); }
__device__ __forceinline__ void st_vt(bf16_t* VT, int row, int h, int d, f32x4 v) {
    const int b = row / SEQ, t = row % SEQ; bf16_t* p = VT + ((size_t)(b * 8 + h) * 128 + d) * SEQ + (t & ~15) + perm16(t & 15);
    p[0] = f2bf(v[0]); p[SEQ] = f2bf(v[1]); p[2 * (size_t)SEQ] = f2bf(v[2]); p[3 * (size_t)SEQ] = f2bf(v[3]);
}
struct FAbIn2 { bf16_t *Q, *K, *VT; float *QI, *U, *WI; unsigned short* KI16;
    __device__ __forceinline__ void operator()(int r, int c, f32x4 v) const {
        if (c < 1024) st_bf16x4(Q + (size_t)r * 1024 + c, v);
        else if (c < 2048) st_bf16x4(K + (size_t)r * 1024 + (c - 1024), v);
        else if (c < 3072) st_vt(VT, r, (c - 2048) >> 7, (c - 2048) & 127, v);
        else if (c < 4096) st_f32x4(QI + (size_t)r * 1024 + (c - 3072), v);
        else if (c < 5120) st_f32x4(U + (size_t)r * 1024 + (c - 4096), v);
        else if (c < 5184) { typedef _Float16 h2 __attribute__((ext_vector_type(2))); union { h2 h; unsigned u; } a, b; a.h = (h2){(_Float16)v[0], (_Float16)v[1]}; b.h = (h2){(_Float16)v[2], (_Float16)v[3]};
            u32x2 w; w.x = a.u; w.y = b.u; *(u32x2*)(KI16 + (size_t)r * 64 + (c - 5120)) = w; }
        else if (c < 5200) st_f32x4(WI + (size_t)r * 16 + (c - 5184), v);
    } };
struct FKvUp2 { bf16_t *K1, *VT;
    __device__ __forceinline__ void operator()(int r, int c, f32x4 v) const {
        const int h = c >> 8, d = c & 255;
        if (d < 128) st_bf16x4(K1 + (size_t)r * 1536 + h * 192 + d, v);
        else st_vt(VT, r, h, d - 128, v);
    } };

template <class E> __device__ __forceinline__ void ph_gemm_e(LAS unsigned char* lds, const bf16_t* A, int lda, const bf16_t* Bt, int ldb, int M, int N, int K, const E& e, int bid, int nblk, int a_shift = 0, int a_bytes = 0) {
    pg8::Gemm g; g.A = A; g.Bt = Bt; g.M = M; g.N = N; g.K = K; g.lda = lda; g.ldb = ldb; g.a_shift = a_shift; g.a_bytes = a_bytes; g.pad_ = 0;
    pg8::StaticOrder S; S.init(M, N, nblk, bid);
    pg8::gemm_phase<E, pg8::StaticOrder, false>(lds, g, S, e, nullptr);
    __syncthreads();
}
template <class F> __device__ __forceinline__ void ph_gemm(LAS unsigned char* lds, const bf16_t* A, int lda, const bf16_t* Bt, int ldb, int M, int N, int K, const F& f, int bid, int nblk, int a_shift = 0, int a_bytes = 0) {
    EpiG<F> e; e.f = f;
    ph_gemm_e(lds, A, lda, Bt, ldb, M, N, K, e, bid, nblk, a_shift, a_bytes);
}
template <class F> __device__ __forceinline__ void ph_gemm8(LAS unsigned char* lds, const unsigned char* A, int lda, const unsigned char* Bt, int ldb, int M, int N, int K, const F& f, int bid, int nblk) {
    EpiG<F, true> e; e.f = f;
    ph_gemm_e(lds, (const bf16_t*)A, lda / 2, (const bf16_t*)Bt, ldb / 2, M, N, K / 2, e, bid, nblk, 0, 0);
}
struct FPool { bf16_t* CC; const float* pb; const float* ps;
    __device__ __forceinline__ void operator()(int r, int c, f32x4 v) const { const f32x4 b = *(const f32x4*)(pb + c), s = *(const f32x4*)(ps + c); st_bf16x4(CC + (size_t)r * 2048 + 1024 + c, (v + b) * s); } };
struct EpiLru {
    static constexpr bool PERM = false, AFTER_DRAIN = false, FP8 = false;
    const bf16_t* XCB; const float *ba, *bx, *lam; float *LA, *LB;
    __device__ __forceinline__ void operator()(const f32x4 (&acc)[2][2][4][2], const pg8::Unit& u, int wr, int wc, int fr, int fq) const {
        const int row0 = u.pm * 256 + wr * 64 + fr;
#pragma unroll
        for (int n = 0; n < 2; ++n) {
            const int ch = u.pn * 128 + wc * 32 + 16 * n + 4 * fq;
            const f32x4 bav = *(const f32x4*)(ba + ch), bxv = *(const f32x4*)(bx + ch), lm = *(const f32x4*)(lam + ch);
            f32x4 sp;
#pragma unroll
            for (int j = 0; j < 4; ++j) sp[j] = log1pf(__expf(-lm[j]));
#pragma unroll
            for (int ai = 0; ai < 2; ++ai)
#pragma unroll
                for (int m = 0; m < 4; ++m) {
                    const int row = row0 + ai * 128 + m * 16;
                    const u32x2 xw = *(const u32x2*)(XCB + (size_t)row * 1024 + ch);
                    const f32x4 xc = {__uint_as_float(xw.x << 16), __uint_as_float(xw.x & 0xFFFF0000u), __uint_as_float(xw.y << 16), __uint_as_float(xw.y & 0xFFFF0000u)};
                    const f32x4 ga = acc[ai][0][m][n] + bav, gx = acc[ai][1][m][n] + bxv;
                    f32x4 av, bv;
#pragma unroll
                    for (int j = 0; j < 4; ++j) {
                        const float rg = 1.0f / (1.0f + __expf(-ga[j])), ig = 1.0f / (1.0f + __expf(-gx[j]));
                        const float log_a = -8.0f * rg * sp[j], a = __expf(log_a), mult = sqrtf(-expm1f(2.0f * log_a));
                        av[j] = a; bv[j] = mult * (ig * xc[j]);
                    }
                    *(f32x4*)(LA + (size_t)row * 1024 + ch) = av; *(f32x4*)(LB + (size_t)row * 1024 + ch) = bv;
                }
        }
    }
};
__device__ __forceinline__ void ph_pooled(const float* __restrict__ U, bf16_t* __restrict__ P, int bid, int nblk) {
    for (int i = bid * 512 + opaque_tid(); i < 256 * (NTOK / 64); i += nblk * 512) {
        const int c4 = i & 255, row0 = (i >> 8) * 64, t0 = row0 % SEQ, g = c4 >> 6, win = 2 << g;
        const f32x4* up = (const f32x4*)U + (size_t)row0 * 256 + c4;
        f32x4 s = {0.f, 0.f, 0.f, 0.f};
        if (t0 > 0) { for (int k = 1; k < win; ++k) s += up[-(ptrdiff_t)k * 256]; }
        for (int r = 0; r < 64; ++r) {
            const int t = t0 + r; const f32x4 u0 = up[(ptrdiff_t)r * 256];
            s += u0;
            const int cnt = (t + 1 < win) ? (t + 1) : win;
            st_bf16x4(P + (size_t)(row0 + r) * 1024 + c4 * 4, s * (1.0f / (float)cnt) - u0);
            if (t + 1 >= win) s -= up[(ptrdiff_t)(r + 1 - win) * 256];
        }
    }
}
__device__ __forceinline__ void ph_xc(const bf16_t* __restrict__ XL, const float* __restrict__ cw, const float* __restrict__ cb, bf16_t* __restrict__ XCB, int bid, int nblk) {
    for (int i = bid * 512 + opaque_tid(); i < 128 * (NTOK / 32); i += nblk * 512) {
        const int c8 = (i & 127) * 8, row0 = (i >> 7) * 32, t0 = row0 % SEQ;
        float w0[8], w1[8], w2[8], w3[8], bb[8];
#pragma unroll
        for (int j = 0; j < 8; ++j) { w0[j] = cw[c8 + j]; w1[j] = cw[1024 + c8 + j]; w2[j] = cw[2048 + c8 + j]; w3[j] = cw[3072 + c8 + j]; bb[j] = cb[c8 + j]; }
        u32x4 p3 = {0u, 0u, 0u, 0u}, p2 = p3, p1 = p3;
        if (t0 >= 3) { p3 = *(const u32x4*)(XL + (size_t)(row0 - 3) * 1024 + c8); p2 = *(const u32x4*)(XL + (size_t)(row0 - 2) * 1024 + c8); p1 = *(const u32x4*)(XL + (size_t)(row0 - 1) * 1024 + c8); }
        for (int r = 0; r < 32; ++r) {
            const u32x4 cur = *(const u32x4*)(XL + (size_t)(row0 + r) * 1024 + c8);
            const unsigned a3[4] = {p3.x, p3.y, p3.z, p3.w}, a2[4] = {p2.x, p2.y, p2.z, p2.w}, a1[4] = {p1.x, p1.y, p1.z, p1.w}, a0[4] = {cur.x, cur.y, cur.z, cur.w};
            float y[8];
#pragma unroll
            for (int j = 0; j < 4; ++j) {
                y[2 * j] = bb[2 * j] + w0[2 * j] * __uint_as_float(a3[j] << 16) + w1[2 * j] * __uint_as_float(a2[j] << 16) + w2[2 * j] * __uint_as_float(a1[j] << 16) + w3[2 * j] * __uint_as_float(a0[j] << 16);
                y[2 * j + 1] = bb[2 * j + 1] + w0[2 * j + 1] * __uint_as_float(a3[j] & 0xFFFF0000u) + w1[2 * j + 1] * __uint_as_float(a2[j] & 0xFFFF0000u) + w2[2 * j + 1] * __uint_as_float(a1[j] & 0xFFFF0000u) + w3[2 * j + 1] * __uint_as_float(a0[j] & 0xFFFF0000u); }
            u32x4 o; o.x = pack2bf(y[0], y[1]); o.y = pack2bf(y[2], y[3]); o.z = pack2bf(y[4], y[5]); o.w = pack2bf(y[6], y[7]);
            *(u32x4*)(XCB + (size_t)(row0 + r) * 1024 + c8) = o;
            p3 = p2; p2 = p1; p1 = cur;
        }
    }
}
__device__ __forceinline__ void ph_convT(LAS unsigned char* lds, const float* __restrict__ W, int ldw, int src_col0, int ncols, int K, bf16_t* __restrict__ Bt, int ldd, int bid, int nblk) {
    const int tid = opaque_tid(), sub = tid >> 8, t8 = tid & 255, tx = t8 & 31, ty = t8 >> 5;
    LAS float* tile = (LAS float*)lds + sub * (32 * 33);
    const int ntx = (ncols + 31) / 32, ntiles = ntx * (K / 32);
    for (int base = bid * 2; base < ntiles; base += nblk * 2) {
        const int tl = base + sub; const bool act = tl < ntiles;
        const int n0 = (tl % ntx) * 32, k0 = (tl / ntx) * 32;
        if (act) {
#pragma unroll
            for (int i = 0; i < 4; ++i) { const int k = k0 + ty + 8 * i, n = n0 + tx; tile[(ty + 8 * i) * 33 + tx] = (n < ncols) ? W[(size_t)k * ldw + src_col0 + n] : 0.f; } }
        __syncthreads();
        if (act) {
#pragma unroll
            for (int i = 0; i < 4; ++i) { const int n = n0 + ty + 8 * i, k = k0 + tx; if (n < ncols) Bt[(size_t)n * ldd + k] = f2bf(tile[tx * 33 + ty + 8 * i]); } }
        __syncthreads();
    }
}
__device__ __forceinline__ void ph_convT8(LAS unsigned char* lds, const float* __restrict__ W, int ldw, int ncols, int K, unsigned char* __restrict__ Bt, int bid, int nblk) {
    const int tid = opaque_tid(), sub = tid >> 8, t8 = tid & 255, tx = t8 & 31, ty = t8 >> 5;
    LAS float* tile = (LAS float*)lds + sub * (32 * 33);
    const int ntx = ncols / 32, ntiles = ntx * (K / 32);
    for (int base = bid * 2; base < ntiles; base += nblk * 2) {
        const int tl = base + sub; const bool act = tl < ntiles;
        const int n0 = (tl % ntx) * 32, k0 = (tl / ntx) * 32;
        if (act) {
#pragma unroll
            for (int i = 0; i < 4; ++i) tile[(ty + 8 * i) * 33 + tx] = W[(size_t)(k0 + ty + 8 * i) * ldw + n0 + tx]; }
        __syncthreads();
        if (act) {
            const int nn = t8 >> 3, kk = (t8 & 7) * 4;
            int pk = 0;
            pk = __builtin_amdgcn_cvt_pk_fp8_f32(64.f * tile[(kk + 0) * 33 + nn], 64.f * tile[(kk + 1) * 33 + nn], pk, false);
            pk = __builtin_amdgcn_cvt_pk_fp8_f32(64.f * tile[(kk + 2) * 33 + nn], 64.f * tile[(kk + 3) * 33 + nn], pk, true);
            *(int*)(Bt + (size_t)(n0 + nn) * K + k0 + kk) = pk; }
        __syncthreads();
    }
}
template <int NC> __device__ __forceinline__ void ph_rmsnorm(const float* __restrict__ x, const float* __restrict__ g, bf16_t* __restrict__ out, int bid, int nblk) {
    const int lane = opaque_tid() & 63, w = opaque_tid() >> 6;
    constexpr int NV = NC / 256;
    for (int row = bid * 8 + w; row < NTOK; row += nblk * 8) {
        const f32x4* xr = (const f32x4*)(x + (size_t)row * NC);
        f32x4 v[NV]; float ss = 0.f;
#pragma unroll
        for (int i = 0; i < NV; ++i) { v[i] = xr[lane + 64 * i]; ss += v[i][0] * v[i][0] + v[i][1] * v[i][1] + v[i][2] * v[i][2] + v[i][3] * v[i][3]; }
        ss = wave_sum(ss);
        const float r = rsqrtf(ss * (1.0f / NC) + NORM_EPS);
#pragma unroll
        for (int i = 0; i < NV; ++i) { const f32x4 gg = ((const f32x4*)g)[lane + 64 * i]; st_bf16x4(out + (size_t)row * NC + 4 * (lane + 64 * i), v[i] * r * gg); }
    }
}
__device__ __forceinline__ void ph_resnorm(const float* xin, const bf16_t* __restrict__ m, const float* __restrict__ gpost, const float* __restrict__ gpre, float* xout, bf16_t* __restrict__ h, unsigned char* __restrict__ h8, int bid, int nblk) {
    const int lane = opaque_tid() & 63, w = opaque_tid() >> 6;
    for (int row = bid * 8 + w; row < NTOK; row += nblk * 8) {
        const f32x4* xr = (const f32x4*)(xin + (size_t)row * DM);
        const u32x2* mr = (const u32x2*)(m + (size_t)row * DM);
        f32x4 mv[8], xv[8]; float ss = 0.f;
#pragma unroll
        for (int i = 0; i < 8; ++i) { const u32x2 wd = mr[lane + 64 * i]; mv[i][0] = __uint_as_float(wd.x << 16); mv[i][1] = __uint_as_float(wd.x & 0xFFFF0000u); mv[i][2] = __uint_as_float(wd.y << 16); mv[i][3] = __uint_as_float(wd.y & 0xFFFF0000u);
            xv[i] = xr[lane + 64 * i]; ss += mv[i][0] * mv[i][0] + mv[i][1] * mv[i][1] + mv[i][2] * mv[i][2] + mv[i][3] * mv[i][3]; }
        ss = wave_sum(ss);
        const float r1 = rsqrtf(ss * (1.0f / DM) + NORM_EPS);
        float s2 = 0.f;
#pragma unroll
        for (int i = 0; i < 8; ++i) { const f32x4 gg = ((const f32x4*)gpost)[lane + 64 * i]; xv[i] = xv[i] + mv[i] * r1 * gg; ((f32x4*)(xout + (size_t)row * DM))[lane + 64 * i] = xv[i];
            s2 += xv[i][0] * xv[i][0] + xv[i][1] * xv[i][1] + xv[i][2] * xv[i][2] + xv[i][3] * xv[i][3]; }
        if (gpre) {
            s2 = wave_sum(s2);
            const float r2 = rsqrtf(s2 * (1.0f / DM) + NORM_EPS);
#pragma unroll
            for (int i = 0; i < 8; ++i) { const f32x4 gg = ((const f32x4*)gpre)[lane + 64 * i]; const f32x4 y = xv[i] * r2 * gg;
                if (h8) { int pk = 0; pk = __builtin_amdgcn_cvt_pk_fp8_f32(y[0], y[1], pk, false); pk = __builtin_amdgcn_cvt_pk_fp8_f32(y[2], y[3], pk, true); *(int*)(h8 + (size_t)row * DM + 4 * (lane + 64 * i)) = pk; }
                else st_bf16x4(h + (size_t)row * DM + 4 * (lane + 64 * i), y); }
        }
    }
}
__device__ __forceinline__ void ph_scan1(const float* __restrict__ Aa, const float* __restrict__ Bb, float* __restrict__ CA, float* __restrict__ CH, int bid, int nblk) {
    for (int i = bid * 512 + opaque_tid(); i < 2 * 256 * 1024; i += nblk * 512) {
        const int ch = i & 1023, chunk = (i >> 10) & 255, b = i >> 18;
        const size_t base = ((size_t)b * SEQ + (size_t)chunk * 64) * 1024 + ch;
        float h = 0.f, P = 1.f;
        for (int s = 0; s < 64; ++s) { const float a = Aa[base + (size_t)s * 1024]; h = a * h + Bb[base + (size_t)s * 1024]; P *= a; }
        CA[i] = P; CH[i] = h;
    }
}
__device__ __forceinline__ void ph_scan2(const float* __restrict__ CA, const float* __restrict__ CH, float* __restrict__ CIN, int bid, int nblk) {
    for (int i = bid * 512 + opaque_tid(); i < 2048; i += nblk * 512) {
        const int ch = i & 1023, b = i >> 10;
        float h = 0.f;
        for (int c = 0; c < 256; ++c) { const int j = (b * 256 + c) * 1024 + ch; CIN[j] = h; h = CA[j] * h + CH[j]; }
    }
}
__device__ __forceinline__ void ph_scan3(const float* __restrict__ Aa, const float* __restrict__ Bb, const float* __restrict__ CIN, const bf16_t* __restrict__ YG, bf16_t* __restrict__ CC, int bid, int nblk) {
    for (int i = bid * 512 + opaque_tid(); i < 2 * 256 * 1024; i += nblk * 512) {
        const int ch = i & 1023, chunk = (i >> 10) & 255, b = i >> 18;
        const size_t row0 = (size_t)b * SEQ + (size_t)chunk * 64;
        float h = CIN[i];
        for (int s = 0; s < 64; ++s) { const size_t r = row0 + s; h = Aa[r * 1024 + ch] * h + Bb[r * 1024 + ch];
            CC[r * 2048 + 1024 + ch] = f2bf(h * gelu_tanh(bf2f(YG[r * 1024 + ch]))); }
    }
}
__device__ __forceinline__ void ph_rope_q(bf16_t* __restrict__ Q1, const int* __restrict__ pos, int bid, int nblk) {
    for (int idx = bid * 512 + opaque_tid(); idx < NTOK * 8 * 32; idx += nblk * 512) {
        const int i = idx & 31, h = (idx >> 5) & 7, row = idx >> 8;
        float c, s; rope_cs(pos[row], i, c, s);
        bf16_t* p = Q1 + (size_t)row * 1536 + h * 192 + 128;
        const float x1 = bf2f(p[i]), x2 = bf2f(p[32 + i]);
        p[i] = f2bf(x1 * c - x2 * s); p[32 + i] = f2bf(x2 * c + x1 * s);
    }
}
__device__ __forceinline__ void ph_rope_k(const float* __restrict__ KR, const int* __restrict__ pos, bf16_t* __restrict__ K1, int bid, int nblk) {
    for (int idx = bid * 512 + opaque_tid(); idx < NTOK * 32; idx += nblk * 512) {
        const int i = idx & 31, row = idx >> 5;
        float c, s; rope_cs(pos[row], i, c, s);
        const float x1 = KR[(size_t)row * 64 + i], x2 = KR[(size_t)row * 64 + 32 + i];
        const bf16_t o1 = f2bf(x1 * c - x2 * s), o2 = f2bf(x2 * c + x1 * s);
#pragma unroll
        for (int h = 0; h < 8; ++h) { bf16_t* p = K1 + (size_t)row * 1536 + h * 192 + 128; p[i] = o1; p[32 + i] = o2; }
    }
}
__device__ __forceinline__ void ph_ffn_gate(const bf16_t* __restrict__ HID, const float* __restrict__ cw, const float* __restrict__ cb, bf16_t* __restrict__ ACT, int bid, int nblk) {
    for (int i = bid * 512 + opaque_tid(); i < 512 * (SEQ / 64); i += nblk * 512) {
        const int c8 = (i & 511) * 8, t0 = (i >> 9) * 64;
        float wg[3][8], wv[3][8], bg[8], bv[8];
#pragma unroll
        for (int j = 0; j < 8; ++j) { bg[j] = cb[c8 + j]; bv[j] = cb[4096 + c8 + j];
#pragma unroll
            for (int k = 0; k < 3; ++k) { wg[k][j] = cw[k * 8192 + c8 + j]; wv[k][j] = cw[k * 8192 + 4096 + c8 + j]; } }
        u32x4 g2 = {0u, 0u, 0u, 0u}, g1 = g2, v2 = g2, v1 = g2;
        if (t0 >= 2) { g2 = *(const u32x4*)(HID + (size_t)(t0 - 2) * 8192 + c8); g1 = *(const u32x4*)(HID + (size_t)(t0 - 1) * 8192 + c8);
                       v2 = *(const u32x4*)(HID + (size_t)(t0 - 2) * 8192 + 4096 + c8); v1 = *(const u32x4*)(HID + (size_t)(t0 - 1) * 8192 + 4096 + c8); }
        for (int r = 0; r < 64; ++r) {
            const u32x4 g0 = *(const u32x4*)(HID + (size_t)(t0 + r) * 8192 + c8), v0 = *(const u32x4*)(HID + (size_t)(t0 + r) * 8192 + 4096 + c8);
            const unsigned G2[4] = {g2.x, g2.y, g2.z, g2.w}, G1[4] = {g1.x, g1.y, g1.z, g1.w}, G0[4] = {g0.x, g0.y, g0.z, g0.w};
            const unsigned V2[4] = {v2.x, v2.y, v2.z, v2.w}, V1[4] = {v1.x, v1.y, v1.z, v1.w}, V0[4] = {v0.x, v0.y, v0.z, v0.w};
            float o[8];
#pragma unroll
            for (int j = 0; j < 4; ++j) {
                const float ge = bg[2 * j] + wg[0][2 * j] * __uint_as_float(G2[j] << 16) + wg[1][2 * j] * __uint_as_float(G1[j] << 16) + wg[2][2 * j] * __uint_as_float(G0[j] << 16);
                const float go = bg[2 * j + 1] + wg[0][2 * j + 1] * __uint_as_float(G2[j] & 0xFFFF0000u) + wg[1][2 * j + 1] * __uint_as_float(G1[j] & 0xFFFF0000u) + wg[2][2 * j + 1] * __uint_as_float(G0[j] & 0xFFFF0000u);
                const float ve = bv[2 * j] + wv[0][2 * j] * __uint_as_float(V2[j] << 16) + wv[1][2 * j] * __uint_as_float(V1[j] << 16) + wv[2][2 * j] * __uint_as_float(V0[j] << 16);
                const float vo = bv[2 * j + 1] + wv[0][2 * j + 1] * __uint_as_float(V2[j] & 0xFFFF0000u) + wv[1][2 * j + 1] * __uint_as_float(V1[j] & 0xFFFF0000u) + wv[2][2 * j + 1] * __uint_as_float(V0[j] & 0xFFFF0000u);
                o[2 * j] = gelu_tanh(ge) * ve; o[2 * j + 1] = gelu_tanh(go) * vo; }
            u32x4 ov; ov.x = pack2bf(o[0], o[1]); ov.y = pack2bf(o[2], o[3]); ov.z = pack2bf(o[4], o[5]); ov.w = pack2bf(o[6], o[7]);
            *(u32x4*)(ACT + (size_t)(t0 + r) * 4096 + c8) = ov;
            g2 = g1; g1 = g0; v2 = v1; v1 = v0;
        }
    }
}

__device__ __forceinline__ void ph_conv_lru(const float* __restrict__ wa, const float* __restrict__ wx, bf16_t* __restrict__ Bt, int bid, int nblk) {
    for (int e = bid * 512 + opaque_tid(); e < 8 * 2 * 128 * 128; e += nblk * 512) {
        const int d = e & 127, c = (e >> 7) & 127, gate = (e >> 14) & 1, nb = e >> 15;
        const float v = (gate ? wx : wa)[((size_t)nb * 128 + c) * 128 + d];
        bf16_t* row = Bt + (size_t)(nb * 256 + gate * 128 + d) * 256;
        row[(nb & 1) * 128 + c] = f2bf(v); row[(1 - (nb & 1)) * 128 + c] = 0;
    }
}

static constexpr size_t MiB = 1048576;
static constexpr size_t W_UP0 = 0 * MiB, W_UP1 = 32 * MiB, W_DN0 = 64 * MiB, W_DN1 = 80 * MiB, W_ABIN = 96 * MiB, W_ABOUT = 117 * MiB, W_CDIN = 125 * MiB, W_CDOUT = 137 * MiB,
                        W_QUP = 145 * MiB, W_KVUP = 146 * MiB + 512 * 1024, W_POOL = 147 * MiB + 512 * 1024;
static constexpr size_t R_H = 148 * MiB;
static constexpr size_t R_Q0 = 276 * MiB, R_K0 = 340 * MiB, R_VT0 = 404 * MiB, R_QI = 468 * MiB, R_M0 = 468 * MiB, R_U = 596 * MiB, R_KI = 724 * MiB, R_WI = 732 * MiB, R_MASK = 734 * MiB, R_CC0 = 830 * MiB, R_POOLED = 958 * MiB;
static constexpr size_t R_HID = 276 * MiB, R_ACT = 532 * MiB, R_F = 660 * MiB;
static constexpr size_t R_VT1 = 276 * MiB, R_CQ = 276 * MiB, R_CKV = 340 * MiB, R_KR = 372 * MiB, R_XL = 380 * MiB, R_YG = 444 * MiB, R_CQN = 508 * MiB, R_CKVN = 540 * MiB, R_LA = 556 * MiB, R_LB = 684 * MiB,
                        R_Q1 = 812 * MiB, R_K1 = 908 * MiB, R_CA = 1004 * MiB, R_CH = 1006 * MiB, R_CIN = 1008 * MiB, R_CC1 = 148 * MiB, R_M1 = 276 * MiB, R_XCB = 148 * MiB, W_LRU = 1010 * MiB;
static constexpr size_t WS_BAR = 1022 * MiB, WS_NEED = 1022 * MiB + 65536;
static constexpr int MK_LDS = 162816;

struct MK { const float* in[28]; float* out; unsigned char* ws; int ph_lo, ph_hi; };

__global__ __launch_bounds__(512, 2) void k_mega(MK p) {
    extern __shared__ __attribute__((aligned(16))) unsigned char shm[];
    LAS unsigned char* lds = (LAS unsigned char*)shm;
    const int bid0 = (int)blockIdx.x, nblk0 = (int)gridDim.x;
    volatile LAS unsigned* xbw = (volatile LAS unsigned*)(lds + MK_LDS - 16);
    if (threadIdx.x == 0) { xbw[0] = 0u; xbw[1] = 0u; xbw[2] = 0u; xbw[3] = 0u; }
    if ((threadIdx.x & 63) == 0) *(volatile LAS int*)(size_t)(TID_TAB_LDS + 4 * ((unsigned)__builtin_amdgcn_s_getreg(((6 - 1) << 11) | 4) & 63u)) = (int)(threadIdx.x >> 6);
    __syncthreads();
    XcdBarrier bar = xcd_barrier_post((unsigned*)(p.ws + WS_BAR), xbw);
#ifndef KARG_PLAIN
#define KARG_PLAIN 0
#endif
#if KARG_PLAIN
#define KARG_DECL const MK& P_ = p;
#else
#define KARG_DECL KPtr P__ = kp; asm volatile("" : "+s"(P__)); const __attribute__((address_space(4))) MK& P_ = *P__;
#endif
    typedef const __attribute__((address_space(4))) MK* KPtr;
    KPtr kp = (KPtr)__builtin_amdgcn_kernarg_segment_ptr();
#define WSP(T, off) ((T*)(ws + (off)))
#define PHASE_BEGIN if (pc >= p.ph_lo && pc < p.ph_hi) { const int bid = opaque_s(bid0), nblk = opaque_s(nblk0); \
    KARG_DECL unsigned char* const ws = P_.ws; float* const xo = P_.out; const float* const x = P_.in[0]; const int* const positions = (const int*)P_.in[1]; \
    const float *const mix_pre_g = P_.in[2], *const mix_post_g = P_.in[3], *const ffn_pre_g = P_.in[4], *const ffn_post_g = P_.in[5], *const ffn_up = P_.in[6], *const ffn_conv_w = P_.in[7], *const ffn_conv_b = P_.in[8], *const ffn_down = P_.in[9], \
    *const ab_w_in = P_.in[10], *const pool_w = P_.in[11], *const pool_b = P_.in[12], *const pool_scale = P_.in[13], *const ab_w_out = P_.in[14], *const cd_w_in = P_.in[15], *const q_norm_g = P_.in[16], *const w_q_up = P_.in[17], \
    *const kv_norm_g = P_.in[18], *const w_kv_up = P_.in[19], *const lru_conv_w = P_.in[20], *const lru_conv_b = P_.in[21], *const lru_wa = P_.in[22], *const lru_ba = P_.in[23], *const lru_wx = P_.in[24], *const lru_bx = P_.in[25], \
    *const lru_lambda = P_.in[26], *const cd_w_out = P_.in[27]; bf16_t* const H = WSP(bf16_t, R_H); const bf16_t* const CC = WSP(bf16_t, LAYER_CC); bf16_t* const Mx = WSP(bf16_t, LAYER_MX); \
    (void)xo; (void)x; (void)positions; (void)mix_pre_g; (void)mix_post_g; (void)ffn_pre_g; (void)ffn_post_g; (void)ffn_up; (void)ffn_conv_w; (void)ffn_conv_b; (void)ffn_down; (void)ab_w_in; (void)pool_w; (void)pool_b; (void)pool_scale; \
    (void)ab_w_out; (void)cd_w_in; (void)q_norm_g; (void)w_q_up; (void)kv_norm_g; (void)w_kv_up; (void)lru_conv_w; (void)lru_conv_b; (void)lru_wa; (void)lru_ba; (void)lru_wx; (void)lru_bx; (void)lru_lambda; (void)cd_w_out; (void)H; (void)CC; (void)Mx;
#define PHASE_END } if (pc >= p.ph_lo && pc + 1 < p.ph_hi) xcd_barrier(bar); ++pc;
    int pc = 0;
#define LAYER_CC R_CC0
#define LAYER_MX R_M0
    PHASE_BEGIN
#if !((SKIPMASK >> 0) & 1)
#if FP8_UP0
        ph_convT8(lds, ffn_up, 8192, 8192, 2048, WSP(unsigned char, W_UP0), bid, nblk);
#else
        ph_convT(lds, ffn_up, 8192, 0, 8192, 2048, WSP(bf16_t, W_UP0), 2048, bid, nblk);
#endif
#if FP8_UP1
        ph_convT8(lds, ffn_up + (size_t)2048 * 8192, 8192, 8192, 2048, WSP(unsigned char, W_UP1), bid, nblk);
#else
        ph_convT(lds, ffn_up + (size_t)2048 * 8192, 8192, 0, 8192, 2048, WSP(bf16_t, W_UP1), 2048, bid, nblk);
#endif
        ph_convT(lds, ffn_down, 2048, 0, 2048, 4096, WSP(bf16_t, W_DN0), 4096, bid, nblk);
        ph_convT(lds, ffn_down + (size_t)4096 * 2048, 2048, 0, 2048, 4096, WSP(bf16_t, W_DN1), 4096, bid, nblk);
        ph_convT(lds, ab_w_in, 5200, 0, 4096, 2048, WSP(bf16_t, W_ABIN), 2048, bid, nblk);
        ph_convT(lds, ab_w_in, 5200, 4176, 1024, 2048, WSP(bf16_t, W_ABIN) + (size_t)4096 * 2048, 2048, bid, nblk);
        ph_convT(lds, ab_w_in, 5200, 4096, 64, 2048, WSP(bf16_t, W_ABIN) + (size_t)5120 * 2048, 2048, bid, nblk);
        ph_convT(lds, ab_w_in, 5200, 4160, 16, 2048, WSP(bf16_t, W_ABIN) + (size_t)5184 * 2048, 2048, bid, nblk);
        ph_convT(lds, ab_w_out, 2048, 0, 2048, 2048, WSP(bf16_t, W_ABOUT), 2048, bid, nblk);
        ph_convT(lds, cd_w_in, 2880, 0, 832, 2048, WSP(bf16_t, W_CDIN), 2048, bid, nblk);
        ph_convT(lds, cd_w_in, 2880, 832, 2048, 2048, WSP(bf16_t, W_CDIN) + (size_t)1024 * 2048, 2048, bid, nblk);
        ph_convT(lds, cd_w_out, 2048, 0, 2048, 2048, WSP(bf16_t, W_CDOUT), 2048, bid, nblk);
        ph_convT(lds, w_q_up, 1536, 0, 1536, 512, WSP(bf16_t, W_QUP), 512, bid, nblk);
        ph_convT(lds, w_kv_up, 2048, 0, 2048, 256, WSP(bf16_t, W_KVUP), 256, bid, nblk);
        for (int g = 0; g < 4; ++g) ph_convT(lds, pool_w + (size_t)g * 65536, 256, 0, 256, 256, WSP(bf16_t, W_POOL) + (size_t)g * 65536, 256, bid, nblk);
        ph_rmsnorm<2048>(x, mix_pre_g, H, bid, nblk);
#endif
    PHASE_END
    {
            PHASE_BEGIN
#if !((SKIPMASK >> 1) & 1)
                FAbIn2 f; f.Q = WSP(bf16_t, R_Q0); f.K = WSP(bf16_t, R_K0); f.VT = WSP(bf16_t, R_VT0); f.QI = WSP(float, R_QI); f.U = WSP(float, R_U); f.WI = WSP(float, R_WI); f.KI16 = WSP(unsigned short, R_KI);
                ph_gemm(lds, H, 2048, WSP(bf16_t, W_ABIN), 2048, NTOK, 5376, 2048, f, bid, nblk);
#endif
            PHASE_END
            PHASE_BEGIN
#if !((SKIPMASK >> 2) & 1)
                ph_pooled(WSP(float, R_U), WSP(bf16_t, R_POOLED), bid, nblk);
                IdxArgs a; a.QI = WSP(float, R_QI); a.KI16 = WSP(unsigned short, R_KI); a.WI = WSP(float, R_WI); a.MT = WSP(unsigned long long, R_MASK);
                idx_phase(lds, a, bid, nblk);
#endif
            PHASE_END
            PHASE_BEGIN
#if !((SKIPMASK >> 3) & 1)
                { FPool f; f.CC = WSP(bf16_t, R_CC0); f.pb = pool_b; f.ps = pool_scale; ph_gemm(lds, WSP(bf16_t, R_POOLED), 1024, WSP(bf16_t, W_POOL), 256, NTOK, 1024, 256, f, bid, nblk, 0, 512); }
                AttnArgs a; a.Q = WSP(bf16_t, R_Q0); a.K = WSP(bf16_t, R_K0); a.VT = WSP(bf16_t, R_VT0); a.MT = WSP(unsigned long long, R_MASK); a.O = WSP(bf16_t, R_CC0); a.ldq = 1024; a.ldk = 1024; a.ldo = 2048;
                a.sc_log2e = 0.08838834764831845f * 1.4426950408889634f;
                attn_phase<128, true>(lds, a, bid, nblk);
#endif
            PHASE_END
        PHASE_BEGIN
#if !((SKIPMASK >> 4) & 1)
            FStoreBf16 f; f.O = Mx; f.ldc = 2048; f.pad_ = 0;
            ph_gemm(lds, CC, 2048, WSP(bf16_t, W_ABOUT), 2048, NTOK, 2048, 2048, f, bid, nblk);
#endif
        PHASE_END
        PHASE_BEGIN
#if !((SKIPMASK >> 5) & 1)
            ph_resnorm(x, Mx, mix_post_g + 0, ffn_pre_g + 0, xo, H, FP8_UP0 ? WSP(unsigned char, R_H) : (unsigned char*)nullptr, bid, nblk);
#endif
        PHASE_END
        for (int half = 0; half < 2; ++half) {
            PHASE_BEGIN
#if !((SKIPMASK >> 6) & 1)
                FStoreBf16 f; f.O = WSP(bf16_t, R_HID); f.ldc = 8192; f.pad_ = 0;

#if FP8_UP0
                ph_gemm8(lds, WSP(unsigned char, R_H) + (size_t)half * SEQ * 2048, 2048, WSP(unsigned char, W_UP0), 2048, SEQ, 8192, 2048, f, bid, nblk);
#else
                ph_gemm(lds, H + (size_t)half * SEQ * 2048, 2048, WSP(bf16_t, W_UP0), 2048, SEQ, 8192, 2048, f, bid, nblk);
#endif

#endif
            PHASE_END
            PHASE_BEGIN
#if !((SKIPMASK >> 7) & 1)
                ph_ffn_gate(WSP(bf16_t, R_HID), ffn_conv_w + 0, ffn_conv_b + 0, WSP(bf16_t, R_ACT), bid, nblk);
#endif
            PHASE_END
            PHASE_BEGIN
#if !((SKIPMASK >> 8) & 1)
                FStoreBf16 f; f.O = WSP(bf16_t, R_F) + (size_t)half * SEQ * 2048; f.ldc = 2048; f.pad_ = 0;
                ph_gemm(lds, WSP(bf16_t, R_ACT), 4096, WSP(bf16_t, W_DN0), 4096, SEQ, 2048, 4096, f, bid, nblk);
#endif
            PHASE_END
        }
        PHASE_BEGIN
#if !((SKIPMASK >> 9) & 1)
            ph_resnorm(xo, WSP(bf16_t, R_F), ffn_post_g + 0, mix_pre_g + 2048, xo, H, nullptr, bid, nblk);
#endif
        PHASE_END
    }
    {
#undef LAYER_CC
#undef LAYER_MX
#define LAYER_CC R_CC1
#define LAYER_MX R_M1
            PHASE_BEGIN
#if !((SKIPMASK >> 10) & 1)
                FCdIn f; f.CQ = WSP(float, R_CQ); f.CKV = WSP(float, R_CKV); f.KR = WSP(float, R_KR); f.XL = WSP(bf16_t, R_XL); f.YG = WSP(bf16_t, R_YG);
                ph_gemm(lds, H, 2048, WSP(bf16_t, W_CDIN), 2048, NTOK, 3072, 2048, f, bid, nblk);
#endif
            PHASE_END
            PHASE_BEGIN
#if !((SKIPMASK >> 11) & 1)
                ph_xc(WSP(bf16_t, R_XL), lru_conv_w, lru_conv_b, WSP(bf16_t, R_XCB), bid, nblk);
                ph_conv_lru(lru_wa, lru_wx, WSP(bf16_t, W_LRU), bid, nblk);
                ph_rmsnorm<512>(WSP(float, R_CQ), q_norm_g, WSP(bf16_t, R_CQN), bid, nblk);
                ph_rmsnorm<256>(WSP(float, R_CKV), kv_norm_g, WSP(bf16_t, R_CKVN), bid, nblk);
            PHASE_END
            PHASE_BEGIN
                { EpiLru ep; ep.XCB = WSP(bf16_t, R_XCB); ep.ba = lru_ba; ep.bx = lru_bx; ep.lam = lru_lambda; ep.LA = WSP(float, R_LA); ep.LB = WSP(float, R_LB);
                  ph_gemm_e(lds, WSP(bf16_t, R_XCB), 1024, WSP(bf16_t, W_LRU), 256, NTOK, 2048, 256, ep, bid, nblk, 1, 512); }
                { FStoreBf16 f; f.O = WSP(bf16_t, R_Q1); f.ldc = 1536; f.pad_ = 0; ph_gemm(lds, WSP(bf16_t, R_CQN), 512, WSP(bf16_t, W_QUP), 512, NTOK, 1536, 512, f, bid, nblk); }
                { FKvUp2 f; f.K1 = WSP(bf16_t, R_K1); f.VT = WSP(bf16_t, R_VT1); ph_gemm(lds, WSP(bf16_t, R_CKVN), 256, WSP(bf16_t, W_KVUP), 256, NTOK, 2048, 256, f, bid, nblk); }
            PHASE_END
            PHASE_BEGIN
                ph_scan1(WSP(float, R_LA), WSP(float, R_LB), WSP(float, R_CA), WSP(float, R_CH), bid, nblk);
                ph_rope_q(WSP(bf16_t, R_Q1), positions, bid, nblk);
                ph_rope_k(WSP(float, R_KR), positions, WSP(bf16_t, R_K1), bid, nblk);
            PHASE_END
            PHASE_BEGIN
                ph_scan2(WSP(float, R_CA), WSP(float, R_CH), WSP(float, R_CIN), bid, nblk);
            PHASE_END
            PHASE_BEGIN
                ph_scan3(WSP(float, R_LA), WSP(float, R_LB), WSP(float, R_CIN), WSP(bf16_t, R_YG), WSP(bf16_t, R_CC1), bid, nblk);
                AttnArgs a; a.Q = WSP(bf16_t, R_Q1); a.K = WSP(bf16_t, R_K1); a.VT = WSP(bf16_t, R_VT1); a.MT = nullptr; a.O = WSP(bf16_t, R_CC1); a.ldq = 1536; a.ldk = 1536; a.ldo = 2048;
                a.sc_log2e = 0.07216878364870322f * 1.4426950408889634f;
                attn_phase<192, false>(lds, a, bid, nblk);
#endif
            PHASE_END
        PHASE_BEGIN
#if !((SKIPMASK >> 15) & 1)
            FStoreBf16 f; f.O = Mx; f.ldc = 2048; f.pad_ = 0;
            ph_gemm(lds, CC, 2048, WSP(bf16_t, W_CDOUT), 2048, NTOK, 2048, 2048, f, bid, nblk);
#endif
        PHASE_END
        PHASE_BEGIN
#if !((SKIPMASK >> 16) & 1)
            ph_resnorm((const float*)xo, Mx, mix_post_g + 2048, ffn_pre_g + 2048, xo, H, FP8_UP1 ? WSP(unsigned char, R_H) : (unsigned char*)nullptr, bid, nblk);
#endif
        PHASE_END
        for (int half = 0; half < 2; ++half) {
            PHASE_BEGIN
#if !((SKIPMASK >> 17) & 1)
                FStoreBf16 f; f.O = WSP(bf16_t, R_HID); f.ldc = 8192; f.pad_ = 0;

#if FP8_UP1
                ph_gemm8(lds, WSP(unsigned char, R_H) + (size_t)half * SEQ * 2048, 2048, WSP(unsigned char, W_UP1), 2048, SEQ, 8192, 2048, f, bid, nblk);
#else
                ph_gemm(lds, H + (size_t)half * SEQ * 2048, 2048, WSP(bf16_t, W_UP1), 2048, SEQ, 8192, 2048, f, bid, nblk);
#endif

#endif
            PHASE_END
            PHASE_BEGIN
#if !((SKIPMASK >> 18) & 1)
                ph_ffn_gate(WSP(bf16_t, R_HID), ffn_conv_w + 24576, ffn_conv_b + 8192, WSP(bf16_t, R_ACT), bid, nblk);
#endif
            PHASE_END
            PHASE_BEGIN
#if !((SKIPMASK >> 19) & 1)
                FStoreBf16 f; f.O = WSP(bf16_t, R_F) + (size_t)half * SEQ * 2048; f.ldc = 2048; f.pad_ = 0;
                ph_gemm(lds, WSP(bf16_t, R_ACT), 4096, WSP(bf16_t, W_DN1), 4096, SEQ, 2048, 4096, f, bid, nblk);
#endif
            PHASE_END
        }
        PHASE_BEGIN
#if !((SKIPMASK >> 20) & 1)
            ph_resnorm(xo, WSP(bf16_t, R_F), ffn_post_g + 2048, (const float*)nullptr, xo, H, nullptr, bid, nblk);
#endif
        PHASE_END
    }
#undef LAYER_CC
#undef LAYER_MX
#undef WSP
#undef PHASE_BEGIN
#undef PHASE_END
}

#ifndef MK_N_LAUNCHES
#define MK_N_LAUNCHES 1
#endif
static constexpr int MK_NPHASES = 1 + 3 + 7 + 2 * 9;

extern "C" void kernel_launch(void* const* d_in, const int* in_sizes, int n_in, void* d_out, int out_size, void* d_ws, size_t ws_size, hipStream_t stream) {
    static int grid = 0;
    if (grid == 0) {
        if (n_in != 28 || out_size != NTOK * DM || ws_size < WS_NEED) { fprintf(stderr, "kernel_launch: unexpected shapes (n_in %d out %d ws %zu)\n", n_in, out_size, ws_size); grid = -1; return; }
        int dev = 0, cus = 0, per_cu = 0;
        if (hipGetDevice(&dev) != hipSuccess || hipDeviceGetAttribute(&cus, hipDeviceAttributeMultiprocessorCount, dev) != hipSuccess) { grid = -1; return; }
        if (hipFuncSetAttribute((const void*)k_mega, hipFuncAttributeMaxDynamicSharedMemorySize, MK_LDS) != hipSuccess) { fprintf(stderr, "kernel_launch: hipFuncSetAttribute failed\n"); grid = -1; return; }
        if (hipOccupancyMaxActiveBlocksPerMultiprocessor(&per_cu, (const void*)k_mega, 512, MK_LDS) != hipSuccess || per_cu < 1) { fprintf(stderr, "kernel_launch: occupancy query says %d\n", per_cu); }
        (void)hipGetLastError();
        grid = cus;
        if (grid != 256) { fprintf(stderr, "kernel_launch: built for 256 CUs, found %d\n", grid); grid = -1; return; }
    }
    if (grid < 0) return;
    unsigned char* ws = (unsigned char*)d_ws;
    (void)hipMemsetAsync(ws + WS_BAR, 0, XCD_BAR_WORDS * sizeof(unsigned), stream);
    (void)hipMemsetAsync(ws + W_ABIN + (size_t)5200 * 2048 * 2, 0, (size_t)176 * 2048 * 2, stream);
    (void)hipMemsetAsync(ws + W_CDIN + (size_t)832 * 2048 * 2, 0, (size_t)192 * 2048 * 2, stream);
    MK p{};
    for (int i = 0; i < 28; ++i) p.in[i] = (const float*)d_in[i];
    p.out = (float*)d_out; p.ws = ws;
#if MK_N_LAUNCHES == 1
    p.ph_lo = 0; p.ph_hi = 1 << 20;
    hipLaunchKernelGGL(k_mega, dim3(grid), dim3(512), MK_LDS, stream, p);
#else
    for (int ph = 0; ph < MK_NPHASES; ++ph) { p.ph_lo = ph; p.ph_hi = ph + 1; hipLaunchKernelGGL(k_mega, dim3(grid), dim3(512), MK_LDS, stream, p); }
#endif
}
```

```cpp
#include <hip/hip_runtime.h>
#include <stdint.h>
#include <stdio.h>

#define LAS __attribute__((address_space(3)))
typedef unsigned short bf16_t;
typedef float f32x4 __attribute__((ext_vector_type(4)));
typedef unsigned u32x4 __attribute__((ext_vector_type(4)));
typedef unsigned u32x2 __attribute__((ext_vector_type(2)));

static constexpr int NTOK = 32768, SEQ = 16384, NBATCH = 2, DM = 2048, DFF = 4096;
static constexpr float NORM_EPS = 1e-6f;

__device__ __forceinline__ bf16_t f2bf(float f) { unsigned u = __float_as_uint(f); u += 0x7FFFu + ((u >> 16) & 1u); return (bf16_t)(u >> 16); }
__device__ __forceinline__ float bf2f(bf16_t b) { return __uint_as_float(((unsigned)b) << 16); }
__device__ __forceinline__ unsigned pack2bf(float lo, float hi) { return (unsigned)f2bf(lo) | ((unsigned)f2bf(hi) << 16); }
__device__ __forceinline__ float gelu_tanh(float x) { const float u = 0.7978845608028654f * (x + 0.044715f * x * x * x); return 0.5f * x * (1.0f + tanhf(u)); }
__device__ __forceinline__ float wave_sum(float v) {
#pragma unroll
    for (int o = 32; o >= 1; o >>= 1) v += __shfl_xor(v, o);
    return v;
}

#ifndef TID_PLAIN
#define TID_PLAIN 0
#endif
static constexpr int TID_TAB_LDS = 162816 - 16 - 256;
#if TID_PLAIN
__device__ __forceinline__ int opaque_tid() { int t = (int)threadIdx.x; asm volatile("" : "+v"(t)); return t; }
#else
__device__ __forceinline__ int opaque_tid() {
    const unsigned slot = (unsigned)__builtin_amdgcn_s_getreg(((6 - 1) << 11) | 4) & 63u;
    const int w = __builtin_amdgcn_readfirstlane(*(const volatile LAS int*)(size_t)(TID_TAB_LDS + 4 * slot));
    int lane; asm volatile("v_mbcnt_lo_u32_b32 %0, -1, 0\n\tv_mbcnt_hi_u32_b32 %0, -1, %0" : "=v"(lane));
    return w * 64 + lane;
}
#endif

__device__ __forceinline__ int opaque_s(int v) { asm volatile("" : "+s"(v)); return v; }

template <class T> __device__ __forceinline__ const T* opaque_p(const T* p) { asm volatile("" : "+s"(p)); return p; }

#ifndef PG8_EPI_RECOMP
#define PG8_EPI_RECOMP 1
#endif
#ifndef PG8_ASM_DMA
#define PG8_ASM_DMA 1
#endif
#include <hip/hip_runtime.h>
namespace pg8 {
#define PG8_LAS __attribute__((address_space(3)))
typedef unsigned short bf16_t;
typedef short bf16x8 __attribute__((ext_vector_type(8)));
typedef float f32x4 __attribute__((ext_vector_type(4)));
typedef unsigned u32x4 __attribute__((ext_vector_type(4)));
typedef int i32x8 __attribute__((ext_vector_type(8)));
typedef int i32x4 __attribute__((ext_vector_type(4)));
constexpr int BM = 256, BK = 64, HALF = 128, HTB = HALF * BK * 2  , STAGE_BYTES = 8 * HTB, NXCD = 8, WGM = 8;

__host__ __device__ __forceinline__ int lds_byte(int r, int c) { const int st = (r >> 4) * 2 + (c >> 5), rr = r & 15, cc = c & 31, ob = rr * 64 + cc * 2; return st * 1024 + (ob ^ (((ob >> 9) & 1) << 5)); }
__host__ __device__ __forceinline__ void stage_rc(int b, int& R, int& C) { const int st = b / 1024, sb = b % 1024, swz = sb ^ (((sb >> 9) & 1) << 5); R = (st >> 1) * 16 + swz / 64; C = (st & 1) * 32 + (swz % 64) / 2; }
__host__ __device__ __forceinline__ int perm32(int rho) { const int n = rho >> 4, i = rho & 15; return 8 * (i >> 2) + 4 * n + (i & 3); }

struct Unit { int pm, pn; };
struct Gemm { const bf16_t* A; const bf16_t* Bt; int M, N, K, lda, ldb, a_shift, a_bytes, pad_; };

struct StaticOrder {
    int nM, nN, nwg, G, c;
    __host__ __device__ void init(int M, int N, int G_, int c_) { nM = M / BM; nN = N / BM; nwg = nM * nN; G = G_; c = c_; }
    __host__ __device__ bool next(int i, Unit& u) const {
        const long L = (long)i * G + c; if (L >= nwg) return false;
        int wgid = (int)L; { const int q = nwg / NXCD, r = nwg % NXCD, xcd = wgid % NXCD, off = wgid / NXCD; wgid = (xcd < r ? xcd * (q + 1) : r * (q + 1) + (xcd - r) * q) + off; }
        const int nig = WGM * nN, gid = wgid / nig, fm = gid * WGM, gsz = (nM - fm) < WGM ? (nM - fm) : WGM;
        u.pm = fm + ((wgid % nig) % gsz); u.pn = (wgid % nig) / gsz; return true;
    }
    __device__ __forceinline__ void a_ready(const Unit&) const {}
    __device__ __forceinline__ void done(const Unit&) const {}
};

template <class Epi, class Sched, bool STAMP = false>
__device__ __forceinline__ void gemm_phase(PG8_LAS unsigned char* lds, const Gemm g, const Sched& S, const Epi& E, unsigned long long* stamps) {
    const int tid = opaque_tid(), wid = __builtin_amdgcn_readfirstlane(tid >> 6), lane = tid & 63, wr = wid >> 2, wc = wid & 3, fr = lane & 15, fq = lane >> 4;
    const int K = g.K, nt = K / BK;
    int ts_lo = 0, ts_hi = 0, nts = 0; const unsigned long long rt_entry = STAMP ? (unsigned long long)wall_clock64() : 0ull;
#define PG8_STAMP() do { if (STAMP && wid == 0 && nts < 64) { const unsigned long long _c = (unsigned long long)clock64(); \
        ts_lo = (lane == nts) ? (int)(unsigned)_c : ts_lo; ts_hi = (lane == nts) ? (int)(unsigned)(_c >> 32) : ts_hi; ++nts; } } while (0)
    PG8_STAMP();
    unsigned voffA[2], voffB[2];
#pragma unroll
    for (int i = 0; i < 2; ++i) { int R, C; stage_rc(tid * 16 + i * 8192, R, C); const int Rb = Epi::PERM ? ((R & ~31) + perm32(R & 31)) : R;
        voffA[i] = (unsigned)(R * g.lda + C) * 2u; voffB[i] = (unsigned)(Rb * g.ldb + C) * 2u; }
    const size_t kstep = (size_t)(BK * 2);
    const size_t hstepA = (size_t)HALF * g.lda * 2, hstepB = (size_t)HALF * g.ldb * 2;
    const size_t tstepA = 2 * hstepA, tstepB = 2 * hstepB;
    const unsigned ldsbase_ = (unsigned)(size_t)lds;
    const int sc_w_ = 0x79797979, sc_a_ = 0x7F7F7F7F;
    (void)sc_w_; (void)sc_a_;
    const unsigned ldsw = (unsigned)wid * 1024u;
    const int aoff = lds_byte(wr * 64 + fr, fq * 8), boff = lds_byte(wc * 32 + fr, fq * 8);
#define PG8_SA(b, h) (((b) * 2 + (h)) * HTB)
#define PG8_SB(b, h) ((4 + (b) * 2 + (h)) * HTB)
#if PG8_ASM_DMA
#define PG8_STAGE(bufoff, gbase, voff) do { _Pragma("unroll") for (int _i = 0; _i < 2; ++_i) { unsigned keep_; \
        asm volatile("s_mov_b32 %0, m0\n\ts_mov_b32 m0, %3\n\ts_nop 0\n\tglobal_load_lds_dwordx4 %1, %2\n\ts_mov_b32 m0, %0" \
                     : "=&s"(keep_) : "v"((voff)[_i]), "s"((const char*)(gbase)), "s"(ldsbase_ + (unsigned)(bufoff) + ldsw + (unsigned)(_i * 8192)) : "memory"); } } while (0)
#else
#define PG8_STAGE(bufoff, gbase, voff) do { _Pragma("unroll") for (int _i = 0; _i < 2; ++_i) \
        __builtin_amdgcn_global_load_lds((const unsigned*)((const char*)(gbase) + (voff)[_i]), (PG8_LAS unsigned*)(lds + (bufoff) + ldsw + _i * 8192), 16, 0, 0); } while (0)
#endif
#define PG8_LDA(dst, b, h) do { _Pragma("unroll") for (int m = 0; m < 4; ++m) { dst[m].lo = *(const PG8_LAS i32x4*)(lds + PG8_SA(b, h) + aoff + m * 2048); dst[m].hi = *(const PG8_LAS i32x4*)(lds + PG8_SA(b, h) + aoff + m * 2048 + 1024); } } while (0)
#define PG8_LDB(dst, b, h) do { _Pragma("unroll") for (int n = 0; n < 2; ++n) { dst[n].lo = *(const PG8_LAS i32x4*)(lds + PG8_SB(b, h) + boff + n * 2048); dst[n].hi = *(const PG8_LAS i32x4*)(lds + PG8_SB(b, h) + boff + n * 2048 + 1024); } } while (0)
#define PG8_MMA(ai, bj, At, Bt) do { __builtin_amdgcn_s_setprio(1); \
        if constexpr (Epi::FP8) { _Pragma("unroll") for (int m = 0; m < 4; ++m) _Pragma("unroll") for (int n = 0; n < 2; ++n) \
            asm volatile("v_mfma_scale_f32_16x16x128_f8f6f4 %0, %1, %2, %0, %3, %4 op_sel_hi:[0,0,0]" : "+v"(acc[ai][bj][m][n]) : "v"(Bt[n]), "v"(At[m]), "v"(sc_w_), "v"(sc_a_)); } \
        else { _Pragma("unroll") for (int m = 0; m < 4; ++m) _Pragma("unroll") for (int n = 0; n < 2; ++n) { \
            const i32x4 bl_ = Bt[n].lo, bh_ = Bt[n].hi, al_ = At[m].lo, ah_ = At[m].hi;     \
            acc[ai][bj][m][n] = __builtin_amdgcn_mfma_f32_16x16x32_bf16(__builtin_bit_cast(bf16x8, bl_), __builtin_bit_cast(bf16x8, al_), acc[ai][bj][m][n], 0, 0, 0); \
            acc[ai][bj][m][n] = __builtin_amdgcn_mfma_f32_16x16x32_bf16(__builtin_bit_cast(bf16x8, bh_), __builtin_bit_cast(bf16x8, ah_), acc[ai][bj][m][n], 0, 0, 0); } } \
        __builtin_amdgcn_s_setprio(0); } while (0)
#define PG8_WAIT_V(n) asm volatile("s_waitcnt vmcnt(" #n ")" ::: "memory")
#define PG8_WAIT_L(n) asm volatile("s_waitcnt lgkmcnt(" #n ")" ::: "memory")
#define PG8_BAR __builtin_amdgcn_s_barrier()
#define PG8_SCHED __builtin_amdgcn_sched_barrier(0)
    Unit cur, nxt; int ui = 0;
    if (!S.next(0, cur)) return;
    f32x4 acc[2][2][4][2];
#pragma unroll
    for (int a = 0; a < 2; ++a)
#pragma unroll
        for (int b = 0; b < 2; ++b)
#pragma unroll
            for (int m = 0; m < 4; ++m)
#pragma unroll
                for (int n = 0; n < 2; ++n) acc[a][b][m][n] = (f32x4){0.f, 0.f, 0.f, 0.f};
    i32x8 At[4], B0[2], B1[2];
    const char* cA = (const char*)g.A + (size_t)cur.pm * tstepA + (size_t)(cur.pn >> g.a_shift) * g.a_bytes; const char* cB = (const char*)g.Bt + (size_t)cur.pn * tstepB;
    S.a_ready(cur);
    PG8_STAGE(PG8_SB(0, 0), cB, voffB); PG8_STAGE(PG8_SA(0, 0), cA, voffA); PG8_STAGE(PG8_SB(0, 1), cB + hstepB, voffB); PG8_STAGE(PG8_SA(0, 1), cA + hstepA, voffA);
    if (wr == 1) PG8_BAR;
    PG8_WAIT_V(4); PG8_BAR;
    PG8_STAGE(PG8_SB(1, 0), cB + kstep, voffB); PG8_STAGE(PG8_SA(1, 0), cA + kstep, voffA); PG8_STAGE(PG8_SB(1, 1), cB + hstepB + kstep, voffB);
    PG8_WAIT_V(6); PG8_BAR;
    PG8_STAMP();
    for (;;) {
        const bool has_next = S.next(ui + 1, nxt);
        const char* nA = has_next ? (const char*)g.A + (size_t)nxt.pm * tstepA + (size_t)(nxt.pn >> g.a_shift) * g.a_bytes : cA; const char* nB = has_next ? (const char*)g.Bt + (size_t)nxt.pn * tstepB : cB;
        for (int t = 0; t < nt; t += 2) {
            const bool last = (t == nt - 2);
            const char* a1 = cA + (size_t)(t + 1) * kstep;
            const char* a2 = last ? nA : cA + (size_t)(t + 2) * kstep; const char* b2 = last ? nB : cB + (size_t)(t + 2) * kstep;
            const char* a3 = a2 + kstep; const char* b3 = b2 + kstep;
            if (last && has_next) S.a_ready(nxt);
            PG8_LDB(B0, 0, 0); PG8_SCHED; PG8_LDA(At, 0, 0); PG8_STAGE(PG8_SA(1, 1), a1 + hstepA, voffA);
            PG8_WAIT_L(8); PG8_BAR; PG8_WAIT_L(0); PG8_MMA(0, 0, At, B0); PG8_BAR; PG8_SCHED;
            PG8_LDB(B1, 0, 1); PG8_STAGE(PG8_SB(0, 0), b2, voffB);
            PG8_BAR; PG8_WAIT_L(0); PG8_MMA(0, 1, At, B1); PG8_BAR;
            PG8_LDA(At, 0, 1); PG8_STAGE(PG8_SA(0, 0), a2, voffA);
            PG8_BAR; PG8_WAIT_L(0); PG8_MMA(1, 0, At, B0); PG8_BAR; PG8_SCHED;
            PG8_STAGE(PG8_SB(0, 1), b2 + hstepB, voffB);
            PG8_WAIT_V(6); PG8_BAR; PG8_MMA(1, 1, At, B1); PG8_BAR;
            PG8_LDB(B0, 1, 0); PG8_SCHED; PG8_LDA(At, 1, 0); PG8_STAGE(PG8_SA(0, 1), a2 + hstepA, voffA);
            PG8_WAIT_L(8); PG8_BAR; PG8_WAIT_L(0); PG8_MMA(0, 0, At, B0); PG8_BAR; PG8_SCHED;
            PG8_LDB(B1, 1, 1); PG8_STAGE(PG8_SB(1, 0), b3, voffB);
            PG8_BAR; PG8_WAIT_L(0); PG8_MMA(0, 1, At, B1); PG8_BAR;
            PG8_LDA(At, 1, 1); PG8_STAGE(PG8_SA(1, 0), a3, voffA);
            PG8_BAR; PG8_WAIT_L(0); PG8_MMA(1, 0, At, B0); PG8_BAR; PG8_SCHED;
            PG8_STAGE(PG8_SB(1, 1), b3 + hstepB, voffB);
            PG8_WAIT_V(6); PG8_BAR; PG8_MMA(1, 1, At, B1); PG8_BAR;
        }
        PG8_STAMP();
        if constexpr (Epi::FP8) { asm volatile("s_nop 15\n\ts_nop 15" ::: "memory"); }
        if constexpr (!Epi::AFTER_DRAIN) {
#if PG8_EPI_RECOMP
            const int t2_ = opaque_tid(), l2_ = t2_ & 63, w2_ = __builtin_amdgcn_readfirstlane(t2_ >> 6);
            E(acc, cur, w2_ >> 2, w2_ & 3, l2_ & 15, l2_ >> 4); S.done(cur);
#else
            E(acc, cur, wr, wc, fr, fq); S.done(cur);
#endif
        }
        PG8_STAMP();
        if (!has_next) break;
#pragma unroll
        for (int a = 0; a < 2; ++a)
#pragma unroll
            for (int b = 0; b < 2; ++b)
#pragma unroll
                for (int m = 0; m < 4; ++m)
#pragma unroll
                    for (int n = 0; n < 2; ++n) acc[a][b][m][n] = (f32x4){0.f, 0.f, 0.f, 0.f};
        cur = nxt; cA = nA; cB = nB; ++ui;
    }
    PG8_WAIT_V(0);
    if (wr == 0) PG8_BAR;
    PG8_BAR;
    if constexpr (Epi::AFTER_DRAIN) { E.fused(acc, cur, wr, wc, fr, fq, lds, wid, lane); S.done(cur); }
    PG8_STAMP();
    if (STAMP && wid == 0) { stamps[lane] = lane < nts ? (((unsigned long long)(unsigned)ts_hi << 32) | (unsigned)ts_lo) : 0ull;
        if (lane == 62) stamps[62] = rt_entry; if (lane == 63) stamps[63] = (unsigned long long)wall_clock64(); }
#undef PG8_STAMP
#undef PG8_SA
#undef PG8_SB
#undef PG8_STAGE
#undef PG8_LDA
#undef PG8_LDB
#undef PG8_MMA
#undef PG8_WAIT_V
#undef PG8_WAIT_L
#undef PG8_BAR
#undef PG8_SCHED
}
}

#include <cstdio>
#include <ctime>
#include <cstdlib>
#include <cstring>
#include <cmath>
#include <vector>

template <class F, bool F8 = false> struct EpiG {
    static constexpr bool PERM = false, AFTER_DRAIN = false, FP8 = F8;
    F f;
    __device__ __forceinline__ void operator()(const f32x4 (&acc)[2][2][4][2], const pg8::Unit& u, int wr, int wc, int fr, int fq) const {
        const int row0 = u.pm * 256 + wr * 64 + fr, col0 = u.pn * 256 + wc * 32 + 4 * fq;
#pragma unroll
        for (int ai = 0; ai < 2; ++ai)
#pragma unroll
            for (int m = 0; m < 4; ++m)
#pragma unroll
                for (int bj = 0; bj < 2; ++bj)
#pragma unroll
                    for (int n = 0; n < 2; ++n) f(row0 + ai * 128 + m * 16, col0 + bj * 128 + n * 16, acc[ai][bj][m][n]);
    }
};
__device__ __forceinline__ void st_bf16x4(bf16_t* p, f32x4 v) { u32x2 w; w.x = pack2bf(v[0], v[1]); w.y = pack2bf(v[2], v[3]); *(u32x2*)p = w; }
__device__ __forceinline__ void st_f32x4(float* p, f32x4 v) { *(f32x4*)p = v; }

struct FStoreBf16 { bf16_t* O; int ldc; int pad_; __device__ __forceinline__ void operator()(int r, int c, f32x4 v) const { st_bf16x4(O + (size_t)r * ldc + c, v); } };
struct FAbIn { bf16_t *Q, *K, *V; float *QI, *U, *WI; unsigned short* KI16;
    __device__ __forceinline__ void operator()(int r, int c, f32x4 v) const {
        if (c < 1024) st_bf16x4(Q + (size_t)r * 1024 + c, v);
        else if (c < 2048) st_bf16x4(K + (size_t)r * 1024 + (c - 1024), v);
        else if (c < 3072) st_bf16x4(V + (size_t)r * 1024 + (c - 2048), v);
        else if (c < 4096) st_f32x4(QI + (size_t)r * 1024 + (c - 3072), v);
        else if (c < 5120) st_f32x4(U + (size_t)r * 1024 + (c - 4096), v);
        else if (c < 5184) { typedef _Float16 h2 __attribute__((ext_vector_type(2))); union { h2 h; unsigned u; } a, b; a.h = (h2){(_Float16)v[0], (_Float16)v[1]}; b.h = (h2){(_Float16)v[2], (_Float16)v[3]};
            u32x2 w; w.x = a.u; w.y = b.u; *(u32x2*)(KI16 + (size_t)r * 64 + (c - 5120)) = w; }
        else if (c < 5200) st_f32x4(WI + (size_t)r * 16 + (c - 5184), v);
    } };
struct FCdIn { float *CQ, *CKV, *KR; bf16_t *XL, *YG;
    __device__ __forceinline__ void operator()(int r, int c, f32x4 v) const {
        if (c < 512) st_f32x4(CQ + (size_t)r * 512 + c, v);
        else if (c < 768) st_f32x4(CKV + (size_t)r * 256 + (c - 512), v);
        else if (c < 832) st_f32x4(KR + (size_t)r * 64 + (c - 768), v);
        else if (c < 1024) {}
        else if (c < 2048) st_bf16x4(XL + (size_t)r * 1024 + (c - 1024), v);
        else st_bf16x4(YG + (size_t)r * 1024 + (c - 2048), v);
    } };
struct FKvUp { bf16_t *K1, *V1;
    __device__ __forceinline__ void operator()(int r, int c, f32x4 v) const {
        const int h = c >> 8, d = c & 255;
        if (d < 128) st_bf16x4(K1 + (size_t)r * 1536 + h * 192 + d, v);
        else st_bf16x4(V1 + (size_t)r * 1024 + h * 128 + (d - 128), v);
    } };

__device__ __forceinline__ unsigned ord_key(float f) { const unsigned b = __float_as_uint(f); return (b & 0x80000000u) ? ~b : (b | 0x80000000u); }
__device__ __forceinline__ void rope_cs(int pos, int i, float& c, float& s) { const float freq = powf(10000.0f, -(float)i / 32.0f); const float ang = (float)pos * freq; sincosf(ang, &s, &c); }

typedef short bf16x8 __attribute__((ext_vector_type(8)));
typedef float f32x16 __attribute__((ext_vector_type(16)));
__device__ __forceinline__ unsigned cvtpk(float lo, float hi) { unsigned r; asm("v_cvt_pk_bf16_f32 %0, %1, %2" : "=v"(r) : "v"(lo), "v"(hi)); return r; }
__device__ __forceinline__ float max3_asm(float a, float b, float c) { float r; asm("v_max3_f32 %0, %1, %2, %3" : "=v"(r) : "v"(a), "v"(b), "v"(c)); return r; }

struct AttnArgs { const bf16_t* Q; const bf16_t* K; const bf16_t* VT; const unsigned long long* MT; bf16_t* O; int ldq, ldk, ldo; float sc_log2e; };

template <int DQK, bool MASKED>
__device__ __forceinline__ void attn_item(LAS unsigned char* lds, const AttnArgs& a, int b, int h, int qb) {
    constexpr int NKS = DQK / 16, PK = DQK * 2, PV = 128, KB_BYTES = 64 * PK, VB_BYTES = 128 * PV, NPK = DQK / 8, NKP = (64 * NPK) / 512, V_OFF = 3 * KB_BYTES;
    const int tid = opaque_tid(), lane = tid & 63, w = __builtin_amdgcn_readfirstlane(tid >> 6), n = lane & 31, hf = lane >> 5;
    const int nt = 4 * qb + 4, cw = 4 * qb + (w >> 1);
    const int trow = qb * 256 + w * 32 + n;
    const size_t grow = (size_t)b * SEQ + trow;
    bf16x8 qf[NKS];
    { const bf16_t* qp = a.Q + grow * a.ldq + h * DQK + hf * 8;
#pragma unroll
      for (int ks = 0; ks < NKS; ++ks) qf[ks] = *(const bf16x8*)(qp + ks * 16); }
    f32x16 o[4];
#pragma unroll
    for (int dt = 0; dt < 4; ++dt)
#pragma unroll
        for (int r = 0; r < 16; ++r) o[dt][r] = 0.f;
    float m_run = -INFINITY, l_run = 0.f;
    const float c = a.sc_log2e;
    const bf16_t* Kg = a.K + (size_t)b * SEQ * a.ldk + h * DQK;
    const bf16_t* Vg = a.VT + (size_t)(b * 8 + h) * 128 * SEQ;
    const unsigned long long* Mg = MASKED ? a.MT + (size_t)b * 256 * SEQ + trow : nullptr;
    auto dma_k = [&](int kt) {
        LAS unsigned char* kb = lds + (kt % 3) * KB_BYTES;
#pragma unroll
        for (int i = 0; i < NKP; ++i) { const int s = (w + 8 * i) * 64 + lane, r = s / NPK, cp = s % NPK, cc = cp ^ (NPK == 16 ? (r & 15) : ((r >> 1) & 7));
            __builtin_amdgcn_global_load_lds((const unsigned*)(Kg + (size_t)(kt * 64 + r) * a.ldk + cc * 8), (LAS unsigned*)(kb + (w + 8 * i) * 1024), 16, 0, 0); }
    };
    auto dma_v = [&](int kt) {
        LAS unsigned char* vb = lds + V_OFF + (kt & 1) * VB_BYTES;
#pragma unroll
        for (int i = 0; i < 2; ++i) { const int s = (w + 8 * i) * 64 + lane, d = s >> 3, cp = s & 7, cc = cp ^ ((d >> 1) & 7);
            __builtin_amdgcn_global_load_lds((const unsigned*)(Vg + (size_t)d * SEQ + kt * 64 + cc * 8), (LAS unsigned*)(vb + (w + 8 * i) * 1024), 16, 0, 0); }
    };
    const int kswz = (NPK == 16) ? (n & 15) : ((n >> 1) & 7), vswz = (n >> 1) & 7;
    auto qk = [&](int kt, f32x16& s0, f32x16& s1) {
        const LAS unsigned char* ka = lds + (kt % 3) * KB_BYTES + n * PK;
#pragma unroll
        for (int r = 0; r < 16; ++r) { s0[r] = 0.f; s1[r] = 0.f; }
#pragma unroll
        for (int ks = 0; ks < NKS; ++ks) {
            const int po = ((2 * ks + hf) ^ kswz) * 16;
            const bf16x8 a0 = *(const LAS bf16x8*)(ka + po), a1 = *(const LAS bf16x8*)(ka + 32 * PK + po);
            s0 = __builtin_amdgcn_mfma_f32_32x32x16_bf16(a0, qf[ks], s0, 0, 0, 0);
            s1 = __builtin_amdgcn_mfma_f32_32x32x16_bf16(a1, qf[ks], s1, 0, 0, 0);
        }
    };
    auto rowmax = [&](int kt, f32x16& s0, f32x16& s1) -> float {
        if (MASKED) {
            const unsigned long long mw = Mg[(size_t)kt * SEQ]; const unsigned mlo = (unsigned)mw >> (hf * 4), mhi = (unsigned)(mw >> 32) >> (hf * 4);
#pragma unroll
            for (int r = 0; r < 16; ++r) { const unsigned bit = 1u << ((r >> 2) * 8 + (r & 3));
                s0[r] = (mlo & bit) ? s0[r] : -INFINITY; s1[r] = (mhi & bit) ? s1[r] : -INFINITY; }
        }
        float mx = max3_asm(s0[0], s1[0], s0[1]);
        mx = max3_asm(mx, s1[1], s0[2]);
#pragma unroll
        for (int r = 2; r < 15; ++r) mx = max3_asm(mx, s1[r], s0[r + 1]);
        mx = max3_asm(mx, s1[15], mx);
        const auto rr = __builtin_amdgcn_permlane32_swap(__float_as_uint(mx), __float_as_uint(mx), false, false);
        return fmaxf(__uint_as_float(rr[0]), __uint_as_float(rr[1]));
    };
    dma_k(0); dma_v(0); if (nt > 1) dma_k(1);
    asm volatile("s_waitcnt vmcnt(0)" ::: "memory");
    __syncthreads();
    f32x16 sc0, sc1, sn0, sn1;
    qk(0, sc0, sc1);
    float mx_cur = rowmax(0, sc0, sc1), mx_next = -INFINITY;
#pragma unroll
    for (int r = 0; r < 16; ++r) { sn0[r] = 0.f; sn1[r] = 0.f; }
    for (int kt = 0; kt < nt; ++kt) {
        if (kt + 2 < nt) dma_k(kt + 2);
        if (kt + 1 < nt) dma_v(kt + 1);
        const bool act = kt <= cw, actn = kt + 1 <= cw;
        float m_use = 0.f;
        if (act) {
            const float m_new = fmaxf(m_run, mx_cur);
            m_use = (MASKED && m_new == -INFINITY) ? 0.f : m_new;
            if (__any(m_new > m_run)) {
                const float al = __builtin_amdgcn_exp2f((m_run - m_use) * c);
                l_run *= al;
#pragma unroll
                for (int dt = 0; dt < 4; ++dt)
#pragma unroll
                    for (int r = 0; r < 16; ++r) o[dt][r] *= al;
            }
            m_run = m_new;
        }
        if (actn) qk(kt + 1, sn0, sn1);
        bf16x8 pf[4];
        if (act) {
            const float mc = m_use * c;
            float ps = 0.f;
#pragma unroll
            for (int r = 0; r < 16; ++r) { sc0[r] = __builtin_amdgcn_exp2f(fmaf(sc0[r], c, -mc)); sc1[r] = __builtin_amdgcn_exp2f(fmaf(sc1[r], c, -mc)); ps += sc0[r] + sc1[r]; }
            l_run += ps;
            u32x4 t;
            t.x = cvtpk(sc0[0], sc0[1]); t.y = cvtpk(sc0[2], sc0[3]); t.z = cvtpk(sc0[4], sc0[5]); t.w = cvtpk(sc0[6], sc0[7]); pf[0] = *(bf16x8*)&t;
            t.x = cvtpk(sc0[8], sc0[9]); t.y = cvtpk(sc0[10], sc0[11]); t.z = cvtpk(sc0[12], sc0[13]); t.w = cvtpk(sc0[14], sc0[15]); pf[1] = *(bf16x8*)&t;
            t.x = cvtpk(sc1[0], sc1[1]); t.y = cvtpk(sc1[2], sc1[3]); t.z = cvtpk(sc1[4], sc1[5]); t.w = cvtpk(sc1[6], sc1[7]); pf[2] = *(bf16x8*)&t;
            t.x = cvtpk(sc1[8], sc1[9]); t.y = cvtpk(sc1[10], sc1[11]); t.z = cvtpk(sc1[12], sc1[13]); t.w = cvtpk(sc1[14], sc1[15]); pf[3] = *(bf16x8*)&t;
            const LAS unsigned char* va = lds + V_OFF + (kt & 1) * VB_BYTES + n * PV;
#pragma unroll
            for (int g = 0; g < 4; ++g) { const int po = ((2 * g + hf) ^ vswz) * 16;
#pragma unroll
                for (int dt = 0; dt < 4; ++dt) { const bf16x8 vf = *(const LAS bf16x8*)(va + dt * 32 * PV + po); o[dt] = __builtin_amdgcn_mfma_f32_32x32x16_bf16(vf, pf[g], o[dt], 0, 0, 0); } }
        }
        if (actn) mx_next = rowmax(kt + 1, sn0, sn1);
        sc0 = sn0; sc1 = sn1; mx_cur = mx_next;
        asm volatile("s_waitcnt vmcnt(0)" ::: "memory");
        __syncthreads();
    }
    const float lt = l_run + __shfl_xor(l_run, 32);
    const float inv = 1.0f / lt;
    bf16_t* op = a.O + grow * a.ldo + h * 128 + hf * 4;
#pragma unroll
    for (int dt = 0; dt < 4; ++dt)
#pragma unroll
        for (int r4 = 0; r4 < 4; ++r4) { u32x2 wv; wv.x = cvtpk(o[dt][4 * r4] * inv, o[dt][4 * r4 + 1] * inv); wv.y = cvtpk(o[dt][4 * r4 + 2] * inv, o[dt][4 * r4 + 3] * inv);
            *(u32x2*)(op + dt * 32 + r4 * 8) = wv; }
}
struct TTrue { static constexpr bool value = true; }; struct TFalse { static constexpr bool value = false; };
template <int DQK, bool MASKED>
__device__ __forceinline__ void attn_item3(LAS unsigned char* lds, const AttnArgs& a, int b, int h, int qb) {
    constexpr int NKS = DQK / 16, PK = DQK * 2, PV = 128, KB_BYTES = 64 * PK, VB_BYTES = 128 * PV, NPK = DQK / 8, NKP = (64 * NPK) / 512, V_OFF = 3 * KB_BYTES;
    const int tid = opaque_tid(), lane = tid & 63, w = __builtin_amdgcn_readfirstlane(tid >> 6), n = lane & 31, hf = lane >> 5;
    const int nt = 4 * qb + 4, cw = 4 * qb + (w >> 1);
    const int trow = qb * 256 + w * 32 + n;
    const size_t grow = (size_t)b * SEQ + trow;
    bf16x8 qf[NKS];
    { const bf16_t* qp = a.Q + grow * a.ldq + h * DQK + hf * 8;
#pragma unroll
      for (int ks = 0; ks < NKS; ++ks) qf[ks] = *(const bf16x8*)(qp + ks * 16); }
    f32x16 o[4];
#pragma unroll
    for (int dt = 0; dt < 4; ++dt)
#pragma unroll
        for (int r = 0; r < 16; ++r) o[dt][r] = 0.f;
    float m_run = -INFINITY, l_run = 0.f;
    const float c = a.sc_log2e;
    const bf16_t* Kg = a.K + (size_t)b * SEQ * a.ldk + h * DQK;
    const bf16_t* Vg = a.VT + (size_t)(b * 8 + h) * 128 * SEQ;
    const unsigned long long* Mg = MASKED ? a.MT + (size_t)b * 256 * SEQ + trow : nullptr;
    auto dma_k = [&](int kt) {
        LAS unsigned char* kb = lds + (kt % 3) * KB_BYTES;
#pragma unroll
        for (int i = 0; i < NKP; ++i) { const int s = (w + 8 * i) * 64 + lane, r = s / NPK, cp = s % NPK, cc = cp ^ (NPK == 16 ? (r & 15) : ((r >> 1) & 7));
            __builtin_amdgcn_global_load_lds((const unsigned*)(Kg + (size_t)(kt * 64 + r) * a.ldk + cc * 8), (LAS unsigned*)(kb + (w + 8 * i) * 1024), 16, 0, 0); }
    };
    auto dma_v = [&](int kt) {
        LAS unsigned char* vb = lds + V_OFF + (kt & 1) * VB_BYTES;
#pragma unroll
        for (int i = 0; i < 2; ++i) { const int s = (w + 8 * i) * 64 + lane, d = s >> 3, cp = s & 7, cc = cp ^ ((d >> 1) & 7);
            __builtin_amdgcn_global_load_lds((const unsigned*)(Vg + (size_t)d * SEQ + kt * 64 + cc * 8), (LAS unsigned*)(vb + (w + 8 * i) * 1024), 16, 0, 0); }
    };
    const int kswz = (NPK == 16) ? (n & 15) : ((n >> 1) & 7), vswz = (n >> 1) & 7;
    auto qk = [&](int kt, f32x16& s0, f32x16& s1) {
        const LAS unsigned char* ka = lds + (kt % 3) * KB_BYTES + n * PK;
#pragma unroll
        for (int r = 0; r < 16; ++r) { s0[r] = 0.f; s1[r] = 0.f; }
#pragma unroll
        for (int ks = 0; ks < NKS; ++ks) {
            const int po = ((2 * ks + hf) ^ kswz) * 16;
            const bf16x8 a0 = *(const LAS bf16x8*)(ka + po), a1 = *(const LAS bf16x8*)(ka + 32 * PK + po);
            s0 = __builtin_amdgcn_mfma_f32_32x32x16_bf16(a0, qf[ks], s0, 0, 0, 0);
            s1 = __builtin_amdgcn_mfma_f32_32x32x16_bf16(a1, qf[ks], s1, 0, 0, 0);
        }
    };
    auto rowmax = [&](unsigned long long mw, bool, f32x16& s0, f32x16& s1) -> float {
        if (MASKED) {
            const unsigned mlo = (unsigned)mw >> (hf * 4), mhi = (unsigned)(mw >> 32) >> (hf * 4);
#pragma unroll
            for (int r = 0; r < 16; ++r) { const unsigned bit = 1u << ((r >> 2) * 8 + (r & 3));
                s0[r] = (mlo & bit) ? s0[r] : -INFINITY; s1[r] = (mhi & bit) ? s1[r] : -INFINITY; }
        }
        float mx = max3_asm(s0[0], s1[0], s0[1]);
        mx = max3_asm(mx, s1[1], s0[2]);
#pragma unroll
        for (int r = 2; r < 15; ++r) mx = max3_asm(mx, s1[r], s0[r + 1]);
        mx = max3_asm(mx, s1[15], mx);
        const auto rr = __builtin_amdgcn_permlane32_swap(__float_as_uint(mx), __float_as_uint(mx), false, false);
        return fmaxf(__uint_as_float(rr[0]), __uint_as_float(rr[1]));
    };
    dma_k(0); dma_v(0); if (nt > 1) dma_k(1);
    unsigned long long mw_pre = MASKED ? Mg[(size_t)(nt > 1 ? 1 : 0) * SEQ] : 0ull;
    asm volatile("s_waitcnt vmcnt(0)" ::: "memory");
    __syncthreads();
    f32x16 sa0, sa1, sb0, sb1;
    qk(0, sa0, sa1);
    float mx_cur = rowmax(MASKED ? Mg[0] : 0ull, false, sa0, sa1);
    auto step = [&](int kt, f32x16& c0, f32x16& c1, f32x16& n0, f32x16& n1, auto full_tag) {
        constexpr bool FULL = decltype(full_tag)::value;
        if (kt + 2 < nt) dma_k(kt + 2);
        if (kt + 1 < nt) dma_v(kt + 1);
        const unsigned long long mw_now = mw_pre;
        if (MASKED) mw_pre = Mg[(size_t)(kt + 2 < nt ? kt + 2 : kt) * SEQ];
        const bool act = FULL || kt <= cw, actn = FULL || kt + 1 <= cw;
        const float m_new = fmaxf(m_run, mx_cur);
        const float m_use = (MASKED && m_new == -INFINITY) ? 0.f : m_new;
        if (act && __any(m_new > m_run)) {
            const float al = __builtin_amdgcn_exp2f((m_run - m_use) * c);
            l_run *= al;
#pragma unroll
            for (int dt = 0; dt < 4; ++dt)
#pragma unroll
                for (int r = 0; r < 16; ++r) o[dt][r] *= al;
        }
        if (act) m_run = m_new;
        if (FULL) {
            qk(kt + 1, n0, n1);
            const float mc = m_use * c;
            float ps = 0.f;
#pragma unroll
            for (int r = 0; r < 16; ++r) { c0[r] = __builtin_amdgcn_exp2f(fmaf(c0[r], c, -mc)); c1[r] = __builtin_amdgcn_exp2f(fmaf(c1[r], c, -mc)); ps += c0[r] + c1[r]; }
            l_run += ps;
            bf16x8 pf[4]; u32x4 t;
            t.x = cvtpk(c0[0], c0[1]); t.y = cvtpk(c0[2], c0[3]); t.z = cvtpk(c0[4], c0[5]); t.w = cvtpk(c0[6], c0[7]); pf[0] = *(bf16x8*)&t;
            t.x = cvtpk(c0[8], c0[9]); t.y = cvtpk(c0[10], c0[11]); t.z = cvtpk(c0[12], c0[13]); t.w = cvtpk(c0[14], c0[15]); pf[1] = *(bf16x8*)&t;
            t.x = cvtpk(c1[0], c1[1]); t.y = cvtpk(c1[2], c1[3]); t.z = cvtpk(c1[4], c1[5]); t.w = cvtpk(c1[6], c1[7]); pf[2] = *(bf16x8*)&t;
            t.x = cvtpk(c1[8], c1[9]); t.y = cvtpk(c1[10], c1[11]); t.z = cvtpk(c1[12], c1[13]); t.w = cvtpk(c1[14], c1[15]); pf[3] = *(bf16x8*)&t;
            const LAS unsigned char* va = lds + V_OFF + (kt & 1) * VB_BYTES + n * PV;
#pragma unroll
            for (int g = 0; g < 4; ++g) { const int po = ((2 * g + hf) ^ vswz) * 16;
#pragma unroll
                for (int dt = 0; dt < 4; ++dt) { const bf16x8 vf = *(const LAS bf16x8*)(va + dt * 32 * PV + po); o[dt] = __builtin_amdgcn_mfma_f32_32x32x16_bf16(vf, pf[g], o[dt], 0, 0, 0); } }
            mx_cur = rowmax(mw_now, false, n0, n1);
        } else {
            if (actn) qk(kt + 1, n0, n1);
            if (act) {
                const float mc = m_use * c;
                float ps = 0.f;
#pragma unroll
                for (int r = 0; r < 16; ++r) { c0[r] = __builtin_amdgcn_exp2f(fmaf(c0[r], c, -mc)); c1[r] = __builtin_amdgcn_exp2f(fmaf(c1[r], c, -mc)); ps += c0[r] + c1[r]; }
                l_run += ps;
                bf16x8 pf[4]; u32x4 t;
                t.x = cvtpk(c0[0], c0[1]); t.y = cvtpk(c0[2], c0[3]); t.z = cvtpk(c0[4], c0[5]); t.w = cvtpk(c0[6], c0[7]); pf[0] = *(bf16x8*)&t;
                t.x = cvtpk(c0[8], c0[9]); t.y = cvtpk(c0[10], c0[11]); t.z = cvtpk(c0[12], c0[13]); t.w = cvtpk(c0[14], c0[15]); pf[1] = *(bf16x8*)&t;
                t.x = cvtpk(c1[0], c1[1]); t.y = cvtpk(c1[2], c1[3]); t.z = cvtpk(c1[4], c1[5]); t.w = cvtpk(c1[6], c1[7]); pf[2] = *(bf16x8*)&t;
                t.x = cvtpk(c1[8], c1[9]); t.y = cvtpk(c1[10], c1[11]); t.z = cvtpk(c1[12], c1[13]); t.w = cvtpk(c1[14], c1[15]); pf[3] = *(bf16x8*)&t;
                const LAS unsigned char* va = lds + V_OFF + (kt & 1) * VB_BYTES + n * PV;
#pragma unroll
                for (int g = 0; g < 4; ++g) { const int po = ((2 * g + hf) ^ vswz) * 16;
#pragma unroll
                    for (int dt = 0; dt < 4; ++dt) { const bf16x8 vf = *(const LAS bf16x8*)(va + dt * 32 * PV + po); o[dt] = __builtin_amdgcn_mfma_f32_32x32x16_bf16(vf, pf[g], o[dt], 0, 0, 0); } }
            }
            if (actn) mx_cur = rowmax(mw_now, false, n0, n1);
        }
        asm volatile("s_waitcnt vmcnt(0)" ::: "memory");
        __syncthreads();
    };
    int kt = 0;
    for (; kt < 4 * qb; kt += 2) { step(kt, sa0, sa1, sb0, sb1, TTrue{}); step(kt + 1, sb0, sb1, sa0, sa1, TTrue{}); }
    for (; kt < nt; kt += 2) { step(kt, sa0, sa1, sb0, sb1, TFalse{}); step(kt + 1, sb0, sb1, sa0, sa1, TFalse{}); }
    const float lt = l_run + __shfl_xor(l_run, 32);
    const float inv = 1.0f / lt;
    bf16_t* op = a.O + grow * a.ldo + h * 128 + hf * 4;
#pragma unroll
    for (int dt = 0; dt < 4; ++dt)
#pragma unroll
        for (int r4 = 0; r4 < 4; ++r4) { u32x2 wv; wv.x = cvtpk(o[dt][4 * r4] * inv, o[dt][4 * r4 + 1] * inv); wv.y = cvtpk(o[dt][4 * r4 + 2] * inv, o[dt][4 * r4 + 3] * inv);
            *(u32x2*)(op + dt * 32 + r4 * 8) = wv; }
}
template <int DQK, bool MASKED>
__device__ __forceinline__ void attn_phase(LAS unsigned char* lds, const AttnArgs& a, int bid, int nblk) {
    for (int p = bid; p < 512; p += nblk) {
        const int bh = (p & 7) + 8 * (p >> 8), j = (p >> 3) & 31;
#pragma unroll 1
        for (int i = 0; i < 2; ++i) { if (DQK == 128) attn_item3<DQK, MASKED>(lds, a, bh >> 3, bh & 7, i ? j : 63 - j); else attn_item<DQK, MASKED>(lds, a, bh >> 3, bh & 7, i ? j : 63 - j); }
    }
}

typedef _Float16 f16x8 __attribute__((ext_vector_type(8)));
struct IdxArgs { const float* QI; const unsigned short* KI16; const float* WI; unsigned long long* MT; };
static constexpr int IDX_CAP = 640, IDX_CS = 0, IDX_CI = 32 * IDX_CAP * 4, IDX_KT = IDX_CI + 32 * IDX_CAP * 2, IDX_CNT = IDX_KT + 32768, IDX_TAU = IDX_CNT + 128, IDX_LDS = IDX_TAU + 128;
static_assert(IDX_KT % 1024 == 0, "K tile buffers must be 1 KiB aligned");

__device__ __forceinline__ float ord_inv(unsigned T) { return __uint_as_float((T & 0x80000000u) ? (T & 0x7FFFFFFFu) : ~T); }
__device__ __forceinline__ unsigned lane_prefix(unsigned long long m) { return __builtin_amdgcn_mbcnt_hi((unsigned)(m >> 32), __builtin_amdgcn_mbcnt_lo((unsigned)m, 0u)); }
__device__ __forceinline__ float relu_asm(float x) { float y; asm("v_max_f32 %0, 0, %1" : "=v"(y) : "v"(x)); return y; }
__device__ __forceinline__ void glds16(const void* gsrc, unsigned lds_dst) {
    unsigned keep;
    asm volatile("s_mov_b32 %0, m0\n\ts_mov_b32 m0, %2\n\ts_nop 0\n\tglobal_load_lds_dwordx4 %1, off\n\ts_mov_b32 m0, %0" : "=&s"(keep) : "v"(gsrc), "s"(lds_dst) : "memory");
}

template <bool EXACT> __device__ __forceinline__ int idx_compact(LAS unsigned char* lds, int qq, int lane, int n, float& tau) {
    LAS float* cs = (LAS float*)(lds + IDX_CS) + qq * IDX_CAP; LAS unsigned short* ci = (LAS unsigned short*)(lds + IDX_CI) + qq * IDX_CAP;
    float sv[10]; unsigned short iv[10]; unsigned uk[10];
#pragma unroll
    for (int j = 0; j < 10; ++j) { const int idx = lane + 64 * j; const bool valid = idx < n; sv[j] = cs[idx]; iv[j] = ci[idx]; uk[j] = valid ? ord_key(sv[j]) : 0u; }
    auto count_ge = [&](unsigned t) { int c = 0;
#pragma unroll
        for (int j = 0; j < 10; ++j) c += __builtin_popcountll(__ballot(uk[j] >= t));
        return c; };
    unsigned lo = ord_key(tau), hi = 0xFF800001u;
    if (lo > 0x80800000u) { const unsigned h2 = lo + 0x00800000u;
        if (h2 < hi) { if (count_ge(h2) >= 256) lo = h2; else hi = h2; } }
    while (hi - lo > 1u) {
        const unsigned mid = lo + ((hi - lo) >> 1); const int c = count_ge(mid);
        if (c >= 256) { lo = mid; if (!EXACT && c <= 336) break; } else hi = mid;
    }
    const unsigned T = lo;
    int need = 0;
    if (EXACT) { int ngt = 0;
#pragma unroll
        for (int j = 0; j < 10; ++j) ngt += __builtin_popcountll(__ballot(uk[j] > T));
        need = 256 - ngt; }
    int base = 0, tiebase = 0;
#pragma unroll
    for (int j = 0; j < 10; ++j) {
        bool keep;
        if (EXACT) { const bool gt = uk[j] > T, eq = uk[j] == T; const unsigned long long em = __ballot(eq); keep = gt || (eq && (tiebase + (int)lane_prefix(em)) < need); tiebase += __builtin_popcountll(em); }
        else keep = uk[j] >= T;
        const unsigned long long km = __ballot(keep);
        const int pos = base + (int)lane_prefix(km);
        if (keep) { cs[pos] = sv[j]; ci[pos] = iv[j]; }
        base += __builtin_popcountll(km);
    }
    tau = ord_inv(T);
    return base;
}

__device__ __forceinline__ void idx_item(LAS unsigned char* lds, const IdxArgs& a, int b, int hc) {
    const int tid = opaque_tid(), lane = tid & 63, w = __builtin_amdgcn_readfirstlane(tid >> 6), n = lane & 31, hf = lane >> 5;
    const int t0 = hc * 32, L = (t0 / 64 + 1) * 64, nsub = L / 32, ntile = (L + 127) / 128;
    const size_t q0 = (size_t)b * SEQ + t0 + 4 * w;
    LAS float* cs = (LAS float*)(lds + IDX_CS); LAS unsigned short* ci = (LAS unsigned short*)(lds + IDX_CI);
    LAS unsigned* cnt = (LAS unsigned*)(lds + IDX_CNT);
    f16x8 qf[2][4];
#pragma unroll
    for (int rt = 0; rt < 2; ++rt) { const float* qp = a.QI + (q0 + 2 * rt + (n >> 4)) * 1024 + (n & 15) * 64 + hf * 8;
#pragma unroll
        for (int ks = 0; ks < 4; ++ks) { const f32x4 x0 = *(const f32x4*)(qp + ks * 16), x1 = *(const f32x4*)(qp + ks * 16 + 4);
            f16x8 v; v[0] = (_Float16)x0[0]; v[1] = (_Float16)x0[1]; v[2] = (_Float16)x0[2]; v[3] = (_Float16)x0[3]; v[4] = (_Float16)x1[0]; v[5] = (_Float16)x1[1]; v[6] = (_Float16)x1[2]; v[7] = (_Float16)x1[3];
            qf[rt][ks] = v; } }
    float wv[2][16];
#pragma unroll
    for (int rt = 0; rt < 2; ++rt)
#pragma unroll
        for (int r = 0; r < 16; ++r) wv[rt][r] = a.WI[(q0 + 2 * rt + (r >> 3)) * 16 + (((r & 3) + 8 * (r >> 2) + 4 * hf) & 15)] * (0.125f * 0.25f);
    if (tid < 32) cnt[tid] = 0u;
    int cq0 = 0, cq1 = 0, cq2 = 0, cq3 = 0;
    float tq0 = -INFINITY, tq1 = -INFINITY, tq2 = -INFINITY, tq3 = -INFINITY;
    float tau0 = INFINITY, tau1 = INFINITY;
    const unsigned short* Kg = a.KI16 + (size_t)b * SEQ * 64;
    const unsigned ldsbase = (unsigned)(size_t)lds;
    auto dma = [&](int kt, int buf) {
#pragma unroll
        for (int i = 0; i < 2; ++i) { const int s = (w + 8 * i) * 64 + lane, r = s >> 3, cp = s & 7, cc = cp ^ ((r >> 1) & 7);
            glds16(Kg + (size_t)(kt * 128 + r) * 64 + cc * 8, ldsbase + IDX_KT + buf * 16384 + (w + 8 * i) * 1024); }
    };
    dma(0, 0);
    asm volatile("s_waitcnt vmcnt(0)" ::: "memory");
    __syncthreads();
    const int kswz = (n >> 1) & 7;
    f32x16 accA[2], accB[2];
#pragma unroll
    for (int rt = 0; rt < 2; ++rt)
#pragma unroll
        for (int r = 0; r < 16; ++r) { accA[rt][r] = 0.f; accB[rt][r] = 0.f; }
    int keyA = 0, keyB = 0;
    auto epilogue = [&](const f32x16 (&acc)[2], int key) {
        float sc[2];
#pragma unroll
        for (int rt = 0; rt < 2; ++rt) { float pa = 0.f, pb = 0.f;
#pragma unroll
            for (int r = 0; r < 8; ++r) { pa = fmaf(relu_asm(acc[rt][r]), wv[rt][r], pa); pb = fmaf(relu_asm(acc[rt][r + 8]), wv[rt][r + 8], pb); }
            const auto rr = __builtin_amdgcn_permlane32_swap(__float_as_uint(pa), __float_as_uint(pb), false, false);
            sc[rt] = __uint_as_float(rr[0]) + __uint_as_float(rr[1]); }
        const bool c0 = sc[0] > tau0, c1 = sc[1] > tau1;
        const unsigned long long m0 = __ballot(c0), m1 = __ballot(c1);
        if (m0 | m1) {
            const unsigned l0 = (unsigned)m0, h0 = (unsigned)(m0 >> 32), l1 = (unsigned)m1, h1 = (unsigned)(m1 >> 32);
            const int p0 = hf ? cq1 + (int)__builtin_amdgcn_mbcnt_hi(h0, 0u) : cq0 + (int)__builtin_amdgcn_mbcnt_lo(l0, 0u);
            const int p1 = hf ? cq3 + (int)__builtin_amdgcn_mbcnt_hi(h1, 0u) : cq2 + (int)__builtin_amdgcn_mbcnt_lo(l1, 0u);
            if (c0 && p0 < IDX_CAP) { const int qq = 4 * w + hf; cs[qq * IDX_CAP + p0] = sc[0]; ci[qq * IDX_CAP + p0] = (unsigned short)key; }
            if (c1 && p1 < IDX_CAP) { const int qq = 4 * w + 2 + hf; cs[qq * IDX_CAP + p1] = sc[1]; ci[qq * IDX_CAP + p1] = (unsigned short)key; }
            cq0 += __builtin_popcount(l0); cq1 += __builtin_popcount(h0); cq2 += __builtin_popcount(l1); cq3 += __builtin_popcount(h1);
        }
    };
    auto mma = [&](f32x16 (&acc)[2], const LAS unsigned char* kr) {
        f16x8 kf[4];
#pragma unroll
        for (int ks = 0; ks < 4; ++ks) kf[ks] = *(const LAS f16x8*)(kr + ((2 * ks + hf) ^ kswz) * 16);
#pragma unroll
        for (int rt = 0; rt < 2; ++rt) {
            f32x16 c;
#pragma unroll
            for (int r = 0; r < 16; ++r) c[r] = 0.f;
#pragma unroll
            for (int ks = 0; ks < 4; ++ks) c = __builtin_amdgcn_mfma_f32_32x32x16_f16(qf[rt][ks], kf[ks], c, 0, 0, 0);
            acc[rt] = c; }
    };
#ifdef IDX_PROBE2
  for (int rep_ = 0; rep_ < 2; ++rep_) {
    if (rep_ == 1) { epilogue(accB, keyB); tau0 = INFINITY; tau1 = INFINITY; __syncthreads(); dma(0, 0); asm volatile("s_waitcnt vmcnt(0)" ::: "memory"); __syncthreads(); }
#endif
    for (int kt = 0; kt < ntile; ++kt) {
        if (kt + 1 < ntile) dma(kt + 1, (kt + 1) & 1);
#ifdef IDX_PROBE2
        if (rep_ == 0)
#endif
        { const unsigned c_all = cnt[lane & 31];
          if (__ballot(c_all > (unsigned)(IDX_CAP - 160))) {
              if (cq0 > 400) cq0 = idx_compact<false>(lds, 4 * w + 0, lane, cq0, tq0);
              if (cq1 > 400) cq1 = idx_compact<false>(lds, 4 * w + 1, lane, cq1, tq1);
              if (cq2 > 400) cq2 = idx_compact<false>(lds, 4 * w + 2, lane, cq2, tq2);
              if (cq3 > 400) cq3 = idx_compact<false>(lds, 4 * w + 3, lane, cq3, tq3);
              if (kt > 0) { tau0 = hf ? tq1 : tq0; tau1 = hf ? tq3 : tq2; }
          } }
        const LAS unsigned char* kb = lds + IDX_KT + (kt & 1) * 16384 + n * 128;
        const int sbase = kt * 4;
#ifdef IDX_PROBE2
        if (sbase + 0 < nsub) { mma(accA, kb); epilogue(accB, keyB); keyA = kt * 128 + n; if (kt == 0 && rep_ == 0) { tau0 = -INFINITY; tau1 = -INFINITY; } }
#else
        if (sbase + 0 < nsub) { mma(accA, kb); epilogue(accB, keyB); keyA = kt * 128 + n; if (kt == 0) { tau0 = -INFINITY; tau1 = -INFINITY; } }
#endif
        if (sbase + 1 < nsub) { mma(accB, kb + 32 * 128); epilogue(accA, keyA); keyB = kt * 128 + 32 + n; }
        if (sbase + 2 < nsub) { mma(accA, kb + 64 * 128); epilogue(accB, keyB); keyA = kt * 128 + 64 + n; }
        if (sbase + 3 < nsub) { mma(accB, kb + 96 * 128); epilogue(accA, keyA); keyB = kt * 128 + 96 + n; }
        if (lane < 4) cnt[4 * w + lane] = (unsigned)(lane == 0 ? cq0 : (lane == 1 ? cq1 : (lane == 2 ? cq2 : cq3)));
        asm volatile("s_waitcnt vmcnt(0)" ::: "memory");
        __syncthreads();
    }
#ifdef IDX_PROBE2
  }
#endif
    epilogue(accB, keyB);
    __syncthreads();
    LAS unsigned* bm = (LAS unsigned*)(lds + IDX_KT) + w * 512;
    if (cq0 > 256) cq0 = idx_compact<true>(lds, 4 * w + 0, lane, cq0, tq0);
    if (cq1 > 256) cq1 = idx_compact<true>(lds, 4 * w + 1, lane, cq1, tq1);
    if (cq2 > 256) cq2 = idx_compact<true>(lds, 4 * w + 2, lane, cq2, tq2);
    if (cq3 > 256) cq3 = idx_compact<true>(lds, 4 * w + 3, lane, cq3, tq3);
#pragma unroll 1
    for (int i = 0; i < 4; ++i) {
        const int qq = 4 * w + i;
        const int nsel = (i == 0) ? cq0 : ((i == 1) ? cq1 : ((i == 2) ? cq2 : cq3));
#pragma unroll
        for (int j = 0; j < 8; ++j) bm[lane + 64 * j] = 0u;
#pragma unroll
        for (int j = 0; j < 4; ++j) { const int idx = lane + 64 * j; if (idx < nsel) { const unsigned k = ci[qq * IDX_CAP + idx]; (void)__hip_atomic_fetch_or(bm + (k >> 5), 1u << (k & 31), __ATOMIC_RELAXED, __HIP_MEMORY_SCOPE_WORKGROUP); } }
        const int tq = t0 + qq;
#pragma unroll 1
        for (int kt = lane; kt < L / 64; kt += 64) { const unsigned long long v = (unsigned long long)bm[2 * kt] | ((unsigned long long)bm[2 * kt + 1] << 32); a.MT[((size_t)b * 256 + kt) * SEQ + tq] = v; }
    }
    __syncthreads();
}
__device__ __forceinline__ void idx_phase(LAS unsigned char* lds, const IdxArgs& a, int bid, int nblk) {
    for (int k = bid; k < 256; k += nblk) {
#pragma unroll 1
        for (int i = 0; i < 4; ++i) idx_item(lds, a, i & 1, (i < 2) ? 511 - k : k);
    }
}
#define XB_TMO      128
#define XB_XCNT(j)  (256  + 64 * (j))
#define XB_XSUB(j)  (1280 + 64 * (j))
#define XB_XGEN(j)  (2304 + 64 * (j))
#define XB_TOP      3328
#define XB_TOPGEN   3392
#define XCD_BAR_WORDS 3456
#define XB_SPIN_CAP (1u << 23)


__device__ __forceinline__ unsigned xb_ld(unsigned* p)              { return __hip_atomic_load(p, __ATOMIC_RELAXED, __HIP_MEMORY_SCOPE_AGENT); }
__device__ __forceinline__ unsigned xb_add(unsigned* p, unsigned v) { return __hip_atomic_fetch_add(p, v, __ATOMIC_RELAXED, __HIP_MEMORY_SCOPE_AGENT); }
__device__ __forceinline__ unsigned xb_xcc_id() { return (unsigned)__builtin_amdgcn_s_getreg((3 << 11) | 20) & 0xFu; }
#define XB_SPIN(cond, bar) do { unsigned _sp = 0; while (cond) { __builtin_amdgcn_s_sleep(1); \
    if ((++_sp & 255u) == 0u) { if (xb_ld(&(bar)[XB_TMO])) break; if (_sp > XB_SPIN_CAP) { atomicAdd(&(bar)[XB_TMO], 1u); break; } } } } while (0)

struct XcdBarrier {
    unsigned* bar; unsigned x;
    volatile LAS unsigned* st;
};

__device__ __forceinline__ XcdBarrier xcd_barrier_post(unsigned* bar, volatile LAS unsigned* st) {
    XcdBarrier b; b.bar = bar; b.x = xb_xcc_id(); b.st = st;
    if (threadIdx.x == 0) (void)xb_add(&bar[XB_XCNT(b.x)], 1u);
    return b;
}
__device__ __forceinline__ void xcd_barrier_complete(unsigned* bar, unsigned x, unsigned& nloc, unsigned& nx) {
    const unsigned G = gridDim.x * gridDim.y * gridDim.z;
    unsigned sum, cnt, mine, sp = 0u;
    for (;;) {
        sum = 0u; cnt = 0u; mine = 0u;
#pragma unroll
        for (unsigned j = 0; j < 16; ++j) { const unsigned c = xb_ld(&bar[XB_XCNT(j)]); sum += c; cnt += (c > 0u) ? 1u : 0u; mine = (j == x) ? c : mine; }
        if (sum == G) break;
        __builtin_amdgcn_s_sleep(1);
        if ((++sp & 255u) == 0u) { if (xb_ld(&bar[XB_TMO])) break; if (sp > XB_SPIN_CAP) { atomicAdd(&bar[XB_TMO], 1u); break; } }
    }
    nloc = mine > 0u ? mine : 1u; nx = cnt > 0u ? cnt : 1u;
}

__device__ __forceinline__ void xcd_barrier(const XcdBarrier& b) {
    asm volatile("s_waitcnt vmcnt(0)" ::: "memory");
    __syncthreads();
    if (threadIdx.x == 0) {
        unsigned* bar = b.bar;
        __builtin_amdgcn_s_waitcnt(0);
        unsigned nloc = b.st[0], nx = b.st[1];
        if (nloc == 0u) { xcd_barrier_complete(bar, b.x, nloc, nx); b.st[0] = nloc; b.st[1] = nx; }
        const unsigned old = xb_add(&bar[XB_XSUB(b.x)], 1u);
        const unsigned gen = old / nloc;
        if (old + 1u == (gen + 1u) * nloc) {
            __builtin_amdgcn_fence(__ATOMIC_RELEASE, "agent");
            asm volatile("s_waitcnt vmcnt(0)" ::: "memory");
            const unsigned og = xb_add(&bar[XB_TOP], 1u);
            const unsigned tg = og / nx;
            if (og + 1u == (tg + 1u) * nx) xb_add(&bar[XB_TOPGEN], 1u);
            else XB_SPIN(xb_ld(&bar[XB_TOPGEN]) == tg, bar);
            __builtin_amdgcn_fence(__ATOMIC_ACQUIRE, "agent");
            xb_add(&bar[XB_XGEN(b.x)], 1u);
            asm volatile("s_waitcnt vmcnt(0)" ::: "memory");
        } else {
            XB_SPIN(xb_ld(&bar[XB_XGEN(b.x)]) == gen, bar);
            __builtin_amdgcn_fence(__ATOMIC_ACQUIRE, "agent");
            asm volatile("s_waitcnt vmcnt(0)" ::: "memory");
        }
    }
    __syncthreads();
}

#ifndef FP8_UP0
#define FP8_UP0 0
#endif
#ifndef FP8_UP1
#define FP8_UP1 1
#endif
#ifndef FP8_DN0
#define FP8_DN0 0
#endif
#ifndef FP8_DN1
#define FP8_DN1 1
#endif
#ifndef SKIPMASK
#define SKIPMASK 0
#endif

__device__ __forceinline__ int perm16(int t) { const int a = (t >> 2) & 3; return (t & ~12) | ((a == 1 ? 2 : (a == 2 ? 1 : a)) << 2); }
__device__ __forceinline__ void st_vt(bf16_t* VT, int row, int h, int d, f32x4 v) {
    const int b = row / SEQ, t = row % SEQ; bf16_t* p = VT + ((size_t)(b * 8 + h) * 128 + d) * SEQ + (t & ~15) + perm16(t & 15);
    p[0] = f2bf(v[0]); p[SEQ] = f2bf(v[1]); p[2 * (size_t)SEQ] = f2bf(v[2]); p[3 * (size_t)SEQ] = f2bf(v[3]);
}
struct FAbIn2 { bf16_t *Q, *K, *VT; float *QI, *U, *WI; unsigned short* KI16;
    __device__ __forceinline__ void operator()(int r, int c, f32x4 v) const {
        if (c < 1024) st_bf16x4(Q + (size_t)r * 1024 + c, v);
        else if (c < 2048) st_bf16x4(K + (size_t)r * 1024 + (c - 1024), v);
        else if (c < 3072) st_vt(VT, r, (c - 2048) >> 7, (c - 2048) & 127, v);
        else if (c < 4096) st_f32x4(QI + (size_t)r * 1024 + (c - 3072), v);
        else if (c < 5120) st_f32x4(U + (size_t)r * 1024 + (c - 4096), v);
        else if (c < 5184) { typedef _Float16 h2 __attribute__((ext_vector_type(2))); union { h2 h; unsigned u; } a, b; a.h = (h2){(_Float16)v[0], (_Float16)v[1]}; b.h = (h2){(_Float16)v[2], (_Float16)v[3]};
            u32x2 w; w.x = a.u; w.y = b.u; *(u32x2*)(KI16 + (size_t)r * 64 + (c - 5120)) = w; }
        else if (c < 5200) st_f32x4(WI + (size_t)r * 16 + (c - 5184), v);
    } };
struct FKvUp2 { bf16_t *K1, *VT;
    __device__ __forceinline__ void operator()(int r, int c, f32x4 v) const {
        const int h = c >> 8, d = c & 255;
        if (d < 128) st_bf16x4(K1 + (size_t)r * 1536 + h * 192 + d, v);
        else st_vt(VT, r, h, d - 128, v);
    } };

template <class E> __device__ __forceinline__ void ph_gemm_e(LAS unsigned char* lds, const bf16_t* A, int lda, const bf16_t* Bt, int ldb, int M, int N, int K, const E& e, int bid, int nblk, int a_shift = 0, int a_bytes = 0) {
    pg8::Gemm g; g.A = A; g.Bt = Bt; g.M = M; g.N = N; g.K = K; g.lda = lda; g.ldb = ldb; g.a_shift = a_shift; g.a_bytes = a_bytes; g.pad_ = 0;
    pg8::StaticOrder S; S.init(M, N, nblk, bid);
    pg8::gemm_phase<E, pg8::StaticOrder, false>(lds, g, S, e, nullptr);
    __syncthreads();
}
template <class F> __device__ __forceinline__ void ph_gemm(LAS unsigned char* lds, const bf16_t* A, int lda, const bf16_t* Bt, int ldb, int M, int N, int K, const F& f, int bid, int nblk, int a_shift = 0, int a_bytes = 0) {
    EpiG<F> e; e.f = f;
    ph_gemm_e(lds, A, lda, Bt, ldb, M, N, K, e, bid, nblk, a_shift, a_bytes);
}
template <class F> __device__ __forceinline__ void ph_gemm8(LAS unsigned char* lds, const unsigned char* A, int lda, const unsigned char* Bt, int ldb, int M, int N, int K, const F& f, int bid, int nblk) {
    EpiG<F, true> e; e.f = f;
    ph_gemm_e(lds, (const bf16_t*)A, lda / 2, (const bf16_t*)Bt, ldb / 2, M, N, K / 2, e, bid, nblk, 0, 0);
}
struct FPool { bf16_t* CC; const float* pb; const float* ps;
    __device__ __forceinline__ void operator()(int r, int c, f32x4 v) const { const f32x4 b = *(const f32x4*)(pb + c), s = *(const f32x4*)(ps + c); st_bf16x4(CC + (size_t)r * 2048 + 1024 + c, (v + b) * s); } };
struct EpiLru {
    static constexpr bool PERM = false, AFTER_DRAIN = false, FP8 = false;
    const bf16_t* XCB; const float *ba, *bx, *lam; float *LA, *LB;
    __device__ __forceinline__ void operator()(const f32x4 (&acc)[2][2][4][2], const pg8::Unit& u, int wr, int wc, int fr, int fq) const {
        const int row0 = u.pm * 256 + wr * 64 + fr;
#pragma unroll
        for (int n = 0; n < 2; ++n) {
            const int ch = u.pn * 128 + wc * 32 + 16 * n + 4 * fq;
            const f32x4 bav = *(const f32x4*)(ba + ch), bxv = *(const f32x4*)(bx + ch), lm = *(const f32x4*)(lam + ch);
            f32x4 sp;
#pragma unroll
            for (int j = 0; j < 4; ++j) sp[j] = log1pf(__expf(-lm[j]));
#pragma unroll
            for (int ai = 0; ai < 2; ++ai)
#pragma unroll
                for (int m = 0; m < 4; ++m) {
                    const int row = row0 + ai * 128 + m * 16;
                    const u32x2 xw = *(const u32x2*)(XCB + (size_t)row * 1024 + ch);
                    const f32x4 xc = {__uint_as_float(xw.x << 16), __uint_as_float(xw.x & 0xFFFF0000u), __uint_as_float(xw.y << 16), __uint_as_float(xw.y & 0xFFFF0000u)};
                    const f32x4 ga = acc[ai][0][m][n] + bav, gx = acc[ai][1][m][n] + bxv;
                    f32x4 av, bv;
#pragma unroll
                    for (int j = 0; j < 4; ++j) {
                        const float rg = 1.0f / (1.0f + __expf(-ga[j])), ig = 1.0f / (1.0f + __expf(-gx[j]));
                        const float log_a = -8.0f * rg * sp[j], a = __expf(log_a), mult = sqrtf(-expm1f(2.0f * log_a));
                        av[j] = a; bv[j] = mult * (ig * xc[j]);
                    }
                    *(f32x4*)(LA + (size_t)row * 1024 + ch) = av; *(f32x4*)(LB + (size_t)row * 1024 + ch) = bv;
                }
        }
    }
};
__device__ __forceinline__ void ph_pooled(const float* __restrict__ U, bf16_t* __restrict__ P, int bid, int nblk) {
    for (int i = bid * 512 + opaque_tid(); i < 256 * (NTOK / 64); i += nblk * 512) {
        const int c4 = i & 255, row0 = (i >> 8) * 64, t0 = row0 % SEQ, g = c4 >> 6, win = 2 << g;
        const f32x4* up = (const f32x4*)U + (size_t)row0 * 256 + c4;
        f32x4 s = {0.f, 0.f, 0.f, 0.f};
        if (t0 > 0) { for (int k = 1; k < win; ++k) s += up[-(ptrdiff_t)k * 256]; }
        for (int r = 0; r < 64; ++r) {
            const int t = t0 + r; const f32x4 u0 = up[(ptrdiff_t)r * 256];
            s += u0;
            const int cnt = (t + 1 < win) ? (t + 1) : win;
            st_bf16x4(P + (size_t)(row0 + r) * 1024 + c4 * 4, s * (1.0f / (float)cnt) - u0);
            if (t + 1 >= win) s -= up[(ptrdiff_t)(r + 1 - win) * 256];
        }
    }
}
__device__ __forceinline__ void ph_xc(const bf16_t* __restrict__ XL, const float* __restrict__ cw, const float* __restrict__ cb, bf16_t* __restrict__ XCB, int bid, int nblk) {
    for (int i = bid * 512 + opaque_tid(); i < 128 * (NTOK / 32); i += nblk * 512) {
        const int c8 = (i & 127) * 8, row0 = (i >> 7) * 32, t0 = row0 % SEQ;
        float w0[8], w1[8], w2[8], w3[8], bb[8];
#pragma unroll
        for (int j = 0; j < 8; ++j) { w0[j] = cw[c8 + j]; w1[j] = cw[1024 + c8 + j]; w2[j] = cw[2048 + c8 + j]; w3[j] = cw[3072 + c8 + j]; bb[j] = cb[c8 + j]; }
        u32x4 p3 = {0u, 0u, 0u, 0u}, p2 = p3, p1 = p3;
        if (t0 >= 3) { p3 = *(const u32x4*)(XL + (size_t)(row0 - 3) * 1024 + c8); p2 = *(const u32x4*)(XL + (size_t)(row0 - 2) * 1024 + c8); p1 = *(const u32x4*)(XL + (size_t)(row0 - 1) * 1024 + c8); }
        for (int r = 0; r < 32; ++r) {
            const u32x4 cur = *(const u32x4*)(XL + (size_t)(row0 + r) * 1024 + c8);
            const unsigned a3[4] = {p3.x, p3.y, p3.z, p3.w}, a2[4] = {p2.x, p2.y, p2.z, p2.w}, a1[4] = {p1.x, p1.y, p1.z, p1.w}, a0[4] = {cur.x, cur.y, cur.z, cur.w};
            float y[8];
#pragma unroll
            for (int j = 0; j < 4; ++j) {
                y[2 * j] = bb[2 * j] + w0[2 * j] * __uint_as_float(a3[j] << 16) + w1[2 * j] * __uint_as_float(a2[j] << 16) + w2[2 * j] * __uint_as_float(a1[j] << 16) + w3[2 * j] * __uint_as_float(a0[j] << 16);
                y[2 * j + 1] = bb[2 * j + 1] + w0[2 * j + 1] * __uint_as_float(a3[j] & 0xFFFF0000u) + w1[2 * j + 1] * __uint_as_float(a2[j] & 0xFFFF0000u) + w2[2 * j + 1] * __uint_as_float(a1[j] & 0xFFFF0000u) + w3[2 * j + 1] * __uint_as_float(a0[j] & 0xFFFF0000u); }
            u32x4 o; o.x = pack2bf(y[0], y[1]); o.y = pack2bf(y[2], y[3]); o.z = pack2bf(y[4], y[5]); o.w = pack2bf(y[6], y[7]);
            *(u32x4*)(XCB + (size_t)(row0 + r) * 1024 + c8) = o;
            p3 = p2; p2 = p1; p1 = cur;
        }
    }
}
__device__ __forceinline__ void ph_convT(LAS unsigned char* lds, const float* __restrict__ W, int ldw, int src_col0, int ncols, int K, bf16_t* __restrict__ Bt, int ldd, int bid, int nblk) {
    const int tid = opaque_tid(), sub = tid >> 8, t8 = tid & 255, tx = t8 & 31, ty = t8 >> 5;
    LAS float* tile = (LAS float*)lds + sub * (32 * 33);
    const int ntx = (ncols + 31) / 32, ntiles = ntx * (K / 32);
    for (int base = bid * 2; base < ntiles; base += nblk * 2) {
        const int tl = base + sub; const bool act = tl < ntiles;
        const int n0 = (tl % ntx) * 32, k0 = (tl / ntx) * 32;
        if (act) {
#pragma unroll
            for (int i = 0; i < 4; ++i) { const int k = k0 + ty + 8 * i, n = n0 + tx; tile[(ty + 8 * i) * 33 + tx] = (n < ncols) ? W[(size_t)k * ldw + src_col0 + n] : 0.f; } }
        __syncthreads();
        if (act) {
#pragma unroll
            for (int i = 0; i < 4; ++i) { const int n = n0 + ty + 8 * i, k = k0 + tx; if (n < ncols) Bt[(size_t)n * ldd + k] = f2bf(tile[tx * 33 + ty + 8 * i]); } }
        __syncthreads();
    }
}
__device__ __forceinline__ void ph_convT8(LAS unsigned char* lds, const float* __restrict__ W, int ldw, int ncols, int K, unsigned char* __restrict__ Bt, int bid, int nblk) {
    const int tid = opaque_tid(), sub = tid >> 8, t8 = tid & 255, tx = t8 & 31, ty = t8 >> 5;
    LAS float* tile = (LAS float*)lds + sub * (32 * 33);
    const int ntx = ncols / 32, ntiles = ntx * (K / 32);
    for (int base = bid * 2; base < ntiles; base += nblk * 2) {
        const int tl = base + sub; const bool act = tl < ntiles;
        const int n0 = (tl % ntx) * 32, k0 = (tl / ntx) * 32;
        if (act) {
#pragma unroll
            for (int i = 0; i < 4; ++i) tile[(ty + 8 * i) * 33 + tx] = W[(size_t)(k0 + ty + 8 * i) * ldw + n0 + tx]; }
        __syncthreads();
        if (act) {
            const int nn = t8 >> 3, kk = (t8 & 7) * 4;
            int pk = 0;
            pk = __builtin_amdgcn_cvt_pk_fp8_f32(64.f * tile[(kk + 0) * 33 + nn], 64.f * tile[(kk + 1) * 33 + nn], pk, false);
            pk = __builtin_amdgcn_cvt_pk_fp8_f32(64.f * tile[(kk + 2) * 33 + nn], 64.f * tile[(kk + 3) * 33 + nn], pk, true);
            *(int*)(Bt + (size_t)(n0 + nn) * K + k0 + kk) = pk; }
        __syncthreads();
    }
}
template <int NC> __device__ __forceinline__ void ph_rmsnorm(const float* __restrict__ x, const float* __restrict__ g, bf16_t* __restrict__ out, int bid, int nblk) {
    const int lane = opaque_tid() & 63, w = opaque_tid() >> 6;
    constexpr int NV = NC / 256;
    for (int row = bid * 8 + w; row < NTOK; row += nblk * 8) {
        const f32x4* xr = (const f32x4*)(x + (size_t)row * NC);
        f32x4 v[NV]; float ss = 0.f;
#pragma unroll
        for (int i = 0; i < NV; ++i) { v[i] = xr[lane + 64 * i]; ss += v[i][0] * v[i][0] + v[i][1] * v[i][1] + v[i][2] * v[i][2] + v[i][3] * v[i][3]; }
        ss = wave_sum(ss);
        const float r = rsqrtf(ss * (1.0f / NC) + NORM_EPS);
#pragma unroll
        for (int i = 0; i < NV; ++i) { const f32x4 gg = ((const f32x4*)g)[lane + 64 * i]; st_bf16x4(out + (size_t)row * NC + 4 * (lane + 64 * i), v[i] * r * gg); }
    }
}
__device__ __forceinline__ void ph_resnorm(const float* xin, const bf16_t* __restrict__ m, const float* __restrict__ gpost, const float* __restrict__ gpre, float* xout, bf16_t* __restrict__ h, unsigned char* __restrict__ h8, int bid, int nblk) {
    const int lane = opaque_tid() & 63, w = opaque_tid() >> 6;
    for (int row = bid * 8 + w; row < NTOK; row += nblk * 8) {
        const f32x4* xr = (const f32x4*)(xin + (size_t)row * DM);
        const u32x2* mr = (const u32x2*)(m + (size_t)row * DM);
        f32x4 mv[8], xv[8]; float ss = 0.f;
#pragma unroll
        for (int i = 0; i < 8; ++i) { const u32x2 wd = mr[lane + 64 * i]; mv[i][0] = __uint_as_float(wd.x << 16); mv[i][1] = __uint_as_float(wd.x & 0xFFFF0000u); mv[i][2] = __uint_as_float(wd.y << 16); mv[i][3] = __uint_as_float(wd.y & 0xFFFF0000u);
            xv[i] = xr[lane + 64 * i]; ss += mv[i][0] * mv[i][0] + mv[i][1] * mv[i][1] + mv[i][2] * mv[i][2] + mv[i][3] * mv[i][3]; }
        ss = wave_sum(ss);
        const float r1 = rsqrtf(ss * (1.0f / DM) + NORM_EPS);
        float s2 = 0.f;
#pragma unroll
        for (int i = 0; i < 8; ++i) { const f32x4 gg = ((const f32x4*)gpost)[lane + 64 * i]; xv[i] = xv[i] + mv[i] * r1 * gg; ((f32x4*)(xout + (size_t)row * DM))[lane + 64 * i] = xv[i];
            s2 += xv[i][0] * xv[i][0] + xv[i][1] * xv[i][1] + xv[i][2] * xv[i][2] + xv[i][3] * xv[i][3]; }
        if (gpre) {
            s2 = wave_sum(s2);
            const float r2 = rsqrtf(s2 * (1.0f / DM) + NORM_EPS);
#pragma unroll
            for (int i = 0; i < 8; ++i) { const f32x4 gg = ((const f32x4*)gpre)[lane + 64 * i]; const f32x4 y = xv[i] * r2 * gg;
                if (h8) { int pk = 0; pk = __builtin_amdgcn_cvt_pk_fp8_f32(y[0], y[1], pk, false); pk = __builtin_amdgcn_cvt_pk_fp8_f32(y[2], y[3], pk, true); *(int*)(h8 + (size_t)row * DM + 4 * (lane + 64 * i)) = pk; }
                else st_bf16x4(h + (size_t)row * DM + 4 * (lane + 64 * i), y); }
        }
    }
}
__device__ __forceinline__ void ph_scan1(const float* __restrict__ Aa, const float* __restrict__ Bb, float* __restrict__ CA, float* __restrict__ CH, int bid, int nblk) {
    for (int i = bid * 512 + opaque_tid(); i < 2 * 256 * 1024; i += nblk * 512) {
        const int ch = i & 1023, chunk = (i >> 10) & 255, b = i >> 18;
        const size_t base = ((size_t)b * SEQ + (size_t)chunk * 64) * 1024 + ch;
        float h = 0.f, P = 1.f;
        for (int s = 0; s < 64; ++s) { const float a = Aa[base + (size_t)s * 1024]; h = a * h + Bb[base + (size_t)s * 1024]; P *= a; }
        CA[i] = P; CH[i] = h;
    }
}
__device__ __forceinline__ void ph_scan2(const float* __restrict__ CA, const float* __restrict__ CH, float* __restrict__ CIN, int bid, int nblk) {
    for (int i = bid * 512 + opaque_tid(); i < 2048; i += nblk * 512) {
        const int ch = i & 1023, b = i >> 10;
        float h = 0.f;
        for (int c = 0; c < 256; ++c) { const int j = (b * 256 + c) * 1024 + ch; CIN[j] = h; h = CA[j] * h + CH[j]; }
    }
}
__device__ __forceinline__ void ph_scan3(const float* __restrict__ Aa, const float* __restrict__ Bb, const float* __restrict__ CIN, const bf16_t* __restrict__ YG, bf16_t* __restrict__ CC, int bid, int nblk) {
    for (int i = bid * 512 + opaque_tid(); i < 2 * 256 * 1024; i += nblk * 512) {
        const int ch = i & 1023, chunk = (i >> 10) & 255, b = i >> 18;
        const size_t row0 = (size_t)b * SEQ + (size_t)chunk * 64;
        float h = CIN[i];
        for (int s = 0; s < 64; ++s) { const size_t r = row0 + s; h = Aa[r * 1024 + ch] * h + Bb[r * 1024 + ch];
            CC[r * 2048 + 1024 + ch] = f2bf(h * gelu_tanh(bf2f(YG[r * 1024 + ch]))); }
    }
}
__device__ __forceinline__ void ph_rope_q(bf16_t* __restrict__ Q1, const int* __restrict__ pos, int bid, int nblk) {
    for (int idx = bid * 512 + opaque_tid(); idx < NTOK * 8 * 32; idx += nblk * 512) {
        const int i = idx & 31, h = (idx >> 5) & 7, row = idx >> 8;
        float c, s; rope_cs(pos[row], i, c, s);
        bf16_t* p = Q1 + (size_t)row * 1536 + h * 192 + 128;
        const float x1 = bf2f(p[i]), x2 = bf2f(p[32 + i]);
        p[i] = f2bf(x1 * c - x2 * s); p[32 + i] = f2bf(x2 * c + x1 * s);
    }
}
__device__ __forceinline__ void ph_rope_k(const float* __restrict__ KR, const int* __restrict__ pos, bf16_t* __restrict__ K1, int bid, int nblk) {
    for (int idx = bid * 512 + opaque_tid(); idx < NTOK * 32; idx += nblk * 512) {
        const int i = idx & 31, row = idx >> 5;
        float c, s; rope_cs(pos[row], i, c, s);
        const float x1 = KR[(size_t)row * 64 + i], x2 = KR[(size_t)row * 64 + 32 + i];
        const bf16_t o1 = f2bf(x1 * c - x2 * s), o2 = f2bf(x2 * c + x1 * s);
#pragma unroll
        for (int h = 0; h < 8; ++h) { bf16_t* p = K1 + (size_t)row * 1536 + h * 192 + 128; p[i] = o1; p[32 + i] = o2; }
    }
}
template <bool OUT8> __device__ __forceinline__ void ph_ffn_gate(const bf16_t* __restrict__ HID, const float* __restrict__ cw, const float* __restrict__ cb, bf16_t* __restrict__ ACT, int bid, int nblk) {
    for (int i = bid * 512 + opaque_tid(); i < 512 * (SEQ / 64); i += nblk * 512) {
        const int c8 = (i & 511) * 8, t0 = (i >> 9) * 64;
        float wg[3][8], wv[3][8], bg[8], bv[8];
#pragma unroll
        for (int j = 0; j < 8; ++j) { bg[j] = cb[c8 + j]; bv[j] = cb[4096 + c8 + j];
#pragma unroll
            for (int k = 0; k < 3; ++k) { wg[k][j] = cw[k * 8192 + c8 + j]; wv[k][j] = cw[k * 8192 + 4096 + c8 + j]; } }
        u32x4 g2 = {0u, 0u, 0u, 0u}, g1 = g2, v2 = g2, v1 = g2;
        if (t0 >= 2) { g2 = *(const u32x4*)(HID + (size_t)(t0 - 2) * 8192 + c8); g1 = *(const u32x4*)(HID + (size_t)(t0 - 1) * 8192 + c8);
                       v2 = *(const u32x4*)(HID + (size_t)(t0 - 2) * 8192 + 4096 + c8); v1 = *(const u32x4*)(HID + (size_t)(t0 - 1) * 8192 + 4096 + c8); }
        for (int r = 0; r < 64; ++r) {
            const u32x4 g0 = *(const u32x4*)(HID + (size_t)(t0 + r) * 8192 + c8), v0 = *(const u32x4*)(HID + (size_t)(t0 + r) * 8192 + 4096 + c8);
            const unsigned G2[4] = {g2.x, g2.y, g2.z, g2.w}, G1[4] = {g1.x, g1.y, g1.z, g1.w}, G0[4] = {g0.x, g0.y, g0.z, g0.w};
            const unsigned V2[4] = {v2.x, v2.y, v2.z, v2.w}, V1[4] = {v1.x, v1.y, v1.z, v1.w}, V0[4] = {v0.x, v0.y, v0.z, v0.w};
            float o[8];
#pragma unroll
            for (int j = 0; j < 4; ++j) {
                const float ge = bg[2 * j] + wg[0][2 * j] * __uint_as_float(G2[j] << 16) + wg[1][2 * j] * __uint_as_float(G1[j] << 16) + wg[2][2 * j] * __uint_as_float(G0[j] << 16);
                const float go = bg[2 * j + 1] + wg[0][2 * j + 1] * __uint_as_float(G2[j] & 0xFFFF0000u) + wg[1][2 * j + 1] * __uint_as_float(G1[j] & 0xFFFF0000u) + wg[2][2 * j + 1] * __uint_as_float(G0[j] & 0xFFFF0000u);
                const float ve = bv[2 * j] + wv[0][2 * j] * __uint_as_float(V2[j] << 16) + wv[1][2 * j] * __uint_as_float(V1[j] << 16) + wv[2][2 * j] * __uint_as_float(V0[j] << 16);
                const float vo = bv[2 * j + 1] + wv[0][2 * j + 1] * __uint_as_float(V2[j] & 0xFFFF0000u) + wv[1][2 * j + 1] * __uint_as_float(V1[j] & 0xFFFF0000u) + wv[2][2 * j + 1] * __uint_as_float(V0[j] & 0xFFFF0000u);
                o[2 * j] = gelu_tanh(ge) * ve; o[2 * j + 1] = gelu_tanh(go) * vo; }
            if (OUT8) { int p0 = 0, p1 = 0;
                p0 = __builtin_amdgcn_cvt_pk_fp8_f32(o[0], o[1], p0, false); p0 = __builtin_amdgcn_cvt_pk_fp8_f32(o[2], o[3], p0, true);
                p1 = __builtin_amdgcn_cvt_pk_fp8_f32(o[4], o[5], p1, false); p1 = __builtin_amdgcn_cvt_pk_fp8_f32(o[6], o[7], p1, true);
                u32x2 ov; ov.x = (unsigned)p0; ov.y = (unsigned)p1; *(u32x2*)((unsigned char*)ACT + (size_t)(t0 + r) * 4096 + c8) = ov; }
            else { u32x4 ov; ov.x = pack2bf(o[0], o[1]); ov.y = pack2bf(o[2], o[3]); ov.z = pack2bf(o[4], o[5]); ov.w = pack2bf(o[6], o[7]);
                *(u32x4*)(ACT + (size_t)(t0 + r) * 4096 + c8) = ov; }
            g2 = g1; g1 = g0; v2 = v1; v1 = v0;
        }
    }
}

__device__ __forceinline__ void ph_conv_lru(const float* __restrict__ wa, const float* __restrict__ wx, bf16_t* __restrict__ Bt, int bid, int nblk) {
    for (int e = bid * 512 + opaque_tid(); e < 8 * 2 * 128 * 128; e += nblk * 512) {
        const int d = e & 127, c = (e >> 7) & 127, gate = (e >> 14) & 1, nb = e >> 15;
        const float v = (gate ? wx : wa)[((size_t)nb * 128 + c) * 128 + d];
        bf16_t* row = Bt + (size_t)(nb * 256 + gate * 128 + d) * 256;
        row[(nb & 1) * 128 + c] = f2bf(v); row[(1 - (nb & 1)) * 128 + c] = 0;
    }
}

static constexpr size_t MiB = 1048576;
static constexpr size_t W_UP0 = 0 * MiB, W_UP1 = 32 * MiB, W_DN0 = 64 * MiB, W_DN1 = 80 * MiB, W_ABIN = 96 * MiB, W_ABOUT = 117 * MiB, W_CDIN = 125 * MiB, W_CDOUT = 137 * MiB,
                        W_QUP = 145 * MiB, W_KVUP = 146 * MiB + 512 * 1024, W_POOL = 147 * MiB + 512 * 1024;
static constexpr size_t R_H = 148 * MiB;
static constexpr size_t R_Q0 = 276 * MiB, R_K0 = 340 * MiB, R_VT0 = 404 * MiB, R_QI = 468 * MiB, R_M0 = 468 * MiB, R_U = 596 * MiB, R_KI = 724 * MiB, R_WI = 732 * MiB, R_MASK = 734 * MiB, R_CC0 = 830 * MiB, R_POOLED = 958 * MiB;
static constexpr size_t R_HID = 276 * MiB, R_ACT = 532 * MiB, R_F = 660 * MiB;
static constexpr size_t R_VT1 = 276 * MiB, R_CQ = 276 * MiB, R_CKV = 340 * MiB, R_KR = 372 * MiB, R_XL = 380 * MiB, R_YG = 444 * MiB, R_CQN = 508 * MiB, R_CKVN = 540 * MiB, R_LA = 556 * MiB, R_LB = 684 * MiB,
                        R_Q1 = 812 * MiB, R_K1 = 908 * MiB, R_CA = 1004 * MiB, R_CH = 1006 * MiB, R_CIN = 1008 * MiB, R_CC1 = 148 * MiB, R_M1 = 276 * MiB, R_XCB = 148 * MiB, W_LRU = 1010 * MiB;
static constexpr size_t WS_BAR = 1022 * MiB, WS_NEED = 1022 * MiB + 65536;
static constexpr int MK_LDS = 162816;

struct MK { const float* in[28]; float* out; unsigned char* ws; int ph_lo, ph_hi; };

__global__ __launch_bounds__(512, 2) void k_mega(MK p) {
    extern __shared__ __attribute__((aligned(16))) unsigned char shm[];
    LAS unsigned char* lds = (LAS unsigned char*)shm;
    const int bid0 = (int)blockIdx.x, nblk0 = (int)gridDim.x;
    volatile LAS unsigned* xbw = (volatile LAS unsigned*)(lds + MK_LDS - 16);
    if (threadIdx.x == 0) { xbw[0] = 0u; xbw[1] = 0u; xbw[2] = 0u; xbw[3] = 0u; }
    if ((threadIdx.x & 63) == 0) *(volatile LAS int*)(size_t)(TID_TAB_LDS + 4 * ((unsigned)__builtin_amdgcn_s_getreg(((6 - 1) << 11) | 4) & 63u)) = (int)(threadIdx.x >> 6);
    __syncthreads();
    XcdBarrier bar = xcd_barrier_post((unsigned*)(p.ws + WS_BAR), xbw);
#ifndef KARG_PLAIN
#define KARG_PLAIN 0
#endif
#if KARG_PLAIN
#define KARG_DECL const MK& P_ = p;
#else
#define KARG_DECL KPtr P__ = kp; asm volatile("" : "+s"(P__)); const __attribute__((address_space(4))) MK& P_ = *P__;
#endif
    typedef const __attribute__((address_space(4))) MK* KPtr;
    KPtr kp = (KPtr)__builtin_amdgcn_kernarg_segment_ptr();
#define WSP(T, off) ((T*)(ws + (off)))
#define PHASE_BEGIN if (pc >= p.ph_lo && pc < p.ph_hi) { const int bid = opaque_s(bid0), nblk = opaque_s(nblk0); \
    KARG_DECL unsigned char* const ws = P_.ws; float* const xo = P_.out; const float* const x = P_.in[0]; const int* const positions = (const int*)P_.in[1]; \
    const float *const mix_pre_g = P_.in[2], *const mix_post_g = P_.in[3], *const ffn_pre_g = P_.in[4], *const ffn_post_g = P_.in[5], *const ffn_up = P_.in[6], *const ffn_conv_w = P_.in[7], *const ffn_conv_b = P_.in[8], *const ffn_down = P_.in[9], \
    *const ab_w_in = P_.in[10], *const pool_w = P_.in[11], *const pool_b = P_.in[12], *const pool_scale = P_.in[13], *const ab_w_out = P_.in[14], *const cd_w_in = P_.in[15], *const q_norm_g = P_.in[16], *const w_q_up = P_.in[17], \
    *const kv_norm_g = P_.in[18], *const w_kv_up = P_.in[19], *const lru_conv_w = P_.in[20], *const lru_conv_b = P_.in[21], *const lru_wa = P_.in[22], *const lru_ba = P_.in[23], *const lru_wx = P_.in[24], *const lru_bx = P_.in[25], \
    *const lru_lambda = P_.in[26], *const cd_w_out = P_.in[27]; bf16_t* const H = WSP(bf16_t, R_H); const bf16_t* const CC = WSP(bf16_t, LAYER_CC); bf16_t* const Mx = WSP(bf16_t, LAYER_MX); \
    (void)xo; (void)x; (void)positions; (void)mix_pre_g; (void)mix_post_g; (void)ffn_pre_g; (void)ffn_post_g; (void)ffn_up; (void)ffn_conv_w; (void)ffn_conv_b; (void)ffn_down; (void)ab_w_in; (void)pool_w; (void)pool_b; (void)pool_scale; \
    (void)ab_w_out; (void)cd_w_in; (void)q_norm_g; (void)w_q_up; (void)kv_norm_g; (void)w_kv_up; (void)lru_conv_w; (void)lru_conv_b; (void)lru_wa; (void)lru_ba; (void)lru_wx; (void)lru_bx; (void)lru_lambda; (void)cd_w_out; (void)H; (void)CC; (void)Mx;
#define PHASE_END } if (pc >= p.ph_lo && pc + 1 < p.ph_hi) xcd_barrier(bar); ++pc;
    int pc = 0;
#define LAYER_CC R_CC0
#define LAYER_MX R_M0
    PHASE_BEGIN
#if !((SKIPMASK >> 0) & 1)
#if FP8_UP0
        ph_convT8(lds, ffn_up, 8192, 8192, 2048, WSP(unsigned char, W_UP0), bid, nblk);
#else
        ph_convT(lds, ffn_up, 8192, 0, 8192, 2048, WSP(bf16_t, W_UP0), 2048, bid, nblk);
#endif
#if FP8_UP1
        ph_convT8(lds, ffn_up + (size_t)2048 * 8192, 8192, 8192, 2048, WSP(unsigned char, W_UP1), bid, nblk);
#else
        ph_convT(lds, ffn_up + (size_t)2048 * 8192, 8192, 0, 8192, 2048, WSP(bf16_t, W_UP1), 2048, bid, nblk);
#endif
#if FP8_DN0
        ph_convT8(lds, ffn_down, 2048, 2048, 4096, WSP(unsigned char, W_DN0), bid, nblk);
#else
        ph_convT(lds, ffn_down, 2048, 0, 2048, 4096, WSP(bf16_t, W_DN0), 4096, bid, nblk);
#endif
#if FP8_DN1
        ph_convT8(lds, ffn_down + (size_t)4096 * 2048, 2048, 2048, 4096, WSP(unsigned char, W_DN1), bid, nblk);
#else
        ph_convT(lds, ffn_down + (size_t)4096 * 2048, 2048, 0, 2048, 4096, WSP(bf16_t, W_DN1), 4096, bid, nblk);
#endif
        ph_convT(lds, ab_w_in, 5200, 0, 4096, 2048, WSP(bf16_t, W_ABIN), 2048, bid, nblk);
        ph_convT(lds, ab_w_in, 5200, 4176, 1024, 2048, WSP(bf16_t, W_ABIN) + (size_t)4096 * 2048, 2048, bid, nblk);
        ph_convT(lds, ab_w_in, 5200, 4096, 64, 2048, WSP(bf16_t, W_ABIN) + (size_t)5120 * 2048, 2048, bid, nblk);
        ph_convT(lds, ab_w_in, 5200, 4160, 16, 2048, WSP(bf16_t, W_ABIN) + (size_t)5184 * 2048, 2048, bid, nblk);
        ph_convT(lds, ab_w_out, 2048, 0, 2048, 2048, WSP(bf16_t, W_ABOUT), 2048, bid, nblk);
        ph_convT(lds, cd_w_in, 2880, 0, 832, 2048, WSP(bf16_t, W_CDIN), 2048, bid, nblk);
        ph_convT(lds, cd_w_in, 2880, 832, 2048, 2048, WSP(bf16_t, W_CDIN) + (size_t)1024 * 2048, 2048, bid, nblk);
        ph_convT(lds, cd_w_out, 2048, 0, 2048, 2048, WSP(bf16_t, W_CDOUT), 2048, bid, nblk);
        ph_convT(lds, w_q_up, 1536, 0, 1536, 512, WSP(bf16_t, W_QUP), 512, bid, nblk);
        ph_convT(lds, w_kv_up, 2048, 0, 2048, 256, WSP(bf16_t, W_KVUP), 256, bid, nblk);
        for (int g = 0; g < 4; ++g) ph_convT(lds, pool_w + (size_t)g * 65536, 256, 0, 256, 256, WSP(bf16_t, W_POOL) + (size_t)g * 65536, 256, bid, nblk);
        ph_rmsnorm<2048>(x, mix_pre_g, H, bid, nblk);
#endif
    PHASE_END
    {
            PHASE_BEGIN
#if !((SKIPMASK >> 1) & 1)
                FAbIn2 f; f.Q = WSP(bf16_t, R_Q0); f.K = WSP(bf16_t, R_K0); f.VT = WSP(bf16_t, R_VT0); f.QI = WSP(float, R_QI); f.U = WSP(float, R_U); f.WI = WSP(float, R_WI); f.KI16 = WSP(unsigned short, R_KI);
                ph_gemm(lds, H, 2048, WSP(bf16_t, W_ABIN), 2048, NTOK, 5376, 2048, f, bid, nblk);
#endif
            PHASE_END
            PHASE_BEGIN
#if !((SKIPMASK >> 2) & 1)
                ph_pooled(WSP(float, R_U), WSP(bf16_t, R_POOLED), bid, nblk);
                IdxArgs a; a.QI = WSP(float, R_QI); a.KI16 = WSP(unsigned short, R_KI); a.WI = WSP(float, R_WI); a.MT = WSP(unsigned long long, R_MASK);
                idx_phase(lds, a, bid, nblk);
#endif
            PHASE_END
            PHASE_BEGIN
#if !((SKIPMASK >> 3) & 1)
                { FPool f; f.CC = WSP(bf16_t, R_CC0); f.pb = pool_b; f.ps = pool_scale; ph_gemm(lds, WSP(bf16_t, R_POOLED), 1024, WSP(bf16_t, W_POOL), 256, NTOK, 1024, 256, f, bid, nblk, 0, 512); }
                AttnArgs a; a.Q = WSP(bf16_t, R_Q0); a.K = WSP(bf16_t, R_K0); a.VT = WSP(bf16_t, R_VT0); a.MT = WSP(unsigned long long, R_MASK); a.O = WSP(bf16_t, R_CC0); a.ldq = 1024; a.ldk = 1024; a.ldo = 2048;
                a.sc_log2e = 0.08838834764831845f * 1.4426950408889634f;
                attn_phase<128, true>(lds, a, bid, nblk);
#endif
            PHASE_END
        PHASE_BEGIN
#if !((SKIPMASK >> 4) & 1)
            FStoreBf16 f; f.O = Mx; f.ldc = 2048; f.pad_ = 0;
            ph_gemm(lds, CC, 2048, WSP(bf16_t, W_ABOUT), 2048, NTOK, 2048, 2048, f, bid, nblk);
#endif
        PHASE_END
        PHASE_BEGIN
#if !((SKIPMASK >> 5) & 1)
            ph_resnorm(x, Mx, mix_post_g + 0, ffn_pre_g + 0, xo, H, FP8_UP0 ? WSP(unsigned char, R_H) : (unsigned char*)nullptr, bid, nblk);
#endif
        PHASE_END
        for (int half = 0; half < 2; ++half) {
            PHASE_BEGIN
#if !((SKIPMASK >> 6) & 1)
                FStoreBf16 f; f.O = WSP(bf16_t, R_HID); f.ldc = 8192; f.pad_ = 0;

#if FP8_UP0
                ph_gemm8(lds, WSP(unsigned char, R_H) + (size_t)half * SEQ * 2048, 2048, WSP(unsigned char, W_UP0), 2048, SEQ, 8192, 2048, f, bid, nblk);
#else
                ph_gemm(lds, H + (size_t)half * SEQ * 2048, 2048, WSP(bf16_t, W_UP0), 2048, SEQ, 8192, 2048, f, bid, nblk);
#endif

#endif
            PHASE_END
            PHASE_BEGIN
#if !((SKIPMASK >> 7) & 1)
                ph_ffn_gate<FP8_DN0 != 0>(WSP(bf16_t, R_HID), ffn_conv_w + 0, ffn_conv_b + 0, WSP(bf16_t, R_ACT), bid, nblk);
#endif
            PHASE_END
            PHASE_BEGIN
#if !((SKIPMASK >> 8) & 1)
                FStoreBf16 f; f.O = WSP(bf16_t, R_F) + (size_t)half * SEQ * 2048; f.ldc = 2048; f.pad_ = 0;

#if FP8_DN0
                ph_gemm8(lds, WSP(unsigned char, R_ACT), 4096, WSP(unsigned char, W_DN0), 4096, SEQ, 2048, 4096, f, bid, nblk);
#else
                ph_gemm(lds, WSP(bf16_t, R_ACT), 4096, WSP(bf16_t, W_DN0), 4096, SEQ, 2048, 4096, f, bid, nblk);
#endif

#endif
            PHASE_END
        }
        PHASE_BEGIN
#if !((SKIPMASK >> 9) & 1)
            ph_resnorm(xo, WSP(bf16_t, R_F), ffn_post_g + 0, mix_pre_g + 2048, xo, H, nullptr, bid, nblk);
#endif
        PHASE_END
    }
    {
#undef LAYER_CC
#undef LAYER_MX
#define LAYER_CC R_CC1
#define LAYER_MX R_M1
            PHASE_BEGIN
#if !((SKIPMASK >> 10) & 1)
                FCdIn f; f.CQ = WSP(float, R_CQ); f.CKV = WSP(float, R_CKV); f.KR = WSP(float, R_KR); f.XL = WSP(bf16_t, R_XL); f.YG = WSP(bf16_t, R_YG);
                ph_gemm(lds, H, 2048, WSP(bf16_t, W_CDIN), 2048, NTOK, 3072, 2048, f, bid, nblk);
#endif
            PHASE_END
            PHASE_BEGIN
#if !((SKIPMASK >> 11) & 1)
                ph_xc(WSP(bf16_t, R_XL), lru_conv_w, lru_conv_b, WSP(bf16_t, R_XCB), bid, nblk);
                ph_conv_lru(lru_wa, lru_wx, WSP(bf16_t, W_LRU), bid, nblk);
                ph_rmsnorm<512>(WSP(float, R_CQ), q_norm_g, WSP(bf16_t, R_CQN), bid, nblk);
                ph_rmsnorm<256>(WSP(float, R_CKV), kv_norm_g, WSP(bf16_t, R_CKVN), bid, nblk);
            PHASE_END
            PHASE_BEGIN
                { EpiLru ep; ep.XCB = WSP(bf16_t, R_XCB); ep.ba = lru_ba; ep.bx = lru_bx; ep.lam = lru_lambda; ep.LA = WSP(float, R_LA); ep.LB = WSP(float, R_LB);
                  ph_gemm_e(lds, WSP(bf16_t, R_XCB), 1024, WSP(bf16_t, W_LRU), 256, NTOK, 2048, 256, ep, bid, nblk, 1, 512); }
                { FStoreBf16 f; f.O = WSP(bf16_t, R_Q1); f.ldc = 1536; f.pad_ = 0; ph_gemm(lds, WSP(bf16_t, R_CQN), 512, WSP(bf16_t, W_QUP), 512, NTOK, 1536, 512, f, bid, nblk); }
                { FKvUp2 f; f.K1 = WSP(bf16_t, R_K1); f.VT = WSP(bf16_t, R_VT1); ph_gemm(lds, WSP(bf16_t, R_CKVN), 256, WSP(bf16_t, W_KVUP), 256, NTOK, 2048, 256, f, bid, nblk); }
            PHASE_END
            PHASE_BEGIN
                ph_scan1(WSP(float, R_LA), WSP(float, R_LB), WSP(float, R_CA), WSP(float, R_CH), bid, nblk);
                ph_rope_q(WSP(bf16_t, R_Q1), positions, bid, nblk);
                ph_rope_k(WSP(float, R_KR), positions, WSP(bf16_t, R_K1), bid, nblk);
            PHASE_END
            PHASE_BEGIN
                ph_scan2(WSP(float, R_CA), WSP(float, R_CH), WSP(float, R_CIN), bid, nblk);
            PHASE_END
            PHASE_BEGIN
                ph_scan3(WSP(float, R_LA), WSP(float, R_LB), WSP(float, R_CIN), WSP(bf16_t, R_YG), WSP(bf16_t, R_CC1), bid, nblk);
                AttnArgs a; a.Q = WSP(bf16_t, R_Q1); a.K = WSP(bf16_t, R_K1); a.VT = WSP(bf16_t, R_VT1); a.MT = nullptr; a.O = WSP(bf16_t, R_CC1); a.ldq = 1536; a.ldk = 1536; a.ldo = 2048;
                a.sc_log2e = 0.07216878364870322f * 1.4426950408889634f;
                attn_phase<192, false>(lds, a, bid, nblk);
#endif
            PHASE_END
        PHASE_BEGIN
#if !((SKIPMASK >> 15) & 1)
            FStoreBf16 f; f.O = Mx; f.ldc = 2048; f.pad_ = 0;
            ph_gemm(lds, CC, 2048, WSP(bf16_t, W_CDOUT), 2048, NTOK, 2048, 2048, f, bid, nblk);
#endif
        PHASE_END
        PHASE_BEGIN
#if !((SKIPMASK >> 16) & 1)
            ph_resnorm((const float*)xo, Mx, mix_post_g + 2048, ffn_pre_g + 2048, xo, H, FP8_UP1 ? WSP(unsigned char, R_H) : (unsigned char*)nullptr, bid, nblk);
#endif
        PHASE_END
        for (int half = 0; half < 2; ++half) {
            PHASE_BEGIN
#if !((SKIPMASK >> 17) & 1)
                FStoreBf16 f; f.O = WSP(bf16_t, R_HID); f.ldc = 8192; f.pad_ = 0;

#if FP8_UP1
                ph_gemm8(lds, WSP(unsigned char, R_H) + (size_t)half * SEQ * 2048, 2048, WSP(unsigned char, W_UP1), 2048, SEQ, 8192, 2048, f, bid, nblk);
#else
                ph_gemm(lds, H + (size_t)half * SEQ * 2048, 2048, WSP(bf16_t, W_UP1), 2048, SEQ, 8192, 2048, f, bid, nblk);
#endif

#endif
            PHASE_END
            PHASE_BEGIN
#if !((SKIPMASK >> 18) & 1)
                ph_ffn_gate<FP8_DN1 != 0>(WSP(bf16_t, R_HID), ffn_conv_w + 24576, ffn_conv_b + 8192, WSP(bf16_t, R_ACT), bid, nblk);
#endif
            PHASE_END
            PHASE_BEGIN
#if !((SKIPMASK >> 19) & 1)
                FStoreBf16 f; f.O = WSP(bf16_t, R_F) + (size_t)half * SEQ * 2048; f.ldc = 2048; f.pad_ = 0;

#if FP8_DN1
                ph_gemm8(lds, WSP(unsigned char, R_ACT), 4096, WSP(unsigned char, W_DN1), 4096, SEQ, 2048, 4096, f, bid, nblk);
#else
                ph_gemm(lds, WSP(bf16_t, R_ACT), 4096, WSP(bf16_t, W_DN1), 4096, SEQ, 2048, 4096, f, bid, nblk);
#endif

#endif
            PHASE_END
        }
        PHASE_BEGIN
#if !((SKIPMASK >> 20) & 1)
            ph_resnorm(xo, WSP(bf16_t, R_F), ffn_post_g + 2048, (const float*)nullptr, xo, H, nullptr, bid, nblk);
#endif
        PHASE_END
    }
#undef LAYER_CC
#undef LAYER_MX
#undef WSP
#undef PHASE_BEGIN
#undef PHASE_END
}

#ifndef MK_N_LAUNCHES
#define MK_N_LAUNCHES 1
#endif
static constexpr int MK_NPHASES = 1 + 3 + 7 + 2 * 9;

extern "C" void kernel_launch(void* const* d_in, const int* in_sizes, int n_in, void* d_out, int out_size, void* d_ws, size_t ws_size, hipStream_t stream) {
    static int grid = 0;
    if (grid == 0) {
        if (n_in != 28 || out_size != NTOK * DM || ws_size < WS_NEED) { fprintf(stderr, "kernel_launch: unexpected shapes (n_in %d out %d ws %zu)\n", n_in, out_size, ws_size); grid = -1; return; }
        int dev = 0, cus = 0, per_cu = 0;
        if (hipGetDevice(&dev) != hipSuccess || hipDeviceGetAttribute(&cus, hipDeviceAttributeMultiprocessorCount, dev) != hipSuccess) { grid = -1; return; }
        if (hipFuncSetAttribute((const void*)k_mega, hipFuncAttributeMaxDynamicSharedMemorySize, MK_LDS) != hipSuccess) { fprintf(stderr, "kernel_launch: hipFuncSetAttribute failed\n"); grid = -1; return; }
        if (hipOccupancyMaxActiveBlocksPerMultiprocessor(&per_cu, (const void*)k_mega, 512, MK_LDS) != hipSuccess || per_cu < 1) { fprintf(stderr, "kernel_launch: occupancy query says %d\n", per_cu); }
        (void)hipGetLastError();
        grid = cus;
        if (grid != 256) { fprintf(stderr, "kernel_launch: built for 256 CUs, found %d\n", grid); grid = -1; return; }
    }
    if (grid < 0) return;
    unsigned char* ws = (unsigned char*)d_ws;
    (void)hipMemsetAsync(ws + WS_BAR, 0, XCD_BAR_WORDS * sizeof(unsigned), stream);
    (void)hipMemsetAsync(ws + W_ABIN + (size_t)5200 * 2048 * 2, 0, (size_t)176 * 2048 * 2, stream);
    (void)hipMemsetAsync(ws + W_CDIN + (size_t)832 * 2048 * 2, 0, (size_t)192 * 2048 * 2, stream);
    MK p{};
    for (int i = 0; i < 28; ++i) p.in[i] = (const float*)d_in[i];
    p.out = (float*)d_out; p.ws = ws;
#if MK_N_LAUNCHES == 1
    p.ph_lo = 0; p.ph_hi = 1 << 20;
    hipLaunchKernelGGL(k_mega, dim3(grid), dim3(512), MK_LDS, stream, p);
#else
    for (int ph = 0; ph < MK_NPHASES; ++ph) { p.ph_lo = ph; p.ph_hi = ph + 1; hipLaunchKernelGGL(k_mega, dim3(grid), dim3(512), MK_LDS, stream, p); }
#endif
}
```

```cpp
#include <hip/hip_runtime.h>
#include <stdint.h>
#include <stdio.h>

#define LAS __attribute__((address_space(3)))
typedef unsigned short bf16_t;
typedef float f32x4 __attribute__((ext_vector_type(4)));
typedef unsigned u32x4 __attribute__((ext_vector_type(4)));
typedef unsigned u32x2 __attribute__((ext_vector_type(2)));

static constexpr int NTOK = 32768, SEQ = 16384, NBATCH = 2, DM = 2048, DFF = 4096;
static constexpr float NORM_EPS = 1e-6f;

__device__ __forceinline__ bf16_t f2bf(float f) { unsigned u = __float_as_uint(f); u += 0x7FFFu + ((u >> 16) & 1u); return (bf16_t)(u >> 16); }
__device__ __forceinline__ float bf2f(bf16_t b) { return __uint_as_float(((unsigned)b) << 16); }
__device__ __forceinline__ unsigned pack2bf(float lo, float hi) { return (unsigned)f2bf(lo) | ((unsigned)f2bf(hi) << 16); }
__device__ __forceinline__ float gelu_tanh(float x) { const float u = 0.7978845608028654f * (x + 0.044715f * x * x * x); return 0.5f * x * (1.0f + tanhf(u)); }
__device__ __forceinline__ float wave_sum(float v) {
#pragma unroll
    for (int o = 32; o >= 1; o >>= 1) v += __shfl_xor(v, o);
    return v;
}

#ifndef TID_PLAIN
#define TID_PLAIN 0
#endif
static constexpr int TID_TAB_LDS = 162816 - 16 - 256;
#if TID_PLAIN
__device__ __forceinline__ int opaque_tid() { int t = (int)threadIdx.x; asm volatile("" : "+v"(t)); return t; }
#else
__device__ __forceinline__ int opaque_tid() {
    const unsigned slot = (unsigned)__builtin_amdgcn_s_getreg(((6 - 1) << 11) | 4) & 63u;
    const int w = __builtin_amdgcn_readfirstlane(*(const volatile LAS int*)(size_t)(TID_TAB_LDS + 4 * slot));
    int lane; asm volatile("v_mbcnt_lo_u32_b32 %0, -1, 0\n\tv_mbcnt_hi_u32_b32 %0, -1, %0" : "=v"(lane));
    return w * 64 + lane;
}
#endif

__device__ __forceinline__ int opaque_s(int v) { asm volatile("" : "+s"(v)); return v; }

template <class T> __device__ __forceinline__ const T* opaque_p(const T* p) { asm volatile("" : "+s"(p)); return p; }

#ifndef PG8_EPI_RECOMP
#define PG8_EPI_RECOMP 1
#endif
#ifndef PG8_ASM_DMA
#define PG8_ASM_DMA 1
#endif
#include <hip/hip_runtime.h>
namespace pg8 {
#define PG8_LAS __attribute__((address_space(3)))
typedef unsigned short bf16_t;
typedef short bf16x8 __attribute__((ext_vector_type(8)));
typedef float f32x4 __attribute__((ext_vector_type(4)));
typedef unsigned u32x4 __attribute__((ext_vector_type(4)));
typedef int i32x8 __attribute__((ext_vector_type(8)));
typedef int i32x4 __attribute__((ext_vector_type(4)));
constexpr int BM = 256, BK = 64, HALF = 128, HTB = HALF * BK * 2  , STAGE_BYTES = 8 * HTB, NXCD = 8, WGM = 8;

__host__ __device__ __forceinline__ int lds_byte(int r, int c) { const int st = (r >> 4) * 2 + (c >> 5), rr = r & 15, cc = c & 31, ob = rr * 64 + cc * 2; return st * 1024 + (ob ^ (((ob >> 9) & 1) << 5)); }
__host__ __device__ __forceinline__ void stage_rc(int b, int& R, int& C) { const int st = b / 1024, sb = b % 1024, swz = sb ^ (((sb >> 9) & 1) << 5); R = (st >> 1) * 16 + swz / 64; C = (st & 1) * 32 + (swz % 64) / 2; }
__host__ __device__ __forceinline__ int perm32(int rho) { const int n = rho >> 4, i = rho & 15; return 8 * (i >> 2) + 4 * n + (i & 3); }

struct Unit { int pm, pn; };
struct Gemm { const bf16_t* A; const bf16_t* Bt; int M, N, K, lda, ldb, a_shift, a_bytes, cmode; };

struct StaticOrder {
    int nM, nN, nwg, G, c;
    __host__ __device__ void init(int M, int N, int G_, int c_) { nM = M / BM; nN = N / BM; nwg = nM * nN; G = G_; c = c_; }
    __host__ __device__ bool next(int i, Unit& u) const {
        const long L = (long)i * G + c; if (L >= nwg) return false;
        int wgid = (int)L; { const int q = nwg / NXCD, r = nwg % NXCD, xcd = wgid % NXCD, off = wgid / NXCD; wgid = (xcd < r ? xcd * (q + 1) : r * (q + 1) + (xcd - r) * q) + off; }
        const int nig = WGM * nN, gid = wgid / nig, fm = gid * WGM, gsz = (nM - fm) < WGM ? (nM - fm) : WGM;
        u.pm = fm + ((wgid % nig) % gsz); u.pn = (wgid % nig) / gsz; return true;
    }
    __device__ __forceinline__ void a_ready(const Unit&) const {}
    __device__ __forceinline__ void done(const Unit&) const {}
};

template <class Epi, class Sched, bool STAMP = false>
__device__ __forceinline__ void gemm_phase(PG8_LAS unsigned char* lds, const Gemm g, const Sched& S, const Epi& E, unsigned long long* stamps) {
    const int tid = opaque_tid(), wid = __builtin_amdgcn_readfirstlane(tid >> 6), lane = tid & 63, wr = wid >> 2, wc = wid & 3, fr = lane & 15, fq = lane >> 4;
    const int K = g.K, nt = K / BK;
    int ts_lo = 0, ts_hi = 0, nts = 0; const unsigned long long rt_entry = STAMP ? (unsigned long long)wall_clock64() : 0ull;
#define PG8_STAMP() do { if (STAMP && wid == 0 && nts < 64) { const unsigned long long _c = (unsigned long long)clock64(); \
        ts_lo = (lane == nts) ? (int)(unsigned)_c : ts_lo; ts_hi = (lane == nts) ? (int)(unsigned)(_c >> 32) : ts_hi; ++nts; } } while (0)
    PG8_STAMP();
    unsigned voffA[2], voffB[2];
#pragma unroll
    for (int i = 0; i < 2; ++i) { int R, C; stage_rc(tid * 16 + i * 8192, R, C); const int Rb = Epi::PERM ? ((R & ~31) + perm32(R & 31)) : R;
        const int Ra = g.cmode ? (R - 2 * (R >> 6)) : R;
        voffA[i] = (unsigned)(Ra * g.lda + C) * 2u; voffB[i] = (unsigned)(Rb * g.ldb + C) * 2u; }
    const size_t kstep = (size_t)(BK * 2);
    const size_t hstepA = (size_t)(g.cmode ? HALF - 4 : HALF) * g.lda * 2, hstepB = (size_t)HALF * g.ldb * 2;
    const size_t tstepA = 2 * hstepA, tstepB = 2 * hstepB;
    const unsigned ldsbase_ = (unsigned)(size_t)lds;
    const int sc_w_ = 0x79797979, sc_a_ = 0x7F7F7F7F;
    (void)sc_w_; (void)sc_a_;
    const unsigned ldsw = (unsigned)wid * 1024u;
    const int aoff = lds_byte(wr * 64 + fr, fq * 8), boff = lds_byte(wc * 32 + fr, fq * 8);
#define PG8_SA(b, h) (((b) * 2 + (h)) * HTB)
#define PG8_SB(b, h) ((4 + (b) * 2 + (h)) * HTB)
#if PG8_ASM_DMA
#define PG8_STAGE(bufoff, gbase, voff) do { _Pragma("unroll") for (int _i = 0; _i < 2; ++_i) { unsigned keep_; \
        asm volatile("s_mov_b32 %0, m0\n\ts_mov_b32 m0, %3\n\ts_nop 0\n\tglobal_load_lds_dwordx4 %1, %2\n\ts_mov_b32 m0, %0" \
                     : "=&s"(keep_) : "v"((voff)[_i]), "s"((const char*)(gbase)), "s"(ldsbase_ + (unsigned)(bufoff) + ldsw + (unsigned)(_i * 8192)) : "memory"); } } while (0)
#else
#define PG8_STAGE(bufoff, gbase, voff) do { _Pragma("unroll") for (int _i = 0; _i < 2; ++_i) \
        __builtin_amdgcn_global_load_lds((const unsigned*)((const char*)(gbase) + (voff)[_i]), (PG8_LAS unsigned*)(lds + (bufoff) + ldsw + _i * 8192), 16, 0, 0); } while (0)
#endif
#define PG8_LDA(dst, b, h) do { _Pragma("unroll") for (int m = 0; m < 4; ++m) { dst[m].lo = *(const PG8_LAS i32x4*)(lds + PG8_SA(b, h) + aoff + m * 2048); dst[m].hi = *(const PG8_LAS i32x4*)(lds + PG8_SA(b, h) + aoff + m * 2048 + 1024); } } while (0)
#define PG8_LDB(dst, b, h) do { _Pragma("unroll") for (int n = 0; n < 2; ++n) { dst[n].lo = *(const PG8_LAS i32x4*)(lds + PG8_SB(b, h) + boff + n * 2048); dst[n].hi = *(const PG8_LAS i32x4*)(lds + PG8_SB(b, h) + boff + n * 2048 + 1024); } } while (0)
#define PG8_MMA(ai, bj, At, Bt) do { __builtin_amdgcn_s_setprio(1); \
        if constexpr (Epi::FP8) { _Pragma("unroll") for (int m = 0; m < 4; ++m) _Pragma("unroll") for (int n = 0; n < 2; ++n) \
            asm volatile("v_mfma_scale_f32_16x16x128_f8f6f4 %0, %1, %2, %0, %3, %4 op_sel_hi:[0,0,0]" : "+v"(acc[ai][bj][m][n]) : "v"(Bt[n]), "v"(At[m]), "v"(sc_w_), "v"(sc_a_)); } \
        else { _Pragma("unroll") for (int m = 0; m < 4; ++m) _Pragma("unroll") for (int n = 0; n < 2; ++n) { \
            const i32x4 bl_ = Bt[n].lo, bh_ = Bt[n].hi, al_ = At[m].lo, ah_ = At[m].hi;     \
            acc[ai][bj][m][n] = __builtin_amdgcn_mfma_f32_16x16x32_bf16(__builtin_bit_cast(bf16x8, bl_), __builtin_bit_cast(bf16x8, al_), acc[ai][bj][m][n], 0, 0, 0); \
            acc[ai][bj][m][n] = __builtin_amdgcn_mfma_f32_16x16x32_bf16(__builtin_bit_cast(bf16x8, bh_), __builtin_bit_cast(bf16x8, ah_), acc[ai][bj][m][n], 0, 0, 0); } } \
        __builtin_amdgcn_s_setprio(0); } while (0)
#define PG8_WAIT_V(n) asm volatile("s_waitcnt vmcnt(" #n ")" ::: "memory")
#define PG8_WAIT_L(n) asm volatile("s_waitcnt lgkmcnt(" #n ")" ::: "memory")
#define PG8_BAR __builtin_amdgcn_s_barrier()
#define PG8_SCHED __builtin_amdgcn_sched_barrier(0)
    Unit cur, nxt; int ui = 0;
    if (!S.next(0, cur)) return;
    f32x4 acc[2][2][4][2];
#pragma unroll
    for (int a = 0; a < 2; ++a)
#pragma unroll
        for (int b = 0; b < 2; ++b)
#pragma unroll
            for (int m = 0; m < 4; ++m)
#pragma unroll
                for (int n = 0; n < 2; ++n) acc[a][b][m][n] = (f32x4){0.f, 0.f, 0.f, 0.f};
    i32x8 At[4], B0[2], B1[2];
    auto a_base_ = [&](const Unit& u_) -> const char* { return g.cmode ? (const char*)g.A + ((long)(u_.pm / 67) * 16384 + (long)(u_.pm % 67) * 248 - 2) * (long)g.lda * 2 : (const char*)g.A + (size_t)u_.pm * tstepA + (size_t)(u_.pn >> g.a_shift) * g.a_bytes; };
    const char* cA = a_base_(cur); const char* cB = (const char*)g.Bt + (size_t)cur.pn * tstepB;
    S.a_ready(cur);
    PG8_STAGE(PG8_SB(0, 0), cB, voffB); PG8_STAGE(PG8_SA(0, 0), cA, voffA); PG8_STAGE(PG8_SB(0, 1), cB + hstepB, voffB); PG8_STAGE(PG8_SA(0, 1), cA + hstepA, voffA);
    if (wr == 1) PG8_BAR;
    PG8_WAIT_V(4); PG8_BAR;
    PG8_STAGE(PG8_SB(1, 0), cB + kstep, voffB); PG8_STAGE(PG8_SA(1, 0), cA + kstep, voffA); PG8_STAGE(PG8_SB(1, 1), cB + hstepB + kstep, voffB);
    PG8_WAIT_V(6); PG8_BAR;
    PG8_STAMP();
    for (;;) {
        const bool has_next = S.next(ui + 1, nxt);
        const char* nA = has_next ? a_base_(nxt) : cA; const char* nB = has_next ? (const char*)g.Bt + (size_t)nxt.pn * tstepB : cB;
        for (int t = 0; t < nt; t += 2) {
            const bool last = (t == nt - 2);
            const char* a1 = cA + (size_t)(t + 1) * kstep;
            const char* a2 = last ? nA : cA + (size_t)(t + 2) * kstep; const char* b2 = last ? nB : cB + (size_t)(t + 2) * kstep;
            const char* a3 = a2 + kstep; const char* b3 = b2 + kstep;
            if (last && has_next) S.a_ready(nxt);
            PG8_LDB(B0, 0, 0); PG8_SCHED; PG8_LDA(At, 0, 0); PG8_STAGE(PG8_SA(1, 1), a1 + hstepA, voffA);
            PG8_WAIT_L(8); PG8_BAR; PG8_WAIT_L(0); PG8_MMA(0, 0, At, B0); PG8_BAR; PG8_SCHED;
            PG8_LDB(B1, 0, 1); PG8_STAGE(PG8_SB(0, 0), b2, voffB);
            PG8_BAR; PG8_WAIT_L(0); PG8_MMA(0, 1, At, B1); PG8_BAR;
            PG8_LDA(At, 0, 1); PG8_STAGE(PG8_SA(0, 0), a2, voffA);
            PG8_BAR; PG8_WAIT_L(0); PG8_MMA(1, 0, At, B0); PG8_BAR; PG8_SCHED;
            PG8_STAGE(PG8_SB(0, 1), b2 + hstepB, voffB);
            PG8_WAIT_V(6); PG8_BAR; PG8_MMA(1, 1, At, B1); PG8_BAR;
            PG8_LDB(B0, 1, 0); PG8_SCHED; PG8_LDA(At, 1, 0); PG8_STAGE(PG8_SA(0, 1), a2 + hstepA, voffA);
            PG8_WAIT_L(8); PG8_BAR; PG8_WAIT_L(0); PG8_MMA(0, 0, At, B0); PG8_BAR; PG8_SCHED;
            PG8_LDB(B1, 1, 1); PG8_STAGE(PG8_SB(1, 0), b3, voffB);
            PG8_BAR; PG8_WAIT_L(0); PG8_MMA(0, 1, At, B1); PG8_BAR;
            PG8_LDA(At, 1, 1); PG8_STAGE(PG8_SA(1, 0), a3, voffA);
            PG8_BAR; PG8_WAIT_L(0); PG8_MMA(1, 0, At, B0); PG8_BAR; PG8_SCHED;
            PG8_STAGE(PG8_SB(1, 1), b3 + hstepB, voffB);
            PG8_WAIT_V(6); PG8_BAR; PG8_MMA(1, 1, At, B1); PG8_BAR;
        }
        PG8_STAMP();
        if constexpr (Epi::FP8) { asm volatile("s_nop 15\n\ts_nop 15" ::: "memory"); }
        if constexpr (!Epi::AFTER_DRAIN) {
#if PG8_EPI_RECOMP
            const int t2_ = opaque_tid(), l2_ = t2_ & 63, w2_ = __builtin_amdgcn_readfirstlane(t2_ >> 6);
            E(acc, cur, w2_ >> 2, w2_ & 3, l2_ & 15, l2_ >> 4); S.done(cur);
#else
            E(acc, cur, wr, wc, fr, fq); S.done(cur);
#endif
        }
        PG8_STAMP();
        if (!has_next) break;
#pragma unroll
        for (int a = 0; a < 2; ++a)
#pragma unroll
            for (int b = 0; b < 2; ++b)
#pragma unroll
                for (int m = 0; m < 4; ++m)
#pragma unroll
                    for (int n = 0; n < 2; ++n) acc[a][b][m][n] = (f32x4){0.f, 0.f, 0.f, 0.f};
        cur = nxt; cA = nA; cB = nB; ++ui;
    }
    PG8_WAIT_V(0);
    if (wr == 0) PG8_BAR;
    PG8_BAR;
    if constexpr (Epi::AFTER_DRAIN) { E.fused(acc, cur, wr, wc, fr, fq, lds, wid, lane); S.done(cur); }
    PG8_STAMP();
    if (STAMP && wid == 0) { stamps[lane] = lane < nts ? (((unsigned long long)(unsigned)ts_hi << 32) | (unsigned)ts_lo) : 0ull;
        if (lane == 62) stamps[62] = rt_entry; if (lane == 63) stamps[63] = (unsigned long long)wall_clock64(); }
#undef PG8_STAMP
#undef PG8_SA
#undef PG8_SB
#undef PG8_STAGE
#undef PG8_LDA
#undef PG8_LDB
#undef PG8_MMA
#undef PG8_WAIT_V
#undef PG8_WAIT_L
#undef PG8_BAR
#undef PG8_SCHED
}
}

#include <cstdio>
#include <ctime>
#include <cstdlib>
#include <cstring>
#include <cmath>
#include <vector>

template <class F, bool F8 = false> struct EpiG {
    static constexpr bool PERM = false, AFTER_DRAIN = false, FP8 = F8;
    F f;
    __device__ __forceinline__ void operator()(const f32x4 (&acc)[2][2][4][2], const pg8::Unit& u, int wr, int wc, int fr, int fq) const {
        const int row0 = u.pm * 256 + wr * 64 + fr, col0 = u.pn * 256 + wc * 32 + 4 * fq;
#pragma unroll
        for (int ai = 0; ai < 2; ++ai)
#pragma unroll
            for (int m = 0; m < 4; ++m)
#pragma unroll
                for (int bj = 0; bj < 2; ++bj)
#pragma unroll
                    for (int n = 0; n < 2; ++n) f(row0 + ai * 128 + m * 16, col0 + bj * 128 + n * 16, acc[ai][bj][m][n]);
    }
};
__device__ __forceinline__ void st_bf16x4(bf16_t* p, f32x4 v) { u32x2 w; w.x = pack2bf(v[0], v[1]); w.y = pack2bf(v[2], v[3]); *(u32x2*)p = w; }
__device__ __forceinline__ void st_f32x4(float* p, f32x4 v) { *(f32x4*)p = v; }

struct FStoreBf16 { bf16_t* O; int ldc; int pad_; __device__ __forceinline__ void operator()(int r, int c, f32x4 v) const { st_bf16x4(O + (size_t)r * ldc + c, v); } };
struct FAbIn { bf16_t *Q, *K, *V; float *QI, *U, *WI; unsigned short* KI16;
    __device__ __forceinline__ void operator()(int r, int c, f32x4 v) const {
        if (c < 1024) st_bf16x4(Q + (size_t)r * 1024 + c, v);
        else if (c < 2048) st_bf16x4(K + (size_t)r * 1024 + (c - 1024), v);
        else if (c < 3072) st_bf16x4(V + (size_t)r * 1024 + (c - 2048), v);
        else if (c < 4096) st_f32x4(QI + (size_t)r * 1024 + (c - 3072), v);
        else if (c < 5120) st_f32x4(U + (size_t)r * 1024 + (c - 4096), v);
        else if (c < 5184) { typedef _Float16 h2 __attribute__((ext_vector_type(2))); union { h2 h; unsigned u; } a, b; a.h = (h2){(_Float16)v[0], (_Float16)v[1]}; b.h = (h2){(_Float16)v[2], (_Float16)v[3]};
            u32x2 w; w.x = a.u; w.y = b.u; *(u32x2*)(KI16 + (size_t)r * 64 + (c - 5120)) = w; }
        else if (c < 5200) st_f32x4(WI + (size_t)r * 16 + (c - 5184), v);
    } };
struct FCdIn { float *CQ, *CKV, *KR; bf16_t *XL, *YG;
    __device__ __forceinline__ void operator()(int r, int c, f32x4 v) const {
        if (c < 512) st_f32x4(CQ + (size_t)r * 512 + c, v);
        else if (c < 768) st_f32x4(CKV + (size_t)r * 256 + (c - 512), v);
        else if (c < 832) st_f32x4(KR + (size_t)r * 64 + (c - 768), v);
        else if (c < 1024) {}
        else if (c < 2048) st_bf16x4(XL + (size_t)r * 1024 + (c - 1024), v);
        else st_bf16x4(YG + (size_t)r * 1024 + (c - 2048), v);
    } };
struct FKvUp { bf16_t *K1, *V1;
    __device__ __forceinline__ void operator()(int r, int c, f32x4 v) const {
        const int h = c >> 8, d = c & 255;
        if (d < 128) st_bf16x4(K1 + (size_t)r * 1536 + h * 192 + d, v);
        else st_bf16x4(V1 + (size_t)r * 1024 + h * 128 + (d - 128), v);
    } };

__device__ __forceinline__ unsigned ord_key(float f) { const unsigned b = __float_as_uint(f); return (b & 0x80000000u) ? ~b : (b | 0x80000000u); }
__device__ __forceinline__ void rope_cs(int pos, int i, float& c, float& s) { const float freq = powf(10000.0f, -(float)i / 32.0f); const float ang = (float)pos * freq; sincosf(ang, &s, &c); }

typedef short bf16x8 __attribute__((ext_vector_type(8)));
typedef float f32x16 __attribute__((ext_vector_type(16)));
__device__ __forceinline__ unsigned cvtpk(float lo, float hi) { unsigned r; asm("v_cvt_pk_bf16_f32 %0, %1, %2" : "=v"(r) : "v"(lo), "v"(hi)); return r; }
__device__ __forceinline__ float max3_asm(float a, float b, float c) { float r; asm("v_max3_f32 %0, %1, %2, %3" : "=v"(r) : "v"(a), "v"(b), "v"(c)); return r; }

struct AttnArgs { const bf16_t* Q; const bf16_t* K; const bf16_t* VT; const unsigned long long* MT; bf16_t* O; int ldq, ldk, ldo; float sc_log2e; };

template <int DQK, bool MASKED>
__device__ __forceinline__ void attn_item(LAS unsigned char* lds, const AttnArgs& a, int b, int h, int qb) {
    constexpr int NKS = DQK / 16, PK = DQK * 2, PV = 128, KB_BYTES = 64 * PK, VB_BYTES = 128 * PV, NPK = DQK / 8, NKP = (64 * NPK) / 512, V_OFF = 3 * KB_BYTES;
    const int tid = opaque_tid(), lane = tid & 63, w = __builtin_amdgcn_readfirstlane(tid >> 6), n = lane & 31, hf = lane >> 5;
    const int nt = 4 * qb + 4, cw = 4 * qb + (w >> 1);
    const int trow = qb * 256 + w * 32 + n;
    const size_t grow = (size_t)b * SEQ + trow;
    bf16x8 qf[NKS];
    { const bf16_t* qp = a.Q + grow * a.ldq + h * DQK + hf * 8;
#pragma unroll
      for (int ks = 0; ks < NKS; ++ks) qf[ks] = *(const bf16x8*)(qp + ks * 16); }
    f32x16 o[4];
#pragma unroll
    for (int dt = 0; dt < 4; ++dt)
#pragma unroll
        for (int r = 0; r < 16; ++r) o[dt][r] = 0.f;
    float m_run = -INFINITY, l_run = 0.f;
    const float c = a.sc_log2e;
    const bf16_t* Kg = a.K + (size_t)b * SEQ * a.ldk + h * DQK;
    const bf16_t* Vg = a.VT + (size_t)(b * 8 + h) * 128 * SEQ;
    const unsigned long long* Mg = MASKED ? a.MT + (size_t)b * 256 * SEQ + trow : nullptr;
    auto dma_k = [&](int kt) {
        LAS unsigned char* kb = lds + (kt % 3) * KB_BYTES;
#pragma unroll
        for (int i = 0; i < NKP; ++i) { const int s = (w + 8 * i) * 64 + lane, r = s / NPK, cp = s % NPK, cc = cp ^ (NPK == 16 ? (r & 15) : ((r >> 1) & 7));
            __builtin_amdgcn_global_load_lds((const unsigned*)(Kg + (size_t)(kt * 64 + r) * a.ldk + cc * 8), (LAS unsigned*)(kb + (w + 8 * i) * 1024), 16, 0, 0); }
    };
    auto dma_v = [&](int kt) {
        LAS unsigned char* vb = lds + V_OFF + (kt & 1) * VB_BYTES;
#pragma unroll
        for (int i = 0; i < 2; ++i) { const int s = (w + 8 * i) * 64 + lane, d = s >> 3, cp = s & 7, cc = cp ^ ((d >> 1) & 7);
            __builtin_amdgcn_global_load_lds((const unsigned*)(Vg + (size_t)d * SEQ + kt * 64 + cc * 8), (LAS unsigned*)(vb + (w + 8 * i) * 1024), 16, 0, 0); }
    };
    const int kswz = (NPK == 16) ? (n & 15) : ((n >> 1) & 7), vswz = (n >> 1) & 7;
    auto qk = [&](int kt, f32x16& s0, f32x16& s1) {
        const LAS unsigned char* ka = lds + (kt % 3) * KB_BYTES + n * PK;
#pragma unroll
        for (int r = 0; r < 16; ++r) { s0[r] = 0.f; s1[r] = 0.f; }
#pragma unroll
        for (int ks = 0; ks < NKS; ++ks) {
            const int po = ((2 * ks + hf) ^ kswz) * 16;
            const bf16x8 a0 = *(const LAS bf16x8*)(ka + po), a1 = *(const LAS bf16x8*)(ka + 32 * PK + po);
            s0 = __builtin_amdgcn_mfma_f32_32x32x16_bf16(a0, qf[ks], s0, 0, 0, 0);
            s1 = __builtin_amdgcn_mfma_f32_32x32x16_bf16(a1, qf[ks], s1, 0, 0, 0);
        }
    };
    auto rowmax = [&](int kt, f32x16& s0, f32x16& s1) -> float {
        if (MASKED) {
            const unsigned long long mw = Mg[(size_t)kt * SEQ]; const unsigned mlo = (unsigned)mw >> (hf * 4), mhi = (unsigned)(mw >> 32) >> (hf * 4);
#pragma unroll
            for (int r = 0; r < 16; ++r) { const unsigned bit = 1u << ((r >> 2) * 8 + (r & 3));
                s0[r] = (mlo & bit) ? s0[r] : -INFINITY; s1[r] = (mhi & bit) ? s1[r] : -INFINITY; }
        }
        float mx = max3_asm(s0[0], s1[0], s0[1]);
        mx = max3_asm(mx, s1[1], s0[2]);
#pragma unroll
        for (int r = 2; r < 15; ++r) mx = max3_asm(mx, s1[r], s0[r + 1]);
        mx = max3_asm(mx, s1[15], mx);
        const auto rr = __builtin_amdgcn_permlane32_swap(__float_as_uint(mx), __float_as_uint(mx), false, false);
        return fmaxf(__uint_as_float(rr[0]), __uint_as_float(rr[1]));
    };
    dma_k(0); dma_v(0); if (nt > 1) dma_k(1);
    asm volatile("s_waitcnt vmcnt(0)" ::: "memory");
    __syncthreads();
    f32x16 sc0, sc1, sn0, sn1;
    qk(0, sc0, sc1);
    float mx_cur = rowmax(0, sc0, sc1), mx_next = -INFINITY;
#pragma unroll
    for (int r = 0; r < 16; ++r) { sn0[r] = 0.f; sn1[r] = 0.f; }
    for (int kt = 0; kt < nt; ++kt) {
        if (kt + 2 < nt) dma_k(kt + 2);
        if (kt + 1 < nt) dma_v(kt + 1);
        const bool act = kt <= cw, actn = kt + 1 <= cw;
        float m_use = 0.f;
        if (act) {
            const float m_new = fmaxf(m_run, mx_cur);
            m_use = (MASKED && m_new == -INFINITY) ? 0.f : m_new;
            if (__any(m_new > m_run)) {
                const float al = __builtin_amdgcn_exp2f((m_run - m_use) * c);
                l_run *= al;
#pragma unroll
                for (int dt = 0; dt < 4; ++dt)
#pragma unroll
                    for (int r = 0; r < 16; ++r) o[dt][r] *= al;
            }
            m_run = m_new;
        }
        if (actn) qk(kt + 1, sn0, sn1);
        bf16x8 pf[4];
        if (act) {
            const float mc = m_use * c;
            float ps = 0.f;
#pragma unroll
            for (int r = 0; r < 16; ++r) { sc0[r] = __builtin_amdgcn_exp2f(fmaf(sc0[r], c, -mc)); sc1[r] = __builtin_amdgcn_exp2f(fmaf(sc1[r], c, -mc)); ps += sc0[r] + sc1[r]; }
            l_run += ps;
            u32x4 t;
            t.x = cvtpk(sc0[0], sc0[1]); t.y = cvtpk(sc0[2], sc0[3]); t.z = cvtpk(sc0[4], sc0[5]); t.w = cvtpk(sc0[6], sc0[7]); pf[0] = *(bf16x8*)&t;
            t.x = cvtpk(sc0[8], sc0[9]); t.y = cvtpk(sc0[10], sc0[11]); t.z = cvtpk(sc0[12], sc0[13]); t.w = cvtpk(sc0[14], sc0[15]); pf[1] = *(bf16x8*)&t;
            t.x = cvtpk(sc1[0], sc1[1]); t.y = cvtpk(sc1[2], sc1[3]); t.z = cvtpk(sc1[4], sc1[5]); t.w = cvtpk(sc1[6], sc1[7]); pf[2] = *(bf16x8*)&t;
            t.x = cvtpk(sc1[8], sc1[9]); t.y = cvtpk(sc1[10], sc1[11]); t.z = cvtpk(sc1[12], sc1[13]); t.w = cvtpk(sc1[14], sc1[15]); pf[3] = *(bf16x8*)&t;
            const LAS unsigned char* va = lds + V_OFF + (kt & 1) * VB_BYTES + n * PV;
#pragma unroll
            for (int g = 0; g < 4; ++g) { const int po = ((2 * g + hf) ^ vswz) * 16;
#pragma unroll
                for (int dt = 0; dt < 4; ++dt) { const bf16x8 vf = *(const LAS bf16x8*)(va + dt * 32 * PV + po); o[dt] = __builtin_amdgcn_mfma_f32_32x32x16_bf16(vf, pf[g], o[dt], 0, 0, 0); } }
        }
        if (actn) mx_next = rowmax(kt + 1, sn0, sn1);
        sc0 = sn0; sc1 = sn1; mx_cur = mx_next;
        asm volatile("s_waitcnt vmcnt(0)" ::: "memory");
        __syncthreads();
    }
    const float lt = l_run + __shfl_xor(l_run, 32);
    const float inv = 1.0f / lt;
    bf16_t* op = a.O + grow * a.ldo + h * 128 + hf * 4;
#pragma unroll
    for (int dt = 0; dt < 4; ++dt)
#pragma unroll
        for (int r4 = 0; r4 < 4; ++r4) { u32x2 wv; wv.x = cvtpk(o[dt][4 * r4] * inv, o[dt][4 * r4 + 1] * inv); wv.y = cvtpk(o[dt][4 * r4 + 2] * inv, o[dt][4 * r4 + 3] * inv);
            *(u32x2*)(op + dt * 32 + r4 * 8) = wv; }
}
struct TTrue { static constexpr bool value = true; }; struct TFalse { static constexpr bool value = false; };
template <int DQK, bool MASKED>
__device__ __forceinline__ void attn_item3(LAS unsigned char* lds, const AttnArgs& a, int b, int h, int qb) {
    constexpr int NKS = DQK / 16, PK = DQK * 2, PV = 128, KB_BYTES = 64 * PK, VB_BYTES = 128 * PV, NPK = DQK / 8, NKP = (64 * NPK) / 512, V_OFF = 3 * KB_BYTES;
    const int tid = opaque_tid(), lane = tid & 63, w = __builtin_amdgcn_readfirstlane(tid >> 6), n = lane & 31, hf = lane >> 5;
    const int nt = 4 * qb + 4, cw = 4 * qb + (w >> 1);
    const int trow = qb * 256 + w * 32 + n;
    const size_t grow = (size_t)b * SEQ + trow;
    bf16x8 qf[NKS];
    { const bf16_t* qp = a.Q + grow * a.ldq + h * DQK + hf * 8;
#pragma unroll
      for (int ks = 0; ks < NKS; ++ks) qf[ks] = *(const bf16x8*)(qp + ks * 16); }
    f32x16 o[4];
#pragma unroll
    for (int dt = 0; dt < 4; ++dt)
#pragma unroll
        for (int r = 0; r < 16; ++r) o[dt][r] = 0.f;
    float m_run = -INFINITY, l_run = 0.f;
    const float c = a.sc_log2e;
    const bf16_t* Kg = a.K + (size_t)b * SEQ * a.ldk + h * DQK;
    const bf16_t* Vg = a.VT + (size_t)(b * 8 + h) * 128 * SEQ;
    const unsigned long long* Mg = MASKED ? a.MT + (size_t)b * 256 * SEQ + trow : nullptr;
    auto dma_k = [&](int kt) {
        LAS unsigned char* kb = lds + (kt % 3) * KB_BYTES;
#pragma unroll
        for (int i = 0; i < NKP; ++i) { const int s = (w + 8 * i) * 64 + lane, r = s / NPK, cp = s % NPK, cc = cp ^ (NPK == 16 ? (r & 15) : ((r >> 1) & 7));
            __builtin_amdgcn_global_load_lds((const unsigned*)(Kg + (size_t)(kt * 64 + r) * a.ldk + cc * 8), (LAS unsigned*)(kb + (w + 8 * i) * 1024), 16, 0, 0); }
    };
    auto dma_v = [&](int kt) {
        LAS unsigned char* vb = lds + V_OFF + (kt & 1) * VB_BYTES;
#pragma unroll
        for (int i = 0; i < 2; ++i) { const int s = (w + 8 * i) * 64 + lane, d = s >> 3, cp = s & 7, cc = cp ^ ((d >> 1) & 7);
            __builtin_amdgcn_global_load_lds((const unsigned*)(Vg + (size_t)d * SEQ + kt * 64 + cc * 8), (LAS unsigned*)(vb + (w + 8 * i) * 1024), 16, 0, 0); }
    };
    const int kswz = (NPK == 16) ? (n & 15) : ((n >> 1) & 7), vswz = (n >> 1) & 7;
    auto qk = [&](int kt, f32x16& s0, f32x16& s1) {
        const LAS unsigned char* ka = lds + (kt % 3) * KB_BYTES + n * PK;
#pragma unroll
        for (int r = 0; r < 16; ++r) { s0[r] = 0.f; s1[r] = 0.f; }
#pragma unroll
        for (int ks = 0; ks < NKS; ++ks) {
            const int po = ((2 * ks + hf) ^ kswz) * 16;
            const bf16x8 a0 = *(const LAS bf16x8*)(ka + po), a1 = *(const LAS bf16x8*)(ka + 32 * PK + po);
            s0 = __builtin_amdgcn_mfma_f32_32x32x16_bf16(a0, qf[ks], s0, 0, 0, 0);
            s1 = __builtin_amdgcn_mfma_f32_32x32x16_bf16(a1, qf[ks], s1, 0, 0, 0);
        }
    };
    auto rowmax = [&](unsigned long long mw, bool, f32x16& s0, f32x16& s1) -> float {
        if (MASKED) {
            const unsigned mlo = (unsigned)mw >> (hf * 4), mhi = (unsigned)(mw >> 32) >> (hf * 4);
#pragma unroll
            for (int r = 0; r < 16; ++r) { const unsigned bit = 1u << ((r >> 2) * 8 + (r & 3));
                s0[r] = (mlo & bit) ? s0[r] : -INFINITY; s1[r] = (mhi & bit) ? s1[r] : -INFINITY; }
        }
        float mx = max3_asm(s0[0], s1[0], s0[1]);
        mx = max3_asm(mx, s1[1], s0[2]);
#pragma unroll
        for (int r = 2; r < 15; ++r) mx = max3_asm(mx, s1[r], s0[r + 1]);
        mx = max3_asm(mx, s1[15], mx);
        const auto rr = __builtin_amdgcn_permlane32_swap(__float_as_uint(mx), __float_as_uint(mx), false, false);
        return fmaxf(__uint_as_float(rr[0]), __uint_as_float(rr[1]));
    };
    dma_k(0); dma_v(0); if (nt > 1) dma_k(1);
    unsigned long long mw_pre = MASKED ? Mg[(size_t)(nt > 1 ? 1 : 0) * SEQ] : 0ull;
    asm volatile("s_waitcnt vmcnt(0)" ::: "memory");
    __syncthreads();
    f32x16 sa0, sa1, sb0, sb1;
    qk(0, sa0, sa1);
    float mx_cur = rowmax(MASKED ? Mg[0] : 0ull, false, sa0, sa1);
    auto step = [&](int kt, f32x16& c0, f32x16& c1, f32x16& n0, f32x16& n1, auto full_tag) {
        constexpr bool FULL = decltype(full_tag)::value;
        if (kt + 2 < nt) dma_k(kt + 2);
        if (kt + 1 < nt) dma_v(kt + 1);
        const unsigned long long mw_now = mw_pre;
        if (MASKED) mw_pre = Mg[(size_t)(kt + 2 < nt ? kt + 2 : kt) * SEQ];
        const bool act = FULL || kt <= cw, actn = FULL || kt + 1 <= cw;
        const float m_new = fmaxf(m_run, mx_cur);
        const float m_use = (MASKED && m_new == -INFINITY) ? 0.f : m_new;
        if (act && __any(m_new > m_run)) {
            const float al = __builtin_amdgcn_exp2f((m_run - m_use) * c);
            l_run *= al;
#pragma unroll
            for (int dt = 0; dt < 4; ++dt)
#pragma unroll
                for (int r = 0; r < 16; ++r) o[dt][r] *= al;
        }
        if (act) m_run = m_new;
        if (FULL) {
            qk(kt + 1, n0, n1);
            const float mc = m_use * c;
            float ps = 0.f;
#pragma unroll
            for (int r = 0; r < 16; ++r) { c0[r] = __builtin_amdgcn_exp2f(fmaf(c0[r], c, -mc)); c1[r] = __builtin_amdgcn_exp2f(fmaf(c1[r], c, -mc)); ps += c0[r] + c1[r]; }
            l_run += ps;
            bf16x8 pf[4]; u32x4 t;
            t.x = cvtpk(c0[0], c0[1]); t.y = cvtpk(c0[2], c0[3]); t.z = cvtpk(c0[4], c0[5]); t.w = cvtpk(c0[6], c0[7]); pf[0] = *(bf16x8*)&t;
            t.x = cvtpk(c0[8], c0[9]); t.y = cvtpk(c0[10], c0[11]); t.z = cvtpk(c0[12], c0[13]); t.w = cvtpk(c0[14], c0[15]); pf[1] = *(bf16x8*)&t;
            t.x = cvtpk(c1[0], c1[1]); t.y = cvtpk(c1[2], c1[3]); t.z = cvtpk(c1[4], c1[5]); t.w = cvtpk(c1[6], c1[7]); pf[2] = *(bf16x8*)&t;
            t.x = cvtpk(c1[8], c1[9]); t.y = cvtpk(c1[10], c1[11]); t.z = cvtpk(c1[12], c1[13]); t.w = cvtpk(c1[14], c1[15]); pf[3] = *(bf16x8*)&t;
            const LAS unsigned char* va = lds + V_OFF + (kt & 1) * VB_BYTES + n * PV;
#pragma unroll
            for (int g = 0; g < 4; ++g) { const int po = ((2 * g + hf) ^ vswz) * 16;
#pragma unroll
                for (int dt = 0; dt < 4; ++dt) { const bf16x8 vf = *(const LAS bf16x8*)(va + dt * 32 * PV + po); o[dt] = __builtin_amdgcn_mfma_f32_32x32x16_bf16(vf, pf[g], o[dt], 0, 0, 0); } }
            mx_cur = rowmax(mw_now, false, n0, n1);
        } else {
            if (actn) qk(kt + 1, n0, n1);
            if (act) {
                const float mc = m_use * c;
                float ps = 0.f;
#pragma unroll
                for (int r = 0; r < 16; ++r) { c0[r] = __builtin_amdgcn_exp2f(fmaf(c0[r], c, -mc)); c1[r] = __builtin_amdgcn_exp2f(fmaf(c1[r], c, -mc)); ps += c0[r] + c1[r]; }
                l_run += ps;
                bf16x8 pf[4]; u32x4 t;
                t.x = cvtpk(c0[0], c0[1]); t.y = cvtpk(c0[2], c0[3]); t.z = cvtpk(c0[4], c0[5]); t.w = cvtpk(c0[6], c0[7]); pf[0] = *(bf16x8*)&t;
                t.x = cvtpk(c0[8], c0[9]); t.y = cvtpk(c0[10], c0[11]); t.z = cvtpk(c0[12], c0[13]); t.w = cvtpk(c0[14], c0[15]); pf[1] = *(bf16x8*)&t;
                t.x = cvtpk(c1[0], c1[1]); t.y = cvtpk(c1[2], c1[3]); t.z = cvtpk(c1[4], c1[5]); t.w = cvtpk(c1[6], c1[7]); pf[2] = *(bf16x8*)&t;
                t.x = cvtpk(c1[8], c1[9]); t.y = cvtpk(c1[10], c1[11]); t.z = cvtpk(c1[12], c1[13]); t.w = cvtpk(c1[14], c1[15]); pf[3] = *(bf16x8*)&t;
                const LAS unsigned char* va = lds + V_OFF + (kt & 1) * VB_BYTES + n * PV;
#pragma unroll
                for (int g = 0; g < 4; ++g) { const int po = ((2 * g + hf) ^ vswz) * 16;
#pragma unroll
                    for (int dt = 0; dt < 4; ++dt) { const bf16x8 vf = *(const LAS bf16x8*)(va + dt * 32 * PV + po); o[dt] = __builtin_amdgcn_mfma_f32_32x32x16_bf16(vf, pf[g], o[dt], 0, 0, 0); } }
            }
            if (actn) mx_cur = rowmax(mw_now, false, n0, n1);
        }
        asm volatile("s_waitcnt vmcnt(0)" ::: "memory");
        __syncthreads();
    };
    int kt = 0;
    for (; kt < 4 * qb; kt += 2) { step(kt, sa0, sa1, sb0, sb1, TTrue{}); step(kt + 1, sb0, sb1, sa0, sa1, TTrue{}); }
    for (; kt < nt; kt += 2) { step(kt, sa0, sa1, sb0, sb1, TFalse{}); step(kt + 1, sb0, sb1, sa0, sa1, TFalse{}); }
    const float lt = l_run + __shfl_xor(l_run, 32);
    const float inv = 1.0f / lt;
    bf16_t* op = a.O + grow * a.ldo + h * 128 + hf * 4;
#pragma unroll
    for (int dt = 0; dt < 4; ++dt)
#pragma unroll
        for (int r4 = 0; r4 < 4; ++r4) { u32x2 wv; wv.x = cvtpk(o[dt][4 * r4] * inv, o[dt][4 * r4 + 1] * inv); wv.y = cvtpk(o[dt][4 * r4 + 2] * inv, o[dt][4 * r4 + 3] * inv);
            *(u32x2*)(op + dt * 32 + r4 * 8) = wv; }
}
template <int DQK, bool MASKED>
__device__ __forceinline__ void attn_phase(LAS unsigned char* lds, const AttnArgs& a, int bid, int nblk) {
    for (int p = bid; p < 512; p += nblk) {
        const int bh = (p & 7) + 8 * (p >> 8), j = (p >> 3) & 31;
#pragma unroll 1
        for (int i = 0; i < 2; ++i) { if (DQK == 128) attn_item3<DQK, MASKED>(lds, a, bh >> 3, bh & 7, i ? j : 63 - j); else attn_item<DQK, MASKED>(lds, a, bh >> 3, bh & 7, i ? j : 63 - j); }
    }
}

#ifdef IDX_PROBE_FINAL
#define IDX_PF_ 1
#else
#define IDX_PF_ 0
#endif
typedef _Float16 f16x8 __attribute__((ext_vector_type(8)));
struct IdxArgs { const float* QI; const unsigned short* KI16; const float* WI; unsigned long long* MT; };
static constexpr int IDX_CAP = 640, IDX_CS = 0, IDX_CI = 32 * IDX_CAP * 4, IDX_KT = IDX_CI + 32 * IDX_CAP * 2, IDX_CNT = IDX_KT + 32768, IDX_TAU = IDX_CNT + 128, IDX_LDS = IDX_TAU + 128;
static_assert(IDX_KT % 1024 == 0, "K tile buffers must be 1 KiB aligned");

__device__ __forceinline__ float ord_inv(unsigned T) { return __uint_as_float((T & 0x80000000u) ? (T & 0x7FFFFFFFu) : ~T); }
__device__ __forceinline__ unsigned lane_prefix(unsigned long long m) { return __builtin_amdgcn_mbcnt_hi((unsigned)(m >> 32), __builtin_amdgcn_mbcnt_lo((unsigned)m, 0u)); }
__device__ __forceinline__ float relu_asm(float x) { float y; asm("v_max_f32 %0, 0, %1" : "=v"(y) : "v"(x)); return y; }
__device__ __forceinline__ void glds16(const void* gsrc, unsigned lds_dst) {
    unsigned keep;
    asm volatile("s_mov_b32 %0, m0\n\ts_mov_b32 m0, %2\n\ts_nop 0\n\tglobal_load_lds_dwordx4 %1, off\n\ts_mov_b32 m0, %0" : "=&s"(keep) : "v"(gsrc), "s"(lds_dst) : "memory");
}

template <bool EXACT> __device__ __forceinline__ int idx_compact(LAS unsigned char* lds, int qq, int lane, int n, float& tau) {
    LAS float* cs = (LAS float*)(lds + IDX_CS) + qq * IDX_CAP; LAS unsigned short* ci = (LAS unsigned short*)(lds + IDX_CI) + qq * IDX_CAP;
    float sv[10]; unsigned short iv[10]; unsigned uk[10];
#pragma unroll
    for (int j = 0; j < 10; ++j) { const int idx = lane + 64 * j; const bool valid = idx < n; sv[j] = cs[idx]; iv[j] = ci[idx]; uk[j] = valid ? ord_key(sv[j]) : 0u; }
    auto count_ge = [&](unsigned t) { int c = 0;
#pragma unroll
        for (int j = 0; j < 10; ++j) c += __builtin_popcountll(__ballot(uk[j] >= t));
        return c; };
    unsigned lo = ord_key(tau), hi = 0xFF800001u;
    if (lo > 0x80800000u) { const unsigned h2 = lo + 0x00800000u;
        if (h2 < hi) { if (count_ge(h2) >= 256) lo = h2; else hi = h2; } }
    while (hi - lo > 1u) {
        const unsigned mid = lo + ((hi - lo) >> 1); const int c = count_ge(mid);
        if (c >= 256) { lo = mid; if (!EXACT && c <= 336) break; } else hi = mid;
    }
    const unsigned T = lo;
    int need = 0;
    if (EXACT) { int ngt = 0;
#pragma unroll
        for (int j = 0; j < 10; ++j) ngt += __builtin_popcountll(__ballot(uk[j] > T));
        need = 256 - ngt; }
    int base = 0, tiebase = 0;
#pragma unroll
    for (int j = 0; j < 10; ++j) {
        bool keep;
        if (EXACT) { const bool gt = uk[j] > T, eq = uk[j] == T; const unsigned long long em = __ballot(eq); keep = gt || (eq && (tiebase + (int)lane_prefix(em)) < need); tiebase += __builtin_popcountll(em); }
        else keep = uk[j] >= T;
        const unsigned long long km = __ballot(keep);
        const int pos = base + (int)lane_prefix(km);
        if (keep) { cs[pos] = sv[j]; ci[pos] = iv[j]; }
        base += __builtin_popcountll(km);
    }
    tau = ord_inv(T);
    return base;
}

__device__ __forceinline__ void idx_item(LAS unsigned char* lds, const IdxArgs& a, int b, int hc) {
    const int tid = opaque_tid(), lane = tid & 63, w = __builtin_amdgcn_readfirstlane(tid >> 6), n = lane & 31, hf = lane >> 5;
    const int t0 = hc * 32, L = (t0 / 64 + 1) * 64, nsub = L / 32, ntile = (L + 127) / 128;
    const size_t q0 = (size_t)b * SEQ + t0 + 4 * w;
    LAS float* cs = (LAS float*)(lds + IDX_CS); LAS unsigned short* ci = (LAS unsigned short*)(lds + IDX_CI);
    LAS unsigned* cnt = (LAS unsigned*)(lds + IDX_CNT);
    f16x8 qf[2][4];
#pragma unroll
    for (int rt = 0; rt < 2; ++rt) { const float* qp = a.QI + (q0 + 2 * rt + (n >> 4)) * 1024 + (n & 15) * 64 + hf * 8;
#pragma unroll
        for (int ks = 0; ks < 4; ++ks) { const f32x4 x0 = *(const f32x4*)(qp + ks * 16), x1 = *(const f32x4*)(qp + ks * 16 + 4);
            f16x8 v; v[0] = (_Float16)x0[0]; v[1] = (_Float16)x0[1]; v[2] = (_Float16)x0[2]; v[3] = (_Float16)x0[3]; v[4] = (_Float16)x1[0]; v[5] = (_Float16)x1[1]; v[6] = (_Float16)x1[2]; v[7] = (_Float16)x1[3];
            qf[rt][ks] = v; } }
    float wv[2][16];
#pragma unroll
    for (int rt = 0; rt < 2; ++rt)
#pragma unroll
        for (int r = 0; r < 16; ++r) wv[rt][r] = a.WI[(q0 + 2 * rt + (r >> 3)) * 16 + (((r & 3) + 8 * (r >> 2) + 4 * hf) & 15)] * (0.125f * 0.25f);
    if (tid < 32) cnt[tid] = 0u;
    int cq0 = 0, cq1 = 0, cq2 = 0, cq3 = 0;
    float tq0 = -INFINITY, tq1 = -INFINITY, tq2 = -INFINITY, tq3 = -INFINITY;
    float tau0 = INFINITY, tau1 = INFINITY;
    const unsigned short* Kg = a.KI16 + (size_t)b * SEQ * 64;
    const unsigned ldsbase = (unsigned)(size_t)lds;
    auto dma = [&](int kt, int buf) {
#pragma unroll
        for (int i = 0; i < 2; ++i) { const int s = (w + 8 * i) * 64 + lane, r = s >> 3, cp = s & 7, cc = cp ^ ((r >> 1) & 7);
            glds16(Kg + (size_t)(kt * 128 + r) * 64 + cc * 8, ldsbase + IDX_KT + buf * 16384 + (w + 8 * i) * 1024); }
    };
    dma(0, 0);
    asm volatile("s_waitcnt vmcnt(0)" ::: "memory");
    __syncthreads();
    const int kswz = (n >> 1) & 7;
    f32x16 accA[2], accB[2];
#pragma unroll
    for (int rt = 0; rt < 2; ++rt)
#pragma unroll
        for (int r = 0; r < 16; ++r) { accA[rt][r] = 0.f; accB[rt][r] = 0.f; }
    int keyA = 0, keyB = 0;
    auto epilogue = [&](const f32x16 (&acc)[2], int key) {
        float sc[2];
#pragma unroll
        for (int rt = 0; rt < 2; ++rt) { float pa = 0.f, pb = 0.f;
#pragma unroll
            for (int r = 0; r < 8; ++r) { pa = fmaf(relu_asm(acc[rt][r]), wv[rt][r], pa); pb = fmaf(relu_asm(acc[rt][r + 8]), wv[rt][r + 8], pb); }
            const auto rr = __builtin_amdgcn_permlane32_swap(__float_as_uint(pa), __float_as_uint(pb), false, false);
            sc[rt] = __uint_as_float(rr[0]) + __uint_as_float(rr[1]); }
        const bool c0 = sc[0] > tau0, c1 = sc[1] > tau1;
        const unsigned long long m0 = __ballot(c0), m1 = __ballot(c1);
        if (m0 | m1) {
            const unsigned l0 = (unsigned)m0, h0 = (unsigned)(m0 >> 32), l1 = (unsigned)m1, h1 = (unsigned)(m1 >> 32);
            const int p0 = hf ? cq1 + (int)__builtin_amdgcn_mbcnt_hi(h0, 0u) : cq0 + (int)__builtin_amdgcn_mbcnt_lo(l0, 0u);
            const int p1 = hf ? cq3 + (int)__builtin_amdgcn_mbcnt_hi(h1, 0u) : cq2 + (int)__builtin_amdgcn_mbcnt_lo(l1, 0u);
            if (c0 && p0 < IDX_CAP) { const int qq = 4 * w + hf; cs[qq * IDX_CAP + p0] = sc[0]; ci[qq * IDX_CAP + p0] = (unsigned short)key; }
            if (c1 && p1 < IDX_CAP) { const int qq = 4 * w + 2 + hf; cs[qq * IDX_CAP + p1] = sc[1]; ci[qq * IDX_CAP + p1] = (unsigned short)key; }
            cq0 += __builtin_popcount(l0); cq1 += __builtin_popcount(h0); cq2 += __builtin_popcount(l1); cq3 += __builtin_popcount(h1);
        }
    };
    auto mma = [&](f32x16 (&acc)[2], const LAS unsigned char* kr) {
        f16x8 kf[4];
#pragma unroll
        for (int ks = 0; ks < 4; ++ks) kf[ks] = *(const LAS f16x8*)(kr + ((2 * ks + hf) ^ kswz) * 16);
#pragma unroll
        for (int rt = 0; rt < 2; ++rt) {
            f32x16 c;
#pragma unroll
            for (int r = 0; r < 16; ++r) c[r] = 0.f;
#pragma unroll
            for (int ks = 0; ks < 4; ++ks) c = __builtin_amdgcn_mfma_f32_32x32x16_f16(qf[rt][ks], kf[ks], c, 0, 0, 0);
            acc[rt] = c; }
    };
#ifdef IDX_PROBE2
  for (int rep_ = 0; rep_ < 2; ++rep_) {
    if (rep_ == 1) { epilogue(accB, keyB); tau0 = INFINITY; tau1 = INFINITY; __syncthreads(); dma(0, 0); asm volatile("s_waitcnt vmcnt(0)" ::: "memory"); __syncthreads(); }
#endif
    for (int kt = 0; kt < ntile; ++kt) {
        if (kt + 1 < ntile) dma(kt + 1, (kt + 1) & 1);
#ifdef IDX_PROBE2
        if (rep_ == 0)
#endif
        { const unsigned c_all = cnt[lane & 31];
          if (__ballot(c_all > (unsigned)(IDX_CAP - 160))) {
              if (cq0 > 400) cq0 = idx_compact<false>(lds, 4 * w + 0, lane, cq0, tq0);
              if (cq1 > 400) cq1 = idx_compact<false>(lds, 4 * w + 1, lane, cq1, tq1);
              if (cq2 > 400) cq2 = idx_compact<false>(lds, 4 * w + 2, lane, cq2, tq2);
              if (cq3 > 400) cq3 = idx_compact<false>(lds, 4 * w + 3, lane, cq3, tq3);
              if (kt > 0) { tau0 = hf ? tq1 : tq0; tau1 = hf ? tq3 : tq2; }
          } }
        const LAS unsigned char* kb = lds + IDX_KT + (kt & 1) * 16384 + n * 128;
        const int sbase = kt * 4;
#ifdef IDX_PROBE2
        if (sbase + 0 < nsub) { mma(accA, kb); epilogue(accB, keyB); keyA = kt * 128 + n; if (kt == 0 && rep_ == 0) { tau0 = -INFINITY; tau1 = -INFINITY; } }
#else
        if (sbase + 0 < nsub) { mma(accA, kb); epilogue(accB, keyB); keyA = kt * 128 + n; if (kt == 0) { tau0 = -INFINITY; tau1 = -INFINITY; } }
#endif
        if (sbase + 1 < nsub) { mma(accB, kb + 32 * 128); epilogue(accA, keyA); keyB = kt * 128 + 32 + n; }
        if (sbase + 2 < nsub) { mma(accA, kb + 64 * 128); epilogue(accB, keyB); keyA = kt * 128 + 64 + n; }
        if (sbase + 3 < nsub) { mma(accB, kb + 96 * 128); epilogue(accA, keyA); keyB = kt * 128 + 96 + n; }
        if (lane < 4) cnt[4 * w + lane] = (unsigned)(lane == 0 ? cq0 : (lane == 1 ? cq1 : (lane == 2 ? cq2 : cq3)));
        asm volatile("s_waitcnt vmcnt(0)" ::: "memory");
        __syncthreads();
    }
#ifdef IDX_PROBE2
  }
#endif
    epilogue(accB, keyB);
    __syncthreads();
    LAS unsigned* bm = (LAS unsigned*)(lds + IDX_KT) + w * 512;
#ifdef IDX_PROBE_FINAL
  for (int rep2_ = 0; rep2_ < 2; ++rep2_) {
#endif
    if (cq0 > 256 - IDX_PF_) cq0 = idx_compact<true>(lds, 4 * w + 0, lane, cq0, tq0);
    if (cq1 > 256 - IDX_PF_) cq1 = idx_compact<true>(lds, 4 * w + 1, lane, cq1, tq1);
    if (cq2 > 256 - IDX_PF_) cq2 = idx_compact<true>(lds, 4 * w + 2, lane, cq2, tq2);
    if (cq3 > 256 - IDX_PF_) cq3 = idx_compact<true>(lds, 4 * w + 3, lane, cq3, tq3);
#pragma unroll 1
    for (int i = 0; i < 4; ++i) {
        const int qq = 4 * w + i;
        const int nsel = (i == 0) ? cq0 : ((i == 1) ? cq1 : ((i == 2) ? cq2 : cq3));
#pragma unroll
        for (int j = 0; j < 8; ++j) bm[lane + 64 * j] = 0u;
#pragma unroll
        for (int j = 0; j < 4; ++j) { const int idx = lane + 64 * j; if (idx < nsel) { const unsigned k = ci[qq * IDX_CAP + idx]; (void)__hip_atomic_fetch_or(bm + (k >> 5), 1u << (k & 31), __ATOMIC_RELAXED, __HIP_MEMORY_SCOPE_WORKGROUP); } }
        const int tq = t0 + qq;
#pragma unroll 1
        for (int kt = lane; kt < L / 64; kt += 64) { const unsigned long long v = (unsigned long long)bm[2 * kt] | ((unsigned long long)bm[2 * kt + 1] << 32); a.MT[((size_t)b * 256 + kt) * SEQ + tq] = v; }
    }
#ifdef IDX_PROBE_FINAL
  }
#endif
    __syncthreads();
}
__device__ __forceinline__ void idx_phase(LAS unsigned char* lds, const IdxArgs& a, int bid, int nblk) {
    for (int k = bid; k < 256; k += nblk) {
#pragma unroll 1
        for (int i = 0; i < 4; ++i) idx_item(lds, a, i & 1, (i < 2) ? 511 - k : k);
    }
}
#define XB_TMO      128
#define XB_XCNT(j)  (256  + 64 * (j))
#define XB_XSUB(j)  (1280 + 64 * (j))
#define XB_XGEN(j)  (2304 + 64 * (j))
#define XB_TOP      3328
#define XB_TOPGEN   3392
#define XCD_BAR_WORDS 3456
#define XB_SPIN_CAP (1u << 23)


__device__ __forceinline__ unsigned xb_ld(unsigned* p)              { return __hip_atomic_load(p, __ATOMIC_RELAXED, __HIP_MEMORY_SCOPE_AGENT); }
__device__ __forceinline__ unsigned xb_add(unsigned* p, unsigned v) { return __hip_atomic_fetch_add(p, v, __ATOMIC_RELAXED, __HIP_MEMORY_SCOPE_AGENT); }
__device__ __forceinline__ unsigned xb_xcc_id() { return (unsigned)__builtin_amdgcn_s_getreg((3 << 11) | 20) & 0xFu; }
#define XB_SPIN(cond, bar) do { unsigned _sp = 0; while (cond) { __builtin_amdgcn_s_sleep(1); \
    if ((++_sp & 255u) == 0u) { if (xb_ld(&(bar)[XB_TMO])) break; if (_sp > XB_SPIN_CAP) { atomicAdd(&(bar)[XB_TMO], 1u); break; } } } } while (0)

struct XcdBarrier {
    unsigned* bar; unsigned x;
    volatile LAS unsigned* st;
};

__device__ __forceinline__ XcdBarrier xcd_barrier_post(unsigned* bar, volatile LAS unsigned* st) {
    XcdBarrier b; b.bar = bar; b.x = xb_xcc_id(); b.st = st;
    if (threadIdx.x == 0) (void)xb_add(&bar[XB_XCNT(b.x)], 1u);
    return b;
}
__device__ __forceinline__ void xcd_barrier_complete(unsigned* bar, unsigned x, unsigned& nloc, unsigned& nx) {
    const unsigned G = gridDim.x * gridDim.y * gridDim.z;
    unsigned sum, cnt, mine, sp = 0u;
    for (;;) {
        sum = 0u; cnt = 0u; mine = 0u;
#pragma unroll
        for (unsigned j = 0; j < 16; ++j) { const unsigned c = xb_ld(&bar[XB_XCNT(j)]); sum += c; cnt += (c > 0u) ? 1u : 0u; mine = (j == x) ? c : mine; }
        if (sum == G) break;
        __builtin_amdgcn_s_sleep(1);
        if ((++sp & 255u) == 0u) { if (xb_ld(&bar[XB_TMO])) break; if (sp > XB_SPIN_CAP) { atomicAdd(&bar[XB_TMO], 1u); break; } }
    }
    nloc = mine > 0u ? mine : 1u; nx = cnt > 0u ? cnt : 1u;
}

__device__ __forceinline__ void xcd_barrier(const XcdBarrier& b) {
    asm volatile("s_waitcnt vmcnt(0)" ::: "memory");
    __syncthreads();
    if (threadIdx.x == 0) {
        unsigned* bar = b.bar;
        __builtin_amdgcn_s_waitcnt(0);
        unsigned nloc = b.st[0], nx = b.st[1];
        if (nloc == 0u) { xcd_barrier_complete(bar, b.x, nloc, nx); b.st[0] = nloc; b.st[1] = nx; }
        const unsigned old = xb_add(&bar[XB_XSUB(b.x)], 1u);
        const unsigned gen = old / nloc;
        if (old + 1u == (gen + 1u) * nloc) {
            __builtin_amdgcn_fence(__ATOMIC_RELEASE, "agent");
            asm volatile("s_waitcnt vmcnt(0)" ::: "memory");
            const unsigned og = xb_add(&bar[XB_TOP], 1u);
            const unsigned tg = og / nx;
            if (og + 1u == (tg + 1u) * nx) xb_add(&bar[XB_TOPGEN], 1u);
            else XB_SPIN(xb_ld(&bar[XB_TOPGEN]) == tg, bar);
            __builtin_amdgcn_fence(__ATOMIC_ACQUIRE, "agent");
            xb_add(&bar[XB_XGEN(b.x)], 1u);
            asm volatile("s_waitcnt vmcnt(0)" ::: "memory");
        } else {
            XB_SPIN(xb_ld(&bar[XB_XGEN(b.x)]) == gen, bar);
            __builtin_amdgcn_fence(__ATOMIC_ACQUIRE, "agent");
            asm volatile("s_waitcnt vmcnt(0)" ::: "memory");
        }
    }
    __syncthreads();
}

#ifndef FP8_UP0
#define FP8_UP0 0
#endif
#ifndef FP8_UP1
#define FP8_UP1 1
#endif
#ifndef FP8_DN0
#define FP8_DN0 0
#endif
#ifndef FP8_DN1
#define FP8_DN1 1
#endif
#ifndef SKIPMASK
#define SKIPMASK 0
#endif

__device__ __forceinline__ int perm16(int t) { const int a = (t >> 2) & 3; return (t & ~12) | ((a == 1 ? 2 : (a == 2 ? 1 : a)) << 2); }
__device__ __forceinline__ void st_vt(bf16_t* VT, int row, int h, int d, f32x4 v) {
    const int b = row / SEQ, t = row % SEQ; bf16_t* p = VT + ((size_t)(b * 8 + h) * 128 + d) * SEQ + (t & ~15) + perm16(t & 15);
    p[0] = f2bf(v[0]); p[SEQ] = f2bf(v[1]); p[2 * (size_t)SEQ] = f2bf(v[2]); p[3 * (size_t)SEQ] = f2bf(v[3]);
}
struct FAbIn2 { bf16_t *Q, *K, *VT; float *QI, *U, *WI; unsigned short* KI16;
    __device__ __forceinline__ void operator()(int r, int c, f32x4 v) const {
        if (c < 1024) st_bf16x4(Q + (size_t)r * 1024 + c, v);
        else if (c < 2048) st_bf16x4(K + (size_t)r * 1024 + (c - 1024), v);
        else if (c < 3072) st_vt(VT, r, (c - 2048) >> 7, (c - 2048) & 127, v);
        else if (c < 4096) st_f32x4(QI + (size_t)r * 1024 + (c - 3072), v);
        else if (c < 5120) st_f32x4(U + (size_t)r * 1024 + (c - 4096), v);
        else if (c < 5184) { typedef _Float16 h2 __attribute__((ext_vector_type(2))); union { h2 h; unsigned u; } a, b; a.h = (h2){(_Float16)v[0], (_Float16)v[1]}; b.h = (h2){(_Float16)v[2], (_Float16)v[3]};
            u32x2 w; w.x = a.u; w.y = b.u; *(u32x2*)(KI16 + (size_t)r * 64 + (c - 5120)) = w; }
        else if (c < 5200) st_f32x4(WI + (size_t)r * 16 + (c - 5184), v);
    } };
struct FKvUp2 { bf16_t *K1, *VT;
    __device__ __forceinline__ void operator()(int r, int c, f32x4 v) const {
        const int h = c >> 8, d = c & 255;
        if (d < 128) st_bf16x4(K1 + (size_t)r * 1536 + h * 192 + d, v);
        else st_vt(VT, r, h, d - 128, v);
    } };

template <class E> __device__ __forceinline__ void ph_gemm_e(LAS unsigned char* lds, const bf16_t* A, int lda, const bf16_t* Bt, int ldb, int M, int N, int K, const E& e, int bid, int nblk, int a_shift = 0, int a_bytes = 0, int cmode = 0) {
    pg8::Gemm g; g.A = A; g.Bt = Bt; g.M = M; g.N = N; g.K = K; g.lda = lda; g.ldb = ldb; g.a_shift = a_shift; g.a_bytes = a_bytes; g.cmode = cmode;
    pg8::StaticOrder S; S.init(M, N, nblk, bid);
    pg8::gemm_phase<E, pg8::StaticOrder, false>(lds, g, S, e, nullptr);
    __syncthreads();
}
template <class F> __device__ __forceinline__ void ph_gemm(LAS unsigned char* lds, const bf16_t* A, int lda, const bf16_t* Bt, int ldb, int M, int N, int K, const F& f, int bid, int nblk, int a_shift = 0, int a_bytes = 0) {
    EpiG<F> e; e.f = f;
    ph_gemm_e(lds, A, lda, Bt, ldb, M, N, K, e, bid, nblk, a_shift, a_bytes);
}
template <class F> __device__ __forceinline__ void ph_gemm8(LAS unsigned char* lds, const unsigned char* A, int lda, const unsigned char* Bt, int ldb, int M, int N, int K, const F& f, int bid, int nblk) {
    EpiG<F, true> e; e.f = f;
    ph_gemm_e(lds, (const bf16_t*)A, lda / 2, (const bf16_t*)Bt, ldb / 2, M, N, K / 2, e, bid, nblk, 0, 0);
}
__device__ __forceinline__ float dpp_ror1(float v) { return __int_as_float(__builtin_amdgcn_update_dpp(0, __float_as_int(v), 0x121, 0xF, 0xF, false)); }
__device__ __forceinline__ float dpp_ror2(float v) { return __int_as_float(__builtin_amdgcn_update_dpp(0, __float_as_int(v), 0x122, 0xF, 0xF, false)); }
__device__ __forceinline__ float dpp_shr1(float old, float v) { return __int_as_float(__builtin_amdgcn_update_dpp(__float_as_int(old), __float_as_int(v), 0x111, 0xF, 0xF, false)); }
__device__ __forceinline__ float dpp_shr2(float old, float v) { return __int_as_float(__builtin_amdgcn_update_dpp(__float_as_int(old), __float_as_int(v), 0x112, 0xF, 0xF, false)); }
__device__ __forceinline__ float gelu_fast(float x) { const float u2 = 1.5957691216057308f * (x + 0.044715f * x * x * x); return x * __builtin_amdgcn_rcpf(1.0f + __builtin_amdgcn_exp2f(-1.4426950408889634f * u2)); }
template <bool OUT8, bool F8> struct EpiGate {
    static constexpr bool PERM = false, AFTER_DRAIN = false, FP8 = F8;
    const float* cw; const float* cb; void* ACT;
    __device__ __forceinline__ void operator()(const f32x4 (&acc)[2][2][4][2], const pg8::Unit& u, int wr, int wc, int fr, int fq) const {
        const int bt = u.pm / 67, ti = u.pm % 67;
#pragma unroll
        for (int n = 0; n < 2; ++n) {
            const int c = u.pn * 128 + wc * 32 + 16 * n + 4 * fq;
            const f32x4 g0 = *(const f32x4*)(cw + c), g1 = *(const f32x4*)(cw + 8192 + c), g2 = *(const f32x4*)(cw + 16384 + c), gb = *(const f32x4*)(cb + c);
            const f32x4 v0 = *(const f32x4*)(cw + 4096 + c), v1 = *(const f32x4*)(cw + 8192 + 4096 + c), v2 = *(const f32x4*)(cw + 16384 + 4096 + c), vb = *(const f32x4*)(cb + 4096 + c);
#pragma unroll
            for (int ai = 0; ai < 2; ++ai) {
                const int strip = 2 * ai + wr, tbase = ti * 248 + strip * 62 - 2;
                f32x4 pg = {0.f, 0.f, 0.f, 0.f}, pv = pg;
#pragma unroll
                for (int m = 0; m < 4; ++m) {
                    f32x4 xg = acc[ai][0][m][n], xv = acc[ai][1][m][n];
                    const int t = tbase + 16 * m + fr;
                    if (t < 0) { xg = (f32x4){0.f, 0.f, 0.f, 0.f}; xv = xg; }
                    f32x4 og, ov;
#pragma unroll
                    for (int j = 0; j < 4; ++j) {
                        const float gp1 = dpp_shr1(dpp_ror1(pg[j]), xg[j]), gp2 = dpp_shr2(dpp_ror2(pg[j]), xg[j]);
                        const float vp1 = dpp_shr1(dpp_ror1(pv[j]), xv[j]), vp2 = dpp_shr2(dpp_ror2(pv[j]), xv[j]);
                        og[j] = gb[j] + g0[j] * gp2 + g1[j] * gp1 + g2[j] * xg[j];
                        ov[j] = vb[j] + v0[j] * vp2 + v1[j] * vp1 + v2[j] * xv[j];
                        og[j] = gelu_fast(og[j]) * ov[j];
                    }
                    pg = xg; pv = xv;
                    if (16 * m + fr >= 2 && t < SEQ) {
                        const size_t o = ((size_t)bt * SEQ + t) * 4096 + c;
                        if (OUT8) { int pk = 0; pk = __builtin_amdgcn_cvt_pk_fp8_f32(og[0], og[1], pk, false); pk = __builtin_amdgcn_cvt_pk_fp8_f32(og[2], og[3], pk, true); *(int*)((unsigned char*)ACT + o) = pk; }
                        else st_bf16x4((bf16_t*)ACT + o, og);
                    }
                }
            }
        }
    }
};
struct FPool { bf16_t* CC; const float* pb; const float* ps;
    __device__ __forceinline__ void operator()(int r, int c, f32x4 v) const { const f32x4 b = *(const f32x4*)(pb + c), s = *(const f32x4*)(ps + c); st_bf16x4(CC + (size_t)r * 2048 + 1024 + c, (v + b) * s); } };
struct EpiLru {
    static constexpr bool PERM = false, AFTER_DRAIN = false, FP8 = false;
    const bf16_t* XCB; const float *ba, *bx, *lam; float *LA, *LB;
    __device__ __forceinline__ void operator()(const f32x4 (&acc)[2][2][4][2], const pg8::Unit& u, int wr, int wc, int fr, int fq) const {
        const int row0 = u.pm * 256 + wr * 64 + fr;
#pragma unroll
        for (int n = 0; n < 2; ++n) {
            const int ch = u.pn * 128 + wc * 32 + 16 * n + 4 * fq;
            const f32x4 bav = *(const f32x4*)(ba + ch), bxv = *(const f32x4*)(bx + ch), lm = *(const f32x4*)(lam + ch);
            f32x4 sp;
#pragma unroll
            for (int j = 0; j < 4; ++j) sp[j] = log1pf(__expf(-lm[j]));
#pragma unroll
            for (int ai = 0; ai < 2; ++ai)
#pragma unroll
                for (int m = 0; m < 4; ++m) {
                    const int row = row0 + ai * 128 + m * 16;
                    const u32x2 xw = *(const u32x2*)(XCB + (size_t)row * 1024 + ch);
                    const f32x4 xc = {__uint_as_float(xw.x << 16), __uint_as_float(xw.x & 0xFFFF0000u), __uint_as_float(xw.y << 16), __uint_as_float(xw.y & 0xFFFF0000u)};
                    const f32x4 ga = acc[ai][0][m][n] + bav, gx = acc[ai][1][m][n] + bxv;
                    f32x4 av, bv;
#pragma unroll
                    for (int j = 0; j < 4; ++j) {
                        const float rg = 1.0f / (1.0f + __expf(-ga[j])), ig = 1.0f / (1.0f + __expf(-gx[j]));
                        const float log_a = -8.0f * rg * sp[j], a = __expf(log_a), mult = sqrtf(-expm1f(2.0f * log_a));
                        av[j] = a; bv[j] = mult * (ig * xc[j]);
                    }
                    *(f32x4*)(LA + (size_t)row * 1024 + ch) = av; *(f32x4*)(LB + (size_t)row * 1024 + ch) = bv;
                }
        }
    }
};
__device__ __forceinline__ void ph_pooled(const float* __restrict__ U, bf16_t* __restrict__ P, int bid, int nblk) {
    for (int i = bid * 512 + opaque_tid(); i < 256 * (NTOK / 64); i += nblk * 512) {
        const int c4 = i & 255, row0 = (i >> 8) * 64, t0 = row0 % SEQ, g = c4 >> 6, win = 2 << g;
        const f32x4* up = (const f32x4*)U + (size_t)row0 * 256 + c4;
        f32x4 s = {0.f, 0.f, 0.f, 0.f};
        if (t0 > 0) { for (int k = 1; k < win; ++k) s += up[-(ptrdiff_t)k * 256]; }
#pragma unroll 8
        for (int r = 0; r < 64; ++r) {
            const int t = t0 + r; const f32x4 u0 = up[(ptrdiff_t)r * 256];
            s += u0;
            const int cnt = (t + 1 < win) ? (t + 1) : win;
            st_bf16x4(P + (size_t)(row0 + r) * 1024 + c4 * 4, s * (1.0f / (float)cnt) - u0);
            if (t + 1 >= win) s -= up[(ptrdiff_t)(r + 1 - win) * 256];
        }
    }
}
__device__ __forceinline__ void ph_xc(const bf16_t* __restrict__ XL, const float* __restrict__ cw, const float* __restrict__ cb, bf16_t* __restrict__ XCB, int bid, int nblk) {
    for (int i = bid * 512 + opaque_tid(); i < 128 * (NTOK / 32); i += nblk * 512) {
        const int c8 = (i & 127) * 8, row0 = (i >> 7) * 32, t0 = row0 % SEQ;
        float w0[8], w1[8], w2[8], w3[8], bb[8];
#pragma unroll
        for (int j = 0; j < 8; ++j) { w0[j] = cw[c8 + j]; w1[j] = cw[1024 + c8 + j]; w2[j] = cw[2048 + c8 + j]; w3[j] = cw[3072 + c8 + j]; bb[j] = cb[c8 + j]; }
        u32x4 p3 = {0u, 0u, 0u, 0u}, p2 = p3, p1 = p3;
        if (t0 >= 3) { p3 = *(const u32x4*)(XL + (size_t)(row0 - 3) * 1024 + c8); p2 = *(const u32x4*)(XL + (size_t)(row0 - 2) * 1024 + c8); p1 = *(const u32x4*)(XL + (size_t)(row0 - 1) * 1024 + c8); }
#pragma unroll 8
        for (int r = 0; r < 32; ++r) {
            const u32x4 cur = *(const u32x4*)(XL + (size_t)(row0 + r) * 1024 + c8);
            const unsigned a3[4] = {p3.x, p3.y, p3.z, p3.w}, a2[4] = {p2.x, p2.y, p2.z, p2.w}, a1[4] = {p1.x, p1.y, p1.z, p1.w}, a0[4] = {cur.x, cur.y, cur.z, cur.w};
            float y[8];
#pragma unroll
            for (int j = 0; j < 4; ++j) {
                y[2 * j] = bb[2 * j] + w0[2 * j] * __uint_as_float(a3[j] << 16) + w1[2 * j] * __uint_as_float(a2[j] << 16) + w2[2 * j] * __uint_as_float(a1[j] << 16) + w3[2 * j] * __uint_as_float(a0[j] << 16);
                y[2 * j + 1] = bb[2 * j + 1] + w0[2 * j + 1] * __uint_as_float(a3[j] & 0xFFFF0000u) + w1[2 * j + 1] * __uint_as_float(a2[j] & 0xFFFF0000u) + w2[2 * j + 1] * __uint_as_float(a1[j] & 0xFFFF0000u) + w3[2 * j + 1] * __uint_as_float(a0[j] & 0xFFFF0000u); }
            u32x4 o; o.x = pack2bf(y[0], y[1]); o.y = pack2bf(y[2], y[3]); o.z = pack2bf(y[4], y[5]); o.w = pack2bf(y[6], y[7]);
            *(u32x4*)(XCB + (size_t)(row0 + r) * 1024 + c8) = o;
            p3 = p2; p2 = p1; p1 = cur;
        }
    }
}
__device__ __forceinline__ int up_src_col(int n0) { return ((n0 >> 7) & 1) * 4096 + (n0 >> 8) * 128 + (n0 & 127); }
__device__ __forceinline__ void ph_convT(LAS unsigned char* lds, const float* __restrict__ W, int ldw, int src_col0, int ncols, int K, bf16_t* __restrict__ Bt, int ldd, int bid, int nblk, bool upperm = false) {
    const int tid = opaque_tid(), sub = tid >> 8, t8 = tid & 255, tx = t8 & 31, ty = t8 >> 5;
    LAS float* tile = (LAS float*)lds + sub * (32 * 33);
    const int ntx = (ncols + 31) / 32, ntiles = ntx * (K / 32);
    for (int base = bid * 2; base < ntiles; base += nblk * 2) {
        const int tl = base + sub; const bool act = tl < ntiles;
        const int n0 = (tl % ntx) * 32, k0 = (tl / ntx) * 32;
        if (act) {
#pragma unroll
            for (int i = 0; i < 4; ++i) { const int k = k0 + ty + 8 * i, n = n0 + tx; tile[(ty + 8 * i) * 33 + tx] = (n < ncols) ? W[(size_t)k * ldw + src_col0 + (upperm ? up_src_col(n0) + tx : n)] : 0.f; } }
        __syncthreads();
        if (act) {
#pragma unroll
            for (int i = 0; i < 4; ++i) { const int n = n0 + ty + 8 * i, k = k0 + tx; if (n < ncols) Bt[(size_t)n * ldd + k] = f2bf(tile[tx * 33 + ty + 8 * i]); } }
        __syncthreads();
    }
}
__device__ __forceinline__ void ph_convT8(LAS unsigned char* lds, const float* __restrict__ W, int ldw, int ncols, int K, unsigned char* __restrict__ Bt, int bid, int nblk, bool upperm = false) {
    const int tid = opaque_tid(), sub = tid >> 8, t8 = tid & 255, tx = t8 & 31, ty = t8 >> 5;
    LAS float* tile = (LAS float*)lds + sub * (32 * 33);
    const int ntx = ncols / 32, ntiles = ntx * (K / 32);
    for (int base = bid * 2; base < ntiles; base += nblk * 2) {
        const int tl = base + sub; const bool act = tl < ntiles;
        const int n0 = (tl % ntx) * 32, k0 = (tl / ntx) * 32;
        if (act) {
#pragma unroll
            for (int i = 0; i < 4; ++i) tile[(ty + 8 * i) * 33 + tx] = W[(size_t)(k0 + ty + 8 * i) * ldw + (upperm ? up_src_col(n0) : n0) + tx]; }
        __syncthreads();
        if (act) {
            const int nn = t8 >> 3, kk = (t8 & 7) * 4;
            int pk = 0;
            pk = __builtin_amdgcn_cvt_pk_fp8_f32(64.f * tile[(kk + 0) * 33 + nn], 64.f * tile[(kk + 1) * 33 + nn], pk, false);
            pk = __builtin_amdgcn_cvt_pk_fp8_f32(64.f * tile[(kk + 2) * 33 + nn], 64.f * tile[(kk + 3) * 33 + nn], pk, true);
            *(int*)(Bt + (size_t)(n0 + nn) * K + k0 + kk) = pk; }
        __syncthreads();
    }
}
template <int NC> __device__ __forceinline__ void ph_rmsnorm(const float* __restrict__ x, const float* __restrict__ g, bf16_t* __restrict__ out, int bid, int nblk) {
    const int lane = opaque_tid() & 63, w = opaque_tid() >> 6;
    constexpr int NV = NC / 256;
    for (int row = bid * 8 + w; row < NTOK; row += nblk * 8) {
        const f32x4* xr = (const f32x4*)(x + (size_t)row * NC);
        f32x4 v[NV]; float ss = 0.f;
#pragma unroll
        for (int i = 0; i < NV; ++i) { v[i] = xr[lane + 64 * i]; ss += v[i][0] * v[i][0] + v[i][1] * v[i][1] + v[i][2] * v[i][2] + v[i][3] * v[i][3]; }
        ss = wave_sum(ss);
        const float r = rsqrtf(ss * (1.0f / NC) + NORM_EPS);
#pragma unroll
        for (int i = 0; i < NV; ++i) { const f32x4 gg = ((const f32x4*)g)[lane + 64 * i]; st_bf16x4(out + (size_t)row * NC + 4 * (lane + 64 * i), v[i] * r * gg); }
    }
}
template <bool IN16, bool OUT16>
__device__ __forceinline__ void ph_resnorm(const void* xin, const bf16_t* __restrict__ m, const float* __restrict__ gpost, const float* __restrict__ gpre, void* xout, bf16_t* __restrict__ h, unsigned char* __restrict__ h8, int bid, int nblk) {
    const int tid_ = opaque_tid(), lane = tid_ & 63, w = tid_ >> 6;
    for (int row = bid * 8 + w; row < NTOK; row += nblk * 8) {
        const u32x2* mr = (const u32x2*)(m + (size_t)row * DM);
        f32x4 mv[8], xv[8]; float ss = 0.f;
#pragma unroll
        for (int i = 0; i < 8; ++i) { const u32x2 wd = mr[lane + 64 * i]; mv[i][0] = __uint_as_float(wd.x << 16); mv[i][1] = __uint_as_float(wd.x & 0xFFFF0000u); mv[i][2] = __uint_as_float(wd.y << 16); mv[i][3] = __uint_as_float(wd.y & 0xFFFF0000u);
            if (IN16) { const u32x2 xw = ((const u32x2*)((const bf16_t*)xin + (size_t)row * DM))[lane + 64 * i];
                xv[i][0] = __uint_as_float(xw.x << 16); xv[i][1] = __uint_as_float(xw.x & 0xFFFF0000u); xv[i][2] = __uint_as_float(xw.y << 16); xv[i][3] = __uint_as_float(xw.y & 0xFFFF0000u); }
            else xv[i] = ((const f32x4*)((const float*)xin + (size_t)row * DM))[lane + 64 * i];
            ss += mv[i][0] * mv[i][0] + mv[i][1] * mv[i][1] + mv[i][2] * mv[i][2] + mv[i][3] * mv[i][3]; }
        ss = wave_sum(ss);
        const float r1 = rsqrtf(ss * (1.0f / DM) + NORM_EPS);
        float s2 = 0.f;
#pragma unroll
        for (int i = 0; i < 8; ++i) { const f32x4 gg = ((const f32x4*)gpost)[lane + 64 * i]; xv[i] = xv[i] + mv[i] * r1 * gg;
            if (OUT16) st_bf16x4((bf16_t*)xout + (size_t)row * DM + 4 * (lane + 64 * i), xv[i]); else ((f32x4*)((float*)xout + (size_t)row * DM))[lane + 64 * i] = xv[i];
            s2 += xv[i][0] * xv[i][0] + xv[i][1] * xv[i][1] + xv[i][2] * xv[i][2] + xv[i][3] * xv[i][3]; }
        if (gpre) {
            s2 = wave_sum(s2);
            const float r2 = rsqrtf(s2 * (1.0f / DM) + NORM_EPS);
#pragma unroll
            for (int i = 0; i < 8; ++i) { const f32x4 gg = ((const f32x4*)gpre)[lane + 64 * i]; const f32x4 y = xv[i] * r2 * gg;
                if (h8) { int pk = 0; pk = __builtin_amdgcn_cvt_pk_fp8_f32(y[0], y[1], pk, false); pk = __builtin_amdgcn_cvt_pk_fp8_f32(y[2], y[3], pk, true); *(int*)(h8 + (size_t)row * DM + 4 * (lane + 64 * i)) = pk; }
                else st_bf16x4(h + (size_t)row * DM + 4 * (lane + 64 * i), y); }
        }
    }
}
__device__ __forceinline__ void ph_scan1(const float* __restrict__ Aa, const float* __restrict__ Bb, float* __restrict__ CA, float* __restrict__ CH, int bid, int nblk) {
    for (int i = bid * 512 + opaque_tid(); i < 2 * 256 * 1024; i += nblk * 512) {
        const int ch = i & 1023, chunk = (i >> 10) & 255, b = i >> 18;
        const size_t base = ((size_t)b * SEQ + (size_t)chunk * 64) * 1024 + ch;
        float h = 0.f, P = 1.f;
#pragma unroll 8
        for (int s = 0; s < 64; ++s) { const float a = Aa[base + (size_t)s * 1024]; h = a * h + Bb[base + (size_t)s * 1024]; P *= a; }
        CA[i] = P; CH[i] = h;
    }
}
__device__ __forceinline__ void ph_scan2(const float* __restrict__ CA, const float* __restrict__ CH, float* __restrict__ CIN, int bid, int nblk) {
    for (int i = bid * 512 + opaque_tid(); i < 2048; i += nblk * 512) {
        const int ch = i & 1023, b = i >> 10;
        float h = 0.f;
#pragma unroll 8
        for (int c = 0; c < 256; ++c) { const int j = (b * 256 + c) * 1024 + ch; CIN[j] = h; h = CA[j] * h + CH[j]; }
    }
}
__device__ __forceinline__ void ph_scan3(const float* __restrict__ Aa, const float* __restrict__ Bb, const float* __restrict__ CIN, const bf16_t* __restrict__ YG, bf16_t* __restrict__ CC, int bid, int nblk) {
    for (int i = bid * 512 + opaque_tid(); i < 2 * 256 * 1024; i += nblk * 512) {
        const int ch = i & 1023, chunk = (i >> 10) & 255, b = i >> 18;
        const size_t row0 = (size_t)b * SEQ + (size_t)chunk * 64;
        float h = CIN[i];
#pragma unroll 8
        for (int s = 0; s < 64; ++s) { const size_t r = row0 + s; h = Aa[r * 1024 + ch] * h + Bb[r * 1024 + ch];
            CC[r * 2048 + 1024 + ch] = f2bf(h * gelu_tanh(bf2f(YG[r * 1024 + ch]))); }
    }
}
__device__ __forceinline__ void ph_rope_q(bf16_t* __restrict__ Q1, const int* __restrict__ pos, int bid, int nblk) {
    for (int idx = bid * 512 + opaque_tid(); idx < NTOK * 8 * 32; idx += nblk * 512) {
        const int i = idx & 31, h = (idx >> 5) & 7, row = idx >> 8;
        float c, s; rope_cs(pos[row], i, c, s);
        bf16_t* p = Q1 + (size_t)row * 1536 + h * 192 + 128;
        const float x1 = bf2f(p[i]), x2 = bf2f(p[32 + i]);
        p[i] = f2bf(x1 * c - x2 * s); p[32 + i] = f2bf(x2 * c + x1 * s);
    }
}
__device__ __forceinline__ void ph_rope_k(const float* __restrict__ KR, const int* __restrict__ pos, bf16_t* __restrict__ K1, int bid, int nblk) {
    for (int idx = bid * 512 + opaque_tid(); idx < NTOK * 32; idx += nblk * 512) {
        const int i = idx & 31, row = idx >> 5;
        float c, s; rope_cs(pos[row], i, c, s);
        const float x1 = KR[(size_t)row * 64 + i], x2 = KR[(size_t)row * 64 + 32 + i];
        const bf16_t o1 = f2bf(x1 * c - x2 * s), o2 = f2bf(x2 * c + x1 * s);
#pragma unroll
        for (int h = 0; h < 8; ++h) { bf16_t* p = K1 + (size_t)row * 1536 + h * 192 + 128; p[i] = o1; p[32 + i] = o2; }
    }
}
template <bool OUT8> __device__ __forceinline__ void ph_ffn_gate(const bf16_t* __restrict__ HID, const float* __restrict__ cw, const float* __restrict__ cb, bf16_t* __restrict__ ACT, int bid, int nblk) {
    for (int i = bid * 512 + opaque_tid(); i < 512 * (SEQ / 64); i += nblk * 512) {
        const int c8 = (i & 511) * 8, t0 = (i >> 9) * 64;
        float wg[3][8], wv[3][8], bg[8], bv[8];
#pragma unroll
        for (int j = 0; j < 8; ++j) { bg[j] = cb[c8 + j]; bv[j] = cb[4096 + c8 + j];
#pragma unroll
            for (int k = 0; k < 3; ++k) { wg[k][j] = cw[k * 8192 + c8 + j]; wv[k][j] = cw[k * 8192 + 4096 + c8 + j]; } }
        u32x4 g2 = {0u, 0u, 0u, 0u}, g1 = g2, v2 = g2, v1 = g2;
        if (t0 >= 2) { g2 = *(const u32x4*)(HID + (size_t)(t0 - 2) * 8192 + c8); g1 = *(const u32x4*)(HID + (size_t)(t0 - 1) * 8192 + c8);
                       v2 = *(const u32x4*)(HID + (size_t)(t0 - 2) * 8192 + 4096 + c8); v1 = *(const u32x4*)(HID + (size_t)(t0 - 1) * 8192 + 4096 + c8); }
#pragma unroll 8
        for (int r = 0; r < 64; ++r) {
            const u32x4 g0 = *(const u32x4*)(HID + (size_t)(t0 + r) * 8192 + c8), v0 = *(const u32x4*)(HID + (size_t)(t0 + r) * 8192 + 4096 + c8);
            const unsigned G2[4] = {g2.x, g2.y, g2.z, g2.w}, G1[4] = {g1.x, g1.y, g1.z, g1.w}, G0[4] = {g0.x, g0.y, g0.z, g0.w};
            const unsigned V2[4] = {v2.x, v2.y, v2.z, v2.w}, V1[4] = {v1.x, v1.y, v1.z, v1.w}, V0[4] = {v0.x, v0.y, v0.z, v0.w};
            float o[8];
#pragma unroll
            for (int j = 0; j < 4; ++j) {
                const float ge = bg[2 * j] + wg[0][2 * j] * __uint_as_float(G2[j] << 16) + wg[1][2 * j] * __uint_as_float(G1[j] << 16) + wg[2][2 * j] * __uint_as_float(G0[j] << 16);
                const float go = bg[2 * j + 1] + wg[0][2 * j + 1] * __uint_as_float(G2[j] & 0xFFFF0000u) + wg[1][2 * j + 1] * __uint_as_float(G1[j] & 0xFFFF0000u) + wg[2][2 * j + 1] * __uint_as_float(G0[j] & 0xFFFF0000u);
                const float ve = bv[2 * j] + wv[0][2 * j] * __uint_as_float(V2[j] << 16) + wv[1][2 * j] * __uint_as_float(V1[j] << 16) + wv[2][2 * j] * __uint_as_float(V0[j] << 16);
                const float vo = bv[2 * j + 1] + wv[0][2 * j + 1] * __uint_as_float(V2[j] & 0xFFFF0000u) + wv[1][2 * j + 1] * __uint_as_float(V1[j] & 0xFFFF0000u) + wv[2][2 * j + 1] * __uint_as_float(V0[j] & 0xFFFF0000u);
                o[2 * j] = gelu_tanh(ge) * ve; o[2 * j + 1] = gelu_tanh(go) * vo; }
            if (OUT8) { int p0 = 0, p1 = 0;
                p0 = __builtin_amdgcn_cvt_pk_fp8_f32(o[0], o[1], p0, false); p0 = __builtin_amdgcn_cvt_pk_fp8_f32(o[2], o[3], p0, true);
                p1 = __builtin_amdgcn_cvt_pk_fp8_f32(o[4], o[5], p1, false); p1 = __builtin_amdgcn_cvt_pk_fp8_f32(o[6], o[7], p1, true);
                u32x2 ov; ov.x = (unsigned)p0; ov.y = (unsigned)p1; *(u32x2*)((unsigned char*)ACT + (size_t)(t0 + r) * 4096 + c8) = ov; }
            else { u32x4 ov; ov.x = pack2bf(o[0], o[1]); ov.y = pack2bf(o[2], o[3]); ov.z = pack2bf(o[4], o[5]); ov.w = pack2bf(o[6], o[7]);
                *(u32x4*)(ACT + (size_t)(t0 + r) * 4096 + c8) = ov; }
            g2 = g1; g1 = g0; v2 = v1; v1 = v0;
        }
    }
}

__device__ __forceinline__ void ph_conv_lru(const float* __restrict__ wa, const float* __restrict__ wx, bf16_t* __restrict__ Bt, int bid, int nblk) {
    for (int e = bid * 512 + opaque_tid(); e < 8 * 2 * 128 * 128; e += nblk * 512) {
        const int d = e & 127, c = (e >> 7) & 127, gate = (e >> 14) & 1, nb = e >> 15;
        const float v = (gate ? wx : wa)[((size_t)nb * 128 + c) * 128 + d];
        bf16_t* row = Bt + (size_t)(nb * 256 + gate * 128 + d) * 256;
        row[(nb & 1) * 128 + c] = f2bf(v); row[(1 - (nb & 1)) * 128 + c] = 0;
    }
}

static constexpr size_t MiB = 1048576;
static constexpr size_t W_UP0 = 0 * MiB, W_UP1 = 32 * MiB, W_DN0 = 64 * MiB, W_DN1 = 80 * MiB, W_ABIN = 96 * MiB, W_ABOUT = 117 * MiB, W_CDIN = 125 * MiB, W_CDOUT = 137 * MiB,
                        W_QUP = 145 * MiB, W_KVUP = 146 * MiB + 512 * 1024, W_POOL = 147 * MiB + 512 * 1024;
static constexpr size_t R_H = 148 * MiB;
static constexpr size_t R_Q0 = 276 * MiB, R_K0 = 340 * MiB, R_VT0 = 404 * MiB, R_QI = 468 * MiB, R_M0 = 468 * MiB, R_U = 596 * MiB, R_KI = 724 * MiB, R_WI = 732 * MiB, R_MASK = 734 * MiB, R_CC0 = 830 * MiB, R_POOLED = 958 * MiB;
static constexpr size_t R_HID = 276 * MiB, R_ACT = 532 * MiB, R_F = 660 * MiB, R_X3 = 788 * MiB;
static constexpr size_t R_VT1 = 276 * MiB, R_CQ = 276 * MiB, R_CKV = 340 * MiB, R_KR = 372 * MiB, R_XL = 380 * MiB, R_YG = 444 * MiB, R_CQN = 508 * MiB, R_CKVN = 540 * MiB, R_LA = 556 * MiB, R_LB = 684 * MiB,
                        R_Q1 = 812 * MiB, R_K1 = 908 * MiB, R_CA = 1004 * MiB, R_CH = 1006 * MiB, R_CIN = 1008 * MiB, R_CC1 = 148 * MiB, R_M1 = 276 * MiB, R_XCB = 148 * MiB, W_LRU = 1010 * MiB;
static constexpr size_t WS_BAR = 1022 * MiB, WS_NEED = 1022 * MiB + 65536;
static constexpr int MK_LDS = 162816;

struct MK { const float* in[28]; float* out; unsigned char* ws; int ph_lo, ph_hi; };

__global__ __launch_bounds__(512, 2) void k_mega(MK p) {
    extern __shared__ __attribute__((aligned(16))) unsigned char shm[];
    LAS unsigned char* lds = (LAS unsigned char*)shm;
    const int bid0 = (int)blockIdx.x, nblk0 = (int)gridDim.x;
    volatile LAS unsigned* xbw = (volatile LAS unsigned*)(lds + MK_LDS - 16);
    if (threadIdx.x == 0) { xbw[0] = 0u; xbw[1] = 0u; xbw[2] = 0u; xbw[3] = 0u; }
    if ((threadIdx.x & 63) == 0) *(volatile LAS int*)(size_t)(TID_TAB_LDS + 4 * ((unsigned)__builtin_amdgcn_s_getreg(((6 - 1) << 11) | 4) & 63u)) = (int)(threadIdx.x >> 6);
    __syncthreads();
    XcdBarrier bar = xcd_barrier_post((unsigned*)(p.ws + WS_BAR), xbw);
#ifndef KARG_PLAIN
#define KARG_PLAIN 0
#endif
#if KARG_PLAIN
#define KARG_DECL const MK& P_ = p;
#else
#define KARG_DECL KPtr P__ = kp; asm volatile("" : "+s"(P__)); const __attribute__((address_space(4))) MK& P_ = *P__;
#endif
    typedef const __attribute__((address_space(4))) MK* KPtr;
    KPtr kp = (KPtr)__builtin_amdgcn_kernarg_segment_ptr();
#define WSP(T, off) ((T*)(ws + (off)))
#define PHASE_BEGIN if (pc >= p.ph_lo && pc < p.ph_hi) { const int bid = opaque_s(bid0), nblk = opaque_s(nblk0); \
    KARG_DECL unsigned char* const ws = P_.ws; float* const xo = P_.out; const float* const x = P_.in[0]; const int* const positions = (const int*)P_.in[1]; \
    const float *const mix_pre_g = P_.in[2], *const mix_post_g = P_.in[3], *const ffn_pre_g = P_.in[4], *const ffn_post_g = P_.in[5], *const ffn_up = P_.in[6], *const ffn_conv_w = P_.in[7], *const ffn_conv_b = P_.in[8], *const ffn_down = P_.in[9], \
    *const ab_w_in = P_.in[10], *const pool_w = P_.in[11], *const pool_b = P_.in[12], *const pool_scale = P_.in[13], *const ab_w_out = P_.in[14], *const cd_w_in = P_.in[15], *const q_norm_g = P_.in[16], *const w_q_up = P_.in[17], \
    *const kv_norm_g = P_.in[18], *const w_kv_up = P_.in[19], *const lru_conv_w = P_.in[20], *const lru_conv_b = P_.in[21], *const lru_wa = P_.in[22], *const lru_ba = P_.in[23], *const lru_wx = P_.in[24], *const lru_bx = P_.in[25], \
    *const lru_lambda = P_.in[26], *const cd_w_out = P_.in[27]; bf16_t* const H = WSP(bf16_t, R_H); const bf16_t* const CC = WSP(bf16_t, LAYER_CC); bf16_t* const Mx = WSP(bf16_t, LAYER_MX); \
    (void)xo; (void)x; (void)positions; (void)mix_pre_g; (void)mix_post_g; (void)ffn_pre_g; (void)ffn_post_g; (void)ffn_up; (void)ffn_conv_w; (void)ffn_conv_b; (void)ffn_down; (void)ab_w_in; (void)pool_w; (void)pool_b; (void)pool_scale; \
    (void)ab_w_out; (void)cd_w_in; (void)q_norm_g; (void)w_q_up; (void)kv_norm_g; (void)w_kv_up; (void)lru_conv_w; (void)lru_conv_b; (void)lru_wa; (void)lru_ba; (void)lru_wx; (void)lru_bx; (void)lru_lambda; (void)cd_w_out; (void)H; (void)CC; (void)Mx;
#define PHASE_END } if (pc >= p.ph_lo && pc + 1 < p.ph_hi) xcd_barrier(bar); ++pc;
    int pc = 0;
#define LAYER_CC R_CC0
#define LAYER_MX R_M0
    PHASE_BEGIN
#if !((SKIPMASK >> 0) & 1)
#if FP8_UP0
        ph_convT8(lds, ffn_up, 8192, 8192, 2048, WSP(unsigned char, W_UP0), bid, nblk, true);
#else
        ph_convT(lds, ffn_up, 8192, 0, 8192, 2048, WSP(bf16_t, W_UP0), 2048, bid, nblk, true);
#endif
#if FP8_UP1
        ph_convT8(lds, ffn_up + (size_t)2048 * 8192, 8192, 8192, 2048, WSP(unsigned char, W_UP1), bid, nblk, true);
#else
        ph_convT(lds, ffn_up + (size_t)2048 * 8192, 8192, 0, 8192, 2048, WSP(bf16_t, W_UP1), 2048, bid, nblk, true);
#endif
#if FP8_DN0
        ph_convT8(lds, ffn_down, 2048, 2048, 4096, WSP(unsigned char, W_DN0), bid, nblk);
#else
        ph_convT(lds, ffn_down, 2048, 0, 2048, 4096, WSP(bf16_t, W_DN0), 4096, bid, nblk);
#endif
#if FP8_DN1
        ph_convT8(lds, ffn_down + (size_t)4096 * 2048, 2048, 2048, 4096, WSP(unsigned char, W_DN1), bid, nblk);
#else
        ph_convT(lds, ffn_down + (size_t)4096 * 2048, 2048, 0, 2048, 4096, WSP(bf16_t, W_DN1), 4096, bid, nblk);
#endif
        ph_convT(lds, ab_w_in, 5200, 0, 4096, 2048, WSP(bf16_t, W_ABIN), 2048, bid, nblk);
        ph_convT(lds, ab_w_in, 5200, 4176, 1024, 2048, WSP(bf16_t, W_ABIN) + (size_t)4096 * 2048, 2048, bid, nblk);
        ph_convT(lds, ab_w_in, 5200, 4096, 64, 2048, WSP(bf16_t, W_ABIN) + (size_t)5120 * 2048, 2048, bid, nblk);
        ph_convT(lds, ab_w_in, 5200, 4160, 16, 2048, WSP(bf16_t, W_ABIN) + (size_t)5184 * 2048, 2048, bid, nblk);
        ph_convT(lds, ab_w_out, 2048, 0, 2048, 2048, WSP(bf16_t, W_ABOUT), 2048, bid, nblk);
        ph_convT(lds, cd_w_in, 2880, 0, 832, 2048, WSP(bf16_t, W_CDIN), 2048, bid, nblk);
        ph_convT(lds, cd_w_in, 2880, 832, 2048, 2048, WSP(bf16_t, W_CDIN) + (size_t)1024 * 2048, 2048, bid, nblk);
        ph_convT(lds, cd_w_out, 2048, 0, 2048, 2048, WSP(bf16_t, W_CDOUT), 2048, bid, nblk);
        ph_convT(lds, w_q_up, 1536, 0, 1536, 512, WSP(bf16_t, W_QUP), 512, bid, nblk);
        ph_convT(lds, w_kv_up, 2048, 0, 2048, 256, WSP(bf16_t, W_KVUP), 256, bid, nblk);
        for (int g = 0; g < 4; ++g) ph_convT(lds, pool_w + (size_t)g * 65536, 256, 0, 256, 256, WSP(bf16_t, W_POOL) + (size_t)g * 65536, 256, bid, nblk);
        ph_rmsnorm<2048>(x, mix_pre_g, H, bid, nblk);
#endif
    PHASE_END
    {
            PHASE_BEGIN
#if !((SKIPMASK >> 1) & 1)
                FAbIn2 f; f.Q = WSP(bf16_t, R_Q0); f.K = WSP(bf16_t, R_K0); f.VT = WSP(bf16_t, R_VT0); f.QI = WSP(float, R_QI); f.U = WSP(float, R_U); f.WI = WSP(float, R_WI); f.KI16 = WSP(unsigned short, R_KI);
                ph_gemm(lds, H, 2048, WSP(bf16_t, W_ABIN), 2048, NTOK, 5376, 2048, f, bid, nblk);
#endif
            PHASE_END
            PHASE_BEGIN
#if !((SKIPMASK >> 2) & 1)
                ph_pooled(WSP(float, R_U), WSP(bf16_t, R_POOLED), bid, nblk);
                IdxArgs a; a.QI = WSP(float, R_QI); a.KI16 = WSP(unsigned short, R_KI); a.WI = WSP(float, R_WI); a.MT = WSP(unsigned long long, R_MASK);
                idx_phase(lds, a, bid, nblk);
#endif
            PHASE_END
            PHASE_BEGIN
#if !((SKIPMASK >> 3) & 1)
                { FPool f; f.CC = WSP(bf16_t, R_CC0); f.pb = pool_b; f.ps = pool_scale; ph_gemm(lds, WSP(bf16_t, R_POOLED), 1024, WSP(bf16_t, W_POOL), 256, NTOK, 1024, 256, f, bid, nblk, 0, 512); }
                AttnArgs a; a.Q = WSP(bf16_t, R_Q0); a.K = WSP(bf16_t, R_K0); a.VT = WSP(bf16_t, R_VT0); a.MT = WSP(unsigned long long, R_MASK); a.O = WSP(bf16_t, R_CC0); a.ldq = 1024; a.ldk = 1024; a.ldo = 2048;
                a.sc_log2e = 0.08838834764831845f * 1.4426950408889634f;
                attn_phase<128, true>(lds, a, bid, nblk);
#endif
            PHASE_END
        PHASE_BEGIN
#if !((SKIPMASK >> 4) & 1)
            FStoreBf16 f; f.O = Mx; f.ldc = 2048; f.pad_ = 0;
            ph_gemm(lds, CC, 2048, WSP(bf16_t, W_ABOUT), 2048, NTOK, 2048, 2048, f, bid, nblk);
#endif
        PHASE_END
        PHASE_BEGIN
#if !((SKIPMASK >> 5) & 1)
            ph_resnorm<false, true>(x, Mx, mix_post_g + 0, ffn_pre_g + 0, xo, H, FP8_UP0 ? WSP(unsigned char, R_H) : (unsigned char*)nullptr, bid, nblk);
#endif
        PHASE_END
        PHASE_BEGIN
#if FP8_UP0
            { EpiGate<FP8_DN0 != 0, true> ep; ep.cw = ffn_conv_w + 0; ep.cb = ffn_conv_b + 0; ep.ACT = WSP(void, R_HID);
              ph_gemm_e(lds, (const bf16_t*)WSP(unsigned char, R_H), 1024, (const bf16_t*)WSP(unsigned char, W_UP0), 1024, 134 * 256, 8192, 1024, ep, bid, nblk, 0, 0, 1); }
#else
            { EpiGate<FP8_DN0 != 0, false> ep; ep.cw = ffn_conv_w + 0; ep.cb = ffn_conv_b + 0; ep.ACT = WSP(void, R_HID);
              ph_gemm_e(lds, H, 2048, WSP(bf16_t, W_UP0), 2048, 134 * 256, 8192, 2048, ep, bid, nblk, 0, 0, 1); }
#endif
        PHASE_END
        PHASE_BEGIN
            FStoreBf16 f; f.O = WSP(bf16_t, R_F); f.ldc = 2048; f.pad_ = 0;
#if FP8_DN0
            ph_gemm8(lds, WSP(unsigned char, R_HID), 4096, WSP(unsigned char, W_DN0), 4096, NTOK, 2048, 4096, f, bid, nblk);
#else
            ph_gemm(lds, WSP(bf16_t, R_HID), 4096, WSP(bf16_t, W_DN0), 4096, NTOK, 2048, 4096, f, bid, nblk);
#endif
        PHASE_END
        PHASE_BEGIN
#if !((SKIPMASK >> 9) & 1)
            ph_resnorm<true, true>(xo, WSP(bf16_t, R_F), ffn_post_g + 0, mix_pre_g + 2048, xo, H, nullptr, bid, nblk);
#endif
        PHASE_END
    }
    {
#undef LAYER_CC
#undef LAYER_MX
#define LAYER_CC R_CC1
#define LAYER_MX R_M1
            PHASE_BEGIN
#if !((SKIPMASK >> 10) & 1)
                FCdIn f; f.CQ = WSP(float, R_CQ); f.CKV = WSP(float, R_CKV); f.KR = WSP(float, R_KR); f.XL = WSP(bf16_t, R_XL); f.YG = WSP(bf16_t, R_YG);
                ph_gemm(lds, H, 2048, WSP(bf16_t, W_CDIN), 2048, NTOK, 3072, 2048, f, bid, nblk);
#endif
            PHASE_END
            PHASE_BEGIN
#if !((SKIPMASK >> 11) & 1)
                ph_xc(WSP(bf16_t, R_XL), lru_conv_w, lru_conv_b, WSP(bf16_t, R_XCB), bid, nblk);
                ph_conv_lru(lru_wa, lru_wx, WSP(bf16_t, W_LRU), bid, nblk);
                ph_rmsnorm<512>(WSP(float, R_CQ), q_norm_g, WSP(bf16_t, R_CQN), bid, nblk);
                ph_rmsnorm<256>(WSP(float, R_CKV), kv_norm_g, WSP(bf16_t, R_CKVN), bid, nblk);
            PHASE_END
            PHASE_BEGIN
                { EpiLru ep; ep.XCB = WSP(bf16_t, R_XCB); ep.ba = lru_ba; ep.bx = lru_bx; ep.lam = lru_lambda; ep.LA = WSP(float, R_LA); ep.LB = WSP(float, R_LB);
                  ph_gemm_e(lds, WSP(bf16_t, R_XCB), 1024, WSP(bf16_t, W_LRU), 256, NTOK, 2048, 256, ep, bid, nblk, 1, 512); }
                { FStoreBf16 f; f.O = WSP(bf16_t, R_Q1); f.ldc = 1536; f.pad_ = 0; ph_gemm(lds, WSP(bf16_t, R_CQN), 512, WSP(bf16_t, W_QUP), 512, NTOK, 1536, 512, f, bid, nblk); }
                { FKvUp2 f; f.K1 = WSP(bf16_t, R_K1); f.VT = WSP(bf16_t, R_VT1); ph_gemm(lds, WSP(bf16_t, R_CKVN), 256, WSP(bf16_t, W_KVUP), 256, NTOK, 2048, 256, f, bid, nblk); }
            PHASE_END
            PHASE_BEGIN
                ph_scan1(WSP(float, R_LA), WSP(float, R_LB), WSP(float, R_CA), WSP(float, R_CH), bid, nblk);
                ph_rope_q(WSP(bf16_t, R_Q1), positions, bid, nblk);
                ph_rope_k(WSP(float, R_KR), positions, WSP(bf16_t, R_K1), bid, nblk);
            PHASE_END
            PHASE_BEGIN
                ph_scan2(WSP(float, R_CA), WSP(float, R_CH), WSP(float, R_CIN), bid, nblk);
            PHASE_END
            PHASE_BEGIN
                ph_scan3(WSP(float, R_LA), WSP(float, R_LB), WSP(float, R_CIN), WSP(bf16_t, R_YG), WSP(bf16_t, R_CC1), bid, nblk);
                AttnArgs a; a.Q = WSP(bf16_t, R_Q1); a.K = WSP(bf16_t, R_K1); a.VT = WSP(bf16_t, R_VT1); a.MT = nullptr; a.O = WSP(bf16_t, R_CC1); a.ldq = 1536; a.ldk = 1536; a.ldo = 2048;
                a.sc_log2e = 0.07216878364870322f * 1.4426950408889634f;
                attn_phase<192, false>(lds, a, bid, nblk);
#endif
            PHASE_END
        PHASE_BEGIN
#if !((SKIPMASK >> 15) & 1)
            FStoreBf16 f; f.O = Mx; f.ldc = 2048; f.pad_ = 0;
            ph_gemm(lds, CC, 2048, WSP(bf16_t, W_CDOUT), 2048, NTOK, 2048, 2048, f, bid, nblk);
#endif
        PHASE_END
        PHASE_BEGIN
#if !((SKIPMASK >> 16) & 1)
            ph_resnorm<true, true>(xo, Mx, mix_post_g + 2048, ffn_pre_g + 2048, WSP(bf16_t, R_X3), H, FP8_UP1 ? WSP(unsigned char, R_H) : (unsigned char*)nullptr, bid, nblk);
#endif
        PHASE_END
        PHASE_BEGIN
#if FP8_UP1
            { EpiGate<FP8_DN1 != 0, true> ep; ep.cw = ffn_conv_w + 24576; ep.cb = ffn_conv_b + 8192; ep.ACT = WSP(void, R_HID);
              ph_gemm_e(lds, (const bf16_t*)WSP(unsigned char, R_H), 1024, (const bf16_t*)WSP(unsigned char, W_UP1), 1024, 134 * 256, 8192, 1024, ep, bid, nblk, 0, 0, 1); }
#else
            { EpiGate<FP8_DN1 != 0, false> ep; ep.cw = ffn_conv_w + 24576; ep.cb = ffn_conv_b + 8192; ep.ACT = WSP(void, R_HID);
              ph_gemm_e(lds, H, 2048, WSP(bf16_t, W_UP1), 2048, 134 * 256, 8192, 2048, ep, bid, nblk, 0, 0, 1); }
#endif
        PHASE_END
        PHASE_BEGIN
            FStoreBf16 f; f.O = WSP(bf16_t, R_F); f.ldc = 2048; f.pad_ = 0;
#if FP8_DN1
            ph_gemm8(lds, WSP(unsigned char, R_HID), 4096, WSP(unsigned char, W_DN1), 4096, NTOK, 2048, 4096, f, bid, nblk);
#else
            ph_gemm(lds, WSP(bf16_t, R_HID), 4096, WSP(bf16_t, W_DN1), 4096, NTOK, 2048, 4096, f, bid, nblk);
#endif
        PHASE_END
        PHASE_BEGIN
#if !((SKIPMASK >> 20) & 1)
            ph_resnorm<true, false>(WSP(bf16_t, R_X3), WSP(bf16_t, R_F), ffn_post_g + 2048, (const float*)nullptr, xo, H, nullptr, bid, nblk);
#endif
        PHASE_END
    }
#undef LAYER_CC
#undef LAYER_MX
#undef WSP
#undef PHASE_BEGIN
#undef PHASE_END
}

#ifndef MK_N_LAUNCHES
#define MK_N_LAUNCHES 1
#endif
static constexpr int MK_NPHASES = 1 + 3 + 7 + 2 * 5;

extern "C" void kernel_launch(void* const* d_in, const int* in_sizes, int n_in, void* d_out, int out_size, void* d_ws, size_t ws_size, hipStream_t stream) {
    static int grid = 0;
    if (grid == 0) {
        if (n_in != 28 || out_size != NTOK * DM || ws_size < WS_NEED) { fprintf(stderr, "kernel_launch: unexpected shapes (n_in %d out %d ws %zu)\n", n_in, out_size, ws_size); grid = -1; return; }
        int dev = 0, cus = 0, per_cu = 0;
        if (hipGetDevice(&dev) != hipSuccess || hipDeviceGetAttribute(&cus, hipDeviceAttributeMultiprocessorCount, dev) != hipSuccess) { grid = -1; return; }
        if (hipFuncSetAttribute((const void*)k_mega, hipFuncAttributeMaxDynamicSharedMemorySize, MK_LDS) != hipSuccess) { fprintf(stderr, "kernel_launch: hipFuncSetAttribute failed\n"); grid = -1; return; }
        if (hipOccupancyMaxActiveBlocksPerMultiprocessor(&per_cu, (const void*)k_mega, 512, MK_LDS) != hipSuccess || per_cu < 1) { fprintf(stderr, "kernel_launch: occupancy query says %d\n", per_cu); }
        (void)hipGetLastError();
        grid = cus;
        if (grid != 256) { fprintf(stderr, "kernel_launch: built for 256 CUs, found %d\n", grid); grid = -1; return; }
    }
    if (grid < 0) return;
    unsigned char* ws = (unsigned char*)d_ws;
    (void)hipMemsetAsync(ws + WS_BAR, 0, XCD_BAR_WORDS * sizeof(unsigned), stream);
    (void)hipMemsetAsync(ws + W_ABIN + (size_t)5200 * 2048 * 2, 0, (size_t)176 * 2048 * 2, stream);
    (void)hipMemsetAsync(ws + W_CDIN + (size_t)832 * 2048 * 2, 0, (size_t)192 * 2048 * 2, stream);
    MK p{};
    for (int i = 0; i < 28; ++i) p.in[i] = (const float*)d_in[i];
    p.out = (float*)d_out; p.ws = ws;
#if MK_N_LAUNCHES == 1
    p.ph_lo = 0; p.ph_hi = 1 << 20;
    hipLaunchKernelGGL(k_mega, dim3(grid), dim3(512), MK_LDS, stream, p);
#else
    for (int ph = 0; ph < MK_NPHASES; ++ph) { p.ph_lo = ph; p.ph_hi = ph + 1; hipLaunchKernelGGL(k_mega, dim3(grid), dim3(512), MK_LDS, stream, p); }
#endif
}
```

```cpp
#include <hip/hip_runtime.h>
#include <stdint.h>
#include <stdio.h>

#define LAS __attribute__((address_space(3)))
typedef unsigned short bf16_t;
typedef float f32x4 __attribute__((ext_vector_type(4)));
typedef unsigned u32x4 __attribute__((ext_vector_type(4)));
typedef unsigned u32x2 __attribute__((ext_vector_type(2)));

static constexpr int NTOK = 32768, SEQ = 16384, NBATCH = 2, DM = 2048, DFF = 4096;
static constexpr float NORM_EPS = 1e-6f;

__device__ __forceinline__ bf16_t f2bf(float f) { unsigned u = __float_as_uint(f); u += 0x7FFFu + ((u >> 16) & 1u); return (bf16_t)(u >> 16); }
__device__ __forceinline__ float bf2f(bf16_t b) { return __uint_as_float(((unsigned)b) << 16); }
__device__ __forceinline__ unsigned pack2bf(float lo, float hi) { return (unsigned)f2bf(lo) | ((unsigned)f2bf(hi) << 16); }
__device__ __forceinline__ float gelu_tanh(float x) { const float u = 0.7978845608028654f * (x + 0.044715f * x * x * x); return 0.5f * x * (1.0f + tanhf(u)); }
__device__ __forceinline__ float wave_sum(float v) {
#pragma unroll
    for (int o = 32; o >= 1; o >>= 1) v += __shfl_xor(v, o);
    return v;
}

#ifndef TID_PLAIN
#define TID_PLAIN 0
#endif
static constexpr int TID_TAB_LDS = 162816 - 16 - 256;
#if TID_PLAIN
__device__ __forceinline__ int opaque_tid() { int t = (int)threadIdx.x; asm volatile("" : "+v"(t)); return t; }
#else
__device__ __forceinline__ int opaque_tid() {
    const unsigned slot = (unsigned)__builtin_amdgcn_s_getreg(((6 - 1) << 11) | 4) & 63u;
    const int w = __builtin_amdgcn_readfirstlane(*(const volatile LAS int*)(size_t)(TID_TAB_LDS + 4 * slot));
    int lane; asm volatile("v_mbcnt_lo_u32_b32 %0, -1, 0\n\tv_mbcnt_hi_u32_b32 %0, -1, %0" : "=v"(lane));
    return w * 64 + lane;
}
#endif

__device__ __forceinline__ int opaque_s(int v) { asm volatile("" : "+s"(v)); return v; }

template <class T> __device__ __forceinline__ const T* opaque_p(const T* p) { asm volatile("" : "+s"(p)); return p; }

#ifndef PG8_EPI_RECOMP
#define PG8_EPI_RECOMP 1
#endif
#ifndef PG8_ASM_DMA
#define PG8_ASM_DMA 1
#endif
#include <hip/hip_runtime.h>
namespace pg8 {
#define PG8_LAS __attribute__((address_space(3)))
typedef unsigned short bf16_t;
typedef short bf16x8 __attribute__((ext_vector_type(8)));
typedef float f32x4 __attribute__((ext_vector_type(4)));
typedef unsigned u32x4 __attribute__((ext_vector_type(4)));
typedef int i32x8 __attribute__((ext_vector_type(8)));
typedef int i32x4 __attribute__((ext_vector_type(4)));
constexpr int BM = 256, BK = 64, HALF = 128, HTB = HALF * BK * 2  , STAGE_BYTES = 8 * HTB, NXCD = 8, WGM = 8;

__host__ __device__ __forceinline__ int lds_byte(int r, int c) { const int st = (r >> 4) * 2 + (c >> 5), rr = r & 15, cc = c & 31, ob = rr * 64 + cc * 2; return st * 1024 + (ob ^ (((ob >> 9) & 1) << 5)); }
__host__ __device__ __forceinline__ void stage_rc(int b, int& R, int& C) { const int st = b / 1024, sb = b % 1024, swz = sb ^ (((sb >> 9) & 1) << 5); R = (st >> 1) * 16 + swz / 64; C = (st & 1) * 32 + (swz % 64) / 2; }
__host__ __device__ __forceinline__ int perm32(int rho) { const int n = rho >> 4, i = rho & 15; return 8 * (i >> 2) + 4 * n + (i & 3); }

struct Unit { int pm, pn; };
struct Gemm { const bf16_t* A; const bf16_t* Bt; int M, N, K, lda, ldb, a_shift, a_bytes, cmode; };

struct StaticOrder {
    int nM, nN, nwg, G, c;
    __host__ __device__ void init(int M, int N, int G_, int c_) { nM = M / BM; nN = N / BM; nwg = nM * nN; G = G_; c = c_; }
    __host__ __device__ bool next(int i, Unit& u) const {
        const long L = (long)i * G + c; if (L >= nwg) return false;
        int wgid = (int)L; { const int q = nwg / NXCD, r = nwg % NXCD, xcd = wgid % NXCD, off = wgid / NXCD; wgid = (xcd < r ? xcd * (q + 1) : r * (q + 1) + (xcd - r) * q) + off; }
        const int nig = WGM * nN, gid = wgid / nig, fm = gid * WGM, gsz = (nM - fm) < WGM ? (nM - fm) : WGM;
        u.pm = fm + ((wgid % nig) % gsz); u.pn = (wgid % nig) / gsz; return true;
    }
    __device__ __forceinline__ void a_ready(const Unit&) const {}
    __device__ __forceinline__ void done(const Unit&) const {}
};

template <class Epi, class Sched, bool STAMP = false>
__device__ __forceinline__ void gemm_phase(PG8_LAS unsigned char* lds, const Gemm g, const Sched& S, const Epi& E, unsigned long long* stamps) {
    const int tid = opaque_tid(), wid = __builtin_amdgcn_readfirstlane(tid >> 6), lane = tid & 63, wr = wid >> 2, wc = wid & 3, fr = lane & 15, fq = lane >> 4;
    const int K = g.K, nt = K / BK;
    int ts_lo = 0, ts_hi = 0, nts = 0; const unsigned long long rt_entry = STAMP ? (unsigned long long)wall_clock64() : 0ull;
#define PG8_STAMP() do { if (STAMP && wid == 0 && nts < 64) { const unsigned long long _c = (unsigned long long)clock64(); \
        ts_lo = (lane == nts) ? (int)(unsigned)_c : ts_lo; ts_hi = (lane == nts) ? (int)(unsigned)(_c >> 32) : ts_hi; ++nts; } } while (0)
    PG8_STAMP();
    unsigned voffA[2], voffB[2];
#pragma unroll
    for (int i = 0; i < 2; ++i) { int R, C; stage_rc(tid * 16 + i * 8192, R, C); const int Rb = Epi::PERM ? ((R & ~31) + perm32(R & 31)) : R;
        const int Ra = g.cmode ? (R - 2 * (R >> 6)) : R;
        voffA[i] = (unsigned)(Ra * g.lda + C) * 2u; voffB[i] = (unsigned)(Rb * g.ldb + C) * 2u; }
    const size_t kstep = (size_t)(BK * 2);
    const size_t hstepA = (size_t)(g.cmode ? HALF - 4 : HALF) * g.lda * 2, hstepB = (size_t)HALF * g.ldb * 2;
    const size_t tstepA = 2 * hstepA, tstepB = 2 * hstepB;
    const unsigned ldsbase_ = (unsigned)(size_t)lds;
    const int sc_w_ = 0x79797979, sc_a_ = 0x7F7F7F7F;
    (void)sc_w_; (void)sc_a_;
    const unsigned ldsw = (unsigned)wid * 1024u;
    const int aoff = lds_byte(wr * 64 + fr, fq * 8), boff = lds_byte(wc * 32 + fr, fq * 8);
#define PG8_SA(b, h) (((b) * 2 + (h)) * HTB)
#define PG8_SB(b, h) ((4 + (b) * 2 + (h)) * HTB)
#if PG8_ASM_DMA
#define PG8_STAGE(bufoff, gbase, voff) do { _Pragma("unroll") for (int _i = 0; _i < 2; ++_i) { unsigned keep_; \
        asm volatile("s_mov_b32 %0, m0\n\ts_mov_b32 m0, %3\n\ts_nop 0\n\tglobal_load_lds_dwordx4 %1, %2\n\ts_mov_b32 m0, %0" \
                     : "=&s"(keep_) : "v"((voff)[_i]), "s"((const char*)(gbase)), "s"(ldsbase_ + (unsigned)(bufoff) + ldsw + (unsigned)(_i * 8192)) : "memory"); } } while (0)
#else
#define PG8_STAGE(bufoff, gbase, voff) do { _Pragma("unroll") for (int _i = 0; _i < 2; ++_i) \
        __builtin_amdgcn_global_load_lds((const unsigned*)((const char*)(gbase) + (voff)[_i]), (PG8_LAS unsigned*)(lds + (bufoff) + ldsw + _i * 8192), 16, 0, 0); } while (0)
#endif
#define PG8_LDA(dst, b, h) do { _Pragma("unroll") for (int m = 0; m < 4; ++m) { dst[m].lo = *(const PG8_LAS i32x4*)(lds + PG8_SA(b, h) + aoff + m * 2048); dst[m].hi = *(const PG8_LAS i32x4*)(lds + PG8_SA(b, h) + aoff + m * 2048 + 1024); } } while (0)
#define PG8_LDB(dst, b, h) do { _Pragma("unroll") for (int n = 0; n < 2; ++n) { dst[n].lo = *(const PG8_LAS i32x4*)(lds + PG8_SB(b, h) + boff + n * 2048); dst[n].hi = *(const PG8_LAS i32x4*)(lds + PG8_SB(b, h) + boff + n * 2048 + 1024); } } while (0)
#define PG8_MMA(ai, bj, At, Bt) do { __builtin_amdgcn_s_setprio(1); \
        if constexpr (Epi::FP8) { _Pragma("unroll") for (int m = 0; m < 4; ++m) _Pragma("unroll") for (int n = 0; n < 2; ++n) \
            asm volatile("v_mfma_scale_f32_16x16x128_f8f6f4 %0, %1, %2, %0, %3, %4 op_sel_hi:[0,0,0]" : "+v"(acc[ai][bj][m][n]) : "v"(Bt[n]), "v"(At[m]), "v"(sc_w_), "v"(sc_a_)); } \
        else { _Pragma("unroll") for (int m = 0; m < 4; ++m) _Pragma("unroll") for (int n = 0; n < 2; ++n) { \
            const i32x4 bl_ = Bt[n].lo, bh_ = Bt[n].hi, al_ = At[m].lo, ah_ = At[m].hi;     \
            acc[ai][bj][m][n] = __builtin_amdgcn_mfma_f32_16x16x32_bf16(__builtin_bit_cast(bf16x8, bl_), __builtin_bit_cast(bf16x8, al_), acc[ai][bj][m][n], 0, 0, 0); \
            acc[ai][bj][m][n] = __builtin_amdgcn_mfma_f32_16x16x32_bf16(__builtin_bit_cast(bf16x8, bh_), __builtin_bit_cast(bf16x8, ah_), acc[ai][bj][m][n], 0, 0, 0); } } \
        __builtin_amdgcn_s_setprio(0); } while (0)
#define PG8_WAIT_V(n) asm volatile("s_waitcnt vmcnt(" #n ")" ::: "memory")
#define PG8_WAIT_L(n) asm volatile("s_waitcnt lgkmcnt(" #n ")" ::: "memory")
#define PG8_BAR __builtin_amdgcn_s_barrier()
#define PG8_SCHED __builtin_amdgcn_sched_barrier(0)
    Unit cur, nxt; int ui = 0;
    if (!S.next(0, cur)) return;
    f32x4 acc[2][2][4][2];
#pragma unroll
    for (int a = 0; a < 2; ++a)
#pragma unroll
        for (int b = 0; b < 2; ++b)
#pragma unroll
            for (int m = 0; m < 4; ++m)
#pragma unroll
                for (int n = 0; n < 2; ++n) acc[a][b][m][n] = (f32x4){0.f, 0.f, 0.f, 0.f};
    i32x8 At[4], B0[2], B1[2];
    auto a_base_ = [&](const Unit& u_) -> const char* { return g.cmode ? (const char*)g.A + ((long)(u_.pm / 67) * 16384 + (long)(u_.pm % 67) * 248 - 2) * (long)g.lda * 2 : (const char*)g.A + (size_t)u_.pm * tstepA + (size_t)(u_.pn >> g.a_shift) * g.a_bytes; };
    const char* cA = a_base_(cur); const char* cB = (const char*)g.Bt + (size_t)cur.pn * tstepB;
    S.a_ready(cur);
    PG8_STAGE(PG8_SB(0, 0), cB, voffB); PG8_STAGE(PG8_SA(0, 0), cA, voffA); PG8_STAGE(PG8_SB(0, 1), cB + hstepB, voffB); PG8_STAGE(PG8_SA(0, 1), cA + hstepA, voffA);
    if (wr == 1) PG8_BAR;
    PG8_WAIT_V(4); PG8_BAR;
    PG8_STAGE(PG8_SB(1, 0), cB + kstep, voffB); PG8_STAGE(PG8_SA(1, 0), cA + kstep, voffA); PG8_STAGE(PG8_SB(1, 1), cB + hstepB + kstep, voffB);
    PG8_WAIT_V(6); PG8_BAR;
    PG8_STAMP();
    for (;;) {
        const bool has_next = S.next(ui + 1, nxt);
        const char* nA = has_next ? a_base_(nxt) : cA; const char* nB = has_next ? (const char*)g.Bt + (size_t)nxt.pn * tstepB : cB;
        for (int t = 0; t < nt; t += 2) {
            const bool last = (t == nt - 2);
            const char* a1 = cA + (size_t)(t + 1) * kstep;
            const char* a2 = last ? nA : cA + (size_t)(t + 2) * kstep; const char* b2 = last ? nB : cB + (size_t)(t + 2) * kstep;
            const char* a3 = a2 + kstep; const char* b3 = b2 + kstep;
            if (last && has_next) S.a_ready(nxt);
            PG8_LDB(B0, 0, 0); PG8_SCHED; PG8_LDA(At, 0, 0); PG8_STAGE(PG8_SA(1, 1), a1 + hstepA, voffA);
            PG8_WAIT_L(8); PG8_BAR; PG8_WAIT_L(0); PG8_MMA(0, 0, At, B0); PG8_BAR; PG8_SCHED;
            PG8_LDB(B1, 0, 1); PG8_STAGE(PG8_SB(0, 0), b2, voffB);
            PG8_BAR; PG8_WAIT_L(0); PG8_MMA(0, 1, At, B1); PG8_BAR;
            PG8_LDA(At, 0, 1); PG8_STAGE(PG8_SA(0, 0), a2, voffA);
            PG8_BAR; PG8_WAIT_L(0); PG8_MMA(1, 0, At, B0); PG8_BAR; PG8_SCHED;
            PG8_STAGE(PG8_SB(0, 1), b2 + hstepB, voffB);
            PG8_WAIT_V(6); PG8_BAR; PG8_MMA(1, 1, At, B1); PG8_BAR;
            PG8_LDB(B0, 1, 0); PG8_SCHED; PG8_LDA(At, 1, 0); PG8_STAGE(PG8_SA(0, 1), a2 + hstepA, voffA);
            PG8_WAIT_L(8); PG8_BAR; PG8_WAIT_L(0); PG8_MMA(0, 0, At, B0); PG8_BAR; PG8_SCHED;
            PG8_LDB(B1, 1, 1); PG8_STAGE(PG8_SB(1, 0), b3, voffB);
            PG8_BAR; PG8_WAIT_L(0); PG8_MMA(0, 1, At, B1); PG8_BAR;
            PG8_LDA(At, 1, 1); PG8_STAGE(PG8_SA(1, 0), a3, voffA);
            PG8_BAR; PG8_WAIT_L(0); PG8_MMA(1, 0, At, B0); PG8_BAR; PG8_SCHED;
            PG8_STAGE(PG8_SB(1, 1), b3 + hstepB, voffB);
            PG8_WAIT_V(6); PG8_BAR; PG8_MMA(1, 1, At, B1); PG8_BAR;
        }
        PG8_STAMP();
        if constexpr (Epi::FP8) { asm volatile("s_nop 15\n\ts_nop 15" ::: "memory"); }
        if constexpr (!Epi::AFTER_DRAIN) {
#if PG8_EPI_RECOMP
            const int t2_ = opaque_tid(), l2_ = t2_ & 63, w2_ = __builtin_amdgcn_readfirstlane(t2_ >> 6);
            E(acc, cur, w2_ >> 2, w2_ & 3, l2_ & 15, l2_ >> 4); S.done(cur);
#else
            E(acc, cur, wr, wc, fr, fq); S.done(cur);
#endif
        }
        PG8_STAMP();
        if (!has_next) break;
#pragma unroll
        for (int a = 0; a < 2; ++a)
#pragma unroll
            for (int b = 0; b < 2; ++b)
#pragma unroll
                for (int m = 0; m < 4; ++m)
#pragma unroll
                    for (int n = 0; n < 2; ++n) acc[a][b][m][n] = (f32x4){0.f, 0.f, 0.f, 0.f};
        cur = nxt; cA = nA; cB = nB; ++ui;
    }
    PG8_WAIT_V(0);
    if (wr == 0) PG8_BAR;
    PG8_BAR;
    if constexpr (Epi::AFTER_DRAIN) { E.fused(acc, cur, wr, wc, fr, fq, lds, wid, lane); S.done(cur); }
    PG8_STAMP();
    if (STAMP && wid == 0) { stamps[lane] = lane < nts ? (((unsigned long long)(unsigned)ts_hi << 32) | (unsigned)ts_lo) : 0ull;
        if (lane == 62) stamps[62] = rt_entry; if (lane == 63) stamps[63] = (unsigned long long)wall_clock64(); }
#undef PG8_STAMP
#undef PG8_SA
#undef PG8_SB
#undef PG8_STAGE
#undef PG8_LDA
#undef PG8_LDB
#undef PG8_MMA
#undef PG8_WAIT_V
#undef PG8_WAIT_L
#undef PG8_BAR
#undef PG8_SCHED
}
}

#include <cstdio>
#include <ctime>
#include <cstdlib>
#include <cstring>
#include <cmath>
#include <vector>

template <class F, bool F8 = false> struct EpiG {
    static constexpr bool PERM = false, AFTER_DRAIN = false, FP8 = F8;
    F f;
    __device__ __forceinline__ void operator()(const f32x4 (&acc)[2][2][4][2], const pg8::Unit& u, int wr, int wc, int fr, int fq) const {
        const int row0 = u.pm * 256 + wr * 64 + fr, col0 = u.pn * 256 + wc * 32 + 4 * fq;
#pragma unroll
        for (int ai = 0; ai < 2; ++ai)
#pragma unroll
            for (int m = 0; m < 4; ++m)
#pragma unroll
                for (int bj = 0; bj < 2; ++bj)
#pragma unroll
                    for (int n = 0; n < 2; ++n) f(row0 + ai * 128 + m * 16, col0 + bj * 128 + n * 16, acc[ai][bj][m][n]);
    }
};
__device__ __forceinline__ void st_bf16x4(bf16_t* p, f32x4 v) { u32x2 w; w.x = pack2bf(v[0], v[1]); w.y = pack2bf(v[2], v[3]); *(u32x2*)p = w; }
__device__ __forceinline__ void st_f32x4(float* p, f32x4 v) { *(f32x4*)p = v; }

struct FStoreBf16 { bf16_t* O; int ldc; int pad_; __device__ __forceinline__ void operator()(int r, int c, f32x4 v) const { st_bf16x4(O + (size_t)r * ldc + c, v); } };
struct FAbIn { bf16_t *Q, *K, *V; float *QI, *U, *WI; unsigned short* KI16;
    __device__ __forceinline__ void operator()(int r, int c, f32x4 v) const {
        if (c < 1024) st_bf16x4(Q + (size_t)r * 1024 + c, v);
        else if (c < 2048) st_bf16x4(K + (size_t)r * 1024 + (c - 1024), v);
        else if (c < 3072) st_bf16x4(V + (size_t)r * 1024 + (c - 2048), v);
        else if (c < 4096) st_f32x4(QI + (size_t)r * 1024 + (c - 3072), v);
        else if (c < 5120) st_f32x4(U + (size_t)r * 1024 + (c - 4096), v);
        else if (c < 5184) { typedef _Float16 h2 __attribute__((ext_vector_type(2))); union { h2 h; unsigned u; } a, b; a.h = (h2){(_Float16)v[0], (_Float16)v[1]}; b.h = (h2){(_Float16)v[2], (_Float16)v[3]};
            u32x2 w; w.x = a.u; w.y = b.u; *(u32x2*)(KI16 + (size_t)r * 64 + (c - 5120)) = w; }
        else if (c < 5200) st_f32x4(WI + (size_t)r * 16 + (c - 5184), v);
    } };
struct FCdIn { float *CQ, *CKV, *KR; bf16_t *XL, *YG;
    __device__ __forceinline__ void operator()(int r, int c, f32x4 v) const {
        if (c < 512) st_f32x4(CQ + (size_t)r * 512 + c, v);
        else if (c < 768) st_f32x4(CKV + (size_t)r * 256 + (c - 512), v);
        else if (c < 832) st_f32x4(KR + (size_t)r * 64 + (c - 768), v);
        else if (c < 1024) {}
        else if (c < 2048) st_bf16x4(XL + (size_t)r * 1024 + (c - 1024), v);
        else st_bf16x4(YG + (size_t)r * 1024 + (c - 2048), v);
    } };
struct FKvUp { bf16_t *K1, *V1;
    __device__ __forceinline__ void operator()(int r, int c, f32x4 v) const {
        const int h = c >> 8, d = c & 255;
        if (d < 128) st_bf16x4(K1 + (size_t)r * 1536 + h * 192 + d, v);
        else st_bf16x4(V1 + (size_t)r * 1024 + h * 128 + (d - 128), v);
    } };

__device__ __forceinline__ unsigned ord_key(float f) { const unsigned b = __float_as_uint(f); return (b & 0x80000000u) ? ~b : (b | 0x80000000u); }
__device__ __forceinline__ void rope_cs(int pos, int i, float& c, float& s) { const float freq = powf(10000.0f, -(float)i / 32.0f); const float ang = (float)pos * freq; sincosf(ang, &s, &c); }

typedef short bf16x8 __attribute__((ext_vector_type(8)));
typedef float f32x16 __attribute__((ext_vector_type(16)));
__device__ __forceinline__ unsigned cvtpk(float lo, float hi) { unsigned r; asm("v_cvt_pk_bf16_f32 %0, %1, %2" : "=v"(r) : "v"(lo), "v"(hi)); return r; }
__device__ __forceinline__ float max3_asm(float a, float b, float c) { float r; asm("v_max3_f32 %0, %1, %2, %3" : "=v"(r) : "v"(a), "v"(b), "v"(c)); return r; }

struct AttnArgs { const bf16_t* Q; const bf16_t* K; const bf16_t* VT; const unsigned long long* MT; bf16_t* O; int ldq, ldk, ldo; float sc_log2e; };

template <int DQK, bool MASKED>
__device__ __forceinline__ void attn_item(LAS unsigned char* lds, const AttnArgs& a, int b, int h, int qb) {
    constexpr int NKS = DQK / 16, PK = DQK * 2, PV = 128, KB_BYTES = 64 * PK, VB_BYTES = 128 * PV, NPK = DQK / 8, NKP = (64 * NPK) / 512, V_OFF = 3 * KB_BYTES;
    const int tid = opaque_tid(), lane = tid & 63, w = __builtin_amdgcn_readfirstlane(tid >> 6), n = lane & 31, hf = lane >> 5;
    const int nt = 4 * qb + 4, cw = 4 * qb + (w >> 1);
    const int trow = qb * 256 + w * 32 + n;
    const size_t grow = (size_t)b * SEQ + trow;
    bf16x8 qf[NKS];
    { const bf16_t* qp = a.Q + grow * a.ldq + h * DQK + hf * 8;
#pragma unroll
      for (int ks = 0; ks < NKS; ++ks) qf[ks] = *(const bf16x8*)(qp + ks * 16); }
    f32x16 o[4];
#pragma unroll
    for (int dt = 0; dt < 4; ++dt)
#pragma unroll
        for (int r = 0; r < 16; ++r) o[dt][r] = 0.f;
    float m_run = -INFINITY, l_run = 0.f;
    const float c = a.sc_log2e;
    const bf16_t* Kg = a.K + (size_t)b * SEQ * a.ldk + h * DQK;
    const bf16_t* Vg = a.VT + (size_t)(b * 8 + h) * 128 * SEQ;
    const unsigned long long* Mg = MASKED ? a.MT + (size_t)b * 256 * SEQ + trow : nullptr;
    auto dma_k = [&](int kt) {
        LAS unsigned char* kb = lds + (kt % 3) * KB_BYTES;
#pragma unroll
        for (int i = 0; i < NKP; ++i) { const int s = (w + 8 * i) * 64 + lane, r = s / NPK, cp = s % NPK, cc = cp ^ (NPK == 16 ? (r & 15) : ((r >> 1) & 7));
            __builtin_amdgcn_global_load_lds((const unsigned*)(Kg + (size_t)(kt * 64 + r) * a.ldk + cc * 8), (LAS unsigned*)(kb + (w + 8 * i) * 1024), 16, 0, 0); }
    };
    auto dma_v = [&](int kt) {
        LAS unsigned char* vb = lds + V_OFF + (kt & 1) * VB_BYTES;
#pragma unroll
        for (int i = 0; i < 2; ++i) { const int s = (w + 8 * i) * 64 + lane, d = s >> 3, cp = s & 7, cc = cp ^ ((d >> 1) & 7);
            __builtin_amdgcn_global_load_lds((const unsigned*)(Vg + (size_t)d * SEQ + kt * 64 + cc * 8), (LAS unsigned*)(vb + (w + 8 * i) * 1024), 16, 0, 0); }
    };
    const int kswz = (NPK == 16) ? (n & 15) : ((n >> 1) & 7), vswz = (n >> 1) & 7;
    auto qk = [&](int kt, f32x16& s0, f32x16& s1) {
        const LAS unsigned char* ka = lds + (kt % 3) * KB_BYTES + n * PK;
#pragma unroll
        for (int r = 0; r < 16; ++r) { s0[r] = 0.f; s1[r] = 0.f; }
#pragma unroll
        for (int ks = 0; ks < NKS; ++ks) {
            const int po = ((2 * ks + hf) ^ kswz) * 16;
            const bf16x8 a0 = *(const LAS bf16x8*)(ka + po), a1 = *(const LAS bf16x8*)(ka + 32 * PK + po);
            s0 = __builtin_amdgcn_mfma_f32_32x32x16_bf16(a0, qf[ks], s0, 0, 0, 0);
            s1 = __builtin_amdgcn_mfma_f32_32x32x16_bf16(a1, qf[ks], s1, 0, 0, 0);
        }
    };
    auto rowmax = [&](int kt, f32x16& s0, f32x16& s1) -> float {
        if (MASKED) {
            const unsigned long long mw = Mg[(size_t)kt * SEQ]; const unsigned mlo = (unsigned)mw >> (hf * 4), mhi = (unsigned)(mw >> 32) >> (hf * 4);
#pragma unroll
            for (int r = 0; r < 16; ++r) { const unsigned bit = 1u << ((r >> 2) * 8 + (r & 3));
                s0[r] = (mlo & bit) ? s0[r] : -INFINITY; s1[r] = (mhi & bit) ? s1[r] : -INFINITY; }
        }
        float mx = max3_asm(s0[0], s1[0], s0[1]);
        mx = max3_asm(mx, s1[1], s0[2]);
#pragma unroll
        for (int r = 2; r < 15; ++r) mx = max3_asm(mx, s1[r], s0[r + 1]);
        mx = max3_asm(mx, s1[15], mx);
        const auto rr = __builtin_amdgcn_permlane32_swap(__float_as_uint(mx), __float_as_uint(mx), false, false);
        return fmaxf(__uint_as_float(rr[0]), __uint_as_float(rr[1]));
    };
    dma_k(0); dma_v(0); if (nt > 1) dma_k(1);
    asm volatile("s_waitcnt vmcnt(0)" ::: "memory");
    __syncthreads();
    f32x16 sc0, sc1, sn0, sn1;
    qk(0, sc0, sc1);
    float mx_cur = rowmax(0, sc0, sc1), mx_next = -INFINITY;
#pragma unroll
    for (int r = 0; r < 16; ++r) { sn0[r] = 0.f; sn1[r] = 0.f; }
    for (int kt = 0; kt < nt; ++kt) {
        if (kt + 2 < nt) dma_k(kt + 2);
        if (kt + 1 < nt) dma_v(kt + 1);
        const bool act = kt <= cw, actn = kt + 1 <= cw;
        float m_use = 0.f;
        if (act) {
            const float m_new = fmaxf(m_run, mx_cur);
            m_use = (MASKED && m_new == -INFINITY) ? 0.f : m_new;
            if (__any(m_new > m_run)) {
                const float al = __builtin_amdgcn_exp2f((m_run - m_use) * c);
                l_run *= al;
#pragma unroll
                for (int dt = 0; dt < 4; ++dt)
#pragma unroll
                    for (int r = 0; r < 16; ++r) o[dt][r] *= al;
            }
            m_run = m_new;
        }
        if (actn) qk(kt + 1, sn0, sn1);
        bf16x8 pf[4];
        if (act) {
            const float mc = m_use * c;
            float ps = 0.f;
#pragma unroll
            for (int r = 0; r < 16; ++r) { sc0[r] = __builtin_amdgcn_exp2f(fmaf(sc0[r], c, -mc)); sc1[r] = __builtin_amdgcn_exp2f(fmaf(sc1[r], c, -mc)); ps += sc0[r] + sc1[r]; }
            l_run += ps;
            u32x4 t;
            t.x = cvtpk(sc0[0], sc0[1]); t.y = cvtpk(sc0[2], sc0[3]); t.z = cvtpk(sc0[4], sc0[5]); t.w = cvtpk(sc0[6], sc0[7]); pf[0] = *(bf16x8*)&t;
            t.x = cvtpk(sc0[8], sc0[9]); t.y = cvtpk(sc0[10], sc0[11]); t.z = cvtpk(sc0[12], sc0[13]); t.w = cvtpk(sc0[14], sc0[15]); pf[1] = *(bf16x8*)&t;
            t.x = cvtpk(sc1[0], sc1[1]); t.y = cvtpk(sc1[2], sc1[3]); t.z = cvtpk(sc1[4], sc1[5]); t.w = cvtpk(sc1[6], sc1[7]); pf[2] = *(bf16x8*)&t;
            t.x = cvtpk(sc1[8], sc1[9]); t.y = cvtpk(sc1[10], sc1[11]); t.z = cvtpk(sc1[12], sc1[13]); t.w = cvtpk(sc1[14], sc1[15]); pf[3] = *(bf16x8*)&t;
            const LAS unsigned char* va = lds + V_OFF + (kt & 1) * VB_BYTES + n * PV;
#pragma unroll
            for (int g = 0; g < 4; ++g) { const int po = ((2 * g + hf) ^ vswz) * 16;
#pragma unroll
                for (int dt = 0; dt < 4; ++dt) { const bf16x8 vf = *(const LAS bf16x8*)(va + dt * 32 * PV + po); o[dt] = __builtin_amdgcn_mfma_f32_32x32x16_bf16(vf, pf[g], o[dt], 0, 0, 0); } }
        }
        if (actn) mx_next = rowmax(kt + 1, sn0, sn1);
        sc0 = sn0; sc1 = sn1; mx_cur = mx_next;
        asm volatile("s_waitcnt vmcnt(0)" ::: "memory");
        __syncthreads();
    }
    const float lt = l_run + __shfl_xor(l_run, 32);
    const float inv = 1.0f / lt;
    bf16_t* op = a.O + grow * a.ldo + h * 128 + hf * 4;
#pragma unroll
    for (int dt = 0; dt < 4; ++dt)
#pragma unroll
        for (int r4 = 0; r4 < 4; ++r4) { u32x2 wv; wv.x = cvtpk(o[dt][4 * r4] * inv, o[dt][4 * r4 + 1] * inv); wv.y = cvtpk(o[dt][4 * r4 + 2] * inv, o[dt][4 * r4 + 3] * inv);
            *(u32x2*)(op + dt * 32 + r4 * 8) = wv; }
}
struct TTrue { static constexpr bool value = true; }; struct TFalse { static constexpr bool value = false; };
typedef int i32x8q __attribute__((ext_vector_type(8)));
typedef int i32x4q __attribute__((ext_vector_type(4)));
template <int DQK, bool MASKED, bool QK8>
__device__ __forceinline__ void attn_item3(LAS unsigned char* lds, const AttnArgs& a, int b, int h, int qb) {
    constexpr int NKS = QK8 ? DQK / 64 : DQK / 16, PK = QK8 ? DQK : DQK * 2, PV = 128, KB_BYTES = 64 * PK, VB_BYTES = 128 * PV, NPK = PK / 16, NKP = (64 * NPK + 511) / 512, V_OFF = 3 * KB_BYTES;
    const int tid = opaque_tid(), lane = tid & 63, w = __builtin_amdgcn_readfirstlane(tid >> 6), n = lane & 31, hf = lane >> 5;
    const int nt = 4 * qb + 4, cw = 4 * qb + (w >> 1);
    const int trow = qb * 256 + w * 32 + n;
    const size_t grow = (size_t)b * SEQ + trow;
    bf16x8 qf[QK8 ? 1 : NKS]; i32x8q q8[QK8 ? NKS : 1];
    if (QK8) { const unsigned char* qp = (const unsigned char*)a.Q + grow * a.ldq + h * DQK + hf * 32;
#pragma unroll
      for (int ks = 0; ks < NKS; ++ks) { q8[ks].lo = *(const i32x4q*)(qp + ks * 64); q8[ks].hi = *(const i32x4q*)(qp + ks * 64 + 16); } }
    else { const bf16_t* qp = a.Q + grow * a.ldq + h * DQK + hf * 8;
#pragma unroll
      for (int ks = 0; ks < NKS; ++ks) qf[ks] = *(const bf16x8*)(qp + ks * 16); }
    f32x16 o[4];
#pragma unroll
    for (int dt = 0; dt < 4; ++dt)
#pragma unroll
        for (int r = 0; r < 16; ++r) o[dt][r] = 0.f;
    float m_run = -INFINITY, l_run = 0.f;
    const float c = a.sc_log2e;
    const unsigned char* Kg = (const unsigned char*)a.K + ((size_t)b * SEQ * a.ldk + h * DQK) * (QK8 ? 1 : 2);
    const bf16_t* Vg = a.VT + (size_t)(b * 8 + h) * 128 * SEQ;
    const unsigned long long* Mg = MASKED ? a.MT + (size_t)b * 256 * SEQ + trow : nullptr;
    auto dma_k = [&](int kt) {
        LAS unsigned char* kb = lds + (kt % 3) * KB_BYTES;
#pragma unroll
        for (int i = 0; i < NKP; ++i) { if ((w + 8 * i) * 64 >= 64 * NPK) break;
            const int s = (w + 8 * i) * 64 + lane, r = s / NPK, cp = s % NPK, cc = cp ^ (NPK == 16 ? (r & 15) : (NPK == 12 ? ((r >> 2) & 3) : ((r >> 1) & 7)));
            __builtin_amdgcn_global_load_lds((const unsigned*)(Kg + ((size_t)(kt * 64 + r) * a.ldk) * (QK8 ? 1 : 2) + cc * 16), (LAS unsigned*)(kb + (w + 8 * i) * 1024), 16, 0, 0); }
    };
    auto dma_v = [&](int kt) {
        LAS unsigned char* vb = lds + V_OFF + (kt & 1) * VB_BYTES;
#pragma unroll
        for (int i = 0; i < 2; ++i) { const int s = (w + 8 * i) * 64 + lane, d = s >> 3, cp = s & 7, cc = cp ^ ((d >> 1) & 7);
            __builtin_amdgcn_global_load_lds((const unsigned*)(Vg + (size_t)d * SEQ + kt * 64 + cc * 8), (LAS unsigned*)(vb + (w + 8 * i) * 1024), 16, 0, 0); }
    };
    const int kswz = (NPK == 16) ? (n & 15) : (NPK == 12 ? ((n >> 2) & 3) : ((n >> 1) & 7)), vswz = (n >> 1) & 7;
    auto qk = [&](int kt, f32x16& s0, f32x16& s1) {
        const LAS unsigned char* ka = lds + (kt % 3) * KB_BYTES + n * PK;
#pragma unroll
        for (int r = 0; r < 16; ++r) { s0[r] = 0.f; s1[r] = 0.f; }
        if (QK8) {
#pragma unroll
            for (int ks = 0; ks < NKS; ++ks) {
                const int p0 = ((4 * ks + 2 * hf) ^ kswz) * 16, p1 = ((4 * ks + 2 * hf + 1) ^ kswz) * 16;
                i32x8q a0, a1;
                a0.lo = *(const LAS i32x4q*)(ka + p0); a0.hi = *(const LAS i32x4q*)(ka + p1);
                a1.lo = *(const LAS i32x4q*)(ka + 32 * PK + p0); a1.hi = *(const LAS i32x4q*)(ka + 32 * PK + p1);
                s0 = __builtin_amdgcn_mfma_scale_f32_32x32x64_f8f6f4(a0, q8[ks], s0, 0, 0, 0, 0x7F7F7F7F, 0, 0x7F7F7F7F);
                s1 = __builtin_amdgcn_mfma_scale_f32_32x32x64_f8f6f4(a1, q8[ks], s1, 0, 0, 0, 0x7F7F7F7F, 0, 0x7F7F7F7F);
            }
        } else {
#pragma unroll
            for (int ks = 0; ks < NKS; ++ks) {
                const int po = ((2 * ks + hf) ^ kswz) * 16;
                const bf16x8 a0 = *(const LAS bf16x8*)(ka + po), a1 = *(const LAS bf16x8*)(ka + 32 * PK + po);
                s0 = __builtin_amdgcn_mfma_f32_32x32x16_bf16(a0, qf[ks], s0, 0, 0, 0);
                s1 = __builtin_amdgcn_mfma_f32_32x32x16_bf16(a1, qf[ks], s1, 0, 0, 0);
            }
        }
    };
    auto rowmax = [&](unsigned long long mw, bool, f32x16& s0, f32x16& s1) -> float {
        if (MASKED) {
            const unsigned mlo = (unsigned)mw >> (hf * 4), mhi = (unsigned)(mw >> 32) >> (hf * 4);
#pragma unroll
            for (int r = 0; r < 16; ++r) { const unsigned bit = 1u << ((r >> 2) * 8 + (r & 3));
                s0[r] = (mlo & bit) ? s0[r] : -INFINITY; s1[r] = (mhi & bit) ? s1[r] : -INFINITY; }
        }
        float mx = max3_asm(s0[0], s1[0], s0[1]);
        mx = max3_asm(mx, s1[1], s0[2]);
#pragma unroll
        for (int r = 2; r < 15; ++r) mx = max3_asm(mx, s1[r], s0[r + 1]);
        mx = max3_asm(mx, s1[15], mx);
        const auto rr = __builtin_amdgcn_permlane32_swap(__float_as_uint(mx), __float_as_uint(mx), false, false);
        return fmaxf(__uint_as_float(rr[0]), __uint_as_float(rr[1]));
    };
    dma_k(0); dma_v(0); if (nt > 1) dma_k(1);
    unsigned long long mw_pre = MASKED ? Mg[(size_t)(nt > 1 ? 1 : 0) * SEQ] : 0ull;
    asm volatile("s_waitcnt vmcnt(0)" ::: "memory");
    __syncthreads();
    f32x16 sa0, sa1, sb0, sb1;
    qk(0, sa0, sa1);
    float mx_cur = rowmax(MASKED ? Mg[0] : 0ull, false, sa0, sa1);
    auto step = [&](int kt, f32x16& c0, f32x16& c1, f32x16& n0, f32x16& n1, auto full_tag) {
        constexpr bool FULL = decltype(full_tag)::value;
        if (kt + 2 < nt) dma_k(kt + 2);
        if (kt + 1 < nt) dma_v(kt + 1);
        const unsigned long long mw_now = mw_pre;
        if (MASKED) mw_pre = Mg[(size_t)(kt + 2 < nt ? kt + 2 : kt) * SEQ];
        const bool act = FULL || kt <= cw, actn = FULL || kt + 1 <= cw;
        const float m_new = fmaxf(m_run, mx_cur);
        const float m_use = (MASKED && m_new == -INFINITY) ? 0.f : m_new;
        if (act && __any(m_new > m_run)) {
            const float al = __builtin_amdgcn_exp2f((m_run - m_use) * c);
            l_run *= al;
#pragma unroll
            for (int dt = 0; dt < 4; ++dt)
#pragma unroll
                for (int r = 0; r < 16; ++r) o[dt][r] *= al;
        }
        if (act) m_run = m_new;
        if (FULL) {
            qk(kt + 1, n0, n1);
            const float mc = m_use * c;
            float ps = 0.f;
#pragma unroll
            for (int r = 0; r < 16; ++r) { c0[r] = __builtin_amdgcn_exp2f(fmaf(c0[r], c, -mc)); c1[r] = __builtin_amdgcn_exp2f(fmaf(c1[r], c, -mc)); ps += c0[r] + c1[r]; }
            l_run += ps;
            bf16x8 pf[4]; u32x4 t;
            t.x = cvtpk(c0[0], c0[1]); t.y = cvtpk(c0[2], c0[3]); t.z = cvtpk(c0[4], c0[5]); t.w = cvtpk(c0[6], c0[7]); pf[0] = *(bf16x8*)&t;
            t.x = cvtpk(c0[8], c0[9]); t.y = cvtpk(c0[10], c0[11]); t.z = cvtpk(c0[12], c0[13]); t.w = cvtpk(c0[14], c0[15]); pf[1] = *(bf16x8*)&t;
            t.x = cvtpk(c1[0], c1[1]); t.y = cvtpk(c1[2], c1[3]); t.z = cvtpk(c1[4], c1[5]); t.w = cvtpk(c1[6], c1[7]); pf[2] = *(bf16x8*)&t;
            t.x = cvtpk(c1[8], c1[9]); t.y = cvtpk(c1[10], c1[11]); t.z = cvtpk(c1[12], c1[13]); t.w = cvtpk(c1[14], c1[15]); pf[3] = *(bf16x8*)&t;
            const LAS unsigned char* va = lds + V_OFF + (kt & 1) * VB_BYTES + n * PV;
#pragma unroll
            for (int g = 0; g < 4; ++g) { const int po = ((2 * g + hf) ^ vswz) * 16;
#pragma unroll
                for (int dt = 0; dt < 4; ++dt) { const bf16x8 vf = *(const LAS bf16x8*)(va + dt * 32 * PV + po); o[dt] = __builtin_amdgcn_mfma_f32_32x32x16_bf16(vf, pf[g], o[dt], 0, 0, 0); } }
            mx_cur = rowmax(mw_now, false, n0, n1);
        } else {
            if (actn) qk(kt + 1, n0, n1);
            if (act) {
                const float mc = m_use * c;
                float ps = 0.f;
#pragma unroll
                for (int r = 0; r < 16; ++r) { c0[r] = __builtin_amdgcn_exp2f(fmaf(c0[r], c, -mc)); c1[r] = __builtin_amdgcn_exp2f(fmaf(c1[r], c, -mc)); ps += c0[r] + c1[r]; }
                l_run += ps;
                bf16x8 pf[4]; u32x4 t;
                t.x = cvtpk(c0[0], c0[1]); t.y = cvtpk(c0[2], c0[3]); t.z = cvtpk(c0[4], c0[5]); t.w = cvtpk(c0[6], c0[7]); pf[0] = *(bf16x8*)&t;
                t.x = cvtpk(c0[8], c0[9]); t.y = cvtpk(c0[10], c0[11]); t.z = cvtpk(c0[12], c0[13]); t.w = cvtpk(c0[14], c0[15]); pf[1] = *(bf16x8*)&t;
                t.x = cvtpk(c1[0], c1[1]); t.y = cvtpk(c1[2], c1[3]); t.z = cvtpk(c1[4], c1[5]); t.w = cvtpk(c1[6], c1[7]); pf[2] = *(bf16x8*)&t;
                t.x = cvtpk(c1[8], c1[9]); t.y = cvtpk(c1[10], c1[11]); t.z = cvtpk(c1[12], c1[13]); t.w = cvtpk(c1[14], c1[15]); pf[3] = *(bf16x8*)&t;
                const LAS unsigned char* va = lds + V_OFF + (kt & 1) * VB_BYTES + n * PV;
#pragma unroll
                for (int g = 0; g < 4; ++g) { const int po = ((2 * g + hf) ^ vswz) * 16;
#pragma unroll
                    for (int dt = 0; dt < 4; ++dt) { const bf16x8 vf = *(const LAS bf16x8*)(va + dt * 32 * PV + po); o[dt] = __builtin_amdgcn_mfma_f32_32x32x16_bf16(vf, pf[g], o[dt], 0, 0, 0); } }
            }
            if (actn) mx_cur = rowmax(mw_now, false, n0, n1);
        }
        asm volatile("s_waitcnt vmcnt(0)" ::: "memory");
        __syncthreads();
    };
    int kt = 0;
    for (; kt < 4 * qb; kt += 2) { step(kt, sa0, sa1, sb0, sb1, TTrue{}); step(kt + 1, sb0, sb1, sa0, sa1, TTrue{}); }
    for (; kt < nt; kt += 2) { step(kt, sa0, sa1, sb0, sb1, TFalse{}); step(kt + 1, sb0, sb1, sa0, sa1, TFalse{}); }
    const float lt = l_run + __shfl_xor(l_run, 32);
    const float inv = 1.0f / lt;
    bf16_t* op = a.O + grow * a.ldo + h * 128 + hf * 4;
#pragma unroll
    for (int dt = 0; dt < 4; ++dt)
#pragma unroll
        for (int r4 = 0; r4 < 4; ++r4) { u32x2 wv; wv.x = cvtpk(o[dt][4 * r4] * inv, o[dt][4 * r4 + 1] * inv); wv.y = cvtpk(o[dt][4 * r4 + 2] * inv, o[dt][4 * r4 + 3] * inv);
            *(u32x2*)(op + dt * 32 + r4 * 8) = wv; }
}
template <int DQK, bool MASKED>
__device__ __forceinline__ void attn_phase(LAS unsigned char* lds, const AttnArgs& a, int bid, int nblk) {
    for (int p = bid; p < 512; p += nblk) {
        const int bh = (p & 7) + 8 * (p >> 8), j = (p >> 3) & 31;
#pragma unroll 1
        for (int i = 0; i < 2; ++i) attn_item3<DQK, MASKED, DQK == 192>(lds, a, bh >> 3, bh & 7, i ? j : 63 - j);
    }
}

#ifdef IDX_PROBE_FINAL
#define IDX_PF_ 1
#else
#define IDX_PF_ 0
#endif
typedef _Float16 f16x8 __attribute__((ext_vector_type(8)));
struct IdxArgs { const float* QI; const unsigned short* KI16; const float* WI; unsigned long long* MT; };
static constexpr int IDX_CAP = 640, IDX_CS = 0, IDX_CI = 32 * IDX_CAP * 4, IDX_KT = IDX_CI + 32 * IDX_CAP * 2, IDX_CNT = IDX_KT + 32768, IDX_TAU = IDX_CNT + 128, IDX_LDS = IDX_TAU + 128;
static_assert(IDX_KT % 1024 == 0, "K tile buffers must be 1 KiB aligned");

__device__ __forceinline__ float ord_inv(unsigned T) { return __uint_as_float((T & 0x80000000u) ? (T & 0x7FFFFFFFu) : ~T); }
__device__ __forceinline__ unsigned lane_prefix(unsigned long long m) { return __builtin_amdgcn_mbcnt_hi((unsigned)(m >> 32), __builtin_amdgcn_mbcnt_lo((unsigned)m, 0u)); }
__device__ __forceinline__ float relu_asm(float x) { float y; asm("v_max_f32 %0, 0, %1" : "=v"(y) : "v"(x)); return y; }
__device__ __forceinline__ void glds16(const void* gsrc, unsigned lds_dst) {
    unsigned keep;
    asm volatile("s_mov_b32 %0, m0\n\ts_mov_b32 m0, %2\n\ts_nop 0\n\tglobal_load_lds_dwordx4 %1, off\n\ts_mov_b32 m0, %0" : "=&s"(keep) : "v"(gsrc), "s"(lds_dst) : "memory");
}

template <bool EXACT> __device__ __forceinline__ int idx_compact(LAS unsigned char* lds, int qq, int lane, int n, float& tau) {
    LAS float* cs = (LAS float*)(lds + IDX_CS) + qq * IDX_CAP; LAS unsigned short* ci = (LAS unsigned short*)(lds + IDX_CI) + qq * IDX_CAP;
    float sv[10]; unsigned short iv[10]; unsigned uk[10];
#pragma unroll
    for (int j = 0; j < 10; ++j) { const int idx = lane + 64 * j; const bool valid = idx < n; sv[j] = cs[idx]; iv[j] = ci[idx]; uk[j] = valid ? ord_key(sv[j]) : 0u; }
    auto count_ge = [&](unsigned t) { int c = 0;
#pragma unroll
        for (int j = 0; j < 10; ++j) c += __builtin_popcountll(__ballot(uk[j] >= t));
        return c; };
    unsigned lo = ord_key(tau), hi = 0xFF800001u;
    if (lo > 0x80800000u) { const unsigned h2 = lo + 0x00800000u;
        if (h2 < hi) { if (count_ge(h2) >= 256) lo = h2; else hi = h2; } }
    while (hi - lo > 1u) {
        const unsigned mid = lo + ((hi - lo) >> 1); const int c = count_ge(mid);
        if (c >= 256) { lo = mid; if (!EXACT && c <= 336) break; } else hi = mid;
    }
    const unsigned T = lo;
    int need = 0;
    if (EXACT) { int ngt = 0;
#pragma unroll
        for (int j = 0; j < 10; ++j) ngt += __builtin_popcountll(__ballot(uk[j] > T));
        need = 256 - ngt; }
    int base = 0, tiebase = 0;
#pragma unroll
    for (int j = 0; j < 10; ++j) {
        bool keep;
        if (EXACT) { const bool gt = uk[j] > T, eq = uk[j] == T; const unsigned long long em = __ballot(eq); keep = gt || (eq && (tiebase + (int)lane_prefix(em)) < need); tiebase += __builtin_popcountll(em); }
        else keep = uk[j] >= T;
        const unsigned long long km = __ballot(keep);
        const int pos = base + (int)lane_prefix(km);
        if (keep) { cs[pos] = sv[j]; ci[pos] = iv[j]; }
        base += __builtin_popcountll(km);
    }
    tau = ord_inv(T);
    return base;
}

__device__ __forceinline__ void idx_item(LAS unsigned char* lds, const IdxArgs& a, int b, int hc) {
    const int tid = opaque_tid(), lane = tid & 63, w = __builtin_amdgcn_readfirstlane(tid >> 6), n = lane & 31, hf = lane >> 5;
    const int t0 = hc * 32, L = (t0 / 64 + 1) * 64, nsub = L / 32, ntile = (L + 127) / 128;
    const size_t q0 = (size_t)b * SEQ + t0 + 4 * w;
    LAS float* cs = (LAS float*)(lds + IDX_CS); LAS unsigned short* ci = (LAS unsigned short*)(lds + IDX_CI);
    LAS unsigned* cnt = (LAS unsigned*)(lds + IDX_CNT);
    f16x8 qf[2][4];
#pragma unroll
    for (int rt = 0; rt < 2; ++rt) { const float* qp = a.QI + (q0 + 2 * rt + (n >> 4)) * 1024 + (n & 15) * 64 + hf * 8;
#pragma unroll
        for (int ks = 0; ks < 4; ++ks) { const f32x4 x0 = *(const f32x4*)(qp + ks * 16), x1 = *(const f32x4*)(qp + ks * 16 + 4);
            f16x8 v; v[0] = (_Float16)x0[0]; v[1] = (_Float16)x0[1]; v[2] = (_Float16)x0[2]; v[3] = (_Float16)x0[3]; v[4] = (_Float16)x1[0]; v[5] = (_Float16)x1[1]; v[6] = (_Float16)x1[2]; v[7] = (_Float16)x1[3];
            qf[rt][ks] = v; } }
    float wv[2][16];
#pragma unroll
    for (int rt = 0; rt < 2; ++rt)
#pragma unroll
        for (int r = 0; r < 16; ++r) wv[rt][r] = a.WI[(q0 + 2 * rt + (r >> 3)) * 16 + (((r & 3) + 8 * (r >> 2) + 4 * hf) & 15)] * (0.125f * 0.25f);
    if (tid < 32) cnt[tid] = 0u;
    int cq0 = 0, cq1 = 0, cq2 = 0, cq3 = 0;
    float tq0 = -INFINITY, tq1 = -INFINITY, tq2 = -INFINITY, tq3 = -INFINITY;
    float tau0 = INFINITY, tau1 = INFINITY;
    const unsigned short* Kg = a.KI16 + (size_t)b * SEQ * 64;
    const unsigned ldsbase = (unsigned)(size_t)lds;
    auto dma = [&](int kt, int buf) {
#pragma unroll
        for (int i = 0; i < 2; ++i) { const int s = (w + 8 * i) * 64 + lane, r = s >> 3, cp = s & 7, cc = cp ^ ((r >> 1) & 7);
            glds16(Kg + (size_t)(kt * 128 + r) * 64 + cc * 8, ldsbase + IDX_KT + buf * 16384 + (w + 8 * i) * 1024); }
    };
    dma(0, 0);
    asm volatile("s_waitcnt vmcnt(0)" ::: "memory");
    __syncthreads();
    const int kswz = (n >> 1) & 7;
    f32x16 accA[2], accB[2];
#pragma unroll
    for (int rt = 0; rt < 2; ++rt)
#pragma unroll
        for (int r = 0; r < 16; ++r) { accA[rt][r] = 0.f; accB[rt][r] = 0.f; }
    int keyA = 0, keyB = 0;
    auto epilogue = [&](const f32x16 (&acc)[2], int key) {
        float sc[2];
#pragma unroll
        for (int rt = 0; rt < 2; ++rt) { float pa = 0.f, pb = 0.f;
#pragma unroll
            for (int r = 0; r < 8; ++r) { pa = fmaf(relu_asm(acc[rt][r]), wv[rt][r], pa); pb = fmaf(relu_asm(acc[rt][r + 8]), wv[rt][r + 8], pb); }
            const auto rr = __builtin_amdgcn_permlane32_swap(__float_as_uint(pa), __float_as_uint(pb), false, false);
            sc[rt] = __uint_as_float(rr[0]) + __uint_as_float(rr[1]); }
        const bool c0 = sc[0] > tau0, c1 = sc[1] > tau1;
        const unsigned long long m0 = __ballot(c0), m1 = __ballot(c1);
        if (m0 | m1) {
            const unsigned l0 = (unsigned)m0, h0 = (unsigned)(m0 >> 32), l1 = (unsigned)m1, h1 = (unsigned)(m1 >> 32);
            const int p0 = hf ? cq1 + (int)__builtin_amdgcn_mbcnt_hi(h0, 0u) : cq0 + (int)__builtin_amdgcn_mbcnt_lo(l0, 0u);
            const int p1 = hf ? cq3 + (int)__builtin_amdgcn_mbcnt_hi(h1, 0u) : cq2 + (int)__builtin_amdgcn_mbcnt_lo(l1, 0u);
            if (c0 && p0 < IDX_CAP) { const int qq = 4 * w + hf; cs[qq * IDX_CAP + p0] = sc[0]; ci[qq * IDX_CAP + p0] = (unsigned short)key; }
            if (c1 && p1 < IDX_CAP) { const int qq = 4 * w + 2 + hf; cs[qq * IDX_CAP + p1] = sc[1]; ci[qq * IDX_CAP + p1] = (unsigned short)key; }
            cq0 += __builtin_popcount(l0); cq1 += __builtin_popcount(h0); cq2 += __builtin_popcount(l1); cq3 += __builtin_popcount(h1);
        }
    };
    auto mma = [&](f32x16 (&acc)[2], const LAS unsigned char* kr) {
        f16x8 kf[4];
#pragma unroll
        for (int ks = 0; ks < 4; ++ks) kf[ks] = *(const LAS f16x8*)(kr + ((2 * ks + hf) ^ kswz) * 16);
#pragma unroll
        for (int rt = 0; rt < 2; ++rt) {
            f32x16 c;
#pragma unroll
            for (int r = 0; r < 16; ++r) c[r] = 0.f;
#pragma unroll
            for (int ks = 0; ks < 4; ++ks) c = __builtin_amdgcn_mfma_f32_32x32x16_f16(qf[rt][ks], kf[ks], c, 0, 0, 0);
            acc[rt] = c; }
    };
#ifdef IDX_PROBE2
  for (int rep_ = 0; rep_ < 2; ++rep_) {
    if (rep_ == 1) { epilogue(accB, keyB); tau0 = INFINITY; tau1 = INFINITY; __syncthreads(); dma(0, 0); asm volatile("s_waitcnt vmcnt(0)" ::: "memory"); __syncthreads(); }
#endif
    for (int kt = 0; kt < ntile; ++kt) {
        if (kt + 1 < ntile) dma(kt + 1, (kt + 1) & 1);
#ifdef IDX_PROBE2
        if (rep_ == 0)
#endif
        { const unsigned c_all = cnt[lane & 31];
          if (__ballot(c_all > (unsigned)(IDX_CAP - 160))) {
              if (cq0 > 400) cq0 = idx_compact<false>(lds, 4 * w + 0, lane, cq0, tq0);
              if (cq1 > 400) cq1 = idx_compact<false>(lds, 4 * w + 1, lane, cq1, tq1);
              if (cq2 > 400) cq2 = idx_compact<false>(lds, 4 * w + 2, lane, cq2, tq2);
              if (cq3 > 400) cq3 = idx_compact<false>(lds, 4 * w + 3, lane, cq3, tq3);
              if (kt > 0) { tau0 = hf ? tq1 : tq0; tau1 = hf ? tq3 : tq2; }
          } }
        const LAS unsigned char* kb = lds + IDX_KT + (kt & 1) * 16384 + n * 128;
        const int sbase = kt * 4;
#ifdef IDX_PROBE2
        if (sbase + 0 < nsub) { mma(accA, kb); epilogue(accB, keyB); keyA = kt * 128 + n; if (kt == 0 && rep_ == 0) { tau0 = -INFINITY; tau1 = -INFINITY; } }
#else
        if (sbase + 0 < nsub) { mma(accA, kb); epilogue(accB, keyB); keyA = kt * 128 + n; if (kt == 0) { tau0 = -INFINITY; tau1 = -INFINITY; } }
#endif
        if (sbase + 1 < nsub) { mma(accB, kb + 32 * 128); epilogue(accA, keyA); keyB = kt * 128 + 32 + n; }
        if (sbase + 2 < nsub) { mma(accA, kb + 64 * 128); epilogue(accB, keyB); keyA = kt * 128 + 64 + n; }
        if (sbase + 3 < nsub) { mma(accB, kb + 96 * 128); epilogue(accA, keyA); keyB = kt * 128 + 96 + n; }
        if (lane < 4) cnt[4 * w + lane] = (unsigned)(lane == 0 ? cq0 : (lane == 1 ? cq1 : (lane == 2 ? cq2 : cq3)));
        asm volatile("s_waitcnt vmcnt(0)" ::: "memory");
        __syncthreads();
    }
#ifdef IDX_PROBE2
  }
#endif
    epilogue(accB, keyB);
    __syncthreads();
    LAS unsigned* bm = (LAS unsigned*)(lds + IDX_KT) + w * 512;
#ifdef IDX_PROBE_FINAL
  for (int rep2_ = 0; rep2_ < 2; ++rep2_) {
#endif
    if (cq0 > 256 - IDX_PF_) cq0 = idx_compact<true>(lds, 4 * w + 0, lane, cq0, tq0);
    if (cq1 > 256 - IDX_PF_) cq1 = idx_compact<true>(lds, 4 * w + 1, lane, cq1, tq1);
    if (cq2 > 256 - IDX_PF_) cq2 = idx_compact<true>(lds, 4 * w + 2, lane, cq2, tq2);
    if (cq3 > 256 - IDX_PF_) cq3 = idx_compact<true>(lds, 4 * w + 3, lane, cq3, tq3);
#pragma unroll 1
    for (int i = 0; i < 4; ++i) {
        const int qq = 4 * w + i;
        const int nsel = (i == 0) ? cq0 : ((i == 1) ? cq1 : ((i == 2) ? cq2 : cq3));
#pragma unroll
        for (int j = 0; j < 8; ++j) bm[lane + 64 * j] = 0u;
#pragma unroll
        for (int j = 0; j < 4; ++j) { const int idx = lane + 64 * j; if (idx < nsel) { const unsigned k = ci[qq * IDX_CAP + idx]; (void)__hip_atomic_fetch_or(bm + (k >> 5), 1u << (k & 31), __ATOMIC_RELAXED, __HIP_MEMORY_SCOPE_WORKGROUP); } }
        const int tq = t0 + qq;
#pragma unroll 1
        for (int kt = lane; kt < L / 64; kt += 64) { const unsigned long long v = (unsigned long long)bm[2 * kt] | ((unsigned long long)bm[2 * kt + 1] << 32); a.MT[((size_t)b * 256 + kt) * SEQ + tq] = v; }
    }
#ifdef IDX_PROBE_FINAL
  }
#endif
    __syncthreads();
}
__device__ __forceinline__ void idx_phase(LAS unsigned char* lds, const IdxArgs& a, int bid, int nblk) {
    for (int k = bid; k < 256; k += nblk) {
#pragma unroll 1
        for (int i = 0; i < 4; ++i) idx_item(lds, a, i & 1, (i < 2) ? 511 - k : k);
    }
}
#define XB_TMO      128
#define XB_XCNT(j)  (256  + 64 * (j))
#define XB_XSUB(j)  (1280 + 64 * (j))
#define XB_XGEN(j)  (2304 + 64 * (j))
#define XB_TOP      3328
#define XB_TOPGEN   3392
#define XCD_BAR_WORDS 3456
#define XB_SPIN_CAP (1u << 23)


__device__ __forceinline__ unsigned xb_ld(unsigned* p)              { return __hip_atomic_load(p, __ATOMIC_RELAXED, __HIP_MEMORY_SCOPE_AGENT); }
__device__ __forceinline__ unsigned xb_add(unsigned* p, unsigned v) { return __hip_atomic_fetch_add(p, v, __ATOMIC_RELAXED, __HIP_MEMORY_SCOPE_AGENT); }
__device__ __forceinline__ unsigned xb_xcc_id() { return (unsigned)__builtin_amdgcn_s_getreg((3 << 11) | 20) & 0xFu; }
#define XB_SPIN(cond, bar) do { unsigned _sp = 0; while (cond) { __builtin_amdgcn_s_sleep(1); \
    if ((++_sp & 255u) == 0u) { if (xb_ld(&(bar)[XB_TMO])) break; if (_sp > XB_SPIN_CAP) { atomicAdd(&(bar)[XB_TMO], 1u); break; } } } } while (0)

struct XcdBarrier {
    unsigned* bar; unsigned x;
    volatile LAS unsigned* st;
};

__device__ __forceinline__ XcdBarrier xcd_barrier_post(unsigned* bar, volatile LAS unsigned* st) {
    XcdBarrier b; b.bar = bar; b.x = xb_xcc_id(); b.st = st;
    if (threadIdx.x == 0) (void)xb_add(&bar[XB_XCNT(b.x)], 1u);
    return b;
}
__device__ __forceinline__ void xcd_barrier_complete(unsigned* bar, unsigned x, unsigned& nloc, unsigned& nx) {
    const unsigned G = gridDim.x * gridDim.y * gridDim.z;
    unsigned sum, cnt, mine, sp = 0u;
    for (;;) {
        sum = 0u; cnt = 0u; mine = 0u;
#pragma unroll
        for (unsigned j = 0; j < 16; ++j) { const unsigned c = xb_ld(&bar[XB_XCNT(j)]); sum += c; cnt += (c > 0u) ? 1u : 0u; mine = (j == x) ? c : mine; }
        if (sum == G) break;
        __builtin_amdgcn_s_sleep(1);
        if ((++sp & 255u) == 0u) { if (xb_ld(&bar[XB_TMO])) break; if (sp > XB_SPIN_CAP) { atomicAdd(&bar[XB_TMO], 1u); break; } }
    }
    nloc = mine > 0u ? mine : 1u; nx = cnt > 0u ? cnt : 1u;
}

__device__ __forceinline__ void xcd_barrier(const XcdBarrier& b) {
    asm volatile("s_waitcnt vmcnt(0)" ::: "memory");
    __syncthreads();
    if (threadIdx.x == 0) {
        unsigned* bar = b.bar;
        __builtin_amdgcn_s_waitcnt(0);
        unsigned nloc = b.st[0], nx = b.st[1];
        if (nloc == 0u) { xcd_barrier_complete(bar, b.x, nloc, nx); b.st[0] = nloc; b.st[1] = nx; }
        const unsigned old = xb_add(&bar[XB_XSUB(b.x)], 1u);
        const unsigned gen = old / nloc;
        if (old + 1u == (gen + 1u) * nloc) {
            __builtin_amdgcn_fence(__ATOMIC_RELEASE, "agent");
            asm volatile("s_waitcnt vmcnt(0)" ::: "memory");
            const unsigned og = xb_add(&bar[XB_TOP], 1u);
            const unsigned tg = og / nx;
            if (og + 1u == (tg + 1u) * nx) xb_add(&bar[XB_TOPGEN], 1u);
            else XB_SPIN(xb_ld(&bar[XB_TOPGEN]) == tg, bar);
            __builtin_amdgcn_fence(__ATOMIC_ACQUIRE, "agent");
            xb_add(&bar[XB_XGEN(b.x)], 1u);
            asm volatile("s_waitcnt vmcnt(0)" ::: "memory");
        } else {
            XB_SPIN(xb_ld(&bar[XB_XGEN(b.x)]) == gen, bar);
            __builtin_amdgcn_fence(__ATOMIC_ACQUIRE, "agent");
            asm volatile("s_waitcnt vmcnt(0)" ::: "memory");
        }
    }
    __syncthreads();
}

#ifndef FP8_QKV
#define FP8_QKV 1
#endif
#ifndef FP8_UP0
#define FP8_UP0 0
#endif
#ifndef FP8_UP1
#define FP8_UP1 1
#endif
#ifndef FP8_DN0
#define FP8_DN0 0
#endif
#ifndef FP8_DN1
#define FP8_DN1 1
#endif
#ifndef SKIPMASK
#define SKIPMASK 0
#endif

__device__ __forceinline__ int perm16(int t) { const int a = (t >> 2) & 3; return (t & ~12) | ((a == 1 ? 2 : (a == 2 ? 1 : a)) << 2); }
__device__ __forceinline__ void st_vt(bf16_t* VT, int row, int h, int d, f32x4 v) {
    const int b = row / SEQ, t = row % SEQ; bf16_t* p = VT + ((size_t)(b * 8 + h) * 128 + d) * SEQ + (t & ~15) + perm16(t & 15);
    p[0] = f2bf(v[0]); p[SEQ] = f2bf(v[1]); p[2 * (size_t)SEQ] = f2bf(v[2]); p[3 * (size_t)SEQ] = f2bf(v[3]);
}
struct FAbIn2 { bf16_t *Q, *K, *VT; float *QI, *U, *WI; unsigned short* KI16;
    __device__ __forceinline__ void operator()(int r, int c, f32x4 v) const {
        if (c < 1024) st_bf16x4(Q + (size_t)r * 1024 + c, v);
        else if (c < 2048) st_bf16x4(K + (size_t)r * 1024 + (c - 1024), v);
        else if (c < 3072) st_vt(VT, r, (c - 2048) >> 7, (c - 2048) & 127, v);
        else if (c < 4096) st_f32x4(QI + (size_t)r * 1024 + (c - 3072), v);
        else if (c < 5120) st_f32x4(U + (size_t)r * 1024 + (c - 4096), v);
        else if (c < 5184) { typedef _Float16 h2 __attribute__((ext_vector_type(2))); union { h2 h; unsigned u; } a, b; a.h = (h2){(_Float16)v[0], (_Float16)v[1]}; b.h = (h2){(_Float16)v[2], (_Float16)v[3]};
            u32x2 w; w.x = a.u; w.y = b.u; *(u32x2*)(KI16 + (size_t)r * 64 + (c - 5120)) = w; }
        else if (c < 5200) st_f32x4(WI + (size_t)r * 16 + (c - 5184), v);
    } };
struct FAbInHi { FAbIn2 f; __device__ __forceinline__ void operator()(int r, int c, f32x4 v) const { f(r, c + 3072, v); } };
struct FKvUp2 { unsigned char* K8; bf16_t* VT;
    __device__ __forceinline__ void operator()(int r, int c, f32x4 v) const {
        const int h = c >> 8, d = c & 255;
        if (d < 128) { int pk = 0; pk = __builtin_amdgcn_cvt_pk_fp8_f32(v[0], v[1], pk, false); pk = __builtin_amdgcn_cvt_pk_fp8_f32(v[2], v[3], pk, true); *(int*)(K8 + (size_t)r * 1536 + h * 192 + d) = pk; }
        else st_vt(VT, r, h, d - 128, v);
    } };

template <class E> __device__ __forceinline__ void ph_gemm_e(LAS unsigned char* lds, const bf16_t* A, int lda, const bf16_t* Bt, int ldb, int M, int N, int K, const E& e, int bid, int nblk, int a_shift = 0, int a_bytes = 0, int cmode = 0) {
    pg8::Gemm g; g.A = A; g.Bt = Bt; g.M = M; g.N = N; g.K = K; g.lda = lda; g.ldb = ldb; g.a_shift = a_shift; g.a_bytes = a_bytes; g.cmode = cmode;
    pg8::StaticOrder S; S.init(M, N, nblk, bid);
    pg8::gemm_phase<E, pg8::StaticOrder, false>(lds, g, S, e, nullptr);
    __syncthreads();
}
template <class F> __device__ __forceinline__ void ph_gemm(LAS unsigned char* lds, const bf16_t* A, int lda, const bf16_t* Bt, int ldb, int M, int N, int K, const F& f, int bid, int nblk, int a_shift = 0, int a_bytes = 0) {
    EpiG<F> e; e.f = f;
    ph_gemm_e(lds, A, lda, Bt, ldb, M, N, K, e, bid, nblk, a_shift, a_bytes);
}
template <class F> __device__ __forceinline__ void ph_gemm8(LAS unsigned char* lds, const unsigned char* A, int lda, const unsigned char* Bt, int ldb, int M, int N, int K, const F& f, int bid, int nblk) {
    EpiG<F, true> e; e.f = f;
    ph_gemm_e(lds, (const bf16_t*)A, lda / 2, (const bf16_t*)Bt, ldb / 2, M, N, K / 2, e, bid, nblk, 0, 0);
}
__device__ __forceinline__ float dpp_ror1(float v) { return __int_as_float(__builtin_amdgcn_update_dpp(0, __float_as_int(v), 0x121, 0xF, 0xF, false)); }
__device__ __forceinline__ float dpp_ror2(float v) { return __int_as_float(__builtin_amdgcn_update_dpp(0, __float_as_int(v), 0x122, 0xF, 0xF, false)); }
__device__ __forceinline__ float dpp_shr1(float old, float v) { return __int_as_float(__builtin_amdgcn_update_dpp(__float_as_int(old), __float_as_int(v), 0x111, 0xF, 0xF, false)); }
__device__ __forceinline__ float dpp_shr2(float old, float v) { return __int_as_float(__builtin_amdgcn_update_dpp(__float_as_int(old), __float_as_int(v), 0x112, 0xF, 0xF, false)); }
__device__ __forceinline__ float gelu_fast(float x) { const float u2 = 1.5957691216057308f * (x + 0.044715f * x * x * x); return x * __builtin_amdgcn_rcpf(1.0f + __builtin_amdgcn_exp2f(-1.4426950408889634f * u2)); }
template <bool OUT8, bool F8> struct EpiGate {
    static constexpr bool PERM = false, AFTER_DRAIN = false, FP8 = F8;
    const float* cw; const float* cb; void* ACT;
    __device__ __forceinline__ void operator()(const f32x4 (&acc)[2][2][4][2], const pg8::Unit& u, int wr, int wc, int fr, int fq) const {
        const int bt = u.pm / 67, ti = u.pm % 67;
#pragma unroll
        for (int n = 0; n < 2; ++n) {
            const int c = u.pn * 128 + wc * 32 + 16 * n + 4 * fq;
            const f32x4 g0 = *(const f32x4*)(cw + c), g1 = *(const f32x4*)(cw + 8192 + c), g2 = *(const f32x4*)(cw + 16384 + c), gb = *(const f32x4*)(cb + c);
            const f32x4 v0 = *(const f32x4*)(cw + 4096 + c), v1 = *(const f32x4*)(cw + 8192 + 4096 + c), v2 = *(const f32x4*)(cw + 16384 + 4096 + c), vb = *(const f32x4*)(cb + 4096 + c);
#pragma unroll
            for (int ai = 0; ai < 2; ++ai) {
                const int strip = 2 * ai + wr, tbase = ti * 248 + strip * 62 - 2;
                f32x4 pg = {0.f, 0.f, 0.f, 0.f}, pv = pg;
#pragma unroll
                for (int m = 0; m < 4; ++m) {
                    f32x4 xg = acc[ai][0][m][n], xv = acc[ai][1][m][n];
                    const int t = tbase + 16 * m + fr;
                    if (t < 0) { xg = (f32x4){0.f, 0.f, 0.f, 0.f}; xv = xg; }
                    f32x4 og, ov;
#pragma unroll
                    for (int j = 0; j < 4; ++j) {
                        const float gp1 = dpp_shr1(dpp_ror1(pg[j]), xg[j]), gp2 = dpp_shr2(dpp_ror2(pg[j]), xg[j]);
                        const float vp1 = dpp_shr1(dpp_ror1(pv[j]), xv[j]), vp2 = dpp_shr2(dpp_ror2(pv[j]), xv[j]);
                        og[j] = gb[j] + g0[j] * gp2 + g1[j] * gp1 + g2[j] * xg[j];
                        ov[j] = vb[j] + v0[j] * vp2 + v1[j] * vp1 + v2[j] * xv[j];
                        og[j] = gelu_fast(og[j]) * ov[j];
                    }
                    pg = xg; pv = xv;
                    if (16 * m + fr >= 2 && t < SEQ) {
                        const size_t o = ((size_t)bt * SEQ + t) * 4096 + c;
                        if (OUT8) { int pk = 0; pk = __builtin_amdgcn_cvt_pk_fp8_f32(og[0], og[1], pk, false); pk = __builtin_amdgcn_cvt_pk_fp8_f32(og[2], og[3], pk, true); *(int*)((unsigned char*)ACT + o) = pk; }
                        else st_bf16x4((bf16_t*)ACT + o, og);
                    }
                }
            }
        }
    }
};
struct FPool { bf16_t* CC; const float* pb; const float* ps;
    __device__ __forceinline__ void operator()(int r, int c, f32x4 v) const { const f32x4 b = *(const f32x4*)(pb + c), s = *(const f32x4*)(ps + c); st_bf16x4(CC + (size_t)r * 2048 + 1024 + c, (v + b) * s); } };
struct EpiLru {
    static constexpr bool PERM = false, AFTER_DRAIN = false, FP8 = false;
    const bf16_t* XCB; const float *ba, *bx, *lam; float *LA, *LB;
    __device__ __forceinline__ void operator()(const f32x4 (&acc)[2][2][4][2], const pg8::Unit& u, int wr, int wc, int fr, int fq) const {
        const int row0 = u.pm * 256 + wr * 64 + fr;
#pragma unroll
        for (int n = 0; n < 2; ++n) {
            const int ch = u.pn * 128 + wc * 32 + 16 * n + 4 * fq;
            const f32x4 bav = *(const f32x4*)(ba + ch), bxv = *(const f32x4*)(bx + ch), lm = *(const f32x4*)(lam + ch);
            f32x4 sp;
#pragma unroll
            for (int j = 0; j < 4; ++j) sp[j] = log1pf(__expf(-lm[j]));
#pragma unroll
            for (int ai = 0; ai < 2; ++ai)
#pragma unroll
                for (int m = 0; m < 4; ++m) {
                    const int row = row0 + ai * 128 + m * 16;
                    const u32x2 xw = *(const u32x2*)(XCB + (size_t)row * 1024 + ch);
                    const f32x4 xc = {__uint_as_float(xw.x << 16), __uint_as_float(xw.x & 0xFFFF0000u), __uint_as_float(xw.y << 16), __uint_as_float(xw.y & 0xFFFF0000u)};
                    const f32x4 ga = acc[ai][0][m][n] + bav, gx = acc[ai][1][m][n] + bxv;
                    f32x4 av, bv;
#pragma unroll
                    for (int j = 0; j < 4; ++j) {
                        const float rg = 1.0f / (1.0f + __expf(-ga[j])), ig = 1.0f / (1.0f + __expf(-gx[j]));
                        const float log_a = -8.0f * rg * sp[j], a = __expf(log_a), mult = sqrtf(-expm1f(2.0f * log_a));
                        av[j] = a; bv[j] = mult * (ig * xc[j]);
                    }
                    *(f32x4*)(LA + (size_t)row * 1024 + ch) = av; *(f32x4*)(LB + (size_t)row * 1024 + ch) = bv;
                }
        }
    }
};
__device__ __forceinline__ void ph_pooled(const float* __restrict__ U, bf16_t* __restrict__ P, int bid, int nblk) {
    for (int i = bid * 512 + opaque_tid(); i < 256 * (NTOK / 64); i += nblk * 512) {
        const int c4 = i & 255, row0 = (i >> 8) * 64, t0 = row0 % SEQ, g = c4 >> 6, win = 2 << g;
        const f32x4* up = (const f32x4*)U + (size_t)row0 * 256 + c4;
        f32x4 s = {0.f, 0.f, 0.f, 0.f};
        if (t0 > 0) { for (int k = 1; k < win; ++k) s += up[-(ptrdiff_t)k * 256]; }
#pragma unroll 8
        for (int r = 0; r < 64; ++r) {
            const int t = t0 + r; const f32x4 u0 = up[(ptrdiff_t)r * 256];
            s += u0;
            const int cnt = (t + 1 < win) ? (t + 1) : win;
            st_bf16x4(P + (size_t)(row0 + r) * 1024 + c4 * 4, s * (1.0f / (float)cnt) - u0);
            if (t + 1 >= win) s -= up[(ptrdiff_t)(r + 1 - win) * 256];
        }
    }
}
__device__ __forceinline__ void ph_xc(const bf16_t* __restrict__ XL, const float* __restrict__ cw, const float* __restrict__ cb, bf16_t* __restrict__ XCB, int bid, int nblk) {
    for (int i = bid * 512 + opaque_tid(); i < 128 * (NTOK / 32); i += nblk * 512) {
        const int c8 = (i & 127) * 8, row0 = (i >> 7) * 32, t0 = row0 % SEQ;
        float w0[8], w1[8], w2[8], w3[8], bb[8];
#pragma unroll
        for (int j = 0; j < 8; ++j) { w0[j] = cw[c8 + j]; w1[j] = cw[1024 + c8 + j]; w2[j] = cw[2048 + c8 + j]; w3[j] = cw[3072 + c8 + j]; bb[j] = cb[c8 + j]; }
        u32x4 p3 = {0u, 0u, 0u, 0u}, p2 = p3, p1 = p3;
        if (t0 >= 3) { p3 = *(const u32x4*)(XL + (size_t)(row0 - 3) * 1024 + c8); p2 = *(const u32x4*)(XL + (size_t)(row0 - 2) * 1024 + c8); p1 = *(const u32x4*)(XL + (size_t)(row0 - 1) * 1024 + c8); }
#pragma unroll 8
        for (int r = 0; r < 32; ++r) {
            const u32x4 cur = *(const u32x4*)(XL + (size_t)(row0 + r) * 1024 + c8);
            const unsigned a3[4] = {p3.x, p3.y, p3.z, p3.w}, a2[4] = {p2.x, p2.y, p2.z, p2.w}, a1[4] = {p1.x, p1.y, p1.z, p1.w}, a0[4] = {cur.x, cur.y, cur.z, cur.w};
            float y[8];
#pragma unroll
            for (int j = 0; j < 4; ++j) {
                y[2 * j] = bb[2 * j] + w0[2 * j] * __uint_as_float(a3[j] << 16) + w1[2 * j] * __uint_as_float(a2[j] << 16) + w2[2 * j] * __uint_as_float(a1[j] << 16) + w3[2 * j] * __uint_as_float(a0[j] << 16);
                y[2 * j + 1] = bb[2 * j + 1] + w0[2 * j + 1] * __uint_as_float(a3[j] & 0xFFFF0000u) + w1[2 * j + 1] * __uint_as_float(a2[j] & 0xFFFF0000u) + w2[2 * j + 1] * __uint_as_float(a1[j] & 0xFFFF0000u) + w3[2 * j + 1] * __uint_as_float(a0[j] & 0xFFFF0000u); }
            u32x4 o; o.x = pack2bf(y[0], y[1]); o.y = pack2bf(y[2], y[3]); o.z = pack2bf(y[4], y[5]); o.w = pack2bf(y[6], y[7]);
            *(u32x4*)(XCB + (size_t)(row0 + r) * 1024 + c8) = o;
            p3 = p2; p2 = p1; p1 = cur;
        }
    }
}
__device__ __forceinline__ int up_src_col(int n0) { return ((n0 >> 7) & 1) * 4096 + (n0 >> 8) * 128 + (n0 & 127); }
template <bool OUT8>
__device__ __forceinline__ void ph_convT_g(LAS unsigned char* lds, const float* __restrict__ W, int ldw, int src_col0, int ncols, int K, void* __restrict__ Bt, int ldd, int bid, int nblk, bool upperm) {
    const int tid = opaque_tid(), sub = tid >> 8, t8 = tid & 255;
    LAS float* tile = (LAS float*)lds + sub * (64 * 65);
    const int ntx = (ncols + 63) / 64, ntiles = ntx * (K / 64);
    for (int base = bid * 2; base < ntiles; base += nblk * 2) {
        const int tl = base + sub; const bool act = tl < ntiles;
        const int n0 = (tl % ntx) * 64, k0 = (tl / ntx) * 64;
        if (act) {
            const int c4 = (t8 & 15) * 4, kr = t8 >> 4;
            const int nsrc = src_col0 + (upperm ? up_src_col(n0 + c4) : n0 + c4);
#pragma unroll
            for (int i = 0; i < 4; ++i) { const int kl = kr + 16 * i;
                f32x4 v = {0.f, 0.f, 0.f, 0.f};
                if (n0 + c4 < ncols) v = *(const f32x4*)(W + (size_t)(k0 + kl) * ldw + nsrc);
                tile[kl * 65 + c4] = v[0]; tile[kl * 65 + c4 + 1] = v[1]; tile[kl * 65 + c4 + 2] = v[2]; tile[kl * 65 + c4 + 3] = v[3]; } }
        __syncthreads();
        if (act) {
            const int k8 = (t8 & 7) * 8, nr = t8 >> 3;
#pragma unroll
            for (int i = 0; i < 2; ++i) { const int nl = nr + 32 * i;
                if (n0 + nl < ncols) {
                    float v[8];
#pragma unroll
                    for (int j = 0; j < 8; ++j) v[j] = tile[(k8 + j) * 65 + nl];
                    if (OUT8) { int p0 = 0, p1 = 0;
                        p0 = __builtin_amdgcn_cvt_pk_fp8_f32(64.f * v[0], 64.f * v[1], p0, false); p0 = __builtin_amdgcn_cvt_pk_fp8_f32(64.f * v[2], 64.f * v[3], p0, true);
                        p1 = __builtin_amdgcn_cvt_pk_fp8_f32(64.f * v[4], 64.f * v[5], p1, false); p1 = __builtin_amdgcn_cvt_pk_fp8_f32(64.f * v[6], 64.f * v[7], p1, true);
                        u32x2 o; o.x = (unsigned)p0; o.y = (unsigned)p1; *(u32x2*)((unsigned char*)Bt + (size_t)(n0 + nl) * ldd + k0 + k8) = o; }
                    else { u32x4 o; o.x = pack2bf(v[0], v[1]); o.y = pack2bf(v[2], v[3]); o.z = pack2bf(v[4], v[5]); o.w = pack2bf(v[6], v[7]);
                        *(u32x4*)((bf16_t*)Bt + (size_t)(n0 + nl) * ldd + k0 + k8) = o; }
                } } }
        __syncthreads();
    }
}
__device__ __forceinline__ void ph_convT(LAS unsigned char* lds, const float* __restrict__ W, int ldw, int src_col0, int ncols, int K, bf16_t* __restrict__ Bt, int ldd, int bid, int nblk, bool upperm = false) {
    ph_convT_g<false>(lds, W, ldw, src_col0, ncols, K, Bt, ldd, bid, nblk, upperm);
}
__device__ __forceinline__ void ph_convT8(LAS unsigned char* lds, const float* __restrict__ W, int ldw, int ncols, int K, unsigned char* __restrict__ Bt, int bid, int nblk, bool upperm = false) {
    ph_convT_g<true>(lds, W, ldw, 0, ncols, K, Bt, K, bid, nblk, upperm);
}
template <int NC> __device__ __forceinline__ void ph_rmsnorm(const float* __restrict__ x, const float* __restrict__ g, bf16_t* __restrict__ out, int bid, int nblk, unsigned char* __restrict__ out8 = nullptr) {
    const int lane = opaque_tid() & 63, w = opaque_tid() >> 6;
    constexpr int NV = NC / 256;
    for (int row = bid * 8 + w; row < NTOK; row += nblk * 8) {
        const f32x4* xr = (const f32x4*)(x + (size_t)row * NC);
        f32x4 v[NV]; float ss = 0.f;
#pragma unroll
        for (int i = 0; i < NV; ++i) { v[i] = xr[lane + 64 * i]; ss += v[i][0] * v[i][0] + v[i][1] * v[i][1] + v[i][2] * v[i][2] + v[i][3] * v[i][3]; }
        ss = wave_sum(ss);
        const float r = rsqrtf(ss * (1.0f / NC) + NORM_EPS);
#pragma unroll
        for (int i = 0; i < NV; ++i) { const f32x4 gg = ((const f32x4*)g)[lane + 64 * i]; const f32x4 y = v[i] * r * gg; st_bf16x4(out + (size_t)row * NC + 4 * (lane + 64 * i), y);
            if (out8) { int pk = 0; pk = __builtin_amdgcn_cvt_pk_fp8_f32(y[0], y[1], pk, false); pk = __builtin_amdgcn_cvt_pk_fp8_f32(y[2], y[3], pk, true); *(int*)(out8 + (size_t)row * NC + 4 * (lane + 64 * i)) = pk; } }
    }
}
template <bool IN16, bool OUT16>
__device__ __forceinline__ void ph_resnorm(const void* xin, const bf16_t* __restrict__ m, const float* __restrict__ gpost, const float* __restrict__ gpre, void* xout, bf16_t* __restrict__ h, unsigned char* __restrict__ h8, int bid, int nblk) {
    const int tid_ = opaque_tid(), lane = tid_ & 63, w = tid_ >> 6;
    for (int row = bid * 8 + w; row < NTOK; row += nblk * 8) {
        const u32x2* mr = (const u32x2*)(m + (size_t)row * DM);
        f32x4 mv[8], xv[8]; float ss = 0.f;
#pragma unroll
        for (int i = 0; i < 8; ++i) { const u32x2 wd = mr[lane + 64 * i]; mv[i][0] = __uint_as_float(wd.x << 16); mv[i][1] = __uint_as_float(wd.x & 0xFFFF0000u); mv[i][2] = __uint_as_float(wd.y << 16); mv[i][3] = __uint_as_float(wd.y & 0xFFFF0000u);
            if (IN16) { const u32x2 xw = ((const u32x2*)((const bf16_t*)xin + (size_t)row * DM))[lane + 64 * i];
                xv[i][0] = __uint_as_float(xw.x << 16); xv[i][1] = __uint_as_float(xw.x & 0xFFFF0000u); xv[i][2] = __uint_as_float(xw.y << 16); xv[i][3] = __uint_as_float(xw.y & 0xFFFF0000u); }
            else xv[i] = ((const f32x4*)((const float*)xin + (size_t)row * DM))[lane + 64 * i];
            ss += mv[i][0] * mv[i][0] + mv[i][1] * mv[i][1] + mv[i][2] * mv[i][2] + mv[i][3] * mv[i][3]; }
        ss = wave_sum(ss);
        const float r1 = rsqrtf(ss * (1.0f / DM) + NORM_EPS);
        float s2 = 0.f;
#pragma unroll
        for (int i = 0; i < 8; ++i) { const f32x4 gg = ((const f32x4*)gpost)[lane + 64 * i]; xv[i] = xv[i] + mv[i] * r1 * gg;
            if (OUT16) st_bf16x4((bf16_t*)xout + (size_t)row * DM + 4 * (lane + 64 * i), xv[i]); else ((f32x4*)((float*)xout + (size_t)row * DM))[lane + 64 * i] = xv[i];
            s2 += xv[i][0] * xv[i][0] + xv[i][1] * xv[i][1] + xv[i][2] * xv[i][2] + xv[i][3] * xv[i][3]; }
        if (gpre) {
            s2 = wave_sum(s2);
            const float r2 = rsqrtf(s2 * (1.0f / DM) + NORM_EPS);
#pragma unroll
            for (int i = 0; i < 8; ++i) { const f32x4 gg = ((const f32x4*)gpre)[lane + 64 * i]; const f32x4 y = xv[i] * r2 * gg;
                if (h8) { int pk = 0; pk = __builtin_amdgcn_cvt_pk_fp8_f32(y[0], y[1], pk, false); pk = __builtin_amdgcn_cvt_pk_fp8_f32(y[2], y[3], pk, true); *(int*)(h8 + (size_t)row * DM + 4 * (lane + 64 * i)) = pk; }
                else st_bf16x4(h + (size_t)row * DM + 4 * (lane + 64 * i), y); }
        }
    }
}
__device__ __forceinline__ void ph_scan1(const float* __restrict__ Aa, const float* __restrict__ Bb, float* __restrict__ CA, float* __restrict__ CH, int bid, int nblk) {
    for (int i = bid * 512 + opaque_tid(); i < 2 * 256 * 1024; i += nblk * 512) {
        const int ch = i & 1023, chunk = (i >> 10) & 255, b = i >> 18;
        const size_t base = ((size_t)b * SEQ + (size_t)chunk * 64) * 1024 + ch;
        float h = 0.f, P = 1.f;
#pragma unroll 8
        for (int s = 0; s < 64; ++s) { const float a = Aa[base + (size_t)s * 1024]; h = a * h + Bb[base + (size_t)s * 1024]; P *= a; }
        CA[i] = P; CH[i] = h;
    }
}
__device__ __forceinline__ void ph_scan2(const float* __restrict__ CA, const float* __restrict__ CH, float* __restrict__ CIN, int bid, int nblk) {
    for (int i = bid * 512 + opaque_tid(); i < 2048; i += nblk * 512) {
        const int ch = i & 1023, b = i >> 10;
        float h = 0.f;
#pragma unroll 8
        for (int c = 0; c < 256; ++c) { const int j = (b * 256 + c) * 1024 + ch; CIN[j] = h; h = CA[j] * h + CH[j]; }
    }
}
__device__ __forceinline__ void ph_scan3(const float* __restrict__ Aa, const float* __restrict__ Bb, const float* __restrict__ CIN, const bf16_t* __restrict__ YG, bf16_t* __restrict__ CC, int bid, int nblk) {
    for (int i = bid * 512 + opaque_tid(); i < 2 * 256 * 1024; i += nblk * 512) {
        const int ch = i & 1023, chunk = (i >> 10) & 255, b = i >> 18;
        const size_t row0 = (size_t)b * SEQ + (size_t)chunk * 64;
        float h = CIN[i];
#pragma unroll 8
        for (int s = 0; s < 64; ++s) { const size_t r = row0 + s; h = Aa[r * 1024 + ch] * h + Bb[r * 1024 + ch];
            CC[r * 2048 + 1024 + ch] = f2bf(h * gelu_tanh(bf2f(YG[r * 1024 + ch]))); }
    }
}
__device__ __forceinline__ void ph_rope_q(const bf16_t* __restrict__ Q1, const int* __restrict__ pos, unsigned char* __restrict__ Q8, int bid, int nblk) {
    for (int idx = bid * 512 + opaque_tid(); idx < NTOK * 8 * 4; idx += nblk * 512) {
        const int g = idx & 3, h = (idx >> 2) & 7, row = idx >> 5;
        const bf16_t* p = Q1 + (size_t)row * 1536 + h * 192; unsigned char* q = Q8 + (size_t)row * 1536 + h * 192;
#pragma unroll
        for (int k = 0; k < 4; ++k) { const u32x4 w = *(const u32x4*)(p + 32 * g + 8 * k);
            int p0 = 0, p1 = 0;
            p0 = __builtin_amdgcn_cvt_pk_fp8_f32(__uint_as_float(w.x << 16), __uint_as_float(w.x & 0xFFFF0000u), p0, false); p0 = __builtin_amdgcn_cvt_pk_fp8_f32(__uint_as_float(w.y << 16), __uint_as_float(w.y & 0xFFFF0000u), p0, true);
            p1 = __builtin_amdgcn_cvt_pk_fp8_f32(__uint_as_float(w.z << 16), __uint_as_float(w.z & 0xFFFF0000u), p1, false); p1 = __builtin_amdgcn_cvt_pk_fp8_f32(__uint_as_float(w.w << 16), __uint_as_float(w.w & 0xFFFF0000u), p1, true);
            u32x2 o; o.x = (unsigned)p0; o.y = (unsigned)p1; *(u32x2*)(q + 32 * g + 8 * k) = o; }
        const u32x4 w1 = *(const u32x4*)(p + 128 + 8 * g), w2 = *(const u32x4*)(p + 160 + 8 * g);
        const unsigned a1[4] = {w1.x, w1.y, w1.z, w1.w}, a2[4] = {w2.x, w2.y, w2.z, w2.w};
        float o1[8], o2[8]; const int ps = pos[row];
#pragma unroll
        for (int j = 0; j < 8; ++j) { float cs, sn; rope_cs(ps, 8 * g + j, cs, sn);
            const float x1 = (j & 1) ? __uint_as_float(a1[j >> 1] & 0xFFFF0000u) : __uint_as_float(a1[j >> 1] << 16), x2 = (j & 1) ? __uint_as_float(a2[j >> 1] & 0xFFFF0000u) : __uint_as_float(a2[j >> 1] << 16);
            o1[j] = x1 * cs - x2 * sn; o2[j] = x2 * cs + x1 * sn; }
        int p0 = 0, p1 = 0, p2 = 0, p3 = 0;
        p0 = __builtin_amdgcn_cvt_pk_fp8_f32(o1[0], o1[1], p0, false); p0 = __builtin_amdgcn_cvt_pk_fp8_f32(o1[2], o1[3], p0, true); p1 = __builtin_amdgcn_cvt_pk_fp8_f32(o1[4], o1[5], p1, false); p1 = __builtin_amdgcn_cvt_pk_fp8_f32(o1[6], o1[7], p1, true);
        p2 = __builtin_amdgcn_cvt_pk_fp8_f32(o2[0], o2[1], p2, false); p2 = __builtin_amdgcn_cvt_pk_fp8_f32(o2[2], o2[3], p2, true); p3 = __builtin_amdgcn_cvt_pk_fp8_f32(o2[4], o2[5], p3, false); p3 = __builtin_amdgcn_cvt_pk_fp8_f32(o2[6], o2[7], p3, true);
        u32x2 oa; oa.x = (unsigned)p0; oa.y = (unsigned)p1; *(u32x2*)(q + 128 + 8 * g) = oa;
        u32x2 ob; ob.x = (unsigned)p2; ob.y = (unsigned)p3; *(u32x2*)(q + 160 + 8 * g) = ob;
    }
}
__device__ __forceinline__ void ph_rope_k(const float* __restrict__ KR, const int* __restrict__ pos, unsigned char* __restrict__ K8, int bid, int nblk) {
    for (int idx = bid * 512 + opaque_tid(); idx < NTOK * 32; idx += nblk * 512) {
        const int i = idx & 31, row = idx >> 5;
        float c, s; rope_cs(pos[row], i, c, s);
        const float x1 = KR[(size_t)row * 64 + i], x2 = KR[(size_t)row * 64 + 32 + i];
        const int pk = __builtin_amdgcn_cvt_pk_fp8_f32(x1 * c - x2 * s, x2 * c + x1 * s, 0, false);
        const unsigned char o1 = (unsigned char)(pk & 0xFF), o2 = (unsigned char)((pk >> 8) & 0xFF);
#pragma unroll
        for (int h = 0; h < 8; ++h) { unsigned char* p = K8 + (size_t)row * 1536 + h * 192 + 128; p[i] = o1; p[32 + i] = o2; }
    }
}
template <bool OUT8> __device__ __forceinline__ void ph_ffn_gate(const bf16_t* __restrict__ HID, const float* __restrict__ cw, const float* __restrict__ cb, bf16_t* __restrict__ ACT, int bid, int nblk) {
    for (int i = bid * 512 + opaque_tid(); i < 512 * (SEQ / 64); i += nblk * 512) {
        const int c8 = (i & 511) * 8, t0 = (i >> 9) * 64;
        float wg[3][8], wv[3][8], bg[8], bv[8];
#pragma unroll
        for (int j = 0; j < 8; ++j) { bg[j] = cb[c8 + j]; bv[j] = cb[4096 + c8 + j];
#pragma unroll
            for (int k = 0; k < 3; ++k) { wg[k][j] = cw[k * 8192 + c8 + j]; wv[k][j] = cw[k * 8192 + 4096 + c8 + j]; } }
        u32x4 g2 = {0u, 0u, 0u, 0u}, g1 = g2, v2 = g2, v1 = g2;
        if (t0 >= 2) { g2 = *(const u32x4*)(HID + (size_t)(t0 - 2) * 8192 + c8); g1 = *(const u32x4*)(HID + (size_t)(t0 - 1) * 8192 + c8);
                       v2 = *(const u32x4*)(HID + (size_t)(t0 - 2) * 8192 + 4096 + c8); v1 = *(const u32x4*)(HID + (size_t)(t0 - 1) * 8192 + 4096 + c8); }
#pragma unroll 8
        for (int r = 0; r < 64; ++r) {
            const u32x4 g0 = *(const u32x4*)(HID + (size_t)(t0 + r) * 8192 + c8), v0 = *(const u32x4*)(HID + (size_t)(t0 + r) * 8192 + 4096 + c8);
            const unsigned G2[4] = {g2.x, g2.y, g2.z, g2.w}, G1[4] = {g1.x, g1.y, g1.z, g1.w}, G0[4] = {g0.x, g0.y, g0.z, g0.w};
            const unsigned V2[4] = {v2.x, v2.y, v2.z, v2.w}, V1[4] = {v1.x, v1.y, v1.z, v1.w}, V0[4] = {v0.x, v0.y, v0.z, v0.w};
            float o[8];
#pragma unroll
            for (int j = 0; j < 4; ++j) {
                const float ge = bg[2 * j] + wg[0][2 * j] * __uint_as_float(G2[j] << 16) + wg[1][2 * j] * __uint_as_float(G1[j] << 16) + wg[2][2 * j] * __uint_as_float(G0[j] << 16);
                const float go = bg[2 * j + 1] + wg[0][2 * j + 1] * __uint_as_float(G2[j] & 0xFFFF0000u) + wg[1][2 * j + 1] * __uint_as_float(G1[j] & 0xFFFF0000u) + wg[2][2 * j + 1] * __uint_as_float(G0[j] & 0xFFFF0000u);
                const float ve = bv[2 * j] + wv[0][2 * j] * __uint_as_float(V2[j] << 16) + wv[1][2 * j] * __uint_as_float(V1[j] << 16) + wv[2][2 * j] * __uint_as_float(V0[j] << 16);
                const float vo = bv[2 * j + 1] + wv[0][2 * j + 1] * __uint_as_float(V2[j] & 0xFFFF0000u) + wv[1][2 * j + 1] * __uint_as_float(V1[j] & 0xFFFF0000u) + wv[2][2 * j + 1] * __uint_as_float(V0[j] & 0xFFFF0000u);
                o[2 * j] = gelu_tanh(ge) * ve; o[2 * j + 1] = gelu_tanh(go) * vo; }
            if (OUT8) { int p0 = 0, p1 = 0;
                p0 = __builtin_amdgcn_cvt_pk_fp8_f32(o[0], o[1], p0, false); p0 = __builtin_amdgcn_cvt_pk_fp8_f32(o[2], o[3], p0, true);
                p1 = __builtin_amdgcn_cvt_pk_fp8_f32(o[4], o[5], p1, false); p1 = __builtin_amdgcn_cvt_pk_fp8_f32(o[6], o[7], p1, true);
                u32x2 ov; ov.x = (unsigned)p0; ov.y = (unsigned)p1; *(u32x2*)((unsigned char*)ACT + (size_t)(t0 + r) * 4096 + c8) = ov; }
            else { u32x4 ov; ov.x = pack2bf(o[0], o[1]); ov.y = pack2bf(o[2], o[3]); ov.z = pack2bf(o[4], o[5]); ov.w = pack2bf(o[6], o[7]);
                *(u32x4*)(ACT + (size_t)(t0 + r) * 4096 + c8) = ov; }
            g2 = g1; g1 = g0; v2 = v1; v1 = v0;
        }
    }
}

__device__ __forceinline__ void ph_conv_lru(const float* __restrict__ wa, const float* __restrict__ wx, bf16_t* __restrict__ Bt, int bid, int nblk) {
    for (int e = bid * 512 + opaque_tid(); e < 8 * 2 * 128 * 128; e += nblk * 512) {
        const int d = e & 127, c = (e >> 7) & 127, gate = (e >> 14) & 1, nb = e >> 15;
        const float v = (gate ? wx : wa)[((size_t)nb * 128 + c) * 128 + d];
        bf16_t* row = Bt + (size_t)(nb * 256 + gate * 128 + d) * 256;
        row[(nb & 1) * 128 + c] = f2bf(v); row[(1 - (nb & 1)) * 128 + c] = 0;
    }
}

static constexpr size_t MiB = 1048576;
static constexpr size_t W_UP0 = 0 * MiB, W_UP1 = 32 * MiB, W_DN0 = 64 * MiB, W_DN1 = 80 * MiB, W_ABIN = 96 * MiB, W_ABOUT = 117 * MiB, W_CDIN = 125 * MiB, W_CDOUT = 137 * MiB,
                        W_QUP = 145 * MiB, W_KVUP = 146 * MiB + 512 * 1024, W_POOL = 147 * MiB + 512 * 1024;
static constexpr size_t R_H = 148 * MiB;
static constexpr size_t R_Q0 = 276 * MiB, R_K0 = 340 * MiB, R_VT0 = 404 * MiB, R_QI = 468 * MiB, R_M0 = 468 * MiB, R_U = 596 * MiB, R_KI = 724 * MiB, R_WI = 732 * MiB, R_MASK = 734 * MiB, R_CC0 = 830 * MiB, R_POOLED = 958 * MiB, R_H8A = 830 * MiB;
static constexpr size_t R_HID = 276 * MiB, R_ACT = 532 * MiB, R_F = 660 * MiB, R_X3 = 788 * MiB;
static constexpr size_t R_VT1 = 276 * MiB, R_CQ = 276 * MiB, R_CKV = 340 * MiB, R_KR = 372 * MiB, R_XL = 380 * MiB, R_YG = 444 * MiB, R_CQN = 508 * MiB, R_CKVN = 540 * MiB, R_LA = 556 * MiB, R_LB = 684 * MiB,
                        R_Q1 = 812 * MiB, R_K1 = 908 * MiB, R_Q8 = 956 * MiB,     R_CA = 1004 * MiB, R_CH = 1006 * MiB, R_CIN = 1008 * MiB, R_CC1 = 148 * MiB, R_M1 = 276 * MiB, R_XCB = 148 * MiB, W_LRU = 1010 * MiB;
static constexpr size_t WS_BAR = 1022 * MiB, WS_NEED = 1022 * MiB + 65536;
static constexpr int MK_LDS = 162816;

struct MK { const float* in[28]; float* out; unsigned char* ws; int ph_lo, ph_hi; };

__global__ __launch_bounds__(512, 2) void k_mega(MK p) {
    extern __shared__ __attribute__((aligned(16))) unsigned char shm[];
    LAS unsigned char* lds = (LAS unsigned char*)shm;
    const int bid0 = (int)blockIdx.x, nblk0 = (int)gridDim.x;
    volatile LAS unsigned* xbw = (volatile LAS unsigned*)(lds + MK_LDS - 16);
    if (threadIdx.x == 0) { xbw[0] = 0u; xbw[1] = 0u; xbw[2] = 0u; xbw[3] = 0u; }
    if ((threadIdx.x & 63) == 0) *(volatile LAS int*)(size_t)(TID_TAB_LDS + 4 * ((unsigned)__builtin_amdgcn_s_getreg(((6 - 1) << 11) | 4) & 63u)) = (int)(threadIdx.x >> 6);
    __syncthreads();
    XcdBarrier bar = xcd_barrier_post((unsigned*)(p.ws + WS_BAR), xbw);
#ifndef KARG_PLAIN
#define KARG_PLAIN 0
#endif
#if KARG_PLAIN
#define KARG_DECL const MK& P_ = p;
#else
#define KARG_DECL KPtr P__ = kp; asm volatile("" : "+s"(P__)); const __attribute__((address_space(4))) MK& P_ = *P__;
#endif
    typedef const __attribute__((address_space(4))) MK* KPtr;
    KPtr kp = (KPtr)__builtin_amdgcn_kernarg_segment_ptr();
#define WSP(T, off) ((T*)(ws + (off)))
#define PHASE_BEGIN if (pc >= p.ph_lo && pc < p.ph_hi) { const int bid = opaque_s(bid0), nblk = opaque_s(nblk0); \
    KARG_DECL unsigned char* const ws = P_.ws; float* const xo = P_.out; const float* const x = P_.in[0]; const int* const positions = (const int*)P_.in[1]; \
    const float *const mix_pre_g = P_.in[2], *const mix_post_g = P_.in[3], *const ffn_pre_g = P_.in[4], *const ffn_post_g = P_.in[5], *const ffn_up = P_.in[6], *const ffn_conv_w = P_.in[7], *const ffn_conv_b = P_.in[8], *const ffn_down = P_.in[9], \
    *const ab_w_in = P_.in[10], *const pool_w = P_.in[11], *const pool_b = P_.in[12], *const pool_scale = P_.in[13], *const ab_w_out = P_.in[14], *const cd_w_in = P_.in[15], *const q_norm_g = P_.in[16], *const w_q_up = P_.in[17], \
    *const kv_norm_g = P_.in[18], *const w_kv_up = P_.in[19], *const lru_conv_w = P_.in[20], *const lru_conv_b = P_.in[21], *const lru_wa = P_.in[22], *const lru_ba = P_.in[23], *const lru_wx = P_.in[24], *const lru_bx = P_.in[25], \
    *const lru_lambda = P_.in[26], *const cd_w_out = P_.in[27]; bf16_t* const H = WSP(bf16_t, R_H); const bf16_t* const CC = WSP(bf16_t, LAYER_CC); bf16_t* const Mx = WSP(bf16_t, LAYER_MX); \
    (void)xo; (void)x; (void)positions; (void)mix_pre_g; (void)mix_post_g; (void)ffn_pre_g; (void)ffn_post_g; (void)ffn_up; (void)ffn_conv_w; (void)ffn_conv_b; (void)ffn_down; (void)ab_w_in; (void)pool_w; (void)pool_b; (void)pool_scale; \
    (void)ab_w_out; (void)cd_w_in; (void)q_norm_g; (void)w_q_up; (void)kv_norm_g; (void)w_kv_up; (void)lru_conv_w; (void)lru_conv_b; (void)lru_wa; (void)lru_ba; (void)lru_wx; (void)lru_bx; (void)lru_lambda; (void)cd_w_out; (void)H; (void)CC; (void)Mx;
#define PHASE_END } if (pc >= p.ph_lo && pc + 1 < p.ph_hi) xcd_barrier(bar); ++pc;
    int pc = 0;
#define LAYER_CC R_CC0
#define LAYER_MX R_M0
    PHASE_BEGIN
#if !((SKIPMASK >> 0) & 1)
#if FP8_UP0
        ph_convT8(lds, ffn_up, 8192, 8192, 2048, WSP(unsigned char, W_UP0), bid, nblk, true);
#else
        ph_convT(lds, ffn_up, 8192, 0, 8192, 2048, WSP(bf16_t, W_UP0), 2048, bid, nblk, true);
#endif
#if FP8_UP1
        ph_convT8(lds, ffn_up + (size_t)2048 * 8192, 8192, 8192, 2048, WSP(unsigned char, W_UP1), bid, nblk, true);
#else
        ph_convT(lds, ffn_up + (size_t)2048 * 8192, 8192, 0, 8192, 2048, WSP(bf16_t, W_UP1), 2048, bid, nblk, true);
#endif
#if FP8_DN0
        ph_convT8(lds, ffn_down, 2048, 2048, 4096, WSP(unsigned char, W_DN0), bid, nblk);
#else
        ph_convT(lds, ffn_down, 2048, 0, 2048, 4096, WSP(bf16_t, W_DN0), 4096, bid, nblk);
#endif
#if FP8_DN1
        ph_convT8(lds, ffn_down + (size_t)4096 * 2048, 2048, 2048, 4096, WSP(unsigned char, W_DN1), bid, nblk);
#else
        ph_convT(lds, ffn_down + (size_t)4096 * 2048, 2048, 0, 2048, 4096, WSP(bf16_t, W_DN1), 4096, bid, nblk);
#endif
#if FP8_QKV
        ph_convT8(lds, ab_w_in, 5200, 3072, 2048, WSP(unsigned char, W_ABIN), bid, nblk);
        ph_convT(lds, ab_w_in, 5200, 3072, 1024, 2048, WSP(bf16_t, W_ABIN) + (size_t)3072 * 2048, 2048, bid, nblk);
#else
        ph_convT(lds, ab_w_in, 5200, 0, 4096, 2048, WSP(bf16_t, W_ABIN), 2048, bid, nblk);
#endif
        ph_convT(lds, ab_w_in, 5200, 4176, 1024, 2048, WSP(bf16_t, W_ABIN) + (size_t)4096 * 2048, 2048, bid, nblk);
        ph_convT(lds, ab_w_in, 5200, 4096, 64, 2048, WSP(bf16_t, W_ABIN) + (size_t)5120 * 2048, 2048, bid, nblk);
        ph_convT(lds, ab_w_in, 5200, 4160, 16, 2048, WSP(bf16_t, W_ABIN) + (size_t)5184 * 2048, 2048, bid, nblk);
        ph_convT(lds, ab_w_out, 2048, 0, 2048, 2048, WSP(bf16_t, W_ABOUT), 2048, bid, nblk);
        ph_convT(lds, cd_w_in, 2880, 0, 832, 2048, WSP(bf16_t, W_CDIN), 2048, bid, nblk);
        ph_convT(lds, cd_w_in, 2880, 832, 2048, 2048, WSP(bf16_t, W_CDIN) + (size_t)1024 * 2048, 2048, bid, nblk);
        ph_convT(lds, cd_w_out, 2048, 0, 2048, 2048, WSP(bf16_t, W_CDOUT), 2048, bid, nblk);
        ph_convT(lds, w_q_up, 1536, 0, 1536, 512, WSP(bf16_t, W_QUP), 512, bid, nblk);
        ph_convT(lds, w_kv_up, 2048, 0, 2048, 256, WSP(bf16_t, W_KVUP), 256, bid, nblk);
        for (int g = 0; g < 4; ++g) ph_convT(lds, pool_w + (size_t)g * 65536, 256, 0, 256, 256, WSP(bf16_t, W_POOL) + (size_t)g * 65536, 256, bid, nblk);
        ph_rmsnorm<2048>(x, mix_pre_g, H, bid, nblk, FP8_QKV ? WSP(unsigned char, R_H8A) : (unsigned char*)nullptr);
#endif
    PHASE_END
    {
            PHASE_BEGIN
#if !((SKIPMASK >> 1) & 1)
                FAbIn2 f; f.Q = WSP(bf16_t, R_Q0); f.K = WSP(bf16_t, R_K0); f.VT = WSP(bf16_t, R_VT0); f.QI = WSP(float, R_QI); f.U = WSP(float, R_U); f.WI = WSP(float, R_WI); f.KI16 = WSP(unsigned short, R_KI);
#if FP8_QKV
                ph_gemm8(lds, WSP(unsigned char, R_H8A), 2048, WSP(unsigned char, W_ABIN), 2048, NTOK, 3072, 2048, f, bid, nblk);
                { FAbInHi fh; fh.f = f; ph_gemm(lds, H, 2048, WSP(bf16_t, W_ABIN) + (size_t)3072 * 2048, 2048, NTOK, 2304, 2048, fh, bid, nblk); }
#else
                ph_gemm(lds, H, 2048, WSP(bf16_t, W_ABIN), 2048, NTOK, 5376, 2048, f, bid, nblk);
#endif
#endif
            PHASE_END
            PHASE_BEGIN
#if !((SKIPMASK >> 2) & 1)
                ph_pooled(WSP(float, R_U), WSP(bf16_t, R_POOLED), bid, nblk);
                IdxArgs a; a.QI = WSP(float, R_QI); a.KI16 = WSP(unsigned short, R_KI); a.WI = WSP(float, R_WI); a.MT = WSP(unsigned long long, R_MASK);
                idx_phase(lds, a, bid, nblk);
#endif
            PHASE_END
            PHASE_BEGIN
#if !((SKIPMASK >> 3) & 1)
                { FPool f; f.CC = WSP(bf16_t, R_CC0); f.pb = pool_b; f.ps = pool_scale; ph_gemm(lds, WSP(bf16_t, R_POOLED), 1024, WSP(bf16_t, W_POOL), 256, NTOK, 1024, 256, f, bid, nblk, 0, 512); }
                AttnArgs a; a.Q = WSP(bf16_t, R_Q0); a.K = WSP(bf16_t, R_K0); a.VT = WSP(bf16_t, R_VT0); a.MT = WSP(unsigned long long, R_MASK); a.O = WSP(bf16_t, R_CC0); a.ldq = 1024; a.ldk = 1024; a.ldo = 2048;
                a.sc_log2e = 0.08838834764831845f * 1.4426950408889634f;
                attn_phase<128, true>(lds, a, bid, nblk);
#endif
            PHASE_END
        PHASE_BEGIN
#if !((SKIPMASK >> 4) & 1)
            FStoreBf16 f; f.O = Mx; f.ldc = 2048; f.pad_ = 0;
            ph_gemm(lds, CC, 2048, WSP(bf16_t, W_ABOUT), 2048, NTOK, 2048, 2048, f, bid, nblk);
#endif
        PHASE_END
        PHASE_BEGIN
#if !((SKIPMASK >> 5) & 1)
            ph_resnorm<false, true>(x, Mx, mix_post_g + 0, ffn_pre_g + 0, xo, H, FP8_UP0 ? WSP(unsigned char, R_H) : (unsigned char*)nullptr, bid, nblk);
#endif
        PHASE_END
        PHASE_BEGIN
#if FP8_UP0
            { EpiGate<FP8_DN0 != 0, true> ep; ep.cw = ffn_conv_w + 0; ep.cb = ffn_conv_b + 0; ep.ACT = WSP(void, R_HID);
              ph_gemm_e(lds, (const bf16_t*)WSP(unsigned char, R_H), 1024, (const bf16_t*)WSP(unsigned char, W_UP0), 1024, 134 * 256, 8192, 1024, ep, bid, nblk, 0, 0, 1); }
#else
            { EpiGate<FP8_DN0 != 0, false> ep; ep.cw = ffn_conv_w + 0; ep.cb = ffn_conv_b + 0; ep.ACT = WSP(void, R_HID);
              ph_gemm_e(lds, H, 2048, WSP(bf16_t, W_UP0), 2048, 134 * 256, 8192, 2048, ep, bid, nblk, 0, 0, 1); }
#endif
        PHASE_END
        PHASE_BEGIN
            FStoreBf16 f; f.O = WSP(bf16_t, R_F); f.ldc = 2048; f.pad_ = 0;
#if FP8_DN0
            ph_gemm8(lds, WSP(unsigned char, R_HID), 4096, WSP(unsigned char, W_DN0), 4096, NTOK, 2048, 4096, f, bid, nblk);
#else
            ph_gemm(lds, WSP(bf16_t, R_HID), 4096, WSP(bf16_t, W_DN0), 4096, NTOK, 2048, 4096, f, bid, nblk);
#endif
        PHASE_END
        PHASE_BEGIN
#if !((SKIPMASK >> 9) & 1)
            ph_resnorm<true, true>(xo, WSP(bf16_t, R_F), ffn_post_g + 0, mix_pre_g + 2048, xo, H, nullptr, bid, nblk);
#endif
        PHASE_END
    }
    {
#undef LAYER_CC
#undef LAYER_MX
#define LAYER_CC R_CC1
#define LAYER_MX R_M1
            PHASE_BEGIN
#if !((SKIPMASK >> 10) & 1)
                FCdIn f; f.CQ = WSP(float, R_CQ); f.CKV = WSP(float, R_CKV); f.KR = WSP(float, R_KR); f.XL = WSP(bf16_t, R_XL); f.YG = WSP(bf16_t, R_YG);
                ph_gemm(lds, H, 2048, WSP(bf16_t, W_CDIN), 2048, NTOK, 3072, 2048, f, bid, nblk);
#endif
            PHASE_END
            PHASE_BEGIN
#if !((SKIPMASK >> 11) & 1)
                ph_xc(WSP(bf16_t, R_XL), lru_conv_w, lru_conv_b, WSP(bf16_t, R_XCB), bid, nblk);
                ph_conv_lru(lru_wa, lru_wx, WSP(bf16_t, W_LRU), bid, nblk);
                ph_rmsnorm<512>(WSP(float, R_CQ), q_norm_g, WSP(bf16_t, R_CQN), bid, nblk);
                ph_rmsnorm<256>(WSP(float, R_CKV), kv_norm_g, WSP(bf16_t, R_CKVN), bid, nblk);
            PHASE_END
            PHASE_BEGIN
                { EpiLru ep; ep.XCB = WSP(bf16_t, R_XCB); ep.ba = lru_ba; ep.bx = lru_bx; ep.lam = lru_lambda; ep.LA = WSP(float, R_LA); ep.LB = WSP(float, R_LB);
                  ph_gemm_e(lds, WSP(bf16_t, R_XCB), 1024, WSP(bf16_t, W_LRU), 256, NTOK, 2048, 256, ep, bid, nblk, 1, 512); }
                { FStoreBf16 f; f.O = WSP(bf16_t, R_Q1); f.ldc = 1536; f.pad_ = 0; ph_gemm(lds, WSP(bf16_t, R_CQN), 512, WSP(bf16_t, W_QUP), 512, NTOK, 1536, 512, f, bid, nblk); }
                { FKvUp2 f; f.K8 = WSP(unsigned char, R_K1); f.VT = WSP(bf16_t, R_VT1); ph_gemm(lds, WSP(bf16_t, R_CKVN), 256, WSP(bf16_t, W_KVUP), 256, NTOK, 2048, 256, f, bid, nblk); }
            PHASE_END
            PHASE_BEGIN
                ph_scan1(WSP(float, R_LA), WSP(float, R_LB), WSP(float, R_CA), WSP(float, R_CH), bid, nblk);
                ph_rope_q(WSP(bf16_t, R_Q1), positions, WSP(unsigned char, R_Q8), bid, nblk);
                ph_rope_k(WSP(float, R_KR), positions, WSP(unsigned char, R_K1), bid, nblk);
            PHASE_END
            PHASE_BEGIN
                ph_scan2(WSP(float, R_CA), WSP(float, R_CH), WSP(float, R_CIN), bid, nblk);
            PHASE_END
            PHASE_BEGIN
                ph_scan3(WSP(float, R_LA), WSP(float, R_LB), WSP(float, R_CIN), WSP(bf16_t, R_YG), WSP(bf16_t, R_CC1), bid, nblk);
                AttnArgs a; a.Q = WSP(bf16_t, R_Q8); a.K = WSP(bf16_t, R_K1); a.VT = WSP(bf16_t, R_VT1); a.MT = nullptr; a.O = WSP(bf16_t, R_CC1); a.ldq = 1536; a.ldk = 1536; a.ldo = 2048;
                a.sc_log2e = 0.07216878364870322f * 1.4426950408889634f;
                attn_phase<192, false>(lds, a, bid, nblk);
#endif
            PHASE_END
        PHASE_BEGIN
#if !((SKIPMASK >> 15) & 1)
            FStoreBf16 f; f.O = Mx; f.ldc = 2048; f.pad_ = 0;
            ph_gemm(lds, CC, 2048, WSP(bf16_t, W_CDOUT), 2048, NTOK, 2048, 2048, f, bid, nblk);
#endif
        PHASE_END
        PHASE_BEGIN
#if !((SKIPMASK >> 16) & 1)
            ph_resnorm<true, true>(xo, Mx, mix_post_g + 2048, ffn_pre_g + 2048, WSP(bf16_t, R_X3), H, FP8_UP1 ? WSP(unsigned char, R_H) : (unsigned char*)nullptr, bid, nblk);
#endif
        PHASE_END
        PHASE_BEGIN
#if FP8_UP1
            { EpiGate<FP8_DN1 != 0, true> ep; ep.cw = ffn_conv_w + 24576; ep.cb = ffn_conv_b + 8192; ep.ACT = WSP(void, R_HID);
              ph_gemm_e(lds, (const bf16_t*)WSP(unsigned char, R_H), 1024, (const bf16_t*)WSP(unsigned char, W_UP1), 1024, 134 * 256, 8192, 1024, ep, bid, nblk, 0, 0, 1); }
#else
            { EpiGate<FP8_DN1 != 0, false> ep; ep.cw = ffn_conv_w + 24576; ep.cb = ffn_conv_b + 8192; ep.ACT = WSP(void, R_HID);
              ph_gemm_e(lds, H, 2048, WSP(bf16_t, W_UP1), 2048, 134 * 256, 8192, 2048, ep, bid, nblk, 0, 0, 1); }
#endif
        PHASE_END
        PHASE_BEGIN
            FStoreBf16 f; f.O = WSP(bf16_t, R_F); f.ldc = 2048; f.pad_ = 0;
#if FP8_DN1
            ph_gemm8(lds, WSP(unsigned char, R_HID), 4096, WSP(unsigned char, W_DN1), 4096, NTOK, 2048, 4096, f, bid, nblk);
#else
            ph_gemm(lds, WSP(bf16_t, R_HID), 4096, WSP(bf16_t, W_DN1), 4096, NTOK, 2048, 4096, f, bid, nblk);
#endif
        PHASE_END
        PHASE_BEGIN
#if !((SKIPMASK >> 20) & 1)
            ph_resnorm<true, false>(WSP(bf16_t, R_X3), WSP(bf16_t, R_F), ffn_post_g + 2048, (const float*)nullptr, xo, H, nullptr, bid, nblk);
#endif
        PHASE_END
    }
#undef LAYER_CC
#undef LAYER_MX
#undef WSP
#undef PHASE_BEGIN
#undef PHASE_END
}

#ifndef MK_N_LAUNCHES
#define MK_N_LAUNCHES 1
#endif
static constexpr int MK_NPHASES = 1 + 3 + 7 + 2 * 5;

extern "C" void kernel_launch(void* const* d_in, const int* in_sizes, int n_in, void* d_out, int out_size, void* d_ws, size_t ws_size, hipStream_t stream) {
    static int grid = 0;
    if (grid == 0) {
        if (n_in != 28 || out_size != NTOK * DM || ws_size < WS_NEED) { fprintf(stderr, "kernel_launch: unexpected shapes (n_in %d out %d ws %zu)\n", n_in, out_size, ws_size); grid = -1; return; }
        int dev = 0, cus = 0, per_cu = 0;
        if (hipGetDevice(&dev) != hipSuccess || hipDeviceGetAttribute(&cus, hipDeviceAttributeMultiprocessorCount, dev) != hipSuccess) { grid = -1; return; }
        if (hipFuncSetAttribute((const void*)k_mega, hipFuncAttributeMaxDynamicSharedMemorySize, MK_LDS) != hipSuccess) { fprintf(stderr, "kernel_launch: hipFuncSetAttribute failed\n"); grid = -1; return; }
        if (hipOccupancyMaxActiveBlocksPerMultiprocessor(&per_cu, (const void*)k_mega, 512, MK_LDS) != hipSuccess || per_cu < 1) { fprintf(stderr, "kernel_launch: occupancy query says %d\n", per_cu); }
        (void)hipGetLastError();
        grid = cus;
        if (grid != 256) { fprintf(stderr, "kernel_launch: built for 256 CUs, found %d\n", grid); grid = -1; return; }
    }
    if (grid < 0) return;
    unsigned char* ws = (unsigned char*)d_ws;
    (void)hipMemsetAsync(ws + WS_BAR, 0, XCD_BAR_WORDS * sizeof(unsigned), stream);
    (void)hipMemsetAsync(ws + W_ABIN + (size_t)5200 * 2048 * 2, 0, (size_t)176 * 2048 * 2, stream);
    (void)hipMemsetAsync(ws + W_CDIN + (size_t)832 * 2048 * 2, 0, (size_t)192 * 2048 * 2, stream);
    MK p{};
    for (int i = 0; i < 28; ++i) p.in[i] = (const float*)d_in[i];
    p.out = (float*)d_out; p.ws = ws;
#if MK_N_LAUNCHES == 1
    p.ph_lo = 0; p.ph_hi = 1 << 20;
    hipLaunchKernelGGL(k_mega, dim3(grid), dim3(512), MK_LDS, stream, p);
#else
    for (int ph = 0; ph < MK_NPHASES; ++ph) { p.ph_lo = ph; p.ph_hi = ph + 1; hipLaunchKernelGGL(k_mega, dim3(grid), dim3(512), MK_LDS, stream, p); }
#endif
}
```

```cpp
#include <hip/hip_runtime.h>
#include <stdint.h>
#include <stdio.h>

#define LAS __attribute__((address_space(3)))
typedef unsigned short bf16_t;
typedef float f32x4 __attribute__((ext_vector_type(4)));
typedef unsigned u32x4 __attribute__((ext_vector_type(4)));
typedef unsigned u32x2 __attribute__((ext_vector_type(2)));

static constexpr int NTOK = 32768, SEQ = 16384, NBATCH = 2, DM = 2048, DFF = 4096;
static constexpr float NORM_EPS = 1e-6f;

__device__ __forceinline__ bf16_t f2bf(float f) { unsigned u = __float_as_uint(f); u += 0x7FFFu + ((u >> 16) & 1u); return (bf16_t)(u >> 16); }
__device__ __forceinline__ float bf2f(bf16_t b) { return __uint_as_float(((unsigned)b) << 16); }
__device__ __forceinline__ unsigned pack2bf(float lo, float hi) { return (unsigned)f2bf(lo) | ((unsigned)f2bf(hi) << 16); }
__device__ __forceinline__ float gelu_tanh(float x) { const float u = 0.7978845608028654f * (x + 0.044715f * x * x * x); return 0.5f * x * (1.0f + tanhf(u)); }
__device__ __forceinline__ float wave_sum(float v) {
#pragma unroll
    for (int o = 32; o >= 1; o >>= 1) v += __shfl_xor(v, o);
    return v;
}

#ifndef TID_PLAIN
#define TID_PLAIN 0
#endif
static constexpr int TID_TAB_LDS = 162816 - 16 - 256;
#if TID_PLAIN
__device__ __forceinline__ int opaque_tid() { int t = (int)threadIdx.x; asm volatile("" : "+v"(t)); return t; }
#else
__device__ __forceinline__ int opaque_tid() {
    const unsigned slot = (unsigned)__builtin_amdgcn_s_getreg(((6 - 1) << 11) | 4) & 63u;
    const int w = __builtin_amdgcn_readfirstlane(*(const volatile LAS int*)(size_t)(TID_TAB_LDS + 4 * slot));
    int lane; asm volatile("v_mbcnt_lo_u32_b32 %0, -1, 0\n\tv_mbcnt_hi_u32_b32 %0, -1, %0" : "=v"(lane));
    return w * 64 + lane;
}
#endif

__device__ __forceinline__ int opaque_s(int v) { asm volatile("" : "+s"(v)); return v; }

template <class T> __device__ __forceinline__ const T* opaque_p(const T* p) { asm volatile("" : "+s"(p)); return p; }

#ifndef PG8_EPI_RECOMP
#define PG8_EPI_RECOMP 1
#endif
#ifndef PG8_ASM_DMA
#define PG8_ASM_DMA 1
#endif
#include <hip/hip_runtime.h>
namespace pg8 {
#define PG8_LAS __attribute__((address_space(3)))
typedef unsigned short bf16_t;
typedef short bf16x8 __attribute__((ext_vector_type(8)));
typedef float f32x4 __attribute__((ext_vector_type(4)));
typedef unsigned u32x4 __attribute__((ext_vector_type(4)));
typedef int i32x8 __attribute__((ext_vector_type(8)));
typedef int i32x4 __attribute__((ext_vector_type(4)));
constexpr int BM = 256, BK = 64, HALF = 128, HTB = HALF * BK * 2  , STAGE_BYTES = 8 * HTB, NXCD = 8, WGM = 8;

__host__ __device__ __forceinline__ int lds_byte(int r, int c) { const int st = (r >> 4) * 2 + (c >> 5), rr = r & 15, cc = c & 31, ob = rr * 64 + cc * 2; return st * 1024 + (ob ^ (((ob >> 9) & 1) << 5)); }
__host__ __device__ __forceinline__ void stage_rc(int b, int& R, int& C) { const int st = b / 1024, sb = b % 1024, swz = sb ^ (((sb >> 9) & 1) << 5); R = (st >> 1) * 16 + swz / 64; C = (st & 1) * 32 + (swz % 64) / 2; }
__host__ __device__ __forceinline__ int perm32(int rho) { const int n = rho >> 4, i = rho & 15; return 8 * (i >> 2) + 4 * n + (i & 3); }

struct Unit { int pm, pn; };
struct Gemm { const bf16_t* A; const bf16_t* Bt; int M, N, K, lda, ldb, a_shift, a_bytes, cmode; };

struct StaticOrder {
    int nM, nN, nwg, G, c;
    __host__ __device__ void init(int M, int N, int G_, int c_) { nM = M / BM; nN = N / BM; nwg = nM * nN; G = G_; c = c_; }
    __host__ __device__ bool next(int i, Unit& u) const {
        const long L = (long)i * G + c; if (L >= nwg) return false;
        int wgid = (int)L; { const int q = nwg / NXCD, r = nwg % NXCD, xcd = wgid % NXCD, off = wgid / NXCD; wgid = (xcd < r ? xcd * (q + 1) : r * (q + 1) + (xcd - r) * q) + off; }
        const int nig = WGM * nN, gid = wgid / nig, fm = gid * WGM, gsz = (nM - fm) < WGM ? (nM - fm) : WGM;
        u.pm = fm + ((wgid % nig) % gsz); u.pn = (wgid % nig) / gsz; return true;
    }
    __device__ __forceinline__ void a_ready(const Unit&) const {}
    __device__ __forceinline__ void done(const Unit&) const {}
};

template <class Epi, class Sched, bool STAMP = false>
__device__ __forceinline__ void gemm_phase(PG8_LAS unsigned char* lds, const Gemm g, const Sched& S, const Epi& E, unsigned long long* stamps) {
    const int tid = opaque_tid(), wid = __builtin_amdgcn_readfirstlane(tid >> 6), lane = tid & 63, wr = wid >> 2, wc = wid & 3, fr = lane & 15, fq = lane >> 4;
    const int K = g.K, nt = K / BK;
    int ts_lo = 0, ts_hi = 0, nts = 0; const unsigned long long rt_entry = STAMP ? (unsigned long long)wall_clock64() : 0ull;
#define PG8_STAMP() do { if (STAMP && wid == 0 && nts < 64) { const unsigned long long _c = (unsigned long long)clock64(); \
        ts_lo = (lane == nts) ? (int)(unsigned)_c : ts_lo; ts_hi = (lane == nts) ? (int)(unsigned)(_c >> 32) : ts_hi; ++nts; } } while (0)
    PG8_STAMP();
    unsigned voffA[2], voffB[2];
#pragma unroll
    for (int i = 0; i < 2; ++i) { int R, C; stage_rc(tid * 16 + i * 8192, R, C); const int Rb = Epi::PERM ? ((R & ~31) + perm32(R & 31)) : R;
        const int Ra = g.cmode ? (R - 2 * (R >> 6)) : R;
        voffA[i] = (unsigned)(Ra * g.lda + C) * 2u; voffB[i] = (unsigned)(Rb * g.ldb + C) * 2u; }
    const size_t kstep = (size_t)(BK * 2);
    const size_t hstepA = (size_t)(g.cmode ? HALF - 4 : HALF) * g.lda * 2, hstepB = (size_t)HALF * g.ldb * 2;
    const size_t tstepA = 2 * hstepA, tstepB = 2 * hstepB;
    const unsigned ldsbase_ = (unsigned)(size_t)lds;
    const int sc_w_ = 0x79797979, sc_a_ = 0x7F7F7F7F;
    (void)sc_w_; (void)sc_a_;
    const unsigned ldsw = (unsigned)wid * 1024u;
    const int aoff = lds_byte(wr * 64 + fr, fq * 8), boff = lds_byte(wc * 32 + fr, fq * 8);
#define PG8_SA(b, h) (((b) * 2 + (h)) * HTB)
#define PG8_SB(b, h) ((4 + (b) * 2 + (h)) * HTB)
#if PG8_ASM_DMA
#define PG8_STAGE(bufoff, gbase, voff) do { _Pragma("unroll") for (int _i = 0; _i < 2; ++_i) { unsigned keep_; \
        asm volatile("s_mov_b32 %0, m0\n\ts_mov_b32 m0, %3\n\ts_nop 0\n\tglobal_load_lds_dwordx4 %1, %2\n\ts_mov_b32 m0, %0" \
                     : "=&s"(keep_) : "v"((voff)[_i]), "s"((const char*)(gbase)), "s"(ldsbase_ + (unsigned)(bufoff) + ldsw + (unsigned)(_i * 8192)) : "memory"); } } while (0)
#else
#define PG8_STAGE(bufoff, gbase, voff) do { _Pragma("unroll") for (int _i = 0; _i < 2; ++_i) \
        __builtin_amdgcn_global_load_lds((const unsigned*)((const char*)(gbase) + (voff)[_i]), (PG8_LAS unsigned*)(lds + (bufoff) + ldsw + _i * 8192), 16, 0, 0); } while (0)
#endif
#define PG8_LDA(dst, b, h) do { _Pragma("unroll") for (int m = 0; m < 4; ++m) { dst[m].lo = *(const PG8_LAS i32x4*)(lds + PG8_SA(b, h) + aoff + m * 2048); dst[m].hi = *(const PG8_LAS i32x4*)(lds + PG8_SA(b, h) + aoff + m * 2048 + 1024); } } while (0)
#define PG8_LDB(dst, b, h) do { _Pragma("unroll") for (int n = 0; n < 2; ++n) { dst[n].lo = *(const PG8_LAS i32x4*)(lds + PG8_SB(b, h) + boff + n * 2048); dst[n].hi = *(const PG8_LAS i32x4*)(lds + PG8_SB(b, h) + boff + n * 2048 + 1024); } } while (0)
#define PG8_MMA(ai, bj, At, Bt) do { __builtin_amdgcn_s_setprio(1); \
        if constexpr (Epi::FP8) { _Pragma("unroll") for (int m = 0; m < 4; ++m) _Pragma("unroll") for (int n = 0; n < 2; ++n) \
            asm volatile("v_mfma_scale_f32_16x16x128_f8f6f4 %0, %1, %2, %0, %3, %4 op_sel_hi:[0,0,0]" : "+v"(acc[ai][bj][m][n]) : "v"(Bt[n]), "v"(At[m]), "v"(sc_w_), "v"(sc_a_)); } \
        else { _Pragma("unroll") for (int m = 0; m < 4; ++m) _Pragma("unroll") for (int n = 0; n < 2; ++n) { \
            const i32x4 bl_ = Bt[n].lo, bh_ = Bt[n].hi, al_ = At[m].lo, ah_ = At[m].hi;     \
            acc[ai][bj][m][n] = __builtin_amdgcn_mfma_f32_16x16x32_bf16(__builtin_bit_cast(bf16x8, bl_), __builtin_bit_cast(bf16x8, al_), acc[ai][bj][m][n], 0, 0, 0); \
            acc[ai][bj][m][n] = __builtin_amdgcn_mfma_f32_16x16x32_bf16(__builtin_bit_cast(bf16x8, bh_), __builtin_bit_cast(bf16x8, ah_), acc[ai][bj][m][n], 0, 0, 0); } } \
        __builtin_amdgcn_s_setprio(0); } while (0)
#define PG8_WAIT_V(n) asm volatile("s_waitcnt vmcnt(" #n ")" ::: "memory")
#define PG8_WAIT_L(n) asm volatile("s_waitcnt lgkmcnt(" #n ")" ::: "memory")
#define PG8_BAR __builtin_amdgcn_s_barrier()
#define PG8_SCHED __builtin_amdgcn_sched_barrier(0)
    Unit cur, nxt; int ui = 0;
    if (!S.next(0, cur)) return;
    f32x4 acc[2][2][4][2];
#pragma unroll
    for (int a = 0; a < 2; ++a)
#pragma unroll
        for (int b = 0; b < 2; ++b)
#pragma unroll
            for (int m = 0; m < 4; ++m)
#pragma unroll
                for (int n = 0; n < 2; ++n) acc[a][b][m][n] = (f32x4){0.f, 0.f, 0.f, 0.f};
    i32x8 At[4], B0[2], B1[2];
    auto a_base_ = [&](const Unit& u_) -> const char* { return g.cmode ? (const char*)g.A + ((long)(u_.pm / 67) * 16384 + (long)(u_.pm % 67) * 248 - 2) * (long)g.lda * 2 : (const char*)g.A + (size_t)u_.pm * tstepA + (size_t)(u_.pn >> g.a_shift) * g.a_bytes; };
    const char* cA = a_base_(cur); const char* cB = (const char*)g.Bt + (size_t)cur.pn * tstepB;
    S.a_ready(cur);
    PG8_STAGE(PG8_SB(0, 0), cB, voffB); PG8_STAGE(PG8_SA(0, 0), cA, voffA); PG8_STAGE(PG8_SB(0, 1), cB + hstepB, voffB); PG8_STAGE(PG8_SA(0, 1), cA + hstepA, voffA);
    if (wr == 1) PG8_BAR;
    PG8_WAIT_V(4); PG8_BAR;
    PG8_STAGE(PG8_SB(1, 0), cB + kstep, voffB); PG8_STAGE(PG8_SA(1, 0), cA + kstep, voffA); PG8_STAGE(PG8_SB(1, 1), cB + hstepB + kstep, voffB);
    PG8_WAIT_V(6); PG8_BAR;
    PG8_STAMP();
    for (;;) {
        const bool has_next = S.next(ui + 1, nxt);
        const char* nA = has_next ? a_base_(nxt) : cA; const char* nB = has_next ? (const char*)g.Bt + (size_t)nxt.pn * tstepB : cB;
        for (int t = 0; t < nt; t += 2) {
            const bool last = (t == nt - 2);
            const char* a1 = cA + (size_t)(t + 1) * kstep;
            const char* a2 = last ? nA : cA + (size_t)(t + 2) * kstep; const char* b2 = last ? nB : cB + (size_t)(t + 2) * kstep;
            const char* a3 = a2 + kstep; const char* b3 = b2 + kstep;
            if (last && has_next) S.a_ready(nxt);
            PG8_LDB(B0, 0, 0); PG8_SCHED; PG8_LDA(At, 0, 0); PG8_STAGE(PG8_SA(1, 1), a1 + hstepA, voffA);
            PG8_WAIT_L(8); PG8_BAR; PG8_WAIT_L(0); PG8_MMA(0, 0, At, B0); PG8_BAR; PG8_SCHED;
            PG8_LDB(B1, 0, 1); PG8_STAGE(PG8_SB(0, 0), b2, voffB);
            PG8_BAR; PG8_WAIT_L(0); PG8_MMA(0, 1, At, B1); PG8_BAR;
            PG8_LDA(At, 0, 1); PG8_STAGE(PG8_SA(0, 0), a2, voffA);
            PG8_BAR; PG8_WAIT_L(0); PG8_MMA(1, 0, At, B0); PG8_BAR; PG8_SCHED;
            PG8_STAGE(PG8_SB(0, 1), b2 + hstepB, voffB);
            PG8_WAIT_V(6); PG8_BAR; PG8_MMA(1, 1, At, B1); PG8_BAR;
            PG8_LDB(B0, 1, 0); PG8_SCHED; PG8_LDA(At, 1, 0); PG8_STAGE(PG8_SA(0, 1), a2 + hstepA, voffA);
            PG8_WAIT_L(8); PG8_BAR; PG8_WAIT_L(0); PG8_MMA(0, 0, At, B0); PG8_BAR; PG8_SCHED;
            PG8_LDB(B1, 1, 1); PG8_STAGE(PG8_SB(1, 0), b3, voffB);
            PG8_BAR; PG8_WAIT_L(0); PG8_MMA(0, 1, At, B1); PG8_BAR;
            PG8_LDA(At, 1, 1); PG8_STAGE(PG8_SA(1, 0), a3, voffA);
            PG8_BAR; PG8_WAIT_L(0); PG8_MMA(1, 0, At, B0); PG8_BAR; PG8_SCHED;
            PG8_STAGE(PG8_SB(1, 1), b3 + hstepB, voffB);
            PG8_WAIT_V(6); PG8_BAR; PG8_MMA(1, 1, At, B1); PG8_BAR;
        }
        PG8_STAMP();
        if constexpr (Epi::FP8) { asm volatile("s_nop 15\n\ts_nop 15" ::: "memory"); }
        if constexpr (!Epi::AFTER_DRAIN) {
#if PG8_EPI_RECOMP
            const int t2_ = opaque_tid(), l2_ = t2_ & 63, w2_ = __builtin_amdgcn_readfirstlane(t2_ >> 6);
            E(acc, cur, w2_ >> 2, w2_ & 3, l2_ & 15, l2_ >> 4); S.done(cur);
#else
            E(acc, cur, wr, wc, fr, fq); S.done(cur);
#endif
        }
        PG8_STAMP();
        if (!has_next) break;
#pragma unroll
        for (int a = 0; a < 2; ++a)
#pragma unroll
            for (int b = 0; b < 2; ++b)
#pragma unroll
                for (int m = 0; m < 4; ++m)
#pragma unroll
                    for (int n = 0; n < 2; ++n) acc[a][b][m][n] = (f32x4){0.f, 0.f, 0.f, 0.f};
        cur = nxt; cA = nA; cB = nB; ++ui;
    }
    PG8_WAIT_V(0);
    if (wr == 0) PG8_BAR;
    PG8_BAR;
    if constexpr (Epi::AFTER_DRAIN) { E.fused(acc, cur, wr, wc, fr, fq, lds, wid, lane); S.done(cur); }
    PG8_STAMP();
    if (STAMP && wid == 0) { stamps[lane] = lane < nts ? (((unsigned long long)(unsigned)ts_hi << 32) | (unsigned)ts_lo) : 0ull;
        if (lane == 62) stamps[62] = rt_entry; if (lane == 63) stamps[63] = (unsigned long long)wall_clock64(); }
#undef PG8_STAMP
#undef PG8_SA
#undef PG8_SB
#undef PG8_STAGE
#undef PG8_LDA
#undef PG8_LDB
#undef PG8_MMA
#undef PG8_WAIT_V
#undef PG8_WAIT_L
#undef PG8_BAR
#undef PG8_SCHED
}
}

#include <cstdio>
#include <ctime>
#include <cstdlib>
#include <cstring>
#include <cmath>
#include <vector>

template <class F, bool F8 = false> struct EpiG {
    static constexpr bool PERM = false, AFTER_DRAIN = false, FP8 = F8;
    F f;
    __device__ __forceinline__ void operator()(const f32x4 (&acc)[2][2][4][2], const pg8::Unit& u, int wr, int wc, int fr, int fq) const {
        const int row0 = u.pm * 256 + wr * 64 + fr, col0 = u.pn * 256 + wc * 32 + 4 * fq;
#pragma unroll
        for (int ai = 0; ai < 2; ++ai)
#pragma unroll
            for (int m = 0; m < 4; ++m)
#pragma unroll
                for (int bj = 0; bj < 2; ++bj)
#pragma unroll
                    for (int n = 0; n < 2; ++n) f(row0 + ai * 128 + m * 16, col0 + bj * 128 + n * 16, acc[ai][bj][m][n]);
    }
};
__device__ __forceinline__ void st_bf16x4(bf16_t* p, f32x4 v) { u32x2 w; w.x = pack2bf(v[0], v[1]); w.y = pack2bf(v[2], v[3]); *(u32x2*)p = w; }
__device__ __forceinline__ void st_f32x4(float* p, f32x4 v) { *(f32x4*)p = v; }

struct FStoreBf16 { bf16_t* O; int ldc; int pad_; __device__ __forceinline__ void operator()(int r, int c, f32x4 v) const { st_bf16x4(O + (size_t)r * ldc + c, v); } };
struct FAbIn { bf16_t *Q, *K, *V; float *QI, *U, *WI; unsigned short* KI16;
    __device__ __forceinline__ void operator()(int r, int c, f32x4 v) const {
        if (c < 1024) st_bf16x4(Q + (size_t)r * 1024 + c, v);
        else if (c < 2048) st_bf16x4(K + (size_t)r * 1024 + (c - 1024), v);
        else if (c < 3072) st_bf16x4(V + (size_t)r * 1024 + (c - 2048), v);
        else if (c < 4096) st_f32x4(QI + (size_t)r * 1024 + (c - 3072), v);
        else if (c < 5120) st_f32x4(U + (size_t)r * 1024 + (c - 4096), v);
        else if (c < 5184) { typedef _Float16 h2 __attribute__((ext_vector_type(2))); union { h2 h; unsigned u; } a, b; a.h = (h2){(_Float16)v[0], (_Float16)v[1]}; b.h = (h2){(_Float16)v[2], (_Float16)v[3]};
            u32x2 w; w.x = a.u; w.y = b.u; *(u32x2*)(KI16 + (size_t)r * 64 + (c - 5120)) = w; }
        else if (c < 5200) st_f32x4(WI + (size_t)r * 16 + (c - 5184), v);
    } };
struct FCdIn { float *CQ, *CKV, *KR; bf16_t *XL, *YG;
    __device__ __forceinline__ void operator()(int r, int c, f32x4 v) const {
        if (c < 512) st_f32x4(CQ + (size_t)r * 512 + c, v);
        else if (c < 768) st_f32x4(CKV + (size_t)r * 256 + (c - 512), v);
        else if (c < 832) st_f32x4(KR + (size_t)r * 64 + (c - 768), v);
        else if (c < 1024) {}
        else if (c < 2048) st_bf16x4(XL + (size_t)r * 1024 + (c - 1024), v);
        else st_bf16x4(YG + (size_t)r * 1024 + (c - 2048), v);
    } };
struct FKvUp { bf16_t *K1, *V1;
    __device__ __forceinline__ void operator()(int r, int c, f32x4 v) const {
        const int h = c >> 8, d = c & 255;
        if (d < 128) st_bf16x4(K1 + (size_t)r * 1536 + h * 192 + d, v);
        else st_bf16x4(V1 + (size_t)r * 1024 + h * 128 + (d - 128), v);
    } };

__device__ __forceinline__ unsigned ord_key(float f) { const unsigned b = __float_as_uint(f); return (b & 0x80000000u) ? ~b : (b | 0x80000000u); }
__device__ __forceinline__ void rope_cs(int pos, int i, float& c, float& s) { const float freq = powf(10000.0f, -(float)i / 32.0f); const float ang = (float)pos * freq; sincosf(ang, &s, &c); }
#ifndef PV8_MLA
#define PV8_MLA 0
#endif
#ifndef PV8_DSA
#define PV8_DSA 1
#endif

typedef short bf16x8 __attribute__((ext_vector_type(8)));
typedef float f32x16 __attribute__((ext_vector_type(16)));
__device__ __forceinline__ unsigned cvtpk(float lo, float hi) { unsigned r; asm("v_cvt_pk_bf16_f32 %0, %1, %2" : "=v"(r) : "v"(lo), "v"(hi)); return r; }
__device__ __forceinline__ float max3_asm(float a, float b, float c) { float r; asm("v_max3_f32 %0, %1, %2, %3" : "=v"(r) : "v"(a), "v"(b), "v"(c)); return r; }

struct AttnArgs { const bf16_t* Q; const bf16_t* K; const bf16_t* VT; const unsigned long long* MT; bf16_t* O; int ldq, ldk, ldo; float sc_log2e; };

template <int DQK, bool MASKED>
__device__ __forceinline__ void attn_item(LAS unsigned char* lds, const AttnArgs& a, int b, int h, int qb) {
    constexpr int NKS = DQK / 16, PK = DQK * 2, PV = 128, KB_BYTES = 64 * PK, VB_BYTES = 128 * PV, NPK = DQK / 8, NKP = (64 * NPK) / 512, V_OFF = 3 * KB_BYTES;
    const int tid = opaque_tid(), lane = tid & 63, w = __builtin_amdgcn_readfirstlane(tid >> 6), n = lane & 31, hf = lane >> 5;
    const int nt = 4 * qb + 4, cw = 4 * qb + (w >> 1);
    const int trow = qb * 256 + w * 32 + n;
    const size_t grow = (size_t)b * SEQ + trow;
    bf16x8 qf[NKS];
    { const bf16_t* qp = a.Q + grow * a.ldq + h * DQK + hf * 8;
#pragma unroll
      for (int ks = 0; ks < NKS; ++ks) qf[ks] = *(const bf16x8*)(qp + ks * 16); }
    f32x16 o[4];
#pragma unroll
    for (int dt = 0; dt < 4; ++dt)
#pragma unroll
        for (int r = 0; r < 16; ++r) o[dt][r] = 0.f;
    float m_run = -INFINITY, l_run = 0.f;
    const float c = a.sc_log2e;
    const bf16_t* Kg = a.K + (size_t)b * SEQ * a.ldk + h * DQK;
    const bf16_t* Vg = a.VT + (size_t)(b * 8 + h) * 128 * SEQ;
    const unsigned long long* Mg = MASKED ? a.MT + (size_t)b * 256 * SEQ + trow : nullptr;
    auto dma_k = [&](int kt) {
        LAS unsigned char* kb = lds + (kt % 3) * KB_BYTES;
#pragma unroll
        for (int i = 0; i < NKP; ++i) { const int s = (w + 8 * i) * 64 + lane, r = s / NPK, cp = s % NPK, cc = cp ^ (NPK == 16 ? (r & 15) : ((r >> 1) & 7));
            __builtin_amdgcn_global_load_lds((const unsigned*)(Kg + (size_t)(kt * 64 + r) * a.ldk + cc * 8), (LAS unsigned*)(kb + (w + 8 * i) * 1024), 16, 0, 0); }
    };
    auto dma_v = [&](int kt) {
        LAS unsigned char* vb = lds + V_OFF + (kt & 1) * VB_BYTES;
#pragma unroll
        for (int i = 0; i < 2; ++i) { const int s = (w + 8 * i) * 64 + lane, d = s >> 3, cp = s & 7, cc = cp ^ ((d >> 1) & 7);
            __builtin_amdgcn_global_load_lds((const unsigned*)(Vg + (size_t)d * SEQ + kt * 64 + cc * 8), (LAS unsigned*)(vb + (w + 8 * i) * 1024), 16, 0, 0); }
    };
    const int kswz = (NPK == 16) ? (n & 15) : ((n >> 1) & 7), vswz = (n >> 1) & 7;
    auto qk = [&](int kt, f32x16& s0, f32x16& s1) {
        const LAS unsigned char* ka = lds + (kt % 3) * KB_BYTES + n * PK;
#pragma unroll
        for (int r = 0; r < 16; ++r) { s0[r] = 0.f; s1[r] = 0.f; }
#pragma unroll
        for (int ks = 0; ks < NKS; ++ks) {
            const int po = ((2 * ks + hf) ^ kswz) * 16;
            const bf16x8 a0 = *(const LAS bf16x8*)(ka + po), a1 = *(const LAS bf16x8*)(ka + 32 * PK + po);
            s0 = __builtin_amdgcn_mfma_f32_32x32x16_bf16(a0, qf[ks], s0, 0, 0, 0);
            s1 = __builtin_amdgcn_mfma_f32_32x32x16_bf16(a1, qf[ks], s1, 0, 0, 0);
        }
    };
    auto rowmax = [&](int kt, f32x16& s0, f32x16& s1) -> float {
        if (MASKED) {
            const unsigned long long mw = Mg[(size_t)kt * SEQ]; const unsigned mlo = (unsigned)mw >> (hf * 4), mhi = (unsigned)(mw >> 32) >> (hf * 4);
#pragma unroll
            for (int r = 0; r < 16; ++r) { const unsigned bit = 1u << ((r >> 2) * 8 + (r & 3));
                s0[r] = (mlo & bit) ? s0[r] : -INFINITY; s1[r] = (mhi & bit) ? s1[r] : -INFINITY; }
        }
        float mx = max3_asm(s0[0], s1[0], s0[1]);
        mx = max3_asm(mx, s1[1], s0[2]);
#pragma unroll
        for (int r = 2; r < 15; ++r) mx = max3_asm(mx, s1[r], s0[r + 1]);
        mx = max3_asm(mx, s1[15], mx);
        const auto rr = __builtin_amdgcn_permlane32_swap(__float_as_uint(mx), __float_as_uint(mx), false, false);
        return fmaxf(__uint_as_float(rr[0]), __uint_as_float(rr[1]));
    };
    dma_k(0); dma_v(0); if (nt > 1) dma_k(1);
    asm volatile("s_waitcnt vmcnt(0)" ::: "memory");
    __syncthreads();
    f32x16 sc0, sc1, sn0, sn1;
    qk(0, sc0, sc1);
    float mx_cur = rowmax(0, sc0, sc1), mx_next = -INFINITY;
#pragma unroll
    for (int r = 0; r < 16; ++r) { sn0[r] = 0.f; sn1[r] = 0.f; }
    for (int kt = 0; kt < nt; ++kt) {
        if (kt + 2 < nt) dma_k(kt + 2);
        if (kt + 1 < nt) dma_v(kt + 1);
        const bool act = kt <= cw, actn = kt + 1 <= cw;
        float m_use = 0.f;
        if (act) {
            const float m_new = fmaxf(m_run, mx_cur);
            m_use = (MASKED && m_new == -INFINITY) ? 0.f : m_new;
            if (__any(m_new > m_run)) {
                const float al = __builtin_amdgcn_exp2f((m_run - m_use) * c);
                l_run *= al;
#pragma unroll
                for (int dt = 0; dt < 4; ++dt)
#pragma unroll
                    for (int r = 0; r < 16; ++r) o[dt][r] *= al;
            }
            m_run = m_new;
        }
        if (actn) qk(kt + 1, sn0, sn1);
        bf16x8 pf[4];
        if (act) {
            const float mc = m_use * c;
            float ps = 0.f;
#pragma unroll
            for (int r = 0; r < 16; ++r) { sc0[r] = __builtin_amdgcn_exp2f(fmaf(sc0[r], c, -mc)); sc1[r] = __builtin_amdgcn_exp2f(fmaf(sc1[r], c, -mc)); ps += sc0[r] + sc1[r]; }
            l_run += ps;
            u32x4 t;
            t.x = cvtpk(sc0[0], sc0[1]); t.y = cvtpk(sc0[2], sc0[3]); t.z = cvtpk(sc0[4], sc0[5]); t.w = cvtpk(sc0[6], sc0[7]); pf[0] = *(bf16x8*)&t;
            t.x = cvtpk(sc0[8], sc0[9]); t.y = cvtpk(sc0[10], sc0[11]); t.z = cvtpk(sc0[12], sc0[13]); t.w = cvtpk(sc0[14], sc0[15]); pf[1] = *(bf16x8*)&t;
            t.x = cvtpk(sc1[0], sc1[1]); t.y = cvtpk(sc1[2], sc1[3]); t.z = cvtpk(sc1[4], sc1[5]); t.w = cvtpk(sc1[6], sc1[7]); pf[2] = *(bf16x8*)&t;
            t.x = cvtpk(sc1[8], sc1[9]); t.y = cvtpk(sc1[10], sc1[11]); t.z = cvtpk(sc1[12], sc1[13]); t.w = cvtpk(sc1[14], sc1[15]); pf[3] = *(bf16x8*)&t;
            const LAS unsigned char* va = lds + V_OFF + (kt & 1) * VB_BYTES + n * PV;
#pragma unroll
            for (int g = 0; g < 4; ++g) { const int po = ((2 * g + hf) ^ vswz) * 16;
#pragma unroll
                for (int dt = 0; dt < 4; ++dt) { const bf16x8 vf = *(const LAS bf16x8*)(va + dt * 32 * PV + po); o[dt] = __builtin_amdgcn_mfma_f32_32x32x16_bf16(vf, pf[g], o[dt], 0, 0, 0); } }
        }
        if (actn) mx_next = rowmax(kt + 1, sn0, sn1);
        sc0 = sn0; sc1 = sn1; mx_cur = mx_next;
        asm volatile("s_waitcnt vmcnt(0)" ::: "memory");
        __syncthreads();
    }
    const float lt = l_run + __shfl_xor(l_run, 32);
    const float inv = 1.0f / lt;
    bf16_t* op = a.O + grow * a.ldo + h * 128 + hf * 4;
#pragma unroll
    for (int dt = 0; dt < 4; ++dt)
#pragma unroll
        for (int r4 = 0; r4 < 4; ++r4) { u32x2 wv; wv.x = cvtpk(o[dt][4 * r4] * inv, o[dt][4 * r4 + 1] * inv); wv.y = cvtpk(o[dt][4 * r4 + 2] * inv, o[dt][4 * r4 + 3] * inv);
            *(u32x2*)(op + dt * 32 + r4 * 8) = wv; }
}
struct TTrue { static constexpr bool value = true; }; struct TFalse { static constexpr bool value = false; };
typedef int i32x8q __attribute__((ext_vector_type(8)));
typedef int i32x4q __attribute__((ext_vector_type(4)));
template <int DQK, bool MASKED, bool QK8>
__device__ __forceinline__ void attn_item3(LAS unsigned char* lds, const AttnArgs& a, int b, int h, int qb) {
    constexpr int NKS = QK8 ? DQK / 64 : DQK / 16, PK = QK8 ? DQK : DQK * 2, PV = 64, KB_BYTES = 64 * PK, VB_BYTES = 128 * PV, NPK = PK / 16, NKP = (64 * NPK + 511) / 512, V_OFF = 3 * KB_BYTES;
    const int tid = opaque_tid(), lane = tid & 63, w = __builtin_amdgcn_readfirstlane(tid >> 6), n = lane & 31, hf = lane >> 5;
    const int nt = 4 * qb + 4, cw = 4 * qb + (w >> 1);
    const int trow = qb * 256 + w * 32 + n;
    const size_t grow = (size_t)b * SEQ + trow;
    bf16x8 qf[QK8 ? 1 : NKS]; i32x8q q8[QK8 ? NKS : 1];
    if (QK8) { const unsigned char* qp = (const unsigned char*)a.Q + grow * a.ldq + h * DQK + hf * 32;
#pragma unroll
      for (int ks = 0; ks < NKS; ++ks) { q8[ks].lo = *(const i32x4q*)(qp + ks * 64); q8[ks].hi = *(const i32x4q*)(qp + ks * 64 + 16); } }
    else { const bf16_t* qp = a.Q + grow * a.ldq + h * DQK + hf * 8;
#pragma unroll
      for (int ks = 0; ks < NKS; ++ks) qf[ks] = *(const bf16x8*)(qp + ks * 16); }
    f32x16 o[4];
#pragma unroll
    for (int dt = 0; dt < 4; ++dt)
#pragma unroll
        for (int r = 0; r < 16; ++r) o[dt][r] = 0.f;
    float m_run = -INFINITY, l_run = 0.f;
    const float c = a.sc_log2e;
    const unsigned char* Kg = (const unsigned char*)a.K + ((size_t)b * SEQ * a.ldk + h * DQK) * (QK8 ? 1 : 2);
    const unsigned char* Vg = (const unsigned char*)a.VT + (size_t)(b * 8 + h) * 128 * SEQ;
    const unsigned long long* Mg = MASKED ? a.MT + (size_t)b * 256 * SEQ + trow : nullptr;
    auto dma_k = [&](int kt) {
        LAS unsigned char* kb = lds + (kt % 3) * KB_BYTES;
#pragma unroll
        for (int i = 0; i < NKP; ++i) { if ((w + 8 * i) * 64 >= 64 * NPK) break;
            const int s = (w + 8 * i) * 64 + lane, r = s / NPK, cp = s % NPK, cc = cp ^ (NPK == 16 ? (r & 15) : (NPK == 12 ? ((r >> 2) & 3) : ((r >> 1) & 7)));
            __builtin_amdgcn_global_load_lds((const unsigned*)(Kg + ((size_t)(kt * 64 + r) * a.ldk) * (QK8 ? 1 : 2) + cc * 16), (LAS unsigned*)(kb + (w + 8 * i) * 1024), 16, 0, 0); }
    };
    auto dma_v = [&](int kt) {
        LAS unsigned char* vb = lds + V_OFF + (kt & 1) * VB_BYTES;
        const int s = w * 64 + lane, d = s >> 2, cp = s & 3, cc = cp ^ ((d >> 2) & 3);
        __builtin_amdgcn_global_load_lds((const unsigned*)(Vg + (size_t)d * SEQ + kt * 64 + cc * 16), (LAS unsigned*)(vb + w * 1024), 16, 0, 0);
    };
    const int kswz = (NPK == 16) ? (n & 15) : (NPK == 12 ? ((n >> 2) & 3) : ((n >> 1) & 7)), vswz = (n >> 2) & 3;
    auto qk = [&](int kt, f32x16& s0, f32x16& s1) {
        const LAS unsigned char* ka = lds + (kt % 3) * KB_BYTES + n * PK;
#pragma unroll
        for (int r = 0; r < 16; ++r) { s0[r] = 0.f; s1[r] = 0.f; }
        if (QK8) {
#pragma unroll
            for (int ks = 0; ks < NKS; ++ks) {
                const int p0 = ((4 * ks + 2 * hf) ^ kswz) * 16, p1 = ((4 * ks + 2 * hf + 1) ^ kswz) * 16;
                i32x8q a0, a1;
                a0.lo = *(const LAS i32x4q*)(ka + p0); a0.hi = *(const LAS i32x4q*)(ka + p1);
                a1.lo = *(const LAS i32x4q*)(ka + 32 * PK + p0); a1.hi = *(const LAS i32x4q*)(ka + 32 * PK + p1);
                s0 = __builtin_amdgcn_mfma_scale_f32_32x32x64_f8f6f4(a0, q8[ks], s0, 0, 0, 0, 0x7F7F7F7F, 0, 0x7F7F7F7F);
                s1 = __builtin_amdgcn_mfma_scale_f32_32x32x64_f8f6f4(a1, q8[ks], s1, 0, 0, 0, 0x7F7F7F7F, 0, 0x7F7F7F7F);
            }
        } else {
#pragma unroll
            for (int ks = 0; ks < NKS; ++ks) {
                const int po = ((2 * ks + hf) ^ kswz) * 16;
                const bf16x8 a0 = *(const LAS bf16x8*)(ka + po), a1 = *(const LAS bf16x8*)(ka + 32 * PK + po);
                s0 = __builtin_amdgcn_mfma_f32_32x32x16_bf16(a0, qf[ks], s0, 0, 0, 0);
                s1 = __builtin_amdgcn_mfma_f32_32x32x16_bf16(a1, qf[ks], s1, 0, 0, 0);
            }
        }
    };
    auto rowmax = [&](unsigned long long mw, bool, f32x16& s0, f32x16& s1) -> float {
        if (MASKED) {
            const unsigned mlo = (unsigned)mw >> (hf * 4), mhi = (unsigned)(mw >> 32) >> (hf * 4);
#pragma unroll
            for (int r = 0; r < 16; ++r) { const unsigned bit = 1u << ((r >> 2) * 8 + (r & 3));
                s0[r] = (mlo & bit) ? s0[r] : -INFINITY; s1[r] = (mhi & bit) ? s1[r] : -INFINITY; }
        }
        float mx = max3_asm(s0[0], s1[0], s0[1]);
        mx = max3_asm(mx, s1[1], s0[2]);
#pragma unroll
        for (int r = 2; r < 15; ++r) mx = max3_asm(mx, s1[r], s0[r + 1]);
        mx = max3_asm(mx, s1[15], mx);
        const auto rr = __builtin_amdgcn_permlane32_swap(__float_as_uint(mx), __float_as_uint(mx), false, false);
        return fmaxf(__uint_as_float(rr[0]), __uint_as_float(rr[1]));
    };
    auto pv = [&](const f32x16& c0, const f32x16& c1, int kt) {
        i32x8q pb;
#pragma unroll
        for (int i = 0; i < 4; ++i) { int d0 = 0, d1 = 0;
            d0 = __builtin_amdgcn_cvt_pk_fp8_f32(c0[4 * i], c0[4 * i + 1], d0, false); d0 = __builtin_amdgcn_cvt_pk_fp8_f32(c0[4 * i + 2], c0[4 * i + 3], d0, true);
            d1 = __builtin_amdgcn_cvt_pk_fp8_f32(c1[4 * i], c1[4 * i + 1], d1, false); d1 = __builtin_amdgcn_cvt_pk_fp8_f32(c1[4 * i + 2], c1[4 * i + 3], d1, true);
            pb[i] = d0; pb[4 + i] = d1; }
        const LAS unsigned char* va = lds + V_OFF + (kt & 1) * VB_BYTES + n * PV;
        const int q0_ = ((2 * hf) ^ vswz) * 16, q1_ = ((2 * hf + 1) ^ vswz) * 16;
#pragma unroll
        for (int dt = 0; dt < 4; ++dt) { i32x8q vf; vf.lo = *(const LAS i32x4q*)(va + dt * 32 * PV + q0_); vf.hi = *(const LAS i32x4q*)(va + dt * 32 * PV + q1_);
            o[dt] = __builtin_amdgcn_mfma_scale_f32_32x32x64_f8f6f4(vf, pb, o[dt], 0, 0, 0, 0x7F7F7F7F, 0, 0x79797979); }
    };
    dma_k(0); dma_v(0); if (nt > 1) dma_k(1);
    unsigned long long mw_pre = MASKED ? Mg[(size_t)(nt > 1 ? 1 : 0) * SEQ] : 0ull;
    asm volatile("s_waitcnt vmcnt(0)" ::: "memory");
    __syncthreads();
    f32x16 sa0, sa1, sb0, sb1;
    qk(0, sa0, sa1);
    float mx_cur = rowmax(MASKED ? Mg[0] : 0ull, false, sa0, sa1);
    auto step = [&](int kt, f32x16& c0, f32x16& c1, f32x16& n0, f32x16& n1, auto full_tag) {
        constexpr bool FULL = decltype(full_tag)::value;
        if (kt + 2 < nt) dma_k(kt + 2);
        if (kt + 1 < nt) dma_v(kt + 1);
        const unsigned long long mw_now = mw_pre;
        if (MASKED) mw_pre = Mg[(size_t)(kt + 2 < nt ? kt + 2 : kt) * SEQ];
        const bool act = FULL || kt <= cw, actn = FULL || kt + 1 <= cw;
        const float m_new = fmaxf(m_run, mx_cur);
        const float m_use = (MASKED && m_new == -INFINITY) ? 0.f : m_new;
        if (act && __any(m_new > m_run)) {
            const float al = __builtin_amdgcn_exp2f((m_run - m_use) * c);
            l_run *= al;
#pragma unroll
            for (int dt = 0; dt < 4; ++dt)
#pragma unroll
                for (int r = 0; r < 16; ++r) o[dt][r] *= al;
        }
        if (act) m_run = m_new;
        if (FULL) {
            qk(kt + 1, n0, n1);
            const float mc = m_use * c - 6.0f;
            float ps = 0.f;
#pragma unroll
            for (int r = 0; r < 16; ++r) { c0[r] = __builtin_amdgcn_exp2f(fmaf(c0[r], c, -mc)); c1[r] = __builtin_amdgcn_exp2f(fmaf(c1[r], c, -mc)); ps += c0[r] + c1[r]; }
            l_run += ps;
            pv(c0, c1, kt);
            mx_cur = rowmax(mw_now, false, n0, n1);
        } else {
            if (actn) qk(kt + 1, n0, n1);
            if (act) {
                const float mc = m_use * c - 6.0f;
                float ps = 0.f;
#pragma unroll
                for (int r = 0; r < 16; ++r) { c0[r] = __builtin_amdgcn_exp2f(fmaf(c0[r], c, -mc)); c1[r] = __builtin_amdgcn_exp2f(fmaf(c1[r], c, -mc)); ps += c0[r] + c1[r]; }
                l_run += ps;
                pv(c0, c1, kt);
            }
            if (actn) mx_cur = rowmax(mw_now, false, n0, n1);
        }
        asm volatile("s_waitcnt vmcnt(0)" ::: "memory");
        __syncthreads();
    };
    int kt = 0;
    for (; kt < 4 * qb; kt += 2) { step(kt, sa0, sa1, sb0, sb1, TTrue{}); step(kt + 1, sb0, sb1, sa0, sa1, TTrue{}); }
    for (; kt < nt; kt += 2) { step(kt, sa0, sa1, sb0, sb1, TFalse{}); step(kt + 1, sb0, sb1, sa0, sa1, TFalse{}); }
    const float lt = l_run + __shfl_xor(l_run, 32);
    const float inv = 64.0f / lt;
    bf16_t* op = a.O + grow * a.ldo + h * 128 + hf * 4;
#pragma unroll
    for (int dt = 0; dt < 4; ++dt)
#pragma unroll
        for (int r4 = 0; r4 < 4; ++r4) { u32x2 wv; wv.x = cvtpk(o[dt][4 * r4] * inv, o[dt][4 * r4 + 1] * inv); wv.y = cvtpk(o[dt][4 * r4 + 2] * inv, o[dt][4 * r4 + 3] * inv);
            *(u32x2*)(op + dt * 32 + r4 * 8) = wv; }
}
template <int DQK, bool MASKED, bool QK8>
__device__ __forceinline__ void attn_item3b(LAS unsigned char* lds, const AttnArgs& a, int b, int h, int qb) {
    constexpr int NKS = QK8 ? DQK / 64 : DQK / 16, PK = QK8 ? DQK : DQK * 2, PV = 128, KB_BYTES = 64 * PK, VB_BYTES = 128 * PV, NPK = PK / 16, NKP = (64 * NPK + 511) / 512, V_OFF = 3 * KB_BYTES;
    const int tid = opaque_tid(), lane = tid & 63, w = __builtin_amdgcn_readfirstlane(tid >> 6), n = lane & 31, hf = lane >> 5;
    const int nt = 4 * qb + 4, cw = 4 * qb + (w >> 1);
    const int trow = qb * 256 + w * 32 + n;
    const size_t grow = (size_t)b * SEQ + trow;
    bf16x8 qf[QK8 ? 1 : NKS]; i32x8q q8[QK8 ? NKS : 1];
    if (QK8) { const unsigned char* qp = (const unsigned char*)a.Q + grow * a.ldq + h * DQK + hf * 32;
#pragma unroll
      for (int ks = 0; ks < NKS; ++ks) { q8[ks].lo = *(const i32x4q*)(qp + ks * 64); q8[ks].hi = *(const i32x4q*)(qp + ks * 64 + 16); } }
    else { const bf16_t* qp = a.Q + grow * a.ldq + h * DQK + hf * 8;
#pragma unroll
      for (int ks = 0; ks < NKS; ++ks) qf[ks] = *(const bf16x8*)(qp + ks * 16); }
    f32x16 o[4];
#pragma unroll
    for (int dt = 0; dt < 4; ++dt)
#pragma unroll
        for (int r = 0; r < 16; ++r) o[dt][r] = 0.f;
    float m_run = -INFINITY, l_run = 0.f;
    const float c = a.sc_log2e;
    const unsigned char* Kg = (const unsigned char*)a.K + ((size_t)b * SEQ * a.ldk + h * DQK) * (QK8 ? 1 : 2);
    const bf16_t* Vg = a.VT + (size_t)(b * 8 + h) * 128 * SEQ;
    const unsigned long long* Mg = MASKED ? a.MT + (size_t)b * 256 * SEQ + trow : nullptr;
    auto dma_k = [&](int kt) {
        LAS unsigned char* kb = lds + (kt % 3) * KB_BYTES;
#pragma unroll
        for (int i = 0; i < NKP; ++i) { if ((w + 8 * i) * 64 >= 64 * NPK) break;
            const int s = (w + 8 * i) * 64 + lane, r = s / NPK, cp = s % NPK, cc = cp ^ (NPK == 16 ? (r & 15) : (NPK == 12 ? ((r >> 2) & 3) : ((r >> 1) & 7)));
            __builtin_amdgcn_global_load_lds((const unsigned*)(Kg + ((size_t)(kt * 64 + r) * a.ldk) * (QK8 ? 1 : 2) + cc * 16), (LAS unsigned*)(kb + (w + 8 * i) * 1024), 16, 0, 0); }
    };
    auto dma_v = [&](int kt) {
        LAS unsigned char* vb = lds + V_OFF + (kt & 1) * VB_BYTES;
#pragma unroll
        for (int i = 0; i < 2; ++i) { const int s = (w + 8 * i) * 64 + lane, d = s >> 3, cp = s & 7, cc = cp ^ ((d >> 1) & 7);
            __builtin_amdgcn_global_load_lds((const unsigned*)(Vg + (size_t)d * SEQ + kt * 64 + cc * 8), (LAS unsigned*)(vb + (w + 8 * i) * 1024), 16, 0, 0); }
    };
    const int kswz = (NPK == 16) ? (n & 15) : (NPK == 12 ? ((n >> 2) & 3) : ((n >> 1) & 7)), vswz = (n >> 1) & 7;
    auto qk = [&](int kt, f32x16& s0, f32x16& s1) {
        const LAS unsigned char* ka = lds + (kt % 3) * KB_BYTES + n * PK;
#pragma unroll
        for (int r = 0; r < 16; ++r) { s0[r] = 0.f; s1[r] = 0.f; }
        if (QK8) {
#pragma unroll
            for (int ks = 0; ks < NKS; ++ks) {
                const int p0 = ((4 * ks + 2 * hf) ^ kswz) * 16, p1 = ((4 * ks + 2 * hf + 1) ^ kswz) * 16;
                i32x8q a0, a1;
                a0.lo = *(const LAS i32x4q*)(ka + p0); a0.hi = *(const LAS i32x4q*)(ka + p1);
                a1.lo = *(const LAS i32x4q*)(ka + 32 * PK + p0); a1.hi = *(const LAS i32x4q*)(ka + 32 * PK + p1);
                s0 = __builtin_amdgcn_mfma_scale_f32_32x32x64_f8f6f4(a0, q8[ks], s0, 0, 0, 0, 0x7F7F7F7F, 0, 0x7F7F7F7F);
                s1 = __builtin_amdgcn_mfma_scale_f32_32x32x64_f8f6f4(a1, q8[ks], s1, 0, 0, 0, 0x7F7F7F7F, 0, 0x7F7F7F7F);
            }
        } else {
#pragma unroll
            for (int ks = 0; ks < NKS; ++ks) {
                const int po = ((2 * ks + hf) ^ kswz) * 16;
                const bf16x8 a0 = *(const LAS bf16x8*)(ka + po), a1 = *(const LAS bf16x8*)(ka + 32 * PK + po);
                s0 = __builtin_amdgcn_mfma_f32_32x32x16_bf16(a0, qf[ks], s0, 0, 0, 0);
                s1 = __builtin_amdgcn_mfma_f32_32x32x16_bf16(a1, qf[ks], s1, 0, 0, 0);
            }
        }
    };
    auto rowmax = [&](unsigned long long mw, bool, f32x16& s0, f32x16& s1) -> float {
        if (MASKED) {
            const unsigned mlo = (unsigned)mw >> (hf * 4), mhi = (unsigned)(mw >> 32) >> (hf * 4);
#pragma unroll
            for (int r = 0; r < 16; ++r) { const unsigned bit = 1u << ((r >> 2) * 8 + (r & 3));
                s0[r] = (mlo & bit) ? s0[r] : -INFINITY; s1[r] = (mhi & bit) ? s1[r] : -INFINITY; }
        }
        float mx = max3_asm(s0[0], s1[0], s0[1]);
        mx = max3_asm(mx, s1[1], s0[2]);
#pragma unroll
        for (int r = 2; r < 15; ++r) mx = max3_asm(mx, s1[r], s0[r + 1]);
        mx = max3_asm(mx, s1[15], mx);
        const auto rr = __builtin_amdgcn_permlane32_swap(__float_as_uint(mx), __float_as_uint(mx), false, false);
        return fmaxf(__uint_as_float(rr[0]), __uint_as_float(rr[1]));
    };
    dma_k(0); dma_v(0); if (nt > 1) dma_k(1);
    unsigned long long mw_pre = MASKED ? Mg[(size_t)(nt > 1 ? 1 : 0) * SEQ] : 0ull;
    asm volatile("s_waitcnt vmcnt(0)" ::: "memory");
    __syncthreads();
    f32x16 sa0, sa1, sb0, sb1;
    qk(0, sa0, sa1);
    float mx_cur = rowmax(MASKED ? Mg[0] : 0ull, false, sa0, sa1);
    auto step = [&](int kt, f32x16& c0, f32x16& c1, f32x16& n0, f32x16& n1, auto full_tag) {
        constexpr bool FULL = decltype(full_tag)::value;
        if (kt + 2 < nt) dma_k(kt + 2);
        if (kt + 1 < nt) dma_v(kt + 1);
        const unsigned long long mw_now = mw_pre;
        if (MASKED) mw_pre = Mg[(size_t)(kt + 2 < nt ? kt + 2 : kt) * SEQ];
        const bool act = FULL || kt <= cw, actn = FULL || kt + 1 <= cw;
        const float m_new = fmaxf(m_run, mx_cur);
        const float m_use = (MASKED && m_new == -INFINITY) ? 0.f : m_new;
        if (act && __any(m_new > m_run)) {
            const float al = __builtin_amdgcn_exp2f((m_run - m_use) * c);
            l_run *= al;
#pragma unroll
            for (int dt = 0; dt < 4; ++dt)
#pragma unroll
                for (int r = 0; r < 16; ++r) o[dt][r] *= al;
        }
        if (act) m_run = m_new;
        if (FULL) {
            qk(kt + 1, n0, n1);
            const float mc = m_use * c;
            float ps = 0.f;
#pragma unroll
            for (int r = 0; r < 16; ++r) { c0[r] = __builtin_amdgcn_exp2f(fmaf(c0[r], c, -mc)); c1[r] = __builtin_amdgcn_exp2f(fmaf(c1[r], c, -mc)); ps += c0[r] + c1[r]; }
            l_run += ps;
            bf16x8 pf[4]; u32x4 t;
            t.x = cvtpk(c0[0], c0[1]); t.y = cvtpk(c0[2], c0[3]); t.z = cvtpk(c0[4], c0[5]); t.w = cvtpk(c0[6], c0[7]); pf[0] = *(bf16x8*)&t;
            t.x = cvtpk(c0[8], c0[9]); t.y = cvtpk(c0[10], c0[11]); t.z = cvtpk(c0[12], c0[13]); t.w = cvtpk(c0[14], c0[15]); pf[1] = *(bf16x8*)&t;
            t.x = cvtpk(c1[0], c1[1]); t.y = cvtpk(c1[2], c1[3]); t.z = cvtpk(c1[4], c1[5]); t.w = cvtpk(c1[6], c1[7]); pf[2] = *(bf16x8*)&t;
            t.x = cvtpk(c1[8], c1[9]); t.y = cvtpk(c1[10], c1[11]); t.z = cvtpk(c1[12], c1[13]); t.w = cvtpk(c1[14], c1[15]); pf[3] = *(bf16x8*)&t;
            const LAS unsigned char* va = lds + V_OFF + (kt & 1) * VB_BYTES + n * PV;
#pragma unroll
            for (int g = 0; g < 4; ++g) { const int po = ((2 * g + hf) ^ vswz) * 16;
#pragma unroll
                for (int dt = 0; dt < 4; ++dt) { const bf16x8 vf = *(const LAS bf16x8*)(va + dt * 32 * PV + po); o[dt] = __builtin_amdgcn_mfma_f32_32x32x16_bf16(vf, pf[g], o[dt], 0, 0, 0); } }
            mx_cur = rowmax(mw_now, false, n0, n1);
        } else {
            if (actn) qk(kt + 1, n0, n1);
            if (act) {
                const float mc = m_use * c;
                float ps = 0.f;
#pragma unroll
                for (int r = 0; r < 16; ++r) { c0[r] = __builtin_amdgcn_exp2f(fmaf(c0[r], c, -mc)); c1[r] = __builtin_amdgcn_exp2f(fmaf(c1[r], c, -mc)); ps += c0[r] + c1[r]; }
                l_run += ps;
                bf16x8 pf[4]; u32x4 t;
                t.x = cvtpk(c0[0], c0[1]); t.y = cvtpk(c0[2], c0[3]); t.z = cvtpk(c0[4], c0[5]); t.w = cvtpk(c0[6], c0[7]); pf[0] = *(bf16x8*)&t;
                t.x = cvtpk(c0[8], c0[9]); t.y = cvtpk(c0[10], c0[11]); t.z = cvtpk(c0[12], c0[13]); t.w = cvtpk(c0[14], c0[15]); pf[1] = *(bf16x8*)&t;
                t.x = cvtpk(c1[0], c1[1]); t.y = cvtpk(c1[2], c1[3]); t.z = cvtpk(c1[4], c1[5]); t.w = cvtpk(c1[6], c1[7]); pf[2] = *(bf16x8*)&t;
                t.x = cvtpk(c1[8], c1[9]); t.y = cvtpk(c1[10], c1[11]); t.z = cvtpk(c1[12], c1[13]); t.w = cvtpk(c1[14], c1[15]); pf[3] = *(bf16x8*)&t;
                const LAS unsigned char* va = lds + V_OFF + (kt & 1) * VB_BYTES + n * PV;
#pragma unroll
                for (int g = 0; g < 4; ++g) { const int po = ((2 * g + hf) ^ vswz) * 16;
#pragma unroll
                    for (int dt = 0; dt < 4; ++dt) { const bf16x8 vf = *(const LAS bf16x8*)(va + dt * 32 * PV + po); o[dt] = __builtin_amdgcn_mfma_f32_32x32x16_bf16(vf, pf[g], o[dt], 0, 0, 0); } }
            }
            if (actn) mx_cur = rowmax(mw_now, false, n0, n1);
        }
        asm volatile("s_waitcnt vmcnt(0)" ::: "memory");
        __syncthreads();
    };
    int kt = 0;
    for (; kt < 4 * qb; kt += 2) { step(kt, sa0, sa1, sb0, sb1, TTrue{}); step(kt + 1, sb0, sb1, sa0, sa1, TTrue{}); }
    for (; kt < nt; kt += 2) { step(kt, sa0, sa1, sb0, sb1, TFalse{}); step(kt + 1, sb0, sb1, sa0, sa1, TFalse{}); }
    const float lt = l_run + __shfl_xor(l_run, 32);
    const float inv = 1.0f / lt;
    bf16_t* op = a.O + grow * a.ldo + h * 128 + hf * 4;
#pragma unroll
    for (int dt = 0; dt < 4; ++dt)
#pragma unroll
        for (int r4 = 0; r4 < 4; ++r4) { u32x2 wv; wv.x = cvtpk(o[dt][4 * r4] * inv, o[dt][4 * r4 + 1] * inv); wv.y = cvtpk(o[dt][4 * r4 + 2] * inv, o[dt][4 * r4 + 3] * inv);
            *(u32x2*)(op + dt * 32 + r4 * 8) = wv; }
}
template <int DQK, bool MASKED>
__device__ __forceinline__ void attn_phase(LAS unsigned char* lds, const AttnArgs& a, int bid, int nblk) {
    for (int p = bid; p < 512; p += nblk) {
        const int bh = (p & 7) + 8 * (p >> 8), j = (p >> 3) & 31;
#pragma unroll 1
        for (int i = 0; i < 2; ++i) { if ((DQK == 192) ? (PV8_MLA != 0) : (PV8_DSA != 0)) attn_item3<DQK, MASKED, true>(lds, a, bh >> 3, bh & 7, i ? j : 63 - j); else attn_item3b<DQK, MASKED, true>(lds, a, bh >> 3, bh & 7, i ? j : 63 - j); }
    }
}

#ifdef IDX_PROBE_FINAL
#define IDX_PF_ 1
#else
#define IDX_PF_ 0
#endif
typedef _Float16 f16x8 __attribute__((ext_vector_type(8)));
struct IdxArgs { const float* QI; const unsigned short* KI16; const float* WI; unsigned long long* MT; };
static constexpr int IDX_CAP = 640, IDX_CS = 0, IDX_CI = 32 * IDX_CAP * 4, IDX_KT = IDX_CI + 32 * IDX_CAP * 2, IDX_CNT = IDX_KT + 32768, IDX_TAU = IDX_CNT + 128, IDX_LDS = IDX_TAU + 128;
static_assert(IDX_KT % 1024 == 0, "K tile buffers must be 1 KiB aligned");

__device__ __forceinline__ float ord_inv(unsigned T) { return __uint_as_float((T & 0x80000000u) ? (T & 0x7FFFFFFFu) : ~T); }
__device__ __forceinline__ unsigned lane_prefix(unsigned long long m) { return __builtin_amdgcn_mbcnt_hi((unsigned)(m >> 32), __builtin_amdgcn_mbcnt_lo((unsigned)m, 0u)); }
__device__ __forceinline__ float relu_asm(float x) { float y; asm("v_max_f32 %0, 0, %1" : "=v"(y) : "v"(x)); return y; }
__device__ __forceinline__ void glds16(const void* gsrc, unsigned lds_dst) {
    unsigned keep;
    asm volatile("s_mov_b32 %0, m0\n\ts_mov_b32 m0, %2\n\ts_nop 0\n\tglobal_load_lds_dwordx4 %1, off\n\ts_mov_b32 m0, %0" : "=&s"(keep) : "v"(gsrc), "s"(lds_dst) : "memory");
}

template <bool EXACT> __device__ __forceinline__ int idx_compact(LAS unsigned char* lds, int qq, int lane, int n, float& tau) {
    LAS float* cs = (LAS float*)(lds + IDX_CS) + qq * IDX_CAP; LAS unsigned short* ci = (LAS unsigned short*)(lds + IDX_CI) + qq * IDX_CAP;
    float sv[10]; unsigned short iv[10]; unsigned uk[10];
#pragma unroll
    for (int j = 0; j < 10; ++j) { const int idx = lane + 64 * j; const bool valid = idx < n; sv[j] = cs[idx]; iv[j] = ci[idx]; uk[j] = valid ? ord_key(sv[j]) : 0u; }
    auto count_ge = [&](unsigned t) { int c = 0;
#pragma unroll
        for (int j = 0; j < 10; ++j) c += __builtin_popcountll(__ballot(uk[j] >= t));
        return c; };
    unsigned lo = ord_key(tau), hi = 0xFF800001u;
    if (lo > 0x80800000u) { const unsigned h2 = lo + 0x00800000u;
        if (h2 < hi) { if (count_ge(h2) >= 256) lo = h2; else hi = h2; } }
    while (hi - lo > 1u) {
        const unsigned mid = lo + ((hi - lo) >> 1); const int c = count_ge(mid);
        if (c >= 256) { lo = mid; if (!EXACT && c <= 336) break; } else hi = mid;
    }
    const unsigned T = lo;
    int need = 0;
    if (EXACT) { int ngt = 0;
#pragma unroll
        for (int j = 0; j < 10; ++j) ngt += __builtin_popcountll(__ballot(uk[j] > T));
        need = 256 - ngt; }
    int base = 0, tiebase = 0;
#pragma unroll
    for (int j = 0; j < 10; ++j) {
        bool keep;
        if (EXACT) { const bool gt = uk[j] > T, eq = uk[j] == T; const unsigned long long em = __ballot(eq); keep = gt || (eq && (tiebase + (int)lane_prefix(em)) < need); tiebase += __builtin_popcountll(em); }
        else keep = uk[j] >= T;
        const unsigned long long km = __ballot(keep);
        const int pos = base + (int)lane_prefix(km);
        if (keep) { cs[pos] = sv[j]; ci[pos] = iv[j]; }
        base += __builtin_popcountll(km);
    }
    tau = ord_inv(T);
    return base;
}

__device__ __forceinline__ void idx_item(LAS unsigned char* lds, const IdxArgs& a, int b, int hc) {
    const int tid = opaque_tid(), lane = tid & 63, w = __builtin_amdgcn_readfirstlane(tid >> 6), n = lane & 31, hf = lane >> 5;
    const int t0 = hc * 32, L = (t0 / 64 + 1) * 64, nsub = L / 32, ntile = (L + 127) / 128;
    const size_t q0 = (size_t)b * SEQ + t0 + 4 * w;
    LAS float* cs = (LAS float*)(lds + IDX_CS); LAS unsigned short* ci = (LAS unsigned short*)(lds + IDX_CI);
    LAS unsigned* cnt = (LAS unsigned*)(lds + IDX_CNT);
    f16x8 qf[2][4];
#pragma unroll
    for (int rt = 0; rt < 2; ++rt) { const float* qp = a.QI + (q0 + 2 * rt + (n >> 4)) * 1024 + (n & 15) * 64 + hf * 8;
#pragma unroll
        for (int ks = 0; ks < 4; ++ks) { const f32x4 x0 = *(const f32x4*)(qp + ks * 16), x1 = *(const f32x4*)(qp + ks * 16 + 4);
            f16x8 v; v[0] = (_Float16)x0[0]; v[1] = (_Float16)x0[1]; v[2] = (_Float16)x0[2]; v[3] = (_Float16)x0[3]; v[4] = (_Float16)x1[0]; v[5] = (_Float16)x1[1]; v[6] = (_Float16)x1[2]; v[7] = (_Float16)x1[3];
            qf[rt][ks] = v; } }
    float wv[2][16];
#pragma unroll
    for (int rt = 0; rt < 2; ++rt)
#pragma unroll
        for (int r = 0; r < 16; ++r) wv[rt][r] = a.WI[(q0 + 2 * rt + (r >> 3)) * 16 + (((r & 3) + 8 * (r >> 2) + 4 * hf) & 15)] * (0.125f * 0.25f);
    if (tid < 32) cnt[tid] = 0u;
    int cq0 = 0, cq1 = 0, cq2 = 0, cq3 = 0;
    float tq0 = -INFINITY, tq1 = -INFINITY, tq2 = -INFINITY, tq3 = -INFINITY;
    float tau0 = INFINITY, tau1 = INFINITY;
    const unsigned short* Kg = a.KI16 + (size_t)b * SEQ * 64;
    const unsigned ldsbase = (unsigned)(size_t)lds;
    auto dma = [&](int kt, int buf) {
#pragma unroll
        for (int i = 0; i < 2; ++i) { const int s = (w + 8 * i) * 64 + lane, r = s >> 3, cp = s & 7, cc = cp ^ ((r >> 1) & 7);
            glds16(Kg + (size_t)(kt * 128 + r) * 64 + cc * 8, ldsbase + IDX_KT + buf * 16384 + (w + 8 * i) * 1024); }
    };
    dma(0, 0);
    asm volatile("s_waitcnt vmcnt(0)" ::: "memory");
    __syncthreads();
    const int kswz = (n >> 1) & 7;
    f32x16 accA[2], accB[2];
#pragma unroll
    for (int rt = 0; rt < 2; ++rt)
#pragma unroll
        for (int r = 0; r < 16; ++r) { accA[rt][r] = 0.f; accB[rt][r] = 0.f; }
    int keyA = 0, keyB = 0;
    auto epilogue = [&](const f32x16 (&acc)[2], int key) {
        float sc[2];
#pragma unroll
        for (int rt = 0; rt < 2; ++rt) { float pa = 0.f, pb = 0.f;
#pragma unroll
            for (int r = 0; r < 8; ++r) { pa = fmaf(relu_asm(acc[rt][r]), wv[rt][r], pa); pb = fmaf(relu_asm(acc[rt][r + 8]), wv[rt][r + 8], pb); }
            const auto rr = __builtin_amdgcn_permlane32_swap(__float_as_uint(pa), __float_as_uint(pb), false, false);
            sc[rt] = __uint_as_float(rr[0]) + __uint_as_float(rr[1]); }
        const bool c0 = sc[0] > tau0, c1 = sc[1] > tau1;
        const unsigned long long m0 = __ballot(c0), m1 = __ballot(c1);
        if (m0 | m1) {
            const unsigned l0 = (unsigned)m0, h0 = (unsigned)(m0 >> 32), l1 = (unsigned)m1, h1 = (unsigned)(m1 >> 32);
            const int p0 = hf ? cq1 + (int)__builtin_amdgcn_mbcnt_hi(h0, 0u) : cq0 + (int)__builtin_amdgcn_mbcnt_lo(l0, 0u);
            const int p1 = hf ? cq3 + (int)__builtin_amdgcn_mbcnt_hi(h1, 0u) : cq2 + (int)__builtin_amdgcn_mbcnt_lo(l1, 0u);
            if (c0 && p0 < IDX_CAP) { const int qq = 4 * w + hf; cs[qq * IDX_CAP + p0] = sc[0]; ci[qq * IDX_CAP + p0] = (unsigned short)key; }
            if (c1 && p1 < IDX_CAP) { const int qq = 4 * w + 2 + hf; cs[qq * IDX_CAP + p1] = sc[1]; ci[qq * IDX_CAP + p1] = (unsigned short)key; }
            cq0 += __builtin_popcount(l0); cq1 += __builtin_popcount(h0); cq2 += __builtin_popcount(l1); cq3 += __builtin_popcount(h1);
        }
    };
    auto mma = [&](f32x16 (&acc)[2], const LAS unsigned char* kr) {
        f16x8 kf[4];
#pragma unroll
        for (int ks = 0; ks < 4; ++ks) kf[ks] = *(const LAS f16x8*)(kr + ((2 * ks + hf) ^ kswz) * 16);
#pragma unroll
        for (int rt = 0; rt < 2; ++rt) {
            f32x16 c;
#pragma unroll
            for (int r = 0; r < 16; ++r) c[r] = 0.f;
#pragma unroll
            for (int ks = 0; ks < 4; ++ks) c = __builtin_amdgcn_mfma_f32_32x32x16_f16(qf[rt][ks], kf[ks], c, 0, 0, 0);
            acc[rt] = c; }
    };
#ifdef IDX_PROBE2
  for (int rep_ = 0; rep_ < 2; ++rep_) {
    if (rep_ == 1) { epilogue(accB, keyB); tau0 = INFINITY; tau1 = INFINITY; __syncthreads(); dma(0, 0); asm volatile("s_waitcnt vmcnt(0)" ::: "memory"); __syncthreads(); }
#endif
    for (int kt = 0; kt < ntile; ++kt) {
        if (kt + 1 < ntile) dma(kt + 1, (kt + 1) & 1);
#ifdef IDX_PROBE2
        if (rep_ == 0)
#endif
        { const unsigned c_all = cnt[lane & 31];
          if (__ballot(c_all > (unsigned)(IDX_CAP - 160))) {
              if (cq0 > 400) cq0 = idx_compact<false>(lds, 4 * w + 0, lane, cq0, tq0);
              if (cq1 > 400) cq1 = idx_compact<false>(lds, 4 * w + 1, lane, cq1, tq1);
              if (cq2 > 400) cq2 = idx_compact<false>(lds, 4 * w + 2, lane, cq2, tq2);
              if (cq3 > 400) cq3 = idx_compact<false>(lds, 4 * w + 3, lane, cq3, tq3);
              if (kt > 0) { tau0 = hf ? tq1 : tq0; tau1 = hf ? tq3 : tq2; }
          } }
        const LAS unsigned char* kb = lds + IDX_KT + (kt & 1) * 16384 + n * 128;
        const int sbase = kt * 4;
#ifdef IDX_PROBE2
        if (sbase + 0 < nsub) { mma(accA, kb); epilogue(accB, keyB); keyA = kt * 128 + n; if (kt == 0 && rep_ == 0) { tau0 = -INFINITY; tau1 = -INFINITY; } }
#else
        if (sbase + 0 < nsub) { mma(accA, kb); epilogue(accB, keyB); keyA = kt * 128 + n; if (kt == 0) { tau0 = -INFINITY; tau1 = -INFINITY; } }
#endif
        if (sbase + 1 < nsub) { mma(accB, kb + 32 * 128); epilogue(accA, keyA); keyB = kt * 128 + 32 + n; }
        if (sbase + 2 < nsub) { mma(accA, kb + 64 * 128); epilogue(accB, keyB); keyA = kt * 128 + 64 + n; }
        if (sbase + 3 < nsub) { mma(accB, kb + 96 * 128); epilogue(accA, keyA); keyB = kt * 128 + 96 + n; }
        if (lane < 4) cnt[4 * w + lane] = (unsigned)(lane == 0 ? cq0 : (lane == 1 ? cq1 : (lane == 2 ? cq2 : cq3)));
        asm volatile("s_waitcnt vmcnt(0)" ::: "memory");
        __syncthreads();
    }
#ifdef IDX_PROBE2
  }
#endif
    epilogue(accB, keyB);
    __syncthreads();
    LAS unsigned* bm = (LAS unsigned*)(lds + IDX_KT) + w * 512;
#ifdef IDX_PROBE_FINAL
  for (int rep2_ = 0; rep2_ < 2; ++rep2_) {
#endif
    if (cq0 > 256 - IDX_PF_) cq0 = idx_compact<true>(lds, 4 * w + 0, lane, cq0, tq0);
    if (cq1 > 256 - IDX_PF_) cq1 = idx_compact<true>(lds, 4 * w + 1, lane, cq1, tq1);
    if (cq2 > 256 - IDX_PF_) cq2 = idx_compact<true>(lds, 4 * w + 2, lane, cq2, tq2);
    if (cq3 > 256 - IDX_PF_) cq3 = idx_compact<true>(lds, 4 * w + 3, lane, cq3, tq3);
#pragma unroll 1
    for (int i = 0; i < 4; ++i) {
        const int qq = 4 * w + i;
        const int nsel = (i == 0) ? cq0 : ((i == 1) ? cq1 : ((i == 2) ? cq2 : cq3));
#pragma unroll
        for (int j = 0; j < 8; ++j) bm[lane + 64 * j] = 0u;
#pragma unroll
        for (int j = 0; j < 4; ++j) { const int idx = lane + 64 * j; if (idx < nsel) { const unsigned k = ci[qq * IDX_CAP + idx]; (void)__hip_atomic_fetch_or(bm + (k >> 5), 1u << (k & 31), __ATOMIC_RELAXED, __HIP_MEMORY_SCOPE_WORKGROUP); } }
        const int tq = t0 + qq;
#pragma unroll 1
        for (int kt = lane; kt < L / 64; kt += 64) { const unsigned long long v = (unsigned long long)bm[2 * kt] | ((unsigned long long)bm[2 * kt + 1] << 32); a.MT[((size_t)b * 256 + kt) * SEQ + tq] = v; }
    }
#ifdef IDX_PROBE_FINAL
  }
#endif
    __syncthreads();
}
__device__ __forceinline__ void idx_phase(LAS unsigned char* lds, const IdxArgs& a, int bid, int nblk) {
    for (int k = bid; k < 256; k += nblk) {
#pragma unroll 1
        for (int i = 0; i < 4; ++i) idx_item(lds, a, i & 1, (i < 2) ? 511 - k : k);
    }
}
#define XB_TMO      128
#define XB_XCNT(j)  (256  + 64 * (j))
#define XB_XSUB(j)  (1280 + 64 * (j))
#define XB_XGEN(j)  (2304 + 64 * (j))
#define XB_TOP      3328
#define XB_TOPGEN   3392
#define XCD_BAR_WORDS 3456
#define XB_SPIN_CAP (1u << 23)


__device__ __forceinline__ unsigned xb_ld(unsigned* p)              { return __hip_atomic_load(p, __ATOMIC_RELAXED, __HIP_MEMORY_SCOPE_AGENT); }
__device__ __forceinline__ unsigned xb_add(unsigned* p, unsigned v) { return __hip_atomic_fetch_add(p, v, __ATOMIC_RELAXED, __HIP_MEMORY_SCOPE_AGENT); }
__device__ __forceinline__ unsigned xb_xcc_id() { return (unsigned)__builtin_amdgcn_s_getreg((3 << 11) | 20) & 0xFu; }
#define XB_SPIN(cond, bar) do { unsigned _sp = 0; while (cond) { __builtin_amdgcn_s_sleep(1); \
    if ((++_sp & 255u) == 0u) { if (xb_ld(&(bar)[XB_TMO])) break; if (_sp > XB_SPIN_CAP) { atomicAdd(&(bar)[XB_TMO], 1u); break; } } } } while (0)

struct XcdBarrier {
    unsigned* bar; unsigned x;
    volatile LAS unsigned* st;
};

__device__ __forceinline__ XcdBarrier xcd_barrier_post(unsigned* bar, volatile LAS unsigned* st) {
    XcdBarrier b; b.bar = bar; b.x = xb_xcc_id(); b.st = st;
    if (threadIdx.x == 0) (void)xb_add(&bar[XB_XCNT(b.x)], 1u);
    return b;
}
__device__ __forceinline__ void xcd_barrier_complete(unsigned* bar, unsigned x, unsigned& nloc, unsigned& nx) {
    const unsigned G = gridDim.x * gridDim.y * gridDim.z;
    unsigned sum, cnt, mine, sp = 0u;
    for (;;) {
        sum = 0u; cnt = 0u; mine = 0u;
#pragma unroll
        for (unsigned j = 0; j < 16; ++j) { const unsigned c = xb_ld(&bar[XB_XCNT(j)]); sum += c; cnt += (c > 0u) ? 1u : 0u; mine = (j == x) ? c : mine; }
        if (sum == G) break;
        __builtin_amdgcn_s_sleep(1);
        if ((++sp & 255u) == 0u) { if (xb_ld(&bar[XB_TMO])) break; if (sp > XB_SPIN_CAP) { atomicAdd(&bar[XB_TMO], 1u); break; } }
    }
    nloc = mine > 0u ? mine : 1u; nx = cnt > 0u ? cnt : 1u;
}

__device__ __forceinline__ void xcd_barrier(const XcdBarrier& b) {
    asm volatile("s_waitcnt vmcnt(0)" ::: "memory");
    __syncthreads();
    if (threadIdx.x == 0) {
        unsigned* bar = b.bar;
        __builtin_amdgcn_s_waitcnt(0);
        unsigned nloc = b.st[0], nx = b.st[1];
        if (nloc == 0u) { xcd_barrier_complete(bar, b.x, nloc, nx); b.st[0] = nloc; b.st[1] = nx; }
        const unsigned old = xb_add(&bar[XB_XSUB(b.x)], 1u);
        const unsigned gen = old / nloc;
        if (old + 1u == (gen + 1u) * nloc) {
            __builtin_amdgcn_fence(__ATOMIC_RELEASE, "agent");
            asm volatile("s_waitcnt vmcnt(0)" ::: "memory");
            const unsigned og = xb_add(&bar[XB_TOP], 1u);
            const unsigned tg = og / nx;
            if (og + 1u == (tg + 1u) * nx) xb_add(&bar[XB_TOPGEN], 1u);
            else XB_SPIN(xb_ld(&bar[XB_TOPGEN]) == tg, bar);
            __builtin_amdgcn_fence(__ATOMIC_ACQUIRE, "agent");
            xb_add(&bar[XB_XGEN(b.x)], 1u);
            asm volatile("s_waitcnt vmcnt(0)" ::: "memory");
        } else {
            XB_SPIN(xb_ld(&bar[XB_XGEN(b.x)]) == gen, bar);
            __builtin_amdgcn_fence(__ATOMIC_ACQUIRE, "agent");
            asm volatile("s_waitcnt vmcnt(0)" ::: "memory");
        }
    }
    __syncthreads();
}

#ifndef FP8_QKV
#define FP8_QKV 1
#endif
#ifndef FP8_UP0
#define FP8_UP0 0
#endif
#ifndef FP8_UP1
#define FP8_UP1 1
#endif
#ifndef FP8_DN0
#define FP8_DN0 0
#endif
#ifndef FP8_DN1
#define FP8_DN1 1
#endif
#ifndef SKIPMASK
#define SKIPMASK 0
#endif

__device__ __forceinline__ int perm16(int t) { const int a = (t >> 2) & 3; return (t & ~12) | ((a == 1 ? 2 : (a == 2 ? 1 : a)) << 2); }
__device__ __forceinline__ void st_vt16(bf16_t* VT, int row, int h, int d, f32x4 v) {
    const int b = row / SEQ, t = row % SEQ; bf16_t* p = VT + ((size_t)(b * 8 + h) * 128 + d) * SEQ + (t & ~15) + perm16(t & 15);
    p[0] = f2bf(v[0]); p[SEQ] = f2bf(v[1]); p[2 * (size_t)SEQ] = f2bf(v[2]); p[3 * (size_t)SEQ] = f2bf(v[3]);
}
__device__ __forceinline__ int perm64(int kk) { const int sub = kk >> 5, k5 = kk & 31; return 32 * ((k5 >> 2) & 1) + 16 * sub + (((k5 >> 3) << 2) | (k5 & 3)); }
__device__ __forceinline__ void st_vt8(bf16_t* VT_, int row, int h, int d, f32x4 v) {
    const int b = row / SEQ, t = row % SEQ; unsigned char* p = (unsigned char*)VT_ + ((size_t)(b * 8 + h) * 128 + d) * SEQ + (t & ~63) + perm64(t & 63);
    const int pk0 = __builtin_amdgcn_cvt_pk_fp8_f32(v[0], v[1], 0, false), pk1 = __builtin_amdgcn_cvt_pk_fp8_f32(v[2], v[3], 0, false);
    p[0] = (unsigned char)(pk0 & 0xFF); p[SEQ] = (unsigned char)((pk0 >> 8) & 0xFF); p[2 * (size_t)SEQ] = (unsigned char)(pk1 & 0xFF); p[3 * (size_t)SEQ] = (unsigned char)((pk1 >> 8) & 0xFF);
}
__device__ __forceinline__ void st_fp8x4(unsigned char* p, f32x4 v) { int pk = 0; pk = __builtin_amdgcn_cvt_pk_fp8_f32(v[0], v[1], pk, false); pk = __builtin_amdgcn_cvt_pk_fp8_f32(v[2], v[3], pk, true); *(int*)p = pk; }
struct FAbIn2 { unsigned char *Q, *K; bf16_t* VT; float *QI, *U, *WI; unsigned short* KI16;
    __device__ __forceinline__ void operator()(int r, int c, f32x4 v) const {
        if (c < 1024) st_fp8x4(Q + (size_t)r * 1024 + c, v);
        else if (c < 2048) st_fp8x4(K + (size_t)r * 1024 + (c - 1024), v);
        else if (c < 3072) { if (PV8_DSA) st_vt8(VT, r, (c - 2048) >> 7, (c - 2048) & 127, v); else st_vt16(VT, r, (c - 2048) >> 7, (c - 2048) & 127, v); }
        else if (c < 4096) st_f32x4(QI + (size_t)r * 1024 + (c - 3072), v);
        else if (c < 5120) st_f32x4(U + (size_t)r * 1024 + (c - 4096), v);
        else if (c < 5184) { typedef _Float16 h2 __attribute__((ext_vector_type(2))); union { h2 h; unsigned u; } a, b; a.h = (h2){(_Float16)v[0], (_Float16)v[1]}; b.h = (h2){(_Float16)v[2], (_Float16)v[3]};
            u32x2 w; w.x = a.u; w.y = b.u; *(u32x2*)(KI16 + (size_t)r * 64 + (c - 5120)) = w; }
        else if (c < 5200) st_f32x4(WI + (size_t)r * 16 + (c - 5184), v);
    } };
struct FAbInHi { FAbIn2 f; __device__ __forceinline__ void operator()(int r, int c, f32x4 v) const { f(r, c + 3072, v); } };
struct FKvUp2 { unsigned char* K8; bf16_t* VT;
    __device__ __forceinline__ void operator()(int r, int c, f32x4 v) const {
        const int h = c >> 8, d = c & 255;
        if (d < 128) { int pk = 0; pk = __builtin_amdgcn_cvt_pk_fp8_f32(v[0], v[1], pk, false); pk = __builtin_amdgcn_cvt_pk_fp8_f32(v[2], v[3], pk, true); *(int*)(K8 + (size_t)r * 1536 + h * 192 + d) = pk; }
        else { if (PV8_MLA) st_vt8(VT, r, h, d - 128, v); else st_vt16(VT, r, h, d - 128, v); }
    } };

template <class E> __device__ __forceinline__ void ph_gemm_e(LAS unsigned char* lds, const bf16_t* A, int lda, const bf16_t* Bt, int ldb, int M, int N, int K, const E& e, int bid, int nblk, int a_shift = 0, int a_bytes = 0, int cmode = 0) {
    pg8::Gemm g; g.A = A; g.Bt = Bt; g.M = M; g.N = N; g.K = K; g.lda = lda; g.ldb = ldb; g.a_shift = a_shift; g.a_bytes = a_bytes; g.cmode = cmode;
    pg8::StaticOrder S; S.init(M, N, nblk, bid);
    pg8::gemm_phase<E, pg8::StaticOrder, false>(lds, g, S, e, nullptr);
    __syncthreads();
}
template <class F> __device__ __forceinline__ void ph_gemm(LAS unsigned char* lds, const bf16_t* A, int lda, const bf16_t* Bt, int ldb, int M, int N, int K, const F& f, int bid, int nblk, int a_shift = 0, int a_bytes = 0) {
    EpiG<F> e; e.f = f;
    ph_gemm_e(lds, A, lda, Bt, ldb, M, N, K, e, bid, nblk, a_shift, a_bytes);
}
template <class F> __device__ __forceinline__ void ph_gemm8(LAS unsigned char* lds, const unsigned char* A, int lda, const unsigned char* Bt, int ldb, int M, int N, int K, const F& f, int bid, int nblk) {
    EpiG<F, true> e; e.f = f;
    ph_gemm_e(lds, (const bf16_t*)A, lda / 2, (const bf16_t*)Bt, ldb / 2, M, N, K / 2, e, bid, nblk, 0, 0);
}
__device__ __forceinline__ float dpp_ror1(float v) { return __int_as_float(__builtin_amdgcn_update_dpp(0, __float_as_int(v), 0x121, 0xF, 0xF, false)); }
__device__ __forceinline__ float dpp_ror2(float v) { return __int_as_float(__builtin_amdgcn_update_dpp(0, __float_as_int(v), 0x122, 0xF, 0xF, false)); }
__device__ __forceinline__ float dpp_shr1(float old, float v) { return __int_as_float(__builtin_amdgcn_update_dpp(__float_as_int(old), __float_as_int(v), 0x111, 0xF, 0xF, false)); }
__device__ __forceinline__ float dpp_shr2(float old, float v) { return __int_as_float(__builtin_amdgcn_update_dpp(__float_as_int(old), __float_as_int(v), 0x112, 0xF, 0xF, false)); }
__device__ __forceinline__ float gelu_fast(float x) { const float u2 = 1.5957691216057308f * (x + 0.044715f * x * x * x); return x * __builtin_amdgcn_rcpf(1.0f + __builtin_amdgcn_exp2f(-1.4426950408889634f * u2)); }
template <bool OUT8, bool F8> struct EpiGate {
    static constexpr bool PERM = false, AFTER_DRAIN = false, FP8 = F8;
    const float* cw; const float* cb; void* ACT;
    __device__ __forceinline__ void operator()(const f32x4 (&acc)[2][2][4][2], const pg8::Unit& u, int wr, int wc, int fr, int fq) const {
        const int bt = u.pm / 67, ti = u.pm % 67;
#pragma unroll
        for (int n = 0; n < 2; ++n) {
            const int c = u.pn * 128 + wc * 32 + 16 * n + 4 * fq;
            const f32x4 g0 = *(const f32x4*)(cw + c), g1 = *(const f32x4*)(cw + 8192 + c), g2 = *(const f32x4*)(cw + 16384 + c), gb = *(const f32x4*)(cb + c);
            const f32x4 v0 = *(const f32x4*)(cw + 4096 + c), v1 = *(const f32x4*)(cw + 8192 + 4096 + c), v2 = *(const f32x4*)(cw + 16384 + 4096 + c), vb = *(const f32x4*)(cb + 4096 + c);
#pragma unroll
            for (int ai = 0; ai < 2; ++ai) {
                const int strip = 2 * ai + wr, tbase = ti * 248 + strip * 62 - 2;
                f32x4 pg = {0.f, 0.f, 0.f, 0.f}, pv = pg;
#pragma unroll
                for (int m = 0; m < 4; ++m) {
                    f32x4 xg = acc[ai][0][m][n], xv = acc[ai][1][m][n];
                    const int t = tbase + 16 * m + fr;
                    if (t < 0) { xg = (f32x4){0.f, 0.f, 0.f, 0.f}; xv = xg; }
                    f32x4 og, ov;
#pragma unroll
                    for (int j = 0; j < 4; ++j) {
                        const float gp1 = dpp_shr1(dpp_ror1(pg[j]), xg[j]), gp2 = dpp_shr2(dpp_ror2(pg[j]), xg[j]);
                        const float vp1 = dpp_shr1(dpp_ror1(pv[j]), xv[j]), vp2 = dpp_shr2(dpp_ror2(pv[j]), xv[j]);
                        og[j] = gb[j] + g0[j] * gp2 + g1[j] * gp1 + g2[j] * xg[j];
                        ov[j] = vb[j] + v0[j] * vp2 + v1[j] * vp1 + v2[j] * xv[j];
                        og[j] = gelu_fast(og[j]) * ov[j];
                    }
                    pg = xg; pv = xv;
                    if (16 * m + fr >= 2 && t < SEQ) {
                        const size_t o = ((size_t)bt * SEQ + t) * 4096 + c;
                        if (OUT8) { int pk = 0; pk = __builtin_amdgcn_cvt_pk_fp8_f32(og[0], og[1], pk, false); pk = __builtin_amdgcn_cvt_pk_fp8_f32(og[2], og[3], pk, true); *(int*)((unsigned char*)ACT + o) = pk; }
                        else st_bf16x4((bf16_t*)ACT + o, og);
                    }
                }
            }
        }
    }
};
struct FPool { bf16_t* CC; const float* pb; const float* ps;
    __device__ __forceinline__ void operator()(int r, int c, f32x4 v) const { const f32x4 b = *(const f32x4*)(pb + c), s = *(const f32x4*)(ps + c); st_bf16x4(CC + (size_t)r * 2048 + 1024 + c, (v + b) * s); } };
struct EpiLru {
    static constexpr bool PERM = false, AFTER_DRAIN = false, FP8 = false;
    const bf16_t* XCB; const float *ba, *bx, *lam; float *LA, *LB;
    __device__ __forceinline__ void operator()(const f32x4 (&acc)[2][2][4][2], const pg8::Unit& u, int wr, int wc, int fr, int fq) const {
        const int row0 = u.pm * 256 + wr * 64 + fr;
#pragma unroll
        for (int n = 0; n < 2; ++n) {
            const int ch = u.pn * 128 + wc * 32 + 16 * n + 4 * fq;
            const f32x4 bav = *(const f32x4*)(ba + ch), bxv = *(const f32x4*)(bx + ch), lm = *(const f32x4*)(lam + ch);
            f32x4 sp;
#pragma unroll
            for (int j = 0; j < 4; ++j) sp[j] = log1pf(__expf(-lm[j]));
#pragma unroll
            for (int ai = 0; ai < 2; ++ai)
#pragma unroll
                for (int m = 0; m < 4; ++m) {
                    const int row = row0 + ai * 128 + m * 16;
                    const u32x2 xw = *(const u32x2*)(XCB + (size_t)row * 1024 + ch);
                    const f32x4 xc = {__uint_as_float(xw.x << 16), __uint_as_float(xw.x & 0xFFFF0000u), __uint_as_float(xw.y << 16), __uint_as_float(xw.y & 0xFFFF0000u)};
                    const f32x4 ga = acc[ai][0][m][n] + bav, gx = acc[ai][1][m][n] + bxv;
                    f32x4 av, bv;
#pragma unroll
                    for (int j = 0; j < 4; ++j) {
                        const float rg = 1.0f / (1.0f + __expf(-ga[j])), ig = 1.0f / (1.0f + __expf(-gx[j]));
                        const float log_a = -8.0f * rg * sp[j], a = __expf(log_a), mult = sqrtf(-expm1f(2.0f * log_a));
                        av[j] = a; bv[j] = mult * (ig * xc[j]);
                    }
                    *(f32x4*)(LA + (size_t)row * 1024 + ch) = av; *(f32x4*)(LB + (size_t)row * 1024 + ch) = bv;
                }
        }
    }
};
__device__ __forceinline__ void ph_pooled(const float* __restrict__ U, bf16_t* __restrict__ P, int bid, int nblk) {
    for (int i = bid * 512 + opaque_tid(); i < 256 * (NTOK / 64); i += nblk * 512) {
        const int c4 = i & 255, row0 = (i >> 8) * 64, t0 = row0 % SEQ, g = c4 >> 6, win = 2 << g;
        const f32x4* up = (const f32x4*)U + (size_t)row0 * 256 + c4;
        f32x4 s = {0.f, 0.f, 0.f, 0.f};
        if (t0 > 0) { for (int k = 1; k < win; ++k) s += up[-(ptrdiff_t)k * 256]; }
#pragma unroll 8
        for (int r = 0; r < 64; ++r) {
            const int t = t0 + r; const f32x4 u0 = up[(ptrdiff_t)r * 256];
            s += u0;
            const int cnt = (t + 1 < win) ? (t + 1) : win;
            st_bf16x4(P + (size_t)(row0 + r) * 1024 + c4 * 4, s * (1.0f / (float)cnt) - u0);
            if (t + 1 >= win) s -= up[(ptrdiff_t)(r + 1 - win) * 256];
        }
    }
}
__device__ __forceinline__ void ph_xc(const bf16_t* __restrict__ XL, const float* __restrict__ cw, const float* __restrict__ cb, bf16_t* __restrict__ XCB, int bid, int nblk) {
    for (int i = bid * 512 + opaque_tid(); i < 128 * (NTOK / 32); i += nblk * 512) {
        const int c8 = (i & 127) * 8, row0 = (i >> 7) * 32, t0 = row0 % SEQ;
        float w0[8], w1[8], w2[8], w3[8], bb[8];
#pragma unroll
        for (int j = 0; j < 8; ++j) { w0[j] = cw[c8 + j]; w1[j] = cw[1024 + c8 + j]; w2[j] = cw[2048 + c8 + j]; w3[j] = cw[3072 + c8 + j]; bb[j] = cb[c8 + j]; }
        u32x4 p3 = {0u, 0u, 0u, 0u}, p2 = p3, p1 = p3;
        if (t0 >= 3) { p3 = *(const u32x4*)(XL + (size_t)(row0 - 3) * 1024 + c8); p2 = *(const u32x4*)(XL + (size_t)(row0 - 2) * 1024 + c8); p1 = *(const u32x4*)(XL + (size_t)(row0 - 1) * 1024 + c8); }
#pragma unroll 8
        for (int r = 0; r < 32; ++r) {
            const u32x4 cur = *(const u32x4*)(XL + (size_t)(row0 + r) * 1024 + c8);
            const unsigned a3[4] = {p3.x, p3.y, p3.z, p3.w}, a2[4] = {p2.x, p2.y, p2.z, p2.w}, a1[4] = {p1.x, p1.y, p1.z, p1.w}, a0[4] = {cur.x, cur.y, cur.z, cur.w};
            float y[8];
#pragma unroll
            for (int j = 0; j < 4; ++j) {
                y[2 * j] = bb[2 * j] + w0[2 * j] * __uint_as_float(a3[j] << 16) + w1[2 * j] * __uint_as_float(a2[j] << 16) + w2[2 * j] * __uint_as_float(a1[j] << 16) + w3[2 * j] * __uint_as_float(a0[j] << 16);
                y[2 * j + 1] = bb[2 * j + 1] + w0[2 * j + 1] * __uint_as_float(a3[j] & 0xFFFF0000u) + w1[2 * j + 1] * __uint_as_float(a2[j] & 0xFFFF0000u) + w2[2 * j + 1] * __uint_as_float(a1[j] & 0xFFFF0000u) + w3[2 * j + 1] * __uint_as_float(a0[j] & 0xFFFF0000u); }
            u32x4 o; o.x = pack2bf(y[0], y[1]); o.y = pack2bf(y[2], y[3]); o.z = pack2bf(y[4], y[5]); o.w = pack2bf(y[6], y[7]);
            *(u32x4*)(XCB + (size_t)(row0 + r) * 1024 + c8) = o;
            p3 = p2; p2 = p1; p1 = cur;
        }
    }
}
__device__ __forceinline__ int up_src_col(int n0) { return ((n0 >> 7) & 1) * 4096 + (n0 >> 8) * 128 + (n0 & 127); }
template <bool OUT8>
__device__ __forceinline__ void ph_convT_g(LAS unsigned char* lds, const float* __restrict__ W, int ldw, int src_col0, int ncols, int K, void* __restrict__ Bt, int ldd, int bid, int nblk, bool upperm) {
    const int tid = opaque_tid(), sub = tid >> 8, t8 = tid & 255;
    LAS float* tile = (LAS float*)lds + sub * (64 * 65);
    const int ntx = (ncols + 63) / 64, ntiles = ntx * (K / 64);
    for (int base = bid * 2; base < ntiles; base += nblk * 2) {
        const int tl = base + sub; const bool act = tl < ntiles;
        const int n0 = (tl % ntx) * 64, k0 = (tl / ntx) * 64;
        if (act) {
            const int c4 = (t8 & 15) * 4, kr = t8 >> 4;
            const int nsrc = src_col0 + (upperm ? up_src_col(n0 + c4) : n0 + c4);
#pragma unroll
            for (int i = 0; i < 4; ++i) { const int kl = kr + 16 * i;
                f32x4 v = {0.f, 0.f, 0.f, 0.f};
                if (n0 + c4 < ncols) v = *(const f32x4*)(W + (size_t)(k0 + kl) * ldw + nsrc);
                tile[kl * 65 + c4] = v[0]; tile[kl * 65 + c4 + 1] = v[1]; tile[kl * 65 + c4 + 2] = v[2]; tile[kl * 65 + c4 + 3] = v[3]; } }
        __syncthreads();
        if (act) {
            const int k8 = (t8 & 7) * 8, nr = t8 >> 3;
#pragma unroll
            for (int i = 0; i < 2; ++i) { const int nl = nr + 32 * i;
                if (n0 + nl < ncols) {
                    float v[8];
#pragma unroll
                    for (int j = 0; j < 8; ++j) v[j] = tile[(k8 + j) * 65 + nl];
                    if (OUT8) { int p0 = 0, p1 = 0;
                        p0 = __builtin_amdgcn_cvt_pk_fp8_f32(64.f * v[0], 64.f * v[1], p0, false); p0 = __builtin_amdgcn_cvt_pk_fp8_f32(64.f * v[2], 64.f * v[3], p0, true);
                        p1 = __builtin_amdgcn_cvt_pk_fp8_f32(64.f * v[4], 64.f * v[5], p1, false); p1 = __builtin_amdgcn_cvt_pk_fp8_f32(64.f * v[6], 64.f * v[7], p1, true);
                        u32x2 o; o.x = (unsigned)p0; o.y = (unsigned)p1; *(u32x2*)((unsigned char*)Bt + (size_t)(n0 + nl) * ldd + k0 + k8) = o; }
                    else { u32x4 o; o.x = pack2bf(v[0], v[1]); o.y = pack2bf(v[2], v[3]); o.z = pack2bf(v[4], v[5]); o.w = pack2bf(v[6], v[7]);
                        *(u32x4*)((bf16_t*)Bt + (size_t)(n0 + nl) * ldd + k0 + k8) = o; }
                } } }
        __syncthreads();
    }
}
__device__ __forceinline__ void ph_convT(LAS unsigned char* lds, const float* __restrict__ W, int ldw, int src_col0, int ncols, int K, bf16_t* __restrict__ Bt, int ldd, int bid, int nblk, bool upperm = false) {
    ph_convT_g<false>(lds, W, ldw, src_col0, ncols, K, Bt, ldd, bid, nblk, upperm);
}
__device__ __forceinline__ void ph_convT8(LAS unsigned char* lds, const float* __restrict__ W, int ldw, int ncols, int K, unsigned char* __restrict__ Bt, int bid, int nblk, bool upperm = false) {
    ph_convT_g<true>(lds, W, ldw, 0, ncols, K, Bt, K, bid, nblk, upperm);
}
template <int NC> __device__ __forceinline__ void ph_rmsnorm(const float* __restrict__ x, const float* __restrict__ g, bf16_t* __restrict__ out, int bid, int nblk, unsigned char* __restrict__ out8 = nullptr) {
    const int lane = opaque_tid() & 63, w = opaque_tid() >> 6;
    constexpr int NV = NC / 256;
    for (int row = bid * 8 + w; row < NTOK; row += nblk * 8) {
        const f32x4* xr = (const f32x4*)(x + (size_t)row * NC);
        f32x4 v[NV]; float ss = 0.f;
#pragma unroll
        for (int i = 0; i < NV; ++i) { v[i] = xr[lane + 64 * i]; ss += v[i][0] * v[i][0] + v[i][1] * v[i][1] + v[i][2] * v[i][2] + v[i][3] * v[i][3]; }
        ss = wave_sum(ss);
        const float r = rsqrtf(ss * (1.0f / NC) + NORM_EPS);
#pragma unroll
        for (int i = 0; i < NV; ++i) { const f32x4 gg = ((const f32x4*)g)[lane + 64 * i]; const f32x4 y = v[i] * r * gg; st_bf16x4(out + (size_t)row * NC + 4 * (lane + 64 * i), y);
            if (out8) { int pk = 0; pk = __builtin_amdgcn_cvt_pk_fp8_f32(y[0], y[1], pk, false); pk = __builtin_amdgcn_cvt_pk_fp8_f32(y[2], y[3], pk, true); *(int*)(out8 + (size_t)row * NC + 4 * (lane + 64 * i)) = pk; } }
    }
}
template <bool IN16, bool OUT16>
__device__ __forceinline__ void ph_resnorm(const void* xin, const bf16_t* __restrict__ m, const float* __restrict__ gpost, const float* __restrict__ gpre, void* xout, bf16_t* __restrict__ h, unsigned char* __restrict__ h8, int bid, int nblk) {
    const int tid_ = opaque_tid(), lane = tid_ & 63, w = tid_ >> 6;
    for (int row = bid * 8 + w; row < NTOK; row += nblk * 8) {
        const u32x2* mr = (const u32x2*)(m + (size_t)row * DM);
        f32x4 mv[8], xv[8]; float ss = 0.f;
#pragma unroll
        for (int i = 0; i < 8; ++i) { const u32x2 wd = mr[lane + 64 * i]; mv[i][0] = __uint_as_float(wd.x << 16); mv[i][1] = __uint_as_float(wd.x & 0xFFFF0000u); mv[i][2] = __uint_as_float(wd.y << 16); mv[i][3] = __uint_as_float(wd.y & 0xFFFF0000u);
            if (IN16) { const u32x2 xw = ((const u32x2*)((const bf16_t*)xin + (size_t)row * DM))[lane + 64 * i];
                xv[i][0] = __uint_as_float(xw.x << 16); xv[i][1] = __uint_as_float(xw.x & 0xFFFF0000u); xv[i][2] = __uint_as_float(xw.y << 16); xv[i][3] = __uint_as_float(xw.y & 0xFFFF0000u); }
            else xv[i] = ((const f32x4*)((const float*)xin + (size_t)row * DM))[lane + 64 * i];
            ss += mv[i][0] * mv[i][0] + mv[i][1] * mv[i][1] + mv[i][2] * mv[i][2] + mv[i][3] * mv[i][3]; }
        ss = wave_sum(ss);
        const float r1 = rsqrtf(ss * (1.0f / DM) + NORM_EPS);
        float s2 = 0.f;
#pragma unroll
        for (int i = 0; i < 8; ++i) { const f32x4 gg = ((const f32x4*)gpost)[lane + 64 * i]; xv[i] = xv[i] + mv[i] * r1 * gg;
            if (OUT16) st_bf16x4((bf16_t*)xout + (size_t)row * DM + 4 * (lane + 64 * i), xv[i]); else ((f32x4*)((float*)xout + (size_t)row * DM))[lane + 64 * i] = xv[i];
            s2 += xv[i][0] * xv[i][0] + xv[i][1] * xv[i][1] + xv[i][2] * xv[i][2] + xv[i][3] * xv[i][3]; }
        if (gpre) {
            s2 = wave_sum(s2);
            const float r2 = rsqrtf(s2 * (1.0f / DM) + NORM_EPS);
#pragma unroll
            for (int i = 0; i < 8; ++i) { const f32x4 gg = ((const f32x4*)gpre)[lane + 64 * i]; const f32x4 y = xv[i] * r2 * gg;
                if (h8) { int pk = 0; pk = __builtin_amdgcn_cvt_pk_fp8_f32(y[0], y[1], pk, false); pk = __builtin_amdgcn_cvt_pk_fp8_f32(y[2], y[3], pk, true); *(int*)(h8 + (size_t)row * DM + 4 * (lane + 64 * i)) = pk; }
                else st_bf16x4(h + (size_t)row * DM + 4 * (lane + 64 * i), y); }
        }
    }
}
__device__ __forceinline__ void ph_scan1(const float* __restrict__ Aa, const float* __restrict__ Bb, float* __restrict__ CA, float* __restrict__ CH, int bid, int nblk) {
    for (int i = bid * 512 + opaque_tid(); i < 2 * 256 * 1024; i += nblk * 512) {
        const int ch = i & 1023, chunk = (i >> 10) & 255, b = i >> 18;
        const size_t base = ((size_t)b * SEQ + (size_t)chunk * 64) * 1024 + ch;
        float h = 0.f, P = 1.f;
#pragma unroll 8
        for (int s = 0; s < 64; ++s) { const float a = Aa[base + (size_t)s * 1024]; h = a * h + Bb[base + (size_t)s * 1024]; P *= a; }
        CA[i] = P; CH[i] = h;
    }
}
__device__ __forceinline__ void ph_scan2(const float* __restrict__ CA, const float* __restrict__ CH, float* __restrict__ CIN, int bid, int nblk) {
    for (int i = bid * 512 + opaque_tid(); i < 2048; i += nblk * 512) {
        const int ch = i & 1023, b = i >> 10;
        float h = 0.f;
#pragma unroll 8
        for (int c = 0; c < 256; ++c) { const int j = (b * 256 + c) * 1024 + ch; CIN[j] = h; h = CA[j] * h + CH[j]; }
    }
}
__device__ __forceinline__ void ph_scan3(const float* __restrict__ Aa, const float* __restrict__ Bb, const float* __restrict__ CIN, const bf16_t* __restrict__ YG, bf16_t* __restrict__ CC, int bid, int nblk) {
    for (int i = bid * 512 + opaque_tid(); i < 2 * 256 * 1024; i += nblk * 512) {
        const int ch = i & 1023, chunk = (i >> 10) & 255, b = i >> 18;
        const size_t row0 = (size_t)b * SEQ + (size_t)chunk * 64;
        float h = CIN[i];
#pragma unroll 8
        for (int s = 0; s < 64; ++s) { const size_t r = row0 + s; h = Aa[r * 1024 + ch] * h + Bb[r * 1024 + ch];
            CC[r * 2048 + 1024 + ch] = f2bf(h * gelu_tanh(bf2f(YG[r * 1024 + ch]))); }
    }
}
__device__ __forceinline__ void ph_rope_q(const bf16_t* __restrict__ Q1, const int* __restrict__ pos, unsigned char* __restrict__ Q8, int bid, int nblk) {
    for (int idx = bid * 512 + opaque_tid(); idx < NTOK * 8 * 4; idx += nblk * 512) {
        const int g = idx & 3, h = (idx >> 2) & 7, row = idx >> 5;
        const bf16_t* p = Q1 + (size_t)row * 1536 + h * 192; unsigned char* q = Q8 + (size_t)row * 1536 + h * 192;
#pragma unroll
        for (int k = 0; k < 4; ++k) { const u32x4 w = *(const u32x4*)(p + 32 * g + 8 * k);
            int p0 = 0, p1 = 0;
            p0 = __builtin_amdgcn_cvt_pk_fp8_f32(__uint_as_float(w.x << 16), __uint_as_float(w.x & 0xFFFF0000u), p0, false); p0 = __builtin_amdgcn_cvt_pk_fp8_f32(__uint_as_float(w.y << 16), __uint_as_float(w.y & 0xFFFF0000u), p0, true);
            p1 = __builtin_amdgcn_cvt_pk_fp8_f32(__uint_as_float(w.z << 16), __uint_as_float(w.z & 0xFFFF0000u), p1, false); p1 = __builtin_amdgcn_cvt_pk_fp8_f32(__uint_as_float(w.w << 16), __uint_as_float(w.w & 0xFFFF0000u), p1, true);
            u32x2 o; o.x = (unsigned)p0; o.y = (unsigned)p1; *(u32x2*)(q + 32 * g + 8 * k) = o; }
        const u32x4 w1 = *(const u32x4*)(p + 128 + 8 * g), w2 = *(const u32x4*)(p + 160 + 8 * g);
        const unsigned a1[4] = {w1.x, w1.y, w1.z, w1.w}, a2[4] = {w2.x, w2.y, w2.z, w2.w};
        float o1[8], o2[8]; const int ps = pos[row];
#pragma unroll
        for (int j = 0; j < 8; ++j) { float cs, sn; rope_cs(ps, 8 * g + j, cs, sn);
            const float x1 = (j & 1) ? __uint_as_float(a1[j >> 1] & 0xFFFF0000u) : __uint_as_float(a1[j >> 1] << 16), x2 = (j & 1) ? __uint_as_float(a2[j >> 1] & 0xFFFF0000u) : __uint_as_float(a2[j >> 1] << 16);
            o1[j] = x1 * cs - x2 * sn; o2[j] = x2 * cs + x1 * sn; }
        int p0 = 0, p1 = 0, p2 = 0, p3 = 0;
        p0 = __builtin_amdgcn_cvt_pk_fp8_f32(o1[0], o1[1], p0, false); p0 = __builtin_amdgcn_cvt_pk_fp8_f32(o1[2], o1[3], p0, true); p1 = __builtin_amdgcn_cvt_pk_fp8_f32(o1[4], o1[5], p1, false); p1 = __builtin_amdgcn_cvt_pk_fp8_f32(o1[6], o1[7], p1, true);
        p2 = __builtin_amdgcn_cvt_pk_fp8_f32(o2[0], o2[1], p2, false); p2 = __builtin_amdgcn_cvt_pk_fp8_f32(o2[2], o2[3], p2, true); p3 = __builtin_amdgcn_cvt_pk_fp8_f32(o2[4], o2[5], p3, false); p3 = __builtin_amdgcn_cvt_pk_fp8_f32(o2[6], o2[7], p3, true);
        u32x2 oa; oa.x = (unsigned)p0; oa.y = (unsigned)p1; *(u32x2*)(q + 128 + 8 * g) = oa;
        u32x2 ob; ob.x = (unsigned)p2; ob.y = (unsigned)p3; *(u32x2*)(q + 160 + 8 * g) = ob;
    }
}
__device__ __forceinline__ void ph_rope_k(const float* __restrict__ KR, const int* __restrict__ pos, unsigned char* __restrict__ K8, int bid, int nblk) {
    for (int idx = bid * 512 + opaque_tid(); idx < NTOK * 32; idx += nblk * 512) {
        const int i = idx & 31, row = idx >> 5;
        float c, s; rope_cs(pos[row], i, c, s);
        const float x1 = KR[(size_t)row * 64 + i], x2 = KR[(size_t)row * 64 + 32 + i];
        const int pk = __builtin_amdgcn_cvt_pk_fp8_f32(x1 * c - x2 * s, x2 * c + x1 * s, 0, false);
        const unsigned char o1 = (unsigned char)(pk & 0xFF), o2 = (unsigned char)((pk >> 8) & 0xFF);
#pragma unroll
        for (int h = 0; h < 8; ++h) { unsigned char* p = K8 + (size_t)row * 1536 + h * 192 + 128; p[i] = o1; p[32 + i] = o2; }
    }
}
template <bool OUT8> __device__ __forceinline__ void ph_ffn_gate(const bf16_t* __restrict__ HID, const float* __restrict__ cw, const float* __restrict__ cb, bf16_t* __restrict__ ACT, int bid, int nblk) {
    for (int i = bid * 512 + opaque_tid(); i < 512 * (SEQ / 64); i += nblk * 512) {
        const int c8 = (i & 511) * 8, t0 = (i >> 9) * 64;
        float wg[3][8], wv[3][8], bg[8], bv[8];
#pragma unroll
        for (int j = 0; j < 8; ++j) { bg[j] = cb[c8 + j]; bv[j] = cb[4096 + c8 + j];
#pragma unroll
            for (int k = 0; k < 3; ++k) { wg[k][j] = cw[k * 8192 + c8 + j]; wv[k][j] = cw[k * 8192 + 4096 + c8 + j]; } }
        u32x4 g2 = {0u, 0u, 0u, 0u}, g1 = g2, v2 = g2, v1 = g2;
        if (t0 >= 2) { g2 = *(const u32x4*)(HID + (size_t)(t0 - 2) * 8192 + c8); g1 = *(const u32x4*)(HID + (size_t)(t0 - 1) * 8192 + c8);
                       v2 = *(const u32x4*)(HID + (size_t)(t0 - 2) * 8192 + 4096 + c8); v1 = *(const u32x4*)(HID + (size_t)(t0 - 1) * 8192 + 4096 + c8); }
#pragma unroll 8
        for (int r = 0; r < 64; ++r) {
            const u32x4 g0 = *(const u32x4*)(HID + (size_t)(t0 + r) * 8192 + c8), v0 = *(const u32x4*)(HID + (size_t)(t0 + r) * 8192 + 4096 + c8);
            const unsigned G2[4] = {g2.x, g2.y, g2.z, g2.w}, G1[4] = {g1.x, g1.y, g1.z, g1.w}, G0[4] = {g0.x, g0.y, g0.z, g0.w};
            const unsigned V2[4] = {v2.x, v2.y, v2.z, v2.w}, V1[4] = {v1.x, v1.y, v1.z, v1.w}, V0[4] = {v0.x, v0.y, v0.z, v0.w};
            float o[8];
#pragma unroll
            for (int j = 0; j < 4; ++j) {
                const float ge = bg[2 * j] + wg[0][2 * j] * __uint_as_float(G2[j] << 16) + wg[1][2 * j] * __uint_as_float(G1[j] << 16) + wg[2][2 * j] * __uint_as_float(G0[j] << 16);
                const float go = bg[2 * j + 1] + wg[0][2 * j + 1] * __uint_as_float(G2[j] & 0xFFFF0000u) + wg[1][2 * j + 1] * __uint_as_float(G1[j] & 0xFFFF0000u) + wg[2][2 * j + 1] * __uint_as_float(G0[j] & 0xFFFF0000u);
                const float ve = bv[2 * j] + wv[0][2 * j] * __uint_as_float(V2[j] << 16) + wv[1][2 * j] * __uint_as_float(V1[j] << 16) + wv[2][2 * j] * __uint_as_float(V0[j] << 16);
                const float vo = bv[2 * j + 1] + wv[0][2 * j + 1] * __uint_as_float(V2[j] & 0xFFFF0000u) + wv[1][2 * j + 1] * __uint_as_float(V1[j] & 0xFFFF0000u) + wv[2][2 * j + 1] * __uint_as_float(V0[j] & 0xFFFF0000u);
                o[2 * j] = gelu_tanh(ge) * ve; o[2 * j + 1] = gelu_tanh(go) * vo; }
            if (OUT8) { int p0 = 0, p1 = 0;
                p0 = __builtin_amdgcn_cvt_pk_fp8_f32(o[0], o[1], p0, false); p0 = __builtin_amdgcn_cvt_pk_fp8_f32(o[2], o[3], p0, true);
                p1 = __builtin_amdgcn_cvt_pk_fp8_f32(o[4], o[5], p1, false); p1 = __builtin_amdgcn_cvt_pk_fp8_f32(o[6], o[7], p1, true);
                u32x2 ov; ov.x = (unsigned)p0; ov.y = (unsigned)p1; *(u32x2*)((unsigned char*)ACT + (size_t)(t0 + r) * 4096 + c8) = ov; }
            else { u32x4 ov; ov.x = pack2bf(o[0], o[1]); ov.y = pack2bf(o[2], o[3]); ov.z = pack2bf(o[4], o[5]); ov.w = pack2bf(o[6], o[7]);
                *(u32x4*)(ACT + (size_t)(t0 + r) * 4096 + c8) = ov; }
            g2 = g1; g1 = g0; v2 = v1; v1 = v0;
        }
    }
}

__device__ __forceinline__ void ph_conv_lru(const float* __restrict__ wa, const float* __restrict__ wx, bf16_t* __restrict__ Bt, int bid, int nblk) {
    for (int e = bid * 512 + opaque_tid(); e < 8 * 2 * 128 * 128; e += nblk * 512) {
        const int d = e & 127, c = (e >> 7) & 127, gate = (e >> 14) & 1, nb = e >> 15;
        const float v = (gate ? wx : wa)[((size_t)nb * 128 + c) * 128 + d];
        bf16_t* row = Bt + (size_t)(nb * 256 + gate * 128 + d) * 256;
        row[(nb & 1) * 128 + c] = f2bf(v); row[(1 - (nb & 1)) * 128 + c] = 0;
    }
}

static constexpr size_t MiB = 1048576;
static constexpr size_t W_UP0 = 0 * MiB, W_UP1 = 32 * MiB, W_DN0 = 64 * MiB, W_DN1 = 80 * MiB, W_ABIN = 96 * MiB, W_ABOUT = 117 * MiB, W_CDIN = 125 * MiB, W_CDOUT = 137 * MiB,
                        W_QUP = 145 * MiB, W_KVUP = 146 * MiB + 512 * 1024, W_POOL = 147 * MiB + 512 * 1024;
static constexpr size_t R_H = 148 * MiB;
static constexpr size_t R_Q0 = 276 * MiB, R_K0 = 340 * MiB, R_VT0 = 404 * MiB, R_QI = 468 * MiB, R_M0 = 468 * MiB, R_U = 596 * MiB, R_KI = 724 * MiB, R_WI = 732 * MiB, R_MASK = 734 * MiB, R_CC0 = 830 * MiB, R_POOLED = 958 * MiB, R_H8A = 830 * MiB;
static constexpr size_t R_HID = 276 * MiB, R_ACT = 532 * MiB, R_F = 660 * MiB, R_X3 = 788 * MiB;
static constexpr size_t R_VT1 = 276 * MiB, R_CQ = 276 * MiB, R_CKV = 340 * MiB, R_KR = 372 * MiB, R_XL = 380 * MiB, R_YG = 444 * MiB, R_CQN = 508 * MiB, R_CKVN = 540 * MiB, R_LA = 556 * MiB, R_LB = 684 * MiB,
                        R_Q1 = 812 * MiB, R_K1 = 908 * MiB, R_Q8 = 956 * MiB,     R_CA = 1004 * MiB, R_CH = 1006 * MiB, R_CIN = 1008 * MiB, R_CC1 = 148 * MiB, R_M1 = 276 * MiB, R_XCB = 148 * MiB, W_LRU = 1010 * MiB;
static constexpr size_t WS_BAR = 1022 * MiB, WS_NEED = 1022 * MiB + 65536;
static constexpr int MK_LDS = 162816;

struct MK { const float* in[28]; float* out; unsigned char* ws; int ph_lo, ph_hi; };

__global__ __launch_bounds__(512, 2) void k_mega(MK p) {
    extern __shared__ __attribute__((aligned(16))) unsigned char shm[];
    LAS unsigned char* lds = (LAS unsigned char*)shm;
    const int bid0 = (int)blockIdx.x, nblk0 = (int)gridDim.x;
    volatile LAS unsigned* xbw = (volatile LAS unsigned*)(lds + MK_LDS - 16);
    if (threadIdx.x == 0) { xbw[0] = 0u; xbw[1] = 0u; xbw[2] = 0u; xbw[3] = 0u; }
    if ((threadIdx.x & 63) == 0) *(volatile LAS int*)(size_t)(TID_TAB_LDS + 4 * ((unsigned)__builtin_amdgcn_s_getreg(((6 - 1) << 11) | 4) & 63u)) = (int)(threadIdx.x >> 6);
    __syncthreads();
    XcdBarrier bar = xcd_barrier_post((unsigned*)(p.ws + WS_BAR), xbw);
#ifndef KARG_PLAIN
#define KARG_PLAIN 0
#endif
#if KARG_PLAIN
#define KARG_DECL const MK& P_ = p;
#else
#define KARG_DECL KPtr P__ = kp; asm volatile("" : "+s"(P__)); const __attribute__((address_space(4))) MK& P_ = *P__;
#endif
    typedef const __attribute__((address_space(4))) MK* KPtr;
    KPtr kp = (KPtr)__builtin_amdgcn_kernarg_segment_ptr();
#define WSP(T, off) ((T*)(ws + (off)))
#define PHASE_BEGIN if (pc >= p.ph_lo && pc < p.ph_hi) { const int bid = opaque_s(bid0), nblk = opaque_s(nblk0); \
    KARG_DECL unsigned char* const ws = P_.ws; float* const xo = P_.out; const float* const x = P_.in[0]; const int* const positions = (const int*)P_.in[1]; \
    const float *const mix_pre_g = P_.in[2], *const mix_post_g = P_.in[3], *const ffn_pre_g = P_.in[4], *const ffn_post_g = P_.in[5], *const ffn_up = P_.in[6], *const ffn_conv_w = P_.in[7], *const ffn_conv_b = P_.in[8], *const ffn_down = P_.in[9], \
    *const ab_w_in = P_.in[10], *const pool_w = P_.in[11], *const pool_b = P_.in[12], *const pool_scale = P_.in[13], *const ab_w_out = P_.in[14], *const cd_w_in = P_.in[15], *const q_norm_g = P_.in[16], *const w_q_up = P_.in[17], \
    *const kv_norm_g = P_.in[18], *const w_kv_up = P_.in[19], *const lru_conv_w = P_.in[20], *const lru_conv_b = P_.in[21], *const lru_wa = P_.in[22], *const lru_ba = P_.in[23], *const lru_wx = P_.in[24], *const lru_bx = P_.in[25], \
    *const lru_lambda = P_.in[26], *const cd_w_out = P_.in[27]; bf16_t* const H = WSP(bf16_t, R_H); const bf16_t* const CC = WSP(bf16_t, LAYER_CC); bf16_t* const Mx = WSP(bf16_t, LAYER_MX); \
    (void)xo; (void)x; (void)positions; (void)mix_pre_g; (void)mix_post_g; (void)ffn_pre_g; (void)ffn_post_g; (void)ffn_up; (void)ffn_conv_w; (void)ffn_conv_b; (void)ffn_down; (void)ab_w_in; (void)pool_w; (void)pool_b; (void)pool_scale; \
    (void)ab_w_out; (void)cd_w_in; (void)q_norm_g; (void)w_q_up; (void)kv_norm_g; (void)w_kv_up; (void)lru_conv_w; (void)lru_conv_b; (void)lru_wa; (void)lru_ba; (void)lru_wx; (void)lru_bx; (void)lru_lambda; (void)cd_w_out; (void)H; (void)CC; (void)Mx;
#define PHASE_END } if (pc >= p.ph_lo && pc + 1 < p.ph_hi) xcd_barrier(bar); ++pc;
    int pc = 0;
#define LAYER_CC R_CC0
#define LAYER_MX R_M0
    PHASE_BEGIN
#if !((SKIPMASK >> 0) & 1)
#if FP8_UP0
        ph_convT8(lds, ffn_up, 8192, 8192, 2048, WSP(unsigned char, W_UP0), bid, nblk, true);
#else
        ph_convT(lds, ffn_up, 8192, 0, 8192, 2048, WSP(bf16_t, W_UP0), 2048, bid, nblk, true);
#endif
#if FP8_UP1
        ph_convT8(lds, ffn_up + (size_t)2048 * 8192, 8192, 8192, 2048, WSP(unsigned char, W_UP1), bid, nblk, true);
#else
        ph_convT(lds, ffn_up + (size_t)2048 * 8192, 8192, 0, 8192, 2048, WSP(bf16_t, W_UP1), 2048, bid, nblk, true);
#endif
#if FP8_DN0
        ph_convT8(lds, ffn_down, 2048, 2048, 4096, WSP(unsigned char, W_DN0), bid, nblk);
#else
        ph_convT(lds, ffn_down, 2048, 0, 2048, 4096, WSP(bf16_t, W_DN0), 4096, bid, nblk);
#endif
#if FP8_DN1
        ph_convT8(lds, ffn_down + (size_t)4096 * 2048, 2048, 2048, 4096, WSP(unsigned char, W_DN1), bid, nblk);
#else
        ph_convT(lds, ffn_down + (size_t)4096 * 2048, 2048, 0, 2048, 4096, WSP(bf16_t, W_DN1), 4096, bid, nblk);
#endif
#if FP8_QKV
        ph_convT8(lds, ab_w_in, 5200, 3072, 2048, WSP(unsigned char, W_ABIN), bid, nblk);
        ph_convT(lds, ab_w_in, 5200, 3072, 1024, 2048, WSP(bf16_t, W_ABIN) + (size_t)3072 * 2048, 2048, bid, nblk);
#else
        ph_convT(lds, ab_w_in, 5200, 0, 4096, 2048, WSP(bf16_t, W_ABIN), 2048, bid, nblk);
#endif
        ph_convT(lds, ab_w_in, 5200, 4176, 1024, 2048, WSP(bf16_t, W_ABIN) + (size_t)4096 * 2048, 2048, bid, nblk);
        ph_convT(lds, ab_w_in, 5200, 4096, 64, 2048, WSP(bf16_t, W_ABIN) + (size_t)5120 * 2048, 2048, bid, nblk);
        ph_convT(lds, ab_w_in, 5200, 4160, 16, 2048, WSP(bf16_t, W_ABIN) + (size_t)5184 * 2048, 2048, bid, nblk);
        ph_convT(lds, ab_w_out, 2048, 0, 2048, 2048, WSP(bf16_t, W_ABOUT), 2048, bid, nblk);
        ph_convT(lds, cd_w_in, 2880, 0, 832, 2048, WSP(bf16_t, W_CDIN), 2048, bid, nblk);
        ph_convT(lds, cd_w_in, 2880, 832, 2048, 2048, WSP(bf16_t, W_CDIN) + (size_t)1024 * 2048, 2048, bid, nblk);
        ph_convT(lds, cd_w_out, 2048, 0, 2048, 2048, WSP(bf16_t, W_CDOUT), 2048, bid, nblk);
        ph_convT(lds, w_q_up, 1536, 0, 1536, 512, WSP(bf16_t, W_QUP), 512, bid, nblk);
        ph_convT(lds, w_kv_up, 2048, 0, 2048, 256, WSP(bf16_t, W_KVUP), 256, bid, nblk);
        for (int g = 0; g < 4; ++g) ph_convT(lds, pool_w + (size_t)g * 65536, 256, 0, 256, 256, WSP(bf16_t, W_POOL) + (size_t)g * 65536, 256, bid, nblk);
        ph_rmsnorm<2048>(x, mix_pre_g, H, bid, nblk, FP8_QKV ? WSP(unsigned char, R_H8A) : (unsigned char*)nullptr);
#endif
    PHASE_END
    {
            PHASE_BEGIN
#if !((SKIPMASK >> 1) & 1)
                FAbIn2 f; f.Q = WSP(unsigned char, R_Q0); f.K = WSP(unsigned char, R_K0); f.VT = WSP(bf16_t, R_VT0); f.QI = WSP(float, R_QI); f.U = WSP(float, R_U); f.WI = WSP(float, R_WI); f.KI16 = WSP(unsigned short, R_KI);
#if FP8_QKV
                ph_gemm8(lds, WSP(unsigned char, R_H8A), 2048, WSP(unsigned char, W_ABIN), 2048, NTOK, 3072, 2048, f, bid, nblk);
                { FAbInHi fh; fh.f = f; ph_gemm(lds, H, 2048, WSP(bf16_t, W_ABIN) + (size_t)3072 * 2048, 2048, NTOK, 2304, 2048, fh, bid, nblk); }
#else
                ph_gemm(lds, H, 2048, WSP(bf16_t, W_ABIN), 2048, NTOK, 5376, 2048, f, bid, nblk);
#endif
#endif
            PHASE_END
            PHASE_BEGIN
#if !((SKIPMASK >> 2) & 1)
                ph_pooled(WSP(float, R_U), WSP(bf16_t, R_POOLED), bid, nblk);
                IdxArgs a; a.QI = WSP(float, R_QI); a.KI16 = WSP(unsigned short, R_KI); a.WI = WSP(float, R_WI); a.MT = WSP(unsigned long long, R_MASK);
                idx_phase(lds, a, bid, nblk);
#endif
            PHASE_END
            PHASE_BEGIN
#if !((SKIPMASK >> 3) & 1)
                { FPool f; f.CC = WSP(bf16_t, R_CC0); f.pb = pool_b; f.ps = pool_scale; ph_gemm(lds, WSP(bf16_t, R_POOLED), 1024, WSP(bf16_t, W_POOL), 256, NTOK, 1024, 256, f, bid, nblk, 0, 512); }
                AttnArgs a; a.Q = WSP(bf16_t, R_Q0); a.K = WSP(bf16_t, R_K0); a.VT = WSP(bf16_t, R_VT0); a.MT = WSP(unsigned long long, R_MASK); a.O = WSP(bf16_t, R_CC0); a.ldq = 1024; a.ldk = 1024; a.ldo = 2048;
                a.sc_log2e = 0.08838834764831845f * 1.4426950408889634f;
                attn_phase<128, true>(lds, a, bid, nblk);
#endif
            PHASE_END
        PHASE_BEGIN
#if !((SKIPMASK >> 4) & 1)
            FStoreBf16 f; f.O = Mx; f.ldc = 2048; f.pad_ = 0;
            ph_gemm(lds, CC, 2048, WSP(bf16_t, W_ABOUT), 2048, NTOK, 2048, 2048, f, bid, nblk);
#endif
        PHASE_END
        PHASE_BEGIN
#if !((SKIPMASK >> 5) & 1)
            ph_resnorm<false, true>(x, Mx, mix_post_g + 0, ffn_pre_g + 0, xo, H, FP8_UP0 ? WSP(unsigned char, R_H) : (unsigned char*)nullptr, bid, nblk);
#endif
        PHASE_END
        PHASE_BEGIN
#if FP8_UP0
            { EpiGate<FP8_DN0 != 0, true> ep; ep.cw = ffn_conv_w + 0; ep.cb = ffn_conv_b + 0; ep.ACT = WSP(void, R_HID);
              ph_gemm_e(lds, (const bf16_t*)WSP(unsigned char, R_H), 1024, (const bf16_t*)WSP(unsigned char, W_UP0), 1024, 134 * 256, 8192, 1024, ep, bid, nblk, 0, 0, 1); }
#else
            { EpiGate<FP8_DN0 != 0, false> ep; ep.cw = ffn_conv_w + 0; ep.cb = ffn_conv_b + 0; ep.ACT = WSP(void, R_HID);
              ph_gemm_e(lds, H, 2048, WSP(bf16_t, W_UP0), 2048, 134 * 256, 8192, 2048, ep, bid, nblk, 0, 0, 1); }
#endif
        PHASE_END
        PHASE_BEGIN
            FStoreBf16 f; f.O = WSP(bf16_t, R_F); f.ldc = 2048; f.pad_ = 0;
#if FP8_DN0
            ph_gemm8(lds, WSP(unsigned char, R_HID), 4096, WSP(unsigned char, W_DN0), 4096, NTOK, 2048, 4096, f, bid, nblk);
#else
            ph_gemm(lds, WSP(bf16_t, R_HID), 4096, WSP(bf16_t, W_DN0), 4096, NTOK, 2048, 4096, f, bid, nblk);
#endif
        PHASE_END
        PHASE_BEGIN
#if !((SKIPMASK >> 9) & 1)
            ph_resnorm<true, true>(xo, WSP(bf16_t, R_F), ffn_post_g + 0, mix_pre_g + 2048, xo, H, nullptr, bid, nblk);
#endif
        PHASE_END
    }
    {
#undef LAYER_CC
#undef LAYER_MX
#define LAYER_CC R_CC1
#define LAYER_MX R_M1
            PHASE_BEGIN
#if !((SKIPMASK >> 10) & 1)
                FCdIn f; f.CQ = WSP(float, R_CQ); f.CKV = WSP(float, R_CKV); f.KR = WSP(float, R_KR); f.XL = WSP(bf16_t, R_XL); f.YG = WSP(bf16_t, R_YG);
                ph_gemm(lds, H, 2048, WSP(bf16_t, W_CDIN), 2048, NTOK, 3072, 2048, f, bid, nblk);
#endif
            PHASE_END
            PHASE_BEGIN
#if !((SKIPMASK >> 11) & 1)
                ph_xc(WSP(bf16_t, R_XL), lru_conv_w, lru_conv_b, WSP(bf16_t, R_XCB), bid, nblk);
                ph_conv_lru(lru_wa, lru_wx, WSP(bf16_t, W_LRU), bid, nblk);
                ph_rmsnorm<512>(WSP(float, R_CQ), q_norm_g, WSP(bf16_t, R_CQN), bid, nblk);
                ph_rmsnorm<256>(WSP(float, R_CKV), kv_norm_g, WSP(bf16_t, R_CKVN), bid, nblk);
            PHASE_END
            PHASE_BEGIN
                { EpiLru ep; ep.XCB = WSP(bf16_t, R_XCB); ep.ba = lru_ba; ep.bx = lru_bx; ep.lam = lru_lambda; ep.LA = WSP(float, R_LA); ep.LB = WSP(float, R_LB);
                  ph_gemm_e(lds, WSP(bf16_t, R_XCB), 1024, WSP(bf16_t, W_LRU), 256, NTOK, 2048, 256, ep, bid, nblk, 1, 512); }
                { FStoreBf16 f; f.O = WSP(bf16_t, R_Q1); f.ldc = 1536; f.pad_ = 0; ph_gemm(lds, WSP(bf16_t, R_CQN), 512, WSP(bf16_t, W_QUP), 512, NTOK, 1536, 512, f, bid, nblk); }
                { FKvUp2 f; f.K8 = WSP(unsigned char, R_K1); f.VT = WSP(bf16_t, R_VT1); ph_gemm(lds, WSP(bf16_t, R_CKVN), 256, WSP(bf16_t, W_KVUP), 256, NTOK, 2048, 256, f, bid, nblk); }
            PHASE_END
            PHASE_BEGIN
                ph_scan1(WSP(float, R_LA), WSP(float, R_LB), WSP(float, R_CA), WSP(float, R_CH), bid, nblk);
                ph_rope_q(WSP(bf16_t, R_Q1), positions, WSP(unsigned char, R_Q8), bid, nblk);
                ph_rope_k(WSP(float, R_KR), positions, WSP(unsigned char, R_K1), bid, nblk);
            PHASE_END
            PHASE_BEGIN
                ph_scan2(WSP(float, R_CA), WSP(float, R_CH), WSP(float, R_CIN), bid, nblk);
            PHASE_END
            PHASE_BEGIN
                ph_scan3(WSP(float, R_LA), WSP(float, R_LB), WSP(float, R_CIN), WSP(bf16_t, R_YG), WSP(bf16_t, R_CC1), bid, nblk);
                AttnArgs a; a.Q = WSP(bf16_t, R_Q8); a.K = WSP(bf16_t, R_K1); a.VT = WSP(bf16_t, R_VT1); a.MT = nullptr; a.O = WSP(bf16_t, R_CC1); a.ldq = 1536; a.ldk = 1536; a.ldo = 2048;
                a.sc_log2e = 0.07216878364870322f * 1.4426950408889634f;
                attn_phase<192, false>(lds, a, bid, nblk);
#endif
            PHASE_END
        PHASE_BEGIN
#if !((SKIPMASK >> 15) & 1)
            FStoreBf16 f; f.O = Mx; f.ldc = 2048; f.pad_ = 0;
            ph_gemm(lds, CC, 2048, WSP(bf16_t, W_CDOUT), 2048, NTOK, 2048, 2048, f, bid, nblk);
#endif
        PHASE_END
        PHASE_BEGIN
#if !((SKIPMASK >> 16) & 1)
            ph_resnorm<true, true>(xo, Mx, mix_post_g + 2048, ffn_pre_g + 2048, WSP(bf16_t, R_X3), H, FP8_UP1 ? WSP(unsigned char, R_H) : (unsigned char*)nullptr, bid, nblk);
#endif
        PHASE_END
        PHASE_BEGIN
#if FP8_UP1
            { EpiGate<FP8_DN1 != 0, true> ep; ep.cw = ffn_conv_w + 24576; ep.cb = ffn_conv_b + 8192; ep.ACT = WSP(void, R_HID);
              ph_gemm_e(lds, (const bf16_t*)WSP(unsigned char, R_H), 1024, (const bf16_t*)WSP(unsigned char, W_UP1), 1024, 134 * 256, 8192, 1024, ep, bid, nblk, 0, 0, 1); }
#else
            { EpiGate<FP8_DN1 != 0, false> ep; ep.cw = ffn_conv_w + 24576; ep.cb = ffn_conv_b + 8192; ep.ACT = WSP(void, R_HID);
              ph_gemm_e(lds, H, 2048, WSP(bf16_t, W_UP1), 2048, 134 * 256, 8192, 2048, ep, bid, nblk, 0, 0, 1); }
#endif
        PHASE_END
        PHASE_BEGIN
            FStoreBf16 f; f.O = WSP(bf16_t, R_F); f.ldc = 2048; f.pad_ = 0;
#if FP8_DN1
            ph_gemm8(lds, WSP(unsigned char, R_HID), 4096, WSP(unsigned char, W_DN1), 4096, NTOK, 2048, 4096, f, bid, nblk);
#else
            ph_gemm(lds, WSP(bf16_t, R_HID), 4096, WSP(bf16_t, W_DN1), 4096, NTOK, 2048, 4096, f, bid, nblk);
#endif
        PHASE_END
        PHASE_BEGIN
#if !((SKIPMASK >> 20) & 1)
            ph_resnorm<true, false>(WSP(bf16_t, R_X3), WSP(bf16_t, R_F), ffn_post_g + 2048, (const float*)nullptr, xo, H, nullptr, bid, nblk);
#endif
        PHASE_END
    }
#undef LAYER_CC
#undef LAYER_MX
#undef WSP
#undef PHASE_BEGIN
#undef PHASE_END
}

#ifndef MK_N_LAUNCHES
#define MK_N_LAUNCHES 1
#endif
static constexpr int MK_NPHASES = 1 + 3 + 7 + 2 * 5;

extern "C" void kernel_launch(void* const* d_in, const int* in_sizes, int n_in, void* d_out, int out_size, void* d_ws, size_t ws_size, hipStream_t stream) {
    static int grid = 0;
    if (grid == 0) {
        if (n_in != 28 || out_size != NTOK * DM || ws_size < WS_NEED) { fprintf(stderr, "kernel_launch: unexpected shapes (n_in %d out %d ws %zu)\n", n_in, out_size, ws_size); grid = -1; return; }
        int dev = 0, cus = 0, per_cu = 0;
        if (hipGetDevice(&dev) != hipSuccess || hipDeviceGetAttribute(&cus, hipDeviceAttributeMultiprocessorCount, dev) != hipSuccess) { grid = -1; return; }
        if (hipFuncSetAttribute((const void*)k_mega, hipFuncAttributeMaxDynamicSharedMemorySize, MK_LDS) != hipSuccess) { fprintf(stderr, "kernel_launch: hipFuncSetAttribute failed\n"); grid = -1; return; }
        if (hipOccupancyMaxActiveBlocksPerMultiprocessor(&per_cu, (const void*)k_mega, 512, MK_LDS) != hipSuccess || per_cu < 1) { fprintf(stderr, "kernel_launch: occupancy query says %d\n", per_cu); }
        (void)hipGetLastError();
        grid = cus;
        if (grid != 256) { fprintf(stderr, "kernel_launch: built for 256 CUs, found %d\n", grid); grid = -1; return; }
    }
    if (grid < 0) return;
    unsigned char* ws = (unsigned char*)d_ws;
    (void)hipMemsetAsync(ws + WS_BAR, 0, XCD_BAR_WORDS * sizeof(unsigned), stream);
    (void)hipMemsetAsync(ws + W_ABIN + (size_t)5200 * 2048 * 2, 0, (size_t)176 * 2048 * 2, stream);
    (void)hipMemsetAsync(ws + W_CDIN + (size_t)832 * 2048 * 2, 0, (size_t)192 * 2048 * 2, stream);
    MK p{};
    for (int i = 0; i < 28; ++i) p.in[i] = (const float*)d_in[i];
    p.out = (float*)d_out; p.ws = ws;
#if MK_N_LAUNCHES == 1
    p.ph_lo = 0; p.ph_hi = 1 << 20;
    hipLaunchKernelGGL(k_mega, dim3(grid), dim3(512), MK_LDS, stream, p);
#else
    for (int ph = 0; ph < MK_NPHASES; ++ph) { p.ph_lo = ph; p.ph_hi = ph + 1; hipLaunchKernelGGL(k_mega, dim3(grid), dim3(512), MK_LDS, stream, p); }
#endif
}
```

```cpp
#include <hip/hip_runtime.h>
#include <stdint.h>
#include <stdio.h>

#define LAS __attribute__((address_space(3)))
typedef unsigned short bf16_t;
typedef float f32x4 __attribute__((ext_vector_type(4)));
typedef unsigned u32x4 __attribute__((ext_vector_type(4)));
typedef unsigned u32x2 __attribute__((ext_vector_type(2)));

static constexpr int NTOK = 32768, SEQ = 16384, NBATCH = 2, DM = 2048, DFF = 4096;
static constexpr float NORM_EPS = 1e-6f;

__device__ __forceinline__ bf16_t f2bf(float f) { unsigned u = __float_as_uint(f); u += 0x7FFFu + ((u >> 16) & 1u); return (bf16_t)(u >> 16); }
__device__ __forceinline__ float bf2f(bf16_t b) { return __uint_as_float(((unsigned)b) << 16); }
__device__ __forceinline__ unsigned pack2bf(float lo, float hi) { return (unsigned)f2bf(lo) | ((unsigned)f2bf(hi) << 16); }
__device__ __forceinline__ float gelu_tanh(float x) { const float u = 0.7978845608028654f * (x + 0.044715f * x * x * x); return 0.5f * x * (1.0f + tanhf(u)); }
__device__ __forceinline__ float wave_sum(float v) {
#pragma unroll
    for (int o = 32; o >= 1; o >>= 1) v += __shfl_xor(v, o);
    return v;
}

#ifndef TID_PLAIN
#define TID_PLAIN 0
#endif
static constexpr int TID_TAB_LDS = 162816 - 16 - 256;
#if TID_PLAIN
__device__ __forceinline__ int opaque_tid() { int t = (int)threadIdx.x; asm volatile("" : "+v"(t)); return t; }
#else
__device__ __forceinline__ int opaque_tid() {
    const unsigned slot = (unsigned)__builtin_amdgcn_s_getreg(((6 - 1) << 11) | 4) & 63u;
    const int w = __builtin_amdgcn_readfirstlane(*(const volatile LAS int*)(size_t)(TID_TAB_LDS + 4 * slot));
    int lane; asm volatile("v_mbcnt_lo_u32_b32 %0, -1, 0\n\tv_mbcnt_hi_u32_b32 %0, -1, %0" : "=v"(lane));
    return w * 64 + lane;
}
#endif

__device__ __forceinline__ int opaque_s(int v) { asm volatile("" : "+s"(v)); return v; }

template <class T> __device__ __forceinline__ const T* opaque_p(const T* p) { asm volatile("" : "+s"(p)); return p; }

#ifndef PG8_EPI_RECOMP
#define PG8_EPI_RECOMP 1
#endif
#ifndef PG8_ASM_DMA
#define PG8_ASM_DMA 1
#endif
#include <hip/hip_runtime.h>
namespace pg8 {
#define PG8_LAS __attribute__((address_space(3)))
typedef unsigned short bf16_t;
typedef short bf16x8 __attribute__((ext_vector_type(8)));
typedef float f32x4 __attribute__((ext_vector_type(4)));
typedef unsigned u32x4 __attribute__((ext_vector_type(4)));
typedef int i32x8 __attribute__((ext_vector_type(8)));
typedef int i32x4 __attribute__((ext_vector_type(4)));
constexpr int BM = 256, BK = 64, HALF = 128, HTB = HALF * BK * 2  , STAGE_BYTES = 8 * HTB, NXCD = 8, WGM = 8;

__host__ __device__ __forceinline__ int lds_byte(int r, int c) { const int st = (r >> 4) * 2 + (c >> 5), rr = r & 15, cc = c & 31, ob = rr * 64 + cc * 2; return st * 1024 + (ob ^ (((ob >> 9) & 1) << 5)); }
__host__ __device__ __forceinline__ void stage_rc(int b, int& R, int& C) { const int st = b / 1024, sb = b % 1024, swz = sb ^ (((sb >> 9) & 1) << 5); R = (st >> 1) * 16 + swz / 64; C = (st & 1) * 32 + (swz % 64) / 2; }
__host__ __device__ __forceinline__ int perm32(int rho) { const int n = rho >> 4, i = rho & 15; return 8 * (i >> 2) + 4 * n + (i & 3); }

struct Unit { int pm, pn; };
struct Gemm { const bf16_t* A; const bf16_t* Bt; int M, N, K, lda, ldb, a_shift, a_bytes, cmode; };

struct StaticOrder {
    int nM, nN, nwg, G, c;
    __host__ __device__ void init(int M, int N, int G_, int c_) { nM = M / BM; nN = N / BM; nwg = nM * nN; G = G_; c = c_; }
    __host__ __device__ bool next(int i, Unit& u) const {
        const long L = (long)i * G + c; if (L >= nwg) return false;
        int wgid = (int)L; { const int q = nwg / NXCD, r = nwg % NXCD, xcd = wgid % NXCD, off = wgid / NXCD; wgid = (xcd < r ? xcd * (q + 1) : r * (q + 1) + (xcd - r) * q) + off; }
        const int nig = WGM * nN, gid = wgid / nig, fm = gid * WGM, gsz = (nM - fm) < WGM ? (nM - fm) : WGM;
        u.pm = fm + ((wgid % nig) % gsz); u.pn = (wgid % nig) / gsz; return true;
    }
    __device__ __forceinline__ void a_ready(const Unit&) const {}
    __device__ __forceinline__ void done(const Unit&) const {}
};

template <class Epi, class Sched, bool STAMP = false>
__device__ __forceinline__ void gemm_phase(PG8_LAS unsigned char* lds, const Gemm g, const Sched& S, const Epi& E, unsigned long long* stamps) {
    const int tid = opaque_tid(), wid = __builtin_amdgcn_readfirstlane(tid >> 6), lane = tid & 63, wr = wid >> 2, wc = wid & 3, fr = lane & 15, fq = lane >> 4;
    const int K = g.K, nt = K / BK;
    int ts_lo = 0, ts_hi = 0, nts = 0; const unsigned long long rt_entry = STAMP ? (unsigned long long)wall_clock64() : 0ull;
#define PG8_STAMP() do { if (STAMP && wid == 0 && nts < 64) { const unsigned long long _c = (unsigned long long)clock64(); \
        ts_lo = (lane == nts) ? (int)(unsigned)_c : ts_lo; ts_hi = (lane == nts) ? (int)(unsigned)(_c >> 32) : ts_hi; ++nts; } } while (0)
    PG8_STAMP();
    unsigned voffA[2], voffB[2];
#pragma unroll
    for (int i = 0; i < 2; ++i) { int R, C; stage_rc(tid * 16 + i * 8192, R, C); const int Rb = Epi::PERM ? ((R & ~31) + perm32(R & 31)) : R;
        const int Ra = g.cmode ? (R - 2 * (R >> 6)) : R;
        voffA[i] = (unsigned)(Ra * g.lda + C) * 2u; voffB[i] = (unsigned)(Rb * g.ldb + C) * 2u; }
    const size_t kstep = (size_t)(BK * 2);
    const size_t hstepA = (size_t)(g.cmode ? HALF - 4 : HALF) * g.lda * 2, hstepB = (size_t)HALF * g.ldb * 2;
    const size_t tstepA = 2 * hstepA, tstepB = 2 * hstepB;
    const unsigned ldsbase_ = (unsigned)(size_t)lds;
    const int sc_w_ = 0x79797979, sc_a_ = 0x7F7F7F7F;
    (void)sc_w_; (void)sc_a_;
    const unsigned ldsw = (unsigned)wid * 1024u;
    const int aoff = lds_byte(wr * 64 + fr, fq * 8), boff = lds_byte(wc * 32 + fr, fq * 8);
#define PG8_SA(b, h) (((b) * 2 + (h)) * HTB)
#define PG8_SB(b, h) ((4 + (b) * 2 + (h)) * HTB)
#if PG8_ASM_DMA
#define PG8_STAGE(bufoff, gbase, voff) do { _Pragma("unroll") for (int _i = 0; _i < 2; ++_i) { unsigned keep_; \
        asm volatile("s_mov_b32 %0, m0\n\ts_mov_b32 m0, %3\n\ts_nop 0\n\tglobal_load_lds_dwordx4 %1, %2\n\ts_mov_b32 m0, %0" \
                     : "=&s"(keep_) : "v"((voff)[_i]), "s"((const char*)(gbase)), "s"(ldsbase_ + (unsigned)(bufoff) + ldsw + (unsigned)(_i * 8192)) : "memory"); } } while (0)
#else
#define PG8_STAGE(bufoff, gbase, voff) do { _Pragma("unroll") for (int _i = 0; _i < 2; ++_i) \
        __builtin_amdgcn_global_load_lds((const unsigned*)((const char*)(gbase) + (voff)[_i]), (PG8_LAS unsigned*)(lds + (bufoff) + ldsw + _i * 8192), 16, 0, 0); } while (0)
#endif
#define PG8_LDA(dst, b, h) do { _Pragma("unroll") for (int m = 0; m < 4; ++m) { dst[m].lo = *(const PG8_LAS i32x4*)(lds + PG8_SA(b, h) + aoff + m * 2048); dst[m].hi = *(const PG8_LAS i32x4*)(lds + PG8_SA(b, h) + aoff + m * 2048 + 1024); } } while (0)
#define PG8_LDB(dst, b, h) do { _Pragma("unroll") for (int n = 0; n < 2; ++n) { dst[n].lo = *(const PG8_LAS i32x4*)(lds + PG8_SB(b, h) + boff + n * 2048); dst[n].hi = *(const PG8_LAS i32x4*)(lds + PG8_SB(b, h) + boff + n * 2048 + 1024); } } while (0)
#define PG8_MMA(ai, bj, At, Bt) do { __builtin_amdgcn_s_setprio(1); \
        if constexpr (Epi::FP8) { _Pragma("unroll") for (int m = 0; m < 4; ++m) _Pragma("unroll") for (int n = 0; n < 2; ++n) \
            asm volatile("v_mfma_scale_f32_16x16x128_f8f6f4 %0, %1, %2, %0, %3, %4 op_sel_hi:[0,0,0]" : "+v"(acc[ai][bj][m][n]) : "v"(Bt[n]), "v"(At[m]), "v"(sc_w_), "v"(sc_a_)); } \
        else { _Pragma("unroll") for (int m = 0; m < 4; ++m) _Pragma("unroll") for (int n = 0; n < 2; ++n) { \
            const i32x4 bl_ = Bt[n].lo, bh_ = Bt[n].hi, al_ = At[m].lo, ah_ = At[m].hi;     \
            acc[ai][bj][m][n] = __builtin_amdgcn_mfma_f32_16x16x32_bf16(__builtin_bit_cast(bf16x8, bl_), __builtin_bit_cast(bf16x8, al_), acc[ai][bj][m][n], 0, 0, 0); \
            acc[ai][bj][m][n] = __builtin_amdgcn_mfma_f32_16x16x32_bf16(__builtin_bit_cast(bf16x8, bh_), __builtin_bit_cast(bf16x8, ah_), acc[ai][bj][m][n], 0, 0, 0); } } \
        __builtin_amdgcn_s_setprio(0); } while (0)
#define PG8_WAIT_V(n) asm volatile("s_waitcnt vmcnt(" #n ")" ::: "memory")
#define PG8_WAIT_L(n) asm volatile("s_waitcnt lgkmcnt(" #n ")" ::: "memory")
#define PG8_BAR __builtin_amdgcn_s_barrier()
#define PG8_SCHED __builtin_amdgcn_sched_barrier(0)
    Unit cur, nxt; int ui = 0;
    if (!S.next(0, cur)) return;
    f32x4 acc[2][2][4][2];
#pragma unroll
    for (int a = 0; a < 2; ++a)
#pragma unroll
        for (int b = 0; b < 2; ++b)
#pragma unroll
            for (int m = 0; m < 4; ++m)
#pragma unroll
                for (int n = 0; n < 2; ++n) acc[a][b][m][n] = (f32x4){0.f, 0.f, 0.f, 0.f};
    i32x8 At[4], B0[2], B1[2];
    auto a_base_ = [&](const Unit& u_) -> const char* { return g.cmode ? (const char*)g.A + ((long)(u_.pm / 67) * 16384 + (long)(u_.pm % 67) * 248 - 2) * (long)g.lda * 2 : (const char*)g.A + (size_t)u_.pm * tstepA + (size_t)(u_.pn >> g.a_shift) * g.a_bytes; };
    const char* cA = a_base_(cur); const char* cB = (const char*)g.Bt + (size_t)cur.pn * tstepB;
    S.a_ready(cur);
    PG8_STAGE(PG8_SB(0, 0), cB, voffB); PG8_STAGE(PG8_SA(0, 0), cA, voffA); PG8_STAGE(PG8_SB(0, 1), cB + hstepB, voffB); PG8_STAGE(PG8_SA(0, 1), cA + hstepA, voffA);
    if (wr == 1) PG8_BAR;
    PG8_WAIT_V(4); PG8_BAR;
    PG8_STAGE(PG8_SB(1, 0), cB + kstep, voffB); PG8_STAGE(PG8_SA(1, 0), cA + kstep, voffA); PG8_STAGE(PG8_SB(1, 1), cB + hstepB + kstep, voffB);
    PG8_WAIT_V(6); PG8_BAR;
    PG8_STAMP();
    for (;;) {
        const bool has_next = S.next(ui + 1, nxt);
        const char* nA = has_next ? a_base_(nxt) : cA; const char* nB = has_next ? (const char*)g.Bt + (size_t)nxt.pn * tstepB : cB;
        for (int t = 0; t < nt; t += 2) {
            const bool last = (t == nt - 2);
            const char* a1 = cA + (size_t)(t + 1) * kstep;
            const char* a2 = last ? nA : cA + (size_t)(t + 2) * kstep; const char* b2 = last ? nB : cB + (size_t)(t + 2) * kstep;
            const char* a3 = a2 + kstep; const char* b3 = b2 + kstep;
            if (last && has_next) S.a_ready(nxt);
            PG8_LDB(B0, 0, 0); PG8_SCHED; PG8_LDA(At, 0, 0); PG8_STAGE(PG8_SA(1, 1), a1 + hstepA, voffA);
            PG8_WAIT_L(8); PG8_BAR; PG8_WAIT_L(0); PG8_MMA(0, 0, At, B0); PG8_BAR; PG8_SCHED;
            PG8_LDB(B1, 0, 1); PG8_STAGE(PG8_SB(0, 0), b2, voffB);
            PG8_BAR; PG8_WAIT_L(0); PG8_MMA(0, 1, At, B1); PG8_BAR;
            PG8_LDA(At, 0, 1); PG8_STAGE(PG8_SA(0, 0), a2, voffA);
            PG8_BAR; PG8_WAIT_L(0); PG8_MMA(1, 0, At, B0); PG8_BAR; PG8_SCHED;
            PG8_STAGE(PG8_SB(0, 1), b2 + hstepB, voffB);
            PG8_WAIT_V(6); PG8_BAR; PG8_MMA(1, 1, At, B1); PG8_BAR;
            PG8_LDB(B0, 1, 0); PG8_SCHED; PG8_LDA(At, 1, 0); PG8_STAGE(PG8_SA(0, 1), a2 + hstepA, voffA);
            PG8_WAIT_L(8); PG8_BAR; PG8_WAIT_L(0); PG8_MMA(0, 0, At, B0); PG8_BAR; PG8_SCHED;
            PG8_LDB(B1, 1, 1); PG8_STAGE(PG8_SB(1, 0), b3, voffB);
            PG8_BAR; PG8_WAIT_L(0); PG8_MMA(0, 1, At, B1); PG8_BAR;
            PG8_LDA(At, 1, 1); PG8_STAGE(PG8_SA(1, 0), a3, voffA);
            PG8_BAR; PG8_WAIT_L(0); PG8_MMA(1, 0, At, B0); PG8_BAR; PG8_SCHED;
            PG8_STAGE(PG8_SB(1, 1), b3 + hstepB, voffB);
            PG8_WAIT_V(6); PG8_BAR; PG8_MMA(1, 1, At, B1); PG8_BAR;
        }
        PG8_STAMP();
        if constexpr (Epi::FP8) { asm volatile("s_nop 15\n\ts_nop 15" ::: "memory"); }
        if constexpr (!Epi::AFTER_DRAIN) {
#if PG8_EPI_RECOMP
            const int t2_ = opaque_tid(), l2_ = t2_ & 63, w2_ = __builtin_amdgcn_readfirstlane(t2_ >> 6);
            E(acc, cur, w2_ >> 2, w2_ & 3, l2_ & 15, l2_ >> 4); S.done(cur);
#else
            E(acc, cur, wr, wc, fr, fq); S.done(cur);
#endif
        }
        PG8_STAMP();
        if (!has_next) break;
#pragma unroll
        for (int a = 0; a < 2; ++a)
#pragma unroll
            for (int b = 0; b < 2; ++b)
#pragma unroll
                for (int m = 0; m < 4; ++m)
#pragma unroll
                    for (int n = 0; n < 2; ++n) acc[a][b][m][n] = (f32x4){0.f, 0.f, 0.f, 0.f};
        cur = nxt; cA = nA; cB = nB; ++ui;
    }
    PG8_WAIT_V(0);
    if (wr == 0) PG8_BAR;
    PG8_BAR;
    if constexpr (Epi::AFTER_DRAIN) { E.fused(acc, cur, wr, wc, fr, fq, lds, wid, lane); S.done(cur); }
    PG8_STAMP();
    if (STAMP && wid == 0) { stamps[lane] = lane < nts ? (((unsigned long long)(unsigned)ts_hi << 32) | (unsigned)ts_lo) : 0ull;
        if (lane == 62) stamps[62] = rt_entry; if (lane == 63) stamps[63] = (unsigned long long)wall_clock64(); }
#undef PG8_STAMP
#undef PG8_SA
#undef PG8_SB
#undef PG8_STAGE
#undef PG8_LDA
#undef PG8_LDB
#undef PG8_MMA
#undef PG8_WAIT_V
#undef PG8_WAIT_L
#undef PG8_BAR
#undef PG8_SCHED
}
}

#include <cstdio>
#include <ctime>
#include <cstdlib>
#include <cstring>
#include <cmath>
#include <vector>

template <class F, bool F8 = false> struct EpiG {
    static constexpr bool PERM = false, AFTER_DRAIN = false, FP8 = F8;
    F f;
    __device__ __forceinline__ void operator()(const f32x4 (&acc)[2][2][4][2], const pg8::Unit& u, int wr, int wc, int fr, int fq) const {
        const int row0 = u.pm * 256 + wr * 64 + fr, col0 = u.pn * 256 + wc * 32 + 4 * fq;
#pragma unroll
        for (int ai = 0; ai < 2; ++ai)
#pragma unroll
            for (int m = 0; m < 4; ++m)
#pragma unroll
                for (int bj = 0; bj < 2; ++bj)
#pragma unroll
                    for (int n = 0; n < 2; ++n) f(row0 + ai * 128 + m * 16, col0 + bj * 128 + n * 16, acc[ai][bj][m][n]);
    }
};
__device__ __forceinline__ void st_bf16x4(bf16_t* p, f32x4 v) { u32x2 w; w.x = pack2bf(v[0], v[1]); w.y = pack2bf(v[2], v[3]); *(u32x2*)p = w; }
__device__ __forceinline__ void st_f32x4(float* p, f32x4 v) { *(f32x4*)p = v; }

struct FStoreBf16 { bf16_t* O; int ldc; int pad_; __device__ __forceinline__ void operator()(int r, int c, f32x4 v) const { st_bf16x4(O + (size_t)r * ldc + c, v); } };
struct FAbIn { bf16_t *Q, *K, *V; float *QI, *U, *WI; unsigned short* KI16;
    __device__ __forceinline__ void operator()(int r, int c, f32x4 v) const {
        if (c < 1024) st_bf16x4(Q + (size_t)r * 1024 + c, v);
        else if (c < 2048) st_bf16x4(K + (size_t)r * 1024 + (c - 1024), v);
        else if (c < 3072) st_bf16x4(V + (size_t)r * 1024 + (c - 2048), v);
        else if (c < 4096) st_f32x4(QI + (size_t)r * 1024 + (c - 3072), v);
        else if (c < 5120) st_f32x4(U + (size_t)r * 1024 + (c - 4096), v);
        else if (c < 5184) { typedef _Float16 h2 __attribute__((ext_vector_type(2))); union { h2 h; unsigned u; } a, b; a.h = (h2){(_Float16)v[0], (_Float16)v[1]}; b.h = (h2){(_Float16)v[2], (_Float16)v[3]};
            u32x2 w; w.x = a.u; w.y = b.u; *(u32x2*)(KI16 + (size_t)r * 64 + (c - 5120)) = w; }
        else if (c < 5200) st_f32x4(WI + (size_t)r * 16 + (c - 5184), v);
    } };
struct FCdIn { float *CQ, *CKV, *KR; bf16_t *XL, *YG;
    __device__ __forceinline__ void operator()(int r, int c, f32x4 v) const {
        if (c < 512) st_f32x4(CQ + (size_t)r * 512 + c, v);
        else if (c < 768) st_f32x4(CKV + (size_t)r * 256 + (c - 512), v);
        else if (c < 832) st_f32x4(KR + (size_t)r * 64 + (c - 768), v);
        else if (c < 1024) {}
        else if (c < 2048) st_bf16x4(XL + (size_t)r * 1024 + (c - 1024), v);
        else st_bf16x4(YG + (size_t)r * 1024 + (c - 2048), v);
    } };
struct FKvUp { bf16_t *K1, *V1;
    __device__ __forceinline__ void operator()(int r, int c, f32x4 v) const {
        const int h = c >> 8, d = c & 255;
        if (d < 128) st_bf16x4(K1 + (size_t)r * 1536 + h * 192 + d, v);
        else st_bf16x4(V1 + (size_t)r * 1024 + h * 128 + (d - 128), v);
    } };

__device__ __forceinline__ unsigned ord_key(float f) { const unsigned b = __float_as_uint(f); return (b & 0x80000000u) ? ~b : (b | 0x80000000u); }
__device__ __forceinline__ void rope_cs(int pos, int i, float& c, float& s) { const float freq = powf(10000.0f, -(float)i / 32.0f); const float ang = (float)pos * freq; sincosf(ang, &s, &c); }
#ifndef PV8_MLA
#define PV8_MLA 1
#endif
#ifndef PV8_DSA
#define PV8_DSA 1
#endif

typedef short bf16x8 __attribute__((ext_vector_type(8)));
typedef float f32x16 __attribute__((ext_vector_type(16)));
__device__ __forceinline__ unsigned cvtpk(float lo, float hi) { unsigned r; asm("v_cvt_pk_bf16_f32 %0, %1, %2" : "=v"(r) : "v"(lo), "v"(hi)); return r; }
__device__ __forceinline__ float max3_asm(float a, float b, float c) { float r; asm("v_max3_f32 %0, %1, %2, %3" : "=v"(r) : "v"(a), "v"(b), "v"(c)); return r; }

struct AttnArgs { const bf16_t* Q; const bf16_t* K; const bf16_t* VT; const unsigned long long* MT; bf16_t* O; int ldq, ldk, ldo; float sc_log2e; };

template <int DQK, bool MASKED>
__device__ __forceinline__ void attn_item(LAS unsigned char* lds, const AttnArgs& a, int b, int h, int qb) {
    constexpr int NKS = DQK / 16, PK = DQK * 2, PV = 128, KB_BYTES = 64 * PK, VB_BYTES = 128 * PV, NPK = DQK / 8, NKP = (64 * NPK) / 512, V_OFF = 3 * KB_BYTES;
    const int tid = opaque_tid(), lane = tid & 63, w = __builtin_amdgcn_readfirstlane(tid >> 6), n = lane & 31, hf = lane >> 5;
    const int nt = 4 * qb + 4, cw = 4 * qb + (w >> 1);
    const int trow = qb * 256 + w * 32 + n;
    const size_t grow = (size_t)b * SEQ + trow;
    bf16x8 qf[NKS];
    { const bf16_t* qp = a.Q + grow * a.ldq + h * DQK + hf * 8;
#pragma unroll
      for (int ks = 0; ks < NKS; ++ks) qf[ks] = *(const bf16x8*)(qp + ks * 16); }
    f32x16 o[4];
#pragma unroll
    for (int dt = 0; dt < 4; ++dt)
#pragma unroll
        for (int r = 0; r < 16; ++r) o[dt][r] = 0.f;
    float m_run = -INFINITY, l_run = 0.f;
    const float c = a.sc_log2e;
    const bf16_t* Kg = a.K + (size_t)b * SEQ * a.ldk + h * DQK;
    const bf16_t* Vg = a.VT + (size_t)(b * 8 + h) * 128 * SEQ;
    const unsigned long long* Mg = MASKED ? a.MT + (size_t)b * 256 * SEQ + trow : nullptr;
    auto dma_k = [&](int kt) {
        LAS unsigned char* kb = lds + (kt % 3) * KB_BYTES;
#pragma unroll
        for (int i = 0; i < NKP; ++i) { const int s = (w + 8 * i) * 64 + lane, r = s / NPK, cp = s % NPK, cc = cp ^ (NPK == 16 ? (r & 15) : ((r >> 1) & 7));
            __builtin_amdgcn_global_load_lds((const unsigned*)(Kg + (size_t)(kt * 64 + r) * a.ldk + cc * 8), (LAS unsigned*)(kb + (w + 8 * i) * 1024), 16, 0, 0); }
    };
    auto dma_v = [&](int kt) {
        LAS unsigned char* vb = lds + V_OFF + (kt & 1) * VB_BYTES;
#pragma unroll
        for (int i = 0; i < 2; ++i) { const int s = (w + 8 * i) * 64 + lane, d = s >> 3, cp = s & 7, cc = cp ^ ((d >> 1) & 7);
            __builtin_amdgcn_global_load_lds((const unsigned*)(Vg + (size_t)d * SEQ + kt * 64 + cc * 8), (LAS unsigned*)(vb + (w + 8 * i) * 1024), 16, 0, 0); }
    };
    const int kswz = (NPK == 16) ? (n & 15) : ((n >> 1) & 7), vswz = (n >> 1) & 7;
    auto qk = [&](int kt, f32x16& s0, f32x16& s1) {
        const LAS unsigned char* ka = lds + (kt % 3) * KB_BYTES + n * PK;
#pragma unroll
        for (int r = 0; r < 16; ++r) { s0[r] = 0.f; s1[r] = 0.f; }
#pragma unroll
        for (int ks = 0; ks < NKS; ++ks) {
            const int po = ((2 * ks + hf) ^ kswz) * 16;
            const bf16x8 a0 = *(const LAS bf16x8*)(ka + po), a1 = *(const LAS bf16x8*)(ka + 32 * PK + po);
            s0 = __builtin_amdgcn_mfma_f32_32x32x16_bf16(a0, qf[ks], s0, 0, 0, 0);
            s1 = __builtin_amdgcn_mfma_f32_32x32x16_bf16(a1, qf[ks], s1, 0, 0, 0);
        }
    };
    auto rowmax = [&](int kt, f32x16& s0, f32x16& s1) -> float {
        if (MASKED) {
            const unsigned long long mw = Mg[(size_t)kt * SEQ]; const unsigned mlo = (unsigned)mw >> (hf * 4), mhi = (unsigned)(mw >> 32) >> (hf * 4);
#pragma unroll
            for (int r = 0; r < 16; ++r) { const unsigned bit = 1u << ((r >> 2) * 8 + (r & 3));
                s0[r] = (mlo & bit) ? s0[r] : -INFINITY; s1[r] = (mhi & bit) ? s1[r] : -INFINITY; }
        }
        float mx = max3_asm(s0[0], s1[0], s0[1]);
        mx = max3_asm(mx, s1[1], s0[2]);
#pragma unroll
        for (int r = 2; r < 15; ++r) mx = max3_asm(mx, s1[r], s0[r + 1]);
        mx = max3_asm(mx, s1[15], mx);
        const auto rr = __builtin_amdgcn_permlane32_swap(__float_as_uint(mx), __float_as_uint(mx), false, false);
        return fmaxf(__uint_as_float(rr[0]), __uint_as_float(rr[1]));
    };
    dma_k(0); dma_v(0); if (nt > 1) dma_k(1);
    asm volatile("s_waitcnt vmcnt(0)" ::: "memory");
    __syncthreads();
    f32x16 sc0, sc1, sn0, sn1;
    qk(0, sc0, sc1);
    float mx_cur = rowmax(0, sc0, sc1), mx_next = -INFINITY;
#pragma unroll
    for (int r = 0; r < 16; ++r) { sn0[r] = 0.f; sn1[r] = 0.f; }
    for (int kt = 0; kt < nt; ++kt) {
        if (kt + 2 < nt) dma_k(kt + 2);
        if (kt + 1 < nt) dma_v(kt + 1);
        const bool act = kt <= cw, actn = kt + 1 <= cw;
        float m_use = 0.f;
        if (act) {
            const float m_new = fmaxf(m_run, mx_cur);
            m_use = (MASKED && m_new == -INFINITY) ? 0.f : m_new;
            if (__any(m_new > m_run)) {
                const float al = __builtin_amdgcn_exp2f((m_run - m_use) * c);
                l_run *= al;
#pragma unroll
                for (int dt = 0; dt < 4; ++dt)
#pragma unroll
                    for (int r = 0; r < 16; ++r) o[dt][r] *= al;
            }
            m_run = m_new;
        }
        if (actn) qk(kt + 1, sn0, sn1);
        bf16x8 pf[4];
        if (act) {
            const float mc = m_use * c;
            float ps = 0.f;
#pragma unroll
            for (int r = 0; r < 16; ++r) { sc0[r] = __builtin_amdgcn_exp2f(fmaf(sc0[r], c, -mc)); sc1[r] = __builtin_amdgcn_exp2f(fmaf(sc1[r], c, -mc)); ps += sc0[r] + sc1[r]; }
            l_run += ps;
            u32x4 t;
            t.x = cvtpk(sc0[0], sc0[1]); t.y = cvtpk(sc0[2], sc0[3]); t.z = cvtpk(sc0[4], sc0[5]); t.w = cvtpk(sc0[6], sc0[7]); pf[0] = *(bf16x8*)&t;
            t.x = cvtpk(sc0[8], sc0[9]); t.y = cvtpk(sc0[10], sc0[11]); t.z = cvtpk(sc0[12], sc0[13]); t.w = cvtpk(sc0[14], sc0[15]); pf[1] = *(bf16x8*)&t;
            t.x = cvtpk(sc1[0], sc1[1]); t.y = cvtpk(sc1[2], sc1[3]); t.z = cvtpk(sc1[4], sc1[5]); t.w = cvtpk(sc1[6], sc1[7]); pf[2] = *(bf16x8*)&t;
            t.x = cvtpk(sc1[8], sc1[9]); t.y = cvtpk(sc1[10], sc1[11]); t.z = cvtpk(sc1[12], sc1[13]); t.w = cvtpk(sc1[14], sc1[15]); pf[3] = *(bf16x8*)&t;
            const LAS unsigned char* va = lds + V_OFF + (kt & 1) * VB_BYTES + n * PV;
#pragma unroll
            for (int g = 0; g < 4; ++g) { const int po = ((2 * g + hf) ^ vswz) * 16;
#pragma unroll
                for (int dt = 0; dt < 4; ++dt) { const bf16x8 vf = *(const LAS bf16x8*)(va + dt * 32 * PV + po); o[dt] = __builtin_amdgcn_mfma_f32_32x32x16_bf16(vf, pf[g], o[dt], 0, 0, 0); } }
        }
        if (actn) mx_next = rowmax(kt + 1, sn0, sn1);
        sc0 = sn0; sc1 = sn1; mx_cur = mx_next;
        asm volatile("s_waitcnt vmcnt(0)" ::: "memory");
        __syncthreads();
    }
    const float lt = l_run + __shfl_xor(l_run, 32);
    const float inv = 1.0f / lt;
    bf16_t* op = a.O + grow * a.ldo + h * 128 + hf * 4;
#pragma unroll
    for (int dt = 0; dt < 4; ++dt)
#pragma unroll
        for (int r4 = 0; r4 < 4; ++r4) { u32x2 wv; wv.x = cvtpk(o[dt][4 * r4] * inv, o[dt][4 * r4 + 1] * inv); wv.y = cvtpk(o[dt][4 * r4 + 2] * inv, o[dt][4 * r4 + 3] * inv);
            *(u32x2*)(op + dt * 32 + r4 * 8) = wv; }
}
static constexpr int ATT_MTBL = 65536;
struct TTrue { static constexpr bool value = true; }; struct TFalse { static constexpr bool value = false; };
typedef int i32x8q __attribute__((ext_vector_type(8)));
typedef int i32x4q __attribute__((ext_vector_type(4)));
#define MFMA8_FENCE2(acc0, acc1, srcA, srcB) asm volatile("s_nop 15\n\ts_nop 9" : "+v"(acc0), "+v"(acc1) : "v"(srcA), "v"(srcB))
#define MFMA8_FENCE4(a0_, a1_, a2_, a3_, srcA, srcB) asm volatile("s_nop 15\n\ts_nop 9" : "+v"(a0_), "+v"(a1_), "+v"(a2_), "+v"(a3_) : "v"(srcA), "v"(srcB))
template <int DQK, bool MASKED, bool QK8>
__device__ __forceinline__ void attn_item3(LAS unsigned char* lds, const AttnArgs& a, int b, int h, int qb) {
    constexpr int NKS = QK8 ? DQK / 64 : DQK / 16, PK = QK8 ? DQK : DQK * 2, PV = 64, KB_BYTES = 64 * PK, VB_BYTES = 128 * PV, NPK = PK / 16, NKP = (64 * NPK + 511) / 512, V_OFF = 3 * KB_BYTES;
    const int tid = opaque_tid(), lane = tid & 63, w = __builtin_amdgcn_readfirstlane(tid >> 6), n = lane & 31, hf = lane >> 5;
    const int nt = 4 * qb + 4, cw = 4 * qb + (w >> 1);
    const int trow = qb * 256 + w * 32 + n;
    const size_t grow = (size_t)b * SEQ + trow;
    bf16x8 qf[QK8 ? 1 : NKS]; i32x8q q8[QK8 ? NKS : 1];
    if (QK8) { const unsigned char* qp = (const unsigned char*)a.Q + grow * a.ldq + h * DQK + hf * 32;
#pragma unroll
      for (int ks = 0; ks < NKS; ++ks) { q8[ks].lo = *(const i32x4q*)(qp + ks * 64); q8[ks].hi = *(const i32x4q*)(qp + ks * 64 + 16); } }
    else { const bf16_t* qp = a.Q + grow * a.ldq + h * DQK + hf * 8;
#pragma unroll
      for (int ks = 0; ks < NKS; ++ks) qf[ks] = *(const bf16x8*)(qp + ks * 16); }
    f32x16 o[4];
#pragma unroll
    for (int dt = 0; dt < 4; ++dt)
#pragma unroll
        for (int r = 0; r < 16; ++r) o[dt][r] = 0.f;
    float m_run = MASKED ? -1000.0f : -INFINITY, l_run = 0.f;
    const float c = a.sc_log2e;
    const unsigned char* Kg = (const unsigned char*)a.K + ((size_t)b * SEQ * a.ldk + h * DQK) * (QK8 ? 1 : 2);
    const unsigned char* Vg = (const unsigned char*)a.VT + (size_t)(b * 8 + h) * 128 * SEQ;
    const unsigned long long* Mg = MASKED ? a.MT + (size_t)b * 256 * SEQ + trow : nullptr;
    auto dma_k = [&](int kt) {
        LAS unsigned char* kb = lds + (kt % 3) * KB_BYTES;
#pragma unroll
        for (int i = 0; i < NKP; ++i) { if ((w + 8 * i) * 64 >= 64 * NPK) break;
            const int s = (w + 8 * i) * 64 + lane, r = s / NPK, cp = s % NPK, cc = cp ^ (NPK == 16 ? (r & 15) : (NPK == 12 ? ((r >> 2) & 3) : ((r >> 1) & 7)));
            __builtin_amdgcn_global_load_lds((const unsigned*)(Kg + ((size_t)(kt * 64 + r) * a.ldk) * (QK8 ? 1 : 2) + cc * 16), (LAS unsigned*)(kb + (w + 8 * i) * 1024), 16, 0, 0); }
    };
    auto dma_v = [&](int kt) {
        LAS unsigned char* vb = lds + V_OFF + (kt & 1) * VB_BYTES;
        const int s = w * 64 + lane, d = s >> 2, cp = s & 3, cc = cp ^ ((d >> 2) & 3);
        __builtin_amdgcn_global_load_lds((const unsigned*)(Vg + (size_t)d * SEQ + kt * 64 + cc * 16), (LAS unsigned*)(vb + w * 1024), 16, 0, 0);
    };
    const int kswz = (NPK == 16) ? (n & 15) : (NPK == 12 ? ((n >> 2) & 3) : ((n >> 1) & 7)), vswz = (n >> 2) & 3;
    auto qk = [&](int kt, f32x16& s0, f32x16& s1, bool fence) {
        const LAS unsigned char* ka = lds + (kt % 3) * KB_BYTES + n * PK;
#pragma unroll
        for (int r = 0; r < 16; ++r) { s0[r] = 0.f; s1[r] = 0.f; }
        if (QK8) {
#pragma unroll
            for (int ks = 0; ks < NKS; ++ks) {
                const int p0 = ((4 * ks + 2 * hf) ^ kswz) * 16, p1 = ((4 * ks + 2 * hf + 1) ^ kswz) * 16;
                i32x8q a0, a1;
                a0.lo = *(const LAS i32x4q*)(ka + p0); a0.hi = *(const LAS i32x4q*)(ka + p1);
                a1.lo = *(const LAS i32x4q*)(ka + 32 * PK + p0); a1.hi = *(const LAS i32x4q*)(ka + 32 * PK + p1);
                s0 = __builtin_amdgcn_mfma_scale_f32_32x32x64_f8f6f4(a0, q8[ks], s0, 0, 0, 0, 0x7F7F7F7F, 0, 0x7F7F7F7F);
                s1 = __builtin_amdgcn_mfma_scale_f32_32x32x64_f8f6f4(a1, q8[ks], s1, 0, 0, 0, 0x7F7F7F7F, 0, 0x7F7F7F7F);
                if (ks == NKS - 1 && fence) MFMA8_FENCE2(s0, s1, a0, a1);
            }
        } else {
#pragma unroll
            for (int ks = 0; ks < NKS; ++ks) {
                const int po = ((2 * ks + hf) ^ kswz) * 16;
                const bf16x8 a0 = *(const LAS bf16x8*)(ka + po), a1 = *(const LAS bf16x8*)(ka + 32 * PK + po);
                s0 = __builtin_amdgcn_mfma_f32_32x32x16_bf16(a0, qf[ks], s0, 0, 0, 0);
                s1 = __builtin_amdgcn_mfma_f32_32x32x16_bf16(a1, qf[ks], s1, 0, 0, 0);
            }
        }
    };
    i32x8q idA0, idA1;
#pragma unroll
    for (int i = 0; i < 8; ++i) { const int v = (i == (n >> 2)) ? (0x38 << (8 * (n & 3))) : 0; idA0[i] = hf ? 0 : v; idA1[i] = hf ? v : 0; }
    auto maskmma = [&](unsigned long long mw, f32x16& s0, f32x16& s1, bool fence) {
        if (MASKED) {
            const unsigned bits = hf ? (unsigned)(mw >> 32) : (unsigned)mw;
            const LAS u32x2* tbl = (const LAS u32x2*)(lds + ATT_MTBL);
            i32x8q bm;
#pragma unroll
            for (int i = 0; i < 4; ++i) { const u32x2 t = tbl[(bits >> (8 * i)) & 255u]; bm[2 * i] = (int)t.x; bm[2 * i + 1] = (int)t.y; }
            s0 = __builtin_amdgcn_mfma_scale_f32_32x32x64_f8f6f4(idA0, bm, s0, 0, 0, 0, 0x7F7F7F7F, 0, (int)0x82828282);
            s1 = __builtin_amdgcn_mfma_scale_f32_32x32x64_f8f6f4(idA1, bm, s1, 0, 0, 0, 0x7F7F7F7F, 0, (int)0x82828282);
            MFMA8_FENCE2(s0, s1, idA1, bm);
        }
    };
    auto rowmax = [&](f32x16& s0, f32x16& s1) -> float {
        float mx = max3_asm(s0[0], s1[0], s0[1]);
        mx = max3_asm(mx, s1[1], s0[2]);
#pragma unroll
        for (int r = 2; r < 15; ++r) mx = max3_asm(mx, s1[r], s0[r + 1]);
        mx = max3_asm(mx, s1[15], mx);
        const auto rr = __builtin_amdgcn_permlane32_swap(__float_as_uint(mx), __float_as_uint(mx), false, false);
        return fmaxf(__uint_as_float(rr[0]), __uint_as_float(rr[1]));
    };
    auto pv = [&](const f32x16& c0, const f32x16& c1, int kt, bool fence) {
        i32x8q pb;
#pragma unroll
        for (int i = 0; i < 4; ++i) { int d0 = 0, d1 = 0;
            d0 = __builtin_amdgcn_cvt_pk_fp8_f32(c0[4 * i], c0[4 * i + 1], d0, false); d0 = __builtin_amdgcn_cvt_pk_fp8_f32(c0[4 * i + 2], c0[4 * i + 3], d0, true);
            d1 = __builtin_amdgcn_cvt_pk_fp8_f32(c1[4 * i], c1[4 * i + 1], d1, false); d1 = __builtin_amdgcn_cvt_pk_fp8_f32(c1[4 * i + 2], c1[4 * i + 3], d1, true);
            pb[i] = d0; pb[4 + i] = d1; }
        const LAS unsigned char* va = lds + V_OFF + (kt & 1) * VB_BYTES + n * PV;
        const int q0_ = ((2 * hf) ^ vswz) * 16, q1_ = ((2 * hf + 1) ^ vswz) * 16;
#pragma unroll
        for (int dt = 0; dt < 4; ++dt) { i32x8q vf; vf.lo = *(const LAS i32x4q*)(va + dt * 32 * PV + q0_); vf.hi = *(const LAS i32x4q*)(va + dt * 32 * PV + q1_);
            o[dt] = __builtin_amdgcn_mfma_scale_f32_32x32x64_f8f6f4(vf, pb, o[dt], 0, 0, 0, 0x7F7F7F7F, 0, 0x79797979);
            if (dt == 3) MFMA8_FENCE4(o[0], o[1], o[2], o[3], vf, pb); }
    };
    dma_k(0); dma_v(0); if (nt > 1) dma_k(1);
    unsigned long long mw_pre = MASKED ? Mg[(size_t)(nt > 1 ? 1 : 0) * SEQ] : 0ull;
    asm volatile("s_waitcnt vmcnt(0)" ::: "memory");
    __syncthreads();
    f32x16 sa0, sa1, sb0, sb1;
    qk(0, sa0, sa1, true); maskmma(MASKED ? Mg[0] : 0ull, sa0, sa1, true);
    float mx_cur = rowmax(sa0, sa1);
    auto step = [&](int kt, f32x16& c0, f32x16& c1, f32x16& n0, f32x16& n1, auto full_tag) {
        constexpr bool FULL = decltype(full_tag)::value;
        if (kt + 2 < nt) dma_k(kt + 2);
        if (kt + 1 < nt) dma_v(kt + 1);
        const unsigned long long mw_now = mw_pre;
        if (MASKED) mw_pre = Mg[(size_t)(kt + 2 < nt ? kt + 2 : kt) * SEQ];
        const bool act = FULL || kt <= cw, actn = FULL || kt + 1 <= cw;
        const float m_new = fmaxf(m_run, mx_cur);
        const float m_use = (MASKED && m_new == -INFINITY) ? 0.f : m_new;
        if (act && __any(m_new > m_run)) {
            const float al = __builtin_amdgcn_exp2f((m_run - m_use) * c);
            l_run *= al;
#pragma unroll
            for (int dt = 0; dt < 4; ++dt)
#pragma unroll
                for (int r = 0; r < 16; ++r) o[dt][r] *= al;
        }
        if (act) m_run = m_new;
        if (FULL) {
            qk(kt + 1, n0, n1, !MASKED); maskmma(mw_now, n0, n1, true);
            const float mc = m_use * c - 6.0f;
            float ps = 0.f;
#pragma unroll
            for (int r = 0; r < 16; ++r) { c0[r] = __builtin_amdgcn_exp2f(fmaf(c0[r], c, -mc)); c1[r] = __builtin_amdgcn_exp2f(fmaf(c1[r], c, -mc)); ps += c0[r] + c1[r]; }
            l_run += ps;
            pv(c0, c1, kt, true);
            mx_cur = rowmax(n0, n1);
        } else {
            if (actn) { qk(kt + 1, n0, n1, true); maskmma(mw_now, n0, n1, true); }
            if (act) {
                const float mc = m_use * c - 6.0f;
                float ps = 0.f;
#pragma unroll
                for (int r = 0; r < 16; ++r) { c0[r] = __builtin_amdgcn_exp2f(fmaf(c0[r], c, -mc)); c1[r] = __builtin_amdgcn_exp2f(fmaf(c1[r], c, -mc)); ps += c0[r] + c1[r]; }
                l_run += ps;
                pv(c0, c1, kt, true);
            }
            if (actn) mx_cur = rowmax(n0, n1);
        }
        asm volatile("s_waitcnt vmcnt(0)" ::: "memory");
        __syncthreads();
    };
    int kt = 0;
    for (; kt < 4 * qb; kt += 2) { step(kt, sa0, sa1, sb0, sb1, TTrue{}); step(kt + 1, sb0, sb1, sa0, sa1, TTrue{}); }
    for (; kt < nt; kt += 2) { step(kt, sa0, sa1, sb0, sb1, TFalse{}); step(kt + 1, sb0, sb1, sa0, sa1, TFalse{}); }
    const float lt = l_run + __shfl_xor(l_run, 32);
    const float inv = 64.0f / lt;
    bf16_t* op = a.O + grow * a.ldo + h * 128 + hf * 4;
#pragma unroll
    for (int dt = 0; dt < 4; ++dt)
#pragma unroll
        for (int r4 = 0; r4 < 4; ++r4) { u32x2 wv; wv.x = cvtpk(o[dt][4 * r4] * inv, o[dt][4 * r4 + 1] * inv); wv.y = cvtpk(o[dt][4 * r4 + 2] * inv, o[dt][4 * r4 + 3] * inv);
            *(u32x2*)(op + dt * 32 + r4 * 8) = wv; }
}
template <int DQK, bool MASKED, bool QK8>
__device__ __forceinline__ void attn_item3b(LAS unsigned char* lds, const AttnArgs& a, int b, int h, int qb) {
    constexpr int NKS = QK8 ? DQK / 64 : DQK / 16, PK = QK8 ? DQK : DQK * 2, PV = 128, KB_BYTES = 64 * PK, VB_BYTES = 128 * PV, NPK = PK / 16, NKP = (64 * NPK + 511) / 512, V_OFF = 3 * KB_BYTES;
    const int tid = opaque_tid(), lane = tid & 63, w = __builtin_amdgcn_readfirstlane(tid >> 6), n = lane & 31, hf = lane >> 5;
    const int nt = 4 * qb + 4, cw = 4 * qb + (w >> 1);
    const int trow = qb * 256 + w * 32 + n;
    const size_t grow = (size_t)b * SEQ + trow;
    bf16x8 qf[QK8 ? 1 : NKS]; i32x8q q8[QK8 ? NKS : 1];
    if (QK8) { const unsigned char* qp = (const unsigned char*)a.Q + grow * a.ldq + h * DQK + hf * 32;
#pragma unroll
      for (int ks = 0; ks < NKS; ++ks) { q8[ks].lo = *(const i32x4q*)(qp + ks * 64); q8[ks].hi = *(const i32x4q*)(qp + ks * 64 + 16); } }
    else { const bf16_t* qp = a.Q + grow * a.ldq + h * DQK + hf * 8;
#pragma unroll
      for (int ks = 0; ks < NKS; ++ks) qf[ks] = *(const bf16x8*)(qp + ks * 16); }
    f32x16 o[4];
#pragma unroll
    for (int dt = 0; dt < 4; ++dt)
#pragma unroll
        for (int r = 0; r < 16; ++r) o[dt][r] = 0.f;
    float m_run = -INFINITY, l_run = 0.f;
    const float c = a.sc_log2e;
    const unsigned char* Kg = (const unsigned char*)a.K + ((size_t)b * SEQ * a.ldk + h * DQK) * (QK8 ? 1 : 2);
    const bf16_t* Vg = a.VT + (size_t)(b * 8 + h) * 128 * SEQ;
    const unsigned long long* Mg = MASKED ? a.MT + (size_t)b * 256 * SEQ + trow : nullptr;
    auto dma_k = [&](int kt) {
        LAS unsigned char* kb = lds + (kt % 3) * KB_BYTES;
#pragma unroll
        for (int i = 0; i < NKP; ++i) { if ((w + 8 * i) * 64 >= 64 * NPK) break;
            const int s = (w + 8 * i) * 64 + lane, r = s / NPK, cp = s % NPK, cc = cp ^ (NPK == 16 ? (r & 15) : (NPK == 12 ? ((r >> 2) & 3) : ((r >> 1) & 7)));
            __builtin_amdgcn_global_load_lds((const unsigned*)(Kg + ((size_t)(kt * 64 + r) * a.ldk) * (QK8 ? 1 : 2) + cc * 16), (LAS unsigned*)(kb + (w + 8 * i) * 1024), 16, 0, 0); }
    };
    auto dma_v = [&](int kt) {
        LAS unsigned char* vb = lds + V_OFF + (kt & 1) * VB_BYTES;
#pragma unroll
        for (int i = 0; i < 2; ++i) { const int s = (w + 8 * i) * 64 + lane, d = s >> 3, cp = s & 7, cc = cp ^ ((d >> 1) & 7);
            __builtin_amdgcn_global_load_lds((const unsigned*)(Vg + (size_t)d * SEQ + kt * 64 + cc * 8), (LAS unsigned*)(vb + (w + 8 * i) * 1024), 16, 0, 0); }
    };
    const int kswz = (NPK == 16) ? (n & 15) : (NPK == 12 ? ((n >> 2) & 3) : ((n >> 1) & 7)), vswz = (n >> 1) & 7;
    auto qk = [&](int kt, f32x16& s0, f32x16& s1) {
        const LAS unsigned char* ka = lds + (kt % 3) * KB_BYTES + n * PK;
#pragma unroll
        for (int r = 0; r < 16; ++r) { s0[r] = 0.f; s1[r] = 0.f; }
        if (QK8) {
#pragma unroll
            for (int ks = 0; ks < NKS; ++ks) {
                const int p0 = ((4 * ks + 2 * hf) ^ kswz) * 16, p1 = ((4 * ks + 2 * hf + 1) ^ kswz) * 16;
                i32x8q a0, a1;
                a0.lo = *(const LAS i32x4q*)(ka + p0); a0.hi = *(const LAS i32x4q*)(ka + p1);
                a1.lo = *(const LAS i32x4q*)(ka + 32 * PK + p0); a1.hi = *(const LAS i32x4q*)(ka + 32 * PK + p1);
                s0 = __builtin_amdgcn_mfma_scale_f32_32x32x64_f8f6f4(a0, q8[ks], s0, 0, 0, 0, 0x7F7F7F7F, 0, 0x7F7F7F7F);
                s1 = __builtin_amdgcn_mfma_scale_f32_32x32x64_f8f6f4(a1, q8[ks], s1, 0, 0, 0, 0x7F7F7F7F, 0, 0x7F7F7F7F);
                if (ks == NKS - 1) MFMA8_FENCE2(s0, s1, a0, a1);
            }
        } else {
#pragma unroll
            for (int ks = 0; ks < NKS; ++ks) {
                const int po = ((2 * ks + hf) ^ kswz) * 16;
                const bf16x8 a0 = *(const LAS bf16x8*)(ka + po), a1 = *(const LAS bf16x8*)(ka + 32 * PK + po);
                s0 = __builtin_amdgcn_mfma_f32_32x32x16_bf16(a0, qf[ks], s0, 0, 0, 0);
                s1 = __builtin_amdgcn_mfma_f32_32x32x16_bf16(a1, qf[ks], s1, 0, 0, 0);
            }
        }
    };
    auto rowmax = [&](unsigned long long mw, bool, f32x16& s0, f32x16& s1) -> float {
        if (MASKED) {
            const unsigned mlo = (unsigned)mw >> (hf * 4), mhi = (unsigned)(mw >> 32) >> (hf * 4);
#pragma unroll
            for (int r = 0; r < 16; ++r) { const unsigned bit = 1u << ((r >> 2) * 8 + (r & 3));
                s0[r] = (mlo & bit) ? s0[r] : -INFINITY; s1[r] = (mhi & bit) ? s1[r] : -INFINITY; }
        }
        float mx = max3_asm(s0[0], s1[0], s0[1]);
        mx = max3_asm(mx, s1[1], s0[2]);
#pragma unroll
        for (int r = 2; r < 15; ++r) mx = max3_asm(mx, s1[r], s0[r + 1]);
        mx = max3_asm(mx, s1[15], mx);
        const auto rr = __builtin_amdgcn_permlane32_swap(__float_as_uint(mx), __float_as_uint(mx), false, false);
        return fmaxf(__uint_as_float(rr[0]), __uint_as_float(rr[1]));
    };
    dma_k(0); dma_v(0); if (nt > 1) dma_k(1);
    unsigned long long mw_pre = MASKED ? Mg[(size_t)(nt > 1 ? 1 : 0) * SEQ] : 0ull;
    asm volatile("s_waitcnt vmcnt(0)" ::: "memory");
    __syncthreads();
    f32x16 sa0, sa1, sb0, sb1;
    qk(0, sa0, sa1);
    float mx_cur = rowmax(MASKED ? Mg[0] : 0ull, false, sa0, sa1);
    auto step = [&](int kt, f32x16& c0, f32x16& c1, f32x16& n0, f32x16& n1, auto full_tag) {
        constexpr bool FULL = decltype(full_tag)::value;
        if (kt + 2 < nt) dma_k(kt + 2);
        if (kt + 1 < nt) dma_v(kt + 1);
        const unsigned long long mw_now = mw_pre;
        if (MASKED) mw_pre = Mg[(size_t)(kt + 2 < nt ? kt + 2 : kt) * SEQ];
        const bool act = FULL || kt <= cw, actn = FULL || kt + 1 <= cw;
        const float m_new = fmaxf(m_run, mx_cur);
        const float m_use = (MASKED && m_new == -INFINITY) ? 0.f : m_new;
        if (act && __any(m_new > m_run)) {
            const float al = __builtin_amdgcn_exp2f((m_run - m_use) * c);
            l_run *= al;
#pragma unroll
            for (int dt = 0; dt < 4; ++dt)
#pragma unroll
                for (int r = 0; r < 16; ++r) o[dt][r] *= al;
        }
        if (act) m_run = m_new;
        if (FULL) {
            qk(kt + 1, n0, n1);
            const float mc = m_use * c;
            float ps = 0.f;
#pragma unroll
            for (int r = 0; r < 16; ++r) { c0[r] = __builtin_amdgcn_exp2f(fmaf(c0[r], c, -mc)); c1[r] = __builtin_amdgcn_exp2f(fmaf(c1[r], c, -mc)); ps += c0[r] + c1[r]; }
            l_run += ps;
            bf16x8 pf[4]; u32x4 t;
            t.x = cvtpk(c0[0], c0[1]); t.y = cvtpk(c0[2], c0[3]); t.z = cvtpk(c0[4], c0[5]); t.w = cvtpk(c0[6], c0[7]); pf[0] = *(bf16x8*)&t;
            t.x = cvtpk(c0[8], c0[9]); t.y = cvtpk(c0[10], c0[11]); t.z = cvtpk(c0[12], c0[13]); t.w = cvtpk(c0[14], c0[15]); pf[1] = *(bf16x8*)&t;
            t.x = cvtpk(c1[0], c1[1]); t.y = cvtpk(c1[2], c1[3]); t.z = cvtpk(c1[4], c1[5]); t.w = cvtpk(c1[6], c1[7]); pf[2] = *(bf16x8*)&t;
            t.x = cvtpk(c1[8], c1[9]); t.y = cvtpk(c1[10], c1[11]); t.z = cvtpk(c1[12], c1[13]); t.w = cvtpk(c1[14], c1[15]); pf[3] = *(bf16x8*)&t;
            const LAS unsigned char* va = lds + V_OFF + (kt & 1) * VB_BYTES + n * PV;
#pragma unroll
            for (int g = 0; g < 4; ++g) { const int po = ((2 * g + hf) ^ vswz) * 16;
#pragma unroll
                for (int dt = 0; dt < 4; ++dt) { const bf16x8 vf = *(const LAS bf16x8*)(va + dt * 32 * PV + po); o[dt] = __builtin_amdgcn_mfma_f32_32x32x16_bf16(vf, pf[g], o[dt], 0, 0, 0); } }
            mx_cur = rowmax(mw_now, false, n0, n1);
        } else {
            if (actn) qk(kt + 1, n0, n1);
            if (act) {
                const float mc = m_use * c;
                float ps = 0.f;
#pragma unroll
                for (int r = 0; r < 16; ++r) { c0[r] = __builtin_amdgcn_exp2f(fmaf(c0[r], c, -mc)); c1[r] = __builtin_amdgcn_exp2f(fmaf(c1[r], c, -mc)); ps += c0[r] + c1[r]; }
                l_run += ps;
                bf16x8 pf[4]; u32x4 t;
                t.x = cvtpk(c0[0], c0[1]); t.y = cvtpk(c0[2], c0[3]); t.z = cvtpk(c0[4], c0[5]); t.w = cvtpk(c0[6], c0[7]); pf[0] = *(bf16x8*)&t;
                t.x = cvtpk(c0[8], c0[9]); t.y = cvtpk(c0[10], c0[11]); t.z = cvtpk(c0[12], c0[13]); t.w = cvtpk(c0[14], c0[15]); pf[1] = *(bf16x8*)&t;
                t.x = cvtpk(c1[0], c1[1]); t.y = cvtpk(c1[2], c1[3]); t.z = cvtpk(c1[4], c1[5]); t.w = cvtpk(c1[6], c1[7]); pf[2] = *(bf16x8*)&t;
                t.x = cvtpk(c1[8], c1[9]); t.y = cvtpk(c1[10], c1[11]); t.z = cvtpk(c1[12], c1[13]); t.w = cvtpk(c1[14], c1[15]); pf[3] = *(bf16x8*)&t;
                const LAS unsigned char* va = lds + V_OFF + (kt & 1) * VB_BYTES + n * PV;
#pragma unroll
                for (int g = 0; g < 4; ++g) { const int po = ((2 * g + hf) ^ vswz) * 16;
#pragma unroll
                    for (int dt = 0; dt < 4; ++dt) { const bf16x8 vf = *(const LAS bf16x8*)(va + dt * 32 * PV + po); o[dt] = __builtin_amdgcn_mfma_f32_32x32x16_bf16(vf, pf[g], o[dt], 0, 0, 0); } }
            }
            if (actn) mx_cur = rowmax(mw_now, false, n0, n1);
        }
        asm volatile("s_waitcnt vmcnt(0)" ::: "memory");
        __syncthreads();
    };
    int kt = 0;
    for (; kt < 4 * qb; kt += 2) { step(kt, sa0, sa1, sb0, sb1, TTrue{}); step(kt + 1, sb0, sb1, sa0, sa1, TTrue{}); }
    for (; kt < nt; kt += 2) { step(kt, sa0, sa1, sb0, sb1, TFalse{}); step(kt + 1, sb0, sb1, sa0, sa1, TFalse{}); }
    const float lt = l_run + __shfl_xor(l_run, 32);
    const float inv = 1.0f / lt;
    bf16_t* op = a.O + grow * a.ldo + h * 128 + hf * 4;
#pragma unroll
    for (int dt = 0; dt < 4; ++dt)
#pragma unroll
        for (int r4 = 0; r4 < 4; ++r4) { u32x2 wv; wv.x = cvtpk(o[dt][4 * r4] * inv, o[dt][4 * r4 + 1] * inv); wv.y = cvtpk(o[dt][4 * r4 + 2] * inv, o[dt][4 * r4 + 3] * inv);
            *(u32x2*)(op + dt * 32 + r4 * 8) = wv; }
}
template <int DQK, bool MASKED>
__device__ __forceinline__ void attn_phase(LAS unsigned char* lds, const AttnArgs& a, int bid, int nblk) {
    if (MASKED) {
        const int t = opaque_tid();
        if (t < 256) { unsigned lo = 0u, hi = 0u;
#pragma unroll
            for (int i = 0; i < 4; ++i) { if (!((t >> i) & 1)) lo |= 0xFEu << (8 * i); if (!((t >> (4 + i)) & 1)) hi |= 0xFEu << (8 * i); }
            u32x2 v; v.x = lo; v.y = hi; ((LAS u32x2*)(lds + ATT_MTBL))[t] = v; }
        __syncthreads();
    }
    for (int p = bid; p < 512; p += nblk) {
        const int bh = (p & 7) + 8 * (p >> 8), j = (p >> 3) & 31;
#pragma unroll 1
        for (int i = 0; i < 2; ++i) { if ((DQK == 192) ? (PV8_MLA != 0) : (PV8_DSA != 0)) attn_item3<DQK, MASKED, true>(lds, a, bh >> 3, bh & 7, i ? j : 63 - j); else attn_item3b<DQK, MASKED, true>(lds, a, bh >> 3, bh & 7, i ? j : 63 - j); }
    }
}

#ifdef IDX_PROBE_FINAL
#define IDX_PF_ 1
#else
#define IDX_PF_ 0
#endif
typedef _Float16 f16x8 __attribute__((ext_vector_type(8)));
struct IdxArgs { const float* QI; const unsigned short* KI16; const float* WI; unsigned long long* MT; };
static constexpr int IDX_CAP = 640, IDX_CS = 0, IDX_CI = 32 * IDX_CAP * 4, IDX_KT = IDX_CI + 32 * IDX_CAP * 2, IDX_CNT = IDX_KT + 32768, IDX_TAU = IDX_CNT + 128, IDX_LDS = IDX_TAU + 128;
static_assert(IDX_KT % 1024 == 0, "K tile buffers must be 1 KiB aligned");

__device__ __forceinline__ float ord_inv(unsigned T) { return __uint_as_float((T & 0x80000000u) ? (T & 0x7FFFFFFFu) : ~T); }
__device__ __forceinline__ unsigned lane_prefix(unsigned long long m) { return __builtin_amdgcn_mbcnt_hi((unsigned)(m >> 32), __builtin_amdgcn_mbcnt_lo((unsigned)m, 0u)); }
__device__ __forceinline__ float relu_asm(float x) { float y; asm("v_max_f32 %0, 0, %1" : "=v"(y) : "v"(x)); return y; }
__device__ __forceinline__ void glds16(const void* gsrc, unsigned lds_dst) {
    unsigned keep;
    asm volatile("s_mov_b32 %0, m0\n\ts_mov_b32 m0, %2\n\ts_nop 0\n\tglobal_load_lds_dwordx4 %1, off\n\ts_mov_b32 m0, %0" : "=&s"(keep) : "v"(gsrc), "s"(lds_dst) : "memory");
}

template <bool EXACT> __device__ __forceinline__ int idx_compact(LAS unsigned char* lds, int qq, int lane, int n, float& tau) {
    LAS float* cs = (LAS float*)(lds + IDX_CS) + qq * IDX_CAP; LAS unsigned short* ci = (LAS unsigned short*)(lds + IDX_CI) + qq * IDX_CAP;
    float sv[10]; unsigned short iv[10]; unsigned uk[10];
#pragma unroll
    for (int j = 0; j < 10; ++j) { const int idx = lane + 64 * j; const bool valid = idx < n; sv[j] = cs[idx]; iv[j] = ci[idx]; uk[j] = valid ? ord_key(sv[j]) : 0u; }
    auto count_ge = [&](unsigned t) { int c = 0;
#pragma unroll
        for (int j = 0; j < 10; ++j) c += __builtin_popcountll(__ballot(uk[j] >= t));
        return c; };
    unsigned lo = ord_key(tau), hi = 0xFF800001u;
    if (lo > 0x80800000u) { const unsigned h2 = lo + 0x00800000u;
        if (h2 < hi) { if (count_ge(h2) >= 256) lo = h2; else hi = h2; } }
    while (hi - lo > 1u) {
        const unsigned mid = lo + ((hi - lo) >> 1); const int c = count_ge(mid);
        if (c >= 256) { lo = mid; if (!EXACT && c <= 336) break; } else hi = mid;
    }
    const unsigned T = lo;
    int need = 0;
    if (EXACT) { int ngt = 0;
#pragma unroll
        for (int j = 0; j < 10; ++j) ngt += __builtin_popcountll(__ballot(uk[j] > T));
        need = 256 - ngt; }
    int base = 0, tiebase = 0;
#pragma unroll
    for (int j = 0; j < 10; ++j) {
        bool keep;
        if (EXACT) { const bool gt = uk[j] > T, eq = uk[j] == T; const unsigned long long em = __ballot(eq); keep = gt || (eq && (tiebase + (int)lane_prefix(em)) < need); tiebase += __builtin_popcountll(em); }
        else keep = uk[j] >= T;
        const unsigned long long km = __ballot(keep);
        const int pos = base + (int)lane_prefix(km);
        if (keep) { cs[pos] = sv[j]; ci[pos] = iv[j]; }
        base += __builtin_popcountll(km);
    }
    tau = ord_inv(T);
    return base;
}

__device__ __forceinline__ void idx_item(LAS unsigned char* lds, const IdxArgs& a, int b, int hc) {
    const int tid = opaque_tid(), lane = tid & 63, w = __builtin_amdgcn_readfirstlane(tid >> 6), n = lane & 31, hf = lane >> 5;
    const int t0 = hc * 32, L = (t0 / 64 + 1) * 64, nsub = L / 32, ntile = (L + 127) / 128;
    const size_t q0 = (size_t)b * SEQ + t0 + 4 * w;
    LAS float* cs = (LAS float*)(lds + IDX_CS); LAS unsigned short* ci = (LAS unsigned short*)(lds + IDX_CI);
    LAS unsigned* cnt = (LAS unsigned*)(lds + IDX_CNT);
    f16x8 qf[2][4];
#pragma unroll
    for (int rt = 0; rt < 2; ++rt) { const float* qp = a.QI + (q0 + 2 * rt + (n >> 4)) * 1024 + (n & 15) * 64 + hf * 8;
#pragma unroll
        for (int ks = 0; ks < 4; ++ks) { const f32x4 x0 = *(const f32x4*)(qp + ks * 16), x1 = *(const f32x4*)(qp + ks * 16 + 4);
            f16x8 v; v[0] = (_Float16)x0[0]; v[1] = (_Float16)x0[1]; v[2] = (_Float16)x0[2]; v[3] = (_Float16)x0[3]; v[4] = (_Float16)x1[0]; v[5] = (_Float16)x1[1]; v[6] = (_Float16)x1[2]; v[7] = (_Float16)x1[3];
            qf[rt][ks] = v; } }
    float wv[2][16];
#pragma unroll
    for (int rt = 0; rt < 2; ++rt)
#pragma unroll
        for (int r = 0; r < 16; ++r) wv[rt][r] = a.WI[(q0 + 2 * rt + (r >> 3)) * 16 + (((r & 3) + 8 * (r >> 2) + 4 * hf) & 15)] * (0.125f * 0.25f);
    if (tid < 32) cnt[tid] = 0u;
    int cq0 = 0, cq1 = 0, cq2 = 0, cq3 = 0;
    float tq0 = -INFINITY, tq1 = -INFINITY, tq2 = -INFINITY, tq3 = -INFINITY;
    float tau0 = INFINITY, tau1 = INFINITY;
    const unsigned short* Kg = a.KI16 + (size_t)b * SEQ * 64;
    const unsigned ldsbase = (unsigned)(size_t)lds;
    auto dma = [&](int kt, int buf) {
#pragma unroll
        for (int i = 0; i < 2; ++i) { const int s = (w + 8 * i) * 64 + lane, r = s >> 3, cp = s & 7, cc = cp ^ ((r >> 1) & 7);
            glds16(Kg + (size_t)(kt * 128 + r) * 64 + cc * 8, ldsbase + IDX_KT + buf * 16384 + (w + 8 * i) * 1024); }
    };
    dma(0, 0);
    asm volatile("s_waitcnt vmcnt(0)" ::: "memory");
    __syncthreads();
    const int kswz = (n >> 1) & 7;
    f32x16 accA[2], accB[2];
#pragma unroll
    for (int rt = 0; rt < 2; ++rt)
#pragma unroll
        for (int r = 0; r < 16; ++r) { accA[rt][r] = 0.f; accB[rt][r] = 0.f; }
    int keyA = 0, keyB = 0;
    auto epilogue = [&](const f32x16 (&acc)[2], int key) {
        float sc[2];
#pragma unroll
        for (int rt = 0; rt < 2; ++rt) { float pa = 0.f, pb = 0.f;
#pragma unroll
            for (int r = 0; r < 8; ++r) { pa = fmaf(relu_asm(acc[rt][r]), wv[rt][r], pa); pb = fmaf(relu_asm(acc[rt][r + 8]), wv[rt][r + 8], pb); }
            const auto rr = __builtin_amdgcn_permlane32_swap(__float_as_uint(pa), __float_as_uint(pb), false, false);
            sc[rt] = __uint_as_float(rr[0]) + __uint_as_float(rr[1]); }
        const bool c0 = sc[0] > tau0, c1 = sc[1] > tau1;
        const unsigned long long m0 = __ballot(c0), m1 = __ballot(c1);
        if (m0 | m1) {
            const unsigned l0 = (unsigned)m0, h0 = (unsigned)(m0 >> 32), l1 = (unsigned)m1, h1 = (unsigned)(m1 >> 32);
            const int p0 = hf ? cq1 + (int)__builtin_amdgcn_mbcnt_hi(h0, 0u) : cq0 + (int)__builtin_amdgcn_mbcnt_lo(l0, 0u);
            const int p1 = hf ? cq3 + (int)__builtin_amdgcn_mbcnt_hi(h1, 0u) : cq2 + (int)__builtin_amdgcn_mbcnt_lo(l1, 0u);
            if (c0 && p0 < IDX_CAP) { const int qq = 4 * w + hf; cs[qq * IDX_CAP + p0] = sc[0]; ci[qq * IDX_CAP + p0] = (unsigned short)key; }
            if (c1 && p1 < IDX_CAP) { const int qq = 4 * w + 2 + hf; cs[qq * IDX_CAP + p1] = sc[1]; ci[qq * IDX_CAP + p1] = (unsigned short)key; }
            cq0 += __builtin_popcount(l0); cq1 += __builtin_popcount(h0); cq2 += __builtin_popcount(l1); cq3 += __builtin_popcount(h1);
        }
    };
    auto mma = [&](f32x16 (&acc)[2], const LAS unsigned char* kr) {
        f16x8 kf[4];
#pragma unroll
        for (int ks = 0; ks < 4; ++ks) kf[ks] = *(const LAS f16x8*)(kr + ((2 * ks + hf) ^ kswz) * 16);
#pragma unroll
        for (int rt = 0; rt < 2; ++rt) {
            f32x16 c;
#pragma unroll
            for (int r = 0; r < 16; ++r) c[r] = 0.f;
#pragma unroll
            for (int ks = 0; ks < 4; ++ks) c = __builtin_amdgcn_mfma_f32_32x32x16_f16(qf[rt][ks], kf[ks], c, 0, 0, 0);
            acc[rt] = c; }
    };
#ifdef IDX_PROBE2
  for (int rep_ = 0; rep_ < 2; ++rep_) {
    if (rep_ == 1) { epilogue(accB, keyB); tau0 = INFINITY; tau1 = INFINITY; __syncthreads(); dma(0, 0); asm volatile("s_waitcnt vmcnt(0)" ::: "memory"); __syncthreads(); }
#endif
    for (int kt = 0; kt < ntile; ++kt) {
        if (kt + 1 < ntile) dma(kt + 1, (kt + 1) & 1);
#ifdef IDX_PROBE2
        if (rep_ == 0)
#endif
        { const unsigned c_all = cnt[lane & 31];
          if (__ballot(c_all > (unsigned)(IDX_CAP - 160))) {
              if (cq0 > 400) cq0 = idx_compact<false>(lds, 4 * w + 0, lane, cq0, tq0);
              if (cq1 > 400) cq1 = idx_compact<false>(lds, 4 * w + 1, lane, cq1, tq1);
              if (cq2 > 400) cq2 = idx_compact<false>(lds, 4 * w + 2, lane, cq2, tq2);
              if (cq3 > 400) cq3 = idx_compact<false>(lds, 4 * w + 3, lane, cq3, tq3);
              if (kt > 0) { tau0 = hf ? tq1 : tq0; tau1 = hf ? tq3 : tq2; }
          } }
        const LAS unsigned char* kb = lds + IDX_KT + (kt & 1) * 16384 + n * 128;
        const int sbase = kt * 4;
#ifdef IDX_PROBE2
        if (sbase + 0 < nsub) { mma(accA, kb); epilogue(accB, keyB); keyA = kt * 128 + n; if (kt == 0 && rep_ == 0) { tau0 = -INFINITY; tau1 = -INFINITY; } }
#else
        if (sbase + 0 < nsub) { mma(accA, kb); epilogue(accB, keyB); keyA = kt * 128 + n; if (kt == 0) { tau0 = -INFINITY; tau1 = -INFINITY; } }
#endif
        if (sbase + 1 < nsub) { mma(accB, kb + 32 * 128); epilogue(accA, keyA); keyB = kt * 128 + 32 + n; }
        if (sbase + 2 < nsub) { mma(accA, kb + 64 * 128); epilogue(accB, keyB); keyA = kt * 128 + 64 + n; }
        if (sbase + 3 < nsub) { mma(accB, kb + 96 * 128); epilogue(accA, keyA); keyB = kt * 128 + 96 + n; }
        if (lane < 4) cnt[4 * w + lane] = (unsigned)(lane == 0 ? cq0 : (lane == 1 ? cq1 : (lane == 2 ? cq2 : cq3)));
        asm volatile("s_waitcnt vmcnt(0)" ::: "memory");
        __syncthreads();
    }
#ifdef IDX_PROBE2
  }
#endif
    epilogue(accB, keyB);
    __syncthreads();
    LAS unsigned* bm = (LAS unsigned*)(lds + IDX_KT) + w * 512;
#ifdef IDX_PROBE_FINAL
  for (int rep2_ = 0; rep2_ < 2; ++rep2_) {
#endif
    if (cq0 > 256 - IDX_PF_) cq0 = idx_compact<true>(lds, 4 * w + 0, lane, cq0, tq0);
    if (cq1 > 256 - IDX_PF_) cq1 = idx_compact<true>(lds, 4 * w + 1, lane, cq1, tq1);
    if (cq2 > 256 - IDX_PF_) cq2 = idx_compact<true>(lds, 4 * w + 2, lane, cq2, tq2);
    if (cq3 > 256 - IDX_PF_) cq3 = idx_compact<true>(lds, 4 * w + 3, lane, cq3, tq3);
#pragma unroll 1
    for (int i = 0; i < 4; ++i) {
        const int qq = 4 * w + i;
        const int nsel = (i == 0) ? cq0 : ((i == 1) ? cq1 : ((i == 2) ? cq2 : cq3));
#pragma unroll
        for (int j = 0; j < 8; ++j) bm[lane + 64 * j] = 0u;
#pragma unroll
        for (int j = 0; j < 4; ++j) { const int idx = lane + 64 * j; if (idx < nsel) { const unsigned k = ci[qq * IDX_CAP + idx]; (void)__hip_atomic_fetch_or(bm + (k >> 5), 1u << (k & 31), __ATOMIC_RELAXED, __HIP_MEMORY_SCOPE_WORKGROUP); } }
        const int tq = t0 + qq;
#pragma unroll 1
        for (int kt = lane; kt < L / 64; kt += 64) { const unsigned long long v = (unsigned long long)bm[2 * kt] | ((unsigned long long)bm[2 * kt + 1] << 32); a.MT[((size_t)b * 256 + kt) * SEQ + tq] = v; }
    }
#ifdef IDX_PROBE_FINAL
  }
#endif
    __syncthreads();
}
__device__ __forceinline__ void idx_phase(LAS unsigned char* lds, const IdxArgs& a, int bid, int nblk) {
    for (int k = bid; k < 256; k += nblk) {
#pragma unroll 1
        for (int i = 0; i < 4; ++i) idx_item(lds, a, i & 1, (i < 2) ? 511 - k : k);
    }
}
#define XB_TMO      128
#define XB_XCNT(j)  (256  + 64 * (j))
#define XB_XSUB(j)  (1280 + 64 * (j))
#define XB_XGEN(j)  (2304 + 64 * (j))
#define XB_TOP      3328
#define XB_TOPGEN   3392
#define XCD_BAR_WORDS 3456
#define XB_SPIN_CAP (1u << 23)


__device__ __forceinline__ unsigned xb_ld(unsigned* p)              { return __hip_atomic_load(p, __ATOMIC_RELAXED, __HIP_MEMORY_SCOPE_AGENT); }
__device__ __forceinline__ unsigned xb_add(unsigned* p, unsigned v) { return __hip_atomic_fetch_add(p, v, __ATOMIC_RELAXED, __HIP_MEMORY_SCOPE_AGENT); }
__device__ __forceinline__ unsigned xb_xcc_id() { return (unsigned)__builtin_amdgcn_s_getreg((3 << 11) | 20) & 0xFu; }
#define XB_SPIN(cond, bar) do { unsigned _sp = 0; while (cond) { __builtin_amdgcn_s_sleep(1); \
    if ((++_sp & 255u) == 0u) { if (xb_ld(&(bar)[XB_TMO])) break; if (_sp > XB_SPIN_CAP) { atomicAdd(&(bar)[XB_TMO], 1u); break; } } } } while (0)

struct XcdBarrier {
    unsigned* bar; unsigned x;
    volatile LAS unsigned* st;
};

__device__ __forceinline__ XcdBarrier xcd_barrier_post(unsigned* bar, volatile LAS unsigned* st) {
    XcdBarrier b; b.bar = bar; b.x = xb_xcc_id(); b.st = st;
    if (threadIdx.x == 0) (void)xb_add(&bar[XB_XCNT(b.x)], 1u);
    return b;
}
__device__ __forceinline__ void xcd_barrier_complete(unsigned* bar, unsigned x, unsigned& nloc, unsigned& nx) {
    const unsigned G = gridDim.x * gridDim.y * gridDim.z;
    unsigned sum, cnt, mine, sp = 0u;
    for (;;) {
        sum = 0u; cnt = 0u; mine = 0u;
#pragma unroll
        for (unsigned j = 0; j < 16; ++j) { const unsigned c = xb_ld(&bar[XB_XCNT(j)]); sum += c; cnt += (c > 0u) ? 1u : 0u; mine = (j == x) ? c : mine; }
        if (sum == G) break;
        __builtin_amdgcn_s_sleep(1);
        if ((++sp & 255u) == 0u) { if (xb_ld(&bar[XB_TMO])) break; if (sp > XB_SPIN_CAP) { atomicAdd(&bar[XB_TMO], 1u); break; } }
    }
    nloc = mine > 0u ? mine : 1u; nx = cnt > 0u ? cnt : 1u;
}

__device__ __forceinline__ void xcd_barrier(const XcdBarrier& b) {
    asm volatile("s_waitcnt vmcnt(0)" ::: "memory");
    __syncthreads();
    if (threadIdx.x == 0) {
        unsigned* bar = b.bar;
        __builtin_amdgcn_s_waitcnt(0);
        unsigned nloc = b.st[0], nx = b.st[1];
        if (nloc == 0u) { xcd_barrier_complete(bar, b.x, nloc, nx); b.st[0] = nloc; b.st[1] = nx; }
        const unsigned old = xb_add(&bar[XB_XSUB(b.x)], 1u);
        const unsigned gen = old / nloc;
        if (old + 1u == (gen + 1u) * nloc) {
            __builtin_amdgcn_fence(__ATOMIC_RELEASE, "agent");
            asm volatile("s_waitcnt vmcnt(0)" ::: "memory");
            const unsigned og = xb_add(&bar[XB_TOP], 1u);
            const unsigned tg = og / nx;
            if (og + 1u == (tg + 1u) * nx) xb_add(&bar[XB_TOPGEN], 1u);
            else XB_SPIN(xb_ld(&bar[XB_TOPGEN]) == tg, bar);
            __builtin_amdgcn_fence(__ATOMIC_ACQUIRE, "agent");
            xb_add(&bar[XB_XGEN(b.x)], 1u);
            asm volatile("s_waitcnt vmcnt(0)" ::: "memory");
        } else {
            XB_SPIN(xb_ld(&bar[XB_XGEN(b.x)]) == gen, bar);
            __builtin_amdgcn_fence(__ATOMIC_ACQUIRE, "agent");
            asm volatile("s_waitcnt vmcnt(0)" ::: "memory");
        }
    }
    __syncthreads();
}

#ifndef FP8_QKV
#define FP8_QKV 1
#endif
#ifndef FP8_UP0
#define FP8_UP0 0
#endif
#ifndef FP8_UP1
#define FP8_UP1 1
#endif
#ifndef FP8_DN0
#define FP8_DN0 0
#endif
#ifndef FP8_DN1
#define FP8_DN1 1
#endif
#ifndef SKIPMASK
#define SKIPMASK 0
#endif

__device__ __forceinline__ int perm16(int t) { const int a = (t >> 2) & 3; return (t & ~12) | ((a == 1 ? 2 : (a == 2 ? 1 : a)) << 2); }
__device__ __forceinline__ void st_vt16(bf16_t* VT, int row, int h, int d, f32x4 v) {
    const int b = row / SEQ, t = row % SEQ; bf16_t* p = VT + ((size_t)(b * 8 + h) * 128 + d) * SEQ + (t & ~15) + perm16(t & 15);
    p[0] = f2bf(v[0]); p[SEQ] = f2bf(v[1]); p[2 * (size_t)SEQ] = f2bf(v[2]); p[3 * (size_t)SEQ] = f2bf(v[3]);
}
__device__ __forceinline__ int perm64(int kk) { const int sub = kk >> 5, k5 = kk & 31; return 32 * ((k5 >> 2) & 1) + 16 * sub + (((k5 >> 3) << 2) | (k5 & 3)); }
__device__ __forceinline__ void st_vt8(bf16_t* VT_, int row, int h, int d, f32x4 v) {
    const int b = row / SEQ, t = row % SEQ; unsigned char* p = (unsigned char*)VT_ + ((size_t)(b * 8 + h) * 128 + d) * SEQ + (t & ~63) + perm64(t & 63);
    const int pk0 = __builtin_amdgcn_cvt_pk_fp8_f32(v[0], v[1], 0, false), pk1 = __builtin_amdgcn_cvt_pk_fp8_f32(v[2], v[3], 0, false);
    p[0] = (unsigned char)(pk0 & 0xFF); p[SEQ] = (unsigned char)((pk0 >> 8) & 0xFF); p[2 * (size_t)SEQ] = (unsigned char)(pk1 & 0xFF); p[3 * (size_t)SEQ] = (unsigned char)((pk1 >> 8) & 0xFF);
}
__device__ __forceinline__ void st_fp8x4(unsigned char* p, f32x4 v) { int pk = 0; pk = __builtin_amdgcn_cvt_pk_fp8_f32(v[0], v[1], pk, false); pk = __builtin_amdgcn_cvt_pk_fp8_f32(v[2], v[3], pk, true); *(int*)p = pk; }
struct FAbIn2 { unsigned char *Q, *K; bf16_t* VT; float *QI, *U, *WI; unsigned short* KI16;
    __device__ __forceinline__ void operator()(int r, int c, f32x4 v) const {
        if (c < 1024) st_fp8x4(Q + (size_t)r * 1024 + c, v);
        else if (c < 2048) st_fp8x4(K + (size_t)r * 1024 + (c - 1024), v);
        else if (c < 3072) { if (PV8_DSA) st_vt8(VT, r, (c - 2048) >> 7, (c - 2048) & 127, v); else st_vt16(VT, r, (c - 2048) >> 7, (c - 2048) & 127, v); }
        else if (c < 4096) st_f32x4(QI + (size_t)r * 1024 + (c - 3072), v);
        else if (c < 5120) st_f32x4(U + (size_t)r * 1024 + (c - 4096), v);
        else if (c < 5184) { typedef _Float16 h2 __attribute__((ext_vector_type(2))); union { h2 h; unsigned u; } a, b; a.h = (h2){(_Float16)v[0], (_Float16)v[1]}; b.h = (h2){(_Float16)v[2], (_Float16)v[3]};
            u32x2 w; w.x = a.u; w.y = b.u; *(u32x2*)(KI16 + (size_t)r * 64 + (c - 5120)) = w; }
        else if (c < 5200) st_f32x4(WI + (size_t)r * 16 + (c - 5184), v);
    } };
struct FAbInHi { FAbIn2 f; __device__ __forceinline__ void operator()(int r, int c, f32x4 v) const { f(r, c + 3072, v); } };
struct FKvUp2 { unsigned char* K8; bf16_t* VT;
    __device__ __forceinline__ void operator()(int r, int c, f32x4 v) const {
        const int h = c >> 8, d = c & 255;
        if (d < 128) { int pk = 0; pk = __builtin_amdgcn_cvt_pk_fp8_f32(v[0], v[1], pk, false); pk = __builtin_amdgcn_cvt_pk_fp8_f32(v[2], v[3], pk, true); *(int*)(K8 + (size_t)r * 1536 + h * 192 + d) = pk; }
        else { if (PV8_MLA) st_vt8(VT, r, h, d - 128, v); else st_vt16(VT, r, h, d - 128, v); }
    } };

template <class E> __device__ __forceinline__ void ph_gemm_e(LAS unsigned char* lds, const bf16_t* A, int lda, const bf16_t* Bt, int ldb, int M, int N, int K, const E& e, int bid, int nblk, int a_shift = 0, int a_bytes = 0, int cmode = 0) {
    pg8::Gemm g; g.A = A; g.Bt = Bt; g.M = M; g.N = N; g.K = K; g.lda = lda; g.ldb = ldb; g.a_shift = a_shift; g.a_bytes = a_bytes; g.cmode = cmode;
    pg8::StaticOrder S; S.init(M, N, nblk, bid);
    pg8::gemm_phase<E, pg8::StaticOrder, false>(lds, g, S, e, nullptr);
    __syncthreads();
}
template <class F> __device__ __forceinline__ void ph_gemm(LAS unsigned char* lds, const bf16_t* A, int lda, const bf16_t* Bt, int ldb, int M, int N, int K, const F& f, int bid, int nblk, int a_shift = 0, int a_bytes = 0) {
    EpiG<F> e; e.f = f;
    ph_gemm_e(lds, A, lda, Bt, ldb, M, N, K, e, bid, nblk, a_shift, a_bytes);
}
template <class F> __device__ __forceinline__ void ph_gemm8(LAS unsigned char* lds, const unsigned char* A, int lda, const unsigned char* Bt, int ldb, int M, int N, int K, const F& f, int bid, int nblk) {
    EpiG<F, true> e; e.f = f;
    ph_gemm_e(lds, (const bf16_t*)A, lda / 2, (const bf16_t*)Bt, ldb / 2, M, N, K / 2, e, bid, nblk, 0, 0);
}
__device__ __forceinline__ float dpp_ror1(float v) { return __int_as_float(__builtin_amdgcn_update_dpp(0, __float_as_int(v), 0x121, 0xF, 0xF, false)); }
__device__ __forceinline__ float dpp_ror2(float v) { return __int_as_float(__builtin_amdgcn_update_dpp(0, __float_as_int(v), 0x122, 0xF, 0xF, false)); }
__device__ __forceinline__ float dpp_shr1(float old, float v) { return __int_as_float(__builtin_amdgcn_update_dpp(__float_as_int(old), __float_as_int(v), 0x111, 0xF, 0xF, false)); }
__device__ __forceinline__ float dpp_shr2(float old, float v) { return __int_as_float(__builtin_amdgcn_update_dpp(__float_as_int(old), __float_as_int(v), 0x112, 0xF, 0xF, false)); }
__device__ __forceinline__ float gelu_fast(float x) { const float u2 = 1.5957691216057308f * (x + 0.044715f * x * x * x); return x * __builtin_amdgcn_rcpf(1.0f + __builtin_amdgcn_exp2f(-1.4426950408889634f * u2)); }
template <bool OUT8, bool F8> struct EpiGate {
    static constexpr bool PERM = false, AFTER_DRAIN = false, FP8 = F8;
    const float* cw; const float* cb; void* ACT;
    __device__ __forceinline__ void operator()(const f32x4 (&acc)[2][2][4][2], const pg8::Unit& u, int wr, int wc, int fr, int fq) const {
        const int bt = u.pm / 67, ti = u.pm % 67;
#pragma unroll
        for (int n = 0; n < 2; ++n) {
            const int c = u.pn * 128 + wc * 32 + 16 * n + 4 * fq;
            const f32x4 g0 = *(const f32x4*)(cw + c), g1 = *(const f32x4*)(cw + 8192 + c), g2 = *(const f32x4*)(cw + 16384 + c), gb = *(const f32x4*)(cb + c);
            const f32x4 v0 = *(const f32x4*)(cw + 4096 + c), v1 = *(const f32x4*)(cw + 8192 + 4096 + c), v2 = *(const f32x4*)(cw + 16384 + 4096 + c), vb = *(const f32x4*)(cb + 4096 + c);
#pragma unroll
            for (int ai = 0; ai < 2; ++ai) {
                const int strip = 2 * ai + wr, tbase = ti * 248 + strip * 62 - 2;
                f32x4 pg = {0.f, 0.f, 0.f, 0.f}, pv = pg;
#pragma unroll
                for (int m = 0; m < 4; ++m) {
                    f32x4 xg = acc[ai][0][m][n], xv = acc[ai][1][m][n];
                    const int t = tbase + 16 * m + fr;
                    if (t < 0) { xg = (f32x4){0.f, 0.f, 0.f, 0.f}; xv = xg; }
                    f32x4 og, ov;
#pragma unroll
                    for (int j = 0; j < 4; ++j) {
                        const float gp1 = dpp_shr1(dpp_ror1(pg[j]), xg[j]), gp2 = dpp_shr2(dpp_ror2(pg[j]), xg[j]);
                        const float vp1 = dpp_shr1(dpp_ror1(pv[j]), xv[j]), vp2 = dpp_shr2(dpp_ror2(pv[j]), xv[j]);
                        og[j] = gb[j] + g0[j] * gp2 + g1[j] * gp1 + g2[j] * xg[j];
                        ov[j] = vb[j] + v0[j] * vp2 + v1[j] * vp1 + v2[j] * xv[j];
                        og[j] = gelu_fast(og[j]) * ov[j];
                    }
                    pg = xg; pv = xv;
                    if (16 * m + fr >= 2 && t < SEQ) {
                        const size_t o = ((size_t)bt * SEQ + t) * 4096 + c;
                        if (OUT8) { int pk = 0; pk = __builtin_amdgcn_cvt_pk_fp8_f32(og[0], og[1], pk, false); pk = __builtin_amdgcn_cvt_pk_fp8_f32(og[2], og[3], pk, true); *(int*)((unsigned char*)ACT + o) = pk; }
                        else st_bf16x4((bf16_t*)ACT + o, og);
                    }
                }
            }
        }
    }
};
struct FPool { bf16_t* CC; const float* pb; const float* ps;
    __device__ __forceinline__ void operator()(int r, int c, f32x4 v) const { const f32x4 b = *(const f32x4*)(pb + c), s = *(const f32x4*)(ps + c); st_bf16x4(CC + (size_t)r * 2048 + 1024 + c, (v + b) * s); } };
struct EpiLru {
    static constexpr bool PERM = false, AFTER_DRAIN = false, FP8 = false;
    const bf16_t* XCB; const float *ba, *bx, *lam; float *LA, *LB;
    __device__ __forceinline__ void operator()(const f32x4 (&acc)[2][2][4][2], const pg8::Unit& u, int wr, int wc, int fr, int fq) const {
        const int row0 = u.pm * 256 + wr * 64 + fr;
#pragma unroll
        for (int n = 0; n < 2; ++n) {
            const int ch = u.pn * 128 + wc * 32 + 16 * n + 4 * fq;
            const f32x4 bav = *(const f32x4*)(ba + ch), bxv = *(const f32x4*)(bx + ch), lm = *(const f32x4*)(lam + ch);
            f32x4 sp;
#pragma unroll
            for (int j = 0; j < 4; ++j) sp[j] = log1pf(__expf(-lm[j]));
#pragma unroll
            for (int ai = 0; ai < 2; ++ai)
#pragma unroll
                for (int m = 0; m < 4; ++m) {
                    const int row = row0 + ai * 128 + m * 16;
                    const u32x2 xw = *(const u32x2*)(XCB + (size_t)row * 1024 + ch);
                    const f32x4 xc = {__uint_as_float(xw.x << 16), __uint_as_float(xw.x & 0xFFFF0000u), __uint_as_float(xw.y << 16), __uint_as_float(xw.y & 0xFFFF0000u)};
                    const f32x4 ga = acc[ai][0][m][n] + bav, gx = acc[ai][1][m][n] + bxv;
                    f32x4 av, bv;
#pragma unroll
                    for (int j = 0; j < 4; ++j) {
                        const float rg = 1.0f / (1.0f + __expf(-ga[j])), ig = 1.0f / (1.0f + __expf(-gx[j]));
                        const float log_a = -8.0f * rg * sp[j], a = __expf(log_a), mult = sqrtf(-expm1f(2.0f * log_a));
                        av[j] = a; bv[j] = mult * (ig * xc[j]);
                    }
                    *(f32x4*)(LA + (size_t)row * 1024 + ch) = av; *(f32x4*)(LB + (size_t)row * 1024 + ch) = bv;
                }
        }
    }
};
__device__ __forceinline__ void ph_pooled(const float* __restrict__ U, bf16_t* __restrict__ P, int bid, int nblk) {
    for (int i = bid * 512 + opaque_tid(); i < 256 * (NTOK / 64); i += nblk * 512) {
        const int c4 = i & 255, row0 = (i >> 8) * 64, t0 = row0 % SEQ, g = c4 >> 6, win = 2 << g;
        const f32x4* up = (const f32x4*)U + (size_t)row0 * 256 + c4;
        f32x4 s = {0.f, 0.f, 0.f, 0.f};
        if (t0 > 0) { for (int k = 1; k < win; ++k) s += up[-(ptrdiff_t)k * 256]; }
#pragma unroll 8
        for (int r = 0; r < 64; ++r) {
            const int t = t0 + r; const f32x4 u0 = up[(ptrdiff_t)r * 256];
            s += u0;
            const int cnt = (t + 1 < win) ? (t + 1) : win;
            st_bf16x4(P + (size_t)(row0 + r) * 1024 + c4 * 4, s * (1.0f / (float)cnt) - u0);
            if (t + 1 >= win) s -= up[(ptrdiff_t)(r + 1 - win) * 256];
        }
    }
}
__device__ __forceinline__ void ph_xc(const bf16_t* __restrict__ XL, const float* __restrict__ cw, const float* __restrict__ cb, bf16_t* __restrict__ XCB, int bid, int nblk) {
    for (int i = bid * 512 + opaque_tid(); i < 128 * (NTOK / 32); i += nblk * 512) {
        const int c8 = (i & 127) * 8, row0 = (i >> 7) * 32, t0 = row0 % SEQ;
        float w0[8], w1[8], w2[8], w3[8], bb[8];
#pragma unroll
        for (int j = 0; j < 8; ++j) { w0[j] = cw[c8 + j]; w1[j] = cw[1024 + c8 + j]; w2[j] = cw[2048 + c8 + j]; w3[j] = cw[3072 + c8 + j]; bb[j] = cb[c8 + j]; }
        u32x4 p3 = {0u, 0u, 0u, 0u}, p2 = p3, p1 = p3;
        if (t0 >= 3) { p3 = *(const u32x4*)(XL + (size_t)(row0 - 3) * 1024 + c8); p2 = *(const u32x4*)(XL + (size_t)(row0 - 2) * 1024 + c8); p1 = *(const u32x4*)(XL + (size_t)(row0 - 1) * 1024 + c8); }
#pragma unroll 8
        for (int r = 0; r < 32; ++r) {
            const u32x4 cur = *(const u32x4*)(XL + (size_t)(row0 + r) * 1024 + c8);
            const unsigned a3[4] = {p3.x, p3.y, p3.z, p3.w}, a2[4] = {p2.x, p2.y, p2.z, p2.w}, a1[4] = {p1.x, p1.y, p1.z, p1.w}, a0[4] = {cur.x, cur.y, cur.z, cur.w};
            float y[8];
#pragma unroll
            for (int j = 0; j < 4; ++j) {
                y[2 * j] = bb[2 * j] + w0[2 * j] * __uint_as_float(a3[j] << 16) + w1[2 * j] * __uint_as_float(a2[j] << 16) + w2[2 * j] * __uint_as_float(a1[j] << 16) + w3[2 * j] * __uint_as_float(a0[j] << 16);
                y[2 * j + 1] = bb[2 * j + 1] + w0[2 * j + 1] * __uint_as_float(a3[j] & 0xFFFF0000u) + w1[2 * j + 1] * __uint_as_float(a2[j] & 0xFFFF0000u) + w2[2 * j + 1] * __uint_as_float(a1[j] & 0xFFFF0000u) + w3[2 * j + 1] * __uint_as_float(a0[j] & 0xFFFF0000u); }
            u32x4 o; o.x = pack2bf(y[0], y[1]); o.y = pack2bf(y[2], y[3]); o.z = pack2bf(y[4], y[5]); o.w = pack2bf(y[6], y[7]);
            *(u32x4*)(XCB + (size_t)(row0 + r) * 1024 + c8) = o;
            p3 = p2; p2 = p1; p1 = cur;
        }
    }
}
__device__ __forceinline__ int up_src_col(int n0) { return ((n0 >> 7) & 1) * 4096 + (n0 >> 8) * 128 + (n0 & 127); }
template <bool OUT8>
__device__ __forceinline__ void ph_convT_g(LAS unsigned char* lds, const float* __restrict__ W, int ldw, int src_col0, int ncols, int K, void* __restrict__ Bt, int ldd, int bid, int nblk, bool upperm) {
    const int tid = opaque_tid(), sub = tid >> 8, t8 = tid & 255;
    LAS float* tile = (LAS float*)lds + sub * (64 * 65);
    const int ntx = (ncols + 63) / 64, ntiles = ntx * (K / 64);
    for (int base = bid * 2; base < ntiles; base += nblk * 2) {
        const int tl = base + sub; const bool act = tl < ntiles;
        const int n0 = (tl % ntx) * 64, k0 = (tl / ntx) * 64;
        if (act) {
            const int c4 = (t8 & 15) * 4, kr = t8 >> 4;
            const int nsrc = src_col0 + (upperm ? up_src_col(n0 + c4) : n0 + c4);
#pragma unroll
            for (int i = 0; i < 4; ++i) { const int kl = kr + 16 * i;
                f32x4 v = {0.f, 0.f, 0.f, 0.f};
                if (n0 + c4 < ncols) v = *(const f32x4*)(W + (size_t)(k0 + kl) * ldw + nsrc);
                tile[kl * 65 + c4] = v[0]; tile[kl * 65 + c4 + 1] = v[1]; tile[kl * 65 + c4 + 2] = v[2]; tile[kl * 65 + c4 + 3] = v[3]; } }
        __syncthreads();
        if (act) {
            const int k8 = (t8 & 7) * 8, nr = t8 >> 3;
#pragma unroll
            for (int i = 0; i < 2; ++i) { const int nl = nr + 32 * i;
                if (n0 + nl < ncols) {
                    float v[8];
#pragma unroll
                    for (int j = 0; j < 8; ++j) v[j] = tile[(k8 + j) * 65 + nl];
                    if (OUT8) { int p0 = 0, p1 = 0;
                        p0 = __builtin_amdgcn_cvt_pk_fp8_f32(64.f * v[0], 64.f * v[1], p0, false); p0 = __builtin_amdgcn_cvt_pk_fp8_f32(64.f * v[2], 64.f * v[3], p0, true);
                        p1 = __builtin_amdgcn_cvt_pk_fp8_f32(64.f * v[4], 64.f * v[5], p1, false); p1 = __builtin_amdgcn_cvt_pk_fp8_f32(64.f * v[6], 64.f * v[7], p1, true);
                        u32x2 o; o.x = (unsigned)p0; o.y = (unsigned)p1; *(u32x2*)((unsigned char*)Bt + (size_t)(n0 + nl) * ldd + k0 + k8) = o; }
                    else { u32x4 o; o.x = pack2bf(v[0], v[1]); o.y = pack2bf(v[2], v[3]); o.z = pack2bf(v[4], v[5]); o.w = pack2bf(v[6], v[7]);
                        *(u32x4*)((bf16_t*)Bt + (size_t)(n0 + nl) * ldd + k0 + k8) = o; }
                } } }
        __syncthreads();
    }
}
__device__ __forceinline__ void ph_convT(LAS unsigned char* lds, const float* __restrict__ W, int ldw, int src_col0, int ncols, int K, bf16_t* __restrict__ Bt, int ldd, int bid, int nblk, bool upperm = false) {
    ph_convT_g<false>(lds, W, ldw, src_col0, ncols, K, Bt, ldd, bid, nblk, upperm);
}
__device__ __forceinline__ void ph_convT8(LAS unsigned char* lds, const float* __restrict__ W, int ldw, int ncols, int K, unsigned char* __restrict__ Bt, int bid, int nblk, bool upperm = false) {
    ph_convT_g<true>(lds, W, ldw, 0, ncols, K, Bt, K, bid, nblk, upperm);
}
template <int NC> __device__ __forceinline__ void ph_rmsnorm(const float* __restrict__ x, const float* __restrict__ g, bf16_t* __restrict__ out, int bid, int nblk, unsigned char* __restrict__ out8 = nullptr) {
    const int lane = opaque_tid() & 63, w = opaque_tid() >> 6;
    constexpr int NV = NC / 256;
    for (int row = bid * 8 + w; row < NTOK; row += nblk * 8) {
        const f32x4* xr = (const f32x4*)(x + (size_t)row * NC);
        f32x4 v[NV]; float ss = 0.f;
#pragma unroll
        for (int i = 0; i < NV; ++i) { v[i] = xr[lane + 64 * i]; ss += v[i][0] * v[i][0] + v[i][1] * v[i][1] + v[i][2] * v[i][2] + v[i][3] * v[i][3]; }
        ss = wave_sum(ss);
        const float r = rsqrtf(ss * (1.0f / NC) + NORM_EPS);
#pragma unroll
        for (int i = 0; i < NV; ++i) { const f32x4 gg = ((const f32x4*)g)[lane + 64 * i]; const f32x4 y = v[i] * r * gg; st_bf16x4(out + (size_t)row * NC + 4 * (lane + 64 * i), y);
            if (out8) { int pk = 0; pk = __builtin_amdgcn_cvt_pk_fp8_f32(y[0], y[1], pk, false); pk = __builtin_amdgcn_cvt_pk_fp8_f32(y[2], y[3], pk, true); *(int*)(out8 + (size_t)row * NC + 4 * (lane + 64 * i)) = pk; } }
    }
}
template <bool IN16, bool OUT16>
__device__ __forceinline__ void ph_resnorm(const void* xin, const bf16_t* __restrict__ m, const float* __restrict__ gpost, const float* __restrict__ gpre, void* xout, bf16_t* __restrict__ h, unsigned char* __restrict__ h8, int bid, int nblk) {
    const int tid_ = opaque_tid(), lane = tid_ & 63, w = tid_ >> 6;
    for (int row = bid * 8 + w; row < NTOK; row += nblk * 8) {
        const u32x2* mr = (const u32x2*)(m + (size_t)row * DM);
        f32x4 mv[8], xv[8]; float ss = 0.f;
#pragma unroll
        for (int i = 0; i < 8; ++i) { const u32x2 wd = mr[lane + 64 * i]; mv[i][0] = __uint_as_float(wd.x << 16); mv[i][1] = __uint_as_float(wd.x & 0xFFFF0000u); mv[i][2] = __uint_as_float(wd.y << 16); mv[i][3] = __uint_as_float(wd.y & 0xFFFF0000u);
            if (IN16) { const u32x2 xw = ((const u32x2*)((const bf16_t*)xin + (size_t)row * DM))[lane + 64 * i];
                xv[i][0] = __uint_as_float(xw.x << 16); xv[i][1] = __uint_as_float(xw.x & 0xFFFF0000u); xv[i][2] = __uint_as_float(xw.y << 16); xv[i][3] = __uint_as_float(xw.y & 0xFFFF0000u); }
            else xv[i] = ((const f32x4*)((const float*)xin + (size_t)row * DM))[lane + 64 * i];
            ss += mv[i][0] * mv[i][0] + mv[i][1] * mv[i][1] + mv[i][2] * mv[i][2] + mv[i][3] * mv[i][3]; }
        ss = wave_sum(ss);
        const float r1 = rsqrtf(ss * (1.0f / DM) + NORM_EPS);
        float s2 = 0.f;
#pragma unroll
        for (int i = 0; i < 8; ++i) { const f32x4 gg = ((const f32x4*)gpost)[lane + 64 * i]; xv[i] = xv[i] + mv[i] * r1 * gg;
            if (OUT16) st_bf16x4((bf16_t*)xout + (size_t)row * DM + 4 * (lane + 64 * i), xv[i]); else ((f32x4*)((float*)xout + (size_t)row * DM))[lane + 64 * i] = xv[i];
            s2 += xv[i][0] * xv[i][0] + xv[i][1] * xv[i][1] + xv[i][2] * xv[i][2] + xv[i][3] * xv[i][3]; }
        if (gpre) {
            s2 = wave_sum(s2);
            const float r2 = rsqrtf(s2 * (1.0f / DM) + NORM_EPS);
#pragma unroll
            for (int i = 0; i < 8; ++i) { const f32x4 gg = ((const f32x4*)gpre)[lane + 64 * i]; const f32x4 y = xv[i] * r2 * gg;
                if (h8) { int pk = 0; pk = __builtin_amdgcn_cvt_pk_fp8_f32(y[0], y[1], pk, false); pk = __builtin_amdgcn_cvt_pk_fp8_f32(y[2], y[3], pk, true); *(int*)(h8 + (size_t)row * DM + 4 * (lane + 64 * i)) = pk; }
                else st_bf16x4(h + (size_t)row * DM + 4 * (lane + 64 * i), y); }
        }
    }
}
__device__ __forceinline__ void ph_scan1(const float* __restrict__ Aa, const float* __restrict__ Bb, float* __restrict__ CA, float* __restrict__ CH, int bid, int nblk) {
    for (int i = bid * 512 + opaque_tid(); i < 2 * 256 * 1024; i += nblk * 512) {
        const int ch = i & 1023, chunk = (i >> 10) & 255, b = i >> 18;
        const size_t base = ((size_t)b * SEQ + (size_t)chunk * 64) * 1024 + ch;
        float h = 0.f, P = 1.f;
#pragma unroll 8
        for (int s = 0; s < 64; ++s) { const float a = Aa[base + (size_t)s * 1024]; h = a * h + Bb[base + (size_t)s * 1024]; P *= a; }
        CA[i] = P; CH[i] = h;
    }
}
__device__ __forceinline__ void ph_scan2(const float* __restrict__ CA, const float* __restrict__ CH, float* __restrict__ CIN, int bid, int nblk) {
    for (int i = bid * 512 + opaque_tid(); i < 2048; i += nblk * 512) {
        const int ch = i & 1023, b = i >> 10;
        float h = 0.f;
#pragma unroll 8
        for (int c = 0; c < 256; ++c) { const int j = (b * 256 + c) * 1024 + ch; CIN[j] = h; h = CA[j] * h + CH[j]; }
    }
}
__device__ __forceinline__ void ph_scan3(const float* __restrict__ Aa, const float* __restrict__ Bb, const float* __restrict__ CIN, const bf16_t* __restrict__ YG, bf16_t* __restrict__ CC, int bid, int nblk) {
    for (int i = bid * 512 + opaque_tid(); i < 2 * 256 * 1024; i += nblk * 512) {
        const int ch = i & 1023, chunk = (i >> 10) & 255, b = i >> 18;
        const size_t row0 = (size_t)b * SEQ + (size_t)chunk * 64;
        float h = CIN[i];
#pragma unroll 8
        for (int s = 0; s < 64; ++s) { const size_t r = row0 + s; h = Aa[r * 1024 + ch] * h + Bb[r * 1024 + ch];
            CC[r * 2048 + 1024 + ch] = f2bf(h * gelu_tanh(bf2f(YG[r * 1024 + ch]))); }
    }
}
__device__ __forceinline__ void ph_rope_q(const bf16_t* __restrict__ Q1, const int* __restrict__ pos, unsigned char* __restrict__ Q8, int bid, int nblk) {
    for (int idx = bid * 512 + opaque_tid(); idx < NTOK * 8 * 4; idx += nblk * 512) {
        const int g = idx & 3, h = (idx >> 2) & 7, row = idx >> 5;
        const bf16_t* p = Q1 + (size_t)row * 1536 + h * 192; unsigned char* q = Q8 + (size_t)row * 1536 + h * 192;
#pragma unroll
        for (int k = 0; k < 4; ++k) { const u32x4 w = *(const u32x4*)(p + 32 * g + 8 * k);
            int p0 = 0, p1 = 0;
            p0 = __builtin_amdgcn_cvt_pk_fp8_f32(__uint_as_float(w.x << 16), __uint_as_float(w.x & 0xFFFF0000u), p0, false); p0 = __builtin_amdgcn_cvt_pk_fp8_f32(__uint_as_float(w.y << 16), __uint_as_float(w.y & 0xFFFF0000u), p0, true);
            p1 = __builtin_amdgcn_cvt_pk_fp8_f32(__uint_as_float(w.z << 16), __uint_as_float(w.z & 0xFFFF0000u), p1, false); p1 = __builtin_amdgcn_cvt_pk_fp8_f32(__uint_as_float(w.w << 16), __uint_as_float(w.w & 0xFFFF0000u), p1, true);
            u32x2 o; o.x = (unsigned)p0; o.y = (unsigned)p1; *(u32x2*)(q + 32 * g + 8 * k) = o; }
        const u32x4 w1 = *(const u32x4*)(p + 128 + 8 * g), w2 = *(const u32x4*)(p + 160 + 8 * g);
        const unsigned a1[4] = {w1.x, w1.y, w1.z, w1.w}, a2[4] = {w2.x, w2.y, w2.z, w2.w};
        float o1[8], o2[8]; const int ps = pos[row];
#pragma unroll
        for (int j = 0; j < 8; ++j) { float cs, sn; rope_cs(ps, 8 * g + j, cs, sn);
            const float x1 = (j & 1) ? __uint_as_float(a1[j >> 1] & 0xFFFF0000u) : __uint_as_float(a1[j >> 1] << 16), x2 = (j & 1) ? __uint_as_float(a2[j >> 1] & 0xFFFF0000u) : __uint_as_float(a2[j >> 1] << 16);
            o1[j] = x1 * cs - x2 * sn; o2[j] = x2 * cs + x1 * sn; }
        int p0 = 0, p1 = 0, p2 = 0, p3 = 0;
        p0 = __builtin_amdgcn_cvt_pk_fp8_f32(o1[0], o1[1], p0, false); p0 = __builtin_amdgcn_cvt_pk_fp8_f32(o1[2], o1[3], p0, true); p1 = __builtin_amdgcn_cvt_pk_fp8_f32(o1[4], o1[5], p1, false); p1 = __builtin_amdgcn_cvt_pk_fp8_f32(o1[6], o1[7], p1, true);
        p2 = __builtin_amdgcn_cvt_pk_fp8_f32(o2[0], o2[1], p2, false); p2 = __builtin_amdgcn_cvt_pk_fp8_f32(o2[2], o2[3], p2, true); p3 = __builtin_amdgcn_cvt_pk_fp8_f32(o2[4], o2[5], p3, false); p3 = __builtin_amdgcn_cvt_pk_fp8_f32(o2[6], o2[7], p3, true);
        u32x2 oa; oa.x = (unsigned)p0; oa.y = (unsigned)p1; *(u32x2*)(q + 128 + 8 * g) = oa;
        u32x2 ob; ob.x = (unsigned)p2; ob.y = (unsigned)p3; *(u32x2*)(q + 160 + 8 * g) = ob;
    }
}
__device__ __forceinline__ void ph_rope_k(const float* __restrict__ KR, const int* __restrict__ pos, unsigned char* __restrict__ K8, int bid, int nblk) {
    for (int idx = bid * 512 + opaque_tid(); idx < NTOK * 32; idx += nblk * 512) {
        const int i = idx & 31, row = idx >> 5;
        float c, s; rope_cs(pos[row], i, c, s);
        const float x1 = KR[(size_t)row * 64 + i], x2 = KR[(size_t)row * 64 + 32 + i];
        const int pk = __builtin_amdgcn_cvt_pk_fp8_f32(x1 * c - x2 * s, x2 * c + x1 * s, 0, false);
        const unsigned char o1 = (unsigned char)(pk & 0xFF), o2 = (unsigned char)((pk >> 8) & 0xFF);
#pragma unroll
        for (int h = 0; h < 8; ++h) { unsigned char* p = K8 + (size_t)row * 1536 + h * 192 + 128; p[i] = o1; p[32 + i] = o2; }
    }
}
template <bool OUT8> __device__ __forceinline__ void ph_ffn_gate(const bf16_t* __restrict__ HID, const float* __restrict__ cw, const float* __restrict__ cb, bf16_t* __restrict__ ACT, int bid, int nblk) {
    for (int i = bid * 512 + opaque_tid(); i < 512 * (SEQ / 64); i += nblk * 512) {
        const int c8 = (i & 511) * 8, t0 = (i >> 9) * 64;
        float wg[3][8], wv[3][8], bg[8], bv[8];
#pragma unroll
        for (int j = 0; j < 8; ++j) { bg[j] = cb[c8 + j]; bv[j] = cb[4096 + c8 + j];
#pragma unroll
            for (int k = 0; k < 3; ++k) { wg[k][j] = cw[k * 8192 + c8 + j]; wv[k][j] = cw[k * 8192 + 4096 + c8 + j]; } }
        u32x4 g2 = {0u, 0u, 0u, 0u}, g1 = g2, v2 = g2, v1 = g2;
        if (t0 >= 2) { g2 = *(const u32x4*)(HID + (size_t)(t0 - 2) * 8192 + c8); g1 = *(const u32x4*)(HID + (size_t)(t0 - 1) * 8192 + c8);
                       v2 = *(const u32x4*)(HID + (size_t)(t0 - 2) * 8192 + 4096 + c8); v1 = *(const u32x4*)(HID + (size_t)(t0 - 1) * 8192 + 4096 + c8); }
#pragma unroll 8
        for (int r = 0; r < 64; ++r) {
            const u32x4 g0 = *(const u32x4*)(HID + (size_t)(t0 + r) * 8192 + c8), v0 = *(const u32x4*)(HID + (size_t)(t0 + r) * 8192 + 4096 + c8);
            const unsigned G2[4] = {g2.x, g2.y, g2.z, g2.w}, G1[4] = {g1.x, g1.y, g1.z, g1.w}, G0[4] = {g0.x, g0.y, g0.z, g0.w};
            const unsigned V2[4] = {v2.x, v2.y, v2.z, v2.w}, V1[4] = {v1.x, v1.y, v1.z, v1.w}, V0[4] = {v0.x, v0.y, v0.z, v0.w};
            float o[8];
#pragma unroll
            for (int j = 0; j < 4; ++j) {
                const float ge = bg[2 * j] + wg[0][2 * j] * __uint_as_float(G2[j] << 16) + wg[1][2 * j] * __uint_as_float(G1[j] << 16) + wg[2][2 * j] * __uint_as_float(G0[j] << 16);
                const float go = bg[2 * j + 1] + wg[0][2 * j + 1] * __uint_as_float(G2[j] & 0xFFFF0000u) + wg[1][2 * j + 1] * __uint_as_float(G1[j] & 0xFFFF0000u) + wg[2][2 * j + 1] * __uint_as_float(G0[j] & 0xFFFF0000u);
                const float ve = bv[2 * j] + wv[0][2 * j] * __uint_as_float(V2[j] << 16) + wv[1][2 * j] * __uint_as_float(V1[j] << 16) + wv[2][2 * j] * __uint_as_float(V0[j] << 16);
                const float vo = bv[2 * j + 1] + wv[0][2 * j + 1] * __uint_as_float(V2[j] & 0xFFFF0000u) + wv[1][2 * j + 1] * __uint_as_float(V1[j] & 0xFFFF0000u) + wv[2][2 * j + 1] * __uint_as_float(V0[j] & 0xFFFF0000u);
                o[2 * j] = gelu_tanh(ge) * ve; o[2 * j + 1] = gelu_tanh(go) * vo; }
            if (OUT8) { int p0 = 0, p1 = 0;
                p0 = __builtin_amdgcn_cvt_pk_fp8_f32(o[0], o[1], p0, false); p0 = __builtin_amdgcn_cvt_pk_fp8_f32(o[2], o[3], p0, true);
                p1 = __builtin_amdgcn_cvt_pk_fp8_f32(o[4], o[5], p1, false); p1 = __builtin_amdgcn_cvt_pk_fp8_f32(o[6], o[7], p1, true);
                u32x2 ov; ov.x = (unsigned)p0; ov.y = (unsigned)p1; *(u32x2*)((unsigned char*)ACT + (size_t)(t0 + r) * 4096 + c8) = ov; }
            else { u32x4 ov; ov.x = pack2bf(o[0], o[1]); ov.y = pack2bf(o[2], o[3]); ov.z = pack2bf(o[4], o[5]); ov.w = pack2bf(o[6], o[7]);
                *(u32x4*)(ACT + (size_t)(t0 + r) * 4096 + c8) = ov; }
            g2 = g1; g1 = g0; v2 = v1; v1 = v0;
        }
    }
}

__device__ __forceinline__ void ph_conv_lru(const float* __restrict__ wa, const float* __restrict__ wx, bf16_t* __restrict__ Bt, int bid, int nblk) {
    for (int e = bid * 512 + opaque_tid(); e < 8 * 2 * 128 * 128; e += nblk * 512) {
        const int d = e & 127, c = (e >> 7) & 127, gate = (e >> 14) & 1, nb = e >> 15;
        const float v = (gate ? wx : wa)[((size_t)nb * 128 + c) * 128 + d];
        bf16_t* row = Bt + (size_t)(nb * 256 + gate * 128 + d) * 256;
        row[(nb & 1) * 128 + c] = f2bf(v); row[(1 - (nb & 1)) * 128 + c] = 0;
    }
}

static constexpr size_t MiB = 1048576;
static constexpr size_t W_UP0 = 0 * MiB, W_UP1 = 32 * MiB, W_DN0 = 64 * MiB, W_DN1 = 80 * MiB, W_ABIN = 96 * MiB, W_ABOUT = 117 * MiB, W_CDIN = 125 * MiB, W_CDOUT = 137 * MiB,
                        W_QUP = 145 * MiB, W_KVUP = 146 * MiB + 512 * 1024, W_POOL = 147 * MiB + 512 * 1024;
static constexpr size_t R_H = 148 * MiB;
static constexpr size_t R_Q0 = 276 * MiB, R_K0 = 340 * MiB, R_VT0 = 404 * MiB, R_QI = 468 * MiB, R_M0 = 468 * MiB, R_U = 596 * MiB, R_KI = 724 * MiB, R_WI = 732 * MiB, R_MASK = 734 * MiB, R_CC0 = 830 * MiB, R_POOLED = 958 * MiB, R_H8A = 830 * MiB;
static constexpr size_t R_HID = 276 * MiB, R_ACT = 532 * MiB, R_F = 660 * MiB, R_X3 = 788 * MiB;
static constexpr size_t R_VT1 = 276 * MiB, R_CQ = 276 * MiB, R_CKV = 340 * MiB, R_KR = 372 * MiB, R_XL = 380 * MiB, R_YG = 444 * MiB, R_CQN = 508 * MiB, R_CKVN = 540 * MiB, R_LA = 556 * MiB, R_LB = 684 * MiB,
                        R_Q1 = 812 * MiB, R_K1 = 908 * MiB, R_Q8 = 956 * MiB,     R_CA = 1004 * MiB, R_CH = 1006 * MiB, R_CIN = 1008 * MiB, R_CC1 = 148 * MiB, R_M1 = 276 * MiB, R_XCB = 148 * MiB, W_LRU = 1010 * MiB;
static constexpr size_t WS_BAR = 1022 * MiB, WS_NEED = 1022 * MiB + 65536;
static constexpr int MK_LDS = 162816;

struct MK { const float* in[28]; float* out; unsigned char* ws; int ph_lo, ph_hi; };

__global__ __launch_bounds__(512, 2) void k_mega(MK p) {
    extern __shared__ __attribute__((aligned(16))) unsigned char shm[];
    LAS unsigned char* lds = (LAS unsigned char*)shm;
    const int bid0 = (int)blockIdx.x, nblk0 = (int)gridDim.x;
    volatile LAS unsigned* xbw = (volatile LAS unsigned*)(lds + MK_LDS - 16);
    if (threadIdx.x == 0) { xbw[0] = 0u; xbw[1] = 0u; xbw[2] = 0u; xbw[3] = 0u; }
    if ((threadIdx.x & 63) == 0) *(volatile LAS int*)(size_t)(TID_TAB_LDS + 4 * ((unsigned)__builtin_amdgcn_s_getreg(((6 - 1) << 11) | 4) & 63u)) = (int)(threadIdx.x >> 6);
    __syncthreads();
    XcdBarrier bar = xcd_barrier_post((unsigned*)(p.ws + WS_BAR), xbw);
#ifndef KARG_PLAIN
#define KARG_PLAIN 0
#endif
#if KARG_PLAIN
#define KARG_DECL const MK& P_ = p;
#else
#define KARG_DECL KPtr P__ = kp; asm volatile("" : "+s"(P__)); const __attribute__((address_space(4))) MK& P_ = *P__;
#endif
    typedef const __attribute__((address_space(4))) MK* KPtr;
    KPtr kp = (KPtr)__builtin_amdgcn_kernarg_segment_ptr();
#define WSP(T, off) ((T*)(ws + (off)))
#define PHASE_BEGIN if (pc >= p.ph_lo && pc < p.ph_hi) { const int bid = opaque_s(bid0), nblk = opaque_s(nblk0); \
    KARG_DECL unsigned char* const ws = P_.ws; float* const xo = P_.out; const float* const x = P_.in[0]; const int* const positions = (const int*)P_.in[1]; \
    const float *const mix_pre_g = P_.in[2], *const mix_post_g = P_.in[3], *const ffn_pre_g = P_.in[4], *const ffn_post_g = P_.in[5], *const ffn_up = P_.in[6], *const ffn_conv_w = P_.in[7], *const ffn_conv_b = P_.in[8], *const ffn_down = P_.in[9], \
    *const ab_w_in = P_.in[10], *const pool_w = P_.in[11], *const pool_b = P_.in[12], *const pool_scale = P_.in[13], *const ab_w_out = P_.in[14], *const cd_w_in = P_.in[15], *const q_norm_g = P_.in[16], *const w_q_up = P_.in[17], \
    *const kv_norm_g = P_.in[18], *const w_kv_up = P_.in[19], *const lru_conv_w = P_.in[20], *const lru_conv_b = P_.in[21], *const lru_wa = P_.in[22], *const lru_ba = P_.in[23], *const lru_wx = P_.in[24], *const lru_bx = P_.in[25], \
    *const lru_lambda = P_.in[26], *const cd_w_out = P_.in[27]; bf16_t* const H = WSP(bf16_t, R_H); const bf16_t* const CC = WSP(bf16_t, LAYER_CC); bf16_t* const Mx = WSP(bf16_t, LAYER_MX); \
    (void)xo; (void)x; (void)positions; (void)mix_pre_g; (void)mix_post_g; (void)ffn_pre_g; (void)ffn_post_g; (void)ffn_up; (void)ffn_conv_w; (void)ffn_conv_b; (void)ffn_down; (void)ab_w_in; (void)pool_w; (void)pool_b; (void)pool_scale; \
    (void)ab_w_out; (void)cd_w_in; (void)q_norm_g; (void)w_q_up; (void)kv_norm_g; (void)w_kv_up; (void)lru_conv_w; (void)lru_conv_b; (void)lru_wa; (void)lru_ba; (void)lru_wx; (void)lru_bx; (void)lru_lambda; (void)cd_w_out; (void)H; (void)CC; (void)Mx;
#define PHASE_END } if (pc >= p.ph_lo && pc + 1 < p.ph_hi) xcd_barrier(bar); ++pc;
    int pc = 0;
#define LAYER_CC R_CC0
#define LAYER_MX R_M0
    PHASE_BEGIN
#if !((SKIPMASK >> 0) & 1)
#if FP8_UP0
        ph_convT8(lds, ffn_up, 8192, 8192, 2048, WSP(unsigned char, W_UP0), bid, nblk, true);
#else
        ph_convT(lds, ffn_up, 8192, 0, 8192, 2048, WSP(bf16_t, W_UP0), 2048, bid, nblk, true);
#endif
#if FP8_UP1
        ph_convT8(lds, ffn_up + (size_t)2048 * 8192, 8192, 8192, 2048, WSP(unsigned char, W_UP1), bid, nblk, true);
#else
        ph_convT(lds, ffn_up + (size_t)2048 * 8192, 8192, 0, 8192, 2048, WSP(bf16_t, W_UP1), 2048, bid, nblk, true);
#endif
#if FP8_DN0
        ph_convT8(lds, ffn_down, 2048, 2048, 4096, WSP(unsigned char, W_DN0), bid, nblk);
#else
        ph_convT(lds, ffn_down, 2048, 0, 2048, 4096, WSP(bf16_t, W_DN0), 4096, bid, nblk);
#endif
#if FP8_DN1
        ph_convT8(lds, ffn_down + (size_t)4096 * 2048, 2048, 2048, 4096, WSP(unsigned char, W_DN1), bid, nblk);
#else
        ph_convT(lds, ffn_down + (size_t)4096 * 2048, 2048, 0, 2048, 4096, WSP(bf16_t, W_DN1), 4096, bid, nblk);
#endif
#if FP8_QKV
        ph_convT8(lds, ab_w_in, 5200, 3072, 2048, WSP(unsigned char, W_ABIN), bid, nblk);
        ph_convT(lds, ab_w_in, 5200, 3072, 1024, 2048, WSP(bf16_t, W_ABIN) + (size_t)3072 * 2048, 2048, bid, nblk);
#else
        ph_convT(lds, ab_w_in, 5200, 0, 4096, 2048, WSP(bf16_t, W_ABIN), 2048, bid, nblk);
#endif
        ph_convT(lds, ab_w_in, 5200, 4176, 1024, 2048, WSP(bf16_t, W_ABIN) + (size_t)4096 * 2048, 2048, bid, nblk);
        ph_convT(lds, ab_w_in, 5200, 4096, 64, 2048, WSP(bf16_t, W_ABIN) + (size_t)5120 * 2048, 2048, bid, nblk);
        ph_convT(lds, ab_w_in, 5200, 4160, 16, 2048, WSP(bf16_t, W_ABIN) + (size_t)5184 * 2048, 2048, bid, nblk);
        ph_convT(lds, ab_w_out, 2048, 0, 2048, 2048, WSP(bf16_t, W_ABOUT), 2048, bid, nblk);
        ph_convT(lds, cd_w_in, 2880, 0, 832, 2048, WSP(bf16_t, W_CDIN), 2048, bid, nblk);
        ph_convT(lds, cd_w_in, 2880, 832, 2048, 2048, WSP(bf16_t, W_CDIN) + (size_t)1024 * 2048, 2048, bid, nblk);
        ph_convT(lds, cd_w_out, 2048, 0, 2048, 2048, WSP(bf16_t, W_CDOUT), 2048, bid, nblk);
        ph_convT(lds, w_q_up, 1536, 0, 1536, 512, WSP(bf16_t, W_QUP), 512, bid, nblk);
        ph_convT(lds, w_kv_up, 2048, 0, 2048, 256, WSP(bf16_t, W_KVUP), 256, bid, nblk);
        for (int g = 0; g < 4; ++g) ph_convT(lds, pool_w + (size_t)g * 65536, 256, 0, 256, 256, WSP(bf16_t, W_POOL) + (size_t)g * 65536, 256, bid, nblk);
        ph_rmsnorm<2048>(x, mix_pre_g, H, bid, nblk, FP8_QKV ? WSP(unsigned char, R_H8A) : (unsigned char*)nullptr);
#endif
    PHASE_END
    {
            PHASE_BEGIN
#if !((SKIPMASK >> 1) & 1)
                FAbIn2 f; f.Q = WSP(unsigned char, R_Q0); f.K = WSP(unsigned char, R_K0); f.VT = WSP(bf16_t, R_VT0); f.QI = WSP(float, R_QI); f.U = WSP(float, R_U); f.WI = WSP(float, R_WI); f.KI16 = WSP(unsigned short, R_KI);
#if FP8_QKV
                ph_gemm8(lds, WSP(unsigned char, R_H8A), 2048, WSP(unsigned char, W_ABIN), 2048, NTOK, 3072, 2048, f, bid, nblk);
                { FAbInHi fh; fh.f = f; ph_gemm(lds, H, 2048, WSP(bf16_t, W_ABIN) + (size_t)3072 * 2048, 2048, NTOK, 2304, 2048, fh, bid, nblk); }
#else
                ph_gemm(lds, H, 2048, WSP(bf16_t, W_ABIN), 2048, NTOK, 5376, 2048, f, bid, nblk);
#endif
#endif
            PHASE_END
            PHASE_BEGIN
#if !((SKIPMASK >> 2) & 1)
                ph_pooled(WSP(float, R_U), WSP(bf16_t, R_POOLED), bid, nblk);
                IdxArgs a; a.QI = WSP(float, R_QI); a.KI16 = WSP(unsigned short, R_KI); a.WI = WSP(float, R_WI); a.MT = WSP(unsigned long long, R_MASK);
                idx_phase(lds, a, bid, nblk);
#endif
            PHASE_END
            PHASE_BEGIN
#if !((SKIPMASK >> 3) & 1)
                { FPool f; f.CC = WSP(bf16_t, R_CC0); f.pb = pool_b; f.ps = pool_scale; ph_gemm(lds, WSP(bf16_t, R_POOLED), 1024, WSP(bf16_t, W_POOL), 256, NTOK, 1024, 256, f, bid, nblk, 0, 512); }
                AttnArgs a; a.Q = WSP(bf16_t, R_Q0); a.K = WSP(bf16_t, R_K0); a.VT = WSP(bf16_t, R_VT0); a.MT = WSP(unsigned long long, R_MASK); a.O = WSP(bf16_t, R_CC0); a.ldq = 1024; a.ldk = 1024; a.ldo = 2048;
                a.sc_log2e = 0.08838834764831845f * 1.4426950408889634f;
                attn_phase<128, true>(lds, a, bid, nblk);
#endif
            PHASE_END
        PHASE_BEGIN
#if !((SKIPMASK >> 4) & 1)
            FStoreBf16 f; f.O = Mx; f.ldc = 2048; f.pad_ = 0;
            ph_gemm(lds, CC, 2048, WSP(bf16_t, W_ABOUT), 2048, NTOK, 2048, 2048, f, bid, nblk);
#endif
        PHASE_END
        PHASE_BEGIN
#if !((SKIPMASK >> 5) & 1)
            ph_resnorm<false, true>(x, Mx, mix_post_g + 0, ffn_pre_g + 0, xo, H, FP8_UP0 ? WSP(unsigned char, R_H) : (unsigned char*)nullptr, bid, nblk);
#endif
        PHASE_END
        PHASE_BEGIN
#if FP8_UP0
            { EpiGate<FP8_DN0 != 0, true> ep; ep.cw = ffn_conv_w + 0; ep.cb = ffn_conv_b + 0; ep.ACT = WSP(void, R_HID);
              ph_gemm_e(lds, (const bf16_t*)WSP(unsigned char, R_H), 1024, (const bf16_t*)WSP(unsigned char, W_UP0), 1024, 134 * 256, 8192, 1024, ep, bid, nblk, 0, 0, 1); }
#else
            { EpiGate<FP8_DN0 != 0, false> ep; ep.cw = ffn_conv_w + 0; ep.cb = ffn_conv_b + 0; ep.ACT = WSP(void, R_HID);
              ph_gemm_e(lds, H, 2048, WSP(bf16_t, W_UP0), 2048, 134 * 256, 8192, 2048, ep, bid, nblk, 0, 0, 1); }
#endif
        PHASE_END
        PHASE_BEGIN
            FStoreBf16 f; f.O = WSP(bf16_t, R_F); f.ldc = 2048; f.pad_ = 0;
#if FP8_DN0
            ph_gemm8(lds, WSP(unsigned char, R_HID), 4096, WSP(unsigned char, W_DN0), 4096, NTOK, 2048, 4096, f, bid, nblk);
#else
            ph_gemm(lds, WSP(bf16_t, R_HID), 4096, WSP(bf16_t, W_DN0), 4096, NTOK, 2048, 4096, f, bid, nblk);
#endif
        PHASE_END
        PHASE_BEGIN
#if !((SKIPMASK >> 9) & 1)
            ph_resnorm<true, true>(xo, WSP(bf16_t, R_F), ffn_post_g + 0, mix_pre_g + 2048, xo, H, nullptr, bid, nblk);
#endif
        PHASE_END
    }
    {
#undef LAYER_CC
#undef LAYER_MX
#define LAYER_CC R_CC1
#define LAYER_MX R_M1
            PHASE_BEGIN
#if !((SKIPMASK >> 10) & 1)
                FCdIn f; f.CQ = WSP(float, R_CQ); f.CKV = WSP(float, R_CKV); f.KR = WSP(float, R_KR); f.XL = WSP(bf16_t, R_XL); f.YG = WSP(bf16_t, R_YG);
                ph_gemm(lds, H, 2048, WSP(bf16_t, W_CDIN), 2048, NTOK, 3072, 2048, f, bid, nblk);
#endif
            PHASE_END
            PHASE_BEGIN
#if !((SKIPMASK >> 11) & 1)
                ph_xc(WSP(bf16_t, R_XL), lru_conv_w, lru_conv_b, WSP(bf16_t, R_XCB), bid, nblk);
                ph_conv_lru(lru_wa, lru_wx, WSP(bf16_t, W_LRU), bid, nblk);
                ph_rmsnorm<512>(WSP(float, R_CQ), q_norm_g, WSP(bf16_t, R_CQN), bid, nblk);
                ph_rmsnorm<256>(WSP(float, R_CKV), kv_norm_g, WSP(bf16_t, R_CKVN), bid, nblk);
            PHASE_END
            PHASE_BEGIN
                { EpiLru ep; ep.XCB = WSP(bf16_t, R_XCB); ep.ba = lru_ba; ep.bx = lru_bx; ep.lam = lru_lambda; ep.LA = WSP(float, R_LA); ep.LB = WSP(float, R_LB);
                  ph_gemm_e(lds, WSP(bf16_t, R_XCB), 1024, WSP(bf16_t, W_LRU), 256, NTOK, 2048, 256, ep, bid, nblk, 1, 512); }
                { FStoreBf16 f; f.O = WSP(bf16_t, R_Q1); f.ldc = 1536; f.pad_ = 0; ph_gemm(lds, WSP(bf16_t, R_CQN), 512, WSP(bf16_t, W_QUP), 512, NTOK, 1536, 512, f, bid, nblk); }
                { FKvUp2 f; f.K8 = WSP(unsigned char, R_K1); f.VT = WSP(bf16_t, R_VT1); ph_gemm(lds, WSP(bf16_t, R_CKVN), 256, WSP(bf16_t, W_KVUP), 256, NTOK, 2048, 256, f, bid, nblk); }
            PHASE_END
            PHASE_BEGIN
                ph_scan1(WSP(float, R_LA), WSP(float, R_LB), WSP(float, R_CA), WSP(float, R_CH), bid, nblk);
                ph_rope_q(WSP(bf16_t, R_Q1), positions, WSP(unsigned char, R_Q8), bid, nblk);
                ph_rope_k(WSP(float, R_KR), positions, WSP(unsigned char, R_K1), bid, nblk);
            PHASE_END
            PHASE_BEGIN
                ph_scan2(WSP(float, R_CA), WSP(float, R_CH), WSP(float, R_CIN), bid, nblk);
            PHASE_END
            PHASE_BEGIN
                ph_scan3(WSP(float, R_LA), WSP(float, R_LB), WSP(float, R_CIN), WSP(bf16_t, R_YG), WSP(bf16_t, R_CC1), bid, nblk);
                AttnArgs a; a.Q = WSP(bf16_t, R_Q8); a.K = WSP(bf16_t, R_K1); a.VT = WSP(bf16_t, R_VT1); a.MT = nullptr; a.O = WSP(bf16_t, R_CC1); a.ldq = 1536; a.ldk = 1536; a.ldo = 2048;
                a.sc_log2e = 0.07216878364870322f * 1.4426950408889634f;
                attn_phase<192, false>(lds, a, bid, nblk);
#endif
            PHASE_END
        PHASE_BEGIN
#if !((SKIPMASK >> 15) & 1)
            FStoreBf16 f; f.O = Mx; f.ldc = 2048; f.pad_ = 0;
            ph_gemm(lds, CC, 2048, WSP(bf16_t, W_CDOUT), 2048, NTOK, 2048, 2048, f, bid, nblk);
#endif
        PHASE_END
        PHASE_BEGIN
#if !((SKIPMASK >> 16) & 1)
            ph_resnorm<true, true>(xo, Mx, mix_post_g + 2048, ffn_pre_g + 2048, WSP(bf16_t, R_X3), H, FP8_UP1 ? WSP(unsigned char, R_H) : (unsigned char*)nullptr, bid, nblk);
#endif
        PHASE_END
        PHASE_BEGIN
#if FP8_UP1
            { EpiGate<FP8_DN1 != 0, true> ep; ep.cw = ffn_conv_w + 24576; ep.cb = ffn_conv_b + 8192; ep.ACT = WSP(void, R_HID);
              ph_gemm_e(lds, (const bf16_t*)WSP(unsigned char, R_H), 1024, (const bf16_t*)WSP(unsigned char, W_UP1), 1024, 134 * 256, 8192, 1024, ep, bid, nblk, 0, 0, 1); }
#else
            { EpiGate<FP8_DN1 != 0, false> ep; ep.cw = ffn_conv_w + 24576; ep.cb = ffn_conv_b + 8192; ep.ACT = WSP(void, R_HID);
              ph_gemm_e(lds, H, 2048, WSP(bf16_t, W_UP1), 2048, 134 * 256, 8192, 2048, ep, bid, nblk, 0, 0, 1); }
#endif
        PHASE_END
        PHASE_BEGIN
            FStoreBf16 f; f.O = WSP(bf16_t, R_F); f.ldc = 2048; f.pad_ = 0;
#if FP8_DN1
            ph_gemm8(lds, WSP(unsigned char, R_HID), 4096, WSP(unsigned char, W_DN1), 4096, NTOK, 2048, 4096, f, bid, nblk);
#else
            ph_gemm(lds, WSP(bf16_t, R_HID), 4096, WSP(bf16_t, W_DN1), 4096, NTOK, 2048, 4096, f, bid, nblk);
#endif
        PHASE_END
        PHASE_BEGIN
#if !((SKIPMASK >> 20) & 1)
            ph_resnorm<true, false>(WSP(bf16_t, R_X3), WSP(bf16_t, R_F), ffn_post_g + 2048, (const float*)nullptr, xo, H, nullptr, bid, nblk);
#endif
        PHASE_END
    }
#undef LAYER_CC
#undef LAYER_MX
#undef WSP
#undef PHASE_BEGIN
#undef PHASE_END
}

#ifndef MK_N_LAUNCHES
#define MK_N_LAUNCHES 1
#endif
static constexpr int MK_NPHASES = 1 + 3 + 7 + 2 * 5;

extern "C" void kernel_launch(void* const* d_in, const int* in_sizes, int n_in, void* d_out, int out_size, void* d_ws, size_t ws_size, hipStream_t stream) {
    static int grid = 0;
    if (grid == 0) {
        if (n_in != 28 || out_size != NTOK * DM || ws_size < WS_NEED) { fprintf(stderr, "kernel_launch: unexpected shapes (n_in %d out %d ws %zu)\n", n_in, out_size, ws_size); grid = -1; return; }
        int dev = 0, cus = 0, per_cu = 0;
        if (hipGetDevice(&dev) != hipSuccess || hipDeviceGetAttribute(&cus, hipDeviceAttributeMultiprocessorCount, dev) != hipSuccess) { grid = -1; return; }
        if (hipFuncSetAttribute((const void*)k_mega, hipFuncAttributeMaxDynamicSharedMemorySize, MK_LDS) != hipSuccess) { fprintf(stderr, "kernel_launch: hipFuncSetAttribute failed\n"); grid = -1; return; }
        if (hipOccupancyMaxActiveBlocksPerMultiprocessor(&per_cu, (const void*)k_mega, 512, MK_LDS) != hipSuccess || per_cu < 1) { fprintf(stderr, "kernel_launch: occupancy query says %d\n", per_cu); }
        (void)hipGetLastError();
        grid = cus;
        if (grid != 256) { fprintf(stderr, "kernel_launch: built for 256 CUs, found %d\n", grid); grid = -1; return; }
    }
    if (grid < 0) return;
    unsigned char* ws = (unsigned char*)d_ws;
    (void)hipMemsetAsync(ws + WS_BAR, 0, XCD_BAR_WORDS * sizeof(unsigned), stream);
    (void)hipMemsetAsync(ws + W_ABIN + (size_t)5200 * 2048 * 2, 0, (size_t)176 * 2048 * 2, stream);
    (void)hipMemsetAsync(ws + W_CDIN + (size_t)832 * 2048 * 2, 0, (size_t)192 * 2048 * 2, stream);
    MK p{};
    for (int i = 0; i < 28; ++i) p.in[i] = (const float*)d_in[i];
    p.out = (float*)d_out; p.ws = ws;
#if MK_N_LAUNCHES == 1
    p.ph_lo = 0; p.ph_hi = 1 << 20;
    hipLaunchKernelGGL(k_mega, dim3(grid), dim3(512), MK_LDS, stream, p);
#else
    for (int ph = 0; ph < MK_NPHASES; ++ph) { p.ph_lo = ph; p.ph_hi = ph + 1; hipLaunchKernelGGL(k_mega, dim3(grid), dim3(512), MK_LDS, stream, p); }
#endif
}
```

```cpp
#include <hip/hip_runtime.h>
#include <stdint.h>
#include <stdio.h>

#define LAS __attribute__((address_space(3)))
typedef unsigned short bf16_t;
typedef float f32x4 __attribute__((ext_vector_type(4)));
typedef unsigned u32x4 __attribute__((ext_vector_type(4)));
typedef unsigned u32x2 __attribute__((ext_vector_type(2)));

static constexpr int NTOK = 32768, SEQ = 16384, NBATCH = 2, DM = 2048, DFF = 4096;
static constexpr float NORM_EPS = 1e-6f;

__device__ __forceinline__ bf16_t f2bf(float f) { unsigned u = __float_as_uint(f); u += 0x7FFFu + ((u >> 16) & 1u); return (bf16_t)(u >> 16); }
__device__ __forceinline__ float bf2f(bf16_t b) { return __uint_as_float(((unsigned)b) << 16); }
__device__ __forceinline__ unsigned pack2bf(float lo, float hi) { return (unsigned)f2bf(lo) | ((unsigned)f2bf(hi) << 16); }
__device__ __forceinline__ float gelu_tanh(float x) { const float u = 0.7978845608028654f * (x + 0.044715f * x * x * x); return 0.5f * x * (1.0f + tanhf(u)); }
__device__ __forceinline__ float wave_sum(float v) {
#pragma unroll
    for (int o = 32; o >= 1; o >>= 1) v += __shfl_xor(v, o);
    return v;
}

#ifndef TID_PLAIN
#define TID_PLAIN 0
#endif
static constexpr int TID_TAB_LDS = 162816 - 16 - 256;
#if TID_PLAIN
__device__ __forceinline__ int opaque_tid() { int t = (int)threadIdx.x; asm volatile("" : "+v"(t)); return t; }
#else
__device__ __forceinline__ int opaque_tid() {
    const unsigned slot = (unsigned)__builtin_amdgcn_s_getreg(((6 - 1) << 11) | 4) & 63u;
    const int w = __builtin_amdgcn_readfirstlane(*(const volatile LAS int*)(size_t)(TID_TAB_LDS + 4 * slot));
    int lane; asm volatile("v_mbcnt_lo_u32_b32 %0, -1, 0\n\tv_mbcnt_hi_u32_b32 %0, -1, %0" : "=v"(lane));
    return w * 64 + lane;
}
#endif

__device__ __forceinline__ int opaque_s(int v) { asm volatile("" : "+s"(v)); return v; }

template <class T> __device__ __forceinline__ const T* opaque_p(const T* p) { asm volatile("" : "+s"(p)); return p; }

#ifndef PG8_EPI_RECOMP
#define PG8_EPI_RECOMP 1
#endif
#ifndef PG8_ASM_DMA
#define PG8_ASM_DMA 1
#endif
#include <hip/hip_runtime.h>
namespace pg8 {
#define PG8_LAS __attribute__((address_space(3)))
typedef unsigned short bf16_t;
typedef short bf16x8 __attribute__((ext_vector_type(8)));
typedef float f32x4 __attribute__((ext_vector_type(4)));
typedef unsigned u32x4 __attribute__((ext_vector_type(4)));
typedef int i32x8 __attribute__((ext_vector_type(8)));
typedef int i32x4 __attribute__((ext_vector_type(4)));
constexpr int BM = 256, BK = 64, HALF = 128, HTB = HALF * BK * 2  , STAGE_BYTES = 8 * HTB, NXCD = 8, WGM = 8;

__host__ __device__ __forceinline__ int lds_byte(int r, int c) { const int st = (r >> 4) * 2 + (c >> 5), rr = r & 15, cc = c & 31, ob = rr * 64 + cc * 2; return st * 1024 + (ob ^ (((ob >> 9) & 1) << 5)); }
__host__ __device__ __forceinline__ void stage_rc(int b, int& R, int& C) { const int st = b / 1024, sb = b % 1024, swz = sb ^ (((sb >> 9) & 1) << 5); R = (st >> 1) * 16 + swz / 64; C = (st & 1) * 32 + (swz % 64) / 2; }
__host__ __device__ __forceinline__ int perm32(int rho) { const int n = rho >> 4, i = rho & 15; return 8 * (i >> 2) + 4 * n + (i & 3); }

struct Unit { int pm, pn; };
struct Gemm { const bf16_t* A; const bf16_t* Bt; int M, N, K, lda, ldb, a_shift, a_bytes, cmode; };

struct StaticOrder {
    int nM, nN, nwg, G, c;
    __host__ __device__ void init(int M, int N, int G_, int c_) { nM = M / BM; nN = N / BM; nwg = nM * nN; G = G_; c = c_; }
    __host__ __device__ bool next(int i, Unit& u) const {
        const long L = (long)i * G + c; if (L >= nwg) return false;
        int wgid = (int)L; { const int q = nwg / NXCD, r = nwg % NXCD, xcd = wgid % NXCD, off = wgid / NXCD; wgid = (xcd < r ? xcd * (q + 1) : r * (q + 1) + (xcd - r) * q) + off; }
        const int nig = WGM * nN, gid = wgid / nig, fm = gid * WGM, gsz = (nM - fm) < WGM ? (nM - fm) : WGM;
        u.pm = fm + ((wgid % nig) % gsz); u.pn = (wgid % nig) / gsz; return true;
    }
    __device__ __forceinline__ void a_ready(const Unit&) const {}
    __device__ __forceinline__ void done(const Unit&) const {}
};

template <class Epi, class Sched, bool STAMP = false>
__device__ __forceinline__ void gemm_phase(PG8_LAS unsigned char* lds, const Gemm g, const Sched& S, const Epi& E, unsigned long long* stamps) {
    const int tid = opaque_tid(), wid = __builtin_amdgcn_readfirstlane(tid >> 6), lane = tid & 63, wr = wid >> 2, wc = wid & 3, fr = lane & 15, fq = lane >> 4;
    const int K = g.K, nt = K / BK;
    int ts_lo = 0, ts_hi = 0, nts = 0; const unsigned long long rt_entry = STAMP ? (unsigned long long)wall_clock64() : 0ull;
#define PG8_STAMP() do { if (STAMP && wid == 0 && nts < 64) { const unsigned long long _c = (unsigned long long)clock64(); \
        ts_lo = (lane == nts) ? (int)(unsigned)_c : ts_lo; ts_hi = (lane == nts) ? (int)(unsigned)(_c >> 32) : ts_hi; ++nts; } } while (0)
    PG8_STAMP();
    unsigned voffA[2], voffB[2];
#pragma unroll
    for (int i = 0; i < 2; ++i) { int R, C; stage_rc(tid * 16 + i * 8192, R, C); const int Rb = Epi::PERM ? ((R & ~31) + perm32(R & 31)) : R;
        const int Ra = g.cmode ? (R - 2 * (R >> 6)) : R;
        voffA[i] = (unsigned)(Ra * g.lda + C) * 2u; voffB[i] = (unsigned)(Rb * g.ldb + C) * 2u; }
    const size_t kstep = (size_t)(BK * 2);
    const size_t hstepA = (size_t)(g.cmode ? HALF - 4 : HALF) * g.lda * 2, hstepB = (size_t)HALF * g.ldb * 2;
    const size_t tstepA = 2 * hstepA, tstepB = 2 * hstepB;
    const unsigned ldsbase_ = (unsigned)(size_t)lds;
    const int sc_w_ = 0x79797979, sc_a_ = 0x7F7F7F7F;
    (void)sc_w_; (void)sc_a_;
    const unsigned ldsw = (unsigned)wid * 1024u;
    const int aoff = lds_byte(wr * 64 + fr, fq * 8), boff = lds_byte(wc * 32 + fr, fq * 8);
#define PG8_SA(b, h) (((b) * 2 + (h)) * HTB)
#define PG8_SB(b, h) ((4 + (b) * 2 + (h)) * HTB)
#if PG8_ASM_DMA
#define PG8_STAGE(bufoff, gbase, voff) do { _Pragma("unroll") for (int _i = 0; _i < 2; ++_i) { unsigned keep_; \
        asm volatile("s_mov_b32 %0, m0\n\ts_mov_b32 m0, %3\n\ts_nop 0\n\tglobal_load_lds_dwordx4 %1, %2\n\ts_mov_b32 m0, %0" \
                     : "=&s"(keep_) : "v"((voff)[_i]), "s"((const char*)(gbase)), "s"(ldsbase_ + (unsigned)(bufoff) + ldsw + (unsigned)(_i * 8192)) : "memory"); } } while (0)
#else
#define PG8_STAGE(bufoff, gbase, voff) do { _Pragma("unroll") for (int _i = 0; _i < 2; ++_i) \
        __builtin_amdgcn_global_load_lds((const unsigned*)((const char*)(gbase) + (voff)[_i]), (PG8_LAS unsigned*)(lds + (bufoff) + ldsw + _i * 8192), 16, 0, 0); } while (0)
#endif
#define PG8_LDA(dst, b, h) do { _Pragma("unroll") for (int m = 0; m < 4; ++m) { dst[m].lo = *(const PG8_LAS i32x4*)(lds + PG8_SA(b, h) + aoff + m * 2048); dst[m].hi = *(const PG8_LAS i32x4*)(lds + PG8_SA(b, h) + aoff + m * 2048 + 1024); } } while (0)
#define PG8_LDB(dst, b, h) do { _Pragma("unroll") for (int n = 0; n < 2; ++n) { dst[n].lo = *(const PG8_LAS i32x4*)(lds + PG8_SB(b, h) + boff + n * 2048); dst[n].hi = *(const PG8_LAS i32x4*)(lds + PG8_SB(b, h) + boff + n * 2048 + 1024); } } while (0)
#define PG8_MMA(ai, bj, At, Bt) do { __builtin_amdgcn_s_setprio(1); \
        if constexpr (Epi::FP8) { _Pragma("unroll") for (int m = 0; m < 4; ++m) _Pragma("unroll") for (int n = 0; n < 2; ++n) \
            asm volatile("v_mfma_scale_f32_16x16x128_f8f6f4 %0, %1, %2, %0, %3, %4 op_sel_hi:[0,0,0]" : "+v"(acc[ai][bj][m][n]) : "v"(Bt[n]), "v"(At[m]), "v"(sc_w_), "v"(sc_a_)); } \
        else { _Pragma("unroll") for (int m = 0; m < 4; ++m) _Pragma("unroll") for (int n = 0; n < 2; ++n) { \
            const i32x4 bl_ = Bt[n].lo, bh_ = Bt[n].hi, al_ = At[m].lo, ah_ = At[m].hi;     \
            acc[ai][bj][m][n] = __builtin_amdgcn_mfma_f32_16x16x32_bf16(__builtin_bit_cast(bf16x8, bl_), __builtin_bit_cast(bf16x8, al_), acc[ai][bj][m][n], 0, 0, 0); \
            acc[ai][bj][m][n] = __builtin_amdgcn_mfma_f32_16x16x32_bf16(__builtin_bit_cast(bf16x8, bh_), __builtin_bit_cast(bf16x8, ah_), acc[ai][bj][m][n], 0, 0, 0); } } \
        __builtin_amdgcn_s_setprio(0); } while (0)
#define PG8_WAIT_V(n) asm volatile("s_waitcnt vmcnt(" #n ")" ::: "memory")
#define PG8_WAIT_L(n) asm volatile("s_waitcnt lgkmcnt(" #n ")" ::: "memory")
#define PG8_BAR __builtin_amdgcn_s_barrier()
#define PG8_SCHED __builtin_amdgcn_sched_barrier(0)
    Unit cur, nxt; int ui = 0;
    if (!S.next(0, cur)) return;
    f32x4 acc[2][2][4][2];
#pragma unroll
    for (int a = 0; a < 2; ++a)
#pragma unroll
        for (int b = 0; b < 2; ++b)
#pragma unroll
            for (int m = 0; m < 4; ++m)
#pragma unroll
                for (int n = 0; n < 2; ++n) acc[a][b][m][n] = (f32x4){0.f, 0.f, 0.f, 0.f};
    i32x8 At[4], B0[2], B1[2];
    auto a_base_ = [&](const Unit& u_) -> const char* { return g.cmode ? (const char*)g.A + ((long)(u_.pm / 67) * 16384 + (long)(u_.pm % 67) * 248 - 2) * (long)g.lda * 2 : (const char*)g.A + (size_t)u_.pm * tstepA + (size_t)(u_.pn >> g.a_shift) * g.a_bytes; };
    const char* cA = a_base_(cur); const char* cB = (const char*)g.Bt + (size_t)cur.pn * tstepB;
    S.a_ready(cur);
    PG8_STAGE(PG8_SB(0, 0), cB, voffB); PG8_STAGE(PG8_SA(0, 0), cA, voffA); PG8_STAGE(PG8_SB(0, 1), cB + hstepB, voffB); PG8_STAGE(PG8_SA(0, 1), cA + hstepA, voffA);
    if (wr == 1) PG8_BAR;
    PG8_WAIT_V(4); PG8_BAR;
    PG8_STAGE(PG8_SB(1, 0), cB + kstep, voffB); PG8_STAGE(PG8_SA(1, 0), cA + kstep, voffA); PG8_STAGE(PG8_SB(1, 1), cB + hstepB + kstep, voffB);
    PG8_WAIT_V(6); PG8_BAR;
    PG8_STAMP();
    for (;;) {
        const bool has_next = S.next(ui + 1, nxt);
        const char* nA = has_next ? a_base_(nxt) : cA; const char* nB = has_next ? (const char*)g.Bt + (size_t)nxt.pn * tstepB : cB;
        for (int t = 0; t < nt; t += 2) {
            const bool last = (t == nt - 2);
            const char* a1 = cA + (size_t)(t + 1) * kstep;
            const char* a2 = last ? nA : cA + (size_t)(t + 2) * kstep; const char* b2 = last ? nB : cB + (size_t)(t + 2) * kstep;
            const char* a3 = a2 + kstep; const char* b3 = b2 + kstep;
            if (last && has_next) S.a_ready(nxt);
            PG8_LDB(B0, 0, 0); PG8_SCHED; PG8_LDA(At, 0, 0); PG8_STAGE(PG8_SA(1, 1), a1 + hstepA, voffA);
            PG8_WAIT_L(8); PG8_BAR; PG8_WAIT_L(0); PG8_MMA(0, 0, At, B0); PG8_BAR; PG8_SCHED;
            PG8_LDB(B1, 0, 1); PG8_STAGE(PG8_SB(0, 0), b2, voffB);
            PG8_BAR; PG8_WAIT_L(0); PG8_MMA(0, 1, At, B1); PG8_BAR;
            PG8_LDA(At, 0, 1); PG8_STAGE(PG8_SA(0, 0), a2, voffA);
            PG8_BAR; PG8_WAIT_L(0); PG8_MMA(1, 0, At, B0); PG8_BAR; PG8_SCHED;
            PG8_STAGE(PG8_SB(0, 1), b2 + hstepB, voffB);
            PG8_WAIT_V(6); PG8_BAR; PG8_MMA(1, 1, At, B1); PG8_BAR;
            PG8_LDB(B0, 1, 0); PG8_SCHED; PG8_LDA(At, 1, 0); PG8_STAGE(PG8_SA(0, 1), a2 + hstepA, voffA);
            PG8_WAIT_L(8); PG8_BAR; PG8_WAIT_L(0); PG8_MMA(0, 0, At, B0); PG8_BAR; PG8_SCHED;
            PG8_LDB(B1, 1, 1); PG8_STAGE(PG8_SB(1, 0), b3, voffB);
            PG8_BAR; PG8_WAIT_L(0); PG8_MMA(0, 1, At, B1); PG8_BAR;
            PG8_LDA(At, 1, 1); PG8_STAGE(PG8_SA(1, 0), a3, voffA);
            PG8_BAR; PG8_WAIT_L(0); PG8_MMA(1, 0, At, B0); PG8_BAR; PG8_SCHED;
            PG8_STAGE(PG8_SB(1, 1), b3 + hstepB, voffB);
            PG8_WAIT_V(6); PG8_BAR; PG8_MMA(1, 1, At, B1); PG8_BAR;
        }
        PG8_STAMP();
        if constexpr (Epi::FP8) { asm volatile("s_nop 15\n\ts_nop 15" ::: "memory"); }
        if constexpr (!Epi::AFTER_DRAIN) {
#if PG8_EPI_RECOMP
            const int t2_ = opaque_tid(), l2_ = t2_ & 63, w2_ = __builtin_amdgcn_readfirstlane(t2_ >> 6);
            E(acc, cur, w2_ >> 2, w2_ & 3, l2_ & 15, l2_ >> 4); S.done(cur);
#else
            E(acc, cur, wr, wc, fr, fq); S.done(cur);
#endif
        }
        PG8_STAMP();
        if (!has_next) break;
#pragma unroll
        for (int a = 0; a < 2; ++a)
#pragma unroll
            for (int b = 0; b < 2; ++b)
#pragma unroll
                for (int m = 0; m < 4; ++m)
#pragma unroll
                    for (int n = 0; n < 2; ++n) acc[a][b][m][n] = (f32x4){0.f, 0.f, 0.f, 0.f};
        cur = nxt; cA = nA; cB = nB; ++ui;
    }
    PG8_WAIT_V(0);
    if (wr == 0) PG8_BAR;
    PG8_BAR;
    if constexpr (Epi::AFTER_DRAIN) { E.fused(acc, cur, wr, wc, fr, fq, lds, wid, lane); S.done(cur); }
    PG8_STAMP();
    if (STAMP && wid == 0) { stamps[lane] = lane < nts ? (((unsigned long long)(unsigned)ts_hi << 32) | (unsigned)ts_lo) : 0ull;
        if (lane == 62) stamps[62] = rt_entry; if (lane == 63) stamps[63] = (unsigned long long)wall_clock64(); }
#undef PG8_STAMP
#undef PG8_SA
#undef PG8_SB
#undef PG8_STAGE
#undef PG8_LDA
#undef PG8_LDB
#undef PG8_MMA
#undef PG8_WAIT_V
#undef PG8_WAIT_L
#undef PG8_BAR
#undef PG8_SCHED
}
}

#include <cstdio>
#include <ctime>
#include <cstdlib>
#include <cstring>
#include <cmath>
#include <vector>

template <class F, bool F8 = false> struct EpiG {
    static constexpr bool PERM = false, AFTER_DRAIN = false, FP8 = F8;
    F f;
    __device__ __forceinline__ void operator()(const f32x4 (&acc)[2][2][4][2], const pg8::Unit& u, int wr, int wc, int fr, int fq) const {
        const int row0 = u.pm * 256 + wr * 64 + fr, col0 = u.pn * 256 + wc * 32 + 4 * fq;
#pragma unroll
        for (int ai = 0; ai < 2; ++ai)
#pragma unroll
            for (int m = 0; m < 4; ++m)
#pragma unroll
                for (int bj = 0; bj < 2; ++bj)
#pragma unroll
                    for (int n = 0; n < 2; ++n) f(row0 + ai * 128 + m * 16, col0 + bj * 128 + n * 16, acc[ai][bj][m][n]);
    }
};
__device__ __forceinline__ void st_bf16x4(bf16_t* p, f32x4 v) { u32x2 w; w.x = pack2bf(v[0], v[1]); w.y = pack2bf(v[2], v[3]); *(u32x2*)p = w; }
__device__ __forceinline__ void st_f32x4(float* p, f32x4 v) { *(f32x4*)p = v; }

struct FStoreBf16 { bf16_t* O; int ldc; int pad_; __device__ __forceinline__ void operator()(int r, int c, f32x4 v) const { st_bf16x4(O + (size_t)r * ldc + c, v); } };
struct FAbIn { bf16_t *Q, *K, *V; float *QI, *U, *WI; unsigned short* KI16;
    __device__ __forceinline__ void operator()(int r, int c, f32x4 v) const {
        if (c < 1024) st_bf16x4(Q + (size_t)r * 1024 + c, v);
        else if (c < 2048) st_bf16x4(K + (size_t)r * 1024 + (c - 1024), v);
        else if (c < 3072) st_bf16x4(V + (size_t)r * 1024 + (c - 2048), v);
        else if (c < 4096) st_f32x4(QI + (size_t)r * 1024 + (c - 3072), v);
        else if (c < 5120) st_f32x4(U + (size_t)r * 1024 + (c - 4096), v);
        else if (c < 5184) { typedef _Float16 h2 __attribute__((ext_vector_type(2))); union { h2 h; unsigned u; } a, b; a.h = (h2){(_Float16)v[0], (_Float16)v[1]}; b.h = (h2){(_Float16)v[2], (_Float16)v[3]};
            u32x2 w; w.x = a.u; w.y = b.u; *(u32x2*)(KI16 + (size_t)r * 64 + (c - 5120)) = w; }
        else if (c < 5200) st_f32x4(WI + (size_t)r * 16 + (c - 5184), v);
    } };
struct FCdIn { float *CQ, *CKV, *KR; bf16_t *XL, *YG;
    __device__ __forceinline__ void operator()(int r, int c, f32x4 v) const {
        if (c < 512) st_f32x4(CQ + (size_t)r * 512 + c, v);
        else if (c < 768) st_f32x4(CKV + (size_t)r * 256 + (c - 512), v);
        else if (c < 832) st_f32x4(KR + (size_t)r * 64 + (c - 768), v);
        else if (c < 1024) {}
        else if (c < 2048) st_bf16x4(XL + (size_t)r * 1024 + (c - 1024), v);
        else st_bf16x4(YG + (size_t)r * 1024 + (c - 2048), v);
    } };
struct FKvUp { bf16_t *K1, *V1;
    __device__ __forceinline__ void operator()(int r, int c, f32x4 v) const {
        const int h = c >> 8, d = c & 255;
        if (d < 128) st_bf16x4(K1 + (size_t)r * 1536 + h * 192 + d, v);
        else st_bf16x4(V1 + (size_t)r * 1024 + h * 128 + (d - 128), v);
    } };

__device__ __forceinline__ unsigned ord_key(float f) { const unsigned b = __float_as_uint(f); return (b & 0x80000000u) ? ~b : (b | 0x80000000u); }
__device__ __forceinline__ void rope_cs(int pos, int i, float& c, float& s) { const float freq = powf(10000.0f, -(float)i / 32.0f); const float ang = (float)pos * freq; sincosf(ang, &s, &c); }
#define PV8_MLA 1
#define PV8_DSA 1

typedef short bf16x8 __attribute__((ext_vector_type(8)));
typedef float f32x16 __attribute__((ext_vector_type(16)));
__device__ __forceinline__ unsigned cvtpk(float lo, float hi) { unsigned r; asm("v_cvt_pk_bf16_f32 %0, %1, %2" : "=v"(r) : "v"(lo), "v"(hi)); return r; }
__device__ __forceinline__ float max3_asm(float a, float b, float c) { float r; asm("v_max3_f32 %0, %1, %2, %3" : "=v"(r) : "v"(a), "v"(b), "v"(c)); return r; }

struct AttnArgs { const bf16_t* Q; const bf16_t* K; const bf16_t* VT; const unsigned long long* MT; bf16_t* O; int ldq, ldk, ldo; float sc_log2e; };

static constexpr int ATT_MTBL = 65536;
struct TTrue { static constexpr bool value = true; }; struct TFalse { static constexpr bool value = false; };
typedef int i32x8q __attribute__((ext_vector_type(8)));
typedef int i32x4q __attribute__((ext_vector_type(4)));
#define MFMA8_FENCE2(acc0, acc1, srcA, srcB) asm volatile("s_nop 15\n\ts_nop 9" : "+v"(acc0), "+v"(acc1) : "v"(srcA), "v"(srcB))
#define MFMA8_FENCE4(a0_, a1_, a2_, a3_, srcA, srcB) asm volatile("s_nop 15\n\ts_nop 9" : "+v"(a0_), "+v"(a1_), "+v"(a2_), "+v"(a3_) : "v"(srcA), "v"(srcB))
template <int DQK, bool MASKED, bool QK8>
__device__ __forceinline__ void attn_item3(LAS unsigned char* lds, const AttnArgs& a, int b, int h, int qb) {
    constexpr int NKS = QK8 ? DQK / 64 : DQK / 16, PK = QK8 ? DQK : DQK * 2, PV = 64, KB_BYTES = 64 * PK, VB_BYTES = 128 * PV, NPK = PK / 16, NKP = (64 * NPK + 511) / 512, V_OFF = 3 * KB_BYTES;
    const int tid = opaque_tid(), lane = tid & 63, w = __builtin_amdgcn_readfirstlane(tid >> 6), n = lane & 31, hf = lane >> 5;
    const int nt = 4 * qb + 4, cw = 4 * qb + (w >> 1);
    const int trow = qb * 256 + w * 32 + n;
    const size_t grow = (size_t)b * SEQ + trow;
    bf16x8 qf[QK8 ? 1 : NKS]; i32x8q q8[QK8 ? NKS : 1];
    if (QK8) { const unsigned char* qp = (const unsigned char*)a.Q + grow * a.ldq + h * DQK + hf * 32;
#pragma unroll
      for (int ks = 0; ks < NKS; ++ks) { q8[ks].lo = *(const i32x4q*)(qp + ks * 64); q8[ks].hi = *(const i32x4q*)(qp + ks * 64 + 16); } }
    else { const bf16_t* qp = a.Q + grow * a.ldq + h * DQK + hf * 8;
#pragma unroll
      for (int ks = 0; ks < NKS; ++ks) qf[ks] = *(const bf16x8*)(qp + ks * 16); }
    f32x16 o[4];
#pragma unroll
    for (int dt = 0; dt < 4; ++dt)
#pragma unroll
        for (int r = 0; r < 16; ++r) o[dt][r] = 0.f;
    float m_run = MASKED ? -1000.0f : -INFINITY, l_run = 0.f;
    const float c = a.sc_log2e;
    const unsigned char* Kg = (const unsigned char*)a.K + ((size_t)b * SEQ * a.ldk + h * DQK) * (QK8 ? 1 : 2);
    const unsigned char* Vg = (const unsigned char*)a.VT + (size_t)(b * 8 + h) * 128 * SEQ;
    const unsigned long long* Mg = MASKED ? a.MT + (size_t)b * 256 * SEQ + trow : nullptr;
    auto dma_k = [&](int kt) {
        LAS unsigned char* kb = lds + (kt % 3) * KB_BYTES;
#pragma unroll
        for (int i = 0; i < NKP; ++i) { if ((w + 8 * i) * 64 >= 64 * NPK) break;
            const int s = (w + 8 * i) * 64 + lane, r = s / NPK, cp = s % NPK, cc = cp ^ (NPK == 16 ? (r & 15) : (NPK == 12 ? ((r >> 2) & 3) : ((r >> 1) & 7)));
            __builtin_amdgcn_global_load_lds((const unsigned*)(Kg + ((size_t)(kt * 64 + r) * a.ldk) * (QK8 ? 1 : 2) + cc * 16), (LAS unsigned*)(kb + (w + 8 * i) * 1024), 16, 0, 0); }
    };
    auto dma_v = [&](int kt) {
        LAS unsigned char* vb = lds + V_OFF + (kt & 1) * VB_BYTES;
        const int s = w * 64 + lane, d = s >> 2, cp = s & 3, cc = cp ^ ((d >> 2) & 3);
        __builtin_amdgcn_global_load_lds((const unsigned*)(Vg + (size_t)d * SEQ + kt * 64 + cc * 16), (LAS unsigned*)(vb + w * 1024), 16, 0, 0);
    };
    const int kswz = (NPK == 16) ? (n & 15) : (NPK == 12 ? ((n >> 2) & 3) : ((n >> 1) & 7)), vswz = (n >> 2) & 3;
    auto qk = [&](int kt, f32x16& s0, f32x16& s1, bool fence) {
        const LAS unsigned char* ka = lds + (kt % 3) * KB_BYTES + n * PK;
#pragma unroll
        for (int r = 0; r < 16; ++r) { s0[r] = 0.f; s1[r] = 0.f; }
        if (QK8) {
#pragma unroll
            for (int ks = 0; ks < NKS; ++ks) {
                const int p0 = ((4 * ks + 2 * hf) ^ kswz) * 16, p1 = ((4 * ks + 2 * hf + 1) ^ kswz) * 16;
                i32x8q a0, a1;
                a0.lo = *(const LAS i32x4q*)(ka + p0); a0.hi = *(const LAS i32x4q*)(ka + p1);
                a1.lo = *(const LAS i32x4q*)(ka + 32 * PK + p0); a1.hi = *(const LAS i32x4q*)(ka + 32 * PK + p1);
                s0 = __builtin_amdgcn_mfma_scale_f32_32x32x64_f8f6f4(a0, q8[ks], s0, 0, 0, 0, 0x7F7F7F7F, 0, 0x7F7F7F7F);
                s1 = __builtin_amdgcn_mfma_scale_f32_32x32x64_f8f6f4(a1, q8[ks], s1, 0, 0, 0, 0x7F7F7F7F, 0, 0x7F7F7F7F);
                if (ks == NKS - 1 && fence) MFMA8_FENCE2(s0, s1, a0, a1);
            }
        } else {
#pragma unroll
            for (int ks = 0; ks < NKS; ++ks) {
                const int po = ((2 * ks + hf) ^ kswz) * 16;
                const bf16x8 a0 = *(const LAS bf16x8*)(ka + po), a1 = *(const LAS bf16x8*)(ka + 32 * PK + po);
                s0 = __builtin_amdgcn_mfma_f32_32x32x16_bf16(a0, qf[ks], s0, 0, 0, 0);
                s1 = __builtin_amdgcn_mfma_f32_32x32x16_bf16(a1, qf[ks], s1, 0, 0, 0);
            }
        }
    };
    i32x8q idA0, idA1;
#pragma unroll
    for (int i = 0; i < 8; ++i) { const int v = (i == (n >> 2)) ? (0x38 << (8 * (n & 3))) : 0; idA0[i] = hf ? 0 : v; idA1[i] = hf ? v : 0; }
    auto maskmma = [&](unsigned long long mw, f32x16& s0, f32x16& s1, bool fence) {
        if (MASKED) {
            const unsigned bits = hf ? (unsigned)(mw >> 32) : (unsigned)mw;
            const LAS u32x2* tbl = (const LAS u32x2*)(lds + ATT_MTBL);
            i32x8q bm;
#pragma unroll
            for (int i = 0; i < 4; ++i) { const u32x2 t = tbl[(bits >> (8 * i)) & 255u]; bm[2 * i] = (int)t.x; bm[2 * i + 1] = (int)t.y; }
            s0 = __builtin_amdgcn_mfma_scale_f32_32x32x64_f8f6f4(idA0, bm, s0, 0, 0, 0, 0x7F7F7F7F, 0, (int)0x82828282);
            s1 = __builtin_amdgcn_mfma_scale_f32_32x32x64_f8f6f4(idA1, bm, s1, 0, 0, 0, 0x7F7F7F7F, 0, (int)0x82828282);
            MFMA8_FENCE2(s0, s1, idA1, bm);
        }
    };
    auto rowmax = [&](f32x16& s0, f32x16& s1) -> float {
        float mx = max3_asm(s0[0], s1[0], s0[1]);
        mx = max3_asm(mx, s1[1], s0[2]);
#pragma unroll
        for (int r = 2; r < 15; ++r) mx = max3_asm(mx, s1[r], s0[r + 1]);
        mx = max3_asm(mx, s1[15], mx);
        const auto rr = __builtin_amdgcn_permlane32_swap(__float_as_uint(mx), __float_as_uint(mx), false, false);
        return fmaxf(__uint_as_float(rr[0]), __uint_as_float(rr[1]));
    };
    auto pv = [&](const f32x16& c0, const f32x16& c1, int kt, bool fence) {
        i32x8q pb;
#pragma unroll
        for (int i = 0; i < 4; ++i) { int d0 = 0, d1 = 0;
            d0 = __builtin_amdgcn_cvt_pk_fp8_f32(c0[4 * i], c0[4 * i + 1], d0, false); d0 = __builtin_amdgcn_cvt_pk_fp8_f32(c0[4 * i + 2], c0[4 * i + 3], d0, true);
            d1 = __builtin_amdgcn_cvt_pk_fp8_f32(c1[4 * i], c1[4 * i + 1], d1, false); d1 = __builtin_amdgcn_cvt_pk_fp8_f32(c1[4 * i + 2], c1[4 * i + 3], d1, true);
            pb[i] = d0; pb[4 + i] = d1; }
        const LAS unsigned char* va = lds + V_OFF + (kt & 1) * VB_BYTES + n * PV;
        const int q0_ = ((2 * hf) ^ vswz) * 16, q1_ = ((2 * hf + 1) ^ vswz) * 16;
#pragma unroll
        for (int dt = 0; dt < 4; ++dt) { i32x8q vf; vf.lo = *(const LAS i32x4q*)(va + dt * 32 * PV + q0_); vf.hi = *(const LAS i32x4q*)(va + dt * 32 * PV + q1_);
            o[dt] = __builtin_amdgcn_mfma_scale_f32_32x32x64_f8f6f4(vf, pb, o[dt], 0, 0, 0, 0x7F7F7F7F, 0, 0x79797979);
            if (dt == 3) MFMA8_FENCE4(o[0], o[1], o[2], o[3], vf, pb); }
    };
    dma_k(0); dma_v(0); if (nt > 1) dma_k(1);
    unsigned long long mw_pre = MASKED ? Mg[(size_t)(nt > 1 ? 1 : 0) * SEQ] : 0ull;
    asm volatile("s_waitcnt vmcnt(0)" ::: "memory");
    __syncthreads();
    f32x16 sa0, sa1, sb0, sb1;
    qk(0, sa0, sa1, true); maskmma(MASKED ? Mg[0] : 0ull, sa0, sa1, true);
    float mx_cur = rowmax(sa0, sa1);
    auto step = [&](int kt, f32x16& c0, f32x16& c1, f32x16& n0, f32x16& n1, auto full_tag) {
        constexpr bool FULL = decltype(full_tag)::value;
        if (kt + 2 < nt) dma_k(kt + 2);
        if (kt + 1 < nt) dma_v(kt + 1);
        const unsigned long long mw_now = mw_pre;
        if (MASKED) mw_pre = Mg[(size_t)(kt + 2 < nt ? kt + 2 : kt) * SEQ];
        const bool act = FULL || kt <= cw, actn = FULL || kt + 1 <= cw;
        const float m_new = fmaxf(m_run, mx_cur);
        const float m_use = (MASKED && m_new == -INFINITY) ? 0.f : m_new;
        if (act && __any(m_new > m_run)) {
            const float al = __builtin_amdgcn_exp2f((m_run - m_use) * c);
            l_run *= al;
#pragma unroll
            for (int dt = 0; dt < 4; ++dt)
#pragma unroll
                for (int r = 0; r < 16; ++r) o[dt][r] *= al;
        }
        if (act) m_run = m_new;
        if (FULL) {
            qk(kt + 1, n0, n1, !MASKED); maskmma(mw_now, n0, n1, true);
            const float mc = m_use * c - 6.0f;
            float ps = 0.f;
#pragma unroll
            for (int r = 0; r < 16; ++r) { c0[r] = __builtin_amdgcn_exp2f(fmaf(c0[r], c, -mc)); c1[r] = __builtin_amdgcn_exp2f(fmaf(c1[r], c, -mc)); ps += c0[r] + c1[r]; }
            l_run += ps;
            pv(c0, c1, kt, true);
            mx_cur = rowmax(n0, n1);
        } else {
            if (actn) { qk(kt + 1, n0, n1, true); maskmma(mw_now, n0, n1, true); }
            if (act) {
                const float mc = m_use * c - 6.0f;
                float ps = 0.f;
#pragma unroll
                for (int r = 0; r < 16; ++r) { c0[r] = __builtin_amdgcn_exp2f(fmaf(c0[r], c, -mc)); c1[r] = __builtin_amdgcn_exp2f(fmaf(c1[r], c, -mc)); ps += c0[r] + c1[r]; }
                l_run += ps;
                pv(c0, c1, kt, true);
            }
            if (actn) mx_cur = rowmax(n0, n1);
        }
        asm volatile("s_waitcnt vmcnt(0)" ::: "memory");
        __syncthreads();
    };
    int kt = 0;
    for (; kt < 4 * qb; kt += 2) { step(kt, sa0, sa1, sb0, sb1, TTrue{}); step(kt + 1, sb0, sb1, sa0, sa1, TTrue{}); }
    for (; kt < nt; kt += 2) { step(kt, sa0, sa1, sb0, sb1, TFalse{}); step(kt + 1, sb0, sb1, sa0, sa1, TFalse{}); }
    const float lt = l_run + __shfl_xor(l_run, 32);
    const float inv = 64.0f / lt;
    bf16_t* op = a.O + grow * a.ldo + h * 128 + hf * 4;
#pragma unroll
    for (int dt = 0; dt < 4; ++dt)
#pragma unroll
        for (int r4 = 0; r4 < 4; ++r4) { u32x2 wv; wv.x = cvtpk(o[dt][4 * r4] * inv, o[dt][4 * r4 + 1] * inv); wv.y = cvtpk(o[dt][4 * r4 + 2] * inv, o[dt][4 * r4 + 3] * inv);
            *(u32x2*)(op + dt * 32 + r4 * 8) = wv; }
}
template <int DQK, bool MASKED>
__device__ __forceinline__ void attn_phase(LAS unsigned char* lds, const AttnArgs& a, int bid, int nblk) {
    if (MASKED) {
        const int t = opaque_tid();
        if (t < 256) { unsigned lo = 0u, hi = 0u;
#pragma unroll
            for (int i = 0; i < 4; ++i) { if (!((t >> i) & 1)) lo |= 0xFEu << (8 * i); if (!((t >> (4 + i)) & 1)) hi |= 0xFEu << (8 * i); }
            u32x2 v; v.x = lo; v.y = hi; ((LAS u32x2*)(lds + ATT_MTBL))[t] = v; }
        __syncthreads();
    }
    for (int p = bid; p < 512; p += nblk) {
        const int bh = (p & 7) + 8 * (p >> 8), j = (p >> 3) & 31;
#pragma unroll 1
        for (int i = 0; i < 2; ++i) attn_item3<DQK, MASKED, true>(lds, a, bh >> 3, bh & 7, i ? j : 63 - j);
    }
}

#ifdef IDX_PROBE_FINAL
#define IDX_PF_ 1
#else
#define IDX_PF_ 0
#endif
typedef _Float16 f16x8 __attribute__((ext_vector_type(8)));
struct IdxArgs { const float* QI; const unsigned short* KI16; const float* WI; unsigned long long* MT; };
static constexpr int IDX_CAP = 640, IDX_CS = 0, IDX_CI = 32 * IDX_CAP * 4, IDX_KT = IDX_CI + 32 * IDX_CAP * 2, IDX_CNT = IDX_KT + 32768, IDX_TAU = IDX_CNT + 128, IDX_LDS = IDX_TAU + 128;
static_assert(IDX_KT % 1024 == 0, "K tile buffers must be 1 KiB aligned");

__device__ __forceinline__ float ord_inv(unsigned T) { return __uint_as_float((T & 0x80000000u) ? (T & 0x7FFFFFFFu) : ~T); }
__device__ __forceinline__ unsigned lane_prefix(unsigned long long m) { return __builtin_amdgcn_mbcnt_hi((unsigned)(m >> 32), __builtin_amdgcn_mbcnt_lo((unsigned)m, 0u)); }
__device__ __forceinline__ float relu_asm(float x) { float y; asm("v_max_f32 %0, 0, %1" : "=v"(y) : "v"(x)); return y; }
__device__ __forceinline__ void glds16(const void* gsrc, unsigned lds_dst) {
    unsigned keep;
    asm volatile("s_mov_b32 %0, m0\n\ts_mov_b32 m0, %2\n\ts_nop 0\n\tglobal_load_lds_dwordx4 %1, off\n\ts_mov_b32 m0, %0" : "=&s"(keep) : "v"(gsrc), "s"(lds_dst) : "memory");
}

template <bool EXACT> __device__ __forceinline__ int idx_compact(LAS unsigned char* lds, int qq, int lane, int n, float& tau) {
    LAS float* cs = (LAS float*)(lds + IDX_CS) + qq * IDX_CAP; LAS unsigned short* ci = (LAS unsigned short*)(lds + IDX_CI) + qq * IDX_CAP;
    float sv[10]; unsigned short iv[10]; unsigned uk[10];
#pragma unroll
    for (int j = 0; j < 10; ++j) { const int idx = lane + 64 * j; const bool valid = idx < n; sv[j] = cs[idx]; iv[j] = ci[idx]; uk[j] = valid ? ord_key(sv[j]) : 0u; }
    auto count_ge = [&](unsigned t) { int c = 0;
#pragma unroll
        for (int j = 0; j < 10; ++j) c += __builtin_popcountll(__ballot(uk[j] >= t));
        return c; };
    unsigned lo = ord_key(tau), hi = 0xFF800001u;
    if (lo > 0x80800000u) { const unsigned h2 = lo + 0x00800000u;
        if (h2 < hi) { if (count_ge(h2) >= 256) lo = h2; else hi = h2; } }
    while (hi - lo > 1u) {
        const unsigned mid = lo + ((hi - lo) >> 1); const int c = count_ge(mid);
        if (c >= 256) { lo = mid; if (!EXACT && c <= 336) break; } else hi = mid;
    }
    const unsigned T = lo;
    int need = 0;
    if (EXACT) { int ngt = 0;
#pragma unroll
        for (int j = 0; j < 10; ++j) ngt += __builtin_popcountll(__ballot(uk[j] > T));
        need = 256 - ngt; }
    int base = 0, tiebase = 0;
#pragma unroll
    for (int j = 0; j < 10; ++j) {
        bool keep;
        if (EXACT) { const bool gt = uk[j] > T, eq = uk[j] == T; const unsigned long long em = __ballot(eq); keep = gt || (eq && (tiebase + (int)lane_prefix(em)) < need); tiebase += __builtin_popcountll(em); }
        else keep = uk[j] >= T;
        const unsigned long long km = __ballot(keep);
        const int pos = base + (int)lane_prefix(km);
        if (keep) { cs[pos] = sv[j]; ci[pos] = iv[j]; }
        base += __builtin_popcountll(km);
    }
    tau = ord_inv(T);
    return base;
}

__device__ __forceinline__ void idx_item(LAS unsigned char* lds, const IdxArgs& a, int b, int hc) {
    const int tid = opaque_tid(), lane = tid & 63, w = __builtin_amdgcn_readfirstlane(tid >> 6), n = lane & 31, hf = lane >> 5;
    const int t0 = hc * 32, L = (t0 / 64 + 1) * 64, nsub = L / 32, ntile = (L + 127) / 128;
    const size_t q0 = (size_t)b * SEQ + t0 + 4 * w;
    LAS float* cs = (LAS float*)(lds + IDX_CS); LAS unsigned short* ci = (LAS unsigned short*)(lds + IDX_CI);
    LAS unsigned* cnt = (LAS unsigned*)(lds + IDX_CNT);
    f16x8 qf[2][4];
#pragma unroll
    for (int rt = 0; rt < 2; ++rt) { const float* qp = a.QI + (q0 + 2 * rt + (n >> 4)) * 1024 + (n & 15) * 64 + hf * 8;
#pragma unroll
        for (int ks = 0; ks < 4; ++ks) { const f32x4 x0 = *(const f32x4*)(qp + ks * 16), x1 = *(const f32x4*)(qp + ks * 16 + 4);
            f16x8 v; v[0] = (_Float16)x0[0]; v[1] = (_Float16)x0[1]; v[2] = (_Float16)x0[2]; v[3] = (_Float16)x0[3]; v[4] = (_Float16)x1[0]; v[5] = (_Float16)x1[1]; v[6] = (_Float16)x1[2]; v[7] = (_Float16)x1[3];
            qf[rt][ks] = v; } }
    float wv[2][16];
#pragma unroll
    for (int rt = 0; rt < 2; ++rt)
#pragma unroll
        for (int r = 0; r < 16; ++r) wv[rt][r] = a.WI[(q0 + 2 * rt + (r >> 3)) * 16 + (((r & 3) + 8 * (r >> 2) + 4 * hf) & 15)] * (0.125f * 0.25f);
    if (tid < 32) cnt[tid] = 0u;
    int cq0 = 0, cq1 = 0, cq2 = 0, cq3 = 0;
    float tq0 = -INFINITY, tq1 = -INFINITY, tq2 = -INFINITY, tq3 = -INFINITY;
    float tau0 = INFINITY, tau1 = INFINITY;
    const unsigned short* Kg = a.KI16 + (size_t)b * SEQ * 64;
    const unsigned ldsbase = (unsigned)(size_t)lds;
    auto dma = [&](int kt, int buf) {
#pragma unroll
        for (int i = 0; i < 2; ++i) { const int s = (w + 8 * i) * 64 + lane, r = s >> 3, cp = s & 7, cc = cp ^ ((r >> 1) & 7);
            glds16(Kg + (size_t)(kt * 128 + r) * 64 + cc * 8, ldsbase + IDX_KT + buf * 16384 + (w + 8 * i) * 1024); }
    };
    dma(0, 0);
    asm volatile("s_waitcnt vmcnt(0)" ::: "memory");
    __syncthreads();
    const int kswz = (n >> 1) & 7;
    f32x16 accA[2], accB[2];
#pragma unroll
    for (int rt = 0; rt < 2; ++rt)
#pragma unroll
        for (int r = 0; r < 16; ++r) { accA[rt][r] = 0.f; accB[rt][r] = 0.f; }
    int keyA = 0, keyB = 0;
    auto epilogue = [&](const f32x16 (&acc)[2], int key) {
        float sc[2];
#pragma unroll
        for (int rt = 0; rt < 2; ++rt) { float pa = 0.f, pb = 0.f;
#pragma unroll
            for (int r = 0; r < 8; ++r) { pa = fmaf(relu_asm(acc[rt][r]), wv[rt][r], pa); pb = fmaf(relu_asm(acc[rt][r + 8]), wv[rt][r + 8], pb); }
            const auto rr = __builtin_amdgcn_permlane32_swap(__float_as_uint(pa), __float_as_uint(pb), false, false);
            sc[rt] = __uint_as_float(rr[0]) + __uint_as_float(rr[1]); }
        const bool c0 = sc[0] > tau0, c1 = sc[1] > tau1;
        const unsigned long long m0 = __ballot(c0), m1 = __ballot(c1);
        if (m0 | m1) {
            const unsigned l0 = (unsigned)m0, h0 = (unsigned)(m0 >> 32), l1 = (unsigned)m1, h1 = (unsigned)(m1 >> 32);
            const int p0 = hf ? cq1 + (int)__builtin_amdgcn_mbcnt_hi(h0, 0u) : cq0 + (int)__builtin_amdgcn_mbcnt_lo(l0, 0u);
            const int p1 = hf ? cq3 + (int)__builtin_amdgcn_mbcnt_hi(h1, 0u) : cq2 + (int)__builtin_amdgcn_mbcnt_lo(l1, 0u);
            if (c0 && p0 < IDX_CAP) { const int qq = 4 * w + hf; cs[qq * IDX_CAP + p0] = sc[0]; ci[qq * IDX_CAP + p0] = (unsigned short)key; }
            if (c1 && p1 < IDX_CAP) { const int qq = 4 * w + 2 + hf; cs[qq * IDX_CAP + p1] = sc[1]; ci[qq * IDX_CAP + p1] = (unsigned short)key; }
            cq0 += __builtin_popcount(l0); cq1 += __builtin_popcount(h0); cq2 += __builtin_popcount(l1); cq3 += __builtin_popcount(h1);
        }
    };
    auto mma = [&](f32x16 (&acc)[2], const LAS unsigned char* kr) {
        f16x8 kf[4];
#pragma unroll
        for (int ks = 0; ks < 4; ++ks) kf[ks] = *(const LAS f16x8*)(kr + ((2 * ks + hf) ^ kswz) * 16);
#pragma unroll
        for (int rt = 0; rt < 2; ++rt) {
            f32x16 c;
#pragma unroll
            for (int r = 0; r < 16; ++r) c[r] = 0.f;
#pragma unroll
            for (int ks = 0; ks < 4; ++ks) c = __builtin_amdgcn_mfma_f32_32x32x16_f16(qf[rt][ks], kf[ks], c, 0, 0, 0);
            acc[rt] = c; }
    };
#ifdef IDX_PROBE2
  for (int rep_ = 0; rep_ < 2; ++rep_) {
    if (rep_ == 1) { epilogue(accB, keyB); tau0 = INFINITY; tau1 = INFINITY; __syncthreads(); dma(0, 0); asm volatile("s_waitcnt vmcnt(0)" ::: "memory"); __syncthreads(); }
#endif
    for (int kt = 0; kt < ntile; ++kt) {
        if (kt + 1 < ntile) dma(kt + 1, (kt + 1) & 1);
#ifdef IDX_PROBE2
        if (rep_ == 0)
#endif
        { const unsigned c_all = cnt[lane & 31];
          if (__ballot(c_all > (unsigned)(IDX_CAP - 160))) {
              if (cq0 > 400) cq0 = idx_compact<false>(lds, 4 * w + 0, lane, cq0, tq0);
              if (cq1 > 400) cq1 = idx_compact<false>(lds, 4 * w + 1, lane, cq1, tq1);
              if (cq2 > 400) cq2 = idx_compact<false>(lds, 4 * w + 2, lane, cq2, tq2);
              if (cq3 > 400) cq3 = idx_compact<false>(lds, 4 * w + 3, lane, cq3, tq3);
              if (kt > 0) { tau0 = hf ? tq1 : tq0; tau1 = hf ? tq3 : tq2; }
          } }
        const LAS unsigned char* kb = lds + IDX_KT + (kt & 1) * 16384 + n * 128;
        const int sbase = kt * 4;
#ifdef IDX_PROBE2
        if (sbase + 0 < nsub) { mma(accA, kb); epilogue(accB, keyB); keyA = kt * 128 + n; if (kt == 0 && rep_ == 0) { tau0 = -INFINITY; tau1 = -INFINITY; } }
#else
        if (sbase + 0 < nsub) { mma(accA, kb); epilogue(accB, keyB); keyA = kt * 128 + n; if (kt == 0) { tau0 = -INFINITY; tau1 = -INFINITY; } }
#endif
        if (sbase + 1 < nsub) { mma(accB, kb + 32 * 128); epilogue(accA, keyA); keyB = kt * 128 + 32 + n; }
        if (sbase + 2 < nsub) { mma(accA, kb + 64 * 128); epilogue(accB, keyB); keyA = kt * 128 + 64 + n; }
        if (sbase + 3 < nsub) { mma(accB, kb + 96 * 128); epilogue(accA, keyA); keyB = kt * 128 + 96 + n; }
        if (lane < 4) cnt[4 * w + lane] = (unsigned)(lane == 0 ? cq0 : (lane == 1 ? cq1 : (lane == 2 ? cq2 : cq3)));
        asm volatile("s_waitcnt vmcnt(0)" ::: "memory");
        __syncthreads();
    }
#ifdef IDX_PROBE2
  }
#endif
    epilogue(accB, keyB);
    __syncthreads();
    LAS unsigned* bm = (LAS unsigned*)(lds + IDX_KT) + w * 512;
#ifdef IDX_PROBE_FINAL
  for (int rep2_ = 0; rep2_ < 2; ++rep2_) {
#endif
    if (cq0 > 256 - IDX_PF_) cq0 = idx_compact<true>(lds, 4 * w + 0, lane, cq0, tq0);
    if (cq1 > 256 - IDX_PF_) cq1 = idx_compact<true>(lds, 4 * w + 1, lane, cq1, tq1);
    if (cq2 > 256 - IDX_PF_) cq2 = idx_compact<true>(lds, 4 * w + 2, lane, cq2, tq2);
    if (cq3 > 256 - IDX_PF_) cq3 = idx_compact<true>(lds, 4 * w + 3, lane, cq3, tq3);
#pragma unroll 1
    for (int i = 0; i < 4; ++i) {
        const int qq = 4 * w + i;
        const int nsel = (i == 0) ? cq0 : ((i == 1) ? cq1 : ((i == 2) ? cq2 : cq3));
#pragma unroll
        for (int j = 0; j < 8; ++j) bm[lane + 64 * j] = 0u;
#pragma unroll
        for (int j = 0; j < 4; ++j) { const int idx = lane + 64 * j; if (idx < nsel) { const unsigned k = ci[qq * IDX_CAP + idx]; (void)__hip_atomic_fetch_or(bm + (k >> 5), 1u << (k & 31), __ATOMIC_RELAXED, __HIP_MEMORY_SCOPE_WORKGROUP); } }
        const int tq = t0 + qq;
#pragma unroll 1
        for (int kt = lane; kt < L / 64; kt += 64) { const unsigned long long v = (unsigned long long)bm[2 * kt] | ((unsigned long long)bm[2 * kt + 1] << 32); a.MT[((size_t)b * 256 + kt) * SEQ + tq] = v; }
    }
#ifdef IDX_PROBE_FINAL
  }
#endif
    __syncthreads();
}
__device__ __forceinline__ void idx_phase(LAS unsigned char* lds, const IdxArgs& a, int bid, int nblk) {
    for (int k = bid; k < 256; k += nblk) {
#pragma unroll 1
        for (int i = 0; i < 4; ++i) idx_item(lds, a, i & 1, (i < 2) ? 511 - k : k);
    }
}
#define XB_TMO      128
#define XB_XCNT(j)  (256  + 64 * (j))
#define XB_XSUB(j)  (1280 + 64 * (j))
#define XB_XGEN(j)  (2304 + 64 * (j))
#define XB_TOP      3328
#define XB_TOPGEN   3392
#define XCD_BAR_WORDS 3456
#define XB_SPIN_CAP (1u << 23)


__device__ __forceinline__ unsigned xb_ld(unsigned* p)              { return __hip_atomic_load(p, __ATOMIC_RELAXED, __HIP_MEMORY_SCOPE_AGENT); }
__device__ __forceinline__ unsigned xb_add(unsigned* p, unsigned v) { return __hip_atomic_fetch_add(p, v, __ATOMIC_RELAXED, __HIP_MEMORY_SCOPE_AGENT); }
__device__ __forceinline__ unsigned xb_xcc_id() { return (unsigned)__builtin_amdgcn_s_getreg((3 << 11) | 20) & 0xFu; }
#define XB_SPIN(cond, bar) do { unsigned _sp = 0; while (cond) { __builtin_amdgcn_s_sleep(1); \
    if ((++_sp & 255u) == 0u) { if (xb_ld(&(bar)[XB_TMO])) break; if (_sp > XB_SPIN_CAP) { atomicAdd(&(bar)[XB_TMO], 1u); break; } } } } while (0)

struct XcdBarrier {
    unsigned* bar; unsigned x;
    volatile LAS unsigned* st;
};

__device__ __forceinline__ XcdBarrier xcd_barrier_post(unsigned* bar, volatile LAS unsigned* st) {
    XcdBarrier b; b.bar = bar; b.x = xb_xcc_id(); b.st = st;
    if (threadIdx.x == 0) (void)xb_add(&bar[XB_XCNT(b.x)], 1u);
    return b;
}
__device__ __forceinline__ void xcd_barrier_complete(unsigned* bar, unsigned x, unsigned& nloc, unsigned& nx) {
    const unsigned G = gridDim.x * gridDim.y * gridDim.z;
    unsigned sum, cnt, mine, sp = 0u;
    for (;;) {
        sum = 0u; cnt = 0u; mine = 0u;
#pragma unroll
        for (unsigned j = 0; j < 16; ++j) { const unsigned c = xb_ld(&bar[XB_XCNT(j)]); sum += c; cnt += (c > 0u) ? 1u : 0u; mine = (j == x) ? c : mine; }
        if (sum == G) break;
        __builtin_amdgcn_s_sleep(1);
        if ((++sp & 255u) == 0u) { if (xb_ld(&bar[XB_TMO])) break; if (sp > XB_SPIN_CAP) { atomicAdd(&bar[XB_TMO], 1u); break; } }
    }
    nloc = mine > 0u ? mine : 1u; nx = cnt > 0u ? cnt : 1u;
}

__device__ __forceinline__ void xcd_barrier(const XcdBarrier& b) {
    asm volatile("s_waitcnt vmcnt(0)" ::: "memory");
    __syncthreads();
    if (threadIdx.x == 0) {
        unsigned* bar = b.bar;
        __builtin_amdgcn_s_waitcnt(0);
        unsigned nloc = b.st[0], nx = b.st[1];
        if (nloc == 0u) { xcd_barrier_complete(bar, b.x, nloc, nx); b.st[0] = nloc; b.st[1] = nx; }
        const unsigned old = xb_add(&bar[XB_XSUB(b.x)], 1u);
        const unsigned gen = old / nloc;
        if (old + 1u == (gen + 1u) * nloc) {
            __builtin_amdgcn_fence(__ATOMIC_RELEASE, "agent");
            asm volatile("s_waitcnt vmcnt(0)" ::: "memory");
            const unsigned og = xb_add(&bar[XB_TOP], 1u);
            const unsigned tg = og / nx;
            if (og + 1u == (tg + 1u) * nx) xb_add(&bar[XB_TOPGEN], 1u);
            else XB_SPIN(xb_ld(&bar[XB_TOPGEN]) == tg, bar);
            __builtin_amdgcn_fence(__ATOMIC_ACQUIRE, "agent");
            xb_add(&bar[XB_XGEN(b.x)], 1u);
            asm volatile("s_waitcnt vmcnt(0)" ::: "memory");
        } else {
            XB_SPIN(xb_ld(&bar[XB_XGEN(b.x)]) == gen, bar);
            __builtin_amdgcn_fence(__ATOMIC_ACQUIRE, "agent");
            asm volatile("s_waitcnt vmcnt(0)" ::: "memory");
        }
    }
    __syncthreads();
}

#ifndef FP8_QKV
#define FP8_QKV 1
#endif
#ifndef FP8_UP0
#define FP8_UP0 0
#endif
#ifndef FP8_UP1
#define FP8_UP1 1
#endif
#ifndef FP8_DN0
#define FP8_DN0 0
#endif
#ifndef FP8_DN1
#define FP8_DN1 1
#endif
#ifndef SKIPMASK
#define SKIPMASK 0
#endif

__device__ __forceinline__ int perm16(int t) { const int a = (t >> 2) & 3; return (t & ~12) | ((a == 1 ? 2 : (a == 2 ? 1 : a)) << 2); }
__device__ __forceinline__ void st_vt16(bf16_t* VT, int row, int h, int d, f32x4 v) {
    const int b = row / SEQ, t = row % SEQ; bf16_t* p = VT + ((size_t)(b * 8 + h) * 128 + d) * SEQ + (t & ~15) + perm16(t & 15);
    p[0] = f2bf(v[0]); p[SEQ] = f2bf(v[1]); p[2 * (size_t)SEQ] = f2bf(v[2]); p[3 * (size_t)SEQ] = f2bf(v[3]);
}
__device__ __forceinline__ int perm64(int kk) { const int sub = kk >> 5, k5 = kk & 31; return 32 * ((k5 >> 2) & 1) + 16 * sub + (((k5 >> 3) << 2) | (k5 & 3)); }
__device__ __forceinline__ void st_vt8(bf16_t* VT_, int row, int h, int d, f32x4 v) {
    const int b = row / SEQ, t = row % SEQ; unsigned char* p = (unsigned char*)VT_ + ((size_t)(b * 8 + h) * 128 + d) * SEQ + (t & ~63) + perm64(t & 63);
    const int pk0 = __builtin_amdgcn_cvt_pk_fp8_f32(v[0], v[1], 0, false), pk1 = __builtin_amdgcn_cvt_pk_fp8_f32(v[2], v[3], 0, false);
    p[0] = (unsigned char)(pk0 & 0xFF); p[SEQ] = (unsigned char)((pk0 >> 8) & 0xFF); p[2 * (size_t)SEQ] = (unsigned char)(pk1 & 0xFF); p[3 * (size_t)SEQ] = (unsigned char)((pk1 >> 8) & 0xFF);
}
__device__ __forceinline__ void st_fp8x4(unsigned char* p, f32x4 v) { int pk = 0; pk = __builtin_amdgcn_cvt_pk_fp8_f32(v[0], v[1], pk, false); pk = __builtin_amdgcn_cvt_pk_fp8_f32(v[2], v[3], pk, true); *(int*)p = pk; }
struct FAbIn2 { unsigned char *Q, *K; bf16_t* VT; float *QI, *U, *WI; unsigned short* KI16;
    __device__ __forceinline__ void operator()(int r, int c, f32x4 v) const {
        if (c < 1024) st_fp8x4(Q + (size_t)r * 1024 + c, v);
        else if (c < 2048) st_fp8x4(K + (size_t)r * 1024 + (c - 1024), v);
        else if (c < 3072) { if (PV8_DSA) st_vt8(VT, r, (c - 2048) >> 7, (c - 2048) & 127, v); else st_vt16(VT, r, (c - 2048) >> 7, (c - 2048) & 127, v); }
        else if (c < 4096) st_f32x4(QI + (size_t)r * 1024 + (c - 3072), v);
        else if (c < 5120) st_f32x4(U + (size_t)r * 1024 + (c - 4096), v);
        else if (c < 5184) { typedef _Float16 h2 __attribute__((ext_vector_type(2))); union { h2 h; unsigned u; } a, b; a.h = (h2){(_Float16)v[0], (_Float16)v[1]}; b.h = (h2){(_Float16)v[2], (_Float16)v[3]};
            u32x2 w; w.x = a.u; w.y = b.u; *(u32x2*)(KI16 + (size_t)r * 64 + (c - 5120)) = w; }
        else if (c < 5200) st_f32x4(WI + (size_t)r * 16 + (c - 5184), v);
    } };
struct FAbInHi { FAbIn2 f; __device__ __forceinline__ void operator()(int r, int c, f32x4 v) const { f(r, c + 3072, v); } };
struct FKvUp2 { unsigned char* K8; bf16_t* VT;
    __device__ __forceinline__ void operator()(int r, int c, f32x4 v) const {
        const int h = c >> 8, d = c & 255;
        if (d < 128) { int pk = 0; pk = __builtin_amdgcn_cvt_pk_fp8_f32(v[0], v[1], pk, false); pk = __builtin_amdgcn_cvt_pk_fp8_f32(v[2], v[3], pk, true); *(int*)(K8 + (size_t)r * 1536 + h * 192 + d) = pk; }
        else { if (PV8_MLA) st_vt8(VT, r, h, d - 128, v); else st_vt16(VT, r, h, d - 128, v); }
    } };

template <class E> __device__ __forceinline__ void ph_gemm_e(LAS unsigned char* lds, const bf16_t* A, int lda, const bf16_t* Bt, int ldb, int M, int N, int K, const E& e, int bid, int nblk, int a_shift = 0, int a_bytes = 0, int cmode = 0) {
    pg8::Gemm g; g.A = A; g.Bt = Bt; g.M = M; g.N = N; g.K = K; g.lda = lda; g.ldb = ldb; g.a_shift = a_shift; g.a_bytes = a_bytes; g.cmode = cmode;
    pg8::StaticOrder S; S.init(M, N, nblk, bid);
    pg8::gemm_phase<E, pg8::StaticOrder, false>(lds, g, S, e, nullptr);
    __syncthreads();
}
template <class F> __device__ __forceinline__ void ph_gemm(LAS unsigned char* lds, const bf16_t* A, int lda, const bf16_t* Bt, int ldb, int M, int N, int K, const F& f, int bid, int nblk, int a_shift = 0, int a_bytes = 0) {
    EpiG<F> e; e.f = f;
    ph_gemm_e(lds, A, lda, Bt, ldb, M, N, K, e, bid, nblk, a_shift, a_bytes);
}
template <class F> __device__ __forceinline__ void ph_gemm8(LAS unsigned char* lds, const unsigned char* A, int lda, const unsigned char* Bt, int ldb, int M, int N, int K, const F& f, int bid, int nblk) {
    EpiG<F, true> e; e.f = f;
    ph_gemm_e(lds, (const bf16_t*)A, lda / 2, (const bf16_t*)Bt, ldb / 2, M, N, K / 2, e, bid, nblk, 0, 0);
}
__device__ __forceinline__ float dpp_ror1(float v) { return __int_as_float(__builtin_amdgcn_update_dpp(0, __float_as_int(v), 0x121, 0xF, 0xF, false)); }
__device__ __forceinline__ float dpp_ror2(float v) { return __int_as_float(__builtin_amdgcn_update_dpp(0, __float_as_int(v), 0x122, 0xF, 0xF, false)); }
__device__ __forceinline__ float dpp_shr1(float old, float v) { return __int_as_float(__builtin_amdgcn_update_dpp(__float_as_int(old), __float_as_int(v), 0x111, 0xF, 0xF, false)); }
__device__ __forceinline__ float dpp_shr2(float old, float v) { return __int_as_float(__builtin_amdgcn_update_dpp(__float_as_int(old), __float_as_int(v), 0x112, 0xF, 0xF, false)); }
__device__ __forceinline__ float gelu_fast(float x) { const float u2 = 1.5957691216057308f * (x + 0.044715f * x * x * x); return x * __builtin_amdgcn_rcpf(1.0f + __builtin_amdgcn_exp2f(-1.4426950408889634f * u2)); }
template <bool OUT8, bool F8> struct EpiGate {
    static constexpr bool PERM = false, AFTER_DRAIN = false, FP8 = F8;
    const float* cw; const float* cb; void* ACT;
    __device__ __forceinline__ void operator()(const f32x4 (&acc)[2][2][4][2], const pg8::Unit& u, int wr, int wc, int fr, int fq) const {
        const int bt = u.pm / 67, ti = u.pm % 67;
#pragma unroll
        for (int n = 0; n < 2; ++n) {
            const int c = u.pn * 128 + wc * 32 + 16 * n + 4 * fq;
            const f32x4 g0 = *(const f32x4*)(cw + c), g1 = *(const f32x4*)(cw + 8192 + c), g2 = *(const f32x4*)(cw + 16384 + c), gb = *(const f32x4*)(cb + c);
            const f32x4 v0 = *(const f32x4*)(cw + 4096 + c), v1 = *(const f32x4*)(cw + 8192 + 4096 + c), v2 = *(const f32x4*)(cw + 16384 + 4096 + c), vb = *(const f32x4*)(cb + 4096 + c);
#pragma unroll
            for (int ai = 0; ai < 2; ++ai) {
                const int strip = 2 * ai + wr, tbase = ti * 248 + strip * 62 - 2;
                f32x4 pg = {0.f, 0.f, 0.f, 0.f}, pv = pg;
#pragma unroll
                for (int m = 0; m < 4; ++m) {
                    f32x4 xg = acc[ai][0][m][n], xv = acc[ai][1][m][n];
                    const int t = tbase + 16 * m + fr;
                    if (t < 0) { xg = (f32x4){0.f, 0.f, 0.f, 0.f}; xv = xg; }
                    f32x4 og, ov;
#pragma unroll
                    for (int j = 0; j < 4; ++j) {
                        const float gp1 = dpp_shr1(dpp_ror1(pg[j]), xg[j]), gp2 = dpp_shr2(dpp_ror2(pg[j]), xg[j]);
                        const float vp1 = dpp_shr1(dpp_ror1(pv[j]), xv[j]), vp2 = dpp_shr2(dpp_ror2(pv[j]), xv[j]);
                        og[j] = gb[j] + g0[j] * gp2 + g1[j] * gp1 + g2[j] * xg[j];
                        ov[j] = vb[j] + v0[j] * vp2 + v1[j] * vp1 + v2[j] * xv[j];
                        og[j] = gelu_fast(og[j]) * ov[j];
                    }
                    pg = xg; pv = xv;
                    if (16 * m + fr >= 2 && t < SEQ) {
                        const size_t o = ((size_t)bt * SEQ + t) * 4096 + c;
                        if (OUT8) { int pk = 0; pk = __builtin_amdgcn_cvt_pk_fp8_f32(og[0], og[1], pk, false); pk = __builtin_amdgcn_cvt_pk_fp8_f32(og[2], og[3], pk, true); *(int*)((unsigned char*)ACT + o) = pk; }
                        else st_bf16x4((bf16_t*)ACT + o, og);
                    }
                }
            }
        }
    }
};
struct FPool { bf16_t* CC; const float* pb; const float* ps;
    __device__ __forceinline__ void operator()(int r, int c, f32x4 v) const { const f32x4 b = *(const f32x4*)(pb + c), s = *(const f32x4*)(ps + c); st_bf16x4(CC + (size_t)r * 2048 + 1024 + c, (v + b) * s); } };
struct EpiLru {
    static constexpr bool PERM = false, AFTER_DRAIN = false, FP8 = false;
    const bf16_t* XCB; const float *ba, *bx, *lam; bf16_t *LA, *LB;
    __device__ __forceinline__ void operator()(const f32x4 (&acc)[2][2][4][2], const pg8::Unit& u, int wr, int wc, int fr, int fq) const {
        const int row0 = u.pm * 256 + wr * 64 + fr;
#pragma unroll
        for (int n = 0; n < 2; ++n) {
            const int ch = u.pn * 128 + wc * 32 + 16 * n + 4 * fq;
            const f32x4 bav = *(const f32x4*)(ba + ch), bxv = *(const f32x4*)(bx + ch), lm = *(const f32x4*)(lam + ch);
            f32x4 sp;
#pragma unroll
            for (int j = 0; j < 4; ++j) sp[j] = log1pf(__expf(-lm[j]));
#pragma unroll
            for (int ai = 0; ai < 2; ++ai)
#pragma unroll
                for (int m = 0; m < 4; ++m) {
                    const int row = row0 + ai * 128 + m * 16;
                    const u32x2 xw = *(const u32x2*)(XCB + (size_t)row * 1024 + ch);
                    const f32x4 xc = {__uint_as_float(xw.x << 16), __uint_as_float(xw.x & 0xFFFF0000u), __uint_as_float(xw.y << 16), __uint_as_float(xw.y & 0xFFFF0000u)};
                    const f32x4 ga = acc[ai][0][m][n] + bav, gx = acc[ai][1][m][n] + bxv;
                    f32x4 av, bv;
#pragma unroll
                    for (int j = 0; j < 4; ++j) {
                        const float rg = 1.0f / (1.0f + __expf(-ga[j])), ig = 1.0f / (1.0f + __expf(-gx[j]));
                        const float log_a = -8.0f * rg * sp[j], a = __expf(log_a), mult = sqrtf(-expm1f(2.0f * log_a));
                        av[j] = -expm1f(log_a); bv[j] = mult * (ig * xc[j]); (void)a;
                    }
                    st_bf16x4(LA + (size_t)row * 1024 + ch, av); st_bf16x4(LB + (size_t)row * 1024 + ch, bv);
                }
        }
    }
};
__device__ __forceinline__ void ph_pooled(const float* __restrict__ U, bf16_t* __restrict__ P, int bid, int nblk) {
    for (int i = bid * 512 + opaque_tid(); i < 256 * (NTOK / 64); i += nblk * 512) {
        const int c4 = i & 255, row0 = (i >> 8) * 64, t0 = row0 % SEQ, g = c4 >> 6, win = 2 << g;
        const f32x4* up = (const f32x4*)U + (size_t)row0 * 256 + c4;
        f32x4 s = {0.f, 0.f, 0.f, 0.f};
        if (t0 > 0) { for (int k = 1; k < win; ++k) s += up[-(ptrdiff_t)k * 256]; }
#pragma unroll 8
        for (int r = 0; r < 64; ++r) {
            const int t = t0 + r; const f32x4 u0 = up[(ptrdiff_t)r * 256];
            s += u0;
            const int cnt = (t + 1 < win) ? (t + 1) : win;
            st_bf16x4(P + (size_t)(row0 + r) * 1024 + c4 * 4, s * (1.0f / (float)cnt) - u0);
            if (t + 1 >= win) s -= up[(ptrdiff_t)(r + 1 - win) * 256];
        }
    }
}
__device__ __forceinline__ void ph_xc(const bf16_t* __restrict__ XL, const float* __restrict__ cw, const float* __restrict__ cb, bf16_t* __restrict__ XCB, int bid, int nblk) {
    for (int i = bid * 512 + opaque_tid(); i < 128 * (NTOK / 32); i += nblk * 512) {
        const int c8 = (i & 127) * 8, row0 = (i >> 7) * 32, t0 = row0 % SEQ;
        float w0[8], w1[8], w2[8], w3[8], bb[8];
#pragma unroll
        for (int j = 0; j < 8; ++j) { w0[j] = cw[c8 + j]; w1[j] = cw[1024 + c8 + j]; w2[j] = cw[2048 + c8 + j]; w3[j] = cw[3072 + c8 + j]; bb[j] = cb[c8 + j]; }
        u32x4 p3 = {0u, 0u, 0u, 0u}, p2 = p3, p1 = p3;
        if (t0 >= 3) { p3 = *(const u32x4*)(XL + (size_t)(row0 - 3) * 1024 + c8); p2 = *(const u32x4*)(XL + (size_t)(row0 - 2) * 1024 + c8); p1 = *(const u32x4*)(XL + (size_t)(row0 - 1) * 1024 + c8); }
#pragma unroll 8
        for (int r = 0; r < 32; ++r) {
            const u32x4 cur = *(const u32x4*)(XL + (size_t)(row0 + r) * 1024 + c8);
            const unsigned a3[4] = {p3.x, p3.y, p3.z, p3.w}, a2[4] = {p2.x, p2.y, p2.z, p2.w}, a1[4] = {p1.x, p1.y, p1.z, p1.w}, a0[4] = {cur.x, cur.y, cur.z, cur.w};
            float y[8];
#pragma unroll
            for (int j = 0; j < 4; ++j) {
                y[2 * j] = bb[2 * j] + w0[2 * j] * __uint_as_float(a3[j] << 16) + w1[2 * j] * __uint_as_float(a2[j] << 16) + w2[2 * j] * __uint_as_float(a1[j] << 16) + w3[2 * j] * __uint_as_float(a0[j] << 16);
                y[2 * j + 1] = bb[2 * j + 1] + w0[2 * j + 1] * __uint_as_float(a3[j] & 0xFFFF0000u) + w1[2 * j + 1] * __uint_as_float(a2[j] & 0xFFFF0000u) + w2[2 * j + 1] * __uint_as_float(a1[j] & 0xFFFF0000u) + w3[2 * j + 1] * __uint_as_float(a0[j] & 0xFFFF0000u); }
            u32x4 o; o.x = pack2bf(y[0], y[1]); o.y = pack2bf(y[2], y[3]); o.z = pack2bf(y[4], y[5]); o.w = pack2bf(y[6], y[7]);
            *(u32x4*)(XCB + (size_t)(row0 + r) * 1024 + c8) = o;
            p3 = p2; p2 = p1; p1 = cur;
        }
    }
}
__device__ __forceinline__ int up_src_col(int n0) { return ((n0 >> 7) & 1) * 4096 + (n0 >> 8) * 128 + (n0 & 127); }
template <bool OUT8>
__device__ __forceinline__ void ph_convT_g(LAS unsigned char* lds, const float* __restrict__ W, int ldw, int src_col0, int ncols, int K, void* __restrict__ Bt, int ldd, int bid, int nblk, bool upperm) {
    const int tid = opaque_tid(), sub = tid >> 8, t8 = tid & 255;
    LAS float* tile = (LAS float*)lds + sub * (64 * 65);
    const int ntx = (ncols + 63) / 64, ntiles = ntx * (K / 64);
    for (int base = bid * 2; base < ntiles; base += nblk * 2) {
        const int tl = base + sub; const bool act = tl < ntiles;
        const int n0 = (tl % ntx) * 64, k0 = (tl / ntx) * 64;
        if (act) {
            const int c4 = (t8 & 15) * 4, kr = t8 >> 4;
            const int nsrc = src_col0 + (upperm ? up_src_col(n0 + c4) : n0 + c4);
#pragma unroll
            for (int i = 0; i < 4; ++i) { const int kl = kr + 16 * i;
                f32x4 v = {0.f, 0.f, 0.f, 0.f};
                if (n0 + c4 < ncols) v = *(const f32x4*)(W + (size_t)(k0 + kl) * ldw + nsrc);
                tile[kl * 65 + c4] = v[0]; tile[kl * 65 + c4 + 1] = v[1]; tile[kl * 65 + c4 + 2] = v[2]; tile[kl * 65 + c4 + 3] = v[3]; } }
        __syncthreads();
        if (act) {
            const int k8 = (t8 & 7) * 8, nr = t8 >> 3;
#pragma unroll
            for (int i = 0; i < 2; ++i) { const int nl = nr + 32 * i;
                if (n0 + nl < ncols) {
                    float v[8];
#pragma unroll
                    for (int j = 0; j < 8; ++j) v[j] = tile[(k8 + j) * 65 + nl];
                    if (OUT8) { int p0 = 0, p1 = 0;
                        p0 = __builtin_amdgcn_cvt_pk_fp8_f32(64.f * v[0], 64.f * v[1], p0, false); p0 = __builtin_amdgcn_cvt_pk_fp8_f32(64.f * v[2], 64.f * v[3], p0, true);
                        p1 = __builtin_amdgcn_cvt_pk_fp8_f32(64.f * v[4], 64.f * v[5], p1, false); p1 = __builtin_amdgcn_cvt_pk_fp8_f32(64.f * v[6], 64.f * v[7], p1, true);
                        u32x2 o; o.x = (unsigned)p0; o.y = (unsigned)p1; *(u32x2*)((unsigned char*)Bt + (size_t)(n0 + nl) * ldd + k0 + k8) = o; }
                    else { u32x4 o; o.x = pack2bf(v[0], v[1]); o.y = pack2bf(v[2], v[3]); o.z = pack2bf(v[4], v[5]); o.w = pack2bf(v[6], v[7]);
                        *(u32x4*)((bf16_t*)Bt + (size_t)(n0 + nl) * ldd + k0 + k8) = o; }
                } } }
        __syncthreads();
    }
}
__device__ __forceinline__ void ph_convT(LAS unsigned char* lds, const float* __restrict__ W, int ldw, int src_col0, int ncols, int K, bf16_t* __restrict__ Bt, int ldd, int bid, int nblk, bool upperm = false) {
    ph_convT_g<false>(lds, W, ldw, src_col0, ncols, K, Bt, ldd, bid, nblk, upperm);
}
__device__ __forceinline__ void ph_convT8(LAS unsigned char* lds, const float* __restrict__ W, int ldw, int ncols, int K, unsigned char* __restrict__ Bt, int bid, int nblk, bool upperm = false) {
    ph_convT_g<true>(lds, W, ldw, 0, ncols, K, Bt, K, bid, nblk, upperm);
}
template <int NC> __device__ __forceinline__ void ph_rmsnorm(const float* __restrict__ x, const float* __restrict__ g, bf16_t* __restrict__ out, int bid, int nblk, unsigned char* __restrict__ out8 = nullptr) {
    const int lane = opaque_tid() & 63, w = opaque_tid() >> 6;
    constexpr int NV = NC / 256;
    for (int row = bid * 8 + w; row < NTOK; row += nblk * 8) {
        const f32x4* xr = (const f32x4*)(x + (size_t)row * NC);
        f32x4 v[NV]; float ss = 0.f;
#pragma unroll
        for (int i = 0; i < NV; ++i) { v[i] = xr[lane + 64 * i]; ss += v[i][0] * v[i][0] + v[i][1] * v[i][1] + v[i][2] * v[i][2] + v[i][3] * v[i][3]; }
        ss = wave_sum(ss);
        const float r = rsqrtf(ss * (1.0f / NC) + NORM_EPS);
#pragma unroll
        for (int i = 0; i < NV; ++i) { const f32x4 gg = ((const f32x4*)g)[lane + 64 * i]; const f32x4 y = v[i] * r * gg; st_bf16x4(out + (size_t)row * NC + 4 * (lane + 64 * i), y);
            if (out8) { int pk = 0; pk = __builtin_amdgcn_cvt_pk_fp8_f32(y[0], y[1], pk, false); pk = __builtin_amdgcn_cvt_pk_fp8_f32(y[2], y[3], pk, true); *(int*)(out8 + (size_t)row * NC + 4 * (lane + 64 * i)) = pk; } }
    }
}
template <bool IN16, bool OUT16>
__device__ __forceinline__ void ph_resnorm(const void* xin, const bf16_t* __restrict__ m, const float* __restrict__ gpost, const float* __restrict__ gpre, void* xout, bf16_t* __restrict__ h, unsigned char* __restrict__ h8, int bid, int nblk) {
    const int tid_ = opaque_tid(), lane = tid_ & 63, w = tid_ >> 6;
    for (int row = bid * 8 + w; row < NTOK; row += nblk * 8) {
        const u32x2* mr = (const u32x2*)(m + (size_t)row * DM);
        f32x4 mv[8], xv[8]; float ss = 0.f;
#pragma unroll
        for (int i = 0; i < 8; ++i) { const u32x2 wd = mr[lane + 64 * i]; mv[i][0] = __uint_as_float(wd.x << 16); mv[i][1] = __uint_as_float(wd.x & 0xFFFF0000u); mv[i][2] = __uint_as_float(wd.y << 16); mv[i][3] = __uint_as_float(wd.y & 0xFFFF0000u);
            if (IN16) { const u32x2 xw = ((const u32x2*)((const bf16_t*)xin + (size_t)row * DM))[lane + 64 * i];
                xv[i][0] = __uint_as_float(xw.x << 16); xv[i][1] = __uint_as_float(xw.x & 0xFFFF0000u); xv[i][2] = __uint_as_float(xw.y << 16); xv[i][3] = __uint_as_float(xw.y & 0xFFFF0000u); }
            else xv[i] = ((const f32x4*)((const float*)xin + (size_t)row * DM))[lane + 64 * i];
            ss += mv[i][0] * mv[i][0] + mv[i][1] * mv[i][1] + mv[i][2] * mv[i][2] + mv[i][3] * mv[i][3]; }
        ss = wave_sum(ss);
        const float r1 = rsqrtf(ss * (1.0f / DM) + NORM_EPS);
        float s2 = 0.f;
#pragma unroll
        for (int i = 0; i < 8; ++i) { const f32x4 gg = ((const f32x4*)gpost)[lane + 64 * i]; xv[i] = xv[i] + mv[i] * r1 * gg;
            if (OUT16) st_bf16x4((bf16_t*)xout + (size_t)row * DM + 4 * (lane + 64 * i), xv[i]); else ((f32x4*)((float*)xout + (size_t)row * DM))[lane + 64 * i] = xv[i];
            s2 += xv[i][0] * xv[i][0] + xv[i][1] * xv[i][1] + xv[i][2] * xv[i][2] + xv[i][3] * xv[i][3]; }
        if (gpre) {
            s2 = wave_sum(s2);
            const float r2 = rsqrtf(s2 * (1.0f / DM) + NORM_EPS);
#pragma unroll
            for (int i = 0; i < 8; ++i) { const f32x4 gg = ((const f32x4*)gpre)[lane + 64 * i]; const f32x4 y = xv[i] * r2 * gg;
                if (h8) { int pk = 0; pk = __builtin_amdgcn_cvt_pk_fp8_f32(y[0], y[1], pk, false); pk = __builtin_amdgcn_cvt_pk_fp8_f32(y[2], y[3], pk, true); *(int*)(h8 + (size_t)row * DM + 4 * (lane + 64 * i)) = pk; }
                else st_bf16x4(h + (size_t)row * DM + 4 * (lane + 64 * i), y); }
        }
    }
}
__device__ __forceinline__ void ph_scan1(const bf16_t* __restrict__ Aa, const bf16_t* __restrict__ Bb, float* __restrict__ CA, float* __restrict__ CH, int bid, int nblk) {
    for (int i = bid * 512 + opaque_tid(); i < 2 * 256 * 1024; i += nblk * 512) {
        const int ch = i & 1023, chunk = (i >> 10) & 255, b = i >> 18;
        const size_t base = ((size_t)b * SEQ + (size_t)chunk * 64) * 1024 + ch;
        float h = 0.f, P = 1.f;
#pragma unroll 8
        for (int s = 0; s < 64; ++s) { const float a = 1.0f - bf2f(Aa[base + (size_t)s * 1024]); h = a * h + bf2f(Bb[base + (size_t)s * 1024]); P *= a; }
        CA[i] = P; CH[i] = h;
    }
}
__device__ __forceinline__ void ph_scan2(const float* __restrict__ CA, const float* __restrict__ CH, float* __restrict__ CIN, int bid, int nblk) {
    for (int i = bid * 512 + opaque_tid(); i < 2048; i += nblk * 512) {
        const int ch = i & 1023, b = i >> 10;
        float h = 0.f;
#pragma unroll 8
        for (int c = 0; c < 256; ++c) { const int j = (b * 256 + c) * 1024 + ch; CIN[j] = h; h = CA[j] * h + CH[j]; }
    }
}
__device__ __forceinline__ void ph_scan3(const bf16_t* __restrict__ Aa, const bf16_t* __restrict__ Bb, const float* __restrict__ CIN, const bf16_t* __restrict__ YG, bf16_t* __restrict__ CC, int bid, int nblk) {
    for (int i = bid * 512 + opaque_tid(); i < 2 * 256 * 1024; i += nblk * 512) {
        const int ch = i & 1023, chunk = (i >> 10) & 255, b = i >> 18;
        const size_t row0 = (size_t)b * SEQ + (size_t)chunk * 64;
        float h = CIN[i];
#pragma unroll 8
        for (int s = 0; s < 64; ++s) { const size_t r = row0 + s; h = (1.0f - bf2f(Aa[r * 1024 + ch])) * h + bf2f(Bb[r * 1024 + ch]);
            CC[r * 2048 + 1024 + ch] = f2bf(h * gelu_tanh(bf2f(YG[r * 1024 + ch]))); }
    }
}
__device__ __forceinline__ void ph_rope_q(const bf16_t* __restrict__ Q1, const int* __restrict__ pos, unsigned char* __restrict__ Q8, int bid, int nblk) {
    for (int idx = bid * 512 + opaque_tid(); idx < NTOK * 8 * 4; idx += nblk * 512) {
        const int g = idx & 3, h = (idx >> 2) & 7, row = idx >> 5;
        const bf16_t* p = Q1 + (size_t)row * 1536 + h * 192; unsigned char* q = Q8 + (size_t)row * 1536 + h * 192;
#pragma unroll
        for (int k = 0; k < 4; ++k) { const u32x4 w = *(const u32x4*)(p + 32 * g + 8 * k);
            int p0 = 0, p1 = 0;
            p0 = __builtin_amdgcn_cvt_pk_fp8_f32(__uint_as_float(w.x << 16), __uint_as_float(w.x & 0xFFFF0000u), p0, false); p0 = __builtin_amdgcn_cvt_pk_fp8_f32(__uint_as_float(w.y << 16), __uint_as_float(w.y & 0xFFFF0000u), p0, true);
            p1 = __builtin_amdgcn_cvt_pk_fp8_f32(__uint_as_float(w.z << 16), __uint_as_float(w.z & 0xFFFF0000u), p1, false); p1 = __builtin_amdgcn_cvt_pk_fp8_f32(__uint_as_float(w.w << 16), __uint_as_float(w.w & 0xFFFF0000u), p1, true);
            u32x2 o; o.x = (unsigned)p0; o.y = (unsigned)p1; *(u32x2*)(q + 32 * g + 8 * k) = o; }
        const u32x4 w1 = *(const u32x4*)(p + 128 + 8 * g), w2 = *(const u32x4*)(p + 160 + 8 * g);
        const unsigned a1[4] = {w1.x, w1.y, w1.z, w1.w}, a2[4] = {w2.x, w2.y, w2.z, w2.w};
        float o1[8], o2[8]; const int ps = pos[row];
#pragma unroll
        for (int j = 0; j < 8; ++j) { float cs, sn; rope_cs(ps, 8 * g + j, cs, sn);
            const float x1 = (j & 1) ? __uint_as_float(a1[j >> 1] & 0xFFFF0000u) : __uint_as_float(a1[j >> 1] << 16), x2 = (j & 1) ? __uint_as_float(a2[j >> 1] & 0xFFFF0000u) : __uint_as_float(a2[j >> 1] << 16);
            o1[j] = x1 * cs - x2 * sn; o2[j] = x2 * cs + x1 * sn; }
        int p0 = 0, p1 = 0, p2 = 0, p3 = 0;
        p0 = __builtin_amdgcn_cvt_pk_fp8_f32(o1[0], o1[1], p0, false); p0 = __builtin_amdgcn_cvt_pk_fp8_f32(o1[2], o1[3], p0, true); p1 = __builtin_amdgcn_cvt_pk_fp8_f32(o1[4], o1[5], p1, false); p1 = __builtin_amdgcn_cvt_pk_fp8_f32(o1[6], o1[7], p1, true);
        p2 = __builtin_amdgcn_cvt_pk_fp8_f32(o2[0], o2[1], p2, false); p2 = __builtin_amdgcn_cvt_pk_fp8_f32(o2[2], o2[3], p2, true); p3 = __builtin_amdgcn_cvt_pk_fp8_f32(o2[4], o2[5], p3, false); p3 = __builtin_amdgcn_cvt_pk_fp8_f32(o2[6], o2[7], p3, true);
        u32x2 oa; oa.x = (unsigned)p0; oa.y = (unsigned)p1; *(u32x2*)(q + 128 + 8 * g) = oa;
        u32x2 ob; ob.x = (unsigned)p2; ob.y = (unsigned)p3; *(u32x2*)(q + 160 + 8 * g) = ob;
    }
}
__device__ __forceinline__ void ph_rope_k(const float* __restrict__ KR, const int* __restrict__ pos, unsigned char* __restrict__ K8, int bid, int nblk) {
    for (int idx = bid * 512 + opaque_tid(); idx < NTOK * 32; idx += nblk * 512) {
        const int i = idx & 31, row = idx >> 5;
        float c, s; rope_cs(pos[row], i, c, s);
        const float x1 = KR[(size_t)row * 64 + i], x2 = KR[(size_t)row * 64 + 32 + i];
        const int pk = __builtin_amdgcn_cvt_pk_fp8_f32(x1 * c - x2 * s, x2 * c + x1 * s, 0, false);
        const unsigned char o1 = (unsigned char)(pk & 0xFF), o2 = (unsigned char)((pk >> 8) & 0xFF);
#pragma unroll
        for (int h = 0; h < 8; ++h) { unsigned char* p = K8 + (size_t)row * 1536 + h * 192 + 128; p[i] = o1; p[32 + i] = o2; }
    }
}
template <bool OUT8> __device__ __forceinline__ void ph_ffn_gate(const bf16_t* __restrict__ HID, const float* __restrict__ cw, const float* __restrict__ cb, bf16_t* __restrict__ ACT, int bid, int nblk) {
    for (int i = bid * 512 + opaque_tid(); i < 512 * (SEQ / 64); i += nblk * 512) {
        const int c8 = (i & 511) * 8, t0 = (i >> 9) * 64;
        float wg[3][8], wv[3][8], bg[8], bv[8];
#pragma unroll
        for (int j = 0; j < 8; ++j) { bg[j] = cb[c8 + j]; bv[j] = cb[4096 + c8 + j];
#pragma unroll
            for (int k = 0; k < 3; ++k) { wg[k][j] = cw[k * 8192 + c8 + j]; wv[k][j] = cw[k * 8192 + 4096 + c8 + j]; } }
        u32x4 g2 = {0u, 0u, 0u, 0u}, g1 = g2, v2 = g2, v1 = g2;
        if (t0 >= 2) { g2 = *(const u32x4*)(HID + (size_t)(t0 - 2) * 8192 + c8); g1 = *(const u32x4*)(HID + (size_t)(t0 - 1) * 8192 + c8);
                       v2 = *(const u32x4*)(HID + (size_t)(t0 - 2) * 8192 + 4096 + c8); v1 = *(const u32x4*)(HID + (size_t)(t0 - 1) * 8192 + 4096 + c8); }
#pragma unroll 8
        for (int r = 0; r < 64; ++r) {
            const u32x4 g0 = *(const u32x4*)(HID + (size_t)(t0 + r) * 8192 + c8), v0 = *(const u32x4*)(HID + (size_t)(t0 + r) * 8192 + 4096 + c8);
            const unsigned G2[4] = {g2.x, g2.y, g2.z, g2.w}, G1[4] = {g1.x, g1.y, g1.z, g1.w}, G0[4] = {g0.x, g0.y, g0.z, g0.w};
            const unsigned V2[4] = {v2.x, v2.y, v2.z, v2.w}, V1[4] = {v1.x, v1.y, v1.z, v1.w}, V0[4] = {v0.x, v0.y, v0.z, v0.w};
            float o[8];
#pragma unroll
            for (int j = 0; j < 4; ++j) {
                const float ge = bg[2 * j] + wg[0][2 * j] * __uint_as_float(G2[j] << 16) + wg[1][2 * j] * __uint_as_float(G1[j] << 16) + wg[2][2 * j] * __uint_as_float(G0[j] << 16);
                const float go = bg[2 * j + 1] + wg[0][2 * j + 1] * __uint_as_float(G2[j] & 0xFFFF0000u) + wg[1][2 * j + 1] * __uint_as_float(G1[j] & 0xFFFF0000u) + wg[2][2 * j + 1] * __uint_as_float(G0[j] & 0xFFFF0000u);
                const float ve = bv[2 * j] + wv[0][2 * j] * __uint_as_float(V2[j] << 16) + wv[1][2 * j] * __uint_as_float(V1[j] << 16) + wv[2][2 * j] * __uint_as_float(V0[j] << 16);
                const float vo = bv[2 * j + 1] + wv[0][2 * j + 1] * __uint_as_float(V2[j] & 0xFFFF0000u) + wv[1][2 * j + 1] * __uint_as_float(V1[j] & 0xFFFF0000u) + wv[2][2 * j + 1] * __uint_as_float(V0[j] & 0xFFFF0000u);
                o[2 * j] = gelu_tanh(ge) * ve; o[2 * j + 1] = gelu_tanh(go) * vo; }
            if (OUT8) { int p0 = 0, p1 = 0;
                p0 = __builtin_amdgcn_cvt_pk_fp8_f32(o[0], o[1], p0, false); p0 = __builtin_amdgcn_cvt_pk_fp8_f32(o[2], o[3], p0, true);
                p1 = __builtin_amdgcn_cvt_pk_fp8_f32(o[4], o[5], p1, false); p1 = __builtin_amdgcn_cvt_pk_fp8_f32(o[6], o[7], p1, true);
                u32x2 ov; ov.x = (unsigned)p0; ov.y = (unsigned)p1; *(u32x2*)((unsigned char*)ACT + (size_t)(t0 + r) * 4096 + c8) = ov; }
            else { u32x4 ov; ov.x = pack2bf(o[0], o[1]); ov.y = pack2bf(o[2], o[3]); ov.z = pack2bf(o[4], o[5]); ov.w = pack2bf(o[6], o[7]);
                *(u32x4*)(ACT + (size_t)(t0 + r) * 4096 + c8) = ov; }
            g2 = g1; g1 = g0; v2 = v1; v1 = v0;
        }
    }
}

__device__ __forceinline__ void ph_conv_lru(const float* __restrict__ wa, const float* __restrict__ wx, bf16_t* __restrict__ Bt, int bid, int nblk) {
    for (int e = bid * 512 + opaque_tid(); e < 8 * 2 * 128 * 128; e += nblk * 512) {
        const int d = e & 127, c = (e >> 7) & 127, gate = (e >> 14) & 1, nb = e >> 15;
        const float v = (gate ? wx : wa)[((size_t)nb * 128 + c) * 128 + d];
        bf16_t* row = Bt + (size_t)(nb * 256 + gate * 128 + d) * 256;
        row[(nb & 1) * 128 + c] = f2bf(v); row[(1 - (nb & 1)) * 128 + c] = 0;
    }
}

static constexpr size_t MiB = 1048576;
static constexpr size_t W_UP0 = 0 * MiB, W_UP1 = 32 * MiB, W_DN0 = 64 * MiB, W_DN1 = 80 * MiB, W_ABIN = 96 * MiB, W_ABOUT = 117 * MiB, W_CDIN = 125 * MiB, W_CDOUT = 137 * MiB,
                        W_QUP = 145 * MiB, W_KVUP = 146 * MiB + 512 * 1024, W_POOL = 147 * MiB + 512 * 1024;
static constexpr size_t R_H = 148 * MiB;
static constexpr size_t R_Q0 = 276 * MiB, R_K0 = 340 * MiB, R_VT0 = 404 * MiB, R_QI = 468 * MiB, R_M0 = 468 * MiB, R_U = 596 * MiB, R_KI = 724 * MiB, R_WI = 732 * MiB, R_MASK = 734 * MiB, R_CC0 = 830 * MiB, R_POOLED = 958 * MiB, R_H8A = 830 * MiB;
static constexpr size_t R_HID = 276 * MiB, R_ACT = 532 * MiB, R_F = 660 * MiB, R_X3 = 788 * MiB;
static constexpr size_t R_VT1 = 276 * MiB, R_CQ = 276 * MiB, R_CKV = 340 * MiB, R_KR = 372 * MiB, R_XL = 380 * MiB, R_YG = 444 * MiB, R_CQN = 508 * MiB, R_CKVN = 540 * MiB, R_LA = 556 * MiB, R_LB = 684 * MiB,
                        R_Q1 = 812 * MiB, R_K1 = 908 * MiB, R_Q8 = 956 * MiB,     R_CA = 1004 * MiB, R_CH = 1006 * MiB, R_CIN = 1008 * MiB, R_CC1 = 148 * MiB, R_M1 = 276 * MiB, R_XCB = 148 * MiB, W_LRU = 1010 * MiB;
static constexpr size_t WS_BAR = 1022 * MiB, WS_NEED = 1022 * MiB + 65536;
static constexpr int MK_LDS = 162816;

struct MK { const float* in[28]; float* out; unsigned char* ws; int ph_lo, ph_hi; };

__global__ __launch_bounds__(512, 2) void k_mega(MK p) {
    extern __shared__ __attribute__((aligned(16))) unsigned char shm[];
    LAS unsigned char* lds = (LAS unsigned char*)shm;
    const int bid0 = (int)blockIdx.x, nblk0 = (int)gridDim.x;
    volatile LAS unsigned* xbw = (volatile LAS unsigned*)(lds + MK_LDS - 16);
    if (threadIdx.x == 0) { xbw[0] = 0u; xbw[1] = 0u; xbw[2] = 0u; xbw[3] = 0u; }
    if ((threadIdx.x & 63) == 0) *(volatile LAS int*)(size_t)(TID_TAB_LDS + 4 * ((unsigned)__builtin_amdgcn_s_getreg(((6 - 1) << 11) | 4) & 63u)) = (int)(threadIdx.x >> 6);
    __syncthreads();
    XcdBarrier bar = xcd_barrier_post((unsigned*)(p.ws + WS_BAR), xbw);
#ifndef KARG_PLAIN
#define KARG_PLAIN 0
#endif
#if KARG_PLAIN
#define KARG_DECL const MK& P_ = p;
#else
#define KARG_DECL KPtr P__ = kp; asm volatile("" : "+s"(P__)); const __attribute__((address_space(4))) MK& P_ = *P__;
#endif
    typedef const __attribute__((address_space(4))) MK* KPtr;
    KPtr kp = (KPtr)__builtin_amdgcn_kernarg_segment_ptr();
#define WSP(T, off) ((T*)(ws + (off)))
#define PHASE_BEGIN if (pc >= p.ph_lo && pc < p.ph_hi) { const int bid = opaque_s(bid0), nblk = opaque_s(nblk0); \
    KARG_DECL unsigned char* const ws = P_.ws; float* const xo = P_.out; const float* const x = P_.in[0]; const int* const positions = (const int*)P_.in[1]; \
    const float *const mix_pre_g = P_.in[2], *const mix_post_g = P_.in[3], *const ffn_pre_g = P_.in[4], *const ffn_post_g = P_.in[5], *const ffn_up = P_.in[6], *const ffn_conv_w = P_.in[7], *const ffn_conv_b = P_.in[8], *const ffn_down = P_.in[9], \
    *const ab_w_in = P_.in[10], *const pool_w = P_.in[11], *const pool_b = P_.in[12], *const pool_scale = P_.in[13], *const ab_w_out = P_.in[14], *const cd_w_in = P_.in[15], *const q_norm_g = P_.in[16], *const w_q_up = P_.in[17], \
    *const kv_norm_g = P_.in[18], *const w_kv_up = P_.in[19], *const lru_conv_w = P_.in[20], *const lru_conv_b = P_.in[21], *const lru_wa = P_.in[22], *const lru_ba = P_.in[23], *const lru_wx = P_.in[24], *const lru_bx = P_.in[25], \
    *const lru_lambda = P_.in[26], *const cd_w_out = P_.in[27]; bf16_t* const H = WSP(bf16_t, R_H); const bf16_t* const CC = WSP(bf16_t, LAYER_CC); bf16_t* const Mx = WSP(bf16_t, LAYER_MX); \
    (void)xo; (void)x; (void)positions; (void)mix_pre_g; (void)mix_post_g; (void)ffn_pre_g; (void)ffn_post_g; (void)ffn_up; (void)ffn_conv_w; (void)ffn_conv_b; (void)ffn_down; (void)ab_w_in; (void)pool_w; (void)pool_b; (void)pool_scale; \
    (void)ab_w_out; (void)cd_w_in; (void)q_norm_g; (void)w_q_up; (void)kv_norm_g; (void)w_kv_up; (void)lru_conv_w; (void)lru_conv_b; (void)lru_wa; (void)lru_ba; (void)lru_wx; (void)lru_bx; (void)lru_lambda; (void)cd_w_out; (void)H; (void)CC; (void)Mx;
#define PHASE_END } if (pc >= p.ph_lo && pc + 1 < p.ph_hi) xcd_barrier(bar); ++pc;
    int pc = 0;
#define LAYER_CC R_CC0
#define LAYER_MX R_M0
    PHASE_BEGIN
#if !((SKIPMASK >> 0) & 1)
#if FP8_UP0
        ph_convT8(lds, ffn_up, 8192, 8192, 2048, WSP(unsigned char, W_UP0), bid, nblk, true);
#else
        ph_convT(lds, ffn_up, 8192, 0, 8192, 2048, WSP(bf16_t, W_UP0), 2048, bid, nblk, true);
#endif
#if FP8_UP1
        ph_convT8(lds, ffn_up + (size_t)2048 * 8192, 8192, 8192, 2048, WSP(unsigned char, W_UP1), bid, nblk, true);
#else
        ph_convT(lds, ffn_up + (size_t)2048 * 8192, 8192, 0, 8192, 2048, WSP(bf16_t, W_UP1), 2048, bid, nblk, true);
#endif
#if FP8_DN0
        ph_convT8(lds, ffn_down, 2048, 2048, 4096, WSP(unsigned char, W_DN0), bid, nblk);
#else
        ph_convT(lds, ffn_down, 2048, 0, 2048, 4096, WSP(bf16_t, W_DN0), 4096, bid, nblk);
#endif
#if FP8_DN1
        ph_convT8(lds, ffn_down + (size_t)4096 * 2048, 2048, 2048, 4096, WSP(unsigned char, W_DN1), bid, nblk);
#else
        ph_convT(lds, ffn_down + (size_t)4096 * 2048, 2048, 0, 2048, 4096, WSP(bf16_t, W_DN1), 4096, bid, nblk);
#endif
#if FP8_QKV
        ph_convT8(lds, ab_w_in, 5200, 3072, 2048, WSP(unsigned char, W_ABIN), bid, nblk);
        ph_convT(lds, ab_w_in, 5200, 3072, 1024, 2048, WSP(bf16_t, W_ABIN) + (size_t)3072 * 2048, 2048, bid, nblk);
#else
        ph_convT(lds, ab_w_in, 5200, 0, 4096, 2048, WSP(bf16_t, W_ABIN), 2048, bid, nblk);
#endif
        ph_convT(lds, ab_w_in, 5200, 4176, 1024, 2048, WSP(bf16_t, W_ABIN) + (size_t)4096 * 2048, 2048, bid, nblk);
        ph_convT(lds, ab_w_in, 5200, 4096, 64, 2048, WSP(bf16_t, W_ABIN) + (size_t)5120 * 2048, 2048, bid, nblk);
        ph_convT(lds, ab_w_in, 5200, 4160, 16, 2048, WSP(bf16_t, W_ABIN) + (size_t)5184 * 2048, 2048, bid, nblk);
        ph_convT(lds, ab_w_out, 2048, 0, 2048, 2048, WSP(bf16_t, W_ABOUT), 2048, bid, nblk);
        ph_convT(lds, cd_w_in, 2880, 0, 832, 2048, WSP(bf16_t, W_CDIN), 2048, bid, nblk);
        ph_convT(lds, cd_w_in, 2880, 832, 2048, 2048, WSP(bf16_t, W_CDIN) + (size_t)1024 * 2048, 2048, bid, nblk);
        ph_convT(lds, cd_w_out, 2048, 0, 2048, 2048, WSP(bf16_t, W_CDOUT), 2048, bid, nblk);
        ph_convT(lds, w_q_up, 1536, 0, 1536, 512, WSP(bf16_t, W_QUP), 512, bid, nblk);
        ph_convT(lds, w_kv_up, 2048, 0, 2048, 256, WSP(bf16_t, W_KVUP), 256, bid, nblk);
        for (int g = 0; g < 4; ++g) ph_convT(lds, pool_w + (size_t)g * 65536, 256, 0, 256, 256, WSP(bf16_t, W_POOL) + (size_t)g * 65536, 256, bid, nblk);
        ph_rmsnorm<2048>(x, mix_pre_g, H, bid, nblk, FP8_QKV ? WSP(unsigned char, R_H8A) : (unsigned char*)nullptr);
#endif
    PHASE_END
    {
            PHASE_BEGIN
#if !((SKIPMASK >> 1) & 1)
                FAbIn2 f; f.Q = WSP(unsigned char, R_Q0); f.K = WSP(unsigned char, R_K0); f.VT = WSP(bf16_t, R_VT0); f.QI = WSP(float, R_QI); f.U = WSP(float, R_U); f.WI = WSP(float, R_WI); f.KI16 = WSP(unsigned short, R_KI);
#if FP8_QKV
                ph_gemm8(lds, WSP(unsigned char, R_H8A), 2048, WSP(unsigned char, W_ABIN), 2048, NTOK, 3072, 2048, f, bid, nblk);
                { FAbInHi fh; fh.f = f; ph_gemm(lds, H, 2048, WSP(bf16_t, W_ABIN) + (size_t)3072 * 2048, 2048, NTOK, 2304, 2048, fh, bid, nblk); }
#else
                ph_gemm(lds, H, 2048, WSP(bf16_t, W_ABIN), 2048, NTOK, 5376, 2048, f, bid, nblk);
#endif
#endif
            PHASE_END
            PHASE_BEGIN
#if !((SKIPMASK >> 2) & 1)
                ph_pooled(WSP(float, R_U), WSP(bf16_t, R_POOLED), bid, nblk);
                IdxArgs a; a.QI = WSP(float, R_QI); a.KI16 = WSP(unsigned short, R_KI); a.WI = WSP(float, R_WI); a.MT = WSP(unsigned long long, R_MASK);
                idx_phase(lds, a, bid, nblk);
#endif
            PHASE_END
            PHASE_BEGIN
#if !((SKIPMASK >> 3) & 1)
                { FPool f; f.CC = WSP(bf16_t, R_CC0); f.pb = pool_b; f.ps = pool_scale; ph_gemm(lds, WSP(bf16_t, R_POOLED), 1024, WSP(bf16_t, W_POOL), 256, NTOK, 1024, 256, f, bid, nblk, 0, 512); }
                AttnArgs a; a.Q = WSP(bf16_t, R_Q0); a.K = WSP(bf16_t, R_K0); a.VT = WSP(bf16_t, R_VT0); a.MT = WSP(unsigned long long, R_MASK); a.O = WSP(bf16_t, R_CC0); a.ldq = 1024; a.ldk = 1024; a.ldo = 2048;
                a.sc_log2e = 0.08838834764831845f * 1.4426950408889634f;
                attn_phase<128, true>(lds, a, bid, nblk);
#endif
            PHASE_END
        PHASE_BEGIN
#if !((SKIPMASK >> 4) & 1)
            FStoreBf16 f; f.O = Mx; f.ldc = 2048; f.pad_ = 0;
            ph_gemm(lds, CC, 2048, WSP(bf16_t, W_ABOUT), 2048, NTOK, 2048, 2048, f, bid, nblk);
#endif
        PHASE_END
        PHASE_BEGIN
#if !((SKIPMASK >> 5) & 1)
            ph_resnorm<false, true>(x, Mx, mix_post_g + 0, ffn_pre_g + 0, xo, H, FP8_UP0 ? WSP(unsigned char, R_H) : (unsigned char*)nullptr, bid, nblk);
#endif
        PHASE_END
        PHASE_BEGIN
#if FP8_UP0
            { EpiGate<FP8_DN0 != 0, true> ep; ep.cw = ffn_conv_w + 0; ep.cb = ffn_conv_b + 0; ep.ACT = WSP(void, R_HID);
              ph_gemm_e(lds, (const bf16_t*)WSP(unsigned char, R_H), 1024, (const bf16_t*)WSP(unsigned char, W_UP0), 1024, 134 * 256, 8192, 1024, ep, bid, nblk, 0, 0, 1); }
#else
            { EpiGate<FP8_DN0 != 0, false> ep; ep.cw = ffn_conv_w + 0; ep.cb = ffn_conv_b + 0; ep.ACT = WSP(void, R_HID);
              ph_gemm_e(lds, H, 2048, WSP(bf16_t, W_UP0), 2048, 134 * 256, 8192, 2048, ep, bid, nblk, 0, 0, 1); }
#endif
        PHASE_END
        PHASE_BEGIN
            FStoreBf16 f; f.O = WSP(bf16_t, R_F); f.ldc = 2048; f.pad_ = 0;
#if FP8_DN0
            ph_gemm8(lds, WSP(unsigned char, R_HID), 4096, WSP(unsigned char, W_DN0), 4096, NTOK, 2048, 4096, f, bid, nblk);
#else
            ph_gemm(lds, WSP(bf16_t, R_HID), 4096, WSP(bf16_t, W_DN0), 4096, NTOK, 2048, 4096, f, bid, nblk);
#endif
        PHASE_END
        PHASE_BEGIN
#if !((SKIPMASK >> 9) & 1)
            ph_resnorm<true, true>(xo, WSP(bf16_t, R_F), ffn_post_g + 0, mix_pre_g + 2048, xo, H, nullptr, bid, nblk);
#endif
        PHASE_END
    }
    {
#undef LAYER_CC
#undef LAYER_MX
#define LAYER_CC R_CC1
#define LAYER_MX R_M1
            PHASE_BEGIN
#if !((SKIPMASK >> 10) & 1)
                FCdIn f; f.CQ = WSP(float, R_CQ); f.CKV = WSP(float, R_CKV); f.KR = WSP(float, R_KR); f.XL = WSP(bf16_t, R_XL); f.YG = WSP(bf16_t, R_YG);
                ph_gemm(lds, H, 2048, WSP(bf16_t, W_CDIN), 2048, NTOK, 3072, 2048, f, bid, nblk);
#endif
            PHASE_END
            PHASE_BEGIN
#if !((SKIPMASK >> 11) & 1)
                ph_xc(WSP(bf16_t, R_XL), lru_conv_w, lru_conv_b, WSP(bf16_t, R_XCB), bid, nblk);
                ph_conv_lru(lru_wa, lru_wx, WSP(bf16_t, W_LRU), bid, nblk);
                ph_rmsnorm<512>(WSP(float, R_CQ), q_norm_g, WSP(bf16_t, R_CQN), bid, nblk);
                ph_rmsnorm<256>(WSP(float, R_CKV), kv_norm_g, WSP(bf16_t, R_CKVN), bid, nblk);
            PHASE_END
            PHASE_BEGIN
                { EpiLru ep; ep.XCB = WSP(bf16_t, R_XCB); ep.ba = lru_ba; ep.bx = lru_bx; ep.lam = lru_lambda; ep.LA = WSP(bf16_t, R_LA); ep.LB = WSP(bf16_t, R_LB);
                  ph_gemm_e(lds, WSP(bf16_t, R_XCB), 1024, WSP(bf16_t, W_LRU), 256, NTOK, 2048, 256, ep, bid, nblk, 1, 512); }
                { FStoreBf16 f; f.O = WSP(bf16_t, R_Q1); f.ldc = 1536; f.pad_ = 0; ph_gemm(lds, WSP(bf16_t, R_CQN), 512, WSP(bf16_t, W_QUP), 512, NTOK, 1536, 512, f, bid, nblk); }
                { FKvUp2 f; f.K8 = WSP(unsigned char, R_K1); f.VT = WSP(bf16_t, R_VT1); ph_gemm(lds, WSP(bf16_t, R_CKVN), 256, WSP(bf16_t, W_KVUP), 256, NTOK, 2048, 256, f, bid, nblk); }
            PHASE_END
            PHASE_BEGIN
                ph_scan1(WSP(bf16_t, R_LA), WSP(bf16_t, R_LB), WSP(float, R_CA), WSP(float, R_CH), bid, nblk);
                ph_rope_q(WSP(bf16_t, R_Q1), positions, WSP(unsigned char, R_Q8), bid, nblk);
                ph_rope_k(WSP(float, R_KR), positions, WSP(unsigned char, R_K1), bid, nblk);
            PHASE_END
            PHASE_BEGIN
                ph_scan2(WSP(float, R_CA), WSP(float, R_CH), WSP(float, R_CIN), bid, nblk);
            PHASE_END
            PHASE_BEGIN
                ph_scan3(WSP(bf16_t, R_LA), WSP(bf16_t, R_LB), WSP(float, R_CIN), WSP(bf16_t, R_YG), WSP(bf16_t, R_CC1), bid, nblk);
                AttnArgs a; a.Q = WSP(bf16_t, R_Q8); a.K = WSP(bf16_t, R_K1); a.VT = WSP(bf16_t, R_VT1); a.MT = nullptr; a.O = WSP(bf16_t, R_CC1); a.ldq = 1536; a.ldk = 1536; a.ldo = 2048;
                a.sc_log2e = 0.07216878364870322f * 1.4426950408889634f;
                attn_phase<192, false>(lds, a, bid, nblk);
#endif
            PHASE_END
        PHASE_BEGIN
#if !((SKIPMASK >> 15) & 1)
            FStoreBf16 f; f.O = Mx; f.ldc = 2048; f.pad_ = 0;
            ph_gemm(lds, CC, 2048, WSP(bf16_t, W_CDOUT), 2048, NTOK, 2048, 2048, f, bid, nblk);
#endif
        PHASE_END
        PHASE_BEGIN
#if !((SKIPMASK >> 16) & 1)
            ph_resnorm<true, true>(xo, Mx, mix_post_g + 2048, ffn_pre_g + 2048, WSP(bf16_t, R_X3), H, FP8_UP1 ? WSP(unsigned char, R_H) : (unsigned char*)nullptr, bid, nblk);
#endif
        PHASE_END
        PHASE_BEGIN
#if FP8_UP1
            { EpiGate<FP8_DN1 != 0, true> ep; ep.cw = ffn_conv_w + 24576; ep.cb = ffn_conv_b + 8192; ep.ACT = WSP(void, R_HID);
              ph_gemm_e(lds, (const bf16_t*)WSP(unsigned char, R_H), 1024, (const bf16_t*)WSP(unsigned char, W_UP1), 1024, 134 * 256, 8192, 1024, ep, bid, nblk, 0, 0, 1); }
#else
            { EpiGate<FP8_DN1 != 0, false> ep; ep.cw = ffn_conv_w + 24576; ep.cb = ffn_conv_b + 8192; ep.ACT = WSP(void, R_HID);
              ph_gemm_e(lds, H, 2048, WSP(bf16_t, W_UP1), 2048, 134 * 256, 8192, 2048, ep, bid, nblk, 0, 0, 1); }
#endif
        PHASE_END
        PHASE_BEGIN
            FStoreBf16 f; f.O = WSP(bf16_t, R_F); f.ldc = 2048; f.pad_ = 0;
#if FP8_DN1
            ph_gemm8(lds, WSP(unsigned char, R_HID), 4096, WSP(unsigned char, W_DN1), 4096, NTOK, 2048, 4096, f, bid, nblk);
#else
            ph_gemm(lds, WSP(bf16_t, R_HID), 4096, WSP(bf16_t, W_DN1), 4096, NTOK, 2048, 4096, f, bid, nblk);
#endif
        PHASE_END
        PHASE_BEGIN
#if !((SKIPMASK >> 20) & 1)
            ph_resnorm<true, false>(WSP(bf16_t, R_X3), WSP(bf16_t, R_F), ffn_post_g + 2048, (const float*)nullptr, xo, H, nullptr, bid, nblk);
#endif
        PHASE_END
    }
#undef LAYER_CC
#undef LAYER_MX
#undef WSP
#undef PHASE_BEGIN
#undef PHASE_END
}

#ifndef MK_N_LAUNCHES
#define MK_N_LAUNCHES 1
#endif
static constexpr int MK_NPHASES = 1 + 3 + 7 + 2 * 5;

extern "C" void kernel_launch(void* const* d_in, const int* in_sizes, int n_in, void* d_out, int out_size, void* d_ws, size_t ws_size, hipStream_t stream) {
    static int grid = 0;
    if (grid == 0) {
        if (n_in != 28 || out_size != NTOK * DM || ws_size < WS_NEED) { fprintf(stderr, "kernel_launch: unexpected shapes (n_in %d out %d ws %zu)\n", n_in, out_size, ws_size); grid = -1; return; }
        int dev = 0, cus = 0, per_cu = 0;
        if (hipGetDevice(&dev) != hipSuccess || hipDeviceGetAttribute(&cus, hipDeviceAttributeMultiprocessorCount, dev) != hipSuccess) { grid = -1; return; }
        if (hipFuncSetAttribute((const void*)k_mega, hipFuncAttributeMaxDynamicSharedMemorySize, MK_LDS) != hipSuccess) { fprintf(stderr, "kernel_launch: hipFuncSetAttribute failed\n"); grid = -1; return; }
        if (hipOccupancyMaxActiveBlocksPerMultiprocessor(&per_cu, (const void*)k_mega, 512, MK_LDS) != hipSuccess || per_cu < 1) { fprintf(stderr, "kernel_launch: occupancy query says %d\n", per_cu); }
        (void)hipGetLastError();
        grid = cus;
        if (grid != 256) { fprintf(stderr, "kernel_launch: built for 256 CUs, found %d\n", grid); grid = -1; return; }
    }
    if (grid < 0) return;
    unsigned char* ws = (unsigned char*)d_ws;
    (void)hipMemsetAsync(ws + WS_BAR, 0, XCD_BAR_WORDS * sizeof(unsigned), stream);
    (void)hipMemsetAsync(ws + W_ABIN + (size_t)5200 * 2048 * 2, 0, (size_t)176 * 2048 * 2, stream);
    (void)hipMemsetAsync(ws + W_CDIN + (size_t)832 * 2048 * 2, 0, (size_t)192 * 2048 * 2, stream);
    MK p{};
    for (int i = 0; i < 28; ++i) p.in[i] = (const float*)d_in[i];
    p.out = (float*)d_out; p.ws = ws;
#if MK_N_LAUNCHES == 1
    p.ph_lo = 0; p.ph_hi = 1 << 20;
    hipLaunchKernelGGL(k_mega, dim3(grid), dim3(512), MK_LDS, stream, p);
#else
    for (int ph = 0; ph < MK_NPHASES; ++ph) { p.ph_lo = ph; p.ph_hi = ph + 1; hipLaunchKernelGGL(k_mega, dim3(grid), dim3(512), MK_LDS, stream, p); }
#endif
}
```

```cpp
#include <hip/hip_runtime.h>
#include <stdint.h>
#include <stdio.h>

#define LAS __attribute__((address_space(3)))
typedef unsigned short bf16_t;
typedef float f32x4 __attribute__((ext_vector_type(4)));
typedef unsigned u32x4 __attribute__((ext_vector_type(4)));
typedef unsigned u32x2 __attribute__((ext_vector_type(2)));

static constexpr int NTOK = 32768, SEQ = 16384, NBATCH = 2, DM = 2048, DFF = 4096;
static constexpr float NORM_EPS = 1e-6f;

__device__ __forceinline__ bf16_t f2bf(float f) { unsigned u = __float_as_uint(f); u += 0x7FFFu + ((u >> 16) & 1u); return (bf16_t)(u >> 16); }
__device__ __forceinline__ float bf2f(bf16_t b) { return __uint_as_float(((unsigned)b) << 16); }
__device__ __forceinline__ unsigned pack2bf(float lo, float hi) { unsigned r; asm("v_cvt_pk_bf16_f32 %0, %1, %2" : "=v"(r) : "v"(lo), "v"(hi)); return r; }
__device__ __forceinline__ float gelu_tanh(float x) { const float u = 0.7978845608028654f * (x + 0.044715f * x * x * x); return 0.5f * x * (1.0f + tanhf(u)); }
__device__ __forceinline__ float wave_sum(float v) {
#pragma unroll
    for (int o = 32; o >= 1; o >>= 1) v += __shfl_xor(v, o);
    return v;
}

#ifndef TID_PLAIN
#define TID_PLAIN 0
#endif
static constexpr int TID_TAB_LDS = 162816 - 16 - 256;
#if TID_PLAIN
__device__ __forceinline__ int opaque_tid() { int t = (int)threadIdx.x; asm volatile("" : "+v"(t)); return t; }
#else
__device__ __forceinline__ int opaque_tid() {
    const unsigned slot = (unsigned)__builtin_amdgcn_s_getreg(((6 - 1) << 11) | 4) & 63u;
    const int w = __builtin_amdgcn_readfirstlane(*(const volatile LAS int*)(size_t)(TID_TAB_LDS + 4 * slot));
    int lane; asm volatile("v_mbcnt_lo_u32_b32 %0, -1, 0\n\tv_mbcnt_hi_u32_b32 %0, -1, %0" : "=v"(lane));
    return w * 64 + lane;
}
#endif

__device__ __forceinline__ int opaque_s(int v) { asm volatile("" : "+s"(v)); return v; }

template <class T> __device__ __forceinline__ const T* opaque_p(const T* p) { asm volatile("" : "+s"(p)); return p; }

#ifndef PG8_EPI_RECOMP
#define PG8_EPI_RECOMP 1
#endif
#ifndef PG8_ASM_DMA
#define PG8_ASM_DMA 1
#endif
#include <hip/hip_runtime.h>
namespace pg8 {
#define PG8_LAS __attribute__((address_space(3)))
typedef unsigned short bf16_t;
typedef short bf16x8 __attribute__((ext_vector_type(8)));
typedef float f32x4 __attribute__((ext_vector_type(4)));
typedef unsigned u32x4 __attribute__((ext_vector_type(4)));
typedef int i32x8 __attribute__((ext_vector_type(8)));
typedef int i32x4 __attribute__((ext_vector_type(4)));
constexpr int BM = 256, BK = 64, HALF = 128, HTB = HALF * BK * 2  , STAGE_BYTES = 8 * HTB, NXCD = 8, WGM = 8;

__host__ __device__ __forceinline__ int lds_byte(int r, int c) { const int st = (r >> 4) * 2 + (c >> 5), rr = r & 15, cc = c & 31, ob = rr * 64 + cc * 2; return st * 1024 + (ob ^ (((ob >> 9) & 1) << 5)); }
__host__ __device__ __forceinline__ void stage_rc(int b, int& R, int& C) { const int st = b / 1024, sb = b % 1024, swz = sb ^ (((sb >> 9) & 1) << 5); R = (st >> 1) * 16 + swz / 64; C = (st & 1) * 32 + (swz % 64) / 2; }
__host__ __device__ __forceinline__ int perm32(int rho) { const int n = rho >> 4, i = rho & 15; return 8 * (i >> 2) + 4 * n + (i & 3); }

struct Unit { int pm, pn; };
struct Gemm { const bf16_t* A; const bf16_t* Bt; int M, N, K, lda, ldb, a_shift, a_bytes, cmode; };

struct StaticOrder {
    int nM, nN, nwg, G, c;
    __host__ __device__ void init(int M, int N, int G_, int c_) { nM = M / BM; nN = N / BM; nwg = nM * nN; G = G_; c = c_; }
    __host__ __device__ bool next(int i, Unit& u) const {
        const long L = (long)i * G + c; if (L >= nwg) return false;
        int wgid = (int)L; { const int q = nwg / NXCD, r = nwg % NXCD, xcd = wgid % NXCD, off = wgid / NXCD; wgid = (xcd < r ? xcd * (q + 1) : r * (q + 1) + (xcd - r) * q) + off; }
        const int nig = WGM * nN, gid = wgid / nig, fm = gid * WGM, gsz = (nM - fm) < WGM ? (nM - fm) : WGM;
        u.pm = fm + ((wgid % nig) % gsz); u.pn = (wgid % nig) / gsz; return true;
    }
    __device__ __forceinline__ void a_ready(const Unit&) const {}
    __device__ __forceinline__ void done(const Unit&) const {}
};

template <class Epi, class Sched, bool STAMP = false>
__device__ __forceinline__ void gemm_phase(PG8_LAS unsigned char* lds, const Gemm g, const Sched& S, const Epi& E, unsigned long long* stamps) {
    const int tid = opaque_tid(), wid = __builtin_amdgcn_readfirstlane(tid >> 6), lane = tid & 63, wr = wid >> 2, wc = wid & 3, fr = lane & 15, fq = lane >> 4;
    const int K = g.K, nt = K / BK;
    int ts_lo = 0, ts_hi = 0, nts = 0; const unsigned long long rt_entry = STAMP ? (unsigned long long)wall_clock64() : 0ull;
#define PG8_STAMP() do { if (STAMP && wid == 0 && nts < 64) { const unsigned long long _c = (unsigned long long)clock64(); \
        ts_lo = (lane == nts) ? (int)(unsigned)_c : ts_lo; ts_hi = (lane == nts) ? (int)(unsigned)(_c >> 32) : ts_hi; ++nts; } } while (0)
    PG8_STAMP();
    unsigned voffA[2], voffB[2];
#pragma unroll
    for (int i = 0; i < 2; ++i) { int R, C; stage_rc(tid * 16 + i * 8192, R, C); const int Rb = Epi::PERM ? ((R & ~31) + perm32(R & 31)) : R;
        const int Ra = g.cmode ? (R - 2 * (R >> 6)) : R;
        voffA[i] = (unsigned)(Ra * g.lda + C) * 2u; voffB[i] = (unsigned)(Rb * g.ldb + C) * 2u; }
    const size_t kstep = (size_t)(BK * 2);
    const size_t hstepA = (size_t)(g.cmode ? HALF - 4 : HALF) * g.lda * 2, hstepB = (size_t)HALF * g.ldb * 2;
    const size_t tstepA = 2 * hstepA, tstepB = 2 * hstepB;
    const unsigned ldsbase_ = (unsigned)(size_t)lds;
    const int sc_w_ = 0x79797979, sc_a_ = 0x7F7F7F7F;
    (void)sc_w_; (void)sc_a_;
    const unsigned ldsw = (unsigned)wid * 1024u;
    const int aoff = lds_byte(wr * 64 + fr, fq * 8), boff = lds_byte(wc * 32 + fr, fq * 8);
#define PG8_SA(b, h) (((b) * 2 + (h)) * HTB)
#define PG8_SB(b, h) ((4 + (b) * 2 + (h)) * HTB)
#if PG8_ASM_DMA
#define PG8_STAGE(bufoff, gbase, voff) do { _Pragma("unroll") for (int _i = 0; _i < 2; ++_i) { unsigned keep_; \
        asm volatile("s_mov_b32 %0, m0\n\ts_mov_b32 m0, %3\n\ts_nop 0\n\tglobal_load_lds_dwordx4 %1, %2\n\ts_mov_b32 m0, %0" \
                     : "=&s"(keep_) : "v"((voff)[_i]), "s"((const char*)(gbase)), "s"(ldsbase_ + (unsigned)(bufoff) + ldsw + (unsigned)(_i * 8192)) : "memory"); } } while (0)
#else
#define PG8_STAGE(bufoff, gbase, voff) do { _Pragma("unroll") for (int _i = 0; _i < 2; ++_i) \
        __builtin_amdgcn_global_load_lds((const unsigned*)((const char*)(gbase) + (voff)[_i]), (PG8_LAS unsigned*)(lds + (bufoff) + ldsw + _i * 8192), 16, 0, 0); } while (0)
#endif
#define PG8_LDA(dst, b, h) do { _Pragma("unroll") for (int m = 0; m < 4; ++m) { dst[m].lo = *(const PG8_LAS i32x4*)(lds + PG8_SA(b, h) + aoff + m * 2048); dst[m].hi = *(const PG8_LAS i32x4*)(lds + PG8_SA(b, h) + aoff + m * 2048 + 1024); } } while (0)
#define PG8_LDB(dst, b, h) do { _Pragma("unroll") for (int n = 0; n < 2; ++n) { dst[n].lo = *(const PG8_LAS i32x4*)(lds + PG8_SB(b, h) + boff + n * 2048); dst[n].hi = *(const PG8_LAS i32x4*)(lds + PG8_SB(b, h) + boff + n * 2048 + 1024); } } while (0)
#define PG8_MMA(ai, bj, At, Bt) do { __builtin_amdgcn_s_setprio(1); \
        if constexpr (Epi::FP8) { _Pragma("unroll") for (int m = 0; m < 4; ++m) _Pragma("unroll") for (int n = 0; n < 2; ++n) \
            asm volatile("v_mfma_scale_f32_16x16x128_f8f6f4 %0, %1, %2, %0, %3, %4 op_sel_hi:[0,0,0]" : "+v"(acc[ai][bj][m][n]) : "v"(Bt[n]), "v"(At[m]), "v"(sc_w_), "v"(sc_a_)); } \
        else { _Pragma("unroll") for (int m = 0; m < 4; ++m) _Pragma("unroll") for (int n = 0; n < 2; ++n) { \
            const i32x4 bl_ = Bt[n].lo, bh_ = Bt[n].hi, al_ = At[m].lo, ah_ = At[m].hi;     \
            acc[ai][bj][m][n] = __builtin_amdgcn_mfma_f32_16x16x32_bf16(__builtin_bit_cast(bf16x8, bl_), __builtin_bit_cast(bf16x8, al_), acc[ai][bj][m][n], 0, 0, 0); \
            acc[ai][bj][m][n] = __builtin_amdgcn_mfma_f32_16x16x32_bf16(__builtin_bit_cast(bf16x8, bh_), __builtin_bit_cast(bf16x8, ah_), acc[ai][bj][m][n], 0, 0, 0); } } \
        __builtin_amdgcn_s_setprio(0); } while (0)
#define PG8_WAIT_V(n) asm volatile("s_waitcnt vmcnt(" #n ")" ::: "memory")
#define PG8_WAIT_L(n) asm volatile("s_waitcnt lgkmcnt(" #n ")" ::: "memory")
#define PG8_BAR __builtin_amdgcn_s_barrier()
#define PG8_SCHED __builtin_amdgcn_sched_barrier(0)
    Unit cur, nxt; int ui = 0;
    if (!S.next(0, cur)) return;
    f32x4 acc[2][2][4][2];
#pragma unroll
    for (int a = 0; a < 2; ++a)
#pragma unroll
        for (int b = 0; b < 2; ++b)
#pragma unroll
            for (int m = 0; m < 4; ++m)
#pragma unroll
                for (int n = 0; n < 2; ++n) acc[a][b][m][n] = (f32x4){0.f, 0.f, 0.f, 0.f};
    i32x8 At[4], B0[2], B1[2];
    auto a_base_ = [&](const Unit& u_) -> const char* { return g.cmode ? (const char*)g.A + ((long)(u_.pm / 67) * 16384 + (long)(u_.pm % 67) * 248 - 2) * (long)g.lda * 2 : (const char*)g.A + (size_t)u_.pm * tstepA + (size_t)(u_.pn >> g.a_shift) * g.a_bytes; };
    const char* cA = a_base_(cur); const char* cB = (const char*)g.Bt + (size_t)cur.pn * tstepB;
    S.a_ready(cur);
    PG8_STAGE(PG8_SB(0, 0), cB, voffB); PG8_STAGE(PG8_SA(0, 0), cA, voffA); PG8_STAGE(PG8_SB(0, 1), cB + hstepB, voffB); PG8_STAGE(PG8_SA(0, 1), cA + hstepA, voffA);
    if (wr == 1) PG8_BAR;
    PG8_WAIT_V(4); PG8_BAR;
    PG8_STAGE(PG8_SB(1, 0), cB + kstep, voffB); PG8_STAGE(PG8_SA(1, 0), cA + kstep, voffA); PG8_STAGE(PG8_SB(1, 1), cB + hstepB + kstep, voffB);
    PG8_WAIT_V(6); PG8_BAR;
    PG8_STAMP();
    for (;;) {
        const bool has_next = S.next(ui + 1, nxt);
        const char* nA = has_next ? a_base_(nxt) : cA; const char* nB = has_next ? (const char*)g.Bt + (size_t)nxt.pn * tstepB : cB;
        for (int t = 0; t < nt; t += 2) {
            const bool last = (t == nt - 2);
            const char* a1 = cA + (size_t)(t + 1) * kstep;
            const char* a2 = last ? nA : cA + (size_t)(t + 2) * kstep; const char* b2 = last ? nB : cB + (size_t)(t + 2) * kstep;
            const char* a3 = a2 + kstep; const char* b3 = b2 + kstep;
            if (last && has_next) S.a_ready(nxt);
            PG8_LDB(B0, 0, 0); PG8_SCHED; PG8_LDA(At, 0, 0); PG8_STAGE(PG8_SA(1, 1), a1 + hstepA, voffA);
            PG8_WAIT_L(8); PG8_BAR; PG8_WAIT_L(0); PG8_MMA(0, 0, At, B0); PG8_BAR; PG8_SCHED;
            PG8_LDB(B1, 0, 1); PG8_STAGE(PG8_SB(0, 0), b2, voffB);
            PG8_BAR; PG8_WAIT_L(0); PG8_MMA(0, 1, At, B1); PG8_BAR;
            PG8_LDA(At, 0, 1); PG8_STAGE(PG8_SA(0, 0), a2, voffA);
            PG8_BAR; PG8_WAIT_L(0); PG8_MMA(1, 0, At, B0); PG8_BAR; PG8_SCHED;
            PG8_STAGE(PG8_SB(0, 1), b2 + hstepB, voffB);
            PG8_WAIT_V(6); PG8_BAR; PG8_MMA(1, 1, At, B1); PG8_BAR;
            PG8_LDB(B0, 1, 0); PG8_SCHED; PG8_LDA(At, 1, 0); PG8_STAGE(PG8_SA(0, 1), a2 + hstepA, voffA);
            PG8_WAIT_L(8); PG8_BAR; PG8_WAIT_L(0); PG8_MMA(0, 0, At, B0); PG8_BAR; PG8_SCHED;
            PG8_LDB(B1, 1, 1); PG8_STAGE(PG8_SB(1, 0), b3, voffB);
            PG8_BAR; PG8_WAIT_L(0); PG8_MMA(0, 1, At, B1); PG8_BAR;
            PG8_LDA(At, 1, 1); PG8_STAGE(PG8_SA(1, 0), a3, voffA);
            PG8_BAR; PG8_WAIT_L(0); PG8_MMA(1, 0, At, B0); PG8_BAR; PG8_SCHED;
            PG8_STAGE(PG8_SB(1, 1), b3 + hstepB, voffB);
            PG8_WAIT_V(6); PG8_BAR; PG8_MMA(1, 1, At, B1); PG8_BAR;
        }
        PG8_STAMP();
        if constexpr (Epi::FP8) { asm volatile("s_nop 15\n\ts_nop 15" ::: "memory"); }
        if constexpr (!Epi::AFTER_DRAIN) {
#if PG8_EPI_RECOMP
            const int t2_ = opaque_tid(), l2_ = t2_ & 63, w2_ = __builtin_amdgcn_readfirstlane(t2_ >> 6);
            E(acc, cur, w2_ >> 2, w2_ & 3, l2_ & 15, l2_ >> 4); S.done(cur);
#else
            E(acc, cur, wr, wc, fr, fq); S.done(cur);
#endif
        }
        PG8_STAMP();
        if (!has_next) break;
#pragma unroll
        for (int a = 0; a < 2; ++a)
#pragma unroll
            for (int b = 0; b < 2; ++b)
#pragma unroll
                for (int m = 0; m < 4; ++m)
#pragma unroll
                    for (int n = 0; n < 2; ++n) acc[a][b][m][n] = (f32x4){0.f, 0.f, 0.f, 0.f};
        cur = nxt; cA = nA; cB = nB; ++ui;
    }
    PG8_WAIT_V(0);
    if (wr == 0) PG8_BAR;
    PG8_BAR;
    if constexpr (Epi::AFTER_DRAIN) { E.fused(acc, cur, wr, wc, fr, fq, lds, wid, lane); S.done(cur); }
    PG8_STAMP();
    if (STAMP && wid == 0) { stamps[lane] = lane < nts ? (((unsigned long long)(unsigned)ts_hi << 32) | (unsigned)ts_lo) : 0ull;
        if (lane == 62) stamps[62] = rt_entry; if (lane == 63) stamps[63] = (unsigned long long)wall_clock64(); }
#undef PG8_STAMP
#undef PG8_SA
#undef PG8_SB
#undef PG8_STAGE
#undef PG8_LDA
#undef PG8_LDB
#undef PG8_MMA
#undef PG8_WAIT_V
#undef PG8_WAIT_L
#undef PG8_BAR
#undef PG8_SCHED
}
}

#include <cstdio>
#include <ctime>
#include <cstdlib>
#include <cstring>
#include <cmath>
#include <vector>

template <class F, bool F8 = false> struct EpiG {
    static constexpr bool PERM = false, AFTER_DRAIN = false, FP8 = F8;
    F f;
    __device__ __forceinline__ void operator()(const f32x4 (&acc)[2][2][4][2], const pg8::Unit& u, int wr, int wc, int fr, int fq) const {
        const int row0 = u.pm * 256 + wr * 64 + fr, col0 = u.pn * 256 + wc * 32 + 4 * fq;
#pragma unroll
        for (int ai = 0; ai < 2; ++ai)
#pragma unroll
            for (int m = 0; m < 4; ++m)
#pragma unroll
                for (int bj = 0; bj < 2; ++bj)
#pragma unroll
                    for (int n = 0; n < 2; ++n) f(row0 + ai * 128 + m * 16, col0 + bj * 128 + n * 16, acc[ai][bj][m][n]);
    }
};
__device__ __forceinline__ void st_bf16x4(bf16_t* p, f32x4 v) { u32x2 w; w.x = pack2bf(v[0], v[1]); w.y = pack2bf(v[2], v[3]); *(u32x2*)p = w; }
__device__ __forceinline__ void st_f32x4(float* p, f32x4 v) { *(f32x4*)p = v; }

struct FStoreBf16 { bf16_t* O; int ldc; int pad_; __device__ __forceinline__ void operator()(int r, int c, f32x4 v) const { st_bf16x4(O + (size_t)r * ldc + c, v); } };
struct FAbIn { bf16_t *Q, *K, *V; float *QI, *U, *WI; unsigned short* KI16;
    __device__ __forceinline__ void operator()(int r, int c, f32x4 v) const {
        if (c < 1024) st_bf16x4(Q + (size_t)r * 1024 + c, v);
        else if (c < 2048) st_bf16x4(K + (size_t)r * 1024 + (c - 1024), v);
        else if (c < 3072) st_bf16x4(V + (size_t)r * 1024 + (c - 2048), v);
        else if (c < 4096) st_f32x4(QI + (size_t)r * 1024 + (c - 3072), v);
        else if (c < 5120) st_f32x4(U + (size_t)r * 1024 + (c - 4096), v);
        else if (c < 5184) { typedef _Float16 h2 __attribute__((ext_vector_type(2))); union { h2 h; unsigned u; } a, b; a.h = (h2){(_Float16)v[0], (_Float16)v[1]}; b.h = (h2){(_Float16)v[2], (_Float16)v[3]};
            u32x2 w; w.x = a.u; w.y = b.u; *(u32x2*)(KI16 + (size_t)r * 64 + (c - 5120)) = w; }
        else if (c < 5200) st_f32x4(WI + (size_t)r * 16 + (c - 5184), v);
    } };
struct FCdIn { float *CQ, *CKV, *KR; bf16_t *XL, *YG;
    __device__ __forceinline__ void operator()(int r, int c, f32x4 v) const {
        if (c < 512) st_f32x4(CQ + (size_t)r * 512 + c, v);
        else if (c < 768) st_f32x4(CKV + (size_t)r * 256 + (c - 512), v);
        else if (c < 832) st_f32x4(KR + (size_t)r * 64 + (c - 768), v);
        else if (c < 1024) {}
        else if (c < 2048) st_bf16x4(XL + (size_t)r * 1024 + (c - 1024), v);
        else st_bf16x4(YG + (size_t)r * 1024 + (c - 2048), v);
    } };
struct FKvUp { bf16_t *K1, *V1;
    __device__ __forceinline__ void operator()(int r, int c, f32x4 v) const {
        const int h = c >> 8, d = c & 255;
        if (d < 128) st_bf16x4(K1 + (size_t)r * 1536 + h * 192 + d, v);
        else st_bf16x4(V1 + (size_t)r * 1024 + h * 128 + (d - 128), v);
    } };

__device__ __forceinline__ unsigned ord_key(float f) { const unsigned b = __float_as_uint(f); return (b & 0x80000000u) ? ~b : (b | 0x80000000u); }
__device__ __forceinline__ void rope_cs(int pos, int i, float& c, float& s) { const float freq = powf(10000.0f, -(float)i / 32.0f); const float ang = (float)pos * freq; sincosf(ang, &s, &c); }
#define PV8_MLA 1
#define PV8_DSA 1

typedef short bf16x8 __attribute__((ext_vector_type(8)));
typedef float f32x16 __attribute__((ext_vector_type(16)));
__device__ __forceinline__ unsigned cvtpk(float lo, float hi) { unsigned r; asm("v_cvt_pk_bf16_f32 %0, %1, %2" : "=v"(r) : "v"(lo), "v"(hi)); return r; }
__device__ __forceinline__ float max3_asm(float a, float b, float c) { float r; asm("v_max3_f32 %0, %1, %2, %3" : "=v"(r) : "v"(a), "v"(b), "v"(c)); return r; }

struct AttnArgs { const bf16_t* Q; const bf16_t* K; const bf16_t* VT; const unsigned long long* MT; bf16_t* O; int ldq, ldk, ldo; float sc_log2e; };

static constexpr int ATT_MTBL = 65536;
struct TTrue { static constexpr bool value = true; }; struct TFalse { static constexpr bool value = false; };
typedef int i32x8q __attribute__((ext_vector_type(8)));
typedef int i32x4q __attribute__((ext_vector_type(4)));
#define MFMA8_FENCE2(acc0, acc1, srcA, srcB) asm volatile("s_nop 15\n\ts_nop 9" : "+v"(acc0), "+v"(acc1) : "v"(srcA), "v"(srcB))
#define MFMA8_FENCE4(a0_, a1_, a2_, a3_, srcA, srcB) asm volatile("s_nop 15\n\ts_nop 9" : "+v"(a0_), "+v"(a1_), "+v"(a2_), "+v"(a3_) : "v"(srcA), "v"(srcB))
template <int DQK, bool MASKED, bool QK8>
__device__ __forceinline__ void attn_item3(LAS unsigned char* lds, const AttnArgs& a, int b, int h, int qb) {
    constexpr int NKS = QK8 ? DQK / 64 : DQK / 16, PK = QK8 ? DQK : DQK * 2, PV = 64, KB_BYTES = 64 * PK, VB_BYTES = 128 * PV, NPK = PK / 16, NKP = (64 * NPK + 511) / 512, V_OFF = 3 * KB_BYTES;
    const int tid = opaque_tid(), lane = tid & 63, w = __builtin_amdgcn_readfirstlane(tid >> 6), n = lane & 31, hf = lane >> 5;
    const int nt = 4 * qb + 4, cw = 4 * qb + (w >> 1);
    const int trow = qb * 256 + w * 32 + n;
    const size_t grow = (size_t)b * SEQ + trow;
    bf16x8 qf[QK8 ? 1 : NKS]; i32x8q q8[QK8 ? NKS : 1];
    if (QK8) { const unsigned char* qp = (const unsigned char*)a.Q + grow * a.ldq + h * DQK + hf * 32;
#pragma unroll
      for (int ks = 0; ks < NKS; ++ks) { q8[ks].lo = *(const i32x4q*)(qp + ks * 64); q8[ks].hi = *(const i32x4q*)(qp + ks * 64 + 16); } }
    else { const bf16_t* qp = a.Q + grow * a.ldq + h * DQK + hf * 8;
#pragma unroll
      for (int ks = 0; ks < NKS; ++ks) qf[ks] = *(const bf16x8*)(qp + ks * 16); }
    f32x16 o[4];
#pragma unroll
    for (int dt = 0; dt < 4; ++dt)
#pragma unroll
        for (int r = 0; r < 16; ++r) o[dt][r] = 0.f;
    float m_run = MASKED ? -1000.0f : -INFINITY, l_run = 0.f;
    const float c = a.sc_log2e;
    const unsigned char* Kg = (const unsigned char*)a.K + ((size_t)b * SEQ * a.ldk + h * DQK) * (QK8 ? 1 : 2);
    const unsigned char* Vg = (const unsigned char*)a.VT + (size_t)(b * 8 + h) * 128 * SEQ;
    const unsigned long long* Mg = MASKED ? a.MT + (size_t)b * 256 * SEQ + trow : nullptr;
    auto dma_k = [&](int kt) {
        LAS unsigned char* kb = lds + (kt % 3) * KB_BYTES;
#pragma unroll
        for (int i = 0; i < NKP; ++i) { if ((w + 8 * i) * 64 >= 64 * NPK) break;
            const int s = (w + 8 * i) * 64 + lane, r = s / NPK, cp = s % NPK, cc = cp ^ (NPK == 16 ? (r & 15) : (NPK == 12 ? ((r >> 2) & 3) : ((r >> 1) & 7)));
            __builtin_amdgcn_global_load_lds((const unsigned*)(Kg + ((size_t)(kt * 64 + r) * a.ldk) * (QK8 ? 1 : 2) + cc * 16), (LAS unsigned*)(kb + (w + 8 * i) * 1024), 16, 0, 0); }
    };
    auto dma_v = [&](int kt) {
        LAS unsigned char* vb = lds + V_OFF + (kt & 1) * VB_BYTES;
        const int s = w * 64 + lane, d = s >> 2, cp = s & 3, cc = cp ^ ((d >> 2) & 3);
        __builtin_amdgcn_global_load_lds((const unsigned*)(Vg + (size_t)d * SEQ + kt * 64 + cc * 16), (LAS unsigned*)(vb + w * 1024), 16, 0, 0);
    };
    const int kswz = (NPK == 16) ? (n & 15) : (NPK == 12 ? ((n >> 2) & 3) : ((n >> 1) & 7)), vswz = (n >> 2) & 3;
    auto qk = [&](int kt, f32x16& s0, f32x16& s1, bool fence) {
        const LAS unsigned char* ka = lds + (kt % 3) * KB_BYTES + n * PK;
#pragma unroll
        for (int r = 0; r < 16; ++r) { s0[r] = 0.f; s1[r] = 0.f; }
        if (QK8) {
#pragma unroll
            for (int ks = 0; ks < NKS; ++ks) {
                const int p0 = ((4 * ks + 2 * hf) ^ kswz) * 16, p1 = ((4 * ks + 2 * hf + 1) ^ kswz) * 16;
                i32x8q a0, a1;
                a0.lo = *(const LAS i32x4q*)(ka + p0); a0.hi = *(const LAS i32x4q*)(ka + p1);
                a1.lo = *(const LAS i32x4q*)(ka + 32 * PK + p0); a1.hi = *(const LAS i32x4q*)(ka + 32 * PK + p1);
                s0 = __builtin_amdgcn_mfma_scale_f32_32x32x64_f8f6f4(a0, q8[ks], s0, 0, 0, 0, 0x7F7F7F7F, 0, 0x7F7F7F7F);
                s1 = __builtin_amdgcn_mfma_scale_f32_32x32x64_f8f6f4(a1, q8[ks], s1, 0, 0, 0, 0x7F7F7F7F, 0, 0x7F7F7F7F);
                if (ks == NKS - 1 && fence) MFMA8_FENCE2(s0, s1, a0, a1);
            }
        } else {
#pragma unroll
            for (int ks = 0; ks < NKS; ++ks) {
                const int po = ((2 * ks + hf) ^ kswz) * 16;
                const bf16x8 a0 = *(const LAS bf16x8*)(ka + po), a1 = *(const LAS bf16x8*)(ka + 32 * PK + po);
                s0 = __builtin_amdgcn_mfma_f32_32x32x16_bf16(a0, qf[ks], s0, 0, 0, 0);
                s1 = __builtin_amdgcn_mfma_f32_32x32x16_bf16(a1, qf[ks], s1, 0, 0, 0);
            }
        }
    };
    i32x8q idA0, idA1;
#pragma unroll
    for (int i = 0; i < 8; ++i) { const int v = (i == (n >> 2)) ? (0x38 << (8 * (n & 3))) : 0; idA0[i] = hf ? 0 : v; idA1[i] = hf ? v : 0; }
    auto maskmma = [&](unsigned long long mw, f32x16& s0, f32x16& s1, bool fence) {
        if (MASKED) {
            const unsigned bits = hf ? (unsigned)(mw >> 32) : (unsigned)mw;
            const LAS u32x2* tbl = (const LAS u32x2*)(lds + ATT_MTBL);
            i32x8q bm;
#pragma unroll
            for (int i = 0; i < 4; ++i) { const u32x2 t = tbl[(bits >> (8 * i)) & 255u]; bm[2 * i] = (int)t.x; bm[2 * i + 1] = (int)t.y; }
            s0 = __builtin_amdgcn_mfma_scale_f32_32x32x64_f8f6f4(idA0, bm, s0, 0, 0, 0, 0x7F7F7F7F, 0, (int)0x82828282);
            s1 = __builtin_amdgcn_mfma_scale_f32_32x32x64_f8f6f4(idA1, bm, s1, 0, 0, 0, 0x7F7F7F7F, 0, (int)0x82828282);
            MFMA8_FENCE2(s0, s1, idA1, bm);
        }
    };
    auto rowmax = [&](f32x16& s0, f32x16& s1) -> float {
        float mx = max3_asm(s0[0], s1[0], s0[1]);
        mx = max3_asm(mx, s1[1], s0[2]);
#pragma unroll
        for (int r = 2; r < 15; ++r) mx = max3_asm(mx, s1[r], s0[r + 1]);
        mx = max3_asm(mx, s1[15], mx);
        const auto rr = __builtin_amdgcn_permlane32_swap(__float_as_uint(mx), __float_as_uint(mx), false, false);
        return fmaxf(__uint_as_float(rr[0]), __uint_as_float(rr[1]));
    };
    auto pv = [&](const f32x16& c0, const f32x16& c1, int kt, bool fence) {
        i32x8q pb;
#pragma unroll
        for (int i = 0; i < 4; ++i) { int d0 = 0, d1 = 0;
            d0 = __builtin_amdgcn_cvt_pk_fp8_f32(c0[4 * i], c0[4 * i + 1], d0, false); d0 = __builtin_amdgcn_cvt_pk_fp8_f32(c0[4 * i + 2], c0[4 * i + 3], d0, true);
            d1 = __builtin_amdgcn_cvt_pk_fp8_f32(c1[4 * i], c1[4 * i + 1], d1, false); d1 = __builtin_amdgcn_cvt_pk_fp8_f32(c1[4 * i + 2], c1[4 * i + 3], d1, true);
            pb[i] = d0; pb[4 + i] = d1; }
        const LAS unsigned char* va = lds + V_OFF + (kt & 1) * VB_BYTES + n * PV;
        const int q0_ = ((2 * hf) ^ vswz) * 16, q1_ = ((2 * hf + 1) ^ vswz) * 16;
#pragma unroll
        for (int dt = 0; dt < 4; ++dt) { i32x8q vf; vf.lo = *(const LAS i32x4q*)(va + dt * 32 * PV + q0_); vf.hi = *(const LAS i32x4q*)(va + dt * 32 * PV + q1_);
            o[dt] = __builtin_amdgcn_mfma_scale_f32_32x32x64_f8f6f4(vf, pb, o[dt], 0, 0, 0, 0x7F7F7F7F, 0, 0x79797979);
            if (dt == 3) MFMA8_FENCE4(o[0], o[1], o[2], o[3], vf, pb); }
    };
    dma_k(0); dma_v(0); if (nt > 1) dma_k(1);
    unsigned long long mw_pre = MASKED ? Mg[(size_t)(nt > 1 ? 1 : 0) * SEQ] : 0ull;
    asm volatile("s_waitcnt vmcnt(0)" ::: "memory");
    __syncthreads();
    f32x16 sa0, sa1, sb0, sb1;
    qk(0, sa0, sa1, true); maskmma(MASKED ? Mg[0] : 0ull, sa0, sa1, true);
    float mx_cur = rowmax(sa0, sa1);
    auto step = [&](int kt, f32x16& c0, f32x16& c1, f32x16& n0, f32x16& n1, auto full_tag) {
        constexpr bool FULL = decltype(full_tag)::value;
        if (kt + 2 < nt) dma_k(kt + 2);
        if (kt + 1 < nt) dma_v(kt + 1);
        const unsigned long long mw_now = mw_pre;
        if (MASKED) mw_pre = Mg[(size_t)(kt + 2 < nt ? kt + 2 : kt) * SEQ];
        const bool act = FULL || kt <= cw, actn = FULL || kt + 1 <= cw;
        const float m_new = fmaxf(m_run, mx_cur);
        const float m_use = (MASKED && m_new == -INFINITY) ? 0.f : m_new;
        if (act && __any(m_new > m_run)) {
            const float al = __builtin_amdgcn_exp2f((m_run - m_use) * c);
            l_run *= al;
#pragma unroll
            for (int dt = 0; dt < 4; ++dt)
#pragma unroll
                for (int r = 0; r < 16; ++r) o[dt][r] *= al;
        }
        if (act) m_run = m_new;
        if (FULL) {
            qk(kt + 1, n0, n1, !MASKED); maskmma(mw_now, n0, n1, true);
            const float mc = m_use * c - 6.0f;
            float ps = 0.f;
#pragma unroll
            for (int r = 0; r < 16; ++r) { c0[r] = __builtin_amdgcn_exp2f(fmaf(c0[r], c, -mc)); c1[r] = __builtin_amdgcn_exp2f(fmaf(c1[r], c, -mc)); ps += c0[r] + c1[r]; }
            l_run += ps;
            pv(c0, c1, kt, true);
            mx_cur = rowmax(n0, n1);
        } else {
            if (actn) { qk(kt + 1, n0, n1, true); maskmma(mw_now, n0, n1, true); }
            if (act) {
                const float mc = m_use * c - 6.0f;
                float ps = 0.f;
#pragma unroll
                for (int r = 0; r < 16; ++r) { c0[r] = __builtin_amdgcn_exp2f(fmaf(c0[r], c, -mc)); c1[r] = __builtin_amdgcn_exp2f(fmaf(c1[r], c, -mc)); ps += c0[r] + c1[r]; }
                l_run += ps;
                pv(c0, c1, kt, true);
            }
            if (actn) mx_cur = rowmax(n0, n1);
        }
        asm volatile("s_waitcnt vmcnt(0)" ::: "memory");
        __syncthreads();
    };
    int kt = 0;
    for (; kt < 4 * qb; kt += 2) { step(kt, sa0, sa1, sb0, sb1, TTrue{}); step(kt + 1, sb0, sb1, sa0, sa1, TTrue{}); }
    for (; kt < nt; kt += 2) { step(kt, sa0, sa1, sb0, sb1, TFalse{}); step(kt + 1, sb0, sb1, sa0, sa1, TFalse{}); }
    const float lt = l_run + __shfl_xor(l_run, 32);
    const float inv = 64.0f / lt;
    bf16_t* op = a.O + grow * a.ldo + h * 128 + hf * 4;
#pragma unroll
    for (int dt = 0; dt < 4; ++dt)
#pragma unroll
        for (int r4 = 0; r4 < 4; ++r4) { u32x2 wv; wv.x = cvtpk(o[dt][4 * r4] * inv, o[dt][4 * r4 + 1] * inv); wv.y = cvtpk(o[dt][4 * r4 + 2] * inv, o[dt][4 * r4 + 3] * inv);
            *(u32x2*)(op + dt * 32 + r4 * 8) = wv; }
}
template <int DQK, bool MASKED>
__device__ __forceinline__ void attn_phase(LAS unsigned char* lds, const AttnArgs& a, int bid, int nblk) {
    if (MASKED) {
        const int t = opaque_tid();
        if (t < 256) { unsigned lo = 0u, hi = 0u;
#pragma unroll
            for (int i = 0; i < 4; ++i) { if (!((t >> i) & 1)) lo |= 0xFEu << (8 * i); if (!((t >> (4 + i)) & 1)) hi |= 0xFEu << (8 * i); }
            u32x2 v; v.x = lo; v.y = hi; ((LAS u32x2*)(lds + ATT_MTBL))[t] = v; }
        __syncthreads();
    }
    for (int p = bid; p < 512; p += nblk) {
        const int bh = (p & 7) + 8 * (p >> 8), j = (p >> 3) & 31;
#pragma unroll 1
        for (int i = 0; i < 2; ++i) attn_item3<DQK, MASKED, true>(lds, a, bh >> 3, bh & 7, i ? j : 63 - j);
    }
}

#ifdef IDX_PROBE_FINAL
#define IDX_PF_ 1
#else
#define IDX_PF_ 0
#endif
typedef _Float16 f16x8 __attribute__((ext_vector_type(8)));
struct IdxArgs { const float* QI; const unsigned short* KI16; const float* WI; unsigned long long* MT; };
static constexpr int IDX_CAP = 640, IDX_CS = 0, IDX_CI = 32 * IDX_CAP * 4, IDX_KT = IDX_CI + 32 * IDX_CAP * 2, IDX_CNT = IDX_KT + 32768, IDX_TAU = IDX_CNT + 128, IDX_LDS = IDX_TAU + 128;
static_assert(IDX_KT % 1024 == 0, "K tile buffers must be 1 KiB aligned");

__device__ __forceinline__ float ord_inv(unsigned T) { return __uint_as_float((T & 0x80000000u) ? (T & 0x7FFFFFFFu) : ~T); }
__device__ __forceinline__ unsigned lane_prefix(unsigned long long m) { return __builtin_amdgcn_mbcnt_hi((unsigned)(m >> 32), __builtin_amdgcn_mbcnt_lo((unsigned)m, 0u)); }
__device__ __forceinline__ float relu_asm(float x) { float y; asm("v_max_f32 %0, 0, %1" : "=v"(y) : "v"(x)); return y; }
__device__ __forceinline__ void glds16(const void* gsrc, unsigned lds_dst) {
    unsigned keep;
    asm volatile("s_mov_b32 %0, m0\n\ts_mov_b32 m0, %2\n\ts_nop 0\n\tglobal_load_lds_dwordx4 %1, off\n\ts_mov_b32 m0, %0" : "=&s"(keep) : "v"(gsrc), "s"(lds_dst) : "memory");
}

template <bool EXACT> __device__ __forceinline__ int idx_compact(LAS unsigned char* lds, int qq, int lane, int n, float& tau) {
    LAS float* cs = (LAS float*)(lds + IDX_CS) + qq * IDX_CAP; LAS unsigned short* ci = (LAS unsigned short*)(lds + IDX_CI) + qq * IDX_CAP;
    float sv[10]; unsigned short iv[10]; unsigned uk[10];
#pragma unroll
    for (int j = 0; j < 10; ++j) { const int idx = lane + 64 * j; const bool valid = idx < n; sv[j] = cs[idx]; iv[j] = ci[idx]; uk[j] = valid ? ord_key(sv[j]) : 0u; }
    auto count_ge = [&](unsigned t) { int c = 0;
#pragma unroll
        for (int j = 0; j < 10; ++j) c += __builtin_popcountll(__ballot(uk[j] >= t));
        return c; };
    unsigned lo = ord_key(tau), hi = 0xFF800001u;
    if (lo > 0x80800000u) { const unsigned h2 = lo + 0x00800000u;
        if (h2 < hi) { if (count_ge(h2) >= 256) lo = h2; else hi = h2; } }
    while (hi - lo > 1u) {
        const unsigned mid = lo + ((hi - lo) >> 1); const int c = count_ge(mid);
        if (c >= 256) { lo = mid; if (!EXACT && c <= 336) break; } else hi = mid;
    }
    const unsigned T = lo;
    int need = 0;
    if (EXACT) { int ngt = 0;
#pragma unroll
        for (int j = 0; j < 10; ++j) ngt += __builtin_popcountll(__ballot(uk[j] > T));
        need = 256 - ngt; }
    int base = 0, tiebase = 0;
#pragma unroll
    for (int j = 0; j < 10; ++j) {
        bool keep;
        if (EXACT) { const bool gt = uk[j] > T, eq = uk[j] == T; const unsigned long long em = __ballot(eq); keep = gt || (eq && (tiebase + (int)lane_prefix(em)) < need); tiebase += __builtin_popcountll(em); }
        else keep = uk[j] >= T;
        const unsigned long long km = __ballot(keep);
        const int pos = base + (int)lane_prefix(km);
        if (keep) { cs[pos] = sv[j]; ci[pos] = iv[j]; }
        base += __builtin_popcountll(km);
    }
    tau = ord_inv(T);
    return base;
}

__device__ __forceinline__ void idx_item(LAS unsigned char* lds, const IdxArgs& a, int b, int hc) {
    const int tid = opaque_tid(), lane = tid & 63, w = __builtin_amdgcn_readfirstlane(tid >> 6), n = lane & 31, hf = lane >> 5;
    const int t0 = hc * 32, L = (t0 / 64 + 1) * 64, nsub = L / 32, ntile = (L + 127) / 128;
    const size_t q0 = (size_t)b * SEQ + t0 + 4 * w;
    LAS float* cs = (LAS float*)(lds + IDX_CS); LAS unsigned short* ci = (LAS unsigned short*)(lds + IDX_CI);
    LAS unsigned* cnt = (LAS unsigned*)(lds + IDX_CNT);
    f16x8 qf[2][4];
#pragma unroll
    for (int rt = 0; rt < 2; ++rt) { const float* qp = a.QI + (q0 + 2 * rt + (n >> 4)) * 1024 + (n & 15) * 64 + hf * 8;
#pragma unroll
        for (int ks = 0; ks < 4; ++ks) { const f32x4 x0 = *(const f32x4*)(qp + ks * 16), x1 = *(const f32x4*)(qp + ks * 16 + 4);
            f16x8 v; v[0] = (_Float16)x0[0]; v[1] = (_Float16)x0[1]; v[2] = (_Float16)x0[2]; v[3] = (_Float16)x0[3]; v[4] = (_Float16)x1[0]; v[5] = (_Float16)x1[1]; v[6] = (_Float16)x1[2]; v[7] = (_Float16)x1[3];
            qf[rt][ks] = v; } }
    float wv[2][16];
#pragma unroll
    for (int rt = 0; rt < 2; ++rt)
#pragma unroll
        for (int r = 0; r < 16; ++r) wv[rt][r] = a.WI[(q0 + 2 * rt + (r >> 3)) * 16 + (((r & 3) + 8 * (r >> 2) + 4 * hf) & 15)] * (0.125f * 0.25f);
    if (tid < 32) cnt[tid] = 0u;
    int cq0 = 0, cq1 = 0, cq2 = 0, cq3 = 0;
    float tq0 = -INFINITY, tq1 = -INFINITY, tq2 = -INFINITY, tq3 = -INFINITY;
    float tau0 = INFINITY, tau1 = INFINITY;
    const unsigned short* Kg = a.KI16 + (size_t)b * SEQ * 64;
    const unsigned ldsbase = (unsigned)(size_t)lds;
    auto dma = [&](int kt, int buf) {
#pragma unroll
        for (int i = 0; i < 2; ++i) { const int s = (w + 8 * i) * 64 + lane, r = s >> 3, cp = s & 7, cc = cp ^ ((r >> 1) & 7);
            glds16(Kg + (size_t)(kt * 128 + r) * 64 + cc * 8, ldsbase + IDX_KT + buf * 16384 + (w + 8 * i) * 1024); }
    };
    dma(0, 0);
    asm volatile("s_waitcnt vmcnt(0)" ::: "memory");
    __syncthreads();
    const int kswz = (n >> 1) & 7;
    f32x16 accA[2], accB[2];
#pragma unroll
    for (int rt = 0; rt < 2; ++rt)
#pragma unroll
        for (int r = 0; r < 16; ++r) { accA[rt][r] = 0.f; accB[rt][r] = 0.f; }
    int keyA = 0, keyB = 0;
    auto epilogue = [&](const f32x16 (&acc)[2], int key) {
        float sc[2];
#pragma unroll
        for (int rt = 0; rt < 2; ++rt) { float pa = 0.f, pb = 0.f;
#pragma unroll
            for (int r = 0; r < 8; ++r) { pa = fmaf(relu_asm(acc[rt][r]), wv[rt][r], pa); pb = fmaf(relu_asm(acc[rt][r + 8]), wv[rt][r + 8], pb); }
            const auto rr = __builtin_amdgcn_permlane32_swap(__float_as_uint(pa), __float_as_uint(pb), false, false);
            sc[rt] = __uint_as_float(rr[0]) + __uint_as_float(rr[1]); }
        const bool c0 = sc[0] > tau0, c1 = sc[1] > tau1;
        const unsigned long long m0 = __ballot(c0), m1 = __ballot(c1);
        if (m0 | m1) {
            const unsigned l0 = (unsigned)m0, h0 = (unsigned)(m0 >> 32), l1 = (unsigned)m1, h1 = (unsigned)(m1 >> 32);
            const int p0 = hf ? cq1 + (int)__builtin_amdgcn_mbcnt_hi(h0, 0u) : cq0 + (int)__builtin_amdgcn_mbcnt_lo(l0, 0u);
            const int p1 = hf ? cq3 + (int)__builtin_amdgcn_mbcnt_hi(h1, 0u) : cq2 + (int)__builtin_amdgcn_mbcnt_lo(l1, 0u);
            if (c0 && p0 < IDX_CAP) { const int qq = 4 * w + hf; cs[qq * IDX_CAP + p0] = sc[0]; ci[qq * IDX_CAP + p0] = (unsigned short)key; }
            if (c1 && p1 < IDX_CAP) { const int qq = 4 * w + 2 + hf; cs[qq * IDX_CAP + p1] = sc[1]; ci[qq * IDX_CAP + p1] = (unsigned short)key; }
            cq0 += __builtin_popcount(l0); cq1 += __builtin_popcount(h0); cq2 += __builtin_popcount(l1); cq3 += __builtin_popcount(h1);
        }
    };
    auto mma = [&](f32x16 (&acc)[2], const LAS unsigned char* kr) {
        f16x8 kf[4];
#pragma unroll
        for (int ks = 0; ks < 4; ++ks) kf[ks] = *(const LAS f16x8*)(kr + ((2 * ks + hf) ^ kswz) * 16);
#pragma unroll
        for (int rt = 0; rt < 2; ++rt) {
            f32x16 c;
#pragma unroll
            for (int r = 0; r < 16; ++r) c[r] = 0.f;
#pragma unroll
            for (int ks = 0; ks < 4; ++ks) c = __builtin_amdgcn_mfma_f32_32x32x16_f16(qf[rt][ks], kf[ks], c, 0, 0, 0);
            acc[rt] = c; }
    };
#ifdef IDX_PROBE2
  for (int rep_ = 0; rep_ < 2; ++rep_) {
    if (rep_ == 1) { epilogue(accB, keyB); tau0 = INFINITY; tau1 = INFINITY; __syncthreads(); dma(0, 0); asm volatile("s_waitcnt vmcnt(0)" ::: "memory"); __syncthreads(); }
#endif
    for (int kt = 0; kt < ntile; ++kt) {
        if (kt + 1 < ntile) dma(kt + 1, (kt + 1) & 1);
#ifdef IDX_PROBE2
        if (rep_ == 0)
#endif
        { const unsigned c_all = cnt[lane & 31];
          if (__ballot(c_all > (unsigned)(IDX_CAP - 160))) {
              if (cq0 > 400) cq0 = idx_compact<false>(lds, 4 * w + 0, lane, cq0, tq0);
              if (cq1 > 400) cq1 = idx_compact<false>(lds, 4 * w + 1, lane, cq1, tq1);
              if (cq2 > 400) cq2 = idx_compact<false>(lds, 4 * w + 2, lane, cq2, tq2);
              if (cq3 > 400) cq3 = idx_compact<false>(lds, 4 * w + 3, lane, cq3, tq3);
              if (kt > 0) { tau0 = hf ? tq1 : tq0; tau1 = hf ? tq3 : tq2; }
          } }
        const LAS unsigned char* kb = lds + IDX_KT + (kt & 1) * 16384 + n * 128;
        const int sbase = kt * 4;
#ifdef IDX_PROBE2
        if (sbase + 0 < nsub) { mma(accA, kb); epilogue(accB, keyB); keyA = kt * 128 + n; if (kt == 0 && rep_ == 0) { tau0 = -INFINITY; tau1 = -INFINITY; } }
#else
        if (sbase + 0 < nsub) { mma(accA, kb); epilogue(accB, keyB); keyA = kt * 128 + n; if (kt == 0) { tau0 = -INFINITY; tau1 = -INFINITY; } }
#endif
        if (sbase + 1 < nsub) { mma(accB, kb + 32 * 128); epilogue(accA, keyA); keyB = kt * 128 + 32 + n; }
        if (sbase + 2 < nsub) { mma(accA, kb + 64 * 128); epilogue(accB, keyB); keyA = kt * 128 + 64 + n; }
        if (sbase + 3 < nsub) { mma(accB, kb + 96 * 128); epilogue(accA, keyA); keyB = kt * 128 + 96 + n; }
        if (lane < 4) cnt[4 * w + lane] = (unsigned)(lane == 0 ? cq0 : (lane == 1 ? cq1 : (lane == 2 ? cq2 : cq3)));
        asm volatile("s_waitcnt vmcnt(0)" ::: "memory");
        __syncthreads();
    }
#ifdef IDX_PROBE2
  }
#endif
    epilogue(accB, keyB);
    __syncthreads();
    LAS unsigned* bm = (LAS unsigned*)(lds + IDX_KT) + w * 512;
#ifdef IDX_PROBE_FINAL
  for (int rep2_ = 0; rep2_ < 2; ++rep2_) {
#endif
    if (cq0 > 256 - IDX_PF_) cq0 = idx_compact<true>(lds, 4 * w + 0, lane, cq0, tq0);
    if (cq1 > 256 - IDX_PF_) cq1 = idx_compact<true>(lds, 4 * w + 1, lane, cq1, tq1);
    if (cq2 > 256 - IDX_PF_) cq2 = idx_compact<true>(lds, 4 * w + 2, lane, cq2, tq2);
    if (cq3 > 256 - IDX_PF_) cq3 = idx_compact<true>(lds, 4 * w + 3, lane, cq3, tq3);
#pragma unroll 1
    for (int i = 0; i < 4; ++i) {
        const int qq = 4 * w + i;
        const int nsel = (i == 0) ? cq0 : ((i == 1) ? cq1 : ((i == 2) ? cq2 : cq3));
#pragma unroll
        for (int j = 0; j < 8; ++j) bm[lane + 64 * j] = 0u;
#pragma unroll
        for (int j = 0; j < 4; ++j) { const int idx = lane + 64 * j; if (idx < nsel) { const unsigned k = ci[qq * IDX_CAP + idx]; (void)__hip_atomic_fetch_or(bm + (k >> 5), 1u << (k & 31), __ATOMIC_RELAXED, __HIP_MEMORY_SCOPE_WORKGROUP); } }
        const int tq = t0 + qq;
#pragma unroll 1
        for (int kt = lane; kt < L / 64; kt += 64) { const unsigned long long v = (unsigned long long)bm[2 * kt] | ((unsigned long long)bm[2 * kt + 1] << 32); a.MT[((size_t)b * 256 + kt) * SEQ + tq] = v; }
    }
#ifdef IDX_PROBE_FINAL
  }
#endif
    __syncthreads();
}
__device__ __forceinline__ void idx_phase(LAS unsigned char* lds, const IdxArgs& a, int bid, int nblk) {
    for (int k = bid; k < 256; k += nblk) {
#pragma unroll 1
        for (int i = 0; i < 4; ++i) idx_item(lds, a, i & 1, (i < 2) ? 511 - k : k);
    }
}
#define XB_TMO      128
#define XB_XCNT(j)  (256  + 64 * (j))
#define XB_XSUB(j)  (1280 + 64 * (j))
#define XB_XGEN(j)  (2304 + 64 * (j))
#define XB_TOP      3328
#define XB_TOPGEN   3392
#define XCD_BAR_WORDS 3456
#define XB_SPIN_CAP (1u << 23)


__device__ __forceinline__ unsigned xb_ld(unsigned* p)              { return __hip_atomic_load(p, __ATOMIC_RELAXED, __HIP_MEMORY_SCOPE_AGENT); }
__device__ __forceinline__ unsigned xb_add(unsigned* p, unsigned v) { return __hip_atomic_fetch_add(p, v, __ATOMIC_RELAXED, __HIP_MEMORY_SCOPE_AGENT); }
__device__ __forceinline__ unsigned xb_xcc_id() { return (unsigned)__builtin_amdgcn_s_getreg((3 << 11) | 20) & 0xFu; }
#define XB_SPIN(cond, bar) do { unsigned _sp = 0; while (cond) { __builtin_amdgcn_s_sleep(1); \
    if ((++_sp & 255u) == 0u) { if (xb_ld(&(bar)[XB_TMO])) break; if (_sp > XB_SPIN_CAP) { atomicAdd(&(bar)[XB_TMO], 1u); break; } } } } while (0)

struct XcdBarrier {
    unsigned* bar; unsigned x;
    volatile LAS unsigned* st;
};

__device__ __forceinline__ XcdBarrier xcd_barrier_post(unsigned* bar, volatile LAS unsigned* st) {
    XcdBarrier b; b.bar = bar; b.x = xb_xcc_id(); b.st = st;
    if (threadIdx.x == 0) (void)xb_add(&bar[XB_XCNT(b.x)], 1u);
    return b;
}
__device__ __forceinline__ void xcd_barrier_complete(unsigned* bar, unsigned x, unsigned& nloc, unsigned& nx) {
    const unsigned G = gridDim.x * gridDim.y * gridDim.z;
    unsigned sum, cnt, mine, sp = 0u;
    for (;;) {
        sum = 0u; cnt = 0u; mine = 0u;
#pragma unroll
        for (unsigned j = 0; j < 16; ++j) { const unsigned c = xb_ld(&bar[XB_XCNT(j)]); sum += c; cnt += (c > 0u) ? 1u : 0u; mine = (j == x) ? c : mine; }
        if (sum == G) break;
        __builtin_amdgcn_s_sleep(1);
        if ((++sp & 255u) == 0u) { if (xb_ld(&bar[XB_TMO])) break; if (sp > XB_SPIN_CAP) { atomicAdd(&bar[XB_TMO], 1u); break; } }
    }
    nloc = mine > 0u ? mine : 1u; nx = cnt > 0u ? cnt : 1u;
}

__device__ __forceinline__ void xcd_barrier(const XcdBarrier& b) {
    asm volatile("s_waitcnt vmcnt(0)" ::: "memory");
    __syncthreads();
    if (threadIdx.x == 0) {
        unsigned* bar = b.bar;
        __builtin_amdgcn_s_waitcnt(0);
        unsigned nloc = b.st[0], nx = b.st[1];
        if (nloc == 0u) { xcd_barrier_complete(bar, b.x, nloc, nx); b.st[0] = nloc; b.st[1] = nx; }
        const unsigned old = xb_add(&bar[XB_XSUB(b.x)], 1u);
        const unsigned gen = old / nloc;
        if (old + 1u == (gen + 1u) * nloc) {
            __builtin_amdgcn_fence(__ATOMIC_RELEASE, "agent");
            asm volatile("s_waitcnt vmcnt(0)" ::: "memory");
            const unsigned og = xb_add(&bar[XB_TOP], 1u);
            const unsigned tg = og / nx;
            if (og + 1u == (tg + 1u) * nx) xb_add(&bar[XB_TOPGEN], 1u);
            else XB_SPIN(xb_ld(&bar[XB_TOPGEN]) == tg, bar);
            __builtin_amdgcn_fence(__ATOMIC_ACQUIRE, "agent");
            xb_add(&bar[XB_XGEN(b.x)], 1u);
            asm volatile("s_waitcnt vmcnt(0)" ::: "memory");
        } else {
            XB_SPIN(xb_ld(&bar[XB_XGEN(b.x)]) == gen, bar);
            __builtin_amdgcn_fence(__ATOMIC_ACQUIRE, "agent");
            asm volatile("s_waitcnt vmcnt(0)" ::: "memory");
        }
    }
    __syncthreads();
}

#ifndef FP8_QKV
#define FP8_QKV 1
#endif
#ifndef FP8_UP0
#define FP8_UP0 0
#endif
#ifndef FP8_UP1
#define FP8_UP1 1
#endif
#ifndef FP8_DN0
#define FP8_DN0 0
#endif
#ifndef FP8_DN1
#define FP8_DN1 1
#endif
#ifndef SKIPMASK
#define SKIPMASK 0
#endif

__device__ __forceinline__ int perm16(int t) { const int a = (t >> 2) & 3; return (t & ~12) | ((a == 1 ? 2 : (a == 2 ? 1 : a)) << 2); }
__device__ __forceinline__ void st_vt16(bf16_t* VT, int row, int h, int d, f32x4 v) {
    const int b = row / SEQ, t = row % SEQ; bf16_t* p = VT + ((size_t)(b * 8 + h) * 128 + d) * SEQ + (t & ~15) + perm16(t & 15);
    p[0] = f2bf(v[0]); p[SEQ] = f2bf(v[1]); p[2 * (size_t)SEQ] = f2bf(v[2]); p[3 * (size_t)SEQ] = f2bf(v[3]);
}
__device__ __forceinline__ int perm64(int kk) { const int sub = kk >> 5, k5 = kk & 31; return 32 * ((k5 >> 2) & 1) + 16 * sub + (((k5 >> 3) << 2) | (k5 & 3)); }
__device__ __forceinline__ void st_vt8(bf16_t* VT_, int row, int h, int d, f32x4 v) {
    const int b = row / SEQ, t = row % SEQ; unsigned char* p = (unsigned char*)VT_ + ((size_t)(b * 8 + h) * 128 + d) * SEQ + (t & ~63) + perm64(t & 63);
    const int pk0 = __builtin_amdgcn_cvt_pk_fp8_f32(v[0], v[1], 0, false), pk1 = __builtin_amdgcn_cvt_pk_fp8_f32(v[2], v[3], 0, false);
    p[0] = (unsigned char)(pk0 & 0xFF); p[SEQ] = (unsigned char)((pk0 >> 8) & 0xFF); p[2 * (size_t)SEQ] = (unsigned char)(pk1 & 0xFF); p[3 * (size_t)SEQ] = (unsigned char)((pk1 >> 8) & 0xFF);
}
__device__ __forceinline__ void st_fp8x4(unsigned char* p, f32x4 v) { int pk = 0; pk = __builtin_amdgcn_cvt_pk_fp8_f32(v[0], v[1], pk, false); pk = __builtin_amdgcn_cvt_pk_fp8_f32(v[2], v[3], pk, true); *(int*)p = pk; }
struct FAbIn2 { unsigned char *Q, *K; bf16_t* VT; float *QI, *U, *WI; unsigned short* KI16;
    __device__ __forceinline__ void operator()(int r, int c, f32x4 v) const {
        if (c < 1024) st_fp8x4(Q + (size_t)r * 1024 + c, v);
        else if (c < 2048) st_fp8x4(K + (size_t)r * 1024 + (c - 1024), v);
        else if (c < 3072) { if (PV8_DSA) st_vt8(VT, r, (c - 2048) >> 7, (c - 2048) & 127, v); else st_vt16(VT, r, (c - 2048) >> 7, (c - 2048) & 127, v); }
        else if (c < 4096) st_f32x4(QI + (size_t)r * 1024 + (c - 3072), v);
        else if (c < 5120) st_f32x4(U + (size_t)r * 1024 + (c - 4096), v);
        else if (c < 5184) { typedef _Float16 h2 __attribute__((ext_vector_type(2))); union { h2 h; unsigned u; } a, b; a.h = (h2){(_Float16)v[0], (_Float16)v[1]}; b.h = (h2){(_Float16)v[2], (_Float16)v[3]};
            u32x2 w; w.x = a.u; w.y = b.u; *(u32x2*)(KI16 + (size_t)r * 64 + (c - 5120)) = w; }
        else if (c < 5200) st_f32x4(WI + (size_t)r * 16 + (c - 5184), v);
    } };
struct FAbInHi { FAbIn2 f; __device__ __forceinline__ void operator()(int r, int c, f32x4 v) const { f(r, c + 3072, v); } };
struct FKvUp2 { unsigned char* K8; bf16_t* VT;
    __device__ __forceinline__ void operator()(int r, int c, f32x4 v) const {
        const int h = c >> 8, d = c & 255;
        if (d < 128) { int pk = 0; pk = __builtin_amdgcn_cvt_pk_fp8_f32(v[0], v[1], pk, false); pk = __builtin_amdgcn_cvt_pk_fp8_f32(v[2], v[3], pk, true); *(int*)(K8 + (size_t)r * 1536 + h * 192 + d) = pk; }
        else { if (PV8_MLA) st_vt8(VT, r, h, d - 128, v); else st_vt16(VT, r, h, d - 128, v); }
    } };

template <class E> __device__ __forceinline__ void ph_gemm_e(LAS unsigned char* lds, const bf16_t* A, int lda, const bf16_t* Bt, int ldb, int M, int N, int K, const E& e, int bid, int nblk, int a_shift = 0, int a_bytes = 0, int cmode = 0) {
    pg8::Gemm g; g.A = A; g.Bt = Bt; g.M = M; g.N = N; g.K = K; g.lda = lda; g.ldb = ldb; g.a_shift = a_shift; g.a_bytes = a_bytes; g.cmode = cmode;
    pg8::StaticOrder S; S.init(M, N, nblk, bid);
    pg8::gemm_phase<E, pg8::StaticOrder, false>(lds, g, S, e, nullptr);
    __syncthreads();
}
template <class F> __device__ __forceinline__ void ph_gemm(LAS unsigned char* lds, const bf16_t* A, int lda, const bf16_t* Bt, int ldb, int M, int N, int K, const F& f, int bid, int nblk, int a_shift = 0, int a_bytes = 0) {
    EpiG<F> e; e.f = f;
    ph_gemm_e(lds, A, lda, Bt, ldb, M, N, K, e, bid, nblk, a_shift, a_bytes);
}
template <class F> __device__ __forceinline__ void ph_gemm8(LAS unsigned char* lds, const unsigned char* A, int lda, const unsigned char* Bt, int ldb, int M, int N, int K, const F& f, int bid, int nblk) {
    EpiG<F, true> e; e.f = f;
    ph_gemm_e(lds, (const bf16_t*)A, lda / 2, (const bf16_t*)Bt, ldb / 2, M, N, K / 2, e, bid, nblk, 0, 0);
}
template <int CTRL> __device__ __forceinline__ float dpp0(float v) { return __int_as_float(__builtin_amdgcn_update_dpp(0, __float_as_int(v), CTRL, 0xF, 0xF, true)); }
__device__ __forceinline__ float gelu_fast(float x) { const float u2 = 1.5957691216057308f * (x + 0.044715f * x * x * x); return x * __builtin_amdgcn_rcpf(1.0f + __builtin_amdgcn_exp2f(-1.4426950408889634f * u2)); }
template <bool OUT8, bool F8> struct EpiGate {
    static constexpr bool PERM = false, AFTER_DRAIN = false, FP8 = F8;
    const float* cw; const float* cb; void* ACT;
    __device__ __forceinline__ void operator()(const f32x4 (&acc)[2][2][4][2], const pg8::Unit& u, int wr, int wc, int fr, int fq) const {
        const int bt = u.pm / 67, ti = u.pm % 67;
#pragma unroll
        for (int n = 0; n < 2; ++n) {
            const int c = u.pn * 128 + wc * 32 + 16 * n + 4 * fq;
            const f32x4 g0 = *(const f32x4*)(cw + c), g1 = *(const f32x4*)(cw + 8192 + c), g2 = *(const f32x4*)(cw + 16384 + c), gb = *(const f32x4*)(cb + c);
            const f32x4 v0 = *(const f32x4*)(cw + 4096 + c), v1 = *(const f32x4*)(cw + 8192 + 4096 + c), v2 = *(const f32x4*)(cw + 16384 + 4096 + c), vb = *(const f32x4*)(cb + 4096 + c);
            const float w1m = (fr < 1) ? 1.f : 0.f, w2m = (fr < 2) ? 1.f : 0.f;
            const f32x4 g1w = g1 * w1m, g0w = g0 * w2m, v1w = v1 * w1m, v0w = v0 * w2m;
#pragma unroll
            for (int ai = 0; ai < 2; ++ai) {
                const int strip = 2 * ai + wr, tbase = ti * 248 + strip * 62 - 2;
                f32x4 pg = {0.f, 0.f, 0.f, 0.f}, pv = pg;
#pragma unroll
                for (int m = 0; m < 4; ++m) {
                    f32x4 xg = acc[ai][0][m][n], xv = acc[ai][1][m][n];
                    const int t = tbase + 16 * m + fr;
                    if (tbase < 0 && m == 0) { if (t < 0) { xg = (f32x4){0.f, 0.f, 0.f, 0.f}; xv = xg; } }
                    f32x4 og, ov;
#pragma unroll
                    for (int j = 0; j < 4; ++j) {
                        float yg = fmaf(g2[j], xg[j], gb[j]), yv = fmaf(v2[j], xv[j], vb[j]);
                        asm("s_nop 1\n\t"
                            "v_fmac_f32_dpp %0, %2, %6 row_shr:1 row_mask:0xf bank_mask:0xf bound_ctrl:1\n\t"
                            "v_fmac_f32_dpp %1, %3, %10 row_shr:1 row_mask:0xf bank_mask:0xf bound_ctrl:1\n\t"
                            "v_fmac_f32_dpp %0, %2, %7 row_shr:2 row_mask:0xf bank_mask:0xf bound_ctrl:1\n\t"
                            "v_fmac_f32_dpp %1, %3, %11 row_shr:2 row_mask:0xf bank_mask:0xf bound_ctrl:1\n\t"
                            "v_fmac_f32_dpp %0, %4, %8 row_ror:1 row_mask:0xf bank_mask:0xf bound_ctrl:1\n\t"
                            "v_fmac_f32_dpp %1, %5, %12 row_ror:1 row_mask:0xf bank_mask:0xf bound_ctrl:1\n\t"
                            "v_fmac_f32_dpp %0, %4, %9 row_ror:2 row_mask:0xf bank_mask:0xf bound_ctrl:1\n\t"
                            "v_fmac_f32_dpp %1, %5, %13 row_ror:2 row_mask:0xf bank_mask:0xf bound_ctrl:1"
                            : "+v"(yg), "+v"(yv)
                            : "v"(xg[j]), "v"(xv[j]), "v"(pg[j]), "v"(pv[j]), "v"(g1[j]), "v"(g0[j]), "v"(g1w[j]), "v"(g0w[j]), "v"(v1[j]), "v"(v0[j]), "v"(v1w[j]), "v"(v0w[j]));
                        og[j] = gelu_fast(yg) * yv; ov[j] = 0.f;
                    }
                    pg = xg; pv = xv;
                    if (16 * m + fr >= 2 && t < SEQ) {
                        const size_t o = ((size_t)bt * SEQ + t) * 4096 + c;
                        if (OUT8) { int pk = 0; pk = __builtin_amdgcn_cvt_pk_fp8_f32(og[0], og[1], pk, false); pk = __builtin_amdgcn_cvt_pk_fp8_f32(og[2], og[3], pk, true); *(int*)((unsigned char*)ACT + o) = pk; }
                        else st_bf16x4((bf16_t*)ACT + o, og);
                    }
                }
            }
        }
    }
};
struct FPool { bf16_t* CC; const float* pb; const float* ps;
    __device__ __forceinline__ void operator()(int r, int c, f32x4 v) const { const f32x4 b = *(const f32x4*)(pb + c), s = *(const f32x4*)(ps + c); st_bf16x4(CC + (size_t)r * 2048 + 1024 + c, (v + b) * s); } };
struct EpiLru {
    static constexpr bool PERM = false, AFTER_DRAIN = false, FP8 = false;
    const bf16_t* XCB; const float *ba, *bx, *lam; bf16_t *LA, *LB;
    __device__ __forceinline__ void operator()(const f32x4 (&acc)[2][2][4][2], const pg8::Unit& u, int wr, int wc, int fr, int fq) const {
        const int row0 = u.pm * 256 + wr * 64 + fr;
#pragma unroll
        for (int n = 0; n < 2; ++n) {
            const int ch = u.pn * 128 + wc * 32 + 16 * n + 4 * fq;
            const f32x4 bav = *(const f32x4*)(ba + ch), bxv = *(const f32x4*)(bx + ch), lm = *(const f32x4*)(lam + ch);
            f32x4 sp;
#pragma unroll
            for (int j = 0; j < 4; ++j) sp[j] = log1pf(__expf(-lm[j]));
#pragma unroll
            for (int ai = 0; ai < 2; ++ai)
#pragma unroll
                for (int m = 0; m < 4; ++m) {
                    const int row = row0 + ai * 128 + m * 16;
                    const u32x2 xw = *(const u32x2*)(XCB + (size_t)row * 1024 + ch);
                    const f32x4 xc = {__uint_as_float(xw.x << 16), __uint_as_float(xw.x & 0xFFFF0000u), __uint_as_float(xw.y << 16), __uint_as_float(xw.y & 0xFFFF0000u)};
                    const f32x4 ga = acc[ai][0][m][n] + bav, gx = acc[ai][1][m][n] + bxv;
                    f32x4 av, bv;
#pragma unroll
                    for (int j = 0; j < 4; ++j) {
                        const float rg = 1.0f / (1.0f + __expf(-ga[j])), ig = 1.0f / (1.0f + __expf(-gx[j]));
                        const float log_a = -8.0f * rg * sp[j], a = __expf(log_a), mult = sqrtf(-expm1f(2.0f * log_a));
                        av[j] = -expm1f(log_a); bv[j] = mult * (ig * xc[j]); (void)a;
                    }
                    st_bf16x4(LA + (size_t)row * 1024 + ch, av); st_bf16x4(LB + (size_t)row * 1024 + ch, bv);
                }
        }
    }
};
__device__ __forceinline__ void ph_pooled(const float* __restrict__ U, bf16_t* __restrict__ P, int bid, int nblk) {
    for (int i = bid * 512 + opaque_tid(); i < 256 * (NTOK / 64); i += nblk * 512) {
        const int c4 = i & 255, row0 = (i >> 8) * 64, t0 = row0 % SEQ, g = c4 >> 6, win = 2 << g;
        const f32x4* up = (const f32x4*)U + (size_t)row0 * 256 + c4;
        f32x4 s = {0.f, 0.f, 0.f, 0.f};
        if (t0 > 0) { for (int k = 1; k < win; ++k) s += up[-(ptrdiff_t)k * 256]; }
#pragma unroll 8
        for (int r = 0; r < 64; ++r) {
            const int t = t0 + r; const f32x4 u0 = up[(ptrdiff_t)r * 256];
            s += u0;
            const int cnt = (t + 1 < win) ? (t + 1) : win;
            st_bf16x4(P + (size_t)(row0 + r) * 1024 + c4 * 4, s * (1.0f / (float)cnt) - u0);
            if (t + 1 >= win) s -= up[(ptrdiff_t)(r + 1 - win) * 256];
        }
    }
}
__device__ __forceinline__ void ph_xc(const bf16_t* __restrict__ XL, const float* __restrict__ cw, const float* __restrict__ cb, bf16_t* __restrict__ XCB, int bid, int nblk) {
    for (int i = bid * 512 + opaque_tid(); i < 128 * (NTOK / 32); i += nblk * 512) {
        const int c8 = (i & 127) * 8, row0 = (i >> 7) * 32, t0 = row0 % SEQ;
        float w0[8], w1[8], w2[8], w3[8], bb[8];
#pragma unroll
        for (int j = 0; j < 8; ++j) { w0[j] = cw[c8 + j]; w1[j] = cw[1024 + c8 + j]; w2[j] = cw[2048 + c8 + j]; w3[j] = cw[3072 + c8 + j]; bb[j] = cb[c8 + j]; }
        u32x4 p3 = {0u, 0u, 0u, 0u}, p2 = p3, p1 = p3;
        if (t0 >= 3) { p3 = *(const u32x4*)(XL + (size_t)(row0 - 3) * 1024 + c8); p2 = *(const u32x4*)(XL + (size_t)(row0 - 2) * 1024 + c8); p1 = *(const u32x4*)(XL + (size_t)(row0 - 1) * 1024 + c8); }
#pragma unroll 8
        for (int r = 0; r < 32; ++r) {
            const u32x4 cur = *(const u32x4*)(XL + (size_t)(row0 + r) * 1024 + c8);
            const unsigned a3[4] = {p3.x, p3.y, p3.z, p3.w}, a2[4] = {p2.x, p2.y, p2.z, p2.w}, a1[4] = {p1.x, p1.y, p1.z, p1.w}, a0[4] = {cur.x, cur.y, cur.z, cur.w};
            float y[8];
#pragma unroll
            for (int j = 0; j < 4; ++j) {
                y[2 * j] = bb[2 * j] + w0[2 * j] * __uint_as_float(a3[j] << 16) + w1[2 * j] * __uint_as_float(a2[j] << 16) + w2[2 * j] * __uint_as_float(a1[j] << 16) + w3[2 * j] * __uint_as_float(a0[j] << 16);
                y[2 * j + 1] = bb[2 * j + 1] + w0[2 * j + 1] * __uint_as_float(a3[j] & 0xFFFF0000u) + w1[2 * j + 1] * __uint_as_float(a2[j] & 0xFFFF0000u) + w2[2 * j + 1] * __uint_as_float(a1[j] & 0xFFFF0000u) + w3[2 * j + 1] * __uint_as_float(a0[j] & 0xFFFF0000u); }
            u32x4 o; o.x = pack2bf(y[0], y[1]); o.y = pack2bf(y[2], y[3]); o.z = pack2bf(y[4], y[5]); o.w = pack2bf(y[6], y[7]);
            *(u32x4*)(XCB + (size_t)(row0 + r) * 1024 + c8) = o;
            p3 = p2; p2 = p1; p1 = cur;
        }
    }
}
__device__ __forceinline__ int up_src_col(int n0) { return ((n0 >> 7) & 1) * 4096 + (n0 >> 8) * 128 + (n0 & 127); }
template <bool OUT8>
__device__ __forceinline__ void ph_convT_g(LAS unsigned char* lds, const float* __restrict__ W, int ldw, int src_col0, int ncols, int K, void* __restrict__ Bt, int ldd, int bid, int nblk, bool upperm) {
    const int tid = opaque_tid(), sub = tid >> 8, t8 = tid & 255;
    LAS float* tile = (LAS float*)lds + sub * (64 * 65);
    const int ntx = (ncols + 63) / 64, ntiles = ntx * (K / 64);
    for (int base = bid * 2; base < ntiles; base += nblk * 2) {
        const int tl = base + sub; const bool act = tl < ntiles;
        const int n0 = (tl % ntx) * 64, k0 = (tl / ntx) * 64;
        if (act) {
            const int c4 = (t8 & 15) * 4, kr = t8 >> 4;
            const int nsrc = src_col0 + (upperm ? up_src_col(n0 + c4) : n0 + c4);
#pragma unroll
            for (int i = 0; i < 4; ++i) { const int kl = kr + 16 * i;
                f32x4 v = {0.f, 0.f, 0.f, 0.f};
                if (n0 + c4 < ncols) v = *(const f32x4*)(W + (size_t)(k0 + kl) * ldw + nsrc);
                tile[kl * 65 + c4] = v[0]; tile[kl * 65 + c4 + 1] = v[1]; tile[kl * 65 + c4 + 2] = v[2]; tile[kl * 65 + c4 + 3] = v[3]; } }
        __syncthreads();
        if (act) {
            const int k8 = (t8 & 7) * 8, nr = t8 >> 3;
#pragma unroll
            for (int i = 0; i < 2; ++i) { const int nl = nr + 32 * i;
                if (n0 + nl < ncols) {
                    float v[8];
#pragma unroll
                    for (int j = 0; j < 8; ++j) v[j] = tile[(k8 + j) * 65 + nl];
                    if (OUT8) { int p0 = 0, p1 = 0;
                        p0 = __builtin_amdgcn_cvt_pk_fp8_f32(64.f * v[0], 64.f * v[1], p0, false); p0 = __builtin_amdgcn_cvt_pk_fp8_f32(64.f * v[2], 64.f * v[3], p0, true);
                        p1 = __builtin_amdgcn_cvt_pk_fp8_f32(64.f * v[4], 64.f * v[5], p1, false); p1 = __builtin_amdgcn_cvt_pk_fp8_f32(64.f * v[6], 64.f * v[7], p1, true);
                        u32x2 o; o.x = (unsigned)p0; o.y = (unsigned)p1; *(u32x2*)((unsigned char*)Bt + (size_t)(n0 + nl) * ldd + k0 + k8) = o; }
                    else { u32x4 o; o.x = pack2bf(v[0], v[1]); o.y = pack2bf(v[2], v[3]); o.z = pack2bf(v[4], v[5]); o.w = pack2bf(v[6], v[7]);
                        *(u32x4*)((bf16_t*)Bt + (size_t)(n0 + nl) * ldd + k0 + k8) = o; }
                } } }
        __syncthreads();
    }
}
__device__ __forceinline__ void ph_convT(LAS unsigned char* lds, const float* __restrict__ W, int ldw, int src_col0, int ncols, int K, bf16_t* __restrict__ Bt, int ldd, int bid, int nblk, bool upperm = false) {
    ph_convT_g<false>(lds, W, ldw, src_col0, ncols, K, Bt, ldd, bid, nblk, upperm);
}
__device__ __forceinline__ void ph_convT8(LAS unsigned char* lds, const float* __restrict__ W, int ldw, int ncols, int K, unsigned char* __restrict__ Bt, int bid, int nblk, bool upperm = false) {
    ph_convT_g<true>(lds, W, ldw, 0, ncols, K, Bt, K, bid, nblk, upperm);
}
template <int NC> __device__ __forceinline__ void ph_rmsnorm(const float* __restrict__ x, const float* __restrict__ g, bf16_t* __restrict__ out, int bid, int nblk, unsigned char* __restrict__ out8 = nullptr) {
    const int lane = opaque_tid() & 63, w = opaque_tid() >> 6;
    constexpr int NV = NC / 256;
    for (int row = bid * 8 + w; row < NTOK; row += nblk * 8) {
        const f32x4* xr = (const f32x4*)(x + (size_t)row * NC);
        f32x4 v[NV]; float ss = 0.f;
#pragma unroll
        for (int i = 0; i < NV; ++i) { v[i] = xr[lane + 64 * i]; ss += v[i][0] * v[i][0] + v[i][1] * v[i][1] + v[i][2] * v[i][2] + v[i][3] * v[i][3]; }
        ss = wave_sum(ss);
        const float r = rsqrtf(ss * (1.0f / NC) + NORM_EPS);
#pragma unroll
        for (int i = 0; i < NV; ++i) { const f32x4 gg = ((const f32x4*)g)[lane + 64 * i]; const f32x4 y = v[i] * r * gg; st_bf16x4(out + (size_t)row * NC + 4 * (lane + 64 * i), y);
            if (out8) { int pk = 0; pk = __builtin_amdgcn_cvt_pk_fp8_f32(y[0], y[1], pk, false); pk = __builtin_amdgcn_cvt_pk_fp8_f32(y[2], y[3], pk, true); *(int*)(out8 + (size_t)row * NC + 4 * (lane + 64 * i)) = pk; } }
    }
}
template <bool IN16, bool OUT16>
__device__ __forceinline__ void ph_resnorm(const void* xin, const bf16_t* __restrict__ m, const float* __restrict__ gpost, const float* __restrict__ gpre, void* xout, bf16_t* __restrict__ h, unsigned char* __restrict__ h8, int bid, int nblk) {
    const int tid_ = opaque_tid(), lane = tid_ & 63, w = tid_ >> 6;
    for (int row = bid * 8 + w; row < NTOK; row += nblk * 8) {
        const u32x2* mr = (const u32x2*)(m + (size_t)row * DM);
        f32x4 mv[8], xv[8]; float ss = 0.f;
#pragma unroll
        for (int i = 0; i < 8; ++i) { const u32x2 wd = mr[lane + 64 * i]; mv[i][0] = __uint_as_float(wd.x << 16); mv[i][1] = __uint_as_float(wd.x & 0xFFFF0000u); mv[i][2] = __uint_as_float(wd.y << 16); mv[i][3] = __uint_as_float(wd.y & 0xFFFF0000u);
            if (IN16) { const u32x2 xw = ((const u32x2*)((const bf16_t*)xin + (size_t)row * DM))[lane + 64 * i];
                xv[i][0] = __uint_as_float(xw.x << 16); xv[i][1] = __uint_as_float(xw.x & 0xFFFF0000u); xv[i][2] = __uint_as_float(xw.y << 16); xv[i][3] = __uint_as_float(xw.y & 0xFFFF0000u); }
            else xv[i] = ((const f32x4*)((const float*)xin + (size_t)row * DM))[lane + 64 * i];
            ss += mv[i][0] * mv[i][0] + mv[i][1] * mv[i][1] + mv[i][2] * mv[i][2] + mv[i][3] * mv[i][3]; }
        ss = wave_sum(ss);
        const float r1 = rsqrtf(ss * (1.0f / DM) + NORM_EPS);
        float s2 = 0.f;
#pragma unroll
        for (int i = 0; i < 8; ++i) { const f32x4 gg = ((const f32x4*)gpost)[lane + 64 * i]; xv[i] = xv[i] + mv[i] * r1 * gg;
            if (OUT16) st_bf16x4((bf16_t*)xout + (size_t)row * DM + 4 * (lane + 64 * i), xv[i]); else ((f32x4*)((float*)xout + (size_t)row * DM))[lane + 64 * i] = xv[i];
            s2 += xv[i][0] * xv[i][0] + xv[i][1] * xv[i][1] + xv[i][2] * xv[i][2] + xv[i][3] * xv[i][3]; }
        if (gpre) {
            s2 = wave_sum(s2);
            const float r2 = rsqrtf(s2 * (1.0f / DM) + NORM_EPS);
#pragma unroll
            for (int i = 0; i < 8; ++i) { const f32x4 gg = ((const f32x4*)gpre)[lane + 64 * i]; const f32x4 y = xv[i] * r2 * gg;
                if (h8) { int pk = 0; pk = __builtin_amdgcn_cvt_pk_fp8_f32(y[0], y[1], pk, false); pk = __builtin_amdgcn_cvt_pk_fp8_f32(y[2], y[3], pk, true); *(int*)(h8 + (size_t)row * DM + 4 * (lane + 64 * i)) = pk; }
                else st_bf16x4(h + (size_t)row * DM + 4 * (lane + 64 * i), y); }
        }
    }
}
__device__ __forceinline__ void ph_scan1(const bf16_t* __restrict__ Aa, const bf16_t* __restrict__ Bb, float* __restrict__ CA, float* __restrict__ CH, int bid, int nblk) {
    for (int i = bid * 512 + opaque_tid(); i < 2 * 256 * 1024; i += nblk * 512) {
        const int ch = i & 1023, chunk = (i >> 10) & 255, b = i >> 18;
        const size_t base = ((size_t)b * SEQ + (size_t)chunk * 64) * 1024 + ch;
        float h = 0.f, P = 1.f;
#pragma unroll 8
        for (int s = 0; s < 64; ++s) { const float a = 1.0f - bf2f(Aa[base + (size_t)s * 1024]); h = a * h + bf2f(Bb[base + (size_t)s * 1024]); P *= a; }
        CA[i] = P; CH[i] = h;
    }
}
__device__ __forceinline__ void ph_scan2(const float* __restrict__ CA, const float* __restrict__ CH, float* __restrict__ CIN, int bid, int nblk) {
    for (int i = bid * 512 + opaque_tid(); i < 2048; i += nblk * 512) {
        const int ch = i & 1023, b = i >> 10;
        float h = 0.f;
#pragma unroll 8
        for (int c = 0; c < 256; ++c) { const int j = (b * 256 + c) * 1024 + ch; CIN[j] = h; h = CA[j] * h + CH[j]; }
    }
}
__device__ __forceinline__ void ph_scan3(const bf16_t* __restrict__ Aa, const bf16_t* __restrict__ Bb, const float* __restrict__ CIN, const bf16_t* __restrict__ YG, bf16_t* __restrict__ CC, int bid, int nblk) {
    for (int i = bid * 512 + opaque_tid(); i < 2 * 256 * 1024; i += nblk * 512) {
        const int ch = i & 1023, chunk = (i >> 10) & 255, b = i >> 18;
        const size_t row0 = (size_t)b * SEQ + (size_t)chunk * 64;
        float h = CIN[i];
#pragma unroll 8
        for (int s = 0; s < 64; ++s) { const size_t r = row0 + s; h = (1.0f - bf2f(Aa[r * 1024 + ch])) * h + bf2f(Bb[r * 1024 + ch]);
            CC[r * 2048 + 1024 + ch] = f2bf(h * gelu_tanh(bf2f(YG[r * 1024 + ch]))); }
    }
}
__device__ __forceinline__ void ph_rope_q(const bf16_t* __restrict__ Q1, const int* __restrict__ pos, unsigned char* __restrict__ Q8, int bid, int nblk) {
    for (int idx = bid * 512 + opaque_tid(); idx < NTOK * 8 * 4; idx += nblk * 512) {
        const int g = idx & 3, h = (idx >> 2) & 7, row = idx >> 5;
        const bf16_t* p = Q1 + (size_t)row * 1536 + h * 192; unsigned char* q = Q8 + (size_t)row * 1536 + h * 192;
#pragma unroll
        for (int k = 0; k < 4; ++k) { const u32x4 w = *(const u32x4*)(p + 32 * g + 8 * k);
            int p0 = 0, p1 = 0;
            p0 = __builtin_amdgcn_cvt_pk_fp8_f32(__uint_as_float(w.x << 16), __uint_as_float(w.x & 0xFFFF0000u), p0, false); p0 = __builtin_amdgcn_cvt_pk_fp8_f32(__uint_as_float(w.y << 16), __uint_as_float(w.y & 0xFFFF0000u), p0, true);
            p1 = __builtin_amdgcn_cvt_pk_fp8_f32(__uint_as_float(w.z << 16), __uint_as_float(w.z & 0xFFFF0000u), p1, false); p1 = __builtin_amdgcn_cvt_pk_fp8_f32(__uint_as_float(w.w << 16), __uint_as_float(w.w & 0xFFFF0000u), p1, true);
            u32x2 o; o.x = (unsigned)p0; o.y = (unsigned)p1; *(u32x2*)(q + 32 * g + 8 * k) = o; }
        const u32x4 w1 = *(const u32x4*)(p + 128 + 8 * g), w2 = *(const u32x4*)(p + 160 + 8 * g);
        const unsigned a1[4] = {w1.x, w1.y, w1.z, w1.w}, a2[4] = {w2.x, w2.y, w2.z, w2.w};
        float o1[8], o2[8]; const int ps = pos[row];
#pragma unroll
        for (int j = 0; j < 8; ++j) { float cs, sn; rope_cs(ps, 8 * g + j, cs, sn);
            const float x1 = (j & 1) ? __uint_as_float(a1[j >> 1] & 0xFFFF0000u) : __uint_as_float(a1[j >> 1] << 16), x2 = (j & 1) ? __uint_as_float(a2[j >> 1] & 0xFFFF0000u) : __uint_as_float(a2[j >> 1] << 16);
            o1[j] = x1 * cs - x2 * sn; o2[j] = x2 * cs + x1 * sn; }
        int p0 = 0, p1 = 0, p2 = 0, p3 = 0;
        p0 = __builtin_amdgcn_cvt_pk_fp8_f32(o1[0], o1[1], p0, false); p0 = __builtin_amdgcn_cvt_pk_fp8_f32(o1[2], o1[3], p0, true); p1 = __builtin_amdgcn_cvt_pk_fp8_f32(o1[4], o1[5], p1, false); p1 = __builtin_amdgcn_cvt_pk_fp8_f32(o1[6], o1[7], p1, true);
        p2 = __builtin_amdgcn_cvt_pk_fp8_f32(o2[0], o2[1], p2, false); p2 = __builtin_amdgcn_cvt_pk_fp8_f32(o2[2], o2[3], p2, true); p3 = __builtin_amdgcn_cvt_pk_fp8_f32(o2[4], o2[5], p3, false); p3 = __builtin_amdgcn_cvt_pk_fp8_f32(o2[6], o2[7], p3, true);
        u32x2 oa; oa.x = (unsigned)p0; oa.y = (unsigned)p1; *(u32x2*)(q + 128 + 8 * g) = oa;
        u32x2 ob; ob.x = (unsigned)p2; ob.y = (unsigned)p3; *(u32x2*)(q + 160 + 8 * g) = ob;
    }
}
__device__ __forceinline__ void ph_rope_k(const float* __restrict__ KR, const int* __restrict__ pos, unsigned char* __restrict__ K8, int bid, int nblk) {
    for (int idx = bid * 512 + opaque_tid(); idx < NTOK * 32; idx += nblk * 512) {
        const int i = idx & 31, row = idx >> 5;
        float c, s; rope_cs(pos[row], i, c, s);
        const float x1 = KR[(size_t)row * 64 + i], x2 = KR[(size_t)row * 64 + 32 + i];
        const int pk = __builtin_amdgcn_cvt_pk_fp8_f32(x1 * c - x2 * s, x2 * c + x1 * s, 0, false);
        const unsigned char o1 = (unsigned char)(pk & 0xFF), o2 = (unsigned char)((pk >> 8) & 0xFF);
#pragma unroll
        for (int h = 0; h < 8; ++h) { unsigned char* p = K8 + (size_t)row * 1536 + h * 192 + 128; p[i] = o1; p[32 + i] = o2; }
    }
}
template <bool OUT8> __device__ __forceinline__ void ph_ffn_gate(const bf16_t* __restrict__ HID, const float* __restrict__ cw, const float* __restrict__ cb, bf16_t* __restrict__ ACT, int bid, int nblk) {
    for (int i = bid * 512 + opaque_tid(); i < 512 * (SEQ / 64); i += nblk * 512) {
        const int c8 = (i & 511) * 8, t0 = (i >> 9) * 64;
        float wg[3][8], wv[3][8], bg[8], bv[8];
#pragma unroll
        for (int j = 0; j < 8; ++j) { bg[j] = cb[c8 + j]; bv[j] = cb[4096 + c8 + j];
#pragma unroll
            for (int k = 0; k < 3; ++k) { wg[k][j] = cw[k * 8192 + c8 + j]; wv[k][j] = cw[k * 8192 + 4096 + c8 + j]; } }
        u32x4 g2 = {0u, 0u, 0u, 0u}, g1 = g2, v2 = g2, v1 = g2;
        if (t0 >= 2) { g2 = *(const u32x4*)(HID + (size_t)(t0 - 2) * 8192 + c8); g1 = *(const u32x4*)(HID + (size_t)(t0 - 1) * 8192 + c8);
                       v2 = *(const u32x4*)(HID + (size_t)(t0 - 2) * 8192 + 4096 + c8); v1 = *(const u32x4*)(HID + (size_t)(t0 - 1) * 8192 + 4096 + c8); }
#pragma unroll 8
        for (int r = 0; r < 64; ++r) {
            const u32x4 g0 = *(const u32x4*)(HID + (size_t)(t0 + r) * 8192 + c8), v0 = *(const u32x4*)(HID + (size_t)(t0 + r) * 8192 + 4096 + c8);
            const unsigned G2[4] = {g2.x, g2.y, g2.z, g2.w}, G1[4] = {g1.x, g1.y, g1.z, g1.w}, G0[4] = {g0.x, g0.y, g0.z, g0.w};
            const unsigned V2[4] = {v2.x, v2.y, v2.z, v2.w}, V1[4] = {v1.x, v1.y, v1.z, v1.w}, V0[4] = {v0.x, v0.y, v0.z, v0.w};
            float o[8];
#pragma unroll
            for (int j = 0; j < 4; ++j) {
                const float ge = bg[2 * j] + wg[0][2 * j] * __uint_as_float(G2[j] << 16) + wg[1][2 * j] * __uint_as_float(G1[j] << 16) + wg[2][2 * j] * __uint_as_float(G0[j] << 16);
                const float go = bg[2 * j + 1] + wg[0][2 * j + 1] * __uint_as_float(G2[j] & 0xFFFF0000u) + wg[1][2 * j + 1] * __uint_as_float(G1[j] & 0xFFFF0000u) + wg[2][2 * j + 1] * __uint_as_float(G0[j] & 0xFFFF0000u);
                const float ve = bv[2 * j] + wv[0][2 * j] * __uint_as_float(V2[j] << 16) + wv[1][2 * j] * __uint_as_float(V1[j] << 16) + wv[2][2 * j] * __uint_as_float(V0[j] << 16);
                const float vo = bv[2 * j + 1] + wv[0][2 * j + 1] * __uint_as_float(V2[j] & 0xFFFF0000u) + wv[1][2 * j + 1] * __uint_as_float(V1[j] & 0xFFFF0000u) + wv[2][2 * j + 1] * __uint_as_float(V0[j] & 0xFFFF0000u);
                o[2 * j] = gelu_tanh(ge) * ve; o[2 * j + 1] = gelu_tanh(go) * vo; }
            if (OUT8) { int p0 = 0, p1 = 0;
                p0 = __builtin_amdgcn_cvt_pk_fp8_f32(o[0], o[1], p0, false); p0 = __builtin_amdgcn_cvt_pk_fp8_f32(o[2], o[3], p0, true);
                p1 = __builtin_amdgcn_cvt_pk_fp8_f32(o[4], o[5], p1, false); p1 = __builtin_amdgcn_cvt_pk_fp8_f32(o[6], o[7], p1, true);
                u32x2 ov; ov.x = (unsigned)p0; ov.y = (unsigned)p1; *(u32x2*)((unsigned char*)ACT + (size_t)(t0 + r) * 4096 + c8) = ov; }
            else { u32x4 ov; ov.x = pack2bf(o[0], o[1]); ov.y = pack2bf(o[2], o[3]); ov.z = pack2bf(o[4], o[5]); ov.w = pack2bf(o[6], o[7]);
                *(u32x4*)(ACT + (size_t)(t0 + r) * 4096 + c8) = ov; }
            g2 = g1; g1 = g0; v2 = v1; v1 = v0;
        }
    }
}

__device__ __forceinline__ void ph_conv_lru(const float* __restrict__ wa, const float* __restrict__ wx, bf16_t* __restrict__ Bt, int bid, int nblk) {
    for (int e = bid * 512 + opaque_tid(); e < 8 * 2 * 128 * 128; e += nblk * 512) {
        const int d = e & 127, c = (e >> 7) & 127, gate = (e >> 14) & 1, nb = e >> 15;
        const float v = (gate ? wx : wa)[((size_t)nb * 128 + c) * 128 + d];
        bf16_t* row = Bt + (size_t)(nb * 256 + gate * 128 + d) * 256;
        row[(nb & 1) * 128 + c] = f2bf(v); row[(1 - (nb & 1)) * 128 + c] = 0;
    }
}

static constexpr size_t MiB = 1048576;
static constexpr size_t W_UP0 = 0 * MiB, W_UP1 = 32 * MiB, W_DN0 = 64 * MiB, W_DN1 = 80 * MiB, W_ABIN = 96 * MiB, W_ABOUT = 117 * MiB, W_CDIN = 125 * MiB, W_CDOUT = 137 * MiB,
                        W_QUP = 145 * MiB, W_KVUP = 146 * MiB + 512 * 1024, W_POOL = 147 * MiB + 512 * 1024;
static constexpr size_t R_H = 148 * MiB;
static constexpr size_t R_Q0 = 276 * MiB, R_K0 = 340 * MiB, R_VT0 = 404 * MiB, R_QI = 468 * MiB, R_M0 = 468 * MiB, R_U = 596 * MiB, R_KI = 724 * MiB, R_WI = 732 * MiB, R_MASK = 734 * MiB, R_CC0 = 830 * MiB, R_POOLED = 958 * MiB, R_H8A = 830 * MiB;
static constexpr size_t R_HID = 276 * MiB, R_ACT = 532 * MiB, R_F = 660 * MiB, R_X3 = 788 * MiB;
static constexpr size_t R_VT1 = 276 * MiB, R_CQ = 276 * MiB, R_CKV = 340 * MiB, R_KR = 372 * MiB, R_XL = 380 * MiB, R_YG = 444 * MiB, R_CQN = 508 * MiB, R_CKVN = 540 * MiB, R_LA = 556 * MiB, R_LB = 684 * MiB,
                        R_Q1 = 812 * MiB, R_K1 = 908 * MiB, R_Q8 = 956 * MiB,     R_CA = 1004 * MiB, R_CH = 1006 * MiB, R_CIN = 1008 * MiB, R_CC1 = 148 * MiB, R_M1 = 276 * MiB, R_XCB = 148 * MiB, W_LRU = 1010 * MiB;
static constexpr size_t WS_BAR = 1022 * MiB, WS_NEED = 1022 * MiB + 65536;
static constexpr int MK_LDS = 162816;

struct MK { const float* in[28]; float* out; unsigned char* ws; int ph_lo, ph_hi; };

__global__ __launch_bounds__(512, 2) void k_mega(MK p) {
    extern __shared__ __attribute__((aligned(16))) unsigned char shm[];
    LAS unsigned char* lds = (LAS unsigned char*)shm;
    const int bid0 = (int)blockIdx.x, nblk0 = (int)gridDim.x;
    volatile LAS unsigned* xbw = (volatile LAS unsigned*)(lds + MK_LDS - 16);
    if (threadIdx.x == 0) { xbw[0] = 0u; xbw[1] = 0u; xbw[2] = 0u; xbw[3] = 0u; }
    if ((threadIdx.x & 63) == 0) *(volatile LAS int*)(size_t)(TID_TAB_LDS + 4 * ((unsigned)__builtin_amdgcn_s_getreg(((6 - 1) << 11) | 4) & 63u)) = (int)(threadIdx.x >> 6);
    __syncthreads();
    XcdBarrier bar = xcd_barrier_post((unsigned*)(p.ws + WS_BAR), xbw);
#ifndef KARG_PLAIN
#define KARG_PLAIN 0
#endif
#if KARG_PLAIN
#define KARG_DECL const MK& P_ = p;
#else
#define KARG_DECL KPtr P__ = kp; asm volatile("" : "+s"(P__)); const __attribute__((address_space(4))) MK& P_ = *P__;
#endif
    typedef const __attribute__((address_space(4))) MK* KPtr;
    KPtr kp = (KPtr)__builtin_amdgcn_kernarg_segment_ptr();
#define WSP(T, off) ((T*)(ws + (off)))
#define PHASE_BEGIN if (pc >= p.ph_lo && pc < p.ph_hi) { const int bid = opaque_s(bid0), nblk = opaque_s(nblk0); \
    KARG_DECL unsigned char* const ws = P_.ws; float* const xo = P_.out; const float* const x = P_.in[0]; const int* const positions = (const int*)P_.in[1]; \
    const float *const mix_pre_g = P_.in[2], *const mix_post_g = P_.in[3], *const ffn_pre_g = P_.in[4], *const ffn_post_g = P_.in[5], *const ffn_up = P_.in[6], *const ffn_conv_w = P_.in[7], *const ffn_conv_b = P_.in[8], *const ffn_down = P_.in[9], \
    *const ab_w_in = P_.in[10], *const pool_w = P_.in[11], *const pool_b = P_.in[12], *const pool_scale = P_.in[13], *const ab_w_out = P_.in[14], *const cd_w_in = P_.in[15], *const q_norm_g = P_.in[16], *const w_q_up = P_.in[17], \
    *const kv_norm_g = P_.in[18], *const w_kv_up = P_.in[19], *const lru_conv_w = P_.in[20], *const lru_conv_b = P_.in[21], *const lru_wa = P_.in[22], *const lru_ba = P_.in[23], *const lru_wx = P_.in[24], *const lru_bx = P_.in[25], \
    *const lru_lambda = P_.in[26], *const cd_w_out = P_.in[27]; bf16_t* const H = WSP(bf16_t, R_H); const bf16_t* const CC = WSP(bf16_t, LAYER_CC); bf16_t* const Mx = WSP(bf16_t, LAYER_MX); \
    (void)xo; (void)x; (void)positions; (void)mix_pre_g; (void)mix_post_g; (void)ffn_pre_g; (void)ffn_post_g; (void)ffn_up; (void)ffn_conv_w; (void)ffn_conv_b; (void)ffn_down; (void)ab_w_in; (void)pool_w; (void)pool_b; (void)pool_scale; \
    (void)ab_w_out; (void)cd_w_in; (void)q_norm_g; (void)w_q_up; (void)kv_norm_g; (void)w_kv_up; (void)lru_conv_w; (void)lru_conv_b; (void)lru_wa; (void)lru_ba; (void)lru_wx; (void)lru_bx; (void)lru_lambda; (void)cd_w_out; (void)H; (void)CC; (void)Mx;
#define PHASE_END } if (pc >= p.ph_lo && pc + 1 < p.ph_hi) xcd_barrier(bar); ++pc;
    int pc = 0;
#define LAYER_CC R_CC0
#define LAYER_MX R_M0
    PHASE_BEGIN
#if !((SKIPMASK >> 0) & 1)
#if FP8_UP0
        ph_convT8(lds, ffn_up, 8192, 8192, 2048, WSP(unsigned char, W_UP0), bid, nblk, true);
#else
        ph_convT(lds, ffn_up, 8192, 0, 8192, 2048, WSP(bf16_t, W_UP0), 2048, bid, nblk, true);
#endif
#if FP8_UP1
        ph_convT8(lds, ffn_up + (size_t)2048 * 8192, 8192, 8192, 2048, WSP(unsigned char, W_UP1), bid, nblk, true);
#else
        ph_convT(lds, ffn_up + (size_t)2048 * 8192, 8192, 0, 8192, 2048, WSP(bf16_t, W_UP1), 2048, bid, nblk, true);
#endif
#if FP8_DN0
        ph_convT8(lds, ffn_down, 2048, 2048, 4096, WSP(unsigned char, W_DN0), bid, nblk);
#else
        ph_convT(lds, ffn_down, 2048, 0, 2048, 4096, WSP(bf16_t, W_DN0), 4096, bid, nblk);
#endif
#if FP8_DN1
        ph_convT8(lds, ffn_down + (size_t)4096 * 2048, 2048, 2048, 4096, WSP(unsigned char, W_DN1), bid, nblk);
#else
        ph_convT(lds, ffn_down + (size_t)4096 * 2048, 2048, 0, 2048, 4096, WSP(bf16_t, W_DN1), 4096, bid, nblk);
#endif
#if FP8_QKV
        ph_convT8(lds, ab_w_in, 5200, 3072, 2048, WSP(unsigned char, W_ABIN), bid, nblk);
        ph_convT(lds, ab_w_in, 5200, 3072, 1024, 2048, WSP(bf16_t, W_ABIN) + (size_t)3072 * 2048, 2048, bid, nblk);
#else
        ph_convT(lds, ab_w_in, 5200, 0, 4096, 2048, WSP(bf16_t, W_ABIN), 2048, bid, nblk);
#endif
        ph_convT(lds, ab_w_in, 5200, 4176, 1024, 2048, WSP(bf16_t, W_ABIN) + (size_t)4096 * 2048, 2048, bid, nblk);
        ph_convT(lds, ab_w_in, 5200, 4096, 64, 2048, WSP(bf16_t, W_ABIN) + (size_t)5120 * 2048, 2048, bid, nblk);
        ph_convT(lds, ab_w_in, 5200, 4160, 16, 2048, WSP(bf16_t, W_ABIN) + (size_t)5184 * 2048, 2048, bid, nblk);
        ph_convT(lds, ab_w_out, 2048, 0, 2048, 2048, WSP(bf16_t, W_ABOUT), 2048, bid, nblk);
        ph_convT(lds, cd_w_in, 2880, 0, 832, 2048, WSP(bf16_t, W_CDIN), 2048, bid, nblk);
        ph_convT(lds, cd_w_in, 2880, 832, 2048, 2048, WSP(bf16_t, W_CDIN) + (size_t)1024 * 2048, 2048, bid, nblk);
        ph_convT(lds, cd_w_out, 2048, 0, 2048, 2048, WSP(bf16_t, W_CDOUT), 2048, bid, nblk);
        ph_convT(lds, w_q_up, 1536, 0, 1536, 512, WSP(bf16_t, W_QUP), 512, bid, nblk);
        ph_convT(lds, w_kv_up, 2048, 0, 2048, 256, WSP(bf16_t, W_KVUP), 256, bid, nblk);
        for (int g = 0; g < 4; ++g) ph_convT(lds, pool_w + (size_t)g * 65536, 256, 0, 256, 256, WSP(bf16_t, W_POOL) + (size_t)g * 65536, 256, bid, nblk);
        ph_rmsnorm<2048>(x, mix_pre_g, H, bid, nblk, FP8_QKV ? WSP(unsigned char, R_H8A) : (unsigned char*)nullptr);
#endif
    PHASE_END
    {
            PHASE_BEGIN
#if !((SKIPMASK >> 1) & 1)
                FAbIn2 f; f.Q = WSP(unsigned char, R_Q0); f.K = WSP(unsigned char, R_K0); f.VT = WSP(bf16_t, R_VT0); f.QI = WSP(float, R_QI); f.U = WSP(float, R_U); f.WI = WSP(float, R_WI); f.KI16 = WSP(unsigned short, R_KI);
#if FP8_QKV
                ph_gemm8(lds, WSP(unsigned char, R_H8A), 2048, WSP(unsigned char, W_ABIN), 2048, NTOK, 3072, 2048, f, bid, nblk);
                { FAbInHi fh; fh.f = f; ph_gemm(lds, H, 2048, WSP(bf16_t, W_ABIN) + (size_t)3072 * 2048, 2048, NTOK, 2304, 2048, fh, bid, nblk); }
#else
                ph_gemm(lds, H, 2048, WSP(bf16_t, W_ABIN), 2048, NTOK, 5376, 2048, f, bid, nblk);
#endif
#endif
            PHASE_END
            PHASE_BEGIN
#if !((SKIPMASK >> 2) & 1)
                ph_pooled(WSP(float, R_U), WSP(bf16_t, R_POOLED), bid, nblk);
                IdxArgs a; a.QI = WSP(float, R_QI); a.KI16 = WSP(unsigned short, R_KI); a.WI = WSP(float, R_WI); a.MT = WSP(unsigned long long, R_MASK);
                idx_phase(lds, a, bid, nblk);
#endif
            PHASE_END
            PHASE_BEGIN
#if !((SKIPMASK >> 3) & 1)
                { FPool f; f.CC = WSP(bf16_t, R_CC0); f.pb = pool_b; f.ps = pool_scale; ph_gemm(lds, WSP(bf16_t, R_POOLED), 1024, WSP(bf16_t, W_POOL), 256, NTOK, 1024, 256, f, bid, nblk, 0, 512); }
                AttnArgs a; a.Q = WSP(bf16_t, R_Q0); a.K = WSP(bf16_t, R_K0); a.VT = WSP(bf16_t, R_VT0); a.MT = WSP(unsigned long long, R_MASK); a.O = WSP(bf16_t, R_CC0); a.ldq = 1024; a.ldk = 1024; a.ldo = 2048;
                a.sc_log2e = 0.08838834764831845f * 1.4426950408889634f;
                attn_phase<128, true>(lds, a, bid, nblk);
#endif
            PHASE_END
        PHASE_BEGIN
#if !((SKIPMASK >> 4) & 1)
            FStoreBf16 f; f.O = Mx; f.ldc = 2048; f.pad_ = 0;
            ph_gemm(lds, CC, 2048, WSP(bf16_t, W_ABOUT), 2048, NTOK, 2048, 2048, f, bid, nblk);
#endif
        PHASE_END
        PHASE_BEGIN
#if !((SKIPMASK >> 5) & 1)
            ph_resnorm<false, true>(x, Mx, mix_post_g + 0, ffn_pre_g + 0, xo, H, FP8_UP0 ? WSP(unsigned char, R_H) : (unsigned char*)nullptr, bid, nblk);
#endif
        PHASE_END
        PHASE_BEGIN
#if FP8_UP0
            { EpiGate<FP8_DN0 != 0, true> ep; ep.cw = ffn_conv_w + 0; ep.cb = ffn_conv_b + 0; ep.ACT = WSP(void, R_HID);
              ph_gemm_e(lds, (const bf16_t*)WSP(unsigned char, R_H), 1024, (const bf16_t*)WSP(unsigned char, W_UP0), 1024, 134 * 256, 8192, 1024, ep, bid, nblk, 0, 0, 1); }
#else
            { EpiGate<FP8_DN0 != 0, false> ep; ep.cw = ffn_conv_w + 0; ep.cb = ffn_conv_b + 0; ep.ACT = WSP(void, R_HID);
              ph_gemm_e(lds, H, 2048, WSP(bf16_t, W_UP0), 2048, 134 * 256, 8192, 2048, ep, bid, nblk, 0, 0, 1); }
#endif
        PHASE_END
        PHASE_BEGIN
            FStoreBf16 f; f.O = WSP(bf16_t, R_F); f.ldc = 2048; f.pad_ = 0;
#if FP8_DN0
            ph_gemm8(lds, WSP(unsigned char, R_HID), 4096, WSP(unsigned char, W_DN0), 4096, NTOK, 2048, 4096, f, bid, nblk);
#else
            ph_gemm(lds, WSP(bf16_t, R_HID), 4096, WSP(bf16_t, W_DN0), 4096, NTOK, 2048, 4096, f, bid, nblk);
#endif
        PHASE_END
        PHASE_BEGIN
#if !((SKIPMASK >> 9) & 1)
            ph_resnorm<true, true>(xo, WSP(bf16_t, R_F), ffn_post_g + 0, mix_pre_g + 2048, xo, H, nullptr, bid, nblk);
#endif
        PHASE_END
    }
    {
#undef LAYER_CC
#undef LAYER_MX
#define LAYER_CC R_CC1
#define LAYER_MX R_M1
            PHASE_BEGIN
#if !((SKIPMASK >> 10) & 1)
                FCdIn f; f.CQ = WSP(float, R_CQ); f.CKV = WSP(float, R_CKV); f.KR = WSP(float, R_KR); f.XL = WSP(bf16_t, R_XL); f.YG = WSP(bf16_t, R_YG);
                ph_gemm(lds, H, 2048, WSP(bf16_t, W_CDIN), 2048, NTOK, 3072, 2048, f, bid, nblk);
#endif
            PHASE_END
            PHASE_BEGIN
#if !((SKIPMASK >> 11) & 1)
                ph_xc(WSP(bf16_t, R_XL), lru_conv_w, lru_conv_b, WSP(bf16_t, R_XCB), bid, nblk);
                ph_conv_lru(lru_wa, lru_wx, WSP(bf16_t, W_LRU), bid, nblk);
                ph_rmsnorm<512>(WSP(float, R_CQ), q_norm_g, WSP(bf16_t, R_CQN), bid, nblk);
                ph_rmsnorm<256>(WSP(float, R_CKV), kv_norm_g, WSP(bf16_t, R_CKVN), bid, nblk);
            PHASE_END
            PHASE_BEGIN
                { EpiLru ep; ep.XCB = WSP(bf16_t, R_XCB); ep.ba = lru_ba; ep.bx = lru_bx; ep.lam = lru_lambda; ep.LA = WSP(bf16_t, R_LA); ep.LB = WSP(bf16_t, R_LB);
                  ph_gemm_e(lds, WSP(bf16_t, R_XCB), 1024, WSP(bf16_t, W_LRU), 256, NTOK, 2048, 256, ep, bid, nblk, 1, 512); }
                { FStoreBf16 f; f.O = WSP(bf16_t, R_Q1); f.ldc = 1536; f.pad_ = 0; ph_gemm(lds, WSP(bf16_t, R_CQN), 512, WSP(bf16_t, W_QUP), 512, NTOK, 1536, 512, f, bid, nblk); }
                { FKvUp2 f; f.K8 = WSP(unsigned char, R_K1); f.VT = WSP(bf16_t, R_VT1); ph_gemm(lds, WSP(bf16_t, R_CKVN), 256, WSP(bf16_t, W_KVUP), 256, NTOK, 2048, 256, f, bid, nblk); }
            PHASE_END
            PHASE_BEGIN
                ph_scan1(WSP(bf16_t, R_LA), WSP(bf16_t, R_LB), WSP(float, R_CA), WSP(float, R_CH), bid, nblk);
                ph_rope_q(WSP(bf16_t, R_Q1), positions, WSP(unsigned char, R_Q8), bid, nblk);
                ph_rope_k(WSP(float, R_KR), positions, WSP(unsigned char, R_K1), bid, nblk);
            PHASE_END
            PHASE_BEGIN
                ph_scan2(WSP(float, R_CA), WSP(float, R_CH), WSP(float, R_CIN), bid, nblk);
            PHASE_END
            PHASE_BEGIN
                ph_scan3(WSP(bf16_t, R_LA), WSP(bf16_t, R_LB), WSP(float, R_CIN), WSP(bf16_t, R_YG), WSP(bf16_t, R_CC1), bid, nblk);
                AttnArgs a; a.Q = WSP(bf16_t, R_Q8); a.K = WSP(bf16_t, R_K1); a.VT = WSP(bf16_t, R_VT1); a.MT = nullptr; a.O = WSP(bf16_t, R_CC1); a.ldq = 1536; a.ldk = 1536; a.ldo = 2048;
                a.sc_log2e = 0.07216878364870322f * 1.4426950408889634f;
                attn_phase<192, false>(lds, a, bid, nblk);
#endif
            PHASE_END
        PHASE_BEGIN
#if !((SKIPMASK >> 15) & 1)
            FStoreBf16 f; f.O = Mx; f.ldc = 2048; f.pad_ = 0;
            ph_gemm(lds, CC, 2048, WSP(bf16_t, W_CDOUT), 2048, NTOK, 2048, 2048, f, bid, nblk);
#endif
        PHASE_END
        PHASE_BEGIN
#if !((SKIPMASK >> 16) & 1)
            ph_resnorm<true, true>(xo, Mx, mix_post_g + 2048, ffn_pre_g + 2048, WSP(bf16_t, R_X3), H, FP8_UP1 ? WSP(unsigned char, R_H) : (unsigned char*)nullptr, bid, nblk);
#endif
        PHASE_END
        PHASE_BEGIN
#if FP8_UP1
            { EpiGate<FP8_DN1 != 0, true> ep; ep.cw = ffn_conv_w + 24576; ep.cb = ffn_conv_b + 8192; ep.ACT = WSP(void, R_HID);
              ph_gemm_e(lds, (const bf16_t*)WSP(unsigned char, R_H), 1024, (const bf16_t*)WSP(unsigned char, W_UP1), 1024, 134 * 256, 8192, 1024, ep, bid, nblk, 0, 0, 1); }
#else
            { EpiGate<FP8_DN1 != 0, false> ep; ep.cw = ffn_conv_w + 24576; ep.cb = ffn_conv_b + 8192; ep.ACT = WSP(void, R_HID);
              ph_gemm_e(lds, H, 2048, WSP(bf16_t, W_UP1), 2048, 134 * 256, 8192, 2048, ep, bid, nblk, 0, 0, 1); }
#endif
        PHASE_END
        PHASE_BEGIN
            FStoreBf16 f; f.O = WSP(bf16_t, R_F); f.ldc = 2048; f.pad_ = 0;
#if FP8_DN1
            ph_gemm8(lds, WSP(unsigned char, R_HID), 4096, WSP(unsigned char, W_DN1), 4096, NTOK, 2048, 4096, f, bid, nblk);
#else
            ph_gemm(lds, WSP(bf16_t, R_HID), 4096, WSP(bf16_t, W_DN1), 4096, NTOK, 2048, 4096, f, bid, nblk);
#endif
        PHASE_END
        PHASE_BEGIN
#if !((SKIPMASK >> 20) & 1)
            ph_resnorm<true, false>(WSP(bf16_t, R_X3), WSP(bf16_t, R_F), ffn_post_g + 2048, (const float*)nullptr, xo, H, nullptr, bid, nblk);
#endif
        PHASE_END
    }
#undef LAYER_CC
#undef LAYER_MX
#undef WSP
#undef PHASE_BEGIN
#undef PHASE_END
}

#ifndef MK_N_LAUNCHES
#define MK_N_LAUNCHES 1
#endif
static constexpr int MK_NPHASES = 1 + 3 + 7 + 2 * 5;

extern "C" void kernel_launch(void* const* d_in, const int* in_sizes, int n_in, void* d_out, int out_size, void* d_ws, size_t ws_size, hipStream_t stream) {
    static int grid = 0;
    if (grid == 0) {
        if (n_in != 28 || out_size != NTOK * DM || ws_size < WS_NEED) { fprintf(stderr, "kernel_launch: unexpected shapes (n_in %d out %d ws %zu)\n", n_in, out_size, ws_size); grid = -1; return; }
        int dev = 0, cus = 0, per_cu = 0;
        if (hipGetDevice(&dev) != hipSuccess || hipDeviceGetAttribute(&cus, hipDeviceAttributeMultiprocessorCount, dev) != hipSuccess) { grid = -1; return; }
        if (hipFuncSetAttribute((const void*)k_mega, hipFuncAttributeMaxDynamicSharedMemorySize, MK_LDS) != hipSuccess) { fprintf(stderr, "kernel_launch: hipFuncSetAttribute failed\n"); grid = -1; return; }
        if (hipOccupancyMaxActiveBlocksPerMultiprocessor(&per_cu, (const void*)k_mega, 512, MK_LDS) != hipSuccess || per_cu < 1) { fprintf(stderr, "kernel_launch: occupancy query says %d\n", per_cu); }
        (void)hipGetLastError();
        grid = cus;
        if (grid != 256) { fprintf(stderr, "kernel_launch: built for 256 CUs, found %d\n", grid); grid = -1; return; }
    }
    if (grid < 0) return;
    unsigned char* ws = (unsigned char*)d_ws;
    (void)hipMemsetAsync(ws + WS_BAR, 0, XCD_BAR_WORDS * sizeof(unsigned), stream);
    (void)hipMemsetAsync(ws + W_ABIN + (size_t)5200 * 2048 * 2, 0, (size_t)176 * 2048 * 2, stream);
    (void)hipMemsetAsync(ws + W_CDIN + (size_t)832 * 2048 * 2, 0, (size_t)192 * 2048 * 2, stream);
    MK p{};
    for (int i = 0; i < 28; ++i) p.in[i] = (const float*)d_in[i];
    p.out = (float*)d_out; p.ws = ws;
#if MK_N_LAUNCHES == 1
    p.ph_lo = 0; p.ph_hi = 1 << 20;
    hipLaunchKernelGGL(k_mega, dim3(grid), dim3(512), MK_LDS, stream, p);
#else
    for (int ph = 0; ph < MK_NPHASES; ++ph) { p.ph_lo = ph; p.ph_hi = ph + 1; hipLaunchKernelGGL(k_mega, dim3(grid), dim3(512), MK_LDS, stream, p); }
#endif
}
```

```cpp
#include <hip/hip_runtime.h>
#include <stdint.h>
#include <stdio.h>

#define LAS __attribute__((address_space(3)))
typedef unsigned short bf16_t;
typedef float f32x4 __attribute__((ext_vector_type(4)));
typedef unsigned u32x4 __attribute__((ext_vector_type(4)));
typedef unsigned u32x2 __attribute__((ext_vector_type(2)));

static constexpr int NTOK = 32768, SEQ = 16384, NBATCH = 2, DM = 2048, DFF = 4096;
static constexpr float NORM_EPS = 1e-6f;

__device__ __forceinline__ bf16_t f2bf(float f) { unsigned u = __float_as_uint(f); u += 0x7FFFu + ((u >> 16) & 1u); return (bf16_t)(u >> 16); }
__device__ __forceinline__ float bf2f(bf16_t b) { return __uint_as_float(((unsigned)b) << 16); }
__device__ __forceinline__ unsigned pack2bf(float lo, float hi) { unsigned r; asm("v_cvt_pk_bf16_f32 %0, %1, %2" : "=v"(r) : "v"(lo), "v"(hi)); return r; }
__device__ __forceinline__ float gelu_tanh(float x) { const float u = 0.7978845608028654f * (x + 0.044715f * x * x * x); return 0.5f * x * (1.0f + tanhf(u)); }
__device__ __forceinline__ float wave_sum(float v) {
#pragma unroll
    for (int o = 32; o >= 1; o >>= 1) v += __shfl_xor(v, o);
    return v;
}

#ifndef TID_PLAIN
#define TID_PLAIN 0
#endif
static constexpr int TID_TAB_LDS = 162816 - 16 - 256;
#if TID_PLAIN
__device__ __forceinline__ int opaque_tid() { int t = (int)threadIdx.x; asm volatile("" : "+v"(t)); return t; }
#else
__device__ __forceinline__ int opaque_tid() {
    const unsigned slot = (unsigned)__builtin_amdgcn_s_getreg(((6 - 1) << 11) | 4) & 63u;
    const int w = __builtin_amdgcn_readfirstlane(*(const volatile LAS int*)(size_t)(TID_TAB_LDS + 4 * slot));
    int lane; asm volatile("v_mbcnt_lo_u32_b32 %0, -1, 0\n\tv_mbcnt_hi_u32_b32 %0, -1, %0" : "=v"(lane));
    return w * 64 + lane;
}
#endif

__device__ __forceinline__ int opaque_s(int v) { asm volatile("" : "+s"(v)); return v; }

template <class T> __device__ __forceinline__ const T* opaque_p(const T* p) { asm volatile("" : "+s"(p)); return p; }

#ifndef PG8_EPI_RECOMP
#define PG8_EPI_RECOMP 1
#endif
#ifndef PG8_ASM_DMA
#define PG8_ASM_DMA 1
#endif
#include <hip/hip_runtime.h>
namespace pg8 {
#define PG8_LAS __attribute__((address_space(3)))
typedef unsigned short bf16_t;
typedef short bf16x8 __attribute__((ext_vector_type(8)));
typedef float f32x4 __attribute__((ext_vector_type(4)));
typedef unsigned u32x4 __attribute__((ext_vector_type(4)));
typedef int i32x8 __attribute__((ext_vector_type(8)));
typedef int i32x4 __attribute__((ext_vector_type(4)));
constexpr int BM = 256, BK = 64, HALF = 128, HTB = HALF * BK * 2  , STAGE_BYTES = 8 * HTB, NXCD = 8, WGM = 8;

__host__ __device__ __forceinline__ int lds_byte(int r, int c) { const int st = (r >> 4) * 2 + (c >> 5), rr = r & 15, cc = c & 31, ob = rr * 64 + cc * 2; return st * 1024 + (ob ^ (((ob >> 9) & 1) << 5)); }
__host__ __device__ __forceinline__ void stage_rc(int b, int& R, int& C) { const int st = b / 1024, sb = b % 1024, swz = sb ^ (((sb >> 9) & 1) << 5); R = (st >> 1) * 16 + swz / 64; C = (st & 1) * 32 + (swz % 64) / 2; }
__host__ __device__ __forceinline__ int perm32(int rho) { const int n = rho >> 4, i = rho & 15; return 8 * (i >> 2) + 4 * n + (i & 3); }

struct Unit { int pm, pn; };
struct Gemm { const bf16_t* A; const bf16_t* Bt; int M, N, K, lda, ldb, a_shift, a_bytes, cmode; };

struct StaticOrder {
    int nM, nN, nwg, G, c;
    __host__ __device__ void init(int M, int N, int G_, int c_) { nM = M / BM; nN = N / BM; nwg = nM * nN; G = G_; c = c_; }
    __host__ __device__ bool next(int i, Unit& u) const {
        const long L = (long)i * G + c; if (L >= nwg) return false;
        int wgid = (int)L; { const int q = nwg / NXCD, r = nwg % NXCD, xcd = wgid % NXCD, off = wgid / NXCD; wgid = (xcd < r ? xcd * (q + 1) : r * (q + 1) + (xcd - r) * q) + off; }
        const int nig = WGM * nN, gid = wgid / nig, fm = gid * WGM, gsz = (nM - fm) < WGM ? (nM - fm) : WGM;
        u.pm = fm + ((wgid % nig) % gsz); u.pn = (wgid % nig) / gsz; return true;
    }
    __device__ __forceinline__ void a_ready(const Unit&) const {}
    __device__ __forceinline__ void done(const Unit&) const {}
};

template <class Epi, class Sched, bool STAMP = false>
__device__ __forceinline__ void gemm_phase(PG8_LAS unsigned char* lds, const Gemm g, const Sched& S, const Epi& E, unsigned long long* stamps) {
    const int tid = opaque_tid(), wid = __builtin_amdgcn_readfirstlane(tid >> 6), lane = tid & 63, wr = wid >> 2, wc = wid & 3, fr = lane & 15, fq = lane >> 4;
    const int K = g.K, nt = K / BK;
    int ts_lo = 0, ts_hi = 0, nts = 0; const unsigned long long rt_entry = STAMP ? (unsigned long long)wall_clock64() : 0ull;
#define PG8_STAMP() do { if (STAMP && wid == 0 && nts < 64) { const unsigned long long _c = (unsigned long long)clock64(); \
        ts_lo = (lane == nts) ? (int)(unsigned)_c : ts_lo; ts_hi = (lane == nts) ? (int)(unsigned)(_c >> 32) : ts_hi; ++nts; } } while (0)
    PG8_STAMP();
    unsigned voffA[2], voffB[2];
#pragma unroll
    for (int i = 0; i < 2; ++i) { int R, C; stage_rc(tid * 16 + i * 8192, R, C); const int Rb = Epi::PERM ? ((R & ~31) + perm32(R & 31)) : R;
        const int Ra = g.cmode ? (R - 2 * (R >> 6)) : R;
        voffA[i] = (unsigned)(Ra * g.lda + C) * 2u; voffB[i] = (unsigned)(Rb * g.ldb + C) * 2u; }
    const size_t kstep = (size_t)(BK * 2);
    const size_t hstepA = (size_t)(g.cmode ? HALF - 4 : HALF) * g.lda * 2, hstepB = (size_t)HALF * g.ldb * 2;
    const size_t tstepA = 2 * hstepA, tstepB = 2 * hstepB;
    const unsigned ldsbase_ = (unsigned)(size_t)lds;
    const int sc_w_ = 0x79797979, sc_a_ = 0x7F7F7F7F;
    (void)sc_w_; (void)sc_a_;
    const unsigned ldsw = (unsigned)wid * 1024u;
    const int aoff = lds_byte(wr * 64 + fr, fq * 8), boff = lds_byte(wc * 32 + fr, fq * 8);
#define PG8_SA(b, h) (((b) * 2 + (h)) * HTB)
#define PG8_SB(b, h) ((4 + (b) * 2 + (h)) * HTB)
#if PG8_ASM_DMA
#define PG8_STAGE(bufoff, gbase, voff) do { _Pragma("unroll") for (int _i = 0; _i < 2; ++_i) { unsigned keep_; \
        asm volatile("s_mov_b32 %0, m0\n\ts_mov_b32 m0, %3\n\ts_nop 0\n\tglobal_load_lds_dwordx4 %1, %2\n\ts_mov_b32 m0, %0" \
                     : "=&s"(keep_) : "v"((voff)[_i]), "s"((const char*)(gbase)), "s"(ldsbase_ + (unsigned)(bufoff) + ldsw + (unsigned)(_i * 8192)) : "memory"); } } while (0)
#else
#define PG8_STAGE(bufoff, gbase, voff) do { _Pragma("unroll") for (int _i = 0; _i < 2; ++_i) \
        __builtin_amdgcn_global_load_lds((const unsigned*)((const char*)(gbase) + (voff)[_i]), (PG8_LAS unsigned*)(lds + (bufoff) + ldsw + _i * 8192), 16, 0, 0); } while (0)
#endif
#define PG8_LDA(dst, b, h) do { _Pragma("unroll") for (int m = 0; m < 4; ++m) { dst[m].lo = *(const PG8_LAS i32x4*)(lds + PG8_SA(b, h) + aoff + m * 2048); dst[m].hi = *(const PG8_LAS i32x4*)(lds + PG8_SA(b, h) + aoff + m * 2048 + 1024); } } while (0)
#define PG8_LDB(dst, b, h) do { _Pragma("unroll") for (int n = 0; n < 2; ++n) { dst[n].lo = *(const PG8_LAS i32x4*)(lds + PG8_SB(b, h) + boff + n * 2048); dst[n].hi = *(const PG8_LAS i32x4*)(lds + PG8_SB(b, h) + boff + n * 2048 + 1024); } } while (0)
#define PG8_MMA(ai, bj, At, Bt) do { __builtin_amdgcn_s_setprio(1); \
        if constexpr (Epi::FP8) { _Pragma("unroll") for (int m = 0; m < 4; ++m) _Pragma("unroll") for (int n = 0; n < 2; ++n) \
            asm volatile("v_mfma_scale_f32_16x16x128_f8f6f4 %0, %1, %2, %0, %3, %4 op_sel_hi:[0,0,0]" : "+v"(acc[ai][bj][m][n]) : "v"(Bt[n]), "v"(At[m]), "v"(sc_w_), "v"(sc_a_)); } \
        else { _Pragma("unroll") for (int m = 0; m < 4; ++m) _Pragma("unroll") for (int n = 0; n < 2; ++n) { \
            const i32x4 bl_ = Bt[n].lo, bh_ = Bt[n].hi, al_ = At[m].lo, ah_ = At[m].hi;     \
            acc[ai][bj][m][n] = __builtin_amdgcn_mfma_f32_16x16x32_bf16(__builtin_bit_cast(bf16x8, bl_), __builtin_bit_cast(bf16x8, al_), acc[ai][bj][m][n], 0, 0, 0); \
            acc[ai][bj][m][n] = __builtin_amdgcn_mfma_f32_16x16x32_bf16(__builtin_bit_cast(bf16x8, bh_), __builtin_bit_cast(bf16x8, ah_), acc[ai][bj][m][n], 0, 0, 0); } } \
        __builtin_amdgcn_s_setprio(0); } while (0)
#define PG8_WAIT_V(n) asm volatile("s_waitcnt vmcnt(" #n ")" ::: "memory")
#define PG8_WAIT_L(n) asm volatile("s_waitcnt lgkmcnt(" #n ")" ::: "memory")
#define PG8_BAR __builtin_amdgcn_s_barrier()
#define PG8_SCHED __builtin_amdgcn_sched_barrier(0)
    Unit cur, nxt; int ui = 0;
    if (!S.next(0, cur)) return;
    f32x4 acc[2][2][4][2];
#pragma unroll
    for (int a = 0; a < 2; ++a)
#pragma unroll
        for (int b = 0; b < 2; ++b)
#pragma unroll
            for (int m = 0; m < 4; ++m)
#pragma unroll
                for (int n = 0; n < 2; ++n) acc[a][b][m][n] = (f32x4){0.f, 0.f, 0.f, 0.f};
    i32x8 At[4], B0[2], B1[2];
    auto a_base_ = [&](const Unit& u_) -> const char* { return g.cmode ? (const char*)g.A + ((long)(u_.pm / 67) * 16384 + (long)(u_.pm % 67) * 248 - 2) * (long)g.lda * 2 : (const char*)g.A + (size_t)u_.pm * tstepA + (size_t)(u_.pn >> g.a_shift) * g.a_bytes; };
    const char* cA = a_base_(cur); const char* cB = (const char*)g.Bt + (size_t)cur.pn * tstepB;
    S.a_ready(cur);
    PG8_STAGE(PG8_SB(0, 0), cB, voffB); PG8_STAGE(PG8_SA(0, 0), cA, voffA); PG8_STAGE(PG8_SB(0, 1), cB + hstepB, voffB); PG8_STAGE(PG8_SA(0, 1), cA + hstepA, voffA);
    if (wr == 1) PG8_BAR;
    PG8_WAIT_V(4); PG8_BAR;
    PG8_STAGE(PG8_SB(1, 0), cB + kstep, voffB); PG8_STAGE(PG8_SA(1, 0), cA + kstep, voffA); PG8_STAGE(PG8_SB(1, 1), cB + hstepB + kstep, voffB);
    PG8_WAIT_V(6); PG8_BAR;
    PG8_STAMP();
    for (;;) {
        const bool has_next = S.next(ui + 1, nxt);
        const char* nA = has_next ? a_base_(nxt) : cA; const char* nB = has_next ? (const char*)g.Bt + (size_t)nxt.pn * tstepB : cB;
        for (int t = 0; t < nt; t += 2) {
            const bool last = (t == nt - 2);
            const char* a1 = cA + (size_t)(t + 1) * kstep;
            const char* a2 = last ? nA : cA + (size_t)(t + 2) * kstep; const char* b2 = last ? nB : cB + (size_t)(t + 2) * kstep;
            const char* a3 = a2 + kstep; const char* b3 = b2 + kstep;
            if (last && has_next) S.a_ready(nxt);
            PG8_LDB(B0, 0, 0); PG8_SCHED; PG8_LDA(At, 0, 0); PG8_STAGE(PG8_SA(1, 1), a1 + hstepA, voffA);
            PG8_WAIT_L(8); PG8_BAR; PG8_WAIT_L(0); PG8_MMA(0, 0, At, B0); PG8_BAR; PG8_SCHED;
            PG8_LDB(B1, 0, 1); PG8_STAGE(PG8_SB(0, 0), b2, voffB);
            PG8_BAR; PG8_WAIT_L(0); PG8_MMA(0, 1, At, B1); PG8_BAR;
            PG8_LDA(At, 0, 1); PG8_STAGE(PG8_SA(0, 0), a2, voffA);
            PG8_BAR; PG8_WAIT_L(0); PG8_MMA(1, 0, At, B0); PG8_BAR; PG8_SCHED;
            PG8_STAGE(PG8_SB(0, 1), b2 + hstepB, voffB);
            PG8_WAIT_V(6); PG8_BAR; PG8_MMA(1, 1, At, B1); PG8_BAR;
            PG8_LDB(B0, 1, 0); PG8_SCHED; PG8_LDA(At, 1, 0); PG8_STAGE(PG8_SA(0, 1), a2 + hstepA, voffA);
            PG8_WAIT_L(8); PG8_BAR; PG8_WAIT_L(0); PG8_MMA(0, 0, At, B0); PG8_BAR; PG8_SCHED;
            PG8_LDB(B1, 1, 1); PG8_STAGE(PG8_SB(1, 0), b3, voffB);
            PG8_BAR; PG8_WAIT_L(0); PG8_MMA(0, 1, At, B1); PG8_BAR;
            PG8_LDA(At, 1, 1); PG8_STAGE(PG8_SA(1, 0), a3, voffA);
            PG8_BAR; PG8_WAIT_L(0); PG8_MMA(1, 0, At, B0); PG8_BAR; PG8_SCHED;
            PG8_STAGE(PG8_SB(1, 1), b3 + hstepB, voffB);
            PG8_WAIT_V(6); PG8_BAR; PG8_MMA(1, 1, At, B1); PG8_BAR;
        }
        PG8_STAMP();
        if constexpr (Epi::FP8) { asm volatile("s_nop 15\n\ts_nop 15" ::: "memory"); }
        if constexpr (!Epi::AFTER_DRAIN) {
#if PG8_EPI_RECOMP
            const int t2_ = opaque_tid(), l2_ = t2_ & 63, w2_ = __builtin_amdgcn_readfirstlane(t2_ >> 6);
            E(acc, cur, w2_ >> 2, w2_ & 3, l2_ & 15, l2_ >> 4); S.done(cur);
#else
            E(acc, cur, wr, wc, fr, fq); S.done(cur);
#endif
        }
        PG8_STAMP();
        if (!has_next) break;
#pragma unroll
        for (int a = 0; a < 2; ++a)
#pragma unroll
            for (int b = 0; b < 2; ++b)
#pragma unroll
                for (int m = 0; m < 4; ++m)
#pragma unroll
                    for (int n = 0; n < 2; ++n) acc[a][b][m][n] = (f32x4){0.f, 0.f, 0.f, 0.f};
        cur = nxt; cA = nA; cB = nB; ++ui;
    }
    PG8_WAIT_V(0);
    if (wr == 0) PG8_BAR;
    PG8_BAR;
    if constexpr (Epi::AFTER_DRAIN) { E.fused(acc, cur, wr, wc, fr, fq, lds, wid, lane); S.done(cur); }
    PG8_STAMP();
    if (STAMP && wid == 0) { stamps[lane] = lane < nts ? (((unsigned long long)(unsigned)ts_hi << 32) | (unsigned)ts_lo) : 0ull;
        if (lane == 62) stamps[62] = rt_entry; if (lane == 63) stamps[63] = (unsigned long long)wall_clock64(); }
#undef PG8_STAMP
#undef PG8_SA
#undef PG8_SB
#undef PG8_STAGE
#undef PG8_LDA
#undef PG8_LDB
#undef PG8_MMA
#undef PG8_WAIT_V
#undef PG8_WAIT_L
#undef PG8_BAR
#undef PG8_SCHED
}
}

#include <cstdio>
#include <ctime>
#include <cstdlib>
#include <cstring>
#include <cmath>
#include <vector>

template <class F, bool F8 = false> struct EpiG {
    static constexpr bool PERM = false, AFTER_DRAIN = false, FP8 = F8;
    F f;
    __device__ __forceinline__ void operator()(const f32x4 (&acc)[2][2][4][2], const pg8::Unit& u, int wr, int wc, int fr, int fq) const {
        const int row0 = u.pm * 256 + wr * 64 + fr, col0 = u.pn * 256 + wc * 32 + 4 * fq;
#pragma unroll
        for (int ai = 0; ai < 2; ++ai)
#pragma unroll
            for (int m = 0; m < 4; ++m)
#pragma unroll
                for (int bj = 0; bj < 2; ++bj)
#pragma unroll
                    for (int n = 0; n < 2; ++n) f(row0 + ai * 128 + m * 16, col0 + bj * 128 + n * 16, acc[ai][bj][m][n]);
    }
};
__device__ __forceinline__ void st_bf16x4(bf16_t* p, f32x4 v) { u32x2 w; w.x = pack2bf(v[0], v[1]); w.y = pack2bf(v[2], v[3]); *(u32x2*)p = w; }
__device__ __forceinline__ void st_f32x4(float* p, f32x4 v) { *(f32x4*)p = v; }

struct FStoreBf16 { bf16_t* O; int ldc; int pad_; __device__ __forceinline__ void operator()(int r, int c, f32x4 v) const { st_bf16x4(O + (size_t)r * ldc + c, v); } };
struct FAbIn { bf16_t *Q, *K, *V; float *QI, *U, *WI; unsigned short* KI16;
    __device__ __forceinline__ void operator()(int r, int c, f32x4 v) const {
        if (c < 1024) st_bf16x4(Q + (size_t)r * 1024 + c, v);
        else if (c < 2048) st_bf16x4(K + (size_t)r * 1024 + (c - 1024), v);
        else if (c < 3072) st_bf16x4(V + (size_t)r * 1024 + (c - 2048), v);
        else if (c < 4096) st_f32x4(QI + (size_t)r * 1024 + (c - 3072), v);
        else if (c < 5120) st_f32x4(U + (size_t)r * 1024 + (c - 4096), v);
        else if (c < 5184) { typedef _Float16 h2 __attribute__((ext_vector_type(2))); union { h2 h; unsigned u; } a, b; a.h = (h2){(_Float16)v[0], (_Float16)v[1]}; b.h = (h2){(_Float16)v[2], (_Float16)v[3]};
            u32x2 w; w.x = a.u; w.y = b.u; *(u32x2*)(KI16 + (size_t)r * 64 + (c - 5120)) = w; }
        else if (c < 5200) st_f32x4(WI + (size_t)r * 16 + (c - 5184), v);
    } };
struct FCdIn { float *CQ, *CKV, *KR; bf16_t *XL, *YG;
    __device__ __forceinline__ void operator()(int r, int c, f32x4 v) const {
        if (c < 512) st_f32x4(CQ + (size_t)r * 512 + c, v);
        else if (c < 768) st_f32x4(CKV + (size_t)r * 256 + (c - 512), v);
        else if (c < 832) st_f32x4(KR + (size_t)r * 64 + (c - 768), v);
        else if (c < 1024) {}
        else if (c < 2048) st_bf16x4(XL + (size_t)r * 1024 + (c - 1024), v);
        else st_bf16x4(YG + (size_t)r * 1024 + (c - 2048), v);
    } };
struct FKvUp { bf16_t *K1, *V1;
    __device__ __forceinline__ void operator()(int r, int c, f32x4 v) const {
        const int h = c >> 8, d = c & 255;
        if (d < 128) st_bf16x4(K1 + (size_t)r * 1536 + h * 192 + d, v);
        else st_bf16x4(V1 + (size_t)r * 1024 + h * 128 + (d - 128), v);
    } };

__device__ __forceinline__ unsigned ord_key(float f) { const unsigned b = __float_as_uint(f); return (b & 0x80000000u) ? ~b : (b | 0x80000000u); }
__device__ __forceinline__ void rope_cs(int pos, int i, float& c, float& s) { const float freq = powf(10000.0f, -(float)i / 32.0f); const float ang = (float)pos * freq; sincosf(ang, &s, &c); }
#define PV8_MLA 1
#define PV8_DSA 1

typedef short bf16x8 __attribute__((ext_vector_type(8)));
typedef float f32x16 __attribute__((ext_vector_type(16)));
__device__ __forceinline__ unsigned cvtpk(float lo, float hi) { unsigned r; asm("v_cvt_pk_bf16_f32 %0, %1, %2" : "=v"(r) : "v"(lo), "v"(hi)); return r; }
__device__ __forceinline__ float max3_asm(float a, float b, float c) { float r; asm("v_max3_f32 %0, %1, %2, %3" : "=v"(r) : "v"(a), "v"(b), "v"(c)); return r; }

struct AttnArgs { const bf16_t* Q; const bf16_t* K; const bf16_t* VT; const unsigned long long* MT; bf16_t* O; int ldq, ldk, ldo; float sc_log2e; };

static constexpr int ATT_MTBL = 65536;
struct TTrue { static constexpr bool value = true; }; struct TFalse { static constexpr bool value = false; };
typedef int i32x8q __attribute__((ext_vector_type(8)));
typedef int i32x4q __attribute__((ext_vector_type(4)));
#define MFMA8_FENCE2(acc0, acc1, srcA, srcB) asm volatile("s_nop 15\n\ts_nop 9" : "+v"(acc0), "+v"(acc1) : "v"(srcA), "v"(srcB))
#define MFMA8_FENCE4(a0_, a1_, a2_, a3_, srcA, srcB) asm volatile("s_nop 15\n\ts_nop 9" : "+v"(a0_), "+v"(a1_), "+v"(a2_), "+v"(a3_) : "v"(srcA), "v"(srcB))
template <int DQK, bool MASKED, bool QK8>
__device__ __forceinline__ void attn_item3(LAS unsigned char* lds, const AttnArgs& a, int b, int h, int qb) {
    constexpr int NKS = QK8 ? DQK / 64 : DQK / 16, PK = QK8 ? DQK : DQK * 2, PV = 64, KB_BYTES = 64 * PK, VB_BYTES = 128 * PV, NPK = PK / 16, NKP = (64 * NPK + 511) / 512, V_OFF = 3 * KB_BYTES;
    const int tid = opaque_tid(), lane = tid & 63, w = __builtin_amdgcn_readfirstlane(tid >> 6), n = lane & 31, hf = lane >> 5;
    const int nt = 4 * qb + 4, cw = 4 * qb + (w >> 1);
    const int trow = qb * 256 + w * 32 + n;
    const size_t grow = (size_t)b * SEQ + trow;
    bf16x8 qf[QK8 ? 1 : NKS]; i32x8q q8[QK8 ? NKS : 1];
    if (QK8) { const unsigned char* qp = (const unsigned char*)a.Q + grow * a.ldq + h * DQK + hf * 32;
#pragma unroll
      for (int ks = 0; ks < NKS; ++ks) { q8[ks].lo = *(const i32x4q*)(qp + ks * 64); q8[ks].hi = *(const i32x4q*)(qp + ks * 64 + 16); } }
    else { const bf16_t* qp = a.Q + grow * a.ldq + h * DQK + hf * 8;
#pragma unroll
      for (int ks = 0; ks < NKS; ++ks) qf[ks] = *(const bf16x8*)(qp + ks * 16); }
    f32x16 o[4];
#pragma unroll
    for (int dt = 0; dt < 4; ++dt)
#pragma unroll
        for (int r = 0; r < 16; ++r) o[dt][r] = 0.f;
    float m_run = MASKED ? -1000.0f : -INFINITY, l_run = 0.f;
    const float c = a.sc_log2e;
    const unsigned char* Kg = (const unsigned char*)a.K + ((size_t)b * SEQ * a.ldk + h * DQK) * (QK8 ? 1 : 2);
    const unsigned char* Vg = (const unsigned char*)a.VT + (size_t)(b * 8 + h) * 128 * SEQ;
    const unsigned long long* Mg = MASKED ? a.MT + (size_t)b * 256 * SEQ + trow : nullptr;
    auto dma_k = [&](int kt) {
        LAS unsigned char* kb = lds + (kt % 3) * KB_BYTES;
#pragma unroll
        for (int i = 0; i < NKP; ++i) { if ((w + 8 * i) * 64 >= 64 * NPK) break;
            const int s = (w + 8 * i) * 64 + lane, r = s / NPK, cp = s % NPK, cc = cp ^ (NPK == 16 ? (r & 15) : (NPK == 12 ? ((r >> 2) & 3) : ((r >> 1) & 7)));
            __builtin_amdgcn_global_load_lds((const unsigned*)(Kg + ((size_t)(kt * 64 + r) * a.ldk) * (QK8 ? 1 : 2) + cc * 16), (LAS unsigned*)(kb + (w + 8 * i) * 1024), 16, 0, 0); }
    };
    auto dma_v = [&](int kt) {
        LAS unsigned char* vb = lds + V_OFF + (kt & 1) * VB_BYTES;
        const int s = w * 64 + lane, d = s >> 2, cp = s & 3, cc = cp ^ ((d >> 2) & 3);
        __builtin_amdgcn_global_load_lds((const unsigned*)(Vg + (size_t)d * SEQ + kt * 64 + cc * 16), (LAS unsigned*)(vb + w * 1024), 16, 0, 0);
    };
    const int kswz = (NPK == 16) ? (n & 15) : (NPK == 12 ? ((n >> 2) & 3) : ((n >> 1) & 7)), vswz = (n >> 2) & 3;
    auto qk = [&](int kt, f32x16& s0, f32x16& s1, bool fence) {
        const LAS unsigned char* ka = lds + (kt % 3) * KB_BYTES + n * PK;
#pragma unroll
        for (int r = 0; r < 16; ++r) { s0[r] = 0.f; s1[r] = 0.f; }
        if (QK8) {
#pragma unroll
            for (int ks = 0; ks < NKS; ++ks) {
                const int p0 = ((4 * ks + 2 * hf) ^ kswz) * 16, p1 = ((4 * ks + 2 * hf + 1) ^ kswz) * 16;
                i32x8q a0, a1;
                a0.lo = *(const LAS i32x4q*)(ka + p0); a0.hi = *(const LAS i32x4q*)(ka + p1);
                a1.lo = *(const LAS i32x4q*)(ka + 32 * PK + p0); a1.hi = *(const LAS i32x4q*)(ka + 32 * PK + p1);
                s0 = __builtin_amdgcn_mfma_scale_f32_32x32x64_f8f6f4(a0, q8[ks], s0, 0, 0, 0, 0x7F7F7F7F, 0, 0x7F7F7F7F);
                s1 = __builtin_amdgcn_mfma_scale_f32_32x32x64_f8f6f4(a1, q8[ks], s1, 0, 0, 0, 0x7F7F7F7F, 0, 0x7F7F7F7F);
                if (ks == NKS - 1 && fence) MFMA8_FENCE2(s0, s1, a0, a1);
            }
        } else {
#pragma unroll
            for (int ks = 0; ks < NKS; ++ks) {
                const int po = ((2 * ks + hf) ^ kswz) * 16;
                const bf16x8 a0 = *(const LAS bf16x8*)(ka + po), a1 = *(const LAS bf16x8*)(ka + 32 * PK + po);
                s0 = __builtin_amdgcn_mfma_f32_32x32x16_bf16(a0, qf[ks], s0, 0, 0, 0);
                s1 = __builtin_amdgcn_mfma_f32_32x32x16_bf16(a1, qf[ks], s1, 0, 0, 0);
            }
        }
    };
    i32x8q idA0, idA1;
#pragma unroll
    for (int i = 0; i < 8; ++i) { const int v = (i == (n >> 2)) ? (0x38 << (8 * (n & 3))) : 0; idA0[i] = hf ? 0 : v; idA1[i] = hf ? v : 0; }
    auto maskmma = [&](unsigned long long mw, f32x16& s0, f32x16& s1, bool fence) {
        if (MASKED) {
            const unsigned bits = hf ? (unsigned)(mw >> 32) : (unsigned)mw;
            const LAS u32x2* tbl = (const LAS u32x2*)(lds + ATT_MTBL);
            i32x8q bm;
#pragma unroll
            for (int i = 0; i < 4; ++i) { const u32x2 t = tbl[(bits >> (8 * i)) & 255u]; bm[2 * i] = (int)t.x; bm[2 * i + 1] = (int)t.y; }
            s0 = __builtin_amdgcn_mfma_scale_f32_32x32x64_f8f6f4(idA0, bm, s0, 0, 0, 0, 0x7F7F7F7F, 0, (int)0x82828282);
            s1 = __builtin_amdgcn_mfma_scale_f32_32x32x64_f8f6f4(idA1, bm, s1, 0, 0, 0, 0x7F7F7F7F, 0, (int)0x82828282);
            MFMA8_FENCE2(s0, s1, idA1, bm);
        }
    };
    auto rowmax = [&](f32x16& s0, f32x16& s1) -> float {
        float mx = max3_asm(s0[0], s1[0], s0[1]);
        mx = max3_asm(mx, s1[1], s0[2]);
#pragma unroll
        for (int r = 2; r < 15; ++r) mx = max3_asm(mx, s1[r], s0[r + 1]);
        mx = max3_asm(mx, s1[15], mx);
        const auto rr = __builtin_amdgcn_permlane32_swap(__float_as_uint(mx), __float_as_uint(mx), false, false);
        return fmaxf(__uint_as_float(rr[0]), __uint_as_float(rr[1]));
    };
    auto pv = [&](const f32x16& c0, const f32x16& c1, int kt, bool fence) {
        i32x8q pb;
#pragma unroll
        for (int i = 0; i < 4; ++i) { int d0 = 0, d1 = 0;
            d0 = __builtin_amdgcn_cvt_pk_fp8_f32(c0[4 * i], c0[4 * i + 1], d0, false); d0 = __builtin_amdgcn_cvt_pk_fp8_f32(c0[4 * i + 2], c0[4 * i + 3], d0, true);
            d1 = __builtin_amdgcn_cvt_pk_fp8_f32(c1[4 * i], c1[4 * i + 1], d1, false); d1 = __builtin_amdgcn_cvt_pk_fp8_f32(c1[4 * i + 2], c1[4 * i + 3], d1, true);
            pb[i] = d0; pb[4 + i] = d1; }
        const LAS unsigned char* va = lds + V_OFF + (kt & 1) * VB_BYTES + n * PV;
        const int q0_ = ((2 * hf) ^ vswz) * 16, q1_ = ((2 * hf + 1) ^ vswz) * 16;
#pragma unroll
        for (int dt = 0; dt < 4; ++dt) { i32x8q vf; vf.lo = *(const LAS i32x4q*)(va + dt * 32 * PV + q0_); vf.hi = *(const LAS i32x4q*)(va + dt * 32 * PV + q1_);
            o[dt] = __builtin_amdgcn_mfma_scale_f32_32x32x64_f8f6f4(vf, pb, o[dt], 0, 0, 0, 0x7F7F7F7F, 0, 0x79797979);
            if (dt == 3) MFMA8_FENCE4(o[0], o[1], o[2], o[3], vf, pb); }
    };
    dma_k(0); dma_v(0); if (nt > 1) dma_k(1);
    unsigned long long mw_pre = MASKED ? Mg[(size_t)(nt > 1 ? 1 : 0) * SEQ] : 0ull;
    asm volatile("s_waitcnt vmcnt(0)" ::: "memory");
    __syncthreads();
    f32x16 sa0, sa1, sb0, sb1;
    qk(0, sa0, sa1, true); maskmma(MASKED ? Mg[0] : 0ull, sa0, sa1, true);
    float mx_cur = rowmax(sa0, sa1);
    auto step = [&](int kt, f32x16& c0, f32x16& c1, f32x16& n0, f32x16& n1, auto full_tag) {
        constexpr bool FULL = decltype(full_tag)::value;
        if (kt + 2 < nt) dma_k(kt + 2);
        if (kt + 1 < nt) dma_v(kt + 1);
        const unsigned long long mw_now = mw_pre;
        if (MASKED) mw_pre = Mg[(size_t)(kt + 2 < nt ? kt + 2 : kt) * SEQ];
        const bool act = FULL || kt <= cw, actn = FULL || kt + 1 <= cw;
        const float m_new = fmaxf(m_run, mx_cur);
        const float m_use = (MASKED && m_new == -INFINITY) ? 0.f : m_new;
        if (act && __any(m_new > m_run)) {
            const float al = __builtin_amdgcn_exp2f((m_run - m_use) * c);
            l_run *= al;
#pragma unroll
            for (int dt = 0; dt < 4; ++dt)
#pragma unroll
                for (int r = 0; r < 16; ++r) o[dt][r] *= al;
        }
        if (act) m_run = m_new;
        if (FULL) {
            qk(kt + 1, n0, n1, !MASKED); maskmma(mw_now, n0, n1, true);
            const float mc = m_use * c - 6.0f;
            float ps = 0.f;
#pragma unroll
            for (int r = 0; r < 16; ++r) { c0[r] = __builtin_amdgcn_exp2f(fmaf(c0[r], c, -mc)); c1[r] = __builtin_amdgcn_exp2f(fmaf(c1[r], c, -mc)); ps += c0[r] + c1[r]; }
            l_run += ps;
            pv(c0, c1, kt, true);
            mx_cur = rowmax(n0, n1);
        } else {
            if (actn) { qk(kt + 1, n0, n1, true); maskmma(mw_now, n0, n1, true); }
            if (act) {
                const float mc = m_use * c - 6.0f;
                float ps = 0.f;
#pragma unroll
                for (int r = 0; r < 16; ++r) { c0[r] = __builtin_amdgcn_exp2f(fmaf(c0[r], c, -mc)); c1[r] = __builtin_amdgcn_exp2f(fmaf(c1[r], c, -mc)); ps += c0[r] + c1[r]; }
                l_run += ps;
                pv(c0, c1, kt, true);
            }
            if (actn) mx_cur = rowmax(n0, n1);
        }
        asm volatile("s_waitcnt vmcnt(0)" ::: "memory");
        __syncthreads();
    };
    int kt = 0;
    for (; kt < 4 * qb; kt += 2) { step(kt, sa0, sa1, sb0, sb1, TTrue{}); step(kt + 1, sb0, sb1, sa0, sa1, TTrue{}); }
    for (; kt < nt; kt += 2) { step(kt, sa0, sa1, sb0, sb1, TFalse{}); step(kt + 1, sb0, sb1, sa0, sa1, TFalse{}); }
    const float lt = l_run + __shfl_xor(l_run, 32);
    const float inv = 64.0f / lt;
    bf16_t* op = a.O + grow * a.ldo + h * 128 + hf * 4;
#pragma unroll
    for (int dt = 0; dt < 4; ++dt)
#pragma unroll
        for (int r4 = 0; r4 < 4; ++r4) { u32x2 wv; wv.x = cvtpk(o[dt][4 * r4] * inv, o[dt][4 * r4 + 1] * inv); wv.y = cvtpk(o[dt][4 * r4 + 2] * inv, o[dt][4 * r4 + 3] * inv);
            *(u32x2*)(op + dt * 32 + r4 * 8) = wv; }
}
template <int DQK, bool MASKED>
__device__ __forceinline__ void attn_phase(LAS unsigned char* lds, const AttnArgs& a, int bid, int nblk) {
    if (MASKED) {
        const int t = opaque_tid();
        if (t < 256) { unsigned lo = 0u, hi = 0u;
#pragma unroll
            for (int i = 0; i < 4; ++i) { if (!((t >> i) & 1)) lo |= 0xFEu << (8 * i); if (!((t >> (4 + i)) & 1)) hi |= 0xFEu << (8 * i); }
            u32x2 v; v.x = lo; v.y = hi; ((LAS u32x2*)(lds + ATT_MTBL))[t] = v; }
        __syncthreads();
    }
    for (int p = bid; p < 512; p += nblk) {
        const int bh = (p & 7) + 8 * (p >> 8), j = (p >> 3) & 31;
#pragma unroll 1
        for (int i = 0; i < 2; ++i) attn_item3<DQK, MASKED, true>(lds, a, bh >> 3, bh & 7, i ? j : 63 - j);
    }
}

#ifdef IDX_PROBE_FINAL
#define IDX_PF_ 1
#else
#define IDX_PF_ 0
#endif
typedef _Float16 f16x8 __attribute__((ext_vector_type(8)));
struct IdxArgs { const float* QI; const unsigned short* KI16; const float* WI; unsigned long long* MT; };
static constexpr int IDX_CAP = 640, IDX_CS = 0, IDX_CI = 32 * IDX_CAP * 4, IDX_KT = IDX_CI + 32 * IDX_CAP * 2, IDX_CNT = IDX_KT + 32768, IDX_TAU = IDX_CNT + 128, IDX_LDS = IDX_TAU + 128;
static_assert(IDX_KT % 1024 == 0, "K tile buffers must be 1 KiB aligned");

__device__ __forceinline__ float ord_inv(unsigned T) { return __uint_as_float((T & 0x80000000u) ? (T & 0x7FFFFFFFu) : ~T); }
__device__ __forceinline__ unsigned lane_prefix(unsigned long long m) { return __builtin_amdgcn_mbcnt_hi((unsigned)(m >> 32), __builtin_amdgcn_mbcnt_lo((unsigned)m, 0u)); }
__device__ __forceinline__ float relu_asm(float x) { float y; asm("v_max_f32 %0, 0, %1" : "=v"(y) : "v"(x)); return y; }
__device__ __forceinline__ void glds16(const void* gsrc, unsigned lds_dst) {
    unsigned keep;
    asm volatile("s_mov_b32 %0, m0\n\ts_mov_b32 m0, %2\n\ts_nop 0\n\tglobal_load_lds_dwordx4 %1, off\n\ts_mov_b32 m0, %0" : "=&s"(keep) : "v"(gsrc), "s"(lds_dst) : "memory");
}

template <bool EXACT> __device__ __forceinline__ int idx_compact(LAS unsigned char* lds, int qq, int lane, int n, float& tau) {
    LAS float* cs = (LAS float*)(lds + IDX_CS) + qq * IDX_CAP; LAS unsigned short* ci = (LAS unsigned short*)(lds + IDX_CI) + qq * IDX_CAP;
    float sv[10]; unsigned short iv[10]; unsigned uk[10];
#pragma unroll
    for (int j = 0; j < 10; ++j) { const int idx = lane + 64 * j; const bool valid = idx < n; sv[j] = cs[idx]; iv[j] = ci[idx]; uk[j] = valid ? ord_key(sv[j]) : 0u; }
    auto count_ge = [&](unsigned t) { int c = 0;
#pragma unroll
        for (int j = 0; j < 10; ++j) c += __builtin_popcountll(__ballot(uk[j] >= t));
        return c; };
    unsigned lo = ord_key(tau), hi = 0xFF800001u;
    if (lo > 0x80800000u) { const unsigned h2 = lo + 0x00800000u;
        if (h2 < hi) { if (count_ge(h2) >= 256) lo = h2; else hi = h2; } }
    while (hi - lo > 1u) {
        const unsigned mid = lo + ((hi - lo) >> 1); const int c = count_ge(mid);
        if (c >= 256) { lo = mid; if (!EXACT && c <= 336) break; } else hi = mid;
    }
    const unsigned T = lo;
    int need = 0;
    if (EXACT) { int ngt = 0;
#pragma unroll
        for (int j = 0; j < 10; ++j) ngt += __builtin_popcountll(__ballot(uk[j] > T));
        need = 256 - ngt; }
    int base = 0, tiebase = 0;
#pragma unroll
    for (int j = 0; j < 10; ++j) {
        bool keep;
        if (EXACT) { const bool gt = uk[j] > T, eq = uk[j] == T; const unsigned long long em = __ballot(eq); keep = gt || (eq && (tiebase + (int)lane_prefix(em)) < need); tiebase += __builtin_popcountll(em); }
        else keep = uk[j] >= T;
        const unsigned long long km = __ballot(keep);
        const int pos = base + (int)lane_prefix(km);
        if (keep) { cs[pos] = sv[j]; ci[pos] = iv[j]; }
        base += __builtin_popcountll(km);
    }
    tau = ord_inv(T);
    return base;
}

__device__ __forceinline__ void idx_item(LAS unsigned char* lds, const IdxArgs& a, int b, int hc) {
    const int tid = opaque_tid(), lane = tid & 63, w = __builtin_amdgcn_readfirstlane(tid >> 6), n = lane & 31, hf = lane >> 5;
    const int t0 = hc * 32, L = (t0 / 64 + 1) * 64, nsub = L / 32, ntile = (L + 127) / 128;
    const size_t q0 = (size_t)b * SEQ + t0 + 4 * w;
    LAS float* cs = (LAS float*)(lds + IDX_CS); LAS unsigned short* ci = (LAS unsigned short*)(lds + IDX_CI);
    LAS unsigned* cnt = (LAS unsigned*)(lds + IDX_CNT);
    f16x8 qf[2][4];
#pragma unroll
    for (int rt = 0; rt < 2; ++rt) { const float* qp = a.QI + (q0 + 2 * rt + (n >> 4)) * 1024 + (n & 15) * 64 + hf * 8;
#pragma unroll
        for (int ks = 0; ks < 4; ++ks) { const f32x4 x0 = *(const f32x4*)(qp + ks * 16), x1 = *(const f32x4*)(qp + ks * 16 + 4);
            f16x8 v; v[0] = (_Float16)x0[0]; v[1] = (_Float16)x0[1]; v[2] = (_Float16)x0[2]; v[3] = (_Float16)x0[3]; v[4] = (_Float16)x1[0]; v[5] = (_Float16)x1[1]; v[6] = (_Float16)x1[2]; v[7] = (_Float16)x1[3];
            qf[rt][ks] = v; } }
    float wv[2][16];
#pragma unroll
    for (int rt = 0; rt < 2; ++rt)
#pragma unroll
        for (int r = 0; r < 16; ++r) wv[rt][r] = a.WI[(q0 + 2 * rt + (r >> 3)) * 16 + (((r & 3) + 8 * (r >> 2) + 4 * hf) & 15)] * (0.125f * 0.25f);
    if (tid < 32) cnt[tid] = 0u;
    int cq0 = 0, cq1 = 0, cq2 = 0, cq3 = 0;
    float tq0 = -INFINITY, tq1 = -INFINITY, tq2 = -INFINITY, tq3 = -INFINITY;
    float tau0 = INFINITY, tau1 = INFINITY;
    const unsigned short* Kg = a.KI16 + (size_t)b * SEQ * 64;
    const unsigned ldsbase = (unsigned)(size_t)lds;
    auto dma = [&](int kt, int buf) {
#pragma unroll
        for (int i = 0; i < 2; ++i) { const int s = (w + 8 * i) * 64 + lane, r = s >> 3, cp = s & 7, cc = cp ^ ((r >> 1) & 7);
            glds16(Kg + (size_t)(kt * 128 + r) * 64 + cc * 8, ldsbase + IDX_KT + buf * 16384 + (w + 8 * i) * 1024); }
    };
    dma(0, 0);
    asm volatile("s_waitcnt vmcnt(0)" ::: "memory");
    __syncthreads();
    const int kswz = (n >> 1) & 7;
    f32x16 accA[2], accB[2];
#pragma unroll
    for (int rt = 0; rt < 2; ++rt)
#pragma unroll
        for (int r = 0; r < 16; ++r) { accA[rt][r] = 0.f; accB[rt][r] = 0.f; }
    int keyA = 0, keyB = 0;
    auto epilogue = [&](const f32x16 (&acc)[2], int key) {
        float sc[2];
#pragma unroll
        for (int rt = 0; rt < 2; ++rt) { float pa = 0.f, pb = 0.f;
#pragma unroll
            for (int r = 0; r < 8; ++r) { pa = fmaf(relu_asm(acc[rt][r]), wv[rt][r], pa); pb = fmaf(relu_asm(acc[rt][r + 8]), wv[rt][r + 8], pb); }
            const auto rr = __builtin_amdgcn_permlane32_swap(__float_as_uint(pa), __float_as_uint(pb), false, false);
            sc[rt] = __uint_as_float(rr[0]) + __uint_as_float(rr[1]); }
        const bool c0 = sc[0] > tau0, c1 = sc[1] > tau1;
        const unsigned long long m0 = __ballot(c0), m1 = __ballot(c1);
        if (m0 | m1) {
            const unsigned l0 = (unsigned)m0, h0 = (unsigned)(m0 >> 32), l1 = (unsigned)m1, h1 = (unsigned)(m1 >> 32);
            const int p0 = hf ? cq1 + (int)__builtin_amdgcn_mbcnt_hi(h0, 0u) : cq0 + (int)__builtin_amdgcn_mbcnt_lo(l0, 0u);
            const int p1 = hf ? cq3 + (int)__builtin_amdgcn_mbcnt_hi(h1, 0u) : cq2 + (int)__builtin_amdgcn_mbcnt_lo(l1, 0u);
            if (c0 && p0 < IDX_CAP) { const int qq = 4 * w + hf; cs[qq * IDX_CAP + p0] = sc[0]; ci[qq * IDX_CAP + p0] = (unsigned short)key; }
            if (c1 && p1 < IDX_CAP) { const int qq = 4 * w + 2 + hf; cs[qq * IDX_CAP + p1] = sc[1]; ci[qq * IDX_CAP + p1] = (unsigned short)key; }
            cq0 += __builtin_popcount(l0); cq1 += __builtin_popcount(h0); cq2 += __builtin_popcount(l1); cq3 += __builtin_popcount(h1);
        }
    };
    f16x8 kfA[4], kfB[4];
    auto ldk = [&](f16x8 (&kf)[4], const LAS unsigned char* kr) {
#pragma unroll
        for (int ks = 0; ks < 4; ++ks) kf[ks] = *(const LAS f16x8*)(kr + ((2 * ks + hf) ^ kswz) * 16);
    };
    auto mma = [&](f32x16 (&acc)[2], const f16x8 (&kf)[4]) {
#pragma unroll
        for (int rt = 0; rt < 2; ++rt) {
            f32x16 c;
#pragma unroll
            for (int r = 0; r < 16; ++r) c[r] = 0.f;
#pragma unroll
            for (int ks = 0; ks < 4; ++ks) c = __builtin_amdgcn_mfma_f32_32x32x16_f16(qf[rt][ks], kf[ks], c, 0, 0, 0);
            acc[rt] = c; }
    };
#ifdef IDX_PROBE2
  for (int rep_ = 0; rep_ < 2; ++rep_) {
    if (rep_ == 1) { epilogue(accB, keyB); tau0 = INFINITY; tau1 = INFINITY; __syncthreads(); dma(0, 0); asm volatile("s_waitcnt vmcnt(0)" ::: "memory"); __syncthreads(); }
#endif
    for (int kt = 0; kt < ntile; ++kt) {
        if (kt + 1 < ntile) dma(kt + 1, (kt + 1) & 1);
#ifdef IDX_PROBE2
        if (rep_ == 0)
#endif
        { const unsigned c_all = cnt[lane & 31];
          if (__ballot(c_all > (unsigned)(IDX_CAP - 160))) {
              if (cq0 > 400) cq0 = idx_compact<false>(lds, 4 * w + 0, lane, cq0, tq0);
              if (cq1 > 400) cq1 = idx_compact<false>(lds, 4 * w + 1, lane, cq1, tq1);
              if (cq2 > 400) cq2 = idx_compact<false>(lds, 4 * w + 2, lane, cq2, tq2);
              if (cq3 > 400) cq3 = idx_compact<false>(lds, 4 * w + 3, lane, cq3, tq3);
              if (kt > 0) { tau0 = hf ? tq1 : tq0; tau1 = hf ? tq3 : tq2; }
          } }
        const LAS unsigned char* kb = lds + IDX_KT + (kt & 1) * 16384 + n * 128;
        const int sbase = kt * 4;
#ifdef IDX_PROBE2
        if (sbase + 0 < nsub) { ldk(kfA, kb); if (sbase + 1 < nsub) ldk(kfB, kb + 32 * 128); mma(accA, kfA); epilogue(accB, keyB); keyA = kt * 128 + n; if (kt == 0 && rep_ == 0) { tau0 = -INFINITY; tau1 = -INFINITY; } }
#else
        if (sbase + 0 < nsub) { ldk(kfA, kb); if (sbase + 1 < nsub) ldk(kfB, kb + 32 * 128); mma(accA, kfA); epilogue(accB, keyB); keyA = kt * 128 + n; if (kt == 0) { tau0 = -INFINITY; tau1 = -INFINITY; } }
#endif
        if (sbase + 1 < nsub) { if (sbase + 2 < nsub) ldk(kfA, kb + 64 * 128); mma(accB, kfB); epilogue(accA, keyA); keyB = kt * 128 + 32 + n; }
        if (sbase + 2 < nsub) { if (sbase + 3 < nsub) ldk(kfB, kb + 96 * 128); mma(accA, kfA); epilogue(accB, keyB); keyA = kt * 128 + 64 + n; }
        if (sbase + 3 < nsub) { mma(accB, kfB); epilogue(accA, keyA); keyB = kt * 128 + 96 + n; }
        if (lane < 4) cnt[4 * w + lane] = (unsigned)(lane == 0 ? cq0 : (lane == 1 ? cq1 : (lane == 2 ? cq2 : cq3)));
        asm volatile("s_waitcnt vmcnt(0)" ::: "memory");
        __syncthreads();
    }
#ifdef IDX_PROBE2
  }
#endif
    epilogue(accB, keyB);
    __syncthreads();
    LAS unsigned* bm = (LAS unsigned*)(lds + IDX_KT) + w * 512;
#ifdef IDX_PROBE_FINAL
  for (int rep2_ = 0; rep2_ < 2; ++rep2_) {
#endif
    if (cq0 > 256 - IDX_PF_) cq0 = idx_compact<true>(lds, 4 * w + 0, lane, cq0, tq0);
    if (cq1 > 256 - IDX_PF_) cq1 = idx_compact<true>(lds, 4 * w + 1, lane, cq1, tq1);
    if (cq2 > 256 - IDX_PF_) cq2 = idx_compact<true>(lds, 4 * w + 2, lane, cq2, tq2);
    if (cq3 > 256 - IDX_PF_) cq3 = idx_compact<true>(lds, 4 * w + 3, lane, cq3, tq3);
#pragma unroll 1
    for (int i = 0; i < 4; ++i) {
        const int qq = 4 * w + i;
        const int nsel = (i == 0) ? cq0 : ((i == 1) ? cq1 : ((i == 2) ? cq2 : cq3));
#pragma unroll
        for (int j = 0; j < 8; ++j) bm[lane + 64 * j] = 0u;
#pragma unroll
        for (int j = 0; j < 4; ++j) { const int idx = lane + 64 * j; if (idx < nsel) { const unsigned k = ci[qq * IDX_CAP + idx]; (void)__hip_atomic_fetch_or(bm + (k >> 5), 1u << (k & 31), __ATOMIC_RELAXED, __HIP_MEMORY_SCOPE_WORKGROUP); } }
        const int tq = t0 + qq;
#pragma unroll 1
        for (int kt = lane; kt < L / 64; kt += 64) { const unsigned long long v = (unsigned long long)bm[2 * kt] | ((unsigned long long)bm[2 * kt + 1] << 32); a.MT[((size_t)b * 256 + kt) * SEQ + tq] = v; }
    }
#ifdef IDX_PROBE_FINAL
  }
#endif
    __syncthreads();
}
__device__ __forceinline__ void idx_phase(LAS unsigned char* lds, const IdxArgs& a, int bid, int nblk) {
    for (int k = bid; k < 256; k += nblk) {
#pragma unroll 1
        for (int i = 0; i < 4; ++i) idx_item(lds, a, i & 1, (i < 2) ? 511 - k : k);
    }
}
#define XB_TMO      128
#define XB_XCNT(j)  (256  + 64 * (j))
#define XB_XSUB(j)  (1280 + 64 * (j))
#define XB_XGEN(j)  (2304 + 64 * (j))
#define XB_TOP      3328
#define XB_TOPGEN   3392
#define XCD_BAR_WORDS 3456
#define XB_SPIN_CAP (1u << 23)


__device__ __forceinline__ unsigned xb_ld(unsigned* p)              { return __hip_atomic_load(p, __ATOMIC_RELAXED, __HIP_MEMORY_SCOPE_AGENT); }
__device__ __forceinline__ unsigned xb_add(unsigned* p, unsigned v) { return __hip_atomic_fetch_add(p, v, __ATOMIC_RELAXED, __HIP_MEMORY_SCOPE_AGENT); }
__device__ __forceinline__ unsigned xb_xcc_id() { return (unsigned)__builtin_amdgcn_s_getreg((3 << 11) | 20) & 0xFu; }
#define XB_SPIN(cond, bar) do { unsigned _sp = 0; while (cond) { __builtin_amdgcn_s_sleep(1); \
    if ((++_sp & 255u) == 0u) { if (xb_ld(&(bar)[XB_TMO])) break; if (_sp > XB_SPIN_CAP) { atomicAdd(&(bar)[XB_TMO], 1u); break; } } } } while (0)

struct XcdBarrier {
    unsigned* bar; unsigned x;
    volatile LAS unsigned* st;
};

__device__ __forceinline__ XcdBarrier xcd_barrier_post(unsigned* bar, volatile LAS unsigned* st) {
    XcdBarrier b; b.bar = bar; b.x = xb_xcc_id(); b.st = st;
    if (threadIdx.x == 0) (void)xb_add(&bar[XB_XCNT(b.x)], 1u);
    return b;
}
__device__ __forceinline__ void xcd_barrier_complete(unsigned* bar, unsigned x, unsigned& nloc, unsigned& nx) {
    const unsigned G = gridDim.x * gridDim.y * gridDim.z;
    unsigned sum, cnt, mine, sp = 0u;
    for (;;) {
        sum = 0u; cnt = 0u; mine = 0u;
#pragma unroll
        for (unsigned j = 0; j < 16; ++j) { const unsigned c = xb_ld(&bar[XB_XCNT(j)]); sum += c; cnt += (c > 0u) ? 1u : 0u; mine = (j == x) ? c : mine; }
        if (sum == G) break;
        __builtin_amdgcn_s_sleep(1);
        if ((++sp & 255u) == 0u) { if (xb_ld(&bar[XB_TMO])) break; if (sp > XB_SPIN_CAP) { atomicAdd(&bar[XB_TMO], 1u); break; } }
    }
    nloc = mine > 0u ? mine : 1u; nx = cnt > 0u ? cnt : 1u;
}

__device__ __forceinline__ void xcd_barrier(const XcdBarrier& b) {
    asm volatile("s_waitcnt vmcnt(0)" ::: "memory");
    __syncthreads();
    if (threadIdx.x == 0) {
        unsigned* bar = b.bar;
        __builtin_amdgcn_s_waitcnt(0);
        unsigned nloc = b.st[0], nx = b.st[1];
        if (nloc == 0u) { xcd_barrier_complete(bar, b.x, nloc, nx); b.st[0] = nloc; b.st[1] = nx; }
        const unsigned old = xb_add(&bar[XB_XSUB(b.x)], 1u);
        const unsigned gen = old / nloc;
        if (old + 1u == (gen + 1u) * nloc) {
            __builtin_amdgcn_fence(__ATOMIC_RELEASE, "agent");
            asm volatile("s_waitcnt vmcnt(0)" ::: "memory");
            const unsigned og = xb_add(&bar[XB_TOP], 1u);
            const unsigned tg = og / nx;
            if (og + 1u == (tg + 1u) * nx) xb_add(&bar[XB_TOPGEN], 1u);
            else XB_SPIN(xb_ld(&bar[XB_TOPGEN]) == tg, bar);
            __builtin_amdgcn_fence(__ATOMIC_ACQUIRE, "agent");
            xb_add(&bar[XB_XGEN(b.x)], 1u);
            asm volatile("s_waitcnt vmcnt(0)" ::: "memory");
        } else {
            XB_SPIN(xb_ld(&bar[XB_XGEN(b.x)]) == gen, bar);
            __builtin_amdgcn_fence(__ATOMIC_ACQUIRE, "agent");
            asm volatile("s_waitcnt vmcnt(0)" ::: "memory");
        }
    }
    __syncthreads();
}

#ifndef FP8_QKV
#define FP8_QKV 1
#endif
#ifndef FP8_UP0
#define FP8_UP0 0
#endif
#ifndef FP8_UP1
#define FP8_UP1 1
#endif
#ifndef FP8_DN0
#define FP8_DN0 0
#endif
#ifndef FP8_DN1
#define FP8_DN1 1
#endif
#ifndef SKIPMASK
#define SKIPMASK 0
#endif

__device__ __forceinline__ int perm16(int t) { const int a = (t >> 2) & 3; return (t & ~12) | ((a == 1 ? 2 : (a == 2 ? 1 : a)) << 2); }
__device__ __forceinline__ void st_vt16(bf16_t* VT, int row, int h, int d, f32x4 v) {
    const int b = row / SEQ, t = row % SEQ; bf16_t* p = VT + ((size_t)(b * 8 + h) * 128 + d) * SEQ + (t & ~15) + perm16(t & 15);
    p[0] = f2bf(v[0]); p[SEQ] = f2bf(v[1]); p[2 * (size_t)SEQ] = f2bf(v[2]); p[3 * (size_t)SEQ] = f2bf(v[3]);
}
__device__ __forceinline__ int perm64(int kk) { const int sub = kk >> 5, k5 = kk & 31; return 32 * ((k5 >> 2) & 1) + 16 * sub + (((k5 >> 3) << 2) | (k5 & 3)); }
__device__ __forceinline__ void st_vt8(bf16_t* VT_, int row, int h, int d, f32x4 v) {
    const int b = row / SEQ, t = row % SEQ; unsigned char* p = (unsigned char*)VT_ + ((size_t)(b * 8 + h) * 128 + d) * SEQ + (t & ~63) + perm64(t & 63);
    const int pk0 = __builtin_amdgcn_cvt_pk_fp8_f32(v[0], v[1], 0, false), pk1 = __builtin_amdgcn_cvt_pk_fp8_f32(v[2], v[3], 0, false);
    p[0] = (unsigned char)(pk0 & 0xFF); p[SEQ] = (unsigned char)((pk0 >> 8) & 0xFF); p[2 * (size_t)SEQ] = (unsigned char)(pk1 & 0xFF); p[3 * (size_t)SEQ] = (unsigned char)((pk1 >> 8) & 0xFF);
}
__device__ __forceinline__ void st_fp8x4(unsigned char* p, f32x4 v) { int pk = 0; pk = __builtin_amdgcn_cvt_pk_fp8_f32(v[0], v[1], pk, false); pk = __builtin_amdgcn_cvt_pk_fp8_f32(v[2], v[3], pk, true); *(int*)p = pk; }
struct FAbIn2 { unsigned char *Q, *K; bf16_t* VT; float *QI, *U, *WI; unsigned short* KI16;
    __device__ __forceinline__ void operator()(int r, int c, f32x4 v) const {
        if (c < 1024) st_fp8x4(Q + (size_t)r * 1024 + c, v);
        else if (c < 2048) st_fp8x4(K + (size_t)r * 1024 + (c - 1024), v);
        else if (c < 3072) { if (PV8_DSA) st_vt8(VT, r, (c - 2048) >> 7, (c - 2048) & 127, v); else st_vt16(VT, r, (c - 2048) >> 7, (c - 2048) & 127, v); }
        else if (c < 4096) st_f32x4(QI + (size_t)r * 1024 + (c - 3072), v);
        else if (c < 5120) st_f32x4(U + (size_t)r * 1024 + (c - 4096), v);
        else if (c < 5184) { typedef _Float16 h2 __attribute__((ext_vector_type(2))); union { h2 h; unsigned u; } a, b; a.h = (h2){(_Float16)v[0], (_Float16)v[1]}; b.h = (h2){(_Float16)v[2], (_Float16)v[3]};
            u32x2 w; w.x = a.u; w.y = b.u; *(u32x2*)(KI16 + (size_t)r * 64 + (c - 5120)) = w; }
        else if (c < 5200) st_f32x4(WI + (size_t)r * 16 + (c - 5184), v);
    } };
struct FAbInHi { FAbIn2 f; __device__ __forceinline__ void operator()(int r, int c, f32x4 v) const { f(r, c + 3072, v); } };
struct FKvUp2 { unsigned char* K8; bf16_t* VT;
    __device__ __forceinline__ void operator()(int r, int c, f32x4 v) const {
        const int h = c >> 8, d = c & 255;
        if (d < 128) { int pk = 0; pk = __builtin_amdgcn_cvt_pk_fp8_f32(v[0], v[1], pk, false); pk = __builtin_amdgcn_cvt_pk_fp8_f32(v[2], v[3], pk, true); *(int*)(K8 + (size_t)r * 1536 + h * 192 + d) = pk; }
        else { if (PV8_MLA) st_vt8(VT, r, h, d - 128, v); else st_vt16(VT, r, h, d - 128, v); }
    } };

template <class E> __device__ __forceinline__ void ph_gemm_e(LAS unsigned char* lds, const bf16_t* A, int lda, const bf16_t* Bt, int ldb, int M, int N, int K, const E& e, int bid, int nblk, int a_shift = 0, int a_bytes = 0, int cmode = 0) {
    pg8::Gemm g; g.A = A; g.Bt = Bt; g.M = M; g.N = N; g.K = K; g.lda = lda; g.ldb = ldb; g.a_shift = a_shift; g.a_bytes = a_bytes; g.cmode = cmode;
    pg8::StaticOrder S; S.init(M, N, nblk, bid);
    pg8::gemm_phase<E, pg8::StaticOrder, false>(lds, g, S, e, nullptr);
    __syncthreads();
}
template <class F> __device__ __forceinline__ void ph_gemm(LAS unsigned char* lds, const bf16_t* A, int lda, const bf16_t* Bt, int ldb, int M, int N, int K, const F& f, int bid, int nblk, int a_shift = 0, int a_bytes = 0) {
    EpiG<F> e; e.f = f;
    ph_gemm_e(lds, A, lda, Bt, ldb, M, N, K, e, bid, nblk, a_shift, a_bytes);
}
template <class F> __device__ __forceinline__ void ph_gemm8(LAS unsigned char* lds, const unsigned char* A, int lda, const unsigned char* Bt, int ldb, int M, int N, int K, const F& f, int bid, int nblk) {
    EpiG<F, true> e; e.f = f;
    ph_gemm_e(lds, (const bf16_t*)A, lda / 2, (const bf16_t*)Bt, ldb / 2, M, N, K / 2, e, bid, nblk, 0, 0);
}
template <int CTRL> __device__ __forceinline__ float dpp0(float v) { return __int_as_float(__builtin_amdgcn_update_dpp(0, __float_as_int(v), CTRL, 0xF, 0xF, true)); }
__device__ __forceinline__ float gelu_fast(float x) { const float u2 = 1.5957691216057308f * (x + 0.044715f * x * x * x); return x * __builtin_amdgcn_rcpf(1.0f + __builtin_amdgcn_exp2f(-1.4426950408889634f * u2)); }
template <bool OUT8, bool F8> struct EpiGate {
    static constexpr bool PERM = false, AFTER_DRAIN = false, FP8 = F8;
    const float* cw; const float* cb; void* ACT;
    __device__ __forceinline__ void operator()(const f32x4 (&acc)[2][2][4][2], const pg8::Unit& u, int wr, int wc, int fr, int fq) const {
        const int bt = u.pm / 67, ti = u.pm % 67;
#pragma unroll
        for (int n = 0; n < 2; ++n) {
            const int c = u.pn * 128 + wc * 32 + 16 * n + 4 * fq;
            const f32x4 g0 = *(const f32x4*)(cw + c), g1 = *(const f32x4*)(cw + 8192 + c), g2 = *(const f32x4*)(cw + 16384 + c), gb = *(const f32x4*)(cb + c);
            const f32x4 v0 = *(const f32x4*)(cw + 4096 + c), v1 = *(const f32x4*)(cw + 8192 + 4096 + c), v2 = *(const f32x4*)(cw + 16384 + 4096 + c), vb = *(const f32x4*)(cb + 4096 + c);
            const float w1m = (fr < 1) ? 1.f : 0.f, w2m = (fr < 2) ? 1.f : 0.f;
            const f32x4 g1w = g1 * w1m, g0w = g0 * w2m, v1w = v1 * w1m, v0w = v0 * w2m;
#pragma unroll
            for (int ai = 0; ai < 2; ++ai) {
                const int strip = 2 * ai + wr, tbase = ti * 248 + strip * 62 - 2;
                f32x4 pg = {0.f, 0.f, 0.f, 0.f}, pv = pg;
#pragma unroll
                for (int m = 0; m < 4; ++m) {
                    f32x4 xg = acc[ai][0][m][n], xv = acc[ai][1][m][n];
                    const int t = tbase + 16 * m + fr;
                    if (tbase < 0 && m == 0) { if (t < 0) { xg = (f32x4){0.f, 0.f, 0.f, 0.f}; xv = xg; } }
                    f32x4 og, ov;
#pragma unroll
                    for (int j = 0; j < 4; ++j) {
                        float yg = fmaf(g2[j], xg[j], gb[j]), yv = fmaf(v2[j], xv[j], vb[j]);
                        asm("s_nop 1\n\t"
                            "v_fmac_f32_dpp %0, %2, %6 row_shr:1 row_mask:0xf bank_mask:0xf bound_ctrl:1\n\t"
                            "v_fmac_f32_dpp %1, %3, %10 row_shr:1 row_mask:0xf bank_mask:0xf bound_ctrl:1\n\t"
                            "v_fmac_f32_dpp %0, %2, %7 row_shr:2 row_mask:0xf bank_mask:0xf bound_ctrl:1\n\t"
                            "v_fmac_f32_dpp %1, %3, %11 row_shr:2 row_mask:0xf bank_mask:0xf bound_ctrl:1\n\t"
                            "v_fmac_f32_dpp %0, %4, %8 row_ror:1 row_mask:0xf bank_mask:0xf bound_ctrl:1\n\t"
                            "v_fmac_f32_dpp %1, %5, %12 row_ror:1 row_mask:0xf bank_mask:0xf bound_ctrl:1\n\t"
                            "v_fmac_f32_dpp %0, %4, %9 row_ror:2 row_mask:0xf bank_mask:0xf bound_ctrl:1\n\t"
                            "v_fmac_f32_dpp %1, %5, %13 row_ror:2 row_mask:0xf bank_mask:0xf bound_ctrl:1"
                            : "+v"(yg), "+v"(yv)
                            : "v"(xg[j]), "v"(xv[j]), "v"(pg[j]), "v"(pv[j]), "v"(g1[j]), "v"(g0[j]), "v"(g1w[j]), "v"(g0w[j]), "v"(v1[j]), "v"(v0[j]), "v"(v1w[j]), "v"(v0w[j]));
                        og[j] = gelu_fast(yg) * yv; ov[j] = 0.f;
                    }
                    pg = xg; pv = xv;
                    if (16 * m + fr >= 2 && t < SEQ) {
                        const size_t o = ((size_t)bt * SEQ + t) * 4096 + c;
                        if (OUT8) { int pk = 0; pk = __builtin_amdgcn_cvt_pk_fp8_f32(og[0], og[1], pk, false); pk = __builtin_amdgcn_cvt_pk_fp8_f32(og[2], og[3], pk, true); *(int*)((unsigned char*)ACT + o) = pk; }
                        else st_bf16x4((bf16_t*)ACT + o, og);
                    }
                }
            }
        }
    }
};
struct FPool { bf16_t* CC; const float* pb; const float* ps;
    __device__ __forceinline__ void operator()(int r, int c, f32x4 v) const { const f32x4 b = *(const f32x4*)(pb + c), s = *(const f32x4*)(ps + c); st_bf16x4(CC + (size_t)r * 2048 + 1024 + c, (v + b) * s); } };
struct EpiLru {
    static constexpr bool PERM = false, AFTER_DRAIN = false, FP8 = false;
    const bf16_t* XCB; const float *ba, *bx, *lam; bf16_t *LA, *LB;
    __device__ __forceinline__ void operator()(const f32x4 (&acc)[2][2][4][2], const pg8::Unit& u, int wr, int wc, int fr, int fq) const {
        const int row0 = u.pm * 256 + wr * 64 + fr;
#pragma unroll
        for (int n = 0; n < 2; ++n) {
            const int ch = u.pn * 128 + wc * 32 + 16 * n + 4 * fq;
            const f32x4 bav = *(const f32x4*)(ba + ch), bxv = *(const f32x4*)(bx + ch), lm = *(const f32x4*)(lam + ch);
            f32x4 sp;
#pragma unroll
            for (int j = 0; j < 4; ++j) sp[j] = log1pf(__expf(-lm[j]));
#pragma unroll
            for (int ai = 0; ai < 2; ++ai)
#pragma unroll
                for (int m = 0; m < 4; ++m) {
                    const int row = row0 + ai * 128 + m * 16;
                    const u32x2 xw = *(const u32x2*)(XCB + (size_t)row * 1024 + ch);
                    const f32x4 xc = {__uint_as_float(xw.x << 16), __uint_as_float(xw.x & 0xFFFF0000u), __uint_as_float(xw.y << 16), __uint_as_float(xw.y & 0xFFFF0000u)};
                    const f32x4 ga = acc[ai][0][m][n] + bav, gx = acc[ai][1][m][n] + bxv;
                    f32x4 av, bv;
#pragma unroll
                    for (int j = 0; j < 4; ++j) {
                        const float rg = 1.0f / (1.0f + __expf(-ga[j])), ig = 1.0f / (1.0f + __expf(-gx[j]));
                        const float log_a = -8.0f * rg * sp[j], a = __expf(log_a), mult = sqrtf(-expm1f(2.0f * log_a));
                        av[j] = -expm1f(log_a); bv[j] = mult * (ig * xc[j]); (void)a;
                    }
                    st_bf16x4(LA + (size_t)row * 1024 + ch, av); st_bf16x4(LB + (size_t)row * 1024 + ch, bv);
                }
        }
    }
};
__device__ __forceinline__ void ph_pooled(const float* __restrict__ U, bf16_t* __restrict__ P, int bid, int nblk) {
    for (int i = bid * 512 + opaque_tid(); i < 256 * (NTOK / 64); i += nblk * 512) {
        const int c4 = i & 255, row0 = (i >> 8) * 64, t0 = row0 % SEQ, g = c4 >> 6, win = 2 << g;
        const f32x4* up = (const f32x4*)U + (size_t)row0 * 256 + c4;
        f32x4 s = {0.f, 0.f, 0.f, 0.f};
        if (t0 > 0) { for (int k = 1; k < win; ++k) s += up[-(ptrdiff_t)k * 256]; }
#pragma unroll 8
        for (int r = 0; r < 64; ++r) {
            const int t = t0 + r; const f32x4 u0 = up[(ptrdiff_t)r * 256];
            s += u0;
            const int cnt = (t + 1 < win) ? (t + 1) : win;
            st_bf16x4(P + (size_t)(row0 + r) * 1024 + c4 * 4, s * (1.0f / (float)cnt) - u0);
            if (t + 1 >= win) s -= up[(ptrdiff_t)(r + 1 - win) * 256];
        }
    }
}
__device__ __forceinline__ void ph_xc(const bf16_t* __restrict__ XL, const float* __restrict__ cw, const float* __restrict__ cb, bf16_t* __restrict__ XCB, int bid, int nblk) {
    for (int i = bid * 512 + opaque_tid(); i < 128 * (NTOK / 32); i += nblk * 512) {
        const int c8 = (i & 127) * 8, row0 = (i >> 7) * 32, t0 = row0 % SEQ;
        float w0[8], w1[8], w2[8], w3[8], bb[8];
#pragma unroll
        for (int j = 0; j < 8; ++j) { w0[j] = cw[c8 + j]; w1[j] = cw[1024 + c8 + j]; w2[j] = cw[2048 + c8 + j]; w3[j] = cw[3072 + c8 + j]; bb[j] = cb[c8 + j]; }
        u32x4 p3 = {0u, 0u, 0u, 0u}, p2 = p3, p1 = p3;
        if (t0 >= 3) { p3 = *(const u32x4*)(XL + (size_t)(row0 - 3) * 1024 + c8); p2 = *(const u32x4*)(XL + (size_t)(row0 - 2) * 1024 + c8); p1 = *(const u32x4*)(XL + (size_t)(row0 - 1) * 1024 + c8); }
#pragma unroll 8
        for (int r = 0; r < 32; ++r) {
            const u32x4 cur = *(const u32x4*)(XL + (size_t)(row0 + r) * 1024 + c8);
            const unsigned a3[4] = {p3.x, p3.y, p3.z, p3.w}, a2[4] = {p2.x, p2.y, p2.z, p2.w}, a1[4] = {p1.x, p1.y, p1.z, p1.w}, a0[4] = {cur.x, cur.y, cur.z, cur.w};
            float y[8];
#pragma unroll
            for (int j = 0; j < 4; ++j) {
                y[2 * j] = bb[2 * j] + w0[2 * j] * __uint_as_float(a3[j] << 16) + w1[2 * j] * __uint_as_float(a2[j] << 16) + w2[2 * j] * __uint_as_float(a1[j] << 16) + w3[2 * j] * __uint_as_float(a0[j] << 16);
                y[2 * j + 1] = bb[2 * j + 1] + w0[2 * j + 1] * __uint_as_float(a3[j] & 0xFFFF0000u) + w1[2 * j + 1] * __uint_as_float(a2[j] & 0xFFFF0000u) + w2[2 * j + 1] * __uint_as_float(a1[j] & 0xFFFF0000u) + w3[2 * j + 1] * __uint_as_float(a0[j] & 0xFFFF0000u); }
            u32x4 o; o.x = pack2bf(y[0], y[1]); o.y = pack2bf(y[2], y[3]); o.z = pack2bf(y[4], y[5]); o.w = pack2bf(y[6], y[7]);
            *(u32x4*)(XCB + (size_t)(row0 + r) * 1024 + c8) = o;
            p3 = p2; p2 = p1; p1 = cur;
        }
    }
}
__device__ __forceinline__ int up_src_col(int n0) { return ((n0 >> 7) & 1) * 4096 + (n0 >> 8) * 128 + (n0 & 127); }
template <bool OUT8>
__device__ __forceinline__ void ph_convT_g(LAS unsigned char* lds, const float* __restrict__ W, int ldw, int src_col0, int ncols, int K, void* __restrict__ Bt, int ldd, int bid, int nblk, bool upperm) {
    const int tid = opaque_tid(), sub = tid >> 8, t8 = tid & 255;
    LAS float* tile = (LAS float*)lds + sub * (64 * 65);
    const int ntx = (ncols + 63) / 64, ntiles = ntx * (K / 64);
    for (int base = bid * 2; base < ntiles; base += nblk * 2) {
        const int tl = base + sub; const bool act = tl < ntiles;
        const int n0 = (tl % ntx) * 64, k0 = (tl / ntx) * 64;
        if (act) {
            const int c4 = (t8 & 15) * 4, kr = t8 >> 4;
            const int nsrc = src_col0 + (upperm ? up_src_col(n0 + c4) : n0 + c4);
#pragma unroll
            for (int i = 0; i < 4; ++i) { const int kl = kr + 16 * i;
                f32x4 v = {0.f, 0.f, 0.f, 0.f};
                if (n0 + c4 < ncols) v = *(const f32x4*)(W + (size_t)(k0 + kl) * ldw + nsrc);
                tile[kl * 65 + c4] = v[0]; tile[kl * 65 + c4 + 1] = v[1]; tile[kl * 65 + c4 + 2] = v[2]; tile[kl * 65 + c4 + 3] = v[3]; } }
        __syncthreads();
        if (act) {
            const int k8 = (t8 & 7) * 8, nr = t8 >> 3;
#pragma unroll
            for (int i = 0; i < 2; ++i) { const int nl = nr + 32 * i;
                if (n0 + nl < ncols) {
                    float v[8];
#pragma unroll
                    for (int j = 0; j < 8; ++j) v[j] = tile[(k8 + j) * 65 + nl];
                    if (OUT8) { int p0 = 0, p1 = 0;
                        p0 = __builtin_amdgcn_cvt_pk_fp8_f32(64.f * v[0], 64.f * v[1], p0, false); p0 = __builtin_amdgcn_cvt_pk_fp8_f32(64.f * v[2], 64.f * v[3], p0, true);
                        p1 = __builtin_amdgcn_cvt_pk_fp8_f32(64.f * v[4], 64.f * v[5], p1, false); p1 = __builtin_amdgcn_cvt_pk_fp8_f32(64.f * v[6], 64.f * v[7], p1, true);
                        u32x2 o; o.x = (unsigned)p0; o.y = (unsigned)p1; *(u32x2*)((unsigned char*)Bt + (size_t)(n0 + nl) * ldd + k0 + k8) = o; }
                    else { u32x4 o; o.x = pack2bf(v[0], v[1]); o.y = pack2bf(v[2], v[3]); o.z = pack2bf(v[4], v[5]); o.w = pack2bf(v[6], v[7]);
                        *(u32x4*)((bf16_t*)Bt + (size_t)(n0 + nl) * ldd + k0 + k8) = o; }
                } } }
        __syncthreads();
    }
}
__device__ __forceinline__ void ph_convT(LAS unsigned char* lds, const float* __restrict__ W, int ldw, int src_col0, int ncols, int K, bf16_t* __restrict__ Bt, int ldd, int bid, int nblk, bool upperm = false) {
    ph_convT_g<false>(lds, W, ldw, src_col0, ncols, K, Bt, ldd, bid, nblk, upperm);
}
__device__ __forceinline__ void ph_convT8(LAS unsigned char* lds, const float* __restrict__ W, int ldw, int ncols, int K, unsigned char* __restrict__ Bt, int bid, int nblk, bool upperm = false) {
    ph_convT_g<true>(lds, W, ldw, 0, ncols, K, Bt, K, bid, nblk, upperm);
}
template <int NC> __device__ __forceinline__ void ph_rmsnorm(const float* __restrict__ x, const float* __restrict__ g, bf16_t* __restrict__ out, int bid, int nblk, unsigned char* __restrict__ out8 = nullptr) {
    const int lane = opaque_tid() & 63, w = opaque_tid() >> 6;
    constexpr int NV = NC / 256;
    for (int row = bid * 8 + w; row < NTOK; row += nblk * 8) {
        const f32x4* xr = (const f32x4*)(x + (size_t)row * NC);
        f32x4 v[NV]; float ss = 0.f;
#pragma unroll
        for (int i = 0; i < NV; ++i) { v[i] = xr[lane + 64 * i]; ss += v[i][0] * v[i][0] + v[i][1] * v[i][1] + v[i][2] * v[i][2] + v[i][3] * v[i][3]; }
        ss = wave_sum(ss);
        const float r = rsqrtf(ss * (1.0f / NC) + NORM_EPS);
#pragma unroll
        for (int i = 0; i < NV; ++i) { const f32x4 gg = ((const f32x4*)g)[lane + 64 * i]; const f32x4 y = v[i] * r * gg; st_bf16x4(out + (size_t)row * NC + 4 * (lane + 64 * i), y);
            if (out8) { int pk = 0; pk = __builtin_amdgcn_cvt_pk_fp8_f32(y[0], y[1], pk, false); pk = __builtin_amdgcn_cvt_pk_fp8_f32(y[2], y[3], pk, true); *(int*)(out8 + (size_t)row * NC + 4 * (lane + 64 * i)) = pk; } }
    }
}
template <bool IN16, bool OUT16>
__device__ __forceinline__ void ph_resnorm(const void* xin, const bf16_t* __restrict__ m, const float* __restrict__ gpost, const float* __restrict__ gpre, void* xout, bf16_t* __restrict__ h, unsigned char* __restrict__ h8, int bid, int nblk) {
    const int tid_ = opaque_tid(), lane = tid_ & 63, w = tid_ >> 6;
    for (int row = bid * 8 + w; row < NTOK; row += nblk * 8) {
        const u32x2* mr = (const u32x2*)(m + (size_t)row * DM);
        f32x4 mv[8], xv[8]; float ss = 0.f;
#pragma unroll
        for (int i = 0; i < 8; ++i) { const u32x2 wd = mr[lane + 64 * i]; mv[i][0] = __uint_as_float(wd.x << 16); mv[i][1] = __uint_as_float(wd.x & 0xFFFF0000u); mv[i][2] = __uint_as_float(wd.y << 16); mv[i][3] = __uint_as_float(wd.y & 0xFFFF0000u);
            if (IN16) { const u32x2 xw = ((const u32x2*)((const bf16_t*)xin + (size_t)row * DM))[lane + 64 * i];
                xv[i][0] = __uint_as_float(xw.x << 16); xv[i][1] = __uint_as_float(xw.x & 0xFFFF0000u); xv[i][2] = __uint_as_float(xw.y << 16); xv[i][3] = __uint_as_float(xw.y & 0xFFFF0000u); }
            else xv[i] = ((const f32x4*)((const float*)xin + (size_t)row * DM))[lane + 64 * i];
            ss += mv[i][0] * mv[i][0] + mv[i][1] * mv[i][1] + mv[i][2] * mv[i][2] + mv[i][3] * mv[i][3]; }
        ss = wave_sum(ss);
        const float r1 = rsqrtf(ss * (1.0f / DM) + NORM_EPS);
        float s2 = 0.f;
#pragma unroll
        for (int i = 0; i < 8; ++i) { const f32x4 gg = ((const f32x4*)gpost)[lane + 64 * i]; xv[i] = xv[i] + mv[i] * r1 * gg;
            if (OUT16) st_bf16x4((bf16_t*)xout + (size_t)row * DM + 4 * (lane + 64 * i), xv[i]); else ((f32x4*)((float*)xout + (size_t)row * DM))[lane + 64 * i] = xv[i];
            s2 += xv[i][0] * xv[i][0] + xv[i][1] * xv[i][1] + xv[i][2] * xv[i][2] + xv[i][3] * xv[i][3]; }
        if (gpre) {
            s2 = wave_sum(s2);
            const float r2 = rsqrtf(s2 * (1.0f / DM) + NORM_EPS);
#pragma unroll
            for (int i = 0; i < 8; ++i) { const f32x4 gg = ((const f32x4*)gpre)[lane + 64 * i]; const f32x4 y = xv[i] * r2 * gg;
                if (h8) { int pk = 0; pk = __builtin_amdgcn_cvt_pk_fp8_f32(y[0], y[1], pk, false); pk = __builtin_amdgcn_cvt_pk_fp8_f32(y[2], y[3], pk, true); *(int*)(h8 + (size_t)row * DM + 4 * (lane + 64 * i)) = pk; }
                else st_bf16x4(h + (size_t)row * DM + 4 * (lane + 64 * i), y); }
        }
    }
}
__device__ __forceinline__ void ph_scan1(const bf16_t* __restrict__ Aa, const bf16_t* __restrict__ Bb, float* __restrict__ CA, float* __restrict__ CH, int bid, int nblk) {
    for (int i = bid * 512 + opaque_tid(); i < 2 * 256 * 1024; i += nblk * 512) {
        const int ch = i & 1023, chunk = (i >> 10) & 255, b = i >> 18;
        const size_t base = ((size_t)b * SEQ + (size_t)chunk * 64) * 1024 + ch;
        float h = 0.f, P = 1.f;
#pragma unroll 8
        for (int s = 0; s < 64; ++s) { const float a = 1.0f - bf2f(Aa[base + (size_t)s * 1024]); h = a * h + bf2f(Bb[base + (size_t)s * 1024]); P *= a; }
        CA[i] = P; CH[i] = h;
    }
}
__device__ __forceinline__ void ph_scan2(const float* __restrict__ CA, const float* __restrict__ CH, float* __restrict__ CIN, int bid, int nblk) {
    for (int i = bid * 512 + opaque_tid(); i < 2048; i += nblk * 512) {
        const int ch = i & 1023, b = i >> 10;
        float h = 0.f;
#pragma unroll 8
        for (int c = 0; c < 256; ++c) { const int j = (b * 256 + c) * 1024 + ch; CIN[j] = h; h = CA[j] * h + CH[j]; }
    }
}
__device__ __forceinline__ void ph_scan3(const bf16_t* __restrict__ Aa, const bf16_t* __restrict__ Bb, const float* __restrict__ CIN, const bf16_t* __restrict__ YG, bf16_t* __restrict__ CC, int bid, int nblk) {
    for (int i = bid * 512 + opaque_tid(); i < 2 * 256 * 1024; i += nblk * 512) {
        const int ch = i & 1023, chunk = (i >> 10) & 255, b = i >> 18;
        const size_t row0 = (size_t)b * SEQ + (size_t)chunk * 64;
        float h = CIN[i];
#pragma unroll 8
        for (int s = 0; s < 64; ++s) { const size_t r = row0 + s; h = (1.0f - bf2f(Aa[r * 1024 + ch])) * h + bf2f(Bb[r * 1024 + ch]);
            CC[r * 2048 + 1024 + ch] = f2bf(h * gelu_tanh(bf2f(YG[r * 1024 + ch]))); }
    }
}
__device__ __forceinline__ void ph_rope_q(const bf16_t* __restrict__ Q1, const int* __restrict__ pos, unsigned char* __restrict__ Q8, int bid, int nblk) {
    for (int idx = bid * 512 + opaque_tid(); idx < NTOK * 8 * 4; idx += nblk * 512) {
        const int g = idx & 3, h = (idx >> 2) & 7, row = idx >> 5;
        const bf16_t* p = Q1 + (size_t)row * 1536 + h * 192; unsigned char* q = Q8 + (size_t)row * 1536 + h * 192;
#pragma unroll
        for (int k = 0; k < 4; ++k) { const u32x4 w = *(const u32x4*)(p + 32 * g + 8 * k);
            int p0 = 0, p1 = 0;
            p0 = __builtin_amdgcn_cvt_pk_fp8_f32(__uint_as_float(w.x << 16), __uint_as_float(w.x & 0xFFFF0000u), p0, false); p0 = __builtin_amdgcn_cvt_pk_fp8_f32(__uint_as_float(w.y << 16), __uint_as_float(w.y & 0xFFFF0000u), p0, true);
            p1 = __builtin_amdgcn_cvt_pk_fp8_f32(__uint_as_float(w.z << 16), __uint_as_float(w.z & 0xFFFF0000u), p1, false); p1 = __builtin_amdgcn_cvt_pk_fp8_f32(__uint_as_float(w.w << 16), __uint_as_float(w.w & 0xFFFF0000u), p1, true);
            u32x2 o; o.x = (unsigned)p0; o.y = (unsigned)p1; *(u32x2*)(q + 32 * g + 8 * k) = o; }
        const u32x4 w1 = *(const u32x4*)(p + 128 + 8 * g), w2 = *(const u32x4*)(p + 160 + 8 * g);
        const unsigned a1[4] = {w1.x, w1.y, w1.z, w1.w}, a2[4] = {w2.x, w2.y, w2.z, w2.w};
        float o1[8], o2[8]; const int ps = pos[row];
#pragma unroll
        for (int j = 0; j < 8; ++j) { float cs, sn; rope_cs(ps, 8 * g + j, cs, sn);
            const float x1 = (j & 1) ? __uint_as_float(a1[j >> 1] & 0xFFFF0000u) : __uint_as_float(a1[j >> 1] << 16), x2 = (j & 1) ? __uint_as_float(a2[j >> 1] & 0xFFFF0000u) : __uint_as_float(a2[j >> 1] << 16);
            o1[j] = x1 * cs - x2 * sn; o2[j] = x2 * cs + x1 * sn; }
        int p0 = 0, p1 = 0, p2 = 0, p3 = 0;
        p0 = __builtin_amdgcn_cvt_pk_fp8_f32(o1[0], o1[1], p0, false); p0 = __builtin_amdgcn_cvt_pk_fp8_f32(o1[2], o1[3], p0, true); p1 = __builtin_amdgcn_cvt_pk_fp8_f32(o1[4], o1[5], p1, false); p1 = __builtin_amdgcn_cvt_pk_fp8_f32(o1[6], o1[7], p1, true);
        p2 = __builtin_amdgcn_cvt_pk_fp8_f32(o2[0], o2[1], p2, false); p2 = __builtin_amdgcn_cvt_pk_fp8_f32(o2[2], o2[3], p2, true); p3 = __builtin_amdgcn_cvt_pk_fp8_f32(o2[4], o2[5], p3, false); p3 = __builtin_amdgcn_cvt_pk_fp8_f32(o2[6], o2[7], p3, true);
        u32x2 oa; oa.x = (unsigned)p0; oa.y = (unsigned)p1; *(u32x2*)(q + 128 + 8 * g) = oa;
        u32x2 ob; ob.x = (unsigned)p2; ob.y = (unsigned)p3; *(u32x2*)(q + 160 + 8 * g) = ob;
    }
}
__device__ __forceinline__ void ph_rope_k(const float* __restrict__ KR, const int* __restrict__ pos, unsigned char* __restrict__ K8, int bid, int nblk) {
    for (int idx = bid * 512 + opaque_tid(); idx < NTOK * 32; idx += nblk * 512) {
        const int i = idx & 31, row = idx >> 5;
        float c, s; rope_cs(pos[row], i, c, s);
        const float x1 = KR[(size_t)row * 64 + i], x2 = KR[(size_t)row * 64 + 32 + i];
        const int pk = __builtin_amdgcn_cvt_pk_fp8_f32(x1 * c - x2 * s, x2 * c + x1 * s, 0, false);
        const unsigned char o1 = (unsigned char)(pk & 0xFF), o2 = (unsigned char)((pk >> 8) & 0xFF);
#pragma unroll
        for (int h = 0; h < 8; ++h) { unsigned char* p = K8 + (size_t)row * 1536 + h * 192 + 128; p[i] = o1; p[32 + i] = o2; }
    }
}
template <bool OUT8> __device__ __forceinline__ void ph_ffn_gate(const bf16_t* __restrict__ HID, const float* __restrict__ cw, const float* __restrict__ cb, bf16_t* __restrict__ ACT, int bid, int nblk) {
    for (int i = bid * 512 + opaque_tid(); i < 512 * (SEQ / 64); i += nblk * 512) {
        const int c8 = (i & 511) * 8, t0 = (i >> 9) * 64;
        float wg[3][8], wv[3][8], bg[8], bv[8];
#pragma unroll
        for (int j = 0; j < 8; ++j) { bg[j] = cb[c8 + j]; bv[j] = cb[4096 + c8 + j];
#pragma unroll
            for (int k = 0; k < 3; ++k) { wg[k][j] = cw[k * 8192 + c8 + j]; wv[k][j] = cw[k * 8192 + 4096 + c8 + j]; } }
        u32x4 g2 = {0u, 0u, 0u, 0u}, g1 = g2, v2 = g2, v1 = g2;
        if (t0 >= 2) { g2 = *(const u32x4*)(HID + (size_t)(t0 - 2) * 8192 + c8); g1 = *(const u32x4*)(HID + (size_t)(t0 - 1) * 8192 + c8);
                       v2 = *(const u32x4*)(HID + (size_t)(t0 - 2) * 8192 + 4096 + c8); v1 = *(const u32x4*)(HID + (size_t)(t0 - 1) * 8192 + 4096 + c8); }
#pragma unroll 8
        for (int r = 0; r < 64; ++r) {
            const u32x4 g0 = *(const u32x4*)(HID + (size_t)(t0 + r) * 8192 + c8), v0 = *(const u32x4*)(HID + (size_t)(t0 + r) * 8192 + 4096 + c8);
            const unsigned G2[4] = {g2.x, g2.y, g2.z, g2.w}, G1[4] = {g1.x, g1.y, g1.z, g1.w}, G0[4] = {g0.x, g0.y, g0.z, g0.w};
            const unsigned V2[4] = {v2.x, v2.y, v2.z, v2.w}, V1[4] = {v1.x, v1.y, v1.z, v1.w}, V0[4] = {v0.x, v0.y, v0.z, v0.w};
            float o[8];
#pragma unroll
            for (int j = 0; j < 4; ++j) {
                const float ge = bg[2 * j] + wg[0][2 * j] * __uint_as_float(G2[j] << 16) + wg[1][2 * j] * __uint_as_float(G1[j] << 16) + wg[2][2 * j] * __uint_as_float(G0[j] << 16);
                const float go = bg[2 * j + 1] + wg[0][2 * j + 1] * __uint_as_float(G2[j] & 0xFFFF0000u) + wg[1][2 * j + 1] * __uint_as_float(G1[j] & 0xFFFF0000u) + wg[2][2 * j + 1] * __uint_as_float(G0[j] & 0xFFFF0000u);
                const float ve = bv[2 * j] + wv[0][2 * j] * __uint_as_float(V2[j] << 16) + wv[1][2 * j] * __uint_as_float(V1[j] << 16) + wv[2][2 * j] * __uint_as_float(V0[j] << 16);
                const float vo = bv[2 * j + 1] + wv[0][2 * j + 1] * __uint_as_float(V2[j] & 0xFFFF0000u) + wv[1][2 * j + 1] * __uint_as_float(V1[j] & 0xFFFF0000u) + wv[2][2 * j + 1] * __uint_as_float(V0[j] & 0xFFFF0000u);
                o[2 * j] = gelu_tanh(ge) * ve; o[2 * j + 1] = gelu_tanh(go) * vo; }
            if (OUT8) { int p0 = 0, p1 = 0;
                p0 = __builtin_amdgcn_cvt_pk_fp8_f32(o[0], o[1], p0, false); p0 = __builtin_amdgcn_cvt_pk_fp8_f32(o[2], o[3], p0, true);
                p1 = __builtin_amdgcn_cvt_pk_fp8_f32(o[4], o[5], p1, false); p1 = __builtin_amdgcn_cvt_pk_fp8_f32(o[6], o[7], p1, true);
                u32x2 ov; ov.x = (unsigned)p0; ov.y = (unsigned)p1; *(u32x2*)((unsigned char*)ACT + (size_t)(t0 + r) * 4096 + c8) = ov; }
            else { u32x4 ov; ov.x = pack2bf(o[0], o[1]); ov.y = pack2bf(o[2], o[3]); ov.z = pack2bf(o[4], o[5]); ov.w = pack2bf(o[6], o[7]);
                *(u32x4*)(ACT + (size_t)(t0 + r) * 4096 + c8) = ov; }
            g2 = g1; g1 = g0; v2 = v1; v1 = v0;
        }
    }
}

__device__ __forceinline__ void ph_conv_lru(const float* __restrict__ wa, const float* __restrict__ wx, bf16_t* __restrict__ Bt, int bid, int nblk) {
    for (int e = bid * 512 + opaque_tid(); e < 8 * 2 * 128 * 128; e += nblk * 512) {
        const int d = e & 127, c = (e >> 7) & 127, gate = (e >> 14) & 1, nb = e >> 15;
        const float v = (gate ? wx : wa)[((size_t)nb * 128 + c) * 128 + d];
        bf16_t* row = Bt + (size_t)(nb * 256 + gate * 128 + d) * 256;
        row[(nb & 1) * 128 + c] = f2bf(v); row[(1 - (nb & 1)) * 128 + c] = 0;
    }
}

static constexpr size_t MiB = 1048576;
static constexpr size_t W_UP0 = 0 * MiB, W_UP1 = 32 * MiB, W_DN0 = 64 * MiB, W_DN1 = 80 * MiB, W_ABIN = 96 * MiB, W_ABOUT = 117 * MiB, W_CDIN = 125 * MiB, W_CDOUT = 137 * MiB,
                        W_QUP = 145 * MiB, W_KVUP = 146 * MiB + 512 * 1024, W_POOL = 147 * MiB + 512 * 1024;
static constexpr size_t R_H = 148 * MiB;
static constexpr size_t R_Q0 = 276 * MiB, R_K0 = 340 * MiB, R_VT0 = 404 * MiB, R_QI = 468 * MiB, R_M0 = 468 * MiB, R_U = 596 * MiB, R_KI = 724 * MiB, R_WI = 732 * MiB, R_MASK = 734 * MiB, R_CC0 = 830 * MiB, R_POOLED = 958 * MiB, R_H8A = 830 * MiB;
static constexpr size_t R_HID = 276 * MiB, R_ACT = 532 * MiB, R_F = 660 * MiB, R_X3 = 788 * MiB;
static constexpr size_t R_VT1 = 276 * MiB, R_CQ = 276 * MiB, R_CKV = 340 * MiB, R_KR = 372 * MiB, R_XL = 380 * MiB, R_YG = 444 * MiB, R_CQN = 508 * MiB, R_CKVN = 540 * MiB, R_LA = 556 * MiB, R_LB = 684 * MiB,
                        R_Q1 = 812 * MiB, R_K1 = 908 * MiB, R_Q8 = 956 * MiB,     R_CA = 1004 * MiB, R_CH = 1006 * MiB, R_CIN = 1008 * MiB, R_CC1 = 148 * MiB, R_M1 = 276 * MiB, R_XCB = 148 * MiB, W_LRU = 1010 * MiB;
static constexpr size_t WS_BAR = 1022 * MiB, WS_NEED = 1022 * MiB + 65536;
static constexpr int MK_LDS = 162816;

struct MK { const float* in[28]; float* out; unsigned char* ws; int ph_lo, ph_hi; };

__global__ __launch_bounds__(512, 2) void k_mega(MK p) {
    extern __shared__ __attribute__((aligned(16))) unsigned char shm[];
    LAS unsigned char* lds = (LAS unsigned char*)shm;
    const int bid0 = (int)blockIdx.x, nblk0 = (int)gridDim.x;
    volatile LAS unsigned* xbw = (volatile LAS unsigned*)(lds + MK_LDS - 16);
    if (threadIdx.x == 0) { xbw[0] = 0u; xbw[1] = 0u; xbw[2] = 0u; xbw[3] = 0u; }
    if ((threadIdx.x & 63) == 0) *(volatile LAS int*)(size_t)(TID_TAB_LDS + 4 * ((unsigned)__builtin_amdgcn_s_getreg(((6 - 1) << 11) | 4) & 63u)) = (int)(threadIdx.x >> 6);
    __syncthreads();
    XcdBarrier bar = xcd_barrier_post((unsigned*)(p.ws + WS_BAR), xbw);
#ifndef KARG_PLAIN
#define KARG_PLAIN 0
#endif
#if KARG_PLAIN
#define KARG_DECL const MK& P_ = p;
#else
#define KARG_DECL KPtr P__ = kp; asm volatile("" : "+s"(P__)); const __attribute__((address_space(4))) MK& P_ = *P__;
#endif
    typedef const __attribute__((address_space(4))) MK* KPtr;
    KPtr kp = (KPtr)__builtin_amdgcn_kernarg_segment_ptr();
#define WSP(T, off) ((T*)(ws + (off)))
#define PHASE_BEGIN if (pc >= p.ph_lo && pc < p.ph_hi) { const int bid = opaque_s(bid0), nblk = opaque_s(nblk0); \
    KARG_DECL unsigned char* const ws = P_.ws; float* const xo = P_.out; const float* const x = P_.in[0]; const int* const positions = (const int*)P_.in[1]; \
    const float *const mix_pre_g = P_.in[2], *const mix_post_g = P_.in[3], *const ffn_pre_g = P_.in[4], *const ffn_post_g = P_.in[5], *const ffn_up = P_.in[6], *const ffn_conv_w = P_.in[7], *const ffn_conv_b = P_.in[8], *const ffn_down = P_.in[9], \
    *const ab_w_in = P_.in[10], *const pool_w = P_.in[11], *const pool_b = P_.in[12], *const pool_scale = P_.in[13], *const ab_w_out = P_.in[14], *const cd_w_in = P_.in[15], *const q_norm_g = P_.in[16], *const w_q_up = P_.in[17], \
    *const kv_norm_g = P_.in[18], *const w_kv_up = P_.in[19], *const lru_conv_w = P_.in[20], *const lru_conv_b = P_.in[21], *const lru_wa = P_.in[22], *const lru_ba = P_.in[23], *const lru_wx = P_.in[24], *const lru_bx = P_.in[25], \
    *const lru_lambda = P_.in[26], *const cd_w_out = P_.in[27]; bf16_t* const H = WSP(bf16_t, R_H); const bf16_t* const CC = WSP(bf16_t, LAYER_CC); bf16_t* const Mx = WSP(bf16_t, LAYER_MX); \
    (void)xo; (void)x; (void)positions; (void)mix_pre_g; (void)mix_post_g; (void)ffn_pre_g; (void)ffn_post_g; (void)ffn_up; (void)ffn_conv_w; (void)ffn_conv_b; (void)ffn_down; (void)ab_w_in; (void)pool_w; (void)pool_b; (void)pool_scale; \
    (void)ab_w_out; (void)cd_w_in; (void)q_norm_g; (void)w_q_up; (void)kv_norm_g; (void)w_kv_up; (void)lru_conv_w; (void)lru_conv_b; (void)lru_wa; (void)lru_ba; (void)lru_wx; (void)lru_bx; (void)lru_lambda; (void)cd_w_out; (void)H; (void)CC; (void)Mx;
#define PHASE_END } if (pc >= p.ph_lo && pc + 1 < p.ph_hi) xcd_barrier(bar); ++pc;
    int pc = 0;
#define LAYER_CC R_CC0
#define LAYER_MX R_M0
    PHASE_BEGIN
#if !((SKIPMASK >> 0) & 1)
#if FP8_UP0
        ph_convT8(lds, ffn_up, 8192, 8192, 2048, WSP(unsigned char, W_UP0), bid, nblk, true);
#else
        ph_convT(lds, ffn_up, 8192, 0, 8192, 2048, WSP(bf16_t, W_UP0), 2048, bid, nblk, true);
#endif
#if FP8_UP1
        ph_convT8(lds, ffn_up + (size_t)2048 * 8192, 8192, 8192, 2048, WSP(unsigned char, W_UP1), bid, nblk, true);
#else
        ph_convT(lds, ffn_up + (size_t)2048 * 8192, 8192, 0, 8192, 2048, WSP(bf16_t, W_UP1), 2048, bid, nblk, true);
#endif
#if FP8_DN0
        ph_convT8(lds, ffn_down, 2048, 2048, 4096, WSP(unsigned char, W_DN0), bid, nblk);
#else
        ph_convT(lds, ffn_down, 2048, 0, 2048, 4096, WSP(bf16_t, W_DN0), 4096, bid, nblk);
#endif
#if FP8_DN1
        ph_convT8(lds, ffn_down + (size_t)4096 * 2048, 2048, 2048, 4096, WSP(unsigned char, W_DN1), bid, nblk);
#else
        ph_convT(lds, ffn_down + (size_t)4096 * 2048, 2048, 0, 2048, 4096, WSP(bf16_t, W_DN1), 4096, bid, nblk);
#endif
#if FP8_QKV
        ph_convT8(lds, ab_w_in, 5200, 3072, 2048, WSP(unsigned char, W_ABIN), bid, nblk);
        ph_convT(lds, ab_w_in, 5200, 3072, 1024, 2048, WSP(bf16_t, W_ABIN) + (size_t)3072 * 2048, 2048, bid, nblk);
#else
        ph_convT(lds, ab_w_in, 5200, 0, 4096, 2048, WSP(bf16_t, W_ABIN), 2048, bid, nblk);
#endif
        ph_convT(lds, ab_w_in, 5200, 4176, 1024, 2048, WSP(bf16_t, W_ABIN) + (size_t)4096 * 2048, 2048, bid, nblk);
        ph_convT(lds, ab_w_in, 5200, 4096, 64, 2048, WSP(bf16_t, W_ABIN) + (size_t)5120 * 2048, 2048, bid, nblk);
        ph_convT(lds, ab_w_in, 5200, 4160, 16, 2048, WSP(bf16_t, W_ABIN) + (size_t)5184 * 2048, 2048, bid, nblk);
        ph_convT(lds, ab_w_out, 2048, 0, 2048, 2048, WSP(bf16_t, W_ABOUT), 2048, bid, nblk);
        ph_convT(lds, cd_w_in, 2880, 0, 832, 2048, WSP(bf16_t, W_CDIN), 2048, bid, nblk);
        ph_convT(lds, cd_w_in, 2880, 832, 2048, 2048, WSP(bf16_t, W_CDIN) + (size_t)1024 * 2048, 2048, bid, nblk);
        ph_convT(lds, cd_w_out, 2048, 0, 2048, 2048, WSP(bf16_t, W_CDOUT), 2048, bid, nblk);
        ph_convT(lds, w_q_up, 1536, 0, 1536, 512, WSP(bf16_t, W_QUP), 512, bid, nblk);
        ph_convT(lds, w_kv_up, 2048, 0, 2048, 256, WSP(bf16_t, W_KVUP), 256, bid, nblk);
        for (int g = 0; g < 4; ++g) ph_convT(lds, pool_w + (size_t)g * 65536, 256, 0, 256, 256, WSP(bf16_t, W_POOL) + (size_t)g * 65536, 256, bid, nblk);
        ph_rmsnorm<2048>(x, mix_pre_g, H, bid, nblk, FP8_QKV ? WSP(unsigned char, R_H8A) : (unsigned char*)nullptr);
#endif
    PHASE_END
    {
            PHASE_BEGIN
#if !((SKIPMASK >> 1) & 1)
                FAbIn2 f; f.Q = WSP(unsigned char, R_Q0); f.K = WSP(unsigned char, R_K0); f.VT = WSP(bf16_t, R_VT0); f.QI = WSP(float, R_QI); f.U = WSP(float, R_U); f.WI = WSP(float, R_WI); f.KI16 = WSP(unsigned short, R_KI);
#if FP8_QKV
                ph_gemm8(lds, WSP(unsigned char, R_H8A), 2048, WSP(unsigned char, W_ABIN), 2048, NTOK, 3072, 2048, f, bid, nblk);
                { FAbInHi fh; fh.f = f; ph_gemm(lds, H, 2048, WSP(bf16_t, W_ABIN) + (size_t)3072 * 2048, 2048, NTOK, 2304, 2048, fh, bid, nblk); }
#else
                ph_gemm(lds, H, 2048, WSP(bf16_t, W_ABIN), 2048, NTOK, 5376, 2048, f, bid, nblk);
#endif
#endif
            PHASE_END
            PHASE_BEGIN
#if !((SKIPMASK >> 2) & 1)
                ph_pooled(WSP(float, R_U), WSP(bf16_t, R_POOLED), bid, nblk);
                IdxArgs a; a.QI = WSP(float, R_QI); a.KI16 = WSP(unsigned short, R_KI); a.WI = WSP(float, R_WI); a.MT = WSP(unsigned long long, R_MASK);
                idx_phase(lds, a, bid, nblk);
#endif
            PHASE_END
            PHASE_BEGIN
#if !((SKIPMASK >> 3) & 1)
                { FPool f; f.CC = WSP(bf16_t, R_CC0); f.pb = pool_b; f.ps = pool_scale; ph_gemm(lds, WSP(bf16_t, R_POOLED), 1024, WSP(bf16_t, W_POOL), 256, NTOK, 1024, 256, f, bid, nblk, 0, 512); }
                AttnArgs a; a.Q = WSP(bf16_t, R_Q0); a.K = WSP(bf16_t, R_K0); a.VT = WSP(bf16_t, R_VT0); a.MT = WSP(unsigned long long, R_MASK); a.O = WSP(bf16_t, R_CC0); a.ldq = 1024; a.ldk = 1024; a.ldo = 2048;
                a.sc_log2e = 0.08838834764831845f * 1.4426950408889634f;
                attn_phase<128, true>(lds, a, bid, nblk);
#endif
            PHASE_END
        PHASE_BEGIN
#if !((SKIPMASK >> 4) & 1)
            FStoreBf16 f; f.O = Mx; f.ldc = 2048; f.pad_ = 0;
            ph_gemm(lds, CC, 2048, WSP(bf16_t, W_ABOUT), 2048, NTOK, 2048, 2048, f, bid, nblk);
#endif
        PHASE_END
        PHASE_BEGIN
#if !((SKIPMASK >> 5) & 1)
            ph_resnorm<false, true>(x, Mx, mix_post_g + 0, ffn_pre_g + 0, xo, H, FP8_UP0 ? WSP(unsigned char, R_H) : (unsigned char*)nullptr, bid, nblk);
#endif
        PHASE_END
        PHASE_BEGIN
#if FP8_UP0
            { EpiGate<FP8_DN0 != 0, true> ep; ep.cw = ffn_conv_w + 0; ep.cb = ffn_conv_b + 0; ep.ACT = WSP(void, R_HID);
              ph_gemm_e(lds, (const bf16_t*)WSP(unsigned char, R_H), 1024, (const bf16_t*)WSP(unsigned char, W_UP0), 1024, 134 * 256, 8192, 1024, ep, bid, nblk, 0, 0, 1); }
#else
            { EpiGate<FP8_DN0 != 0, false> ep; ep.cw = ffn_conv_w + 0; ep.cb = ffn_conv_b + 0; ep.ACT = WSP(void, R_HID);
              ph_gemm_e(lds, H, 2048, WSP(bf16_t, W_UP0), 2048, 134 * 256, 8192, 2048, ep, bid, nblk, 0, 0, 1); }
#endif
        PHASE_END
        PHASE_BEGIN
            FStoreBf16 f; f.O = WSP(bf16_t, R_F); f.ldc = 2048; f.pad_ = 0;
#if FP8_DN0
            ph_gemm8(lds, WSP(unsigned char, R_HID), 4096, WSP(unsigned char, W_DN0), 4096, NTOK, 2048, 4096, f, bid, nblk);
#else
            ph_gemm(lds, WSP(bf16_t, R_HID), 4096, WSP(bf16_t, W_DN0), 4096, NTOK, 2048, 4096, f, bid, nblk);
#endif
        PHASE_END
        PHASE_BEGIN
#if !((SKIPMASK >> 9) & 1)
            ph_resnorm<true, true>(xo, WSP(bf16_t, R_F), ffn_post_g + 0, mix_pre_g + 2048, xo, H, nullptr, bid, nblk);
#endif
        PHASE_END
    }
    {
#undef LAYER_CC
#undef LAYER_MX
#define LAYER_CC R_CC1
#define LAYER_MX R_M1
            PHASE_BEGIN
#if !((SKIPMASK >> 10) & 1)
                FCdIn f; f.CQ = WSP(float, R_CQ); f.CKV = WSP(float, R_CKV); f.KR = WSP(float, R_KR); f.XL = WSP(bf16_t, R_XL); f.YG = WSP(bf16_t, R_YG);
                ph_gemm(lds, H, 2048, WSP(bf16_t, W_CDIN), 2048, NTOK, 3072, 2048, f, bid, nblk);
#endif
            PHASE_END
            PHASE_BEGIN
#if !((SKIPMASK >> 11) & 1)
                ph_xc(WSP(bf16_t, R_XL), lru_conv_w, lru_conv_b, WSP(bf16_t, R_XCB), bid, nblk);
                ph_conv_lru(lru_wa, lru_wx, WSP(bf16_t, W_LRU), bid, nblk);
                ph_rmsnorm<512>(WSP(float, R_CQ), q_norm_g, WSP(bf16_t, R_CQN), bid, nblk);
                ph_rmsnorm<256>(WSP(float, R_CKV), kv_norm_g, WSP(bf16_t, R_CKVN), bid, nblk);
            PHASE_END
            PHASE_BEGIN
                { EpiLru ep; ep.XCB = WSP(bf16_t, R_XCB); ep.ba = lru_ba; ep.bx = lru_bx; ep.lam = lru_lambda; ep.LA = WSP(bf16_t, R_LA); ep.LB = WSP(bf16_t, R_LB);
                  ph_gemm_e(lds, WSP(bf16_t, R_XCB), 1024, WSP(bf16_t, W_LRU), 256, NTOK, 2048, 256, ep, bid, nblk, 1, 512); }
                { FStoreBf16 f; f.O = WSP(bf16_t, R_Q1); f.ldc = 1536; f.pad_ = 0; ph_gemm(lds, WSP(bf16_t, R_CQN), 512, WSP(bf16_t, W_QUP), 512, NTOK, 1536, 512, f, bid, nblk); }
                { FKvUp2 f; f.K8 = WSP(unsigned char, R_K1); f.VT = WSP(bf16_t, R_VT1); ph_gemm(lds, WSP(bf16_t, R_CKVN), 256, WSP(bf16_t, W_KVUP), 256, NTOK, 2048, 256, f, bid, nblk); }
            PHASE_END
            PHASE_BEGIN
                ph_scan1(WSP(bf16_t, R_LA), WSP(bf16_t, R_LB), WSP(float, R_CA), WSP(float, R_CH), bid, nblk);
                ph_rope_q(WSP(bf16_t, R_Q1), positions, WSP(unsigned char, R_Q8), bid, nblk);
                ph_rope_k(WSP(float, R_KR), positions, WSP(unsigned char, R_K1), bid, nblk);
            PHASE_END
            PHASE_BEGIN
                ph_scan2(WSP(float, R_CA), WSP(float, R_CH), WSP(float, R_CIN), bid, nblk);
            PHASE_END
            PHASE_BEGIN
                ph_scan3(WSP(bf16_t, R_LA), WSP(bf16_t, R_LB), WSP(float, R_CIN), WSP(bf16_t, R_YG), WSP(bf16_t, R_CC1), bid, nblk);
                AttnArgs a; a.Q = WSP(bf16_t, R_Q8); a.K = WSP(bf16_t, R_K1); a.VT = WSP(bf16_t, R_VT1); a.MT = nullptr; a.O = WSP(bf16_t, R_CC1); a.ldq = 1536; a.ldk = 1536; a.ldo = 2048;
                a.sc_log2e = 0.07216878364870322f * 1.4426950408889634f;
                attn_phase<192, false>(lds, a, bid, nblk);
#endif
            PHASE_END
        PHASE_BEGIN
#if !((SKIPMASK >> 15) & 1)
            FStoreBf16 f; f.O = Mx; f.ldc = 2048; f.pad_ = 0;
            ph_gemm(lds, CC, 2048, WSP(bf16_t, W_CDOUT), 2048, NTOK, 2048, 2048, f, bid, nblk);
#endif
        PHASE_END
        PHASE_BEGIN
#if !((SKIPMASK >> 16) & 1)
            ph_resnorm<true, true>(xo, Mx, mix_post_g + 2048, ffn_pre_g + 2048, WSP(bf16_t, R_X3), H, FP8_UP1 ? WSP(unsigned char, R_H) : (unsigned char*)nullptr, bid, nblk);
#endif
        PHASE_END
        PHASE_BEGIN
#if FP8_UP1
            { EpiGate<FP8_DN1 != 0, true> ep; ep.cw = ffn_conv_w + 24576; ep.cb = ffn_conv_b + 8192; ep.ACT = WSP(void, R_HID);
              ph_gemm_e(lds, (const bf16_t*)WSP(unsigned char, R_H), 1024, (const bf16_t*)WSP(unsigned char, W_UP1), 1024, 134 * 256, 8192, 1024, ep, bid, nblk, 0, 0, 1); }
#else
            { EpiGate<FP8_DN1 != 0, false> ep; ep.cw = ffn_conv_w + 24576; ep.cb = ffn_conv_b + 8192; ep.ACT = WSP(void, R_HID);
              ph_gemm_e(lds, H, 2048, WSP(bf16_t, W_UP1), 2048, 134 * 256, 8192, 2048, ep, bid, nblk, 0, 0, 1); }
#endif
        PHASE_END
        PHASE_BEGIN
            FStoreBf16 f; f.O = WSP(bf16_t, R_F); f.ldc = 2048; f.pad_ = 0;
#if FP8_DN1
            ph_gemm8(lds, WSP(unsigned char, R_HID), 4096, WSP(unsigned char, W_DN1), 4096, NTOK, 2048, 4096, f, bid, nblk);
#else
            ph_gemm(lds, WSP(bf16_t, R_HID), 4096, WSP(bf16_t, W_DN1), 4096, NTOK, 2048, 4096, f, bid, nblk);
#endif
        PHASE_END
        PHASE_BEGIN
#if !((SKIPMASK >> 20) & 1)
            ph_resnorm<true, false>(WSP(bf16_t, R_X3), WSP(bf16_t, R_F), ffn_post_g + 2048, (const float*)nullptr, xo, H, nullptr, bid, nblk);
#endif
        PHASE_END
    }
#undef LAYER_CC
#undef LAYER_MX
#undef WSP
#undef PHASE_BEGIN
#undef PHASE_END
}

#ifndef MK_N_LAUNCHES
#define MK_N_LAUNCHES 1
#endif
static constexpr int MK_NPHASES = 1 + 3 + 7 + 2 * 5;

extern "C" void kernel_launch(void* const* d_in, const int* in_sizes, int n_in, void* d_out, int out_size, void* d_ws, size_t ws_size, hipStream_t stream) {
    static int grid = 0;
    if (grid == 0) {
        if (n_in != 28 || out_size != NTOK * DM || ws_size < WS_NEED) { fprintf(stderr, "kernel_launch: unexpected shapes (n_in %d out %d ws %zu)\n", n_in, out_size, ws_size); grid = -1; return; }
        int dev = 0, cus = 0, per_cu = 0;
        if (hipGetDevice(&dev) != hipSuccess || hipDeviceGetAttribute(&cus, hipDeviceAttributeMultiprocessorCount, dev) != hipSuccess) { grid = -1; return; }
        if (hipFuncSetAttribute((const void*)k_mega, hipFuncAttributeMaxDynamicSharedMemorySize, MK_LDS) != hipSuccess) { fprintf(stderr, "kernel_launch: hipFuncSetAttribute failed\n"); grid = -1; return; }
        if (hipOccupancyMaxActiveBlocksPerMultiprocessor(&per_cu, (const void*)k_mega, 512, MK_LDS) != hipSuccess || per_cu < 1) { fprintf(stderr, "kernel_launch: occupancy query says %d\n", per_cu); }
        (void)hipGetLastError();
        grid = cus;
        if (grid != 256) { fprintf(stderr, "kernel_launch: built for 256 CUs, found %d\n", grid); grid = -1; return; }
    }
    if (grid < 0) return;
    unsigned char* ws = (unsigned char*)d_ws;
    (void)hipMemsetAsync(ws + WS_BAR, 0, XCD_BAR_WORDS * sizeof(unsigned), stream);
    (void)hipMemsetAsync(ws + W_ABIN + (size_t)5200 * 2048 * 2, 0, (size_t)176 * 2048 * 2, stream);
    (void)hipMemsetAsync(ws + W_CDIN + (size_t)832 * 2048 * 2, 0, (size_t)192 * 2048 * 2, stream);
    MK p{};
    for (int i = 0; i < 28; ++i) p.in[i] = (const float*)d_in[i];
    p.out = (float*)d_out; p.ws = ws;
#if MK_N_LAUNCHES == 1
    p.ph_lo = 0; p.ph_hi = 1 << 20;
    hipLaunchKernelGGL(k_mega, dim3(grid), dim3(512), MK_LDS, stream, p);
#else
    for (int ph = 0; ph < MK_NPHASES; ++ph) { p.ph_lo = ph; p.ph_hi = ph + 1; hipLaunchKernelGGL(k_mega, dim3(grid), dim3(512), MK_LDS, stream, p); }
#endif
}
```

```cpp
#include <hip/hip_runtime.h>
#include <stdint.h>
#include <stdio.h>

#define LAS __attribute__((address_space(3)))
typedef unsigned short bf16_t;
typedef float f32x4 __attribute__((ext_vector_type(4)));
typedef unsigned u32x4 __attribute__((ext_vector_type(4)));
typedef unsigned u32x2 __attribute__((ext_vector_type(2)));

static constexpr int NTOK = 32768, SEQ = 16384, NBATCH = 2, DM = 2048, DFF = 4096;
static constexpr float NORM_EPS = 1e-6f;

__device__ __forceinline__ bf16_t f2bf(float f) { unsigned u = __float_as_uint(f); u += 0x7FFFu + ((u >> 16) & 1u); return (bf16_t)(u >> 16); }
__device__ __forceinline__ float bf2f(bf16_t b) { return __uint_as_float(((unsigned)b) << 16); }
__device__ __forceinline__ unsigned pack2bf(float lo, float hi) { unsigned r; asm("v_cvt_pk_bf16_f32 %0, %1, %2" : "=v"(r) : "v"(lo), "v"(hi)); return r; }
__device__ __forceinline__ float gelu_tanh(float x) { const float u = 0.7978845608028654f * (x + 0.044715f * x * x * x); return 0.5f * x * (1.0f + tanhf(u)); }
__device__ __forceinline__ float wave_sum(float v) {
#pragma unroll
    for (int o = 32; o >= 1; o >>= 1) v += __shfl_xor(v, o);
    return v;
}

#ifndef TID_PLAIN
#define TID_PLAIN 0
#endif
static constexpr int TID_TAB_LDS = 162816 - 16 - 256;
#if TID_PLAIN
__device__ __forceinline__ int opaque_tid() { int t = (int)threadIdx.x; asm volatile("" : "+v"(t)); return t; }
#else
__device__ __forceinline__ int opaque_tid() {
    const unsigned slot = (unsigned)__builtin_amdgcn_s_getreg(((6 - 1) << 11) | 4) & 63u;
    const int w = __builtin_amdgcn_readfirstlane(*(const volatile LAS int*)(size_t)(TID_TAB_LDS + 4 * slot));
    int lane; asm volatile("v_mbcnt_lo_u32_b32 %0, -1, 0\n\tv_mbcnt_hi_u32_b32 %0, -1, %0" : "=v"(lane));
    return w * 64 + lane;
}
#endif

__device__ __forceinline__ int opaque_s(int v) { asm volatile("" : "+s"(v)); return v; }

template <class T> __device__ __forceinline__ const T* opaque_p(const T* p) { asm volatile("" : "+s"(p)); return p; }

#ifndef PG8_EPI_RECOMP
#define PG8_EPI_RECOMP 1
#endif
#ifndef PG8_ASM_DMA
#define PG8_ASM_DMA 1
#endif
#include <hip/hip_runtime.h>
namespace pg8 {
#define PG8_LAS __attribute__((address_space(3)))
typedef unsigned short bf16_t;
typedef short bf16x8 __attribute__((ext_vector_type(8)));
typedef float f32x4 __attribute__((ext_vector_type(4)));
typedef unsigned u32x4 __attribute__((ext_vector_type(4)));
typedef int i32x8 __attribute__((ext_vector_type(8)));
typedef int i32x4 __attribute__((ext_vector_type(4)));
constexpr int BM = 256, BK = 64, HALF = 128, HTB = HALF * BK * 2  , STAGE_BYTES = 8 * HTB, NXCD = 8, WGM = 8;

__host__ __device__ __forceinline__ int lds_byte(int r, int c) { const int st = (r >> 4) * 2 + (c >> 5), rr = r & 15, cc = c & 31, ob = rr * 64 + cc * 2; return st * 1024 + (ob ^ (((ob >> 9) & 1) << 5)); }
__host__ __device__ __forceinline__ void stage_rc(int b, int& R, int& C) { const int st = b / 1024, sb = b % 1024, swz = sb ^ (((sb >> 9) & 1) << 5); R = (st >> 1) * 16 + swz / 64; C = (st & 1) * 32 + (swz % 64) / 2; }
__host__ __device__ __forceinline__ int perm32(int rho) { const int n = rho >> 4, i = rho & 15; return 8 * (i >> 2) + 4 * n + (i & 3); }

struct Unit { int pm, pn; };
struct Gemm { const bf16_t* A; const bf16_t* Bt; int M, N, K, lda, ldb, a_shift, a_bytes, cmode; };

struct StaticOrder {
    int nM, nN, nwg, G, c;
    __host__ __device__ void init(int M, int N, int G_, int c_) { nM = M / BM; nN = N / BM; nwg = nM * nN; G = G_; c = c_; }
    __host__ __device__ bool next(int i, Unit& u) const {
        const long L = (long)i * G + c; if (L >= nwg) return false;
        int wgid = (int)L; { const int q = nwg / NXCD, r = nwg % NXCD, xcd = wgid % NXCD, off = wgid / NXCD; wgid = (xcd < r ? xcd * (q + 1) : r * (q + 1) + (xcd - r) * q) + off; }
        const int nig = WGM * nN, gid = wgid / nig, fm = gid * WGM, gsz = (nM - fm) < WGM ? (nM - fm) : WGM;
        u.pm = fm + ((wgid % nig) % gsz); u.pn = (wgid % nig) / gsz; return true;
    }
    __device__ __forceinline__ void a_ready(const Unit&) const {}
    __device__ __forceinline__ void done(const Unit&) const {}
};

template <class Epi, class Sched, bool STAMP = false>
__device__ __forceinline__ void gemm_phase(PG8_LAS unsigned char* lds, const Gemm g, const Sched& S, const Epi& E, unsigned long long* stamps) {
    const int tid = opaque_tid(), wid = __builtin_amdgcn_readfirstlane(tid >> 6), lane = tid & 63, wr = wid >> 2, wc = wid & 3, fr = lane & 15, fq = lane >> 4;
    const int K = g.K, nt = K / BK;
    int ts_lo = 0, ts_hi = 0, nts = 0; const unsigned long long rt_entry = STAMP ? (unsigned long long)wall_clock64() : 0ull;
#define PG8_STAMP() do { if (STAMP && wid == 0 && nts < 64) { const unsigned long long _c = (unsigned long long)clock64(); \
        ts_lo = (lane == nts) ? (int)(unsigned)_c : ts_lo; ts_hi = (lane == nts) ? (int)(unsigned)(_c >> 32) : ts_hi; ++nts; } } while (0)
    PG8_STAMP();
    unsigned voffA[2], voffB[2];
#pragma unroll
    for (int i = 0; i < 2; ++i) { int R, C; stage_rc(tid * 16 + i * 8192, R, C); const int Rb = Epi::PERM ? ((R & ~31) + perm32(R & 31)) : R;
        const int Ra = g.cmode ? (R - 2 * (R >> 6)) : R;
        voffA[i] = (unsigned)(Ra * g.lda + C) * 2u; voffB[i] = (unsigned)(Rb * g.ldb + C) * 2u; }
    const size_t kstep = (size_t)(BK * 2);
    const size_t hstepA = (size_t)(g.cmode ? HALF - 4 : HALF) * g.lda * 2, hstepB = (size_t)HALF * g.ldb * 2;
    const size_t tstepA = 2 * hstepA, tstepB = 2 * hstepB;
    const unsigned ldsbase_ = (unsigned)(size_t)lds;
    const int sc_w_ = 0x79797979, sc_a_ = 0x7F7F7F7F;
    (void)sc_w_; (void)sc_a_;
    const unsigned ldsw = (unsigned)wid * 1024u;
    const int aoff = lds_byte(wr * 64 + fr, fq * 8), boff = lds_byte(wc * 32 + fr, fq * 8);
#define PG8_SA(b, h) (((b) * 2 + (h)) * HTB)
#define PG8_SB(b, h) ((4 + (b) * 2 + (h)) * HTB)
#if PG8_ASM_DMA
#define PG8_STAGE(bufoff, gbase, voff) do { _Pragma("unroll") for (int _i = 0; _i < 2; ++_i) { unsigned keep_; \
        asm volatile("s_mov_b32 %0, m0\n\ts_mov_b32 m0, %3\n\ts_nop 0\n\tglobal_load_lds_dwordx4 %1, %2\n\ts_mov_b32 m0, %0" \
                     : "=&s"(keep_) : "v"((voff)[_i]), "s"((const char*)(gbase)), "s"(ldsbase_ + (unsigned)(bufoff) + ldsw + (unsigned)(_i * 8192)) : "memory"); } } while (0)
#else
#define PG8_STAGE(bufoff, gbase, voff) do { _Pragma("unroll") for (int _i = 0; _i < 2; ++_i) \
        __builtin_amdgcn_global_load_lds((const unsigned*)((const char*)(gbase) + (voff)[_i]), (PG8_LAS unsigned*)(lds + (bufoff) + ldsw + _i * 8192), 16, 0, 0); } while (0)
#endif
#define PG8_LDA(dst, b, h) do { _Pragma("unroll") for (int m = 0; m < 4; ++m) { dst[m].lo = *(const PG8_LAS i32x4*)(lds + PG8_SA(b, h) + aoff + m * 2048); dst[m].hi = *(const PG8_LAS i32x4*)(lds + PG8_SA(b, h) + aoff + m * 2048 + 1024); } } while (0)
#define PG8_LDB(dst, b, h) do { _Pragma("unroll") for (int n = 0; n < 2; ++n) { dst[n].lo = *(const PG8_LAS i32x4*)(lds + PG8_SB(b, h) + boff + n * 2048); dst[n].hi = *(const PG8_LAS i32x4*)(lds + PG8_SB(b, h) + boff + n * 2048 + 1024); } } while (0)
#define PG8_MMA(ai, bj, At, Bt) do { __builtin_amdgcn_s_setprio(1); \
        if constexpr (Epi::FP8) { _Pragma("unroll") for (int m = 0; m < 4; ++m) _Pragma("unroll") for (int n = 0; n < 2; ++n) \
            asm volatile("v_mfma_scale_f32_16x16x128_f8f6f4 %0, %1, %2, %0, %3, %4 op_sel_hi:[0,0,0]" : "+v"(acc[ai][bj][m][n]) : "v"(Bt[n]), "v"(At[m]), "v"(sc_w_), "v"(sc_a_)); } \
        else { _Pragma("unroll") for (int m = 0; m < 4; ++m) _Pragma("unroll") for (int n = 0; n < 2; ++n) { \
            const i32x4 bl_ = Bt[n].lo, bh_ = Bt[n].hi, al_ = At[m].lo, ah_ = At[m].hi;     \
            acc[ai][bj][m][n] = __builtin_amdgcn_mfma_f32_16x16x32_bf16(__builtin_bit_cast(bf16x8, bl_), __builtin_bit_cast(bf16x8, al_), acc[ai][bj][m][n], 0, 0, 0); \
            acc[ai][bj][m][n] = __builtin_amdgcn_mfma_f32_16x16x32_bf16(__builtin_bit_cast(bf16x8, bh_), __builtin_bit_cast(bf16x8, ah_), acc[ai][bj][m][n], 0, 0, 0); } } \
        __builtin_amdgcn_s_setprio(0); } while (0)
#define PG8_WAIT_V(n) asm volatile("s_waitcnt vmcnt(" #n ")" ::: "memory")
#define PG8_WAIT_L(n) asm volatile("s_waitcnt lgkmcnt(" #n ")" ::: "memory")
#define PG8_BAR __builtin_amdgcn_s_barrier()
#define PG8_SCHED __builtin_amdgcn_sched_barrier(0)
    Unit cur, nxt; int ui = 0;
    if (!S.next(0, cur)) return;
    f32x4 acc[2][2][4][2];
#pragma unroll
    for (int a = 0; a < 2; ++a)
#pragma unroll
        for (int b = 0; b < 2; ++b)
#pragma unroll
            for (int m = 0; m < 4; ++m)
#pragma unroll
                for (int n = 0; n < 2; ++n) acc[a][b][m][n] = (f32x4){0.f, 0.f, 0.f, 0.f};
    i32x8 At[4], B0[2], B1[2];
    auto a_base_ = [&](const Unit& u_) -> const char* { return g.cmode ? (const char*)g.A + ((long)(u_.pm / 67) * 16384 + (long)(u_.pm % 67) * 248 - 2) * (long)g.lda * 2 : (const char*)g.A + (size_t)u_.pm * tstepA + (size_t)(u_.pn >> g.a_shift) * g.a_bytes; };
    const char* cA = a_base_(cur); const char* cB = (const char*)g.Bt + (size_t)cur.pn * tstepB;
    S.a_ready(cur);
    PG8_STAGE(PG8_SB(0, 0), cB, voffB); PG8_STAGE(PG8_SA(0, 0), cA, voffA); PG8_STAGE(PG8_SB(0, 1), cB + hstepB, voffB); PG8_STAGE(PG8_SA(0, 1), cA + hstepA, voffA);
    if (wr == 1) PG8_BAR;
    PG8_WAIT_V(4); PG8_BAR;
    PG8_STAGE(PG8_SB(1, 0), cB + kstep, voffB); PG8_STAGE(PG8_SA(1, 0), cA + kstep, voffA); PG8_STAGE(PG8_SB(1, 1), cB + hstepB + kstep, voffB);
    PG8_WAIT_V(6); PG8_BAR;
    PG8_STAMP();
    for (;;) {
        const bool has_next = S.next(ui + 1, nxt);
        const char* nA = has_next ? a_base_(nxt) : cA; const char* nB = has_next ? (const char*)g.Bt + (size_t)nxt.pn * tstepB : cB;
        for (int t = 0; t < nt; t += 2) {
            const bool last = (t == nt - 2);
            const char* a1 = cA + (size_t)(t + 1) * kstep;
            const char* a2 = last ? nA : cA + (size_t)(t + 2) * kstep; const char* b2 = last ? nB : cB + (size_t)(t + 2) * kstep;
            const char* a3 = a2 + kstep; const char* b3 = b2 + kstep;
            if (last && has_next) S.a_ready(nxt);
            PG8_LDB(B0, 0, 0); PG8_SCHED; PG8_LDA(At, 0, 0); PG8_STAGE(PG8_SA(1, 1), a1 + hstepA, voffA);
            PG8_WAIT_L(8); PG8_BAR; PG8_WAIT_L(0); PG8_MMA(0, 0, At, B0); PG8_BAR; PG8_SCHED;
            PG8_LDB(B1, 0, 1); PG8_STAGE(PG8_SB(0, 0), b2, voffB);
            PG8_BAR; PG8_WAIT_L(0); PG8_MMA(0, 1, At, B1); PG8_BAR;
            PG8_LDA(At, 0, 1); PG8_STAGE(PG8_SA(0, 0), a2, voffA);
            PG8_BAR; PG8_WAIT_L(0); PG8_MMA(1, 0, At, B0); PG8_BAR; PG8_SCHED;
            PG8_STAGE(PG8_SB(0, 1), b2 + hstepB, voffB);
            PG8_WAIT_V(6); PG8_BAR; PG8_MMA(1, 1, At, B1); PG8_BAR;
            PG8_LDB(B0, 1, 0); PG8_SCHED; PG8_LDA(At, 1, 0); PG8_STAGE(PG8_SA(0, 1), a2 + hstepA, voffA);
            PG8_WAIT_L(8); PG8_BAR; PG8_WAIT_L(0); PG8_MMA(0, 0, At, B0); PG8_BAR; PG8_SCHED;
            PG8_LDB(B1, 1, 1); PG8_STAGE(PG8_SB(1, 0), b3, voffB);
            PG8_BAR; PG8_WAIT_L(0); PG8_MMA(0, 1, At, B1); PG8_BAR;
            PG8_LDA(At, 1, 1); PG8_STAGE(PG8_SA(1, 0), a3, voffA);
            PG8_BAR; PG8_WAIT_L(0); PG8_MMA(1, 0, At, B0); PG8_BAR; PG8_SCHED;
            PG8_STAGE(PG8_SB(1, 1), b3 + hstepB, voffB);
            PG8_WAIT_V(6); PG8_BAR; PG8_MMA(1, 1, At, B1); PG8_BAR;
        }
        PG8_STAMP();
        if constexpr (Epi::FP8) { asm volatile("s_nop 15\n\ts_nop 15" ::: "memory"); }
        if constexpr (!Epi::AFTER_DRAIN) {
#if PG8_EPI_RECOMP
            const int t2_ = opaque_tid(), l2_ = t2_ & 63, w2_ = __builtin_amdgcn_readfirstlane(t2_ >> 6);
            E(acc, cur, w2_ >> 2, w2_ & 3, l2_ & 15, l2_ >> 4); S.done(cur);
#else
            E(acc, cur, wr, wc, fr, fq); S.done(cur);
#endif
        }
        PG8_STAMP();
        if (!has_next) break;
#pragma unroll
        for (int a = 0; a < 2; ++a)
#pragma unroll
            for (int b = 0; b < 2; ++b)
#pragma unroll
                for (int m = 0; m < 4; ++m)
#pragma unroll
                    for (int n = 0; n < 2; ++n) acc[a][b][m][n] = (f32x4){0.f, 0.f, 0.f, 0.f};
        cur = nxt; cA = nA; cB = nB; ++ui;
    }
    PG8_WAIT_V(0);
    if (wr == 0) PG8_BAR;
    PG8_BAR;
    if constexpr (Epi::AFTER_DRAIN) { E.fused(acc, cur, wr, wc, fr, fq, lds, wid, lane); S.done(cur); }
    PG8_STAMP();
    if (STAMP && wid == 0) { stamps[lane] = lane < nts ? (((unsigned long long)(unsigned)ts_hi << 32) | (unsigned)ts_lo) : 0ull;
        if (lane == 62) stamps[62] = rt_entry; if (lane == 63) stamps[63] = (unsigned long long)wall_clock64(); }
#undef PG8_STAMP
#undef PG8_SA
#undef PG8_SB
#undef PG8_STAGE
#undef PG8_LDA
#undef PG8_LDB
#undef PG8_MMA
#undef PG8_WAIT_V
#undef PG8_WAIT_L
#undef PG8_BAR
#undef PG8_SCHED
}
}

#include <cstdio>
#include <ctime>
#include <cstdlib>
#include <cstring>
#include <cmath>
#include <vector>

template <class F, bool F8 = false> struct EpiG {
    static constexpr bool PERM = false, AFTER_DRAIN = false, FP8 = F8;
    F f;
    __device__ __forceinline__ void operator()(const f32x4 (&acc)[2][2][4][2], const pg8::Unit& u, int wr, int wc, int fr, int fq) const {
        const int row0 = u.pm * 256 + wr * 64 + fr, col0 = u.pn * 256 + wc * 32 + 4 * fq;
#pragma unroll
        for (int ai = 0; ai < 2; ++ai)
#pragma unroll
            for (int m = 0; m < 4; ++m)
#pragma unroll
                for (int bj = 0; bj < 2; ++bj)
#pragma unroll
                    for (int n = 0; n < 2; ++n) f(row0 + ai * 128 + m * 16, col0 + bj * 128 + n * 16, acc[ai][bj][m][n]);
    }
};
__device__ __forceinline__ void st_bf16x4(bf16_t* p, f32x4 v) { u32x2 w; w.x = pack2bf(v[0], v[1]); w.y = pack2bf(v[2], v[3]); *(u32x2*)p = w; }
__device__ __forceinline__ void st_f32x4(float* p, f32x4 v) { *(f32x4*)p = v; }

struct FStoreBf16 { bf16_t* O; int ldc; int pad_; __device__ __forceinline__ void operator()(int r, int c, f32x4 v) const { st_bf16x4(O + (size_t)r * ldc + c, v); } };
struct FAbIn { bf16_t *Q, *K, *V; float *QI, *U, *WI; unsigned short* KI16;
    __device__ __forceinline__ void operator()(int r, int c, f32x4 v) const {
        if (c < 1024) st_bf16x4(Q + (size_t)r * 1024 + c, v);
        else if (c < 2048) st_bf16x4(K + (size_t)r * 1024 + (c - 1024), v);
        else if (c < 3072) st_bf16x4(V + (size_t)r * 1024 + (c - 2048), v);
        else if (c < 4096) st_f32x4(QI + (size_t)r * 1024 + (c - 3072), v);
        else if (c < 5120) st_f32x4(U + (size_t)r * 1024 + (c - 4096), v);
        else if (c < 5184) { typedef _Float16 h2 __attribute__((ext_vector_type(2))); union { h2 h; unsigned u; } a, b; a.h = (h2){(_Float16)v[0], (_Float16)v[1]}; b.h = (h2){(_Float16)v[2], (_Float16)v[3]};
            u32x2 w; w.x = a.u; w.y = b.u; *(u32x2*)(KI16 + (size_t)r * 64 + (c - 5120)) = w; }
        else if (c < 5200) st_f32x4(WI + (size_t)r * 16 + (c - 5184), v);
    } };
struct FCdIn { float *CQ, *CKV, *KR; bf16_t *XL, *YG;
    __device__ __forceinline__ void operator()(int r, int c, f32x4 v) const {
        if (c < 512) st_f32x4(CQ + (size_t)r * 512 + c, v);
        else if (c < 768) st_f32x4(CKV + (size_t)r * 256 + (c - 512), v);
        else if (c < 832) st_f32x4(KR + (size_t)r * 64 + (c - 768), v);
        else if (c < 1024) {}
        else if (c < 2048) st_bf16x4(XL + (size_t)r * 1024 + (c - 1024), v);
        else st_bf16x4(YG + (size_t)r * 1024 + (c - 2048), v);
    } };
struct FKvUp { bf16_t *K1, *V1;
    __device__ __forceinline__ void operator()(int r, int c, f32x4 v) const {
        const int h = c >> 8, d = c & 255;
        if (d < 128) st_bf16x4(K1 + (size_t)r * 1536 + h * 192 + d, v);
        else st_bf16x4(V1 + (size_t)r * 1024 + h * 128 + (d - 128), v);
    } };

__device__ __forceinline__ unsigned ord_key(float f) { const unsigned b = __float_as_uint(f); return (b & 0x80000000u) ? ~b : (b | 0x80000000u); }
__device__ __forceinline__ void rope_cs(int pos, int i, float& c, float& s) { const float freq = powf(10000.0f, -(float)i / 32.0f); const float ang = (float)pos * freq; sincosf(ang, &s, &c); }
#define PV8_MLA 1
#define PV8_DSA 1

typedef short bf16x8 __attribute__((ext_vector_type(8)));
typedef float f32x16 __attribute__((ext_vector_type(16)));
__device__ __forceinline__ unsigned cvtpk(float lo, float hi) { unsigned r; asm("v_cvt_pk_bf16_f32 %0, %1, %2" : "=v"(r) : "v"(lo), "v"(hi)); return r; }
__device__ __forceinline__ float max3_asm(float a, float b, float c) { float r; asm("v_max3_f32 %0, %1, %2, %3" : "=v"(r) : "v"(a), "v"(b), "v"(c)); return r; }

struct AttnArgs { const bf16_t* Q; const bf16_t* K; const bf16_t* VT; const unsigned long long* MT; bf16_t* O; int ldq, ldk, ldo; float sc_log2e; };

static constexpr int ATT_MTBL = 65536;
struct TTrue { static constexpr bool value = true; }; struct TFalse { static constexpr bool value = false; };
typedef int i32x8q __attribute__((ext_vector_type(8)));
typedef int i32x4q __attribute__((ext_vector_type(4)));
#define MFMA8_FENCE2(acc0, acc1, srcA, srcB) asm volatile("s_nop 15\n\ts_nop 9" : "+v"(acc0), "+v"(acc1) : "v"(srcA), "v"(srcB))
#define MFMA8_FENCE4(a0_, a1_, a2_, a3_, srcA, srcB) asm volatile("s_nop 15\n\ts_nop 9" : "+v"(a0_), "+v"(a1_), "+v"(a2_), "+v"(a3_) : "v"(srcA), "v"(srcB))
template <int DQK, bool MASKED, bool QK8>
__device__ __forceinline__ void attn_item3(LAS unsigned char* lds, const AttnArgs& a, int b, int h, int qb) {
    constexpr int NKS = QK8 ? DQK / 64 : DQK / 16, PK = QK8 ? DQK : DQK * 2, PV = 64, KB_BYTES = 64 * PK, VB_BYTES = 128 * PV, NPK = PK / 16, NKP = (64 * NPK + 511) / 512, V_OFF = 3 * KB_BYTES;
    const int tid = opaque_tid(), lane = tid & 63, w = __builtin_amdgcn_readfirstlane(tid >> 6), n = lane & 31, hf = lane >> 5;
    const int nt = 4 * qb + 4, cw = 4 * qb + (w >> 1);
    const int trow = qb * 256 + w * 32 + n;
    const size_t grow = (size_t)b * SEQ + trow;
    bf16x8 qf[QK8 ? 1 : NKS]; i32x8q q8[QK8 ? NKS : 1];
    if (QK8) { const unsigned char* qp = (const unsigned char*)a.Q + grow * a.ldq + h * DQK + hf * 32;
#pragma unroll
      for (int ks = 0; ks < NKS; ++ks) { q8[ks].lo = *(const i32x4q*)(qp + ks * 64); q8[ks].hi = *(const i32x4q*)(qp + ks * 64 + 16); } }
    else { const bf16_t* qp = a.Q + grow * a.ldq + h * DQK + hf * 8;
#pragma unroll
      for (int ks = 0; ks < NKS; ++ks) qf[ks] = *(const bf16x8*)(qp + ks * 16); }
    f32x16 o[4];
#pragma unroll
    for (int dt = 0; dt < 4; ++dt)
#pragma unroll
        for (int r = 0; r < 16; ++r) o[dt][r] = 0.f;
    float m_run = MASKED ? -1000.0f : -INFINITY, l_run = 0.f;
    const float c = a.sc_log2e;
    const unsigned char* Kg = (const unsigned char*)a.K + ((size_t)b * SEQ * a.ldk + h * DQK) * (QK8 ? 1 : 2);
    const unsigned char* Vg = (const unsigned char*)a.VT + (size_t)(b * 8 + h) * 128 * SEQ;
    const unsigned long long* Mg = MASKED ? a.MT + (size_t)b * 256 * SEQ + trow : nullptr;
    auto dma_k = [&](int kt) {
        LAS unsigned char* kb = lds + (kt % 3) * KB_BYTES;
#pragma unroll
        for (int i = 0; i < NKP; ++i) { if ((w + 8 * i) * 64 >= 64 * NPK) break;
            const int s = (w + 8 * i) * 64 + lane, r = s / NPK, cp = s % NPK, cc = cp ^ (NPK == 16 ? (r & 15) : (NPK == 12 ? ((r >> 2) & 3) : ((r >> 1) & 7)));
            __builtin_amdgcn_global_load_lds((const unsigned*)(Kg + ((size_t)(kt * 64 + r) * a.ldk) * (QK8 ? 1 : 2) + cc * 16), (LAS unsigned*)(kb + (w + 8 * i) * 1024), 16, 0, 0); }
    };
    auto dma_v = [&](int kt) {
        LAS unsigned char* vb = lds + V_OFF + (kt & 1) * VB_BYTES;
        const int s = w * 64 + lane, d = s >> 2, cp = s & 3, cc = cp ^ ((d >> 2) & 3);
        __builtin_amdgcn_global_load_lds((const unsigned*)(Vg + (size_t)d * SEQ + kt * 64 + cc * 16), (LAS unsigned*)(vb + w * 1024), 16, 0, 0);
    };
    const int kswz = (NPK == 16) ? (n & 15) : (NPK == 12 ? ((n >> 2) & 3) : ((n >> 1) & 7)), vswz = (n >> 2) & 3;
    auto qk = [&](int kt, f32x16& s0, f32x16& s1, bool fence) {
        const LAS unsigned char* ka = lds + (kt % 3) * KB_BYTES + n * PK;
#pragma unroll
        for (int r = 0; r < 16; ++r) { s0[r] = 0.f; s1[r] = 0.f; }
        if (QK8) {
#pragma unroll
            for (int ks = 0; ks < NKS; ++ks) {
                const int p0 = ((4 * ks + 2 * hf) ^ kswz) * 16, p1 = ((4 * ks + 2 * hf + 1) ^ kswz) * 16;
                i32x8q a0, a1;
                a0.lo = *(const LAS i32x4q*)(ka + p0); a0.hi = *(const LAS i32x4q*)(ka + p1);
                a1.lo = *(const LAS i32x4q*)(ka + 32 * PK + p0); a1.hi = *(const LAS i32x4q*)(ka + 32 * PK + p1);
                s0 = __builtin_amdgcn_mfma_scale_f32_32x32x64_f8f6f4(a0, q8[ks], s0, 0, 0, 0, 0x7F7F7F7F, 0, 0x7F7F7F7F);
                s1 = __builtin_amdgcn_mfma_scale_f32_32x32x64_f8f6f4(a1, q8[ks], s1, 0, 0, 0, 0x7F7F7F7F, 0, 0x7F7F7F7F);
                if (ks == NKS - 1 && fence) MFMA8_FENCE2(s0, s1, a0, a1);
            }
        } else {
#pragma unroll
            for (int ks = 0; ks < NKS; ++ks) {
                const int po = ((2 * ks + hf) ^ kswz) * 16;
                const bf16x8 a0 = *(const LAS bf16x8*)(ka + po), a1 = *(const LAS bf16x8*)(ka + 32 * PK + po);
                s0 = __builtin_amdgcn_mfma_f32_32x32x16_bf16(a0, qf[ks], s0, 0, 0, 0);
                s1 = __builtin_amdgcn_mfma_f32_32x32x16_bf16(a1, qf[ks], s1, 0, 0, 0);
            }
        }
    };
    i32x8q idA0, idA1;
#pragma unroll
    for (int i = 0; i < 8; ++i) { const int v = (i == (n >> 2)) ? (0x38 << (8 * (n & 3))) : 0; idA0[i] = hf ? 0 : v; idA1[i] = hf ? v : 0; }
    auto maskmma = [&](unsigned long long mw, f32x16& s0, f32x16& s1, bool fence) {
        if (MASKED) {
            const unsigned bits = hf ? (unsigned)(mw >> 32) : (unsigned)mw;
            const LAS u32x2* tbl = (const LAS u32x2*)(lds + ATT_MTBL);
            i32x8q bm;
#pragma unroll
            for (int i = 0; i < 4; ++i) { const u32x2 t = tbl[(bits >> (8 * i)) & 255u]; bm[2 * i] = (int)t.x; bm[2 * i + 1] = (int)t.y; }
            s0 = __builtin_amdgcn_mfma_scale_f32_32x32x64_f8f6f4(idA0, bm, s0, 0, 0, 0, 0x7F7F7F7F, 0, (int)0x82828282);
            s1 = __builtin_amdgcn_mfma_scale_f32_32x32x64_f8f6f4(idA1, bm, s1, 0, 0, 0, 0x7F7F7F7F, 0, (int)0x82828282);
            MFMA8_FENCE2(s0, s1, idA1, bm);
        }
    };
    auto rowmax = [&](f32x16& s0, f32x16& s1) -> float {
        float mx = max3_asm(s0[0], s1[0], s0[1]);
        mx = max3_asm(mx, s1[1], s0[2]);
#pragma unroll
        for (int r = 2; r < 15; ++r) mx = max3_asm(mx, s1[r], s0[r + 1]);
        mx = max3_asm(mx, s1[15], mx);
        const auto rr = __builtin_amdgcn_permlane32_swap(__float_as_uint(mx), __float_as_uint(mx), false, false);
        return fmaxf(__uint_as_float(rr[0]), __uint_as_float(rr[1]));
    };
    auto pv = [&](const f32x16& c0, const f32x16& c1, int kt, bool fence) {
        i32x8q pb;
#pragma unroll
        for (int i = 0; i < 4; ++i) { int d0 = 0, d1 = 0;
            d0 = __builtin_amdgcn_cvt_pk_fp8_f32(c0[4 * i], c0[4 * i + 1], d0, false); d0 = __builtin_amdgcn_cvt_pk_fp8_f32(c0[4 * i + 2], c0[4 * i + 3], d0, true);
            d1 = __builtin_amdgcn_cvt_pk_fp8_f32(c1[4 * i], c1[4 * i + 1], d1, false); d1 = __builtin_amdgcn_cvt_pk_fp8_f32(c1[4 * i + 2], c1[4 * i + 3], d1, true);
            pb[i] = d0; pb[4 + i] = d1; }
        const LAS unsigned char* va = lds + V_OFF + (kt & 1) * VB_BYTES + n * PV;
        const int q0_ = ((2 * hf) ^ vswz) * 16, q1_ = ((2 * hf + 1) ^ vswz) * 16;
#pragma unroll
        for (int dt = 0; dt < 4; ++dt) { i32x8q vf; vf.lo = *(const LAS i32x4q*)(va + dt * 32 * PV + q0_); vf.hi = *(const LAS i32x4q*)(va + dt * 32 * PV + q1_);
            o[dt] = __builtin_amdgcn_mfma_scale_f32_32x32x64_f8f6f4(vf, pb, o[dt], 0, 0, 0, 0x7F7F7F7F, 0, 0x79797979);
            if (dt == 3) MFMA8_FENCE4(o[0], o[1], o[2], o[3], vf, pb); }
    };
    dma_k(0); dma_v(0); if (nt > 1) dma_k(1);
    unsigned long long mw_pre = MASKED ? Mg[(size_t)(nt > 1 ? 1 : 0) * SEQ] : 0ull;
    asm volatile("s_waitcnt vmcnt(0)" ::: "memory");
    __syncthreads();
    f32x16 sa0, sa1, sb0, sb1;
    qk(0, sa0, sa1, true); maskmma(MASKED ? Mg[0] : 0ull, sa0, sa1, true);
    float mx_cur = rowmax(sa0, sa1);
    auto step = [&](int kt, f32x16& c0, f32x16& c1, f32x16& n0, f32x16& n1, auto full_tag) {
        constexpr bool FULL = decltype(full_tag)::value;
        if (kt + 2 < nt) dma_k(kt + 2);
        if (kt + 1 < nt) dma_v(kt + 1);
        const unsigned long long mw_now = mw_pre;
        if (MASKED) mw_pre = Mg[(size_t)(kt + 2 < nt ? kt + 2 : kt) * SEQ];
        const bool act = FULL || kt <= cw, actn = FULL || kt + 1 <= cw;
        const float m_new = fmaxf(m_run, mx_cur);
        const float m_use = (MASKED && m_new == -INFINITY) ? 0.f : m_new;
        if (act && __any(m_new > m_run)) {
            const float al = __builtin_amdgcn_exp2f((m_run - m_use) * c);
            l_run *= al;
#pragma unroll
            for (int dt = 0; dt < 4; ++dt)
#pragma unroll
                for (int r = 0; r < 16; ++r) o[dt][r] *= al;
        }
        if (act) m_run = m_new;
        if (FULL) {
            qk(kt + 1, n0, n1, !MASKED); maskmma(mw_now, n0, n1, true);
            const float mc = m_use * c - 6.0f;
            float ps = 0.f;
#pragma unroll
            for (int r = 0; r < 16; ++r) { c0[r] = __builtin_amdgcn_exp2f(fmaf(c0[r], c, -mc)); c1[r] = __builtin_amdgcn_exp2f(fmaf(c1[r], c, -mc)); ps += c0[r] + c1[r]; }
            l_run += ps;
            pv(c0, c1, kt, true);
            mx_cur = rowmax(n0, n1);
        } else {
            if (actn) { qk(kt + 1, n0, n1, true); maskmma(mw_now, n0, n1, true); }
            if (act) {
                const float mc = m_use * c - 6.0f;
                float ps = 0.f;
#pragma unroll
                for (int r = 0; r < 16; ++r) { c0[r] = __builtin_amdgcn_exp2f(fmaf(c0[r], c, -mc)); c1[r] = __builtin_amdgcn_exp2f(fmaf(c1[r], c, -mc)); ps += c0[r] + c1[r]; }
                l_run += ps;
                pv(c0, c1, kt, true);
            }
            if (actn) mx_cur = rowmax(n0, n1);
        }
        asm volatile("s_waitcnt vmcnt(0)" ::: "memory");
        __syncthreads();
    };
    int kt = 0;
    for (; kt < 4 * qb; kt += 2) { step(kt, sa0, sa1, sb0, sb1, TTrue{}); step(kt + 1, sb0, sb1, sa0, sa1, TTrue{}); }
    for (; kt < nt; kt += 2) { step(kt, sa0, sa1, sb0, sb1, TFalse{}); step(kt + 1, sb0, sb1, sa0, sa1, TFalse{}); }
    const float lt = l_run + __shfl_xor(l_run, 32);
    const float inv = 64.0f / lt;
    bf16_t* op = a.O + grow * a.ldo + h * 128 + hf * 4;
#pragma unroll
    for (int dt = 0; dt < 4; ++dt)
#pragma unroll
        for (int r4 = 0; r4 < 4; ++r4) { u32x2 wv; wv.x = cvtpk(o[dt][4 * r4] * inv, o[dt][4 * r4 + 1] * inv); wv.y = cvtpk(o[dt][4 * r4 + 2] * inv, o[dt][4 * r4 + 3] * inv);
            *(u32x2*)(op + dt * 32 + r4 * 8) = wv; }
}
template <int DQK, bool MASKED>
__device__ __forceinline__ void attn_phase(LAS unsigned char* lds, const AttnArgs& a, int bid, int nblk) {
    if (MASKED) {
        const int t = opaque_tid();
        if (t < 256) { unsigned lo = 0u, hi = 0u;
#pragma unroll
            for (int i = 0; i < 4; ++i) { if (!((t >> i) & 1)) lo |= 0xFEu << (8 * i); if (!((t >> (4 + i)) & 1)) hi |= 0xFEu << (8 * i); }
            u32x2 v; v.x = lo; v.y = hi; ((LAS u32x2*)(lds + ATT_MTBL))[t] = v; }
        __syncthreads();
    }
    for (int p = bid; p < 512; p += nblk) {
        const int bh = (p & 7) + 8 * (p >> 8), j = (p >> 3) & 31;
#pragma unroll 1
        for (int i = 0; i < 2; ++i) attn_item3<DQK, MASKED, true>(lds, a, bh >> 3, bh & 7, i ? j : 63 - j);
    }
}

#ifdef IDX_PROBE_FINAL
#define IDX_PF_ 1
#else
#define IDX_PF_ 0
#endif
typedef _Float16 f16x8 __attribute__((ext_vector_type(8)));
struct IdxArgs { const float* QI; const unsigned short* KI16; const float* WI; unsigned long long* MT; };
static constexpr int IDX_CAP = 640, IDX_CS = 0, IDX_CI = 32 * IDX_CAP * 4, IDX_KT = IDX_CI + 32 * IDX_CAP * 2, IDX_CNT = IDX_KT + 32768, IDX_TAU = IDX_CNT + 128, IDX_LDS = IDX_TAU + 128;
static_assert(IDX_KT % 1024 == 0, "K tile buffers must be 1 KiB aligned");

__device__ __forceinline__ float ord_inv(unsigned T) { return __uint_as_float((T & 0x80000000u) ? (T & 0x7FFFFFFFu) : ~T); }
__device__ __forceinline__ unsigned lane_prefix(unsigned long long m) { return __builtin_amdgcn_mbcnt_hi((unsigned)(m >> 32), __builtin_amdgcn_mbcnt_lo((unsigned)m, 0u)); }
__device__ __forceinline__ float relu_asm(float x) { float y; asm("v_max_f32 %0, 0, %1" : "=v"(y) : "v"(x)); return y; }
__device__ __forceinline__ void glds16(const void* gsrc, unsigned lds_dst) {
    unsigned keep;
    asm volatile("s_mov_b32 %0, m0\n\ts_mov_b32 m0, %2\n\ts_nop 0\n\tglobal_load_lds_dwordx4 %1, off\n\ts_mov_b32 m0, %0" : "=&s"(keep) : "v"(gsrc), "s"(lds_dst) : "memory");
}

template <bool EXACT> __device__ __forceinline__ int idx_compact(LAS unsigned char* lds, int qq, int lane, int n, float& tau) {
    LAS float* cs = (LAS float*)(lds + IDX_CS) + qq * IDX_CAP; LAS unsigned short* ci = (LAS unsigned short*)(lds + IDX_CI) + qq * IDX_CAP;
    float sv[10]; unsigned short iv[10]; unsigned uk[10];
#pragma unroll
    for (int j = 0; j < 10; ++j) { const int idx = lane + 64 * j; const bool valid = idx < n; sv[j] = cs[idx]; iv[j] = ci[idx]; uk[j] = valid ? ord_key(sv[j]) : 0u; }
    auto count_ge = [&](unsigned t) { int c = 0;
#pragma unroll
        for (int j = 0; j < 10; ++j) c += __builtin_popcountll(__ballot(uk[j] >= t));
        return c; };
    unsigned lo = ord_key(tau), hi = 0xFF800001u;
    if (lo > 0x80800000u) { const unsigned h2 = lo + 0x00800000u;
        if (h2 < hi) { if (count_ge(h2) >= 256) lo = h2; else hi = h2; } }
    while (hi - lo > 1u) {
        const unsigned mid = lo + ((hi - lo) >> 1); const int c = count_ge(mid);
        if (c >= 256) { lo = mid; if (EXACT ? (c == 256) : (c <= 336)) break; } else hi = mid;
    }
    const unsigned T = lo;
    int need = 0;
    if (EXACT) { int ngt = 0;
#pragma unroll
        for (int j = 0; j < 10; ++j) ngt += __builtin_popcountll(__ballot(uk[j] > T));
        need = 256 - ngt; }
    int base = 0, tiebase = 0;
#pragma unroll
    for (int j = 0; j < 10; ++j) {
        bool keep;
        if (EXACT) { const bool gt = uk[j] > T, eq = uk[j] == T; const unsigned long long em = __ballot(eq); keep = gt || (eq && (tiebase + (int)lane_prefix(em)) < need); tiebase += __builtin_popcountll(em); }
        else keep = uk[j] >= T;
        const unsigned long long km = __ballot(keep);
        const int pos = base + (int)lane_prefix(km);
        if (keep) { cs[pos] = sv[j]; ci[pos] = iv[j]; }
        base += __builtin_popcountll(km);
    }
    tau = ord_inv(T);
    return base;
}

__device__ __forceinline__ void idx_item(LAS unsigned char* lds, const IdxArgs& a, int b, int hc) {
    const int tid = opaque_tid(), lane = tid & 63, w = __builtin_amdgcn_readfirstlane(tid >> 6), n = lane & 31, hf = lane >> 5;
    const int t0 = hc * 32, L = (t0 / 64 + 1) * 64, nsub = L / 32, ntile = (L + 127) / 128;
    const size_t q0 = (size_t)b * SEQ + t0 + 4 * w;
    LAS float* cs = (LAS float*)(lds + IDX_CS); LAS unsigned short* ci = (LAS unsigned short*)(lds + IDX_CI);
    LAS unsigned* cnt = (LAS unsigned*)(lds + IDX_CNT);
    f16x8 qf[2][4];
#pragma unroll
    for (int rt = 0; rt < 2; ++rt) { const float* qp = a.QI + (q0 + 2 * rt + (n >> 4)) * 1024 + (n & 15) * 64 + hf * 8;
#pragma unroll
        for (int ks = 0; ks < 4; ++ks) { const f32x4 x0 = *(const f32x4*)(qp + ks * 16), x1 = *(const f32x4*)(qp + ks * 16 + 4);
            f16x8 v; v[0] = (_Float16)x0[0]; v[1] = (_Float16)x0[1]; v[2] = (_Float16)x0[2]; v[3] = (_Float16)x0[3]; v[4] = (_Float16)x1[0]; v[5] = (_Float16)x1[1]; v[6] = (_Float16)x1[2]; v[7] = (_Float16)x1[3];
            qf[rt][ks] = v; } }
    float wv[2][16];
#pragma unroll
    for (int rt = 0; rt < 2; ++rt)
#pragma unroll
        for (int r = 0; r < 16; ++r) wv[rt][r] = a.WI[(q0 + 2 * rt + (r >> 3)) * 16 + (((r & 3) + 8 * (r >> 2) + 4 * hf) & 15)] * (0.125f * 0.25f);
    if (tid < 32) cnt[tid] = 0u;
    int cq0 = 0, cq1 = 0, cq2 = 0, cq3 = 0;
    float tq0 = -INFINITY, tq1 = -INFINITY, tq2 = -INFINITY, tq3 = -INFINITY;
    float tau0 = INFINITY, tau1 = INFINITY;
    const unsigned short* Kg = a.KI16 + (size_t)b * SEQ * 64;
    const unsigned ldsbase = (unsigned)(size_t)lds;
    auto dma = [&](int kt, int buf) {
#pragma unroll
        for (int i = 0; i < 2; ++i) { const int s = (w + 8 * i) * 64 + lane, r = s >> 3, cp = s & 7, cc = cp ^ ((r >> 1) & 7);
            glds16(Kg + (size_t)(kt * 128 + r) * 64 + cc * 8, ldsbase + IDX_KT + buf * 16384 + (w + 8 * i) * 1024); }
    };
    dma(0, 0);
    asm volatile("s_waitcnt vmcnt(0)" ::: "memory");
    __syncthreads();
    const int kswz = (n >> 1) & 7;
    f32x16 accA[2], accB[2];
#pragma unroll
    for (int rt = 0; rt < 2; ++rt)
#pragma unroll
        for (int r = 0; r < 16; ++r) { accA[rt][r] = 0.f; accB[rt][r] = 0.f; }
    int keyA = 0, keyB = 0;
    auto epilogue = [&](const f32x16 (&acc)[2], int key) {
        float sc[2];
#pragma unroll
        for (int rt = 0; rt < 2; ++rt) { float pa = 0.f, pb = 0.f;
#pragma unroll
            for (int r = 0; r < 8; ++r) { pa = fmaf(relu_asm(acc[rt][r]), wv[rt][r], pa); pb = fmaf(relu_asm(acc[rt][r + 8]), wv[rt][r + 8], pb); }
            const auto rr = __builtin_amdgcn_permlane32_swap(__float_as_uint(pa), __float_as_uint(pb), false, false);
            sc[rt] = __uint_as_float(rr[0]) + __uint_as_float(rr[1]); }
        const bool c0 = sc[0] > tau0, c1 = sc[1] > tau1;
        const unsigned long long m0 = __ballot(c0), m1 = __ballot(c1);
        if (m0 | m1) {
            const unsigned l0 = (unsigned)m0, h0 = (unsigned)(m0 >> 32), l1 = (unsigned)m1, h1 = (unsigned)(m1 >> 32);
            const int p0 = hf ? cq1 + (int)__builtin_amdgcn_mbcnt_hi(h0, 0u) : cq0 + (int)__builtin_amdgcn_mbcnt_lo(l0, 0u);
            const int p1 = hf ? cq3 + (int)__builtin_amdgcn_mbcnt_hi(h1, 0u) : cq2 + (int)__builtin_amdgcn_mbcnt_lo(l1, 0u);
            if (c0 && p0 < IDX_CAP) { const int qq = 4 * w + hf; cs[qq * IDX_CAP + p0] = sc[0]; ci[qq * IDX_CAP + p0] = (unsigned short)key; }
            if (c1 && p1 < IDX_CAP) { const int qq = 4 * w + 2 + hf; cs[qq * IDX_CAP + p1] = sc[1]; ci[qq * IDX_CAP + p1] = (unsigned short)key; }
            cq0 += __builtin_popcount(l0); cq1 += __builtin_popcount(h0); cq2 += __builtin_popcount(l1); cq3 += __builtin_popcount(h1);
        }
    };
    f16x8 kfA[4], kfB[4];
    auto ldk = [&](f16x8 (&kf)[4], const LAS unsigned char* kr) {
#pragma unroll
        for (int ks = 0; ks < 4; ++ks) kf[ks] = *(const LAS f16x8*)(kr + ((2 * ks + hf) ^ kswz) * 16);
    };
    auto mma = [&](f32x16 (&acc)[2], const f16x8 (&kf)[4]) {
#pragma unroll
        for (int rt = 0; rt < 2; ++rt) {
            f32x16 c;
#pragma unroll
            for (int r = 0; r < 16; ++r) c[r] = 0.f;
#pragma unroll
            for (int ks = 0; ks < 4; ++ks) c = __builtin_amdgcn_mfma_f32_32x32x16_f16(qf[rt][ks], kf[ks], c, 0, 0, 0);
            acc[rt] = c; }
    };
#ifdef IDX_PROBE2
  for (int rep_ = 0; rep_ < 2; ++rep_) {
    if (rep_ == 1) { epilogue(accB, keyB); tau0 = INFINITY; tau1 = INFINITY; __syncthreads(); dma(0, 0); asm volatile("s_waitcnt vmcnt(0)" ::: "memory"); __syncthreads(); }
#endif
    for (int kt = 0; kt < ntile; ++kt) {
        if (kt + 1 < ntile) dma(kt + 1, (kt + 1) & 1);
#ifdef IDX_PROBE2
        if (rep_ == 0)
#endif
        { const unsigned c_all = cnt[lane & 31];
          if (__ballot(c_all > (unsigned)(IDX_CAP - 160))) {
#pragma unroll 1
              for (int i = 0; i < 4; ++i) {
                  int cqi = (i == 0) ? cq0 : ((i == 1) ? cq1 : ((i == 2) ? cq2 : cq3));
                  if (cqi > 400) { float tqi = (i == 0) ? tq0 : ((i == 1) ? tq1 : ((i == 2) ? tq2 : tq3));
                      cqi = idx_compact<false>(lds, 4 * w + i, lane, cqi, tqi);
                      if (i == 0) { cq0 = cqi; tq0 = tqi; } else if (i == 1) { cq1 = cqi; tq1 = tqi; } else if (i == 2) { cq2 = cqi; tq2 = tqi; } else { cq3 = cqi; tq3 = tqi; } }
              }
              if (kt > 0) { tau0 = hf ? tq1 : tq0; tau1 = hf ? tq3 : tq2; }
          } }
        const LAS unsigned char* kb = lds + IDX_KT + (kt & 1) * 16384 + n * 128;
        const int sbase = kt * 4;
#ifdef IDX_PROBE2
        if (sbase + 0 < nsub) { ldk(kfA, kb); if (sbase + 1 < nsub) ldk(kfB, kb + 32 * 128); mma(accA, kfA); epilogue(accB, keyB); keyA = kt * 128 + n; if (kt == 0 && rep_ == 0) { tau0 = -INFINITY; tau1 = -INFINITY; } }
#else
        if (sbase + 0 < nsub) { ldk(kfA, kb); if (sbase + 1 < nsub) ldk(kfB, kb + 32 * 128); mma(accA, kfA); epilogue(accB, keyB); keyA = kt * 128 + n; if (kt == 0) { tau0 = -INFINITY; tau1 = -INFINITY; } }
#endif
        if (sbase + 1 < nsub) { if (sbase + 2 < nsub) ldk(kfA, kb + 64 * 128); mma(accB, kfB); epilogue(accA, keyA); keyB = kt * 128 + 32 + n; }
        if (sbase + 2 < nsub) { if (sbase + 3 < nsub) ldk(kfB, kb + 96 * 128); mma(accA, kfA); epilogue(accB, keyB); keyA = kt * 128 + 64 + n; }
        if (sbase + 3 < nsub) { mma(accB, kfB); epilogue(accA, keyA); keyB = kt * 128 + 96 + n; }
        if (lane < 4) cnt[4 * w + lane] = (unsigned)(lane == 0 ? cq0 : (lane == 1 ? cq1 : (lane == 2 ? cq2 : cq3)));
        asm volatile("s_waitcnt vmcnt(0)" ::: "memory");
        __syncthreads();
    }
#ifdef IDX_PROBE2
  }
#endif
    epilogue(accB, keyB);
    __syncthreads();
    const int lane2 = opaque_tid() & 63;
    LAS unsigned* bm = (LAS unsigned*)(lds + IDX_KT) + w * 512;
#ifdef IDX_PROBE_FINAL
  for (int rep2_ = 0; rep2_ < 2; ++rep2_) {
#endif
#pragma unroll 1
    for (int i = 0; i < 4; ++i) {
        const int qq = 4 * w + i;
        int nsel = (i == 0) ? cq0 : ((i == 1) ? cq1 : ((i == 2) ? cq2 : cq3));
        if (nsel > 256 - IDX_PF_) { float tqi = (i == 0) ? tq0 : ((i == 1) ? tq1 : ((i == 2) ? tq2 : tq3)); nsel = idx_compact<true>(lds, qq, lane2, nsel, tqi); }
#pragma unroll
        for (int j = 0; j < 8; ++j) bm[lane2 + 64 * j] = 0u;
#pragma unroll
        for (int j = 0; j < 4; ++j) { const int idx = lane2 + 64 * j; if (idx < nsel) { const unsigned k = ci[qq * IDX_CAP + idx]; (void)__hip_atomic_fetch_or(bm + (k >> 5), 1u << (k & 31), __ATOMIC_RELAXED, __HIP_MEMORY_SCOPE_WORKGROUP); } }
        const int tq = t0 + qq;
#pragma unroll 1
        for (int kt = lane2; kt < L / 64; kt += 64) { const unsigned long long v = (unsigned long long)bm[2 * kt] | ((unsigned long long)bm[2 * kt + 1] << 32); a.MT[((size_t)b * 256 + kt) * SEQ + tq] = v; }
    }
#ifdef IDX_PROBE_FINAL
  }
#endif
    __syncthreads();
}
__device__ __forceinline__ void idx_phase(LAS unsigned char* lds, const IdxArgs& a, int bid, int nblk) {
    for (int k = bid; k < 256; k += nblk) {
#pragma unroll 1
        for (int i = 0; i < 4; ++i) idx_item(lds, a, i & 1, (i < 2) ? 511 - k : k);
    }
}
#define XB_TMO      128
#define XB_XCNT(j)  (256  + 64 * (j))
#define XB_XSUB(j)  (1280 + 64 * (j))
#define XB_XGEN(j)  (2304 + 64 * (j))
#define XB_TOP      3328
#define XB_TOPGEN   3392
#define XCD_BAR_WORDS 3456
#define XB_SPIN_CAP (1u << 23)


__device__ __forceinline__ unsigned xb_ld(unsigned* p)              { return __hip_atomic_load(p, __ATOMIC_RELAXED, __HIP_MEMORY_SCOPE_AGENT); }
__device__ __forceinline__ unsigned xb_add(unsigned* p, unsigned v) { return __hip_atomic_fetch_add(p, v, __ATOMIC_RELAXED, __HIP_MEMORY_SCOPE_AGENT); }
__device__ __forceinline__ unsigned xb_xcc_id() { return (unsigned)__builtin_amdgcn_s_getreg((3 << 11) | 20) & 0xFu; }
#define XB_SPIN(cond, bar) do { unsigned _sp = 0; while (cond) { __builtin_amdgcn_s_sleep(1); \
    if ((++_sp & 255u) == 0u) { if (xb_ld(&(bar)[XB_TMO])) break; if (_sp > XB_SPIN_CAP) { atomicAdd(&(bar)[XB_TMO], 1u); break; } } } } while (0)

struct XcdBarrier {
    unsigned* bar; unsigned x;
    volatile LAS unsigned* st;
};

__device__ __forceinline__ XcdBarrier xcd_barrier_post(unsigned* bar, volatile LAS unsigned* st) {
    XcdBarrier b; b.bar = bar; b.x = xb_xcc_id(); b.st = st;
    if (threadIdx.x == 0) (void)xb_add(&bar[XB_XCNT(b.x)], 1u);
    return b;
}
__device__ __forceinline__ void xcd_barrier_complete(unsigned* bar, unsigned x, unsigned& nloc, unsigned& nx) {
    const unsigned G = gridDim.x * gridDim.y * gridDim.z;
    unsigned sum, cnt, mine, sp = 0u;
    for (;;) {
        sum = 0u; cnt = 0u; mine = 0u;
#pragma unroll
        for (unsigned j = 0; j < 16; ++j) { const unsigned c = xb_ld(&bar[XB_XCNT(j)]); sum += c; cnt += (c > 0u) ? 1u : 0u; mine = (j == x) ? c : mine; }
        if (sum == G) break;
        __builtin_amdgcn_s_sleep(1);
        if ((++sp & 255u) == 0u) { if (xb_ld(&bar[XB_TMO])) break; if (sp > XB_SPIN_CAP) { atomicAdd(&bar[XB_TMO], 1u); break; } }
    }
    nloc = mine > 0u ? mine : 1u; nx = cnt > 0u ? cnt : 1u;
}

__device__ __forceinline__ void xcd_barrier(const XcdBarrier& b) {
    asm volatile("s_waitcnt vmcnt(0)" ::: "memory");
    __syncthreads();
    if (threadIdx.x == 0) {
        unsigned* bar = b.bar;
        __builtin_amdgcn_s_waitcnt(0);
        unsigned nloc = b.st[0], nx = b.st[1];
        if (nloc == 0u) { xcd_barrier_complete(bar, b.x, nloc, nx); b.st[0] = nloc; b.st[1] = nx; }
        const unsigned old = xb_add(&bar[XB_XSUB(b.x)], 1u);
        const unsigned gen = old / nloc;
        if (old + 1u == (gen + 1u) * nloc) {
            __builtin_amdgcn_fence(__ATOMIC_RELEASE, "agent");
            asm volatile("s_waitcnt vmcnt(0)" ::: "memory");
            const unsigned og = xb_add(&bar[XB_TOP], 1u);
            const unsigned tg = og / nx;
            if (og + 1u == (tg + 1u) * nx) xb_add(&bar[XB_TOPGEN], 1u);
            else XB_SPIN(xb_ld(&bar[XB_TOPGEN]) == tg, bar);
            __builtin_amdgcn_fence(__ATOMIC_ACQUIRE, "agent");
            xb_add(&bar[XB_XGEN(b.x)], 1u);
            asm volatile("s_waitcnt vmcnt(0)" ::: "memory");
        } else {
            XB_SPIN(xb_ld(&bar[XB_XGEN(b.x)]) == gen, bar);
            __builtin_amdgcn_fence(__ATOMIC_ACQUIRE, "agent");
            asm volatile("s_waitcnt vmcnt(0)" ::: "memory");
        }
    }
    __syncthreads();
}

#ifndef FP8_QKV
#define FP8_QKV 1
#endif
#ifndef FP8_UP0
#define FP8_UP0 0
#endif
#ifndef FP8_UP1
#define FP8_UP1 1
#endif
#ifndef FP8_DN0
#define FP8_DN0 0
#endif
#ifndef FP8_DN1
#define FP8_DN1 1
#endif
#ifndef SKIPMASK
#define SKIPMASK 0
#endif

__device__ __forceinline__ int perm16(int t) { const int a = (t >> 2) & 3; return (t & ~12) | ((a == 1 ? 2 : (a == 2 ? 1 : a)) << 2); }
__device__ __forceinline__ void st_vt16(bf16_t* VT, int row, int h, int d, f32x4 v) {
    const int b = row / SEQ, t = row % SEQ; bf16_t* p = VT + ((size_t)(b * 8 + h) * 128 + d) * SEQ + (t & ~15) + perm16(t & 15);
    p[0] = f2bf(v[0]); p[SEQ] = f2bf(v[1]); p[2 * (size_t)SEQ] = f2bf(v[2]); p[3 * (size_t)SEQ] = f2bf(v[3]);
}
__device__ __forceinline__ int perm64(int kk) { const int sub = kk >> 5, k5 = kk & 31; return 32 * ((k5 >> 2) & 1) + 16 * sub + (((k5 >> 3) << 2) | (k5 & 3)); }
__device__ __forceinline__ void st_vt8(bf16_t* VT_, int row, int h, int d, f32x4 v) {
    const int b = row / SEQ, t = row % SEQ; unsigned char* p = (unsigned char*)VT_ + ((size_t)(b * 8 + h) * 128 + d) * SEQ + (t & ~63) + perm64(t & 63);
    const int pk0 = __builtin_amdgcn_cvt_pk_fp8_f32(v[0], v[1], 0, false), pk1 = __builtin_amdgcn_cvt_pk_fp8_f32(v[2], v[3], 0, false);
    p[0] = (unsigned char)(pk0 & 0xFF); p[SEQ] = (unsigned char)((pk0 >> 8) & 0xFF); p[2 * (size_t)SEQ] = (unsigned char)(pk1 & 0xFF); p[3 * (size_t)SEQ] = (unsigned char)((pk1 >> 8) & 0xFF);
}
__device__ __forceinline__ void st_fp8x4(unsigned char* p, f32x4 v) { int pk = 0; pk = __builtin_amdgcn_cvt_pk_fp8_f32(v[0], v[1], pk, false); pk = __builtin_amdgcn_cvt_pk_fp8_f32(v[2], v[3], pk, true); *(int*)p = pk; }
struct FAbIn2 { unsigned char *Q, *K; bf16_t* VT; float *QI, *U, *WI; unsigned short* KI16;
    __device__ __forceinline__ void operator()(int r, int c, f32x4 v) const {
        if (c < 1024) st_fp8x4(Q + (size_t)r * 1024 + c, v);
        else if (c < 2048) st_fp8x4(K + (size_t)r * 1024 + (c - 1024), v);
        else if (c < 3072) { if (PV8_DSA) st_vt8(VT, r, (c - 2048) >> 7, (c - 2048) & 127, v); else st_vt16(VT, r, (c - 2048) >> 7, (c - 2048) & 127, v); }
        else if (c < 4096) st_f32x4(QI + (size_t)r * 1024 + (c - 3072), v);
        else if (c < 5120) st_f32x4(U + (size_t)r * 1024 + (c - 4096), v);
        else if (c < 5184) { typedef _Float16 h2 __attribute__((ext_vector_type(2))); union { h2 h; unsigned u; } a, b; a.h = (h2){(_Float16)v[0], (_Float16)v[1]}; b.h = (h2){(_Float16)v[2], (_Float16)v[3]};
            u32x2 w; w.x = a.u; w.y = b.u; *(u32x2*)(KI16 + (size_t)r * 64 + (c - 5120)) = w; }
        else if (c < 5200) st_f32x4(WI + (size_t)r * 16 + (c - 5184), v);
    } };
struct FAbInHi { FAbIn2 f; __device__ __forceinline__ void operator()(int r, int c, f32x4 v) const { f(r, c + 3072, v); } };
struct FKvUp2 { unsigned char* K8; bf16_t* VT;
    __device__ __forceinline__ void operator()(int r, int c, f32x4 v) const {
        const int h = c >> 8, d = c & 255;
        if (d < 128) { int pk = 0; pk = __builtin_amdgcn_cvt_pk_fp8_f32(v[0], v[1], pk, false); pk = __builtin_amdgcn_cvt_pk_fp8_f32(v[2], v[3], pk, true); *(int*)(K8 + (size_t)r * 1536 + h * 192 + d) = pk; }
        else { if (PV8_MLA) st_vt8(VT, r, h, d - 128, v); else st_vt16(VT, r, h, d - 128, v); }
    } };

template <class E> __device__ __forceinline__ void ph_gemm_e(LAS unsigned char* lds, const bf16_t* A, int lda, const bf16_t* Bt, int ldb, int M, int N, int K, const E& e, int bid, int nblk, int a_shift = 0, int a_bytes = 0, int cmode = 0) {
    pg8::Gemm g; g.A = A; g.Bt = Bt; g.M = M; g.N = N; g.K = K; g.lda = lda; g.ldb = ldb; g.a_shift = a_shift; g.a_bytes = a_bytes; g.cmode = cmode;
    pg8::StaticOrder S; S.init(M, N, nblk, bid);
    pg8::gemm_phase<E, pg8::StaticOrder, false>(lds, g, S, e, nullptr);
    __syncthreads();
}
template <class F> __device__ __forceinline__ void ph_gemm(LAS unsigned char* lds, const bf16_t* A, int lda, const bf16_t* Bt, int ldb, int M, int N, int K, const F& f, int bid, int nblk, int a_shift = 0, int a_bytes = 0) {
    EpiG<F> e; e.f = f;
    ph_gemm_e(lds, A, lda, Bt, ldb, M, N, K, e, bid, nblk, a_shift, a_bytes);
}
template <class F> __device__ __forceinline__ void ph_gemm8(LAS unsigned char* lds, const unsigned char* A, int lda, const unsigned char* Bt, int ldb, int M, int N, int K, const F& f, int bid, int nblk) {
    EpiG<F, true> e; e.f = f;
    ph_gemm_e(lds, (const bf16_t*)A, lda / 2, (const bf16_t*)Bt, ldb / 2, M, N, K / 2, e, bid, nblk, 0, 0);
}
template <int CTRL> __device__ __forceinline__ float dpp0(float v) { return __int_as_float(__builtin_amdgcn_update_dpp(0, __float_as_int(v), CTRL, 0xF, 0xF, true)); }
__device__ __forceinline__ float gelu_fast(float x) { const float u2 = 1.5957691216057308f * (x + 0.044715f * x * x * x); return x * __builtin_amdgcn_rcpf(1.0f + __builtin_amdgcn_exp2f(-1.4426950408889634f * u2)); }
template <bool OUT8, bool F8> struct EpiGate {
    static constexpr bool PERM = false, AFTER_DRAIN = false, FP8 = F8;
    const float* cw; const float* cb; void* ACT;
    __device__ __forceinline__ void operator()(const f32x4 (&acc)[2][2][4][2], const pg8::Unit& u, int wr, int wc, int fr, int fq) const {
        const int bt = u.pm / 67, ti = u.pm % 67;
#pragma unroll
        for (int n = 0; n < 2; ++n) {
            const int c = u.pn * 128 + wc * 32 + 16 * n + 4 * fq;
            const f32x4 g0 = *(const f32x4*)(cw + c), g1 = *(const f32x4*)(cw + 8192 + c), g2 = *(const f32x4*)(cw + 16384 + c), gb = *(const f32x4*)(cb + c);
            const f32x4 v0 = *(const f32x4*)(cw + 4096 + c), v1 = *(const f32x4*)(cw + 8192 + 4096 + c), v2 = *(const f32x4*)(cw + 16384 + 4096 + c), vb = *(const f32x4*)(cb + 4096 + c);
            const float w1m = (fr < 1) ? 1.f : 0.f, w2m = (fr < 2) ? 1.f : 0.f;
            const f32x4 g1w = g1 * w1m, g0w = g0 * w2m, v1w = v1 * w1m, v0w = v0 * w2m;
#pragma unroll
            for (int ai = 0; ai < 2; ++ai) {
                const int strip = 2 * ai + wr, tbase = ti * 248 + strip * 62 - 2;
                f32x4 pg = {0.f, 0.f, 0.f, 0.f}, pv = pg;
#pragma unroll
                for (int m = 0; m < 4; ++m) {
                    f32x4 xg = acc[ai][0][m][n], xv = acc[ai][1][m][n];
                    const int t = tbase + 16 * m + fr;
                    if (tbase < 0 && m == 0) { if (t < 0) { xg = (f32x4){0.f, 0.f, 0.f, 0.f}; xv = xg; } }
                    f32x4 og, ov;
#pragma unroll
                    for (int j = 0; j < 4; ++j) {
                        float yg = fmaf(g2[j], xg[j], gb[j]), yv = fmaf(v2[j], xv[j], vb[j]);
                        asm("s_nop 1\n\t"
                            "v_fmac_f32_dpp %0, %2, %6 row_shr:1 row_mask:0xf bank_mask:0xf bound_ctrl:1\n\t"
                            "v_fmac_f32_dpp %1, %3, %10 row_shr:1 row_mask:0xf bank_mask:0xf bound_ctrl:1\n\t"
                            "v_fmac_f32_dpp %0, %2, %7 row_shr:2 row_mask:0xf bank_mask:0xf bound_ctrl:1\n\t"
                            "v_fmac_f32_dpp %1, %3, %11 row_shr:2 row_mask:0xf bank_mask:0xf bound_ctrl:1\n\t"
                            "v_fmac_f32_dpp %0, %4, %8 row_ror:1 row_mask:0xf bank_mask:0xf bound_ctrl:1\n\t"
                            "v_fmac_f32_dpp %1, %5, %12 row_ror:1 row_mask:0xf bank_mask:0xf bound_ctrl:1\n\t"
                            "v_fmac_f32_dpp %0, %4, %9 row_ror:2 row_mask:0xf bank_mask:0xf bound_ctrl:1\n\t"
                            "v_fmac_f32_dpp %1, %5, %13 row_ror:2 row_mask:0xf bank_mask:0xf bound_ctrl:1"
                            : "+v"(yg), "+v"(yv)
                            : "v"(xg[j]), "v"(xv[j]), "v"(pg[j]), "v"(pv[j]), "v"(g1[j]), "v"(g0[j]), "v"(g1w[j]), "v"(g0w[j]), "v"(v1[j]), "v"(v0[j]), "v"(v1w[j]), "v"(v0w[j]));
                        og[j] = gelu_fast(yg) * yv; ov[j] = 0.f;
                    }
                    pg = xg; pv = xv;
                    if (16 * m + fr >= 2 && t < SEQ) {
                        const size_t o = ((size_t)bt * SEQ + t) * 4096 + c;
                        if (OUT8) { int pk = 0; pk = __builtin_amdgcn_cvt_pk_fp8_f32(og[0], og[1], pk, false); pk = __builtin_amdgcn_cvt_pk_fp8_f32(og[2], og[3], pk, true); *(int*)((unsigned char*)ACT + o) = pk; }
                        else st_bf16x4((bf16_t*)ACT + o, og);
                    }
                }
            }
        }
    }
};
struct FPool { bf16_t* CC; const float* pb; const float* ps;
    __device__ __forceinline__ void operator()(int r, int c, f32x4 v) const { const f32x4 b = *(const f32x4*)(pb + c), s = *(const f32x4*)(ps + c); st_bf16x4(CC + (size_t)r * 2048 + 1024 + c, (v + b) * s); } };
struct EpiLru {
    static constexpr bool PERM = false, AFTER_DRAIN = false, FP8 = false;
    const bf16_t* XCB; const float *ba, *bx, *lam; bf16_t *LA, *LB;
    __device__ __forceinline__ void operator()(const f32x4 (&acc)[2][2][4][2], const pg8::Unit& u, int wr, int wc, int fr, int fq) const {
        const int row0 = u.pm * 256 + wr * 64 + fr;
#pragma unroll
        for (int n = 0; n < 2; ++n) {
            const int ch = u.pn * 128 + wc * 32 + 16 * n + 4 * fq;
            const f32x4 bav = *(const f32x4*)(ba + ch), bxv = *(const f32x4*)(bx + ch), lm = *(const f32x4*)(lam + ch);
            f32x4 sp;
#pragma unroll
            for (int j = 0; j < 4; ++j) sp[j] = log1pf(__expf(-lm[j]));
#pragma unroll
            for (int ai = 0; ai < 2; ++ai)
#pragma unroll
                for (int m = 0; m < 4; ++m) {
                    const int row = row0 + ai * 128 + m * 16;
                    const u32x2 xw = *(const u32x2*)(XCB + (size_t)row * 1024 + ch);
                    const f32x4 xc = {__uint_as_float(xw.x << 16), __uint_as_float(xw.x & 0xFFFF0000u), __uint_as_float(xw.y << 16), __uint_as_float(xw.y & 0xFFFF0000u)};
                    const f32x4 ga = acc[ai][0][m][n] + bav, gx = acc[ai][1][m][n] + bxv;
                    f32x4 av, bv;
#pragma unroll
                    for (int j = 0; j < 4; ++j) {
                        const float rg = 1.0f / (1.0f + __expf(-ga[j])), ig = 1.0f / (1.0f + __expf(-gx[j]));
                        const float log_a = -8.0f * rg * sp[j], a = __expf(log_a), mult = sqrtf(-expm1f(2.0f * log_a));
                        av[j] = -expm1f(log_a); bv[j] = mult * (ig * xc[j]); (void)a;
                    }
                    st_bf16x4(LA + (size_t)row * 1024 + ch, av); st_bf16x4(LB + (size_t)row * 1024 + ch, bv);
                }
        }
    }
};
__device__ __forceinline__ void ph_pooled(const float* __restrict__ U, bf16_t* __restrict__ P, int bid, int nblk) {
    for (int i = bid * 512 + opaque_tid(); i < 256 * (NTOK / 64); i += nblk * 512) {
        const int c4 = i & 255, row0 = (i >> 8) * 64, t0 = row0 % SEQ, g = c4 >> 6, win = 2 << g;
        const f32x4* up = (const f32x4*)U + (size_t)row0 * 256 + c4;
        f32x4 s = {0.f, 0.f, 0.f, 0.f};
        if (t0 > 0) { for (int k = 1; k < win; ++k) s += up[-(ptrdiff_t)k * 256]; }
#pragma unroll 8
        for (int r = 0; r < 64; ++r) {
            const int t = t0 + r; const f32x4 u0 = up[(ptrdiff_t)r * 256];
            s += u0;
            const int cnt = (t + 1 < win) ? (t + 1) : win;
            st_bf16x4(P + (size_t)(row0 + r) * 1024 + c4 * 4, s * (1.0f / (float)cnt) - u0);
            if (t + 1 >= win) s -= up[(ptrdiff_t)(r + 1 - win) * 256];
        }
    }
}
__device__ __forceinline__ void ph_xc(const bf16_t* __restrict__ XL, const float* __restrict__ cw, const float* __restrict__ cb, bf16_t* __restrict__ XCB, int bid, int nblk) {
    for (int i = bid * 512 + opaque_tid(); i < 128 * (NTOK / 32); i += nblk * 512) {
        const int c8 = (i & 127) * 8, row0 = (i >> 7) * 32, t0 = row0 % SEQ;
        float w0[8], w1[8], w2[8], w3[8], bb[8];
#pragma unroll
        for (int j = 0; j < 8; ++j) { w0[j] = cw[c8 + j]; w1[j] = cw[1024 + c8 + j]; w2[j] = cw[2048 + c8 + j]; w3[j] = cw[3072 + c8 + j]; bb[j] = cb[c8 + j]; }
        u32x4 p3 = {0u, 0u, 0u, 0u}, p2 = p3, p1 = p3;
        if (t0 >= 3) { p3 = *(const u32x4*)(XL + (size_t)(row0 - 3) * 1024 + c8); p2 = *(const u32x4*)(XL + (size_t)(row0 - 2) * 1024 + c8); p1 = *(const u32x4*)(XL + (size_t)(row0 - 1) * 1024 + c8); }
#pragma unroll 8
        for (int r = 0; r < 32; ++r) {
            const u32x4 cur = *(const u32x4*)(XL + (size_t)(row0 + r) * 1024 + c8);
            const unsigned a3[4] = {p3.x, p3.y, p3.z, p3.w}, a2[4] = {p2.x, p2.y, p2.z, p2.w}, a1[4] = {p1.x, p1.y, p1.z, p1.w}, a0[4] = {cur.x, cur.y, cur.z, cur.w};
            float y[8];
#pragma unroll
            for (int j = 0; j < 4; ++j) {
                y[2 * j] = bb[2 * j] + w0[2 * j] * __uint_as_float(a3[j] << 16) + w1[2 * j] * __uint_as_float(a2[j] << 16) + w2[2 * j] * __uint_as_float(a1[j] << 16) + w3[2 * j] * __uint_as_float(a0[j] << 16);
                y[2 * j + 1] = bb[2 * j + 1] + w0[2 * j + 1] * __uint_as_float(a3[j] & 0xFFFF0000u) + w1[2 * j + 1] * __uint_as_float(a2[j] & 0xFFFF0000u) + w2[2 * j + 1] * __uint_as_float(a1[j] & 0xFFFF0000u) + w3[2 * j + 1] * __uint_as_float(a0[j] & 0xFFFF0000u); }
            u32x4 o; o.x = pack2bf(y[0], y[1]); o.y = pack2bf(y[2], y[3]); o.z = pack2bf(y[4], y[5]); o.w = pack2bf(y[6], y[7]);
            *(u32x4*)(XCB + (size_t)(row0 + r) * 1024 + c8) = o;
            p3 = p2; p2 = p1; p1 = cur;
        }
    }
}
__device__ __forceinline__ int up_src_col(int n0) { return ((n0 >> 7) & 1) * 4096 + (n0 >> 8) * 128 + (n0 & 127); }
template <bool OUT8>
__device__ __forceinline__ void ph_convT_g(LAS unsigned char* lds, const float* __restrict__ W, int ldw, int src_col0, int ncols, int K, void* __restrict__ Bt, int ldd, int bid, int nblk, bool upperm) {
    const int tid = opaque_tid(), sub = tid >> 8, t8 = tid & 255;
    LAS float* tile = (LAS float*)lds + sub * (64 * 65);
    const int ntx = (ncols + 63) / 64, ntiles = ntx * (K / 64);
    for (int base = bid * 2; base < ntiles; base += nblk * 2) {
        const int tl = base + sub; const bool act = tl < ntiles;
        const int n0 = (tl % ntx) * 64, k0 = (tl / ntx) * 64;
        if (act) {
            const int c4 = (t8 & 15) * 4, kr = t8 >> 4;
            const int nsrc = src_col0 + (upperm ? up_src_col(n0 + c4) : n0 + c4);
#pragma unroll
            for (int i = 0; i < 4; ++i) { const int kl = kr + 16 * i;
                f32x4 v = {0.f, 0.f, 0.f, 0.f};
                if (n0 + c4 < ncols) v = *(const f32x4*)(W + (size_t)(k0 + kl) * ldw + nsrc);
                tile[kl * 65 + c4] = v[0]; tile[kl * 65 + c4 + 1] = v[1]; tile[kl * 65 + c4 + 2] = v[2]; tile[kl * 65 + c4 + 3] = v[3]; } }
        __syncthreads();
        if (act) {
            const int k8 = (t8 & 7) * 8, nr = t8 >> 3;
#pragma unroll
            for (int i = 0; i < 2; ++i) { const int nl = nr + 32 * i;
                if (n0 + nl < ncols) {
                    float v[8];
#pragma unroll
                    for (int j = 0; j < 8; ++j) v[j] = tile[(k8 + j) * 65 + nl];
                    if (OUT8) { int p0 = 0, p1 = 0;
                        p0 = __builtin_amdgcn_cvt_pk_fp8_f32(64.f * v[0], 64.f * v[1], p0, false); p0 = __builtin_amdgcn_cvt_pk_fp8_f32(64.f * v[2], 64.f * v[3], p0, true);
                        p1 = __builtin_amdgcn_cvt_pk_fp8_f32(64.f * v[4], 64.f * v[5], p1, false); p1 = __builtin_amdgcn_cvt_pk_fp8_f32(64.f * v[6], 64.f * v[7], p1, true);
                        u32x2 o; o.x = (unsigned)p0; o.y = (unsigned)p1; *(u32x2*)((unsigned char*)Bt + (size_t)(n0 + nl) * ldd + k0 + k8) = o; }
                    else { u32x4 o; o.x = pack2bf(v[0], v[1]); o.y = pack2bf(v[2], v[3]); o.z = pack2bf(v[4], v[5]); o.w = pack2bf(v[6], v[7]);
                        *(u32x4*)((bf16_t*)Bt + (size_t)(n0 + nl) * ldd + k0 + k8) = o; }
                } } }
        __syncthreads();
    }
}
__device__ __forceinline__ void ph_convT(LAS unsigned char* lds, const float* __restrict__ W, int ldw, int src_col0, int ncols, int K, bf16_t* __restrict__ Bt, int ldd, int bid, int nblk, bool upperm = false) {
    ph_convT_g<false>(lds, W, ldw, src_col0, ncols, K, Bt, ldd, bid, nblk, upperm);
}
__device__ __forceinline__ void ph_convT8(LAS unsigned char* lds, const float* __restrict__ W, int ldw, int ncols, int K, unsigned char* __restrict__ Bt, int bid, int nblk, bool upperm = false) {
    ph_convT_g<true>(lds, W, ldw, 0, ncols, K, Bt, K, bid, nblk, upperm);
}
template <int NC> __device__ __forceinline__ void ph_rmsnorm(const float* __restrict__ x, const float* __restrict__ g, bf16_t* __restrict__ out, int bid, int nblk, unsigned char* __restrict__ out8 = nullptr) {
    const int lane = opaque_tid() & 63, w = opaque_tid() >> 6;
    constexpr int NV = NC / 256;
    for (int row = bid * 8 + w; row < NTOK; row += nblk * 8) {
        const f32x4* xr = (const f32x4*)(x + (size_t)row * NC);
        f32x4 v[NV]; float ss = 0.f;
#pragma unroll
        for (int i = 0; i < NV; ++i) { v[i] = xr[lane + 64 * i]; ss += v[i][0] * v[i][0] + v[i][1] * v[i][1] + v[i][2] * v[i][2] + v[i][3] * v[i][3]; }
        ss = wave_sum(ss);
        const float r = rsqrtf(ss * (1.0f / NC) + NORM_EPS);
#pragma unroll
        for (int i = 0; i < NV; ++i) { const f32x4 gg = ((const f32x4*)g)[lane + 64 * i]; const f32x4 y = v[i] * r * gg; st_bf16x4(out + (size_t)row * NC + 4 * (lane + 64 * i), y);
            if (out8) { int pk = 0; pk = __builtin_amdgcn_cvt_pk_fp8_f32(y[0], y[1], pk, false); pk = __builtin_amdgcn_cvt_pk_fp8_f32(y[2], y[3], pk, true); *(int*)(out8 + (size_t)row * NC + 4 * (lane + 64 * i)) = pk; } }
    }
}
template <bool IN16, bool OUT16>
__device__ __forceinline__ void ph_resnorm(const void* xin, const bf16_t* __restrict__ m, const float* __restrict__ gpost, const float* __restrict__ gpre, void* xout, bf16_t* __restrict__ h, unsigned char* __restrict__ h8, int bid, int nblk) {
    const int tid_ = opaque_tid(), lane = tid_ & 63, w = tid_ >> 6;
    for (int row = bid * 8 + w; row < NTOK; row += nblk * 8) {
        const u32x2* mr = (const u32x2*)(m + (size_t)row * DM);
        f32x4 mv[8], xv[8]; float ss = 0.f;
#pragma unroll
        for (int i = 0; i < 8; ++i) { const u32x2 wd = mr[lane + 64 * i]; mv[i][0] = __uint_as_float(wd.x << 16); mv[i][1] = __uint_as_float(wd.x & 0xFFFF0000u); mv[i][2] = __uint_as_float(wd.y << 16); mv[i][3] = __uint_as_float(wd.y & 0xFFFF0000u);
            if (IN16) { const u32x2 xw = ((const u32x2*)((const bf16_t*)xin + (size_t)row * DM))[lane + 64 * i];
                xv[i][0] = __uint_as_float(xw.x << 16); xv[i][1] = __uint_as_float(xw.x & 0xFFFF0000u); xv[i][2] = __uint_as_float(xw.y << 16); xv[i][3] = __uint_as_float(xw.y & 0xFFFF0000u); }
            else xv[i] = ((const f32x4*)((const float*)xin + (size_t)row * DM))[lane + 64 * i];
            ss += mv[i][0] * mv[i][0] + mv[i][1] * mv[i][1] + mv[i][2] * mv[i][2] + mv[i][3] * mv[i][3]; }
        ss = wave_sum(ss);
        const float r1 = rsqrtf(ss * (1.0f / DM) + NORM_EPS);
        float s2 = 0.f;
#pragma unroll
        for (int i = 0; i < 8; ++i) { const f32x4 gg = ((const f32x4*)gpost)[lane + 64 * i]; xv[i] = xv[i] + mv[i] * r1 * gg;
            if (OUT16) st_bf16x4((bf16_t*)xout + (size_t)row * DM + 4 * (lane + 64 * i), xv[i]); else ((f32x4*)((float*)xout + (size_t)row * DM))[lane + 64 * i] = xv[i];
            s2 += xv[i][0] * xv[i][0] + xv[i][1] * xv[i][1] + xv[i][2] * xv[i][2] + xv[i][3] * xv[i][3]; }
        if (gpre) {
            s2 = wave_sum(s2);
            const float r2 = rsqrtf(s2 * (1.0f / DM) + NORM_EPS);
#pragma unroll
            for (int i = 0; i < 8; ++i) { const f32x4 gg = ((const f32x4*)gpre)[lane + 64 * i]; const f32x4 y = xv[i] * r2 * gg;
                if (h8) { int pk = 0; pk = __builtin_amdgcn_cvt_pk_fp8_f32(y[0], y[1], pk, false); pk = __builtin_amdgcn_cvt_pk_fp8_f32(y[2], y[3], pk, true); *(int*)(h8 + (size_t)row * DM + 4 * (lane + 64 * i)) = pk; }
                else st_bf16x4(h + (size_t)row * DM + 4 * (lane + 64 * i), y); }
        }
    }
}
__device__ __forceinline__ void ph_scan1(const bf16_t* __restrict__ Aa, const bf16_t* __restrict__ Bb, float* __restrict__ CA, float* __restrict__ CH, int bid, int nblk) {
    for (int i = bid * 512 + opaque_tid(); i < 2 * 256 * 1024; i += nblk * 512) {
        const int ch = i & 1023, chunk = (i >> 10) & 255, b = i >> 18;
        const size_t base = ((size_t)b * SEQ + (size_t)chunk * 64) * 1024 + ch;
        float h = 0.f, P = 1.f;
#pragma unroll 8
        for (int s = 0; s < 64; ++s) { const float a = 1.0f - bf2f(Aa[base + (size_t)s * 1024]); h = a * h + bf2f(Bb[base + (size_t)s * 1024]); P *= a; }
        CA[i] = P; CH[i] = h;
    }
}
__device__ __forceinline__ void ph_scan2(const float* __restrict__ CA, const float* __restrict__ CH, float* __restrict__ CIN, int bid, int nblk) {
    for (int i = bid * 512 + opaque_tid(); i < 2048; i += nblk * 512) {
        const int ch = i & 1023, b = i >> 10;
        float h = 0.f;
#pragma unroll 8
        for (int c = 0; c < 256; ++c) { const int j = (b * 256 + c) * 1024 + ch; CIN[j] = h; h = CA[j] * h + CH[j]; }
    }
}
__device__ __forceinline__ void ph_scan3(const bf16_t* __restrict__ Aa, const bf16_t* __restrict__ Bb, const float* __restrict__ CIN, const bf16_t* __restrict__ YG, bf16_t* __restrict__ CC, int bid, int nblk) {
    for (int i = bid * 512 + opaque_tid(); i < 2 * 256 * 1024; i += nblk * 512) {
        const int ch = i & 1023, chunk = (i >> 10) & 255, b = i >> 18;
        const size_t row0 = (size_t)b * SEQ + (size_t)chunk * 64;
        float h = CIN[i];
#pragma unroll 8
        for (int s = 0; s < 64; ++s) { const size_t r = row0 + s; h = (1.0f - bf2f(Aa[r * 1024 + ch])) * h + bf2f(Bb[r * 1024 + ch]);
            CC[r * 2048 + 1024 + ch] = f2bf(h * gelu_tanh(bf2f(YG[r * 1024 + ch]))); }
    }
}
__device__ __forceinline__ void ph_rope_q(const bf16_t* __restrict__ Q1, const int* __restrict__ pos, unsigned char* __restrict__ Q8, int bid, int nblk) {
    for (int idx = bid * 512 + opaque_tid(); idx < NTOK * 8 * 4; idx += nblk * 512) {
        const int g = idx & 3, h = (idx >> 2) & 7, row = idx >> 5;
        const bf16_t* p = Q1 + (size_t)row * 1536 + h * 192; unsigned char* q = Q8 + (size_t)row * 1536 + h * 192;
#pragma unroll
        for (int k = 0; k < 4; ++k) { const u32x4 w = *(const u32x4*)(p + 32 * g + 8 * k);
            int p0 = 0, p1 = 0;
            p0 = __builtin_amdgcn_cvt_pk_fp8_f32(__uint_as_float(w.x << 16), __uint_as_float(w.x & 0xFFFF0000u), p0, false); p0 = __builtin_amdgcn_cvt_pk_fp8_f32(__uint_as_float(w.y << 16), __uint_as_float(w.y & 0xFFFF0000u), p0, true);
            p1 = __builtin_amdgcn_cvt_pk_fp8_f32(__uint_as_float(w.z << 16), __uint_as_float(w.z & 0xFFFF0000u), p1, false); p1 = __builtin_amdgcn_cvt_pk_fp8_f32(__uint_as_float(w.w << 16), __uint_as_float(w.w & 0xFFFF0000u), p1, true);
            u32x2 o; o.x = (unsigned)p0; o.y = (unsigned)p1; *(u32x2*)(q + 32 * g + 8 * k) = o; }
        const u32x4 w1 = *(const u32x4*)(p + 128 + 8 * g), w2 = *(const u32x4*)(p + 160 + 8 * g);
        const unsigned a1[4] = {w1.x, w1.y, w1.z, w1.w}, a2[4] = {w2.x, w2.y, w2.z, w2.w};
        float o1[8], o2[8]; const int ps = pos[row];
#pragma unroll
        for (int j = 0; j < 8; ++j) { float cs, sn; rope_cs(ps, 8 * g + j, cs, sn);
            const float x1 = (j & 1) ? __uint_as_float(a1[j >> 1] & 0xFFFF0000u) : __uint_as_float(a1[j >> 1] << 16), x2 = (j & 1) ? __uint_as_float(a2[j >> 1] & 0xFFFF0000u) : __uint_as_float(a2[j >> 1] << 16);
            o1[j] = x1 * cs - x2 * sn; o2[j] = x2 * cs + x1 * sn; }
        int p0 = 0, p1 = 0, p2 = 0, p3 = 0;
        p0 = __builtin_amdgcn_cvt_pk_fp8_f32(o1[0], o1[1], p0, false); p0 = __builtin_amdgcn_cvt_pk_fp8_f32(o1[2], o1[3], p0, true); p1 = __builtin_amdgcn_cvt_pk_fp8_f32(o1[4], o1[5], p1, false); p1 = __builtin_amdgcn_cvt_pk_fp8_f32(o1[6], o1[7], p1, true);
        p2 = __builtin_amdgcn_cvt_pk_fp8_f32(o2[0], o2[1], p2, false); p2 = __builtin_amdgcn_cvt_pk_fp8_f32(o2[2], o2[3], p2, true); p3 = __builtin_amdgcn_cvt_pk_fp8_f32(o2[4], o2[5], p3, false); p3 = __builtin_amdgcn_cvt_pk_fp8_f32(o2[6], o2[7], p3, true);
        u32x2 oa; oa.x = (unsigned)p0; oa.y = (unsigned)p1; *(u32x2*)(q + 128 + 8 * g) = oa;
        u32x2 ob; ob.x = (unsigned)p2; ob.y = (unsigned)p3; *(u32x2*)(q + 160 + 8 * g) = ob;
    }
}
__device__ __forceinline__ void ph_rope_k(const float* __restrict__ KR, const int* __restrict__ pos, unsigned char* __restrict__ K8, int bid, int nblk) {
    for (int idx = bid * 512 + opaque_tid(); idx < NTOK * 32; idx += nblk * 512) {
        const int i = idx & 31, row = idx >> 5;
        float c, s; rope_cs(pos[row], i, c, s);
        const float x1 = KR[(size_t)row * 64 + i], x2 = KR[(size_t)row * 64 + 32 + i];
        const int pk = __builtin_amdgcn_cvt_pk_fp8_f32(x1 * c - x2 * s, x2 * c + x1 * s, 0, false);
        const unsigned char o1 = (unsigned char)(pk & 0xFF), o2 = (unsigned char)((pk >> 8) & 0xFF);
#pragma unroll
        for (int h = 0; h < 8; ++h) { unsigned char* p = K8 + (size_t)row * 1536 + h * 192 + 128; p[i] = o1; p[32 + i] = o2; }
    }
}
template <bool OUT8> __device__ __forceinline__ void ph_ffn_gate(const bf16_t* __restrict__ HID, const float* __restrict__ cw, const float* __restrict__ cb, bf16_t* __restrict__ ACT, int bid, int nblk) {
    for (int i = bid * 512 + opaque_tid(); i < 512 * (SEQ / 64); i += nblk * 512) {
        const int c8 = (i & 511) * 8, t0 = (i >> 9) * 64;
        float wg[3][8], wv[3][8], bg[8], bv[8];
#pragma unroll
        for (int j = 0; j < 8; ++j) { bg[j] = cb[c8 + j]; bv[j] = cb[4096 + c8 + j];
#pragma unroll
            for (int k = 0; k < 3; ++k) { wg[k][j] = cw[k * 8192 + c8 + j]; wv[k][j] = cw[k * 8192 + 4096 + c8 + j]; } }
        u32x4 g2 = {0u, 0u, 0u, 0u}, g1 = g2, v2 = g2, v1 = g2;
        if (t0 >= 2) { g2 = *(const u32x4*)(HID + (size_t)(t0 - 2) * 8192 + c8); g1 = *(const u32x4*)(HID + (size_t)(t0 - 1) * 8192 + c8);
                       v2 = *(const u32x4*)(HID + (size_t)(t0 - 2) * 8192 + 4096 + c8); v1 = *(const u32x4*)(HID + (size_t)(t0 - 1) * 8192 + 4096 + c8); }
#pragma unroll 8
        for (int r = 0; r < 64; ++r) {
            const u32x4 g0 = *(const u32x4*)(HID + (size_t)(t0 + r) * 8192 + c8), v0 = *(const u32x4*)(HID + (size_t)(t0 + r) * 8192 + 4096 + c8);
            const unsigned G2[4] = {g2.x, g2.y, g2.z, g2.w}, G1[4] = {g1.x, g1.y, g1.z, g1.w}, G0[4] = {g0.x, g0.y, g0.z, g0.w};
            const unsigned V2[4] = {v2.x, v2.y, v2.z, v2.w}, V1[4] = {v1.x, v1.y, v1.z, v1.w}, V0[4] = {v0.x, v0.y, v0.z, v0.w};
            float o[8];
#pragma unroll
            for (int j = 0; j < 4; ++j) {
                const float ge = bg[2 * j] + wg[0][2 * j] * __uint_as_float(G2[j] << 16) + wg[1][2 * j] * __uint_as_float(G1[j] << 16) + wg[2][2 * j] * __uint_as_float(G0[j] << 16);
                const float go = bg[2 * j + 1] + wg[0][2 * j + 1] * __uint_as_float(G2[j] & 0xFFFF0000u) + wg[1][2 * j + 1] * __uint_as_float(G1[j] & 0xFFFF0000u) + wg[2][2 * j + 1] * __uint_as_float(G0[j] & 0xFFFF0000u);
                const float ve = bv[2 * j] + wv[0][2 * j] * __uint_as_float(V2[j] << 16) + wv[1][2 * j] * __uint_as_float(V1[j] << 16) + wv[2][2 * j] * __uint_as_float(V0[j] << 16);
                const float vo = bv[2 * j + 1] + wv[0][2 * j + 1] * __uint_as_float(V2[j] & 0xFFFF0000u) + wv[1][2 * j + 1] * __uint_as_float(V1[j] & 0xFFFF0000u) + wv[2][2 * j + 1] * __uint_as_float(V0[j] & 0xFFFF0000u);
                o[2 * j] = gelu_tanh(ge) * ve; o[2 * j + 1] = gelu_tanh(go) * vo; }
            if (OUT8) { int p0 = 0, p1 = 0;
                p0 = __builtin_amdgcn_cvt_pk_fp8_f32(o[0], o[1], p0, false); p0 = __builtin_amdgcn_cvt_pk_fp8_f32(o[2], o[3], p0, true);
                p1 = __builtin_amdgcn_cvt_pk_fp8_f32(o[4], o[5], p1, false); p1 = __builtin_amdgcn_cvt_pk_fp8_f32(o[6], o[7], p1, true);
                u32x2 ov; ov.x = (unsigned)p0; ov.y = (unsigned)p1; *(u32x2*)((unsigned char*)ACT + (size_t)(t0 + r) * 4096 + c8) = ov; }
            else { u32x4 ov; ov.x = pack2bf(o[0], o[1]); ov.y = pack2bf(o[2], o[3]); ov.z = pack2bf(o[4], o[5]); ov.w = pack2bf(o[6], o[7]);
                *(u32x4*)(ACT + (size_t)(t0 + r) * 4096 + c8) = ov; }
            g2 = g1; g1 = g0; v2 = v1; v1 = v0;
        }
    }
}

__device__ __forceinline__ void ph_conv_lru(const float* __restrict__ wa, const float* __restrict__ wx, bf16_t* __restrict__ Bt, int bid, int nblk) {
    for (int e = bid * 512 + opaque_tid(); e < 8 * 2 * 128 * 128; e += nblk * 512) {
        const int d = e & 127, c = (e >> 7) & 127, gate = (e >> 14) & 1, nb = e >> 15;
        const float v = (gate ? wx : wa)[((size_t)nb * 128 + c) * 128 + d];
        bf16_t* row = Bt + (size_t)(nb * 256 + gate * 128 + d) * 256;
        row[(nb & 1) * 128 + c] = f2bf(v); row[(1 - (nb & 1)) * 128 + c] = 0;
    }
}

static constexpr size_t MiB = 1048576;
static constexpr size_t W_UP0 = 0 * MiB, W_UP1 = 32 * MiB, W_DN0 = 64 * MiB, W_DN1 = 80 * MiB, W_ABIN = 96 * MiB, W_ABOUT = 117 * MiB, W_CDIN = 125 * MiB, W_CDOUT = 137 * MiB,
                        W_QUP = 145 * MiB, W_KVUP = 146 * MiB + 512 * 1024, W_POOL = 147 * MiB + 512 * 1024;
static constexpr size_t R_H = 148 * MiB;
static constexpr size_t R_Q0 = 276 * MiB, R_K0 = 340 * MiB, R_VT0 = 404 * MiB, R_QI = 468 * MiB, R_M0 = 468 * MiB, R_U = 596 * MiB, R_KI = 724 * MiB, R_WI = 732 * MiB, R_MASK = 734 * MiB, R_CC0 = 830 * MiB, R_POOLED = 958 * MiB, R_H8A = 830 * MiB;
static constexpr size_t R_HID = 276 * MiB, R_ACT = 532 * MiB, R_F = 660 * MiB, R_X3 = 788 * MiB;
static constexpr size_t R_VT1 = 276 * MiB, R_CQ = 276 * MiB, R_CKV = 340 * MiB, R_KR = 372 * MiB, R_XL = 380 * MiB, R_YG = 444 * MiB, R_CQN = 508 * MiB, R_CKVN = 540 * MiB, R_LA = 556 * MiB, R_LB = 684 * MiB,
                        R_Q1 = 812 * MiB, R_K1 = 908 * MiB, R_Q8 = 956 * MiB,     R_CA = 1004 * MiB, R_CH = 1006 * MiB, R_CIN = 1008 * MiB, R_CC1 = 148 * MiB, R_M1 = 276 * MiB, R_XCB = 148 * MiB, W_LRU = 1010 * MiB;
static constexpr size_t WS_BAR = 1022 * MiB, WS_NEED = 1022 * MiB + 65536;
static constexpr int MK_LDS = 162816;

struct MK { const float* in[28]; float* out; unsigned char* ws; int ph_lo, ph_hi; };

__global__ __launch_bounds__(512, 2) void k_mega(MK p) {
    extern __shared__ __attribute__((aligned(16))) unsigned char shm[];
    LAS unsigned char* lds = (LAS unsigned char*)shm;
    const int bid0 = (int)blockIdx.x, nblk0 = (int)gridDim.x;
    volatile LAS unsigned* xbw = (volatile LAS unsigned*)(lds + MK_LDS - 16);
    if (threadIdx.x == 0) { xbw[0] = 0u; xbw[1] = 0u; xbw[2] = 0u; xbw[3] = 0u; }
    if ((threadIdx.x & 63) == 0) *(volatile LAS int*)(size_t)(TID_TAB_LDS + 4 * ((unsigned)__builtin_amdgcn_s_getreg(((6 - 1) << 11) | 4) & 63u)) = (int)(threadIdx.x >> 6);
    __syncthreads();
    XcdBarrier bar = xcd_barrier_post((unsigned*)(p.ws + WS_BAR), xbw);
#ifndef KARG_PLAIN
#define KARG_PLAIN 0
#endif
#if KARG_PLAIN
#define KARG_DECL const MK& P_ = p;
#else
#define KARG_DECL KPtr P__ = kp; asm volatile("" : "+s"(P__)); const __attribute__((address_space(4))) MK& P_ = *P__;
#endif
    typedef const __attribute__((address_space(4))) MK* KPtr;
    KPtr kp = (KPtr)__builtin_amdgcn_kernarg_segment_ptr();
#define WSP(T, off) ((T*)(ws + (off)))
#define PHASE_BEGIN if (pc >= p.ph_lo && pc < p.ph_hi) { const int bid = opaque_s(bid0), nblk = opaque_s(nblk0); \
    KARG_DECL unsigned char* const ws = P_.ws; float* const xo = P_.out; const float* const x = P_.in[0]; const int* const positions = (const int*)P_.in[1]; \
    const float *const mix_pre_g = P_.in[2], *const mix_post_g = P_.in[3], *const ffn_pre_g = P_.in[4], *const ffn_post_g = P_.in[5], *const ffn_up = P_.in[6], *const ffn_conv_w = P_.in[7], *const ffn_conv_b = P_.in[8], *const ffn_down = P_.in[9], \
    *const ab_w_in = P_.in[10], *const pool_w = P_.in[11], *const pool_b = P_.in[12], *const pool_scale = P_.in[13], *const ab_w_out = P_.in[14], *const cd_w_in = P_.in[15], *const q_norm_g = P_.in[16], *const w_q_up = P_.in[17], \
    *const kv_norm_g = P_.in[18], *const w_kv_up = P_.in[19], *const lru_conv_w = P_.in[20], *const lru_conv_b = P_.in[21], *const lru_wa = P_.in[22], *const lru_ba = P_.in[23], *const lru_wx = P_.in[24], *const lru_bx = P_.in[25], \
    *const lru_lambda = P_.in[26], *const cd_w_out = P_.in[27]; bf16_t* const H = WSP(bf16_t, R_H); const bf16_t* const CC = WSP(bf16_t, LAYER_CC); bf16_t* const Mx = WSP(bf16_t, LAYER_MX); \
    (void)xo; (void)x; (void)positions; (void)mix_pre_g; (void)mix_post_g; (void)ffn_pre_g; (void)ffn_post_g; (void)ffn_up; (void)ffn_conv_w; (void)ffn_conv_b; (void)ffn_down; (void)ab_w_in; (void)pool_w; (void)pool_b; (void)pool_scale; \
    (void)ab_w_out; (void)cd_w_in; (void)q_norm_g; (void)w_q_up; (void)kv_norm_g; (void)w_kv_up; (void)lru_conv_w; (void)lru_conv_b; (void)lru_wa; (void)lru_ba; (void)lru_wx; (void)lru_bx; (void)lru_lambda; (void)cd_w_out; (void)H; (void)CC; (void)Mx;
#define PHASE_END } if (pc >= p.ph_lo && pc + 1 < p.ph_hi) xcd_barrier(bar); ++pc;
    int pc = 0;
#define LAYER_CC R_CC0
#define LAYER_MX R_M0
    PHASE_BEGIN
#if !((SKIPMASK >> 0) & 1)
#if FP8_UP0
        ph_convT8(lds, ffn_up, 8192, 8192, 2048, WSP(unsigned char, W_UP0), bid, nblk, true);
#else
        ph_convT(lds, ffn_up, 8192, 0, 8192, 2048, WSP(bf16_t, W_UP0), 2048, bid, nblk, true);
#endif
#if FP8_UP1
        ph_convT8(lds, ffn_up + (size_t)2048 * 8192, 8192, 8192, 2048, WSP(unsigned char, W_UP1), bid, nblk, true);
#else
        ph_convT(lds, ffn_up + (size_t)2048 * 8192, 8192, 0, 8192, 2048, WSP(bf16_t, W_UP1), 2048, bid, nblk, true);
#endif
#if FP8_DN0
        ph_convT8(lds, ffn_down, 2048, 2048, 4096, WSP(unsigned char, W_DN0), bid, nblk);
#else
        ph_convT(lds, ffn_down, 2048, 0, 2048, 4096, WSP(bf16_t, W_DN0), 4096, bid, nblk);
#endif
#if FP8_DN1
        ph_convT8(lds, ffn_down + (size_t)4096 * 2048, 2048, 2048, 4096, WSP(unsigned char, W_DN1), bid, nblk);
#else
        ph_convT(lds, ffn_down + (size_t)4096 * 2048, 2048, 0, 2048, 4096, WSP(bf16_t, W_DN1), 4096, bid, nblk);
#endif
#if FP8_QKV
        ph_convT8(lds, ab_w_in, 5200, 3072, 2048, WSP(unsigned char, W_ABIN), bid, nblk);
        ph_convT(lds, ab_w_in, 5200, 3072, 1024, 2048, WSP(bf16_t, W_ABIN) + (size_t)3072 * 2048, 2048, bid, nblk);
#else
        ph_convT(lds, ab_w_in, 5200, 0, 4096, 2048, WSP(bf16_t, W_ABIN), 2048, bid, nblk);
#endif
        ph_convT(lds, ab_w_in, 5200, 4176, 1024, 2048, WSP(bf16_t, W_ABIN) + (size_t)4096 * 2048, 2048, bid, nblk);
        ph_convT(lds, ab_w_in, 5200, 4096, 64, 2048, WSP(bf16_t, W_ABIN) + (size_t)5120 * 2048, 2048, bid, nblk);
        ph_convT(lds, ab_w_in, 5200, 4160, 16, 2048, WSP(bf16_t, W_ABIN) + (size_t)5184 * 2048, 2048, bid, nblk);
        ph_convT(lds, ab_w_out, 2048, 0, 2048, 2048, WSP(bf16_t, W_ABOUT), 2048, bid, nblk);
        ph_convT(lds, cd_w_in, 2880, 0, 832, 2048, WSP(bf16_t, W_CDIN), 2048, bid, nblk);
        ph_convT(lds, cd_w_in, 2880, 832, 2048, 2048, WSP(bf16_t, W_CDIN) + (size_t)1024 * 2048, 2048, bid, nblk);
        ph_convT(lds, cd_w_out, 2048, 0, 2048, 2048, WSP(bf16_t, W_CDOUT), 2048, bid, nblk);
        ph_convT(lds, w_q_up, 1536, 0, 1536, 512, WSP(bf16_t, W_QUP), 512, bid, nblk);
        ph_convT(lds, w_kv_up, 2048, 0, 2048, 256, WSP(bf16_t, W_KVUP), 256, bid, nblk);
        for (int g = 0; g < 4; ++g) ph_convT(lds, pool_w + (size_t)g * 65536, 256, 0, 256, 256, WSP(bf16_t, W_POOL) + (size_t)g * 65536, 256, bid, nblk);
        ph_rmsnorm<2048>(x, mix_pre_g, H, bid, nblk, FP8_QKV ? WSP(unsigned char, R_H8A) : (unsigned char*)nullptr);
#endif
    PHASE_END
    {
            PHASE_BEGIN
#if !((SKIPMASK >> 1) & 1)
                FAbIn2 f; f.Q = WSP(unsigned char, R_Q0); f.K = WSP(unsigned char, R_K0); f.VT = WSP(bf16_t, R_VT0); f.QI = WSP(float, R_QI); f.U = WSP(float, R_U); f.WI = WSP(float, R_WI); f.KI16 = WSP(unsigned short, R_KI);
#if FP8_QKV
                ph_gemm8(lds, WSP(unsigned char, R_H8A), 2048, WSP(unsigned char, W_ABIN), 2048, NTOK, 3072, 2048, f, bid, nblk);
                { FAbInHi fh; fh.f = f; ph_gemm(lds, H, 2048, WSP(bf16_t, W_ABIN) + (size_t)3072 * 2048, 2048, NTOK, 2304, 2048, fh, bid, nblk); }
#else
                ph_gemm(lds, H, 2048, WSP(bf16_t, W_ABIN), 2048, NTOK, 5376, 2048, f, bid, nblk);
#endif
#endif
            PHASE_END
            PHASE_BEGIN
#if !((SKIPMASK >> 2) & 1)
                ph_pooled(WSP(float, R_U), WSP(bf16_t, R_POOLED), bid, nblk);
                IdxArgs a; a.QI = WSP(float, R_QI); a.KI16 = WSP(unsigned short, R_KI); a.WI = WSP(float, R_WI); a.MT = WSP(unsigned long long, R_MASK);
                idx_phase(lds, a, bid, nblk);
#endif
            PHASE_END
            PHASE_BEGIN
#if !((SKIPMASK >> 3) & 1)
                { FPool f; f.CC = WSP(bf16_t, R_CC0); f.pb = pool_b; f.ps = pool_scale; ph_gemm(lds, WSP(bf16_t, R_POOLED), 1024, WSP(bf16_t, W_POOL), 256, NTOK, 1024, 256, f, bid, nblk, 0, 512); }
                AttnArgs a; a.Q = WSP(bf16_t, R_Q0); a.K = WSP(bf16_t, R_K0); a.VT = WSP(bf16_t, R_VT0); a.MT = WSP(unsigned long long, R_MASK); a.O = WSP(bf16_t, R_CC0); a.ldq = 1024; a.ldk = 1024; a.ldo = 2048;
                a.sc_log2e = 0.08838834764831845f * 1.4426950408889634f;
                attn_phase<128, true>(lds, a, bid, nblk);
#endif
            PHASE_END
        PHASE_BEGIN
#if !((SKIPMASK >> 4) & 1)
            FStoreBf16 f; f.O = Mx; f.ldc = 2048; f.pad_ = 0;
            ph_gemm(lds, CC, 2048, WSP(bf16_t, W_ABOUT), 2048, NTOK, 2048, 2048, f, bid, nblk);
#endif
        PHASE_END
        PHASE_BEGIN
#if !((SKIPMASK >> 5) & 1)
            ph_resnorm<false, true>(x, Mx, mix_post_g + 0, ffn_pre_g + 0, xo, H, FP8_UP0 ? WSP(unsigned char, R_H) : (unsigned char*)nullptr, bid, nblk);
#endif
        PHASE_END
        PHASE_BEGIN
#if FP8_UP0
            { EpiGate<FP8_DN0 != 0, true> ep; ep.cw = ffn_conv_w + 0; ep.cb = ffn_conv_b + 0; ep.ACT = WSP(void, R_HID);
              ph_gemm_e(lds, (const bf16_t*)WSP(unsigned char, R_H), 1024, (const bf16_t*)WSP(unsigned char, W_UP0), 1024, 134 * 256, 8192, 1024, ep, bid, nblk, 0, 0, 1); }
#else
            { EpiGate<FP8_DN0 != 0, false> ep; ep.cw = ffn_conv_w + 0; ep.cb = ffn_conv_b + 0; ep.ACT = WSP(void, R_HID);
              ph_gemm_e(lds, H, 2048, WSP(bf16_t, W_UP0), 2048, 134 * 256, 8192, 2048, ep, bid, nblk, 0, 0, 1); }
#endif
        PHASE_END
        PHASE_BEGIN
            FStoreBf16 f; f.O = WSP(bf16_t, R_F); f.ldc = 2048; f.pad_ = 0;
#if FP8_DN0
            ph_gemm8(lds, WSP(unsigned char, R_HID), 4096, WSP(unsigned char, W_DN0), 4096, NTOK, 2048, 4096, f, bid, nblk);
#else
            ph_gemm(lds, WSP(bf16_t, R_HID), 4096, WSP(bf16_t, W_DN0), 4096, NTOK, 2048, 4096, f, bid, nblk);
#endif
        PHASE_END
        PHASE_BEGIN
#if !((SKIPMASK >> 9) & 1)
            ph_resnorm<true, true>(xo, WSP(bf16_t, R_F), ffn_post_g + 0, mix_pre_g + 2048, xo, H, nullptr, bid, nblk);
#endif
        PHASE_END
    }
    {
#undef LAYER_CC
#undef LAYER_MX
#define LAYER_CC R_CC1
#define LAYER_MX R_M1
            PHASE_BEGIN
#if !((SKIPMASK >> 10) & 1)
                FCdIn f; f.CQ = WSP(float, R_CQ); f.CKV = WSP(float, R_CKV); f.KR = WSP(float, R_KR); f.XL = WSP(bf16_t, R_XL); f.YG = WSP(bf16_t, R_YG);
                ph_gemm(lds, H, 2048, WSP(bf16_t, W_CDIN), 2048, NTOK, 3072, 2048, f, bid, nblk);
#endif
            PHASE_END
            PHASE_BEGIN
#if !((SKIPMASK >> 11) & 1)
                ph_xc(WSP(bf16_t, R_XL), lru_conv_w, lru_conv_b, WSP(bf16_t, R_XCB), bid, nblk);
                ph_conv_lru(lru_wa, lru_wx, WSP(bf16_t, W_LRU), bid, nblk);
                ph_rmsnorm<512>(WSP(float, R_CQ), q_norm_g, WSP(bf16_t, R_CQN), bid, nblk);
                ph_rmsnorm<256>(WSP(float, R_CKV), kv_norm_g, WSP(bf16_t, R_CKVN), bid, nblk);
            PHASE_END
            PHASE_BEGIN
                { EpiLru ep; ep.XCB = WSP(bf16_t, R_XCB); ep.ba = lru_ba; ep.bx = lru_bx; ep.lam = lru_lambda; ep.LA = WSP(bf16_t, R_LA); ep.LB = WSP(bf16_t, R_LB);
                  ph_gemm_e(lds, WSP(bf16_t, R_XCB), 1024, WSP(bf16_t, W_LRU), 256, NTOK, 2048, 256, ep, bid, nblk, 1, 512); }
                { FStoreBf16 f; f.O = WSP(bf16_t, R_Q1); f.ldc = 1536; f.pad_ = 0; ph_gemm(lds, WSP(bf16_t, R_CQN), 512, WSP(bf16_t, W_QUP), 512, NTOK, 1536, 512, f, bid, nblk); }
                { FKvUp2 f; f.K8 = WSP(unsigned char, R_K1); f.VT = WSP(bf16_t, R_VT1); ph_gemm(lds, WSP(bf16_t, R_CKVN), 256, WSP(bf16_t, W_KVUP), 256, NTOK, 2048, 256, f, bid, nblk); }
            PHASE_END
            PHASE_BEGIN
                ph_scan1(WSP(bf16_t, R_LA), WSP(bf16_t, R_LB), WSP(float, R_CA), WSP(float, R_CH), bid, nblk);
                ph_rope_q(WSP(bf16_t, R_Q1), positions, WSP(unsigned char, R_Q8), bid, nblk);
                ph_rope_k(WSP(float, R_KR), positions, WSP(unsigned char, R_K1), bid, nblk);
            PHASE_END
            PHASE_BEGIN
                ph_scan2(WSP(float, R_CA), WSP(float, R_CH), WSP(float, R_CIN), bid, nblk);
            PHASE_END
            PHASE_BEGIN
                ph_scan3(WSP(bf16_t, R_LA), WSP(bf16_t, R_LB), WSP(float, R_CIN), WSP(bf16_t, R_YG), WSP(bf16_t, R_CC1), bid, nblk);
                AttnArgs a; a.Q = WSP(bf16_t, R_Q8); a.K = WSP(bf16_t, R_K1); a.VT = WSP(bf16_t, R_VT1); a.MT = nullptr; a.O = WSP(bf16_t, R_CC1); a.ldq = 1536; a.ldk = 1536; a.ldo = 2048;
                a.sc_log2e = 0.07216878364870322f * 1.4426950408889634f;
                attn_phase<192, false>(lds, a, bid, nblk);
#endif
            PHASE_END
        PHASE_BEGIN
#if !((SKIPMASK >> 15) & 1)
            FStoreBf16 f; f.O = Mx; f.ldc = 2048; f.pad_ = 0;
            ph_gemm(lds, CC, 2048, WSP(bf16_t, W_CDOUT), 2048, NTOK, 2048, 2048, f, bid, nblk);
#endif
        PHASE_END
        PHASE_BEGIN
#if !((SKIPMASK >> 16) & 1)
            ph_resnorm<true, true>(xo, Mx, mix_post_g + 2048, ffn_pre_g + 2048, WSP(bf16_t, R_X3), H, FP8_UP1 ? WSP(unsigned char, R_H) : (unsigned char*)nullptr, bid, nblk);
#endif
        PHASE_END
        PHASE_BEGIN
#if FP8_UP1
            { EpiGate<FP8_DN1 != 0, true> ep; ep.cw = ffn_conv_w + 24576; ep.cb = ffn_conv_b + 8192; ep.ACT = WSP(void, R_HID);
              ph_gemm_e(lds, (const bf16_t*)WSP(unsigned char, R_H), 1024, (const bf16_t*)WSP(unsigned char, W_UP1), 1024, 134 * 256, 8192, 1024, ep, bid, nblk, 0, 0, 1); }
#else
            { EpiGate<FP8_DN1 != 0, false> ep; ep.cw = ffn_conv_w + 24576; ep.cb = ffn_conv_b + 8192; ep.ACT = WSP(void, R_HID);
              ph_gemm_e(lds, H, 2048, WSP(bf16_t, W_UP1), 2048, 134 * 256, 8192, 2048, ep, bid, nblk, 0, 0, 1); }
#endif
        PHASE_END
        PHASE_BEGIN
            FStoreBf16 f; f.O = WSP(bf16_t, R_F); f.ldc = 2048; f.pad_ = 0;
#if FP8_DN1
            ph_gemm8(lds, WSP(unsigned char, R_HID), 4096, WSP(unsigned char, W_DN1), 4096, NTOK, 2048, 4096, f, bid, nblk);
#else
            ph_gemm(lds, WSP(bf16_t, R_HID), 4096, WSP(bf16_t, W_DN1), 4096, NTOK, 2048, 4096, f, bid, nblk);
#endif
        PHASE_END
        PHASE_BEGIN
#if !((SKIPMASK >> 20) & 1)
            ph_resnorm<true, false>(WSP(bf16_t, R_X3), WSP(bf16_t, R_F), ffn_post_g + 2048, (const float*)nullptr, xo, H, nullptr, bid, nblk);
#endif
        PHASE_END
    }
#undef LAYER_CC
#undef LAYER_MX
#undef WSP
#undef PHASE_BEGIN
#undef PHASE_END
}

#ifndef MK_N_LAUNCHES
#define MK_N_LAUNCHES 1
#endif
static constexpr int MK_NPHASES = 1 + 3 + 7 + 2 * 5;

extern "C" void kernel_launch(void* const* d_in, const int* in_sizes, int n_in, void* d_out, int out_size, void* d_ws, size_t ws_size, hipStream_t stream) {
    static int grid = 0;
    if (grid == 0) {
        if (n_in != 28 || out_size != NTOK * DM || ws_size < WS_NEED) { fprintf(stderr, "kernel_launch: unexpected shapes (n_in %d out %d ws %zu)\n", n_in, out_size, ws_size); grid = -1; return; }
        int dev = 0, cus = 0, per_cu = 0;
        if (hipGetDevice(&dev) != hipSuccess || hipDeviceGetAttribute(&cus, hipDeviceAttributeMultiprocessorCount, dev) != hipSuccess) { grid = -1; return; }
        if (hipFuncSetAttribute((const void*)k_mega, hipFuncAttributeMaxDynamicSharedMemorySize, MK_LDS) != hipSuccess) { fprintf(stderr, "kernel_launch: hipFuncSetAttribute failed\n"); grid = -1; return; }
        if (hipOccupancyMaxActiveBlocksPerMultiprocessor(&per_cu, (const void*)k_mega, 512, MK_LDS) != hipSuccess || per_cu < 1) { fprintf(stderr, "kernel_launch: occupancy query says %d\n", per_cu); }
        (void)hipGetLastError();
        grid = cus;
        if (grid != 256) { fprintf(stderr, "kernel_launch: built for 256 CUs, found %d\n", grid); grid = -1; return; }
    }
    if (grid < 0) return;
    unsigned char* ws = (unsigned char*)d_ws;
    (void)hipMemsetAsync(ws + WS_BAR, 0, XCD_BAR_WORDS * sizeof(unsigned), stream);
    (void)hipMemsetAsync(ws + W_ABIN + (size_t)5200 * 2048 * 2, 0, (size_t)176 * 2048 * 2, stream);
    (void)hipMemsetAsync(ws + W_CDIN + (size_t)832 * 2048 * 2, 0, (size_t)192 * 2048 * 2, stream);
    MK p{};
    for (int i = 0; i < 28; ++i) p.in[i] = (const float*)d_in[i];
    p.out = (float*)d_out; p.ws = ws;
#if MK_N_LAUNCHES == 1
    p.ph_lo = 0; p.ph_hi = 1 << 20;
    hipLaunchKernelGGL(k_mega, dim3(grid), dim3(512), MK_LDS, stream, p);
#else
    for (int ph = 0; ph < MK_NPHASES; ++ph) { p.ph_lo = ph; p.ph_hi = ph + 1; hipLaunchKernelGGL(k_mega, dim3(grid), dim3(512), MK_LDS, stream, p); }
#endif
}
```

```cpp
#include <hip/hip_runtime.h>
#include <stdint.h>
#include <stdio.h>

#define LAS __attribute__((address_space(3)))
typedef unsigned short bf16_t;
typedef float f32x4 __attribute__((ext_vector_type(4)));
typedef unsigned u32x4 __attribute__((ext_vector_type(4)));
typedef unsigned u32x2 __attribute__((ext_vector_type(2)));

static constexpr int NTOK = 32768, SEQ = 16384, NBATCH = 2, DM = 2048, DFF = 4096;
static constexpr float NORM_EPS = 1e-6f;

__device__ __forceinline__ bf16_t f2bf(float f) { unsigned u = __float_as_uint(f); u += 0x7FFFu + ((u >> 16) & 1u); return (bf16_t)(u >> 16); }
__device__ __forceinline__ float bf2f(bf16_t b) { return __uint_as_float(((unsigned)b) << 16); }
__device__ __forceinline__ unsigned pack2bf(float lo, float hi) { unsigned r; asm("v_cvt_pk_bf16_f32 %0, %1, %2" : "=v"(r) : "v"(lo), "v"(hi)); return r; }
__device__ __forceinline__ float gelu_tanh(float x) { const float u = 0.7978845608028654f * (x + 0.044715f * x * x * x); return 0.5f * x * (1.0f + tanhf(u)); }
__device__ __forceinline__ float wave_sum(float v) {
#pragma unroll
    for (int o = 32; o >= 1; o >>= 1) v += __shfl_xor(v, o);
    return v;
}

#ifndef TID_PLAIN
#define TID_PLAIN 0
#endif
static constexpr int TID_TAB_LDS = 162816 - 16 - 256;
#if TID_PLAIN
__device__ __forceinline__ int opaque_tid() { int t = (int)threadIdx.x; asm volatile("" : "+v"(t)); return t; }
#else
__device__ __forceinline__ int opaque_tid() {
    const unsigned slot = (unsigned)__builtin_amdgcn_s_getreg(((6 - 1) << 11) | 4) & 63u;
    const int w = __builtin_amdgcn_readfirstlane(*(const volatile LAS int*)(size_t)(TID_TAB_LDS + 4 * slot));
    int lane; asm volatile("v_mbcnt_lo_u32_b32 %0, -1, 0\n\tv_mbcnt_hi_u32_b32 %0, -1, %0" : "=v"(lane));
    return w * 64 + lane;
}
#endif

__device__ __forceinline__ int opaque_s(int v) { asm volatile("" : "+s"(v)); return v; }

template <class T> __device__ __forceinline__ const T* opaque_p(const T* p) { asm volatile("" : "+s"(p)); return p; }

#ifndef PG8_EPI_RECOMP
#define PG8_EPI_RECOMP 1
#endif
#ifndef PG8_ASM_DMA
#define PG8_ASM_DMA 1
#endif
#include <hip/hip_runtime.h>
namespace pg8 {
#define PG8_LAS __attribute__((address_space(3)))
typedef unsigned short bf16_t;
typedef short bf16x8 __attribute__((ext_vector_type(8)));
typedef float f32x4 __attribute__((ext_vector_type(4)));
typedef unsigned u32x4 __attribute__((ext_vector_type(4)));
typedef int i32x8 __attribute__((ext_vector_type(8)));
typedef int i32x4 __attribute__((ext_vector_type(4)));
constexpr int BM = 256, BK = 64, HALF = 128, HTB = HALF * BK * 2  , STAGE_BYTES = 8 * HTB, NXCD = 8, WGM = 8;

__host__ __device__ __forceinline__ int lds_byte(int r, int c) { const int st = (r >> 4) * 2 + (c >> 5), rr = r & 15, cc = c & 31, ob = rr * 64 + cc * 2; return st * 1024 + (ob ^ (((ob >> 9) & 1) << 5)); }
__host__ __device__ __forceinline__ void stage_rc(int b, int& R, int& C) { const int st = b / 1024, sb = b % 1024, swz = sb ^ (((sb >> 9) & 1) << 5); R = (st >> 1) * 16 + swz / 64; C = (st & 1) * 32 + (swz % 64) / 2; }
__host__ __device__ __forceinline__ int perm32(int rho) { const int n = rho >> 4, i = rho & 15; return 8 * (i >> 2) + 4 * n + (i & 3); }

struct Unit { int pm, pn; };
struct Gemm { const bf16_t* A; const bf16_t* Bt; int M, N, K, lda, ldb, a_shift, a_bytes, cmode; };

struct StaticOrder {
    int nM, nN, nwg, G, c, skew = 0;
    __host__ __device__ void init(int M, int N, int G_, int c_) { nM = M / BM; nN = N / BM; nwg = nM * nN; G = G_; c = c_; }
    __host__ __device__ bool next(int i, Unit& u) const {
        long L = (long)i * G + c;
        if (skew && i >= skew) { const int half = G >> 1, per = (nwg - skew * G) / half, e = i - skew; if (c < half || e >= per) return false; L = (long)skew * G + (long)(c - half) * per + e; }
        if (L >= nwg) return false;
        int wgid = (int)L; { const int q = nwg / NXCD, r = nwg % NXCD, xcd = wgid % NXCD, off = wgid / NXCD; wgid = (xcd < r ? xcd * (q + 1) : r * (q + 1) + (xcd - r) * q) + off; }
        const int nig = WGM * nN, gid = wgid / nig, fm = gid * WGM, gsz = (nM - fm) < WGM ? (nM - fm) : WGM;
        u.pm = fm + ((wgid % nig) % gsz); u.pn = (wgid % nig) / gsz; return true;
    }
    __device__ __forceinline__ void a_ready(const Unit&) const {}
    __device__ __forceinline__ void done(const Unit&) const {}
};

template <class Epi, class Sched, bool STAMP = false>
__device__ __forceinline__ void gemm_phase(PG8_LAS unsigned char* lds, const Gemm g, const Sched& S, const Epi& E, unsigned long long* stamps) {
    const int tid = opaque_tid(), wid = __builtin_amdgcn_readfirstlane(tid >> 6), lane = tid & 63, wr = wid >> 2, wc = wid & 3, fr = lane & 15, fq = lane >> 4;
    const int K = g.K, nt = K / BK;
    int ts_lo = 0, ts_hi = 0, nts = 0; const unsigned long long rt_entry = STAMP ? (unsigned long long)wall_clock64() : 0ull;
#define PG8_STAMP() do { if (STAMP && wid == 0 && nts < 64) { const unsigned long long _c = (unsigned long long)clock64(); \
        ts_lo = (lane == nts) ? (int)(unsigned)_c : ts_lo; ts_hi = (lane == nts) ? (int)(unsigned)(_c >> 32) : ts_hi; ++nts; } } while (0)
    PG8_STAMP();
    unsigned voffA[2], voffB[2];
#pragma unroll
    for (int i = 0; i < 2; ++i) { int R, C; stage_rc(tid * 16 + i * 8192, R, C); const int Rb = Epi::PERM ? ((R & ~31) + perm32(R & 31)) : R;
        const int Ra = g.cmode ? (R - 2 * (R >> 6)) : R;
        voffA[i] = (unsigned)(Ra * g.lda + C) * 2u; voffB[i] = (unsigned)(Rb * g.ldb + C) * 2u; }
    const size_t kstep = (size_t)(BK * 2);
    const size_t hstepA = (size_t)(g.cmode ? HALF - 4 : HALF) * g.lda * 2, hstepB = (size_t)HALF * g.ldb * 2;
    const size_t tstepA = 2 * hstepA, tstepB = 2 * hstepB;
    const unsigned ldsbase_ = (unsigned)(size_t)lds;
    const int sc_w_ = 0x79797979, sc_a_ = 0x7F7F7F7F;
    (void)sc_w_; (void)sc_a_;
    const unsigned ldsw = (unsigned)wid * 1024u;
    const int aoff = lds_byte(wr * 64 + fr, fq * 8), boff = lds_byte(wc * 32 + fr, fq * 8);
#define PG8_SA(b, h) (((b) * 2 + (h)) * HTB)
#define PG8_SB(b, h) ((4 + (b) * 2 + (h)) * HTB)
#if PG8_ASM_DMA
#define PG8_STAGE(bufoff, gbase, voff) do { _Pragma("unroll") for (int _i = 0; _i < 2; ++_i) { unsigned keep_; \
        asm volatile("s_mov_b32 %0, m0\n\ts_mov_b32 m0, %3\n\ts_nop 0\n\tglobal_load_lds_dwordx4 %1, %2\n\ts_mov_b32 m0, %0" \
                     : "=&s"(keep_) : "v"((voff)[_i]), "s"((const char*)(gbase)), "s"(ldsbase_ + (unsigned)(bufoff) + ldsw + (unsigned)(_i * 8192)) : "memory"); } } while (0)
#else
#define PG8_STAGE(bufoff, gbase, voff) do { _Pragma("unroll") for (int _i = 0; _i < 2; ++_i) \
        __builtin_amdgcn_global_load_lds((const unsigned*)((const char*)(gbase) + (voff)[_i]), (PG8_LAS unsigned*)(lds + (bufoff) + ldsw + _i * 8192), 16, 0, 0); } while (0)
#endif
#define PG8_LDA(dst, b, h) do { _Pragma("unroll") for (int m = 0; m < 4; ++m) { dst[m].lo = *(const PG8_LAS i32x4*)(lds + PG8_SA(b, h) + aoff + m * 2048); dst[m].hi = *(const PG8_LAS i32x4*)(lds + PG8_SA(b, h) + aoff + m * 2048 + 1024); } } while (0)
#define PG8_LDB(dst, b, h) do { _Pragma("unroll") for (int n = 0; n < 2; ++n) { dst[n].lo = *(const PG8_LAS i32x4*)(lds + PG8_SB(b, h) + boff + n * 2048); dst[n].hi = *(const PG8_LAS i32x4*)(lds + PG8_SB(b, h) + boff + n * 2048 + 1024); } } while (0)
#define PG8_MMA(ai, bj, At, Bt) do { __builtin_amdgcn_s_setprio(1); \
        if constexpr (Epi::FP8) { _Pragma("unroll") for (int m = 0; m < 4; ++m) _Pragma("unroll") for (int n = 0; n < 2; ++n) \
            asm volatile("v_mfma_scale_f32_16x16x128_f8f6f4 %0, %1, %2, %0, %3, %4 op_sel_hi:[0,0,0]" : "+v"(acc[ai][bj][m][n]) : "v"(Bt[n]), "v"(At[m]), "v"(sc_w_), "v"(sc_a_)); } \
        else { _Pragma("unroll") for (int m = 0; m < 4; ++m) _Pragma("unroll") for (int n = 0; n < 2; ++n) { \
            const i32x4 bl_ = Bt[n].lo, bh_ = Bt[n].hi, al_ = At[m].lo, ah_ = At[m].hi;     \
            acc[ai][bj][m][n] = __builtin_amdgcn_mfma_f32_16x16x32_bf16(__builtin_bit_cast(bf16x8, bl_), __builtin_bit_cast(bf16x8, al_), acc[ai][bj][m][n], 0, 0, 0); \
            acc[ai][bj][m][n] = __builtin_amdgcn_mfma_f32_16x16x32_bf16(__builtin_bit_cast(bf16x8, bh_), __builtin_bit_cast(bf16x8, ah_), acc[ai][bj][m][n], 0, 0, 0); } } \
        __builtin_amdgcn_s_setprio(0); } while (0)
#define PG8_WAIT_V(n) asm volatile("s_waitcnt vmcnt(" #n ")" ::: "memory")
#define PG8_WAIT_L(n) asm volatile("s_waitcnt lgkmcnt(" #n ")" ::: "memory")
#define PG8_BAR __builtin_amdgcn_s_barrier()
#define PG8_SCHED __builtin_amdgcn_sched_barrier(0)
    Unit cur, nxt; int ui = 0;
    if (!S.next(0, cur)) return;
    f32x4 acc[2][2][4][2];
#pragma unroll
    for (int a = 0; a < 2; ++a)
#pragma unroll
        for (int b = 0; b < 2; ++b)
#pragma unroll
            for (int m = 0; m < 4; ++m)
#pragma unroll
                for (int n = 0; n < 2; ++n) acc[a][b][m][n] = (f32x4){0.f, 0.f, 0.f, 0.f};
    i32x8 At[4], B0[2], B1[2];
    auto a_base_ = [&](const Unit& u_) -> const char* { return g.cmode ? (const char*)g.A + ((long)(u_.pm / 67) * 16384 + (long)(u_.pm % 67) * 248 - 2) * (long)g.lda * 2 : (const char*)g.A + (size_t)u_.pm * tstepA + (size_t)(u_.pn >> g.a_shift) * g.a_bytes; };
    const char* cA = a_base_(cur); const char* cB = (const char*)g.Bt + (size_t)cur.pn * tstepB;
    S.a_ready(cur);
    PG8_STAGE(PG8_SB(0, 0), cB, voffB); PG8_STAGE(PG8_SA(0, 0), cA, voffA); PG8_STAGE(PG8_SB(0, 1), cB + hstepB, voffB); PG8_STAGE(PG8_SA(0, 1), cA + hstepA, voffA);
    if (wr == 1) PG8_BAR;
    PG8_WAIT_V(4); PG8_BAR;
    PG8_STAGE(PG8_SB(1, 0), cB + kstep, voffB); PG8_STAGE(PG8_SA(1, 0), cA + kstep, voffA); PG8_STAGE(PG8_SB(1, 1), cB + hstepB + kstep, voffB);
    PG8_WAIT_V(6); PG8_BAR;
    PG8_STAMP();
    for (;;) {
        const bool has_next = S.next(ui + 1, nxt);
        const char* nA = has_next ? a_base_(nxt) : cA; const char* nB = has_next ? (const char*)g.Bt + (size_t)nxt.pn * tstepB : cB;
        for (int t = 0; t < nt; t += 2) {
            const bool last = (t == nt - 2);
            const char* a1 = cA + (size_t)(t + 1) * kstep;
            const char* a2 = last ? nA : cA + (size_t)(t + 2) * kstep; const char* b2 = last ? nB : cB + (size_t)(t + 2) * kstep;
            const char* a3 = a2 + kstep; const char* b3 = b2 + kstep;
            if (last && has_next) S.a_ready(nxt);
            PG8_LDB(B0, 0, 0); PG8_SCHED; PG8_LDA(At, 0, 0); PG8_STAGE(PG8_SA(1, 1), a1 + hstepA, voffA);
            PG8_WAIT_L(8); PG8_BAR; PG8_WAIT_L(0); PG8_MMA(0, 0, At, B0); PG8_BAR; PG8_SCHED;
            PG8_LDB(B1, 0, 1); PG8_STAGE(PG8_SB(0, 0), b2, voffB);
            PG8_BAR; PG8_WAIT_L(0); PG8_MMA(0, 1, At, B1); PG8_BAR;
            PG8_LDA(At, 0, 1); PG8_STAGE(PG8_SA(0, 0), a2, voffA);
            PG8_BAR; PG8_WAIT_L(0); PG8_MMA(1, 0, At, B0); PG8_BAR; PG8_SCHED;
            PG8_STAGE(PG8_SB(0, 1), b2 + hstepB, voffB);
            PG8_WAIT_V(6); PG8_BAR; PG8_MMA(1, 1, At, B1); PG8_BAR;
            PG8_LDB(B0, 1, 0); PG8_SCHED; PG8_LDA(At, 1, 0); PG8_STAGE(PG8_SA(0, 1), a2 + hstepA, voffA);
            PG8_WAIT_L(8); PG8_BAR; PG8_WAIT_L(0); PG8_MMA(0, 0, At, B0); PG8_BAR; PG8_SCHED;
            PG8_LDB(B1, 1, 1); PG8_STAGE(PG8_SB(1, 0), b3, voffB);
            PG8_BAR; PG8_WAIT_L(0); PG8_MMA(0, 1, At, B1); PG8_BAR;
            PG8_LDA(At, 1, 1); PG8_STAGE(PG8_SA(1, 0), a3, voffA);
            PG8_BAR; PG8_WAIT_L(0); PG8_MMA(1, 0, At, B0); PG8_BAR; PG8_SCHED;
            PG8_STAGE(PG8_SB(1, 1), b3 + hstepB, voffB);
            PG8_WAIT_V(6); PG8_BAR; PG8_MMA(1, 1, At, B1); PG8_BAR;
        }
        PG8_STAMP();
        if constexpr (Epi::FP8) { asm volatile("s_nop 15\n\ts_nop 15" ::: "memory"); }
        if constexpr (!Epi::AFTER_DRAIN) {
#if PG8_EPI_RECOMP
            const int t2_ = opaque_tid(), l2_ = t2_ & 63, w2_ = __builtin_amdgcn_readfirstlane(t2_ >> 6);
            E(acc, cur, w2_ >> 2, w2_ & 3, l2_ & 15, l2_ >> 4); S.done(cur);
#else
            E(acc, cur, wr, wc, fr, fq); S.done(cur);
#endif
        }
        PG8_STAMP();
        if (!has_next) break;
#pragma unroll
        for (int a = 0; a < 2; ++a)
#pragma unroll
            for (int b = 0; b < 2; ++b)
#pragma unroll
                for (int m = 0; m < 4; ++m)
#pragma unroll
                    for (int n = 0; n < 2; ++n) acc[a][b][m][n] = (f32x4){0.f, 0.f, 0.f, 0.f};
        cur = nxt; cA = nA; cB = nB; ++ui;
    }
    PG8_WAIT_V(0);
    if (wr == 0) PG8_BAR;
    PG8_BAR;
    if constexpr (Epi::AFTER_DRAIN) { E.fused(acc, cur, wr, wc, fr, fq, lds, wid, lane); S.done(cur); }
    PG8_STAMP();
    if (STAMP && wid == 0) { stamps[lane] = lane < nts ? (((unsigned long long)(unsigned)ts_hi << 32) | (unsigned)ts_lo) : 0ull;
        if (lane == 62) stamps[62] = rt_entry; if (lane == 63) stamps[63] = (unsigned long long)wall_clock64(); }
#undef PG8_STAMP
#undef PG8_SA
#undef PG8_SB
#undef PG8_STAGE
#undef PG8_LDA
#undef PG8_LDB
#undef PG8_MMA
#undef PG8_WAIT_V
#undef PG8_WAIT_L
#undef PG8_BAR
#undef PG8_SCHED
}
}

#include <cstdio>
#include <ctime>
#include <cstdlib>
#include <cstring>
#include <cmath>
#include <vector>

template <class F, bool F8 = false> struct EpiG {
    static constexpr bool PERM = false, AFTER_DRAIN = false, FP8 = F8;
    F f;
    __device__ __forceinline__ void operator()(const f32x4 (&acc)[2][2][4][2], const pg8::Unit& u, int wr, int wc, int fr, int fq) const {
        const int row0 = u.pm * 256 + wr * 64 + fr, col0 = u.pn * 256 + wc * 32 + 4 * fq;
#pragma unroll
        for (int ai = 0; ai < 2; ++ai)
#pragma unroll
            for (int m = 0; m < 4; ++m)
#pragma unroll
                for (int bj = 0; bj < 2; ++bj)
#pragma unroll
                    for (int n = 0; n < 2; ++n) f(row0 + ai * 128 + m * 16, col0 + bj * 128 + n * 16, acc[ai][bj][m][n]);
    }
};
__device__ __forceinline__ void st_bf16x4(bf16_t* p, f32x4 v) { u32x2 w; w.x = pack2bf(v[0], v[1]); w.y = pack2bf(v[2], v[3]); *(u32x2*)p = w; }
__device__ __forceinline__ void st_f32x4(float* p, f32x4 v) { *(f32x4*)p = v; }

struct FStoreBf16 { bf16_t* O; int ldc; int pad_; __device__ __forceinline__ void operator()(int r, int c, f32x4 v) const { st_bf16x4(O + (size_t)r * ldc + c, v); } };
struct FAbIn { bf16_t *Q, *K, *V; float *QI, *U, *WI; unsigned short* KI16;
    __device__ __forceinline__ void operator()(int r, int c, f32x4 v) const {
        if (c < 1024) st_bf16x4(Q + (size_t)r * 1024 + c, v);
        else if (c < 2048) st_bf16x4(K + (size_t)r * 1024 + (c - 1024), v);
        else if (c < 3072) st_bf16x4(V + (size_t)r * 1024 + (c - 2048), v);
        else if (c < 4096) st_f32x4(QI + (size_t)r * 1024 + (c - 3072), v);
        else if (c < 5120) st_f32x4(U + (size_t)r * 1024 + (c - 4096), v);
        else if (c < 5184) { typedef _Float16 h2 __attribute__((ext_vector_type(2))); union { h2 h; unsigned u; } a, b; a.h = (h2){(_Float16)v[0], (_Float16)v[1]}; b.h = (h2){(_Float16)v[2], (_Float16)v[3]};
            u32x2 w; w.x = a.u; w.y = b.u; *(u32x2*)(KI16 + (size_t)r * 64 + (c - 5120)) = w; }
        else if (c < 5200) st_f32x4(WI + (size_t)r * 16 + (c - 5184), v);
    } };
struct FCdIn { float *CQ, *CKV, *KR; bf16_t *XL, *YG; const float* r2;
    __device__ __forceinline__ void operator()(int r, int c, f32x4 v0) const {
        const f32x4 v = v0 * r2[r];
        if (c < 512) st_f32x4(CQ + (size_t)r * 512 + c, v);
        else if (c < 768) st_f32x4(CKV + (size_t)r * 256 + (c - 512), v);
        else if (c < 832) st_f32x4(KR + (size_t)r * 64 + (c - 768), v);
        else if (c < 1024) {}
        else if (c < 2048) st_bf16x4(XL + (size_t)r * 1024 + (c - 1024), v);
        else st_bf16x4(YG + (size_t)r * 1024 + (c - 2048), v);
    } };
struct FKvUp { bf16_t *K1, *V1;
    __device__ __forceinline__ void operator()(int r, int c, f32x4 v) const {
        const int h = c >> 8, d = c & 255;
        if (d < 128) st_bf16x4(K1 + (size_t)r * 1536 + h * 192 + d, v);
        else st_bf16x4(V1 + (size_t)r * 1024 + h * 128 + (d - 128), v);
    } };

__device__ __forceinline__ unsigned ord_key(float f) { const unsigned b = __float_as_uint(f); return (b & 0x80000000u) ? ~b : (b | 0x80000000u); }
__device__ __forceinline__ void rope_cs(int pos, int i, float& c, float& s) { const float freq = powf(10000.0f, -(float)i / 32.0f); const float ang = (float)pos * freq; sincosf(ang, &s, &c); }
#define PV8_MLA 1
#define PV8_DSA 1

typedef short bf16x8 __attribute__((ext_vector_type(8)));
typedef float f32x16 __attribute__((ext_vector_type(16)));
__device__ __forceinline__ unsigned cvtpk(float lo, float hi) { unsigned r; asm("v_cvt_pk_bf16_f32 %0, %1, %2" : "=v"(r) : "v"(lo), "v"(hi)); return r; }
__device__ __forceinline__ float max3_asm(float a, float b, float c) { float r; asm("v_max3_f32 %0, %1, %2, %3" : "=v"(r) : "v"(a), "v"(b), "v"(c)); return r; }

struct AttnArgs { const bf16_t* Q; const bf16_t* K; const bf16_t* VT; const unsigned long long* MT; bf16_t* O; int ldq, ldk, ldo; float sc_log2e; };

static constexpr int ATT_MTBL = 65536;
struct TTrue { static constexpr bool value = true; }; struct TFalse { static constexpr bool value = false; };
typedef int i32x8q __attribute__((ext_vector_type(8)));
typedef int i32x4q __attribute__((ext_vector_type(4)));
#define MFMA8_FENCE2(acc0, acc1, srcA, srcB) asm volatile("s_nop 15\n\ts_nop 9" : "+v"(acc0), "+v"(acc1) : "v"(srcA), "v"(srcB))
#define MFMA8_FENCE4(a0_, a1_, a2_, a3_, srcA, srcB) asm volatile("s_nop 15\n\ts_nop 9" : "+v"(a0_), "+v"(a1_), "+v"(a2_), "+v"(a3_) : "v"(srcA), "v"(srcB))
template <int DQK, bool MASKED, bool QK8>
__device__ __forceinline__ void attn_item3(LAS unsigned char* lds, const AttnArgs& a, int b, int h, int qb) {
    constexpr int NKS = QK8 ? DQK / 64 : DQK / 16, PK = QK8 ? DQK : DQK * 2, PV = 64, KB_BYTES = 64 * PK, VB_BYTES = 128 * PV, NPK = PK / 16, NKP = (64 * NPK + 511) / 512, V_OFF = 3 * KB_BYTES;
    const int tid = opaque_tid(), lane = tid & 63, w = __builtin_amdgcn_readfirstlane(tid >> 6), n = lane & 31, hf = lane >> 5;
    const int nt = 4 * qb + 4, cw = 4 * qb + (w >> 1);
    const int trow = qb * 256 + w * 32 + n;
    const size_t grow = (size_t)b * SEQ + trow;
    bf16x8 qf[QK8 ? 1 : NKS]; i32x8q q8[QK8 ? NKS : 1];
    if (QK8) { const unsigned char* qp = (const unsigned char*)a.Q + grow * a.ldq + h * DQK + hf * 32;
#pragma unroll
      for (int ks = 0; ks < NKS; ++ks) { q8[ks].lo = *(const i32x4q*)(qp + ks * 64); q8[ks].hi = *(const i32x4q*)(qp + ks * 64 + 16); } }
    else { const bf16_t* qp = a.Q + grow * a.ldq + h * DQK + hf * 8;
#pragma unroll
      for (int ks = 0; ks < NKS; ++ks) qf[ks] = *(const bf16x8*)(qp + ks * 16); }
    f32x16 o[4];
#pragma unroll
    for (int dt = 0; dt < 4; ++dt)
#pragma unroll
        for (int r = 0; r < 16; ++r) o[dt][r] = 0.f;
    float m_run = -1000.0f, l_run = 0.f;
    const unsigned char* Kg = (const unsigned char*)a.K + ((size_t)b * SEQ * a.ldk + h * DQK) * (QK8 ? 1 : 2);
    const unsigned char* Vg = (const unsigned char*)a.VT + (size_t)(b * 8 + h) * 128 * SEQ;
    const unsigned long long* Mg = MASKED ? a.MT + (size_t)b * 256 * SEQ + trow : nullptr;
    auto dma_k = [&](int kt) {
        LAS unsigned char* kb = lds + (kt % 3) * KB_BYTES;
#pragma unroll
        for (int i = 0; i < NKP; ++i) { if ((w + 8 * i) * 64 >= 64 * NPK) break;
            const int s = (w + 8 * i) * 64 + lane, r = s / NPK, cp = s % NPK, cc = cp ^ (NPK == 16 ? (r & 15) : (NPK == 12 ? ((r >> 2) & 3) : ((r >> 1) & 7)));
            __builtin_amdgcn_global_load_lds((const unsigned*)(Kg + ((size_t)(kt * 64 + r) * a.ldk) * (QK8 ? 1 : 2) + cc * 16), (LAS unsigned*)(kb + (w + 8 * i) * 1024), 16, 0, 0); }
    };
    auto dma_v = [&](int kt) {
        LAS unsigned char* vb = lds + V_OFF + (kt & 1) * VB_BYTES;
        const int s = w * 64 + lane, d = s >> 2, cp = s & 3, cc = cp ^ ((d >> 2) & 3);
        __builtin_amdgcn_global_load_lds((const unsigned*)(Vg + (size_t)d * SEQ + kt * 64 + cc * 16), (LAS unsigned*)(vb + w * 1024), 16, 0, 0);
    };
    const int kswz = (NPK == 16) ? (n & 15) : (NPK == 12 ? ((n >> 2) & 3) : ((n >> 1) & 7)), vswz = (n >> 2) & 3;
    auto qk = [&](int kt, f32x16& s0, f32x16& s1, bool fence, float init) {
        const LAS unsigned char* ka = lds + (kt % 3) * KB_BYTES + n * PK;
#pragma unroll
        for (int r = 0; r < 16; ++r) { s0[r] = init; s1[r] = init; }
        if (QK8) {
#pragma unroll
            for (int ks = 0; ks < NKS; ++ks) {
                const int p0 = ((4 * ks + 2 * hf) ^ kswz) * 16, p1 = ((4 * ks + 2 * hf + 1) ^ kswz) * 16;
                i32x8q a0, a1;
                a0.lo = *(const LAS i32x4q*)(ka + p0); a0.hi = *(const LAS i32x4q*)(ka + p1);
                a1.lo = *(const LAS i32x4q*)(ka + 32 * PK + p0); a1.hi = *(const LAS i32x4q*)(ka + 32 * PK + p1);
                s0 = __builtin_amdgcn_mfma_scale_f32_32x32x64_f8f6f4(a0, q8[ks], s0, 0, 0, 0, 0x7F7F7F7F, 0, 0x7C7C7C7C);
                s1 = __builtin_amdgcn_mfma_scale_f32_32x32x64_f8f6f4(a1, q8[ks], s1, 0, 0, 0, 0x7F7F7F7F, 0, 0x7C7C7C7C);
                if (ks == NKS - 1 && fence) MFMA8_FENCE2(s0, s1, a0, a1);
            }
        } else {
#pragma unroll
            for (int ks = 0; ks < NKS; ++ks) {
                const int po = ((2 * ks + hf) ^ kswz) * 16;
                const bf16x8 a0 = *(const LAS bf16x8*)(ka + po), a1 = *(const LAS bf16x8*)(ka + 32 * PK + po);
                s0 = __builtin_amdgcn_mfma_f32_32x32x16_bf16(a0, qf[ks], s0, 0, 0, 0);
                s1 = __builtin_amdgcn_mfma_f32_32x32x16_bf16(a1, qf[ks], s1, 0, 0, 0);
            }
        }
    };
    i32x8q idA0, idA1;
#pragma unroll
    for (int i = 0; i < 8; ++i) { const int v = (i == (n >> 2)) ? (0x38 << (8 * (n & 3))) : 0; idA0[i] = hf ? 0 : v; idA1[i] = hf ? v : 0; }
    auto maskmma = [&](unsigned long long mw, f32x16& s0, f32x16& s1, bool fence) {
        if (MASKED) {
            const unsigned bits = hf ? (unsigned)(mw >> 32) : (unsigned)mw;
            const LAS u32x2* tbl = (const LAS u32x2*)(lds + ATT_MTBL);
            i32x8q bm;
#pragma unroll
            for (int i = 0; i < 4; ++i) { const u32x2 t = tbl[(bits >> (8 * i)) & 255u]; bm[2 * i] = (int)t.x; bm[2 * i + 1] = (int)t.y; }
            s0 = __builtin_amdgcn_mfma_scale_f32_32x32x64_f8f6f4(idA0, bm, s0, 0, 0, 0, 0x7F7F7F7F, 0, (int)0x82828282);
            s1 = __builtin_amdgcn_mfma_scale_f32_32x32x64_f8f6f4(idA1, bm, s1, 0, 0, 0, 0x7F7F7F7F, 0, (int)0x82828282);
            MFMA8_FENCE2(s0, s1, idA1, bm);
        }
    };
    auto rowmax = [&](f32x16& s0, f32x16& s1) -> float {
        float mx = max3_asm(s0[0], s1[0], s0[1]);
        mx = max3_asm(mx, s1[1], s0[2]);
#pragma unroll
        for (int r = 2; r < 15; ++r) mx = max3_asm(mx, s1[r], s0[r + 1]);
        mx = max3_asm(mx, s1[15], mx);
        const auto rr = __builtin_amdgcn_permlane32_swap(__float_as_uint(mx), __float_as_uint(mx), false, false);
        return fmaxf(__uint_as_float(rr[0]), __uint_as_float(rr[1]));
    };
    auto pv = [&](const f32x16& c0, const f32x16& c1, int kt, bool fence) {
        i32x8q pb;
#pragma unroll
        for (int i = 0; i < 4; ++i) { int d0 = 0, d1 = 0;
            d0 = __builtin_amdgcn_cvt_pk_fp8_f32(c0[4 * i], c0[4 * i + 1], d0, false); d0 = __builtin_amdgcn_cvt_pk_fp8_f32(c0[4 * i + 2], c0[4 * i + 3], d0, true);
            d1 = __builtin_amdgcn_cvt_pk_fp8_f32(c1[4 * i], c1[4 * i + 1], d1, false); d1 = __builtin_amdgcn_cvt_pk_fp8_f32(c1[4 * i + 2], c1[4 * i + 3], d1, true);
            pb[i] = d0; pb[4 + i] = d1; }
        const LAS unsigned char* va = lds + V_OFF + (kt & 1) * VB_BYTES + n * PV;
        const int q0_ = ((2 * hf) ^ vswz) * 16, q1_ = ((2 * hf + 1) ^ vswz) * 16;
#pragma unroll
        for (int dt = 0; dt < 4; ++dt) { i32x8q vf; vf.lo = *(const LAS i32x4q*)(va + dt * 32 * PV + q0_); vf.hi = *(const LAS i32x4q*)(va + dt * 32 * PV + q1_);
            o[dt] = __builtin_amdgcn_mfma_scale_f32_32x32x64_f8f6f4(vf, pb, o[dt], 0, 0, 0, 0x7F7F7F7F, 0, 0x79797979);
            if (dt == 3) MFMA8_FENCE4(o[0], o[1], o[2], o[3], vf, pb); }
    };
    dma_k(0); dma_v(0); if (nt > 1) dma_k(1);
    unsigned long long mw_pre = MASKED ? Mg[(size_t)(nt > 1 ? 1 : 0) * SEQ] : 0ull;
    asm volatile("s_waitcnt vmcnt(0)" ::: "memory");
    __syncthreads();
    f32x16 sa0, sa1, sb0, sb1;
    float ba = m_run, bb = m_run;
    qk(0, sa0, sa1, true, 6.0f - ba); maskmma(MASKED ? Mg[0] : 0ull, sa0, sa1, true);
    float mx_cur = rowmax(sa0, sa1);
    auto step = [&](int kt, f32x16& c0, f32x16& c1, f32x16& n0, f32x16& n1, float& bc, float& bn, auto full_tag) {
        constexpr bool FULL = decltype(full_tag)::value;
        if (kt + 2 < nt) dma_k(kt + 2);
        if (kt + 1 < nt) dma_v(kt + 1);
        const unsigned long long mw_now = mw_pre;
        if (MASKED) mw_pre = Mg[(size_t)(kt + 2 < nt ? kt + 2 : kt) * SEQ];
        const bool act = FULL || kt <= cw, actn = FULL || kt + 1 <= cw;
        const float mx_abs = mx_cur + (bc - 6.0f);
        const bool grew = act && __any(mx_abs > m_run + 2.5f);
        const float m_new = grew ? fmaxf(m_run, mx_abs) : m_run;
        if (grew) {
            const float al = __builtin_amdgcn_exp2f(m_run - m_new), d = m_new - bc;
            l_run *= al;
#pragma unroll
            for (int dt = 0; dt < 4; ++dt)
#pragma unroll
                for (int r = 0; r < 16; ++r) o[dt][r] *= al;
#pragma unroll
            for (int r = 0; r < 16; ++r) { c0[r] -= d; c1[r] -= d; }
        }
        if (act) m_run = m_new;
        auto sm = [&]() {
            float ps = 0.f;
#pragma unroll
            for (int r = 0; r < 16; ++r) { c0[r] = __builtin_amdgcn_exp2f(c0[r]); c1[r] = __builtin_amdgcn_exp2f(c1[r]); ps += c0[r] + c1[r]; }
            l_run += ps;
        };
        if (FULL) {
            bn = m_run;
            qk(kt + 1, n0, n1, !MASKED, 6.0f - bn); maskmma(mw_now, n0, n1, true);
            sm();
            pv(c0, c1, kt, true);
            mx_cur = rowmax(n0, n1);
        } else {
            if (actn) { bn = m_run; qk(kt + 1, n0, n1, true, 6.0f - bn); maskmma(mw_now, n0, n1, true); }
            if (act) { sm(); pv(c0, c1, kt, true); }
            if (actn) mx_cur = rowmax(n0, n1);
        }
        asm volatile("s_waitcnt vmcnt(0)" ::: "memory");
        __syncthreads();
    };
    int kt = 0;
    for (; kt < 4 * qb; kt += 2) { step(kt, sa0, sa1, sb0, sb1, ba, bb, TTrue{}); step(kt + 1, sb0, sb1, sa0, sa1, bb, ba, TTrue{}); }
    for (; kt < nt; kt += 2) { step(kt, sa0, sa1, sb0, sb1, ba, bb, TFalse{}); step(kt + 1, sb0, sb1, sa0, sa1, bb, ba, TFalse{}); }
    const float lt = l_run + __shfl_xor(l_run, 32);
    const float inv = 64.0f / lt;
    bf16_t* op = a.O + grow * a.ldo + h * 128 + hf * 4;
#pragma unroll
    for (int dt = 0; dt < 4; ++dt)
#pragma unroll
        for (int r4 = 0; r4 < 4; ++r4) { u32x2 wv; wv.x = cvtpk(o[dt][4 * r4] * inv, o[dt][4 * r4 + 1] * inv); wv.y = cvtpk(o[dt][4 * r4 + 2] * inv, o[dt][4 * r4 + 3] * inv);
            *(u32x2*)(op + dt * 32 + r4 * 8) = wv; }
}
template <int DQK, bool MASKED>
__device__ __forceinline__ void attn_phase(LAS unsigned char* lds, const AttnArgs& a, int bid, int nblk) {
    if (MASKED) {
        const int t = opaque_tid();
        if (t < 256) { unsigned lo = 0u, hi = 0u;
#pragma unroll
            for (int i = 0; i < 4; ++i) { if (!((t >> i) & 1)) lo |= 0xFEu << (8 * i); if (!((t >> (4 + i)) & 1)) hi |= 0xFEu << (8 * i); }
            u32x2 v; v.x = lo; v.y = hi; ((LAS u32x2*)(lds + ATT_MTBL))[t] = v; }
        __syncthreads();
    }
    for (int p = bid; p < 512; p += nblk) {
        const int bh = (p & 7) + 8 * (p >> 8), j = (p >> 3) & 31;
#pragma unroll 1
        for (int i = 0; i < 2; ++i) attn_item3<DQK, MASKED, true>(lds, a, bh >> 3, bh & 7, i ? j : 63 - j);
    }
}

#ifdef IDX_PROBE_FINAL
#define IDX_PF_ 1
#else
#define IDX_PF_ 0
#endif
typedef _Float16 f16x8 __attribute__((ext_vector_type(8)));
struct IdxArgs { const unsigned short* QI; const unsigned short* KI16; const float* WI; unsigned long long* MT; };
static constexpr int IDX_CAP = 640, IDX_CS = 0, IDX_CI = 32 * IDX_CAP * 4, IDX_KT = IDX_CI + 32 * IDX_CAP * 2, IDX_CNT = IDX_KT + 32768, IDX_TAU = IDX_CNT + 128, IDX_LDS = IDX_TAU + 128;
static_assert(IDX_KT % 1024 == 0, "K tile buffers must be 1 KiB aligned");

__device__ __forceinline__ float ord_inv(unsigned T) { return __uint_as_float((T & 0x80000000u) ? (T & 0x7FFFFFFFu) : ~T); }
__device__ __forceinline__ unsigned lane_prefix(unsigned long long m) { return __builtin_amdgcn_mbcnt_hi((unsigned)(m >> 32), __builtin_amdgcn_mbcnt_lo((unsigned)m, 0u)); }
__device__ __forceinline__ float relu_asm(float x) { float y; asm("v_max_f32 %0, 0, %1" : "=v"(y) : "v"(x)); return y; }
__device__ __forceinline__ void glds16(const void* gsrc, unsigned lds_dst) {
    unsigned keep;
    asm volatile("s_mov_b32 %0, m0\n\ts_mov_b32 m0, %2\n\ts_nop 0\n\tglobal_load_lds_dwordx4 %1, off\n\ts_mov_b32 m0, %0" : "=&s"(keep) : "v"(gsrc), "s"(lds_dst) : "memory");
}

template <bool EXACT> __device__ __forceinline__ int idx_compact(LAS unsigned char* lds, int qq, int lane, int n, float& tau) {
    LAS float* cs = (LAS float*)(lds + IDX_CS) + qq * IDX_CAP; LAS unsigned short* ci = (LAS unsigned short*)(lds + IDX_CI) + qq * IDX_CAP;
    float sv[10]; unsigned short iv[10]; unsigned uk[10];
#pragma unroll
    for (int j = 0; j < 10; ++j) { const int idx = lane + 64 * j; const bool valid = idx < n; sv[j] = cs[idx]; iv[j] = ci[idx]; uk[j] = valid ? ord_key(sv[j]) : 0u; }
    auto count_ge = [&](unsigned t) { int c = 0;
#pragma unroll
        for (int j = 0; j < 10; ++j) c += __builtin_popcountll(__ballot(uk[j] >= t));
        return c; };
    unsigned lo = ord_key(tau), hi = 0xFF800001u;
    if (lo > 0x80800000u) { const unsigned h2 = lo + 0x00800000u;
        if (h2 < hi) { if (count_ge(h2) >= 256) lo = h2; else hi = h2; } }
    while (hi - lo > 1u) {
        const unsigned mid = lo + ((hi - lo) >> 1); const int c = count_ge(mid);
        if (c >= 256) { lo = mid; if (EXACT ? (c == 256) : (c <= 336)) break; } else hi = mid;
    }
    const unsigned T = lo;
    int need = 0;
    if (EXACT) { int ngt = 0;
#pragma unroll
        for (int j = 0; j < 10; ++j) ngt += __builtin_popcountll(__ballot(uk[j] > T));
        need = 256 - ngt; }
    int base = 0, tiebase = 0;
#pragma unroll
    for (int j = 0; j < 10; ++j) {
        bool keep;
        if (EXACT) { const bool gt = uk[j] > T, eq = uk[j] == T; const unsigned long long em = __ballot(eq); keep = gt || (eq && (tiebase + (int)lane_prefix(em)) < need); tiebase += __builtin_popcountll(em); }
        else keep = uk[j] >= T;
        const unsigned long long km = __ballot(keep);
        const int pos = base + (int)lane_prefix(km);
        if (keep) { cs[pos] = sv[j]; ci[pos] = iv[j]; }
        base += __builtin_popcountll(km);
    }
    tau = ord_inv(T);
    return base;
}

__device__ __forceinline__ void idx_item(LAS unsigned char* lds, const IdxArgs& a, int b, int hc) {
    const int tid = opaque_tid(), lane = tid & 63, w = __builtin_amdgcn_readfirstlane(tid >> 6), n = lane & 31, hf = lane >> 5;
    const int t0 = hc * 32, L = (t0 / 64 + 1) * 64, nsub = L / 32, ntile = (L + 127) / 128;
    const size_t q0 = (size_t)b * SEQ + t0 + 4 * w;
    LAS float* cs = (LAS float*)(lds + IDX_CS); LAS unsigned short* ci = (LAS unsigned short*)(lds + IDX_CI);
    LAS unsigned* cnt = (LAS unsigned*)(lds + IDX_CNT);
    f16x8 qf[2][4];
#pragma unroll
    for (int rt = 0; rt < 2; ++rt) { const unsigned short* qp = a.QI + (q0 + 2 * rt + (n >> 4)) * 1024 + (n & 15) * 64 + hf * 8;
#pragma unroll
        for (int ks = 0; ks < 4; ++ks) qf[rt][ks] = *(const f16x8*)(qp + ks * 16); }
    float wv[2][16];
#pragma unroll
    for (int rt = 0; rt < 2; ++rt)
#pragma unroll
        for (int r = 0; r < 16; ++r) wv[rt][r] = a.WI[(q0 + 2 * rt + (r >> 3)) * 16 + (((r & 3) + 8 * (r >> 2) + 4 * hf) & 15)] * (0.125f * 0.25f);
    if (tid < 32) cnt[tid] = 0u;
    int cq0 = 0, cq1 = 0, cq2 = 0, cq3 = 0;
    float tq0 = -INFINITY, tq1 = -INFINITY, tq2 = -INFINITY, tq3 = -INFINITY;
    float tau0 = INFINITY, tau1 = INFINITY;
    const unsigned short* Kg = a.KI16 + (size_t)b * SEQ * 64;
    const unsigned ldsbase = (unsigned)(size_t)lds;
    auto dma = [&](int kt, int buf) {
#pragma unroll
        for (int i = 0; i < 2; ++i) { const int s = (w + 8 * i) * 64 + lane, r = s >> 3, cp = s & 7, cc = cp ^ ((r >> 1) & 7);
            glds16(Kg + (size_t)(kt * 128 + r) * 64 + cc * 8, ldsbase + IDX_KT + buf * 16384 + (w + 8 * i) * 1024); }
    };
    dma(0, 0);
    asm volatile("s_waitcnt vmcnt(0)" ::: "memory");
    __syncthreads();
    const int kswz = (n >> 1) & 7;
    f32x16 accA[2], accB[2];
#pragma unroll
    for (int rt = 0; rt < 2; ++rt)
#pragma unroll
        for (int r = 0; r < 16; ++r) { accA[rt][r] = 0.f; accB[rt][r] = 0.f; }
    int keyA = 0, keyB = 0;
    auto epilogue = [&](const f32x16 (&acc)[2], int key) {
        float sc[2];
#pragma unroll
        for (int rt = 0; rt < 2; ++rt) { float pa = 0.f, pb = 0.f;
#pragma unroll
            for (int r = 0; r < 8; ++r) { pa = fmaf(relu_asm(acc[rt][r]), wv[rt][r], pa); pb = fmaf(relu_asm(acc[rt][r + 8]), wv[rt][r + 8], pb); }
            const auto rr = __builtin_amdgcn_permlane32_swap(__float_as_uint(pa), __float_as_uint(pb), false, false);
            sc[rt] = __uint_as_float(rr[0]) + __uint_as_float(rr[1]); }
        const bool c0 = sc[0] > tau0, c1 = sc[1] > tau1;
        const unsigned long long m0 = __ballot(c0), m1 = __ballot(c1);
        {
            const unsigned l0 = (unsigned)m0, h0 = (unsigned)(m0 >> 32), l1 = (unsigned)m1, h1 = (unsigned)(m1 >> 32);
            const int p0 = hf ? cq1 + (int)__builtin_amdgcn_mbcnt_hi(h0, 0u) : cq0 + (int)__builtin_amdgcn_mbcnt_lo(l0, 0u);
            const int p1 = hf ? cq3 + (int)__builtin_amdgcn_mbcnt_hi(h1, 0u) : cq2 + (int)__builtin_amdgcn_mbcnt_lo(l1, 0u);
            if (c0 && p0 < IDX_CAP) { const int qq = 4 * w + hf; cs[qq * IDX_CAP + p0] = sc[0]; ci[qq * IDX_CAP + p0] = (unsigned short)key; }
            if (c1 && p1 < IDX_CAP) { const int qq = 4 * w + 2 + hf; cs[qq * IDX_CAP + p1] = sc[1]; ci[qq * IDX_CAP + p1] = (unsigned short)key; }
            cq0 += __builtin_popcount(l0); cq1 += __builtin_popcount(h0); cq2 += __builtin_popcount(l1); cq3 += __builtin_popcount(h1);
        }
    };
    f16x8 kfA[4], kfB[4];
    auto ldk = [&](f16x8 (&kf)[4], const LAS unsigned char* kr) {
#pragma unroll
        for (int ks = 0; ks < 4; ++ks) kf[ks] = *(const LAS f16x8*)(kr + ((2 * ks + hf) ^ kswz) * 16);
    };
    auto mma = [&](f32x16 (&acc)[2], const f16x8 (&kf)[4]) {
#pragma unroll
        for (int rt = 0; rt < 2; ++rt) {
            f32x16 c;
#pragma unroll
            for (int r = 0; r < 16; ++r) c[r] = 0.f;
#pragma unroll
            for (int ks = 0; ks < 4; ++ks) c = __builtin_amdgcn_mfma_f32_32x32x16_f16(qf[rt][ks], kf[ks], c, 0, 0, 0);
            acc[rt] = c; }
    };
#ifdef IDX_PROBE2
  for (int rep_ = 0; rep_ < 2; ++rep_) {
    if (rep_ == 1) { epilogue(accB, keyB); tau0 = INFINITY; tau1 = INFINITY; __syncthreads(); dma(0, 0); asm volatile("s_waitcnt vmcnt(0)" ::: "memory"); __syncthreads(); }
#endif
    for (int kt = 0; kt < ntile; ++kt) {
        if (kt + 1 < ntile) dma(kt + 1, (kt + 1) & 1);
#ifdef IDX_PROBE2
        if (rep_ == 0)
#endif
        { const unsigned c_all = cnt[lane & 31];
          if (__ballot(c_all > (unsigned)(IDX_CAP - (kt == ntile - 1 ? 160 : 128)))) {
#pragma unroll 1
              for (int i = 0; i < 4; ++i) {
                  int cqi = (i == 0) ? cq0 : ((i == 1) ? cq1 : ((i == 2) ? cq2 : cq3));
                  if (cqi > 336) { float tqi = (i == 0) ? tq0 : ((i == 1) ? tq1 : ((i == 2) ? tq2 : tq3));
                      cqi = idx_compact<false>(lds, 4 * w + i, lane, cqi, tqi);
                      if (i == 0) { cq0 = cqi; tq0 = tqi; } else if (i == 1) { cq1 = cqi; tq1 = tqi; } else if (i == 2) { cq2 = cqi; tq2 = tqi; } else { cq3 = cqi; tq3 = tqi; } }
              }
              if (kt > 0) { tau0 = hf ? tq1 : tq0; tau1 = hf ? tq3 : tq2; }
          } }
        const LAS unsigned char* kb = lds + IDX_KT + (kt & 1) * 16384 + n * 128;
        const int sbase = kt * 4;
#ifdef IDX_PROBE2
        if (sbase + 0 < nsub) { ldk(kfA, kb); if (sbase + 1 < nsub) ldk(kfB, kb + 32 * 128); mma(accA, kfA); epilogue(accB, keyB); keyA = kt * 128 + n; if (kt == 0 && rep_ == 0) { tau0 = -INFINITY; tau1 = -INFINITY; } }
#else
        if (sbase + 0 < nsub) { ldk(kfA, kb); if (sbase + 1 < nsub) ldk(kfB, kb + 32 * 128); mma(accA, kfA); epilogue(accB, keyB); keyA = kt * 128 + n; if (kt == 0) { tau0 = -INFINITY; tau1 = -INFINITY; } }
#endif
        if (sbase + 1 < nsub) { if (sbase + 2 < nsub) ldk(kfA, kb + 64 * 128); mma(accB, kfB); epilogue(accA, keyA); keyB = kt * 128 + 32 + n; }
        if (sbase + 2 < nsub) { if (sbase + 3 < nsub) ldk(kfB, kb + 96 * 128); mma(accA, kfA); epilogue(accB, keyB); keyA = kt * 128 + 64 + n; }
        if (sbase + 3 < nsub) { mma(accB, kfB); epilogue(accA, keyA); keyB = kt * 128 + 96 + n; }
        if (lane < 4) cnt[4 * w + lane] = (unsigned)(lane == 0 ? cq0 : (lane == 1 ? cq1 : (lane == 2 ? cq2 : cq3)));
        asm volatile("s_waitcnt vmcnt(0)" ::: "memory");
        __syncthreads();
    }
#ifdef IDX_PROBE2
  }
#endif
    epilogue(accB, keyB);
    __syncthreads();
    const int lane2 = opaque_tid() & 63;
    LAS unsigned* bm = (LAS unsigned*)(lds + IDX_KT) + w * 512;
#ifdef IDX_PROBE_FINAL
  for (int rep2_ = 0; rep2_ < 2; ++rep2_) {
#endif
#pragma unroll 1
    for (int i = 0; i < 4; ++i) {
        const int qq = 4 * w + i;
        int nsel = (i == 0) ? cq0 : ((i == 1) ? cq1 : ((i == 2) ? cq2 : cq3));
        if (nsel > 256 - IDX_PF_) { float tqi = (i == 0) ? tq0 : ((i == 1) ? tq1 : ((i == 2) ? tq2 : tq3)); nsel = idx_compact<true>(lds, qq, lane2, nsel, tqi); }
#pragma unroll
        for (int j = 0; j < 8; ++j) bm[lane2 + 64 * j] = 0u;
#pragma unroll
        for (int j = 0; j < 4; ++j) { const int idx = lane2 + 64 * j; if (idx < nsel) { const unsigned k = ci[qq * IDX_CAP + idx]; (void)__hip_atomic_fetch_or(bm + (k >> 5), 1u << (k & 31), __ATOMIC_RELAXED, __HIP_MEMORY_SCOPE_WORKGROUP); } }
        const int tq = t0 + qq;
#pragma unroll 1
        for (int kt = lane2; kt < L / 64; kt += 64) { const unsigned long long v = (unsigned long long)bm[2 * kt] | ((unsigned long long)bm[2 * kt + 1] << 32); a.MT[((size_t)b * 256 + kt) * SEQ + tq] = v; }
    }
#ifdef IDX_PROBE_FINAL
  }
#endif
    __syncthreads();
}
__device__ __forceinline__ void idx_phase(LAS unsigned char* lds, const IdxArgs& a, int bid, int nblk) {
    for (int k = bid; k < 256; k += nblk) {
#pragma unroll 1
        for (int i = 0; i < 4; ++i) idx_item(lds, a, i & 1, (i < 2) ? 511 - k : k);
    }
}
#define XB_TMO      128
#define XB_XCNT(j)  (256  + 64 * (j))
#define XB_XSUB(j)  (1280 + 64 * (j))
#define XB_XGEN(j)  (2304 + 64 * (j))
#define XB_TOP      3328
#define XB_TOPGEN   3392
#define XCD_BAR_WORDS 3456
#define XB_SPIN_CAP (1u << 23)


__device__ __forceinline__ unsigned xb_ld(unsigned* p)              { return __hip_atomic_load(p, __ATOMIC_RELAXED, __HIP_MEMORY_SCOPE_AGENT); }
__device__ __forceinline__ unsigned xb_add(unsigned* p, unsigned v) { return __hip_atomic_fetch_add(p, v, __ATOMIC_RELAXED, __HIP_MEMORY_SCOPE_AGENT); }
__device__ __forceinline__ unsigned xb_xcc_id() { return (unsigned)__builtin_amdgcn_s_getreg((3 << 11) | 20) & 0xFu; }
#define XB_SPIN(cond, bar) do { unsigned _sp = 0; while (cond) { __builtin_amdgcn_s_sleep(1); \
    if ((++_sp & 255u) == 0u) { if (xb_ld(&(bar)[XB_TMO])) break; if (_sp > XB_SPIN_CAP) { atomicAdd(&(bar)[XB_TMO], 1u); break; } } } } while (0)

struct XcdBarrier {
    unsigned* bar; unsigned x;
    volatile LAS unsigned* st;
};

__device__ __forceinline__ XcdBarrier xcd_barrier_post(unsigned* bar, volatile LAS unsigned* st) {
    XcdBarrier b; b.bar = bar; b.x = xb_xcc_id(); b.st = st;
    if (threadIdx.x == 0) (void)xb_add(&bar[XB_XCNT(b.x)], 1u);
    return b;
}
__device__ __forceinline__ void xcd_barrier_complete(unsigned* bar, unsigned x, unsigned& nloc, unsigned& nx) {
    const unsigned G = gridDim.x * gridDim.y * gridDim.z;
    unsigned sum, cnt, mine, sp = 0u;
    for (;;) {
        sum = 0u; cnt = 0u; mine = 0u;
#pragma unroll
        for (unsigned j = 0; j < 16; ++j) { const unsigned c = xb_ld(&bar[XB_XCNT(j)]); sum += c; cnt += (c > 0u) ? 1u : 0u; mine = (j == x) ? c : mine; }
        if (sum == G) break;
        __builtin_amdgcn_s_sleep(1);
        if ((++sp & 255u) == 0u) { if (xb_ld(&bar[XB_TMO])) break; if (sp > XB_SPIN_CAP) { atomicAdd(&bar[XB_TMO], 1u); break; } }
    }
    nloc = mine > 0u ? mine : 1u; nx = cnt > 0u ? cnt : 1u;
}

__device__ __forceinline__ void xcd_barrier(const XcdBarrier& b) {
    asm volatile("s_waitcnt vmcnt(0)" ::: "memory");
    __syncthreads();
    if (threadIdx.x == 0) {
        unsigned* bar = b.bar;
        __builtin_amdgcn_s_waitcnt(0);
        unsigned nloc = b.st[0], nx = b.st[1];
        if (nloc == 0u) { xcd_barrier_complete(bar, b.x, nloc, nx); b.st[0] = nloc; b.st[1] = nx; }
        const unsigned old = xb_add(&bar[XB_XSUB(b.x)], 1u);
        const unsigned gen = old / nloc;
        if (old + 1u == (gen + 1u) * nloc) {
            __builtin_amdgcn_fence(__ATOMIC_RELEASE, "agent");
            asm volatile("s_waitcnt vmcnt(0)" ::: "memory");
            const unsigned og = xb_add(&bar[XB_TOP], 1u);
            const unsigned tg = og / nx;
            if (og + 1u == (tg + 1u) * nx) xb_add(&bar[XB_TOPGEN], 1u);
            else XB_SPIN(xb_ld(&bar[XB_TOPGEN]) == tg, bar);
            __builtin_amdgcn_fence(__ATOMIC_ACQUIRE, "agent");
            xb_add(&bar[XB_XGEN(b.x)], 1u);
            asm volatile("s_waitcnt vmcnt(0)" ::: "memory");
        } else {
            XB_SPIN(xb_ld(&bar[XB_XGEN(b.x)]) == gen, bar);
            __builtin_amdgcn_fence(__ATOMIC_ACQUIRE, "agent");
            asm volatile("s_waitcnt vmcnt(0)" ::: "memory");
        }
    }
    __syncthreads();
}

#ifndef FP8_QKV
#define FP8_QKV 1
#endif
#ifndef FP8_UP0
#define FP8_UP0 0
#endif
#ifndef FP8_UP1
#define FP8_UP1 1
#endif
#ifndef FP8_DN0
#define FP8_DN0 0
#endif
#ifndef FP8_DN1
#define FP8_DN1 1
#endif
#ifndef SKIPMASK
#define SKIPMASK 0
#endif

__device__ __forceinline__ int perm16(int t) { const int a = (t >> 2) & 3; return (t & ~12) | ((a == 1 ? 2 : (a == 2 ? 1 : a)) << 2); }
__device__ __forceinline__ void st_vt16(bf16_t* VT, int row, int h, int d, f32x4 v) {
    const int b = row / SEQ, t = row % SEQ; bf16_t* p = VT + ((size_t)(b * 8 + h) * 128 + d) * SEQ + (t & ~15) + perm16(t & 15);
    p[0] = f2bf(v[0]); p[SEQ] = f2bf(v[1]); p[2 * (size_t)SEQ] = f2bf(v[2]); p[3 * (size_t)SEQ] = f2bf(v[3]);
}
__device__ __forceinline__ int perm64(int kk) { const int sub = kk >> 5, k5 = kk & 31; return 32 * ((k5 >> 2) & 1) + 16 * sub + (((k5 >> 3) << 2) | (k5 & 3)); }
__device__ __forceinline__ void st_vt8(bf16_t* VT_, int row, int h, int d, f32x4 v) {
    const int b = row / SEQ, t = row % SEQ; unsigned char* p = (unsigned char*)VT_ + ((size_t)(b * 8 + h) * 128 + d) * SEQ + (t & ~63) + perm64(t & 63);
    const int pk0 = __builtin_amdgcn_cvt_pk_fp8_f32(v[0], v[1], 0, false), pk1 = __builtin_amdgcn_cvt_pk_fp8_f32(v[2], v[3], 0, false);
    p[0] = (unsigned char)(pk0 & 0xFF); p[SEQ] = (unsigned char)((pk0 >> 8) & 0xFF); p[2 * (size_t)SEQ] = (unsigned char)(pk1 & 0xFF); p[3 * (size_t)SEQ] = (unsigned char)((pk1 >> 8) & 0xFF);
}
__device__ __forceinline__ void st_fp8x4(unsigned char* p, f32x4 v) { int pk = 0; pk = __builtin_amdgcn_cvt_pk_fp8_f32(v[0], v[1], pk, false); pk = __builtin_amdgcn_cvt_pk_fp8_f32(v[2], v[3], pk, true); *(int*)p = pk; }
static constexpr float QS_DSA = 0.08838834764831845f * 1.4426950408889634f * 8.0f, QS_MLA = 0.07216878364870322f * 1.4426950408889634f * 8.0f;
struct FAbIn2 { unsigned char *Q, *K; bf16_t* VT; unsigned short* QI; float *U, *WI; unsigned short* KI16;
    __device__ __forceinline__ void operator()(int r, int c, f32x4 v) const {
        if (c < 1024) st_fp8x4(Q + (size_t)r * 1024 + c, v * QS_DSA);
        else if (c < 2048) st_fp8x4(K + (size_t)r * 1024 + (c - 1024), v);
        else if (c < 3072) { if (PV8_DSA) st_vt8(VT, r, (c - 2048) >> 7, (c - 2048) & 127, v); else st_vt16(VT, r, (c - 2048) >> 7, (c - 2048) & 127, v); }
        else if (c < 4096) { typedef _Float16 h2 __attribute__((ext_vector_type(2))); union { h2 h; unsigned u; } a, b; a.h = (h2){(_Float16)v[0], (_Float16)v[1]}; b.h = (h2){(_Float16)v[2], (_Float16)v[3]};
            u32x2 w; w.x = a.u; w.y = b.u; *(u32x2*)(QI + (size_t)r * 1024 + (c - 3072)) = w; }
        else if (c < 5120) st_f32x4(U + (size_t)r * 1024 + (c - 4096), v);
        else if (c < 5184) { typedef _Float16 h2 __attribute__((ext_vector_type(2))); union { h2 h; unsigned u; } a, b; a.h = (h2){(_Float16)v[0], (_Float16)v[1]}; b.h = (h2){(_Float16)v[2], (_Float16)v[3]};
            u32x2 w; w.x = a.u; w.y = b.u; *(u32x2*)(KI16 + (size_t)r * 64 + (c - 5120)) = w; }
        else if (c < 5200) st_f32x4(WI + (size_t)r * 16 + (c - 5184), v);
    } };
struct FAbInHi { FAbIn2 f; __device__ __forceinline__ void operator()(int r, int c, f32x4 v) const { f(r, c + 3072, v); } };
struct FKvUp2 { unsigned char* K8; bf16_t* VT;
    __device__ __forceinline__ void operator()(int r, int c, f32x4 v) const {
        const int h = c >> 8, d = c & 255;
        if (d < 128) { int pk = 0; pk = __builtin_amdgcn_cvt_pk_fp8_f32(v[0], v[1], pk, false); pk = __builtin_amdgcn_cvt_pk_fp8_f32(v[2], v[3], pk, true); *(int*)(K8 + (size_t)r * 1536 + h * 192 + d) = pk; }
        else { if (PV8_MLA) st_vt8(VT, r, h, d - 128, v); else st_vt16(VT, r, h, d - 128, v); }
    } };

template <class E> __device__ __forceinline__ void ph_gemm_e(LAS unsigned char* lds, const bf16_t* A, int lda, const bf16_t* Bt, int ldb, int M, int N, int K, const E& e, int bid, int nblk, int a_shift = 0, int a_bytes = 0, int cmode = 0, int skew = 0) {
    pg8::Gemm g; g.A = A; g.Bt = Bt; g.M = M; g.N = N; g.K = K; g.lda = lda; g.ldb = ldb; g.a_shift = a_shift; g.a_bytes = a_bytes; g.cmode = cmode;
    pg8::StaticOrder S; S.init(M, N, nblk, bid); S.skew = skew;
    pg8::gemm_phase<E, pg8::StaticOrder, false>(lds, g, S, e, nullptr);
    __syncthreads();
}
template <class F> __device__ __forceinline__ void ph_gemm(LAS unsigned char* lds, const bf16_t* A, int lda, const bf16_t* Bt, int ldb, int M, int N, int K, const F& f, int bid, int nblk, int a_shift = 0, int a_bytes = 0) {
    EpiG<F> e; e.f = f;
    ph_gemm_e(lds, A, lda, Bt, ldb, M, N, K, e, bid, nblk, a_shift, a_bytes);
}
template <class F> __device__ __forceinline__ void ph_gemm8(LAS unsigned char* lds, const unsigned char* A, int lda, const unsigned char* Bt, int ldb, int M, int N, int K, const F& f, int bid, int nblk, int skew = 0) {
    EpiG<F, true> e; e.f = f;
    ph_gemm_e(lds, (const bf16_t*)A, lda / 2, (const bf16_t*)Bt, ldb / 2, M, N, K / 2, e, bid, nblk, 0, 0, 0, skew);
}
template <int CTRL> __device__ __forceinline__ float dpp0(float v) { return __int_as_float(__builtin_amdgcn_update_dpp(0, __float_as_int(v), CTRL, 0xF, 0xF, true)); }
__device__ __forceinline__ float gelu_fast(float x) { const float u2 = 1.5957691216057308f * (x + 0.044715f * x * x * x); return x * __builtin_amdgcn_rcpf(1.0f + __builtin_amdgcn_exp2f(-1.4426950408889634f * u2)); }
template <bool OUT8, bool F8> struct EpiGate {
    static constexpr bool PERM = false, AFTER_DRAIN = false, FP8 = F8;
    const float* cw; const float* cb; void* ACT;
    __device__ __forceinline__ void operator()(const f32x4 (&acc)[2][2][4][2], const pg8::Unit& u, int wr, int wc, int fr, int fq) const {
        const int bt = u.pm / 67, ti = u.pm % 67;
#pragma unroll
        for (int n = 0; n < 2; ++n) {
            const int c = u.pn * 128 + wc * 32 + 16 * n + 4 * fq;
            const f32x4 g0 = *(const f32x4*)(cw + c), g1 = *(const f32x4*)(cw + 8192 + c), g2 = *(const f32x4*)(cw + 16384 + c), gb = *(const f32x4*)(cb + c);
            const f32x4 v0 = *(const f32x4*)(cw + 4096 + c), v1 = *(const f32x4*)(cw + 8192 + 4096 + c), v2 = *(const f32x4*)(cw + 16384 + 4096 + c), vb = *(const f32x4*)(cb + 4096 + c);
            const float w1m = (fr < 1) ? 1.f : 0.f, w2m = (fr < 2) ? 1.f : 0.f;
            const f32x4 g1w = g1 * w1m, g0w = g0 * w2m, v1w = v1 * w1m, v0w = v0 * w2m;
#pragma unroll
            for (int ai = 0; ai < 2; ++ai) {
                const int strip = 2 * ai + wr, tbase = ti * 248 + strip * 62 - 2;
                f32x4 pg = {0.f, 0.f, 0.f, 0.f}, pv = pg;
#pragma unroll
                for (int m = 0; m < 4; ++m) {
                    f32x4 xg = acc[ai][0][m][n], xv = acc[ai][1][m][n];
                    const int t = tbase + 16 * m + fr;
                    if (tbase < 0 && m == 0) { if (t < 0) { xg = (f32x4){0.f, 0.f, 0.f, 0.f}; xv = xg; } }
                    f32x4 og, ov;
#pragma unroll
                    for (int j = 0; j < 4; ++j) {
                        float yg = fmaf(g2[j], xg[j], gb[j]), yv = fmaf(v2[j], xv[j], vb[j]);
                        asm("s_nop 1\n\t"
                            "v_fmac_f32_dpp %0, %2, %6 row_shr:1 row_mask:0xf bank_mask:0xf bound_ctrl:1\n\t"
                            "v_fmac_f32_dpp %1, %3, %10 row_shr:1 row_mask:0xf bank_mask:0xf bound_ctrl:1\n\t"
                            "v_fmac_f32_dpp %0, %2, %7 row_shr:2 row_mask:0xf bank_mask:0xf bound_ctrl:1\n\t"
                            "v_fmac_f32_dpp %1, %3, %11 row_shr:2 row_mask:0xf bank_mask:0xf bound_ctrl:1\n\t"
                            "v_fmac_f32_dpp %0, %4, %8 row_ror:1 row_mask:0xf bank_mask:0xf bound_ctrl:1\n\t"
                            "v_fmac_f32_dpp %1, %5, %12 row_ror:1 row_mask:0xf bank_mask:0xf bound_ctrl:1\n\t"
                            "v_fmac_f32_dpp %0, %4, %9 row_ror:2 row_mask:0xf bank_mask:0xf bound_ctrl:1\n\t"
                            "v_fmac_f32_dpp %1, %5, %13 row_ror:2 row_mask:0xf bank_mask:0xf bound_ctrl:1"
                            : "+v"(yg), "+v"(yv)
                            : "v"(xg[j]), "v"(xv[j]), "v"(pg[j]), "v"(pv[j]), "v"(g1[j]), "v"(g0[j]), "v"(g1w[j]), "v"(g0w[j]), "v"(v1[j]), "v"(v0[j]), "v"(v1w[j]), "v"(v0w[j]));
                        og[j] = gelu_fast(yg) * yv; ov[j] = 0.f;
                    }
                    pg = xg; pv = xv;
                    if (16 * m + fr >= 2 && t < SEQ) {
                        const size_t o = ((size_t)bt * SEQ + t) * 4096 + c;
                        if (OUT8) { int pk = 0; pk = __builtin_amdgcn_cvt_pk_fp8_f32(og[0], og[1], pk, false); pk = __builtin_amdgcn_cvt_pk_fp8_f32(og[2], og[3], pk, true); *(int*)((unsigned char*)ACT + o) = pk; }
                        else st_bf16x4((bf16_t*)ACT + o, og);
                    }
                }
            }
        }
    }
};
struct FPool { bf16_t* CC; const float* pb; const float* ps;
    __device__ __forceinline__ void operator()(int r, int c, f32x4 v) const { const f32x4 b = *(const f32x4*)(pb + c), s = *(const f32x4*)(ps + c); st_bf16x4(CC + (size_t)r * 2048 + 1024 + c, (v + b) * s); } };
__device__ __forceinline__ float one_minus_exp(float x) {
    const float p = -x * (1.0f + x * (0.5f + x * (0.16666667f + x * 0.041666668f))), d = 1.0f - __expf(x);
    return (x > -0.125f) ? p : d;
}
struct EpiLru {
    static constexpr bool PERM = false, AFTER_DRAIN = false, FP8 = false;
    const bf16_t* XCB; const float *ba, *bx, *lam; bf16_t *LA, *LB;
    __device__ __forceinline__ void operator()(const f32x4 (&acc)[2][2][4][2], const pg8::Unit& u, int wr, int wc, int fr, int fq) const {
        const int row0 = u.pm * 256 + wr * 64 + fr;
#pragma unroll
        for (int n = 0; n < 2; ++n) {
            const int ch = u.pn * 128 + wc * 32 + 16 * n + 4 * fq;
            const f32x4 bav = *(const f32x4*)(ba + ch), bxv = *(const f32x4*)(bx + ch), lm = *(const f32x4*)(lam + ch);
            f32x4 sp;
#pragma unroll
            for (int j = 0; j < 4; ++j) sp[j] = log1pf(__expf(-lm[j]));
#pragma unroll
            for (int ai = 0; ai < 2; ++ai)
#pragma unroll
                for (int m = 0; m < 4; ++m) {
                    const int row = row0 + ai * 128 + m * 16;
                    const u32x2 xw = *(const u32x2*)(XCB + (size_t)row * 1024 + ch);
                    const f32x4 xc = {__uint_as_float(xw.x << 16), __uint_as_float(xw.x & 0xFFFF0000u), __uint_as_float(xw.y << 16), __uint_as_float(xw.y & 0xFFFF0000u)};
                    const f32x4 ga = acc[ai][0][m][n] + bav, gx = acc[ai][1][m][n] + bxv;
                    f32x4 av, bv;
#pragma unroll
                    for (int j = 0; j < 4; ++j) {
                        const float rg = __builtin_amdgcn_rcpf(1.0f + __expf(-ga[j])), ig = __builtin_amdgcn_rcpf(1.0f + __expf(-gx[j]));
                        const float log_a = -8.0f * rg * sp[j];
                        av[j] = one_minus_exp(log_a); bv[j] = __builtin_amdgcn_sqrtf(one_minus_exp(2.0f * log_a)) * (ig * xc[j]);
                    }
                    st_bf16x4(LA + (size_t)row * 1024 + ch, av); st_bf16x4(LB + (size_t)row * 1024 + ch, bv);
                }
        }
    }
};
__device__ __forceinline__ void ph_pooled(const float* __restrict__ U, bf16_t* __restrict__ P, int bid, int nblk) {
    for (int i = bid * 512 + opaque_tid(); i < 256 * (NTOK / 64); i += nblk * 512) {
        const int c4 = i & 255, row0 = (i >> 8) * 64, t0 = row0 % SEQ, g = c4 >> 6, win = 2 << g;
        const f32x4* up = (const f32x4*)U + (size_t)row0 * 256 + c4;
        f32x4 s = {0.f, 0.f, 0.f, 0.f};
        if (t0 > 0) { for (int k = 1; k < win; ++k) s += up[-(ptrdiff_t)k * 256]; }
#pragma unroll 8
        for (int r = 0; r < 64; ++r) {
            const int t = t0 + r; const f32x4 u0 = up[(ptrdiff_t)r * 256];
            s += u0;
            const int cnt = (t + 1 < win) ? (t + 1) : win;
            st_bf16x4(P + (size_t)(row0 + r) * 1024 + c4 * 4, s * (1.0f / (float)cnt) - u0);
            if (t + 1 >= win) s -= up[(ptrdiff_t)(r + 1 - win) * 256];
        }
    }
}
__device__ __forceinline__ void ph_xc(const bf16_t* __restrict__ XL, const float* __restrict__ cw, const float* __restrict__ cb, bf16_t* __restrict__ XCB, int bid, int nblk) {
    for (int i = bid * 512 + opaque_tid(); i < 128 * (NTOK / 32); i += nblk * 512) {
        const int c8 = (i & 127) * 8, row0 = (i >> 7) * 32, t0 = row0 % SEQ;
        float w0[8], w1[8], w2[8], w3[8], bb[8];
#pragma unroll
        for (int j = 0; j < 8; ++j) { w0[j] = cw[c8 + j]; w1[j] = cw[1024 + c8 + j]; w2[j] = cw[2048 + c8 + j]; w3[j] = cw[3072 + c8 + j]; bb[j] = cb[c8 + j]; }
        u32x4 p3 = {0u, 0u, 0u, 0u}, p2 = p3, p1 = p3;
        if (t0 >= 3) { p3 = *(const u32x4*)(XL + (size_t)(row0 - 3) * 1024 + c8); p2 = *(const u32x4*)(XL + (size_t)(row0 - 2) * 1024 + c8); p1 = *(const u32x4*)(XL + (size_t)(row0 - 1) * 1024 + c8); }
#pragma unroll 8
        for (int r = 0; r < 32; ++r) {
            const u32x4 cur = *(const u32x4*)(XL + (size_t)(row0 + r) * 1024 + c8);
            const unsigned a3[4] = {p3.x, p3.y, p3.z, p3.w}, a2[4] = {p2.x, p2.y, p2.z, p2.w}, a1[4] = {p1.x, p1.y, p1.z, p1.w}, a0[4] = {cur.x, cur.y, cur.z, cur.w};
            float y[8];
#pragma unroll
            for (int j = 0; j < 4; ++j) {
                y[2 * j] = bb[2 * j] + w0[2 * j] * __uint_as_float(a3[j] << 16) + w1[2 * j] * __uint_as_float(a2[j] << 16) + w2[2 * j] * __uint_as_float(a1[j] << 16) + w3[2 * j] * __uint_as_float(a0[j] << 16);
                y[2 * j + 1] = bb[2 * j + 1] + w0[2 * j + 1] * __uint_as_float(a3[j] & 0xFFFF0000u) + w1[2 * j + 1] * __uint_as_float(a2[j] & 0xFFFF0000u) + w2[2 * j + 1] * __uint_as_float(a1[j] & 0xFFFF0000u) + w3[2 * j + 1] * __uint_as_float(a0[j] & 0xFFFF0000u); }
            u32x4 o; o.x = pack2bf(y[0], y[1]); o.y = pack2bf(y[2], y[3]); o.z = pack2bf(y[4], y[5]); o.w = pack2bf(y[6], y[7]);
            *(u32x4*)(XCB + (size_t)(row0 + r) * 1024 + c8) = o;
            p3 = p2; p2 = p1; p1 = cur;
        }
    }
}
__device__ __forceinline__ int up_src_col(int n0) { return ((n0 >> 7) & 1) * 4096 + (n0 >> 8) * 128 + (n0 & 127); }
template <bool OUT8>
__device__ __forceinline__ void ph_convT_g(LAS unsigned char* lds, const float* __restrict__ W, int ldw, int src_col0, int ncols, int K, void* __restrict__ Bt, int ldd, int bid, int nblk, bool upperm, const float* __restrict__ gk = nullptr) {
    const int tid = opaque_tid(), sub = tid >> 8, t8 = tid & 255;
    LAS float* tile = (LAS float*)lds + sub * (2 * 64 * 65);
    const int ntx = (ncols + 63) / 64, ntiles = ntx * (K / 64);
    for (int base = bid * 4; base < ntiles; base += nblk * 4) {
#pragma unroll
        for (int u = 0; u < 2; ++u) {
            const int tl = base + sub * 2 + u; const bool act = tl < ntiles;
            const int n0 = (tl % ntx) * 64, k0 = (tl / ntx) * 64;
            if (act) {
                const int c4 = (t8 & 15) * 4, kr = t8 >> 4;
                const int nsrc = src_col0 + (upperm ? up_src_col(n0 + c4) : n0 + c4);
                f32x4 v[4];
#pragma unroll
                for (int i = 0; i < 4; ++i) { v[i] = (f32x4){0.f, 0.f, 0.f, 0.f}; if (n0 + c4 < ncols) v[i] = *(const f32x4*)(W + (size_t)(k0 + kr + 16 * i) * ldw + nsrc); if (gk) v[i] = v[i] * gk[k0 + kr + 16 * i]; }
#pragma unroll
                for (int i = 0; i < 4; ++i) { const int kl = kr + 16 * i; LAS float* tp = tile + u * (64 * 65) + kl * 65 + c4; tp[0] = v[i][0]; tp[1] = v[i][1]; tp[2] = v[i][2]; tp[3] = v[i][3]; } }
        }
        __syncthreads();
#pragma unroll
        for (int u = 0; u < 2; ++u) {
            const int tl = base + sub * 2 + u; const bool act = tl < ntiles;
            const int n0 = (tl % ntx) * 64, k0 = (tl / ntx) * 64;
            if (act) {
                const int k8 = (t8 & 7) * 8, nr = t8 >> 3;
#pragma unroll
                for (int i = 0; i < 2; ++i) { const int nl = nr + 32 * i;
                    if (n0 + nl < ncols) {
                        float v[8];
#pragma unroll
                        for (int j = 0; j < 8; ++j) v[j] = tile[u * (64 * 65) + (k8 + j) * 65 + nl];
                        if (OUT8) { int p0 = 0, p1 = 0;
                            p0 = __builtin_amdgcn_cvt_pk_fp8_f32(64.f * v[0], 64.f * v[1], p0, false); p0 = __builtin_amdgcn_cvt_pk_fp8_f32(64.f * v[2], 64.f * v[3], p0, true);
                            p1 = __builtin_amdgcn_cvt_pk_fp8_f32(64.f * v[4], 64.f * v[5], p1, false); p1 = __builtin_amdgcn_cvt_pk_fp8_f32(64.f * v[6], 64.f * v[7], p1, true);
                            u32x2 o; o.x = (unsigned)p0; o.y = (unsigned)p1; *(u32x2*)((unsigned char*)Bt + (size_t)(n0 + nl) * ldd + k0 + k8) = o; }
                        else { u32x4 o; o.x = pack2bf(v[0], v[1]); o.y = pack2bf(v[2], v[3]); o.z = pack2bf(v[4], v[5]); o.w = pack2bf(v[6], v[7]);
                            *(u32x4*)((bf16_t*)Bt + (size_t)(n0 + nl) * ldd + k0 + k8) = o; }
                    } } }
        }
        __syncthreads();
    }
}
__device__ __forceinline__ void ph_convT(LAS unsigned char* lds, const float* __restrict__ W, int ldw, int src_col0, int ncols, int K, bf16_t* __restrict__ Bt, int ldd, int bid, int nblk, bool upperm = false, const float* __restrict__ gk = nullptr) {
    ph_convT_g<false>(lds, W, ldw, src_col0, ncols, K, Bt, ldd, bid, nblk, upperm, gk);
}
__device__ __forceinline__ void ph_convT8(LAS unsigned char* lds, const float* __restrict__ W, int ldw, int ncols, int K, unsigned char* __restrict__ Bt, int bid, int nblk, bool upperm = false) {
    ph_convT_g<true>(lds, W, ldw, 0, ncols, K, Bt, K, bid, nblk, upperm);
}
template <int NC> __device__ __forceinline__ void ph_rmsnorm(const float* __restrict__ x, const float* __restrict__ g, bf16_t* __restrict__ out, int bid, int nblk, unsigned char* __restrict__ out8 = nullptr) {
    const int lane = opaque_tid() & 63, w = opaque_tid() >> 6;
    constexpr int NV = NC / 256;
    for (int row = bid * 8 + w; row < NTOK; row += nblk * 8) {
        const f32x4* xr = (const f32x4*)(x + (size_t)row * NC);
        f32x4 v[NV]; float ss = 0.f;
#pragma unroll
        for (int i = 0; i < NV; ++i) { v[i] = xr[lane + 64 * i]; ss += v[i][0] * v[i][0] + v[i][1] * v[i][1] + v[i][2] * v[i][2] + v[i][3] * v[i][3]; }
        ss = wave_sum(ss);
        const float r = rsqrtf(ss * (1.0f / NC) + NORM_EPS);
#pragma unroll
        for (int i = 0; i < NV; ++i) { const f32x4 gg = ((const f32x4*)g)[lane + 64 * i]; const f32x4 y = v[i] * r * gg; st_bf16x4(out + (size_t)row * NC + 4 * (lane + 64 * i), y);
            if (out8) { int pk = 0; pk = __builtin_amdgcn_cvt_pk_fp8_f32(y[0], y[1], pk, false); pk = __builtin_amdgcn_cvt_pk_fp8_f32(y[2], y[3], pk, true); *(int*)(out8 + (size_t)row * NC + 4 * (lane + 64 * i)) = pk; } }
    }
}
template <bool IN16, bool OUT16>
__device__ __forceinline__ void ph_resnorm(const void* xin, const bf16_t* __restrict__ m, const float* __restrict__ gpost, const float* __restrict__ gpre, void* xout, bf16_t* __restrict__ h, unsigned char* __restrict__ h8, int bid, int nblk, float* __restrict__ r2out = nullptr) {
    const int tid_ = opaque_tid(), lane = tid_ & 63, w = tid_ >> 6;
    for (int row = bid * 8 + w; row < NTOK; row += nblk * 8) {
        const u32x2* mr = (const u32x2*)(m + (size_t)row * DM);
        f32x4 mv[8], xv[8]; float ss = 0.f;
#pragma unroll
        for (int i = 0; i < 8; ++i) { const u32x2 wd = mr[lane + 64 * i]; mv[i][0] = __uint_as_float(wd.x << 16); mv[i][1] = __uint_as_float(wd.x & 0xFFFF0000u); mv[i][2] = __uint_as_float(wd.y << 16); mv[i][3] = __uint_as_float(wd.y & 0xFFFF0000u);
            if (IN16) { const u32x2 xw = ((const u32x2*)((const bf16_t*)xin + (size_t)row * DM))[lane + 64 * i];
                xv[i][0] = __uint_as_float(xw.x << 16); xv[i][1] = __uint_as_float(xw.x & 0xFFFF0000u); xv[i][2] = __uint_as_float(xw.y << 16); xv[i][3] = __uint_as_float(xw.y & 0xFFFF0000u); }
            else xv[i] = ((const f32x4*)((const float*)xin + (size_t)row * DM))[lane + 64 * i];
            ss += mv[i][0] * mv[i][0] + mv[i][1] * mv[i][1] + mv[i][2] * mv[i][2] + mv[i][3] * mv[i][3]; }
        ss = wave_sum(ss);
        const float r1 = rsqrtf(ss * (1.0f / DM) + NORM_EPS);
        float s2 = 0.f;
#pragma unroll
        for (int i = 0; i < 8; ++i) { const f32x4 gg = ((const f32x4*)gpost)[lane + 64 * i]; xv[i] = xv[i] + mv[i] * r1 * gg;
            if (OUT16) st_bf16x4((bf16_t*)xout + (size_t)row * DM + 4 * (lane + 64 * i), xv[i]); else ((f32x4*)((float*)xout + (size_t)row * DM))[lane + 64 * i] = xv[i];
            s2 += xv[i][0] * xv[i][0] + xv[i][1] * xv[i][1] + xv[i][2] * xv[i][2] + xv[i][3] * xv[i][3]; }
        if (gpre) {
            s2 = wave_sum(s2);
            const float r2 = rsqrtf(s2 * (1.0f / DM) + NORM_EPS);
            if (r2out) { if (lane == 0) r2out[row] = r2; continue; }
#pragma unroll
            for (int i = 0; i < 8; ++i) { const f32x4 gg = ((const f32x4*)gpre)[lane + 64 * i]; const f32x4 y = xv[i] * r2 * gg;
                if (h8) { int pk = 0; pk = __builtin_amdgcn_cvt_pk_fp8_f32(y[0], y[1], pk, false); pk = __builtin_amdgcn_cvt_pk_fp8_f32(y[2], y[3], pk, true); *(int*)(h8 + (size_t)row * DM + 4 * (lane + 64 * i)) = pk; }
                else st_bf16x4(h + (size_t)row * DM + 4 * (lane + 64 * i), y); }
        }
    }
}
__device__ __forceinline__ f32x4 bf4_to_f32(u32x2 w) { f32x4 r; r[0] = __uint_as_float(w.x << 16); r[1] = __uint_as_float(w.x & 0xFFFF0000u); r[2] = __uint_as_float(w.y << 16); r[3] = __uint_as_float(w.y & 0xFFFF0000u); return r; }
__device__ __forceinline__ void ph_scan1(const bf16_t* __restrict__ Aa, const bf16_t* __restrict__ Bb, float* __restrict__ CA, float* __restrict__ CH, int bid, int nblk) {
    for (int i = bid * 512 + opaque_tid(); i < 2 * 256 * 256; i += nblk * 512) {
        const int c4 = i & 255, chunk = (i >> 8) & 255, b = i >> 16;
        const size_t base = ((size_t)b * SEQ + (size_t)chunk * 64) * 1024 + 4 * c4;
        f32x4 h = {0.f, 0.f, 0.f, 0.f}, P = {1.f, 1.f, 1.f, 1.f};
#pragma unroll 8
        for (int s = 0; s < 64; ++s) { const f32x4 a = 1.0f - bf4_to_f32(*(const u32x2*)(Aa + base + (size_t)s * 1024)); h = a * h + bf4_to_f32(*(const u32x2*)(Bb + base + (size_t)s * 1024)); P *= a; }
        ((f32x4*)CA)[i] = P; ((f32x4*)CH)[i] = h;
    }
}
__device__ __forceinline__ void ph_scan2(const float* __restrict__ CA, const float* __restrict__ CH, float* __restrict__ CIN, int bid, int nblk) {
    const int tid = opaque_tid(), lane = tid & 63;
    for (int wv = bid * 8 + (tid >> 6); wv < 512; wv += nblk * 8) {
        const int b = wv >> 8, ch = (wv & 255) * 4 + (lane & 3), part = lane >> 2;
        const size_t j0 = ((size_t)b * 256 + part * 16) * 1024 + ch;
        float ca[16], chv[16];
#pragma unroll
        for (int k = 0; k < 16; ++k) { ca[k] = CA[j0 + (size_t)k * 1024]; chv[k] = CH[j0 + (size_t)k * 1024]; }
        float A = 1.f, H = 0.f;
#pragma unroll
        for (int k = 0; k < 16; ++k) { H = ca[k] * H + chv[k]; A *= ca[k]; }
#pragma unroll
        for (int d = 1; d < 16; d <<= 1) {
            const float Ap = __shfl_up(A, 4 * d), Hp = __shfl_up(H, 4 * d);
            if (part >= d) { H = A * Hp + H; A = A * Ap; }
        }
        float h = __shfl_up(H, 4); if (part == 0) h = 0.f;
#pragma unroll
        for (int k = 0; k < 16; ++k) { CIN[j0 + (size_t)k * 1024] = h; h = ca[k] * h + chv[k]; }
    }
}
__device__ __forceinline__ void ph_scan3(const bf16_t* __restrict__ Aa, const bf16_t* __restrict__ Bb, const float* __restrict__ CIN, const bf16_t* __restrict__ YG, bf16_t* __restrict__ CC, int bid, int nblk) {
    for (int i = bid * 512 + opaque_tid(); i < 2 * 256 * 256; i += nblk * 512) {
        const int c4 = i & 255, chunk = (i >> 8) & 255, b = i >> 16;
        const size_t row0 = (size_t)b * SEQ + (size_t)chunk * 64;
        f32x4 h = ((const f32x4*)CIN)[i];
#pragma unroll 8
        for (int s = 0; s < 64; ++s) { const size_t r = row0 + s;
            h = (1.0f - bf4_to_f32(*(const u32x2*)(Aa + r * 1024 + 4 * c4))) * h + bf4_to_f32(*(const u32x2*)(Bb + r * 1024 + 4 * c4));
            const f32x4 g = bf4_to_f32(*(const u32x2*)(YG + r * 1024 + 4 * c4));
            f32x4 o; o[0] = h[0] * gelu_tanh(g[0]); o[1] = h[1] * gelu_tanh(g[1]); o[2] = h[2] * gelu_tanh(g[2]); o[3] = h[3] * gelu_tanh(g[3]);
            st_bf16x4(CC + r * 2048 + 1024 + 4 * c4, o); }
    }
}
__device__ __forceinline__ void ph_rope_q(const bf16_t* __restrict__ Q1, const int* __restrict__ pos, unsigned char* __restrict__ Q8, int bid, int nblk) {
    for (int idx = bid * 512 + opaque_tid(); idx < NTOK * 8 * 4; idx += nblk * 512) {
        const int g = idx & 3, h = (idx >> 2) & 7, row = idx >> 5;
        const bf16_t* p = Q1 + (size_t)row * 1536 + h * 192; unsigned char* q = Q8 + (size_t)row * 1536 + h * 192;
#pragma unroll
        for (int k = 0; k < 4; ++k) { const u32x4 w = *(const u32x4*)(p + 32 * g + 8 * k);
            int p0 = 0, p1 = 0;
            p0 = __builtin_amdgcn_cvt_pk_fp8_f32(QS_MLA * __uint_as_float(w.x << 16), QS_MLA * __uint_as_float(w.x & 0xFFFF0000u), p0, false); p0 = __builtin_amdgcn_cvt_pk_fp8_f32(QS_MLA * __uint_as_float(w.y << 16), QS_MLA * __uint_as_float(w.y & 0xFFFF0000u), p0, true);
            p1 = __builtin_amdgcn_cvt_pk_fp8_f32(QS_MLA * __uint_as_float(w.z << 16), QS_MLA * __uint_as_float(w.z & 0xFFFF0000u), p1, false); p1 = __builtin_amdgcn_cvt_pk_fp8_f32(QS_MLA * __uint_as_float(w.w << 16), QS_MLA * __uint_as_float(w.w & 0xFFFF0000u), p1, true);
            u32x2 o; o.x = (unsigned)p0; o.y = (unsigned)p1; *(u32x2*)(q + 32 * g + 8 * k) = o; }
        const u32x4 w1 = *(const u32x4*)(p + 128 + 8 * g), w2 = *(const u32x4*)(p + 160 + 8 * g);
        const unsigned a1[4] = {w1.x, w1.y, w1.z, w1.w}, a2[4] = {w2.x, w2.y, w2.z, w2.w};
        float o1[8], o2[8]; const int ps = pos[row];
#pragma unroll
        for (int j = 0; j < 8; ++j) { float cs, sn; rope_cs(ps, 8 * g + j, cs, sn);
            const float x1 = (j & 1) ? __uint_as_float(a1[j >> 1] & 0xFFFF0000u) : __uint_as_float(a1[j >> 1] << 16), x2 = (j & 1) ? __uint_as_float(a2[j >> 1] & 0xFFFF0000u) : __uint_as_float(a2[j >> 1] << 16);
            o1[j] = QS_MLA * (x1 * cs - x2 * sn); o2[j] = QS_MLA * (x2 * cs + x1 * sn); }
        int p0 = 0, p1 = 0, p2 = 0, p3 = 0;
        p0 = __builtin_amdgcn_cvt_pk_fp8_f32(o1[0], o1[1], p0, false); p0 = __builtin_amdgcn_cvt_pk_fp8_f32(o1[2], o1[3], p0, true); p1 = __builtin_amdgcn_cvt_pk_fp8_f32(o1[4], o1[5], p1, false); p1 = __builtin_amdgcn_cvt_pk_fp8_f32(o1[6], o1[7], p1, true);
        p2 = __builtin_amdgcn_cvt_pk_fp8_f32(o2[0], o2[1], p2, false); p2 = __builtin_amdgcn_cvt_pk_fp8_f32(o2[2], o2[3], p2, true); p3 = __builtin_amdgcn_cvt_pk_fp8_f32(o2[4], o2[5], p3, false); p3 = __builtin_amdgcn_cvt_pk_fp8_f32(o2[6], o2[7], p3, true);
        u32x2 oa; oa.x = (unsigned)p0; oa.y = (unsigned)p1; *(u32x2*)(q + 128 + 8 * g) = oa;
        u32x2 ob; ob.x = (unsigned)p2; ob.y = (unsigned)p3; *(u32x2*)(q + 160 + 8 * g) = ob;
    }
}
__device__ __forceinline__ void ph_rope_k(const float* __restrict__ KR, const int* __restrict__ pos, unsigned char* __restrict__ K8, int bid, int nblk) {
    for (int idx = bid * 512 + opaque_tid(); idx < NTOK * 32; idx += nblk * 512) {
        const int i = idx & 31, row = idx >> 5;
        float c, s; rope_cs(pos[row], i, c, s);
        const float x1 = KR[(size_t)row * 64 + i], x2 = KR[(size_t)row * 64 + 32 + i];
        const int pk = __builtin_amdgcn_cvt_pk_fp8_f32(x1 * c - x2 * s, x2 * c + x1 * s, 0, false);
        const unsigned char o1 = (unsigned char)(pk & 0xFF), o2 = (unsigned char)((pk >> 8) & 0xFF);
#pragma unroll
        for (int h = 0; h < 8; ++h) { unsigned char* p = K8 + (size_t)row * 1536 + h * 192 + 128; p[i] = o1; p[32 + i] = o2; }
    }
}
template <bool OUT8> __device__ __forceinline__ void ph_ffn_gate(const bf16_t* __restrict__ HID, const float* __restrict__ cw, const float* __restrict__ cb, bf16_t* __restrict__ ACT, int bid, int nblk) {
    for (int i = bid * 512 + opaque_tid(); i < 512 * (SEQ / 64); i += nblk * 512) {
        const int c8 = (i & 511) * 8, t0 = (i >> 9) * 64;
        float wg[3][8], wv[3][8], bg[8], bv[8];
#pragma unroll
        for (int j = 0; j < 8; ++j) { bg[j] = cb[c8 + j]; bv[j] = cb[4096 + c8 + j];
#pragma unroll
            for (int k = 0; k < 3; ++k) { wg[k][j] = cw[k * 8192 + c8 + j]; wv[k][j] = cw[k * 8192 + 4096 + c8 + j]; } }
        u32x4 g2 = {0u, 0u, 0u, 0u}, g1 = g2, v2 = g2, v1 = g2;
        if (t0 >= 2) { g2 = *(const u32x4*)(HID + (size_t)(t0 - 2) * 8192 + c8); g1 = *(const u32x4*)(HID + (size_t)(t0 - 1) * 8192 + c8);
                       v2 = *(const u32x4*)(HID + (size_t)(t0 - 2) * 8192 + 4096 + c8); v1 = *(const u32x4*)(HID + (size_t)(t0 - 1) * 8192 + 4096 + c8); }
#pragma unroll 8
        for (int r = 0; r < 64; ++r) {
            const u32x4 g0 = *(const u32x4*)(HID + (size_t)(t0 + r) * 8192 + c8), v0 = *(const u32x4*)(HID + (size_t)(t0 + r) * 8192 + 4096 + c8);
            const unsigned G2[4] = {g2.x, g2.y, g2.z, g2.w}, G1[4] = {g1.x, g1.y, g1.z, g1.w}, G0[4] = {g0.x, g0.y, g0.z, g0.w};
            const unsigned V2[4] = {v2.x, v2.y, v2.z, v2.w}, V1[4] = {v1.x, v1.y, v1.z, v1.w}, V0[4] = {v0.x, v0.y, v0.z, v0.w};
            float o[8];
#pragma unroll
            for (int j = 0; j < 4; ++j) {
                const float ge = bg[2 * j] + wg[0][2 * j] * __uint_as_float(G2[j] << 16) + wg[1][2 * j] * __uint_as_float(G1[j] << 16) + wg[2][2 * j] * __uint_as_float(G0[j] << 16);
                const float go = bg[2 * j + 1] + wg[0][2 * j + 1] * __uint_as_float(G2[j] & 0xFFFF0000u) + wg[1][2 * j + 1] * __uint_as_float(G1[j] & 0xFFFF0000u) + wg[2][2 * j + 1] * __uint_as_float(G0[j] & 0xFFFF0000u);
                const float ve = bv[2 * j] + wv[0][2 * j] * __uint_as_float(V2[j] << 16) + wv[1][2 * j] * __uint_as_float(V1[j] << 16) + wv[2][2 * j] * __uint_as_float(V0[j] << 16);
                const float vo = bv[2 * j + 1] + wv[0][2 * j + 1] * __uint_as_float(V2[j] & 0xFFFF0000u) + wv[1][2 * j + 1] * __uint_as_float(V1[j] & 0xFFFF0000u) + wv[2][2 * j + 1] * __uint_as_float(V0[j] & 0xFFFF0000u);
                o[2 * j] = gelu_tanh(ge) * ve; o[2 * j + 1] = gelu_tanh(go) * vo; }
            if (OUT8) { int p0 = 0, p1 = 0;
                p0 = __builtin_amdgcn_cvt_pk_fp8_f32(o[0], o[1], p0, false); p0 = __builtin_amdgcn_cvt_pk_fp8_f32(o[2], o[3], p0, true);
                p1 = __builtin_amdgcn_cvt_pk_fp8_f32(o[4], o[5], p1, false); p1 = __builtin_amdgcn_cvt_pk_fp8_f32(o[6], o[7], p1, true);
                u32x2 ov; ov.x = (unsigned)p0; ov.y = (unsigned)p1; *(u32x2*)((unsigned char*)ACT + (size_t)(t0 + r) * 4096 + c8) = ov; }
            else { u32x4 ov; ov.x = pack2bf(o[0], o[1]); ov.y = pack2bf(o[2], o[3]); ov.z = pack2bf(o[4], o[5]); ov.w = pack2bf(o[6], o[7]);
                *(u32x4*)(ACT + (size_t)(t0 + r) * 4096 + c8) = ov; }
            g2 = g1; g1 = g0; v2 = v1; v1 = v0;
        }
    }
}

__device__ __forceinline__ void ph_conv_lru(const float* __restrict__ wa, const float* __restrict__ wx, bf16_t* __restrict__ Bt, int bid, int nblk) {
    for (int e = bid * 512 + opaque_tid(); e < 8 * 2 * 128 * 128; e += nblk * 512) {
        const int d = e & 127, c = (e >> 7) & 127, gate = (e >> 14) & 1, nb = e >> 15;
        const float v = (gate ? wx : wa)[((size_t)nb * 128 + c) * 128 + d];
        bf16_t* row = Bt + (size_t)(nb * 256 + gate * 128 + d) * 256;
        row[(nb & 1) * 128 + c] = f2bf(v); row[(1 - (nb & 1)) * 128 + c] = 0;
    }
}

static constexpr size_t MiB = 1048576;
static constexpr size_t W_UP0 = 0 * MiB, W_UP1 = 32 * MiB, W_DN0 = 64 * MiB, W_DN1 = 80 * MiB, W_ABIN = 96 * MiB, W_ABOUT = 117 * MiB, W_CDIN = 125 * MiB, W_CDOUT = 137 * MiB,
                        W_QUP = 145 * MiB, W_KVUP = 146 * MiB + 512 * 1024, W_POOL = 147 * MiB + 512 * 1024;
static constexpr size_t R_H = 148 * MiB;
static constexpr size_t R_Q0 = 276 * MiB, R_K0 = 340 * MiB, R_VT0 = 404 * MiB, R_QI = 468 * MiB, R_M0 = 468 * MiB, R_U = 596 * MiB, R_KI = 724 * MiB, R_WI = 732 * MiB, R_MASK = 734 * MiB, R_CC0 = 830 * MiB, R_POOLED = 958 * MiB, R_H8A = 830 * MiB;
static constexpr size_t R_HID = 276 * MiB, R_ACT = 532 * MiB, R_F = 660 * MiB, R_X3 = 788 * MiB;
static constexpr size_t R_VT1 = 276 * MiB, R_CQ = 276 * MiB, R_CKV = 340 * MiB, R_KR = 372 * MiB, R_XL = 380 * MiB, R_YG = 444 * MiB, R_CQN = 508 * MiB, R_CKVN = 540 * MiB, R_LA = 556 * MiB, R_LB = 684 * MiB,
                        R_Q1 = 812 * MiB, R_K1 = 908 * MiB, R_Q8 = 956 * MiB,     R_CA = 1004 * MiB, R_CH = 1006 * MiB, R_CIN = 1008 * MiB, R_CC1 = 148 * MiB, R_M1 = 276 * MiB, R_XCB = 148 * MiB, W_LRU = 1010 * MiB;
static constexpr size_t WS_BAR = 1022 * MiB, WS_NEED = 1022 * MiB + 65536;
static constexpr int MK_LDS = 162816;

struct MK { const float* in[28]; float* out; unsigned char* ws; int ph_lo, ph_hi; };

__global__ __launch_bounds__(512, 2) void k_mega(MK p) {
    extern __shared__ __attribute__((aligned(16))) unsigned char shm[];
    LAS unsigned char* lds = (LAS unsigned char*)shm;
    const int bid0 = (int)blockIdx.x, nblk0 = (int)gridDim.x;
    volatile LAS unsigned* xbw = (volatile LAS unsigned*)(lds + MK_LDS - 16);
    if (threadIdx.x == 0) { xbw[0] = 0u; xbw[1] = 0u; xbw[2] = 0u; xbw[3] = 0u; }
    if ((threadIdx.x & 63) == 0) *(volatile LAS int*)(size_t)(TID_TAB_LDS + 4 * ((unsigned)__builtin_amdgcn_s_getreg(((6 - 1) << 11) | 4) & 63u)) = (int)(threadIdx.x >> 6);
    __syncthreads();
    XcdBarrier bar = xcd_barrier_post((unsigned*)(p.ws + WS_BAR), xbw);
#ifndef KARG_PLAIN
#define KARG_PLAIN 0
#endif
#if KARG_PLAIN
#define KARG_DECL const MK& P_ = p;
#else
#define KARG_DECL KPtr P__ = kp; asm volatile("" : "+s"(P__)); const __attribute__((address_space(4))) MK& P_ = *P__;
#endif
    typedef const __attribute__((address_space(4))) MK* KPtr;
    KPtr kp = (KPtr)__builtin_amdgcn_kernarg_segment_ptr();
#define WSP(T, off) ((T*)(ws + (off)))
#define PHASE_BEGIN if (pc >= p.ph_lo && pc < p.ph_hi) { const int bid = opaque_s(bid0), nblk = opaque_s(nblk0); \
    KARG_DECL unsigned char* const ws = P_.ws; float* const xo = P_.out; const float* const x = P_.in[0]; const int* const positions = (const int*)P_.in[1]; \
    const float *const mix_pre_g = P_.in[2], *const mix_post_g = P_.in[3], *const ffn_pre_g = P_.in[4], *const ffn_post_g = P_.in[5], *const ffn_up = P_.in[6], *const ffn_conv_w = P_.in[7], *const ffn_conv_b = P_.in[8], *const ffn_down = P_.in[9], \
    *const ab_w_in = P_.in[10], *const pool_w = P_.in[11], *const pool_b = P_.in[12], *const pool_scale = P_.in[13], *const ab_w_out = P_.in[14], *const cd_w_in = P_.in[15], *const q_norm_g = P_.in[16], *const w_q_up = P_.in[17], \
    *const kv_norm_g = P_.in[18], *const w_kv_up = P_.in[19], *const lru_conv_w = P_.in[20], *const lru_conv_b = P_.in[21], *const lru_wa = P_.in[22], *const lru_ba = P_.in[23], *const lru_wx = P_.in[24], *const lru_bx = P_.in[25], \
    *const lru_lambda = P_.in[26], *const cd_w_out = P_.in[27]; bf16_t* const H = WSP(bf16_t, R_H); const bf16_t* const CC = WSP(bf16_t, LAYER_CC); bf16_t* const Mx = WSP(bf16_t, LAYER_MX); \
    (void)xo; (void)x; (void)positions; (void)mix_pre_g; (void)mix_post_g; (void)ffn_pre_g; (void)ffn_post_g; (void)ffn_up; (void)ffn_conv_w; (void)ffn_conv_b; (void)ffn_down; (void)ab_w_in; (void)pool_w; (void)pool_b; (void)pool_scale; \
    (void)ab_w_out; (void)cd_w_in; (void)q_norm_g; (void)w_q_up; (void)kv_norm_g; (void)w_kv_up; (void)lru_conv_w; (void)lru_conv_b; (void)lru_wa; (void)lru_ba; (void)lru_wx; (void)lru_bx; (void)lru_lambda; (void)cd_w_out; (void)H; (void)CC; (void)Mx;
#define PHASE_END } if (pc >= p.ph_lo && pc + 1 < p.ph_hi) xcd_barrier(bar); ++pc;
    int pc = 0;
#define LAYER_CC R_CC0
#define LAYER_MX R_M0
    PHASE_BEGIN
#if !((SKIPMASK >> 0) & 1)
#if FP8_UP0
        ph_convT8(lds, ffn_up, 8192, 8192, 2048, WSP(unsigned char, W_UP0), bid, nblk, true);
#else
        ph_convT(lds, ffn_up, 8192, 0, 8192, 2048, WSP(bf16_t, W_UP0), 2048, bid, nblk, true);
#endif
#if FP8_UP1
        ph_convT8(lds, ffn_up + (size_t)2048 * 8192, 8192, 8192, 2048, WSP(unsigned char, W_UP1), bid, nblk, true);
#else
        ph_convT(lds, ffn_up + (size_t)2048 * 8192, 8192, 0, 8192, 2048, WSP(bf16_t, W_UP1), 2048, bid, nblk, true);
#endif
#if FP8_DN0
        ph_convT8(lds, ffn_down, 2048, 2048, 4096, WSP(unsigned char, W_DN0), bid, nblk);
#else
        ph_convT(lds, ffn_down, 2048, 0, 2048, 4096, WSP(bf16_t, W_DN0), 4096, bid, nblk);
#endif
#if FP8_DN1
        if (nblk != 256) ph_convT8(lds, ffn_down + (size_t)4096 * 2048, 2048, 2048, 4096, WSP(unsigned char, W_DN1), bid, nblk);
#else
        ph_convT(lds, ffn_down + (size_t)4096 * 2048, 2048, 0, 2048, 4096, WSP(bf16_t, W_DN1), 4096, bid, nblk);
#endif
#if FP8_QKV
        ph_convT8(lds, ab_w_in, 5200, 3072, 2048, WSP(unsigned char, W_ABIN), bid, nblk);
        ph_convT(lds, ab_w_in, 5200, 3072, 1024, 2048, WSP(bf16_t, W_ABIN) + (size_t)3072 * 2048, 2048, bid, nblk);
#else
        ph_convT(lds, ab_w_in, 5200, 0, 4096, 2048, WSP(bf16_t, W_ABIN), 2048, bid, nblk);
#endif
        ph_convT(lds, ab_w_in, 5200, 4176, 1024, 2048, WSP(bf16_t, W_ABIN) + (size_t)4096 * 2048, 2048, bid, nblk);
#define VB(first) ((bid + nblk - ((first) % nblk)) % nblk)
        ph_convT(lds, ab_w_in, 5200, 4096, 64, 2048, WSP(bf16_t, W_ABIN) + (size_t)5120 * 2048, 2048, VB(104), nblk);
        ph_convT(lds, ab_w_in, 5200, 4160, 16, 2048, WSP(bf16_t, W_ABIN) + (size_t)5184 * 2048, 2048, VB(112), nblk);
        ph_convT(lds, ab_w_out, 2048, 0, 2048, 2048, WSP(bf16_t, W_ABOUT), 2048, bid, nblk);
        if (nblk != 256) {
        ph_convT(lds, cd_w_in, 2880, 0, 832, 2048, WSP(bf16_t, W_CDIN), 2048, bid, nblk, false, mix_pre_g + 2048);
        ph_convT(lds, cd_w_in, 2880, 832, 2048, 2048, WSP(bf16_t, W_CDIN) + (size_t)1024 * 2048, 2048, bid, nblk, false, mix_pre_g + 2048);
        ph_convT(lds, cd_w_out, 2048, 0, 2048, 2048, WSP(bf16_t, W_CDOUT), 2048, bid, nblk);
        ph_convT(lds, w_q_up, 1536, 0, 1536, 512, WSP(bf16_t, W_QUP), 512, VB(136), nblk);
        ph_convT(lds, w_kv_up, 2048, 0, 2048, 256, WSP(bf16_t, W_KVUP), 256, VB(184), nblk);
        }
        for (int g = 0; g < 4; ++g) ph_convT(lds, pool_w + (size_t)g * 65536, 256, 0, 256, 256, WSP(bf16_t, W_POOL) + (size_t)g * 65536, 256, VB(120 + 4 * g), nblk);
#undef VB
        ph_rmsnorm<2048>(x, mix_pre_g, H, bid, nblk, FP8_QKV ? WSP(unsigned char, R_H8A) : (unsigned char*)nullptr);
#endif
    PHASE_END
    {
            PHASE_BEGIN
#if !((SKIPMASK >> 1) & 1)
                FAbIn2 f; f.Q = WSP(unsigned char, R_Q0); f.K = WSP(unsigned char, R_K0); f.VT = WSP(bf16_t, R_VT0); f.QI = WSP(unsigned short, R_QI); f.U = WSP(float, R_U); f.WI = WSP(float, R_WI); f.KI16 = WSP(unsigned short, R_KI);
#if FP8_QKV
                ph_gemm8(lds, WSP(unsigned char, R_H8A), 2048, WSP(unsigned char, W_ABIN), 2048, NTOK, 3072, 2048, f, bid, nblk, nblk == 256 ? 5 : 0);
                { FAbInHi fh; fh.f = f; ph_gemm(lds, H, 2048, WSP(bf16_t, W_ABIN) + (size_t)3072 * 2048, 2048, NTOK, 2304, 2048, fh, bid, nblk); }
#else
                ph_gemm(lds, H, 2048, WSP(bf16_t, W_ABIN), 2048, NTOK, 5376, 2048, f, bid, nblk);
#endif
#endif
            PHASE_END
            PHASE_BEGIN
#if !((SKIPMASK >> 2) & 1)
                ph_pooled(WSP(float, R_U), WSP(bf16_t, R_POOLED), bid, nblk);
                IdxArgs a; a.QI = WSP(unsigned short, R_QI); a.KI16 = WSP(unsigned short, R_KI); a.WI = WSP(float, R_WI); a.MT = WSP(unsigned long long, R_MASK);
                idx_phase(lds, a, bid, nblk);
#endif
            PHASE_END
            PHASE_BEGIN
#if !((SKIPMASK >> 3) & 1)
                { FPool f; f.CC = WSP(bf16_t, R_CC0); f.pb = pool_b; f.ps = pool_scale; ph_gemm(lds, WSP(bf16_t, R_POOLED), 1024, WSP(bf16_t, W_POOL), 256, NTOK, 1024, 256, f, bid, nblk, 0, 512); }
                AttnArgs a; a.Q = WSP(bf16_t, R_Q0); a.K = WSP(bf16_t, R_K0); a.VT = WSP(bf16_t, R_VT0); a.MT = WSP(unsigned long long, R_MASK); a.O = WSP(bf16_t, R_CC0); a.ldq = 1024; a.ldk = 1024; a.ldo = 2048;
                a.sc_log2e = 0.08838834764831845f * 1.4426950408889634f;
                attn_phase<128, true>(lds, a, bid, nblk);
#endif
            PHASE_END
        PHASE_BEGIN
#if !((SKIPMASK >> 4) & 1)
            FStoreBf16 f; f.O = Mx; f.ldc = 2048; f.pad_ = 0;
            ph_gemm(lds, CC, 2048, WSP(bf16_t, W_ABOUT), 2048, NTOK, 2048, 2048, f, bid, nblk);
#endif
        PHASE_END
        PHASE_BEGIN
#if !((SKIPMASK >> 5) & 1)
            ph_resnorm<false, true>(x, Mx, mix_post_g + 0, ffn_pre_g + 0, xo, H, FP8_UP0 ? WSP(unsigned char, R_H) : (unsigned char*)nullptr, bid, nblk);
#endif
        PHASE_END
        PHASE_BEGIN
#if FP8_UP0
            { EpiGate<FP8_DN0 != 0, true> ep; ep.cw = ffn_conv_w + 0; ep.cb = ffn_conv_b + 0; ep.ACT = WSP(void, R_HID);
              ph_gemm_e(lds, (const bf16_t*)WSP(unsigned char, R_H), 1024, (const bf16_t*)WSP(unsigned char, W_UP0), 1024, 134 * 256, 8192, 1024, ep, bid, nblk, 0, 0, 1); }
#else
            { EpiGate<FP8_DN0 != 0, false> ep; ep.cw = ffn_conv_w + 0; ep.cb = ffn_conv_b + 0; ep.ACT = WSP(void, R_HID);
              ph_gemm_e(lds, H, 2048, WSP(bf16_t, W_UP0), 2048, 134 * 256, 8192, 2048, ep, bid, nblk, 0, 0, 1); }
#endif
            if (nblk == 256 && bid >= 192) { const int vb = bid - 192;
                ph_convT(lds, cd_w_in, 2880, 0, 832, 2048, WSP(bf16_t, W_CDIN), 2048, vb, 64, false, mix_pre_g + 2048);
                ph_convT(lds, cd_w_in, 2880, 832, 2048, 2048, WSP(bf16_t, W_CDIN) + (size_t)1024 * 2048, 2048, vb, 64, false, mix_pre_g + 2048);
                ph_convT(lds, cd_w_out, 2048, 0, 2048, 2048, WSP(bf16_t, W_CDOUT), 2048, vb, 64);
                ph_convT(lds, w_q_up, 1536, 0, 1536, 512, WSP(bf16_t, W_QUP), 512, vb, 64);
                ph_convT(lds, w_kv_up, 2048, 0, 2048, 256, WSP(bf16_t, W_KVUP), 256, (vb + 32) & 63, 64); }
        PHASE_END
        PHASE_BEGIN
            FStoreBf16 f; f.O = WSP(bf16_t, R_F); f.ldc = 2048; f.pad_ = 0;
#if FP8_DN0
            ph_gemm8(lds, WSP(unsigned char, R_HID), 4096, WSP(unsigned char, W_DN0), 4096, NTOK, 2048, 4096, f, bid, nblk);
#else
            ph_gemm(lds, WSP(bf16_t, R_HID), 4096, WSP(bf16_t, W_DN0), 4096, NTOK, 2048, 4096, f, bid, nblk);
#endif
        PHASE_END
        PHASE_BEGIN
#if !((SKIPMASK >> 9) & 1)
            ph_resnorm<true, true>(xo, WSP(bf16_t, R_F), ffn_post_g + 0, mix_pre_g + 2048, xo, H, nullptr, bid, nblk, WSP(float, R_CA));
#endif
        PHASE_END
    }
    {
#undef LAYER_CC
#undef LAYER_MX
#define LAYER_CC R_CC1
#define LAYER_MX R_M1
            PHASE_BEGIN
#if !((SKIPMASK >> 10) & 1)
                FCdIn f; f.CQ = WSP(float, R_CQ); f.CKV = WSP(float, R_CKV); f.KR = WSP(float, R_KR); f.XL = WSP(bf16_t, R_XL); f.YG = WSP(bf16_t, R_YG); f.r2 = WSP(float, R_CA);
                ph_gemm(lds, (const bf16_t*)xo, 2048, WSP(bf16_t, W_CDIN), 2048, NTOK, 3072, 2048, f, bid, nblk);
#endif
            PHASE_END
            PHASE_BEGIN
#if !((SKIPMASK >> 11) & 1)
                ph_xc(WSP(bf16_t, R_XL), lru_conv_w, lru_conv_b, WSP(bf16_t, R_XCB), bid, nblk);
                ph_conv_lru(lru_wa, lru_wx, WSP(bf16_t, W_LRU), bid, nblk);
                ph_rmsnorm<512>(WSP(float, R_CQ), q_norm_g, WSP(bf16_t, R_CQN), bid, nblk);
                ph_rmsnorm<256>(WSP(float, R_CKV), kv_norm_g, WSP(bf16_t, R_CKVN), bid, nblk);
            PHASE_END
            PHASE_BEGIN
                { EpiLru ep; ep.XCB = WSP(bf16_t, R_XCB); ep.ba = lru_ba; ep.bx = lru_bx; ep.lam = lru_lambda; ep.LA = WSP(bf16_t, R_LA); ep.LB = WSP(bf16_t, R_LB);
                  ph_gemm_e(lds, WSP(bf16_t, R_XCB), 1024, WSP(bf16_t, W_LRU), 256, NTOK, 2048, 256, ep, bid, nblk, 1, 512); }
                { FStoreBf16 f; f.O = WSP(bf16_t, R_Q1); f.ldc = 1536; f.pad_ = 0; ph_gemm(lds, WSP(bf16_t, R_CQN), 512, WSP(bf16_t, W_QUP), 512, NTOK, 1536, 512, f, bid, nblk); }
                { FKvUp2 f; f.K8 = WSP(unsigned char, R_K1); f.VT = WSP(bf16_t, R_VT1); ph_gemm(lds, WSP(bf16_t, R_CKVN), 256, WSP(bf16_t, W_KVUP), 256, NTOK, 2048, 256, f, bid, nblk); }
            PHASE_END
            PHASE_BEGIN
                ph_scan1(WSP(bf16_t, R_LA), WSP(bf16_t, R_LB), WSP(float, R_CA), WSP(float, R_CH), bid, nblk);
                ph_rope_q(WSP(bf16_t, R_Q1), positions, WSP(unsigned char, R_Q8), bid, nblk);
                ph_rope_k(WSP(float, R_KR), positions, WSP(unsigned char, R_K1), bid, nblk);
            PHASE_END
            PHASE_BEGIN
                ph_scan2(WSP(float, R_CA), WSP(float, R_CH), WSP(float, R_CIN), bid, nblk);
            PHASE_END
            PHASE_BEGIN
                ph_scan3(WSP(bf16_t, R_LA), WSP(bf16_t, R_LB), WSP(float, R_CIN), WSP(bf16_t, R_YG), WSP(bf16_t, R_CC1), bid, nblk);
                AttnArgs a; a.Q = WSP(bf16_t, R_Q8); a.K = WSP(bf16_t, R_K1); a.VT = WSP(bf16_t, R_VT1); a.MT = nullptr; a.O = WSP(bf16_t, R_CC1); a.ldq = 1536; a.ldk = 1536; a.ldo = 2048;
                a.sc_log2e = 0.07216878364870322f * 1.4426950408889634f;
                attn_phase<192, false>(lds, a, bid, nblk);
#endif
            PHASE_END
        PHASE_BEGIN
#if !((SKIPMASK >> 15) & 1)
            FStoreBf16 f; f.O = Mx; f.ldc = 2048; f.pad_ = 0;
            ph_gemm(lds, CC, 2048, WSP(bf16_t, W_CDOUT), 2048, NTOK, 2048, 2048, f, bid, nblk);
#endif
        PHASE_END
        PHASE_BEGIN
#if !((SKIPMASK >> 16) & 1)
            ph_resnorm<true, true>(xo, Mx, mix_post_g + 2048, ffn_pre_g + 2048, WSP(bf16_t, R_X3), H, FP8_UP1 ? WSP(unsigned char, R_H) : (unsigned char*)nullptr, bid, nblk);
#endif
        PHASE_END
        PHASE_BEGIN
#if FP8_UP1
            { EpiGate<FP8_DN1 != 0, true> ep; ep.cw = ffn_conv_w + 24576; ep.cb = ffn_conv_b + 8192; ep.ACT = WSP(void, R_HID);
              ph_gemm_e(lds, (const bf16_t*)WSP(unsigned char, R_H), 1024, (const bf16_t*)WSP(unsigned char, W_UP1), 1024, 134 * 256, 8192, 1024, ep, bid, nblk, 0, 0, 1); }
#else
            { EpiGate<FP8_DN1 != 0, false> ep; ep.cw = ffn_conv_w + 24576; ep.cb = ffn_conv_b + 8192; ep.ACT = WSP(void, R_HID);
              ph_gemm_e(lds, H, 2048, WSP(bf16_t, W_UP1), 2048, 134 * 256, 8192, 2048, ep, bid, nblk, 0, 0, 1); }
#endif
#if FP8_DN1
            if (nblk == 256 && bid >= 192) ph_convT8(lds, ffn_down + (size_t)4096 * 2048, 2048, 2048, 4096, WSP(unsigned char, W_DN1), bid - 192, 64);
#endif
        PHASE_END
        PHASE_BEGIN
            FStoreBf16 f; f.O = WSP(bf16_t, R_F); f.ldc = 2048; f.pad_ = 0;
#if FP8_DN1
            ph_gemm8(lds, WSP(unsigned char, R_HID), 4096, WSP(unsigned char, W_DN1), 4096, NTOK, 2048, 4096, f, bid, nblk);
#else
            ph_gemm(lds, WSP(bf16_t, R_HID), 4096, WSP(bf16_t, W_DN1), 4096, NTOK, 2048, 4096, f, bid, nblk);
#endif
        PHASE_END
        PHASE_BEGIN
#if !((SKIPMASK >> 20) & 1)
            ph_resnorm<true, false>(WSP(bf16_t, R_X3), WSP(bf16_t, R_F), ffn_post_g + 2048, (const float*)nullptr, xo, H, nullptr, bid, nblk);
#endif
        PHASE_END
    }
#undef LAYER_CC
#undef LAYER_MX
#undef WSP
#undef PHASE_BEGIN
#undef PHASE_END
}

#ifndef MK_N_LAUNCHES
#define MK_N_LAUNCHES 1
#endif
static constexpr int MK_NPHASES = 1 + 3 + 7 + 2 * 5;

extern "C" void kernel_launch(void* const* d_in, const int* in_sizes, int n_in, void* d_out, int out_size, void* d_ws, size_t ws_size, hipStream_t stream) {
    static int grid = 0;
    if (grid == 0) {
        if (n_in != 28 || out_size != NTOK * DM || ws_size < WS_NEED) { fprintf(stderr, "kernel_launch: unexpected shapes (n_in %d out %d ws %zu)\n", n_in, out_size, ws_size); grid = -1; return; }
        int dev = 0, cus = 0, per_cu = 0;
        if (hipGetDevice(&dev) != hipSuccess || hipDeviceGetAttribute(&cus, hipDeviceAttributeMultiprocessorCount, dev) != hipSuccess) { grid = -1; return; }
        if (hipFuncSetAttribute((const void*)k_mega, hipFuncAttributeMaxDynamicSharedMemorySize, MK_LDS) != hipSuccess) { fprintf(stderr, "kernel_launch: hipFuncSetAttribute failed\n"); grid = -1; return; }
        if (hipOccupancyMaxActiveBlocksPerMultiprocessor(&per_cu, (const void*)k_mega, 512, MK_LDS) != hipSuccess || per_cu < 1) { fprintf(stderr, "kernel_launch: occupancy query says %d\n", per_cu); }
        (void)hipGetLastError();
        grid = cus;
        if (grid != 256) { fprintf(stderr, "kernel_launch: built for 256 CUs, found %d\n", grid); grid = -1; return; }
    }
    if (grid < 0) return;
    unsigned char* ws = (unsigned char*)d_ws;
    (void)hipMemsetAsync(ws + WS_BAR, 0, XCD_BAR_WORDS * sizeof(unsigned), stream);
    (void)hipMemsetAsync(ws + W_ABIN + (size_t)5200 * 2048 * 2, 0, (size_t)176 * 2048 * 2, stream);
    (void)hipMemsetAsync(ws + W_CDIN + (size_t)832 * 2048 * 2, 0, (size_t)192 * 2048 * 2, stream);
    MK p{};
    for (int i = 0; i < 28; ++i) p.in[i] = (const float*)d_in[i];
    p.out = (float*)d_out; p.ws = ws;
#if MK_N_LAUNCHES == 1
    p.ph_lo = 0; p.ph_hi = 1 << 20;
    hipLaunchKernelGGL(k_mega, dim3(grid), dim3(512), MK_LDS, stream, p);
#else
    for (int ph = 0; ph < MK_NPHASES; ++ph) { p.ph_lo = ph; p.ph_hi = ph + 1; hipLaunchKernelGGL(k_mega, dim3(grid), dim3(512), MK_LDS, stream, p); }
#endif
}
```

```cpp
#include <hip/hip_runtime.h>
#include <stdint.h>
#include <stdio.h>

#define LAS __attribute__((address_space(3)))
typedef unsigned short bf16_t;
typedef float f32x4 __attribute__((ext_vector_type(4)));
typedef unsigned u32x4 __attribute__((ext_vector_type(4)));
typedef unsigned u32x2 __attribute__((ext_vector_type(2)));

static constexpr int NTOK = 32768, SEQ = 16384, NBATCH = 2, DM = 2048, DFF = 4096;
static constexpr float NORM_EPS = 1e-6f;

__device__ __forceinline__ bf16_t f2bf(float f) { unsigned u = __float_as_uint(f); u += 0x7FFFu + ((u >> 16) & 1u); return (bf16_t)(u >> 16); }
__device__ __forceinline__ float bf2f(bf16_t b) { return __uint_as_float(((unsigned)b) << 16); }
__device__ __forceinline__ unsigned pack2bf(float lo, float hi) { unsigned r; asm("v_cvt_pk_bf16_f32 %0, %1, %2" : "=v"(r) : "v"(lo), "v"(hi)); return r; }
__device__ __forceinline__ float gelu_tanh(float x) { const float u = 0.7978845608028654f * (x + 0.044715f * x * x * x); return 0.5f * x * (1.0f + tanhf(u)); }
__device__ __forceinline__ float wave_sum(float v) {
#pragma unroll
    for (int o = 32; o >= 1; o >>= 1) v += __shfl_xor(v, o);
    return v;
}

#ifndef TID_PLAIN
#define TID_PLAIN 0
#endif
static constexpr int TID_TAB_LDS = 162816 - 16 - 256;
#if TID_PLAIN
__device__ __forceinline__ int opaque_tid() { int t = (int)threadIdx.x; asm volatile("" : "+v"(t)); return t; }
#else
__device__ __forceinline__ int opaque_tid() {
    const unsigned slot = (unsigned)__builtin_amdgcn_s_getreg(((6 - 1) << 11) | 4) & 63u;
    const int w = __builtin_amdgcn_readfirstlane(*(const volatile LAS int*)(size_t)(TID_TAB_LDS + 4 * slot));
    int lane; asm volatile("v_mbcnt_lo_u32_b32 %0, -1, 0\n\tv_mbcnt_hi_u32_b32 %0, -1, %0" : "=v"(lane));
    return w * 64 + lane;
}
#endif

__device__ __forceinline__ int opaque_s(int v) { asm volatile("" : "+s"(v)); return v; }

template <class T> __device__ __forceinline__ const T* opaque_p(const T* p) { asm volatile("" : "+s"(p)); return p; }

#ifndef PG8_EPI_RECOMP
#define PG8_EPI_RECOMP 1
#endif
#ifndef PG8_ASM_DMA
#define PG8_ASM_DMA 1
#endif
#include <hip/hip_runtime.h>
namespace pg8 {
#define PG8_LAS __attribute__((address_space(3)))
typedef unsigned short bf16_t;
typedef short bf16x8 __attribute__((ext_vector_type(8)));
typedef float f32x4 __attribute__((ext_vector_type(4)));
typedef unsigned u32x4 __attribute__((ext_vector_type(4)));
typedef int i32x8 __attribute__((ext_vector_type(8)));
typedef int i32x4 __attribute__((ext_vector_type(4)));
constexpr int BM = 256, BK = 64, HALF = 128, HTB = HALF * BK * 2  , STAGE_BYTES = 8 * HTB, NXCD = 8, WGM = 8;

__host__ __device__ __forceinline__ int lds_byte(int r, int c) { const int st = (r >> 4) * 2 + (c >> 5), rr = r & 15, cc = c & 31, ob = rr * 64 + cc * 2; return st * 1024 + (ob ^ (((ob >> 9) & 1) << 5)); }
__host__ __device__ __forceinline__ void stage_rc(int b, int& R, int& C) { const int st = b / 1024, sb = b % 1024, swz = sb ^ (((sb >> 9) & 1) << 5); R = (st >> 1) * 16 + swz / 64; C = (st & 1) * 32 + (swz % 64) / 2; }
__host__ __device__ __forceinline__ int perm32(int rho) { const int n = rho >> 4, i = rho & 15; return 8 * (i >> 2) + 4 * n + (i & 3); }

struct Unit { int pm, pn; };
struct Gemm { const bf16_t* A; const bf16_t* Bt; int M, N, K, lda, ldb, a_shift, a_bytes, cmode; };

struct StaticOrder {
    int nM, nN, nwg, G, c, skew = 0;
    __host__ __device__ void init(int M, int N, int G_, int c_) { nM = M / BM; nN = N / BM; nwg = nM * nN; G = G_; c = c_; }
    __host__ __device__ bool next(int i, Unit& u) const {
        long L = (long)i * G + c;
        if (skew && i >= skew) { const int half = G >> 1, per = (nwg - skew * G) / half, e = i - skew; if (c < half || e >= per) return false; L = (long)skew * G + (long)(c - half) * per + e; }
        if (L >= nwg) return false;
        int wgid = (int)L; { const int q = nwg / NXCD, r = nwg % NXCD, xcd = wgid % NXCD, off = wgid / NXCD; wgid = (xcd < r ? xcd * (q + 1) : r * (q + 1) + (xcd - r) * q) + off; }
        const int nig = WGM * nN, gid = wgid / nig, fm = gid * WGM, gsz = (nM - fm) < WGM ? (nM - fm) : WGM;
        u.pm = fm + ((wgid % nig) % gsz); u.pn = (wgid % nig) / gsz; return true;
    }
    __device__ __forceinline__ void a_ready(const Unit&) const {}
    __device__ __forceinline__ void done(const Unit&) const {}
};

template <class Epi, class Sched, bool STAMP = false>
__device__ __forceinline__ void gemm_phase(PG8_LAS unsigned char* lds, const Gemm g, const Sched& S, const Epi& E, unsigned long long* stamps) {
    const int tid = opaque_tid(), wid = __builtin_amdgcn_readfirstlane(tid >> 6), lane = tid & 63, wr = wid >> 2, wc = wid & 3, fr = lane & 15, fq = lane >> 4;
    const int K = g.K, nt = K / BK;
    int ts_lo = 0, ts_hi = 0, nts = 0; const unsigned long long rt_entry = STAMP ? (unsigned long long)wall_clock64() : 0ull;
#define PG8_STAMP() do { if (STAMP && wid == 0 && nts < 64) { const unsigned long long _c = (unsigned long long)clock64(); \
        ts_lo = (lane == nts) ? (int)(unsigned)_c : ts_lo; ts_hi = (lane == nts) ? (int)(unsigned)(_c >> 32) : ts_hi; ++nts; } } while (0)
    PG8_STAMP();
    unsigned voffA[2], voffB[2];
#pragma unroll
    for (int i = 0; i < 2; ++i) { int R, C; stage_rc(tid * 16 + i * 8192, R, C); const int Rb = Epi::PERM ? ((R & ~31) + perm32(R & 31)) : R;
        const int Ra = g.cmode ? (R - 2 * (R >> 6)) : R;
        voffA[i] = (unsigned)(Ra * g.lda + C) * 2u; voffB[i] = (unsigned)(Rb * g.ldb + C) * 2u; }
    const size_t kstep = (size_t)(BK * 2);
    const size_t hstepA = (size_t)(g.cmode ? HALF - 4 : HALF) * g.lda * 2, hstepB = (size_t)HALF * g.ldb * 2;
    const size_t tstepA = 2 * hstepA, tstepB = 2 * hstepB;
    const unsigned ldsbase_ = (unsigned)(size_t)lds;
    const int sc_w_ = 0x79797979, sc_a_ = 0x7F7F7F7F;
    (void)sc_w_; (void)sc_a_;
    const unsigned ldsw = (unsigned)wid * 1024u;
    const int aoff = lds_byte(wr * 64 + fr, fq * 8), boff = lds_byte(wc * 32 + fr, fq * 8);
#define PG8_SA(b, h) (((b) * 2 + (h)) * HTB)
#define PG8_SB(b, h) ((4 + (b) * 2 + (h)) * HTB)
#if PG8_ASM_DMA
#define PG8_STAGE(bufoff, gbase, voff) do { _Pragma("unroll") for (int _i = 0; _i < 2; ++_i) { unsigned keep_; \
        asm volatile("s_mov_b32 %0, m0\n\ts_mov_b32 m0, %3\n\ts_nop 0\n\tglobal_load_lds_dwordx4 %1, %2\n\ts_mov_b32 m0, %0" \
                     : "=&s"(keep_) : "v"((voff)[_i]), "s"((const char*)(gbase)), "s"(ldsbase_ + (unsigned)(bufoff) + ldsw + (unsigned)(_i * 8192)) : "memory"); } } while (0)
#else
#define PG8_STAGE(bufoff, gbase, voff) do { _Pragma("unroll") for (int _i = 0; _i < 2; ++_i) \
        __builtin_amdgcn_global_load_lds((const unsigned*)((const char*)(gbase) + (voff)[_i]), (PG8_LAS unsigned*)(lds + (bufoff) + ldsw + _i * 8192), 16, 0, 0); } while (0)
#endif
#define PG8_LDA(dst, b, h) do { _Pragma("unroll") for (int m = 0; m < 4; ++m) { dst[m].lo = *(const PG8_LAS i32x4*)(lds + PG8_SA(b, h) + aoff + m * 2048); dst[m].hi = *(const PG8_LAS i32x4*)(lds + PG8_SA(b, h) + aoff + m * 2048 + 1024); } } while (0)
#define PG8_LDB(dst, b, h) do { _Pragma("unroll") for (int n = 0; n < 2; ++n) { dst[n].lo = *(const PG8_LAS i32x4*)(lds + PG8_SB(b, h) + boff + n * 2048); dst[n].hi = *(const PG8_LAS i32x4*)(lds + PG8_SB(b, h) + boff + n * 2048 + 1024); } } while (0)
#define PG8_MMA(ai, bj, At, Bt) do { __builtin_amdgcn_s_setprio(1); \
        if constexpr (Epi::FP8) { _Pragma("unroll") for (int m = 0; m < 4; ++m) _Pragma("unroll") for (int n = 0; n < 2; ++n) \
            asm volatile("v_mfma_scale_f32_16x16x128_f8f6f4 %0, %1, %2, %0, %3, %4 op_sel_hi:[0,0,0]" : "+v"(acc[ai][bj][m][n]) : "v"(Bt[n]), "v"(At[m]), "v"(sc_w_), "v"(sc_a_)); } \
        else { _Pragma("unroll") for (int m = 0; m < 4; ++m) _Pragma("unroll") for (int n = 0; n < 2; ++n) { \
            const i32x4 bl_ = Bt[n].lo, bh_ = Bt[n].hi, al_ = At[m].lo, ah_ = At[m].hi;     \
            acc[ai][bj][m][n] = __builtin_amdgcn_mfma_f32_16x16x32_bf16(__builtin_bit_cast(bf16x8, bl_), __builtin_bit_cast(bf16x8, al_), acc[ai][bj][m][n], 0, 0, 0); \
            acc[ai][bj][m][n] = __builtin_amdgcn_mfma_f32_16x16x32_bf16(__builtin_bit_cast(bf16x8, bh_), __builtin_bit_cast(bf16x8, ah_), acc[ai][bj][m][n], 0, 0, 0); } } \
        __builtin_amdgcn_s_setprio(0); } while (0)
#define PG8_WAIT_V(n) asm volatile("s_waitcnt vmcnt(" #n ")" ::: "memory")
#define PG8_WAIT_L(n) asm volatile("s_waitcnt lgkmcnt(" #n ")" ::: "memory")
#define PG8_BAR __builtin_amdgcn_s_barrier()
#define PG8_SCHED __builtin_amdgcn_sched_barrier(0)
    Unit cur, nxt; int ui = 0;
    if (!S.next(0, cur)) return;
    f32x4 acc[2][2][4][2];
#pragma unroll
    for (int a = 0; a < 2; ++a)
#pragma unroll
        for (int b = 0; b < 2; ++b)
#pragma unroll
            for (int m = 0; m < 4; ++m)
#pragma unroll
                for (int n = 0; n < 2; ++n) acc[a][b][m][n] = (f32x4){0.f, 0.f, 0.f, 0.f};
    i32x8 At[4], B0[2], B1[2];
    auto a_base_ = [&](const Unit& u_) -> const char* { return g.cmode ? (const char*)g.A + ((long)(u_.pm / 67) * 16384 + (long)(u_.pm % 67) * 248 - 2) * (long)g.lda * 2 : (const char*)g.A + (size_t)u_.pm * tstepA + (size_t)(u_.pn >> g.a_shift) * g.a_bytes; };
    const char* cA = a_base_(cur); const char* cB = (const char*)g.Bt + (size_t)cur.pn * tstepB;
    S.a_ready(cur);
    PG8_STAGE(PG8_SB(0, 0), cB, voffB); PG8_STAGE(PG8_SA(0, 0), cA, voffA); PG8_STAGE(PG8_SB(0, 1), cB + hstepB, voffB); PG8_STAGE(PG8_SA(0, 1), cA + hstepA, voffA);
    if (wr == 1) PG8_BAR;
    PG8_WAIT_V(4); PG8_BAR;
    PG8_STAGE(PG8_SB(1, 0), cB + kstep, voffB); PG8_STAGE(PG8_SA(1, 0), cA + kstep, voffA); PG8_STAGE(PG8_SB(1, 1), cB + hstepB + kstep, voffB);
    PG8_WAIT_V(6); PG8_BAR;
    PG8_STAMP();
    for (;;) {
        const bool has_next = S.next(ui + 1, nxt);
        const char* nA = has_next ? a_base_(nxt) : cA; const char* nB = has_next ? (const char*)g.Bt + (size_t)nxt.pn * tstepB : cB;
        for (int t = 0; t < nt; t += 2) {
            const bool last = (t == nt - 2);
            const char* a1 = cA + (size_t)(t + 1) * kstep;
            const char* a2 = last ? nA : cA + (size_t)(t + 2) * kstep; const char* b2 = last ? nB : cB + (size_t)(t + 2) * kstep;
            const char* a3 = a2 + kstep; const char* b3 = b2 + kstep;
            if (last && has_next) S.a_ready(nxt);
            PG8_LDB(B0, 0, 0); PG8_SCHED; PG8_LDA(At, 0, 0); PG8_STAGE(PG8_SA(1, 1), a1 + hstepA, voffA);
            PG8_WAIT_L(8); PG8_BAR; PG8_WAIT_L(0); PG8_MMA(0, 0, At, B0); PG8_BAR; PG8_SCHED;
            PG8_LDB(B1, 0, 1); PG8_STAGE(PG8_SB(0, 0), b2, voffB);
            PG8_BAR; PG8_WAIT_L(0); PG8_MMA(0, 1, At, B1); PG8_BAR;
            PG8_LDA(At, 0, 1); PG8_STAGE(PG8_SA(0, 0), a2, voffA);
            PG8_BAR; PG8_WAIT_L(0); PG8_MMA(1, 0, At, B0); PG8_BAR; PG8_SCHED;
            PG8_STAGE(PG8_SB(0, 1), b2 + hstepB, voffB);
            PG8_WAIT_V(6); PG8_BAR; PG8_MMA(1, 1, At, B1); PG8_BAR;
            PG8_LDB(B0, 1, 0); PG8_SCHED; PG8_LDA(At, 1, 0); PG8_STAGE(PG8_SA(0, 1), a2 + hstepA, voffA);
            PG8_WAIT_L(8); PG8_BAR; PG8_WAIT_L(0); PG8_MMA(0, 0, At, B0); PG8_BAR; PG8_SCHED;
            PG8_LDB(B1, 1, 1); PG8_STAGE(PG8_SB(1, 0), b3, voffB);
            PG8_BAR; PG8_WAIT_L(0); PG8_MMA(0, 1, At, B1); PG8_BAR;
            PG8_LDA(At, 1, 1); PG8_STAGE(PG8_SA(1, 0), a3, voffA);
            PG8_BAR; PG8_WAIT_L(0); PG8_MMA(1, 0, At, B0); PG8_BAR; PG8_SCHED;
            PG8_STAGE(PG8_SB(1, 1), b3 + hstepB, voffB);
            PG8_WAIT_V(6); PG8_BAR; PG8_MMA(1, 1, At, B1); PG8_BAR;
        }
        PG8_STAMP();
        if constexpr (Epi::FP8) { asm volatile("s_nop 15\n\ts_nop 15" ::: "memory"); }
        if constexpr (!Epi::AFTER_DRAIN) {
#if PG8_EPI_RECOMP
            const int t2_ = opaque_tid(), l2_ = t2_ & 63, w2_ = __builtin_amdgcn_readfirstlane(t2_ >> 6);
            E(acc, cur, w2_ >> 2, w2_ & 3, l2_ & 15, l2_ >> 4); S.done(cur);
#else
            E(acc, cur, wr, wc, fr, fq); S.done(cur);
#endif
        }
        PG8_STAMP();
        if (!has_next) break;
#pragma unroll
        for (int a = 0; a < 2; ++a)
#pragma unroll
            for (int b = 0; b < 2; ++b)
#pragma unroll
                for (int m = 0; m < 4; ++m)
#pragma unroll
                    for (int n = 0; n < 2; ++n) acc[a][b][m][n] = (f32x4){0.f, 0.f, 0.f, 0.f};
        cur = nxt; cA = nA; cB = nB; ++ui;
    }
    PG8_WAIT_V(0);
    if (wr == 0) PG8_BAR;
    PG8_BAR;
    if constexpr (Epi::AFTER_DRAIN) { E.fused(acc, cur, wr, wc, fr, fq, lds, wid, lane); S.done(cur); }
    PG8_STAMP();
    if (STAMP && wid == 0) { stamps[lane] = lane < nts ? (((unsigned long long)(unsigned)ts_hi << 32) | (unsigned)ts_lo) : 0ull;
        if (lane == 62) stamps[62] = rt_entry; if (lane == 63) stamps[63] = (unsigned long long)wall_clock64(); }
#undef PG8_STAMP
#undef PG8_SA
#undef PG8_SB
#undef PG8_STAGE
#undef PG8_LDA
#undef PG8_LDB
#undef PG8_MMA
#undef PG8_WAIT_V
#undef PG8_WAIT_L
#undef PG8_BAR
#undef PG8_SCHED
}
}

#include <cstdio>
#include <ctime>
#include <cstdlib>
#include <cstring>
#include <cmath>
#include <vector>

template <class F, bool F8 = false> struct EpiG {
    static constexpr bool PERM = false, AFTER_DRAIN = false, FP8 = F8;
    F f;
    __device__ __forceinline__ void operator()(const f32x4 (&acc)[2][2][4][2], const pg8::Unit& u, int wr, int wc, int fr, int fq) const {
        const int row0 = u.pm * 256 + wr * 64 + fr, col0 = u.pn * 256 + wc * 32 + 4 * fq;
#pragma unroll
        for (int ai = 0; ai < 2; ++ai)
#pragma unroll
            for (int m = 0; m < 4; ++m)
#pragma unroll
                for (int bj = 0; bj < 2; ++bj)
#pragma unroll
                    for (int n = 0; n < 2; ++n) f(row0 + ai * 128 + m * 16, col0 + bj * 128 + n * 16, acc[ai][bj][m][n]);
    }
};
template <class F> struct EpiGRow {
    static constexpr bool PERM = false, AFTER_DRAIN = false, FP8 = false;
    F f; const float* rs;
    __device__ __forceinline__ void operator()(const f32x4 (&acc)[2][2][4][2], const pg8::Unit& u, int wr, int wc, int fr, int fq) const {
        const int row0 = u.pm * 256 + wr * 64 + fr, col0 = u.pn * 256 + wc * 32 + 4 * fq;
        float s[2][4];
#pragma unroll
        for (int ai = 0; ai < 2; ++ai)
#pragma unroll
            for (int m = 0; m < 4; ++m) s[ai][m] = rs[row0 + ai * 128 + m * 16];
#pragma unroll
        for (int ai = 0; ai < 2; ++ai)
#pragma unroll
            for (int m = 0; m < 4; ++m)
#pragma unroll
                for (int bj = 0; bj < 2; ++bj)
#pragma unroll
                    for (int n = 0; n < 2; ++n) f(row0 + ai * 128 + m * 16, col0 + bj * 128 + n * 16, acc[ai][bj][m][n] * s[ai][m]);
    }
};
__device__ __forceinline__ void st_bf16x4(bf16_t* p, f32x4 v) { u32x2 w; w.x = pack2bf(v[0], v[1]); w.y = pack2bf(v[2], v[3]); *(u32x2*)p = w; }
__device__ __forceinline__ void st_f32x4(float* p, f32x4 v) { *(f32x4*)p = v; }

struct FStoreBf16 { bf16_t* O; int ldc; int pad_; __device__ __forceinline__ void operator()(int r, int c, f32x4 v) const { st_bf16x4(O + (size_t)r * ldc + c, v); } };
struct FAbIn { bf16_t *Q, *K, *V; float *QI, *U, *WI; unsigned short* KI16;
    __device__ __forceinline__ void operator()(int r, int c, f32x4 v) const {
        if (c < 1024) st_bf16x4(Q + (size_t)r * 1024 + c, v);
        else if (c < 2048) st_bf16x4(K + (size_t)r * 1024 + (c - 1024), v);
        else if (c < 3072) st_bf16x4(V + (size_t)r * 1024 + (c - 2048), v);
        else if (c < 4096) st_f32x4(QI + (size_t)r * 1024 + (c - 3072), v);
        else if (c < 5120) st_f32x4(U + (size_t)r * 1024 + (c - 4096), v);
        else if (c < 5184) { typedef _Float16 h2 __attribute__((ext_vector_type(2))); union { h2 h; unsigned u; } a, b; a.h = (h2){(_Float16)v[0], (_Float16)v[1]}; b.h = (h2){(_Float16)v[2], (_Float16)v[3]};
            u32x2 w; w.x = a.u; w.y = b.u; *(u32x2*)(KI16 + (size_t)r * 64 + (c - 5120)) = w; }
        else if (c < 5200) st_f32x4(WI + (size_t)r * 16 + (c - 5184), v);
    } };
struct FCdIn { float *CQ, *CKV, *KR; bf16_t *XL, *YG;
    __device__ __forceinline__ void operator()(int r, int c, f32x4 v) const {
        if (c < 512) st_f32x4(CQ + (size_t)r * 512 + c, v);
        else if (c < 768) st_f32x4(CKV + (size_t)r * 256 + (c - 512), v);
        else if (c < 832) st_f32x4(KR + (size_t)r * 64 + (c - 768), v);
        else if (c < 1024) {}
        else if (c < 2048) st_bf16x4(XL + (size_t)r * 1024 + (c - 1024), v);
        else st_bf16x4(YG + (size_t)r * 1024 + (c - 2048), v);
    } };
struct FKvUp { bf16_t *K1, *V1;
    __device__ __forceinline__ void operator()(int r, int c, f32x4 v) const {
        const int h = c >> 8, d = c & 255;
        if (d < 128) st_bf16x4(K1 + (size_t)r * 1536 + h * 192 + d, v);
        else st_bf16x4(V1 + (size_t)r * 1024 + h * 128 + (d - 128), v);
    } };

__device__ __forceinline__ unsigned ord_key(float f) { const unsigned b = __float_as_uint(f); return (b & 0x80000000u) ? ~b : (b | 0x80000000u); }
__device__ __forceinline__ void rope_cs(int pos, int i, float& c, float& s) { const float freq = powf(10000.0f, -(float)i / 32.0f); const float ang = (float)pos * freq; sincosf(ang, &s, &c); }
#define PV8_MLA 1
#define PV8_DSA 1

typedef short bf16x8 __attribute__((ext_vector_type(8)));
typedef float f32x16 __attribute__((ext_vector_type(16)));
__device__ __forceinline__ unsigned cvtpk(float lo, float hi) { unsigned r; asm("v_cvt_pk_bf16_f32 %0, %1, %2" : "=v"(r) : "v"(lo), "v"(hi)); return r; }
__device__ __forceinline__ float max3_asm(float a, float b, float c) { float r; asm("v_max3_f32 %0, %1, %2, %3" : "=v"(r) : "v"(a), "v"(b), "v"(c)); return r; }

struct AttnArgs { const bf16_t* Q; const bf16_t* K; const bf16_t* VT; const unsigned long long* MT; bf16_t* O; int ldq, ldk, ldo; float sc_log2e; };

static constexpr int ATT_MTBL = 65536;
struct TTrue { static constexpr bool value = true; }; struct TFalse { static constexpr bool value = false; };
typedef int i32x8q __attribute__((ext_vector_type(8)));
typedef int i32x4q __attribute__((ext_vector_type(4)));
#define MFMA8_FENCE2(acc0, acc1, srcA, srcB) asm volatile("s_nop 15\n\ts_nop 9" : "+v"(acc0), "+v"(acc1) : "v"(srcA), "v"(srcB))
#define MFMA8_FENCE4(a0_, a1_, a2_, a3_, srcA, srcB) asm volatile("s_nop 15\n\ts_nop 9" : "+v"(a0_), "+v"(a1_), "+v"(a2_), "+v"(a3_) : "v"(srcA), "v"(srcB))
template <int DQK, bool MASKED, bool QK8>
__device__ __forceinline__ void attn_item3(LAS unsigned char* lds, const AttnArgs& a, int b, int h, int qb) {
    constexpr int NKS = QK8 ? DQK / 64 : DQK / 16, PK = QK8 ? DQK : DQK * 2, PV = 64, KB_BYTES = 64 * PK, VB_BYTES = 128 * PV, NPK = PK / 16, NKP = (64 * NPK + 511) / 512, V_OFF = 3 * KB_BYTES;
    const int tid = opaque_tid(), lane = tid & 63, w = __builtin_amdgcn_readfirstlane(tid >> 6), n = lane & 31, hf = lane >> 5;
    const int nt = 4 * qb + 4, cw = 4 * qb + (w >> 1);
    const int trow = qb * 256 + w * 32 + n;
    const size_t grow = (size_t)b * SEQ + trow;
    bf16x8 qf[QK8 ? 1 : NKS]; i32x8q q8[QK8 ? NKS : 1];
    if (QK8) { const unsigned char* qp = (const unsigned char*)a.Q + grow * a.ldq + h * DQK + hf * 32;
#pragma unroll
      for (int ks = 0; ks < NKS; ++ks) { q8[ks].lo = *(const i32x4q*)(qp + ks * 64); q8[ks].hi = *(const i32x4q*)(qp + ks * 64 + 16); } }
    else { const bf16_t* qp = a.Q + grow * a.ldq + h * DQK + hf * 8;
#pragma unroll
      for (int ks = 0; ks < NKS; ++ks) qf[ks] = *(const bf16x8*)(qp + ks * 16); }
    f32x16 o[4];
#pragma unroll
    for (int dt = 0; dt < 4; ++dt)
#pragma unroll
        for (int r = 0; r < 16; ++r) o[dt][r] = 0.f;
    float m_run = -1000.0f, l_run = 0.f;
    const unsigned char* Kg = (const unsigned char*)a.K + ((size_t)b * SEQ * a.ldk + h * DQK) * (QK8 ? 1 : 2);
    const unsigned char* Vg = (const unsigned char*)a.VT + (size_t)(b * 8 + h) * 128 * SEQ;
    const unsigned long long* Mg = MASKED ? a.MT + (size_t)b * 256 * SEQ + trow : nullptr;
    auto dma_k = [&](int kt) {
        LAS unsigned char* kb = lds + (kt % 3) * KB_BYTES;
#pragma unroll
        for (int i = 0; i < NKP; ++i) { if ((w + 8 * i) * 64 >= 64 * NPK) break;
            const int s = (w + 8 * i) * 64 + lane, r = s / NPK, cp = s % NPK, cc = cp ^ (NPK == 16 ? (r & 15) : (NPK == 12 ? ((r >> 2) & 3) : ((r >> 1) & 7)));
            __builtin_amdgcn_global_load_lds((const unsigned*)(Kg + ((size_t)(kt * 64 + r) * a.ldk) * (QK8 ? 1 : 2) + cc * 16), (LAS unsigned*)(kb + (w + 8 * i) * 1024), 16, 0, 0); }
    };
    auto dma_v = [&](int kt) {
        LAS unsigned char* vb = lds + V_OFF + (kt & 1) * VB_BYTES;
        const int s = w * 64 + lane, d = s >> 2, cp = s & 3, cc = cp ^ ((d >> 2) & 3);
        __builtin_amdgcn_global_load_lds((const unsigned*)(Vg + (size_t)d * SEQ + kt * 64 + cc * 16), (LAS unsigned*)(vb + w * 1024), 16, 0, 0);
    };
    const int kswz = (NPK == 16) ? (n & 15) : (NPK == 12 ? ((n >> 2) & 3) : ((n >> 1) & 7)), vswz = (n >> 2) & 3;
    auto qk = [&](int kt, f32x16& s0, f32x16& s1, bool fence, float init) {
        const LAS unsigned char* ka = lds + (kt % 3) * KB_BYTES + n * PK;
#pragma unroll
        for (int r = 0; r < 16; ++r) { s0[r] = init; s1[r] = init; }
        if (QK8) {
#pragma unroll
            for (int ks = 0; ks < NKS; ++ks) {
                const int p0 = ((4 * ks + 2 * hf) ^ kswz) * 16, p1 = ((4 * ks + 2 * hf + 1) ^ kswz) * 16;
                i32x8q a0, a1;
                a0.lo = *(const LAS i32x4q*)(ka + p0); a0.hi = *(const LAS i32x4q*)(ka + p1);
                a1.lo = *(const LAS i32x4q*)(ka + 32 * PK + p0); a1.hi = *(const LAS i32x4q*)(ka + 32 * PK + p1);
                s0 = __builtin_amdgcn_mfma_scale_f32_32x32x64_f8f6f4(a0, q8[ks], s0, 0, 0, 0, 0x7F7F7F7F, 0, 0x7C7C7C7C);
                s1 = __builtin_amdgcn_mfma_scale_f32_32x32x64_f8f6f4(a1, q8[ks], s1, 0, 0, 0, 0x7F7F7F7F, 0, 0x7C7C7C7C);
                if (ks == NKS - 1 && fence) MFMA8_FENCE2(s0, s1, a0, a1);
            }
        } else {
#pragma unroll
            for (int ks = 0; ks < NKS; ++ks) {
                const int po = ((2 * ks + hf) ^ kswz) * 16;
                const bf16x8 a0 = *(const LAS bf16x8*)(ka + po), a1 = *(const LAS bf16x8*)(ka + 32 * PK + po);
                s0 = __builtin_amdgcn_mfma_f32_32x32x16_bf16(a0, qf[ks], s0, 0, 0, 0);
                s1 = __builtin_amdgcn_mfma_f32_32x32x16_bf16(a1, qf[ks], s1, 0, 0, 0);
            }
        }
    };
    i32x8q idA0, idA1;
#pragma unroll
    for (int i = 0; i < 8; ++i) { const int v = (i == (n >> 2)) ? (0x38 << (8 * (n & 3))) : 0; idA0[i] = hf ? 0 : v; idA1[i] = hf ? v : 0; }
    auto maskmma = [&](unsigned long long mw, f32x16& s0, f32x16& s1, bool fence) {
        if (MASKED) {
            const unsigned bits = hf ? (unsigned)(mw >> 32) : (unsigned)mw;
            const LAS u32x2* tbl = (const LAS u32x2*)(lds + ATT_MTBL);
            i32x8q bm;
#pragma unroll
            for (int i = 0; i < 4; ++i) { const u32x2 t = tbl[(bits >> (8 * i)) & 255u]; bm[2 * i] = (int)t.x; bm[2 * i + 1] = (int)t.y; }
            s0 = __builtin_amdgcn_mfma_scale_f32_32x32x64_f8f6f4(idA0, bm, s0, 0, 0, 0, 0x7F7F7F7F, 0, (int)0x82828282);
            s1 = __builtin_amdgcn_mfma_scale_f32_32x32x64_f8f6f4(idA1, bm, s1, 0, 0, 0, 0x7F7F7F7F, 0, (int)0x82828282);
            MFMA8_FENCE2(s0, s1, idA1, bm);
        }
    };
    auto rowmax = [&](f32x16& s0, f32x16& s1) -> float {
        float mx = max3_asm(s0[0], s1[0], s0[1]);
        mx = max3_asm(mx, s1[1], s0[2]);
#pragma unroll
        for (int r = 2; r < 15; ++r) mx = max3_asm(mx, s1[r], s0[r + 1]);
        mx = max3_asm(mx, s1[15], mx);
        const auto rr = __builtin_amdgcn_permlane32_swap(__float_as_uint(mx), __float_as_uint(mx), false, false);
        return fmaxf(__uint_as_float(rr[0]), __uint_as_float(rr[1]));
    };
    auto pv = [&](const f32x16& c0, const f32x16& c1, int kt, bool fence) {
        i32x8q pb;
#pragma unroll
        for (int i = 0; i < 4; ++i) { int d0 = 0, d1 = 0;
            d0 = __builtin_amdgcn_cvt_pk_fp8_f32(c0[4 * i], c0[4 * i + 1], d0, false); d0 = __builtin_amdgcn_cvt_pk_fp8_f32(c0[4 * i + 2], c0[4 * i + 3], d0, true);
            d1 = __builtin_amdgcn_cvt_pk_fp8_f32(c1[4 * i], c1[4 * i + 1], d1, false); d1 = __builtin_amdgcn_cvt_pk_fp8_f32(c1[4 * i + 2], c1[4 * i + 3], d1, true);
            pb[i] = d0; pb[4 + i] = d1; }
        const LAS unsigned char* va = lds + V_OFF + (kt & 1) * VB_BYTES + n * PV;
        const int q0_ = ((2 * hf) ^ vswz) * 16, q1_ = ((2 * hf + 1) ^ vswz) * 16;
#pragma unroll
        for (int dt = 0; dt < 4; ++dt) { i32x8q vf; vf.lo = *(const LAS i32x4q*)(va + dt * 32 * PV + q0_); vf.hi = *(const LAS i32x4q*)(va + dt * 32 * PV + q1_);
            o[dt] = __builtin_amdgcn_mfma_scale_f32_32x32x64_f8f6f4(vf, pb, o[dt], 0, 0, 0, 0x7F7F7F7F, 0, 0x79797979);
            if (dt == 3) MFMA8_FENCE4(o[0], o[1], o[2], o[3], vf, pb); }
    };
    dma_k(0); dma_v(0); if (nt > 1) dma_k(1);
    unsigned long long mw_pre = MASKED ? Mg[(size_t)(nt > 1 ? 1 : 0) * SEQ] : 0ull;
    asm volatile("s_waitcnt vmcnt(0)" ::: "memory");
    __syncthreads();
    f32x16 sa0, sa1, sb0, sb1;
    float ba = m_run, bb = m_run;
    qk(0, sa0, sa1, true, 6.0f - ba); maskmma(MASKED ? Mg[0] : 0ull, sa0, sa1, true);
    float mx_cur = rowmax(sa0, sa1);
    auto step = [&](int kt, f32x16& c0, f32x16& c1, f32x16& n0, f32x16& n1, float& bc, float& bn, auto full_tag) {
        constexpr bool FULL = decltype(full_tag)::value;
        if (kt + 2 < nt) dma_k(kt + 2);
        if (kt + 1 < nt) dma_v(kt + 1);
        const unsigned long long mw_now = mw_pre;
        if (MASKED) mw_pre = Mg[(size_t)(kt + 2 < nt ? kt + 2 : kt) * SEQ];
        const bool act = FULL || kt <= cw, actn = FULL || kt + 1 <= cw;
        const float mx_abs = mx_cur + (bc - 6.0f);
        const bool grew = act && __any(mx_abs > m_run + 2.5f);
        const float m_new = grew ? fmaxf(m_run, mx_abs) : m_run;
        if (grew) {
            const float al = __builtin_amdgcn_exp2f(m_run - m_new), d = m_new - bc;
            l_run *= al;
#pragma unroll
            for (int dt = 0; dt < 4; ++dt)
#pragma unroll
                for (int r = 0; r < 16; ++r) o[dt][r] *= al;
#pragma unroll
            for (int r = 0; r < 16; ++r) { c0[r] -= d; c1[r] -= d; }
        }
        if (act) m_run = m_new;
        auto sm = [&]() {
            float ps = 0.f;
#pragma unroll
            for (int r = 0; r < 16; ++r) { c0[r] = __builtin_amdgcn_exp2f(c0[r]); c1[r] = __builtin_amdgcn_exp2f(c1[r]); ps += c0[r] + c1[r]; }
            l_run += ps;
        };
        if (FULL) {
            bn = m_run;
            qk(kt + 1, n0, n1, !MASKED, 6.0f - bn); maskmma(mw_now, n0, n1, true);
            sm();
            pv(c0, c1, kt, true);
            mx_cur = rowmax(n0, n1);
        } else {
            if (actn) { bn = m_run; qk(kt + 1, n0, n1, true, 6.0f - bn); maskmma(mw_now, n0, n1, true); }
            if (act) { sm(); pv(c0, c1, kt, true); }
            if (actn) mx_cur = rowmax(n0, n1);
        }
        asm volatile("s_waitcnt vmcnt(0)" ::: "memory");
        __syncthreads();
    };
    int kt = 0;
    for (; kt < 4 * qb; kt += 2) { step(kt, sa0, sa1, sb0, sb1, ba, bb, TTrue{}); step(kt + 1, sb0, sb1, sa0, sa1, bb, ba, TTrue{}); }
    for (; kt < nt; kt += 2) { step(kt, sa0, sa1, sb0, sb1, ba, bb, TFalse{}); step(kt + 1, sb0, sb1, sa0, sa1, bb, ba, TFalse{}); }
    const float lt = l_run + __shfl_xor(l_run, 32);
    const float inv = 64.0f / lt;
    bf16_t* op = a.O + grow * a.ldo + h * 128 + hf * 4;
#pragma unroll
    for (int dt = 0; dt < 4; ++dt)
#pragma unroll
        for (int r4 = 0; r4 < 4; ++r4) { u32x2 wv; wv.x = cvtpk(o[dt][4 * r4] * inv, o[dt][4 * r4 + 1] * inv); wv.y = cvtpk(o[dt][4 * r4 + 2] * inv, o[dt][4 * r4 + 3] * inv);
            *(u32x2*)(op + dt * 32 + r4 * 8) = wv; }
}
template <int DQK, bool MASKED>
__device__ __forceinline__ void attn_phase(LAS unsigned char* lds, const AttnArgs& a, int bid, int nblk) {
    if (MASKED) {
        const int t = opaque_tid();
        if (t < 256) { unsigned lo = 0u, hi = 0u;
#pragma unroll
            for (int i = 0; i < 4; ++i) { if (!((t >> i) & 1)) lo |= 0xFEu << (8 * i); if (!((t >> (4 + i)) & 1)) hi |= 0xFEu << (8 * i); }
            u32x2 v; v.x = lo; v.y = hi; ((LAS u32x2*)(lds + ATT_MTBL))[t] = v; }
        __syncthreads();
    }
    for (int p = bid; p < 512; p += nblk) {
        const int bh = (p & 7) + 8 * (p >> 8), j = (p >> 3) & 31;
#pragma unroll 1
        for (int i = 0; i < 2; ++i) attn_item3<DQK, MASKED, true>(lds, a, bh >> 3, bh & 7, i ? j : 63 - j);
    }
}

#ifdef IDX_PROBE_FINAL
#define IDX_PF_ 1
#else
#define IDX_PF_ 0
#endif
typedef _Float16 f16x8 __attribute__((ext_vector_type(8)));
struct IdxArgs { const unsigned short* QI; const unsigned short* KI16; const float* WI; unsigned long long* MT; };
static constexpr int IDX_CAP = 640, IDX_CS = 0, IDX_CI = 32 * IDX_CAP * 4, IDX_KT = IDX_CI + 32 * IDX_CAP * 2, IDX_CNT = IDX_KT + 32768, IDX_TAU = IDX_CNT + 128, IDX_LDS = IDX_TAU + 128;
static_assert(IDX_KT % 1024 == 0, "K tile buffers must be 1 KiB aligned");

__device__ __forceinline__ float ord_inv(unsigned T) { return __uint_as_float((T & 0x80000000u) ? (T & 0x7FFFFFFFu) : ~T); }
__device__ __forceinline__ unsigned lane_prefix(unsigned long long m) { return __builtin_amdgcn_mbcnt_hi((unsigned)(m >> 32), __builtin_amdgcn_mbcnt_lo((unsigned)m, 0u)); }
__device__ __forceinline__ float relu_asm(float x) { float y; asm("v_max_f32 %0, 0, %1" : "=v"(y) : "v"(x)); return y; }
__device__ __forceinline__ void glds16(const void* gsrc, unsigned lds_dst) {
    unsigned keep;
    asm volatile("s_mov_b32 %0, m0\n\ts_mov_b32 m0, %2\n\ts_nop 0\n\tglobal_load_lds_dwordx4 %1, off\n\ts_mov_b32 m0, %0" : "=&s"(keep) : "v"(gsrc), "s"(lds_dst) : "memory");
}

template <bool EXACT> __device__ __forceinline__ int idx_compact(LAS unsigned char* lds, int qq, int lane, int n, float& tau) {
    LAS float* cs = (LAS float*)(lds + IDX_CS) + qq * IDX_CAP; LAS unsigned short* ci = (LAS unsigned short*)(lds + IDX_CI) + qq * IDX_CAP;
    float sv[10]; unsigned short iv[10]; unsigned uk[10];
#pragma unroll
    for (int j = 0; j < 10; ++j) { const int idx = lane + 64 * j; const bool valid = idx < n; sv[j] = cs[idx]; iv[j] = ci[idx]; uk[j] = valid ? ord_key(sv[j]) : 0u; }
    auto count_ge = [&](unsigned t) { int c = 0;
#pragma unroll
        for (int j = 0; j < 10; ++j) c += __builtin_popcountll(__ballot(uk[j] >= t));
        return c; };
    unsigned lo = ord_key(tau), hi = 0xFF800001u;
    if (lo > 0x80800000u) { const unsigned h2 = lo + 0x00800000u;
        if (h2 < hi) { if (count_ge(h2) >= 256) lo = h2; else hi = h2; } }
    while (hi - lo > 1u) {
        const unsigned mid = lo + ((hi - lo) >> 1); const int c = count_ge(mid);
        if (c >= 256) { lo = mid; if (EXACT ? (c == 256) : (c <= 336)) break; } else hi = mid;
    }
    const unsigned T = lo;
    int need = 0;
    if (EXACT) { int ngt = 0;
#pragma unroll
        for (int j = 0; j < 10; ++j) ngt += __builtin_popcountll(__ballot(uk[j] > T));
        need = 256 - ngt; }
    int base = 0, tiebase = 0;
#pragma unroll
    for (int j = 0; j < 10; ++j) {
        bool keep;
        if (EXACT) { const bool gt = uk[j] > T, eq = uk[j] == T; const unsigned long long em = __ballot(eq); keep = gt || (eq && (tiebase + (int)lane_prefix(em)) < need); tiebase += __builtin_popcountll(em); }
        else keep = uk[j] >= T;
        const unsigned long long km = __ballot(keep);
        const int pos = base + (int)lane_prefix(km);
        if (keep) { cs[pos] = sv[j]; ci[pos] = iv[j]; }
        base += __builtin_popcountll(km);
    }
    tau = ord_inv(T);
    return base;
}

__device__ __forceinline__ void idx_item(LAS unsigned char* lds, const IdxArgs& a, int b, int hc) {
    const int tid = opaque_tid(), lane = tid & 63, w = __builtin_amdgcn_readfirstlane(tid >> 6), n = lane & 31, hf = lane >> 5;
    const int t0 = hc * 32, L = (t0 / 64 + 1) * 64, nsub = L / 32, ntile = (L + 127) / 128;
    const size_t q0 = (size_t)b * SEQ + t0 + 4 * w;
    LAS float* cs = (LAS float*)(lds + IDX_CS); LAS unsigned short* ci = (LAS unsigned short*)(lds + IDX_CI);
    LAS unsigned* cnt = (LAS unsigned*)(lds + IDX_CNT);
    f16x8 qf[2][4];
#pragma unroll
    for (int rt = 0; rt < 2; ++rt) { const unsigned short* qp = a.QI + (q0 + 2 * rt + (n >> 4)) * 1024 + (n & 15) * 64 + hf * 8;
#pragma unroll
        for (int ks = 0; ks < 4; ++ks) qf[rt][ks] = *(const f16x8*)(qp + ks * 16); }
    float wv[2][16];
#pragma unroll
    for (int rt = 0; rt < 2; ++rt)
#pragma unroll
        for (int r = 0; r < 16; ++r) wv[rt][r] = a.WI[(q0 + 2 * rt + (r >> 3)) * 16 + (((r & 3) + 8 * (r >> 2) + 4 * hf) & 15)] * (0.125f * 0.25f);
    if (tid < 32) cnt[tid] = 0u;
    int cq0 = 0, cq1 = 0, cq2 = 0, cq3 = 0;
    float tq0 = -INFINITY, tq1 = -INFINITY, tq2 = -INFINITY, tq3 = -INFINITY;
    float tau0 = INFINITY, tau1 = INFINITY;
    const unsigned short* Kg = a.KI16 + (size_t)b * SEQ * 64;
    const unsigned ldsbase = (unsigned)(size_t)lds;
    auto dma = [&](int kt, int buf) {
#pragma unroll
        for (int i = 0; i < 2; ++i) { const int s = (w + 8 * i) * 64 + lane, r = s >> 3, cp = s & 7, cc = cp ^ ((r >> 1) & 7);
            glds16(Kg + (size_t)(kt * 128 + r) * 64 + cc * 8, ldsbase + IDX_KT + buf * 16384 + (w + 8 * i) * 1024); }
    };
    dma(0, 0);
    asm volatile("s_waitcnt vmcnt(0)" ::: "memory");
    __syncthreads();
    const int kswz = (n >> 1) & 7;
    f32x16 accA[2], accB[2];
#pragma unroll
    for (int rt = 0; rt < 2; ++rt)
#pragma unroll
        for (int r = 0; r < 16; ++r) { accA[rt][r] = 0.f; accB[rt][r] = 0.f; }
    int keyA = 0, keyB = 0;
    auto epilogue = [&](const f32x16 (&acc)[2], int key) {
        float sc[2];
#pragma unroll
        for (int rt = 0; rt < 2; ++rt) { float pa = 0.f, pb = 0.f;
#pragma unroll
            for (int r = 0; r < 8; ++r) { pa = fmaf(relu_asm(acc[rt][r]), wv[rt][r], pa); pb = fmaf(relu_asm(acc[rt][r + 8]), wv[rt][r + 8], pb); }
            const auto rr = __builtin_amdgcn_permlane32_swap(__float_as_uint(pa), __float_as_uint(pb), false, false);
            sc[rt] = __uint_as_float(rr[0]) + __uint_as_float(rr[1]); }
        const bool c0 = sc[0] > tau0, c1 = sc[1] > tau1;
        const unsigned long long m0 = __ballot(c0), m1 = __ballot(c1);
        {
            const unsigned l0 = (unsigned)m0, h0 = (unsigned)(m0 >> 32), l1 = (unsigned)m1, h1 = (unsigned)(m1 >> 32);
            const int p0 = hf ? cq1 + (int)__builtin_amdgcn_mbcnt_hi(h0, 0u) : cq0 + (int)__builtin_amdgcn_mbcnt_lo(l0, 0u);
            const int p1 = hf ? cq3 + (int)__builtin_amdgcn_mbcnt_hi(h1, 0u) : cq2 + (int)__builtin_amdgcn_mbcnt_lo(l1, 0u);
            if (c0 && p0 < IDX_CAP) { const int qq = 4 * w + hf; cs[qq * IDX_CAP + p0] = sc[0]; ci[qq * IDX_CAP + p0] = (unsigned short)key; }
            if (c1 && p1 < IDX_CAP) { const int qq = 4 * w + 2 + hf; cs[qq * IDX_CAP + p1] = sc[1]; ci[qq * IDX_CAP + p1] = (unsigned short)key; }
            cq0 += __builtin_popcount(l0); cq1 += __builtin_popcount(h0); cq2 += __builtin_popcount(l1); cq3 += __builtin_popcount(h1);
        }
    };
    f16x8 kfA[4], kfB[4];
    auto ldk = [&](f16x8 (&kf)[4], const LAS unsigned char* kr) {
#pragma unroll
        for (int ks = 0; ks < 4; ++ks) kf[ks] = *(const LAS f16x8*)(kr + ((2 * ks + hf) ^ kswz) * 16);
    };
    auto mma = [&](f32x16 (&acc)[2], const f16x8 (&kf)[4]) {
#pragma unroll
        for (int rt = 0; rt < 2; ++rt) {
            f32x16 c;
#pragma unroll
            for (int r = 0; r < 16; ++r) c[r] = 0.f;
#pragma unroll
            for (int ks = 0; ks < 4; ++ks) c = __builtin_amdgcn_mfma_f32_32x32x16_f16(qf[rt][ks], kf[ks], c, 0, 0, 0);
            acc[rt] = c; }
    };
#ifdef IDX_PROBE2
  for (int rep_ = 0; rep_ < 2; ++rep_) {
    if (rep_ == 1) { epilogue(accB, keyB); tau0 = INFINITY; tau1 = INFINITY; __syncthreads(); dma(0, 0); asm volatile("s_waitcnt vmcnt(0)" ::: "memory"); __syncthreads(); }
#endif
    for (int kt = 0; kt < ntile; ++kt) {
        if (kt + 1 < ntile) dma(kt + 1, (kt + 1) & 1);
#ifdef IDX_PROBE2
        if (rep_ == 0)
#endif
        { const unsigned c_all = cnt[lane & 31];
          if (__ballot(c_all > (unsigned)(IDX_CAP - (kt == ntile - 1 ? 160 : 128)))) {
#pragma unroll 1
              for (int i = 0; i < 4; ++i) {
                  int cqi = (i == 0) ? cq0 : ((i == 1) ? cq1 : ((i == 2) ? cq2 : cq3));
                  if (cqi > 336) { float tqi = (i == 0) ? tq0 : ((i == 1) ? tq1 : ((i == 2) ? tq2 : tq3));
                      cqi = idx_compact<false>(lds, 4 * w + i, lane, cqi, tqi);
                      if (i == 0) { cq0 = cqi; tq0 = tqi; } else if (i == 1) { cq1 = cqi; tq1 = tqi; } else if (i == 2) { cq2 = cqi; tq2 = tqi; } else { cq3 = cqi; tq3 = tqi; } }
              }
              if (kt > 0) { tau0 = hf ? tq1 : tq0; tau1 = hf ? tq3 : tq2; }
          } }
        const LAS unsigned char* kb = lds + IDX_KT + (kt & 1) * 16384 + n * 128;
        const int sbase = kt * 4;
#ifdef IDX_PROBE2
        if (sbase + 0 < nsub) { ldk(kfA, kb); if (sbase + 1 < nsub) ldk(kfB, kb + 32 * 128); mma(accA, kfA); epilogue(accB, keyB); keyA = kt * 128 + n; if (kt == 0 && rep_ == 0) { tau0 = -INFINITY; tau1 = -INFINITY; } }
#else
        if (sbase + 0 < nsub) { ldk(kfA, kb); if (sbase + 1 < nsub) ldk(kfB, kb + 32 * 128); mma(accA, kfA); epilogue(accB, keyB); keyA = kt * 128 + n; if (kt == 0) { tau0 = -INFINITY; tau1 = -INFINITY; } }
#endif
        if (sbase + 1 < nsub) { if (sbase + 2 < nsub) ldk(kfA, kb + 64 * 128); mma(accB, kfB); epilogue(accA, keyA); keyB = kt * 128 + 32 + n; }
        if (sbase + 2 < nsub) { if (sbase + 3 < nsub) ldk(kfB, kb + 96 * 128); mma(accA, kfA); epilogue(accB, keyB); keyA = kt * 128 + 64 + n; }
        if (sbase + 3 < nsub) { mma(accB, kfB); epilogue(accA, keyA); keyB = kt * 128 + 96 + n; }
        if (lane < 4) cnt[4 * w + lane] = (unsigned)(lane == 0 ? cq0 : (lane == 1 ? cq1 : (lane == 2 ? cq2 : cq3)));
        asm volatile("s_waitcnt vmcnt(0)" ::: "memory");
        __syncthreads();
    }
#ifdef IDX_PROBE2
  }
#endif
    epilogue(accB, keyB);
    __syncthreads();
    const int lane2 = opaque_tid() & 63;
    LAS unsigned* bm = (LAS unsigned*)(lds + IDX_KT) + w * 512;
#ifdef IDX_PROBE_FINAL
  for (int rep2_ = 0; rep2_ < 2; ++rep2_) {
#endif
#pragma unroll 1
    for (int i = 0; i < 4; ++i) {
        const int qq = 4 * w + i;
        int nsel = (i == 0) ? cq0 : ((i == 1) ? cq1 : ((i == 2) ? cq2 : cq3));
        if (nsel > 256 - IDX_PF_) { float tqi = (i == 0) ? tq0 : ((i == 1) ? tq1 : ((i == 2) ? tq2 : tq3)); nsel = idx_compact<true>(lds, qq, lane2, nsel, tqi); }
#pragma unroll
        for (int j = 0; j < 8; ++j) bm[lane2 + 64 * j] = 0u;
#pragma unroll
        for (int j = 0; j < 4; ++j) { const int idx = lane2 + 64 * j; if (idx < nsel) { const unsigned k = ci[qq * IDX_CAP + idx]; (void)__hip_atomic_fetch_or(bm + (k >> 5), 1u << (k & 31), __ATOMIC_RELAXED, __HIP_MEMORY_SCOPE_WORKGROUP); } }
        const int tq = t0 + qq;
#pragma unroll 1
        for (int kt = lane2; kt < L / 64; kt += 64) { const unsigned long long v = (unsigned long long)bm[2 * kt] | ((unsigned long long)bm[2 * kt + 1] << 32); a.MT[((size_t)b * 256 + kt) * SEQ + tq] = v; }
    }
#ifdef IDX_PROBE_FINAL
  }
#endif
    __syncthreads();
}
__device__ __forceinline__ void idx_phase(LAS unsigned char* lds, const IdxArgs& a, int bid, int nblk) {
    for (int k = bid; k < 256; k += nblk) {
#pragma unroll 1
        for (int i = 0; i < 4; ++i) idx_item(lds, a, i & 1, (i < 2) ? 511 - k : k);
    }
}
#define XB_TMO      128
#define XB_XCNT(j)  (256  + 64 * (j))
#define XB_XSUB(j)  (1280 + 64 * (j))
#define XB_XGEN(j)  (2304 + 64 * (j))
#define XB_TOP      3328
#define XB_TOPGEN   3392
#define XCD_BAR_WORDS 3456
#define XB_SPIN_CAP (1u << 23)


__device__ __forceinline__ unsigned xb_ld(unsigned* p)              { return __hip_atomic_load(p, __ATOMIC_RELAXED, __HIP_MEMORY_SCOPE_AGENT); }
__device__ __forceinline__ unsigned xb_add(unsigned* p, unsigned v) { return __hip_atomic_fetch_add(p, v, __ATOMIC_RELAXED, __HIP_MEMORY_SCOPE_AGENT); }
__device__ __forceinline__ unsigned xb_xcc_id() { return (unsigned)__builtin_amdgcn_s_getreg((3 << 11) | 20) & 0xFu; }
#define XB_SPIN(cond, bar) do { unsigned _sp = 0; while (cond) { __builtin_amdgcn_s_sleep(1); \
    if ((++_sp & 255u) == 0u) { if (xb_ld(&(bar)[XB_TMO])) break; if (_sp > XB_SPIN_CAP) { atomicAdd(&(bar)[XB_TMO], 1u); break; } } } } while (0)

struct XcdBarrier {
    unsigned* bar; unsigned x;
    volatile LAS unsigned* st;
};

__device__ __forceinline__ XcdBarrier xcd_barrier_post(unsigned* bar, volatile LAS unsigned* st) {
    XcdBarrier b; b.bar = bar; b.x = xb_xcc_id(); b.st = st;
    if (threadIdx.x == 0) (void)xb_add(&bar[XB_XCNT(b.x)], 1u);
    return b;
}
__device__ __forceinline__ void xcd_barrier_complete(unsigned* bar, unsigned x, unsigned& nloc, unsigned& nx) {
    const unsigned G = gridDim.x * gridDim.y * gridDim.z;
    unsigned sum, cnt, mine, sp = 0u;
    for (;;) {
        sum = 0u; cnt = 0u; mine = 0u;
#pragma unroll
        for (unsigned j = 0; j < 16; ++j) { const unsigned c = xb_ld(&bar[XB_XCNT(j)]); sum += c; cnt += (c > 0u) ? 1u : 0u; mine = (j == x) ? c : mine; }
        if (sum == G) break;
        __builtin_amdgcn_s_sleep(1);
        if ((++sp & 255u) == 0u) { if (xb_ld(&bar[XB_TMO])) break; if (sp > XB_SPIN_CAP) { atomicAdd(&bar[XB_TMO], 1u); break; } }
    }
    nloc = mine > 0u ? mine : 1u; nx = cnt > 0u ? cnt : 1u;
}

__device__ __forceinline__ void xcd_barrier(const XcdBarrier& b) {
    asm volatile("s_waitcnt vmcnt(0)" ::: "memory");
    __syncthreads();
    if (threadIdx.x == 0) {
        unsigned* bar = b.bar;
        __builtin_amdgcn_s_waitcnt(0);
        unsigned nloc = b.st[0], nx = b.st[1];
        if (nloc == 0u) { xcd_barrier_complete(bar, b.x, nloc, nx); b.st[0] = nloc; b.st[1] = nx; }
        const unsigned old = xb_add(&bar[XB_XSUB(b.x)], 1u);
        const unsigned gen = old / nloc;
        if (old + 1u == (gen + 1u) * nloc) {
            __builtin_amdgcn_fence(__ATOMIC_RELEASE, "agent");
            asm volatile("s_waitcnt vmcnt(0)" ::: "memory");
            const unsigned og = xb_add(&bar[XB_TOP], 1u);
            const unsigned tg = og / nx;
            if (og + 1u == (tg + 1u) * nx) xb_add(&bar[XB_TOPGEN], 1u);
            else XB_SPIN(xb_ld(&bar[XB_TOPGEN]) == tg, bar);
            __builtin_amdgcn_fence(__ATOMIC_ACQUIRE, "agent");
            xb_add(&bar[XB_XGEN(b.x)], 1u);
            asm volatile("s_waitcnt vmcnt(0)" ::: "memory");
        } else {
            XB_SPIN(xb_ld(&bar[XB_XGEN(b.x)]) == gen, bar);
            __builtin_amdgcn_fence(__ATOMIC_ACQUIRE, "agent");
            asm volatile("s_waitcnt vmcnt(0)" ::: "memory");
        }
    }
    __syncthreads();
}

#ifndef FP8_QKV
#define FP8_QKV 1
#endif
#ifndef FP8_UP0
#define FP8_UP0 0
#endif
#ifndef FP8_UP1
#define FP8_UP1 1
#endif
#ifndef FP8_DN0
#define FP8_DN0 0
#endif
#ifndef FP8_DN1
#define FP8_DN1 1
#endif
#ifndef SKIPMASK
#define SKIPMASK 0
#endif

__device__ __forceinline__ int perm16(int t) { const int a = (t >> 2) & 3; return (t & ~12) | ((a == 1 ? 2 : (a == 2 ? 1 : a)) << 2); }
__device__ __forceinline__ void st_vt16(bf16_t* VT, int row, int h, int d, f32x4 v) {
    const int b = row / SEQ, t = row % SEQ; bf16_t* p = VT + ((size_t)(b * 8 + h) * 128 + d) * SEQ + (t & ~15) + perm16(t & 15);
    p[0] = f2bf(v[0]); p[SEQ] = f2bf(v[1]); p[2 * (size_t)SEQ] = f2bf(v[2]); p[3 * (size_t)SEQ] = f2bf(v[3]);
}
__device__ __forceinline__ int perm64(int kk) { const int sub = kk >> 5, k5 = kk & 31; return 32 * ((k5 >> 2) & 1) + 16 * sub + (((k5 >> 3) << 2) | (k5 & 3)); }
__device__ __forceinline__ void st_vt8(bf16_t* VT_, int row, int h, int d, f32x4 v) {
    const int b = row / SEQ, t = row % SEQ; unsigned char* p = (unsigned char*)VT_ + ((size_t)(b * 8 + h) * 128 + d) * SEQ + (t & ~63) + perm64(t & 63);
    const int pk0 = __builtin_amdgcn_cvt_pk_fp8_f32(v[0], v[1], 0, false), pk1 = __builtin_amdgcn_cvt_pk_fp8_f32(v[2], v[3], 0, false);
    p[0] = (unsigned char)(pk0 & 0xFF); p[SEQ] = (unsigned char)((pk0 >> 8) & 0xFF); p[2 * (size_t)SEQ] = (unsigned char)(pk1 & 0xFF); p[3 * (size_t)SEQ] = (unsigned char)((pk1 >> 8) & 0xFF);
}
__device__ __forceinline__ void st_fp8x4(unsigned char* p, f32x4 v) { int pk = 0; pk = __builtin_amdgcn_cvt_pk_fp8_f32(v[0], v[1], pk, false); pk = __builtin_amdgcn_cvt_pk_fp8_f32(v[2], v[3], pk, true); *(int*)p = pk; }
static constexpr float QS_DSA = 0.08838834764831845f * 1.4426950408889634f * 8.0f, QS_MLA = 0.07216878364870322f * 1.4426950408889634f * 8.0f;
struct FAbIn2 { unsigned char *Q, *K; bf16_t* VT; unsigned short* QI; float *U, *WI; unsigned short* KI16;
    __device__ __forceinline__ void operator()(int r, int c, f32x4 v) const {
        if (c < 1024) st_fp8x4(Q + (size_t)r * 1024 + c, v * QS_DSA);
        else if (c < 2048) st_fp8x4(K + (size_t)r * 1024 + (c - 1024), v);
        else if (c < 3072) { if (PV8_DSA) st_vt8(VT, r, (c - 2048) >> 7, (c - 2048) & 127, v); else st_vt16(VT, r, (c - 2048) >> 7, (c - 2048) & 127, v); }
        else if (c < 4096) { typedef _Float16 h2 __attribute__((ext_vector_type(2))); union { h2 h; unsigned u; } a, b; a.h = (h2){(_Float16)v[0], (_Float16)v[1]}; b.h = (h2){(_Float16)v[2], (_Float16)v[3]};
            u32x2 w; w.x = a.u; w.y = b.u; *(u32x2*)(QI + (size_t)r * 1024 + (c - 3072)) = w; }
        else if (c < 5120) st_f32x4(U + (size_t)r * 1024 + (c - 4096), v);
        else if (c < 5184) { typedef _Float16 h2 __attribute__((ext_vector_type(2))); union { h2 h; unsigned u; } a, b; a.h = (h2){(_Float16)v[0], (_Float16)v[1]}; b.h = (h2){(_Float16)v[2], (_Float16)v[3]};
            u32x2 w; w.x = a.u; w.y = b.u; *(u32x2*)(KI16 + (size_t)r * 64 + (c - 5120)) = w; }
        else if (c < 5200) st_f32x4(WI + (size_t)r * 16 + (c - 5184), v);
    } };
struct FAbInHi { FAbIn2 f; __device__ __forceinline__ void operator()(int r, int c, f32x4 v) const { f(r, c + 3072, v); } };
struct FKvUp2 { unsigned char* K8; bf16_t* VT;
    __device__ __forceinline__ void operator()(int r, int c, f32x4 v) const {
        const int h = c >> 8, d = c & 255;
        if (d < 128) { int pk = 0; pk = __builtin_amdgcn_cvt_pk_fp8_f32(v[0], v[1], pk, false); pk = __builtin_amdgcn_cvt_pk_fp8_f32(v[2], v[3], pk, true); *(int*)(K8 + (size_t)r * 1536 + h * 192 + d) = pk; }
        else { if (PV8_MLA) st_vt8(VT, r, h, d - 128, v); else st_vt16(VT, r, h, d - 128, v); }
    } };

template <class E> __device__ __forceinline__ void ph_gemm_e(LAS unsigned char* lds, const bf16_t* A, int lda, const bf16_t* Bt, int ldb, int M, int N, int K, const E& e, int bid, int nblk, int a_shift = 0, int a_bytes = 0, int cmode = 0, int skew = 0) {
    pg8::Gemm g; g.A = A; g.Bt = Bt; g.M = M; g.N = N; g.K = K; g.lda = lda; g.ldb = ldb; g.a_shift = a_shift; g.a_bytes = a_bytes; g.cmode = cmode;
    pg8::StaticOrder S; S.init(M, N, nblk, bid); S.skew = skew;
    pg8::gemm_phase<E, pg8::StaticOrder, false>(lds, g, S, e, nullptr);
    __syncthreads();
}
template <class F> __device__ __forceinline__ void ph_gemm(LAS unsigned char* lds, const bf16_t* A, int lda, const bf16_t* Bt, int ldb, int M, int N, int K, const F& f, int bid, int nblk, int a_shift = 0, int a_bytes = 0) {
    EpiG<F> e; e.f = f;
    ph_gemm_e(lds, A, lda, Bt, ldb, M, N, K, e, bid, nblk, a_shift, a_bytes);
}
template <class F> __device__ __forceinline__ void ph_gemm8(LAS unsigned char* lds, const unsigned char* A, int lda, const unsigned char* Bt, int ldb, int M, int N, int K, const F& f, int bid, int nblk, int skew = 0) {
    EpiG<F, true> e; e.f = f;
    ph_gemm_e(lds, (const bf16_t*)A, lda / 2, (const bf16_t*)Bt, ldb / 2, M, N, K / 2, e, bid, nblk, 0, 0, 0, skew);
}
template <int CTRL> __device__ __forceinline__ float dpp0(float v) { return __int_as_float(__builtin_amdgcn_update_dpp(0, __float_as_int(v), CTRL, 0xF, 0xF, true)); }
__device__ __forceinline__ float gelu_fast(float x) { const float u2 = 1.5957691216057308f * (x + 0.044715f * x * x * x); return x * __builtin_amdgcn_rcpf(1.0f + __builtin_amdgcn_exp2f(-1.4426950408889634f * u2)); }
template <bool OUT8, bool F8> struct EpiGate {
    static constexpr bool PERM = false, AFTER_DRAIN = false, FP8 = F8;
    const float* cw; const float* cb; void* ACT;
    __device__ __forceinline__ void operator()(const f32x4 (&acc)[2][2][4][2], const pg8::Unit& u, int wr, int wc, int fr, int fq) const {
        const int bt = u.pm / 67, ti = u.pm % 67;
#pragma unroll
        for (int n = 0; n < 2; ++n) {
            const int c = u.pn * 128 + wc * 32 + 16 * n + 4 * fq;
            const f32x4 g0 = *(const f32x4*)(cw + c), g1 = *(const f32x4*)(cw + 8192 + c), g2 = *(const f32x4*)(cw + 16384 + c), gb = *(const f32x4*)(cb + c);
            const f32x4 v0 = *(const f32x4*)(cw + 4096 + c), v1 = *(const f32x4*)(cw + 8192 + 4096 + c), v2 = *(const f32x4*)(cw + 16384 + 4096 + c), vb = *(const f32x4*)(cb + 4096 + c);
            const float w1m = (fr < 1) ? 1.f : 0.f, w2m = (fr < 2) ? 1.f : 0.f;
            const f32x4 g1w = g1 * w1m, g0w = g0 * w2m, v1w = v1 * w1m, v0w = v0 * w2m;
#pragma unroll
            for (int ai = 0; ai < 2; ++ai) {
                const int strip = 2 * ai + wr, tbase = ti * 248 + strip * 62 - 2;
                f32x4 pg = {0.f, 0.f, 0.f, 0.f}, pv = pg;
#pragma unroll
                for (int m = 0; m < 4; ++m) {
                    f32x4 xg = acc[ai][0][m][n], xv = acc[ai][1][m][n];
                    const int t = tbase + 16 * m + fr;
                    if (tbase < 0 && m == 0) { if (t < 0) { xg = (f32x4){0.f, 0.f, 0.f, 0.f}; xv = xg; } }
                    f32x4 og, ov;
#pragma unroll
                    for (int j = 0; j < 4; ++j) {
                        float yg = fmaf(g2[j], xg[j], gb[j]), yv = fmaf(v2[j], xv[j], vb[j]);
                        asm("s_nop 1\n\t"
                            "v_fmac_f32_dpp %0, %2, %6 row_shr:1 row_mask:0xf bank_mask:0xf bound_ctrl:1\n\t"
                            "v_fmac_f32_dpp %1, %3, %10 row_shr:1 row_mask:0xf bank_mask:0xf bound_ctrl:1\n\t"
                            "v_fmac_f32_dpp %0, %2, %7 row_shr:2 row_mask:0xf bank_mask:0xf bound_ctrl:1\n\t"
                            "v_fmac_f32_dpp %1, %3, %11 row_shr:2 row_mask:0xf bank_mask:0xf bound_ctrl:1\n\t"
                            "v_fmac_f32_dpp %0, %4, %8 row_ror:1 row_mask:0xf bank_mask:0xf bound_ctrl:1\n\t"
                            "v_fmac_f32_dpp %1, %5, %12 row_ror:1 row_mask:0xf bank_mask:0xf bound_ctrl:1\n\t"
                            "v_fmac_f32_dpp %0, %4, %9 row_ror:2 row_mask:0xf bank_mask:0xf bound_ctrl:1\n\t"
                            "v_fmac_f32_dpp %1, %5, %13 row_ror:2 row_mask:0xf bank_mask:0xf bound_ctrl:1"
                            : "+v"(yg), "+v"(yv)
                            : "v"(xg[j]), "v"(xv[j]), "v"(pg[j]), "v"(pv[j]), "v"(g1[j]), "v"(g0[j]), "v"(g1w[j]), "v"(g0w[j]), "v"(v1[j]), "v"(v0[j]), "v"(v1w[j]), "v"(v0w[j]));
                        og[j] = gelu_fast(yg) * yv; ov[j] = 0.f;
                    }
                    pg = xg; pv = xv;
                    if (16 * m + fr >= 2 && t < SEQ) {
                        const size_t o = ((size_t)bt * SEQ + t) * 4096 + c;
                        if (OUT8) { int pk = 0; pk = __builtin_amdgcn_cvt_pk_fp8_f32(og[0], og[1], pk, false); pk = __builtin_amdgcn_cvt_pk_fp8_f32(og[2], og[3], pk, true); *(int*)((unsigned char*)ACT + o) = pk; }
                        else st_bf16x4((bf16_t*)ACT + o, og);
                    }
                }
            }
        }
    }
};
struct FPool { bf16_t* CC; const float* pb; const float* ps;
    __device__ __forceinline__ void operator()(int r, int c, f32x4 v) const { const f32x4 b = *(const f32x4*)(pb + c), s = *(const f32x4*)(ps + c); st_bf16x4(CC + (size_t)r * 2048 + 1024 + c, (v + b) * s); } };
__device__ __forceinline__ float one_minus_exp(float x) {
    const float p = -x * (1.0f + x * (0.5f + x * (0.16666667f + x * 0.041666668f))), d = 1.0f - __expf(x);
    return (x > -0.125f) ? p : d;
}
struct EpiLru {
    static constexpr bool PERM = false, AFTER_DRAIN = false, FP8 = false;
    const bf16_t* XCB; const float *ba, *bx, *lam; bf16_t *LA, *LB;
    __device__ __forceinline__ void operator()(const f32x4 (&acc)[2][2][4][2], const pg8::Unit& u, int wr, int wc, int fr, int fq) const {
        const int row0 = u.pm * 256 + wr * 64 + fr;
#pragma unroll
        for (int n = 0; n < 2; ++n) {
            const int ch = u.pn * 128 + wc * 32 + 16 * n + 4 * fq;
            const f32x4 bav = *(const f32x4*)(ba + ch), bxv = *(const f32x4*)(bx + ch), lm = *(const f32x4*)(lam + ch);
            f32x4 sp;
#pragma unroll
            for (int j = 0; j < 4; ++j) sp[j] = log1pf(__expf(-lm[j]));
#pragma unroll
            for (int ai = 0; ai < 2; ++ai)
#pragma unroll
                for (int m = 0; m < 4; ++m) {
                    const int row = row0 + ai * 128 + m * 16;
                    const u32x2 xw = *(const u32x2*)(XCB + (size_t)row * 1024 + ch);
                    const f32x4 xc = {__uint_as_float(xw.x << 16), __uint_as_float(xw.x & 0xFFFF0000u), __uint_as_float(xw.y << 16), __uint_as_float(xw.y & 0xFFFF0000u)};
                    const f32x4 ga = acc[ai][0][m][n] + bav, gx = acc[ai][1][m][n] + bxv;
                    f32x4 av, bv;
#pragma unroll
                    for (int j = 0; j < 4; ++j) {
                        const float rg = __builtin_amdgcn_rcpf(1.0f + __expf(-ga[j])), ig = __builtin_amdgcn_rcpf(1.0f + __expf(-gx[j]));
                        const float log_a = -8.0f * rg * sp[j];
                        av[j] = one_minus_exp(log_a); bv[j] = __builtin_amdgcn_sqrtf(one_minus_exp(2.0f * log_a)) * (ig * xc[j]);
                    }
                    st_bf16x4(LA + (size_t)row * 1024 + ch, av); st_bf16x4(LB + (size_t)row * 1024 + ch, bv);
                }
        }
    }
};
__device__ __forceinline__ void ph_pooled(const float* __restrict__ U, bf16_t* __restrict__ P, int bid, int nblk) {
    for (int i = bid * 512 + opaque_tid(); i < 256 * (NTOK / 64); i += nblk * 512) {
        const int c4 = i & 255, row0 = (i >> 8) * 64, t0 = row0 % SEQ, g = c4 >> 6, win = 2 << g;
        const f32x4* up = (const f32x4*)U + (size_t)row0 * 256 + c4;
        f32x4 s = {0.f, 0.f, 0.f, 0.f};
        if (t0 > 0) { for (int k = 1; k < win; ++k) s += up[-(ptrdiff_t)k * 256]; }
#pragma unroll 8
        for (int r = 0; r < 64; ++r) {
            const int t = t0 + r; const f32x4 u0 = up[(ptrdiff_t)r * 256];
            s += u0;
            const int cnt = (t + 1 < win) ? (t + 1) : win;
            st_bf16x4(P + (size_t)(row0 + r) * 1024 + c4 * 4, s * (1.0f / (float)cnt) - u0);
            if (t + 1 >= win) s -= up[(ptrdiff_t)(r + 1 - win) * 256];
        }
    }
}
__device__ __forceinline__ void ph_xc(const bf16_t* __restrict__ XL, const float* __restrict__ cw, const float* __restrict__ cb, bf16_t* __restrict__ XCB, int bid, int nblk) {
    for (int i = bid * 512 + opaque_tid(); i < 128 * (NTOK / 32); i += nblk * 512) {
        const int c8 = (i & 127) * 8, row0 = (i >> 7) * 32, t0 = row0 % SEQ;
        float w0[8], w1[8], w2[8], w3[8], bb[8];
#pragma unroll
        for (int j = 0; j < 8; ++j) { w0[j] = cw[c8 + j]; w1[j] = cw[1024 + c8 + j]; w2[j] = cw[2048 + c8 + j]; w3[j] = cw[3072 + c8 + j]; bb[j] = cb[c8 + j]; }
        u32x4 p3 = {0u, 0u, 0u, 0u}, p2 = p3, p1 = p3;
        if (t0 >= 3) { p3 = *(const u32x4*)(XL + (size_t)(row0 - 3) * 1024 + c8); p2 = *(const u32x4*)(XL + (size_t)(row0 - 2) * 1024 + c8); p1 = *(const u32x4*)(XL + (size_t)(row0 - 1) * 1024 + c8); }
#pragma unroll 8
        for (int r = 0; r < 32; ++r) {
            const u32x4 cur = *(const u32x4*)(XL + (size_t)(row0 + r) * 1024 + c8);
            const unsigned a3[4] = {p3.x, p3.y, p3.z, p3.w}, a2[4] = {p2.x, p2.y, p2.z, p2.w}, a1[4] = {p1.x, p1.y, p1.z, p1.w}, a0[4] = {cur.x, cur.y, cur.z, cur.w};
            float y[8];
#pragma unroll
            for (int j = 0; j < 4; ++j) {
                y[2 * j] = bb[2 * j] + w0[2 * j] * __uint_as_float(a3[j] << 16) + w1[2 * j] * __uint_as_float(a2[j] << 16) + w2[2 * j] * __uint_as_float(a1[j] << 16) + w3[2 * j] * __uint_as_float(a0[j] << 16);
                y[2 * j + 1] = bb[2 * j + 1] + w0[2 * j + 1] * __uint_as_float(a3[j] & 0xFFFF0000u) + w1[2 * j + 1] * __uint_as_float(a2[j] & 0xFFFF0000u) + w2[2 * j + 1] * __uint_as_float(a1[j] & 0xFFFF0000u) + w3[2 * j + 1] * __uint_as_float(a0[j] & 0xFFFF0000u); }
            u32x4 o; o.x = pack2bf(y[0], y[1]); o.y = pack2bf(y[2], y[3]); o.z = pack2bf(y[4], y[5]); o.w = pack2bf(y[6], y[7]);
            *(u32x4*)(XCB + (size_t)(row0 + r) * 1024 + c8) = o;
            p3 = p2; p2 = p1; p1 = cur;
        }
    }
}
__device__ __forceinline__ int up_src_col(int n0) { return ((n0 >> 7) & 1) * 4096 + (n0 >> 8) * 128 + (n0 & 127); }
template <bool OUT8>
__device__ __forceinline__ void ph_convT_g(LAS unsigned char* lds, const float* __restrict__ W, int ldw, int src_col0, int ncols, int K, void* __restrict__ Bt, int ldd, int bid, int nblk, bool upperm, const float* __restrict__ gk = nullptr) {
    const int tid = opaque_tid(), sub = tid >> 8, t8 = tid & 255;
    LAS float* tile = (LAS float*)lds + sub * (2 * 64 * 65);
    const int ntx = (ncols + 63) / 64, ntiles = ntx * (K / 64);
    for (int base = bid * 4; base < ntiles; base += nblk * 4) {
#pragma unroll
        for (int u = 0; u < 2; ++u) {
            const int tl = base + sub * 2 + u; const bool act = tl < ntiles;
            const int n0 = (tl % ntx) * 64, k0 = (tl / ntx) * 64;
            if (act) {
                const int c4 = (t8 & 15) * 4, kr = t8 >> 4;
                const int nsrc = src_col0 + (upperm ? up_src_col(n0 + c4) : n0 + c4);
                f32x4 v[4];
#pragma unroll
                for (int i = 0; i < 4; ++i) { v[i] = (f32x4){0.f, 0.f, 0.f, 0.f}; if (n0 + c4 < ncols) v[i] = *(const f32x4*)(W + (size_t)(k0 + kr + 16 * i) * ldw + nsrc); if (gk) v[i] = v[i] * gk[k0 + kr + 16 * i]; }
#pragma unroll
                for (int i = 0; i < 4; ++i) { const int kl = kr + 16 * i; LAS float* tp = tile + u * (64 * 65) + kl * 65 + c4; tp[0] = v[i][0]; tp[1] = v[i][1]; tp[2] = v[i][2]; tp[3] = v[i][3]; } }
        }
        __syncthreads();
#pragma unroll
        for (int u = 0; u < 2; ++u) {
            const int tl = base + sub * 2 + u; const bool act = tl < ntiles;
            const int n0 = (tl % ntx) * 64, k0 = (tl / ntx) * 64;
            if (act) {
                const int k8 = (t8 & 7) * 8, nr = t8 >> 3;
#pragma unroll
                for (int i = 0; i < 2; ++i) { const int nl = nr + 32 * i;
                    if (n0 + nl < ncols) {
                        float v[8];
#pragma unroll
                        for (int j = 0; j < 8; ++j) v[j] = tile[u * (64 * 65) + (k8 + j) * 65 + nl];
                        if (OUT8) { int p0 = 0, p1 = 0;
                            p0 = __builtin_amdgcn_cvt_pk_fp8_f32(64.f * v[0], 64.f * v[1], p0, false); p0 = __builtin_amdgcn_cvt_pk_fp8_f32(64.f * v[2], 64.f * v[3], p0, true);
                            p1 = __builtin_amdgcn_cvt_pk_fp8_f32(64.f * v[4], 64.f * v[5], p1, false); p1 = __builtin_amdgcn_cvt_pk_fp8_f32(64.f * v[6], 64.f * v[7], p1, true);
                            u32x2 o; o.x = (unsigned)p0; o.y = (unsigned)p1; *(u32x2*)((unsigned char*)Bt + (size_t)(n0 + nl) * ldd + k0 + k8) = o; }
                        else { u32x4 o; o.x = pack2bf(v[0], v[1]); o.y = pack2bf(v[2], v[3]); o.z = pack2bf(v[4], v[5]); o.w = pack2bf(v[6], v[7]);
                            *(u32x4*)((bf16_t*)Bt + (size_t)(n0 + nl) * ldd + k0 + k8) = o; }
                    } } }
        }
        __syncthreads();
    }
}
__device__ __forceinline__ void ph_convT(LAS unsigned char* lds, const float* __restrict__ W, int ldw, int src_col0, int ncols, int K, bf16_t* __restrict__ Bt, int ldd, int bid, int nblk, bool upperm = false, const float* __restrict__ gk = nullptr) {
    ph_convT_g<false>(lds, W, ldw, src_col0, ncols, K, Bt, ldd, bid, nblk, upperm, gk);
}
__device__ __forceinline__ void ph_convT8(LAS unsigned char* lds, const float* __restrict__ W, int ldw, int ncols, int K, unsigned char* __restrict__ Bt, int bid, int nblk, bool upperm = false) {
    ph_convT_g<true>(lds, W, ldw, 0, ncols, K, Bt, K, bid, nblk, upperm);
}
template <int NC> __device__ __forceinline__ void ph_rmsnorm(const float* __restrict__ x, const float* __restrict__ g, bf16_t* __restrict__ out, int bid, int nblk, unsigned char* __restrict__ out8 = nullptr) {
    const int lane = opaque_tid() & 63, w = opaque_tid() >> 6;
    constexpr int NV = NC / 256;
    for (int row = bid * 8 + w; row < NTOK; row += nblk * 8) {
        const f32x4* xr = (const f32x4*)(x + (size_t)row * NC);
        f32x4 v[NV]; float ss = 0.f;
#pragma unroll
        for (int i = 0; i < NV; ++i) { v[i] = xr[lane + 64 * i]; ss += v[i][0] * v[i][0] + v[i][1] * v[i][1] + v[i][2] * v[i][2] + v[i][3] * v[i][3]; }
        ss = wave_sum(ss);
        const float r = rsqrtf(ss * (1.0f / NC) + NORM_EPS);
#pragma unroll
        for (int i = 0; i < NV; ++i) { const f32x4 gg = ((const f32x4*)g)[lane + 64 * i]; const f32x4 y = v[i] * r * gg; st_bf16x4(out + (size_t)row * NC + 4 * (lane + 64 * i), y);
            if (out8) { int pk = 0; pk = __builtin_amdgcn_cvt_pk_fp8_f32(y[0], y[1], pk, false); pk = __builtin_amdgcn_cvt_pk_fp8_f32(y[2], y[3], pk, true); *(int*)(out8 + (size_t)row * NC + 4 * (lane + 64 * i)) = pk; } }
    }
}
template <bool IN16, bool OUT16>
__device__ __forceinline__ void ph_resnorm(const void* xin, const bf16_t* __restrict__ m, const float* __restrict__ gpost, const float* __restrict__ gpre, void* xout, bf16_t* __restrict__ h, unsigned char* __restrict__ h8, int bid, int nblk, float* __restrict__ r2out = nullptr) {
    const int tid_ = opaque_tid(), lane = tid_ & 63, w = tid_ >> 6;
    for (int row = bid * 8 + w; row < NTOK; row += nblk * 8) {
        const u32x2* mr = (const u32x2*)(m + (size_t)row * DM);
        f32x4 mv[8], xv[8]; float ss = 0.f;
#pragma unroll
        for (int i = 0; i < 8; ++i) { const u32x2 wd = mr[lane + 64 * i]; mv[i][0] = __uint_as_float(wd.x << 16); mv[i][1] = __uint_as_float(wd.x & 0xFFFF0000u); mv[i][2] = __uint_as_float(wd.y << 16); mv[i][3] = __uint_as_float(wd.y & 0xFFFF0000u);
            if (IN16) { const u32x2 xw = ((const u32x2*)((const bf16_t*)xin + (size_t)row * DM))[lane + 64 * i];
                xv[i][0] = __uint_as_float(xw.x << 16); xv[i][1] = __uint_as_float(xw.x & 0xFFFF0000u); xv[i][2] = __uint_as_float(xw.y << 16); xv[i][3] = __uint_as_float(xw.y & 0xFFFF0000u); }
            else xv[i] = ((const f32x4*)((const float*)xin + (size_t)row * DM))[lane + 64 * i];
            ss += mv[i][0] * mv[i][0] + mv[i][1] * mv[i][1] + mv[i][2] * mv[i][2] + mv[i][3] * mv[i][3]; }
        ss = wave_sum(ss);
        const float r1 = rsqrtf(ss * (1.0f / DM) + NORM_EPS);
        float s2 = 0.f;
#pragma unroll
        for (int i = 0; i < 8; ++i) { const f32x4 gg = ((const f32x4*)gpost)[lane + 64 * i]; xv[i] = xv[i] + mv[i] * r1 * gg;
            if (OUT16) st_bf16x4((bf16_t*)xout + (size_t)row * DM + 4 * (lane + 64 * i), xv[i]); else ((f32x4*)((float*)xout + (size_t)row * DM))[lane + 64 * i] = xv[i];
            s2 += xv[i][0] * xv[i][0] + xv[i][1] * xv[i][1] + xv[i][2] * xv[i][2] + xv[i][3] * xv[i][3]; }
        if (gpre) {
            s2 = wave_sum(s2);
            const float r2 = rsqrtf(s2 * (1.0f / DM) + NORM_EPS);
            if (r2out) { if (lane == 0) r2out[row] = r2; continue; }
#pragma unroll
            for (int i = 0; i < 8; ++i) { const f32x4 gg = ((const f32x4*)gpre)[lane + 64 * i]; const f32x4 y = xv[i] * r2 * gg;
                if (h8) { int pk = 0; pk = __builtin_amdgcn_cvt_pk_fp8_f32(y[0], y[1], pk, false); pk = __builtin_amdgcn_cvt_pk_fp8_f32(y[2], y[3], pk, true); *(int*)(h8 + (size_t)row * DM + 4 * (lane + 64 * i)) = pk; }
                else st_bf16x4(h + (size_t)row * DM + 4 * (lane + 64 * i), y); }
        }
    }
}
__device__ __forceinline__ f32x4 bf4_to_f32(u32x2 w) { f32x4 r; r[0] = __uint_as_float(w.x << 16); r[1] = __uint_as_float(w.x & 0xFFFF0000u); r[2] = __uint_as_float(w.y << 16); r[3] = __uint_as_float(w.y & 0xFFFF0000u); return r; }
__device__ __forceinline__ void ph_scan1(const bf16_t* __restrict__ Aa, const bf16_t* __restrict__ Bb, float* __restrict__ CA, float* __restrict__ CH, int bid, int nblk) {
    for (int i = bid * 512 + opaque_tid(); i < 2 * 256 * 256; i += nblk * 512) {
        const int c4 = i & 255, chunk = (i >> 8) & 255, b = i >> 16;
        const size_t base = ((size_t)b * SEQ + (size_t)chunk * 64) * 1024 + 4 * c4;
        f32x4 h = {0.f, 0.f, 0.f, 0.f}, P = {1.f, 1.f, 1.f, 1.f};
#pragma unroll 8
        for (int s = 0; s < 64; ++s) { const f32x4 a = 1.0f - bf4_to_f32(*(const u32x2*)(Aa + base + (size_t)s * 1024)); h = a * h + bf4_to_f32(*(const u32x2*)(Bb + base + (size_t)s * 1024)); P *= a; }
        ((f32x4*)CA)[i] = P; ((f32x4*)CH)[i] = h;
    }
}
__device__ __forceinline__ void ph_scan2(const float* __restrict__ CA, const float* __restrict__ CH, float* __restrict__ CIN, int bid, int nblk) {
    const int tid = opaque_tid(), lane = tid & 63;
    for (int wv = bid * 8 + (tid >> 6); wv < 512; wv += nblk * 8) {
        const int b = wv >> 8, ch = (wv & 255) * 4 + (lane & 3), part = lane >> 2;
        const size_t j0 = ((size_t)b * 256 + part * 16) * 1024 + ch;
        float ca[16], chv[16];
#pragma unroll
        for (int k = 0; k < 16; ++k) { ca[k] = CA[j0 + (size_t)k * 1024]; chv[k] = CH[j0 + (size_t)k * 1024]; }
        float A = 1.f, H = 0.f;
#pragma unroll
        for (int k = 0; k < 16; ++k) { H = ca[k] * H + chv[k]; A *= ca[k]; }
#pragma unroll
        for (int d = 1; d < 16; d <<= 1) {
            const float Ap = __shfl_up(A, 4 * d), Hp = __shfl_up(H, 4 * d);
            if (part >= d) { H = A * Hp + H; A = A * Ap; }
        }
        float h = __shfl_up(H, 4); if (part == 0) h = 0.f;
#pragma unroll
        for (int k = 0; k < 16; ++k) { CIN[j0 + (size_t)k * 1024] = h; h = ca[k] * h + chv[k]; }
    }
}
__device__ __forceinline__ void ph_scan3(const bf16_t* __restrict__ Aa, const bf16_t* __restrict__ Bb, const float* __restrict__ CIN, const bf16_t* __restrict__ YG, bf16_t* __restrict__ CC, int bid, int nblk) {
    for (int i = bid * 512 + opaque_tid(); i < 2 * 256 * 256; i += nblk * 512) {
        const int c4 = i & 255, chunk = (i >> 8) & 255, b = i >> 16;
        const size_t row0 = (size_t)b * SEQ + (size_t)chunk * 64;
        f32x4 h = ((const f32x4*)CIN)[i];
#pragma unroll 8
        for (int s = 0; s < 64; ++s) { const size_t r = row0 + s;
            h = (1.0f - bf4_to_f32(*(const u32x2*)(Aa + r * 1024 + 4 * c4))) * h + bf4_to_f32(*(const u32x2*)(Bb + r * 1024 + 4 * c4));
            const f32x4 g = bf4_to_f32(*(const u32x2*)(YG + r * 1024 + 4 * c4));
            f32x4 o; o[0] = h[0] * gelu_tanh(g[0]); o[1] = h[1] * gelu_tanh(g[1]); o[2] = h[2] * gelu_tanh(g[2]); o[3] = h[3] * gelu_tanh(g[3]);
            st_bf16x4(CC + r * 2048 + 1024 + 4 * c4, o); }
    }
}
__device__ __forceinline__ void ph_rope_q(const bf16_t* __restrict__ Q1, const int* __restrict__ pos, unsigned char* __restrict__ Q8, int bid, int nblk) {
    for (int idx = bid * 512 + opaque_tid(); idx < NTOK * 8 * 4; idx += nblk * 512) {
        const int g = idx & 3, h = (idx >> 2) & 7, row = idx >> 5;
        const bf16_t* p = Q1 + (size_t)row * 1536 + h * 192; unsigned char* q = Q8 + (size_t)row * 1536 + h * 192;
#pragma unroll
        for (int k = 0; k < 4; ++k) { const u32x4 w = *(const u32x4*)(p + 32 * g + 8 * k);
            int p0 = 0, p1 = 0;
            p0 = __builtin_amdgcn_cvt_pk_fp8_f32(QS_MLA * __uint_as_float(w.x << 16), QS_MLA * __uint_as_float(w.x & 0xFFFF0000u), p0, false); p0 = __builtin_amdgcn_cvt_pk_fp8_f32(QS_MLA * __uint_as_float(w.y << 16), QS_MLA * __uint_as_float(w.y & 0xFFFF0000u), p0, true);
            p1 = __builtin_amdgcn_cvt_pk_fp8_f32(QS_MLA * __uint_as_float(w.z << 16), QS_MLA * __uint_as_float(w.z & 0xFFFF0000u), p1, false); p1 = __builtin_amdgcn_cvt_pk_fp8_f32(QS_MLA * __uint_as_float(w.w << 16), QS_MLA * __uint_as_float(w.w & 0xFFFF0000u), p1, true);
            u32x2 o; o.x = (unsigned)p0; o.y = (unsigned)p1; *(u32x2*)(q + 32 * g + 8 * k) = o; }
        const u32x4 w1 = *(const u32x4*)(p + 128 + 8 * g), w2 = *(const u32x4*)(p + 160 + 8 * g);
        const unsigned a1[4] = {w1.x, w1.y, w1.z, w1.w}, a2[4] = {w2.x, w2.y, w2.z, w2.w};
        float o1[8], o2[8]; const int ps = pos[row];
#pragma unroll
        for (int j = 0; j < 8; ++j) { float cs, sn; rope_cs(ps, 8 * g + j, cs, sn);
            const float x1 = (j & 1) ? __uint_as_float(a1[j >> 1] & 0xFFFF0000u) : __uint_as_float(a1[j >> 1] << 16), x2 = (j & 1) ? __uint_as_float(a2[j >> 1] & 0xFFFF0000u) : __uint_as_float(a2[j >> 1] << 16);
            o1[j] = QS_MLA * (x1 * cs - x2 * sn); o2[j] = QS_MLA * (x2 * cs + x1 * sn); }
        int p0 = 0, p1 = 0, p2 = 0, p3 = 0;
        p0 = __builtin_amdgcn_cvt_pk_fp8_f32(o1[0], o1[1], p0, false); p0 = __builtin_amdgcn_cvt_pk_fp8_f32(o1[2], o1[3], p0, true); p1 = __builtin_amdgcn_cvt_pk_fp8_f32(o1[4], o1[5], p1, false); p1 = __builtin_amdgcn_cvt_pk_fp8_f32(o1[6], o1[7], p1, true);
        p2 = __builtin_amdgcn_cvt_pk_fp8_f32(o2[0], o2[1], p2, false); p2 = __builtin_amdgcn_cvt_pk_fp8_f32(o2[2], o2[3], p2, true); p3 = __builtin_amdgcn_cvt_pk_fp8_f32(o2[4], o2[5], p3, false); p3 = __builtin_amdgcn_cvt_pk_fp8_f32(o2[6], o2[7], p3, true);
        u32x2 oa; oa.x = (unsigned)p0; oa.y = (unsigned)p1; *(u32x2*)(q + 128 + 8 * g) = oa;
        u32x2 ob; ob.x = (unsigned)p2; ob.y = (unsigned)p3; *(u32x2*)(q + 160 + 8 * g) = ob;
    }
}
__device__ __forceinline__ void ph_rope_k(const float* __restrict__ KR, const int* __restrict__ pos, unsigned char* __restrict__ K8, int bid, int nblk) {
    for (int idx = bid * 512 + opaque_tid(); idx < NTOK * 32; idx += nblk * 512) {
        const int i = idx & 31, row = idx >> 5;
        float c, s; rope_cs(pos[row], i, c, s);
        const float x1 = KR[(size_t)row * 64 + i], x2 = KR[(size_t)row * 64 + 32 + i];
        const int pk = __builtin_amdgcn_cvt_pk_fp8_f32(x1 * c - x2 * s, x2 * c + x1 * s, 0, false);
        const unsigned char o1 = (unsigned char)(pk & 0xFF), o2 = (unsigned char)((pk >> 8) & 0xFF);
#pragma unroll
        for (int h = 0; h < 8; ++h) { unsigned char* p = K8 + (size_t)row * 1536 + h * 192 + 128; p[i] = o1; p[32 + i] = o2; }
    }
}
template <bool OUT8> __device__ __forceinline__ void ph_ffn_gate(const bf16_t* __restrict__ HID, const float* __restrict__ cw, const float* __restrict__ cb, bf16_t* __restrict__ ACT, int bid, int nblk) {
    for (int i = bid * 512 + opaque_tid(); i < 512 * (SEQ / 64); i += nblk * 512) {
        const int c8 = (i & 511) * 8, t0 = (i >> 9) * 64;
        float wg[3][8], wv[3][8], bg[8], bv[8];
#pragma unroll
        for (int j = 0; j < 8; ++j) { bg[j] = cb[c8 + j]; bv[j] = cb[4096 + c8 + j];
#pragma unroll
            for (int k = 0; k < 3; ++k) { wg[k][j] = cw[k * 8192 + c8 + j]; wv[k][j] = cw[k * 8192 + 4096 + c8 + j]; } }
        u32x4 g2 = {0u, 0u, 0u, 0u}, g1 = g2, v2 = g2, v1 = g2;
        if (t0 >= 2) { g2 = *(const u32x4*)(HID + (size_t)(t0 - 2) * 8192 + c8); g1 = *(const u32x4*)(HID + (size_t)(t0 - 1) * 8192 + c8);
                       v2 = *(const u32x4*)(HID + (size_t)(t0 - 2) * 8192 + 4096 + c8); v1 = *(const u32x4*)(HID + (size_t)(t0 - 1) * 8192 + 4096 + c8); }
#pragma unroll 8
        for (int r = 0; r < 64; ++r) {
            const u32x4 g0 = *(const u32x4*)(HID + (size_t)(t0 + r) * 8192 + c8), v0 = *(const u32x4*)(HID + (size_t)(t0 + r) * 8192 + 4096 + c8);
            const unsigned G2[4] = {g2.x, g2.y, g2.z, g2.w}, G1[4] = {g1.x, g1.y, g1.z, g1.w}, G0[4] = {g0.x, g0.y, g0.z, g0.w};
            const unsigned V2[4] = {v2.x, v2.y, v2.z, v2.w}, V1[4] = {v1.x, v1.y, v1.z, v1.w}, V0[4] = {v0.x, v0.y, v0.z, v0.w};
            float o[8];
#pragma unroll
            for (int j = 0; j < 4; ++j) {
                const float ge = bg[2 * j] + wg[0][2 * j] * __uint_as_float(G2[j] << 16) + wg[1][2 * j] * __uint_as_float(G1[j] << 16) + wg[2][2 * j] * __uint_as_float(G0[j] << 16);
                const float go = bg[2 * j + 1] + wg[0][2 * j + 1] * __uint_as_float(G2[j] & 0xFFFF0000u) + wg[1][2 * j + 1] * __uint_as_float(G1[j] & 0xFFFF0000u) + wg[2][2 * j + 1] * __uint_as_float(G0[j] & 0xFFFF0000u);
                const float ve = bv[2 * j] + wv[0][2 * j] * __uint_as_float(V2[j] << 16) + wv[1][2 * j] * __uint_as_float(V1[j] << 16) + wv[2][2 * j] * __uint_as_float(V0[j] << 16);
                const float vo = bv[2 * j + 1] + wv[0][2 * j + 1] * __uint_as_float(V2[j] & 0xFFFF0000u) + wv[1][2 * j + 1] * __uint_as_float(V1[j] & 0xFFFF0000u) + wv[2][2 * j + 1] * __uint_as_float(V0[j] & 0xFFFF0000u);
                o[2 * j] = gelu_tanh(ge) * ve; o[2 * j + 1] = gelu_tanh(go) * vo; }
            if (OUT8) { int p0 = 0, p1 = 0;
                p0 = __builtin_amdgcn_cvt_pk_fp8_f32(o[0], o[1], p0, false); p0 = __builtin_amdgcn_cvt_pk_fp8_f32(o[2], o[3], p0, true);
                p1 = __builtin_amdgcn_cvt_pk_fp8_f32(o[4], o[5], p1, false); p1 = __builtin_amdgcn_cvt_pk_fp8_f32(o[6], o[7], p1, true);
                u32x2 ov; ov.x = (unsigned)p0; ov.y = (unsigned)p1; *(u32x2*)((unsigned char*)ACT + (size_t)(t0 + r) * 4096 + c8) = ov; }
            else { u32x4 ov; ov.x = pack2bf(o[0], o[1]); ov.y = pack2bf(o[2], o[3]); ov.z = pack2bf(o[4], o[5]); ov.w = pack2bf(o[6], o[7]);
                *(u32x4*)(ACT + (size_t)(t0 + r) * 4096 + c8) = ov; }
            g2 = g1; g1 = g0; v2 = v1; v1 = v0;
        }
    }
}

__device__ __forceinline__ void ph_conv_lru(const float* __restrict__ wa, const float* __restrict__ wx, bf16_t* __restrict__ Bt, int bid, int nblk) {
    for (int e = bid * 512 + opaque_tid(); e < 8 * 2 * 128 * 128; e += nblk * 512) {
        const int d = e & 127, c = (e >> 7) & 127, gate = (e >> 14) & 1, nb = e >> 15;
        const float v = (gate ? wx : wa)[((size_t)nb * 128 + c) * 128 + d];
        bf16_t* row = Bt + (size_t)(nb * 256 + gate * 128 + d) * 256;
        row[(nb & 1) * 128 + c] = f2bf(v); row[(1 - (nb & 1)) * 128 + c] = 0;
    }
}

static constexpr size_t MiB = 1048576;
static constexpr size_t W_UP0 = 0 * MiB, W_UP1 = 32 * MiB, W_DN0 = 64 * MiB, W_DN1 = 80 * MiB, W_ABIN = 96 * MiB, W_ABOUT = 117 * MiB, W_CDIN = 125 * MiB, W_CDOUT = 137 * MiB,
                        W_QUP = 145 * MiB, W_KVUP = 146 * MiB + 512 * 1024, W_POOL = 147 * MiB + 512 * 1024;
static constexpr size_t R_H = 148 * MiB;
static constexpr size_t R_Q0 = 276 * MiB, R_K0 = 340 * MiB, R_VT0 = 404 * MiB, R_QI = 468 * MiB, R_M0 = 468 * MiB, R_U = 596 * MiB, R_KI = 724 * MiB, R_WI = 732 * MiB, R_MASK = 734 * MiB, R_CC0 = 830 * MiB, R_POOLED = 958 * MiB, R_H8A = 830 * MiB;
static constexpr size_t R_HID = 276 * MiB, R_ACT = 532 * MiB, R_F = 660 * MiB, R_X3 = 788 * MiB;
static constexpr size_t R_VT1 = 276 * MiB, R_CQ = 276 * MiB, R_CKV = 340 * MiB, R_KR = 372 * MiB, R_XL = 380 * MiB, R_YG = 444 * MiB, R_CQN = 508 * MiB, R_CKVN = 540 * MiB, R_LA = 556 * MiB, R_LB = 684 * MiB,
                        R_Q1 = 812 * MiB, R_K1 = 908 * MiB, R_Q8 = 956 * MiB,     R_CA = 1004 * MiB, R_CH = 1006 * MiB, R_CIN = 1008 * MiB, R_CC1 = 148 * MiB, R_M1 = 276 * MiB, R_XCB = 148 * MiB, W_LRU = 1010 * MiB;
static constexpr size_t WS_BAR = 1022 * MiB, WS_NEED = 1022 * MiB + 65536;
static constexpr int MK_LDS = 162816;

struct MK { const float* in[28]; float* out; unsigned char* ws; int ph_lo, ph_hi; };

__global__ __launch_bounds__(512, 2) void k_mega(MK p) {
    extern __shared__ __attribute__((aligned(16))) unsigned char shm[];
    LAS unsigned char* lds = (LAS unsigned char*)shm;
    const int bid0 = (int)blockIdx.x, nblk0 = (int)gridDim.x;
    volatile LAS unsigned* xbw = (volatile LAS unsigned*)(lds + MK_LDS - 16);
    if (threadIdx.x == 0) { xbw[0] = 0u; xbw[1] = 0u; xbw[2] = 0u; xbw[3] = 0u; }
    if ((threadIdx.x & 63) == 0) *(volatile LAS int*)(size_t)(TID_TAB_LDS + 4 * ((unsigned)__builtin_amdgcn_s_getreg(((6 - 1) << 11) | 4) & 63u)) = (int)(threadIdx.x >> 6);
    __syncthreads();
    XcdBarrier bar = xcd_barrier_post((unsigned*)(p.ws + WS_BAR), xbw);
#ifndef KARG_PLAIN
#define KARG_PLAIN 0
#endif
#if KARG_PLAIN
#define KARG_DECL const MK& P_ = p;
#else
#define KARG_DECL KPtr P__ = kp; asm volatile("" : "+s"(P__)); const __attribute__((address_space(4))) MK& P_ = *P__;
#endif
    typedef const __attribute__((address_space(4))) MK* KPtr;
    KPtr kp = (KPtr)__builtin_amdgcn_kernarg_segment_ptr();
#define WSP(T, off) ((T*)(ws + (off)))
#define PHASE_BEGIN if (pc >= p.ph_lo && pc < p.ph_hi) { const int bid = opaque_s(bid0), nblk = opaque_s(nblk0); \
    KARG_DECL unsigned char* const ws = P_.ws; float* const xo = P_.out; const float* const x = P_.in[0]; const int* const positions = (const int*)P_.in[1]; \
    const float *const mix_pre_g = P_.in[2], *const mix_post_g = P_.in[3], *const ffn_pre_g = P_.in[4], *const ffn_post_g = P_.in[5], *const ffn_up = P_.in[6], *const ffn_conv_w = P_.in[7], *const ffn_conv_b = P_.in[8], *const ffn_down = P_.in[9], \
    *const ab_w_in = P_.in[10], *const pool_w = P_.in[11], *const pool_b = P_.in[12], *const pool_scale = P_.in[13], *const ab_w_out = P_.in[14], *const cd_w_in = P_.in[15], *const q_norm_g = P_.in[16], *const w_q_up = P_.in[17], \
    *const kv_norm_g = P_.in[18], *const w_kv_up = P_.in[19], *const lru_conv_w = P_.in[20], *const lru_conv_b = P_.in[21], *const lru_wa = P_.in[22], *const lru_ba = P_.in[23], *const lru_wx = P_.in[24], *const lru_bx = P_.in[25], \
    *const lru_lambda = P_.in[26], *const cd_w_out = P_.in[27]; bf16_t* const H = WSP(bf16_t, R_H); const bf16_t* const CC = WSP(bf16_t, LAYER_CC); bf16_t* const Mx = WSP(bf16_t, LAYER_MX); \
    (void)xo; (void)x; (void)positions; (void)mix_pre_g; (void)mix_post_g; (void)ffn_pre_g; (void)ffn_post_g; (void)ffn_up; (void)ffn_conv_w; (void)ffn_conv_b; (void)ffn_down; (void)ab_w_in; (void)pool_w; (void)pool_b; (void)pool_scale; \
    (void)ab_w_out; (void)cd_w_in; (void)q_norm_g; (void)w_q_up; (void)kv_norm_g; (void)w_kv_up; (void)lru_conv_w; (void)lru_conv_b; (void)lru_wa; (void)lru_ba; (void)lru_wx; (void)lru_bx; (void)lru_lambda; (void)cd_w_out; (void)H; (void)CC; (void)Mx;
#define PHASE_END } if (pc >= p.ph_lo && pc + 1 < p.ph_hi) xcd_barrier(bar); ++pc;
    int pc = 0;
#define LAYER_CC R_CC0
#define LAYER_MX R_M0
    PHASE_BEGIN
#if !((SKIPMASK >> 0) & 1)
#if FP8_UP0
        ph_convT8(lds, ffn_up, 8192, 8192, 2048, WSP(unsigned char, W_UP0), bid, nblk, true);
#else
        ph_convT(lds, ffn_up, 8192, 0, 8192, 2048, WSP(bf16_t, W_UP0), 2048, bid, nblk, true);
#endif
#if FP8_UP1
        ph_convT8(lds, ffn_up + (size_t)2048 * 8192, 8192, 8192, 2048, WSP(unsigned char, W_UP1), bid, nblk, true);
#else
        ph_convT(lds, ffn_up + (size_t)2048 * 8192, 8192, 0, 8192, 2048, WSP(bf16_t, W_UP1), 2048, bid, nblk, true);
#endif
#if FP8_DN0
        ph_convT8(lds, ffn_down, 2048, 2048, 4096, WSP(unsigned char, W_DN0), bid, nblk);
#else
        ph_convT(lds, ffn_down, 2048, 0, 2048, 4096, WSP(bf16_t, W_DN0), 4096, bid, nblk);
#endif
#if FP8_DN1
        if (nblk != 256) ph_convT8(lds, ffn_down + (size_t)4096 * 2048, 2048, 2048, 4096, WSP(unsigned char, W_DN1), bid, nblk);
#else
        ph_convT(lds, ffn_down + (size_t)4096 * 2048, 2048, 0, 2048, 4096, WSP(bf16_t, W_DN1), 4096, bid, nblk);
#endif
#if FP8_QKV
        ph_convT8(lds, ab_w_in, 5200, 3072, 2048, WSP(unsigned char, W_ABIN), bid, nblk);
        ph_convT(lds, ab_w_in, 5200, 3072, 1024, 2048, WSP(bf16_t, W_ABIN) + (size_t)3072 * 2048, 2048, bid, nblk);
#else
        ph_convT(lds, ab_w_in, 5200, 0, 4096, 2048, WSP(bf16_t, W_ABIN), 2048, bid, nblk);
#endif
        ph_convT(lds, ab_w_in, 5200, 4176, 1024, 2048, WSP(bf16_t, W_ABIN) + (size_t)4096 * 2048, 2048, bid, nblk);
#define VB(first) ((bid + nblk - ((first) % nblk)) % nblk)
        ph_convT(lds, ab_w_in, 5200, 4096, 64, 2048, WSP(bf16_t, W_ABIN) + (size_t)5120 * 2048, 2048, VB(104), nblk);
        ph_convT(lds, ab_w_in, 5200, 4160, 16, 2048, WSP(bf16_t, W_ABIN) + (size_t)5184 * 2048, 2048, VB(112), nblk);
        ph_convT(lds, ab_w_out, 2048, 0, 2048, 2048, WSP(bf16_t, W_ABOUT), 2048, bid, nblk);
        if (nblk != 256) {
        ph_convT(lds, cd_w_in, 2880, 0, 832, 2048, WSP(bf16_t, W_CDIN), 2048, bid, nblk, false, mix_pre_g + 2048);
        ph_convT(lds, cd_w_in, 2880, 832, 2048, 2048, WSP(bf16_t, W_CDIN) + (size_t)1024 * 2048, 2048, bid, nblk, false, mix_pre_g + 2048);
        ph_convT(lds, cd_w_out, 2048, 0, 2048, 2048, WSP(bf16_t, W_CDOUT), 2048, bid, nblk);
        ph_convT(lds, w_q_up, 1536, 0, 1536, 512, WSP(bf16_t, W_QUP), 512, VB(136), nblk);
        ph_convT(lds, w_kv_up, 2048, 0, 2048, 256, WSP(bf16_t, W_KVUP), 256, VB(184), nblk);
        }
        for (int g = 0; g < 4; ++g) ph_convT(lds, pool_w + (size_t)g * 65536, 256, 0, 256, 256, WSP(bf16_t, W_POOL) + (size_t)g * 65536, 256, VB(120 + 4 * g), nblk);
#undef VB
        ph_rmsnorm<2048>(x, mix_pre_g, H, bid, nblk, FP8_QKV ? WSP(unsigned char, R_H8A) : (unsigned char*)nullptr);
#endif
    PHASE_END
    {
            PHASE_BEGIN
#if !((SKIPMASK >> 1) & 1)
                FAbIn2 f; f.Q = WSP(unsigned char, R_Q0); f.K = WSP(unsigned char, R_K0); f.VT = WSP(bf16_t, R_VT0); f.QI = WSP(unsigned short, R_QI); f.U = WSP(float, R_U); f.WI = WSP(float, R_WI); f.KI16 = WSP(unsigned short, R_KI);
#if FP8_QKV
                ph_gemm8(lds, WSP(unsigned char, R_H8A), 2048, WSP(unsigned char, W_ABIN), 2048, NTOK, 3072, 2048, f, bid, nblk, nblk == 256 ? 5 : 0);
                { FAbInHi fh; fh.f = f; ph_gemm(lds, H, 2048, WSP(bf16_t, W_ABIN) + (size_t)3072 * 2048, 2048, NTOK, 2304, 2048, fh, bid, nblk); }
#else
                ph_gemm(lds, H, 2048, WSP(bf16_t, W_ABIN), 2048, NTOK, 5376, 2048, f, bid, nblk);
#endif
#endif
            PHASE_END
            PHASE_BEGIN
#if !((SKIPMASK >> 2) & 1)
                ph_pooled(WSP(float, R_U), WSP(bf16_t, R_POOLED), bid, nblk);
                IdxArgs a; a.QI = WSP(unsigned short, R_QI); a.KI16 = WSP(unsigned short, R_KI); a.WI = WSP(float, R_WI); a.MT = WSP(unsigned long long, R_MASK);
                idx_phase(lds, a, bid, nblk);
#endif
            PHASE_END
            PHASE_BEGIN
#if !((SKIPMASK >> 3) & 1)
                { FPool f; f.CC = WSP(bf16_t, R_CC0); f.pb = pool_b; f.ps = pool_scale; ph_gemm(lds, WSP(bf16_t, R_POOLED), 1024, WSP(bf16_t, W_POOL), 256, NTOK, 1024, 256, f, bid, nblk, 0, 512); }
                AttnArgs a; a.Q = WSP(bf16_t, R_Q0); a.K = WSP(bf16_t, R_K0); a.VT = WSP(bf16_t, R_VT0); a.MT = WSP(unsigned long long, R_MASK); a.O = WSP(bf16_t, R_CC0); a.ldq = 1024; a.ldk = 1024; a.ldo = 2048;
                a.sc_log2e = 0.08838834764831845f * 1.4426950408889634f;
                attn_phase<128, true>(lds, a, bid, nblk);
#endif
            PHASE_END
        PHASE_BEGIN
#if !((SKIPMASK >> 4) & 1)
            FStoreBf16 f; f.O = Mx; f.ldc = 2048; f.pad_ = 0;
            ph_gemm(lds, CC, 2048, WSP(bf16_t, W_ABOUT), 2048, NTOK, 2048, 2048, f, bid, nblk);
#endif
        PHASE_END
        PHASE_BEGIN
#if !((SKIPMASK >> 5) & 1)
            ph_resnorm<false, true>(x, Mx, mix_post_g + 0, ffn_pre_g + 0, xo, H, FP8_UP0 ? WSP(unsigned char, R_H) : (unsigned char*)nullptr, bid, nblk);
#endif
        PHASE_END
        PHASE_BEGIN
#if FP8_UP0
            { EpiGate<FP8_DN0 != 0, true> ep; ep.cw = ffn_conv_w + 0; ep.cb = ffn_conv_b + 0; ep.ACT = WSP(void, R_HID);
              ph_gemm_e(lds, (const bf16_t*)WSP(unsigned char, R_H), 1024, (const bf16_t*)WSP(unsigned char, W_UP0), 1024, 134 * 256, 8192, 1024, ep, bid, nblk, 0, 0, 1); }
#else
            { EpiGate<FP8_DN0 != 0, false> ep; ep.cw = ffn_conv_w + 0; ep.cb = ffn_conv_b + 0; ep.ACT = WSP(void, R_HID);
              ph_gemm_e(lds, H, 2048, WSP(bf16_t, W_UP0), 2048, 134 * 256, 8192, 2048, ep, bid, nblk, 0, 0, 1); }
#endif
            if (nblk == 256 && bid >= 192) { const int vb = bid - 192;
                ph_convT(lds, cd_w_in, 2880, 0, 832, 2048, WSP(bf16_t, W_CDIN), 2048, vb, 64, false, mix_pre_g + 2048);
                ph_convT(lds, cd_w_in, 2880, 832, 2048, 2048, WSP(bf16_t, W_CDIN) + (size_t)1024 * 2048, 2048, vb, 64, false, mix_pre_g + 2048);
                ph_convT(lds, cd_w_out, 2048, 0, 2048, 2048, WSP(bf16_t, W_CDOUT), 2048, vb, 64);
                ph_convT(lds, w_q_up, 1536, 0, 1536, 512, WSP(bf16_t, W_QUP), 512, vb, 64);
                ph_convT(lds, w_kv_up, 2048, 0, 2048, 256, WSP(bf16_t, W_KVUP), 256, (vb + 32) & 63, 64); }
        PHASE_END
        PHASE_BEGIN
            FStoreBf16 f; f.O = WSP(bf16_t, R_F); f.ldc = 2048; f.pad_ = 0;
#if FP8_DN0
            ph_gemm8(lds, WSP(unsigned char, R_HID), 4096, WSP(unsigned char, W_DN0), 4096, NTOK, 2048, 4096, f, bid, nblk);
#else
            ph_gemm(lds, WSP(bf16_t, R_HID), 4096, WSP(bf16_t, W_DN0), 4096, NTOK, 2048, 4096, f, bid, nblk);
#endif
        PHASE_END
        PHASE_BEGIN
#if !((SKIPMASK >> 9) & 1)
            ph_resnorm<true, true>(xo, WSP(bf16_t, R_F), ffn_post_g + 0, mix_pre_g + 2048, xo, H, nullptr, bid, nblk, WSP(float, R_CA));
#endif
        PHASE_END
    }
    {
#undef LAYER_CC
#undef LAYER_MX
#define LAYER_CC R_CC1
#define LAYER_MX R_M1
            PHASE_BEGIN
#if !((SKIPMASK >> 10) & 1)
                FCdIn f; f.CQ = WSP(float, R_CQ); f.CKV = WSP(float, R_CKV); f.KR = WSP(float, R_KR); f.XL = WSP(bf16_t, R_XL); f.YG = WSP(bf16_t, R_YG);
                { EpiGRow<FCdIn> ep; ep.f = f; ep.rs = WSP(float, R_CA); ph_gemm_e(lds, (const bf16_t*)xo, 2048, WSP(bf16_t, W_CDIN), 2048, NTOK, 3072, 2048, ep, bid, nblk); }
#endif
            PHASE_END
            PHASE_BEGIN
#if !((SKIPMASK >> 11) & 1)
                ph_xc(WSP(bf16_t, R_XL), lru_conv_w, lru_conv_b, WSP(bf16_t, R_XCB), bid, nblk);
                ph_conv_lru(lru_wa, lru_wx, WSP(bf16_t, W_LRU), bid, nblk);
                ph_rmsnorm<512>(WSP(float, R_CQ), q_norm_g, WSP(bf16_t, R_CQN), bid, nblk);
                ph_rmsnorm<256>(WSP(float, R_CKV), kv_norm_g, WSP(bf16_t, R_CKVN), bid, nblk);
            PHASE_END
            PHASE_BEGIN
                { EpiLru ep; ep.XCB = WSP(bf16_t, R_XCB); ep.ba = lru_ba; ep.bx = lru_bx; ep.lam = lru_lambda; ep.LA = WSP(bf16_t, R_LA); ep.LB = WSP(bf16_t, R_LB);
                  ph_gemm_e(lds, WSP(bf16_t, R_XCB), 1024, WSP(bf16_t, W_LRU), 256, NTOK, 2048, 256, ep, bid, nblk, 1, 512); }
                { FStoreBf16 f; f.O = WSP(bf16_t, R_Q1); f.ldc = 1536; f.pad_ = 0; ph_gemm(lds, WSP(bf16_t, R_CQN), 512, WSP(bf16_t, W_QUP), 512, NTOK, 1536, 512, f, bid, nblk); }
                { FKvUp2 f; f.K8 = WSP(unsigned char, R_K1); f.VT = WSP(bf16_t, R_VT1); ph_gemm(lds, WSP(bf16_t, R_CKVN), 256, WSP(bf16_t, W_KVUP), 256, NTOK, 2048, 256, f, bid, nblk); }
            PHASE_END
            PHASE_BEGIN
                ph_scan1(WSP(bf16_t, R_LA), WSP(bf16_t, R_LB), WSP(float, R_CA), WSP(float, R_CH), bid, nblk);
                ph_rope_q(WSP(bf16_t, R_Q1), positions, WSP(unsigned char, R_Q8), bid, nblk);
                ph_rope_k(WSP(float, R_KR), positions, WSP(unsigned char, R_K1), bid, nblk);
            PHASE_END
            PHASE_BEGIN
                ph_scan2(WSP(float, R_CA), WSP(float, R_CH), WSP(float, R_CIN), bid, nblk);
            PHASE_END
            PHASE_BEGIN
                ph_scan3(WSP(bf16_t, R_LA), WSP(bf16_t, R_LB), WSP(float, R_CIN), WSP(bf16_t, R_YG), WSP(bf16_t, R_CC1), bid, nblk);
                AttnArgs a; a.Q = WSP(bf16_t, R_Q8); a.K = WSP(bf16_t, R_K1); a.VT = WSP(bf16_t, R_VT1); a.MT = nullptr; a.O = WSP(bf16_t, R_CC1); a.ldq = 1536; a.ldk = 1536; a.ldo = 2048;
                a.sc_log2e = 0.07216878364870322f * 1.4426950408889634f;
                attn_phase<192, false>(lds, a, bid, nblk);
#endif
            PHASE_END
        PHASE_BEGIN
#if !((SKIPMASK >> 15) & 1)
            FStoreBf16 f; f.O = Mx; f.ldc = 2048; f.pad_ = 0;
            ph_gemm(lds, CC, 2048, WSP(bf16_t, W_CDOUT), 2048, NTOK, 2048, 2048, f, bid, nblk);
#endif
        PHASE_END
        PHASE_BEGIN
#if !((SKIPMASK >> 16) & 1)
            ph_resnorm<true, true>(xo, Mx, mix_post_g + 2048, ffn_pre_g + 2048, WSP(bf16_t, R_X3), H, FP8_UP1 ? WSP(unsigned char, R_H) : (unsigned char*)nullptr, bid, nblk);
#endif
        PHASE_END
        PHASE_BEGIN
#if FP8_UP1
            { EpiGate<FP8_DN1 != 0, true> ep; ep.cw = ffn_conv_w + 24576; ep.cb = ffn_conv_b + 8192; ep.ACT = WSP(void, R_HID);
              ph_gemm_e(lds, (const bf16_t*)WSP(unsigned char, R_H), 1024, (const bf16_t*)WSP(unsigned char, W_UP1), 1024, 134 * 256, 8192, 1024, ep, bid, nblk, 0, 0, 1); }
#else
            { EpiGate<FP8_DN1 != 0, false> ep; ep.cw = ffn_conv_w + 24576; ep.cb = ffn_conv_b + 8192; ep.ACT = WSP(void, R_HID);
              ph_gemm_e(lds, H, 2048, WSP(bf16_t, W_UP1), 2048, 134 * 256, 8192, 2048, ep, bid, nblk, 0, 0, 1); }
#endif
#if FP8_DN1
            if (nblk == 256 && bid >= 192) ph_convT8(lds, ffn_down + (size_t)4096 * 2048, 2048, 2048, 4096, WSP(unsigned char, W_DN1), bid - 192, 64);
#endif
        PHASE_END
        PHASE_BEGIN
            FStoreBf16 f; f.O = WSP(bf16_t, R_F); f.ldc = 2048; f.pad_ = 0;
#if FP8_DN1
            ph_gemm8(lds, WSP(unsigned char, R_HID), 4096, WSP(unsigned char, W_DN1), 4096, NTOK, 2048, 4096, f, bid, nblk);
#else
            ph_gemm(lds, WSP(bf16_t, R_HID), 4096, WSP(bf16_t, W_DN1), 4096, NTOK, 2048, 4096, f, bid, nblk);
#endif
        PHASE_END
        PHASE_BEGIN
#if !((SKIPMASK >> 20) & 1)
            ph_resnorm<true, false>(WSP(bf16_t, R_X3), WSP(bf16_t, R_F), ffn_post_g + 2048, (const float*)nullptr, xo, H, nullptr, bid, nblk);
#endif
        PHASE_END
    }
#undef LAYER_CC
#undef LAYER_MX
#undef WSP
#undef PHASE_BEGIN
#undef PHASE_END
}

#ifndef MK_N_LAUNCHES
#define MK_N_LAUNCHES 1
#endif
static constexpr int MK_NPHASES = 1 + 3 + 7 + 2 * 5;

extern "C" void kernel_launch(void* const* d_in, const int* in_sizes, int n_in, void* d_out, int out_size, void* d_ws, size_t ws_size, hipStream_t stream) {
    static int grid = 0;
    if (grid == 0) {
        if (n_in != 28 || out_size != NTOK * DM || ws_size < WS_NEED) { fprintf(stderr, "kernel_launch: unexpected shapes (n_in %d out %d ws %zu)\n", n_in, out_size, ws_size); grid = -1; return; }
        int dev = 0, cus = 0, per_cu = 0;
        if (hipGetDevice(&dev) != hipSuccess || hipDeviceGetAttribute(&cus, hipDeviceAttributeMultiprocessorCount, dev) != hipSuccess) { grid = -1; return; }
        if (hipFuncSetAttribute((const void*)k_mega, hipFuncAttributeMaxDynamicSharedMemorySize, MK_LDS) != hipSuccess) { fprintf(stderr, "kernel_launch: hipFuncSetAttribute failed\n"); grid = -1; return; }
        if (hipOccupancyMaxActiveBlocksPerMultiprocessor(&per_cu, (const void*)k_mega, 512, MK_LDS) != hipSuccess || per_cu < 1) { fprintf(stderr, "kernel_launch: occupancy query says %d\n", per_cu); }
        (void)hipGetLastError();
        grid = cus;
        if (grid != 256) { fprintf(stderr, "kernel_launch: built for 256 CUs, found %d\n", grid); grid = -1; return; }
    }
    if (grid < 0) return;
    unsigned char* ws = (unsigned char*)d_ws;
    (void)hipMemsetAsync(ws + WS_BAR, 0, XCD_BAR_WORDS * sizeof(unsigned), stream);
    (void)hipMemsetAsync(ws + W_ABIN + (size_t)5200 * 2048 * 2, 0, (size_t)176 * 2048 * 2, stream);
    (void)hipMemsetAsync(ws + W_CDIN + (size_t)832 * 2048 * 2, 0, (size_t)192 * 2048 * 2, stream);
    MK p{};
    for (int i = 0; i < 28; ++i) p.in[i] = (const float*)d_in[i];
    p.out = (float*)d_out; p.ws = ws;
#if MK_N_LAUNCHES == 1
    p.ph_lo = 0; p.ph_hi = 1 << 20;
    hipLaunchKernelGGL(k_mega, dim3(grid), dim3(512), MK_LDS, stream, p);
#else
    for (int ph = 0; ph < MK_NPHASES; ++ph) { p.ph_lo = ph; p.ph_hi = ph + 1; hipLaunchKernelGGL(k_mega, dim3(grid), dim3(512), MK_LDS, stream, p); }
#endif
}
```

```cpp
#include <hip/hip_runtime.h>
#include <stdint.h>
#include <stdio.h>

#define LAS __attribute__((address_space(3)))
typedef unsigned short bf16_t;
typedef float f32x4 __attribute__((ext_vector_type(4)));
typedef unsigned u32x4 __attribute__((ext_vector_type(4)));
typedef unsigned u32x2 __attribute__((ext_vector_type(2)));

static constexpr int NTOK = 32768, SEQ = 16384, NBATCH = 2, DM = 2048, DFF = 4096;
static constexpr float NORM_EPS = 1e-6f;

__device__ __forceinline__ bf16_t f2bf(float f) { unsigned u = __float_as_uint(f); u += 0x7FFFu + ((u >> 16) & 1u); return (bf16_t)(u >> 16); }
__device__ __forceinline__ float bf2f(bf16_t b) { return __uint_as_float(((unsigned)b) << 16); }
__device__ __forceinline__ unsigned pack2bf(float lo, float hi) { unsigned r; asm("v_cvt_pk_bf16_f32 %0, %1, %2" : "=v"(r) : "v"(lo), "v"(hi)); return r; }
__device__ __forceinline__ float gelu_tanh(float x) { const float u = 0.7978845608028654f * (x + 0.044715f * x * x * x); return 0.5f * x * (1.0f + tanhf(u)); }
__device__ __forceinline__ float wave_sum(float v) {
#pragma unroll
    for (int o = 32; o >= 1; o >>= 1) v += __shfl_xor(v, o);
    return v;
}

#ifndef TID_PLAIN
#define TID_PLAIN 0
#endif
static constexpr int TID_TAB_LDS = 162816 - 16 - 256;
#if TID_PLAIN
__device__ __forceinline__ int opaque_tid() { int t = (int)threadIdx.x; asm volatile("" : "+v"(t)); return t; }
#else
__device__ __forceinline__ int opaque_tid() {
    const unsigned slot = (unsigned)__builtin_amdgcn_s_getreg(((6 - 1) << 11) | 4) & 63u;
    const int w = __builtin_amdgcn_readfirstlane(*(const volatile LAS int*)(size_t)(TID_TAB_LDS + 4 * slot));
    int lane; asm volatile("v_mbcnt_lo_u32_b32 %0, -1, 0\n\tv_mbcnt_hi_u32_b32 %0, -1, %0" : "=v"(lane));
    return w * 64 + lane;
}
#endif

__device__ __forceinline__ int opaque_s(int v) { asm volatile("" : "+s"(v)); return v; }

template <class T> __device__ __forceinline__ const T* opaque_p(const T* p) { asm volatile("" : "+s"(p)); return p; }

#ifndef PG8_EPI_RECOMP
#define PG8_EPI_RECOMP 1
#endif
#ifndef PG8_ASM_DMA
#define PG8_ASM_DMA 1
#endif
#include <hip/hip_runtime.h>
namespace pg8 {
#define PG8_LAS __attribute__((address_space(3)))
typedef unsigned short bf16_t;
typedef short bf16x8 __attribute__((ext_vector_type(8)));
typedef float f32x4 __attribute__((ext_vector_type(4)));
typedef unsigned u32x4 __attribute__((ext_vector_type(4)));
typedef int i32x8 __attribute__((ext_vector_type(8)));
typedef int i32x4 __attribute__((ext_vector_type(4)));
constexpr int BM = 256, BK = 64, HALF = 128, HTB = HALF * BK * 2  , STAGE_BYTES = 8 * HTB, NXCD = 8, WGM = 8;

__host__ __device__ __forceinline__ int lds_byte(int r, int c) { const int st = (r >> 4) * 2 + (c >> 5), rr = r & 15, cc = c & 31, ob = rr * 64 + cc * 2; return st * 1024 + (ob ^ (((ob >> 9) & 1) << 5)); }
__host__ __device__ __forceinline__ void stage_rc(int b, int& R, int& C) { const int st = b / 1024, sb = b % 1024, swz = sb ^ (((sb >> 9) & 1) << 5); R = (st >> 1) * 16 + swz / 64; C = (st & 1) * 32 + (swz % 64) / 2; }
__host__ __device__ __forceinline__ int perm32(int rho) { const int n = rho >> 4, i = rho & 15; return 8 * (i >> 2) + 4 * n + (i & 3); }

struct Unit { int pm, pn; };
struct Gemm { const bf16_t* A; const bf16_t* Bt; int M, N, K, lda, ldb, a_shift, a_bytes, cmode; };

struct StaticOrder {
    int nM, nN, nwg, G, c, skew = 0;
    __host__ __device__ void init(int M, int N, int G_, int c_) { nM = M / BM; nN = N / BM; nwg = nM * nN; G = G_; c = c_; }
    __host__ __device__ bool next(int i, Unit& u) const {
        long L = (long)i * G + c;
        if (skew && i >= skew) { const int half = G >> 1, per = (nwg - skew * G) / half, e = i - skew; if (c < half || e >= per) return false; L = (long)skew * G + (long)(c - half) * per + e; }
        if (L >= nwg) return false;
        int wgid = (int)L; { const int q = nwg / NXCD, r = nwg % NXCD, xcd = wgid % NXCD, off = wgid / NXCD; wgid = (xcd < r ? xcd * (q + 1) : r * (q + 1) + (xcd - r) * q) + off; }
        const int nig = WGM * nN, gid = wgid / nig, fm = gid * WGM, gsz = (nM - fm) < WGM ? (nM - fm) : WGM;
        u.pm = fm + ((wgid % nig) % gsz); u.pn = (wgid % nig) / gsz; return true;
    }
    __device__ __forceinline__ void a_ready(const Unit&) const {}
    __device__ __forceinline__ void done(const Unit&) const {}
};

template <class Epi, class Sched, bool STAMP = false>
__device__ __forceinline__ void gemm_phase(PG8_LAS unsigned char* lds, const Gemm g, const Sched& S, const Epi& E, unsigned long long* stamps) {
    const int tid = opaque_tid(), wid = __builtin_amdgcn_readfirstlane(tid >> 6), lane = tid & 63, wr = wid >> 2, wc = wid & 3, fr = lane & 15, fq = lane >> 4;
    const int K = g.K, nt = K / BK;
    int ts_lo = 0, ts_hi = 0, nts = 0; const unsigned long long rt_entry = STAMP ? (unsigned long long)wall_clock64() : 0ull;
#define PG8_STAMP() do { if (STAMP && wid == 0 && nts < 64) { const unsigned long long _c = (unsigned long long)clock64(); \
        ts_lo = (lane == nts) ? (int)(unsigned)_c : ts_lo; ts_hi = (lane == nts) ? (int)(unsigned)(_c >> 32) : ts_hi; ++nts; } } while (0)
    PG8_STAMP();
    unsigned voffA[2], voffB[2];
#pragma unroll
    for (int i = 0; i < 2; ++i) { int R, C; stage_rc(tid * 16 + i * 8192, R, C); const int Rb = Epi::PERM ? ((R & ~31) + perm32(R & 31)) : R;
        const int Ra = g.cmode ? (R - 2 * (R >> 6)) : R;
        voffA[i] = (unsigned)(Ra * g.lda + C) * 2u; voffB[i] = (unsigned)(Rb * g.ldb + C) * 2u; }
    const size_t kstep = (size_t)(BK * 2);
    const size_t hstepA = (size_t)(g.cmode ? HALF - 4 : HALF) * g.lda * 2, hstepB = (size_t)HALF * g.ldb * 2;
    const size_t tstepA = 2 * hstepA, tstepB = 2 * hstepB;
    const unsigned ldsbase_ = (unsigned)(size_t)lds;
    const int sc_w_ = 0x79797979, sc_a_ = 0x7F7F7F7F;
    (void)sc_w_; (void)sc_a_;
    const unsigned ldsw = (unsigned)wid * 1024u;
    const int aoff = lds_byte(wr * 64 + fr, fq * 8), boff = lds_byte(wc * 32 + fr, fq * 8);
#define PG8_SA(b, h) (((b) * 2 + (h)) * HTB)
#define PG8_SB(b, h) ((4 + (b) * 2 + (h)) * HTB)
#if PG8_ASM_DMA
#define PG8_STAGE(bufoff, gbase, voff) do { _Pragma("unroll") for (int _i = 0; _i < 2; ++_i) { unsigned keep_; \
        asm volatile("s_mov_b32 %0, m0\n\ts_mov_b32 m0, %3\n\ts_nop 0\n\tglobal_load_lds_dwordx4 %1, %2\n\ts_mov_b32 m0, %0" \
                     : "=&s"(keep_) : "v"((voff)[_i]), "s"((const char*)(gbase)), "s"(ldsbase_ + (unsigned)(bufoff) + ldsw + (unsigned)(_i * 8192)) : "memory"); } } while (0)
#else
#define PG8_STAGE(bufoff, gbase, voff) do { _Pragma("unroll") for (int _i = 0; _i < 2; ++_i) \
        __builtin_amdgcn_global_load_lds((const unsigned*)((const char*)(gbase) + (voff)[_i]), (PG8_LAS unsigned*)(lds + (bufoff) + ldsw + _i * 8192), 16, 0, 0); } while (0)
#endif
#define PG8_LDA(dst, b, h) do { _Pragma("unroll") for (int m = 0; m < 4; ++m) { dst[m].lo = *(const PG8_LAS i32x4*)(lds + PG8_SA(b, h) + aoff + m * 2048); dst[m].hi = *(const PG8_LAS i32x4*)(lds + PG8_SA(b, h) + aoff + m * 2048 + 1024); } } while (0)
#define PG8_LDB(dst, b, h) do { _Pragma("unroll") for (int n = 0; n < 2; ++n) { dst[n].lo = *(const PG8_LAS i32x4*)(lds + PG8_SB(b, h) + boff + n * 2048); dst[n].hi = *(const PG8_LAS i32x4*)(lds + PG8_SB(b, h) + boff + n * 2048 + 1024); } } while (0)
#define PG8_MMA(ai, bj, At, Bt) do { __builtin_amdgcn_s_setprio(1); \
        if constexpr (Epi::FP8) { _Pragma("unroll") for (int m = 0; m < 4; ++m) _Pragma("unroll") for (int n = 0; n < 2; ++n) \
            asm volatile("v_mfma_scale_f32_16x16x128_f8f6f4 %0, %1, %2, %0, %3, %4 op_sel_hi:[0,0,0]" : "+v"(acc[ai][bj][m][n]) : "v"(Bt[n]), "v"(At[m]), "v"(sc_w_), "v"(sc_a_)); } \
        else { _Pragma("unroll") for (int m = 0; m < 4; ++m) _Pragma("unroll") for (int n = 0; n < 2; ++n) { \
            const i32x4 bl_ = Bt[n].lo, bh_ = Bt[n].hi, al_ = At[m].lo, ah_ = At[m].hi;     \
            acc[ai][bj][m][n] = __builtin_amdgcn_mfma_f32_16x16x32_bf16(__builtin_bit_cast(bf16x8, bl_), __builtin_bit_cast(bf16x8, al_), acc[ai][bj][m][n], 0, 0, 0); \
            acc[ai][bj][m][n] = __builtin_amdgcn_mfma_f32_16x16x32_bf16(__builtin_bit_cast(bf16x8, bh_), __builtin_bit_cast(bf16x8, ah_), acc[ai][bj][m][n], 0, 0, 0); } } \
        __builtin_amdgcn_s_setprio(0); } while (0)
#define PG8_WAIT_V(n) asm volatile("s_waitcnt vmcnt(" #n ")" ::: "memory")
#define PG8_WAIT_L(n) asm volatile("s_waitcnt lgkmcnt(" #n ")" ::: "memory")
#define PG8_BAR __builtin_amdgcn_s_barrier()
#define PG8_SCHED __builtin_amdgcn_sched_barrier(0)
    Unit cur, nxt; int ui = 0;
    if (!S.next(0, cur)) return;
    f32x4 acc[2][2][4][2];
#pragma unroll
    for (int a = 0; a < 2; ++a)
#pragma unroll
        for (int b = 0; b < 2; ++b)
#pragma unroll
            for (int m = 0; m < 4; ++m)
#pragma unroll
                for (int n = 0; n < 2; ++n) acc[a][b][m][n] = (f32x4){0.f, 0.f, 0.f, 0.f};
    i32x8 At[4], B0[2], B1[2];
    auto a_base_ = [&](const Unit& u_) -> const char* { return g.cmode ? (const char*)g.A + ((long)(u_.pm / 67) * 16384 + (long)(u_.pm % 67) * 248 - 2) * (long)g.lda * 2 : (const char*)g.A + (size_t)u_.pm * tstepA + (size_t)(u_.pn >> g.a_shift) * g.a_bytes; };
    const char* cA = a_base_(cur); const char* cB = (const char*)g.Bt + (size_t)cur.pn * tstepB;
    S.a_ready(cur);
    PG8_STAGE(PG8_SB(0, 0), cB, voffB); PG8_STAGE(PG8_SA(0, 0), cA, voffA); PG8_STAGE(PG8_SB(0, 1), cB + hstepB, voffB); PG8_STAGE(PG8_SA(0, 1), cA + hstepA, voffA);
    if (wr == 1) PG8_BAR;
    PG8_WAIT_V(4); PG8_BAR;
    PG8_STAGE(PG8_SB(1, 0), cB + kstep, voffB); PG8_STAGE(PG8_SA(1, 0), cA + kstep, voffA); PG8_STAGE(PG8_SB(1, 1), cB + hstepB + kstep, voffB);
    PG8_WAIT_V(6); PG8_BAR;
    PG8_STAMP();
    for (;;) {
        const bool has_next = S.next(ui + 1, nxt);
        const char* nA = has_next ? a_base_(nxt) : cA; const char* nB = has_next ? (const char*)g.Bt + (size_t)nxt.pn * tstepB : cB;
        for (int t = 0; t < nt; t += 2) {
            const bool last = (t == nt - 2);
            const char* a1 = cA + (size_t)(t + 1) * kstep;
            const char* a2 = last ? nA : cA + (size_t)(t + 2) * kstep; const char* b2 = last ? nB : cB + (size_t)(t + 2) * kstep;
            const char* a3 = a2 + kstep; const char* b3 = b2 + kstep;
            if (last && has_next) S.a_ready(nxt);
            PG8_LDB(B0, 0, 0); PG8_SCHED; PG8_LDA(At, 0, 0); PG8_STAGE(PG8_SA(1, 1), a1 + hstepA, voffA);
            PG8_WAIT_L(8); PG8_BAR; PG8_WAIT_L(0); PG8_MMA(0, 0, At, B0); PG8_BAR; PG8_SCHED;
            PG8_LDB(B1, 0, 1); PG8_STAGE(PG8_SB(0, 0), b2, voffB);
            PG8_BAR; PG8_WAIT_L(0); PG8_MMA(0, 1, At, B1); PG8_BAR;
            PG8_LDA(At, 0, 1); PG8_STAGE(PG8_SA(0, 0), a2, voffA);
            PG8_BAR; PG8_WAIT_L(0); PG8_MMA(1, 0, At, B0); PG8_BAR; PG8_SCHED;
            PG8_STAGE(PG8_SB(0, 1), b2 + hstepB, voffB);
            PG8_WAIT_V(6); PG8_BAR; PG8_MMA(1, 1, At, B1); PG8_BAR;
            PG8_LDB(B0, 1, 0); PG8_SCHED; PG8_LDA(At, 1, 0); PG8_STAGE(PG8_SA(0, 1), a2 + hstepA, voffA);
            PG8_WAIT_L(8); PG8_BAR; PG8_WAIT_L(0); PG8_MMA(0, 0, At, B0); PG8_BAR; PG8_SCHED;
            PG8_LDB(B1, 1, 1); PG8_STAGE(PG8_SB(1, 0), b3, voffB);
            PG8_BAR; PG8_WAIT_L(0); PG8_MMA(0, 1, At, B1); PG8_BAR;
            PG8_LDA(At, 1, 1); PG8_STAGE(PG8_SA(1, 0), a3, voffA);
            PG8_BAR; PG8_WAIT_L(0); PG8_MMA(1, 0, At, B0); PG8_BAR; PG8_SCHED;
            PG8_STAGE(PG8_SB(1, 1), b3 + hstepB, voffB);
            PG8_WAIT_V(6); PG8_BAR; PG8_MMA(1, 1, At, B1); PG8_BAR;
        }
        PG8_STAMP();
        if constexpr (Epi::FP8) { asm volatile("s_nop 15\n\ts_nop 15" ::: "memory"); }
        if constexpr (!Epi::AFTER_DRAIN) {
#if PG8_EPI_RECOMP
            const int t2_ = opaque_tid(), l2_ = t2_ & 63, w2_ = __builtin_amdgcn_readfirstlane(t2_ >> 6);
            E(acc, cur, w2_ >> 2, w2_ & 3, l2_ & 15, l2_ >> 4); S.done(cur);
#else
            E(acc, cur, wr, wc, fr, fq); S.done(cur);
#endif
        }
        PG8_STAMP();
        if (!has_next) break;
#pragma unroll
        for (int a = 0; a < 2; ++a)
#pragma unroll
            for (int b = 0; b < 2; ++b)
#pragma unroll
                for (int m = 0; m < 4; ++m)
#pragma unroll
                    for (int n = 0; n < 2; ++n) acc[a][b][m][n] = (f32x4){0.f, 0.f, 0.f, 0.f};
        cur = nxt; cA = nA; cB = nB; ++ui;
    }
    PG8_WAIT_V(0);
    if (wr == 0) PG8_BAR;
    PG8_BAR;
    if constexpr (Epi::AFTER_DRAIN) { E.fused(acc, cur, wr, wc, fr, fq, lds, wid, lane); S.done(cur); }
    PG8_STAMP();
    if (STAMP && wid == 0) { stamps[lane] = lane < nts ? (((unsigned long long)(unsigned)ts_hi << 32) | (unsigned)ts_lo) : 0ull;
        if (lane == 62) stamps[62] = rt_entry; if (lane == 63) stamps[63] = (unsigned long long)wall_clock64(); }
#undef PG8_STAMP
#undef PG8_SA
#undef PG8_SB
#undef PG8_STAGE
#undef PG8_LDA
#undef PG8_LDB
#undef PG8_MMA
#undef PG8_WAIT_V
#undef PG8_WAIT_L
#undef PG8_BAR
#undef PG8_SCHED
}
}

#include <cstdio>
#include <ctime>
#include <cstdlib>
#include <cstring>
#include <cmath>
#include <vector>

template <class F, bool F8 = false> struct EpiG {
    static constexpr bool PERM = false, AFTER_DRAIN = false, FP8 = F8;
    F f;
    __device__ __forceinline__ void operator()(const f32x4 (&acc)[2][2][4][2], const pg8::Unit& u, int wr, int wc, int fr, int fq) const {
        const int row0 = u.pm * 256 + wr * 64 + fr, col0 = u.pn * 256 + wc * 32 + 4 * fq;
#pragma unroll
        for (int ai = 0; ai < 2; ++ai)
#pragma unroll
            for (int m = 0; m < 4; ++m)
#pragma unroll
                for (int bj = 0; bj < 2; ++bj)
#pragma unroll
                    for (int n = 0; n < 2; ++n) f(row0 + ai * 128 + m * 16, col0 + bj * 128 + n * 16, acc[ai][bj][m][n]);
    }
};
template <class F> struct EpiGRow {
    static constexpr bool PERM = false, AFTER_DRAIN = false, FP8 = false;
    F f; const float* rs;
    __device__ __forceinline__ void operator()(const f32x4 (&acc)[2][2][4][2], const pg8::Unit& u, int wr, int wc, int fr, int fq) const {
        const int row0 = u.pm * 256 + wr * 64 + fr, col0 = u.pn * 256 + wc * 32 + 4 * fq;
        float s[2][4];
#pragma unroll
        for (int ai = 0; ai < 2; ++ai)
#pragma unroll
            for (int m = 0; m < 4; ++m) s[ai][m] = rs[row0 + ai * 128 + m * 16];
#pragma unroll
        for (int ai = 0; ai < 2; ++ai)
#pragma unroll
            for (int m = 0; m < 4; ++m)
#pragma unroll
                for (int bj = 0; bj < 2; ++bj)
#pragma unroll
                    for (int n = 0; n < 2; ++n) f(row0 + ai * 128 + m * 16, col0 + bj * 128 + n * 16, acc[ai][bj][m][n] * s[ai][m]);
    }
};
__device__ __forceinline__ void st_bf16x4(bf16_t* p, f32x4 v) { u32x2 w; w.x = pack2bf(v[0], v[1]); w.y = pack2bf(v[2], v[3]); *(u32x2*)p = w; }
__device__ __forceinline__ void st_f32x4(float* p, f32x4 v) { *(f32x4*)p = v; }

struct FStoreBf16 { bf16_t* O; int ldc; int pad_; __device__ __forceinline__ void operator()(int r, int c, f32x4 v) const { st_bf16x4(O + (size_t)r * ldc + c, v); } };
struct FAbIn { bf16_t *Q, *K, *V; float *QI, *U, *WI; unsigned short* KI16;
    __device__ __forceinline__ void operator()(int r, int c, f32x4 v) const {
        if (c < 1024) st_bf16x4(Q + (size_t)r * 1024 + c, v);
        else if (c < 2048) st_bf16x4(K + (size_t)r * 1024 + (c - 1024), v);
        else if (c < 3072) st_bf16x4(V + (size_t)r * 1024 + (c - 2048), v);
        else if (c < 4096) st_f32x4(QI + (size_t)r * 1024 + (c - 3072), v);
        else if (c < 5120) st_f32x4(U + (size_t)r * 1024 + (c - 4096), v);
        else if (c < 5184) { typedef _Float16 h2 __attribute__((ext_vector_type(2))); union { h2 h; unsigned u; } a, b; a.h = (h2){(_Float16)v[0], (_Float16)v[1]}; b.h = (h2){(_Float16)v[2], (_Float16)v[3]};
            u32x2 w; w.x = a.u; w.y = b.u; *(u32x2*)(KI16 + (size_t)r * 64 + (c - 5120)) = w; }
        else if (c < 5200) st_f32x4(WI + (size_t)r * 16 + (c - 5184), v);
    } };
struct FCdIn { float *CQ, *CKV, *KR; bf16_t *XL, *YG;
    __device__ __forceinline__ void operator()(int r, int c, f32x4 v) const {
        if (c < 512) st_f32x4(CQ + (size_t)r * 512 + c, v);
        else if (c < 768) st_f32x4(CKV + (size_t)r * 256 + (c - 512), v);
        else if (c < 832) st_f32x4(KR + (size_t)r * 64 + (c - 768), v);
        else if (c < 1024) {}
        else if (c < 2048) st_bf16x4(XL + (size_t)r * 1024 + (c - 1024), v);
        else st_bf16x4(YG + (size_t)r * 1024 + (c - 2048), v);
    }
    __device__ __forceinline__ void st8(int r, int c, f32x4 v0, f32x4 v1) const;
};
struct FKvUp { bf16_t *K1, *V1;
    __device__ __forceinline__ void operator()(int r, int c, f32x4 v) const {
        const int h = c >> 8, d = c & 255;
        if (d < 128) st_bf16x4(K1 + (size_t)r * 1536 + h * 192 + d, v);
        else st_bf16x4(V1 + (size_t)r * 1024 + h * 128 + (d - 128), v);
    } };

__device__ __forceinline__ unsigned ord_key(float f) { const unsigned b = __float_as_uint(f); return (b & 0x80000000u) ? ~b : (b | 0x80000000u); }
__device__ __forceinline__ void rope_cs(int pos, int i, float& c, float& s) { const float freq = powf(10000.0f, -(float)i / 32.0f); const float ang = (float)pos * freq; sincosf(ang, &s, &c); }
#define PV8_MLA 1
#define PV8_DSA 1

typedef short bf16x8 __attribute__((ext_vector_type(8)));
typedef float f32x16 __attribute__((ext_vector_type(16)));
__device__ __forceinline__ unsigned cvtpk(float lo, float hi) { unsigned r; asm("v_cvt_pk_bf16_f32 %0, %1, %2" : "=v"(r) : "v"(lo), "v"(hi)); return r; }
__device__ __forceinline__ float max3_asm(float a, float b, float c) { float r; asm("v_max3_f32 %0, %1, %2, %3" : "=v"(r) : "v"(a), "v"(b), "v"(c)); return r; }

struct AttnArgs { const bf16_t* Q; const bf16_t* K; const bf16_t* VT; const unsigned long long* MT; bf16_t* O; int ldq, ldk, ldo; float sc_log2e; };

static constexpr int ATT_MTBL = 65536;
struct TTrue { static constexpr bool value = true; }; struct TFalse { static constexpr bool value = false; };
typedef int i32x8q __attribute__((ext_vector_type(8)));
typedef int i32x4q __attribute__((ext_vector_type(4)));
#define MFMA8_FENCE2(acc0, acc1, srcA, srcB) asm volatile("s_nop 15\n\ts_nop 9" : "+v"(acc0), "+v"(acc1) : "v"(srcA), "v"(srcB))
#define MFMA8_FENCE4(a0_, a1_, a2_, a3_, srcA, srcB) asm volatile("s_nop 15\n\ts_nop 9" : "+v"(a0_), "+v"(a1_), "+v"(a2_), "+v"(a3_) : "v"(srcA), "v"(srcB))
template <int DQK, bool MASKED, bool QK8>
__device__ __forceinline__ void attn_item3(LAS unsigned char* lds, const AttnArgs& a, int b, int h, int qb) {
    constexpr int NKS = QK8 ? DQK / 64 : DQK / 16, PK = QK8 ? DQK : DQK * 2, PV = 64, KB_BYTES = 64 * PK, VB_BYTES = 128 * PV, NPK = PK / 16, NKP = (64 * NPK + 511) / 512, V_OFF = 3 * KB_BYTES;
    const int tid = opaque_tid(), lane = tid & 63, w = __builtin_amdgcn_readfirstlane(tid >> 6), n = lane & 31, hf = lane >> 5;
    const int nt = 4 * qb + 4, cw = 4 * qb + (w >> 1);
    const int trow = qb * 256 + w * 32 + n;
    const size_t grow = (size_t)b * SEQ + trow;
    bf16x8 qf[QK8 ? 1 : NKS]; i32x8q q8[QK8 ? NKS : 1];
    if (QK8) { const unsigned char* qp = (const unsigned char*)a.Q + grow * a.ldq + h * DQK + hf * 32;
#pragma unroll
      for (int ks = 0; ks < NKS; ++ks) { q8[ks].lo = *(const i32x4q*)(qp + ks * 64); q8[ks].hi = *(const i32x4q*)(qp + ks * 64 + 16); } }
    else { const bf16_t* qp = a.Q + grow * a.ldq + h * DQK + hf * 8;
#pragma unroll
      for (int ks = 0; ks < NKS; ++ks) qf[ks] = *(const bf16x8*)(qp + ks * 16); }
    f32x16 o[4];
#pragma unroll
    for (int dt = 0; dt < 4; ++dt)
#pragma unroll
        for (int r = 0; r < 16; ++r) o[dt][r] = 0.f;
    float m_run = -1000.0f, l_run = 0.f;
    const unsigned char* Kg = (const unsigned char*)a.K + ((size_t)b * SEQ * a.ldk + h * DQK) * (QK8 ? 1 : 2);
    const unsigned char* Vg = (const unsigned char*)a.VT + (size_t)(b * 8 + h) * 128 * SEQ;
    const unsigned long long* Mg = MASKED ? a.MT + (size_t)b * 256 * SEQ + trow : nullptr;
    const unsigned char* kp_[NKP]; const unsigned char* vp_;
#pragma unroll
    for (int i = 0; i < NKP; ++i) { const int s = (w + 8 * i) * 64 + lane, r = s / NPK, cp = s % NPK, cc = cp ^ (NPK == 16 ? (r & 15) : (NPK == 12 ? ((r >> 2) & 3) : ((r >> 1) & 7)));
        kp_[i] = Kg + ((size_t)r * a.ldk) * (QK8 ? 1 : 2) + cc * 16; asm volatile("" : "+v"(kp_[i])); }
    { const int s = w * 64 + lane, d = s >> 2, cp = s & 3, cc = cp ^ ((d >> 2) & 3); vp_ = Vg + (size_t)d * SEQ + cc * 16; asm volatile("" : "+v"(vp_)); }
    const size_t ktile_ = (size_t)64 * a.ldk * (QK8 ? 1 : 2);
    auto dma_k = [&](int kt) {
        LAS unsigned char* kb = lds + (kt % 3) * KB_BYTES;
#pragma unroll
        for (int i = 0; i < NKP; ++i) { if ((w + 8 * i) * 64 >= 64 * NPK) break;
            __builtin_amdgcn_global_load_lds((const unsigned*)(kp_[i] + (size_t)kt * ktile_), (LAS unsigned*)(kb + (w + 8 * i) * 1024), 16, 0, 0); }
    };
    auto dma_v = [&](int kt) {
        LAS unsigned char* vb = lds + V_OFF + (kt & 1) * VB_BYTES;
        __builtin_amdgcn_global_load_lds((const unsigned*)(vp_ + kt * 64), (LAS unsigned*)(vb + w * 1024), 16, 0, 0);
    };
    const int kswz = (NPK == 16) ? (n & 15) : (NPK == 12 ? ((n >> 2) & 3) : ((n >> 1) & 7)), vswz = (n >> 2) & 3;
    auto qk = [&](int kt, f32x16& s0, f32x16& s1, bool fence, float init, unsigned long long mw) {
        const LAS unsigned char* ka = lds + (kt % 3) * KB_BYTES + n * PK;
#pragma unroll
        for (int r = 0; r < 16; ++r) { if (!MASKED) { s0[r] = init; s1[r] = init; } }
        if (MASKED) {
            const unsigned lo = (unsigned)mw >> (4 * hf), hi = (unsigned)(mw >> 32) >> (4 * hf);
            const float nb = -16384.0f;
#pragma unroll
            for (int r = 0; r < 16; ++r) { int t0, t1; float a0_, a1_;
                asm("v_bfe_i32 %0, %1, %2, 1" : "=v"(t0) : "v"(lo), "n"((r & 3) + 8 * (r >> 2)));
                asm("v_bfe_i32 %0, %1, %2, 1" : "=v"(t1) : "v"(hi), "n"((r & 3) + 8 * (r >> 2)));
                asm("v_bfi_b32 %0, %1, %2, %3" : "=v"(a0_) : "v"(t0), "v"(init), "v"(nb));
                asm("v_bfi_b32 %0, %1, %2, %3" : "=v"(a1_) : "v"(t1), "v"(init), "v"(nb));
                s0[r] = a0_; s1[r] = a1_; }
        }
        if (QK8) {
#pragma unroll
            for (int ks = 0; ks < NKS; ++ks) {
                const int p0 = ((4 * ks + 2 * hf) ^ kswz) * 16, p1 = ((4 * ks + 2 * hf + 1) ^ kswz) * 16;
                i32x8q a0, a1;
                a0.lo = *(const LAS i32x4q*)(ka + p0); a0.hi = *(const LAS i32x4q*)(ka + p1);
                a1.lo = *(const LAS i32x4q*)(ka + 32 * PK + p0); a1.hi = *(const LAS i32x4q*)(ka + 32 * PK + p1);
                s0 = __builtin_amdgcn_mfma_scale_f32_32x32x64_f8f6f4(a0, q8[ks], s0, 0, 0, 0, 0x7F7F7F7F, 0, 0x7C7C7C7C);
                s1 = __builtin_amdgcn_mfma_scale_f32_32x32x64_f8f6f4(a1, q8[ks], s1, 0, 0, 0, 0x7F7F7F7F, 0, 0x7C7C7C7C);
                if (ks == NKS - 1 && fence) MFMA8_FENCE2(s0, s1, a0, a1);
            }
        } else {
#pragma unroll
            for (int ks = 0; ks < NKS; ++ks) {
                const int po = ((2 * ks + hf) ^ kswz) * 16;
                const bf16x8 a0 = *(const LAS bf16x8*)(ka + po), a1 = *(const LAS bf16x8*)(ka + 32 * PK + po);
                s0 = __builtin_amdgcn_mfma_f32_32x32x16_bf16(a0, qf[ks], s0, 0, 0, 0);
                s1 = __builtin_amdgcn_mfma_f32_32x32x16_bf16(a1, qf[ks], s1, 0, 0, 0);
            }
        }
    };
    auto rowmax = [&](f32x16& s0, f32x16& s1) -> float {
        float mx = max3_asm(s0[0], s1[0], s0[1]);
        mx = max3_asm(mx, s1[1], s0[2]);
#pragma unroll
        for (int r = 2; r < 15; ++r) mx = max3_asm(mx, s1[r], s0[r + 1]);
        mx = max3_asm(mx, s1[15], mx);
        const auto rr = __builtin_amdgcn_permlane32_swap(__float_as_uint(mx), __float_as_uint(mx), false, false);
        return fmaxf(__uint_as_float(rr[0]), __uint_as_float(rr[1]));
    };
    auto pv = [&](const f32x16& c0, const f32x16& c1, int kt, bool fence) {
        i32x8q pb;
#pragma unroll
        for (int i = 0; i < 4; ++i) { int d0 = 0, d1 = 0;
            d0 = __builtin_amdgcn_cvt_pk_fp8_f32(c0[4 * i], c0[4 * i + 1], d0, false); d0 = __builtin_amdgcn_cvt_pk_fp8_f32(c0[4 * i + 2], c0[4 * i + 3], d0, true);
            d1 = __builtin_amdgcn_cvt_pk_fp8_f32(c1[4 * i], c1[4 * i + 1], d1, false); d1 = __builtin_amdgcn_cvt_pk_fp8_f32(c1[4 * i + 2], c1[4 * i + 3], d1, true);
            pb[i] = d0; pb[4 + i] = d1; }
        const LAS unsigned char* va = lds + V_OFF + (kt & 1) * VB_BYTES + n * PV;
        const int q0_ = ((2 * hf) ^ vswz) * 16, q1_ = ((2 * hf + 1) ^ vswz) * 16;
#pragma unroll
        for (int dt = 0; dt < 4; ++dt) { i32x8q vf; vf.lo = *(const LAS i32x4q*)(va + dt * 32 * PV + q0_); vf.hi = *(const LAS i32x4q*)(va + dt * 32 * PV + q1_);
            o[dt] = __builtin_amdgcn_mfma_scale_f32_32x32x64_f8f6f4(vf, pb, o[dt], 0, 0, 0, 0x7F7F7F7F, 0, 0x79797979);
            if (dt == 3) MFMA8_FENCE4(o[0], o[1], o[2], o[3], vf, pb); }
    };
    dma_k(0); dma_v(0); if (nt > 1) dma_k(1);
    unsigned long long mw_pre = MASKED ? Mg[(size_t)(nt > 1 ? 1 : 0) * SEQ] : 0ull;
    asm volatile("s_waitcnt vmcnt(0)" ::: "memory");
    __syncthreads();
    f32x16 sa0, sa1, sb0, sb1;
    float ba = m_run, bb = m_run;
    qk(0, sa0, sa1, true, 6.0f - ba, MASKED ? Mg[0] : 0ull);
    float mx_cur = rowmax(sa0, sa1);
    auto step = [&](int kt, f32x16& c0, f32x16& c1, f32x16& n0, f32x16& n1, float& bc, float& bn, auto full_tag) {
        constexpr bool FULL = decltype(full_tag)::value;
        if (kt + 2 < nt) dma_k(kt + 2);
        if (kt + 1 < nt) dma_v(kt + 1);
        const unsigned long long mw_now = mw_pre;
        if (MASKED) mw_pre = Mg[(size_t)(kt + 2 < nt ? kt + 2 : kt) * SEQ];
        const bool act = FULL || kt <= cw, actn = FULL || kt + 1 <= cw;
        const float mx_abs = mx_cur + (bc - 6.0f);
        const bool grew = act && __any(mx_abs > m_run + 2.5f);
        const float m_new = grew ? fmaxf(m_run, mx_abs) : m_run;
        if (grew) {
            const float al = __builtin_amdgcn_exp2f(m_run - m_new), d = m_new - bc;
            l_run *= al;
#pragma unroll
            for (int dt = 0; dt < 4; ++dt)
#pragma unroll
                for (int r = 0; r < 16; ++r) o[dt][r] *= al;
#pragma unroll
            for (int r = 0; r < 16; ++r) { c0[r] -= d; c1[r] -= d; }
        }
        if (act) m_run = m_new;
        auto sm = [&]() {
            typedef float f32x2_ __attribute__((ext_vector_type(2)));
            f32x2_ ps2 = {0.f, 0.f};
#pragma unroll
            for (int r = 0; r < 16; r += 2) { c0[r] = __builtin_amdgcn_exp2f(c0[r]); c0[r + 1] = __builtin_amdgcn_exp2f(c0[r + 1]); c1[r] = __builtin_amdgcn_exp2f(c1[r]); c1[r + 1] = __builtin_amdgcn_exp2f(c1[r + 1]);
                ps2 += (f32x2_){c0[r], c0[r + 1]}; ps2 += (f32x2_){c1[r], c1[r + 1]}; }
            l_run += ps2.x + ps2.y;
        };
        if (FULL) {
            bn = m_run;
            qk(kt + 1, n0, n1, true, 6.0f - bn, mw_now);
            sm();
            pv(c0, c1, kt, true);
            mx_cur = rowmax(n0, n1);
        } else {
            if (actn) { bn = m_run; qk(kt + 1, n0, n1, true, 6.0f - bn, mw_now); }
            if (act) { sm(); pv(c0, c1, kt, true); }
            if (actn) mx_cur = rowmax(n0, n1);
        }
        asm volatile("s_waitcnt vmcnt(0)" ::: "memory");
        __syncthreads();
    };
    int kt = 0;
    for (; kt < 4 * qb; kt += 2) { step(kt, sa0, sa1, sb0, sb1, ba, bb, TTrue{}); step(kt + 1, sb0, sb1, sa0, sa1, bb, ba, TTrue{}); }
    for (; kt < nt; kt += 2) { step(kt, sa0, sa1, sb0, sb1, ba, bb, TFalse{}); step(kt + 1, sb0, sb1, sa0, sa1, bb, ba, TFalse{}); }
    const float lt = l_run + __shfl_xor(l_run, 32);
    const float inv = 64.0f / lt;
    bf16_t* op = a.O + grow * a.ldo + h * 128 + hf * 4;
#pragma unroll
    for (int dt = 0; dt < 4; ++dt)
#pragma unroll
        for (int r4 = 0; r4 < 4; ++r4) { u32x2 wv; wv.x = cvtpk(o[dt][4 * r4] * inv, o[dt][4 * r4 + 1] * inv); wv.y = cvtpk(o[dt][4 * r4 + 2] * inv, o[dt][4 * r4 + 3] * inv);
            *(u32x2*)(op + dt * 32 + r4 * 8) = wv; }
}
template <int DQK, bool MASKED>
__device__ __forceinline__ void attn_phase(LAS unsigned char* lds, const AttnArgs& a, int bid, int nblk) {
    if (MASKED) {
        const int t = opaque_tid();
        if (t < 256) { unsigned lo = 0u, hi = 0u;
#pragma unroll
            for (int i = 0; i < 4; ++i) { if (!((t >> i) & 1)) lo |= 0xFEu << (8 * i); if (!((t >> (4 + i)) & 1)) hi |= 0xFEu << (8 * i); }
            u32x2 v; v.x = lo; v.y = hi; ((LAS u32x2*)(lds + ATT_MTBL))[t] = v; }
        __syncthreads();
    }
    for (int p = bid; p < 512; p += nblk) {
        const int bh = (p & 7) + 8 * (p >> 8), j = (p >> 3) & 31;
#pragma unroll 1
        for (int i = 0; i < 2; ++i) attn_item3<DQK, MASKED, true>(lds, a, bh >> 3, bh & 7, i ? j : 63 - j);
    }
}

#ifdef IDX_PROBE_FINAL
#define IDX_PF_ 1
#else
#define IDX_PF_ 0
#endif
typedef _Float16 f16x8 __attribute__((ext_vector_type(8)));
struct IdxArgs { const unsigned short* QI; const unsigned short* KI16; const float* WI; unsigned long long* MT; };
static constexpr int IDX_CAP = 640, IDX_CS = 0, IDX_CI = 32 * IDX_CAP * 4, IDX_KT = IDX_CI + 32 * IDX_CAP * 2, IDX_CNT = IDX_KT + 32768, IDX_TAU = IDX_CNT + 128, IDX_LDS = IDX_TAU + 128;
static_assert(IDX_KT % 1024 == 0, "K tile buffers must be 1 KiB aligned");

__device__ __forceinline__ float ord_inv(unsigned T) { return __uint_as_float((T & 0x80000000u) ? (T & 0x7FFFFFFFu) : ~T); }
__device__ __forceinline__ unsigned lane_prefix(unsigned long long m) { return __builtin_amdgcn_mbcnt_hi((unsigned)(m >> 32), __builtin_amdgcn_mbcnt_lo((unsigned)m, 0u)); }
__device__ __forceinline__ float relu_asm(float x) { float y; asm("v_max_f32 %0, 0, %1" : "=v"(y) : "v"(x)); return y; }
__device__ __forceinline__ void glds16(const void* gsrc, unsigned lds_dst) {
    unsigned keep;
    asm volatile("s_mov_b32 %0, m0\n\ts_mov_b32 m0, %2\n\ts_nop 0\n\tglobal_load_lds_dwordx4 %1, off\n\ts_mov_b32 m0, %0" : "=&s"(keep) : "v"(gsrc), "s"(lds_dst) : "memory");
}

template <bool EXACT> __device__ __forceinline__ int idx_compact(LAS unsigned char* lds, int qq, int lane, int n, float& tau) {
    LAS float* cs = (LAS float*)(lds + IDX_CS) + qq * IDX_CAP; LAS unsigned short* ci = (LAS unsigned short*)(lds + IDX_CI) + qq * IDX_CAP;
    float sv[10]; unsigned short iv[10]; unsigned uk[10];
#pragma unroll
    for (int j = 0; j < 10; ++j) { const int idx = lane + 64 * j; const bool valid = idx < n; sv[j] = cs[idx]; iv[j] = ci[idx]; uk[j] = valid ? ord_key(sv[j]) : 0u; }
    auto count_ge = [&](unsigned t) { int c = 0;
#pragma unroll
        for (int j = 0; j < 10; ++j) c += __builtin_popcountll(__ballot(uk[j] >= t));
        return c; };
    unsigned lo = ord_key(tau), hi = 0xFF800001u;
    if (lo > 0x80800000u) { const unsigned h2 = lo + 0x00800000u;
        if (h2 < hi) { if (count_ge(h2) >= 256) lo = h2; else hi = h2; } }
    while (hi - lo > 1u) {
        const unsigned mid = lo + ((hi - lo) >> 1); const int c = count_ge(mid);
        if (c >= 256) { lo = mid; if (EXACT ? (c == 256) : (c <= 336)) break; } else hi = mid;
    }
    const unsigned T = lo;
    int need = 0;
    if (EXACT) { int ngt = 0;
#pragma unroll
        for (int j = 0; j < 10; ++j) ngt += __builtin_popcountll(__ballot(uk[j] > T));
        need = 256 - ngt; }
    int base = 0, tiebase = 0;
#pragma unroll
    for (int j = 0; j < 10; ++j) {
        bool keep;
        if (EXACT) { const bool gt = uk[j] > T, eq = uk[j] == T; const unsigned long long em = __ballot(eq); keep = gt || (eq && (tiebase + (int)lane_prefix(em)) < need); tiebase += __builtin_popcountll(em); }
        else keep = uk[j] >= T;
        const unsigned long long km = __ballot(keep);
        const int pos = base + (int)lane_prefix(km);
        if (keep) { cs[pos] = sv[j]; ci[pos] = iv[j]; }
        base += __builtin_popcountll(km);
    }
    tau = ord_inv(T);
    return base;
}

__device__ __forceinline__ void idx_item(LAS unsigned char* lds, const IdxArgs& a, int b, int hc) {
    const int tid = opaque_tid(), lane = tid & 63, w = __builtin_amdgcn_readfirstlane(tid >> 6), n = lane & 31, hf = lane >> 5;
    const int t0 = hc * 32, L = (t0 / 64 + 1) * 64, nsub = L / 32, ntile = (L + 127) / 128;
    const size_t q0 = (size_t)b * SEQ + t0 + 4 * w;
    LAS float* cs = (LAS float*)(lds + IDX_CS); LAS unsigned short* ci = (LAS unsigned short*)(lds + IDX_CI);
    LAS unsigned* cnt = (LAS unsigned*)(lds + IDX_CNT);
    f16x8 qf[2][4];
#pragma unroll
    for (int rt = 0; rt < 2; ++rt) { const unsigned short* qp = a.QI + (q0 + 2 * rt + (n >> 4)) * 1024 + (n & 15) * 64 + hf * 8;
#pragma unroll
        for (int ks = 0; ks < 4; ++ks) qf[rt][ks] = *(const f16x8*)(qp + ks * 16); }
    float wv[2][16];
#pragma unroll
    for (int rt = 0; rt < 2; ++rt)
#pragma unroll
        for (int r = 0; r < 16; ++r) wv[rt][r] = a.WI[(q0 + 2 * rt + (r >> 3)) * 16 + (((r & 3) + 8 * (r >> 2) + 4 * hf) & 15)] * (0.125f * 0.25f);
    if (tid < 32) cnt[tid] = 0u;
    int cq0 = 0, cq1 = 0, cq2 = 0, cq3 = 0;
    float tq0 = -INFINITY, tq1 = -INFINITY, tq2 = -INFINITY, tq3 = -INFINITY;
    float tau0 = INFINITY, tau1 = INFINITY;
    const unsigned short* Kg = a.KI16 + (size_t)b * SEQ * 64;
    const unsigned ldsbase = (unsigned)(size_t)lds;
    auto dma = [&](int kt, int buf) {
#pragma unroll
        for (int i = 0; i < 2; ++i) { const int s = (w + 8 * i) * 64 + lane, r = s >> 3, cp = s & 7, cc = cp ^ ((r >> 1) & 7);
            glds16(Kg + (size_t)(kt * 128 + r) * 64 + cc * 8, ldsbase + IDX_KT + buf * 16384 + (w + 8 * i) * 1024); }
    };
    dma(0, 0);
    asm volatile("s_waitcnt vmcnt(0)" ::: "memory");
    __syncthreads();
    const int kswz = (n >> 1) & 7;
    f32x16 accA[2], accB[2];
#pragma unroll
    for (int rt = 0; rt < 2; ++rt)
#pragma unroll
        for (int r = 0; r < 16; ++r) { accA[rt][r] = 0.f; accB[rt][r] = 0.f; }
    int keyA = 0, keyB = 0;
    auto epilogue = [&](const f32x16 (&acc)[2], int key) {
        float sc[2];
#pragma unroll
        for (int rt = 0; rt < 2; ++rt) { float pa = 0.f, pb = 0.f;
#pragma unroll
            for (int r = 0; r < 8; ++r) { pa = fmaf(relu_asm(acc[rt][r]), wv[rt][r], pa); pb = fmaf(relu_asm(acc[rt][r + 8]), wv[rt][r + 8], pb); }
            const auto rr = __builtin_amdgcn_permlane32_swap(__float_as_uint(pa), __float_as_uint(pb), false, false);
            sc[rt] = __uint_as_float(rr[0]) + __uint_as_float(rr[1]); }
        const bool c0 = sc[0] > tau0, c1 = sc[1] > tau1;
        const unsigned long long m0 = __ballot(c0), m1 = __ballot(c1);
        {
            const unsigned l0 = (unsigned)m0, h0 = (unsigned)(m0 >> 32), l1 = (unsigned)m1, h1 = (unsigned)(m1 >> 32);
            const int p0 = hf ? cq1 + (int)__builtin_amdgcn_mbcnt_hi(h0, 0u) : cq0 + (int)__builtin_amdgcn_mbcnt_lo(l0, 0u);
            const int p1 = hf ? cq3 + (int)__builtin_amdgcn_mbcnt_hi(h1, 0u) : cq2 + (int)__builtin_amdgcn_mbcnt_lo(l1, 0u);
            if (c0 && p0 < IDX_CAP) { const int qq = 4 * w + hf; cs[qq * IDX_CAP + p0] = sc[0]; ci[qq * IDX_CAP + p0] = (unsigned short)key; }
            if (c1 && p1 < IDX_CAP) { const int qq = 4 * w + 2 + hf; cs[qq * IDX_CAP + p1] = sc[1]; ci[qq * IDX_CAP + p1] = (unsigned short)key; }
            cq0 += __builtin_popcount(l0); cq1 += __builtin_popcount(h0); cq2 += __builtin_popcount(l1); cq3 += __builtin_popcount(h1);
        }
    };
    f16x8 kfA[4], kfB[4];
    auto ldk = [&](f16x8 (&kf)[4], const LAS unsigned char* kr) {
#pragma unroll
        for (int ks = 0; ks < 4; ++ks) kf[ks] = *(const LAS f16x8*)(kr + ((2 * ks + hf) ^ kswz) * 16);
    };
    auto mma = [&](f32x16 (&acc)[2], const f16x8 (&kf)[4]) {
#pragma unroll
        for (int rt = 0; rt < 2; ++rt) {
            f32x16 c;
#pragma unroll
            for (int r = 0; r < 16; ++r) c[r] = 0.f;
#pragma unroll
            for (int ks = 0; ks < 4; ++ks) c = __builtin_amdgcn_mfma_f32_32x32x16_f16(qf[rt][ks], kf[ks], c, 0, 0, 0);
            acc[rt] = c; }
    };
#ifdef IDX_PROBE2
  for (int rep_ = 0; rep_ < 2; ++rep_) {
    if (rep_ == 1) { epilogue(accB, keyB); tau0 = INFINITY; tau1 = INFINITY; __syncthreads(); dma(0, 0); asm volatile("s_waitcnt vmcnt(0)" ::: "memory"); __syncthreads(); }
#endif
    for (int kt = 0; kt < ntile; ++kt) {
        if (kt + 1 < ntile) dma(kt + 1, (kt + 1) & 1);
#ifdef IDX_PROBE2
        if (rep_ == 0)
#endif
        { const unsigned c_all = cnt[lane & 31];
          if (__ballot(c_all > (unsigned)(IDX_CAP - (kt == ntile - 1 ? 160 : 128)))) {
#pragma unroll 1
              for (int i = 0; i < 4; ++i) {
                  int cqi = (i == 0) ? cq0 : ((i == 1) ? cq1 : ((i == 2) ? cq2 : cq3));
                  if (cqi > 336) { float tqi = (i == 0) ? tq0 : ((i == 1) ? tq1 : ((i == 2) ? tq2 : tq3));
                      cqi = idx_compact<false>(lds, 4 * w + i, lane, cqi, tqi);
                      if (i == 0) { cq0 = cqi; tq0 = tqi; } else if (i == 1) { cq1 = cqi; tq1 = tqi; } else if (i == 2) { cq2 = cqi; tq2 = tqi; } else { cq3 = cqi; tq3 = tqi; } }
              }
              if (kt > 0) { tau0 = hf ? tq1 : tq0; tau1 = hf ? tq3 : tq2; }
          } }
        const LAS unsigned char* kb = lds + IDX_KT + (kt & 1) * 16384 + n * 128;
        const int sbase = kt * 4;
#ifdef IDX_PROBE2
        if (sbase + 0 < nsub) { ldk(kfA, kb); if (sbase + 1 < nsub) ldk(kfB, kb + 32 * 128); mma(accA, kfA); epilogue(accB, keyB); keyA = kt * 128 + n; if (kt == 0 && rep_ == 0) { tau0 = -INFINITY; tau1 = -INFINITY; } }
#else
        if (sbase + 0 < nsub) { ldk(kfA, kb); if (sbase + 1 < nsub) ldk(kfB, kb + 32 * 128); mma(accA, kfA); epilogue(accB, keyB); keyA = kt * 128 + n; if (kt == 0) { tau0 = -INFINITY; tau1 = -INFINITY; } }
#endif
        if (sbase + 1 < nsub) { if (sbase + 2 < nsub) ldk(kfA, kb + 64 * 128); mma(accB, kfB); epilogue(accA, keyA); keyB = kt * 128 + 32 + n; }
        if (sbase + 2 < nsub) { if (sbase + 3 < nsub) ldk(kfB, kb + 96 * 128); mma(accA, kfA); epilogue(accB, keyB); keyA = kt * 128 + 64 + n; }
        if (sbase + 3 < nsub) { mma(accB, kfB); epilogue(accA, keyA); keyB = kt * 128 + 96 + n; }
        if (lane < 4) cnt[4 * w + lane] = (unsigned)(lane == 0 ? cq0 : (lane == 1 ? cq1 : (lane == 2 ? cq2 : cq3)));
        asm volatile("s_waitcnt vmcnt(0)" ::: "memory");
        __syncthreads();
    }
#ifdef IDX_PROBE2
  }
#endif
    epilogue(accB, keyB);
    __syncthreads();
    const int lane2 = opaque_tid() & 63;
    LAS unsigned* bm = (LAS unsigned*)(lds + IDX_KT) + w * 512;
#ifdef IDX_PROBE_FINAL
  for (int rep2_ = 0; rep2_ < 2; ++rep2_) {
#endif
#pragma unroll 1
    for (int i = 0; i < 4; ++i) {
        const int qq = 4 * w + i;
        int nsel = (i == 0) ? cq0 : ((i == 1) ? cq1 : ((i == 2) ? cq2 : cq3));
        if (nsel > 256 - IDX_PF_) { float tqi = (i == 0) ? tq0 : ((i == 1) ? tq1 : ((i == 2) ? tq2 : tq3)); nsel = idx_compact<true>(lds, qq, lane2, nsel, tqi); }
#pragma unroll
        for (int j = 0; j < 8; ++j) bm[lane2 + 64 * j] = 0u;
#pragma unroll
        for (int j = 0; j < 4; ++j) { const int idx = lane2 + 64 * j; if (idx < nsel) { const unsigned k = ci[qq * IDX_CAP + idx]; (void)__hip_atomic_fetch_or(bm + (k >> 5), 1u << (k & 31), __ATOMIC_RELAXED, __HIP_MEMORY_SCOPE_WORKGROUP); } }
        const int tq = t0 + qq;
#pragma unroll 1
        for (int kt = lane2; kt < L / 64; kt += 64) { const unsigned long long v = (unsigned long long)bm[2 * kt] | ((unsigned long long)bm[2 * kt + 1] << 32); a.MT[((size_t)b * 256 + kt) * SEQ + tq] = v; }
    }
#ifdef IDX_PROBE_FINAL
  }
#endif
    __syncthreads();
}
__device__ __forceinline__ void idx_phase(LAS unsigned char* lds, const IdxArgs& a, int bid, int nblk) {
    for (int k = bid; k < 256; k += nblk) {
#pragma unroll 1
        for (int i = 0; i < 4; ++i) idx_item(lds, a, i & 1, (i < 2) ? 511 - k : k);
    }
}
#define XB_TMO      128
#define XB_XCNT(j)  (256  + 64 * (j))
#define XB_XSUB(j)  (1280 + 64 * (j))
#define XB_XGEN(j)  (2304 + 64 * (j))
#define XB_TOP      3328
#define XB_TOPGEN   3392
#define XCD_BAR_WORDS 3456
#define XB_SPIN_CAP (1u << 23)


__device__ __forceinline__ unsigned xb_ld(unsigned* p)              { return __hip_atomic_load(p, __ATOMIC_RELAXED, __HIP_MEMORY_SCOPE_AGENT); }
__device__ __forceinline__ unsigned xb_add(unsigned* p, unsigned v) { return __hip_atomic_fetch_add(p, v, __ATOMIC_RELAXED, __HIP_MEMORY_SCOPE_AGENT); }
__device__ __forceinline__ unsigned xb_xcc_id() { return (unsigned)__builtin_amdgcn_s_getreg((3 << 11) | 20) & 0xFu; }
#define XB_SPIN(cond, bar) do { unsigned _sp = 0; while (cond) { __builtin_amdgcn_s_sleep(1); \
    if ((++_sp & 255u) == 0u) { if (xb_ld(&(bar)[XB_TMO])) break; if (_sp > XB_SPIN_CAP) { atomicAdd(&(bar)[XB_TMO], 1u); break; } } } } while (0)

struct XcdBarrier {
    unsigned* bar; unsigned x;
    volatile LAS unsigned* st;
};

__device__ __forceinline__ XcdBarrier xcd_barrier_post(unsigned* bar, volatile LAS unsigned* st) {
    XcdBarrier b; b.bar = bar; b.x = xb_xcc_id(); b.st = st;
    if (threadIdx.x == 0) (void)xb_add(&bar[XB_XCNT(b.x)], 1u);
    return b;
}
__device__ __forceinline__ void xcd_barrier_complete(unsigned* bar, unsigned x, unsigned& nloc, unsigned& nx) {
    const unsigned G = gridDim.x * gridDim.y * gridDim.z;
    unsigned sum, cnt, mine, sp = 0u;
    for (;;) {
        sum = 0u; cnt = 0u; mine = 0u;
#pragma unroll
        for (unsigned j = 0; j < 16; ++j) { const unsigned c = xb_ld(&bar[XB_XCNT(j)]); sum += c; cnt += (c > 0u) ? 1u : 0u; mine = (j == x) ? c : mine; }
        if (sum == G) break;
        __builtin_amdgcn_s_sleep(1);
        if ((++sp & 255u) == 0u) { if (xb_ld(&bar[XB_TMO])) break; if (sp > XB_SPIN_CAP) { atomicAdd(&bar[XB_TMO], 1u); break; } }
    }
    nloc = mine > 0u ? mine : 1u; nx = cnt > 0u ? cnt : 1u;
}

__device__ __forceinline__ void xcd_barrier(const XcdBarrier& b) {
    asm volatile("s_waitcnt vmcnt(0)" ::: "memory");
    __syncthreads();
    if (threadIdx.x == 0) {
        unsigned* bar = b.bar;
        __builtin_amdgcn_s_waitcnt(0);
        unsigned nloc = b.st[0], nx = b.st[1];
        if (nloc == 0u) { xcd_barrier_complete(bar, b.x, nloc, nx); b.st[0] = nloc; b.st[1] = nx; }
        const unsigned old = xb_add(&bar[XB_XSUB(b.x)], 1u);
        const unsigned gen = old / nloc;
        if (old + 1u == (gen + 1u) * nloc) {
            __builtin_amdgcn_fence(__ATOMIC_RELEASE, "agent");
            asm volatile("s_waitcnt vmcnt(0)" ::: "memory");
            const unsigned og = xb_add(&bar[XB_TOP], 1u);
            const unsigned tg = og / nx;
            if (og + 1u == (tg + 1u) * nx) xb_add(&bar[XB_TOPGEN], 1u);
            else XB_SPIN(xb_ld(&bar[XB_TOPGEN]) == tg, bar);
            __builtin_amdgcn_fence(__ATOMIC_ACQUIRE, "agent");
            xb_add(&bar[XB_XGEN(b.x)], 1u);
            asm volatile("s_waitcnt vmcnt(0)" ::: "memory");
        } else {
            XB_SPIN(xb_ld(&bar[XB_XGEN(b.x)]) == gen, bar);
            __builtin_amdgcn_fence(__ATOMIC_ACQUIRE, "agent");
            asm volatile("s_waitcnt vmcnt(0)" ::: "memory");
        }
    }
    __syncthreads();
}

#ifndef FP8_QKV
#define FP8_QKV 1
#endif
#ifndef FP8_UP0
#define FP8_UP0 0
#endif
#ifndef FP8_UP1
#define FP8_UP1 1
#endif
#ifndef FP8_DN0
#define FP8_DN0 0
#endif
#ifndef FP8_DN1
#define FP8_DN1 1
#endif
#ifndef SKIPMASK
#define SKIPMASK 0
#endif

__device__ __forceinline__ int perm16(int t) { const int a = (t >> 2) & 3; return (t & ~12) | ((a == 1 ? 2 : (a == 2 ? 1 : a)) << 2); }
__device__ __forceinline__ void st_vt16(bf16_t* VT, int row, int h, int d, f32x4 v) {
    const int b = row / SEQ, t = row % SEQ; bf16_t* p = VT + ((size_t)(b * 8 + h) * 128 + d) * SEQ + (t & ~15) + perm16(t & 15);
    p[0] = f2bf(v[0]); p[SEQ] = f2bf(v[1]); p[2 * (size_t)SEQ] = f2bf(v[2]); p[3 * (size_t)SEQ] = f2bf(v[3]);
}
__device__ __forceinline__ int perm64(int kk) { const int sub = kk >> 5, k5 = kk & 31; return 32 * ((k5 >> 2) & 1) + 16 * sub + (((k5 >> 3) << 2) | (k5 & 3)); }
__device__ __forceinline__ void st_vt8(bf16_t* VT_, int row, int h, int d, f32x4 v) {
    const int b = row / SEQ, t = row % SEQ; unsigned char* p = (unsigned char*)VT_ + ((size_t)(b * 8 + h) * 128 + d) * SEQ + (t & ~63) + perm64(t & 63);
    const int pk0 = __builtin_amdgcn_cvt_pk_fp8_f32(v[0], v[1], 0, false), pk1 = __builtin_amdgcn_cvt_pk_fp8_f32(v[2], v[3], 0, false);
    p[0] = (unsigned char)(pk0 & 0xFF); p[SEQ] = (unsigned char)((pk0 >> 8) & 0xFF); p[2 * (size_t)SEQ] = (unsigned char)(pk1 & 0xFF); p[3 * (size_t)SEQ] = (unsigned char)((pk1 >> 8) & 0xFF);
}
__device__ __forceinline__ void st_fp8x4(unsigned char* p, f32x4 v) { int pk = 0; pk = __builtin_amdgcn_cvt_pk_fp8_f32(v[0], v[1], pk, false); pk = __builtin_amdgcn_cvt_pk_fp8_f32(v[2], v[3], pk, true); *(int*)p = pk; }
static constexpr float QS_DSA = 0.08838834764831845f * 1.4426950408889634f * 8.0f, QS_MLA = 0.07216878364870322f * 1.4426950408889634f * 8.0f;
struct FAbIn2 { unsigned char *Q, *K; bf16_t* VT; unsigned short* QI; float *U, *WI; unsigned short* KI16;
    __device__ __forceinline__ void operator()(int r, int c, f32x4 v) const {
        if (c < 1024) st_fp8x4(Q + (size_t)r * 1024 + c, v * QS_DSA);
        else if (c < 2048) st_fp8x4(K + (size_t)r * 1024 + (c - 1024), v);
        else if (c < 3072) { if (PV8_DSA) st_vt8(VT, r, (c - 2048) >> 7, (c - 2048) & 127, v); else st_vt16(VT, r, (c - 2048) >> 7, (c - 2048) & 127, v); }
        else if (c < 4096) { typedef _Float16 h2 __attribute__((ext_vector_type(2))); union { h2 h; unsigned u; } a, b; a.h = (h2){(_Float16)v[0], (_Float16)v[1]}; b.h = (h2){(_Float16)v[2], (_Float16)v[3]};
            u32x2 w; w.x = a.u; w.y = b.u; *(u32x2*)(QI + (size_t)r * 1024 + (c - 3072)) = w; }
        else if (c < 5120) st_f32x4(U + (size_t)r * 1024 + (c - 4096), v);
        else if (c < 5184) { typedef _Float16 h2 __attribute__((ext_vector_type(2))); union { h2 h; unsigned u; } a, b; a.h = (h2){(_Float16)v[0], (_Float16)v[1]}; b.h = (h2){(_Float16)v[2], (_Float16)v[3]};
            u32x2 w; w.x = a.u; w.y = b.u; *(u32x2*)(KI16 + (size_t)r * 64 + (c - 5120)) = w; }
        else if (c < 5200) st_f32x4(WI + (size_t)r * 16 + (c - 5184), v);
    }
    static __device__ __forceinline__ void st_fp8x8(unsigned char* p, f32x4 v0, f32x4 v1) { int p0 = 0, p1 = 0;
        p0 = __builtin_amdgcn_cvt_pk_fp8_f32(v0[0], v0[1], p0, false); p0 = __builtin_amdgcn_cvt_pk_fp8_f32(v0[2], v0[3], p0, true);
        p1 = __builtin_amdgcn_cvt_pk_fp8_f32(v1[0], v1[1], p1, false); p1 = __builtin_amdgcn_cvt_pk_fp8_f32(v1[2], v1[3], p1, true);
        u32x2 o; o.x = (unsigned)p0; o.y = (unsigned)p1; *(u32x2*)p = o; }
    static __device__ __forceinline__ void st_f16x8(unsigned short* p, f32x4 v0, f32x4 v1) { typedef _Float16 h2 __attribute__((ext_vector_type(2))); union { h2 h; unsigned u; } a, b, c2, d2;
        a.h = (h2){(_Float16)v0[0], (_Float16)v0[1]}; b.h = (h2){(_Float16)v0[2], (_Float16)v0[3]}; c2.h = (h2){(_Float16)v1[0], (_Float16)v1[1]}; d2.h = (h2){(_Float16)v1[2], (_Float16)v1[3]};
        u32x4 w; w.x = a.u; w.y = b.u; w.z = c2.u; w.w = d2.u; *(u32x4*)p = w; }
    __device__ __forceinline__ void st8(int r, int c, f32x4 v0, f32x4 v1) const {
        if (c < 1024) st_fp8x8(Q + (size_t)r * 1024 + c, v0 * QS_DSA, v1 * QS_DSA);
        else if (c < 2048) st_fp8x8(K + (size_t)r * 1024 + (c - 1024), v0, v1);
        else if (c < 3072) { (*this)(r, c, v0); (*this)(r, c + 4, v1); }
        else if (c < 4096) st_f16x8(QI + (size_t)r * 1024 + (c - 3072), v0, v1);
        else if (c < 5120) { float* p = U + (size_t)r * 1024 + (c - 4096); st_f32x4(p, v0); st_f32x4(p + 4, v1); }
        else if (c < 5184) st_f16x8(KI16 + (size_t)r * 64 + (c - 5120), v0, v1);
        else if (c < 5200) { float* p = WI + (size_t)r * 16 + (c - 5184); st_f32x4(p, v0); st_f32x4(p + 4, v1); }
    } };
struct FAbInHi { FAbIn2 f; __device__ __forceinline__ void operator()(int r, int c, f32x4 v) const { f(r, c + 3072, v); }
    __device__ __forceinline__ void st8(int r, int c, f32x4 v0, f32x4 v1) const { f.st8(r, c + 3072, v0, v1); } };
struct FKvUp2 { unsigned char* K8; bf16_t* VT;
    __device__ __forceinline__ void operator()(int r, int c, f32x4 v) const {
        const int h = c >> 8, d = c & 255;
        if (d < 128) { int pk = 0; pk = __builtin_amdgcn_cvt_pk_fp8_f32(v[0], v[1], pk, false); pk = __builtin_amdgcn_cvt_pk_fp8_f32(v[2], v[3], pk, true); *(int*)(K8 + (size_t)r * 1536 + h * 192 + d) = pk; }
        else { if (PV8_MLA) st_vt8(VT, r, h, d - 128, v); else st_vt16(VT, r, h, d - 128, v); }
    }
    __device__ __forceinline__ void st8(int r, int c, f32x4 v0, f32x4 v1) const {
        const int h = c >> 8, d = c & 255;
        if (d < 128) FAbIn2::st_fp8x8(K8 + (size_t)r * 1536 + h * 192 + d, v0, v1);
        else { (*this)(r, c, v0); (*this)(r, c + 4, v1); }
    } };

template <class E> __device__ __forceinline__ void ph_gemm_e(LAS unsigned char* lds, const bf16_t* A, int lda, const bf16_t* Bt, int ldb, int M, int N, int K, const E& e, int bid, int nblk, int a_shift = 0, int a_bytes = 0, int cmode = 0, int skew = 0) {
    pg8::Gemm g; g.A = A; g.Bt = Bt; g.M = M; g.N = N; g.K = K; g.lda = lda; g.ldb = ldb; g.a_shift = a_shift; g.a_bytes = a_bytes; g.cmode = cmode;
    pg8::StaticOrder S; S.init(M, N, nblk, bid); S.skew = skew;
    pg8::gemm_phase<E, pg8::StaticOrder, false>(lds, g, S, e, nullptr);
    __syncthreads();
}
template <class F> __device__ __forceinline__ void ph_gemm(LAS unsigned char* lds, const bf16_t* A, int lda, const bf16_t* Bt, int ldb, int M, int N, int K, const F& f, int bid, int nblk, int a_shift = 0, int a_bytes = 0) {
    EpiG<F> e; e.f = f;
    ph_gemm_e(lds, A, lda, Bt, ldb, M, N, K, e, bid, nblk, a_shift, a_bytes);
}
template <class F> __device__ __forceinline__ void ph_gemm8(LAS unsigned char* lds, const unsigned char* A, int lda, const unsigned char* Bt, int ldb, int M, int N, int K, const F& f, int bid, int nblk, int skew = 0) {
    EpiG<F, true> e; e.f = f;
    ph_gemm_e(lds, (const bf16_t*)A, lda / 2, (const bf16_t*)Bt, ldb / 2, M, N, K / 2, e, bid, nblk, 0, 0, 0, skew);
}
template <bool F8> struct EpiStore16 {
    static constexpr bool PERM = true, AFTER_DRAIN = false, FP8 = F8;
    bf16_t* O; int ldc;
    __device__ __forceinline__ void operator()(const f32x4 (&acc)[2][2][4][2], const pg8::Unit& u, int wr, int wc, int fr, int fq) const {
        const int row0 = u.pm * 256 + wr * 64 + fr, col0 = u.pn * 256 + wc * 32 + 8 * fq;
#pragma unroll
        for (int ai = 0; ai < 2; ++ai)
#pragma unroll
            for (int m = 0; m < 4; ++m)
#pragma unroll
                for (int bj = 0; bj < 2; ++bj) { const f32x4 v0 = acc[ai][bj][m][0], v1 = acc[ai][bj][m][1];
                    u32x4 o; o.x = pack2bf(v0[0], v0[1]); o.y = pack2bf(v0[2], v0[3]); o.z = pack2bf(v1[0], v1[1]); o.w = pack2bf(v1[2], v1[3]);
                    *(u32x4*)(O + (size_t)(row0 + ai * 128 + m * 16) * ldc + col0 + bj * 128) = o; }
    }
};
__device__ __forceinline__ void ph_gemm_st16(LAS unsigned char* lds, const bf16_t* A, int lda, const bf16_t* Bt, int ldb, int M, int N, int K, bf16_t* O, int ldc, int bid, int nblk) {
    EpiStore16<false> e; e.O = O; e.ldc = ldc; ph_gemm_e(lds, A, lda, Bt, ldb, M, N, K, e, bid, nblk);
}
__device__ __forceinline__ void ph_gemm8_st16(LAS unsigned char* lds, const unsigned char* A, int lda, const unsigned char* Bt, int ldb, int M, int N, int K, bf16_t* O, int ldc, int bid, int nblk) {
    EpiStore16<true> e; e.O = O; e.ldc = ldc; ph_gemm_e(lds, (const bf16_t*)A, lda / 2, (const bf16_t*)Bt, ldb / 2, M, N, K / 2, e, bid, nblk);
}
template <class F, bool F8 = false> struct EpiG8 {
    static constexpr bool PERM = true, AFTER_DRAIN = false, FP8 = F8;
    F f;
    __device__ __forceinline__ void operator()(const f32x4 (&acc)[2][2][4][2], const pg8::Unit& u, int wr, int wc, int fr, int fq) const {
        const int row0 = u.pm * 256 + wr * 64 + fr, col0 = u.pn * 256 + wc * 32 + 8 * fq;
#pragma unroll
        for (int ai = 0; ai < 2; ++ai)
#pragma unroll
            for (int m = 0; m < 4; ++m)
#pragma unroll
                for (int bj = 0; bj < 2; ++bj) f.st8(row0 + ai * 128 + m * 16, col0 + bj * 128, acc[ai][bj][m][0], acc[ai][bj][m][1]);
    }
};
template <class F> struct EpiGRow8 {
    static constexpr bool PERM = true, AFTER_DRAIN = false, FP8 = false;
    F f; const float* rs;
    __device__ __forceinline__ void operator()(const f32x4 (&acc)[2][2][4][2], const pg8::Unit& u, int wr, int wc, int fr, int fq) const {
        const int row0 = u.pm * 256 + wr * 64 + fr, col0 = u.pn * 256 + wc * 32 + 8 * fq;
        float s[2][4];
#pragma unroll
        for (int ai = 0; ai < 2; ++ai)
#pragma unroll
            for (int m = 0; m < 4; ++m) s[ai][m] = rs[row0 + ai * 128 + m * 16];
#pragma unroll
        for (int ai = 0; ai < 2; ++ai)
#pragma unroll
            for (int m = 0; m < 4; ++m)
#pragma unroll
                for (int bj = 0; bj < 2; ++bj) f.st8(row0 + ai * 128 + m * 16, col0 + bj * 128, acc[ai][bj][m][0] * s[ai][m], acc[ai][bj][m][1] * s[ai][m]);
    }
};
__device__ __forceinline__ void st_bf16x8(bf16_t* p, f32x4 v0, f32x4 v1) { u32x4 o; o.x = pack2bf(v0[0], v0[1]); o.y = pack2bf(v0[2], v0[3]); o.z = pack2bf(v1[0], v1[1]); o.w = pack2bf(v1[2], v1[3]); *(u32x4*)p = o; }
__device__ __forceinline__ void FCdIn::st8(int r, int c, f32x4 v0, f32x4 v1) const {
    if (c < 512) { float* p = CQ + (size_t)r * 512 + c; st_f32x4(p, v0); st_f32x4(p + 4, v1); }
    else if (c < 768) { float* p = CKV + (size_t)r * 256 + (c - 512); st_f32x4(p, v0); st_f32x4(p + 4, v1); }
    else if (c < 832) { float* p = KR + (size_t)r * 64 + (c - 768); st_f32x4(p, v0); st_f32x4(p + 4, v1); }
    else if (c < 1024) {}
    else if (c < 2048) st_bf16x8(XL + (size_t)r * 1024 + (c - 1024), v0, v1);
    else st_bf16x8(YG + (size_t)r * 1024 + (c - 2048), v0, v1);
}
template <int CTRL> __device__ __forceinline__ float dpp0(float v) { return __int_as_float(__builtin_amdgcn_update_dpp(0, __float_as_int(v), CTRL, 0xF, 0xF, true)); }
__device__ __forceinline__ float gelu_fast(float x) { const float u2 = 1.5957691216057308f * (x + 0.044715f * x * x * x); return x * __builtin_amdgcn_rcpf(1.0f + __builtin_amdgcn_exp2f(-1.4426950408889634f * u2)); }
template <bool OUT8, bool F8> struct EpiGate {
    static constexpr bool PERM = true, AFTER_DRAIN = false, FP8 = F8;
    const float* cw; const float* cb; void* ACT;
    __device__ __forceinline__ void operator()(const f32x4 (&acc)[2][2][4][2], const pg8::Unit& u, int wr, int wc, int fr, int fq) const {
        const int bt = u.pm / 67, ti = u.pm % 67;
        u32x2 hold_[2][4];
#pragma unroll
        for (int n = 0; n < 2; ++n) {
            const int c = u.pn * 128 + wc * 32 + 8 * fq + 4 * n;
            const f32x4 g0 = *(const f32x4*)(cw + c), g1 = *(const f32x4*)(cw + 8192 + c), g2 = *(const f32x4*)(cw + 16384 + c), gb = *(const f32x4*)(cb + c);
            const f32x4 v0 = *(const f32x4*)(cw + 4096 + c), v1 = *(const f32x4*)(cw + 8192 + 4096 + c), v2 = *(const f32x4*)(cw + 16384 + 4096 + c), vb = *(const f32x4*)(cb + 4096 + c);
            const float w1m = (fr < 1) ? 1.f : 0.f, w2m = (fr < 2) ? 1.f : 0.f;
            const f32x4 g1w = g1 * w1m, g0w = g0 * w2m, v1w = v1 * w1m, v0w = v0 * w2m;
#pragma unroll
            for (int ai = 0; ai < 2; ++ai) {
                const int strip = 2 * ai + wr, tbase = ti * 248 + strip * 62 - 2;
                f32x4 pg = {0.f, 0.f, 0.f, 0.f}, pv = pg;
#pragma unroll
                for (int m = 0; m < 4; ++m) {
                    f32x4 xg = acc[ai][0][m][n], xv = acc[ai][1][m][n];
                    const int t = tbase + 16 * m + fr;
                    if (tbase < 0 && m == 0) { if (t < 0) { xg = (f32x4){0.f, 0.f, 0.f, 0.f}; xv = xg; } }
                    f32x4 og, ov;
#pragma unroll
                    for (int j = 0; j < 4; ++j) {
                        float yg = fmaf(g2[j], xg[j], gb[j]), yv = fmaf(v2[j], xv[j], vb[j]);
                        asm("s_nop 1\n\t"
                            "v_fmac_f32_dpp %0, %2, %6 row_shr:1 row_mask:0xf bank_mask:0xf bound_ctrl:1\n\t"
                            "v_fmac_f32_dpp %1, %3, %10 row_shr:1 row_mask:0xf bank_mask:0xf bound_ctrl:1\n\t"
                            "v_fmac_f32_dpp %0, %2, %7 row_shr:2 row_mask:0xf bank_mask:0xf bound_ctrl:1\n\t"
                            "v_fmac_f32_dpp %1, %3, %11 row_shr:2 row_mask:0xf bank_mask:0xf bound_ctrl:1\n\t"
                            "v_fmac_f32_dpp %0, %4, %8 row_ror:1 row_mask:0xf bank_mask:0xf bound_ctrl:1\n\t"
                            "v_fmac_f32_dpp %1, %5, %12 row_ror:1 row_mask:0xf bank_mask:0xf bound_ctrl:1\n\t"
                            "v_fmac_f32_dpp %0, %4, %9 row_ror:2 row_mask:0xf bank_mask:0xf bound_ctrl:1\n\t"
                            "v_fmac_f32_dpp %1, %5, %13 row_ror:2 row_mask:0xf bank_mask:0xf bound_ctrl:1"
                            : "+v"(yg), "+v"(yv)
                            : "v"(xg[j]), "v"(xv[j]), "v"(pg[j]), "v"(pv[j]), "v"(g1[j]), "v"(g0[j]), "v"(g1w[j]), "v"(g0w[j]), "v"(v1[j]), "v"(v0[j]), "v"(v1w[j]), "v"(v0w[j]));
                        og[j] = gelu_fast(yg) * yv; ov[j] = 0.f;
                    }
                    pg = xg; pv = xv;
                    if (16 * m + fr >= 2 && t < SEQ) {
                        const size_t o = ((size_t)bt * SEQ + t) * 4096 + (c - 4 * n);
                        if (OUT8) { int pk = 0; pk = __builtin_amdgcn_cvt_pk_fp8_f32(og[0], og[1], pk, false); pk = __builtin_amdgcn_cvt_pk_fp8_f32(og[2], og[3], pk, true);
                            if (n == 0) hold_[ai][m].x = (unsigned)pk; else { u32x2 w8; w8.x = hold_[ai][m].x; w8.y = (unsigned)pk; *(u32x2*)((unsigned char*)ACT + o) = w8; } }
                        else { u32x2 w4; w4.x = pack2bf(og[0], og[1]); w4.y = pack2bf(og[2], og[3]);
                            if (n == 0) hold_[ai][m] = w4; else { u32x4 w8; w8.x = hold_[ai][m].x; w8.y = hold_[ai][m].y; w8.z = w4.x; w8.w = w4.y; *(u32x4*)((bf16_t*)ACT + o) = w8; } }
                    }
                }
            }
        }
    }
};
struct FPool { bf16_t* CC; const float* pb; const float* ps;
    __device__ __forceinline__ void operator()(int r, int c, f32x4 v) const { const f32x4 b = *(const f32x4*)(pb + c), s = *(const f32x4*)(ps + c); st_bf16x4(CC + (size_t)r * 2048 + 1024 + c, (v + b) * s); }
    __device__ __forceinline__ void st8(int r, int c, f32x4 v0, f32x4 v1) const { const f32x4 b0 = *(const f32x4*)(pb + c), b1 = *(const f32x4*)(pb + c + 4), s0 = *(const f32x4*)(ps + c), s1 = *(const f32x4*)(ps + c + 4);
        st_bf16x8(CC + (size_t)r * 2048 + 1024 + c, (v0 + b0) * s0, (v1 + b1) * s1); } };
__device__ __forceinline__ float one_minus_exp(float x) {
    const float p = -x * (1.0f + x * (0.5f + x * (0.16666667f + x * 0.041666668f))), d = 1.0f - __expf(x);
    return (x > -0.125f) ? p : d;
}
struct EpiLru {
    static constexpr bool PERM = false, AFTER_DRAIN = false, FP8 = false;
    const bf16_t* XCB; const float *ba, *bx, *lam; bf16_t *LA, *LB;
    __device__ __forceinline__ void operator()(const f32x4 (&acc)[2][2][4][2], const pg8::Unit& u, int wr, int wc, int fr, int fq) const {
        const int row0 = u.pm * 256 + wr * 64 + fr;
#pragma unroll
        for (int n = 0; n < 2; ++n) {
            const int ch = u.pn * 128 + wc * 32 + 16 * n + 4 * fq;
            const f32x4 bav = *(const f32x4*)(ba + ch), bxv = *(const f32x4*)(bx + ch), lm = *(const f32x4*)(lam + ch);
            f32x4 sp;
#pragma unroll
            for (int j = 0; j < 4; ++j) sp[j] = log1pf(__expf(-lm[j]));
#pragma unroll
            for (int ai = 0; ai < 2; ++ai)
#pragma unroll
                for (int m = 0; m < 4; ++m) {
                    const int row = row0 + ai * 128 + m * 16;
                    const u32x2 xw = *(const u32x2*)(XCB + (size_t)row * 1024 + ch);
                    const f32x4 xc = {__uint_as_float(xw.x << 16), __uint_as_float(xw.x & 0xFFFF0000u), __uint_as_float(xw.y << 16), __uint_as_float(xw.y & 0xFFFF0000u)};
                    const f32x4 ga = acc[ai][0][m][n] + bav, gx = acc[ai][1][m][n] + bxv;
                    f32x4 av, bv;
#pragma unroll
                    for (int j = 0; j < 4; ++j) {
                        const float rg = __builtin_amdgcn_rcpf(1.0f + __expf(-ga[j])), ig = __builtin_amdgcn_rcpf(1.0f + __expf(-gx[j]));
                        const float log_a = -8.0f * rg * sp[j];
                        av[j] = one_minus_exp(log_a); bv[j] = __builtin_amdgcn_sqrtf(one_minus_exp(2.0f * log_a)) * (ig * xc[j]);
                    }
                    st_bf16x4(LA + (size_t)row * 1024 + ch, av); st_bf16x4(LB + (size_t)row * 1024 + ch, bv);
                }
        }
    }
};
__device__ __forceinline__ void ph_pooled(const float* __restrict__ U, bf16_t* __restrict__ P, int bid, int nblk) {
    for (int i = bid * 512 + opaque_tid(); i < 256 * (NTOK / 64); i += nblk * 512) {
        const int c4 = i & 255, row0 = (i >> 8) * 64, t0 = row0 % SEQ, g = c4 >> 6, win = 2 << g;
        const f32x4* up = (const f32x4*)U + (size_t)row0 * 256 + c4;
        f32x4 s = {0.f, 0.f, 0.f, 0.f};
        if (t0 > 0) { for (int k = 1; k < win; ++k) s += up[-(ptrdiff_t)k * 256]; }
#pragma unroll 8
        for (int r = 0; r < 64; ++r) {
            const int t = t0 + r; const f32x4 u0 = up[(ptrdiff_t)r * 256];
            s += u0;
            const int cnt = (t + 1 < win) ? (t + 1) : win;
            st_bf16x4(P + (size_t)(row0 + r) * 1024 + c4 * 4, s * (1.0f / (float)cnt) - u0);
            if (t + 1 >= win) s -= up[(ptrdiff_t)(r + 1 - win) * 256];
        }
    }
}
__device__ __forceinline__ void ph_xc(const bf16_t* __restrict__ XL, const float* __restrict__ cw, const float* __restrict__ cb, bf16_t* __restrict__ XCB, int bid, int nblk) {
    for (int i = bid * 512 + opaque_tid(); i < 128 * (NTOK / 32); i += nblk * 512) {
        const int c8 = (i & 127) * 8, row0 = (i >> 7) * 32, t0 = row0 % SEQ;
        float w0[8], w1[8], w2[8], w3[8], bb[8];
#pragma unroll
        for (int j = 0; j < 8; ++j) { w0[j] = cw[c8 + j]; w1[j] = cw[1024 + c8 + j]; w2[j] = cw[2048 + c8 + j]; w3[j] = cw[3072 + c8 + j]; bb[j] = cb[c8 + j]; }
        u32x4 p3 = {0u, 0u, 0u, 0u}, p2 = p3, p1 = p3;
        if (t0 >= 3) { p3 = *(const u32x4*)(XL + (size_t)(row0 - 3) * 1024 + c8); p2 = *(const u32x4*)(XL + (size_t)(row0 - 2) * 1024 + c8); p1 = *(const u32x4*)(XL + (size_t)(row0 - 1) * 1024 + c8); }
#pragma unroll 8
        for (int r = 0; r < 32; ++r) {
            const u32x4 cur = *(const u32x4*)(XL + (size_t)(row0 + r) * 1024 + c8);
            const unsigned a3[4] = {p3.x, p3.y, p3.z, p3.w}, a2[4] = {p2.x, p2.y, p2.z, p2.w}, a1[4] = {p1.x, p1.y, p1.z, p1.w}, a0[4] = {cur.x, cur.y, cur.z, cur.w};
            float y[8];
#pragma unroll
            for (int j = 0; j < 4; ++j) {
                y[2 * j] = bb[2 * j] + w0[2 * j] * __uint_as_float(a3[j] << 16) + w1[2 * j] * __uint_as_float(a2[j] << 16) + w2[2 * j] * __uint_as_float(a1[j] << 16) + w3[2 * j] * __uint_as_float(a0[j] << 16);
                y[2 * j + 1] = bb[2 * j + 1] + w0[2 * j + 1] * __uint_as_float(a3[j] & 0xFFFF0000u) + w1[2 * j + 1] * __uint_as_float(a2[j] & 0xFFFF0000u) + w2[2 * j + 1] * __uint_as_float(a1[j] & 0xFFFF0000u) + w3[2 * j + 1] * __uint_as_float(a0[j] & 0xFFFF0000u); }
            u32x4 o; o.x = pack2bf(y[0], y[1]); o.y = pack2bf(y[2], y[3]); o.z = pack2bf(y[4], y[5]); o.w = pack2bf(y[6], y[7]);
            *(u32x4*)(XCB + (size_t)(row0 + r) * 1024 + c8) = o;
            p3 = p2; p2 = p1; p1 = cur;
        }
    }
}
__device__ __forceinline__ int up_src_col(int n0) { return ((n0 >> 7) & 1) * 4096 + (n0 >> 8) * 128 + (n0 & 127); }
template <bool OUT8>
__device__ __forceinline__ void ph_convT_g(LAS unsigned char* lds, const float* __restrict__ W, int ldw, int src_col0, int ncols, int K, void* __restrict__ Bt, int ldd, int bid, int nblk, bool upperm, const float* __restrict__ gk = nullptr) {
    const int tid = opaque_tid(), sub = tid >> 8, t8 = tid & 255;
    LAS float* tile = (LAS float*)lds + sub * (2 * 64 * 65);
    const int ntx = (ncols + 63) / 64, ntiles = ntx * (K / 64);
    for (int base = bid * 4; base < ntiles; base += nblk * 4) {
#pragma unroll
        for (int u = 0; u < 2; ++u) {
            const int tl = base + sub * 2 + u; const bool act = tl < ntiles;
            const int n0 = (tl % ntx) * 64, k0 = (tl / ntx) * 64;
            if (act) {
                const int c4 = (t8 & 15) * 4, kr = t8 >> 4;
                const int nsrc = src_col0 + (upperm ? up_src_col(n0 + c4) : n0 + c4);
                f32x4 v[4];
#pragma unroll
                for (int i = 0; i < 4; ++i) { v[i] = (f32x4){0.f, 0.f, 0.f, 0.f}; if (n0 + c4 < ncols) v[i] = *(const f32x4*)(W + (size_t)(k0 + kr + 16 * i) * ldw + nsrc); if (gk) v[i] = v[i] * gk[k0 + kr + 16 * i]; }
#pragma unroll
                for (int i = 0; i < 4; ++i) { const int kl = kr + 16 * i; LAS float* tp = tile + u * (64 * 65) + kl * 65 + c4; tp[0] = v[i][0]; tp[1] = v[i][1]; tp[2] = v[i][2]; tp[3] = v[i][3]; } }
        }
        __syncthreads();
#pragma unroll
        for (int u = 0; u < 2; ++u) {
            const int tl = base + sub * 2 + u; const bool act = tl < ntiles;
            const int n0 = (tl % ntx) * 64, k0 = (tl / ntx) * 64;
            if (act) {
                const int k8 = (t8 & 7) * 8, nr = t8 >> 3;
#pragma unroll
                for (int i = 0; i < 2; ++i) { const int nl = nr + 32 * i;
                    if (n0 + nl < ncols) {
                        float v[8];
#pragma unroll
                        for (int j = 0; j < 8; ++j) v[j] = tile[u * (64 * 65) + (k8 + j) * 65 + nl];
                        if (OUT8) { int p0 = 0, p1 = 0;
                            p0 = __builtin_amdgcn_cvt_pk_fp8_f32(64.f * v[0], 64.f * v[1], p0, false); p0 = __builtin_amdgcn_cvt_pk_fp8_f32(64.f * v[2], 64.f * v[3], p0, true);
                            p1 = __builtin_amdgcn_cvt_pk_fp8_f32(64.f * v[4], 64.f * v[5], p1, false); p1 = __builtin_amdgcn_cvt_pk_fp8_f32(64.f * v[6], 64.f * v[7], p1, true);
                            u32x2 o; o.x = (unsigned)p0; o.y = (unsigned)p1; *(u32x2*)((unsigned char*)Bt + (size_t)(n0 + nl) * ldd + k0 + k8) = o; }
                        else { u32x4 o; o.x = pack2bf(v[0], v[1]); o.y = pack2bf(v[2], v[3]); o.z = pack2bf(v[4], v[5]); o.w = pack2bf(v[6], v[7]);
                            *(u32x4*)((bf16_t*)Bt + (size_t)(n0 + nl) * ldd + k0 + k8) = o; }
                    } } }
        }
        __syncthreads();
    }
}
__device__ __forceinline__ void ph_convT(LAS unsigned char* lds, const float* __restrict__ W, int ldw, int src_col0, int ncols, int K, bf16_t* __restrict__ Bt, int ldd, int bid, int nblk, bool upperm = false, const float* __restrict__ gk = nullptr) {
    ph_convT_g<false>(lds, W, ldw, src_col0, ncols, K, Bt, ldd, bid, nblk, upperm, gk);
}
__device__ __forceinline__ void ph_convT8(LAS unsigned char* lds, const float* __restrict__ W, int ldw, int ncols, int K, unsigned char* __restrict__ Bt, int bid, int nblk, bool upperm = false) {
    ph_convT_g<true>(lds, W, ldw, 0, ncols, K, Bt, K, bid, nblk, upperm);
}
template <int NC> __device__ __forceinline__ void ph_rmsnorm(const float* __restrict__ x, const float* __restrict__ g, bf16_t* __restrict__ out, int bid, int nblk, unsigned char* __restrict__ out8 = nullptr) {
    const int lane = opaque_tid() & 63, w = opaque_tid() >> 6;
    constexpr int NV = NC / 256;
    for (int row = bid * 8 + w; row < NTOK; row += nblk * 8) {
        const f32x4* xr = (const f32x4*)(x + (size_t)row * NC);
        f32x4 v[NV]; float ss = 0.f;
#pragma unroll
        for (int i = 0; i < NV; ++i) { v[i] = xr[lane + 64 * i]; ss += v[i][0] * v[i][0] + v[i][1] * v[i][1] + v[i][2] * v[i][2] + v[i][3] * v[i][3]; }
        ss = wave_sum(ss);
        const float r = rsqrtf(ss * (1.0f / NC) + NORM_EPS);
#pragma unroll
        for (int i = 0; i < NV; ++i) { const f32x4 gg = ((const f32x4*)g)[lane + 64 * i]; const f32x4 y = v[i] * r * gg; st_bf16x4(out + (size_t)row * NC + 4 * (lane + 64 * i), y);
            if (out8) { int pk = 0; pk = __builtin_amdgcn_cvt_pk_fp8_f32(y[0], y[1], pk, false); pk = __builtin_amdgcn_cvt_pk_fp8_f32(y[2], y[3], pk, true); *(int*)(out8 + (size_t)row * NC + 4 * (lane + 64 * i)) = pk; } }
    }
}
template <bool IN16, bool OUT16>
__device__ __forceinline__ void ph_resnorm(const void* xin, const bf16_t* __restrict__ m, const float* __restrict__ gpost, const float* __restrict__ gpre, void* xout, bf16_t* __restrict__ h, unsigned char* __restrict__ h8, int bid, int nblk, float* __restrict__ r2out = nullptr) {
    const int tid_ = opaque_tid(), lane = tid_ & 63, w = tid_ >> 6;
    for (int row = bid * 8 + w; row < NTOK; row += nblk * 8) {
        const u32x2* mr = (const u32x2*)(m + (size_t)row * DM);
        f32x4 mv[8], xv[8]; float ss = 0.f;
#pragma unroll
        for (int i = 0; i < 8; ++i) { const u32x2 wd = mr[lane + 64 * i]; mv[i][0] = __uint_as_float(wd.x << 16); mv[i][1] = __uint_as_float(wd.x & 0xFFFF0000u); mv[i][2] = __uint_as_float(wd.y << 16); mv[i][3] = __uint_as_float(wd.y & 0xFFFF0000u);
            if (IN16) { const u32x2 xw = ((const u32x2*)((const bf16_t*)xin + (size_t)row * DM))[lane + 64 * i];
                xv[i][0] = __uint_as_float(xw.x << 16); xv[i][1] = __uint_as_float(xw.x & 0xFFFF0000u); xv[i][2] = __uint_as_float(xw.y << 16); xv[i][3] = __uint_as_float(xw.y & 0xFFFF0000u); }
            else xv[i] = ((const f32x4*)((const float*)xin + (size_t)row * DM))[lane + 64 * i];
            ss += mv[i][0] * mv[i][0] + mv[i][1] * mv[i][1] + mv[i][2] * mv[i][2] + mv[i][3] * mv[i][3]; }
        ss = wave_sum(ss);
        const float r1 = rsqrtf(ss * (1.0f / DM) + NORM_EPS);
        float s2 = 0.f;
#pragma unroll
        for (int i = 0; i < 8; ++i) { const f32x4 gg = ((const f32x4*)gpost)[lane + 64 * i]; xv[i] = xv[i] + mv[i] * r1 * gg;
            if (OUT16) st_bf16x4((bf16_t*)xout + (size_t)row * DM + 4 * (lane + 64 * i), xv[i]); else ((f32x4*)((float*)xout + (size_t)row * DM))[lane + 64 * i] = xv[i];
            s2 += xv[i][0] * xv[i][0] + xv[i][1] * xv[i][1] + xv[i][2] * xv[i][2] + xv[i][3] * xv[i][3]; }
        if (gpre) {
            s2 = wave_sum(s2);
            const float r2 = rsqrtf(s2 * (1.0f / DM) + NORM_EPS);
            if (r2out) { if (lane == 0) r2out[row] = r2; continue; }
#pragma unroll
            for (int i = 0; i < 8; ++i) { const f32x4 gg = ((const f32x4*)gpre)[lane + 64 * i]; const f32x4 y = xv[i] * r2 * gg;
                if (h8) { int pk = 0; pk = __builtin_amdgcn_cvt_pk_fp8_f32(y[0], y[1], pk, false); pk = __builtin_amdgcn_cvt_pk_fp8_f32(y[2], y[3], pk, true); *(int*)(h8 + (size_t)row * DM + 4 * (lane + 64 * i)) = pk; }
                else st_bf16x4(h + (size_t)row * DM + 4 * (lane + 64 * i), y); }
        }
    }
}
__device__ __forceinline__ f32x4 bf4_to_f32(u32x2 w) { f32x4 r; r[0] = __uint_as_float(w.x << 16); r[1] = __uint_as_float(w.x & 0xFFFF0000u); r[2] = __uint_as_float(w.y << 16); r[3] = __uint_as_float(w.y & 0xFFFF0000u); return r; }
__device__ __forceinline__ void ph_scan1(const bf16_t* __restrict__ Aa, const bf16_t* __restrict__ Bb, float* __restrict__ CA, float* __restrict__ CH, int bid, int nblk) {
    for (int i = bid * 512 + opaque_tid(); i < 2 * 256 * 256; i += nblk * 512) {
        const int c4 = i & 255, chunk = (i >> 8) & 255, b = i >> 16;
        const size_t base = ((size_t)b * SEQ + (size_t)chunk * 64) * 1024 + 4 * c4;
        f32x4 h = {0.f, 0.f, 0.f, 0.f}, P = {1.f, 1.f, 1.f, 1.f};
#pragma unroll 8
        for (int s = 0; s < 64; ++s) { const f32x4 a = 1.0f - bf4_to_f32(*(const u32x2*)(Aa + base + (size_t)s * 1024)); h = a * h + bf4_to_f32(*(const u32x2*)(Bb + base + (size_t)s * 1024)); P *= a; }
        ((f32x4*)CA)[i] = P; ((f32x4*)CH)[i] = h;
    }
}
__device__ __forceinline__ void ph_scan2(const float* __restrict__ CA, const float* __restrict__ CH, float* __restrict__ CIN, int bid, int nblk) {
    const int tid = opaque_tid(), lane = tid & 63;
    for (int wv = bid * 8 + (tid >> 6); wv < 512; wv += nblk * 8) {
        const int b = wv >> 8, ch = (wv & 255) * 4 + (lane & 3), part = lane >> 2;
        const size_t j0 = ((size_t)b * 256 + part * 16) * 1024 + ch;
        float ca[16], chv[16];
#pragma unroll
        for (int k = 0; k < 16; ++k) { ca[k] = CA[j0 + (size_t)k * 1024]; chv[k] = CH[j0 + (size_t)k * 1024]; }
        float A = 1.f, H = 0.f;
#pragma unroll
        for (int k = 0; k < 16; ++k) { H = ca[k] * H + chv[k]; A *= ca[k]; }
#pragma unroll
        for (int d = 1; d < 16; d <<= 1) {
            const float Ap = __shfl_up(A, 4 * d), Hp = __shfl_up(H, 4 * d);
            if (part >= d) { H = A * Hp + H; A = A * Ap; }
        }
        float h = __shfl_up(H, 4); if (part == 0) h = 0.f;
#pragma unroll
        for (int k = 0; k < 16; ++k) { CIN[j0 + (size_t)k * 1024] = h; h = ca[k] * h + chv[k]; }
    }
}
__device__ __forceinline__ void ph_scan3(const bf16_t* __restrict__ Aa, const bf16_t* __restrict__ Bb, const float* __restrict__ CIN, const bf16_t* __restrict__ YG, bf16_t* __restrict__ CC, int bid, int nblk) {
    for (int i = bid * 512 + opaque_tid(); i < 2 * 256 * 256; i += nblk * 512) {
        const int c4 = i & 255, chunk = (i >> 8) & 255, b = i >> 16;
        const size_t row0 = (size_t)b * SEQ + (size_t)chunk * 64;
        f32x4 h = ((const f32x4*)CIN)[i];
#pragma unroll 8
        for (int s = 0; s < 64; ++s) { const size_t r = row0 + s;
            h = (1.0f - bf4_to_f32(*(const u32x2*)(Aa + r * 1024 + 4 * c4))) * h + bf4_to_f32(*(const u32x2*)(Bb + r * 1024 + 4 * c4));
            const f32x4 g = bf4_to_f32(*(const u32x2*)(YG + r * 1024 + 4 * c4));
            f32x4 o; o[0] = h[0] * gelu_tanh(g[0]); o[1] = h[1] * gelu_tanh(g[1]); o[2] = h[2] * gelu_tanh(g[2]); o[3] = h[3] * gelu_tanh(g[3]);
            st_bf16x4(CC + r * 2048 + 1024 + 4 * c4, o); }
    }
}
__device__ __forceinline__ void ph_rope_q(const bf16_t* __restrict__ Q1, const int* __restrict__ pos, unsigned char* __restrict__ Q8, int bid, int nblk) {
    for (int idx = bid * 512 + opaque_tid(); idx < NTOK * 8 * 4; idx += nblk * 512) {
        const int g = idx & 3, h = (idx >> 2) & 7, row = idx >> 5;
        const bf16_t* p = Q1 + (size_t)row * 1536 + h * 192; unsigned char* q = Q8 + (size_t)row * 1536 + h * 192;
#pragma unroll
        for (int k = 0; k < 4; ++k) { const u32x4 w = *(const u32x4*)(p + 32 * g + 8 * k);
            int p0 = 0, p1 = 0;
            p0 = __builtin_amdgcn_cvt_pk_fp8_f32(QS_MLA * __uint_as_float(w.x << 16), QS_MLA * __uint_as_float(w.x & 0xFFFF0000u), p0, false); p0 = __builtin_amdgcn_cvt_pk_fp8_f32(QS_MLA * __uint_as_float(w.y << 16), QS_MLA * __uint_as_float(w.y & 0xFFFF0000u), p0, true);
            p1 = __builtin_amdgcn_cvt_pk_fp8_f32(QS_MLA * __uint_as_float(w.z << 16), QS_MLA * __uint_as_float(w.z & 0xFFFF0000u), p1, false); p1 = __builtin_amdgcn_cvt_pk_fp8_f32(QS_MLA * __uint_as_float(w.w << 16), QS_MLA * __uint_as_float(w.w & 0xFFFF0000u), p1, true);
            u32x2 o; o.x = (unsigned)p0; o.y = (unsigned)p1; *(u32x2*)(q + 32 * g + 8 * k) = o; }
        const u32x4 w1 = *(const u32x4*)(p + 128 + 8 * g), w2 = *(const u32x4*)(p + 160 + 8 * g);
        const unsigned a1[4] = {w1.x, w1.y, w1.z, w1.w}, a2[4] = {w2.x, w2.y, w2.z, w2.w};
        float o1[8], o2[8]; const int ps = pos[row];
#pragma unroll
        for (int j = 0; j < 8; ++j) { float cs, sn; rope_cs(ps, 8 * g + j, cs, sn);
            const float x1 = (j & 1) ? __uint_as_float(a1[j >> 1] & 0xFFFF0000u) : __uint_as_float(a1[j >> 1] << 16), x2 = (j & 1) ? __uint_as_float(a2[j >> 1] & 0xFFFF0000u) : __uint_as_float(a2[j >> 1] << 16);
            o1[j] = QS_MLA * (x1 * cs - x2 * sn); o2[j] = QS_MLA * (x2 * cs + x1 * sn); }
        int p0 = 0, p1 = 0, p2 = 0, p3 = 0;
        p0 = __builtin_amdgcn_cvt_pk_fp8_f32(o1[0], o1[1], p0, false); p0 = __builtin_amdgcn_cvt_pk_fp8_f32(o1[2], o1[3], p0, true); p1 = __builtin_amdgcn_cvt_pk_fp8_f32(o1[4], o1[5], p1, false); p1 = __builtin_amdgcn_cvt_pk_fp8_f32(o1[6], o1[7], p1, true);
        p2 = __builtin_amdgcn_cvt_pk_fp8_f32(o2[0], o2[1], p2, false); p2 = __builtin_amdgcn_cvt_pk_fp8_f32(o2[2], o2[3], p2, true); p3 = __builtin_amdgcn_cvt_pk_fp8_f32(o2[4], o2[5], p3, false); p3 = __builtin_amdgcn_cvt_pk_fp8_f32(o2[6], o2[7], p3, true);
        u32x2 oa; oa.x = (unsigned)p0; oa.y = (unsigned)p1; *(u32x2*)(q + 128 + 8 * g) = oa;
        u32x2 ob; ob.x = (unsigned)p2; ob.y = (unsigned)p3; *(u32x2*)(q + 160 + 8 * g) = ob;
    }
}
__device__ __forceinline__ void ph_rope_k(const float* __restrict__ KR, const int* __restrict__ pos, unsigned char* __restrict__ K8, int bid, int nblk) {
    for (int idx = bid * 512 + opaque_tid(); idx < NTOK * 8; idx += nblk * 512) {
        const int i4 = (idx & 7) * 4, row = idx >> 3; const int ps = pos[row];
        const f32x4 x1 = *(const f32x4*)(KR + (size_t)row * 64 + i4), x2 = *(const f32x4*)(KR + (size_t)row * 64 + 32 + i4);
        float a[4], b[4];
#pragma unroll
        for (int j = 0; j < 4; ++j) { float c, s; rope_cs(ps, i4 + j, c, s); a[j] = x1[j] * c - x2[j] * s; b[j] = x2[j] * c + x1[j] * s; }
        int p1 = 0, p2 = 0;
        p1 = __builtin_amdgcn_cvt_pk_fp8_f32(a[0], a[1], p1, false); p1 = __builtin_amdgcn_cvt_pk_fp8_f32(a[2], a[3], p1, true);
        p2 = __builtin_amdgcn_cvt_pk_fp8_f32(b[0], b[1], p2, false); p2 = __builtin_amdgcn_cvt_pk_fp8_f32(b[2], b[3], p2, true);
#pragma unroll
        for (int h = 0; h < 8; ++h) { unsigned char* p = K8 + (size_t)row * 1536 + h * 192 + 128; *(int*)(p + i4) = p1; *(int*)(p + 32 + i4) = p2; }
    }
}
template <bool OUT8> __device__ __forceinline__ void ph_ffn_gate(const bf16_t* __restrict__ HID, const float* __restrict__ cw, const float* __restrict__ cb, bf16_t* __restrict__ ACT, int bid, int nblk) {
    for (int i = bid * 512 + opaque_tid(); i < 512 * (SEQ / 64); i += nblk * 512) {
        const int c8 = (i & 511) * 8, t0 = (i >> 9) * 64;
        float wg[3][8], wv[3][8], bg[8], bv[8];
#pragma unroll
        for (int j = 0; j < 8; ++j) { bg[j] = cb[c8 + j]; bv[j] = cb[4096 + c8 + j];
#pragma unroll
            for (int k = 0; k < 3; ++k) { wg[k][j] = cw[k * 8192 + c8 + j]; wv[k][j] = cw[k * 8192 + 4096 + c8 + j]; } }
        u32x4 g2 = {0u, 0u, 0u, 0u}, g1 = g2, v2 = g2, v1 = g2;
        if (t0 >= 2) { g2 = *(const u32x4*)(HID + (size_t)(t0 - 2) * 8192 + c8); g1 = *(const u32x4*)(HID + (size_t)(t0 - 1) * 8192 + c8);
                       v2 = *(const u32x4*)(HID + (size_t)(t0 - 2) * 8192 + 4096 + c8); v1 = *(const u32x4*)(HID + (size_t)(t0 - 1) * 8192 + 4096 + c8); }
#pragma unroll 8
        for (int r = 0; r < 64; ++r) {
            const u32x4 g0 = *(const u32x4*)(HID + (size_t)(t0 + r) * 8192 + c8), v0 = *(const u32x4*)(HID + (size_t)(t0 + r) * 8192 + 4096 + c8);
            const unsigned G2[4] = {g2.x, g2.y, g2.z, g2.w}, G1[4] = {g1.x, g1.y, g1.z, g1.w}, G0[4] = {g0.x, g0.y, g0.z, g0.w};
            const unsigned V2[4] = {v2.x, v2.y, v2.z, v2.w}, V1[4] = {v1.x, v1.y, v1.z, v1.w}, V0[4] = {v0.x, v0.y, v0.z, v0.w};
            float o[8];
#pragma unroll
            for (int j = 0; j < 4; ++j) {
                const float ge = bg[2 * j] + wg[0][2 * j] * __uint_as_float(G2[j] << 16) + wg[1][2 * j] * __uint_as_float(G1[j] << 16) + wg[2][2 * j] * __uint_as_float(G0[j] << 16);
                const float go = bg[2 * j + 1] + wg[0][2 * j + 1] * __uint_as_float(G2[j] & 0xFFFF0000u) + wg[1][2 * j + 1] * __uint_as_float(G1[j] & 0xFFFF0000u) + wg[2][2 * j + 1] * __uint_as_float(G0[j] & 0xFFFF0000u);
                const float ve = bv[2 * j] + wv[0][2 * j] * __uint_as_float(V2[j] << 16) + wv[1][2 * j] * __uint_as_float(V1[j] << 16) + wv[2][2 * j] * __uint_as_float(V0[j] << 16);
                const float vo = bv[2 * j + 1] + wv[0][2 * j + 1] * __uint_as_float(V2[j] & 0xFFFF0000u) + wv[1][2 * j + 1] * __uint_as_float(V1[j] & 0xFFFF0000u) + wv[2][2 * j + 1] * __uint_as_float(V0[j] & 0xFFFF0000u);
                o[2 * j] = gelu_tanh(ge) * ve; o[2 * j + 1] = gelu_tanh(go) * vo; }
            if (OUT8) { int p0 = 0, p1 = 0;
                p0 = __builtin_amdgcn_cvt_pk_fp8_f32(o[0], o[1], p0, false); p0 = __builtin_amdgcn_cvt_pk_fp8_f32(o[2], o[3], p0, true);
                p1 = __builtin_amdgcn_cvt_pk_fp8_f32(o[4], o[5], p1, false); p1 = __builtin_amdgcn_cvt_pk_fp8_f32(o[6], o[7], p1, true);
                u32x2 ov; ov.x = (unsigned)p0; ov.y = (unsigned)p1; *(u32x2*)((unsigned char*)ACT + (size_t)(t0 + r) * 4096 + c8) = ov; }
            else { u32x4 ov; ov.x = pack2bf(o[0], o[1]); ov.y = pack2bf(o[2], o[3]); ov.z = pack2bf(o[4], o[5]); ov.w = pack2bf(o[6], o[7]);
                *(u32x4*)(ACT + (size_t)(t0 + r) * 4096 + c8) = ov; }
            g2 = g1; g1 = g0; v2 = v1; v1 = v0;
        }
    }
}

__device__ __forceinline__ void ph_conv_lru(const float* __restrict__ wa, const float* __restrict__ wx, bf16_t* __restrict__ Bt, int bid, int nblk) {
    for (int e = bid * 512 + opaque_tid(); e < 8 * 2 * 128 * 128; e += nblk * 512) {
        const int d = e & 127, c = (e >> 7) & 127, gate = (e >> 14) & 1, nb = e >> 15;
        const float v = (gate ? wx : wa)[((size_t)nb * 128 + c) * 128 + d];
        bf16_t* row = Bt + (size_t)(nb * 256 + gate * 128 + d) * 256;
        row[(nb & 1) * 128 + c] = f2bf(v); row[(1 - (nb & 1)) * 128 + c] = 0;
    }
}

static constexpr size_t MiB = 1048576;
static constexpr size_t W_UP0 = 0 * MiB, W_UP1 = 32 * MiB, W_DN0 = 64 * MiB, W_DN1 = 80 * MiB, W_ABIN = 96 * MiB, W_ABOUT = 117 * MiB, W_CDIN = 125 * MiB, W_CDOUT = 137 * MiB,
                        W_QUP = 145 * MiB, W_KVUP = 146 * MiB + 512 * 1024, W_POOL = 147 * MiB + 512 * 1024;
static constexpr size_t R_H = 148 * MiB;
static constexpr size_t R_Q0 = 276 * MiB, R_K0 = 340 * MiB, R_VT0 = 404 * MiB, R_QI = 468 * MiB, R_M0 = 468 * MiB, R_U = 596 * MiB, R_KI = 724 * MiB, R_WI = 732 * MiB, R_MASK = 734 * MiB, R_CC0 = 830 * MiB, R_POOLED = 958 * MiB, R_H8A = 830 * MiB;
static constexpr size_t R_HID = 276 * MiB, R_ACT = 532 * MiB, R_F = 660 * MiB, R_X3 = 788 * MiB;
static constexpr size_t R_VT1 = 276 * MiB, R_CQ = 276 * MiB, R_CKV = 340 * MiB, R_KR = 372 * MiB, R_XL = 380 * MiB, R_YG = 444 * MiB, R_CQN = 508 * MiB, R_CKVN = 540 * MiB, R_LA = 556 * MiB, R_LB = 684 * MiB,
                        R_Q1 = 812 * MiB, R_K1 = 908 * MiB, R_Q8 = 956 * MiB,     R_CA = 1004 * MiB, R_CH = 1006 * MiB, R_CIN = 1008 * MiB, R_CC1 = 148 * MiB, R_M1 = 276 * MiB, R_XCB = 148 * MiB, W_LRU = 1010 * MiB;
static constexpr size_t WS_BAR = 1022 * MiB, WS_NEED = 1022 * MiB + 65536;
static constexpr int MK_LDS = 162816;

struct MK { const float* in[28]; float* out; unsigned char* ws; int ph_lo, ph_hi; };

__global__ __launch_bounds__(512, 2) void k_mega(MK p) {
    extern __shared__ __attribute__((aligned(16))) unsigned char shm[];
    LAS unsigned char* lds = (LAS unsigned char*)shm;
    const int bid0 = (int)blockIdx.x, nblk0 = (int)gridDim.x;
    volatile LAS unsigned* xbw = (volatile LAS unsigned*)(lds + MK_LDS - 16);
    if (threadIdx.x == 0) { xbw[0] = 0u; xbw[1] = 0u; xbw[2] = 0u; xbw[3] = 0u; }
    if ((threadIdx.x & 63) == 0) *(volatile LAS int*)(size_t)(TID_TAB_LDS + 4 * ((unsigned)__builtin_amdgcn_s_getreg(((6 - 1) << 11) | 4) & 63u)) = (int)(threadIdx.x >> 6);
    __syncthreads();
    XcdBarrier bar = xcd_barrier_post((unsigned*)(p.ws + WS_BAR), xbw);
#ifndef KARG_PLAIN
#define KARG_PLAIN 0
#endif
#if KARG_PLAIN
#define KARG_DECL const MK& P_ = p;
#else
#define KARG_DECL KPtr P__ = kp; asm volatile("" : "+s"(P__)); const __attribute__((address_space(4))) MK& P_ = *P__;
#endif
    typedef const __attribute__((address_space(4))) MK* KPtr;
    KPtr kp = (KPtr)__builtin_amdgcn_kernarg_segment_ptr();
#define WSP(T, off) ((T*)(ws + (off)))
#define PHASE_BEGIN if (pc >= p.ph_lo && pc < p.ph_hi) { const int bid = opaque_s(bid0), nblk = opaque_s(nblk0); \
    KARG_DECL unsigned char* const ws = P_.ws; float* const xo = P_.out; const float* const x = P_.in[0]; const int* const positions = (const int*)P_.in[1]; \
    const float *const mix_pre_g = P_.in[2], *const mix_post_g = P_.in[3], *const ffn_pre_g = P_.in[4], *const ffn_post_g = P_.in[5], *const ffn_up = P_.in[6], *const ffn_conv_w = P_.in[7], *const ffn_conv_b = P_.in[8], *const ffn_down = P_.in[9], \
    *const ab_w_in = P_.in[10], *const pool_w = P_.in[11], *const pool_b = P_.in[12], *const pool_scale = P_.in[13], *const ab_w_out = P_.in[14], *const cd_w_in = P_.in[15], *const q_norm_g = P_.in[16], *const w_q_up = P_.in[17], \
    *const kv_norm_g = P_.in[18], *const w_kv_up = P_.in[19], *const lru_conv_w = P_.in[20], *const lru_conv_b = P_.in[21], *const lru_wa = P_.in[22], *const lru_ba = P_.in[23], *const lru_wx = P_.in[24], *const lru_bx = P_.in[25], \
    *const lru_lambda = P_.in[26], *const cd_w_out = P_.in[27]; bf16_t* const H = WSP(bf16_t, R_H); const bf16_t* const CC = WSP(bf16_t, LAYER_CC); bf16_t* const Mx = WSP(bf16_t, LAYER_MX); \
    (void)xo; (void)x; (void)positions; (void)mix_pre_g; (void)mix_post_g; (void)ffn_pre_g; (void)ffn_post_g; (void)ffn_up; (void)ffn_conv_w; (void)ffn_conv_b; (void)ffn_down; (void)ab_w_in; (void)pool_w; (void)pool_b; (void)pool_scale; \
    (void)ab_w_out; (void)cd_w_in; (void)q_norm_g; (void)w_q_up; (void)kv_norm_g; (void)w_kv_up; (void)lru_conv_w; (void)lru_conv_b; (void)lru_wa; (void)lru_ba; (void)lru_wx; (void)lru_bx; (void)lru_lambda; (void)cd_w_out; (void)H; (void)CC; (void)Mx;
#define PHASE_END } if (pc >= p.ph_lo && pc + 1 < p.ph_hi) xcd_barrier(bar); ++pc;
    int pc = 0;
#define LAYER_CC R_CC0
#define LAYER_MX R_M0
    PHASE_BEGIN
#if !((SKIPMASK >> 0) & 1)
#if FP8_UP0
        ph_convT8(lds, ffn_up, 8192, 8192, 2048, WSP(unsigned char, W_UP0), bid, nblk, true);
#else
        ph_convT(lds, ffn_up, 8192, 0, 8192, 2048, WSP(bf16_t, W_UP0), 2048, bid, nblk, true);
#endif
#if FP8_UP1
        ph_convT8(lds, ffn_up + (size_t)2048 * 8192, 8192, 8192, 2048, WSP(unsigned char, W_UP1), bid, nblk, true);
#else
        ph_convT(lds, ffn_up + (size_t)2048 * 8192, 8192, 0, 8192, 2048, WSP(bf16_t, W_UP1), 2048, bid, nblk, true);
#endif
#if FP8_DN0
        ph_convT8(lds, ffn_down, 2048, 2048, 4096, WSP(unsigned char, W_DN0), bid, nblk);
#else
        ph_convT(lds, ffn_down, 2048, 0, 2048, 4096, WSP(bf16_t, W_DN0), 4096, bid, nblk);
#endif
#if FP8_DN1
        if (nblk != 256) ph_convT8(lds, ffn_down + (size_t)4096 * 2048, 2048, 2048, 4096, WSP(unsigned char, W_DN1), bid, nblk);
#else
        ph_convT(lds, ffn_down + (size_t)4096 * 2048, 2048, 0, 2048, 4096, WSP(bf16_t, W_DN1), 4096, bid, nblk);
#endif
#if FP8_QKV
        ph_convT8(lds, ab_w_in, 5200, 3072, 2048, WSP(unsigned char, W_ABIN), bid, nblk);
        ph_convT(lds, ab_w_in, 5200, 3072, 1024, 2048, WSP(bf16_t, W_ABIN) + (size_t)3072 * 2048, 2048, bid, nblk);
#else
        ph_convT(lds, ab_w_in, 5200, 0, 4096, 2048, WSP(bf16_t, W_ABIN), 2048, bid, nblk);
#endif
        ph_convT(lds, ab_w_in, 5200, 4176, 1024, 2048, WSP(bf16_t, W_ABIN) + (size_t)4096 * 2048, 2048, bid, nblk);
#define VB(first) ((bid + nblk - ((first) % nblk)) % nblk)
        ph_convT(lds, ab_w_in, 5200, 4096, 64, 2048, WSP(bf16_t, W_ABIN) + (size_t)5120 * 2048, 2048, VB(104), nblk);
        ph_convT(lds, ab_w_in, 5200, 4160, 16, 2048, WSP(bf16_t, W_ABIN) + (size_t)5184 * 2048, 2048, VB(112), nblk);
        ph_convT(lds, ab_w_out, 2048, 0, 2048, 2048, WSP(bf16_t, W_ABOUT), 2048, bid, nblk);
        if (nblk != 256) {
        ph_convT(lds, cd_w_in, 2880, 0, 832, 2048, WSP(bf16_t, W_CDIN), 2048, bid, nblk, false, mix_pre_g + 2048);
        ph_convT(lds, cd_w_in, 2880, 832, 2048, 2048, WSP(bf16_t, W_CDIN) + (size_t)1024 * 2048, 2048, bid, nblk, false, mix_pre_g + 2048);
        ph_convT(lds, cd_w_out, 2048, 0, 2048, 2048, WSP(bf16_t, W_CDOUT), 2048, bid, nblk);
        ph_convT(lds, w_q_up, 1536, 0, 1536, 512, WSP(bf16_t, W_QUP), 512, VB(136), nblk);
        ph_convT(lds, w_kv_up, 2048, 0, 2048, 256, WSP(bf16_t, W_KVUP), 256, VB(184), nblk);
        }
        for (int g = 0; g < 4; ++g) ph_convT(lds, pool_w + (size_t)g * 65536, 256, 0, 256, 256, WSP(bf16_t, W_POOL) + (size_t)g * 65536, 256, VB(120 + 4 * g), nblk);
#undef VB
        {
            const u32x4 z = {0u, 0u, 0u, 0u};
            for (int t = bid * 512 + opaque_tid(); t < 45056 + 49152; t += nblk * 512) {
                if (t < 45056) ((u32x4*)(ws + W_ABIN + (size_t)5200 * 2048 * 2))[t] = z; else ((u32x4*)(ws + W_CDIN + (size_t)832 * 2048 * 2))[t - 45056] = z; }
        }
        ph_rmsnorm<2048>(x, mix_pre_g, H, bid, nblk, FP8_QKV ? WSP(unsigned char, R_H8A) : (unsigned char*)nullptr);
#endif
    PHASE_END
    {
            PHASE_BEGIN
#if !((SKIPMASK >> 1) & 1)
                FAbIn2 f; f.Q = WSP(unsigned char, R_Q0); f.K = WSP(unsigned char, R_K0); f.VT = WSP(bf16_t, R_VT0); f.QI = WSP(unsigned short, R_QI); f.U = WSP(float, R_U); f.WI = WSP(float, R_WI); f.KI16 = WSP(unsigned short, R_KI);
#if FP8_QKV
                { EpiG8<FAbIn2, true> e8; e8.f = f; ph_gemm_e(lds, (const bf16_t*)WSP(unsigned char, R_H8A), 1024, (const bf16_t*)WSP(unsigned char, W_ABIN), 1024, NTOK, 3072, 1024, e8, bid, nblk, 0, 0, 0, nblk == 256 ? 5 : 0); }
                { EpiG8<FAbInHi> e8; e8.f.f = f; ph_gemm_e(lds, H, 2048, WSP(bf16_t, W_ABIN) + (size_t)3072 * 2048, 2048, NTOK, 2304, 2048, e8, bid, nblk); }
#else
                ph_gemm(lds, H, 2048, WSP(bf16_t, W_ABIN), 2048, NTOK, 5376, 2048, f, bid, nblk);
#endif
#endif
            PHASE_END
            PHASE_BEGIN
#if !((SKIPMASK >> 2) & 1)
                ph_pooled(WSP(float, R_U), WSP(bf16_t, R_POOLED), bid, nblk);
                IdxArgs a; a.QI = WSP(unsigned short, R_QI); a.KI16 = WSP(unsigned short, R_KI); a.WI = WSP(float, R_WI); a.MT = WSP(unsigned long long, R_MASK);
                idx_phase(lds, a, bid, nblk);
#endif
            PHASE_END
            PHASE_BEGIN
#if !((SKIPMASK >> 3) & 1)
                { FPool f; f.CC = WSP(bf16_t, R_CC0); f.pb = pool_b; f.ps = pool_scale; EpiG8<FPool> e8; e8.f = f; ph_gemm_e(lds, WSP(bf16_t, R_POOLED), 1024, WSP(bf16_t, W_POOL), 256, NTOK, 1024, 256, e8, bid, nblk, 0, 512); }
                AttnArgs a; a.Q = WSP(bf16_t, R_Q0); a.K = WSP(bf16_t, R_K0); a.VT = WSP(bf16_t, R_VT0); a.MT = WSP(unsigned long long, R_MASK); a.O = WSP(bf16_t, R_CC0); a.ldq = 1024; a.ldk = 1024; a.ldo = 2048;
                a.sc_log2e = 0.08838834764831845f * 1.4426950408889634f;
                attn_phase<128, true>(lds, a, bid, nblk);
#endif
            PHASE_END
        PHASE_BEGIN
#if !((SKIPMASK >> 4) & 1)
            FStoreBf16 f; f.O = Mx; f.ldc = 2048; f.pad_ = 0;
            ph_gemm_st16(lds, CC, 2048, WSP(bf16_t, W_ABOUT), 2048, NTOK, 2048, 2048, f.O, f.ldc, bid, nblk);
#endif
        PHASE_END
        PHASE_BEGIN
#if !((SKIPMASK >> 5) & 1)
            ph_resnorm<false, true>(x, Mx, mix_post_g + 0, ffn_pre_g + 0, xo, H, FP8_UP0 ? WSP(unsigned char, R_H) : (unsigned char*)nullptr, bid, nblk);
#endif
        PHASE_END
        PHASE_BEGIN
#if FP8_UP0
            { EpiGate<FP8_DN0 != 0, true> ep; ep.cw = ffn_conv_w + 0; ep.cb = ffn_conv_b + 0; ep.ACT = WSP(void, R_HID);
              ph_gemm_e(lds, (const bf16_t*)WSP(unsigned char, R_H), 1024, (const bf16_t*)WSP(unsigned char, W_UP0), 1024, 134 * 256, 8192, 1024, ep, bid, nblk, 0, 0, 1); }
#else
            { EpiGate<FP8_DN0 != 0, false> ep; ep.cw = ffn_conv_w + 0; ep.cb = ffn_conv_b + 0; ep.ACT = WSP(void, R_HID);
              ph_gemm_e(lds, H, 2048, WSP(bf16_t, W_UP0), 2048, 134 * 256, 8192, 2048, ep, bid, nblk, 0, 0, 1); }
#endif
            if (nblk == 256 && bid >= 192) { const int vb = bid - 192;
                ph_convT(lds, cd_w_in, 2880, 0, 832, 2048, WSP(bf16_t, W_CDIN), 2048, vb, 64, false, mix_pre_g + 2048);
                ph_convT(lds, cd_w_in, 2880, 832, 2048, 2048, WSP(bf16_t, W_CDIN) + (size_t)1024 * 2048, 2048, vb, 64, false, mix_pre_g + 2048);
                ph_convT(lds, cd_w_out, 2048, 0, 2048, 2048, WSP(bf16_t, W_CDOUT), 2048, vb, 64);
                ph_convT(lds, w_q_up, 1536, 0, 1536, 512, WSP(bf16_t, W_QUP), 512, vb, 64);
                ph_convT(lds, w_kv_up, 2048, 0, 2048, 256, WSP(bf16_t, W_KVUP), 256, (vb + 32) & 63, 64); }
        PHASE_END
        PHASE_BEGIN
            FStoreBf16 f; f.O = WSP(bf16_t, R_F); f.ldc = 2048; f.pad_ = 0;
#if FP8_DN0
            ph_gemm8(lds, WSP(unsigned char, R_HID), 4096, WSP(unsigned char, W_DN0), 4096, NTOK, 2048, 4096, f, bid, nblk);
#else
            ph_gemm_st16(lds, WSP(bf16_t, R_HID), 4096, WSP(bf16_t, W_DN0), 4096, NTOK, 2048, 4096, f.O, f.ldc, bid, nblk);
#endif
        PHASE_END
        PHASE_BEGIN
#if !((SKIPMASK >> 9) & 1)
            ph_resnorm<true, true>(xo, WSP(bf16_t, R_F), ffn_post_g + 0, mix_pre_g + 2048, xo, H, nullptr, bid, nblk, WSP(float, R_CA));
#endif
        PHASE_END
    }
    {
#undef LAYER_CC
#undef LAYER_MX
#define LAYER_CC R_CC1
#define LAYER_MX R_M1
            PHASE_BEGIN
#if !((SKIPMASK >> 10) & 1)
                FCdIn f; f.CQ = WSP(float, R_CQ); f.CKV = WSP(float, R_CKV); f.KR = WSP(float, R_KR); f.XL = WSP(bf16_t, R_XL); f.YG = WSP(bf16_t, R_YG);
                { EpiGRow8<FCdIn> ep; ep.f = f; ep.rs = WSP(float, R_CA); ph_gemm_e(lds, (const bf16_t*)xo, 2048, WSP(bf16_t, W_CDIN), 2048, NTOK, 3072, 2048, ep, bid, nblk); }
#endif
            PHASE_END
            PHASE_BEGIN
#if !((SKIPMASK >> 11) & 1)
                ph_xc(WSP(bf16_t, R_XL), lru_conv_w, lru_conv_b, WSP(bf16_t, R_XCB), bid, nblk);
                ph_conv_lru(lru_wa, lru_wx, WSP(bf16_t, W_LRU), bid, nblk);
                ph_rmsnorm<512>(WSP(float, R_CQ), q_norm_g, WSP(bf16_t, R_CQN), bid, nblk);
                ph_rmsnorm<256>(WSP(float, R_CKV), kv_norm_g, WSP(bf16_t, R_CKVN), bid, nblk);
            PHASE_END
            PHASE_BEGIN
                { EpiLru ep; ep.XCB = WSP(bf16_t, R_XCB); ep.ba = lru_ba; ep.bx = lru_bx; ep.lam = lru_lambda; ep.LA = WSP(bf16_t, R_LA); ep.LB = WSP(bf16_t, R_LB);
                  ph_gemm_e(lds, WSP(bf16_t, R_XCB), 1024, WSP(bf16_t, W_LRU), 256, NTOK, 2048, 256, ep, bid, nblk, 1, 512); }
                { ph_gemm_st16(lds, WSP(bf16_t, R_CQN), 512, WSP(bf16_t, W_QUP), 512, NTOK, 1536, 512, WSP(bf16_t, R_Q1), 1536, bid, nblk); }
                { FKvUp2 f; f.K8 = WSP(unsigned char, R_K1); f.VT = WSP(bf16_t, R_VT1); EpiG8<FKvUp2> e8; e8.f = f; ph_gemm_e(lds, WSP(bf16_t, R_CKVN), 256, WSP(bf16_t, W_KVUP), 256, NTOK, 2048, 256, e8, bid, nblk); }
            PHASE_END
            PHASE_BEGIN
                ph_scan1(WSP(bf16_t, R_LA), WSP(bf16_t, R_LB), WSP(float, R_CA), WSP(float, R_CH), bid, nblk);
                ph_rope_q(WSP(bf16_t, R_Q1), positions, WSP(unsigned char, R_Q8), bid, nblk);
                ph_rope_k(WSP(float, R_KR), positions, WSP(unsigned char, R_K1), bid, nblk);
            PHASE_END
            PHASE_BEGIN
                ph_scan2(WSP(float, R_CA), WSP(float, R_CH), WSP(float, R_CIN), bid, nblk);
            PHASE_END
            PHASE_BEGIN
                ph_scan3(WSP(bf16_t, R_LA), WSP(bf16_t, R_LB), WSP(float, R_CIN), WSP(bf16_t, R_YG), WSP(bf16_t, R_CC1), bid, nblk);
                AttnArgs a; a.Q = WSP(bf16_t, R_Q8); a.K = WSP(bf16_t, R_K1); a.VT = WSP(bf16_t, R_VT1); a.MT = nullptr; a.O = WSP(bf16_t, R_CC1); a.ldq = 1536; a.ldk = 1536; a.ldo = 2048;
                a.sc_log2e = 0.07216878364870322f * 1.4426950408889634f;
                attn_phase<192, false>(lds, a, bid, nblk);
#endif
            PHASE_END
        PHASE_BEGIN
#if !((SKIPMASK >> 15) & 1)
            FStoreBf16 f; f.O = Mx; f.ldc = 2048; f.pad_ = 0;
            ph_gemm_st16(lds, CC, 2048, WSP(bf16_t, W_CDOUT), 2048, NTOK, 2048, 2048, f.O, f.ldc, bid, nblk);
#endif
        PHASE_END
        PHASE_BEGIN
#if !((SKIPMASK >> 16) & 1)
            ph_resnorm<true, true>(xo, Mx, mix_post_g + 2048, ffn_pre_g + 2048, WSP(bf16_t, R_X3), H, FP8_UP1 ? WSP(unsigned char, R_H) : (unsigned char*)nullptr, bid, nblk);
#endif
        PHASE_END
        PHASE_BEGIN
#if FP8_UP1
            { EpiGate<FP8_DN1 != 0, true> ep; ep.cw = ffn_conv_w + 24576; ep.cb = ffn_conv_b + 8192; ep.ACT = WSP(void, R_HID);
              ph_gemm_e(lds, (const bf16_t*)WSP(unsigned char, R_H), 1024, (const bf16_t*)WSP(unsigned char, W_UP1), 1024, 134 * 256, 8192, 1024, ep, bid, nblk, 0, 0, 1); }
#else
            { EpiGate<FP8_DN1 != 0, false> ep; ep.cw = ffn_conv_w + 24576; ep.cb = ffn_conv_b + 8192; ep.ACT = WSP(void, R_HID);
              ph_gemm_e(lds, H, 2048, WSP(bf16_t, W_UP1), 2048, 134 * 256, 8192, 2048, ep, bid, nblk, 0, 0, 1); }
#endif
#if FP8_DN1
            if (nblk == 256 && bid >= 192) ph_convT8(lds, ffn_down + (size_t)4096 * 2048, 2048, 2048, 4096, WSP(unsigned char, W_DN1), bid - 192, 64);
#endif
        PHASE_END
        PHASE_BEGIN
            FStoreBf16 f; f.O = WSP(bf16_t, R_F); f.ldc = 2048; f.pad_ = 0;
#if FP8_DN1
            ph_gemm8_st16(lds, WSP(unsigned char, R_HID), 4096, WSP(unsigned char, W_DN1), 4096, NTOK, 2048, 4096, f.O, f.ldc, bid, nblk);
#else
            ph_gemm(lds, WSP(bf16_t, R_HID), 4096, WSP(bf16_t, W_DN1), 4096, NTOK, 2048, 4096, f, bid, nblk);
#endif
        PHASE_END
        PHASE_BEGIN
#if !((SKIPMASK >> 20) & 1)
            ph_resnorm<true, false>(WSP(bf16_t, R_X3), WSP(bf16_t, R_F), ffn_post_g + 2048, (const float*)nullptr, xo, H, nullptr, bid, nblk);
#endif
        PHASE_END
    }
#undef LAYER_CC
#undef LAYER_MX
#undef WSP
#undef PHASE_BEGIN
#undef PHASE_END
}

#ifndef MK_N_LAUNCHES
#define MK_N_LAUNCHES 1
#endif
static constexpr int MK_NPHASES = 1 + 3 + 7 + 2 * 5;

extern "C" void kernel_launch(void* const* d_in, const int* in_sizes, int n_in, void* d_out, int out_size, void* d_ws, size_t ws_size, hipStream_t stream) {
    static int grid = 0;
    if (grid == 0) {
        if (n_in != 28 || out_size != NTOK * DM || ws_size < WS_NEED) { fprintf(stderr, "kernel_launch: unexpected shapes (n_in %d out %d ws %zu)\n", n_in, out_size, ws_size); grid = -1; return; }
        int dev = 0, cus = 0, per_cu = 0;
        if (hipGetDevice(&dev) != hipSuccess || hipDeviceGetAttribute(&cus, hipDeviceAttributeMultiprocessorCount, dev) != hipSuccess) { grid = -1; return; }
        if (hipFuncSetAttribute((const void*)k_mega, hipFuncAttributeMaxDynamicSharedMemorySize, MK_LDS) != hipSuccess) { fprintf(stderr, "kernel_launch: hipFuncSetAttribute failed\n"); grid = -1; return; }
        if (hipOccupancyMaxActiveBlocksPerMultiprocessor(&per_cu, (const void*)k_mega, 512, MK_LDS) != hipSuccess || per_cu < 1) { fprintf(stderr, "kernel_launch: occupancy query says %d\n", per_cu); }
        (void)hipGetLastError();
        grid = cus;
        if (grid != 256) { fprintf(stderr, "kernel_launch: built for 256 CUs, found %d\n", grid); grid = -1; return; }
    }
    if (grid < 0) return;
    unsigned char* ws = (unsigned char*)d_ws;
    (void)hipMemsetAsync(ws + WS_BAR, 0, XCD_BAR_WORDS * sizeof(unsigned), stream);
    MK p{};
    for (int i = 0; i < 28; ++i) p.in[i] = (const float*)d_in[i];
    p.out = (float*)d_out; p.ws = ws;
#if MK_N_LAUNCHES == 1
    p.ph_lo = 0; p.ph_hi = 1 << 20;
    hipLaunchKernelGGL(k_mega, dim3(grid), dim3(512), MK_LDS, stream, p);
#else
    for (int ph = 0; ph < MK_NPHASES; ++ph) { p.ph_lo = ph; p.ph_hi = ph + 1; hipLaunchKernelGGL(k_mega, dim3(grid), dim3(512), MK_LDS, stream, p); }
#endif
}
```
